# Optimizing an MI355X kernel written in HIP

```python
import math
import jax, jax.numpy as jnp
from jax import lax
import numpy as np

D_MODEL = 2048
BATCH = 8
SEQ = 4096
DEPTH = 2

H_A = 8
HD_A = 128
KV_RANK = 256
IDX_HEADS = 8
IDX_DIM = 64
TOPK_MAX = 256
H_B = 16
KVH_B = 2
GQA_GROUP = H_B // KVH_B
HD_B = 64
WINDOW = 128
BLOCK = 128
N_BUCKETS = 32
MAX_DISTANCE = 128
N_BIAS_HEADS = H_A + H_B
D_FF = 5632
EPS = 1e-6

W_QA = H_A * HD_A
W_CKV = KV_RANK
W_QI = IDX_HEADS * IDX_DIM
W_KI = IDX_DIM
W_WI = IDX_HEADS
W_QB = H_B * HD_B
W_KB = KVH_B * HD_B
W_VB = KVH_B * HD_B
D_IN = W_QA + W_CKV + W_QI + W_KI + W_WI + W_QB + W_KB + W_VB
D_MIX = H_A * HD_A + H_B * HD_B

kernel_name = "hymba_dsa_swa_macaron_t5"


def rmsnorm(x, g):
    xf = x.astype(jnp.float32)
    y = xf * lax.rsqrt(jnp.mean(xf * xf, axis=-1, keepdims=True) + EPS)
    return (y * g.astype(jnp.float32)).astype(x.dtype)


def layernorm(x, g, b):
    xf = x.astype(jnp.float32)
    mu = jnp.mean(xf, axis=-1, keepdims=True)
    var = jnp.mean(jnp.square(xf - mu), axis=-1, keepdims=True)
    y = (xf - mu) * lax.rsqrt(var + EPS)
    return (y * g.astype(jnp.float32) + b.astype(jnp.float32)).astype(x.dtype)


def swiglu(x, w_gate, w_up, w_down):
    return (jax.nn.silu(x @ w_gate) * (x @ w_up)) @ w_down


def t5_bucket(dist):
    n = jnp.maximum(dist, 0)
    max_exact = N_BUCKETS // 2
    nf = jnp.maximum(n, 1).astype(jnp.float32)
    large = max_exact + (jnp.log(nf / max_exact) / math.log(MAX_DISTANCE / max_exact)
                         * (N_BUCKETS - max_exact)).astype(jnp.int32)
    large = jnp.minimum(large, N_BUCKETS - 1)
    return jnp.where(n < max_exact, n, large)


def dsa_mixer(q, c_kv, q_idx, k_idx, w_idx, w_uk, w_uv, bias_table):
    b, s = q.shape[0], q.shape[1]
    nb = s // BLOCK
    k_sel = min(TOPK_MAX, s // 4)
    q_lat = jnp.einsum("bshd,rhd->bshr", q, w_uk)
    key_pos = jnp.arange(s)
    k_idx32 = k_idx.astype(jnp.float32)

    def to_blocks(a):
        return a.reshape((b, nb, BLOCK) + a.shape[2:]).swapaxes(0, 1)

    def block_fn(args):
        qi, ql, wi, blk = args
        t = blk * BLOCK + jnp.arange(BLOCK)
        dots = jnp.einsum("bthd,bsd->bths", qi.astype(jnp.float32), k_idx32)
        score = jnp.einsum("bth,bths->bts", wi.astype(jnp.float32), jax.nn.relu(dots))
        score = jnp.where((key_pos[None, :] <= t[:, None])[None], score, -jnp.inf)
        _, idx = lax.top_k(score, k_sel)
        c_sel = jax.vmap(lambda c, i: c[i])(c_kv, idx)
        dist = t[None, :, None] - idx
        bias = jnp.moveaxis(bias_table[t5_bucket(dist)], -1, 2).astype(jnp.float32)
        logits = jnp.einsum("bthr,btkr->bthk", ql, c_sel).astype(jnp.float32) * (HD_A ** -0.5) + bias
        logits = jnp.where((dist >= 0)[:, :, None, :], logits, -jnp.inf)
        p = jax.nn.softmax(logits, axis=-1).astype(c_sel.dtype)
        return jnp.einsum("bthk,btkr->bthr", p, c_sel)

    o_lat = lax.map(block_fn, (to_blocks(q_idx), to_blocks(q_lat), to_blocks(w_idx), jnp.arange(nb)))
    o_lat = o_lat.swapaxes(0, 1).reshape(b, s, H_A, KV_RANK)
    return jnp.einsum("bshr,rhd->bshd", o_lat, w_uv).reshape(b, s, H_A * HD_A)


def swa_mixer(q, k, v, sinks, bias_table):
    b, s = q.shape[0], q.shape[1]
    nb = s // BLOCK
    qb = q.reshape(b, nb, BLOCK, KVH_B, GQA_GROUP, HD_B).swapaxes(0, 1)

    def band(a):
        a = a.reshape(b, nb, BLOCK, KVH_B, HD_B)
        prev = jnp.concatenate([jnp.zeros_like(a[:, :1]), a[:, :-1]], axis=1)
        return jnp.concatenate([prev, a], axis=2).swapaxes(0, 1)

    kb, vb = band(k), band(v)
    qi_pos = jnp.arange(BLOCK)
    kj_pos = jnp.arange(2 * BLOCK)
    dist = BLOCK + qi_pos[:, None] - kj_pos[None, :]
    in_window = (dist >= 0) & (dist < WINDOW)
    bias = jnp.moveaxis(bias_table[t5_bucket(dist)], -1, 0)
    bias = bias.reshape(KVH_B, GQA_GROUP, BLOCK, 2 * BLOCK).astype(jnp.float32)
    sink = sinks.astype(jnp.float32).reshape(KVH_B, GQA_GROUP, 1, 1)

    def block_fn(args):
        qi, ki, vi, blk = args
        mask = in_window & (((blk - 1) * BLOCK + kj_pos) >= 0)[None, :]
        logits = jnp.einsum("btkgd,bskd->bkgts", qi, ki).astype(jnp.float32) * (HD_B ** -0.5) + bias
        logits = jnp.where(mask, logits, -jnp.inf)
        sink_col = jnp.broadcast_to(sink, logits.shape[:-1] + (1,))
        p = jax.nn.softmax(jnp.concatenate([logits, sink_col], axis=-1), axis=-1)[..., :-1]
        return jnp.einsum("bkgts,bskd->btkgd", p.astype(vi.dtype), vi)

    o = lax.map(block_fn, (qb, kb, vb, jnp.arange(nb)))
    return o.swapaxes(0, 1).reshape(b, s, H_B * HD_B)


def setup_inputs(seed: int = 0) -> dict:
    key = jax.random.key(seed)
    ks = jax.random.split(key, 24)
    f32 = jnp.float32

    def nrm(k, shape, scale):
        return jax.random.normal(k, shape, f32) * scale

    def gain(k, shape):
        return 1.0 + 0.01 * jax.random.normal(k, shape, f32)

    L = DEPTH
    return {
        "x": jax.random.normal(ks[0], (BATCH, SEQ, D_MODEL), f32),
        "rel_bias": nrm(ks[1], (N_BUCKETS, N_BIAS_HEADS), 0.3),
        "ffn1_norm": gain(ks[2], (L, D_MODEL)),
        "ffn1_gate": nrm(ks[3], (L, D_MODEL, D_FF), D_MODEL ** -0.5),
        "ffn1_up": nrm(ks[4], (L, D_MODEL, D_FF), D_MODEL ** -0.5),
        "ffn1_down": nrm(ks[5], (L, D_FF, D_MODEL), D_FF ** -0.5),
        "mix_norm": gain(ks[6], (L, D_MODEL)),
        "w_in": nrm(ks[7], (L, D_MODEL, D_IN), D_MODEL ** -0.5),
        "kv_norm": gain(ks[8], (L, KV_RANK)),
        "idx_k_norm_g": gain(ks[9], (L, IDX_DIM)),
        "idx_k_norm_b": nrm(ks[10], (L, IDX_DIM), 0.01),
        "w_uk": nrm(ks[11], (L, KV_RANK, H_A, HD_A), KV_RANK ** -0.5),
        "w_uv": nrm(ks[12], (L, KV_RANK, H_A, HD_A), KV_RANK ** -0.5),
        "sinks": nrm(ks[13], (L, H_B), 0.5),
        "w_out": nrm(ks[14], (L, D_MIX, D_MODEL), D_MIX ** -0.5),
        "ffn2_norm": gain(ks[15], (L, D_MODEL)),
        "ffn2_gate": nrm(ks[16], (L, D_MODEL, D_FF), D_MODEL ** -0.5),
        "ffn2_up": nrm(ks[17], (L, D_MODEL, D_FF), D_MODEL ** -0.5),
        "ffn2_down": nrm(ks[18], (L, D_FF, D_MODEL), D_FF ** -0.5),
        "final_norm": gain(ks[19], (D_MODEL,)),
    }


def reference(x, rel_bias, ffn1_norm, ffn1_gate, ffn1_up, ffn1_down, mix_norm, w_in, kv_norm,
              idx_k_norm_g, idx_k_norm_b, w_uk, w_uv, sinks, w_out, ffn2_norm, ffn2_gate,
              ffn2_up, ffn2_down, final_norm):
    b, s, _ = x.shape
    bias_a = rel_bias[:, :H_A]
    bias_b = rel_bias[:, H_A:]
    splits = [W_QA, W_CKV, W_QI, W_KI, W_WI, W_QB, W_KB]
    cuts = [int(c) for c in np.cumsum(splits)]
    h = x
    for l in range(DEPTH):
        h = h + 0.5 * swiglu(rmsnorm(h, ffn1_norm[l]), ffn1_gate[l], ffn1_up[l], ffn1_down[l])
        z = rmsnorm(h, mix_norm[l]) @ w_in[l]
        q_a, c_kv, q_i, k_i, w_i, q_b, k_b, v_b = jnp.split(z, cuts, axis=-1)
        q_a = q_a.reshape(b, s, H_A, HD_A)
        c_kv = rmsnorm(c_kv, kv_norm[l])
        q_i = q_i.reshape(b, s, IDX_HEADS, IDX_DIM)
        k_i = layernorm(k_i, idx_k_norm_g[l], idx_k_norm_b[l])
        w_i = w_i * (IDX_HEADS ** -0.5 * IDX_DIM ** -0.5)
        o_a = dsa_mixer(q_a, c_kv, q_i, k_i, w_i, w_uk[l], w_uv[l], bias_a)
        o_b = swa_mixer(q_b.reshape(b, s, H_B, HD_B), k_b.reshape(b, s, KVH_B, HD_B),
                        v_b.reshape(b, s, KVH_B, HD_B), sinks[l], bias_b)
        h = h + jnp.concatenate([o_a, o_b], axis=-1) @ w_out[l]
        h = h + 0.5 * swiglu(rmsnorm(h, ffn2_norm[l]), ffn2_gate[l], ffn2_up[l], ffn2_down[l])
    return rmsnorm(h, final_norm)
```

```cpp
#include <hip/hip_runtime.h>
#include <cstdio>
#include <cstdint>
namespace pg8 {
#define PG8_LAS __attribute__((address_space(3)))
#define PG8_GAS __attribute__((address_space(1)))
typedef unsigned short bf16_t;
typedef short bf16x8 __attribute__((ext_vector_type(8)));
typedef float f32x4 __attribute__((ext_vector_type(4)));
typedef unsigned u32x4 __attribute__((ext_vector_type(4)));
constexpr int BM = 256, BK = 64, HALF = 128, HTB = HALF * BK * 2  , STAGE_BYTES = 8 * HTB, NXCD = 8, WGM = 8;

__host__ __device__ __forceinline__ int lds_byte(int r, int c) { const int st = (r >> 4) * 2 + (c >> 5), rr = r & 15, cc = c & 31, ob = rr * 64 + cc * 2; return st * 1024 + (ob ^ (((ob >> 9) & 1) << 5)); }
__host__ __device__ __forceinline__ void stage_rc(int b, int& R, int& C) { const int st = b / 1024, sb = b % 1024, swz = sb ^ (((sb >> 9) & 1) << 5); R = (st >> 1) * 16 + swz / 64; C = (st & 1) * 32 + (swz % 64) / 2; }
__host__ __device__ __forceinline__ int perm32(int rho) { const int n = rho >> 4, i = rho & 15; return 8 * (i >> 2) + 4 * n + (i & 3); }

struct Unit { int pm, pn; };
struct Gemm { const PG8_GAS bf16_t* A; const PG8_GAS bf16_t* Bt; int M, N, K; };

struct StaticOrder {
    int nM, nN, nwg, G, c;
    __host__ __device__ void init(int M, int N, int G_, int c_) { nM = M / BM; nN = N / BM; nwg = nM * nN; G = G_; c = c_; }
    __host__ __device__ bool next(int i, Unit& u) const {
        const long L = (long)i * G + c; if (L >= nwg) return false;
        int wgid = (int)L; { const int q = nwg / NXCD, r = nwg % NXCD, xcd = wgid % NXCD, off = wgid / NXCD; wgid = (xcd < r ? xcd * (q + 1) : r * (q + 1) + (xcd - r) * q) + off; }
        const int nig = WGM * nN, gid = wgid / nig, fm = gid * WGM, gsz = (nM - fm) < WGM ? (nM - fm) : WGM;
        u.pm = fm + ((wgid % nig) % gsz); u.pn = (wgid % nig) / gsz; return true;
    }
    __device__ __forceinline__ void a_ready(const Unit&) const {}
    __device__ __forceinline__ void done(const Unit&) const {}
};
__device__ __forceinline__ unsigned cvt_pk_bf16(float lo, float hi) { unsigned r; asm volatile("v_cvt_pk_bf16_f32 %0, %1, %2" : "=v"(r) : "v"(lo), "v"(hi)); return r; }
__device__ __forceinline__ float silu_f(float g) { return g * __builtin_amdgcn_rcpf(1.0f + __builtin_amdgcn_exp2f(-1.4426950408889634f * g)); }

struct EpiSwiglu {
    static constexpr bool PERM = true, AFTER_DRAIN = false;
    PG8_GAS bf16_t* O; int ldc;
    __device__ __forceinline__ void operator()(const f32x4 (&acc)[2][2][4][2], const Unit& u, int wr, int wc, int fr, int fq) const {
        const int row0 = u.pm * BM + wr * 64 + fr, col0 = u.pn * HALF + wc * 32 + 8 * fq;
#pragma unroll
        for (int ai = 0; ai < 2; ++ai)
#pragma unroll
            for (int m = 0; m < 4; ++m) { PG8_GAS bf16_t* rowp = O + (size_t)(row0 + ai * HALF + m * 16) * ldc + col0;
                const f32x4 g0 = acc[ai][0][m][0], g1 = acc[ai][0][m][1], u0 = acc[ai][1][m][0], u1 = acc[ai][1][m][1];
                u32x4 w; w.x = cvt_pk_bf16(silu_f(g0[0]) * u0[0], silu_f(g0[1]) * u0[1]); w.y = cvt_pk_bf16(silu_f(g0[2]) * u0[2], silu_f(g0[3]) * u0[3]);
                w.z = cvt_pk_bf16(silu_f(g1[0]) * u1[0], silu_f(g1[1]) * u1[1]); w.w = cvt_pk_bf16(silu_f(g1[2]) * u1[2], silu_f(g1[3]) * u1[3]);
                *(PG8_GAS u32x4*)rowp = w; }
    }
};
struct EpiResid {
    static constexpr bool PERM = false, AFTER_DRAIN = false;
    const PG8_GAS float* base; PG8_GAS float* out; int ldc; float alpha;
    __device__ __forceinline__ void operator()(const f32x4 (&acc)[2][2][4][2], const Unit& u, int wr, int wc, int fr, int fq) const {
        const int row0 = u.pm * BM + wr * 64 + fr, col0 = u.pn * BM + wc * 32 + 4 * fq;
        f32x4 cur[4], nxt[4];
        { const size_t off = (size_t)row0 * ldc + col0;
#pragma unroll
          for (int q = 0; q < 4; ++q) cur[q] = *(const PG8_GAS f32x4*)(base + off + (q >> 1) * HALF + (q & 1) * 16); }
#pragma unroll
        for (int k = 0; k < 8; ++k) { const int ai = k >> 2, m = k & 3; const size_t off = (size_t)(row0 + ai * HALF + m * 16) * ldc + col0;
            if (k < 7) { const int ai2 = (k + 1) >> 2, m2 = (k + 1) & 3; const size_t off2 = (size_t)(row0 + ai2 * HALF + m2 * 16) * ldc + col0;
#pragma unroll
                for (int q = 0; q < 4; ++q) nxt[q] = *(const PG8_GAS f32x4*)(base + off2 + (q >> 1) * HALF + (q & 1) * 16); }
#pragma unroll
            for (int q = 0; q < 4; ++q) *(PG8_GAS f32x4*)(out + off + (q >> 1) * HALF + (q & 1) * 16) = cur[q] + acc[ai][q >> 1][m][q & 1] * alpha;
#pragma unroll
            for (int q = 0; q < 4; ++q) cur[q] = nxt[q]; }
    }
};
struct EpiBf16 {
    static constexpr bool PERM = true, AFTER_DRAIN = false;
    PG8_GAS bf16_t* O; int ldc;
    __device__ __forceinline__ void operator()(const f32x4 (&acc)[2][2][4][2], const Unit& u, int wr, int wc, int fr, int fq) const {
        const int row0 = u.pm * BM + wr * 64 + fr, col0 = u.pn * BM + wc * 32 + 8 * fq;
#pragma unroll
        for (int ai = 0; ai < 2; ++ai)
#pragma unroll
            for (int m = 0; m < 4; ++m) { PG8_GAS bf16_t* rowp = O + (size_t)(row0 + ai * HALF + m * 16) * ldc + col0;
#pragma unroll
                for (int bj = 0; bj < 2; ++bj) { const f32x4 v0 = acc[ai][bj][m][0], v1 = acc[ai][bj][m][1];
                    u32x4 w; w.x = cvt_pk_bf16(v0[0], v0[1]); w.y = cvt_pk_bf16(v0[2], v0[3]); w.z = cvt_pk_bf16(v1[0], v1[1]); w.w = cvt_pk_bf16(v1[2], v1[3]);
                    *(PG8_GAS u32x4*)(rowp + bj * HALF) = w; } }
    }
};
template <class Epi, class Sched, bool ALIGN_EPI = false, bool SP2 = false>
__device__ __forceinline__ void gemm_phase(PG8_LAS unsigned char* lds, const Gemm g, const Sched& S, const Epi& E) {
    int tid_ = threadIdx.x; asm volatile("" : "+v"(tid_));
    const int tid = tid_, wid = __builtin_amdgcn_readfirstlane(tid >> 6), lane = tid & 63, wr = wid >> 2, wc = wid & 3, fr = lane & 15, fq = lane >> 4;
    const int K = g.K, nt = K / BK;
    unsigned voffA[2], voffB[2];
#pragma unroll
    for (int i = 0; i < 2; ++i) { int R, C; stage_rc(tid * 16 + i * 8192, R, C); const int Rb = Epi::PERM ? ((R & ~31) + perm32(R & 31)) : R;
        voffA[i] = (unsigned)(R * K + C) * 2u; voffB[i] = (unsigned)(Rb * K + C) * 2u; }
    const size_t kstep = (size_t)(BK * 2);
    const size_t hstep = (size_t)HALF * K * 2;
    const size_t tstep = 2 * hstep;
    const unsigned ldsw = (unsigned)wid * 1024u;
    const int aoff = lds_byte(wr * 64 + fr, fq * 8), boff = lds_byte(wc * 32 + fr, fq * 8);
#define PG8_SA(b, h) (((b) * 2 + (h)) * HTB)
#define PG8_SB(b, h) ((4 + (b) * 2 + (h)) * HTB)
#define PG8_STAGE(bufoff, gbase, voff) do { _Pragma("unroll") for (int _i = 0; _i < 2; ++_i) \
        __builtin_amdgcn_global_load_lds((const PG8_GAS unsigned*)((const PG8_GAS char*)(gbase) + (voff)[_i]), (PG8_LAS unsigned*)(lds + (bufoff) + ldsw + _i * 8192), 16, 0, 0); } while (0)
#define PG8_LDA(dst, b, h) do { _Pragma("unroll") for (int m = 0; m < 4; ++m) _Pragma("unroll") for (int k = 0; k < 2; ++k) dst[m][k] = *(const PG8_LAS bf16x8*)(lds + PG8_SA(b, h) + aoff + m * 2048 + k * 1024); } while (0)
#define PG8_LDB(dst, b, h) do { _Pragma("unroll") for (int n = 0; n < 2; ++n) _Pragma("unroll") for (int k = 0; k < 2; ++k) dst[n][k] = *(const PG8_LAS bf16x8*)(lds + PG8_SB(b, h) + boff + n * 2048 + k * 1024); } while (0)
#define PG8_MMA(ai, bj, At, Bt) do { __builtin_amdgcn_s_setprio(1); _Pragma("unroll") for (int m = 0; m < 4; ++m) _Pragma("unroll") for (int n = 0; n < 2; ++n) _Pragma("unroll") for (int k = 0; k < 2; ++k) \
        acc[ai][bj][m][n] = __builtin_amdgcn_mfma_f32_16x16x32_bf16(Bt[n][k], At[m][k], acc[ai][bj][m][n], 0, 0, 0); __builtin_amdgcn_s_setprio(0); } while (0)
#define PG8_WAIT_V(n) asm volatile("s_waitcnt vmcnt(" #n ")" ::: "memory")
#define PG8_WAIT_L(n) asm volatile("s_waitcnt lgkmcnt(" #n ")" ::: "memory")
#define PG8_BAR __builtin_amdgcn_s_barrier()
#define PG8_SCHED __builtin_amdgcn_sched_barrier(0)
    Unit cur, nxt; int ui = 0;
    if (!S.next(0, cur)) return;
    f32x4 acc[2][2][4][2];
#pragma unroll
    for (int a = 0; a < 2; ++a)
#pragma unroll
        for (int b = 0; b < 2; ++b)
#pragma unroll
            for (int m = 0; m < 4; ++m)
#pragma unroll
                for (int n = 0; n < 2; ++n) acc[a][b][m][n] = (f32x4){0.f, 0.f, 0.f, 0.f};
    bf16x8 At[4][2], B0[2][2], B1[2][2];
    const PG8_GAS char* cA = (const PG8_GAS char*)g.A + (size_t)cur.pm * tstep; const PG8_GAS char* cB = (const PG8_GAS char*)g.Bt + (size_t)cur.pn * tstep;
    S.a_ready(cur);
    if constexpr (SP2) {
        PG8_STAGE(PG8_SB(0, 0), cB, voffB); PG8_STAGE(PG8_SB(0, 1), cB + hstep, voffB); PG8_STAGE(PG8_SA(0, 0), cA, voffA); PG8_STAGE(PG8_SA(0, 1), cA + hstep, voffA);
        if (wr == 1) PG8_BAR;
        PG8_WAIT_V(2); PG8_BAR;
        PG8_STAGE(PG8_SB(1, 0), cB + kstep, voffB); PG8_STAGE(PG8_SA(1, 0), cA + kstep, voffA); PG8_STAGE(PG8_SB(1, 1), cB + hstep + kstep, voffB);
        PG8_WAIT_V(6); PG8_BAR;
    } else {
        PG8_STAGE(PG8_SB(0, 0), cB, voffB); PG8_STAGE(PG8_SA(0, 0), cA, voffA); PG8_STAGE(PG8_SB(0, 1), cB + hstep, voffB); PG8_STAGE(PG8_SA(0, 1), cA + hstep, voffA);
        if (wr == 1) PG8_BAR;
        PG8_WAIT_V(4); PG8_BAR;
        PG8_STAGE(PG8_SB(1, 0), cB + kstep, voffB); PG8_STAGE(PG8_SA(1, 0), cA + kstep, voffA); PG8_STAGE(PG8_SB(1, 1), cB + hstep + kstep, voffB);
        PG8_WAIT_V(6); PG8_BAR;
    }
    for (;;) {
        const bool has_next = S.next(ui + 1, nxt);
        const PG8_GAS char* nA = has_next ? (const PG8_GAS char*)g.A + (size_t)nxt.pm * tstep : cA; const PG8_GAS char* nB = has_next ? (const PG8_GAS char*)g.Bt + (size_t)nxt.pn * tstep : cB;
        for (int t = 0; t < nt; t += 2) {
            const bool last = (t == nt - 2);
            const PG8_GAS char* a1 = cA + (size_t)(t + 1) * kstep;
            const PG8_GAS char* a2 = last ? nA : cA + (size_t)(t + 2) * kstep; const PG8_GAS char* b2 = last ? nB : cB + (size_t)(t + 2) * kstep;
            const PG8_GAS char* a3 = a2 + kstep; const PG8_GAS char* b3 = b2 + kstep;
            if (last && has_next) S.a_ready(nxt);
            if constexpr (SP2) {
            PG8_LDB(B0, 0, 0); PG8_LDB(B1, 0, 1); PG8_SCHED; PG8_LDA(At, 0, 0); PG8_STAGE(PG8_SA(1, 1), a1 + hstep, voffA);
            PG8_WAIT_V(8); PG8_WAIT_L(0); PG8_BAR; PG8_MMA(0, 0, At, B0); PG8_MMA(0, 1, At, B1); PG8_BAR; PG8_SCHED;
            PG8_LDA(At, 0, 1); PG8_STAGE(PG8_SB(0, 0), b2, voffB); PG8_STAGE(PG8_SB(0, 1), b2 + hstep, voffB); PG8_STAGE(PG8_SA(0, 0), a2, voffA);
            PG8_WAIT_V(8); PG8_WAIT_L(0); PG8_BAR; PG8_MMA(1, 0, At, B0); PG8_MMA(1, 1, At, B1); PG8_BAR; PG8_SCHED;
            PG8_LDB(B0, 1, 0); PG8_LDB(B1, 1, 1); PG8_SCHED; PG8_LDA(At, 1, 0); PG8_STAGE(PG8_SA(0, 1), a2 + hstep, voffA);
            PG8_WAIT_V(8); PG8_WAIT_L(0); PG8_BAR; PG8_MMA(0, 0, At, B0); PG8_MMA(0, 1, At, B1); PG8_BAR; PG8_SCHED;
            PG8_LDA(At, 1, 1); PG8_STAGE(PG8_SB(1, 0), b3, voffB); PG8_STAGE(PG8_SB(1, 1), b3 + hstep, voffB); PG8_STAGE(PG8_SA(1, 0), a3, voffA);
            PG8_WAIT_V(8); PG8_WAIT_L(0); PG8_BAR; PG8_MMA(1, 0, At, B0); PG8_MMA(1, 1, At, B1); PG8_BAR; PG8_SCHED;
            } else {
            PG8_LDB(B0, 0, 0); PG8_SCHED; PG8_LDA(At, 0, 0); PG8_STAGE(PG8_SA(1, 1), a1 + hstep, voffA);
            PG8_WAIT_L(8); PG8_BAR; PG8_WAIT_L(0); PG8_MMA(0, 0, At, B0); PG8_BAR; PG8_SCHED;
            PG8_LDB(B1, 0, 1); PG8_STAGE(PG8_SB(0, 0), b2, voffB);
            PG8_BAR; PG8_WAIT_L(0); PG8_MMA(0, 1, At, B1); PG8_BAR;
            PG8_LDA(At, 0, 1); PG8_STAGE(PG8_SA(0, 0), a2, voffA);
            PG8_BAR; PG8_WAIT_L(0); PG8_MMA(1, 0, At, B0); PG8_BAR; PG8_SCHED;
            PG8_STAGE(PG8_SB(0, 1), b2 + hstep, voffB);
            PG8_WAIT_V(6); PG8_BAR; PG8_MMA(1, 1, At, B1); PG8_BAR;
            PG8_LDB(B0, 1, 0); PG8_SCHED; PG8_LDA(At, 1, 0); PG8_STAGE(PG8_SA(0, 1), a2 + hstep, voffA);
            PG8_WAIT_L(8); PG8_BAR; PG8_WAIT_L(0); PG8_MMA(0, 0, At, B0); PG8_BAR; PG8_SCHED;
            PG8_LDB(B1, 1, 1); PG8_STAGE(PG8_SB(1, 0), b3, voffB);
            PG8_BAR; PG8_WAIT_L(0); PG8_MMA(0, 1, At, B1); PG8_BAR;
            PG8_LDA(At, 1, 1); PG8_STAGE(PG8_SA(1, 0), a3, voffA);
            PG8_BAR; PG8_WAIT_L(0); PG8_MMA(1, 0, At, B0); PG8_BAR; PG8_SCHED;
            PG8_STAGE(PG8_SB(1, 1), b3 + hstep, voffB);
            PG8_WAIT_V(6); PG8_BAR; PG8_MMA(1, 1, At, B1); PG8_BAR;
            }
        }
        if constexpr (ALIGN_EPI) { if (wr == 0) PG8_BAR; }
        if constexpr (!Epi::AFTER_DRAIN) { E(acc, cur, wr, wc, fr, fq); S.done(cur); }
        if (!has_next) break;
#pragma unroll
        for (int a = 0; a < 2; ++a)
#pragma unroll
            for (int b = 0; b < 2; ++b)
#pragma unroll
                for (int m = 0; m < 4; ++m)
#pragma unroll
                    for (int n = 0; n < 2; ++n) acc[a][b][m][n] = (f32x4){0.f, 0.f, 0.f, 0.f};
        cur = nxt; cA = nA; cB = nB; ++ui;
        if constexpr (ALIGN_EPI) { if (wr == 1) PG8_BAR; }
    }
    PG8_WAIT_V(0);
    if constexpr (!ALIGN_EPI) { if (wr == 0) PG8_BAR; }
    PG8_BAR;
    if constexpr (Epi::AFTER_DRAIN) { E.fused(acc, cur, wr, wc, fr, fq, lds, wid, lane); S.done(cur); }
#undef PG8_SA
#undef PG8_SB
#undef PG8_STAGE
#undef PG8_LDA
#undef PG8_LDB
#undef PG8_MMA
#undef PG8_WAIT_V
#undef PG8_WAIT_L
#undef PG8_BAR
#undef PG8_SCHED
}
}
constexpr int NWAVES = 8;
constexpr int BATCH = 8, SEQ = 4096, D = 2048, FF = 5632, DEPTH = 2;
constexpr int M = BATCH * SEQ;
constexpr int NGU = 2 * FF;
constexpr int H_A = 8, HD_A = 128, RANK = 256, IH = 8, IDIM = 64, TOPK = 256;
constexpr int H_B = 16, KVH = 2, GQA = 8, HD_B = 64, WINDOW = 128;
constexpr int D_IN = 3144;
constexpr float EPS = 1e-6f;
constexpr size_t MiB = 1u << 20;
constexpr size_t WS_CTL = 0, CTL_ZERO_BYTES = 1 * MiB;
constexpr size_t WS_W0 = 2 * MiB, W_LAYER = 162 * MiB;
constexpr size_t WO_GU1 = 0, WO_D1 = 44 * MiB, WO_GU2 = 66 * MiB, WO_D2 = 110 * MiB, WO_IN = 132 * MiB, WO_OUT = 149 * MiB;
constexpr size_t WS_XN = 326 * MiB;
constexpr size_t WS_ACT = 454 * MiB;
constexpr size_t WS_Z = WS_ACT, WS_CKVN = WS_ACT + 272 * MiB, WS_KIN = WS_ACT + 288 * MiB, WS_WIF = WS_ACT + 292 * MiB, WS_IDX = WS_ACT + 294 * MiB;
constexpr int ZLD = 4352, ZC_QLAT = 0, ZC_CKV = 2048, ZC_QI = 2304, ZC_QB = 2816, ZC_KB = 3840, ZC_VB = 3968, ZC_KI = 4096, ZC_WI = 4160;
constexpr int OLD = 3072;
constexpr size_t WS_O = 806 * MiB;
constexpr size_t WS_END = 998 * MiB;
constexpr int CW_TMO = 0, CW_CODE = 1, CW_BAR = 4096;
constexpr int RING_OFF = 0, RING_BYTES = 131072;
constexpr int LDSCTL_OFF = RING_BYTES, MISC_OFF = LDSCTL_OFF + 320;
constexpr int LDS_BYTES = 147456;
#define GAS __attribute__((address_space(1)))
#define LAS __attribute__((address_space(3)))
typedef unsigned short bf16;
typedef unsigned v4u __attribute__((ext_vector_type(4)));
typedef float f32x4 __attribute__((ext_vector_type(4)));
typedef short bf16x8 __attribute__((ext_vector_type(8)));
typedef GAS unsigned gu32;
typedef GAS unsigned long long gu64;
#define RLX_AGENT __ATOMIC_RELAXED, __HIP_MEMORY_SCOPE_AGENT
#define LDS_WAIT() asm volatile("s_waitcnt lgkmcnt(0)" ::: "memory")
#define VM_WAIT() asm volatile("s_waitcnt vmcnt(0)" ::: "memory")
__device__ __forceinline__ unsigned long long rt() { return __builtin_amdgcn_s_memrealtime(); }
__device__ __forceinline__ unsigned f2bf(float f) { unsigned u = __builtin_bit_cast(unsigned, f); return (u + 0x7fffu + ((u >> 16) & 1u)) >> 16; }
__device__ __forceinline__ unsigned pk2(float lo, float hi) { return f2bf(lo) | (f2bf(hi) << 16); }

#define XB_TMO      128
#define XB_XCNT(j)  (256  + 64 * (j))
#define XB_XSUB(j)  (1280 + 64 * (j))
#define XB_XGEN(j)  (2304 + 64 * (j))
#define XB_TOP      3328
#define XB_TOPGEN   3392
#define XCD_BAR_WORDS 3456
#define XB_SPIN_CAP (1u << 18)

__device__ __forceinline__ unsigned xb_ld(unsigned* p)              { return __hip_atomic_load(p, __ATOMIC_RELAXED, __HIP_MEMORY_SCOPE_AGENT); }
__device__ __forceinline__ unsigned xb_add(unsigned* p, unsigned v) { return __hip_atomic_fetch_add(p, v, __ATOMIC_RELAXED, __HIP_MEMORY_SCOPE_AGENT); }
__device__ __forceinline__ unsigned xb_xcc_id() { return (unsigned)__builtin_amdgcn_s_getreg((3 << 11) | 20) & 0xFu; }
#define XB_SPIN(cond, bar) do { unsigned _sp = 0; while (cond) { __builtin_amdgcn_s_sleep(1); \
    if ((++_sp & 255u) == 0u) { if (xb_ld(&(bar)[XB_TMO])) break; if (_sp > XB_SPIN_CAP) { atomicAdd(&(bar)[XB_TMO], 1u); break; } } } } while (0)

struct XcdBarrier {
    unsigned* bar; unsigned x;
    volatile LAS unsigned* st;
};

__device__ __forceinline__ XcdBarrier xcd_barrier_post(unsigned* bar, volatile LAS unsigned* st) {
    XcdBarrier b; b.bar = bar; b.x = xb_xcc_id(); b.st = st;
    if (threadIdx.x == 0) (void)xb_add(&bar[XB_XCNT(b.x)], 1u);
    return b;
}
__device__ __forceinline__ void xcd_barrier_complete(unsigned* bar, unsigned x, unsigned& nloc, unsigned& nx) {
    const unsigned G = gridDim.x * gridDim.y * gridDim.z;
    unsigned sum, cnt, mine, sp = 0u;
    for (;;) {
        sum = 0u; cnt = 0u; mine = 0u;
#pragma unroll
        for (unsigned j = 0; j < 16; ++j) { const unsigned c = xb_ld(&bar[XB_XCNT(j)]); sum += c; cnt += (c > 0u) ? 1u : 0u; mine = (j == x) ? c : mine; }
        if (sum == G) break;
        __builtin_amdgcn_s_sleep(1);
        if ((++sp & 255u) == 0u) { if (xb_ld(&bar[XB_TMO])) break; if (sp > XB_SPIN_CAP) { atomicAdd(&bar[XB_TMO], 1u); break; } }
    }
    nloc = mine > 0u ? mine : 1u; nx = cnt > 0u ? cnt : 1u;
}

__device__ __forceinline__ void xcd_barrier(const XcdBarrier& b) {
    asm volatile("s_waitcnt vmcnt(0)" ::: "memory");
    __syncthreads();
    if (threadIdx.x == 0) {
        unsigned* bar = b.bar;
        __builtin_amdgcn_s_waitcnt(0);
        unsigned nloc = b.st[0], nx = b.st[1];
        if (nloc == 0u) { xcd_barrier_complete(bar, b.x, nloc, nx); b.st[0] = nloc; b.st[1] = nx; }
        const unsigned old = xb_add(&bar[XB_XSUB(b.x)], 1u);
        const unsigned gen = old / nloc;
        if (old + 1u == (gen + 1u) * nloc) {
            __builtin_amdgcn_fence(__ATOMIC_RELEASE, "agent");
            asm volatile("s_waitcnt vmcnt(0)" ::: "memory");
            const unsigned og = xb_add(&bar[XB_TOP], 1u);
            const unsigned tg = og / nx;
            if (og + 1u == (tg + 1u) * nx) xb_add(&bar[XB_TOPGEN], 1u);
            else XB_SPIN(xb_ld(&bar[XB_TOPGEN]) == tg, bar);
            __builtin_amdgcn_fence(__ATOMIC_ACQUIRE, "agent");
            xb_add(&bar[XB_XGEN(b.x)], 1u);
            asm volatile("s_waitcnt vmcnt(0)" ::: "memory");
        } else {
            XB_SPIN(xb_ld(&bar[XB_XGEN(b.x)]) == gen, bar);
            __builtin_amdgcn_fence(__ATOMIC_ACQUIRE, "agent");
            asm volatile("s_waitcnt vmcnt(0)" ::: "memory");
        }
    }
    __syncthreads();
}
__constant__ unsigned char T5_BUCKET[128] = {0, 1, 2, 3, 4, 5, 6, 7, 8, 9, 10, 11, 12, 13, 14, 15, 16, 16, 16, 17, 17, 18, 18, 18, 19, 19, 19, 20, 20, 20, 20, 21, 21, 21, 21, 22, 22, 22, 22, 22, 23, 23, 23, 23, 23, 23, 24, 24, 24, 24, 24, 24, 25, 25, 25, 25, 25, 25, 25, 26, 26, 26, 26, 26, 26, 26, 26, 27, 27, 27, 27, 27, 27, 27, 27, 27, 27, 28, 28, 28, 28, 28, 28, 28, 28, 28, 28, 29, 29, 29, 29, 29, 29, 29, 29, 29, 29, 29, 29, 30, 30, 30, 30, 30, 30, 30, 30, 30, 30, 30, 30, 30, 30, 31, 31, 31, 31, 31, 31, 31, 31, 31, 31, 31, 31, 31, 31, 31};
typedef short s16x4 __attribute__((ext_vector_type(4)));
typedef float f32x16 __attribute__((ext_vector_type(16)));
__device__ __forceinline__ float bf2f(unsigned short b) { return __builtin_bit_cast(float, (unsigned)b << 16); }
__device__ __forceinline__ bf16x8 cat4(s16x4 lo, s16x4 hi) { return __builtin_shufflevector(lo, hi, 0, 1, 2, 3, 4, 5, 6, 7); }
__device__ __forceinline__ void tr_read4(unsigned a0, unsigned a1, unsigned a2, unsigned a3, s16x4& r0, s16x4& r1, s16x4& r2, s16x4& r3) {
    asm volatile("ds_read_b64_tr_b16 %0, %4\n\tds_read_b64_tr_b16 %1, %5\n\tds_read_b64_tr_b16 %2, %6\n\tds_read_b64_tr_b16 %3, %7\n\ts_waitcnt lgkmcnt(0)"
                 : "=&v"(r0), "=&v"(r1), "=&v"(r2), "=&v"(r3) : "v"(a0), "v"(a1), "v"(a2), "v"(a3) : "memory");
}
#define SHX(x, o) __builtin_bit_cast(float, __builtin_amdgcn_ds_bpermute(((lane) ^ (o)) << 2, __builtin_bit_cast(int, (float)(x))))
#define SHXU(x, o) ((unsigned)__builtin_amdgcn_ds_bpermute(((lane) ^ (o)) << 2, (int)(x)))
__device__ __forceinline__ float wave_sum(float v, int lane) {
#pragma unroll
    for (int o = 1; o < 64; o <<= 1) v += SHX(v, o);
    return v;
}
__device__ __forceinline__ void conv_item(const GAS float* W, int ldw, int k0, int c0, int nvalid, GAS bf16* dst, int dld, int drow0, int dk0, float scale, const GAS float* gain, LAS float* scr, int lane) {
    const int c = lane & 31;
#pragma unroll 8
    for (int i = 0; i < 32; ++i) { const int kk = 2 * i + (lane >> 5); float v = 0.f;
        if (c < nvalid) { v = W[(size_t)(k0 + kk) * ldw + c0 + c] * scale; if (gain) v *= gain[k0 + kk]; }
        scr[kk * 33 + c] = v; }
    LDS_WAIT(); asm volatile("" ::: "memory");
    const int c8 = lane & 7;
#pragma unroll
    for (int j = 0; j < 4; ++j) { const int n = (lane >> 3) + 8 * j; const LAS float* s = scr + (8 * c8) * 33 + n;
        v4u o; o.x = pk2(s[0 * 33], s[1 * 33]); o.y = pk2(s[2 * 33], s[3 * 33]); o.z = pk2(s[4 * 33], s[5 * 33]); o.w = pk2(s[6 * 33], s[7 * 33]);
        *(GAS v4u*)(dst + (size_t)(drow0 + n) * dld + dk0 + k0 + 8 * c8) = o; }
    LDS_WAIT(); asm volatile("" ::: "memory");
}
__device__ __forceinline__ void rmsnorm_rows_bf16(const GAS float* X, const GAS float* g, GAS bf16* O, int gw, int NGW, int lane) {
    f32x4 gv[8];
#pragma unroll
    for (int j = 0; j < 8; ++j) gv[j] = ((const GAS f32x4*)g)[lane + 64 * j];
    for (int m = gw; m < M; m += NGW) {
        const GAS f32x4* xr = (const GAS f32x4*)(X + (size_t)m * D) + lane;
        f32x4 v[8]; float s = 0.f;
#pragma unroll
        for (int j = 0; j < 8; ++j) { v[j] = xr[64 * j]; s += (v[j].x * v[j].x + v[j].y * v[j].y) + (v[j].z * v[j].z + v[j].w * v[j].w); }
        const float r = 1.0f / sqrtf(wave_sum(s, lane) * (1.0f / D) + EPS);
        GAS unsigned long long* o8 = (GAS unsigned long long*)(O + (size_t)m * D) + lane;
#pragma unroll
        for (int j = 0; j < 8; ++j) { const f32x4 y = v[j] * r * gv[j]; o8[64 * j] = (unsigned long long)pk2(y.x, y.y) | ((unsigned long long)pk2(y.z, y.w) << 32); }
    }
}
__device__ __forceinline__ void rmsnorm_rows_f32_inplace(GAS float* X, const GAS float* g, int gw, int NGW, int lane) {
    f32x4 gv[8];
#pragma unroll
    for (int j = 0; j < 8; ++j) gv[j] = ((const GAS f32x4*)g)[lane + 64 * j];
    for (int m = gw; m < M; m += NGW) {
        GAS f32x4* xr = (GAS f32x4*)(X + (size_t)m * D) + lane;
        f32x4 v[8]; float s = 0.f;
#pragma unroll
        for (int j = 0; j < 8; ++j) { v[j] = xr[64 * j]; s += (v[j].x * v[j].x + v[j].y * v[j].y) + (v[j].z * v[j].z + v[j].w * v[j].w); }
        const float r = 1.0f / sqrtf(wave_sum(s, lane) * (1.0f / D) + EPS);
#pragma unroll
        for (int j = 0; j < 8; ++j) xr[64 * j] = v[j] * r * gv[j];
    }
}

template <bool P_IFAST>
__device__ __forceinline__ void absorb_unit(const GAS float* Psrc, size_t p_ri, size_t p_rd, const GAS float* Qsrc, size_t q_rj, GAS bf16* out, size_t out_ld, float scale, LAS float* Ps, LAS float* Qs, int tid) {
#pragma unroll 4
    for (int j = 0; j < 16; ++j) { const int e = tid + 512 * j; const int i = P_IFAST ? (e & 63) : (e >> 7), d = P_IFAST ? (e >> 6) : (e & 127);
        Ps[i * 129 + d] = Psrc[(size_t)i * p_ri + (size_t)d * p_rd];
        const int jj = e >> 7, dd = e & 127; Qs[jj * 129 + dd] = Qsrc[(size_t)jj * q_rj + dd]; }
    __syncthreads();
    const int ty = tid >> 6, tx = tid & 63; float acc[8];
#pragma unroll
    for (int i = 0; i < 8; ++i) acc[i] = 0.f;
#pragma unroll 4
    for (int d = 0; d < 128; ++d) { const float q = Qs[tx * 129 + d];
#pragma unroll
        for (int i = 0; i < 8; ++i) acc[i] = fmaf(Ps[(ty * 8 + i) * 129 + d], q, acc[i]); }
#pragma unroll
    for (int i = 0; i < 8; ++i) out[(size_t)(ty * 8 + i) * out_ld + tx] = (bf16)f2bf(acc[i] * scale);
    __syncthreads();
}
__device__ __forceinline__ void post_rows(const GAS bf16* Z, const GAS float* gkv, const GAS float* gki, const GAS float* bki, GAS bf16* CKVN, GAS bf16* KIN, GAS float* WIF, int gw, int NGW, int lane) {
    const f32x4 g4 = ((const GAS f32x4*)gkv)[lane]; const float gk = gki[lane], bk = bki[lane];
    for (int m = gw; m < M; m += NGW) {
        const GAS bf16* zr = Z + (size_t)m * ZLD;
        const unsigned long long raw = *(const GAS unsigned long long*)(zr + ZC_CKV + 4 * lane);
        const float kraw = bf2f(zr[ZC_KI + lane]);
        const float wraw = bf2f(zr[ZC_WI + (lane & 7)]);
        const float c0 = bf2f((unsigned short)raw), c1 = bf2f((unsigned short)(raw >> 16)), c2 = bf2f((unsigned short)(raw >> 32)), c3 = bf2f((unsigned short)(raw >> 48));
        const float r = 1.0f / sqrtf(wave_sum((c0 * c0 + c1 * c1) + (c2 * c2 + c3 * c3), lane) * (1.0f / RANK) + EPS);
        *(GAS unsigned long long*)(CKVN + (size_t)m * RANK + 4 * lane) = (unsigned long long)pk2(c0 * r * g4.x, c1 * r * g4.y) | ((unsigned long long)pk2(c2 * r * g4.z, c3 * r * g4.w) << 32);
        const float mu = wave_sum(kraw, lane) * (1.0f / IDIM); const float dv = kraw - mu;
        const float var = wave_sum(dv * dv, lane) * (1.0f / IDIM);
        KIN[(size_t)m * IDIM + lane] = (bf16)f2bf(dv * (1.0f / sqrtf(var + EPS)) * gk + bk);
        if (lane < 8) WIF[(size_t)m * IH + lane] = wraw;
    }
}
constexpr int SWA_KP = 144, SWA_VP = 192;
constexpr int SWA_K_OFF = 0, SWA_V_OFF = 160 * SWA_KP, SWA_TAB_OFF = SWA_V_OFF + 160 * SWA_VP;
static_assert(SWA_TAB_OFF + 16 * 128 * 4 <= RING_BYTES, "SWA LDS map");
__device__ __forceinline__ void swa_phase(LAS unsigned char* lds, const GAS bf16* Z, GAS bf16* O, const GAS float* rel_bias, const GAS float* sinks, int vcu, int G, int tid, int lane, int wave) {
    LAS float* tab = (LAS float*)(lds + SWA_TAB_OFF);
    for (int e = tid; e < 16 * 128; e += NWAVES * 64) { const int h = e >> 7, dist = e & 127; tab[e] = rel_bias[(int)T5_BUCKET[dist] * 24 + H_A + h]; }
    __syncthreads();
    const int q = lane & 31, hh = lane >> 5;
    const unsigned ldsb = (unsigned)(size_t)lds;
    for (int item = vcu; item < BATCH * 128 * KVH; item += G) {
        const int kvh = item & 1, qt = (item >> 1) & 127, b = item >> 8;
        const int t0 = 32 * qt, s0 = t0 - 128;
        const size_t rowbase = (size_t)b * SEQ;
        for (int c = tid; c < 1280; c += NWAVES * 64) { const int row = c >> 3, ch = c & 7; const int s = s0 + row;
            if (s >= 0) { const GAS bf16* zr = Z + (rowbase + s) * ZLD + kvh * 64 + ch * 8;
                const v4u kv = *(const GAS v4u*)(zr + ZC_KB); const v4u vv = *(const GAS v4u*)(zr + ZC_VB);
                *(LAS v4u*)(lds + SWA_K_OFF + row * SWA_KP + ch * 16) = kv; *(LAS v4u*)(lds + SWA_V_OFF + row * SWA_VP + ch * 16) = vv; } }
        const int hq = kvh * 8 + wave; const int t = t0 + q;
        bf16x8 qf[4];
#pragma unroll
        for (int st = 0; st < 4; ++st) qf[st] = *(const GAS bf16x8*)(Z + (rowbase + t) * ZLD + ZC_QB + hq * 64 + 16 * st + 8 * hh);
        __syncthreads();
        const int kt0 = qt >= 4 ? 0 : 4 - qt;
        f32x16 sacc[5];
#pragma unroll
        for (int kt = 0; kt < 5; ++kt) {
#pragma unroll
            for (int r = 0; r < 16; ++r) sacc[kt][r] = 0.f;
            if (kt >= kt0) {
#pragma unroll
                for (int st = 0; st < 4; ++st) { const bf16x8 kf = *(const LAS bf16x8*)(lds + SWA_K_OFF + (kt * 32 + q) * SWA_KP + (2 * st + hh) * 16);
                    sacc[kt] = __builtin_amdgcn_mfma_f32_32x32x16_bf16(kf, qf[st], sacc[kt], 0, 0, 0); } } }
        const float sink = sinks[hq]; float mx = sink;
        const LAS float* tabh = tab + hq * 128;
#pragma unroll
        for (int kt = 0; kt < 5; ++kt) if (kt >= kt0) {
#pragma unroll
            for (int r = 0; r < 16; ++r) { const int ko = (r & 3) + 8 * (r >> 2) + 4 * hh; const int dist = q + 128 - 32 * kt - ko;
                const float lg = (dist >= 0 && dist < WINDOW) ? sacc[kt][r] + tabh[dist & 127] : -1e30f; sacc[kt][r] = lg; mx = fmaxf(mx, lg); } }
        mx = fmaxf(mx, SHX(mx, 32));
        float l = 0.f;
#pragma unroll
        for (int kt = 0; kt < 5; ++kt) if (kt >= kt0) {
#pragma unroll
            for (int r = 0; r < 16; ++r) { const float p = __expf(sacc[kt][r] - mx); sacc[kt][r] = p; l += p; } }
        l += SHX(l, 32); l += __expf(sink - mx);
        f32x16 oacc[2];
#pragma unroll
        for (int dt = 0; dt < 2; ++dt)
#pragma unroll
            for (int r = 0; r < 16; ++r) oacc[dt][r] = 0.f;
        const unsigned vlane = ldsb + SWA_V_OFF + (unsigned)((4 * hh + ((lane & 15) >> 2)) * SWA_VP + (16 * ((lane >> 4) & 1) + 4 * (lane & 3)) * 2);
#pragma unroll
        for (int kt = 0; kt < 5; ++kt) if (kt >= kt0) {
#pragma unroll
            for (int s2 = 0; s2 < 2; ++s2) {
                bf16x8 pf; { const unsigned w0 = pg8::cvt_pk_bf16(sacc[kt][8 * s2 + 0], sacc[kt][8 * s2 + 1]), w1 = pg8::cvt_pk_bf16(sacc[kt][8 * s2 + 2], sacc[kt][8 * s2 + 3]),
                                     w2 = pg8::cvt_pk_bf16(sacc[kt][8 * s2 + 4], sacc[kt][8 * s2 + 5]), w3 = pg8::cvt_pk_bf16(sacc[kt][8 * s2 + 6], sacc[kt][8 * s2 + 7]);
                    const v4u w = {w0, w1, w2, w3}; pf = __builtin_bit_cast(bf16x8, w); }
                const unsigned a = vlane + (unsigned)((kt * 32 + 16 * s2) * SWA_VP);
                s16x4 r0, r1, r2, r3; tr_read4(a, a + 8 * SWA_VP, a + 64, a + 8 * SWA_VP + 64, r0, r1, r2, r3);
                oacc[0] = __builtin_amdgcn_mfma_f32_32x32x16_bf16(cat4(r0, r1), pf, oacc[0], 0, 0, 0);
                oacc[1] = __builtin_amdgcn_mfma_f32_32x32x16_bf16(cat4(r2, r3), pf, oacc[1], 0, 0, 0); } }
        const float inv = 1.0f / l;
        GAS bf16* orow = O + (rowbase + t) * OLD + 2048 + hq * 64 + 4 * hh;
#pragma unroll
        for (int dt = 0; dt < 2; ++dt)
#pragma unroll
            for (int g4 = 0; g4 < 4; ++g4) { const unsigned long long w = (unsigned long long)pk2(oacc[dt][4 * g4] * inv, oacc[dt][4 * g4 + 1] * inv) | ((unsigned long long)pk2(oacc[dt][4 * g4 + 2] * inv, oacc[dt][4 * g4 + 3] * inv) << 32);
                *(GAS unsigned long long*)(orow + 32 * dt + 8 * g4) = w; }
        __syncthreads();
    }
}
constexpr int TK_BINS = 512, TK_CAP = 128;
#define LDS_ADD(p) __hip_atomic_fetch_add((p), 1u, __ATOMIC_RELAXED, __HIP_MEMORY_SCOPE_WORKGROUP)
constexpr int TK_HIST_OFF = 0, TK_CSC_OFF = 65536, TK_CIX_OFF = TK_CSC_OFF + 32 * TK_CAP * 4, TK_SEL_OFF = TK_CIX_OFF + 32 * TK_CAP * 2, TK_CNT_OFF = TK_SEL_OFF + 32 * 256 * 2;
static_assert(TK_CNT_OFF + 32 * 2 * 4 <= RING_BYTES, "top-k LDS map");
__device__ __forceinline__ float tk_score(const f32x16& acc, int a, const float (&w)[8]) {
    float s = w[0] * fmaxf(acc[8 * a + 0], 0.f);
#pragma unroll
    for (int h = 1; h < 8; ++h) s = fmaf(w[h], fmaxf(acc[8 * a + h], 0.f), s);
    return s;
}
__device__ __forceinline__ int tk_key(float s) {
    const float x = (s + 8.0f) * 32.0f; int b0 = (int)x; b0 = b0 < 0 ? 0 : (b0 > TK_BINS - 1 ? TK_BINS - 1 : b0);
    int sub = (int)((x - (float)b0) * 512.0f); sub = sub < 0 ? 0 : (sub > 511 ? 511 : sub);
    return b0 * 512 + sub;
}
__device__ __forceinline__ void tk_find(const LAS unsigned* h, unsigned need, int lane, int& bin_out, unsigned& above_out) {
    unsigned v[8]; unsigned s = 0;
#pragma unroll
    for (int i = 0; i < 8; ++i) { v[i] = h[8 * lane + i]; s += v[i]; }
    unsigned S = s;
#pragma unroll
    for (int o = 1; o < 64; o <<= 1) { const unsigned t = (unsigned)__builtin_amdgcn_ds_bpermute((lane + o) << 2, (int)S); if (lane + o < 64) S += t; }
    const unsigned long long mask = __ballot(S >= need);
    const int Lm = mask ? 63 - __builtin_clzll(mask) : 0;
    unsigned cum = S - s; int bsel = 8 * lane; unsigned ab = cum; bool found = false;
#pragma unroll
    for (int i = 7; i >= 0; --i) { if (!found) { if (cum + v[i] >= need) { bsel = 8 * lane + i; ab = cum; found = true; } else cum += v[i]; } }
    bin_out = __builtin_amdgcn_readlane(bsel, Lm); above_out = (unsigned)__builtin_amdgcn_readlane((int)ab, Lm);
}
__device__ __forceinline__ void topk_phase(LAS unsigned char* lds, const GAS bf16* Z, const GAS bf16* KIN, const GAS float* WIF, GAS unsigned short* IDX, int vcu, int G, int lane, int wave) {
    LAS unsigned* hist = (LAS unsigned*)(lds + TK_HIST_OFF) + wave * 4 * TK_BINS;
    LAS float* csc = (LAS float*)(lds + TK_CSC_OFF) + wave * 4 * TK_CAP;
    LAS unsigned short* cix = (LAS unsigned short*)(lds + TK_CIX_OFF) + wave * 4 * TK_CAP;
    LAS unsigned short* sel = (LAS unsigned short*)(lds + TK_SEL_OFF) + wave * 4 * 256;
    LAS unsigned* cnt = (LAS unsigned*)(lds + TK_CNT_OFF) + wave * 8;
    const int n = lane & 31, c = lane >> 5;
    const int am = (lane >> 4) & 1, bbm = (lane >> 3) & 1, ccm = (lane >> 2) & 1, dm = lane & 3;
    for (int p2 = vcu; p2 < BATCH * 64; p2 += G) {
#pragma unroll 1
        for (int half = 0; half < 2; ++half) {
            const int b = p2 >> 6, jj = p2 & 63, j = half ? 127 - jj : jj;
            const int t0 = 32 * j + 4 * wave; const size_t rb = (size_t)b * SEQ;
            bf16x8 qa[4];
#pragma unroll
            for (int st = 0; st < 4; ++st) qa[st] = *(const GAS bf16x8*)(Z + (rb + t0 + 2 * ccm + am) * ZLD + ZC_QI + (4 * bbm + dm) * 64 + 16 * st + 8 * c);
            float w0[8], w1[8];
            { const GAS f32x4* wp = (const GAS f32x4*)(WIF + (rb + t0 + 2 * c) * IH); const f32x4 x0 = wp[0], x1 = wp[1], x2 = wp[2], x3 = wp[3];
              w0[0] = x0.x; w0[1] = x0.y; w0[2] = x0.z; w0[3] = x0.w; w0[4] = x1.x; w0[5] = x1.y; w0[6] = x1.z; w0[7] = x1.w;
              w1[0] = x2.x; w1[1] = x2.y; w1[2] = x2.z; w1[3] = x2.w; w1[4] = x3.x; w1[5] = x3.y; w1[6] = x3.z; w1[7] = x3.w; }
            const int tA = t0 + 2 * c, tB = tA + 1;
            for (int i = lane; i < 4 * TK_BINS; i += 64) hist[i] = 0u;
            for (int i = lane; i < 4 * 128; i += 64) ((LAS unsigned*)sel)[i] = 0u;
            if (lane < 8) cnt[lane] = 0u;
            asm volatile("s_waitcnt lgkmcnt(0)" ::: "memory");
            int lo[4], hi[4]; unsigned ab0[4]; bool ov[4];
#pragma unroll
            for (int tk = 0; tk < 4; ++tk) { lo[tk] = 0x7fffffff; hi[tk] = -1; ab0[tk] = 0u; ov[tk] = false; }
            const bool need_sel = (t0 + 3) >= TOPK;
            const GAS bf16* kbase = KIN + (rb + n) * IDIM + 8 * c;
            int mode = need_sel ? 0 : 2;
#pragma unroll 1
            for (;;) {
                const int klo0 = c ? lo[2] : lo[0], khi0 = c ? hi[2] : hi[0], klo1 = c ? lo[3] : lo[1], khi1 = c ? hi[3] : hi[1];
                const bool ov0 = c ? ov[2] : ov[0], ov1 = c ? ov[3] : ov[1];
                bf16x8 kb[4];
#pragma unroll
                for (int st = 0; st < 4; ++st) kb[st] = *(const GAS bf16x8*)(kbase + 16 * st);
#pragma unroll 1
                for (int kt = 0; kt <= j; ++kt) {
                    bf16x8 kn[4];
                    const int ktn = kt < j ? kt + 1 : kt;
#pragma unroll
                    for (int st = 0; st < 4; ++st) kn[st] = *(const GAS bf16x8*)(kbase + (size_t)ktn * 32 * IDIM + 16 * st);
                    f32x16 acc;
#pragma unroll
                    for (int r = 0; r < 16; ++r) acc[r] = 0.f;
#pragma unroll
                    for (int st = 0; st < 4; ++st) acc = __builtin_amdgcn_mfma_f32_32x32x16_bf16(qa[st], kb[st], acc, 0, 0, 0);
                    const float s0 = tk_score(acc, 0, w0), s1 = tk_score(acc, 1, w1);
                    const int s = 32 * kt + n; const int k0 = tk_key(s0), k1 = tk_key(s1);
                    const bool v0 = s <= tA, v1 = s <= tB;
                    if (mode == 0) {
                        if (v0 && tA >= TOPK) LDS_ADD(&hist[(2 * c) * TK_BINS + (k0 >> 9)]);
                        if (v1 && tB >= TOPK) LDS_ADD(&hist[(2 * c + 1) * TK_BINS + (k1 >> 9)]);
                    } else if (mode == 1) {
                        if (v0 && ov0 && k0 >= klo0 && k0 <= khi0) LDS_ADD(&hist[(2 * c) * TK_BINS + (k0 & 511)]);
                        if (v1 && ov1 && k1 >= klo1 && k1 <= khi1) LDS_ADD(&hist[(2 * c + 1) * TK_BINS + (k1 & 511)]);
                    } else {
                        if (v0) { if (k0 > khi0) { const unsigned pos = LDS_ADD(&cnt[(2 * c) * 2]); if (pos < 256u) sel[(2 * c) * 256 + pos] = (unsigned short)s; }
                                  else if (k0 >= klo0) { const unsigned pos = LDS_ADD(&cnt[(2 * c) * 2 + 1]); if (pos < (unsigned)TK_CAP) { csc[(2 * c) * TK_CAP + pos] = s0; cix[(2 * c) * TK_CAP + pos] = (unsigned short)s; } } }
                        if (v1) { if (k1 > khi1) { const unsigned pos = LDS_ADD(&cnt[(2 * c + 1) * 2]); if (pos < 256u) sel[(2 * c + 1) * 256 + pos] = (unsigned short)s; }
                                  else if (k1 >= klo1) { const unsigned pos = LDS_ADD(&cnt[(2 * c + 1) * 2 + 1]); if (pos < (unsigned)TK_CAP) { csc[(2 * c + 1) * TK_CAP + pos] = s1; cix[(2 * c + 1) * TK_CAP + pos] = (unsigned short)s; } } }
                    }
#pragma unroll
                    for (int st = 0; st < 4; ++st) kb[st] = kn[st];
                }
                asm volatile("s_waitcnt lgkmcnt(0)" ::: "memory");
                if (mode == 2) break;
                if (mode == 0) {
                    bool any_over = false;
#pragma unroll
                    for (int tk = 0; tk < 4; ++tk) if (t0 + tk >= TOPK) { int bin; unsigned above; tk_find(hist + tk * TK_BINS, (unsigned)TOPK, lane, bin, above);
                        const unsigned ceq = hist[tk * TK_BINS + bin]; ov[tk] = ceq > (unsigned)TK_CAP; any_over |= ov[tk]; ab0[tk] = above; lo[tk] = bin * 512; hi[tk] = bin * 512 + 511; }
                    mode = any_over ? 1 : 2;
                    if (any_over) { asm volatile("s_waitcnt lgkmcnt(0)" ::: "memory"); for (int i = lane; i < 4 * TK_BINS; i += 64) hist[i] = 0u; asm volatile("s_waitcnt lgkmcnt(0)" ::: "memory"); }
                } else {
#pragma unroll
                    for (int tk = 0; tk < 4; ++tk) if (ov[tk]) { int sub; unsigned above; tk_find(hist + tk * TK_BINS, (unsigned)TOPK - ab0[tk], lane, sub, above); lo[tk] += sub; hi[tk] = lo[tk]; }
                    mode = 2;
                }
            }
#pragma unroll 1
            for (int tk = 0; tk < 4; ++tk) { const int t = t0 + tk;
                if (t >= TOPK) { const unsigned nsel = cnt[tk * 2]; unsigned nc = cnt[tk * 2 + 1]; nc = nc > (unsigned)TK_CAP ? (unsigned)TK_CAP : nc; const unsigned need = nsel < 256u ? 256u - nsel : 0u;
                    for (unsigned q = 0; q < 2; ++q) { const unsigned i = lane + 64 * q;
                        const float si = i < nc ? csc[tk * TK_CAP + i] : 0.f; const unsigned xi = i < nc ? cix[tk * TK_CAP + i] : 0u; unsigned rank = 0;
                        for (unsigned jx = 0; jx < nc; ++jx) { const float sj = csc[tk * TK_CAP + jx]; const unsigned xj = cix[tk * TK_CAP + jx]; rank += (sj > si || (sj == si && xj < xi)) ? 1u : 0u; }
                        if (i < nc && rank < need) sel[tk * 256 + nsel + rank] = (unsigned short)xi; } } }
            asm volatile("s_waitcnt lgkmcnt(0)" ::: "memory");
            { const LAS v4u* sv = (const LAS v4u*)sel; GAS v4u* ov = (GAS v4u*)(IDX + (rb + t0) * TOPK);
              ov[lane] = sv[lane]; ov[lane + 64] = sv[lane + 64]; }
            asm volatile("s_waitcnt vmcnt(0) lgkmcnt(0)" ::: "memory");
        }
    }
}
constexpr int DSA_TAB_OFF = RING_BYTES + 1024;
static_assert(DSA_TAB_OFF + 8 * 129 * 4 <= LDS_BYTES, "DSA LDS map");
__device__ __forceinline__ void dsa_phase(LAS unsigned char* lds_all, const GAS bf16* Z, const GAS bf16* CKVN, const GAS unsigned short* IDX, GAS bf16* O, const GAS float* rel_bias, int gw, int NGW, int tid, int lane, int wave) {
    LAS float* tab = (LAS float*)(lds_all + DSA_TAB_OFF);
    for (int e = tid; e < 8 * 129; e += NWAVES * 64) { const int hh = e / 129, dist = e - hh * 129; tab[e] = rel_bias[(dist < 128 ? (int)T5_BUCKET[dist] : 31) * 24 + hh]; }
    __syncthreads();
    LAS unsigned char* img = lds_all + RING_OFF + wave * 16384;
    const unsigned imgb = (unsigned)(size_t)img;
    const int h = lane & 15, g = lane >> 4;
    const LAS float* tabh = tab + (h & 7) * 129;
    const int TPW = (M + NGW - 1) / NGW;
    const int tok_end = (gw + 1) * TPW < M ? (gw + 1) * TPW : M;
    const int xq = 2 * (lane & 7);
    const int qk_off = (lane & 15) * 512;
    const int q4 = (lane & 15) >> 2, p4 = lane & 3; const int xr = 2 * (4 * (g & 1) + q4);
    const unsigned pv_base = imgb + (unsigned)((4 * g + q4) * 512 + 8 * (p4 & 1));
#pragma unroll 1
    for (int tok = gw * TPW; tok < tok_end; ++tok) {
        const int t = tok & (SEQ - 1); const size_t rb = (size_t)(tok - t);
        const int nsel = t + 1 < TOPK ? t + 1 : TOPK;
        bf16x8 qf[8];
#pragma unroll
        for (int st = 0; st < 8; ++st) { qf[st] = *(const GAS bf16x8*)(Z + (size_t)tok * ZLD + ZC_QLAT + (h & 7) * 256 + 32 * st + 8 * g); if (h >= 8) qf[st] = (bf16x8){0, 0, 0, 0, 0, 0, 0, 0}; }
        f32x4 oacc[16];
#pragma unroll
        for (int rt = 0; rt < 16; ++rt) oacc[rt] = (f32x4){0.f, 0.f, 0.f, 0.f};
        float mrun = -1e30f, lsum = 0.f;
        const GAS unsigned short* ip = IDX + (size_t)tok * TOPK;
#pragma unroll 1
        for (int ch = 0; ch < 8; ++ch) {
            if (32 * ch >= nsel) break;
            const int ixv = (int)ip[32 * ch + (lane & 31)];
            const unsigned long long i0 = *(const GAS unsigned long long*)(ip + 32 * ch + 4 * g), i1 = *(const GAS unsigned long long*)(ip + 32 * ch + 16 + 4 * g);
            asm volatile("s_waitcnt lgkmcnt(0)" ::: "memory");
#pragma unroll
            for (int i = 0; i < 16; ++i) { const int r0 = __builtin_amdgcn_readlane(ixv, 2 * i), r1 = __builtin_amdgcn_readlane(ixv, 2 * i + 1);
                const int row = 2 * i + (lane >> 5); const int ridx = lane < 32 ? r0 : r1; const int chunk = (lane & 31) ^ (2 * (row & 7));
                const GAS unsigned char* src = (const GAS unsigned char*)(CKVN + (rb + ridx) * RANK) + chunk * 16;
                __builtin_amdgcn_global_load_lds((const GAS unsigned*)src, (LAS unsigned*)(img + i * 1024), 16, 0, 0); }
            asm volatile("s_waitcnt vmcnt(0)" ::: "memory");
            f32x4 sa[2];
#pragma unroll
            for (int tl = 0; tl < 2; ++tl) { sa[tl] = (f32x4){0.f, 0.f, 0.f, 0.f};
#pragma unroll
                for (int st = 0; st < 8; ++st) { const bf16x8 a = *(const LAS bf16x8*)(img + qk_off + tl * 16 * 512 + (((4 * st + g) ^ xq) * 16));
                    sa[tl] = __builtin_amdgcn_mfma_f32_16x16x32_bf16(a, qf[st], sa[tl], 0, 0, 0); } }
            float lg[8]; float cmax = -1e30f;
#pragma unroll
            for (int e = 0; e < 8; ++e) { const int tl = e >> 2, jx = e & 3; const int kk = 32 * ch + 16 * tl + 4 * g + jx;
                const int sidx = (int)(((tl ? i1 : i0) >> (16 * jx)) & 0xffffull); int dd = t - sidx; dd = dd < 0 ? 0 : (dd > 128 ? 128 : dd);
                const float v = kk < nsel ? sa[tl][jx] + tabh[dd] : -1e30f; lg[e] = v; cmax = fmaxf(cmax, v); }
            cmax = fmaxf(cmax, SHX(cmax, 16)); cmax = fmaxf(cmax, SHX(cmax, 32));
            const float mnew = fmaxf(mrun, cmax);
            if (__any(mnew > mrun)) { const float alpha = __expf(mrun - mnew); lsum *= alpha;
#pragma unroll
                for (int rt = 0; rt < 16; ++rt) oacc[rt] = oacc[rt] * alpha; }
            mrun = mnew;
            float pe[8];
#pragma unroll
            for (int e = 0; e < 8; ++e) { pe[e] = __expf(lg[e] - mnew); lsum += pe[e]; }
            bf16x8 pf; { const v4u wv = {pg8::cvt_pk_bf16(pe[0], pe[1]), pg8::cvt_pk_bf16(pe[2], pe[3]), pg8::cvt_pk_bf16(pe[4], pe[5]), pg8::cvt_pk_bf16(pe[6], pe[7])}; pf = __builtin_bit_cast(bf16x8, wv); }
#pragma unroll
            for (int rt = 0; rt < 16; rt += 2) {
                const unsigned a0 = pv_base + (unsigned)((((2 * rt) ^ xr) | (p4 >> 1)) * 16), a1 = pv_base + (unsigned)((((2 * rt + 2) ^ xr) | (p4 >> 1)) * 16);
                s16x4 r0, r1, r2, r3; tr_read4(a0, a0 + 16 * 512, a1, a1 + 16 * 512, r0, r1, r2, r3);
                oacc[rt] = __builtin_amdgcn_mfma_f32_16x16x32_bf16(cat4(r0, r1), pf, oacc[rt], 0, 0, 0);
                oacc[rt + 1] = __builtin_amdgcn_mfma_f32_16x16x32_bf16(cat4(r2, r3), pf, oacc[rt + 1], 0, 0, 0); }
        }
        lsum += SHX(lsum, 16); lsum += SHX(lsum, 32);
        const float inv = 1.0f / lsum;
        if (h < 8) { GAS bf16* orow = O + (size_t)tok * OLD + h * 256 + 4 * g;
#pragma unroll
            for (int rt = 0; rt < 16; ++rt) *(GAS unsigned long long*)(orow + 16 * rt) = (unsigned long long)pk2(oacc[rt][0] * inv, oacc[rt][1] * inv) | ((unsigned long long)pk2(oacc[rt][2] * inv, oacc[rt][3] * inv) << 32); }
    }
}
struct Args { const float* in[20]; float* out; unsigned char* ws; };
__device__ __forceinline__ unsigned long long karg_u64(int idx) { unsigned long long r; const unsigned off = (unsigned)idx * 8u;
    asm volatile("s_load_dwordx2 %0, %1, %2\n\ts_waitcnt lgkmcnt(0)" : "=s"(r) : "s"(__builtin_amdgcn_kernarg_segment_ptr()), "s"(off) : "memory"); return r; }
__device__ __forceinline__ const GAS float* karg_in(int i) { return (const GAS float*)karg_u64(i); }
__device__ __forceinline__ GAS float* karg_out() { return (GAS float*)karg_u64(20); }
__device__ __forceinline__ GAS unsigned char* karg_ws() { return (GAS unsigned char*)karg_u64(21); }
#define PHASE_IDS() int tid = threadIdx.x; asm volatile("" : "+v"(tid)); int bx = blockIdx.x; asm volatile("" : "+s"(bx)); int G = gridDim.x; asm volatile("" : "+s"(G)); \
    const int lane = tid & 63, wave = __builtin_amdgcn_readfirstlane(tid >> 6); const int vcu = (G % 8 == 0) ? (bx % 8) * (G / 8) + bx / 8 : bx; const int gw = vcu * NWAVES + wave, NGW = G * NWAVES; \
    GAS unsigned char* ws = karg_ws(); (void)lane; (void)gw; (void)NGW; (void)vcu; (void)ws
__global__ void __launch_bounds__(NWAVES * 64, 2) mk_fwd(Args args) {
    extern __shared__ __attribute__((aligned(16))) unsigned char lds_raw[];
    LAS unsigned char* lds = (LAS unsigned char*)lds_raw;
    volatile LAS unsigned* MISC = (volatile LAS unsigned*)(lds + MISC_OFF);
    for (int u = threadIdx.x; u < (LDS_BYTES - LDSCTL_OFF) / 4; u += NWAVES * 64) ((LAS unsigned*)(lds + LDSCTL_OFF))[u] = 0u;
    __syncthreads();
    (void)xcd_barrier_post((unsigned*)((gu32*)(karg_ws() + WS_CTL) + CW_BAR), MISC + 8);
#define GRID_BAR() do { XcdBarrier b_; b_.bar = (unsigned*)((gu32*)(karg_ws() + WS_CTL) + CW_BAR); b_.x = xb_xcc_id(); b_.st = MISC + 8; xcd_barrier(b_); } while (0)

    {   PHASE_IDS();
        LAS float* scr = (LAS float*)(lds + RING_OFF + wave * 16384);
        constexpr int I_GU = (D / 64) * (FF / 32), I_DN = (FF / 64) * (D / 32);
        constexpr int I_FFN = 2 * I_GU + I_DN, I_IN = 72 * (D / 64), I_OB = (1024 / 64) * (D / 32);
        constexpr int PER_LAYER = 2 * I_FFN + I_IN + I_OB;
        for (int it = gw; it < DEPTH * PER_LAYER; it += NGW) {
            const int l = it / PER_LAYER; int r = it - l * PER_LAYER;
            GAS unsigned char* wl = ws + WS_W0 + (size_t)l * W_LAYER;
            if (r < 2 * I_FFN) {
                const int f = r / I_FFN; r -= f * I_FFN;
                GAS bf16* dgu = (GAS bf16*)(wl + (f ? WO_GU2 : WO_GU1)); GAS bf16* dd = (GAS bf16*)(wl + (f ? WO_D2 : WO_D1));
                if (r < 2 * I_GU) { const int up = r >= I_GU; if (up) r -= I_GU; const int kb = r / (FF / 32), nb = r % (FF / 32), n0 = 32 * nb;
                    const GAS float* wsrc = karg_in(up ? (f ? 17 : 4) : (f ? 16 : 3)) + (size_t)l * D * FF;
                    conv_item(wsrc, FF, 64 * kb, n0, 32, dgu, D, (n0 >> 7) * 256 + (up ? 128 : 0) + (n0 & 127), 0, 1.0f, nullptr, scr, lane); }
                else { r -= 2 * I_GU; const int kb = r / (D / 32), nb = r % (D / 32);
                    conv_item(karg_in(f ? 18 : 5) + (size_t)l * FF * D, D, 64 * kb, 32 * nb, 32, dd, FF, 32 * nb, 0, 1.0f, nullptr, scr, lane); }
            } else if (r < 2 * I_FFN + I_IN) {
                r -= 2 * I_FFN; const int j = r >> 5, kb = r & 31; int src, nvalid = 32; float sc = 1.0f;
                if (j < 8) src = 1024 + 32 * j;
                else if (j < 24) src = 1280 + 32 * (j - 8);
                else if (j < 56) { src = 1864 + 32 * (j - 24); sc = 0.125f; }
                else if (j < 60) src = 2888 + 32 * (j - 56);
                else if (j < 64) src = 3016 + 32 * (j - 60);
                else if (j < 66) src = 1792 + 32 * (j - 64);
                else if (j == 66) { src = 1856; nvalid = 8; sc = 0.044194173824159216f; }
                else { src = 0; nvalid = 0; }
                conv_item(karg_in(7) + (size_t)l * D * D_IN, D_IN, 64 * kb, src, nvalid, (GAS bf16*)(wl + WO_IN), D, 2048 + 32 * j, 0, sc, nullptr, scr, lane);
            } else {
                r -= 2 * I_FFN + I_IN; const int kb = r >> 6, nb = r & 63;
                conv_item(karg_in(14) + (size_t)l * D * D + (size_t)1024 * D, D, 64 * kb, 32 * nb, 32, (GAS bf16*)(wl + WO_OUT), OLD, 32 * nb, 2048, 1.0f, nullptr, scr, lane);
            }
        }
        __syncthreads();
        LAS float* Ps = (LAS float*)(lds + RING_OFF); LAS float* Qs = Ps + 64 * 129;
        for (int u = vcu; u < DEPTH * 2048; u += G) {
            const int l = u >> 11, which = (u >> 10) & 1, v = u & 1023;
            GAS unsigned char* wl = ws + WS_W0 + (size_t)l * W_LAYER;
            if (which == 0) { const int h = v >> 7, rt = (v >> 5) & 3, kt = v & 31;
                absorb_unit<false>(karg_in(11) + (size_t)l * RANK * 1024 + ((size_t)(64 * rt) * 8 + h) * 128, 1024, 1, karg_in(7) + (size_t)l * D * D_IN + (size_t)(64 * kt) * D_IN + h * 128, D_IN,
                                   (GAS bf16*)(wl + WO_IN) + (size_t)(h * 256 + 64 * rt) * D + 64 * kt, D, 0.08838834764831845f, Ps, Qs, tid); }
            else { const int h = v >> 7, nt = (v >> 2) & 31, rt = v & 3;
                absorb_unit<true>(karg_in(14) + (size_t)l * D * D + (size_t)(h * 128) * D + 64 * nt, 1, D, karg_in(12) + (size_t)l * RANK * 1024 + ((size_t)(64 * rt) * 8 + h) * 128, 1024,
                                  (GAS bf16*)(wl + WO_OUT) + (size_t)(64 * nt) * OLD + h * 256 + 64 * rt, OLD, 1.0f, Ps, Qs, tid); }
        }
    }
    GRID_BAR();

#pragma unroll 1
    for (int s = 0; s < 2 * DEPTH; ++s) {
        const int l = s >> 1, f = s & 1;
        {   PHASE_IDS(); rmsnorm_rows_bf16(s == 0 ? karg_in(0) : karg_out(), karg_in(f ? 15 : 2) + (size_t)l * D, (GAS bf16*)(ws + WS_XN), gw, NGW, lane); }
        GRID_BAR();
        {   PHASE_IDS(); GAS unsigned char* wl = ws + WS_W0 + (size_t)l * W_LAYER;
            pg8::Gemm g{(const GAS bf16*)(ws + WS_XN), (const GAS bf16*)(wl + (f ? WO_GU2 : WO_GU1)), M, NGU, D}; pg8::StaticOrder S; S.init(M, NGU, G, bx);
            pg8::EpiSwiglu E{(GAS bf16*)(ws + WS_ACT), FF};
            pg8::gemm_phase<pg8::EpiSwiglu, pg8::StaticOrder, true, true>(lds + RING_OFF, g, S, E); }
        GRID_BAR();
        {   PHASE_IDS(); GAS unsigned char* wl = ws + WS_W0 + (size_t)l * W_LAYER;
            pg8::Gemm g{(const GAS bf16*)(ws + WS_ACT), (const GAS bf16*)(wl + (f ? WO_D2 : WO_D1)), M, D, FF}; pg8::StaticOrder S; S.init(M, D, G, bx);
            pg8::EpiResid E{s == 0 ? karg_in(0) : karg_out(), karg_out(), D, 0.5f};
            pg8::gemm_phase<pg8::EpiResid, pg8::StaticOrder, true, true>(lds + RING_OFF, g, S, E); }
        GRID_BAR();
        if (f == 0) {
            {   PHASE_IDS(); rmsnorm_rows_bf16(karg_out(), karg_in(6) + (size_t)l * D, (GAS bf16*)(ws + WS_XN), gw, NGW, lane); }
            GRID_BAR();
            {   PHASE_IDS(); GAS unsigned char* wl = ws + WS_W0 + (size_t)l * W_LAYER;
                pg8::Gemm g{(const GAS bf16*)(ws + WS_XN), (const GAS bf16*)(wl + WO_IN), M, ZLD, D}; pg8::StaticOrder S; S.init(M, ZLD, G, bx);
                pg8::EpiBf16 E{(GAS bf16*)(ws + WS_Z), ZLD};
                pg8::gemm_phase<pg8::EpiBf16, pg8::StaticOrder, true, true>(lds + RING_OFF, g, S, E); }
            GRID_BAR();
            {   PHASE_IDS();
                post_rows((const GAS bf16*)(ws + WS_Z), karg_in(8) + (size_t)l * RANK, karg_in(9) + (size_t)l * IDIM, karg_in(10) + (size_t)l * IDIM, (GAS bf16*)(ws + WS_CKVN), (GAS bf16*)(ws + WS_KIN), (GAS float*)(ws + WS_WIF), gw, NGW, lane);
                swa_phase(lds + RING_OFF, (const GAS bf16*)(ws + WS_Z), (GAS bf16*)(ws + WS_O), karg_in(1), karg_in(13) + (size_t)l * H_B, vcu, G, tid, lane, wave);
            }
            GRID_BAR();
            {   PHASE_IDS(); topk_phase(lds + RING_OFF, (const GAS bf16*)(ws + WS_Z), (const GAS bf16*)(ws + WS_KIN), (const GAS float*)(ws + WS_WIF), (GAS unsigned short*)(ws + WS_IDX), vcu, G, lane, wave); }
            GRID_BAR();
            {   PHASE_IDS(); dsa_phase(lds, (const GAS bf16*)(ws + WS_Z), (const GAS bf16*)(ws + WS_CKVN), (const GAS unsigned short*)(ws + WS_IDX), (GAS bf16*)(ws + WS_O), karg_in(1), gw, NGW, tid, lane, wave); }
            GRID_BAR();
            {   PHASE_IDS(); GAS unsigned char* wl = ws + WS_W0 + (size_t)l * W_LAYER;
                pg8::Gemm g{(const GAS bf16*)(ws + WS_O), (const GAS bf16*)(wl + WO_OUT), M, D, OLD}; pg8::StaticOrder S; S.init(M, D, G, bx);
                pg8::EpiResid E{karg_out(), karg_out(), D, 1.0f};
                pg8::gemm_phase<pg8::EpiResid, pg8::StaticOrder, true, true>(lds + RING_OFF, g, S, E); }
            GRID_BAR();
        }
    }
    {   PHASE_IDS(); rmsnorm_rows_f32_inplace(karg_out(), karg_in(19), gw, NGW, lane); }
}

extern "C" void kernel_launch(void* const* d_in, const int* in_sizes, int n_in, void* d_out, int out_size, void* d_ws, size_t ws_size, hipStream_t stream) {
    static int grid = 0;
    if (grid == 0) {
        if (n_in != 20 || in_sizes[0] != M * D || out_size != M * D || ws_size < WS_END) { fprintf(stderr, "kernel_launch: unexpected shapes (n_in %d, in0 %d, out %d, ws %zu); nothing launched\n", n_in, n_in > 0 ? in_sizes[0] : -1, out_size, ws_size); grid = -1; return; }
        int dev = 0, cus = 0, per_cu = 0;
        if (hipGetDevice(&dev) != hipSuccess || hipDeviceGetAttribute(&cus, hipDeviceAttributeMultiprocessorCount, dev) != hipSuccess) { grid = -1; return; }
        if (hipFuncSetAttribute((const void*)mk_fwd, hipFuncAttributeMaxDynamicSharedMemorySize, LDS_BYTES) != hipSuccess) { fprintf(stderr, "kernel_launch: hipFuncSetAttribute failed\n"); grid = -1; return; }
        if (hipOccupancyMaxActiveBlocksPerMultiprocessor(&per_cu, (const void*)mk_fwd, NWAVES * 64, LDS_BYTES) != hipSuccess || per_cu < 1) { fprintf(stderr, "kernel_launch: occupancy query reports %d workgroups per CU\n", per_cu); }
        (void)hipGetLastError();
        grid = cus;
    }
    if (grid < 0) return;
    if (hipMemsetAsync((char*)d_ws + WS_CTL, 0, CTL_ZERO_BYTES, stream) != hipSuccess) return;
    Args a{};
    for (int i = 0; i < 20; ++i) a.in[i] = (const float*)d_in[i];
    a.out = (float*)d_out; a.ws = (unsigned char*)d_ws;
    hipLaunchKernelGGL(mk_fwd, dim3(grid), dim3(NWAVES * 64), LDS_BYTES, stream, a);
}
```

```cpp
#include <hip/hip_runtime.h>
#include <cstdio>
#include <cstdint>
namespace pg8 {
#define PG8_LAS __attribute__((address_space(3)))
#define PG8_GAS __attribute__((address_space(1)))
typedef unsigned short bf16_t;
typedef short bf16x8 __attribute__((ext_vector_type(8)));
typedef float f32x4 __attribute__((ext_vector_type(4)));
typedef unsigned u32x4 __attribute__((ext_vector_type(4)));
constexpr int BM = 256, BK = 64, HALF = 128, HTB = HALF * BK * 2  , STAGE_BYTES = 8 * HTB, NXCD = 8, WGM = 8;

__host__ __device__ __forceinline__ int lds_byte(int r, int c) { const int st = (r >> 4) * 2 + (c >> 5), rr = r & 15, cc = c & 31, ob = rr * 64 + cc * 2; return st * 1024 + (ob ^ (((ob >> 9) & 1) << 5)); }
__host__ __device__ __forceinline__ void stage_rc(int b, int& R, int& C) { const int st = b / 1024, sb = b % 1024, swz = sb ^ (((sb >> 9) & 1) << 5); R = (st >> 1) * 16 + swz / 64; C = (st & 1) * 32 + (swz % 64) / 2; }
__host__ __device__ __forceinline__ int perm32(int rho) { const int n = rho >> 4, i = rho & 15; return 8 * (i >> 2) + 4 * n + (i & 3); }

struct Unit { int pm, pn; };
struct Gemm { const PG8_GAS bf16_t* A; const PG8_GAS bf16_t* Bt; int M, N, K; };

struct StaticOrder {
    int nM, nN, nwg, G, c;
    __host__ __device__ void init(int M, int N, int G_, int c_) { nM = M / BM; nN = N / BM; nwg = nM * nN; G = G_; c = c_; }
    __host__ __device__ bool next(int i, Unit& u) const {
        const long L = (long)i * G + c; if (L >= nwg) return false;
        int wgid = (int)L; { const int q = nwg / NXCD, r = nwg % NXCD, xcd = wgid % NXCD, off = wgid / NXCD; wgid = (xcd < r ? xcd * (q + 1) : r * (q + 1) + (xcd - r) * q) + off; }
        const int nig = WGM * nN, gid = wgid / nig, fm = gid * WGM, gsz = (nM - fm) < WGM ? (nM - fm) : WGM;
        u.pm = fm + ((wgid % nig) % gsz); u.pn = (wgid % nig) / gsz; return true;
    }
    __device__ __forceinline__ void a_ready(const Unit&) const {}
    __device__ __forceinline__ void done(const Unit&) const {}
};
__device__ __forceinline__ unsigned long long karg64(int idx) { unsigned long long r; const unsigned off = (unsigned)idx * 8u;
    asm volatile("s_load_dwordx2 %0, %1, %2\n\ts_waitcnt lgkmcnt(0)" : "=s"(r) : "s"(__builtin_amdgcn_kernarg_segment_ptr()), "s"(off) : "memory"); return r; }
__device__ __forceinline__ unsigned cvt_pk_bf16(float lo, float hi) { unsigned r; asm volatile("v_cvt_pk_bf16_f32 %0, %1, %2" : "=v"(r) : "v"(lo), "v"(hi)); return r; }
__device__ __forceinline__ float silu_f(float g) { return g * __builtin_amdgcn_rcpf(1.0f + __builtin_amdgcn_exp2f(-1.4426950408889634f * g)); }

struct EpiSwiglu {
    static constexpr bool PERM = true, AFTER_DRAIN = false;
    PG8_GAS bf16_t* O; int ldc; const PG8_GAS float* ss; float inv_k, eps;
    __device__ __forceinline__ void operator()(const f32x4 (&acc)[2][2][4][2], const Unit& u, int wr, int wc, int fr, int fq) const {
        const int row0 = u.pm * BM + wr * 64 + fr, col0 = u.pn * HALF + wc * 32 + 8 * fq;
        float rs[8]; const int lane_ = fr + 16 * fq;
#pragma unroll
        for (int k = 0; k < 8; ++k) { const PG8_GAS f32x4* p4 = (const PG8_GAS f32x4*)(ss + (size_t)(row0 + (k >> 2) * HALF + (k & 3) * 16) * 32 + 8 * fq); const f32x4 a = p4[0], b = p4[1];
            float t = ((a[0] + a[1]) + (a[2] + a[3])) + ((b[0] + b[1]) + (b[2] + b[3]));
            t += __builtin_bit_cast(float, __builtin_amdgcn_ds_bpermute((lane_ ^ 16) << 2, __builtin_bit_cast(int, t)));
            t += __builtin_bit_cast(float, __builtin_amdgcn_ds_bpermute((lane_ ^ 32) << 2, __builtin_bit_cast(int, t))); rs[k] = t; }
#pragma unroll
        for (int ai = 0; ai < 2; ++ai)
#pragma unroll
            for (int m = 0; m < 4; ++m) { PG8_GAS bf16_t* rowp = O + (size_t)(row0 + ai * HALF + m * 16) * ldc + col0;
                const float r = __builtin_amdgcn_rsqf(rs[ai * 4 + m] * inv_k + eps);
                const f32x4 g0 = acc[ai][0][m][0] * r, g1 = acc[ai][0][m][1] * r, u0 = acc[ai][1][m][0] * r, u1 = acc[ai][1][m][1] * r;
                u32x4 w; w.x = cvt_pk_bf16(silu_f(g0[0]) * u0[0], silu_f(g0[1]) * u0[1]); w.y = cvt_pk_bf16(silu_f(g0[2]) * u0[2], silu_f(g0[3]) * u0[3]);
                w.z = cvt_pk_bf16(silu_f(g1[0]) * u1[0], silu_f(g1[1]) * u1[1]); w.w = cvt_pk_bf16(silu_f(g1[2]) * u1[2], silu_f(g1[3]) * u1[3]);
                *(PG8_GAS u32x4*)rowp = w; }
    }
};
struct EpiResid {
    static constexpr bool PERM = true, AFTER_DRAIN = false;
    float alpha; unsigned hb_off; unsigned ss_off;
    __device__ __forceinline__ void operator()(const f32x4 (&acc)[2][2][4][2], const Unit& u, int wr, int wc, int fr, int fq) const {
        constexpr int ldc = 2048;
        PG8_GAS unsigned char* wsb = (PG8_GAS unsigned char*)karg64(21); PG8_GAS bf16_t* hb = (PG8_GAS bf16_t*)(wsb + hb_off); PG8_GAS float* ss = (PG8_GAS float*)(wsb + ss_off);
        const int row0 = u.pm * BM + wr * 64 + fr, col0 = u.pn * BM + wc * 32 + 8 * fq; const int lane = fr + 16 * fq;
        u32x4 cur[2], nxt[2];
        { const size_t off = (size_t)row0 * ldc + col0; cur[0] = *(const PG8_GAS u32x4*)(hb + off); cur[1] = *(const PG8_GAS u32x4*)(hb + off + HALF); }
#pragma unroll
        for (int k = 0; k < 8; ++k) { const int ai = k >> 2, m = k & 3; const int row = row0 + ai * HALF + m * 16; const size_t off = (size_t)row * ldc + col0;
            if (k < 7) { const int ai2 = (k + 1) >> 2, m2 = (k + 1) & 3; const size_t off2 = (size_t)(row0 + ai2 * HALF + m2 * 16) * ldc + col0;
                nxt[0] = *(const PG8_GAS u32x4*)(hb + off2); nxt[1] = *(const PG8_GAS u32x4*)(hb + off2 + HALF); }
            float sq = 0.f;
#pragma unroll
            for (int bj = 0; bj < 2; ++bj) { const u32x4 b = cur[bj]; const f32x4 a0 = acc[ai][bj][m][0], a1 = acc[ai][bj][m][1]; u32x4 w;
                w.x = cvt_pk_bf16(__builtin_bit_cast(float, b.x << 16) + a0[0] * alpha, __builtin_bit_cast(float, b.x & 0xffff0000u) + a0[1] * alpha);
                w.y = cvt_pk_bf16(__builtin_bit_cast(float, b.y << 16) + a0[2] * alpha, __builtin_bit_cast(float, b.y & 0xffff0000u) + a0[3] * alpha);
                w.z = cvt_pk_bf16(__builtin_bit_cast(float, b.z << 16) + a1[0] * alpha, __builtin_bit_cast(float, b.z & 0xffff0000u) + a1[1] * alpha);
                w.w = cvt_pk_bf16(__builtin_bit_cast(float, b.w << 16) + a1[2] * alpha, __builtin_bit_cast(float, b.w & 0xffff0000u) + a1[3] * alpha);
                *(PG8_GAS u32x4*)(hb + off + bj * HALF) = w;
#pragma unroll
                for (int e = 0; e < 4; ++e) { const float lo = __builtin_bit_cast(float, w[e] << 16), hi = __builtin_bit_cast(float, w[e] & 0xffff0000u); sq = fmaf(lo, lo, sq); sq = fmaf(hi, hi, sq); } }
            sq += __builtin_bit_cast(float, __builtin_amdgcn_ds_bpermute((lane ^ 16) << 2, __builtin_bit_cast(int, sq)));
            sq += __builtin_bit_cast(float, __builtin_amdgcn_ds_bpermute((lane ^ 32) << 2, __builtin_bit_cast(int, sq)));
            if (fq == 0) ss[(size_t)row * 32 + u.pn * 4 + wc] = sq;
            cur[0] = nxt[0]; cur[1] = nxt[1]; }
    }
};
struct EpiBf16 {
    static constexpr bool PERM = true, AFTER_DRAIN = false;
    PG8_GAS bf16_t* O; int ldc; const PG8_GAS float* ss; float inv_k, eps;
    __device__ __forceinline__ void operator()(const f32x4 (&acc)[2][2][4][2], const Unit& u, int wr, int wc, int fr, int fq) const {
        const int row0 = u.pm * BM + wr * 64 + fr, col0 = u.pn * BM + wc * 32 + 8 * fq;
        float rs[8]; const int lane_ = fr + 16 * fq;
#pragma unroll
        for (int k = 0; k < 8; ++k) { const PG8_GAS f32x4* p4 = (const PG8_GAS f32x4*)(ss + (size_t)(row0 + (k >> 2) * HALF + (k & 3) * 16) * 32 + 8 * fq); const f32x4 a = p4[0], b = p4[1];
            float t = ((a[0] + a[1]) + (a[2] + a[3])) + ((b[0] + b[1]) + (b[2] + b[3]));
            t += __builtin_bit_cast(float, __builtin_amdgcn_ds_bpermute((lane_ ^ 16) << 2, __builtin_bit_cast(int, t)));
            t += __builtin_bit_cast(float, __builtin_amdgcn_ds_bpermute((lane_ ^ 32) << 2, __builtin_bit_cast(int, t))); rs[k] = t; }
#pragma unroll
        for (int ai = 0; ai < 2; ++ai)
#pragma unroll
            for (int m = 0; m < 4; ++m) { PG8_GAS bf16_t* rowp = O + (size_t)(row0 + ai * HALF + m * 16) * ldc + col0;
                const float r = __builtin_amdgcn_rsqf(rs[ai * 4 + m] * inv_k + eps);
#pragma unroll
                for (int bj = 0; bj < 2; ++bj) { const f32x4 v0 = acc[ai][bj][m][0] * r, v1 = acc[ai][bj][m][1] * r;
                    u32x4 w; w.x = cvt_pk_bf16(v0[0], v0[1]); w.y = cvt_pk_bf16(v0[2], v0[3]); w.z = cvt_pk_bf16(v1[0], v1[1]); w.w = cvt_pk_bf16(v1[2], v1[3]);
                    *(PG8_GAS u32x4*)(rowp + bj * HALF) = w; } }
    }
};
template <class Epi, class Sched, bool ALIGN_EPI = false, bool SP2 = false>
__device__ __forceinline__ void gemm_phase(PG8_LAS unsigned char* lds, const Gemm g, const Sched& S, const Epi& E) {
    int tid_ = threadIdx.x; asm volatile("" : "+v"(tid_));
    const int tid = tid_, wid = __builtin_amdgcn_readfirstlane(tid >> 6), lane = tid & 63, wr = wid >> 2, wc = wid & 3, fr = lane & 15, fq = lane >> 4;
    const int K = g.K, nt = K / BK;
    unsigned voffA[2], voffB[2];
#pragma unroll
    for (int i = 0; i < 2; ++i) { int R, C; stage_rc(tid * 16 + i * 8192, R, C); const int Rb = Epi::PERM ? ((R & ~31) + perm32(R & 31)) : R;
        voffA[i] = (unsigned)(R * K + C) * 2u; voffB[i] = (unsigned)(Rb * K + C) * 2u; }
    const size_t kstep = (size_t)(BK * 2);
    const size_t hstep = (size_t)HALF * K * 2;
    const size_t tstep = 2 * hstep;
    const unsigned ldsw = (unsigned)wid * 1024u;
    const int aoff = lds_byte(wr * 64 + fr, fq * 8), boff = lds_byte(wc * 32 + fr, fq * 8);
#define PG8_SA(b, h) (((b) * 2 + (h)) * HTB)
#define PG8_SB(b, h) ((4 + (b) * 2 + (h)) * HTB)
#define PG8_STAGE(bufoff, gbase, voff) do { _Pragma("unroll") for (int _i = 0; _i < 2; ++_i) \
        __builtin_amdgcn_global_load_lds((const PG8_GAS unsigned*)((const PG8_GAS char*)(gbase) + (voff)[_i]), (PG8_LAS unsigned*)(lds + (bufoff) + ldsw + _i * 8192), 16, 0, 0); } while (0)
#define PG8_LDA(dst, b, h) do { _Pragma("unroll") for (int m = 0; m < 4; ++m) _Pragma("unroll") for (int k = 0; k < 2; ++k) dst[m][k] = *(const PG8_LAS bf16x8*)(lds + PG8_SA(b, h) + aoff + m * 2048 + k * 1024); } while (0)
#define PG8_LDB(dst, b, h) do { _Pragma("unroll") for (int n = 0; n < 2; ++n) _Pragma("unroll") for (int k = 0; k < 2; ++k) dst[n][k] = *(const PG8_LAS bf16x8*)(lds + PG8_SB(b, h) + boff + n * 2048 + k * 1024); } while (0)
#define PG8_MMA(ai, bj, At, Bt) do { __builtin_amdgcn_s_setprio(1); _Pragma("unroll") for (int m = 0; m < 4; ++m) _Pragma("unroll") for (int n = 0; n < 2; ++n) _Pragma("unroll") for (int k = 0; k < 2; ++k) \
        acc[ai][bj][m][n] = __builtin_amdgcn_mfma_f32_16x16x32_bf16(Bt[n][k], At[m][k], acc[ai][bj][m][n], 0, 0, 0); __builtin_amdgcn_s_setprio(0); } while (0)
#define PG8_WAIT_V(n) asm volatile("s_waitcnt vmcnt(" #n ")" ::: "memory")
#define PG8_WAIT_L(n) asm volatile("s_waitcnt lgkmcnt(" #n ")" ::: "memory")
#define PG8_BAR __builtin_amdgcn_s_barrier()
#define PG8_SCHED __builtin_amdgcn_sched_barrier(0)
    Unit cur, nxt; int ui = 0;
    if (!S.next(0, cur)) return;
    f32x4 acc[2][2][4][2];
#pragma unroll
    for (int a = 0; a < 2; ++a)
#pragma unroll
        for (int b = 0; b < 2; ++b)
#pragma unroll
            for (int m = 0; m < 4; ++m)
#pragma unroll
                for (int n = 0; n < 2; ++n) acc[a][b][m][n] = (f32x4){0.f, 0.f, 0.f, 0.f};
    bf16x8 At[4][2], B0[2][2], B1[2][2];
    const PG8_GAS char* cA = (const PG8_GAS char*)g.A + (size_t)cur.pm * tstep; const PG8_GAS char* cB = (const PG8_GAS char*)g.Bt + (size_t)cur.pn * tstep;
    S.a_ready(cur);
    if constexpr (SP2) {
        PG8_STAGE(PG8_SB(0, 0), cB, voffB); PG8_STAGE(PG8_SB(0, 1), cB + hstep, voffB); PG8_STAGE(PG8_SA(0, 0), cA, voffA); PG8_STAGE(PG8_SA(0, 1), cA + hstep, voffA);
        if (wr == 1) PG8_BAR;
        PG8_WAIT_V(2); PG8_BAR;
        PG8_STAGE(PG8_SB(1, 0), cB + kstep, voffB); PG8_STAGE(PG8_SA(1, 0), cA + kstep, voffA); PG8_STAGE(PG8_SB(1, 1), cB + hstep + kstep, voffB);
        PG8_WAIT_V(6); PG8_BAR;
    } else {
        PG8_STAGE(PG8_SB(0, 0), cB, voffB); PG8_STAGE(PG8_SA(0, 0), cA, voffA); PG8_STAGE(PG8_SB(0, 1), cB + hstep, voffB); PG8_STAGE(PG8_SA(0, 1), cA + hstep, voffA);
        if (wr == 1) PG8_BAR;
        PG8_WAIT_V(4); PG8_BAR;
        PG8_STAGE(PG8_SB(1, 0), cB + kstep, voffB); PG8_STAGE(PG8_SA(1, 0), cA + kstep, voffA); PG8_STAGE(PG8_SB(1, 1), cB + hstep + kstep, voffB);
        PG8_WAIT_V(6); PG8_BAR;
    }
    for (;;) {
        const bool has_next = S.next(ui + 1, nxt);
        const PG8_GAS char* nA = has_next ? (const PG8_GAS char*)g.A + (size_t)nxt.pm * tstep : cA; const PG8_GAS char* nB = has_next ? (const PG8_GAS char*)g.Bt + (size_t)nxt.pn * tstep : cB;
        for (int t = 0; t < nt; t += 2) {
            const bool last = (t == nt - 2);
            const PG8_GAS char* a1 = cA + (size_t)(t + 1) * kstep;
            const PG8_GAS char* a2 = last ? nA : cA + (size_t)(t + 2) * kstep; const PG8_GAS char* b2 = last ? nB : cB + (size_t)(t + 2) * kstep;
            const PG8_GAS char* a3 = a2 + kstep; const PG8_GAS char* b3 = b2 + kstep;
            if (last && has_next) S.a_ready(nxt);
            if constexpr (SP2) {
            PG8_LDB(B0, 0, 0); PG8_LDB(B1, 0, 1); PG8_SCHED; PG8_LDA(At, 0, 0); PG8_STAGE(PG8_SA(1, 1), a1 + hstep, voffA);
            PG8_WAIT_V(8); PG8_WAIT_L(0); PG8_BAR; PG8_MMA(0, 0, At, B0); PG8_MMA(0, 1, At, B1); PG8_BAR; PG8_SCHED;
            PG8_LDA(At, 0, 1); PG8_STAGE(PG8_SB(0, 0), b2, voffB); PG8_STAGE(PG8_SB(0, 1), b2 + hstep, voffB); PG8_STAGE(PG8_SA(0, 0), a2, voffA);
            PG8_WAIT_V(8); PG8_WAIT_L(0); PG8_BAR; PG8_MMA(1, 0, At, B0); PG8_MMA(1, 1, At, B1); PG8_BAR; PG8_SCHED;
            PG8_LDB(B0, 1, 0); PG8_LDB(B1, 1, 1); PG8_SCHED; PG8_LDA(At, 1, 0); PG8_STAGE(PG8_SA(0, 1), a2 + hstep, voffA);
            PG8_WAIT_V(8); PG8_WAIT_L(0); PG8_BAR; PG8_MMA(0, 0, At, B0); PG8_MMA(0, 1, At, B1); PG8_BAR; PG8_SCHED;
            PG8_LDA(At, 1, 1); PG8_STAGE(PG8_SB(1, 0), b3, voffB); PG8_STAGE(PG8_SB(1, 1), b3 + hstep, voffB); PG8_STAGE(PG8_SA(1, 0), a3, voffA);
            PG8_WAIT_V(8); PG8_WAIT_L(0); PG8_BAR; PG8_MMA(1, 0, At, B0); PG8_MMA(1, 1, At, B1); PG8_BAR; PG8_SCHED;
            } else {
            PG8_LDB(B0, 0, 0); PG8_SCHED; PG8_LDA(At, 0, 0); PG8_STAGE(PG8_SA(1, 1), a1 + hstep, voffA);
            PG8_WAIT_L(8); PG8_BAR; PG8_WAIT_L(0); PG8_MMA(0, 0, At, B0); PG8_BAR; PG8_SCHED;
            PG8_LDB(B1, 0, 1); PG8_STAGE(PG8_SB(0, 0), b2, voffB);
            PG8_BAR; PG8_WAIT_L(0); PG8_MMA(0, 1, At, B1); PG8_BAR;
            PG8_LDA(At, 0, 1); PG8_STAGE(PG8_SA(0, 0), a2, voffA);
            PG8_BAR; PG8_WAIT_L(0); PG8_MMA(1, 0, At, B0); PG8_BAR; PG8_SCHED;
            PG8_STAGE(PG8_SB(0, 1), b2 + hstep, voffB);
            PG8_WAIT_V(6); PG8_BAR; PG8_MMA(1, 1, At, B1); PG8_BAR;
            PG8_LDB(B0, 1, 0); PG8_SCHED; PG8_LDA(At, 1, 0); PG8_STAGE(PG8_SA(0, 1), a2 + hstep, voffA);
            PG8_WAIT_L(8); PG8_BAR; PG8_WAIT_L(0); PG8_MMA(0, 0, At, B0); PG8_BAR; PG8_SCHED;
            PG8_LDB(B1, 1, 1); PG8_STAGE(PG8_SB(1, 0), b3, voffB);
            PG8_BAR; PG8_WAIT_L(0); PG8_MMA(0, 1, At, B1); PG8_BAR;
            PG8_LDA(At, 1, 1); PG8_STAGE(PG8_SA(1, 0), a3, voffA);
            PG8_BAR; PG8_WAIT_L(0); PG8_MMA(1, 0, At, B0); PG8_BAR; PG8_SCHED;
            PG8_STAGE(PG8_SB(1, 1), b3 + hstep, voffB);
            PG8_WAIT_V(6); PG8_BAR; PG8_MMA(1, 1, At, B1); PG8_BAR;
            }
        }
        if constexpr (ALIGN_EPI) { if (wr == 0) PG8_BAR; }
        if constexpr (!Epi::AFTER_DRAIN) { E(acc, cur, wr, wc, fr, fq); S.done(cur); }
        if (!has_next) break;
#pragma unroll
        for (int a = 0; a < 2; ++a)
#pragma unroll
            for (int b = 0; b < 2; ++b)
#pragma unroll
                for (int m = 0; m < 4; ++m)
#pragma unroll
                    for (int n = 0; n < 2; ++n) acc[a][b][m][n] = (f32x4){0.f, 0.f, 0.f, 0.f};
        cur = nxt; cA = nA; cB = nB; ++ui;
        if constexpr (ALIGN_EPI) { if (wr == 1) PG8_BAR; }
    }
    PG8_WAIT_V(0);
    if constexpr (!ALIGN_EPI) { if (wr == 0) PG8_BAR; }
    PG8_BAR;
    if constexpr (Epi::AFTER_DRAIN) { E.fused(acc, cur, wr, wc, fr, fq, lds, wid, lane); S.done(cur); }
#undef PG8_SA
#undef PG8_SB
#undef PG8_STAGE
#undef PG8_LDA
#undef PG8_LDB
#undef PG8_MMA
#undef PG8_WAIT_V
#undef PG8_WAIT_L
#undef PG8_BAR
#undef PG8_SCHED
}
}
constexpr int NWAVES = 8;
constexpr int BATCH = 8, SEQ = 4096, D = 2048, FF = 5632, DEPTH = 2;
constexpr int M = BATCH * SEQ;
constexpr int NGU = 2 * FF;
constexpr int H_A = 8, HD_A = 128, RANK = 256, IH = 8, IDIM = 64, TOPK = 256;
constexpr int H_B = 16, KVH = 2, GQA = 8, HD_B = 64, WINDOW = 128;
constexpr int D_IN = 3144;
constexpr float EPS = 1e-6f;
constexpr size_t MiB = 1u << 20;
constexpr size_t WS_CTL = 0, CTL_ZERO_BYTES = 1 * MiB;
constexpr size_t WS_W0 = 2 * MiB, W_LAYER = 162 * MiB;
constexpr size_t WO_GU1 = 0, WO_D1 = 44 * MiB, WO_GU2 = 66 * MiB, WO_D2 = 110 * MiB, WO_IN = 132 * MiB, WO_OUT = 149 * MiB;
constexpr size_t WS_XN = 326 * MiB;
constexpr size_t WS_ACT = 454 * MiB;
constexpr size_t WS_Z = WS_ACT, WS_CKVN = WS_ACT + 272 * MiB, WS_KIN = WS_ACT + 288 * MiB, WS_WIF = WS_ACT + 292 * MiB, WS_IDX = WS_ACT + 294 * MiB;
constexpr int ZLD = 4352, ZC_QLAT = 0, ZC_CKV = 2048, ZC_QI = 2304, ZC_QB = 2816, ZC_KB = 3840, ZC_VB = 3968, ZC_KI = 4096, ZC_WI = 4160;
constexpr int OLD = 3072;
constexpr size_t WS_O = 806 * MiB;
constexpr size_t WS_END = 1006 * MiB;
constexpr size_t WS_SS = 998 * MiB, SS_BYTES = 4 * MiB;
constexpr int CW_TMO = 0, CW_CODE = 1, CW_BAR = 4096;
constexpr int RING_OFF = 0, RING_BYTES = 131072;
constexpr int LDSCTL_OFF = RING_BYTES, MISC_OFF = LDSCTL_OFF + 320;
constexpr int LDS_BYTES = 147456;
#define GAS __attribute__((address_space(1)))
#define LAS __attribute__((address_space(3)))
typedef unsigned short bf16;
typedef unsigned v4u __attribute__((ext_vector_type(4)));
typedef float f32x4 __attribute__((ext_vector_type(4)));
typedef short bf16x8 __attribute__((ext_vector_type(8)));
typedef GAS unsigned gu32;
typedef GAS unsigned long long gu64;
#define RLX_AGENT __ATOMIC_RELAXED, __HIP_MEMORY_SCOPE_AGENT
#define LDS_WAIT() asm volatile("s_waitcnt lgkmcnt(0)" ::: "memory")
#define VM_WAIT() asm volatile("s_waitcnt vmcnt(0)" ::: "memory")
__device__ __forceinline__ unsigned long long rt() { return __builtin_amdgcn_s_memrealtime(); }
__device__ __forceinline__ unsigned f2bf(float f) { unsigned u = __builtin_bit_cast(unsigned, f); return (u + 0x7fffu + ((u >> 16) & 1u)) >> 16; }
__device__ __forceinline__ unsigned pk2(float lo, float hi) { return f2bf(lo) | (f2bf(hi) << 16); }

#define XB_TMO      128
#define XB_XCNT(j)  (256  + 64 * (j))
#define XB_XSUB(j)  (1280 + 64 * (j))
#define XB_XGEN(j)  (2304 + 64 * (j))
#define XB_TOP      3328
#define XB_TOPGEN   3392
#define XCD_BAR_WORDS 3456
#define XB_SPIN_CAP (1u << 18)

__device__ __forceinline__ unsigned xb_ld(unsigned* p)              { return __hip_atomic_load(p, __ATOMIC_RELAXED, __HIP_MEMORY_SCOPE_AGENT); }
__device__ __forceinline__ unsigned xb_add(unsigned* p, unsigned v) { return __hip_atomic_fetch_add(p, v, __ATOMIC_RELAXED, __HIP_MEMORY_SCOPE_AGENT); }
__device__ __forceinline__ unsigned xb_xcc_id() { return (unsigned)__builtin_amdgcn_s_getreg((3 << 11) | 20) & 0xFu; }
#define XB_SPIN(cond, bar) do { unsigned _sp = 0; while (cond) { __builtin_amdgcn_s_sleep(1); \
    if ((++_sp & 255u) == 0u) { if (xb_ld(&(bar)[XB_TMO])) break; if (_sp > XB_SPIN_CAP) { atomicAdd(&(bar)[XB_TMO], 1u); break; } } } } while (0)

struct XcdBarrier {
    unsigned* bar; unsigned x;
    volatile LAS unsigned* st;
};

__device__ __forceinline__ XcdBarrier xcd_barrier_post(unsigned* bar, volatile LAS unsigned* st) {
    XcdBarrier b; b.bar = bar; b.x = xb_xcc_id(); b.st = st;
    if (threadIdx.x == 0) (void)xb_add(&bar[XB_XCNT(b.x)], 1u);
    return b;
}
__device__ __forceinline__ void xcd_barrier_complete(unsigned* bar, unsigned x, unsigned& nloc, unsigned& nx) {
    const unsigned G = gridDim.x * gridDim.y * gridDim.z;
    unsigned sum, cnt, mine, sp = 0u;
    for (;;) {
        sum = 0u; cnt = 0u; mine = 0u;
#pragma unroll
        for (unsigned j = 0; j < 16; ++j) { const unsigned c = xb_ld(&bar[XB_XCNT(j)]); sum += c; cnt += (c > 0u) ? 1u : 0u; mine = (j == x) ? c : mine; }
        if (sum == G) break;
        __builtin_amdgcn_s_sleep(1);
        if ((++sp & 255u) == 0u) { if (xb_ld(&bar[XB_TMO])) break; if (sp > XB_SPIN_CAP) { atomicAdd(&bar[XB_TMO], 1u); break; } }
    }
    nloc = mine > 0u ? mine : 1u; nx = cnt > 0u ? cnt : 1u;
}

__device__ __forceinline__ void xcd_barrier(const XcdBarrier& b) {
    asm volatile("s_waitcnt vmcnt(0)" ::: "memory");
    __syncthreads();
    if (threadIdx.x == 0) {
        unsigned* bar = b.bar;
        __builtin_amdgcn_s_waitcnt(0);
        unsigned nloc = b.st[0], nx = b.st[1];
        if (nloc == 0u) { xcd_barrier_complete(bar, b.x, nloc, nx); b.st[0] = nloc; b.st[1] = nx; }
        const unsigned old = xb_add(&bar[XB_XSUB(b.x)], 1u);
        const unsigned gen = old / nloc;
        if (old + 1u == (gen + 1u) * nloc) {
            __builtin_amdgcn_fence(__ATOMIC_RELEASE, "agent");
            asm volatile("s_waitcnt vmcnt(0)" ::: "memory");
            const unsigned og = xb_add(&bar[XB_TOP], 1u);
            const unsigned tg = og / nx;
            if (og + 1u == (tg + 1u) * nx) xb_add(&bar[XB_TOPGEN], 1u);
            else XB_SPIN(xb_ld(&bar[XB_TOPGEN]) == tg, bar);
            __builtin_amdgcn_fence(__ATOMIC_ACQUIRE, "agent");
            xb_add(&bar[XB_XGEN(b.x)], 1u);
            asm volatile("s_waitcnt vmcnt(0)" ::: "memory");
        } else {
            XB_SPIN(xb_ld(&bar[XB_XGEN(b.x)]) == gen, bar);
            __builtin_amdgcn_fence(__ATOMIC_ACQUIRE, "agent");
            asm volatile("s_waitcnt vmcnt(0)" ::: "memory");
        }
    }
    __syncthreads();
}
__constant__ unsigned char T5_BUCKET[128] = {0, 1, 2, 3, 4, 5, 6, 7, 8, 9, 10, 11, 12, 13, 14, 15, 16, 16, 16, 17, 17, 18, 18, 18, 19, 19, 19, 20, 20, 20, 20, 21, 21, 21, 21, 22, 22, 22, 22, 22, 23, 23, 23, 23, 23, 23, 24, 24, 24, 24, 24, 24, 25, 25, 25, 25, 25, 25, 25, 26, 26, 26, 26, 26, 26, 26, 26, 27, 27, 27, 27, 27, 27, 27, 27, 27, 27, 28, 28, 28, 28, 28, 28, 28, 28, 28, 28, 29, 29, 29, 29, 29, 29, 29, 29, 29, 29, 29, 29, 30, 30, 30, 30, 30, 30, 30, 30, 30, 30, 30, 30, 30, 30, 31, 31, 31, 31, 31, 31, 31, 31, 31, 31, 31, 31, 31, 31, 31};
typedef short s16x4 __attribute__((ext_vector_type(4)));
typedef float f32x16 __attribute__((ext_vector_type(16)));
__device__ __forceinline__ float bf2f(unsigned short b) { return __builtin_bit_cast(float, (unsigned)b << 16); }
__device__ __forceinline__ bf16x8 cat4(s16x4 lo, s16x4 hi) { return __builtin_shufflevector(lo, hi, 0, 1, 2, 3, 4, 5, 6, 7); }
__device__ __forceinline__ void tr_read4(unsigned a0, unsigned a1, unsigned a2, unsigned a3, s16x4& r0, s16x4& r1, s16x4& r2, s16x4& r3) {
    asm volatile("ds_read_b64_tr_b16 %0, %4\n\tds_read_b64_tr_b16 %1, %5\n\tds_read_b64_tr_b16 %2, %6\n\tds_read_b64_tr_b16 %3, %7\n\ts_waitcnt lgkmcnt(0)"
                 : "=&v"(r0), "=&v"(r1), "=&v"(r2), "=&v"(r3) : "v"(a0), "v"(a1), "v"(a2), "v"(a3) : "memory");
}
#define SHX(x, o) __builtin_bit_cast(float, __builtin_amdgcn_ds_bpermute(((lane) ^ (o)) << 2, __builtin_bit_cast(int, (float)(x))))
#define SHXU(x, o) ((unsigned)__builtin_amdgcn_ds_bpermute(((lane) ^ (o)) << 2, (int)(x)))
__device__ __forceinline__ float wave_sum(float v, int lane) {
#pragma unroll
    for (int o = 1; o < 64; o <<= 1) v += SHX(v, o);
    return v;
}
__device__ __forceinline__ void conv_item(const GAS float* W, int ldw, int k0, int c0, int nvalid, GAS bf16* dst, int dld, int drow0, int dk0, float scale, const GAS float* gain, LAS float* scr, int lane) {
    const int c = lane & 31;
#pragma unroll 8
    for (int i = 0; i < 32; ++i) { const int kk = 2 * i + (lane >> 5); float v = 0.f;
        if (c < nvalid) v = W[(size_t)(k0 + kk) * ldw + c0 + c] * scale;
        scr[kk * 33 + c] = v; }
    LDS_WAIT(); asm volatile("" ::: "memory");
    const int c8 = lane & 7;
    f32x4 ga = {1.f, 1.f, 1.f, 1.f}, gb = {1.f, 1.f, 1.f, 1.f};
    if (gain) { ga = *(const GAS f32x4*)(gain + k0 + 8 * c8); gb = *(const GAS f32x4*)(gain + k0 + 8 * c8 + 4); }
#pragma unroll
    for (int j = 0; j < 4; ++j) { const int n = (lane >> 3) + 8 * j; const LAS float* s = scr + (8 * c8) * 33 + n;
        v4u o; o.x = pk2(s[0 * 33] * ga.x, s[1 * 33] * ga.y); o.y = pk2(s[2 * 33] * ga.z, s[3 * 33] * ga.w); o.z = pk2(s[4 * 33] * gb.x, s[5 * 33] * gb.y); o.w = pk2(s[6 * 33] * gb.z, s[7 * 33] * gb.w);
        *(GAS v4u*)(dst + (size_t)(drow0 + n) * dld + dk0 + k0 + 8 * c8) = o; }
    LDS_WAIT(); asm volatile("" ::: "memory");
}
__device__ __forceinline__ void rmsnorm_rows_bf16(const GAS float* X, const GAS float* g, GAS bf16* O, int gw, int NGW, int lane) {
    f32x4 gv[8];
#pragma unroll
    for (int j = 0; j < 8; ++j) gv[j] = ((const GAS f32x4*)g)[lane + 64 * j];
    for (int m = gw; m < M; m += NGW) {
        const GAS f32x4* xr = (const GAS f32x4*)(X + (size_t)m * D) + lane;
        f32x4 v[8]; float s = 0.f;
#pragma unroll
        for (int j = 0; j < 8; ++j) { v[j] = xr[64 * j]; s += (v[j].x * v[j].x + v[j].y * v[j].y) + (v[j].z * v[j].z + v[j].w * v[j].w); }
        const float r = 1.0f / sqrtf(wave_sum(s, lane) * (1.0f / D) + EPS);
        GAS unsigned long long* o8 = (GAS unsigned long long*)(O + (size_t)m * D) + lane;
#pragma unroll
        for (int j = 0; j < 8; ++j) { const f32x4 y = v[j] * r * gv[j]; o8[64 * j] = (unsigned long long)pk2(y.x, y.y) | ((unsigned long long)pk2(y.z, y.w) << 32); }
    }
}
__device__ __forceinline__ void rows_bf16_ss(const GAS float* X, GAS bf16* O, GAS float* ss, int gw, int NGW, int lane) {
    for (int m = gw; m < M; m += NGW) {
        const GAS f32x4* xr = (const GAS f32x4*)(X + (size_t)m * D) + lane;
        f32x4 v[8]; float s = 0.f;
#pragma unroll
        for (int j = 0; j < 8; ++j) { v[j] = xr[64 * j]; s += (v[j].x * v[j].x + v[j].y * v[j].y) + (v[j].z * v[j].z + v[j].w * v[j].w); }
        s = wave_sum(s, lane);
        GAS unsigned long long* o8 = (GAS unsigned long long*)(O + (size_t)m * D) + lane;
#pragma unroll
        for (int j = 0; j < 8; ++j) o8[64 * j] = (unsigned long long)pk2(v[j].x, v[j].y) | ((unsigned long long)pk2(v[j].z, v[j].w) << 32);
        if (lane < 32) ss[(size_t)m * 32 + lane] = lane == 0 ? s : 0.f;
    }
}
__device__ __forceinline__ void final_rows(const GAS bf16* HB, GAS float* OUT, const GAS float* g, const GAS float* ss, int gw, int NGW, int lane) {
    f32x4 gv[8];
#pragma unroll
    for (int j = 0; j < 8; ++j) gv[j] = ((const GAS f32x4*)g)[lane + 64 * j];
    for (int m = gw; m < M; m += NGW) {
        const GAS unsigned long long* hr = (const GAS unsigned long long*)(HB + (size_t)m * D) + lane; GAS f32x4* orow = (GAS f32x4*)(OUT + (size_t)m * D) + lane;
        unsigned long long raw[8];
#pragma unroll
        for (int j = 0; j < 8; ++j) raw[j] = hr[64 * j];
        const float r = 1.0f / sqrtf(wave_sum(lane < 32 ? ss[(size_t)m * 32 + lane] : 0.f, lane) * (1.0f / D) + EPS);
#pragma unroll
        for (int j = 0; j < 8; ++j) { const unsigned lo = (unsigned)raw[j], hi = (unsigned)(raw[j] >> 32);
            f32x4 v = {__builtin_bit_cast(float, lo << 16), __builtin_bit_cast(float, lo & 0xffff0000u), __builtin_bit_cast(float, hi << 16), __builtin_bit_cast(float, hi & 0xffff0000u)};
            orow[64 * j] = v * r * gv[j]; }
    }
}
__device__ __forceinline__ void rmsnorm_rows_f32_inplace(GAS float* X, const GAS float* g, int gw, int NGW, int lane) {
    f32x4 gv[8];
#pragma unroll
    for (int j = 0; j < 8; ++j) gv[j] = ((const GAS f32x4*)g)[lane + 64 * j];
    for (int m = gw; m < M; m += NGW) {
        GAS f32x4* xr = (GAS f32x4*)(X + (size_t)m * D) + lane;
        f32x4 v[8]; float s = 0.f;
#pragma unroll
        for (int j = 0; j < 8; ++j) { v[j] = xr[64 * j]; s += (v[j].x * v[j].x + v[j].y * v[j].y) + (v[j].z * v[j].z + v[j].w * v[j].w); }
        const float r = 1.0f / sqrtf(wave_sum(s, lane) * (1.0f / D) + EPS);
#pragma unroll
        for (int j = 0; j < 8; ++j) xr[64 * j] = v[j] * r * gv[j];
    }
}

template <bool P_IFAST>
__device__ __forceinline__ void absorb_unit(const GAS float* Psrc, size_t p_ri, size_t p_rd, const GAS float* Qsrc, size_t q_rj, GAS bf16* out, size_t out_ld, float scale, const GAS float* qgain, LAS float* Ps, LAS float* Qs, int tid) {
#pragma unroll 4
    for (int j = 0; j < 16; ++j) { const int e = tid + 512 * j; const int i = P_IFAST ? (e & 63) : (e >> 7), d = P_IFAST ? (e >> 6) : (e & 127);
        Ps[i * 129 + d] = Psrc[(size_t)i * p_ri + (size_t)d * p_rd];
        const int jj = e >> 7, dd = e & 127; Qs[jj * 129 + dd] = Qsrc[(size_t)jj * q_rj + dd] * (qgain ? qgain[jj] : 1.0f); }
    __syncthreads();
    const int ty = tid >> 6, tx = tid & 63; float acc[8];
#pragma unroll
    for (int i = 0; i < 8; ++i) acc[i] = 0.f;
#pragma unroll 4
    for (int d = 0; d < 128; ++d) { const float q = Qs[tx * 129 + d];
#pragma unroll
        for (int i = 0; i < 8; ++i) acc[i] = fmaf(Ps[(ty * 8 + i) * 129 + d], q, acc[i]); }
#pragma unroll
    for (int i = 0; i < 8; ++i) out[(size_t)(ty * 8 + i) * out_ld + tx] = (bf16)f2bf(acc[i] * scale);
    __syncthreads();
}
__device__ __forceinline__ void post_rows(const GAS bf16* Z, const GAS float* gkv, const GAS float* gki, const GAS float* bki, GAS bf16* CKVN, GAS bf16* KIN, GAS float* WIF, int gw, int NGW, int lane) {
    const f32x4 g4 = ((const GAS f32x4*)gkv)[lane]; const float gk = gki[lane], bk = bki[lane];
    for (int m = gw; m < M; m += NGW) {
        const GAS bf16* zr = Z + (size_t)m * ZLD;
        const unsigned long long raw = *(const GAS unsigned long long*)(zr + ZC_CKV + 4 * lane);
        const float kraw = bf2f(zr[ZC_KI + lane]);
        const float wraw = bf2f(zr[ZC_WI + (lane & 7)]);
        const float c0 = bf2f((unsigned short)raw), c1 = bf2f((unsigned short)(raw >> 16)), c2 = bf2f((unsigned short)(raw >> 32)), c3 = bf2f((unsigned short)(raw >> 48));
        const float r = 1.0f / sqrtf(wave_sum((c0 * c0 + c1 * c1) + (c2 * c2 + c3 * c3), lane) * (1.0f / RANK) + EPS);
        *(GAS unsigned long long*)(CKVN + (size_t)m * RANK + 4 * lane) = (unsigned long long)pk2(c0 * r * g4.x, c1 * r * g4.y) | ((unsigned long long)pk2(c2 * r * g4.z, c3 * r * g4.w) << 32);
        const float mu = wave_sum(kraw, lane) * (1.0f / IDIM); const float dv = kraw - mu;
        const float var = wave_sum(dv * dv, lane) * (1.0f / IDIM);
        KIN[(size_t)m * IDIM + lane] = (bf16)f2bf(dv * (1.0f / sqrtf(var + EPS)) * gk + bk);
        if (lane < 8) WIF[(size_t)m * IH + lane] = wraw;
    }
}
constexpr int SWA_KP = 144, SWA_VP = 192;
constexpr int SWA_K_OFF = 0, SWA_V_OFF = 160 * SWA_KP, SWA_TAB_OFF = SWA_V_OFF + 160 * SWA_VP;
static_assert(SWA_TAB_OFF + 16 * 128 * 4 <= RING_BYTES, "SWA LDS map");
__device__ __forceinline__ void swa_phase(LAS unsigned char* lds, const GAS bf16* Z, GAS bf16* O, const GAS float* rel_bias, const GAS float* sinks, int vcu, int G, int tid, int lane, int wave) {
    LAS float* tab = (LAS float*)(lds + SWA_TAB_OFF);
    for (int e = tid; e < 16 * 128; e += NWAVES * 64) { const int h = e >> 7, dist = e & 127; tab[e] = rel_bias[(int)T5_BUCKET[dist] * 24 + H_A + h]; }
    __syncthreads();
    const int q = lane & 31, hh = lane >> 5;
    const unsigned ldsb = (unsigned)(size_t)lds;
    for (int item = vcu; item < BATCH * 128 * KVH; item += G) {
        const int kvh = item & 1, qt = (item >> 1) & 127, b = item >> 8;
        const int t0 = 32 * qt, s0 = t0 - 128;
        const size_t rowbase = (size_t)b * SEQ;
        for (int c = tid; c < 1280; c += NWAVES * 64) { const int row = c >> 3, ch = c & 7; const int s = s0 + row;
            if (s >= 0) { const GAS bf16* zr = Z + (rowbase + s) * ZLD + kvh * 64 + ch * 8;
                const v4u kv = *(const GAS v4u*)(zr + ZC_KB); const v4u vv = *(const GAS v4u*)(zr + ZC_VB);
                *(LAS v4u*)(lds + SWA_K_OFF + row * SWA_KP + ch * 16) = kv; *(LAS v4u*)(lds + SWA_V_OFF + row * SWA_VP + ch * 16) = vv; } }
        const int hq = kvh * 8 + wave; const int t = t0 + q;
        bf16x8 qf[4];
#pragma unroll
        for (int st = 0; st < 4; ++st) qf[st] = *(const GAS bf16x8*)(Z + (rowbase + t) * ZLD + ZC_QB + hq * 64 + 16 * st + 8 * hh);
        __syncthreads();
        const int kt0 = qt >= 4 ? 0 : 4 - qt;
        f32x16 sacc[5];
#pragma unroll
        for (int kt = 0; kt < 5; ++kt) {
#pragma unroll
            for (int r = 0; r < 16; ++r) sacc[kt][r] = 0.f;
            if (kt >= kt0) {
#pragma unroll
                for (int st = 0; st < 4; ++st) { const bf16x8 kf = *(const LAS bf16x8*)(lds + SWA_K_OFF + (kt * 32 + q) * SWA_KP + (2 * st + hh) * 16);
                    sacc[kt] = __builtin_amdgcn_mfma_f32_32x32x16_bf16(kf, qf[st], sacc[kt], 0, 0, 0); } } }
        const float sink = sinks[hq]; float mx = sink;
        const LAS float* tabh = tab + hq * 128;
#pragma unroll
        for (int kt = 0; kt < 5; ++kt) if (kt >= kt0) {
#pragma unroll
            for (int r = 0; r < 16; ++r) { const int ko = (r & 3) + 8 * (r >> 2) + 4 * hh; const int dist = q + 128 - 32 * kt - ko;
                const float lg = (dist >= 0 && dist < WINDOW) ? sacc[kt][r] + tabh[dist & 127] : -1e30f; sacc[kt][r] = lg; mx = fmaxf(mx, lg); } }
        mx = fmaxf(mx, SHX(mx, 32));
        float l = 0.f;
#pragma unroll
        for (int kt = 0; kt < 5; ++kt) if (kt >= kt0) {
#pragma unroll
            for (int r = 0; r < 16; ++r) { const float p = __expf(sacc[kt][r] - mx); sacc[kt][r] = p; l += p; } }
        l += SHX(l, 32); l += __expf(sink - mx);
        f32x16 oacc[2];
#pragma unroll
        for (int dt = 0; dt < 2; ++dt)
#pragma unroll
            for (int r = 0; r < 16; ++r) oacc[dt][r] = 0.f;
        const unsigned vlane = ldsb + SWA_V_OFF + (unsigned)((4 * hh + ((lane & 15) >> 2)) * SWA_VP + (16 * ((lane >> 4) & 1) + 4 * (lane & 3)) * 2);
#pragma unroll
        for (int kt = 0; kt < 5; ++kt) if (kt >= kt0) {
#pragma unroll
            for (int s2 = 0; s2 < 2; ++s2) {
                bf16x8 pf; { const unsigned w0 = pg8::cvt_pk_bf16(sacc[kt][8 * s2 + 0], sacc[kt][8 * s2 + 1]), w1 = pg8::cvt_pk_bf16(sacc[kt][8 * s2 + 2], sacc[kt][8 * s2 + 3]),
                                     w2 = pg8::cvt_pk_bf16(sacc[kt][8 * s2 + 4], sacc[kt][8 * s2 + 5]), w3 = pg8::cvt_pk_bf16(sacc[kt][8 * s2 + 6], sacc[kt][8 * s2 + 7]);
                    const v4u w = {w0, w1, w2, w3}; pf = __builtin_bit_cast(bf16x8, w); }
                const unsigned a = vlane + (unsigned)((kt * 32 + 16 * s2) * SWA_VP);
                s16x4 r0, r1, r2, r3; tr_read4(a, a + 8 * SWA_VP, a + 64, a + 8 * SWA_VP + 64, r0, r1, r2, r3);
                oacc[0] = __builtin_amdgcn_mfma_f32_32x32x16_bf16(cat4(r0, r1), pf, oacc[0], 0, 0, 0);
                oacc[1] = __builtin_amdgcn_mfma_f32_32x32x16_bf16(cat4(r2, r3), pf, oacc[1], 0, 0, 0); } }
        const float inv = 1.0f / l;
        GAS bf16* orow = O + (rowbase + t) * OLD + 2048 + hq * 64 + 4 * hh;
#pragma unroll
        for (int dt = 0; dt < 2; ++dt)
#pragma unroll
            for (int g4 = 0; g4 < 4; ++g4) { const unsigned long long w = (unsigned long long)pk2(oacc[dt][4 * g4] * inv, oacc[dt][4 * g4 + 1] * inv) | ((unsigned long long)pk2(oacc[dt][4 * g4 + 2] * inv, oacc[dt][4 * g4 + 3] * inv) << 32);
                *(GAS unsigned long long*)(orow + 32 * dt + 8 * g4) = w; }
        __syncthreads();
    }
}
constexpr int TK_BINS = 512, TK_CAP = 128;
#define LDS_ADD(p) __hip_atomic_fetch_add((p), 1u, __ATOMIC_RELAXED, __HIP_MEMORY_SCOPE_WORKGROUP)
constexpr int TK_HIST_OFF = 0, TK_CSC_OFF = 65536, TK_CIX_OFF = TK_CSC_OFF + 32 * TK_CAP * 4, TK_SEL_OFF = TK_CIX_OFF + 32 * TK_CAP * 2, TK_CNT_OFF = TK_SEL_OFF + 32 * 256 * 2;
static_assert(TK_CNT_OFF + 32 * 2 * 4 <= RING_BYTES, "top-k LDS map");
__device__ __forceinline__ float tk_score(const f32x16& acc, int a, const float (&w)[8]) {
    float s = w[0] * fmaxf(acc[8 * a + 0], 0.f);
#pragma unroll
    for (int h = 1; h < 8; ++h) s = fmaf(w[h], fmaxf(acc[8 * a + h], 0.f), s);
    return s;
}
__device__ __forceinline__ int tk_key(float s) {
    const float x = (s + 8.0f) * 32.0f; int b0 = (int)x; b0 = b0 < 0 ? 0 : (b0 > TK_BINS - 1 ? TK_BINS - 1 : b0);
    int sub = (int)((x - (float)b0) * 512.0f); sub = sub < 0 ? 0 : (sub > 511 ? 511 : sub);
    return b0 * 512 + sub;
}
__device__ __forceinline__ void tk_find(const LAS unsigned* h, unsigned need, int lane, int& bin_out, unsigned& above_out) {
    unsigned v[8]; unsigned s = 0;
#pragma unroll
    for (int i = 0; i < 8; ++i) { v[i] = h[8 * lane + i]; s += v[i]; }
    unsigned S = s;
#pragma unroll
    for (int o = 1; o < 64; o <<= 1) { const unsigned t = (unsigned)__builtin_amdgcn_ds_bpermute((lane + o) << 2, (int)S); if (lane + o < 64) S += t; }
    const unsigned long long mask = __ballot(S >= need);
    const int Lm = mask ? 63 - __builtin_clzll(mask) : 0;
    unsigned cum = S - s; int bsel = 8 * lane; unsigned ab = cum; bool found = false;
#pragma unroll
    for (int i = 7; i >= 0; --i) { if (!found) { if (cum + v[i] >= need) { bsel = 8 * lane + i; ab = cum; found = true; } else cum += v[i]; } }
    bin_out = __builtin_amdgcn_readlane(bsel, Lm); above_out = (unsigned)__builtin_amdgcn_readlane((int)ab, Lm);
}
__device__ __forceinline__ void topk_phase(LAS unsigned char* lds, const GAS bf16* Z, const GAS bf16* KIN, const GAS float* WIF, GAS unsigned short* IDX, int vcu, int G, int lane, int wave) {
    LAS unsigned* hist = (LAS unsigned*)(lds + TK_HIST_OFF) + wave * 4 * TK_BINS;
    LAS float* csc = (LAS float*)(lds + TK_CSC_OFF) + wave * 4 * TK_CAP;
    LAS unsigned short* cix = (LAS unsigned short*)(lds + TK_CIX_OFF) + wave * 4 * TK_CAP;
    LAS unsigned short* sel = (LAS unsigned short*)(lds + TK_SEL_OFF) + wave * 4 * 256;
    LAS unsigned* cnt = (LAS unsigned*)(lds + TK_CNT_OFF) + wave * 8;
    const int n = lane & 31, c = lane >> 5;
    const int am = (lane >> 4) & 1, bbm = (lane >> 3) & 1, ccm = (lane >> 2) & 1, dm = lane & 3;
    for (int p2 = vcu; p2 < BATCH * 64; p2 += G) {
#pragma unroll 1
        for (int half = 0; half < 2; ++half) {
            const int b = p2 >> 6, jj = p2 & 63, j = half ? 127 - jj : jj;
            const int t0 = 32 * j + 4 * wave; const size_t rb = (size_t)b * SEQ;
            bf16x8 qa[4];
#pragma unroll
            for (int st = 0; st < 4; ++st) qa[st] = *(const GAS bf16x8*)(Z + (rb + t0 + 2 * ccm + am) * ZLD + ZC_QI + (4 * bbm + dm) * 64 + 16 * st + 8 * c);
            float w0[8], w1[8];
            { const GAS f32x4* wp = (const GAS f32x4*)(WIF + (rb + t0 + 2 * c) * IH); const f32x4 x0 = wp[0], x1 = wp[1], x2 = wp[2], x3 = wp[3];
              w0[0] = x0.x; w0[1] = x0.y; w0[2] = x0.z; w0[3] = x0.w; w0[4] = x1.x; w0[5] = x1.y; w0[6] = x1.z; w0[7] = x1.w;
              w1[0] = x2.x; w1[1] = x2.y; w1[2] = x2.z; w1[3] = x2.w; w1[4] = x3.x; w1[5] = x3.y; w1[6] = x3.z; w1[7] = x3.w; }
            const int tA = t0 + 2 * c, tB = tA + 1;
            for (int i = lane; i < 4 * TK_BINS; i += 64) hist[i] = 0u;
            for (int i = lane; i < 4 * 128; i += 64) ((LAS unsigned*)sel)[i] = 0u;
            if (lane < 8) cnt[lane] = 0u;
            asm volatile("s_waitcnt lgkmcnt(0)" ::: "memory");
            int lo[4], hi[4]; unsigned ab0[4]; bool ov[4];
#pragma unroll
            for (int tk = 0; tk < 4; ++tk) { lo[tk] = 0x7fffffff; hi[tk] = -1; ab0[tk] = 0u; ov[tk] = false; }
            const bool need_sel = (t0 + 3) >= TOPK;
            const GAS bf16* kbase = KIN + (rb + n) * IDIM + 8 * c;
            int mode = need_sel ? 0 : 2;
#pragma unroll 1
            for (;;) {
                const int klo0 = c ? lo[2] : lo[0], khi0 = c ? hi[2] : hi[0], klo1 = c ? lo[3] : lo[1], khi1 = c ? hi[3] : hi[1];
                const bool ov0 = c ? ov[2] : ov[0], ov1 = c ? ov[3] : ov[1];
                bf16x8 kb[4];
#pragma unroll
                for (int st = 0; st < 4; ++st) kb[st] = *(const GAS bf16x8*)(kbase + 16 * st);
#pragma unroll 1
                for (int kt = 0; kt <= j; ++kt) {
                    bf16x8 kn[4];
                    const int ktn = kt < j ? kt + 1 : kt;
#pragma unroll
                    for (int st = 0; st < 4; ++st) kn[st] = *(const GAS bf16x8*)(kbase + (size_t)ktn * 32 * IDIM + 16 * st);
                    f32x16 acc;
#pragma unroll
                    for (int r = 0; r < 16; ++r) acc[r] = 0.f;
#pragma unroll
                    for (int st = 0; st < 4; ++st) acc = __builtin_amdgcn_mfma_f32_32x32x16_bf16(qa[st], kb[st], acc, 0, 0, 0);
                    const float s0 = tk_score(acc, 0, w0), s1 = tk_score(acc, 1, w1);
                    const int s = 32 * kt + n; const int k0 = tk_key(s0), k1 = tk_key(s1);
                    const bool v0 = s <= tA, v1 = s <= tB;
                    if (mode == 0) {
                        if (v0 && tA >= TOPK) LDS_ADD(&hist[(2 * c) * TK_BINS + (k0 >> 9)]);
                        if (v1 && tB >= TOPK) LDS_ADD(&hist[(2 * c + 1) * TK_BINS + (k1 >> 9)]);
                    } else if (mode == 1) {
                        if (v0 && ov0 && k0 >= klo0 && k0 <= khi0) LDS_ADD(&hist[(2 * c) * TK_BINS + (k0 & 511)]);
                        if (v1 && ov1 && k1 >= klo1 && k1 <= khi1) LDS_ADD(&hist[(2 * c + 1) * TK_BINS + (k1 & 511)]);
                    } else {
                        if (v0) { if (k0 > khi0) { const unsigned pos = LDS_ADD(&cnt[(2 * c) * 2]); if (pos < 256u) sel[(2 * c) * 256 + pos] = (unsigned short)s; }
                                  else if (k0 >= klo0) { const unsigned pos = LDS_ADD(&cnt[(2 * c) * 2 + 1]); if (pos < (unsigned)TK_CAP) { csc[(2 * c) * TK_CAP + pos] = s0; cix[(2 * c) * TK_CAP + pos] = (unsigned short)s; } } }
                        if (v1) { if (k1 > khi1) { const unsigned pos = LDS_ADD(&cnt[(2 * c + 1) * 2]); if (pos < 256u) sel[(2 * c + 1) * 256 + pos] = (unsigned short)s; }
                                  else if (k1 >= klo1) { const unsigned pos = LDS_ADD(&cnt[(2 * c + 1) * 2 + 1]); if (pos < (unsigned)TK_CAP) { csc[(2 * c + 1) * TK_CAP + pos] = s1; cix[(2 * c + 1) * TK_CAP + pos] = (unsigned short)s; } } }
                    }
#pragma unroll
                    for (int st = 0; st < 4; ++st) kb[st] = kn[st];
                }
                asm volatile("s_waitcnt lgkmcnt(0)" ::: "memory");
                if (mode == 2) break;
                if (mode == 0) {
                    bool any_over = false;
#pragma unroll
                    for (int tk = 0; tk < 4; ++tk) if (t0 + tk >= TOPK) { int bin; unsigned above; tk_find(hist + tk * TK_BINS, (unsigned)TOPK, lane, bin, above);
                        const unsigned ceq = hist[tk * TK_BINS + bin]; ov[tk] = ceq > (unsigned)TK_CAP; any_over |= ov[tk]; ab0[tk] = above; lo[tk] = bin * 512; hi[tk] = bin * 512 + 511; }
                    mode = any_over ? 1 : 2;
                    if (any_over) { asm volatile("s_waitcnt lgkmcnt(0)" ::: "memory"); for (int i = lane; i < 4 * TK_BINS; i += 64) hist[i] = 0u; asm volatile("s_waitcnt lgkmcnt(0)" ::: "memory"); }
                } else {
#pragma unroll
                    for (int tk = 0; tk < 4; ++tk) if (ov[tk]) { int sub; unsigned above; tk_find(hist + tk * TK_BINS, (unsigned)TOPK - ab0[tk], lane, sub, above); lo[tk] += sub; hi[tk] = lo[tk]; }
                    mode = 2;
                }
            }
#pragma unroll 1
            for (int tk = 0; tk < 4; ++tk) { const int t = t0 + tk;
                if (t >= TOPK) { const unsigned nsel = cnt[tk * 2]; unsigned nc = cnt[tk * 2 + 1]; nc = nc > (unsigned)TK_CAP ? (unsigned)TK_CAP : nc; const unsigned need = nsel < 256u ? 256u - nsel : 0u;
                    for (unsigned q = 0; q < 2; ++q) { const unsigned i = lane + 64 * q;
                        const float si = i < nc ? csc[tk * TK_CAP + i] : 0.f; const unsigned xi = i < nc ? cix[tk * TK_CAP + i] : 0u; unsigned rank = 0;
                        for (unsigned jx = 0; jx < nc; ++jx) { const float sj = csc[tk * TK_CAP + jx]; const unsigned xj = cix[tk * TK_CAP + jx]; rank += (sj > si || (sj == si && xj < xi)) ? 1u : 0u; }
                        if (i < nc && rank < need) sel[tk * 256 + nsel + rank] = (unsigned short)xi; } } }
            asm volatile("s_waitcnt lgkmcnt(0)" ::: "memory");
            { const LAS v4u* sv = (const LAS v4u*)sel; GAS v4u* ov = (GAS v4u*)(IDX + (rb + t0) * TOPK);
              ov[lane] = sv[lane]; ov[lane + 64] = sv[lane + 64]; }
            asm volatile("s_waitcnt vmcnt(0) lgkmcnt(0)" ::: "memory");
        }
    }
}
constexpr int DSA_TAB_OFF = RING_BYTES + 1024;
static_assert(DSA_TAB_OFF + 8 * 129 * 4 <= LDS_BYTES, "DSA LDS map");
__device__ __forceinline__ void dsa_phase(LAS unsigned char* lds_all, const GAS bf16* Z, const GAS bf16* CKVN, const GAS unsigned short* IDX, GAS bf16* O, const GAS float* rel_bias, int gw, int NGW, int tid, int lane, int wave) {
    LAS float* tab = (LAS float*)(lds_all + DSA_TAB_OFF);
    for (int e = tid; e < 8 * 129; e += NWAVES * 64) { const int hh = e / 129, dist = e - hh * 129; tab[e] = rel_bias[(dist < 128 ? (int)T5_BUCKET[dist] : 31) * 24 + hh]; }
    __syncthreads();
    LAS unsigned char* img = lds_all + RING_OFF + wave * 16384;
    const unsigned imgb = (unsigned)(size_t)img;
    const int h = lane & 15, g = lane >> 4;
    const LAS float* tabh = tab + (h & 7) * 129;
    const int TPW = (M + NGW - 1) / NGW;
    const int tok_end = (gw + 1) * TPW < M ? (gw + 1) * TPW : M;
    const int xq = 2 * (lane & 7);
    const int qk_off = (lane & 15) * 512;
    const int q4 = (lane & 15) >> 2, p4 = lane & 3; const int xr = 2 * (4 * (g & 1) + q4);
    const unsigned pv_base = imgb + (unsigned)((4 * g + q4) * 512 + 8 * (p4 & 1));
#pragma unroll 1
    for (int tok = gw * TPW; tok < tok_end; ++tok) {
        const int t = tok & (SEQ - 1); const size_t rb = (size_t)(tok - t);
        const int nsel = t + 1 < TOPK ? t + 1 : TOPK;
        bf16x8 qf[8];
#pragma unroll
        for (int st = 0; st < 8; ++st) { qf[st] = *(const GAS bf16x8*)(Z + (size_t)tok * ZLD + ZC_QLAT + (h & 7) * 256 + 32 * st + 8 * g); if (h >= 8) qf[st] = (bf16x8){0, 0, 0, 0, 0, 0, 0, 0}; }
        f32x4 oacc[16];
#pragma unroll
        for (int rt = 0; rt < 16; ++rt) oacc[rt] = (f32x4){0.f, 0.f, 0.f, 0.f};
        float mrun = -1e30f, lsum = 0.f;
        const GAS unsigned short* ip = IDX + (size_t)tok * TOPK;
#pragma unroll 1
        for (int ch = 0; ch < 8; ++ch) {
            if (32 * ch >= nsel) break;
            const int ixv = (int)ip[32 * ch + (lane & 31)];
            const unsigned long long i0 = *(const GAS unsigned long long*)(ip + 32 * ch + 4 * g), i1 = *(const GAS unsigned long long*)(ip + 32 * ch + 16 + 4 * g);
            asm volatile("s_waitcnt lgkmcnt(0)" ::: "memory");
#pragma unroll
            for (int i = 0; i < 16; ++i) { const int r0 = __builtin_amdgcn_readlane(ixv, 2 * i), r1 = __builtin_amdgcn_readlane(ixv, 2 * i + 1);
                const int row = 2 * i + (lane >> 5); const int ridx = lane < 32 ? r0 : r1; const int chunk = (lane & 31) ^ (2 * (row & 7));
                const GAS unsigned char* src = (const GAS unsigned char*)(CKVN + (rb + ridx) * RANK) + chunk * 16;
                __builtin_amdgcn_global_load_lds((const GAS unsigned*)src, (LAS unsigned*)(img + i * 1024), 16, 0, 0); }
            asm volatile("s_waitcnt vmcnt(0)" ::: "memory");
            f32x4 sa[2];
#pragma unroll
            for (int tl = 0; tl < 2; ++tl) { sa[tl] = (f32x4){0.f, 0.f, 0.f, 0.f};
#pragma unroll
                for (int st = 0; st < 8; ++st) { const bf16x8 a = *(const LAS bf16x8*)(img + qk_off + tl * 16 * 512 + (((4 * st + g) ^ xq) * 16));
                    sa[tl] = __builtin_amdgcn_mfma_f32_16x16x32_bf16(a, qf[st], sa[tl], 0, 0, 0); } }
            float lg[8]; float cmax = -1e30f;
#pragma unroll
            for (int e = 0; e < 8; ++e) { const int tl = e >> 2, jx = e & 3; const int kk = 32 * ch + 16 * tl + 4 * g + jx;
                const int sidx = (int)(((tl ? i1 : i0) >> (16 * jx)) & 0xffffull); int dd = t - sidx; dd = dd < 0 ? 0 : (dd > 128 ? 128 : dd);
                const float v = kk < nsel ? sa[tl][jx] + tabh[dd] : -1e30f; lg[e] = v; cmax = fmaxf(cmax, v); }
            cmax = fmaxf(cmax, SHX(cmax, 16)); cmax = fmaxf(cmax, SHX(cmax, 32));
            const float mnew = fmaxf(mrun, cmax);
            if (__any(mnew > mrun)) { const float alpha = __expf(mrun - mnew); lsum *= alpha;
#pragma unroll
                for (int rt = 0; rt < 16; ++rt) oacc[rt] = oacc[rt] * alpha; }
            mrun = mnew;
            float pe[8];
#pragma unroll
            for (int e = 0; e < 8; ++e) { pe[e] = __expf(lg[e] - mnew); lsum += pe[e]; }
            bf16x8 pf; { const v4u wv = {pg8::cvt_pk_bf16(pe[0], pe[1]), pg8::cvt_pk_bf16(pe[2], pe[3]), pg8::cvt_pk_bf16(pe[4], pe[5]), pg8::cvt_pk_bf16(pe[6], pe[7])}; pf = __builtin_bit_cast(bf16x8, wv); }
#pragma unroll
            for (int rt = 0; rt < 16; rt += 2) {
                const unsigned a0 = pv_base + (unsigned)((((2 * rt) ^ xr) | (p4 >> 1)) * 16), a1 = pv_base + (unsigned)((((2 * rt + 2) ^ xr) | (p4 >> 1)) * 16);
                s16x4 r0, r1, r2, r3; tr_read4(a0, a0 + 16 * 512, a1, a1 + 16 * 512, r0, r1, r2, r3);
                oacc[rt] = __builtin_amdgcn_mfma_f32_16x16x32_bf16(cat4(r0, r1), pf, oacc[rt], 0, 0, 0);
                oacc[rt + 1] = __builtin_amdgcn_mfma_f32_16x16x32_bf16(cat4(r2, r3), pf, oacc[rt + 1], 0, 0, 0); }
        }
        lsum += SHX(lsum, 16); lsum += SHX(lsum, 32);
        const float inv = 1.0f / lsum;
        if (h < 8) { GAS bf16* orow = O + (size_t)tok * OLD + h * 256 + 4 * g;
#pragma unroll
            for (int rt = 0; rt < 16; ++rt) *(GAS unsigned long long*)(orow + 16 * rt) = (unsigned long long)pk2(oacc[rt][0] * inv, oacc[rt][1] * inv) | ((unsigned long long)pk2(oacc[rt][2] * inv, oacc[rt][3] * inv) << 32); }
    }
}
struct Args { const float* in[20]; float* out; unsigned char* ws; };
__device__ __forceinline__ unsigned long long karg_u64(int idx) { unsigned long long r; const unsigned off = (unsigned)idx * 8u;
    asm volatile("s_load_dwordx2 %0, %1, %2\n\ts_waitcnt lgkmcnt(0)" : "=s"(r) : "s"(__builtin_amdgcn_kernarg_segment_ptr()), "s"(off) : "memory"); return r; }
__device__ __forceinline__ const GAS float* karg_in(int i) { return (const GAS float*)karg_u64(i); }
__device__ __forceinline__ GAS float* karg_out() { return (GAS float*)karg_u64(20); }
__device__ __forceinline__ GAS unsigned char* karg_ws() { return (GAS unsigned char*)karg_u64(21); }
#ifndef REP_P0
#define REP_P0 1
#endif
#ifndef REP_NORM
#define REP_NORM 1
#endif
#ifndef REP_GU
#define REP_GU 1
#endif
#ifndef REP_IN
#define REP_IN 1
#endif
#ifndef REP_POST
#define REP_POST 1
#endif
#ifndef REP_TOPK
#define REP_TOPK 1
#endif
#ifndef REP_DSA
#define REP_DSA 1
#endif
#define REPEAT(n) _Pragma("unroll 1") for (int rep_ = 0; rep_ < (n); ++rep_)
#define PHASE_IDS() int tid = threadIdx.x; asm volatile("" : "+v"(tid)); int bx = blockIdx.x; asm volatile("" : "+s"(bx)); int G = gridDim.x; asm volatile("" : "+s"(G)); \
    const int lane = tid & 63, wave = __builtin_amdgcn_readfirstlane(tid >> 6); const int vcu = (G % 8 == 0) ? (bx % 8) * (G / 8) + bx / 8 : bx; const int gw = vcu * NWAVES + wave, NGW = G * NWAVES; \
    GAS unsigned char* ws = karg_ws(); (void)lane; (void)gw; (void)NGW; (void)vcu; (void)ws
__global__ void __launch_bounds__(NWAVES * 64, 2) mk_fwd(Args args) {
    extern __shared__ __attribute__((aligned(16))) unsigned char lds_raw[];
    LAS unsigned char* lds = (LAS unsigned char*)lds_raw;
    volatile LAS unsigned* MISC = (volatile LAS unsigned*)(lds + MISC_OFF);
    for (int u = threadIdx.x; u < (LDS_BYTES - LDSCTL_OFF) / 4; u += NWAVES * 64) ((LAS unsigned*)(lds + LDSCTL_OFF))[u] = 0u;
    __syncthreads();
    (void)xcd_barrier_post((unsigned*)((gu32*)(karg_ws() + WS_CTL) + CW_BAR), MISC + 8);
#define GRID_BAR() do { XcdBarrier b_; b_.bar = (unsigned*)((gu32*)(karg_ws() + WS_CTL) + CW_BAR); b_.x = xb_xcc_id(); b_.st = MISC + 8; xcd_barrier(b_); } while (0)

    REPEAT(REP_P0) {   PHASE_IDS();
        LAS float* scr = (LAS float*)(lds + RING_OFF + wave * 16384);
        rows_bf16_ss(karg_in(0), (GAS bf16*)(ws + WS_XN), (GAS float*)(ws + WS_SS), gw, NGW, lane);
        constexpr int I_GU = (D / 64) * (FF / 32), I_DN = (FF / 64) * (D / 32);
        constexpr int I_FFN = 2 * I_GU + I_DN, I_IN = 72 * (D / 64), I_OB = (1024 / 64) * (D / 32);
        constexpr int PER_LAYER = 2 * I_FFN + I_IN + I_OB;
        for (int it = gw; it < DEPTH * PER_LAYER; it += NGW) {
            const int l = it / PER_LAYER; int r = it - l * PER_LAYER;
            GAS unsigned char* wl = ws + WS_W0 + (size_t)l * W_LAYER;
            if (r < 2 * I_FFN) {
                const int f = r / I_FFN; r -= f * I_FFN;
                GAS bf16* dgu = (GAS bf16*)(wl + (f ? WO_GU2 : WO_GU1)); GAS bf16* dd = (GAS bf16*)(wl + (f ? WO_D2 : WO_D1));
                if (r < 2 * I_GU) { const int up = r >= I_GU; if (up) r -= I_GU; const int kb = r / (FF / 32), nb = r % (FF / 32), n0 = 32 * nb;
                    const GAS float* wsrc = karg_in(up ? (f ? 17 : 4) : (f ? 16 : 3)) + (size_t)l * D * FF;
                    conv_item(wsrc, FF, 64 * kb, n0, 32, dgu, D, (n0 >> 7) * 256 + (up ? 128 : 0) + (n0 & 127), 0, 1.0f, karg_in(f ? 15 : 2) + (size_t)l * D, scr, lane); }
                else { r -= 2 * I_GU; const int kb = r / (D / 32), nb = r % (D / 32);
                    conv_item(karg_in(f ? 18 : 5) + (size_t)l * FF * D, D, 64 * kb, 32 * nb, 32, dd, FF, 32 * nb, 0, 1.0f, nullptr, scr, lane); }
            } else if (r < 2 * I_FFN + I_IN) {
                r -= 2 * I_FFN; const int j = r >> 5, kb = r & 31; int src, nvalid = 32; float sc = 1.0f;
                if (j < 8) src = 1024 + 32 * j;
                else if (j < 24) src = 1280 + 32 * (j - 8);
                else if (j < 56) { src = 1864 + 32 * (j - 24); sc = 0.125f; }
                else if (j < 60) src = 2888 + 32 * (j - 56);
                else if (j < 64) src = 3016 + 32 * (j - 60);
                else if (j < 66) src = 1792 + 32 * (j - 64);
                else if (j == 66) { src = 1856; nvalid = 8; sc = 0.044194173824159216f; }
                else { src = 0; nvalid = 0; }
                conv_item(karg_in(7) + (size_t)l * D * D_IN, D_IN, 64 * kb, src, nvalid, (GAS bf16*)(wl + WO_IN), D, 2048 + 32 * j, 0, sc, karg_in(6) + (size_t)l * D, scr, lane);
            } else {
                r -= 2 * I_FFN + I_IN; const int kb = r >> 6, nb = r & 63;
                conv_item(karg_in(14) + (size_t)l * D * D + (size_t)1024 * D, D, 64 * kb, 32 * nb, 32, (GAS bf16*)(wl + WO_OUT), OLD, 32 * nb, 2048, 1.0f, nullptr, scr, lane);
            }
        }
        __syncthreads();
        LAS float* Ps = (LAS float*)(lds + RING_OFF); LAS float* Qs = Ps + 64 * 129;
        for (int u = vcu; u < DEPTH * 2048; u += G) {
            const int l = u >> 11, which = (u >> 10) & 1, v = u & 1023;
            GAS unsigned char* wl = ws + WS_W0 + (size_t)l * W_LAYER;
            if (which == 0) { const int h = v >> 7, rt = (v >> 5) & 3, kt = v & 31;
                absorb_unit<false>(karg_in(11) + (size_t)l * RANK * 1024 + ((size_t)(64 * rt) * 8 + h) * 128, 1024, 1, karg_in(7) + (size_t)l * D * D_IN + (size_t)(64 * kt) * D_IN + h * 128, D_IN,
                                   (GAS bf16*)(wl + WO_IN) + (size_t)(h * 256 + 64 * rt) * D + 64 * kt, D, 0.08838834764831845f, karg_in(6) + (size_t)l * D + 64 * kt, Ps, Qs, tid); }
            else { const int h = v >> 7, nt = (v >> 2) & 31, rt = v & 3;
                absorb_unit<true>(karg_in(14) + (size_t)l * D * D + (size_t)(h * 128) * D + 64 * nt, 1, D, karg_in(12) + (size_t)l * RANK * 1024 + ((size_t)(64 * rt) * 8 + h) * 128, 1024,
                                  (GAS bf16*)(wl + WO_OUT) + (size_t)(64 * nt) * OLD + h * 256 + 64 * rt, OLD, 1.0f, nullptr, Ps, Qs, tid); }
        }
    }
    GRID_BAR();

#pragma unroll 1
    for (int s = 0; s < 2 * DEPTH; ++s) {
        const int l = s >> 1, f = s & 1;
        REPEAT(REP_GU) {   PHASE_IDS(); GAS unsigned char* wl = ws + WS_W0 + (size_t)l * W_LAYER;
            pg8::Gemm g{(const GAS bf16*)(ws + WS_XN), (const GAS bf16*)(wl + (f ? WO_GU2 : WO_GU1)), M, NGU, D}; pg8::StaticOrder S; S.init(M, NGU, G, bx);
            pg8::EpiSwiglu E{(GAS bf16*)(ws + WS_ACT), FF, (const GAS float*)(ws + WS_SS + (size_t)((3 * l + 2 * f) & 1) * SS_BYTES), 1.0f / D, EPS};
            pg8::gemm_phase<pg8::EpiSwiglu, pg8::StaticOrder, true, true>(lds + RING_OFF, g, S, E); }
        GRID_BAR();
        {   PHASE_IDS(); GAS unsigned char* wl = ws + WS_W0 + (size_t)l * W_LAYER;
            pg8::Gemm g{(const GAS bf16*)(ws + WS_ACT), (const GAS bf16*)(wl + (f ? WO_D2 : WO_D1)), M, D, FF}; pg8::StaticOrder S; S.init(M, D, G, bx);
            pg8::EpiResid E{0.5f, (unsigned)WS_XN, (unsigned)(WS_SS + (size_t)((3 * l + 2 * f + 1) & 1) * SS_BYTES)};
            pg8::gemm_phase<pg8::EpiResid, pg8::StaticOrder, true, true>(lds + RING_OFF, g, S, E); }
        GRID_BAR();
        if (f == 0) {
            REPEAT(REP_IN) {   PHASE_IDS(); GAS unsigned char* wl = ws + WS_W0 + (size_t)l * W_LAYER;
                pg8::Gemm g{(const GAS bf16*)(ws + WS_XN), (const GAS bf16*)(wl + WO_IN), M, ZLD, D}; pg8::StaticOrder S; S.init(M, ZLD, G, bx);
                pg8::EpiBf16 E{(GAS bf16*)(ws + WS_Z), ZLD, (const GAS float*)(ws + WS_SS + (size_t)((3 * l + 1) & 1) * SS_BYTES), 1.0f / D, EPS};
                pg8::gemm_phase<pg8::EpiBf16, pg8::StaticOrder, true, true>(lds + RING_OFF, g, S, E); }
            GRID_BAR();
            REPEAT(REP_POST) {   PHASE_IDS();
                post_rows((const GAS bf16*)(ws + WS_Z), karg_in(8) + (size_t)l * RANK, karg_in(9) + (size_t)l * IDIM, karg_in(10) + (size_t)l * IDIM, (GAS bf16*)(ws + WS_CKVN), (GAS bf16*)(ws + WS_KIN), (GAS float*)(ws + WS_WIF), gw, NGW, lane);
                swa_phase(lds + RING_OFF, (const GAS bf16*)(ws + WS_Z), (GAS bf16*)(ws + WS_O), karg_in(1), karg_in(13) + (size_t)l * H_B, vcu, G, tid, lane, wave);
            }
            GRID_BAR();
            REPEAT(REP_TOPK) {   PHASE_IDS(); topk_phase(lds + RING_OFF, (const GAS bf16*)(ws + WS_Z), (const GAS bf16*)(ws + WS_KIN), (const GAS float*)(ws + WS_WIF), (GAS unsigned short*)(ws + WS_IDX), vcu, G, lane, wave); }
            GRID_BAR();
            REPEAT(REP_DSA) {   PHASE_IDS(); dsa_phase(lds, (const GAS bf16*)(ws + WS_Z), (const GAS bf16*)(ws + WS_CKVN), (const GAS unsigned short*)(ws + WS_IDX), (GAS bf16*)(ws + WS_O), karg_in(1), gw, NGW, tid, lane, wave); }
            GRID_BAR();
            {   PHASE_IDS(); GAS unsigned char* wl = ws + WS_W0 + (size_t)l * W_LAYER;
                pg8::Gemm g{(const GAS bf16*)(ws + WS_O), (const GAS bf16*)(wl + WO_OUT), M, D, OLD}; pg8::StaticOrder S; S.init(M, D, G, bx);
                pg8::EpiResid E{1.0f, (unsigned)WS_XN, (unsigned)(WS_SS + (size_t)((3 * l + 2) & 1) * SS_BYTES)};
                pg8::gemm_phase<pg8::EpiResid, pg8::StaticOrder, true, true>(lds + RING_OFF, g, S, E); }
            GRID_BAR();
        }
    }
    {   PHASE_IDS(); final_rows((const GAS bf16*)(ws + WS_XN), karg_out(), karg_in(19), (const GAS float*)(ws + WS_SS + (size_t)(6 & 1) * SS_BYTES), gw, NGW, lane); }
}

extern "C" void kernel_launch(void* const* d_in, const int* in_sizes, int n_in, void* d_out, int out_size, void* d_ws, size_t ws_size, hipStream_t stream) {
    static int grid = 0;
    if (grid == 0) {
        if (n_in != 20 || in_sizes[0] != M * D || out_size != M * D || ws_size < WS_END) { fprintf(stderr, "kernel_launch: unexpected shapes (n_in %d, in0 %d, out %d, ws %zu); nothing launched\n", n_in, n_in > 0 ? in_sizes[0] : -1, out_size, ws_size); grid = -1; return; }
        int dev = 0, cus = 0, per_cu = 0;
        if (hipGetDevice(&dev) != hipSuccess || hipDeviceGetAttribute(&cus, hipDeviceAttributeMultiprocessorCount, dev) != hipSuccess) { grid = -1; return; }
        if (hipFuncSetAttribute((const void*)mk_fwd, hipFuncAttributeMaxDynamicSharedMemorySize, LDS_BYTES) != hipSuccess) { fprintf(stderr, "kernel_launch: hipFuncSetAttribute failed\n"); grid = -1; return; }
        if (hipOccupancyMaxActiveBlocksPerMultiprocessor(&per_cu, (const void*)mk_fwd, NWAVES * 64, LDS_BYTES) != hipSuccess || per_cu < 1) { fprintf(stderr, "kernel_launch: occupancy query reports %d workgroups per CU\n", per_cu); }
        (void)hipGetLastError();
        grid = cus;
    }
    if (grid < 0) return;
    if (hipMemsetAsync((char*)d_ws + WS_CTL, 0, CTL_ZERO_BYTES, stream) != hipSuccess) return;
    Args a{};
    for (int i = 0; i < 20; ++i) a.in[i] = (const float*)d_in[i];
    a.out = (float*)d_out; a.ws = (unsigned char*)d_ws;
    hipLaunchKernelGGL(mk_fwd, dim3(grid), dim3(NWAVES * 64), LDS_BYTES, stream, a);
}
```

```cpp
#include <hip/hip_runtime.h>
#include <cstdio>
#include <cstdint>
namespace pg8 {
#define PG8_LAS __attribute__((address_space(3)))
#define PG8_GAS __attribute__((address_space(1)))
typedef unsigned short bf16_t;
typedef short bf16x8 __attribute__((ext_vector_type(8)));
typedef float f32x4 __attribute__((ext_vector_type(4)));
typedef unsigned u32x4 __attribute__((ext_vector_type(4)));
constexpr int BM = 256, BK = 64, HALF = 128, HTB = HALF * BK * 2  , STAGE_BYTES = 8 * HTB, NXCD = 8, WGM = 8;

__host__ __device__ __forceinline__ int lds_byte(int r, int c) { const int st = (r >> 4) * 2 + (c >> 5), rr = r & 15, cc = c & 31, ob = rr * 64 + cc * 2; return st * 1024 + (ob ^ (((ob >> 9) & 1) << 5)); }
__host__ __device__ __forceinline__ void stage_rc(int b, int& R, int& C) { const int st = b / 1024, sb = b % 1024, swz = sb ^ (((sb >> 9) & 1) << 5); R = (st >> 1) * 16 + swz / 64; C = (st & 1) * 32 + (swz % 64) / 2; }
__host__ __device__ __forceinline__ int perm32(int rho) { const int n = rho >> 4, i = rho & 15; return 8 * (i >> 2) + 4 * n + (i & 3); }

struct Unit { int pm, pn; };
struct Gemm { const PG8_GAS bf16_t* A; const PG8_GAS bf16_t* Bt; int M, N, K; };

struct StaticOrder {
    int nM, nN, nwg, G, c;
    __host__ __device__ void init(int M, int N, int G_, int c_) { nM = M / BM; nN = N / BM; nwg = nM * nN; G = G_; c = c_; }
    __host__ __device__ bool next(int i, Unit& u) const {
        const long L = (long)i * G + c; if (L >= nwg) return false;
        int wgid = (int)L; { const int q = nwg / NXCD, r = nwg % NXCD, xcd = wgid % NXCD, off = wgid / NXCD; wgid = (xcd < r ? xcd * (q + 1) : r * (q + 1) + (xcd - r) * q) + off; }
        const int nig = WGM * nN, gid = wgid / nig, fm = gid * WGM, gsz = (nM - fm) < WGM ? (nM - fm) : WGM;
        u.pm = fm + ((wgid % nig) % gsz); u.pn = (wgid % nig) / gsz; return true;
    }
    __device__ __forceinline__ void a_ready(const Unit&) const {}
    __device__ __forceinline__ void done(const Unit&) const {}
};
__device__ __forceinline__ unsigned long long karg64(int idx) { unsigned long long r; const unsigned off = (unsigned)idx * 8u;
    asm volatile("s_load_dwordx2 %0, %1, %2\n\ts_waitcnt lgkmcnt(0)" : "=s"(r) : "s"(__builtin_amdgcn_kernarg_segment_ptr()), "s"(off) : "memory"); return r; }
__device__ __forceinline__ unsigned cvt_pk_bf16(float lo, float hi) { unsigned r; asm volatile("v_cvt_pk_bf16_f32 %0, %1, %2" : "=v"(r) : "v"(lo), "v"(hi)); return r; }
__device__ __forceinline__ float silu_f(float g) { return g * __builtin_amdgcn_rcpf(1.0f + __builtin_amdgcn_exp2f(-1.4426950408889634f * g)); }

struct EpiSwiglu {
    static constexpr bool PERM = true, AFTER_DRAIN = false;
    PG8_GAS bf16_t* O; int ldc; const PG8_GAS float* ss; float inv_k, eps;
    __device__ __forceinline__ void operator()(const f32x4 (&acc)[2][2][4][2], const Unit& u, int wr, int wc, int fr, int fq) const {
        const int row0 = u.pm * BM + wr * 64 + fr, col0 = u.pn * HALF + wc * 32 + 8 * fq;
        float rs[8]; const int lane_ = fr + 16 * fq;
#pragma unroll
        for (int k = 0; k < 8; ++k) { const PG8_GAS f32x4* p4 = (const PG8_GAS f32x4*)(ss + (size_t)(row0 + (k >> 2) * HALF + (k & 3) * 16) * 32 + 8 * fq); const f32x4 a = p4[0], b = p4[1];
            float t = ((a[0] + a[1]) + (a[2] + a[3])) + ((b[0] + b[1]) + (b[2] + b[3]));
            t += __builtin_bit_cast(float, __builtin_amdgcn_ds_bpermute((lane_ ^ 16) << 2, __builtin_bit_cast(int, t)));
            t += __builtin_bit_cast(float, __builtin_amdgcn_ds_bpermute((lane_ ^ 32) << 2, __builtin_bit_cast(int, t))); rs[k] = t; }
#pragma unroll
        for (int ai = 0; ai < 2; ++ai)
#pragma unroll
            for (int m = 0; m < 4; ++m) { PG8_GAS bf16_t* rowp = O + (size_t)(row0 + ai * HALF + m * 16) * ldc + col0;
                const float r = __builtin_amdgcn_rsqf(rs[ai * 4 + m] * inv_k + eps);
                const f32x4 g0 = acc[ai][0][m][0] * r, g1 = acc[ai][0][m][1] * r, u0 = acc[ai][1][m][0] * r, u1 = acc[ai][1][m][1] * r;
                u32x4 w; w.x = cvt_pk_bf16(silu_f(g0[0]) * u0[0], silu_f(g0[1]) * u0[1]); w.y = cvt_pk_bf16(silu_f(g0[2]) * u0[2], silu_f(g0[3]) * u0[3]);
                w.z = cvt_pk_bf16(silu_f(g1[0]) * u1[0], silu_f(g1[1]) * u1[1]); w.w = cvt_pk_bf16(silu_f(g1[2]) * u1[2], silu_f(g1[3]) * u1[3]);
                *(PG8_GAS u32x4*)rowp = w; }
    }
};
struct EpiResid {
    static constexpr bool PERM = true, AFTER_DRAIN = false;
    float alpha; unsigned hb_off; unsigned ss_off;
    __device__ __forceinline__ void operator()(const f32x4 (&acc)[2][2][4][2], const Unit& u, int wr, int wc, int fr, int fq) const {
        constexpr int ldc = 2048;
        PG8_GAS unsigned char* wsb = (PG8_GAS unsigned char*)karg64(21); PG8_GAS bf16_t* hb = (PG8_GAS bf16_t*)(wsb + hb_off); PG8_GAS float* ss = (PG8_GAS float*)(wsb + ss_off);
        const int row0 = u.pm * BM + wr * 64 + fr, col0 = u.pn * BM + wc * 32 + 8 * fq; const int lane = fr + 16 * fq;
        u32x4 cur[2], nxt[2];
        { const size_t off = (size_t)row0 * ldc + col0; cur[0] = *(const PG8_GAS u32x4*)(hb + off); cur[1] = *(const PG8_GAS u32x4*)(hb + off + HALF); }
#pragma unroll
        for (int k = 0; k < 8; ++k) { const int ai = k >> 2, m = k & 3; const int row = row0 + ai * HALF + m * 16; const size_t off = (size_t)row * ldc + col0;
            if (k < 7) { const int ai2 = (k + 1) >> 2, m2 = (k + 1) & 3; const size_t off2 = (size_t)(row0 + ai2 * HALF + m2 * 16) * ldc + col0;
                nxt[0] = *(const PG8_GAS u32x4*)(hb + off2); nxt[1] = *(const PG8_GAS u32x4*)(hb + off2 + HALF); }
            float sq = 0.f;
#pragma unroll
            for (int bj = 0; bj < 2; ++bj) { const u32x4 b = cur[bj]; const f32x4 a0 = acc[ai][bj][m][0], a1 = acc[ai][bj][m][1]; u32x4 w;
                w.x = cvt_pk_bf16(__builtin_bit_cast(float, b.x << 16) + a0[0] * alpha, __builtin_bit_cast(float, b.x & 0xffff0000u) + a0[1] * alpha);
                w.y = cvt_pk_bf16(__builtin_bit_cast(float, b.y << 16) + a0[2] * alpha, __builtin_bit_cast(float, b.y & 0xffff0000u) + a0[3] * alpha);
                w.z = cvt_pk_bf16(__builtin_bit_cast(float, b.z << 16) + a1[0] * alpha, __builtin_bit_cast(float, b.z & 0xffff0000u) + a1[1] * alpha);
                w.w = cvt_pk_bf16(__builtin_bit_cast(float, b.w << 16) + a1[2] * alpha, __builtin_bit_cast(float, b.w & 0xffff0000u) + a1[3] * alpha);
                *(PG8_GAS u32x4*)(hb + off + bj * HALF) = w;
#pragma unroll
                for (int e = 0; e < 4; ++e) { const float lo = __builtin_bit_cast(float, w[e] << 16), hi = __builtin_bit_cast(float, w[e] & 0xffff0000u); sq = fmaf(lo, lo, sq); sq = fmaf(hi, hi, sq); } }
            sq += __builtin_bit_cast(float, __builtin_amdgcn_ds_bpermute((lane ^ 16) << 2, __builtin_bit_cast(int, sq)));
            sq += __builtin_bit_cast(float, __builtin_amdgcn_ds_bpermute((lane ^ 32) << 2, __builtin_bit_cast(int, sq)));
            if (fq == 0) ss[(size_t)row * 32 + u.pn * 4 + wc] = sq;
            cur[0] = nxt[0]; cur[1] = nxt[1]; }
    }
};
struct EpiBf16 {
    static constexpr bool PERM = true, AFTER_DRAIN = false;
    PG8_GAS bf16_t* O; int ldc; const PG8_GAS float* ss; float inv_k, eps;
    __device__ __forceinline__ void operator()(const f32x4 (&acc)[2][2][4][2], const Unit& u, int wr, int wc, int fr, int fq) const {
        const int row0 = u.pm * BM + wr * 64 + fr, col0 = u.pn * BM + wc * 32 + 8 * fq;
        float rs[8]; const int lane_ = fr + 16 * fq;
#pragma unroll
        for (int k = 0; k < 8; ++k) { const PG8_GAS f32x4* p4 = (const PG8_GAS f32x4*)(ss + (size_t)(row0 + (k >> 2) * HALF + (k & 3) * 16) * 32 + 8 * fq); const f32x4 a = p4[0], b = p4[1];
            float t = ((a[0] + a[1]) + (a[2] + a[3])) + ((b[0] + b[1]) + (b[2] + b[3]));
            t += __builtin_bit_cast(float, __builtin_amdgcn_ds_bpermute((lane_ ^ 16) << 2, __builtin_bit_cast(int, t)));
            t += __builtin_bit_cast(float, __builtin_amdgcn_ds_bpermute((lane_ ^ 32) << 2, __builtin_bit_cast(int, t))); rs[k] = t; }
#pragma unroll
        for (int ai = 0; ai < 2; ++ai)
#pragma unroll
            for (int m = 0; m < 4; ++m) { PG8_GAS bf16_t* rowp = O + (size_t)(row0 + ai * HALF + m * 16) * ldc + col0;
                const float r = __builtin_amdgcn_rsqf(rs[ai * 4 + m] * inv_k + eps);
#pragma unroll
                for (int bj = 0; bj < 2; ++bj) { const f32x4 v0 = acc[ai][bj][m][0] * r, v1 = acc[ai][bj][m][1] * r;
                    u32x4 w; w.x = cvt_pk_bf16(v0[0], v0[1]); w.y = cvt_pk_bf16(v0[2], v0[3]); w.z = cvt_pk_bf16(v1[0], v1[1]); w.w = cvt_pk_bf16(v1[2], v1[3]);
                    *(PG8_GAS u32x4*)(rowp + bj * HALF) = w; } }
    }
};
template <class Epi, class Sched, bool ALIGN_EPI = false, bool SP2 = false>
__device__ __forceinline__ void gemm_phase(PG8_LAS unsigned char* lds, const Gemm g, const Sched& S, const Epi& E) {
    int tid_ = threadIdx.x; asm volatile("" : "+v"(tid_));
    const int tid = tid_, wid = __builtin_amdgcn_readfirstlane(tid >> 6), lane = tid & 63, wr = wid >> 2, wc = wid & 3, fr = lane & 15, fq = lane >> 4;
    const int K = g.K, nt = K / BK;
    unsigned voffA[2], voffB[2];
#pragma unroll
    for (int i = 0; i < 2; ++i) { int R, C; stage_rc(tid * 16 + i * 8192, R, C); const int Rb = Epi::PERM ? ((R & ~31) + perm32(R & 31)) : R;
        voffA[i] = (unsigned)(R * K + C) * 2u; voffB[i] = (unsigned)(Rb * K + C) * 2u; }
    const size_t kstep = (size_t)(BK * 2);
    const size_t hstep = (size_t)HALF * K * 2;
    const size_t tstep = 2 * hstep;
    const unsigned ldsw = (unsigned)wid * 1024u;
    const int aoff = lds_byte(wr * 64 + fr, fq * 8), boff = lds_byte(wc * 32 + fr, fq * 8);
#define PG8_SA(b, h) (((b) * 2 + (h)) * HTB)
#define PG8_SB(b, h) ((4 + (b) * 2 + (h)) * HTB)
#define PG8_STAGE(bufoff, gbase, voff) do { _Pragma("unroll") for (int _i = 0; _i < 2; ++_i) \
        __builtin_amdgcn_global_load_lds((const PG8_GAS unsigned*)((const PG8_GAS char*)(gbase) + (voff)[_i]), (PG8_LAS unsigned*)(lds + (bufoff) + ldsw + _i * 8192), 16, 0, 0); } while (0)
#define PG8_LDA(dst, b, h) do { _Pragma("unroll") for (int m = 0; m < 4; ++m) _Pragma("unroll") for (int k = 0; k < 2; ++k) dst[m][k] = *(const PG8_LAS bf16x8*)(lds + PG8_SA(b, h) + aoff + m * 2048 + k * 1024); } while (0)
#define PG8_LDB(dst, b, h) do { _Pragma("unroll") for (int n = 0; n < 2; ++n) _Pragma("unroll") for (int k = 0; k < 2; ++k) dst[n][k] = *(const PG8_LAS bf16x8*)(lds + PG8_SB(b, h) + boff + n * 2048 + k * 1024); } while (0)
#define PG8_MMA(ai, bj, At, Bt) do { __builtin_amdgcn_s_setprio(1); _Pragma("unroll") for (int m = 0; m < 4; ++m) _Pragma("unroll") for (int n = 0; n < 2; ++n) _Pragma("unroll") for (int k = 0; k < 2; ++k) \
        acc[ai][bj][m][n] = __builtin_amdgcn_mfma_f32_16x16x32_bf16(Bt[n][k], At[m][k], acc[ai][bj][m][n], 0, 0, 0); __builtin_amdgcn_s_setprio(0); } while (0)
#define PG8_WAIT_V(n) asm volatile("s_waitcnt vmcnt(" #n ")" ::: "memory")
#define PG8_WAIT_L(n) asm volatile("s_waitcnt lgkmcnt(" #n ")" ::: "memory")
#define PG8_BAR __builtin_amdgcn_s_barrier()
#define PG8_SCHED __builtin_amdgcn_sched_barrier(0)
    Unit cur, nxt; int ui = 0;
    if (!S.next(0, cur)) return;
    f32x4 acc[2][2][4][2];
#pragma unroll
    for (int a = 0; a < 2; ++a)
#pragma unroll
        for (int b = 0; b < 2; ++b)
#pragma unroll
            for (int m = 0; m < 4; ++m)
#pragma unroll
                for (int n = 0; n < 2; ++n) acc[a][b][m][n] = (f32x4){0.f, 0.f, 0.f, 0.f};
    bf16x8 At[4][2], B0[2][2], B1[2][2];
    const PG8_GAS char* cA = (const PG8_GAS char*)g.A + (size_t)cur.pm * tstep; const PG8_GAS char* cB = (const PG8_GAS char*)g.Bt + (size_t)cur.pn * tstep;
    S.a_ready(cur);
    if constexpr (SP2) {
        PG8_STAGE(PG8_SB(0, 0), cB, voffB); PG8_STAGE(PG8_SB(0, 1), cB + hstep, voffB); PG8_STAGE(PG8_SA(0, 0), cA, voffA); PG8_STAGE(PG8_SA(0, 1), cA + hstep, voffA);
        if (wr == 1) PG8_BAR;
        PG8_WAIT_V(2); PG8_BAR;
        PG8_STAGE(PG8_SB(1, 0), cB + kstep, voffB); PG8_STAGE(PG8_SA(1, 0), cA + kstep, voffA); PG8_STAGE(PG8_SB(1, 1), cB + hstep + kstep, voffB);
        PG8_WAIT_V(6); PG8_BAR;
    } else {
        PG8_STAGE(PG8_SB(0, 0), cB, voffB); PG8_STAGE(PG8_SA(0, 0), cA, voffA); PG8_STAGE(PG8_SB(0, 1), cB + hstep, voffB); PG8_STAGE(PG8_SA(0, 1), cA + hstep, voffA);
        if (wr == 1) PG8_BAR;
        PG8_WAIT_V(4); PG8_BAR;
        PG8_STAGE(PG8_SB(1, 0), cB + kstep, voffB); PG8_STAGE(PG8_SA(1, 0), cA + kstep, voffA); PG8_STAGE(PG8_SB(1, 1), cB + hstep + kstep, voffB);
        PG8_WAIT_V(6); PG8_BAR;
    }
    for (;;) {
        const bool has_next = S.next(ui + 1, nxt);
        const PG8_GAS char* nA = has_next ? (const PG8_GAS char*)g.A + (size_t)nxt.pm * tstep : cA; const PG8_GAS char* nB = has_next ? (const PG8_GAS char*)g.Bt + (size_t)nxt.pn * tstep : cB;
        for (int t = 0; t < nt; t += 2) {
            const bool last = (t == nt - 2);
            const PG8_GAS char* a1 = cA + (size_t)(t + 1) * kstep;
            const PG8_GAS char* a2 = last ? nA : cA + (size_t)(t + 2) * kstep; const PG8_GAS char* b2 = last ? nB : cB + (size_t)(t + 2) * kstep;
            const PG8_GAS char* a3 = a2 + kstep; const PG8_GAS char* b3 = b2 + kstep;
            if (last && has_next) S.a_ready(nxt);
            if constexpr (SP2) {
            PG8_LDB(B0, 0, 0); PG8_LDB(B1, 0, 1); PG8_SCHED; PG8_LDA(At, 0, 0); PG8_STAGE(PG8_SA(1, 1), a1 + hstep, voffA);
            PG8_WAIT_V(8); PG8_WAIT_L(0); PG8_BAR; PG8_MMA(0, 0, At, B0); PG8_MMA(0, 1, At, B1); PG8_BAR; PG8_SCHED;
            PG8_LDA(At, 0, 1); PG8_STAGE(PG8_SB(0, 0), b2, voffB); PG8_STAGE(PG8_SB(0, 1), b2 + hstep, voffB); PG8_STAGE(PG8_SA(0, 0), a2, voffA);
            PG8_WAIT_V(8); PG8_WAIT_L(0); PG8_BAR; PG8_MMA(1, 0, At, B0); PG8_MMA(1, 1, At, B1); PG8_BAR; PG8_SCHED;
            PG8_LDB(B0, 1, 0); PG8_LDB(B1, 1, 1); PG8_SCHED; PG8_LDA(At, 1, 0); PG8_STAGE(PG8_SA(0, 1), a2 + hstep, voffA);
            PG8_WAIT_V(8); PG8_WAIT_L(0); PG8_BAR; PG8_MMA(0, 0, At, B0); PG8_MMA(0, 1, At, B1); PG8_BAR; PG8_SCHED;
            PG8_LDA(At, 1, 1); PG8_STAGE(PG8_SB(1, 0), b3, voffB); PG8_STAGE(PG8_SB(1, 1), b3 + hstep, voffB); PG8_STAGE(PG8_SA(1, 0), a3, voffA);
            PG8_WAIT_V(8); PG8_WAIT_L(0); PG8_BAR; PG8_MMA(1, 0, At, B0); PG8_MMA(1, 1, At, B1); PG8_BAR; PG8_SCHED;
            } else {
            PG8_LDB(B0, 0, 0); PG8_SCHED; PG8_LDA(At, 0, 0); PG8_STAGE(PG8_SA(1, 1), a1 + hstep, voffA);
            PG8_WAIT_L(8); PG8_BAR; PG8_WAIT_L(0); PG8_MMA(0, 0, At, B0); PG8_BAR; PG8_SCHED;
            PG8_LDB(B1, 0, 1); PG8_STAGE(PG8_SB(0, 0), b2, voffB);
            PG8_BAR; PG8_WAIT_L(0); PG8_MMA(0, 1, At, B1); PG8_BAR;
            PG8_LDA(At, 0, 1); PG8_STAGE(PG8_SA(0, 0), a2, voffA);
            PG8_BAR; PG8_WAIT_L(0); PG8_MMA(1, 0, At, B0); PG8_BAR; PG8_SCHED;
            PG8_STAGE(PG8_SB(0, 1), b2 + hstep, voffB);
            PG8_WAIT_V(6); PG8_BAR; PG8_MMA(1, 1, At, B1); PG8_BAR;
            PG8_LDB(B0, 1, 0); PG8_SCHED; PG8_LDA(At, 1, 0); PG8_STAGE(PG8_SA(0, 1), a2 + hstep, voffA);
            PG8_WAIT_L(8); PG8_BAR; PG8_WAIT_L(0); PG8_MMA(0, 0, At, B0); PG8_BAR; PG8_SCHED;
            PG8_LDB(B1, 1, 1); PG8_STAGE(PG8_SB(1, 0), b3, voffB);
            PG8_BAR; PG8_WAIT_L(0); PG8_MMA(0, 1, At, B1); PG8_BAR;
            PG8_LDA(At, 1, 1); PG8_STAGE(PG8_SA(1, 0), a3, voffA);
            PG8_BAR; PG8_WAIT_L(0); PG8_MMA(1, 0, At, B0); PG8_BAR; PG8_SCHED;
            PG8_STAGE(PG8_SB(1, 1), b3 + hstep, voffB);
            PG8_WAIT_V(6); PG8_BAR; PG8_MMA(1, 1, At, B1); PG8_BAR;
            }
        }
        if constexpr (ALIGN_EPI) { if (wr == 0) PG8_BAR; }
        if constexpr (!Epi::AFTER_DRAIN) { E(acc, cur, wr, wc, fr, fq); S.done(cur); }
        if (!has_next) break;
#pragma unroll
        for (int a = 0; a < 2; ++a)
#pragma unroll
            for (int b = 0; b < 2; ++b)
#pragma unroll
                for (int m = 0; m < 4; ++m)
#pragma unroll
                    for (int n = 0; n < 2; ++n) acc[a][b][m][n] = (f32x4){0.f, 0.f, 0.f, 0.f};
        cur = nxt; cA = nA; cB = nB; ++ui;
        if constexpr (ALIGN_EPI) { if (wr == 1) PG8_BAR; }
    }
    PG8_WAIT_V(0);
    if constexpr (!ALIGN_EPI) { if (wr == 0) PG8_BAR; }
    PG8_BAR;
    if constexpr (Epi::AFTER_DRAIN) { E.fused(acc, cur, wr, wc, fr, fq, lds, wid, lane); S.done(cur); }
#undef PG8_SA
#undef PG8_SB
#undef PG8_STAGE
#undef PG8_LDA
#undef PG8_LDB
#undef PG8_MMA
#undef PG8_WAIT_V
#undef PG8_WAIT_L
#undef PG8_BAR
#undef PG8_SCHED
}
}
constexpr int NWAVES = 8;
constexpr int BATCH = 8, SEQ = 4096, D = 2048, FF = 5632, DEPTH = 2;
constexpr int M = BATCH * SEQ;
constexpr int NGU = 2 * FF;
constexpr int H_A = 8, HD_A = 128, RANK = 256, IH = 8, IDIM = 64, TOPK = 256;
constexpr int H_B = 16, KVH = 2, GQA = 8, HD_B = 64, WINDOW = 128;
constexpr int D_IN = 3144;
constexpr float EPS = 1e-6f;
constexpr size_t MiB = 1u << 20;
constexpr size_t WS_CTL = 0, CTL_ZERO_BYTES = 1 * MiB;
constexpr size_t WS_W0 = 2 * MiB, W_LAYER = 162 * MiB;
constexpr size_t WO_GU1 = 0, WO_D1 = 44 * MiB, WO_GU2 = 66 * MiB, WO_D2 = 110 * MiB, WO_IN = 132 * MiB, WO_OUT = 149 * MiB;
constexpr size_t WS_XN = 326 * MiB;
constexpr size_t WS_ACT = 454 * MiB;
constexpr size_t WS_Z = WS_ACT, WS_CKVN = WS_ACT + 272 * MiB, WS_KIN = WS_ACT + 288 * MiB, WS_WIF = WS_ACT + 292 * MiB, WS_IDX = WS_ACT + 294 * MiB;
constexpr int ZLD = 4352, ZC_QLAT = 0, ZC_CKV = 2048, ZC_QI = 2304, ZC_QB = 2816, ZC_KB = 3840, ZC_VB = 3968, ZC_KI = 4096, ZC_WI = 4160;
constexpr int OLD = 3072;
constexpr size_t WS_O = 806 * MiB;
constexpr size_t WS_END = 1006 * MiB;
constexpr size_t WS_SS = 998 * MiB, SS_BYTES = 4 * MiB;
constexpr int CW_TMO = 0, CW_CODE = 1, CW_BAR = 4096;
constexpr int RING_OFF = 0, RING_BYTES = 131072;
constexpr int LDSCTL_OFF = RING_BYTES, MISC_OFF = LDSCTL_OFF + 320;
constexpr int LDS_BYTES = 147456;
#define GAS __attribute__((address_space(1)))
#define LAS __attribute__((address_space(3)))
typedef unsigned short bf16;
typedef unsigned v4u __attribute__((ext_vector_type(4)));
typedef float f32x4 __attribute__((ext_vector_type(4)));
typedef short bf16x8 __attribute__((ext_vector_type(8)));
typedef GAS unsigned gu32;
typedef GAS unsigned long long gu64;
#define RLX_AGENT __ATOMIC_RELAXED, __HIP_MEMORY_SCOPE_AGENT
#define LDS_WAIT() asm volatile("s_waitcnt lgkmcnt(0)" ::: "memory")
#define VM_WAIT() asm volatile("s_waitcnt vmcnt(0)" ::: "memory")
__device__ __forceinline__ unsigned long long rt() { return __builtin_amdgcn_s_memrealtime(); }
__device__ __forceinline__ unsigned f2bf(float f) { unsigned u = __builtin_bit_cast(unsigned, f); return (u + 0x7fffu + ((u >> 16) & 1u)) >> 16; }
__device__ __forceinline__ unsigned pk2(float lo, float hi) { return f2bf(lo) | (f2bf(hi) << 16); }

#define XB_TMO      128
#define XB_XCNT(j)  (256  + 64 * (j))
#define XB_XSUB(j)  (1280 + 64 * (j))
#define XB_XGEN(j)  (2304 + 64 * (j))
#define XB_TOP      3328
#define XB_TOPGEN   3392
#define XCD_BAR_WORDS 3456
#define XB_SPIN_CAP (1u << 18)

__device__ __forceinline__ unsigned xb_ld(unsigned* p)              { return __hip_atomic_load(p, __ATOMIC_RELAXED, __HIP_MEMORY_SCOPE_AGENT); }
__device__ __forceinline__ unsigned xb_add(unsigned* p, unsigned v) { return __hip_atomic_fetch_add(p, v, __ATOMIC_RELAXED, __HIP_MEMORY_SCOPE_AGENT); }
__device__ __forceinline__ unsigned xb_xcc_id() { return (unsigned)__builtin_amdgcn_s_getreg((3 << 11) | 20) & 0xFu; }
#define XB_SPIN(cond, bar) do { unsigned _sp = 0; while (cond) { __builtin_amdgcn_s_sleep(1); \
    if ((++_sp & 255u) == 0u) { if (xb_ld(&(bar)[XB_TMO])) break; if (_sp > XB_SPIN_CAP) { atomicAdd(&(bar)[XB_TMO], 1u); break; } } } } while (0)

struct XcdBarrier {
    unsigned* bar; unsigned x;
    volatile LAS unsigned* st;
};

__device__ __forceinline__ XcdBarrier xcd_barrier_post(unsigned* bar, volatile LAS unsigned* st) {
    XcdBarrier b; b.bar = bar; b.x = xb_xcc_id(); b.st = st;
    if (threadIdx.x == 0) (void)xb_add(&bar[XB_XCNT(b.x)], 1u);
    return b;
}
__device__ __forceinline__ void xcd_barrier_complete(unsigned* bar, unsigned x, unsigned& nloc, unsigned& nx) {
    const unsigned G = gridDim.x * gridDim.y * gridDim.z;
    unsigned sum, cnt, mine, sp = 0u;
    for (;;) {
        sum = 0u; cnt = 0u; mine = 0u;
#pragma unroll
        for (unsigned j = 0; j < 16; ++j) { const unsigned c = xb_ld(&bar[XB_XCNT(j)]); sum += c; cnt += (c > 0u) ? 1u : 0u; mine = (j == x) ? c : mine; }
        if (sum == G) break;
        __builtin_amdgcn_s_sleep(1);
        if ((++sp & 255u) == 0u) { if (xb_ld(&bar[XB_TMO])) break; if (sp > XB_SPIN_CAP) { atomicAdd(&bar[XB_TMO], 1u); break; } }
    }
    nloc = mine > 0u ? mine : 1u; nx = cnt > 0u ? cnt : 1u;
}

__device__ __forceinline__ void xcd_barrier(const XcdBarrier& b) {
    asm volatile("s_waitcnt vmcnt(0)" ::: "memory");
    __syncthreads();
    if (threadIdx.x == 0) {
        unsigned* bar = b.bar;
        __builtin_amdgcn_s_waitcnt(0);
        unsigned nloc = b.st[0], nx = b.st[1];
        if (nloc == 0u) { xcd_barrier_complete(bar, b.x, nloc, nx); b.st[0] = nloc; b.st[1] = nx; }
        const unsigned old = xb_add(&bar[XB_XSUB(b.x)], 1u);
        const unsigned gen = old / nloc;
        if (old + 1u == (gen + 1u) * nloc) {
            __builtin_amdgcn_fence(__ATOMIC_RELEASE, "agent");
            asm volatile("s_waitcnt vmcnt(0)" ::: "memory");
            const unsigned og = xb_add(&bar[XB_TOP], 1u);
            const unsigned tg = og / nx;
            if (og + 1u == (tg + 1u) * nx) xb_add(&bar[XB_TOPGEN], 1u);
            else XB_SPIN(xb_ld(&bar[XB_TOPGEN]) == tg, bar);
            __builtin_amdgcn_fence(__ATOMIC_ACQUIRE, "agent");
            xb_add(&bar[XB_XGEN(b.x)], 1u);
            asm volatile("s_waitcnt vmcnt(0)" ::: "memory");
        } else {
            XB_SPIN(xb_ld(&bar[XB_XGEN(b.x)]) == gen, bar);
            __builtin_amdgcn_fence(__ATOMIC_ACQUIRE, "agent");
            asm volatile("s_waitcnt vmcnt(0)" ::: "memory");
        }
    }
    __syncthreads();
}
__constant__ unsigned char T5_BUCKET[128] = {0, 1, 2, 3, 4, 5, 6, 7, 8, 9, 10, 11, 12, 13, 14, 15, 16, 16, 16, 17, 17, 18, 18, 18, 19, 19, 19, 20, 20, 20, 20, 21, 21, 21, 21, 22, 22, 22, 22, 22, 23, 23, 23, 23, 23, 23, 24, 24, 24, 24, 24, 24, 25, 25, 25, 25, 25, 25, 25, 26, 26, 26, 26, 26, 26, 26, 26, 27, 27, 27, 27, 27, 27, 27, 27, 27, 27, 28, 28, 28, 28, 28, 28, 28, 28, 28, 28, 29, 29, 29, 29, 29, 29, 29, 29, 29, 29, 29, 29, 30, 30, 30, 30, 30, 30, 30, 30, 30, 30, 30, 30, 30, 30, 31, 31, 31, 31, 31, 31, 31, 31, 31, 31, 31, 31, 31, 31, 31};
typedef short s16x4 __attribute__((ext_vector_type(4)));
typedef float f32x16 __attribute__((ext_vector_type(16)));
__device__ __forceinline__ float bf2f(unsigned short b) { return __builtin_bit_cast(float, (unsigned)b << 16); }
__device__ __forceinline__ bf16x8 cat4(s16x4 lo, s16x4 hi) { return __builtin_shufflevector(lo, hi, 0, 1, 2, 3, 4, 5, 6, 7); }
__device__ __forceinline__ void tr_read4(unsigned a0, unsigned a1, unsigned a2, unsigned a3, s16x4& r0, s16x4& r1, s16x4& r2, s16x4& r3) {
    asm volatile("ds_read_b64_tr_b16 %0, %4\n\tds_read_b64_tr_b16 %1, %5\n\tds_read_b64_tr_b16 %2, %6\n\tds_read_b64_tr_b16 %3, %7\n\ts_waitcnt lgkmcnt(0)"
                 : "=&v"(r0), "=&v"(r1), "=&v"(r2), "=&v"(r3) : "v"(a0), "v"(a1), "v"(a2), "v"(a3) : "memory");
}
#define SHX(x, o) __builtin_bit_cast(float, __builtin_amdgcn_ds_bpermute(((lane) ^ (o)) << 2, __builtin_bit_cast(int, (float)(x))))
#define SHXU(x, o) ((unsigned)__builtin_amdgcn_ds_bpermute(((lane) ^ (o)) << 2, (int)(x)))
__device__ __forceinline__ float wave_sum(float v, int lane) {
#pragma unroll
    for (int o = 1; o < 64; o <<= 1) v += SHX(v, o);
    return v;
}
__device__ __forceinline__ void conv_item(const GAS float* W, int ldw, int k0, int c0, int nvalid, GAS bf16* dst, int dld, int drow0, int dk0, float scale, const GAS float* gain, LAS float* scr, int lane) {
    const int c = lane & 31;
#pragma unroll 8
    for (int i = 0; i < 32; ++i) { const int kk = 2 * i + (lane >> 5); float v = 0.f;
        if (c < nvalid) v = W[(size_t)(k0 + kk) * ldw + c0 + c] * scale;
        scr[kk * 33 + c] = v; }
    LDS_WAIT(); asm volatile("" ::: "memory");
    const int c8 = lane & 7;
    f32x4 ga = {1.f, 1.f, 1.f, 1.f}, gb = {1.f, 1.f, 1.f, 1.f};
    if (gain) { ga = *(const GAS f32x4*)(gain + k0 + 8 * c8); gb = *(const GAS f32x4*)(gain + k0 + 8 * c8 + 4); }
#pragma unroll
    for (int j = 0; j < 4; ++j) { const int n = (lane >> 3) + 8 * j; const LAS float* s = scr + (8 * c8) * 33 + n;
        v4u o; o.x = pk2(s[0 * 33] * ga.x, s[1 * 33] * ga.y); o.y = pk2(s[2 * 33] * ga.z, s[3 * 33] * ga.w); o.z = pk2(s[4 * 33] * gb.x, s[5 * 33] * gb.y); o.w = pk2(s[6 * 33] * gb.z, s[7 * 33] * gb.w);
        *(GAS v4u*)(dst + (size_t)(drow0 + n) * dld + dk0 + k0 + 8 * c8) = o; }
    LDS_WAIT(); asm volatile("" ::: "memory");
}
__device__ __forceinline__ void rmsnorm_rows_bf16(const GAS float* X, const GAS float* g, GAS bf16* O, int gw, int NGW, int lane) {
    f32x4 gv[8];
#pragma unroll
    for (int j = 0; j < 8; ++j) gv[j] = ((const GAS f32x4*)g)[lane + 64 * j];
    for (int m = gw; m < M; m += NGW) {
        const GAS f32x4* xr = (const GAS f32x4*)(X + (size_t)m * D) + lane;
        f32x4 v[8]; float s = 0.f;
#pragma unroll
        for (int j = 0; j < 8; ++j) { v[j] = xr[64 * j]; s += (v[j].x * v[j].x + v[j].y * v[j].y) + (v[j].z * v[j].z + v[j].w * v[j].w); }
        const float r = 1.0f / sqrtf(wave_sum(s, lane) * (1.0f / D) + EPS);
        GAS unsigned long long* o8 = (GAS unsigned long long*)(O + (size_t)m * D) + lane;
#pragma unroll
        for (int j = 0; j < 8; ++j) { const f32x4 y = v[j] * r * gv[j]; o8[64 * j] = (unsigned long long)pk2(y.x, y.y) | ((unsigned long long)pk2(y.z, y.w) << 32); }
    }
}
__device__ __forceinline__ void rows_bf16_ss(const GAS float* X, GAS bf16* O, GAS float* ss, int gw, int NGW, int lane) {
    for (int m = gw; m < M; m += NGW) {
        const GAS f32x4* xr = (const GAS f32x4*)(X + (size_t)m * D) + lane;
        f32x4 v[8]; float s = 0.f;
#pragma unroll
        for (int j = 0; j < 8; ++j) { v[j] = xr[64 * j]; s += (v[j].x * v[j].x + v[j].y * v[j].y) + (v[j].z * v[j].z + v[j].w * v[j].w); }
        s = wave_sum(s, lane);
        GAS unsigned long long* o8 = (GAS unsigned long long*)(O + (size_t)m * D) + lane;
#pragma unroll
        for (int j = 0; j < 8; ++j) o8[64 * j] = (unsigned long long)pk2(v[j].x, v[j].y) | ((unsigned long long)pk2(v[j].z, v[j].w) << 32);
        if (lane < 32) ss[(size_t)m * 32 + lane] = lane == 0 ? s : 0.f;
    }
}
__device__ __forceinline__ void final_rows(const GAS bf16* HB, GAS float* OUT, const GAS float* g, const GAS float* ss, int gw, int NGW, int lane) {
    f32x4 gv[8];
#pragma unroll
    for (int j = 0; j < 8; ++j) gv[j] = ((const GAS f32x4*)g)[lane + 64 * j];
    for (int m = gw; m < M; m += NGW) {
        const GAS unsigned long long* hr = (const GAS unsigned long long*)(HB + (size_t)m * D) + lane; GAS f32x4* orow = (GAS f32x4*)(OUT + (size_t)m * D) + lane;
        unsigned long long raw[8];
#pragma unroll
        for (int j = 0; j < 8; ++j) raw[j] = hr[64 * j];
        const float r = 1.0f / sqrtf(wave_sum(lane < 32 ? ss[(size_t)m * 32 + lane] : 0.f, lane) * (1.0f / D) + EPS);
#pragma unroll
        for (int j = 0; j < 8; ++j) { const unsigned lo = (unsigned)raw[j], hi = (unsigned)(raw[j] >> 32);
            f32x4 v = {__builtin_bit_cast(float, lo << 16), __builtin_bit_cast(float, lo & 0xffff0000u), __builtin_bit_cast(float, hi << 16), __builtin_bit_cast(float, hi & 0xffff0000u)};
            orow[64 * j] = v * r * gv[j]; }
    }
}
__device__ __forceinline__ void rmsnorm_rows_f32_inplace(GAS float* X, const GAS float* g, int gw, int NGW, int lane) {
    f32x4 gv[8];
#pragma unroll
    for (int j = 0; j < 8; ++j) gv[j] = ((const GAS f32x4*)g)[lane + 64 * j];
    for (int m = gw; m < M; m += NGW) {
        GAS f32x4* xr = (GAS f32x4*)(X + (size_t)m * D) + lane;
        f32x4 v[8]; float s = 0.f;
#pragma unroll
        for (int j = 0; j < 8; ++j) { v[j] = xr[64 * j]; s += (v[j].x * v[j].x + v[j].y * v[j].y) + (v[j].z * v[j].z + v[j].w * v[j].w); }
        const float r = 1.0f / sqrtf(wave_sum(s, lane) * (1.0f / D) + EPS);
#pragma unroll
        for (int j = 0; j < 8; ++j) xr[64 * j] = v[j] * r * gv[j];
    }
}

template <bool P_IFAST>
__device__ __forceinline__ void absorb_unit(const GAS float* Psrc, size_t p_ri, size_t p_rd, const GAS float* Qsrc, size_t q_rj, GAS bf16* out, size_t out_ld, float scale, const GAS float* qgain, LAS float* Ps, LAS float* Qs, int tid) {
#pragma unroll 4
    for (int j = 0; j < 16; ++j) { const int e = tid + 512 * j; const int i = P_IFAST ? (e & 63) : (e >> 7), d = P_IFAST ? (e >> 6) : (e & 127);
        Ps[i * 129 + d] = Psrc[(size_t)i * p_ri + (size_t)d * p_rd];
        const int jj = e >> 7, dd = e & 127; Qs[jj * 129 + dd] = Qsrc[(size_t)jj * q_rj + dd] * (qgain ? qgain[jj] : 1.0f); }
    __syncthreads();
    const int ty = tid >> 6, tx = tid & 63; float acc[8];
#pragma unroll
    for (int i = 0; i < 8; ++i) acc[i] = 0.f;
#pragma unroll 4
    for (int d = 0; d < 128; ++d) { const float q = Qs[tx * 129 + d];
#pragma unroll
        for (int i = 0; i < 8; ++i) acc[i] = fmaf(Ps[(ty * 8 + i) * 129 + d], q, acc[i]); }
#pragma unroll
    for (int i = 0; i < 8; ++i) out[(size_t)(ty * 8 + i) * out_ld + tx] = (bf16)f2bf(acc[i] * scale);
    __syncthreads();
}
__device__ __forceinline__ void post_rows(const GAS bf16* Z, const GAS float* gkv, const GAS float* gki, const GAS float* bki, GAS bf16* CKVN, GAS bf16* KIN, GAS float* WIF, int gw, int NGW, int lane) {
    const f32x4 g4 = ((const GAS f32x4*)gkv)[lane]; const float gk = gki[lane], bk = bki[lane];
    for (int m = gw; m < M; m += NGW) {
        const GAS bf16* zr = Z + (size_t)m * ZLD;
        const unsigned long long raw = *(const GAS unsigned long long*)(zr + ZC_CKV + 4 * lane);
        const float kraw = bf2f(zr[ZC_KI + lane]);
        const float wraw = bf2f(zr[ZC_WI + (lane & 7)]);
        const float c0 = bf2f((unsigned short)raw), c1 = bf2f((unsigned short)(raw >> 16)), c2 = bf2f((unsigned short)(raw >> 32)), c3 = bf2f((unsigned short)(raw >> 48));
        const float r = 1.0f / sqrtf(wave_sum((c0 * c0 + c1 * c1) + (c2 * c2 + c3 * c3), lane) * (1.0f / RANK) + EPS);
        *(GAS unsigned long long*)(CKVN + (size_t)m * RANK + 4 * lane) = (unsigned long long)pk2(c0 * r * g4.x, c1 * r * g4.y) | ((unsigned long long)pk2(c2 * r * g4.z, c3 * r * g4.w) << 32);
        const float mu = wave_sum(kraw, lane) * (1.0f / IDIM); const float dv = kraw - mu;
        const float var = wave_sum(dv * dv, lane) * (1.0f / IDIM);
        KIN[(size_t)m * IDIM + lane] = (bf16)f2bf(dv * (1.0f / sqrtf(var + EPS)) * gk + bk);
        if (lane < 8) WIF[(size_t)m * IH + lane] = wraw;
    }
}
constexpr int SWA_KP = 144, SWA_VP = 192;
constexpr int SWA_K_OFF = 0, SWA_V_OFF = 160 * SWA_KP, SWA_TAB_OFF = SWA_V_OFF + 160 * SWA_VP;
static_assert(SWA_TAB_OFF + 16 * 128 * 4 <= RING_BYTES, "SWA LDS map");
__device__ __forceinline__ void swa_phase(LAS unsigned char* lds, const GAS bf16* Z, GAS bf16* O, const GAS float* rel_bias, const GAS float* sinks, int vcu, int G, int tid, int lane, int wave) {
    LAS float* tab = (LAS float*)(lds + SWA_TAB_OFF);
    for (int e = tid; e < 16 * 128; e += NWAVES * 64) { const int h = e >> 7, dist = e & 127; tab[e] = rel_bias[(int)T5_BUCKET[dist] * 24 + H_A + h]; }
    __syncthreads();
    const int q = lane & 31, hh = lane >> 5;
    const unsigned ldsb = (unsigned)(size_t)lds;
    for (int item = vcu; item < BATCH * 128 * KVH; item += G) {
        const int kvh = item & 1, qt = (item >> 1) & 127, b = item >> 8;
        const int t0 = 32 * qt, s0 = t0 - 128;
        const size_t rowbase = (size_t)b * SEQ;
        for (int c = tid; c < 1280; c += NWAVES * 64) { const int row = c >> 3, ch = c & 7; const int s = s0 + row;
            if (s >= 0) { const GAS bf16* zr = Z + (rowbase + s) * ZLD + kvh * 64 + ch * 8;
                const v4u kv = *(const GAS v4u*)(zr + ZC_KB); const v4u vv = *(const GAS v4u*)(zr + ZC_VB);
                *(LAS v4u*)(lds + SWA_K_OFF + row * SWA_KP + ch * 16) = kv; *(LAS v4u*)(lds + SWA_V_OFF + row * SWA_VP + ch * 16) = vv; } }
        const int hq = kvh * 8 + wave; const int t = t0 + q;
        bf16x8 qf[4];
#pragma unroll
        for (int st = 0; st < 4; ++st) qf[st] = *(const GAS bf16x8*)(Z + (rowbase + t) * ZLD + ZC_QB + hq * 64 + 16 * st + 8 * hh);
        __syncthreads();
        const int kt0 = qt >= 4 ? 0 : 4 - qt;
        f32x16 sacc[5];
#pragma unroll
        for (int kt = 0; kt < 5; ++kt) {
#pragma unroll
            for (int r = 0; r < 16; ++r) sacc[kt][r] = 0.f;
            if (kt >= kt0) {
#pragma unroll
                for (int st = 0; st < 4; ++st) { const bf16x8 kf = *(const LAS bf16x8*)(lds + SWA_K_OFF + (kt * 32 + q) * SWA_KP + (2 * st + hh) * 16);
                    sacc[kt] = __builtin_amdgcn_mfma_f32_32x32x16_bf16(kf, qf[st], sacc[kt], 0, 0, 0); } } }
        const float sink = sinks[hq]; float mx = sink;
        const LAS float* tabh = tab + hq * 128;
#pragma unroll
        for (int kt = 0; kt < 5; ++kt) if (kt >= kt0) {
#pragma unroll
            for (int r = 0; r < 16; ++r) { const int ko = (r & 3) + 8 * (r >> 2) + 4 * hh; const int dist = q + 128 - 32 * kt - ko;
                const float lg = (dist >= 0 && dist < WINDOW) ? sacc[kt][r] + tabh[dist & 127] : -1e30f; sacc[kt][r] = lg; mx = fmaxf(mx, lg); } }
        mx = fmaxf(mx, SHX(mx, 32));
        float l = 0.f;
#pragma unroll
        for (int kt = 0; kt < 5; ++kt) if (kt >= kt0) {
#pragma unroll
            for (int r = 0; r < 16; ++r) { const float p = __expf(sacc[kt][r] - mx); sacc[kt][r] = p; l += p; } }
        l += SHX(l, 32); l += __expf(sink - mx);
        f32x16 oacc[2];
#pragma unroll
        for (int dt = 0; dt < 2; ++dt)
#pragma unroll
            for (int r = 0; r < 16; ++r) oacc[dt][r] = 0.f;
        const unsigned vlane = ldsb + SWA_V_OFF + (unsigned)((4 * hh + ((lane & 15) >> 2)) * SWA_VP + (16 * ((lane >> 4) & 1) + 4 * (lane & 3)) * 2);
#pragma unroll
        for (int kt = 0; kt < 5; ++kt) if (kt >= kt0) {
#pragma unroll
            for (int s2 = 0; s2 < 2; ++s2) {
                bf16x8 pf; { const unsigned w0 = pg8::cvt_pk_bf16(sacc[kt][8 * s2 + 0], sacc[kt][8 * s2 + 1]), w1 = pg8::cvt_pk_bf16(sacc[kt][8 * s2 + 2], sacc[kt][8 * s2 + 3]),
                                     w2 = pg8::cvt_pk_bf16(sacc[kt][8 * s2 + 4], sacc[kt][8 * s2 + 5]), w3 = pg8::cvt_pk_bf16(sacc[kt][8 * s2 + 6], sacc[kt][8 * s2 + 7]);
                    const v4u w = {w0, w1, w2, w3}; pf = __builtin_bit_cast(bf16x8, w); }
                const unsigned a = vlane + (unsigned)((kt * 32 + 16 * s2) * SWA_VP);
                s16x4 r0, r1, r2, r3; tr_read4(a, a + 8 * SWA_VP, a + 64, a + 8 * SWA_VP + 64, r0, r1, r2, r3);
                oacc[0] = __builtin_amdgcn_mfma_f32_32x32x16_bf16(cat4(r0, r1), pf, oacc[0], 0, 0, 0);
                oacc[1] = __builtin_amdgcn_mfma_f32_32x32x16_bf16(cat4(r2, r3), pf, oacc[1], 0, 0, 0); } }
        const float inv = 1.0f / l;
        GAS bf16* orow = O + (rowbase + t) * OLD + 2048 + hq * 64 + 4 * hh;
#pragma unroll
        for (int dt = 0; dt < 2; ++dt)
#pragma unroll
            for (int g4 = 0; g4 < 4; ++g4) { const unsigned long long w = (unsigned long long)pk2(oacc[dt][4 * g4] * inv, oacc[dt][4 * g4 + 1] * inv) | ((unsigned long long)pk2(oacc[dt][4 * g4 + 2] * inv, oacc[dt][4 * g4 + 3] * inv) << 32);
                *(GAS unsigned long long*)(orow + 32 * dt + 8 * g4) = w; }
        __syncthreads();
    }
}
constexpr int TK_BINS = 512, TK_CAP = 128;
#define LDS_ADD(p) __hip_atomic_fetch_add((p), 1u, __ATOMIC_RELAXED, __HIP_MEMORY_SCOPE_WORKGROUP)
constexpr int TK_HIST_OFF = 0, TK_CSC_OFF = 65536, TK_CIX_OFF = TK_CSC_OFF + 32 * TK_CAP * 4, TK_SEL_OFF = TK_CIX_OFF + 32 * TK_CAP * 2, TK_CNT_OFF = TK_SEL_OFF + 32 * 256 * 2, TK_DUM_OFF = TK_CNT_OFF + 32 * 2 * 4, TK_KB_OFF = TK_DUM_OFF + 8 * 64 * 4, TK_KB_BYTES = 64 * 144, TK_FLAG_OFF = TK_KB_OFF + 2 * TK_KB_BYTES;
static_assert(TK_FLAG_OFF + 16 <= RING_BYTES, "top-k LDS map");
__device__ __forceinline__ float tk_relu(float x) { const int b = __builtin_bit_cast(int, x); return __builtin_bit_cast(float, b < 0 ? 0 : b); }
__device__ __forceinline__ float tk_score(const f32x16& acc, int a, const float (&w)[8]) {
    float s = w[0] * tk_relu(acc[8 * a + 0]);
#pragma unroll
    for (int h = 1; h < 8; ++h) s = fmaf(w[h], tk_relu(acc[8 * a + h]), s);
    return s;
}
__device__ __forceinline__ float tk_x(float s, float sc) { return fmaf(s, sc, 256.0f); }
__device__ __forceinline__ int tk_key(float s, float sc) {
    const float x = tk_x(s, sc); int b0 = (int)x; b0 = b0 < 0 ? 0 : (b0 > TK_BINS - 1 ? TK_BINS - 1 : b0);
    int sub = (int)((x - (float)b0) * 512.0f); sub = sub < 0 ? 0 : (sub > 511 ? 511 : sub);
    return b0 * 512 + sub;
}
__device__ __forceinline__ void tk_find(const LAS unsigned* h, unsigned need, int lane, int& bin_out, unsigned& above_out) {
    unsigned v[8]; unsigned s = 0;
#pragma unroll
    for (int i = 0; i < 8; ++i) { v[i] = h[8 * lane + i]; s += v[i]; }
    unsigned S = s;
#pragma unroll
    for (int o = 1; o < 64; o <<= 1) { const unsigned t = (unsigned)__builtin_amdgcn_ds_bpermute((lane + o) << 2, (int)S); if (lane + o < 64) S += t; }
    const unsigned long long mask = __ballot(S >= need);
    const int Lm = mask ? 63 - __builtin_clzll(mask) : 0;
    unsigned cum = S - s; int bsel = 8 * lane; unsigned ab = cum; bool found = false;
#pragma unroll
    for (int i = 7; i >= 0; --i) { if (!found) { if (cum + v[i] >= need) { bsel = 8 * lane + i; ab = cum; found = true; } else cum += v[i]; } }
    bin_out = __builtin_amdgcn_readlane(bsel, Lm); above_out = (unsigned)__builtin_amdgcn_readlane((int)ab, Lm);
}
__device__ __forceinline__ void topk_phase(LAS unsigned char* lds, const GAS bf16* Z, const GAS bf16* KIN, const GAS float* WIF, GAS unsigned short* IDX, int vcu, int G, int lane, int wave) {
    LAS unsigned* hist = (LAS unsigned*)(lds + TK_HIST_OFF) + wave * 4 * TK_BINS;
    LAS float* csc = (LAS float*)(lds + TK_CSC_OFF) + wave * 4 * TK_CAP;
    LAS unsigned short* cix = (LAS unsigned short*)(lds + TK_CIX_OFF) + wave * 4 * TK_CAP;
    LAS unsigned short* sel = (LAS unsigned short*)(lds + TK_SEL_OFF) + wave * 4 * 256;
    LAS unsigned* cnt = (LAS unsigned*)(lds + TK_CNT_OFF) + wave * 8;
    LAS unsigned* dum = (LAS unsigned*)(lds + TK_DUM_OFF) + wave * 64 + lane;
    const int n = lane & 31, c = lane >> 5;
    const int am = (lane >> 4) & 1, bbm = (lane >> 3) & 1, ccm = (lane >> 2) & 1, dm = lane & 3;
    for (int p2 = vcu; p2 < BATCH * 64; p2 += G) {
#pragma unroll 1
        for (int half = 0; half < 2; ++half) {
            const int b = p2 >> 6, jj = p2 & 63, j = half ? 127 - jj : jj;
            const int t0 = 32 * j + 4 * wave; const size_t rb = (size_t)b * SEQ;
            bf16x8 qa[4];
#pragma unroll
            for (int st = 0; st < 4; ++st) qa[st] = *(const GAS bf16x8*)(Z + (rb + t0 + 2 * ccm + am) * ZLD + ZC_QI + (4 * bbm + dm) * 64 + 16 * st + 8 * c);
            float w0[8], w1[8];
            { const GAS f32x4* wp = (const GAS f32x4*)(WIF + (rb + t0 + 2 * c) * IH); const f32x4 x0 = wp[0], x1 = wp[1], x2 = wp[2], x3 = wp[3];
              w0[0] = x0.x; w0[1] = x0.y; w0[2] = x0.z; w0[3] = x0.w; w0[4] = x1.x; w0[5] = x1.y; w0[6] = x1.z; w0[7] = x1.w;
              w1[0] = x2.x; w1[1] = x2.y; w1[2] = x2.z; w1[3] = x2.w; w1[4] = x3.x; w1[5] = x3.y; w1[6] = x3.z; w1[7] = x3.w; }
            float scA, scB;
            { float a = 0.f, bq = 0.f;
#pragma unroll
              for (int h = 0; h < 8; ++h) { a = fmaf(w0[h], w0[h], a); bq = fmaf(w1[h], w1[h], bq); }
              scA = 32.0f / fmaxf(sqrtf(32.0f * a), 1e-20f); scB = 32.0f / fmaxf(sqrtf(32.0f * bq), 1e-20f); }
            const int tA = t0 + 2 * c, tB = tA + 1;
            for (int i = lane; i < 4 * TK_BINS; i += 64) hist[i] = 0u;
            for (int i = lane; i < 4 * 128; i += 64) ((LAS unsigned*)sel)[i] = 0u;
            if (lane < 8) cnt[lane] = 0u;
            asm volatile("s_waitcnt lgkmcnt(0)" ::: "memory");
            int lo[4], hi[4]; unsigned ab0[4]; bool ov[4];
#pragma unroll
            for (int tk = 0; tk < 4; ++tk) { lo[tk] = 0x7fffffff; hi[tk] = -1; ab0[tk] = 0u; ov[tk] = false; }
            const bool need_sel = (t0 + 3) >= TOPK;
            const GAS bf16* kbase = KIN + (rb + n) * IDIM + 8 * c;
            const int tidk = wave * 64 + lane; const int ng = (j + 2) >> 1;
            const GAS bf16* kg0 = KIN + (rb + (tidk >> 3)) * IDIM + (tidk & 7) * 8; const int koff = (tidk >> 3) * 144 + (tidk & 7) * 16;
            LAS unsigned char* kbuf = lds + TK_KB_OFF; volatile LAS unsigned* sflag = (volatile LAS unsigned*)(lds + TK_FLAG_OFF);
            if (tidk == 0) *sflag = 0u;
#define TK_PRIME() { const v4u kr0 = *(const GAS v4u*)kg0; *(LAS v4u*)(kbuf + koff) = kr0; } __syncthreads();
#define TK_GROUP_BEGIN() \
                v4u kr = {0u, 0u, 0u, 0u}; const bool more = g + 1 < ng; if (more) kr = *(const GAS v4u*)(kg0 + (size_t)(g + 1) * 64 * IDIM); \
                const LAS unsigned char* kb_ = kbuf + (g & 1) * TK_KB_BYTES; \
                _Pragma("unroll") for (int u4 = 0; u4 < 2; ++u4) { \
                    f32x16 acc; _Pragma("unroll") for (int r = 0; r < 16; ++r) acc[r] = 0.f; \
                    _Pragma("unroll") for (int st = 0; st < 4; ++st) { const bf16x8 kf = *(const LAS bf16x8*)(kb_ + (32 * u4 + n) * 144 + (2 * st + c) * 16); acc = __builtin_amdgcn_mfma_f32_32x32x16_bf16(qa[st], kf, acc, 0, 0, 0); } \
                    const float s0 = tk_score(acc, 0, w0), s1 = tk_score(acc, 1, w1); const int s = 32 * (2 * g + u4) + n;
#define TK_GROUP_END() } \
                if (more) *(LAS v4u*)(kbuf + ((g + 1) & 1) * TK_KB_BYTES + koff) = kr; \
                __syncthreads();
            bool slow = false;
            if (need_sel) {
                {   TK_PRIME();
#pragma unroll 1
                    for (int g = 0; g < ng; ++g) { TK_GROUP_BEGIN()
                        int b0 = (int)tk_x(s0, scA), b1 = (int)tk_x(s1, scB); b0 = b0 < 0 ? 0 : (b0 > TK_BINS - 1 ? TK_BINS - 1 : b0); b1 = b1 < 0 ? 0 : (b1 > TK_BINS - 1 ? TK_BINS - 1 : b1);
                        LAS unsigned* p0 = (s <= tA) ? &hist[(2 * c) * TK_BINS + b0] : dum; LAS unsigned* p1 = (s <= tB) ? &hist[(2 * c + 1) * TK_BINS + b1] : dum;
                        LDS_ADD(p0); LDS_ADD(p1);
                        TK_GROUP_END() }
                }
                asm volatile("s_waitcnt lgkmcnt(0)" ::: "memory");
#pragma unroll
                for (int tk = 0; tk < 4; ++tk) { int bin; unsigned above; tk_find(hist + tk * TK_BINS, (unsigned)TOPK, lane, bin, above);
                    const unsigned ceq = hist[tk * TK_BINS + bin]; ov[tk] = ceq > (unsigned)TK_CAP; slow |= ov[tk]; ab0[tk] = above; lo[tk] = bin * 512; hi[tk] = bin * 512 + 511; }
                if (slow && lane == 0) *sflag = 1u;
                __syncthreads();
                slow = *sflag != 0u;
            }
            if (!slow) {
                float thi[4], tlo[4];
#pragma unroll
                for (int tk = 0; tk < 4; ++tk) { const int bin = lo[tk] >> 9;
                    thi[tk] = !need_sel ? -__builtin_inff() : (bin >= TK_BINS - 1 ? __builtin_inff() : (float)(bin + 1));
                    tlo[tk] = !need_sel ? __builtin_inff() : (bin == 0 ? -__builtin_inff() : (float)bin); }
                const float thiA = c ? thi[2] : thi[0], tloA = c ? tlo[2] : tlo[0], thiB = c ? thi[3] : thi[1], tloB = c ? tlo[3] : tlo[1];
                unsigned cntA = 0u, cntB = 0u;
                LAS unsigned short* selA = sel + (2 * c) * 256; LAS unsigned short* selB = sel + (2 * c + 1) * 256; LAS unsigned short* dum16 = (LAS unsigned short*)dum;
                TK_PRIME();
#pragma unroll 1
                for (int g = 0; g < ng; ++g) { TK_GROUP_BEGIN()
                    const float x0 = (s <= tA) ? tk_x(s0, scA) : __builtin_nanf(""), x1 = (s <= tB) ? tk_x(s1, scB) : __builtin_nanf("");
                    const bool a0 = x0 >= thiA, a1 = x1 >= thiB; const bool c0 = !a0 && x0 >= tloA, c1 = !a1 && x1 >= tloB;
                    const unsigned long long m0 = __ballot(a0), m1 = __ballot(a1);
                    const unsigned pre0 = c ? __builtin_amdgcn_mbcnt_hi((unsigned)(m0 >> 32), 0u) : __builtin_amdgcn_mbcnt_lo((unsigned)m0, 0u);
                    const unsigned pre1 = c ? __builtin_amdgcn_mbcnt_hi((unsigned)(m1 >> 32), 0u) : __builtin_amdgcn_mbcnt_lo((unsigned)m1, 0u);
                    const unsigned pos0 = cntA + pre0, pos1 = cntB + pre1;
                    LAS unsigned short* q0 = (a0 && pos0 < 256u) ? selA + pos0 : dum16; LAS unsigned short* q1 = (a1 && pos1 < 256u) ? selB + pos1 : dum16;
                    *q0 = (unsigned short)s; *q1 = (unsigned short)s;
                    cntA += c ? (unsigned)__builtin_popcount((unsigned)(m0 >> 32)) : (unsigned)__builtin_popcount((unsigned)m0);
                    cntB += c ? (unsigned)__builtin_popcount((unsigned)(m1 >> 32)) : (unsigned)__builtin_popcount((unsigned)m1);
                    if (__ballot(c0 || c1)) {
                        if (c0) { const unsigned pos = LDS_ADD(&cnt[(2 * c) * 2 + 1]); if (pos < (unsigned)TK_CAP) { csc[(2 * c) * TK_CAP + pos] = s0; cix[(2 * c) * TK_CAP + pos] = (unsigned short)s; } }
                        if (c1) { const unsigned pos = LDS_ADD(&cnt[(2 * c + 1) * 2 + 1]); if (pos < (unsigned)TK_CAP) { csc[(2 * c + 1) * TK_CAP + pos] = s1; cix[(2 * c + 1) * TK_CAP + pos] = (unsigned short)s; } } }
                    TK_GROUP_END() }
                if ((lane & 31) == 0) { cnt[(2 * c) * 2] = cntA; cnt[(2 * c + 1) * 2] = cntB; }
                asm volatile("s_waitcnt lgkmcnt(0)" ::: "memory");
            } else {
                for (int i = lane; i < 4 * TK_BINS; i += 64) hist[i] = 0u;
                asm volatile("s_waitcnt lgkmcnt(0)" ::: "memory");
                int mode = 1;
#pragma unroll 1
                for (;;) {
                const int klo0 = c ? lo[2] : lo[0], khi0 = c ? hi[2] : hi[0], klo1 = c ? lo[3] : lo[1], khi1 = c ? hi[3] : hi[1];
                const bool ov0 = c ? ov[2] : ov[0], ov1 = c ? ov[3] : ov[1];
                bf16x8 kb[4][4];
#pragma unroll
                for (int u4 = 0; u4 < 4; ++u4) { const int kq = u4 < j ? u4 : j;
#pragma unroll
                    for (int st = 0; st < 4; ++st) kb[u4][st] = *(const GAS bf16x8*)(kbase + (size_t)kq * 32 * IDIM + 16 * st); }
#pragma unroll 1
                for (int kt = 0; kt <= j; kt += 4) {
                    bf16x8 kn[4][4];
#pragma unroll
                    for (int u4 = 0; u4 < 4; ++u4) { const int kq = kt + 4 + u4 < j ? kt + 4 + u4 : j;
#pragma unroll
                        for (int st = 0; st < 4; ++st) kn[u4][st] = *(const GAS bf16x8*)(kbase + (size_t)kq * 32 * IDIM + 16 * st); }
#pragma unroll
                    for (int u4 = 0; u4 < 4; ++u4) {
                        f32x16 acc;
#pragma unroll
                        for (int r = 0; r < 16; ++r) acc[r] = 0.f;
#pragma unroll
                        for (int st = 0; st < 4; ++st) acc = __builtin_amdgcn_mfma_f32_32x32x16_bf16(qa[st], kb[u4][st], acc, 0, 0, 0);
                        const float s0 = tk_score(acc, 0, w0), s1 = tk_score(acc, 1, w1);
                        const int s = 32 * (kt + u4) + n; const int k0 = tk_key(s0, scA), k1 = tk_key(s1, scB);
                        const bool v0 = s <= tA, v1 = s <= tB;
                        if (mode == 0) {
                            if (v0 && tA >= TOPK) LDS_ADD(&hist[(2 * c) * TK_BINS + (k0 >> 9)]);
                            if (v1 && tB >= TOPK) LDS_ADD(&hist[(2 * c + 1) * TK_BINS + (k1 >> 9)]);
                        } else if (mode == 1) {
                            if (v0 && ov0 && k0 >= klo0 && k0 <= khi0) LDS_ADD(&hist[(2 * c) * TK_BINS + (k0 & 511)]);
                            if (v1 && ov1 && k1 >= klo1 && k1 <= khi1) LDS_ADD(&hist[(2 * c + 1) * TK_BINS + (k1 & 511)]);
                        } else {
                            if (v0) { if (k0 > khi0) { const unsigned pos = LDS_ADD(&cnt[(2 * c) * 2]); if (pos < 256u) sel[(2 * c) * 256 + pos] = (unsigned short)s; }
                                      else if (k0 >= klo0) { const unsigned pos = LDS_ADD(&cnt[(2 * c) * 2 + 1]); if (pos < (unsigned)TK_CAP) { csc[(2 * c) * TK_CAP + pos] = s0; cix[(2 * c) * TK_CAP + pos] = (unsigned short)s; } } }
                            if (v1) { if (k1 > khi1) { const unsigned pos = LDS_ADD(&cnt[(2 * c + 1) * 2]); if (pos < 256u) sel[(2 * c + 1) * 256 + pos] = (unsigned short)s; }
                                      else if (k1 >= klo1) { const unsigned pos = LDS_ADD(&cnt[(2 * c + 1) * 2 + 1]); if (pos < (unsigned)TK_CAP) { csc[(2 * c + 1) * TK_CAP + pos] = s1; cix[(2 * c + 1) * TK_CAP + pos] = (unsigned short)s; } } }
                        }
                    }
#pragma unroll
                    for (int u4 = 0; u4 < 4; ++u4)
#pragma unroll
                        for (int st = 0; st < 4; ++st) kb[u4][st] = kn[u4][st];
                }
                    asm volatile("s_waitcnt lgkmcnt(0)" ::: "memory");
                    if (mode == 2) break;
#pragma unroll
                    for (int tk = 0; tk < 4; ++tk) if (ov[tk]) { int sub; unsigned above; tk_find(hist + tk * TK_BINS, (unsigned)TOPK - ab0[tk], lane, sub, above); lo[tk] += sub; hi[tk] = lo[tk]; }
                    mode = 2;
                }
            }
#undef TK_GROUP_BEGIN
#undef TK_GROUP_END
#undef TK_PRIME
#pragma unroll 1
            for (int tk = 0; tk < 4; ++tk) { const int t = t0 + tk;
                if (t >= TOPK) { const unsigned nsel = cnt[tk * 2]; unsigned nc = cnt[tk * 2 + 1]; nc = nc > (unsigned)TK_CAP ? (unsigned)TK_CAP : nc; const unsigned need = nsel < 256u ? 256u - nsel : 0u;
                    for (unsigned q = 0; q < 2; ++q) { const unsigned i = lane + 64 * q;
                        const float si = i < nc ? csc[tk * TK_CAP + i] : 0.f; const unsigned xi = i < nc ? cix[tk * TK_CAP + i] : 0u; unsigned rank = 0;
                        for (unsigned jx = 0; jx < nc; ++jx) { const float sj = csc[tk * TK_CAP + jx]; const unsigned xj = cix[tk * TK_CAP + jx]; rank += (sj > si || (sj == si && xj < xi)) ? 1u : 0u; }
                        if (i < nc && rank < need) sel[tk * 256 + nsel + rank] = (unsigned short)xi; } } }
            asm volatile("s_waitcnt lgkmcnt(0)" ::: "memory");
            { const LAS v4u* sv = (const LAS v4u*)sel; GAS v4u* ov = (GAS v4u*)(IDX + (rb + t0) * TOPK);
              ov[lane] = sv[lane]; ov[lane + 64] = sv[lane + 64]; }
            asm volatile("s_waitcnt vmcnt(0) lgkmcnt(0)" ::: "memory");
        }
    }
}
constexpr int DSA_TAB_OFF = RING_BYTES + 1024;
static_assert(DSA_TAB_OFF + 8 * 129 * 4 <= LDS_BYTES, "DSA LDS map");
__device__ __forceinline__ void dsa_phase(LAS unsigned char* lds_all, const GAS bf16* Z, const GAS bf16* CKVN, const GAS unsigned short* IDX, GAS bf16* O, const GAS float* rel_bias, int gw, int NGW, int tid, int lane, int wave) {
    LAS float* tab = (LAS float*)(lds_all + DSA_TAB_OFF);
    for (int e = tid; e < 8 * 129; e += NWAVES * 64) { const int hh = e / 129, dist = e - hh * 129; tab[e] = rel_bias[(dist < 128 ? (int)T5_BUCKET[dist] : 31) * 24 + hh]; }
    __syncthreads();
    LAS unsigned char* img = lds_all + RING_OFF + wave * 16384;
    const unsigned imgb = (unsigned)(size_t)img;
    const int h = lane & 15, g = lane >> 4;
    const LAS float* tabh = tab + (h & 7) * 129;
    const int TPW = (M + NGW - 1) / NGW;
    const int tok_end = (gw + 1) * TPW < M ? (gw + 1) * TPW : M;
    const int xq = 2 * (lane & 7);
    const int qk_off = (lane & 15) * 512;
    const int q4 = (lane & 15) >> 2, p4 = lane & 3; const int xr = 2 * (4 * (g & 1) + q4);
    const unsigned pv_base = imgb + (unsigned)((4 * g + q4) * 512 + 8 * (p4 & 1));
#pragma unroll 1
    for (int tok = gw * TPW; tok < tok_end; ++tok) {
        const int t = tok & (SEQ - 1); const size_t rb = (size_t)(tok - t);
        const int nsel = t + 1 < TOPK ? t + 1 : TOPK;
        bf16x8 qf[8];
#pragma unroll
        for (int st = 0; st < 8; ++st) { qf[st] = *(const GAS bf16x8*)(Z + (size_t)tok * ZLD + ZC_QLAT + (h & 7) * 256 + 32 * st + 8 * g); if (h >= 8) qf[st] = (bf16x8){0, 0, 0, 0, 0, 0, 0, 0}; }
        f32x4 oacc[16];
#pragma unroll
        for (int rt = 0; rt < 16; ++rt) oacc[rt] = (f32x4){0.f, 0.f, 0.f, 0.f};
        float mrun = -1e30f, lsum = 0.f;
        const GAS unsigned short* ip = IDX + (size_t)tok * TOPK;
#pragma unroll 1
        for (int ch = 0; ch < 8; ++ch) {
            if (32 * ch >= nsel) break;
            const int ixv = (int)ip[32 * ch + (lane & 31)];
            const unsigned long long i0 = *(const GAS unsigned long long*)(ip + 32 * ch + 4 * g), i1 = *(const GAS unsigned long long*)(ip + 32 * ch + 16 + 4 * g);
            asm volatile("s_waitcnt lgkmcnt(0)" ::: "memory");
#pragma unroll
            for (int i = 0; i < 16; ++i) { const int r0 = __builtin_amdgcn_readlane(ixv, 2 * i), r1 = __builtin_amdgcn_readlane(ixv, 2 * i + 1);
                const int row = 2 * i + (lane >> 5); const int ridx = lane < 32 ? r0 : r1; const int chunk = (lane & 31) ^ (2 * (row & 7));
                const GAS unsigned char* src = (const GAS unsigned char*)(CKVN + (rb + ridx) * RANK) + chunk * 16;
                __builtin_amdgcn_global_load_lds((const GAS unsigned*)src, (LAS unsigned*)(img + i * 1024), 16, 0, 0); }
            asm volatile("s_waitcnt vmcnt(0)" ::: "memory");
            f32x4 sa[2];
#pragma unroll
            for (int tl = 0; tl < 2; ++tl) { sa[tl] = (f32x4){0.f, 0.f, 0.f, 0.f};
#pragma unroll
                for (int st = 0; st < 8; ++st) { const bf16x8 a = *(const LAS bf16x8*)(img + qk_off + tl * 16 * 512 + (((4 * st + g) ^ xq) * 16));
                    sa[tl] = __builtin_amdgcn_mfma_f32_16x16x32_bf16(a, qf[st], sa[tl], 0, 0, 0); } }
            float lg[8]; float cmax = -1e30f;
#pragma unroll
            for (int e = 0; e < 8; ++e) { const int tl = e >> 2, jx = e & 3; const int kk = 32 * ch + 16 * tl + 4 * g + jx;
                const int sidx = (int)(((tl ? i1 : i0) >> (16 * jx)) & 0xffffull); int dd = t - sidx; dd = dd < 0 ? 0 : (dd > 128 ? 128 : dd);
                const float v = kk < nsel ? sa[tl][jx] + tabh[dd] : -1e30f; lg[e] = v; cmax = fmaxf(cmax, v); }
            cmax = fmaxf(cmax, SHX(cmax, 16)); cmax = fmaxf(cmax, SHX(cmax, 32));
            const float mnew = fmaxf(mrun, cmax);
            if (__any(mnew > mrun)) { const float alpha = __expf(mrun - mnew); lsum *= alpha;
#pragma unroll
                for (int rt = 0; rt < 16; ++rt) oacc[rt] = oacc[rt] * alpha; }
            mrun = mnew;
            float pe[8];
#pragma unroll
            for (int e = 0; e < 8; ++e) { pe[e] = __expf(lg[e] - mnew); lsum += pe[e]; }
            bf16x8 pf; { const v4u wv = {pg8::cvt_pk_bf16(pe[0], pe[1]), pg8::cvt_pk_bf16(pe[2], pe[3]), pg8::cvt_pk_bf16(pe[4], pe[5]), pg8::cvt_pk_bf16(pe[6], pe[7])}; pf = __builtin_bit_cast(bf16x8, wv); }
#pragma unroll
            for (int rt = 0; rt < 16; rt += 2) {
                const unsigned a0 = pv_base + (unsigned)((((2 * rt) ^ xr) | (p4 >> 1)) * 16), a1 = pv_base + (unsigned)((((2 * rt + 2) ^ xr) | (p4 >> 1)) * 16);
                s16x4 r0, r1, r2, r3; tr_read4(a0, a0 + 16 * 512, a1, a1 + 16 * 512, r0, r1, r2, r3);
                oacc[rt] = __builtin_amdgcn_mfma_f32_16x16x32_bf16(cat4(r0, r1), pf, oacc[rt], 0, 0, 0);
                oacc[rt + 1] = __builtin_amdgcn_mfma_f32_16x16x32_bf16(cat4(r2, r3), pf, oacc[rt + 1], 0, 0, 0); }
        }
        lsum += SHX(lsum, 16); lsum += SHX(lsum, 32);
        const float inv = 1.0f / lsum;
        if (h < 8) { GAS bf16* orow = O + (size_t)tok * OLD + h * 256 + 4 * g;
#pragma unroll
            for (int rt = 0; rt < 16; ++rt) *(GAS unsigned long long*)(orow + 16 * rt) = (unsigned long long)pk2(oacc[rt][0] * inv, oacc[rt][1] * inv) | ((unsigned long long)pk2(oacc[rt][2] * inv, oacc[rt][3] * inv) << 32); }
    }
}
struct Args { const float* in[20]; float* out; unsigned char* ws; };
__device__ __forceinline__ unsigned long long karg_u64(int idx) { unsigned long long r; const unsigned off = (unsigned)idx * 8u;
    asm volatile("s_load_dwordx2 %0, %1, %2\n\ts_waitcnt lgkmcnt(0)" : "=s"(r) : "s"(__builtin_amdgcn_kernarg_segment_ptr()), "s"(off) : "memory"); return r; }
__device__ __forceinline__ const GAS float* karg_in(int i) { return (const GAS float*)karg_u64(i); }
__device__ __forceinline__ GAS float* karg_out() { return (GAS float*)karg_u64(20); }
__device__ __forceinline__ GAS unsigned char* karg_ws() { return (GAS unsigned char*)karg_u64(21); }
#ifndef REP_P0
#define REP_P0 1
#endif
#ifndef REP_NORM
#define REP_NORM 1
#endif
#ifndef REP_GU
#define REP_GU 1
#endif
#ifndef REP_IN
#define REP_IN 1
#endif
#ifndef REP_POST
#define REP_POST 1
#endif
#ifndef REP_TOPK
#define REP_TOPK 1
#endif
#ifndef REP_DSA
#define REP_DSA 1
#endif
#define REPEAT(n) _Pragma("unroll 1") for (int rep_ = 0; rep_ < (n); ++rep_)
#define PHASE_IDS() int tid = threadIdx.x; asm volatile("" : "+v"(tid)); int bx = blockIdx.x; asm volatile("" : "+s"(bx)); int G = gridDim.x; asm volatile("" : "+s"(G)); \
    const int lane = tid & 63, wave = __builtin_amdgcn_readfirstlane(tid >> 6); const int vcu = (G % 8 == 0) ? (bx % 8) * (G / 8) + bx / 8 : bx; const int gw = vcu * NWAVES + wave, NGW = G * NWAVES; \
    GAS unsigned char* ws = karg_ws(); (void)lane; (void)gw; (void)NGW; (void)vcu; (void)ws
__global__ void __launch_bounds__(NWAVES * 64, 2) mk_fwd(Args args) {
    extern __shared__ __attribute__((aligned(16))) unsigned char lds_raw[];
    LAS unsigned char* lds = (LAS unsigned char*)lds_raw;
    volatile LAS unsigned* MISC = (volatile LAS unsigned*)(lds + MISC_OFF);
    for (int u = threadIdx.x; u < (LDS_BYTES - LDSCTL_OFF) / 4; u += NWAVES * 64) ((LAS unsigned*)(lds + LDSCTL_OFF))[u] = 0u;
    __syncthreads();
    (void)xcd_barrier_post((unsigned*)((gu32*)(karg_ws() + WS_CTL) + CW_BAR), MISC + 8);
#define GRID_BAR() do { XcdBarrier b_; b_.bar = (unsigned*)((gu32*)(karg_ws() + WS_CTL) + CW_BAR); b_.x = xb_xcc_id(); b_.st = MISC + 8; xcd_barrier(b_); } while (0)

    REPEAT(REP_P0) {   PHASE_IDS();
        LAS float* scr = (LAS float*)(lds + RING_OFF + wave * 16384);
        rows_bf16_ss(karg_in(0), (GAS bf16*)(ws + WS_XN), (GAS float*)(ws + WS_SS), gw, NGW, lane);
        constexpr int I_GU = (D / 64) * (FF / 32), I_DN = (FF / 64) * (D / 32);
        constexpr int I_FFN = 2 * I_GU + I_DN, I_IN = 72 * (D / 64), I_OB = (1024 / 64) * (D / 32);
        constexpr int PER_LAYER = 2 * I_FFN + I_IN + I_OB;
        for (int it = gw; it < DEPTH * PER_LAYER; it += NGW) {
            const int l = it / PER_LAYER; int r = it - l * PER_LAYER;
            GAS unsigned char* wl = ws + WS_W0 + (size_t)l * W_LAYER;
            if (r < 2 * I_FFN) {
                const int f = r / I_FFN; r -= f * I_FFN;
                GAS bf16* dgu = (GAS bf16*)(wl + (f ? WO_GU2 : WO_GU1)); GAS bf16* dd = (GAS bf16*)(wl + (f ? WO_D2 : WO_D1));
                if (r < 2 * I_GU) { const int up = r >= I_GU; if (up) r -= I_GU; const int kb = r / (FF / 32), nb = r % (FF / 32), n0 = 32 * nb;
                    const GAS float* wsrc = karg_in(up ? (f ? 17 : 4) : (f ? 16 : 3)) + (size_t)l * D * FF;
                    conv_item(wsrc, FF, 64 * kb, n0, 32, dgu, D, (n0 >> 7) * 256 + (up ? 128 : 0) + (n0 & 127), 0, 1.0f, karg_in(f ? 15 : 2) + (size_t)l * D, scr, lane); }
                else { r -= 2 * I_GU; const int kb = r / (D / 32), nb = r % (D / 32);
                    conv_item(karg_in(f ? 18 : 5) + (size_t)l * FF * D, D, 64 * kb, 32 * nb, 32, dd, FF, 32 * nb, 0, 1.0f, nullptr, scr, lane); }
            } else if (r < 2 * I_FFN + I_IN) {
                r -= 2 * I_FFN; const int j = r >> 5, kb = r & 31; int src, nvalid = 32; float sc = 1.0f;
                if (j < 8) src = 1024 + 32 * j;
                else if (j < 24) src = 1280 + 32 * (j - 8);
                else if (j < 56) { src = 1864 + 32 * (j - 24); sc = 0.125f; }
                else if (j < 60) src = 2888 + 32 * (j - 56);
                else if (j < 64) src = 3016 + 32 * (j - 60);
                else if (j < 66) src = 1792 + 32 * (j - 64);
                else if (j == 66) { src = 1856; nvalid = 8; sc = 0.044194173824159216f; }
                else { src = 0; nvalid = 0; }
                conv_item(karg_in(7) + (size_t)l * D * D_IN, D_IN, 64 * kb, src, nvalid, (GAS bf16*)(wl + WO_IN), D, 2048 + 32 * j, 0, sc, karg_in(6) + (size_t)l * D, scr, lane);
            } else {
                r -= 2 * I_FFN + I_IN; const int kb = r >> 6, nb = r & 63;
                conv_item(karg_in(14) + (size_t)l * D * D + (size_t)1024 * D, D, 64 * kb, 32 * nb, 32, (GAS bf16*)(wl + WO_OUT), OLD, 32 * nb, 2048, 1.0f, nullptr, scr, lane);
            }
        }
        __syncthreads();
        LAS float* Ps = (LAS float*)(lds + RING_OFF); LAS float* Qs = Ps + 64 * 129;
        for (int u = vcu; u < DEPTH * 2048; u += G) {
            const int l = u >> 11, which = (u >> 10) & 1, v = u & 1023;
            GAS unsigned char* wl = ws + WS_W0 + (size_t)l * W_LAYER;
            if (which == 0) { const int h = v >> 7, rt = (v >> 5) & 3, kt = v & 31;
                absorb_unit<false>(karg_in(11) + (size_t)l * RANK * 1024 + ((size_t)(64 * rt) * 8 + h) * 128, 1024, 1, karg_in(7) + (size_t)l * D * D_IN + (size_t)(64 * kt) * D_IN + h * 128, D_IN,
                                   (GAS bf16*)(wl + WO_IN) + (size_t)(h * 256 + 64 * rt) * D + 64 * kt, D, 0.08838834764831845f, karg_in(6) + (size_t)l * D + 64 * kt, Ps, Qs, tid); }
            else { const int h = v >> 7, nt = (v >> 2) & 31, rt = v & 3;
                absorb_unit<true>(karg_in(14) + (size_t)l * D * D + (size_t)(h * 128) * D + 64 * nt, 1, D, karg_in(12) + (size_t)l * RANK * 1024 + ((size_t)(64 * rt) * 8 + h) * 128, 1024,
                                  (GAS bf16*)(wl + WO_OUT) + (size_t)(64 * nt) * OLD + h * 256 + 64 * rt, OLD, 1.0f, nullptr, Ps, Qs, tid); }
        }
    }
    GRID_BAR();

#pragma unroll 1
    for (int s = 0; s < 2 * DEPTH; ++s) {
        const int l = s >> 1, f = s & 1;
        REPEAT(REP_GU) {   PHASE_IDS(); GAS unsigned char* wl = ws + WS_W0 + (size_t)l * W_LAYER;
            pg8::Gemm g{(const GAS bf16*)(ws + WS_XN), (const GAS bf16*)(wl + (f ? WO_GU2 : WO_GU1)), M, NGU, D}; pg8::StaticOrder S; S.init(M, NGU, G, bx);
            pg8::EpiSwiglu E{(GAS bf16*)(ws + WS_ACT), FF, (const GAS float*)(ws + WS_SS + (size_t)((3 * l + 2 * f) & 1) * SS_BYTES), 1.0f / D, EPS};
            pg8::gemm_phase<pg8::EpiSwiglu, pg8::StaticOrder, true, true>(lds + RING_OFF, g, S, E); }
        GRID_BAR();
        {   PHASE_IDS(); GAS unsigned char* wl = ws + WS_W0 + (size_t)l * W_LAYER;
            pg8::Gemm g{(const GAS bf16*)(ws + WS_ACT), (const GAS bf16*)(wl + (f ? WO_D2 : WO_D1)), M, D, FF}; pg8::StaticOrder S; S.init(M, D, G, bx);
            pg8::EpiResid E{0.5f, (unsigned)WS_XN, (unsigned)(WS_SS + (size_t)((3 * l + 2 * f + 1) & 1) * SS_BYTES)};
            pg8::gemm_phase<pg8::EpiResid, pg8::StaticOrder, true, true>(lds + RING_OFF, g, S, E); }
        GRID_BAR();
        if (f == 0) {
            REPEAT(REP_IN) {   PHASE_IDS(); GAS unsigned char* wl = ws + WS_W0 + (size_t)l * W_LAYER;
                pg8::Gemm g{(const GAS bf16*)(ws + WS_XN), (const GAS bf16*)(wl + WO_IN), M, ZLD, D}; pg8::StaticOrder S; S.init(M, ZLD, G, bx);
                pg8::EpiBf16 E{(GAS bf16*)(ws + WS_Z), ZLD, (const GAS float*)(ws + WS_SS + (size_t)((3 * l + 1) & 1) * SS_BYTES), 1.0f / D, EPS};
                pg8::gemm_phase<pg8::EpiBf16, pg8::StaticOrder, true, true>(lds + RING_OFF, g, S, E); }
            GRID_BAR();
            REPEAT(REP_POST) {   PHASE_IDS();
                post_rows((const GAS bf16*)(ws + WS_Z), karg_in(8) + (size_t)l * RANK, karg_in(9) + (size_t)l * IDIM, karg_in(10) + (size_t)l * IDIM, (GAS bf16*)(ws + WS_CKVN), (GAS bf16*)(ws + WS_KIN), (GAS float*)(ws + WS_WIF), gw, NGW, lane);
                swa_phase(lds + RING_OFF, (const GAS bf16*)(ws + WS_Z), (GAS bf16*)(ws + WS_O), karg_in(1), karg_in(13) + (size_t)l * H_B, vcu, G, tid, lane, wave);
            }
            GRID_BAR();
            REPEAT(REP_TOPK) {   PHASE_IDS(); topk_phase(lds + RING_OFF, (const GAS bf16*)(ws + WS_Z), (const GAS bf16*)(ws + WS_KIN), (const GAS float*)(ws + WS_WIF), (GAS unsigned short*)(ws + WS_IDX), vcu, G, lane, wave); }
            GRID_BAR();
            REPEAT(REP_DSA) {   PHASE_IDS(); dsa_phase(lds, (const GAS bf16*)(ws + WS_Z), (const GAS bf16*)(ws + WS_CKVN), (const GAS unsigned short*)(ws + WS_IDX), (GAS bf16*)(ws + WS_O), karg_in(1), gw, NGW, tid, lane, wave); }
            GRID_BAR();
            {   PHASE_IDS(); GAS unsigned char* wl = ws + WS_W0 + (size_t)l * W_LAYER;
                pg8::Gemm g{(const GAS bf16*)(ws + WS_O), (const GAS bf16*)(wl + WO_OUT), M, D, OLD}; pg8::StaticOrder S; S.init(M, D, G, bx);
                pg8::EpiResid E{1.0f, (unsigned)WS_XN, (unsigned)(WS_SS + (size_t)((3 * l + 2) & 1) * SS_BYTES)};
                pg8::gemm_phase<pg8::EpiResid, pg8::StaticOrder, true, true>(lds + RING_OFF, g, S, E); }
            GRID_BAR();
        }
    }
    {   PHASE_IDS(); final_rows((const GAS bf16*)(ws + WS_XN), karg_out(), karg_in(19), (const GAS float*)(ws + WS_SS + (size_t)(6 & 1) * SS_BYTES), gw, NGW, lane); }
}

extern "C" void kernel_launch(void* const* d_in, const int* in_sizes, int n_in, void* d_out, int out_size, void* d_ws, size_t ws_size, hipStream_t stream) {
    static int grid = 0;
    if (grid == 0) {
        if (n_in != 20 || in_sizes[0] != M * D || out_size != M * D || ws_size < WS_END) { fprintf(stderr, "kernel_launch: unexpected shapes (n_in %d, in0 %d, out %d, ws %zu); nothing launched\n", n_in, n_in > 0 ? in_sizes[0] : -1, out_size, ws_size); grid = -1; return; }
        int dev = 0, cus = 0, per_cu = 0;
        if (hipGetDevice(&dev) != hipSuccess || hipDeviceGetAttribute(&cus, hipDeviceAttributeMultiprocessorCount, dev) != hipSuccess) { grid = -1; return; }
        if (hipFuncSetAttribute((const void*)mk_fwd, hipFuncAttributeMaxDynamicSharedMemorySize, LDS_BYTES) != hipSuccess) { fprintf(stderr, "kernel_launch: hipFuncSetAttribute failed\n"); grid = -1; return; }
        if (hipOccupancyMaxActiveBlocksPerMultiprocessor(&per_cu, (const void*)mk_fwd, NWAVES * 64, LDS_BYTES) != hipSuccess || per_cu < 1) { fprintf(stderr, "kernel_launch: occupancy query reports %d workgroups per CU\n", per_cu); }
        (void)hipGetLastError();
        grid = cus;
    }
    if (grid < 0) return;
    if (hipMemsetAsync((char*)d_ws + WS_CTL, 0, CTL_ZERO_BYTES, stream) != hipSuccess) return;
    Args a{};
    for (int i = 0; i < 20; ++i) a.in[i] = (const float*)d_in[i];
    a.out = (float*)d_out; a.ws = (unsigned char*)d_ws;
    hipLaunchKernelGGL(mk_fwd, dim3(grid), dim3(NWAVES * 64), LDS_BYTES, stream, a);
}
```

```cpp
#define F8_MASK 0xA
#include <hip/hip_runtime.h>
#include <cstdio>
#include <cstdint>
namespace pg8 {
#define PG8_LAS __attribute__((address_space(3)))
#define PG8_GAS __attribute__((address_space(1)))
typedef unsigned short bf16_t;
typedef short bf16x8 __attribute__((ext_vector_type(8)));
typedef float f32x4 __attribute__((ext_vector_type(4)));
typedef unsigned u32x4 __attribute__((ext_vector_type(4)));
constexpr int BM = 256, BK = 64, HALF = 128, HTB = HALF * BK * 2  , STAGE_BYTES = 8 * HTB, NXCD = 8, WGM = 8;

__host__ __device__ __forceinline__ int lds_byte(int r, int c) { const int st = (r >> 4) * 2 + (c >> 5), rr = r & 15, cc = c & 31, ob = rr * 64 + cc * 2; return st * 1024 + (ob ^ (((ob >> 9) & 1) << 5)); }
__host__ __device__ __forceinline__ void stage_rc(int b, int& R, int& C) { const int st = b / 1024, sb = b % 1024, swz = sb ^ (((sb >> 9) & 1) << 5); R = (st >> 1) * 16 + swz / 64; C = (st & 1) * 32 + (swz % 64) / 2; }
__host__ __device__ __forceinline__ int perm32(int rho) { const int n = rho >> 4, i = rho & 15; return 8 * (i >> 2) + 4 * n + (i & 3); }

typedef int i32x8 __attribute__((ext_vector_type(8))); typedef int i32x4v __attribute__((ext_vector_type(4)));
__device__ __forceinline__ i32x8 cat8(bf16x8 a, bf16x8 b) { return __builtin_shufflevector(__builtin_bit_cast(i32x4v, a), __builtin_bit_cast(i32x4v, b), 0, 1, 2, 3, 4, 5, 6, 7); }
struct Unit { int pm, pn; };
struct Gemm { const PG8_GAS bf16_t* A; const PG8_GAS bf16_t* Bt; int M, N, K; };

struct StaticOrder {
    int nM, nN, nwg, G, c;
    __host__ __device__ void init(int M, int N, int G_, int c_) { nM = M / BM; nN = N / BM; nwg = nM * nN; G = G_; c = c_; }
    __host__ __device__ bool next(int i, Unit& u) const {
        const long L = (long)i * G + c; if (L >= nwg) return false;
        int wgid = (int)L; { const int q = nwg / NXCD, r = nwg % NXCD, xcd = wgid % NXCD, off = wgid / NXCD; wgid = (xcd < r ? xcd * (q + 1) : r * (q + 1) + (xcd - r) * q) + off; }
        const int nig = WGM * nN, gid = wgid / nig, fm = gid * WGM, gsz = (nM - fm) < WGM ? (nM - fm) : WGM;
        u.pm = fm + ((wgid % nig) % gsz); u.pn = (wgid % nig) / gsz; return true;
    }
    __device__ __forceinline__ void a_ready(const Unit&) const {}
    __device__ __forceinline__ void done(const Unit&) const {}
};
__device__ __forceinline__ unsigned long long karg64(int idx) { unsigned long long r; const unsigned off = (unsigned)idx * 8u;
    asm volatile("s_load_dwordx2 %0, %1, %2\n\ts_waitcnt lgkmcnt(0)" : "=s"(r) : "s"(__builtin_amdgcn_kernarg_segment_ptr()), "s"(off) : "memory"); return r; }
__device__ __forceinline__ unsigned cvt_pk_bf16(float lo, float hi) { unsigned r; asm volatile("v_cvt_pk_bf16_f32 %0, %1, %2" : "=v"(r) : "v"(lo), "v"(hi)); return r; }
__device__ __forceinline__ float silu_f(float g) { return g * __builtin_amdgcn_rcpf(1.0f + __builtin_amdgcn_exp2f(-1.4426950408889634f * g)); }

struct EpiSwiglu {
    static constexpr bool PERM = true, AFTER_DRAIN = false;
    PG8_GAS bf16_t* O; int ldc; const PG8_GAS float* ss; float inv_k, eps, post;
    __device__ __forceinline__ void operator()(const f32x4 (&acc)[2][2][4][2], const Unit& u, int wr, int wc, int fr, int fq) const {
        const int row0 = u.pm * BM + wr * 64 + fr, col0 = u.pn * HALF + wc * 32 + 8 * fq;
        float rs[8]; const int lane_ = fr + 16 * fq;
#pragma unroll
        for (int k = 0; k < 8; ++k) { const PG8_GAS f32x4* p4 = (const PG8_GAS f32x4*)(ss + (size_t)(row0 + (k >> 2) * HALF + (k & 3) * 16) * 32 + 8 * fq); const f32x4 a = p4[0], b = p4[1];
            float t = ((a[0] + a[1]) + (a[2] + a[3])) + ((b[0] + b[1]) + (b[2] + b[3]));
            t += __builtin_bit_cast(float, __builtin_amdgcn_ds_bpermute((lane_ ^ 16) << 2, __builtin_bit_cast(int, t)));
            t += __builtin_bit_cast(float, __builtin_amdgcn_ds_bpermute((lane_ ^ 32) << 2, __builtin_bit_cast(int, t))); rs[k] = t; }
#pragma unroll
        for (int ai = 0; ai < 2; ++ai)
#pragma unroll
            for (int m = 0; m < 4; ++m) { PG8_GAS bf16_t* rowp = O + (size_t)(row0 + ai * HALF + m * 16) * ldc + col0;
                const float r = __builtin_amdgcn_rsqf(rs[ai * 4 + m] * inv_k + eps) * post;
                const f32x4 g0 = acc[ai][0][m][0] * r, g1 = acc[ai][0][m][1] * r, u0 = acc[ai][1][m][0] * r, u1 = acc[ai][1][m][1] * r;
                u32x4 w; w.x = cvt_pk_bf16(silu_f(g0[0]) * u0[0], silu_f(g0[1]) * u0[1]); w.y = cvt_pk_bf16(silu_f(g0[2]) * u0[2], silu_f(g0[3]) * u0[3]);
                w.z = cvt_pk_bf16(silu_f(g1[0]) * u1[0], silu_f(g1[1]) * u1[1]); w.w = cvt_pk_bf16(silu_f(g1[2]) * u1[2], silu_f(g1[3]) * u1[3]);
                *(PG8_GAS u32x4*)rowp = w; }
    }
};
struct EpiResid {
    static constexpr bool PERM = true, AFTER_DRAIN = false;
    float alpha; unsigned hb_off; unsigned ss_off; unsigned h8_off;
    __device__ __forceinline__ void operator()(const f32x4 (&acc)[2][2][4][2], const Unit& u, int wr, int wc, int fr, int fq) const {
        constexpr int ldc = 2048;
        PG8_GAS unsigned char* wsb = (PG8_GAS unsigned char*)karg64(21); PG8_GAS bf16_t* hb = (PG8_GAS bf16_t*)(wsb + hb_off); PG8_GAS float* ss = (PG8_GAS float*)(wsb + ss_off);
        const int row0 = u.pm * BM + wr * 64 + fr, col0 = u.pn * BM + wc * 32 + 8 * fq; const int lane = fr + 16 * fq;
        u32x4 cur[2], nxt[2];
        { const size_t off = (size_t)row0 * ldc + col0; cur[0] = *(const PG8_GAS u32x4*)(hb + off); cur[1] = *(const PG8_GAS u32x4*)(hb + off + HALF); }
#pragma unroll
        for (int k = 0; k < 8; ++k) { const int ai = k >> 2, m = k & 3; const int row = row0 + ai * HALF + m * 16; const size_t off = (size_t)row * ldc + col0;
            if (k < 7) { const int ai2 = (k + 1) >> 2, m2 = (k + 1) & 3; const size_t off2 = (size_t)(row0 + ai2 * HALF + m2 * 16) * ldc + col0;
                nxt[0] = *(const PG8_GAS u32x4*)(hb + off2); nxt[1] = *(const PG8_GAS u32x4*)(hb + off2 + HALF); }
            float sq = 0.f;
#pragma unroll
            for (int bj = 0; bj < 2; ++bj) { const u32x4 b = cur[bj]; const f32x4 a0 = acc[ai][bj][m][0], a1 = acc[ai][bj][m][1]; u32x4 w;
                w.x = cvt_pk_bf16(__builtin_bit_cast(float, b.x << 16) + a0[0] * alpha, __builtin_bit_cast(float, b.x & 0xffff0000u) + a0[1] * alpha);
                w.y = cvt_pk_bf16(__builtin_bit_cast(float, b.y << 16) + a0[2] * alpha, __builtin_bit_cast(float, b.y & 0xffff0000u) + a0[3] * alpha);
                w.z = cvt_pk_bf16(__builtin_bit_cast(float, b.z << 16) + a1[0] * alpha, __builtin_bit_cast(float, b.z & 0xffff0000u) + a1[1] * alpha);
                w.w = cvt_pk_bf16(__builtin_bit_cast(float, b.w << 16) + a1[2] * alpha, __builtin_bit_cast(float, b.w & 0xffff0000u) + a1[3] * alpha);
                *(PG8_GAS u32x4*)(hb + off + bj * HALF) = w;
                if (h8_off) { typedef unsigned u32x2v __attribute__((ext_vector_type(2))); u32x2v q8; int p = 0;
                    p = __builtin_amdgcn_cvt_pk_fp8_f32(__builtin_bit_cast(float, w.x << 16), __builtin_bit_cast(float, w.x & 0xffff0000u), p, false);
                    p = __builtin_amdgcn_cvt_pk_fp8_f32(__builtin_bit_cast(float, w.y << 16), __builtin_bit_cast(float, w.y & 0xffff0000u), p, true); q8.x = (unsigned)p; p = 0;
                    p = __builtin_amdgcn_cvt_pk_fp8_f32(__builtin_bit_cast(float, w.z << 16), __builtin_bit_cast(float, w.z & 0xffff0000u), p, false);
                    p = __builtin_amdgcn_cvt_pk_fp8_f32(__builtin_bit_cast(float, w.w << 16), __builtin_bit_cast(float, w.w & 0xffff0000u), p, true); q8.y = (unsigned)p;
                    *(PG8_GAS u32x2v*)(wsb + h8_off + off + bj * HALF) = q8; }
#pragma unroll
                for (int e = 0; e < 4; ++e) { const float lo = __builtin_bit_cast(float, w[e] << 16), hi = __builtin_bit_cast(float, w[e] & 0xffff0000u); sq = fmaf(lo, lo, sq); sq = fmaf(hi, hi, sq); } }
            sq += __builtin_bit_cast(float, __builtin_amdgcn_ds_bpermute((lane ^ 16) << 2, __builtin_bit_cast(int, sq)));
            sq += __builtin_bit_cast(float, __builtin_amdgcn_ds_bpermute((lane ^ 32) << 2, __builtin_bit_cast(int, sq)));
            if (fq == 0) ss[(size_t)row * 32 + u.pn * 4 + wc] = sq;
            cur[0] = nxt[0]; cur[1] = nxt[1]; }
    }
};
struct EpiBf16 {
    static constexpr bool PERM = true, AFTER_DRAIN = false;
    PG8_GAS bf16_t* O; int ldc; const PG8_GAS float* ss; float inv_k, eps;
    __device__ __forceinline__ void operator()(const f32x4 (&acc)[2][2][4][2], const Unit& u, int wr, int wc, int fr, int fq) const {
        const int row0 = u.pm * BM + wr * 64 + fr, col0 = u.pn * BM + wc * 32 + 8 * fq;
        float rs[8]; const int lane_ = fr + 16 * fq;
#pragma unroll
        for (int k = 0; k < 8; ++k) { const PG8_GAS f32x4* p4 = (const PG8_GAS f32x4*)(ss + (size_t)(row0 + (k >> 2) * HALF + (k & 3) * 16) * 32 + 8 * fq); const f32x4 a = p4[0], b = p4[1];
            float t = ((a[0] + a[1]) + (a[2] + a[3])) + ((b[0] + b[1]) + (b[2] + b[3]));
            t += __builtin_bit_cast(float, __builtin_amdgcn_ds_bpermute((lane_ ^ 16) << 2, __builtin_bit_cast(int, t)));
            t += __builtin_bit_cast(float, __builtin_amdgcn_ds_bpermute((lane_ ^ 32) << 2, __builtin_bit_cast(int, t))); rs[k] = t; }
#pragma unroll
        for (int ai = 0; ai < 2; ++ai)
#pragma unroll
            for (int m = 0; m < 4; ++m) { PG8_GAS bf16_t* rowp = O + (size_t)(row0 + ai * HALF + m * 16) * ldc + col0;
                const float r = __builtin_amdgcn_rsqf(rs[ai * 4 + m] * inv_k + eps);
#pragma unroll
                for (int bj = 0; bj < 2; ++bj) { const f32x4 v0 = acc[ai][bj][m][0] * r, v1 = acc[ai][bj][m][1] * r;
                    u32x4 w; w.x = cvt_pk_bf16(v0[0], v0[1]); w.y = cvt_pk_bf16(v0[2], v0[3]); w.z = cvt_pk_bf16(v1[0], v1[1]); w.w = cvt_pk_bf16(v1[2], v1[3]);
                    *(PG8_GAS u32x4*)(rowp + bj * HALF) = w; } }
    }
};
template <class Epi, class Sched, bool ALIGN_EPI = false, bool SP2 = false, bool F8 = false>
__device__ __forceinline__ void gemm_phase(PG8_LAS unsigned char* lds, const Gemm g, const Sched& S, const Epi& E) {
    int tid_ = threadIdx.x; asm volatile("" : "+v"(tid_));
    const int tid = tid_, wid = __builtin_amdgcn_readfirstlane(tid >> 6), lane = tid & 63, wr = wid >> 2, wc = wid & 3, fr = lane & 15, fq = lane >> 4;
    const int K = g.K, nt = K / BK;
    unsigned voffA[2], voffB[2];
#pragma unroll
    for (int i = 0; i < 2; ++i) { int R, C; stage_rc(tid * 16 + i * 8192, R, C); const int Rb = Epi::PERM ? ((R & ~31) + perm32(R & 31)) : R;
        voffA[i] = (unsigned)(R * K + C) * 2u; voffB[i] = (unsigned)(Rb * K + C) * 2u; }
    const size_t kstep = (size_t)(BK * 2);
    const size_t hstep = (size_t)HALF * K * 2;
    const size_t tstep = 2 * hstep;
    const unsigned ldsw = (unsigned)wid * 1024u;
    const int aoff = lds_byte(wr * 64 + fr, fq * 8), boff = lds_byte(wc * 32 + fr, fq * 8);
#define PG8_SA(b, h) (((b) * 2 + (h)) * HTB)
#define PG8_SB(b, h) ((4 + (b) * 2 + (h)) * HTB)
#define PG8_STAGE(bufoff, gbase, voff) do { _Pragma("unroll") for (int _i = 0; _i < 2; ++_i) \
        __builtin_amdgcn_global_load_lds((const PG8_GAS unsigned*)((const PG8_GAS char*)(gbase) + (voff)[_i]), (PG8_LAS unsigned*)(lds + (bufoff) + ldsw + _i * 8192), 16, 0, 0); } while (0)
#define PG8_LDA(dst, b, h) do { _Pragma("unroll") for (int m = 0; m < 4; ++m) _Pragma("unroll") for (int k = 0; k < 2; ++k) dst[m][k] = *(const PG8_LAS bf16x8*)(lds + PG8_SA(b, h) + aoff + m * 2048 + k * 1024); } while (0)
#define PG8_LDB(dst, b, h) do { _Pragma("unroll") for (int n = 0; n < 2; ++n) _Pragma("unroll") for (int k = 0; k < 2; ++k) dst[n][k] = *(const PG8_LAS bf16x8*)(lds + PG8_SB(b, h) + boff + n * 2048 + k * 1024); } while (0)
#define PG8_MMA(ai, bj, At, Bt) do { __builtin_amdgcn_s_setprio(1); _Pragma("unroll") for (int m = 0; m < 4; ++m) _Pragma("unroll") for (int n = 0; n < 2; ++n) { \
        if constexpr (F8) { asm volatile("v_mfma_f32_16x16x128_f8f6f4 %0, %1, %2, %0" : "+v"(acc[ai][bj][m][n]) : "v"(cat8(Bt[n][0], Bt[n][1])), "v"(cat8(At[m][0], At[m][1]))); } \
        else { _Pragma("unroll") for (int k = 0; k < 2; ++k) acc[ai][bj][m][n] = __builtin_amdgcn_mfma_f32_16x16x32_bf16(Bt[n][k], At[m][k], acc[ai][bj][m][n], 0, 0, 0); } } \
        __builtin_amdgcn_s_setprio(0); } while (0)
#define PG8_WAIT_V(n) asm volatile("s_waitcnt vmcnt(" #n ")" ::: "memory")
#define PG8_WAIT_L(n) asm volatile("s_waitcnt lgkmcnt(" #n ")" ::: "memory")
#define PG8_BAR __builtin_amdgcn_s_barrier()
#define PG8_SCHED __builtin_amdgcn_sched_barrier(0)
    Unit cur, nxt; int ui = 0;
    if (!S.next(0, cur)) return;
    f32x4 acc[2][2][4][2];
#pragma unroll
    for (int a = 0; a < 2; ++a)
#pragma unroll
        for (int b = 0; b < 2; ++b)
#pragma unroll
            for (int m = 0; m < 4; ++m)
#pragma unroll
                for (int n = 0; n < 2; ++n) acc[a][b][m][n] = (f32x4){0.f, 0.f, 0.f, 0.f};
    bf16x8 At[4][2], B0[2][2], B1[2][2];
    const PG8_GAS char* cA = (const PG8_GAS char*)g.A + (size_t)cur.pm * tstep; const PG8_GAS char* cB = (const PG8_GAS char*)g.Bt + (size_t)cur.pn * tstep;
    S.a_ready(cur);
    if constexpr (SP2) {
        PG8_STAGE(PG8_SB(0, 0), cB, voffB); PG8_STAGE(PG8_SB(0, 1), cB + hstep, voffB); PG8_STAGE(PG8_SA(0, 0), cA, voffA); PG8_STAGE(PG8_SA(0, 1), cA + hstep, voffA);
        if (wr == 1) PG8_BAR;
        PG8_WAIT_V(2); PG8_BAR;
        PG8_STAGE(PG8_SB(1, 0), cB + kstep, voffB); PG8_STAGE(PG8_SA(1, 0), cA + kstep, voffA); PG8_STAGE(PG8_SB(1, 1), cB + hstep + kstep, voffB);
        PG8_WAIT_V(6); PG8_BAR;
    } else {
        PG8_STAGE(PG8_SB(0, 0), cB, voffB); PG8_STAGE(PG8_SA(0, 0), cA, voffA); PG8_STAGE(PG8_SB(0, 1), cB + hstep, voffB); PG8_STAGE(PG8_SA(0, 1), cA + hstep, voffA);
        if (wr == 1) PG8_BAR;
        PG8_WAIT_V(4); PG8_BAR;
        PG8_STAGE(PG8_SB(1, 0), cB + kstep, voffB); PG8_STAGE(PG8_SA(1, 0), cA + kstep, voffA); PG8_STAGE(PG8_SB(1, 1), cB + hstep + kstep, voffB);
        PG8_WAIT_V(6); PG8_BAR;
    }
    for (;;) {
        const bool has_next = S.next(ui + 1, nxt);
        const PG8_GAS char* nA = has_next ? (const PG8_GAS char*)g.A + (size_t)nxt.pm * tstep : cA; const PG8_GAS char* nB = has_next ? (const PG8_GAS char*)g.Bt + (size_t)nxt.pn * tstep : cB;
        for (int t = 0; t < nt; t += 2) {
            const bool last = (t == nt - 2);
            const PG8_GAS char* a1 = cA + (size_t)(t + 1) * kstep;
            const PG8_GAS char* a2 = last ? nA : cA + (size_t)(t + 2) * kstep; const PG8_GAS char* b2 = last ? nB : cB + (size_t)(t + 2) * kstep;
            const PG8_GAS char* a3 = a2 + kstep; const PG8_GAS char* b3 = b2 + kstep;
            if (last && has_next) S.a_ready(nxt);
            if constexpr (SP2) {
            PG8_LDB(B0, 0, 0); PG8_LDB(B1, 0, 1); PG8_SCHED; PG8_LDA(At, 0, 0); PG8_STAGE(PG8_SA(1, 1), a1 + hstep, voffA);
            PG8_WAIT_V(8); PG8_WAIT_L(0); PG8_BAR; PG8_MMA(0, 0, At, B0); PG8_MMA(0, 1, At, B1); PG8_BAR; PG8_SCHED;
            PG8_LDA(At, 0, 1); PG8_STAGE(PG8_SB(0, 0), b2, voffB); PG8_STAGE(PG8_SB(0, 1), b2 + hstep, voffB); PG8_STAGE(PG8_SA(0, 0), a2, voffA);
            PG8_WAIT_V(8); PG8_WAIT_L(0); PG8_BAR; PG8_MMA(1, 0, At, B0); PG8_MMA(1, 1, At, B1); PG8_BAR; PG8_SCHED;
            PG8_LDB(B0, 1, 0); PG8_LDB(B1, 1, 1); PG8_SCHED; PG8_LDA(At, 1, 0); PG8_STAGE(PG8_SA(0, 1), a2 + hstep, voffA);
            PG8_WAIT_V(8); PG8_WAIT_L(0); PG8_BAR; PG8_MMA(0, 0, At, B0); PG8_MMA(0, 1, At, B1); PG8_BAR; PG8_SCHED;
            PG8_LDA(At, 1, 1); PG8_STAGE(PG8_SB(1, 0), b3, voffB); PG8_STAGE(PG8_SB(1, 1), b3 + hstep, voffB); PG8_STAGE(PG8_SA(1, 0), a3, voffA);
            PG8_WAIT_V(8); PG8_WAIT_L(0); PG8_BAR; PG8_MMA(1, 0, At, B0); PG8_MMA(1, 1, At, B1); PG8_BAR; PG8_SCHED;
            } else {
            PG8_LDB(B0, 0, 0); PG8_SCHED; PG8_LDA(At, 0, 0); PG8_STAGE(PG8_SA(1, 1), a1 + hstep, voffA);
            PG8_WAIT_L(8); PG8_BAR; PG8_WAIT_L(0); PG8_MMA(0, 0, At, B0); PG8_BAR; PG8_SCHED;
            PG8_LDB(B1, 0, 1); PG8_STAGE(PG8_SB(0, 0), b2, voffB);
            PG8_BAR; PG8_WAIT_L(0); PG8_MMA(0, 1, At, B1); PG8_BAR;
            PG8_LDA(At, 0, 1); PG8_STAGE(PG8_SA(0, 0), a2, voffA);
            PG8_BAR; PG8_WAIT_L(0); PG8_MMA(1, 0, At, B0); PG8_BAR; PG8_SCHED;
            PG8_STAGE(PG8_SB(0, 1), b2 + hstep, voffB);
            PG8_WAIT_V(6); PG8_BAR; PG8_MMA(1, 1, At, B1); PG8_BAR;
            PG8_LDB(B0, 1, 0); PG8_SCHED; PG8_LDA(At, 1, 0); PG8_STAGE(PG8_SA(0, 1), a2 + hstep, voffA);
            PG8_WAIT_L(8); PG8_BAR; PG8_WAIT_L(0); PG8_MMA(0, 0, At, B0); PG8_BAR; PG8_SCHED;
            PG8_LDB(B1, 1, 1); PG8_STAGE(PG8_SB(1, 0), b3, voffB);
            PG8_BAR; PG8_WAIT_L(0); PG8_MMA(0, 1, At, B1); PG8_BAR;
            PG8_LDA(At, 1, 1); PG8_STAGE(PG8_SA(1, 0), a3, voffA);
            PG8_BAR; PG8_WAIT_L(0); PG8_MMA(1, 0, At, B0); PG8_BAR; PG8_SCHED;
            PG8_STAGE(PG8_SB(1, 1), b3 + hstep, voffB);
            PG8_WAIT_V(6); PG8_BAR; PG8_MMA(1, 1, At, B1); PG8_BAR;
            }
        }
        if constexpr (ALIGN_EPI) { if (wr == 0) PG8_BAR; }
        if constexpr (!Epi::AFTER_DRAIN) { E(acc, cur, wr, wc, fr, fq); S.done(cur); }
        if (!has_next) break;
#pragma unroll
        for (int a = 0; a < 2; ++a)
#pragma unroll
            for (int b = 0; b < 2; ++b)
#pragma unroll
                for (int m = 0; m < 4; ++m)
#pragma unroll
                    for (int n = 0; n < 2; ++n) acc[a][b][m][n] = (f32x4){0.f, 0.f, 0.f, 0.f};
        cur = nxt; cA = nA; cB = nB; ++ui;
        if constexpr (ALIGN_EPI) { if (wr == 1) PG8_BAR; }
    }
    PG8_WAIT_V(0);
    if constexpr (!ALIGN_EPI) { if (wr == 0) PG8_BAR; }
    PG8_BAR;
    if constexpr (Epi::AFTER_DRAIN) { E.fused(acc, cur, wr, wc, fr, fq, lds, wid, lane); S.done(cur); }
#undef PG8_SA
#undef PG8_SB
#undef PG8_STAGE
#undef PG8_LDA
#undef PG8_LDB
#undef PG8_MMA
#undef PG8_WAIT_V
#undef PG8_WAIT_L
#undef PG8_BAR
#undef PG8_SCHED
}
}
constexpr int NWAVES = 8;
constexpr int BATCH = 8, SEQ = 4096, D = 2048, FF = 5632, DEPTH = 2;
constexpr int M = BATCH * SEQ;
constexpr int NGU = 2 * FF;
constexpr int H_A = 8, HD_A = 128, RANK = 256, IH = 8, IDIM = 64, TOPK = 256;
constexpr int H_B = 16, KVH = 2, GQA = 8, HD_B = 64, WINDOW = 128;
constexpr int D_IN = 3144;
constexpr float EPS = 1e-6f;
constexpr size_t MiB = 1u << 20;
constexpr size_t WS_CTL = 0, CTL_ZERO_BYTES = 1 * MiB;
#ifndef F8_MASK
#define F8_MASK 0xF
#endif
constexpr float W8_SCALE = 64.0f;
constexpr bool F8_ALL1 = (F8_MASK & 0x5) == 0x5, F8_ALL2 = (F8_MASK & 0xA) == 0xA;
__host__ __device__ constexpr bool f8_on(int l, int f) { return ((F8_MASK >> (2 * l + f)) & 1) != 0; }
constexpr size_t GU1_B = (F8_ALL1 ? 22 : 44) * MiB, GU2_B = (F8_ALL2 ? 22 : 44) * MiB;
constexpr size_t WS_W0 = 2 * MiB;
constexpr size_t WO_GU1 = 0, WO_D1 = GU1_B, WO_GU2 = WO_D1 + 22 * MiB, WO_D2 = WO_GU2 + GU2_B, WO_IN = WO_D2 + 22 * MiB, WO_OUT = WO_IN + 17 * MiB, W_LAYER = WO_OUT + 12 * MiB;
constexpr size_t WS_XN = WS_W0 + 2 * W_LAYER;
constexpr size_t WS_HB8 = WS_XN + 128 * MiB;
constexpr size_t WS_ACT = WS_HB8 + (F8_MASK ? 64 : 0) * MiB;
constexpr size_t WS_Z = WS_ACT, WS_CKVN = WS_ACT + 272 * MiB, WS_KIN = WS_ACT + 288 * MiB, WS_WIF = WS_ACT + 292 * MiB, WS_IDX = WS_ACT + 294 * MiB;
constexpr int ZLD = 4352, ZC_QLAT = 0, ZC_CKV = 2048, ZC_QI = 2304, ZC_QB = 2816, ZC_KB = 3840, ZC_VB = 3968, ZC_KI = 4096, ZC_WI = 4160;
constexpr int OLD = 3072;
constexpr size_t WS_O = WS_ACT + 352 * MiB;
constexpr size_t WS_SS = WS_O + 192 * MiB, SS_BYTES = 4 * MiB;
constexpr size_t WS_END = WS_SS + 2 * SS_BYTES;
static_assert(WS_END <= 1024 * MiB, "d_ws map exceeds 1 GiB");
constexpr int CW_TMO = 0, CW_CODE = 1, CW_BAR = 4096;
constexpr int RING_OFF = 0, RING_BYTES = 131072;
constexpr int LDSCTL_OFF = RING_BYTES, MISC_OFF = LDSCTL_OFF + 320;
constexpr int LDS_BYTES = 147456;
#define GAS __attribute__((address_space(1)))
#define LAS __attribute__((address_space(3)))
typedef unsigned short bf16;
typedef unsigned v4u __attribute__((ext_vector_type(4)));
typedef float f32x4 __attribute__((ext_vector_type(4)));
typedef short bf16x8 __attribute__((ext_vector_type(8)));
typedef GAS unsigned gu32;
typedef GAS unsigned long long gu64;
#define RLX_AGENT __ATOMIC_RELAXED, __HIP_MEMORY_SCOPE_AGENT
#define LDS_WAIT() asm volatile("s_waitcnt lgkmcnt(0)" ::: "memory")
#define VM_WAIT() asm volatile("s_waitcnt vmcnt(0)" ::: "memory")
__device__ __forceinline__ unsigned long long rt() { return __builtin_amdgcn_s_memrealtime(); }
__device__ __forceinline__ unsigned f2bf(float f) { unsigned u = __builtin_bit_cast(unsigned, f); return (u + 0x7fffu + ((u >> 16) & 1u)) >> 16; }
__device__ __forceinline__ unsigned pk2(float lo, float hi) { return f2bf(lo) | (f2bf(hi) << 16); }

#define XB_TMO      128
#define XB_XCNT(j)  (256  + 64 * (j))
#define XB_XSUB(j)  (1280 + 64 * (j))
#define XB_XGEN(j)  (2304 + 64 * (j))
#define XB_TOP      3328
#define XB_TOPGEN   3392
#define XCD_BAR_WORDS 3456
#define XB_SPIN_CAP (1u << 18)

__device__ __forceinline__ unsigned xb_ld(unsigned* p)              { return __hip_atomic_load(p, __ATOMIC_RELAXED, __HIP_MEMORY_SCOPE_AGENT); }
__device__ __forceinline__ unsigned xb_add(unsigned* p, unsigned v) { return __hip_atomic_fetch_add(p, v, __ATOMIC_RELAXED, __HIP_MEMORY_SCOPE_AGENT); }
__device__ __forceinline__ unsigned xb_xcc_id() { return (unsigned)__builtin_amdgcn_s_getreg((3 << 11) | 20) & 0xFu; }
#define XB_SPIN(cond, bar) do { unsigned _sp = 0; while (cond) { __builtin_amdgcn_s_sleep(1); \
    if ((++_sp & 255u) == 0u) { if (xb_ld(&(bar)[XB_TMO])) break; if (_sp > XB_SPIN_CAP) { atomicAdd(&(bar)[XB_TMO], 1u); break; } } } } while (0)

struct XcdBarrier {
    unsigned* bar; unsigned x;
    volatile LAS unsigned* st;
};

__device__ __forceinline__ XcdBarrier xcd_barrier_post(unsigned* bar, volatile LAS unsigned* st) {
    XcdBarrier b; b.bar = bar; b.x = xb_xcc_id(); b.st = st;
    if (threadIdx.x == 0) (void)xb_add(&bar[XB_XCNT(b.x)], 1u);
    return b;
}
__device__ __forceinline__ void xcd_barrier_complete(unsigned* bar, unsigned x, unsigned& nloc, unsigned& nx) {
    const unsigned G = gridDim.x * gridDim.y * gridDim.z;
    unsigned sum, cnt, mine, sp = 0u;
    for (;;) {
        sum = 0u; cnt = 0u; mine = 0u;
#pragma unroll
        for (unsigned j = 0; j < 16; ++j) { const unsigned c = xb_ld(&bar[XB_XCNT(j)]); sum += c; cnt += (c > 0u) ? 1u : 0u; mine = (j == x) ? c : mine; }
        if (sum == G) break;
        __builtin_amdgcn_s_sleep(1);
        if ((++sp & 255u) == 0u) { if (xb_ld(&bar[XB_TMO])) break; if (sp > XB_SPIN_CAP) { atomicAdd(&bar[XB_TMO], 1u); break; } }
    }
    nloc = mine > 0u ? mine : 1u; nx = cnt > 0u ? cnt : 1u;
}

__device__ __forceinline__ void xcd_barrier(const XcdBarrier& b) {
    asm volatile("s_waitcnt vmcnt(0)" ::: "memory");
    __syncthreads();
    if (threadIdx.x == 0) {
        unsigned* bar = b.bar;
        __builtin_amdgcn_s_waitcnt(0);
        unsigned nloc = b.st[0], nx = b.st[1];
        if (nloc == 0u) { xcd_barrier_complete(bar, b.x, nloc, nx); b.st[0] = nloc; b.st[1] = nx; }
        const unsigned old = xb_add(&bar[XB_XSUB(b.x)], 1u);
        const unsigned gen = old / nloc;
        if (old + 1u == (gen + 1u) * nloc) {
            __builtin_amdgcn_fence(__ATOMIC_RELEASE, "agent");
            asm volatile("s_waitcnt vmcnt(0)" ::: "memory");
            const unsigned og = xb_add(&bar[XB_TOP], 1u);
            const unsigned tg = og / nx;
            if (og + 1u == (tg + 1u) * nx) xb_add(&bar[XB_TOPGEN], 1u);
            else XB_SPIN(xb_ld(&bar[XB_TOPGEN]) == tg, bar);
            __builtin_amdgcn_fence(__ATOMIC_ACQUIRE, "agent");
            xb_add(&bar[XB_XGEN(b.x)], 1u);
            asm volatile("s_waitcnt vmcnt(0)" ::: "memory");
        } else {
            XB_SPIN(xb_ld(&bar[XB_XGEN(b.x)]) == gen, bar);
            __builtin_amdgcn_fence(__ATOMIC_ACQUIRE, "agent");
            asm volatile("s_waitcnt vmcnt(0)" ::: "memory");
        }
    }
    __syncthreads();
}
__constant__ unsigned char T5_BUCKET[128] = {0, 1, 2, 3, 4, 5, 6, 7, 8, 9, 10, 11, 12, 13, 14, 15, 16, 16, 16, 17, 17, 18, 18, 18, 19, 19, 19, 20, 20, 20, 20, 21, 21, 21, 21, 22, 22, 22, 22, 22, 23, 23, 23, 23, 23, 23, 24, 24, 24, 24, 24, 24, 25, 25, 25, 25, 25, 25, 25, 26, 26, 26, 26, 26, 26, 26, 26, 27, 27, 27, 27, 27, 27, 27, 27, 27, 27, 28, 28, 28, 28, 28, 28, 28, 28, 28, 28, 29, 29, 29, 29, 29, 29, 29, 29, 29, 29, 29, 29, 30, 30, 30, 30, 30, 30, 30, 30, 30, 30, 30, 30, 30, 30, 31, 31, 31, 31, 31, 31, 31, 31, 31, 31, 31, 31, 31, 31, 31};
typedef short s16x4 __attribute__((ext_vector_type(4)));
typedef float f32x16 __attribute__((ext_vector_type(16)));
__device__ __forceinline__ float bf2f(unsigned short b) { return __builtin_bit_cast(float, (unsigned)b << 16); }
__device__ __forceinline__ bf16x8 cat4(s16x4 lo, s16x4 hi) { return __builtin_shufflevector(lo, hi, 0, 1, 2, 3, 4, 5, 6, 7); }
__device__ __forceinline__ void tr_read4(unsigned a0, unsigned a1, unsigned a2, unsigned a3, s16x4& r0, s16x4& r1, s16x4& r2, s16x4& r3) {
    asm volatile("ds_read_b64_tr_b16 %0, %4\n\tds_read_b64_tr_b16 %1, %5\n\tds_read_b64_tr_b16 %2, %6\n\tds_read_b64_tr_b16 %3, %7\n\ts_waitcnt lgkmcnt(0)"
                 : "=&v"(r0), "=&v"(r1), "=&v"(r2), "=&v"(r3) : "v"(a0), "v"(a1), "v"(a2), "v"(a3) : "memory");
}
#define SHX(x, o) __builtin_bit_cast(float, __builtin_amdgcn_ds_bpermute(((lane) ^ (o)) << 2, __builtin_bit_cast(int, (float)(x))))
#define SHXU(x, o) ((unsigned)__builtin_amdgcn_ds_bpermute(((lane) ^ (o)) << 2, (int)(x)))
__device__ __forceinline__ float wave_sum(float v, int lane) {
#pragma unroll
    for (int o = 1; o < 64; o <<= 1) v += SHX(v, o);
    return v;
}
template <bool OUT8 = false>
__device__ __forceinline__ void conv_item(const GAS float* W, int ldw, int k0, int c0, int nvalid, GAS bf16* dst, int dld, int drow0, int dk0, float scale, const GAS float* gain, LAS float* scr, int lane) {
    const int c = lane & 31;
#pragma unroll 8
    for (int i = 0; i < 32; ++i) { const int kk = 2 * i + (lane >> 5); float v = 0.f;
        if (c < nvalid) v = W[(size_t)(k0 + kk) * ldw + c0 + c] * scale;
        scr[kk * 33 + c] = v; }
    LDS_WAIT(); asm volatile("" ::: "memory");
    const int c8 = lane & 7;
    f32x4 ga = {1.f, 1.f, 1.f, 1.f}, gb = {1.f, 1.f, 1.f, 1.f};
    if (gain) { ga = *(const GAS f32x4*)(gain + k0 + 8 * c8); gb = *(const GAS f32x4*)(gain + k0 + 8 * c8 + 4); }
#pragma unroll
    for (int j = 0; j < 4; ++j) { const int n = (lane >> 3) + 8 * j; const LAS float* s = scr + (8 * c8) * 33 + n;
        if constexpr (OUT8) { int p = 0, q = 0;
            p = __builtin_amdgcn_cvt_pk_fp8_f32(s[0 * 33] * ga.x, s[1 * 33] * ga.y, p, false); p = __builtin_amdgcn_cvt_pk_fp8_f32(s[2 * 33] * ga.z, s[3 * 33] * ga.w, p, true);
            q = __builtin_amdgcn_cvt_pk_fp8_f32(s[4 * 33] * gb.x, s[5 * 33] * gb.y, q, false); q = __builtin_amdgcn_cvt_pk_fp8_f32(s[6 * 33] * gb.z, s[7 * 33] * gb.w, q, true);
            *(GAS unsigned long long*)((GAS unsigned char*)dst + (size_t)(drow0 + n) * dld + dk0 + k0 + 8 * c8) = (unsigned long long)(unsigned)p | ((unsigned long long)(unsigned)q << 32); }
        else { v4u o; o.x = pk2(s[0 * 33] * ga.x, s[1 * 33] * ga.y); o.y = pk2(s[2 * 33] * ga.z, s[3 * 33] * ga.w); o.z = pk2(s[4 * 33] * gb.x, s[5 * 33] * gb.y); o.w = pk2(s[6 * 33] * gb.z, s[7 * 33] * gb.w);
            *(GAS v4u*)(dst + (size_t)(drow0 + n) * dld + dk0 + k0 + 8 * c8) = o; } }
    LDS_WAIT(); asm volatile("" ::: "memory");
}
__device__ __forceinline__ void rmsnorm_rows_bf16(const GAS float* X, const GAS float* g, GAS bf16* O, int gw, int NGW, int lane) {
    f32x4 gv[8];
#pragma unroll
    for (int j = 0; j < 8; ++j) gv[j] = ((const GAS f32x4*)g)[lane + 64 * j];
    for (int m = gw; m < M; m += NGW) {
        const GAS f32x4* xr = (const GAS f32x4*)(X + (size_t)m * D) + lane;
        f32x4 v[8]; float s = 0.f;
#pragma unroll
        for (int j = 0; j < 8; ++j) { v[j] = xr[64 * j]; s += (v[j].x * v[j].x + v[j].y * v[j].y) + (v[j].z * v[j].z + v[j].w * v[j].w); }
        const float r = 1.0f / sqrtf(wave_sum(s, lane) * (1.0f / D) + EPS);
        GAS unsigned long long* o8 = (GAS unsigned long long*)(O + (size_t)m * D) + lane;
#pragma unroll
        for (int j = 0; j < 8; ++j) { const f32x4 y = v[j] * r * gv[j]; o8[64 * j] = (unsigned long long)pk2(y.x, y.y) | ((unsigned long long)pk2(y.z, y.w) << 32); }
    }
}
__device__ __forceinline__ void rows_bf16_ss(const GAS float* X, GAS bf16* O, GAS unsigned char* O8, GAS float* ss, int gw, int NGW, int lane) {
    for (int m = gw; m < M; m += NGW) {
        const GAS f32x4* xr = (const GAS f32x4*)(X + (size_t)m * D) + lane;
        f32x4 v[8]; float s = 0.f;
#pragma unroll
        for (int j = 0; j < 8; ++j) { v[j] = xr[64 * j]; s += (v[j].x * v[j].x + v[j].y * v[j].y) + (v[j].z * v[j].z + v[j].w * v[j].w); }
        s = wave_sum(s, lane);
        GAS unsigned long long* o8 = (GAS unsigned long long*)(O + (size_t)m * D) + lane;
#pragma unroll
        for (int j = 0; j < 8; ++j) o8[64 * j] = (unsigned long long)pk2(v[j].x, v[j].y) | ((unsigned long long)pk2(v[j].z, v[j].w) << 32);
        if (O8) { GAS unsigned* q8 = (GAS unsigned*)(O8 + (size_t)m * D) + lane;
#pragma unroll
            for (int j = 0; j < 8; ++j) { int p = 0; p = __builtin_amdgcn_cvt_pk_fp8_f32(v[j].x, v[j].y, p, false); p = __builtin_amdgcn_cvt_pk_fp8_f32(v[j].z, v[j].w, p, true); q8[64 * j] = (unsigned)p; } }
        if (lane < 32) ss[(size_t)m * 32 + lane] = lane == 0 ? s : 0.f;
    }
}
__device__ __forceinline__ void final_rows(const GAS bf16* HB, GAS float* OUT, const GAS float* g, const GAS float* ss, int gw, int NGW, int lane) {
    f32x4 gv[8];
#pragma unroll
    for (int j = 0; j < 8; ++j) gv[j] = ((const GAS f32x4*)g)[lane + 64 * j];
    for (int m = gw; m < M; m += NGW) {
        const GAS unsigned long long* hr = (const GAS unsigned long long*)(HB + (size_t)m * D) + lane; GAS f32x4* orow = (GAS f32x4*)(OUT + (size_t)m * D) + lane;
        unsigned long long raw[8];
#pragma unroll
        for (int j = 0; j < 8; ++j) raw[j] = hr[64 * j];
        const float r = 1.0f / sqrtf(wave_sum(lane < 32 ? ss[(size_t)m * 32 + lane] : 0.f, lane) * (1.0f / D) + EPS);
#pragma unroll
        for (int j = 0; j < 8; ++j) { const unsigned lo = (unsigned)raw[j], hi = (unsigned)(raw[j] >> 32);
            f32x4 v = {__builtin_bit_cast(float, lo << 16), __builtin_bit_cast(float, lo & 0xffff0000u), __builtin_bit_cast(float, hi << 16), __builtin_bit_cast(float, hi & 0xffff0000u)};
            orow[64 * j] = v * r * gv[j]; }
    }
}
__device__ __forceinline__ void rmsnorm_rows_f32_inplace(GAS float* X, const GAS float* g, int gw, int NGW, int lane) {
    f32x4 gv[8];
#pragma unroll
    for (int j = 0; j < 8; ++j) gv[j] = ((const GAS f32x4*)g)[lane + 64 * j];
    for (int m = gw; m < M; m += NGW) {
        GAS f32x4* xr = (GAS f32x4*)(X + (size_t)m * D) + lane;
        f32x4 v[8]; float s = 0.f;
#pragma unroll
        for (int j = 0; j < 8; ++j) { v[j] = xr[64 * j]; s += (v[j].x * v[j].x + v[j].y * v[j].y) + (v[j].z * v[j].z + v[j].w * v[j].w); }
        const float r = 1.0f / sqrtf(wave_sum(s, lane) * (1.0f / D) + EPS);
#pragma unroll
        for (int j = 0; j < 8; ++j) xr[64 * j] = v[j] * r * gv[j];
    }
}

template <bool P_IFAST>
__device__ __forceinline__ void absorb_unit(const GAS float* Psrc, size_t p_ri, size_t p_rd, const GAS float* Qsrc, size_t q_rj, GAS bf16* out, size_t out_ld, float scale, const GAS float* qgain, LAS float* Ps, LAS float* Qs, int tid) {
#pragma unroll 4
    for (int j = 0; j < 16; ++j) { const int e = tid + 512 * j; const int i = P_IFAST ? (e & 63) : (e >> 7), d = P_IFAST ? (e >> 6) : (e & 127);
        Ps[i * 129 + d] = Psrc[(size_t)i * p_ri + (size_t)d * p_rd];
        const int jj = e >> 7, dd = e & 127; Qs[jj * 129 + dd] = Qsrc[(size_t)jj * q_rj + dd] * (qgain ? qgain[jj] : 1.0f); }
    __syncthreads();
    const int ty = tid >> 6, tx = tid & 63; float acc[8];
#pragma unroll
    for (int i = 0; i < 8; ++i) acc[i] = 0.f;
#pragma unroll 4
    for (int d = 0; d < 128; ++d) { const float q = Qs[tx * 129 + d];
#pragma unroll
        for (int i = 0; i < 8; ++i) acc[i] = fmaf(Ps[(ty * 8 + i) * 129 + d], q, acc[i]); }
#pragma unroll
    for (int i = 0; i < 8; ++i) out[(size_t)(ty * 8 + i) * out_ld + tx] = (bf16)f2bf(acc[i] * scale);
    __syncthreads();
}
__device__ __forceinline__ void post_rows(const GAS bf16* Z, const GAS float* gkv, const GAS float* gki, const GAS float* bki, GAS bf16* CKVN, GAS bf16* KIN, GAS float* WIF, int gw, int NGW, int lane) {
    const f32x4 g4 = ((const GAS f32x4*)gkv)[lane]; const float gk = gki[lane], bk = bki[lane];
    for (int m = gw; m < M; m += NGW) {
        const GAS bf16* zr = Z + (size_t)m * ZLD;
        const unsigned long long raw = *(const GAS unsigned long long*)(zr + ZC_CKV + 4 * lane);
        const float kraw = bf2f(zr[ZC_KI + lane]);
        const float wraw = bf2f(zr[ZC_WI + (lane & 7)]);
        const float c0 = bf2f((unsigned short)raw), c1 = bf2f((unsigned short)(raw >> 16)), c2 = bf2f((unsigned short)(raw >> 32)), c3 = bf2f((unsigned short)(raw >> 48));
        const float r = 1.0f / sqrtf(wave_sum((c0 * c0 + c1 * c1) + (c2 * c2 + c3 * c3), lane) * (1.0f / RANK) + EPS);
        *(GAS unsigned long long*)(CKVN + (size_t)m * RANK + 4 * lane) = (unsigned long long)pk2(c0 * r * g4.x, c1 * r * g4.y) | ((unsigned long long)pk2(c2 * r * g4.z, c3 * r * g4.w) << 32);
        const float mu = wave_sum(kraw, lane) * (1.0f / IDIM); const float dv = kraw - mu;
        const float var = wave_sum(dv * dv, lane) * (1.0f / IDIM);
        KIN[(size_t)m * IDIM + lane] = (bf16)f2bf(dv * (1.0f / sqrtf(var + EPS)) * gk + bk);
        if (lane < 8) WIF[(size_t)m * IH + lane] = wraw;
    }
}
constexpr int SWA_KP = 144, SWA_VP = 192;
constexpr int SWA_K_OFF = 0, SWA_V_OFF = 160 * SWA_KP, SWA_TAB_OFF = SWA_V_OFF + 160 * SWA_VP;
static_assert(SWA_TAB_OFF + 16 * 128 * 4 <= RING_BYTES, "SWA LDS map");
__device__ __forceinline__ void swa_phase(LAS unsigned char* lds, const GAS bf16* Z, GAS bf16* O, const GAS float* rel_bias, const GAS float* sinks, int vcu, int G, int tid, int lane, int wave) {
    LAS float* tab = (LAS float*)(lds + SWA_TAB_OFF);
    for (int e = tid; e < 16 * 128; e += NWAVES * 64) { const int h = e >> 7, dist = e & 127; tab[e] = rel_bias[(int)T5_BUCKET[dist] * 24 + H_A + h]; }
    __syncthreads();
    const int q = lane & 31, hh = lane >> 5;
    const unsigned ldsb = (unsigned)(size_t)lds;
    for (int item = vcu; item < BATCH * 128 * KVH; item += G) {
        const int kvh = item & 1, qt = (item >> 1) & 127, b = item >> 8;
        const int t0 = 32 * qt, s0 = t0 - 128;
        const size_t rowbase = (size_t)b * SEQ;
        for (int c = tid; c < 1280; c += NWAVES * 64) { const int row = c >> 3, ch = c & 7; const int s = s0 + row;
            if (s >= 0) { const GAS bf16* zr = Z + (rowbase + s) * ZLD + kvh * 64 + ch * 8;
                const v4u kv = *(const GAS v4u*)(zr + ZC_KB); const v4u vv = *(const GAS v4u*)(zr + ZC_VB);
                *(LAS v4u*)(lds + SWA_K_OFF + row * SWA_KP + ch * 16) = kv; *(LAS v4u*)(lds + SWA_V_OFF + row * SWA_VP + ch * 16) = vv; } }
        const int hq = kvh * 8 + wave; const int t = t0 + q;
        bf16x8 qf[4];
#pragma unroll
        for (int st = 0; st < 4; ++st) qf[st] = *(const GAS bf16x8*)(Z + (rowbase + t) * ZLD + ZC_QB + hq * 64 + 16 * st + 8 * hh);
        __syncthreads();
        const int kt0 = qt >= 4 ? 0 : 4 - qt;
        f32x16 sacc[5];
#pragma unroll
        for (int kt = 0; kt < 5; ++kt) {
#pragma unroll
            for (int r = 0; r < 16; ++r) sacc[kt][r] = 0.f;
            if (kt >= kt0) {
#pragma unroll
                for (int st = 0; st < 4; ++st) { const bf16x8 kf = *(const LAS bf16x8*)(lds + SWA_K_OFF + (kt * 32 + q) * SWA_KP + (2 * st + hh) * 16);
                    sacc[kt] = __builtin_amdgcn_mfma_f32_32x32x16_bf16(kf, qf[st], sacc[kt], 0, 0, 0); } } }
        const float sink = sinks[hq]; float mx = sink;
        const LAS float* tabh = tab + hq * 128;
#pragma unroll
        for (int kt = 0; kt < 5; ++kt) if (kt >= kt0) {
#pragma unroll
            for (int r = 0; r < 16; ++r) { const int ko = (r & 3) + 8 * (r >> 2) + 4 * hh; const int dist = q + 128 - 32 * kt - ko;
                const float lg = (dist >= 0 && dist < WINDOW) ? sacc[kt][r] + tabh[dist & 127] : -1e30f; sacc[kt][r] = lg; mx = fmaxf(mx, lg); } }
        mx = fmaxf(mx, SHX(mx, 32));
        float l = 0.f;
#pragma unroll
        for (int kt = 0; kt < 5; ++kt) if (kt >= kt0) {
#pragma unroll
            for (int r = 0; r < 16; ++r) { const float p = __expf(sacc[kt][r] - mx); sacc[kt][r] = p; l += p; } }
        l += SHX(l, 32); l += __expf(sink - mx);
        f32x16 oacc[2];
#pragma unroll
        for (int dt = 0; dt < 2; ++dt)
#pragma unroll
            for (int r = 0; r < 16; ++r) oacc[dt][r] = 0.f;
        const unsigned vlane = ldsb + SWA_V_OFF + (unsigned)((4 * hh + ((lane & 15) >> 2)) * SWA_VP + (16 * ((lane >> 4) & 1) + 4 * (lane & 3)) * 2);
#pragma unroll
        for (int kt = 0; kt < 5; ++kt) if (kt >= kt0) {
#pragma unroll
            for (int s2 = 0; s2 < 2; ++s2) {
                bf16x8 pf; { const unsigned w0 = pg8::cvt_pk_bf16(sacc[kt][8 * s2 + 0], sacc[kt][8 * s2 + 1]), w1 = pg8::cvt_pk_bf16(sacc[kt][8 * s2 + 2], sacc[kt][8 * s2 + 3]),
                                     w2 = pg8::cvt_pk_bf16(sacc[kt][8 * s2 + 4], sacc[kt][8 * s2 + 5]), w3 = pg8::cvt_pk_bf16(sacc[kt][8 * s2 + 6], sacc[kt][8 * s2 + 7]);
                    const v4u w = {w0, w1, w2, w3}; pf = __builtin_bit_cast(bf16x8, w); }
                const unsigned a = vlane + (unsigned)((kt * 32 + 16 * s2) * SWA_VP);
                s16x4 r0, r1, r2, r3; tr_read4(a, a + 8 * SWA_VP, a + 64, a + 8 * SWA_VP + 64, r0, r1, r2, r3);
                oacc[0] = __builtin_amdgcn_mfma_f32_32x32x16_bf16(cat4(r0, r1), pf, oacc[0], 0, 0, 0);
                oacc[1] = __builtin_amdgcn_mfma_f32_32x32x16_bf16(cat4(r2, r3), pf, oacc[1], 0, 0, 0); } }
        const float inv = 1.0f / l;
        GAS bf16* orow = O + (rowbase + t) * OLD + 2048 + hq * 64 + 4 * hh;
#pragma unroll
        for (int dt = 0; dt < 2; ++dt)
#pragma unroll
            for (int g4 = 0; g4 < 4; ++g4) { const unsigned long long w = (unsigned long long)pk2(oacc[dt][4 * g4] * inv, oacc[dt][4 * g4 + 1] * inv) | ((unsigned long long)pk2(oacc[dt][4 * g4 + 2] * inv, oacc[dt][4 * g4 + 3] * inv) << 32);
                *(GAS unsigned long long*)(orow + 32 * dt + 8 * g4) = w; }
        __syncthreads();
    }
}
constexpr int TK_BINS = 512, TK_CAP = 128;
#define LDS_ADD(p) __hip_atomic_fetch_add((p), 1u, __ATOMIC_RELAXED, __HIP_MEMORY_SCOPE_WORKGROUP)
constexpr int TK_HIST_OFF = 0, TK_CSC_OFF = 65536, TK_CIX_OFF = TK_CSC_OFF + 32 * TK_CAP * 4, TK_SEL_OFF = TK_CIX_OFF + 32 * TK_CAP * 2, TK_CNT_OFF = TK_SEL_OFF + 32 * 256 * 2, TK_DUM_OFF = TK_CNT_OFF + 32 * 2 * 4, TK_KB_OFF = TK_DUM_OFF + 8 * 64 * 4, TK_KB_BYTES = 64 * 144, TK_FLAG_OFF = TK_KB_OFF + 2 * TK_KB_BYTES;
static_assert(TK_FLAG_OFF + 16 <= RING_BYTES, "top-k LDS map");
__device__ __forceinline__ float tk_relu(float x) { const int b = __builtin_bit_cast(int, x); return __builtin_bit_cast(float, b < 0 ? 0 : b); }
__device__ __forceinline__ float tk_score(const f32x16& acc, int a, const float (&w)[8]) {
    float s = w[0] * tk_relu(acc[8 * a + 0]);
#pragma unroll
    for (int h = 1; h < 8; ++h) s = fmaf(w[h], tk_relu(acc[8 * a + h]), s);
    return s;
}
__device__ __forceinline__ float tk_x(float s, float sc) { return fmaf(s, sc, 256.0f); }
__device__ __forceinline__ int tk_key(float s, float sc) {
    const float x = tk_x(s, sc); int b0 = (int)x; b0 = b0 < 0 ? 0 : (b0 > TK_BINS - 1 ? TK_BINS - 1 : b0);
    int sub = (int)((x - (float)b0) * 512.0f); sub = sub < 0 ? 0 : (sub > 511 ? 511 : sub);
    return b0 * 512 + sub;
}
__device__ __forceinline__ void tk_find(const LAS unsigned* h, unsigned need, int lane, int& bin_out, unsigned& above_out) {
    unsigned v[8]; unsigned s = 0;
#pragma unroll
    for (int i = 0; i < 8; ++i) { v[i] = h[8 * lane + i]; s += v[i]; }
    unsigned S = s;
#pragma unroll
    for (int o = 1; o < 64; o <<= 1) { const unsigned t = (unsigned)__builtin_amdgcn_ds_bpermute((lane + o) << 2, (int)S); if (lane + o < 64) S += t; }
    const unsigned long long mask = __ballot(S >= need);
    const int Lm = mask ? 63 - __builtin_clzll(mask) : 0;
    unsigned cum = S - s; int bsel = 8 * lane; unsigned ab = cum; bool found = false;
#pragma unroll
    for (int i = 7; i >= 0; --i) { if (!found) { if (cum + v[i] >= need) { bsel = 8 * lane + i; ab = cum; found = true; } else cum += v[i]; } }
    bin_out = __builtin_amdgcn_readlane(bsel, Lm); above_out = (unsigned)__builtin_amdgcn_readlane((int)ab, Lm);
}
__device__ __forceinline__ void topk_phase(LAS unsigned char* lds, const GAS bf16* Z, const GAS bf16* KIN, const GAS float* WIF, GAS unsigned short* IDX, int vcu, int G, int lane, int wave) {
    LAS unsigned* hist = (LAS unsigned*)(lds + TK_HIST_OFF) + wave * 4 * TK_BINS;
    LAS float* csc = (LAS float*)(lds + TK_CSC_OFF) + wave * 4 * TK_CAP;
    LAS unsigned short* cix = (LAS unsigned short*)(lds + TK_CIX_OFF) + wave * 4 * TK_CAP;
    LAS unsigned short* sel = (LAS unsigned short*)(lds + TK_SEL_OFF) + wave * 4 * 256;
    LAS unsigned* cnt = (LAS unsigned*)(lds + TK_CNT_OFF) + wave * 8;
    LAS unsigned* dum = (LAS unsigned*)(lds + TK_DUM_OFF) + wave * 64 + lane;
    const int n = lane & 31, c = lane >> 5;
    const int am = (lane >> 4) & 1, bbm = (lane >> 3) & 1, ccm = (lane >> 2) & 1, dm = lane & 3;
    for (int p2 = vcu; p2 < BATCH * 64; p2 += G) {
#pragma unroll 1
        for (int half = 0; half < 2; ++half) {
            const int b = p2 >> 6, jj = p2 & 63, j = half ? 127 - jj : jj;
            const int t0 = 32 * j + 4 * wave; const size_t rb = (size_t)b * SEQ;
            bf16x8 qa[4];
#pragma unroll
            for (int st = 0; st < 4; ++st) qa[st] = *(const GAS bf16x8*)(Z + (rb + t0 + 2 * ccm + am) * ZLD + ZC_QI + (4 * bbm + dm) * 64 + 16 * st + 8 * c);
            float w0[8], w1[8];
            { const GAS f32x4* wp = (const GAS f32x4*)(WIF + (rb + t0 + 2 * c) * IH); const f32x4 x0 = wp[0], x1 = wp[1], x2 = wp[2], x3 = wp[3];
              w0[0] = x0.x; w0[1] = x0.y; w0[2] = x0.z; w0[3] = x0.w; w0[4] = x1.x; w0[5] = x1.y; w0[6] = x1.z; w0[7] = x1.w;
              w1[0] = x2.x; w1[1] = x2.y; w1[2] = x2.z; w1[3] = x2.w; w1[4] = x3.x; w1[5] = x3.y; w1[6] = x3.z; w1[7] = x3.w; }
            float scA, scB;
            { float a = 0.f, bq = 0.f;
#pragma unroll
              for (int h = 0; h < 8; ++h) { a = fmaf(w0[h], w0[h], a); bq = fmaf(w1[h], w1[h], bq); }
              scA = 32.0f / fmaxf(sqrtf(32.0f * a), 1e-20f); scB = 32.0f / fmaxf(sqrtf(32.0f * bq), 1e-20f); }
            const int tA = t0 + 2 * c, tB = tA + 1;
            for (int i = lane; i < 4 * TK_BINS; i += 64) hist[i] = 0u;
            for (int i = lane; i < 4 * 128; i += 64) ((LAS unsigned*)sel)[i] = 0u;
            if (lane < 8) cnt[lane] = 0u;
            asm volatile("s_waitcnt lgkmcnt(0)" ::: "memory");
            int lo[4], hi[4]; unsigned ab0[4]; bool ov[4];
#pragma unroll
            for (int tk = 0; tk < 4; ++tk) { lo[tk] = 0x7fffffff; hi[tk] = -1; ab0[tk] = 0u; ov[tk] = false; }
            const bool need_sel = (t0 + 3) >= TOPK;
            const GAS bf16* kbase = KIN + (rb + n) * IDIM + 8 * c;
            const int tidk = wave * 64 + lane; const int ng = (j + 2) >> 1;
            const GAS bf16* kg0 = KIN + (rb + (tidk >> 3)) * IDIM + (tidk & 7) * 8; const int koff = (tidk >> 3) * 144 + (tidk & 7) * 16;
            LAS unsigned char* kbuf = lds + TK_KB_OFF; volatile LAS unsigned* sflag = (volatile LAS unsigned*)(lds + TK_FLAG_OFF);
            if (tidk == 0) *sflag = 0u;
#define TK_PRIME() { const v4u kr0 = *(const GAS v4u*)kg0; *(LAS v4u*)(kbuf + koff) = kr0; } __syncthreads();
#define TK_GROUP_BEGIN() \
                v4u kr = {0u, 0u, 0u, 0u}; const bool more = g + 1 < ng; if (more) kr = *(const GAS v4u*)(kg0 + (size_t)(g + 1) * 64 * IDIM); \
                const LAS unsigned char* kb_ = kbuf + (g & 1) * TK_KB_BYTES; \
                _Pragma("unroll") for (int u4 = 0; u4 < 2; ++u4) { \
                    f32x16 acc; _Pragma("unroll") for (int r = 0; r < 16; ++r) acc[r] = 0.f; \
                    _Pragma("unroll") for (int st = 0; st < 4; ++st) { const bf16x8 kf = *(const LAS bf16x8*)(kb_ + (32 * u4 + n) * 144 + (2 * st + c) * 16); acc = __builtin_amdgcn_mfma_f32_32x32x16_bf16(qa[st], kf, acc, 0, 0, 0); } \
                    const float s0 = tk_score(acc, 0, w0), s1 = tk_score(acc, 1, w1); const int s = 32 * (2 * g + u4) + n;
#define TK_GROUP_END() } \
                if (more) *(LAS v4u*)(kbuf + ((g + 1) & 1) * TK_KB_BYTES + koff) = kr; \
                __syncthreads();
            bool slow = false;
            if (need_sel) {
                {   TK_PRIME();
#pragma unroll 1
                    for (int g = 0; g < ng; ++g) { TK_GROUP_BEGIN()
                        int b0 = (int)tk_x(s0, scA), b1 = (int)tk_x(s1, scB); b0 = b0 < 0 ? 0 : (b0 > TK_BINS - 1 ? TK_BINS - 1 : b0); b1 = b1 < 0 ? 0 : (b1 > TK_BINS - 1 ? TK_BINS - 1 : b1);
                        LAS unsigned* p0 = (s <= tA) ? &hist[(2 * c) * TK_BINS + b0] : dum; LAS unsigned* p1 = (s <= tB) ? &hist[(2 * c + 1) * TK_BINS + b1] : dum;
                        LDS_ADD(p0); LDS_ADD(p1);
                        TK_GROUP_END() }
                }
                asm volatile("s_waitcnt lgkmcnt(0)" ::: "memory");
#pragma unroll
                for (int tk = 0; tk < 4; ++tk) { int bin; unsigned above; tk_find(hist + tk * TK_BINS, (unsigned)TOPK, lane, bin, above);
                    const unsigned ceq = hist[tk * TK_BINS + bin]; ov[tk] = ceq > (unsigned)TK_CAP; slow |= ov[tk]; ab0[tk] = above; lo[tk] = bin * 512; hi[tk] = bin * 512 + 511; }
                if (slow && lane == 0) *sflag = 1u;
                __syncthreads();
                slow = *sflag != 0u;
            }
            if (!slow) {
                float thi[4], tlo[4];
#pragma unroll
                for (int tk = 0; tk < 4; ++tk) { const int bin = lo[tk] >> 9;
                    thi[tk] = !need_sel ? -__builtin_inff() : (bin >= TK_BINS - 1 ? __builtin_inff() : (float)(bin + 1));
                    tlo[tk] = !need_sel ? __builtin_inff() : (bin == 0 ? -__builtin_inff() : (float)bin); }
                const float thiA = c ? thi[2] : thi[0], tloA = c ? tlo[2] : tlo[0], thiB = c ? thi[3] : thi[1], tloB = c ? tlo[3] : tlo[1];
                unsigned cntA = 0u, cntB = 0u;
                LAS unsigned short* selA = sel + (2 * c) * 256; LAS unsigned short* selB = sel + (2 * c + 1) * 256; LAS unsigned short* dum16 = (LAS unsigned short*)dum;
                TK_PRIME();
#pragma unroll 1
                for (int g = 0; g < ng; ++g) { TK_GROUP_BEGIN()
                    const float x0 = (s <= tA) ? tk_x(s0, scA) : __builtin_nanf(""), x1 = (s <= tB) ? tk_x(s1, scB) : __builtin_nanf("");
                    const bool a0 = x0 >= thiA, a1 = x1 >= thiB; const bool c0 = !a0 && x0 >= tloA, c1 = !a1 && x1 >= tloB;
                    const unsigned long long m0 = __ballot(a0), m1 = __ballot(a1);
                    const unsigned pre0 = c ? __builtin_amdgcn_mbcnt_hi((unsigned)(m0 >> 32), 0u) : __builtin_amdgcn_mbcnt_lo((unsigned)m0, 0u);
                    const unsigned pre1 = c ? __builtin_amdgcn_mbcnt_hi((unsigned)(m1 >> 32), 0u) : __builtin_amdgcn_mbcnt_lo((unsigned)m1, 0u);
                    const unsigned pos0 = cntA + pre0, pos1 = cntB + pre1;
                    LAS unsigned short* q0 = (a0 && pos0 < 256u) ? selA + pos0 : dum16; LAS unsigned short* q1 = (a1 && pos1 < 256u) ? selB + pos1 : dum16;
                    *q0 = (unsigned short)s; *q1 = (unsigned short)s;
                    cntA += c ? (unsigned)__builtin_popcount((unsigned)(m0 >> 32)) : (unsigned)__builtin_popcount((unsigned)m0);
                    cntB += c ? (unsigned)__builtin_popcount((unsigned)(m1 >> 32)) : (unsigned)__builtin_popcount((unsigned)m1);
                    if (__ballot(c0 || c1)) {
                        if (c0) { const unsigned pos = LDS_ADD(&cnt[(2 * c) * 2 + 1]); if (pos < (unsigned)TK_CAP) { csc[(2 * c) * TK_CAP + pos] = s0; cix[(2 * c) * TK_CAP + pos] = (unsigned short)s; } }
                        if (c1) { const unsigned pos = LDS_ADD(&cnt[(2 * c + 1) * 2 + 1]); if (pos < (unsigned)TK_CAP) { csc[(2 * c + 1) * TK_CAP + pos] = s1; cix[(2 * c + 1) * TK_CAP + pos] = (unsigned short)s; } } }
                    TK_GROUP_END() }
                if ((lane & 31) == 0) { cnt[(2 * c) * 2] = cntA; cnt[(2 * c + 1) * 2] = cntB; }
                asm volatile("s_waitcnt lgkmcnt(0)" ::: "memory");
            } else {
                for (int i = lane; i < 4 * TK_BINS; i += 64) hist[i] = 0u;
                asm volatile("s_waitcnt lgkmcnt(0)" ::: "memory");
                int mode = 1;
#pragma unroll 1
                for (;;) {
                const int klo0 = c ? lo[2] : lo[0], khi0 = c ? hi[2] : hi[0], klo1 = c ? lo[3] : lo[1], khi1 = c ? hi[3] : hi[1];
                const bool ov0 = c ? ov[2] : ov[0], ov1 = c ? ov[3] : ov[1];
                bf16x8 kb[4][4];
#pragma unroll
                for (int u4 = 0; u4 < 4; ++u4) { const int kq = u4 < j ? u4 : j;
#pragma unroll
                    for (int st = 0; st < 4; ++st) kb[u4][st] = *(const GAS bf16x8*)(kbase + (size_t)kq * 32 * IDIM + 16 * st); }
#pragma unroll 1
                for (int kt = 0; kt <= j; kt += 4) {
                    bf16x8 kn[4][4];
#pragma unroll
                    for (int u4 = 0; u4 < 4; ++u4) { const int kq = kt + 4 + u4 < j ? kt + 4 + u4 : j;
#pragma unroll
                        for (int st = 0; st < 4; ++st) kn[u4][st] = *(const GAS bf16x8*)(kbase + (size_t)kq * 32 * IDIM + 16 * st); }
#pragma unroll
                    for (int u4 = 0; u4 < 4; ++u4) {
                        f32x16 acc;
#pragma unroll
                        for (int r = 0; r < 16; ++r) acc[r] = 0.f;
#pragma unroll
                        for (int st = 0; st < 4; ++st) acc = __builtin_amdgcn_mfma_f32_32x32x16_bf16(qa[st], kb[u4][st], acc, 0, 0, 0);
                        const float s0 = tk_score(acc, 0, w0), s1 = tk_score(acc, 1, w1);
                        const int s = 32 * (kt + u4) + n; const int k0 = tk_key(s0, scA), k1 = tk_key(s1, scB);
                        const bool v0 = s <= tA, v1 = s <= tB;
                        if (mode == 0) {
                            if (v0 && tA >= TOPK) LDS_ADD(&hist[(2 * c) * TK_BINS + (k0 >> 9)]);
                            if (v1 && tB >= TOPK) LDS_ADD(&hist[(2 * c + 1) * TK_BINS + (k1 >> 9)]);
                        } else if (mode == 1) {
                            if (v0 && ov0 && k0 >= klo0 && k0 <= khi0) LDS_ADD(&hist[(2 * c) * TK_BINS + (k0 & 511)]);
                            if (v1 && ov1 && k1 >= klo1 && k1 <= khi1) LDS_ADD(&hist[(2 * c + 1) * TK_BINS + (k1 & 511)]);
                        } else {
                            if (v0) { if (k0 > khi0) { const unsigned pos = LDS_ADD(&cnt[(2 * c) * 2]); if (pos < 256u) sel[(2 * c) * 256 + pos] = (unsigned short)s; }
                                      else if (k0 >= klo0) { const unsigned pos = LDS_ADD(&cnt[(2 * c) * 2 + 1]); if (pos < (unsigned)TK_CAP) { csc[(2 * c) * TK_CAP + pos] = s0; cix[(2 * c) * TK_CAP + pos] = (unsigned short)s; } } }
                            if (v1) { if (k1 > khi1) { const unsigned pos = LDS_ADD(&cnt[(2 * c + 1) * 2]); if (pos < 256u) sel[(2 * c + 1) * 256 + pos] = (unsigned short)s; }
                                      else if (k1 >= klo1) { const unsigned pos = LDS_ADD(&cnt[(2 * c + 1) * 2 + 1]); if (pos < (unsigned)TK_CAP) { csc[(2 * c + 1) * TK_CAP + pos] = s1; cix[(2 * c + 1) * TK_CAP + pos] = (unsigned short)s; } } }
                        }
                    }
#pragma unroll
                    for (int u4 = 0; u4 < 4; ++u4)
#pragma unroll
                        for (int st = 0; st < 4; ++st) kb[u4][st] = kn[u4][st];
                }
                    asm volatile("s_waitcnt lgkmcnt(0)" ::: "memory");
                    if (mode == 2) break;
#pragma unroll
                    for (int tk = 0; tk < 4; ++tk) if (ov[tk]) { int sub; unsigned above; tk_find(hist + tk * TK_BINS, (unsigned)TOPK - ab0[tk], lane, sub, above); lo[tk] += sub; hi[tk] = lo[tk]; }
                    mode = 2;
                }
            }
#undef TK_GROUP_BEGIN
#undef TK_GROUP_END
#undef TK_PRIME
#pragma unroll 1
            for (int tk = 0; tk < 4; ++tk) { const int t = t0 + tk;
                if (t >= TOPK) { const unsigned nsel = cnt[tk * 2]; unsigned nc = cnt[tk * 2 + 1]; nc = nc > (unsigned)TK_CAP ? (unsigned)TK_CAP : nc; const unsigned need = nsel < 256u ? 256u - nsel : 0u;
                    for (unsigned q = 0; q < 2; ++q) { const unsigned i = lane + 64 * q;
                        const float si = i < nc ? csc[tk * TK_CAP + i] : 0.f; const unsigned xi = i < nc ? cix[tk * TK_CAP + i] : 0u; unsigned rank = 0;
                        for (unsigned jx = 0; jx < nc; ++jx) { const float sj = csc[tk * TK_CAP + jx]; const unsigned xj = cix[tk * TK_CAP + jx]; rank += (sj > si || (sj == si && xj < xi)) ? 1u : 0u; }
                        if (i < nc && rank < need) sel[tk * 256 + nsel + rank] = (unsigned short)xi; } } }
            asm volatile("s_waitcnt lgkmcnt(0)" ::: "memory");
            { const LAS v4u* sv = (const LAS v4u*)sel; GAS v4u* ov = (GAS v4u*)(IDX + (rb + t0) * TOPK);
              ov[lane] = sv[lane]; ov[lane + 64] = sv[lane + 64]; }
            asm volatile("s_waitcnt vmcnt(0) lgkmcnt(0)" ::: "memory");
        }
    }
}
constexpr int DSA_TAB_OFF = RING_BYTES + 1024;
static_assert(DSA_TAB_OFF + 8 * 129 * 4 <= LDS_BYTES, "DSA LDS map");
__device__ __forceinline__ void dsa_phase(LAS unsigned char* lds_all, const GAS bf16* Z, const GAS bf16* CKVN, const GAS unsigned short* IDX, GAS bf16* O, const GAS float* rel_bias, int gw, int NGW, int tid, int lane, int wave) {
    LAS float* tab = (LAS float*)(lds_all + DSA_TAB_OFF);
    for (int e = tid; e < 8 * 129; e += NWAVES * 64) { const int hh = e / 129, dist = e - hh * 129; tab[e] = rel_bias[(dist < 128 ? (int)T5_BUCKET[dist] : 31) * 24 + hh]; }
    __syncthreads();
    LAS unsigned char* img = lds_all + RING_OFF + wave * 16384;
    const unsigned imgb = (unsigned)(size_t)img;
    const int h = lane & 15, g = lane >> 4;
    const LAS float* tabh = tab + (h & 7) * 129;
    const int TPW = (M + NGW - 1) / NGW;
    const int tok_end = (gw + 1) * TPW < M ? (gw + 1) * TPW : M;
    const int xq = 2 * (lane & 7);
    const int qk_off = (lane & 15) * 512;
    const int q4 = (lane & 15) >> 2, p4 = lane & 3; const int xr = 2 * (4 * (g & 1) + q4);
    const unsigned pv_base = imgb + (unsigned)((4 * g + q4) * 512 + 8 * (p4 & 1));
#pragma unroll 1
    for (int tok = gw * TPW; tok < tok_end; ++tok) {
        const int t = tok & (SEQ - 1); const size_t rb = (size_t)(tok - t);
        const int nsel = t + 1 < TOPK ? t + 1 : TOPK;
        bf16x8 qf[8];
#pragma unroll
        for (int st = 0; st < 8; ++st) { qf[st] = *(const GAS bf16x8*)(Z + (size_t)tok * ZLD + ZC_QLAT + (h & 7) * 256 + 32 * st + 8 * g); if (h >= 8) qf[st] = (bf16x8){0, 0, 0, 0, 0, 0, 0, 0}; }
        f32x4 oacc[16];
#pragma unroll
        for (int rt = 0; rt < 16; ++rt) oacc[rt] = (f32x4){0.f, 0.f, 0.f, 0.f};
        float mrun = -1e30f, lsum = 0.f;
        const GAS unsigned short* ip = IDX + (size_t)tok * TOPK;
#pragma unroll 1
        for (int ch = 0; ch < 8; ++ch) {
            if (32 * ch >= nsel) break;
            const int ixv = (int)ip[32 * ch + (lane & 31)];
            const unsigned long long i0 = *(const GAS unsigned long long*)(ip + 32 * ch + 4 * g), i1 = *(const GAS unsigned long long*)(ip + 32 * ch + 16 + 4 * g);
            asm volatile("s_waitcnt lgkmcnt(0)" ::: "memory");
#pragma unroll
            for (int i = 0; i < 16; ++i) { const int r0 = __builtin_amdgcn_readlane(ixv, 2 * i), r1 = __builtin_amdgcn_readlane(ixv, 2 * i + 1);
                const int row = 2 * i + (lane >> 5); const int ridx = lane < 32 ? r0 : r1; const int chunk = (lane & 31) ^ (2 * (row & 7));
                const GAS unsigned char* src = (const GAS unsigned char*)(CKVN + (rb + ridx) * RANK) + chunk * 16;
                __builtin_amdgcn_global_load_lds((const GAS unsigned*)src, (LAS unsigned*)(img + i * 1024), 16, 0, 0); }
            asm volatile("s_waitcnt vmcnt(0)" ::: "memory");
            f32x4 sa[2];
#pragma unroll
            for (int tl = 0; tl < 2; ++tl) { sa[tl] = (f32x4){0.f, 0.f, 0.f, 0.f};
#pragma unroll
                for (int st = 0; st < 8; ++st) { const bf16x8 a = *(const LAS bf16x8*)(img + qk_off + tl * 16 * 512 + (((4 * st + g) ^ xq) * 16));
                    sa[tl] = __builtin_amdgcn_mfma_f32_16x16x32_bf16(a, qf[st], sa[tl], 0, 0, 0); } }
            float lg[8]; float cmax = -1e30f;
#pragma unroll
            for (int e = 0; e < 8; ++e) { const int tl = e >> 2, jx = e & 3; const int kk = 32 * ch + 16 * tl + 4 * g + jx;
                const int sidx = (int)(((tl ? i1 : i0) >> (16 * jx)) & 0xffffull); int dd = t - sidx; dd = dd < 0 ? 0 : (dd > 128 ? 128 : dd);
                const float v = kk < nsel ? sa[tl][jx] + tabh[dd] : -1e30f; lg[e] = v; cmax = fmaxf(cmax, v); }
            cmax = fmaxf(cmax, SHX(cmax, 16)); cmax = fmaxf(cmax, SHX(cmax, 32));
            const float mnew = fmaxf(mrun, cmax);
            if (__any(mnew > mrun)) { const float alpha = __expf(mrun - mnew); lsum *= alpha;
#pragma unroll
                for (int rt = 0; rt < 16; ++rt) oacc[rt] = oacc[rt] * alpha; }
            mrun = mnew;
            float pe[8];
#pragma unroll
            for (int e = 0; e < 8; ++e) { pe[e] = __expf(lg[e] - mnew); lsum += pe[e]; }
            bf16x8 pf; { const v4u wv = {pg8::cvt_pk_bf16(pe[0], pe[1]), pg8::cvt_pk_bf16(pe[2], pe[3]), pg8::cvt_pk_bf16(pe[4], pe[5]), pg8::cvt_pk_bf16(pe[6], pe[7])}; pf = __builtin_bit_cast(bf16x8, wv); }
#pragma unroll
            for (int rt = 0; rt < 16; rt += 2) {
                const unsigned a0 = pv_base + (unsigned)((((2 * rt) ^ xr) | (p4 >> 1)) * 16), a1 = pv_base + (unsigned)((((2 * rt + 2) ^ xr) | (p4 >> 1)) * 16);
                s16x4 r0, r1, r2, r3; tr_read4(a0, a0 + 16 * 512, a1, a1 + 16 * 512, r0, r1, r2, r3);
                oacc[rt] = __builtin_amdgcn_mfma_f32_16x16x32_bf16(cat4(r0, r1), pf, oacc[rt], 0, 0, 0);
                oacc[rt + 1] = __builtin_amdgcn_mfma_f32_16x16x32_bf16(cat4(r2, r3), pf, oacc[rt + 1], 0, 0, 0); }
        }
        lsum += SHX(lsum, 16); lsum += SHX(lsum, 32);
        const float inv = 1.0f / lsum;
        if (h < 8) { GAS bf16* orow = O + (size_t)tok * OLD + h * 256 + 4 * g;
#pragma unroll
            for (int rt = 0; rt < 16; ++rt) *(GAS unsigned long long*)(orow + 16 * rt) = (unsigned long long)pk2(oacc[rt][0] * inv, oacc[rt][1] * inv) | ((unsigned long long)pk2(oacc[rt][2] * inv, oacc[rt][3] * inv) << 32); }
    }
}
struct Args { const float* in[20]; float* out; unsigned char* ws; };
__device__ __forceinline__ unsigned long long karg_u64(int idx) { unsigned long long r; const unsigned off = (unsigned)idx * 8u;
    asm volatile("s_load_dwordx2 %0, %1, %2\n\ts_waitcnt lgkmcnt(0)" : "=s"(r) : "s"(__builtin_amdgcn_kernarg_segment_ptr()), "s"(off) : "memory"); return r; }
__device__ __forceinline__ const GAS float* karg_in(int i) { return (const GAS float*)karg_u64(i); }
__device__ __forceinline__ GAS float* karg_out() { return (GAS float*)karg_u64(20); }
__device__ __forceinline__ GAS unsigned char* karg_ws() { return (GAS unsigned char*)karg_u64(21); }
#ifndef REP_P0
#define REP_P0 1
#endif
#ifndef REP_NORM
#define REP_NORM 1
#endif
#ifndef REP_GU
#define REP_GU 1
#endif
#ifndef REP_IN
#define REP_IN 1
#endif
#ifndef REP_POST
#define REP_POST 1
#endif
#ifndef REP_TOPK
#define REP_TOPK 1
#endif
#ifndef REP_DSA
#define REP_DSA 1
#endif
#define REPEAT(n) _Pragma("unroll 1") for (int rep_ = 0; rep_ < (n); ++rep_)
#define PHASE_IDS() int tid = threadIdx.x; asm volatile("" : "+v"(tid)); int bx = blockIdx.x; asm volatile("" : "+s"(bx)); int G = gridDim.x; asm volatile("" : "+s"(G)); \
    const int lane = tid & 63, wave = __builtin_amdgcn_readfirstlane(tid >> 6); const int vcu = (G % 8 == 0) ? (bx % 8) * (G / 8) + bx / 8 : bx; const int gw = vcu * NWAVES + wave, NGW = G * NWAVES; \
    GAS unsigned char* ws = karg_ws(); (void)lane; (void)gw; (void)NGW; (void)vcu; (void)ws
__global__ void __launch_bounds__(NWAVES * 64, 2) mk_fwd(Args args) {
    extern __shared__ __attribute__((aligned(16))) unsigned char lds_raw[];
    LAS unsigned char* lds = (LAS unsigned char*)lds_raw;
    volatile LAS unsigned* MISC = (volatile LAS unsigned*)(lds + MISC_OFF);
    for (int u = threadIdx.x; u < (LDS_BYTES - LDSCTL_OFF) / 4; u += NWAVES * 64) ((LAS unsigned*)(lds + LDSCTL_OFF))[u] = 0u;
    __syncthreads();
    (void)xcd_barrier_post((unsigned*)((gu32*)(karg_ws() + WS_CTL) + CW_BAR), MISC + 8);
#define GRID_BAR() do { XcdBarrier b_; b_.bar = (unsigned*)((gu32*)(karg_ws() + WS_CTL) + CW_BAR); b_.x = xb_xcc_id(); b_.st = MISC + 8; xcd_barrier(b_); } while (0)

    REPEAT(REP_P0) {   PHASE_IDS();
        LAS float* scr = (LAS float*)(lds + RING_OFF + wave * 16384);
        rows_bf16_ss(karg_in(0), (GAS bf16*)(ws + WS_XN), f8_on(0, 0) ? (GAS unsigned char*)(ws + WS_HB8) : (GAS unsigned char*)nullptr, (GAS float*)(ws + WS_SS), gw, NGW, lane);
        constexpr int I_GU = (D / 64) * (FF / 32), I_DN = (FF / 64) * (D / 32);
        constexpr int I_FFN = 2 * I_GU + I_DN, I_IN = 72 * (D / 64), I_OB = (1024 / 64) * (D / 32);
        constexpr int PER_LAYER = 2 * I_FFN + I_IN + I_OB;
        for (int it = gw; it < DEPTH * PER_LAYER; it += NGW) {
            const int l = it / PER_LAYER; int r = it - l * PER_LAYER;
            GAS unsigned char* wl = ws + WS_W0 + (size_t)l * W_LAYER;
            if (r < 2 * I_FFN) {
                const int f = r / I_FFN; r -= f * I_FFN;
                GAS bf16* dgu = (GAS bf16*)(wl + (f ? WO_GU2 : WO_GU1)); GAS bf16* dd = (GAS bf16*)(wl + (f ? WO_D2 : WO_D1));
                if (r < 2 * I_GU) { const int up = r >= I_GU; if (up) r -= I_GU; const int kb = r / (FF / 32), nb = r % (FF / 32), n0 = 32 * nb;
                    const GAS float* wsrc = karg_in(up ? (f ? 17 : 4) : (f ? 16 : 3)) + (size_t)l * D * FF;
                    const int drow = (n0 >> 7) * 256 + (up ? 128 : 0) + (n0 & 127);
                    if (f8_on(l, f)) conv_item<true>(wsrc, FF, 64 * kb, n0, 32, dgu, D, drow, 0, W8_SCALE, karg_in(f ? 15 : 2) + (size_t)l * D, scr, lane);
                    else conv_item(wsrc, FF, 64 * kb, n0, 32, dgu, D, drow, 0, 1.0f, karg_in(f ? 15 : 2) + (size_t)l * D, scr, lane); }
                else { r -= 2 * I_GU; const int kb = r / (D / 32), nb = r % (D / 32);
                    conv_item(karg_in(f ? 18 : 5) + (size_t)l * FF * D, D, 64 * kb, 32 * nb, 32, dd, FF, 32 * nb, 0, 1.0f, nullptr, scr, lane); }
            } else if (r < 2 * I_FFN + I_IN) {
                r -= 2 * I_FFN; const int j = r >> 5, kb = r & 31; int src, nvalid = 32; float sc = 1.0f;
                if (j < 8) src = 1024 + 32 * j;
                else if (j < 24) src = 1280 + 32 * (j - 8);
                else if (j < 56) { src = 1864 + 32 * (j - 24); sc = 0.125f; }
                else if (j < 60) src = 2888 + 32 * (j - 56);
                else if (j < 64) src = 3016 + 32 * (j - 60);
                else if (j < 66) src = 1792 + 32 * (j - 64);
                else if (j == 66) { src = 1856; nvalid = 8; sc = 0.044194173824159216f; }
                else { src = 0; nvalid = 0; }
                conv_item(karg_in(7) + (size_t)l * D * D_IN, D_IN, 64 * kb, src, nvalid, (GAS bf16*)(wl + WO_IN), D, 2048 + 32 * j, 0, sc, karg_in(6) + (size_t)l * D, scr, lane);
            } else {
                r -= 2 * I_FFN + I_IN; const int kb = r >> 6, nb = r & 63;
                conv_item(karg_in(14) + (size_t)l * D * D + (size_t)1024 * D, D, 64 * kb, 32 * nb, 32, (GAS bf16*)(wl + WO_OUT), OLD, 32 * nb, 2048, 1.0f, nullptr, scr, lane);
            }
        }
        __syncthreads();
        LAS float* Ps = (LAS float*)(lds + RING_OFF); LAS float* Qs = Ps + 64 * 129;
        for (int u = vcu; u < DEPTH * 2048; u += G) {
            const int l = u >> 11, which = (u >> 10) & 1, v = u & 1023;
            GAS unsigned char* wl = ws + WS_W0 + (size_t)l * W_LAYER;
            if (which == 0) { const int h = v >> 7, rt = (v >> 5) & 3, kt = v & 31;
                absorb_unit<false>(karg_in(11) + (size_t)l * RANK * 1024 + ((size_t)(64 * rt) * 8 + h) * 128, 1024, 1, karg_in(7) + (size_t)l * D * D_IN + (size_t)(64 * kt) * D_IN + h * 128, D_IN,
                                   (GAS bf16*)(wl + WO_IN) + (size_t)(h * 256 + 64 * rt) * D + 64 * kt, D, 0.08838834764831845f, karg_in(6) + (size_t)l * D + 64 * kt, Ps, Qs, tid); }
            else { const int h = v >> 7, nt = (v >> 2) & 31, rt = v & 3;
                absorb_unit<true>(karg_in(14) + (size_t)l * D * D + (size_t)(h * 128) * D + 64 * nt, 1, D, karg_in(12) + (size_t)l * RANK * 1024 + ((size_t)(64 * rt) * 8 + h) * 128, 1024,
                                  (GAS bf16*)(wl + WO_OUT) + (size_t)(64 * nt) * OLD + h * 256 + 64 * rt, OLD, 1.0f, nullptr, Ps, Qs, tid); }
        }
    }
    GRID_BAR();

#pragma unroll 1
    for (int s = 0; s < 2 * DEPTH; ++s) {
        const int l = s >> 1, f = s & 1;
        REPEAT(REP_GU) {   PHASE_IDS(); GAS unsigned char* wl = ws + WS_W0 + (size_t)l * W_LAYER;
            pg8::StaticOrder S; S.init(M, NGU, G, bx);
            const GAS float* ssp = (const GAS float*)(ws + WS_SS + (size_t)((3 * l + 2 * f) & 1) * SS_BYTES);
            if ((F8_MASK == 0xF) || (F8_MASK != 0 && f8_on(l, f))) {
                if constexpr (F8_MASK != 0) {
                    pg8::Gemm g{(const GAS bf16*)(ws + WS_HB8), (const GAS bf16*)(wl + (f ? WO_GU2 : WO_GU1)), M, NGU, D / 2};
                    pg8::EpiSwiglu E{(GAS bf16*)(ws + WS_ACT), FF, ssp, 1.0f / D, EPS, 1.0f / W8_SCALE};
                    pg8::gemm_phase<pg8::EpiSwiglu, pg8::StaticOrder, true, true, true>(lds + RING_OFF, g, S, E); }
            } else {
                if constexpr (F8_MASK != 0xF) {
                    pg8::Gemm g{(const GAS bf16*)(ws + WS_XN), (const GAS bf16*)(wl + (f ? WO_GU2 : WO_GU1)), M, NGU, D};
                    pg8::EpiSwiglu E{(GAS bf16*)(ws + WS_ACT), FF, ssp, 1.0f / D, EPS, 1.0f};
                    pg8::gemm_phase<pg8::EpiSwiglu, pg8::StaticOrder, true, true, false>(lds + RING_OFF, g, S, E); }
            } }
        GRID_BAR();
        {   PHASE_IDS(); GAS unsigned char* wl = ws + WS_W0 + (size_t)l * W_LAYER;
            pg8::Gemm g{(const GAS bf16*)(ws + WS_ACT), (const GAS bf16*)(wl + (f ? WO_D2 : WO_D1)), M, D, FF}; pg8::StaticOrder S; S.init(M, D, G, bx);
            pg8::EpiResid E{0.5f, (unsigned)WS_XN, (unsigned)(WS_SS + (size_t)((3 * l + 2 * f + 1) & 1) * SS_BYTES), (f == 1 && l + 1 < DEPTH && f8_on(l + 1, 0)) ? (unsigned)WS_HB8 : 0u};
            pg8::gemm_phase<pg8::EpiResid, pg8::StaticOrder, true, true>(lds + RING_OFF, g, S, E); }
        GRID_BAR();
        if (f == 0) {
            REPEAT(REP_IN) {   PHASE_IDS(); GAS unsigned char* wl = ws + WS_W0 + (size_t)l * W_LAYER;
                pg8::Gemm g{(const GAS bf16*)(ws + WS_XN), (const GAS bf16*)(wl + WO_IN), M, ZLD, D}; pg8::StaticOrder S; S.init(M, ZLD, G, bx);
                pg8::EpiBf16 E{(GAS bf16*)(ws + WS_Z), ZLD, (const GAS float*)(ws + WS_SS + (size_t)((3 * l + 1) & 1) * SS_BYTES), 1.0f / D, EPS};
                pg8::gemm_phase<pg8::EpiBf16, pg8::StaticOrder, true, true>(lds + RING_OFF, g, S, E); }
            GRID_BAR();
            REPEAT(REP_POST) {   PHASE_IDS();
                post_rows((const GAS bf16*)(ws + WS_Z), karg_in(8) + (size_t)l * RANK, karg_in(9) + (size_t)l * IDIM, karg_in(10) + (size_t)l * IDIM, (GAS bf16*)(ws + WS_CKVN), (GAS bf16*)(ws + WS_KIN), (GAS float*)(ws + WS_WIF), gw, NGW, lane);
                swa_phase(lds + RING_OFF, (const GAS bf16*)(ws + WS_Z), (GAS bf16*)(ws + WS_O), karg_in(1), karg_in(13) + (size_t)l * H_B, vcu, G, tid, lane, wave);
            }
            GRID_BAR();
            REPEAT(REP_TOPK) {   PHASE_IDS(); topk_phase(lds + RING_OFF, (const GAS bf16*)(ws + WS_Z), (const GAS bf16*)(ws + WS_KIN), (const GAS float*)(ws + WS_WIF), (GAS unsigned short*)(ws + WS_IDX), vcu, G, lane, wave); }
            GRID_BAR();
            REPEAT(REP_DSA) {   PHASE_IDS(); dsa_phase(lds, (const GAS bf16*)(ws + WS_Z), (const GAS bf16*)(ws + WS_CKVN), (const GAS unsigned short*)(ws + WS_IDX), (GAS bf16*)(ws + WS_O), karg_in(1), gw, NGW, tid, lane, wave); }
            GRID_BAR();
            {   PHASE_IDS(); GAS unsigned char* wl = ws + WS_W0 + (size_t)l * W_LAYER;
                pg8::Gemm g{(const GAS bf16*)(ws + WS_O), (const GAS bf16*)(wl + WO_OUT), M, D, OLD}; pg8::StaticOrder S; S.init(M, D, G, bx);
                pg8::EpiResid E{1.0f, (unsigned)WS_XN, (unsigned)(WS_SS + (size_t)((3 * l + 2) & 1) * SS_BYTES), f8_on(l, 1) ? (unsigned)WS_HB8 : 0u};
                pg8::gemm_phase<pg8::EpiResid, pg8::StaticOrder, true, true>(lds + RING_OFF, g, S, E); }
            GRID_BAR();
        }
    }
    {   PHASE_IDS(); final_rows((const GAS bf16*)(ws + WS_XN), karg_out(), karg_in(19), (const GAS float*)(ws + WS_SS + (size_t)(6 & 1) * SS_BYTES), gw, NGW, lane); }
}

extern "C" void kernel_launch(void* const* d_in, const int* in_sizes, int n_in, void* d_out, int out_size, void* d_ws, size_t ws_size, hipStream_t stream) {
    static int grid = 0;
    if (grid == 0) {
        if (n_in != 20 || in_sizes[0] != M * D || out_size != M * D || ws_size < WS_END) { fprintf(stderr, "kernel_launch: unexpected shapes (n_in %d, in0 %d, out %d, ws %zu); nothing launched\n", n_in, n_in > 0 ? in_sizes[0] : -1, out_size, ws_size); grid = -1; return; }
        int dev = 0, cus = 0, per_cu = 0;
        if (hipGetDevice(&dev) != hipSuccess || hipDeviceGetAttribute(&cus, hipDeviceAttributeMultiprocessorCount, dev) != hipSuccess) { grid = -1; return; }
        if (hipFuncSetAttribute((const void*)mk_fwd, hipFuncAttributeMaxDynamicSharedMemorySize, LDS_BYTES) != hipSuccess) { fprintf(stderr, "kernel_launch: hipFuncSetAttribute failed\n"); grid = -1; return; }
        if (hipOccupancyMaxActiveBlocksPerMultiprocessor(&per_cu, (const void*)mk_fwd, NWAVES * 64, LDS_BYTES) != hipSuccess || per_cu < 1) { fprintf(stderr, "kernel_launch: occupancy query reports %d workgroups per CU\n", per_cu); }
        (void)hipGetLastError();
        grid = cus;
    }
    if (grid < 0) return;
    if (hipMemsetAsync((char*)d_ws + WS_CTL, 0, CTL_ZERO_BYTES, stream) != hipSuccess) return;
    Args a{};
    for (int i = 0; i < 20; ++i) a.in[i] = (const float*)d_in[i];
    a.out = (float*)d_out; a.ws = (unsigned char*)d_ws;
    hipLaunchKernelGGL(mk_fwd, dim3(grid), dim3(NWAVES * 64), LDS_BYTES, stream, a);
}
```

```cpp
#define F8_MASK 0xA
#define D8_MASK 0xA
#include <hip/hip_runtime.h>
#include <cstdio>
#include <cstdint>
namespace pg8 {
#define PG8_LAS __attribute__((address_space(3)))
#define PG8_GAS __attribute__((address_space(1)))
typedef unsigned short bf16_t;
typedef short bf16x8 __attribute__((ext_vector_type(8)));
typedef float f32x4 __attribute__((ext_vector_type(4)));
typedef unsigned u32x4 __attribute__((ext_vector_type(4)));
constexpr int BM = 256, BK = 64, HALF = 128, HTB = HALF * BK * 2  , STAGE_BYTES = 8 * HTB, NXCD = 8, WGM = 8;

__host__ __device__ __forceinline__ int lds_byte(int r, int c) { const int st = (r >> 4) * 2 + (c >> 5), rr = r & 15, cc = c & 31, ob = rr * 64 + cc * 2; return st * 1024 + (ob ^ (((ob >> 9) & 1) << 5)); }
__host__ __device__ __forceinline__ void stage_rc(int b, int& R, int& C) { const int st = b / 1024, sb = b % 1024, swz = sb ^ (((sb >> 9) & 1) << 5); R = (st >> 1) * 16 + swz / 64; C = (st & 1) * 32 + (swz % 64) / 2; }
__host__ __device__ __forceinline__ int perm32(int rho) { const int n = rho >> 4, i = rho & 15; return 8 * (i >> 2) + 4 * n + (i & 3); }

typedef int i32x8 __attribute__((ext_vector_type(8))); typedef int i32x4v __attribute__((ext_vector_type(4)));
__device__ __forceinline__ i32x8 cat8(bf16x8 a, bf16x8 b) { return __builtin_shufflevector(__builtin_bit_cast(i32x4v, a), __builtin_bit_cast(i32x4v, b), 0, 1, 2, 3, 4, 5, 6, 7); }
struct Unit { int pm, pn; };
struct Gemm { const PG8_GAS bf16_t* A; const PG8_GAS bf16_t* Bt; int M, N, K; };

struct StaticOrder {
    int nM, nN, nwg, G, c;
    __host__ __device__ void init(int M, int N, int G_, int c_) { nM = M / BM; nN = N / BM; nwg = nM * nN; G = G_; c = c_; }
    __host__ __device__ bool next(int i, Unit& u) const {
        const long L = (long)i * G + c; if (L >= nwg) return false;
        int wgid = (int)L; { const int q = nwg / NXCD, r = nwg % NXCD, xcd = wgid % NXCD, off = wgid / NXCD; wgid = (xcd < r ? xcd * (q + 1) : r * (q + 1) + (xcd - r) * q) + off; }
        const int nig = WGM * nN, gid = wgid / nig, fm = gid * WGM, gsz = (nM - fm) < WGM ? (nM - fm) : WGM;
        u.pm = fm + ((wgid % nig) % gsz); u.pn = (wgid % nig) / gsz; return true;
    }
    __device__ __forceinline__ void a_ready(const Unit&) const {}
    __device__ __forceinline__ void done(const Unit&) const {}
};
__device__ __forceinline__ unsigned long long karg64(int idx) { unsigned long long r; const unsigned off = (unsigned)idx * 8u;
    asm volatile("s_load_dwordx2 %0, %1, %2\n\ts_waitcnt lgkmcnt(0)" : "=s"(r) : "s"(__builtin_amdgcn_kernarg_segment_ptr()), "s"(off) : "memory"); return r; }
__device__ __forceinline__ unsigned cvt_pk_bf16(float lo, float hi) { unsigned r; asm volatile("v_cvt_pk_bf16_f32 %0, %1, %2" : "=v"(r) : "v"(lo), "v"(hi)); return r; }
__device__ __forceinline__ float silu_f(float g) { return g * __builtin_amdgcn_rcpf(1.0f + __builtin_amdgcn_exp2f(-1.4426950408889634f * g)); }

struct EpiSwiglu {
    static constexpr bool PERM = true, AFTER_DRAIN = false;
    PG8_GAS bf16_t* O; int ldc; const PG8_GAS float* ss; float inv_k, eps, post; float out8;
    __device__ __forceinline__ void operator()(const f32x4 (&acc)[2][2][4][2], const Unit& u, int wr, int wc, int fr, int fq) const {
        const int row0 = u.pm * BM + wr * 64 + fr, col0 = u.pn * HALF + wc * 32 + 8 * fq;
        float rs[8]; const int lane_ = fr + 16 * fq;
#pragma unroll
        for (int k = 0; k < 8; ++k) { const PG8_GAS f32x4* p4 = (const PG8_GAS f32x4*)(ss + (size_t)(row0 + (k >> 2) * HALF + (k & 3) * 16) * 32 + 8 * fq); const f32x4 a = p4[0], b = p4[1];
            float t = ((a[0] + a[1]) + (a[2] + a[3])) + ((b[0] + b[1]) + (b[2] + b[3]));
            t += __builtin_bit_cast(float, __builtin_amdgcn_ds_bpermute((lane_ ^ 16) << 2, __builtin_bit_cast(int, t)));
            t += __builtin_bit_cast(float, __builtin_amdgcn_ds_bpermute((lane_ ^ 32) << 2, __builtin_bit_cast(int, t))); rs[k] = t; }
#pragma unroll
        for (int ai = 0; ai < 2; ++ai)
#pragma unroll
            for (int m = 0; m < 4; ++m) { PG8_GAS bf16_t* rowp = O + (size_t)(row0 + ai * HALF + m * 16) * ldc + col0;
                const float r = __builtin_amdgcn_rsqf(rs[ai * 4 + m] * inv_k + eps) * post;
                const f32x4 g0 = acc[ai][0][m][0] * r, g1 = acc[ai][0][m][1] * r, u0 = acc[ai][1][m][0] * r, u1 = acc[ai][1][m][1] * r;
                if (out8 != 0.f) { int p = 0, q = 0;
                    p = __builtin_amdgcn_cvt_pk_fp8_f32(silu_f(g0[0]) * u0[0] * out8, silu_f(g0[1]) * u0[1] * out8, p, false); p = __builtin_amdgcn_cvt_pk_fp8_f32(silu_f(g0[2]) * u0[2] * out8, silu_f(g0[3]) * u0[3] * out8, p, true);
                    q = __builtin_amdgcn_cvt_pk_fp8_f32(silu_f(g1[0]) * u1[0] * out8, silu_f(g1[1]) * u1[1] * out8, q, false); q = __builtin_amdgcn_cvt_pk_fp8_f32(silu_f(g1[2]) * u1[2] * out8, silu_f(g1[3]) * u1[3] * out8, q, true);
                    typedef unsigned u32x2v __attribute__((ext_vector_type(2))); u32x2v w8; w8.x = (unsigned)p; w8.y = (unsigned)q;
                    *(PG8_GAS u32x2v*)((PG8_GAS unsigned char*)O + (size_t)(row0 + ai * HALF + m * 16) * ldc + col0) = w8; }
                else { u32x4 w; w.x = cvt_pk_bf16(silu_f(g0[0]) * u0[0], silu_f(g0[1]) * u0[1]); w.y = cvt_pk_bf16(silu_f(g0[2]) * u0[2], silu_f(g0[3]) * u0[3]);
                w.z = cvt_pk_bf16(silu_f(g1[0]) * u1[0], silu_f(g1[1]) * u1[1]); w.w = cvt_pk_bf16(silu_f(g1[2]) * u1[2], silu_f(g1[3]) * u1[3]);
                *(PG8_GAS u32x4*)rowp = w; } }
    }
};
struct EpiResid {
    static constexpr bool PERM = true, AFTER_DRAIN = false;
    float alpha; unsigned hb_off; unsigned ss_off; unsigned h8_off;
    __device__ __forceinline__ void operator()(const f32x4 (&acc)[2][2][4][2], const Unit& u, int wr, int wc, int fr, int fq) const {
        constexpr int ldc = 2048;
        PG8_GAS unsigned char* wsb = (PG8_GAS unsigned char*)karg64(21); PG8_GAS bf16_t* hb = (PG8_GAS bf16_t*)(wsb + hb_off); PG8_GAS float* ss = (PG8_GAS float*)(wsb + ss_off);
        const int row0 = u.pm * BM + wr * 64 + fr, col0 = u.pn * BM + wc * 32 + 8 * fq; const int lane = fr + 16 * fq;
        u32x4 cur[2], nxt[2];
        { const size_t off = (size_t)row0 * ldc + col0; cur[0] = *(const PG8_GAS u32x4*)(hb + off); cur[1] = *(const PG8_GAS u32x4*)(hb + off + HALF); }
#pragma unroll
        for (int k = 0; k < 8; ++k) { const int ai = k >> 2, m = k & 3; const int row = row0 + ai * HALF + m * 16; const size_t off = (size_t)row * ldc + col0;
            if (k < 7) { const int ai2 = (k + 1) >> 2, m2 = (k + 1) & 3; const size_t off2 = (size_t)(row0 + ai2 * HALF + m2 * 16) * ldc + col0;
                nxt[0] = *(const PG8_GAS u32x4*)(hb + off2); nxt[1] = *(const PG8_GAS u32x4*)(hb + off2 + HALF); }
            float sq = 0.f;
#pragma unroll
            for (int bj = 0; bj < 2; ++bj) { const u32x4 b = cur[bj]; const f32x4 a0 = acc[ai][bj][m][0], a1 = acc[ai][bj][m][1]; u32x4 w;
                w.x = cvt_pk_bf16(__builtin_bit_cast(float, b.x << 16) + a0[0] * alpha, __builtin_bit_cast(float, b.x & 0xffff0000u) + a0[1] * alpha);
                w.y = cvt_pk_bf16(__builtin_bit_cast(float, b.y << 16) + a0[2] * alpha, __builtin_bit_cast(float, b.y & 0xffff0000u) + a0[3] * alpha);
                w.z = cvt_pk_bf16(__builtin_bit_cast(float, b.z << 16) + a1[0] * alpha, __builtin_bit_cast(float, b.z & 0xffff0000u) + a1[1] * alpha);
                w.w = cvt_pk_bf16(__builtin_bit_cast(float, b.w << 16) + a1[2] * alpha, __builtin_bit_cast(float, b.w & 0xffff0000u) + a1[3] * alpha);
                *(PG8_GAS u32x4*)(hb + off + bj * HALF) = w;
                if (h8_off) { typedef unsigned u32x2v __attribute__((ext_vector_type(2))); u32x2v q8; int p = 0;
                    p = __builtin_amdgcn_cvt_pk_fp8_f32(__builtin_bit_cast(float, w.x << 16), __builtin_bit_cast(float, w.x & 0xffff0000u), p, false);
                    p = __builtin_amdgcn_cvt_pk_fp8_f32(__builtin_bit_cast(float, w.y << 16), __builtin_bit_cast(float, w.y & 0xffff0000u), p, true); q8.x = (unsigned)p; p = 0;
                    p = __builtin_amdgcn_cvt_pk_fp8_f32(__builtin_bit_cast(float, w.z << 16), __builtin_bit_cast(float, w.z & 0xffff0000u), p, false);
                    p = __builtin_amdgcn_cvt_pk_fp8_f32(__builtin_bit_cast(float, w.w << 16), __builtin_bit_cast(float, w.w & 0xffff0000u), p, true); q8.y = (unsigned)p;
                    *(PG8_GAS u32x2v*)(wsb + h8_off + off + bj * HALF) = q8; }
#pragma unroll
                for (int e = 0; e < 4; ++e) { const float lo = __builtin_bit_cast(float, w[e] << 16), hi = __builtin_bit_cast(float, w[e] & 0xffff0000u); sq = fmaf(lo, lo, sq); sq = fmaf(hi, hi, sq); } }
            sq += __builtin_bit_cast(float, __builtin_amdgcn_ds_bpermute((lane ^ 16) << 2, __builtin_bit_cast(int, sq)));
            sq += __builtin_bit_cast(float, __builtin_amdgcn_ds_bpermute((lane ^ 32) << 2, __builtin_bit_cast(int, sq)));
            if (fq == 0) ss[(size_t)row * 32 + u.pn * 4 + wc] = sq;
            cur[0] = nxt[0]; cur[1] = nxt[1]; }
    }
};
struct EpiBf16 {
    static constexpr bool PERM = true, AFTER_DRAIN = false;
    PG8_GAS bf16_t* O; int ldc; const PG8_GAS float* ss; float inv_k, eps;
    __device__ __forceinline__ void operator()(const f32x4 (&acc)[2][2][4][2], const Unit& u, int wr, int wc, int fr, int fq) const {
        const int row0 = u.pm * BM + wr * 64 + fr, col0 = u.pn * BM + wc * 32 + 8 * fq;
        float rs[8]; const int lane_ = fr + 16 * fq;
#pragma unroll
        for (int k = 0; k < 8; ++k) { const PG8_GAS f32x4* p4 = (const PG8_GAS f32x4*)(ss + (size_t)(row0 + (k >> 2) * HALF + (k & 3) * 16) * 32 + 8 * fq); const f32x4 a = p4[0], b = p4[1];
            float t = ((a[0] + a[1]) + (a[2] + a[3])) + ((b[0] + b[1]) + (b[2] + b[3]));
            t += __builtin_bit_cast(float, __builtin_amdgcn_ds_bpermute((lane_ ^ 16) << 2, __builtin_bit_cast(int, t)));
            t += __builtin_bit_cast(float, __builtin_amdgcn_ds_bpermute((lane_ ^ 32) << 2, __builtin_bit_cast(int, t))); rs[k] = t; }
#pragma unroll
        for (int ai = 0; ai < 2; ++ai)
#pragma unroll
            for (int m = 0; m < 4; ++m) { PG8_GAS bf16_t* rowp = O + (size_t)(row0 + ai * HALF + m * 16) * ldc + col0;
                const float r = __builtin_amdgcn_rsqf(rs[ai * 4 + m] * inv_k + eps);
#pragma unroll
                for (int bj = 0; bj < 2; ++bj) { const f32x4 v0 = acc[ai][bj][m][0] * r, v1 = acc[ai][bj][m][1] * r;
                    u32x4 w; w.x = cvt_pk_bf16(v0[0], v0[1]); w.y = cvt_pk_bf16(v0[2], v0[3]); w.z = cvt_pk_bf16(v1[0], v1[1]); w.w = cvt_pk_bf16(v1[2], v1[3]);
                    *(PG8_GAS u32x4*)(rowp + bj * HALF) = w; } }
    }
};
template <class Epi, class Sched, bool ALIGN_EPI = false, bool SP2 = false, bool F8 = false>
__device__ __forceinline__ void gemm_phase(PG8_LAS unsigned char* lds, const Gemm g, const Sched& S, const Epi& E) {
    int tid_ = threadIdx.x; asm volatile("" : "+v"(tid_));
    const int tid = tid_, wid = __builtin_amdgcn_readfirstlane(tid >> 6), lane = tid & 63, wr = wid >> 2, wc = wid & 3, fr = lane & 15, fq = lane >> 4;
    const int K = g.K, nt = K / BK;
    unsigned voffA[2], voffB[2];
#pragma unroll
    for (int i = 0; i < 2; ++i) { int R, C; stage_rc(tid * 16 + i * 8192, R, C); const int Rb = Epi::PERM ? ((R & ~31) + perm32(R & 31)) : R;
        voffA[i] = (unsigned)(R * K + C) * 2u; voffB[i] = (unsigned)(Rb * K + C) * 2u; }
    const size_t kstep = (size_t)(BK * 2);
    const size_t hstep = (size_t)HALF * K * 2;
    const size_t tstep = 2 * hstep;
    const unsigned ldsw = (unsigned)wid * 1024u;
    const int aoff = lds_byte(wr * 64 + fr, fq * 8), boff = lds_byte(wc * 32 + fr, fq * 8);
#define PG8_SA(b, h) (((b) * 2 + (h)) * HTB)
#define PG8_SB(b, h) ((4 + (b) * 2 + (h)) * HTB)
#define PG8_STAGE(bufoff, gbase, voff) do { _Pragma("unroll") for (int _i = 0; _i < 2; ++_i) \
        __builtin_amdgcn_global_load_lds((const PG8_GAS unsigned*)((const PG8_GAS char*)(gbase) + (voff)[_i]), (PG8_LAS unsigned*)(lds + (bufoff) + ldsw + _i * 8192), 16, 0, 0); } while (0)
#define PG8_LDA(dst, b, h) do { _Pragma("unroll") for (int m = 0; m < 4; ++m) _Pragma("unroll") for (int k = 0; k < 2; ++k) dst[m][k] = *(const PG8_LAS bf16x8*)(lds + PG8_SA(b, h) + aoff + m * 2048 + k * 1024); } while (0)
#define PG8_LDB(dst, b, h) do { _Pragma("unroll") for (int n = 0; n < 2; ++n) _Pragma("unroll") for (int k = 0; k < 2; ++k) dst[n][k] = *(const PG8_LAS bf16x8*)(lds + PG8_SB(b, h) + boff + n * 2048 + k * 1024); } while (0)
#define PG8_MMA(ai, bj, At, Bt) do { __builtin_amdgcn_s_setprio(1); _Pragma("unroll") for (int m = 0; m < 4; ++m) _Pragma("unroll") for (int n = 0; n < 2; ++n) { \
        if constexpr (F8) { asm volatile("v_mfma_f32_16x16x128_f8f6f4 %0, %1, %2, %0" : "+v"(acc[ai][bj][m][n]) : "v"(cat8(Bt[n][0], Bt[n][1])), "v"(cat8(At[m][0], At[m][1]))); } \
        else { _Pragma("unroll") for (int k = 0; k < 2; ++k) acc[ai][bj][m][n] = __builtin_amdgcn_mfma_f32_16x16x32_bf16(Bt[n][k], At[m][k], acc[ai][bj][m][n], 0, 0, 0); } } \
        __builtin_amdgcn_s_setprio(0); } while (0)
#define PG8_WAIT_V(n) asm volatile("s_waitcnt vmcnt(" #n ")" ::: "memory")
#define PG8_WAIT_L(n) asm volatile("s_waitcnt lgkmcnt(" #n ")" ::: "memory")
#define PG8_BAR __builtin_amdgcn_s_barrier()
#define PG8_SCHED __builtin_amdgcn_sched_barrier(0)
    Unit cur, nxt; int ui = 0;
    if (!S.next(0, cur)) return;
    f32x4 acc[2][2][4][2];
#pragma unroll
    for (int a = 0; a < 2; ++a)
#pragma unroll
        for (int b = 0; b < 2; ++b)
#pragma unroll
            for (int m = 0; m < 4; ++m)
#pragma unroll
                for (int n = 0; n < 2; ++n) acc[a][b][m][n] = (f32x4){0.f, 0.f, 0.f, 0.f};
    bf16x8 At[4][2], B0[2][2], B1[2][2];
    const PG8_GAS char* cA = (const PG8_GAS char*)g.A + (size_t)cur.pm * tstep; const PG8_GAS char* cB = (const PG8_GAS char*)g.Bt + (size_t)cur.pn * tstep;
    S.a_ready(cur);
    if constexpr (SP2) {
        PG8_STAGE(PG8_SB(0, 0), cB, voffB); PG8_STAGE(PG8_SB(0, 1), cB + hstep, voffB); PG8_STAGE(PG8_SA(0, 0), cA, voffA); PG8_STAGE(PG8_SA(0, 1), cA + hstep, voffA);
        if (wr == 1) PG8_BAR;
        PG8_WAIT_V(2); PG8_BAR;
        PG8_STAGE(PG8_SB(1, 0), cB + kstep, voffB); PG8_STAGE(PG8_SA(1, 0), cA + kstep, voffA); PG8_STAGE(PG8_SB(1, 1), cB + hstep + kstep, voffB);
        PG8_WAIT_V(6); PG8_BAR;
    } else {
        PG8_STAGE(PG8_SB(0, 0), cB, voffB); PG8_STAGE(PG8_SA(0, 0), cA, voffA); PG8_STAGE(PG8_SB(0, 1), cB + hstep, voffB); PG8_STAGE(PG8_SA(0, 1), cA + hstep, voffA);
        if (wr == 1) PG8_BAR;
        PG8_WAIT_V(4); PG8_BAR;
        PG8_STAGE(PG8_SB(1, 0), cB + kstep, voffB); PG8_STAGE(PG8_SA(1, 0), cA + kstep, voffA); PG8_STAGE(PG8_SB(1, 1), cB + hstep + kstep, voffB);
        PG8_WAIT_V(6); PG8_BAR;
    }
    for (;;) {
        const bool has_next = S.next(ui + 1, nxt);
        const PG8_GAS char* nA = has_next ? (const PG8_GAS char*)g.A + (size_t)nxt.pm * tstep : cA; const PG8_GAS char* nB = has_next ? (const PG8_GAS char*)g.Bt + (size_t)nxt.pn * tstep : cB;
        for (int t = 0; t < nt; t += 2) {
            const bool last = (t == nt - 2);
            const PG8_GAS char* a1 = cA + (size_t)(t + 1) * kstep;
            const PG8_GAS char* a2 = last ? nA : cA + (size_t)(t + 2) * kstep; const PG8_GAS char* b2 = last ? nB : cB + (size_t)(t + 2) * kstep;
            const PG8_GAS char* a3 = a2 + kstep; const PG8_GAS char* b3 = b2 + kstep;
            if (last && has_next) S.a_ready(nxt);
            if constexpr (SP2) {
            PG8_LDB(B0, 0, 0); PG8_LDB(B1, 0, 1); PG8_SCHED; PG8_LDA(At, 0, 0); PG8_STAGE(PG8_SA(1, 1), a1 + hstep, voffA);
            PG8_WAIT_V(8); PG8_WAIT_L(0); PG8_BAR; PG8_MMA(0, 0, At, B0); PG8_MMA(0, 1, At, B1); PG8_BAR; PG8_SCHED;
            PG8_LDA(At, 0, 1); PG8_STAGE(PG8_SB(0, 0), b2, voffB); PG8_STAGE(PG8_SB(0, 1), b2 + hstep, voffB); PG8_STAGE(PG8_SA(0, 0), a2, voffA);
            PG8_WAIT_V(8); PG8_WAIT_L(0); PG8_BAR; PG8_MMA(1, 0, At, B0); PG8_MMA(1, 1, At, B1); PG8_BAR; PG8_SCHED;
            PG8_LDB(B0, 1, 0); PG8_LDB(B1, 1, 1); PG8_SCHED; PG8_LDA(At, 1, 0); PG8_STAGE(PG8_SA(0, 1), a2 + hstep, voffA);
            PG8_WAIT_V(8); PG8_WAIT_L(0); PG8_BAR; PG8_MMA(0, 0, At, B0); PG8_MMA(0, 1, At, B1); PG8_BAR; PG8_SCHED;
            PG8_LDA(At, 1, 1); PG8_STAGE(PG8_SB(1, 0), b3, voffB); PG8_STAGE(PG8_SB(1, 1), b3 + hstep, voffB); PG8_STAGE(PG8_SA(1, 0), a3, voffA);
            PG8_WAIT_V(8); PG8_WAIT_L(0); PG8_BAR; PG8_MMA(1, 0, At, B0); PG8_MMA(1, 1, At, B1); PG8_BAR; PG8_SCHED;
            } else {
            PG8_LDB(B0, 0, 0); PG8_SCHED; PG8_LDA(At, 0, 0); PG8_STAGE(PG8_SA(1, 1), a1 + hstep, voffA);
            PG8_WAIT_L(8); PG8_BAR; PG8_WAIT_L(0); PG8_MMA(0, 0, At, B0); PG8_BAR; PG8_SCHED;
            PG8_LDB(B1, 0, 1); PG8_STAGE(PG8_SB(0, 0), b2, voffB);
            PG8_BAR; PG8_WAIT_L(0); PG8_MMA(0, 1, At, B1); PG8_BAR;
            PG8_LDA(At, 0, 1); PG8_STAGE(PG8_SA(0, 0), a2, voffA);
            PG8_BAR; PG8_WAIT_L(0); PG8_MMA(1, 0, At, B0); PG8_BAR; PG8_SCHED;
            PG8_STAGE(PG8_SB(0, 1), b2 + hstep, voffB);
            PG8_WAIT_V(6); PG8_BAR; PG8_MMA(1, 1, At, B1); PG8_BAR;
            PG8_LDB(B0, 1, 0); PG8_SCHED; PG8_LDA(At, 1, 0); PG8_STAGE(PG8_SA(0, 1), a2 + hstep, voffA);
            PG8_WAIT_L(8); PG8_BAR; PG8_WAIT_L(0); PG8_MMA(0, 0, At, B0); PG8_BAR; PG8_SCHED;
            PG8_LDB(B1, 1, 1); PG8_STAGE(PG8_SB(1, 0), b3, voffB);
            PG8_BAR; PG8_WAIT_L(0); PG8_MMA(0, 1, At, B1); PG8_BAR;
            PG8_LDA(At, 1, 1); PG8_STAGE(PG8_SA(1, 0), a3, voffA);
            PG8_BAR; PG8_WAIT_L(0); PG8_MMA(1, 0, At, B0); PG8_BAR; PG8_SCHED;
            PG8_STAGE(PG8_SB(1, 1), b3 + hstep, voffB);
            PG8_WAIT_V(6); PG8_BAR; PG8_MMA(1, 1, At, B1); PG8_BAR;
            }
        }
        if constexpr (ALIGN_EPI) { if (wr == 0) PG8_BAR; }
        if constexpr (!Epi::AFTER_DRAIN) { E(acc, cur, wr, wc, fr, fq); S.done(cur); }
        if (!has_next) break;
#pragma unroll
        for (int a = 0; a < 2; ++a)
#pragma unroll
            for (int b = 0; b < 2; ++b)
#pragma unroll
                for (int m = 0; m < 4; ++m)
#pragma unroll
                    for (int n = 0; n < 2; ++n) acc[a][b][m][n] = (f32x4){0.f, 0.f, 0.f, 0.f};
        cur = nxt; cA = nA; cB = nB; ++ui;
        if constexpr (ALIGN_EPI) { if (wr == 1) PG8_BAR; }
    }
    PG8_WAIT_V(0);
    if constexpr (!ALIGN_EPI) { if (wr == 0) PG8_BAR; }
    PG8_BAR;
    if constexpr (Epi::AFTER_DRAIN) { E.fused(acc, cur, wr, wc, fr, fq, lds, wid, lane); S.done(cur); }
#undef PG8_SA
#undef PG8_SB
#undef PG8_STAGE
#undef PG8_LDA
#undef PG8_LDB
#undef PG8_MMA
#undef PG8_WAIT_V
#undef PG8_WAIT_L
#undef PG8_BAR
#undef PG8_SCHED
}
}
constexpr int NWAVES = 8;
constexpr int BATCH = 8, SEQ = 4096, D = 2048, FF = 5632, DEPTH = 2;
constexpr int M = BATCH * SEQ;
constexpr int NGU = 2 * FF;
constexpr int H_A = 8, HD_A = 128, RANK = 256, IH = 8, IDIM = 64, TOPK = 256;
constexpr int H_B = 16, KVH = 2, GQA = 8, HD_B = 64, WINDOW = 128;
constexpr int D_IN = 3144;
constexpr float EPS = 1e-6f;
constexpr size_t MiB = 1u << 20;
constexpr size_t WS_CTL = 0, CTL_ZERO_BYTES = 1 * MiB;
#ifndef F8_MASK
#define F8_MASK 0xF
#endif
constexpr float W8_SCALE = 64.0f;
#ifndef D8_MASK
#define D8_MASK 0xA
#endif
constexpr float A8_SCALE = 8.0f;
__host__ __device__ constexpr bool d8_on(int l, int f) { return ((D8_MASK >> (2 * l + f)) & 1) != 0; }
constexpr float O8_SCALE = 16.0f;
#ifndef OUT_F8
#define OUT_F8 1
#endif
constexpr bool F8_ALL1 = (F8_MASK & 0x5) == 0x5, F8_ALL2 = (F8_MASK & 0xA) == 0xA;
__host__ __device__ constexpr bool f8_on(int l, int f) { return ((F8_MASK >> (2 * l + f)) & 1) != 0; }
constexpr size_t GU1_B = (F8_ALL1 ? 22 : 44) * MiB, GU2_B = (F8_ALL2 ? 22 : 44) * MiB;
constexpr size_t WS_W0 = 2 * MiB;
constexpr size_t WO_GU1 = 0, WO_D1 = GU1_B, WO_GU2 = WO_D1 + 22 * MiB, WO_D2 = WO_GU2 + GU2_B, WO_IN = WO_D2 + 22 * MiB, WO_OUT = WO_IN + 17 * MiB, W_LAYER = WO_OUT + 12 * MiB;
constexpr size_t WS_XN = WS_W0 + 2 * W_LAYER;
constexpr size_t WS_HB8 = WS_XN + 128 * MiB;
constexpr size_t WS_ACT = WS_HB8 + (F8_MASK ? 64 : 0) * MiB;
constexpr size_t WS_Z = WS_ACT, WS_CKVN = WS_ACT + 272 * MiB, WS_KIN = WS_ACT + 288 * MiB, WS_WIF = WS_ACT + 292 * MiB, WS_IDX = WS_ACT + 294 * MiB;
constexpr int ZLD = 4352, ZC_QLAT = 0, ZC_CKV = 2048, ZC_QI = 2304, ZC_QB = 2816, ZC_KB = 3840, ZC_VB = 3968, ZC_KI = 4096, ZC_WI = 4160;
constexpr int OLD = 3072;
constexpr size_t WS_O = WS_ACT + 352 * MiB;
constexpr size_t WS_SS = WS_O + 192 * MiB, SS_BYTES = 4 * MiB;
constexpr size_t WS_END = WS_SS + 2 * SS_BYTES;
static_assert(WS_END <= 1024 * MiB, "d_ws map exceeds 1 GiB");
constexpr int CW_TMO = 0, CW_CODE = 1, CW_BAR = 4096;
constexpr int RING_OFF = 0, RING_BYTES = 131072;
constexpr int LDSCTL_OFF = RING_BYTES, MISC_OFF = LDSCTL_OFF + 320;
constexpr int LDS_BYTES = 147456;
#define GAS __attribute__((address_space(1)))
#define LAS __attribute__((address_space(3)))
typedef unsigned short bf16;
typedef unsigned v4u __attribute__((ext_vector_type(4)));
typedef float f32x4 __attribute__((ext_vector_type(4)));
typedef short bf16x8 __attribute__((ext_vector_type(8)));
typedef GAS unsigned gu32;
typedef GAS unsigned long long gu64;
#define RLX_AGENT __ATOMIC_RELAXED, __HIP_MEMORY_SCOPE_AGENT
#define LDS_WAIT() asm volatile("s_waitcnt lgkmcnt(0)" ::: "memory")
#define VM_WAIT() asm volatile("s_waitcnt vmcnt(0)" ::: "memory")
__device__ __forceinline__ unsigned long long rt() { return __builtin_amdgcn_s_memrealtime(); }
__device__ __forceinline__ unsigned f2bf(float f) { unsigned u = __builtin_bit_cast(unsigned, f); return (u + 0x7fffu + ((u >> 16) & 1u)) >> 16; }
__device__ __forceinline__ unsigned pk2(float lo, float hi) { return f2bf(lo) | (f2bf(hi) << 16); }

#define XB_TMO      128
#define XB_XCNT(j)  (256  + 64 * (j))
#define XB_XSUB(j)  (1280 + 64 * (j))
#define XB_XGEN(j)  (2304 + 64 * (j))
#define XB_TOP      3328
#define XB_TOPGEN   3392
#define XCD_BAR_WORDS 3456
#define XB_SPIN_CAP (1u << 18)

__device__ __forceinline__ unsigned xb_ld(unsigned* p)              { return __hip_atomic_load(p, __ATOMIC_RELAXED, __HIP_MEMORY_SCOPE_AGENT); }
__device__ __forceinline__ unsigned xb_add(unsigned* p, unsigned v) { return __hip_atomic_fetch_add(p, v, __ATOMIC_RELAXED, __HIP_MEMORY_SCOPE_AGENT); }
__device__ __forceinline__ unsigned xb_xcc_id() { return (unsigned)__builtin_amdgcn_s_getreg((3 << 11) | 20) & 0xFu; }
#define XB_SPIN(cond, bar) do { unsigned _sp = 0; while (cond) { __builtin_amdgcn_s_sleep(1); \
    if ((++_sp & 255u) == 0u) { if (xb_ld(&(bar)[XB_TMO])) break; if (_sp > XB_SPIN_CAP) { atomicAdd(&(bar)[XB_TMO], 1u); break; } } } } while (0)

struct XcdBarrier {
    unsigned* bar; unsigned x;
    volatile LAS unsigned* st;
};

__device__ __forceinline__ XcdBarrier xcd_barrier_post(unsigned* bar, volatile LAS unsigned* st) {
    XcdBarrier b; b.bar = bar; b.x = xb_xcc_id(); b.st = st;
    if (threadIdx.x == 0) (void)xb_add(&bar[XB_XCNT(b.x)], 1u);
    return b;
}
__device__ __forceinline__ void xcd_barrier_complete(unsigned* bar, unsigned x, unsigned& nloc, unsigned& nx) {
    const unsigned G = gridDim.x * gridDim.y * gridDim.z;
    unsigned sum, cnt, mine, sp = 0u;
    for (;;) {
        sum = 0u; cnt = 0u; mine = 0u;
#pragma unroll
        for (unsigned j = 0; j < 16; ++j) { const unsigned c = xb_ld(&bar[XB_XCNT(j)]); sum += c; cnt += (c > 0u) ? 1u : 0u; mine = (j == x) ? c : mine; }
        if (sum == G) break;
        __builtin_amdgcn_s_sleep(1);
        if ((++sp & 255u) == 0u) { if (xb_ld(&bar[XB_TMO])) break; if (sp > XB_SPIN_CAP) { atomicAdd(&bar[XB_TMO], 1u); break; } }
    }
    nloc = mine > 0u ? mine : 1u; nx = cnt > 0u ? cnt : 1u;
}

__device__ __forceinline__ void xcd_barrier(const XcdBarrier& b) {
    asm volatile("s_waitcnt vmcnt(0)" ::: "memory");
    __syncthreads();
    if (threadIdx.x == 0) {
        unsigned* bar = b.bar;
        __builtin_amdgcn_s_waitcnt(0);
        unsigned nloc = b.st[0], nx = b.st[1];
        if (nloc == 0u) { xcd_barrier_complete(bar, b.x, nloc, nx); b.st[0] = nloc; b.st[1] = nx; }
        const unsigned old = xb_add(&bar[XB_XSUB(b.x)], 1u);
        const unsigned gen = old / nloc;
        if (old + 1u == (gen + 1u) * nloc) {
            __builtin_amdgcn_fence(__ATOMIC_RELEASE, "agent");
            asm volatile("s_waitcnt vmcnt(0)" ::: "memory");
            const unsigned og = xb_add(&bar[XB_TOP], 1u);
            const unsigned tg = og / nx;
            if (og + 1u == (tg + 1u) * nx) xb_add(&bar[XB_TOPGEN], 1u);
            else XB_SPIN(xb_ld(&bar[XB_TOPGEN]) == tg, bar);
            __builtin_amdgcn_fence(__ATOMIC_ACQUIRE, "agent");
            xb_add(&bar[XB_XGEN(b.x)], 1u);
            asm volatile("s_waitcnt vmcnt(0)" ::: "memory");
        } else {
            XB_SPIN(xb_ld(&bar[XB_XGEN(b.x)]) == gen, bar);
            __builtin_amdgcn_fence(__ATOMIC_ACQUIRE, "agent");
            asm volatile("s_waitcnt vmcnt(0)" ::: "memory");
        }
    }
    __syncthreads();
}
__constant__ unsigned char T5_BUCKET[128] = {0, 1, 2, 3, 4, 5, 6, 7, 8, 9, 10, 11, 12, 13, 14, 15, 16, 16, 16, 17, 17, 18, 18, 18, 19, 19, 19, 20, 20, 20, 20, 21, 21, 21, 21, 22, 22, 22, 22, 22, 23, 23, 23, 23, 23, 23, 24, 24, 24, 24, 24, 24, 25, 25, 25, 25, 25, 25, 25, 26, 26, 26, 26, 26, 26, 26, 26, 27, 27, 27, 27, 27, 27, 27, 27, 27, 27, 28, 28, 28, 28, 28, 28, 28, 28, 28, 28, 29, 29, 29, 29, 29, 29, 29, 29, 29, 29, 29, 29, 30, 30, 30, 30, 30, 30, 30, 30, 30, 30, 30, 30, 30, 30, 31, 31, 31, 31, 31, 31, 31, 31, 31, 31, 31, 31, 31, 31, 31};
typedef short s16x4 __attribute__((ext_vector_type(4)));
typedef float f32x16 __attribute__((ext_vector_type(16)));
__device__ __forceinline__ float bf2f(unsigned short b) { return __builtin_bit_cast(float, (unsigned)b << 16); }
__device__ __forceinline__ bf16x8 cat4(s16x4 lo, s16x4 hi) { return __builtin_shufflevector(lo, hi, 0, 1, 2, 3, 4, 5, 6, 7); }
__device__ __forceinline__ void tr_read4(unsigned a0, unsigned a1, unsigned a2, unsigned a3, s16x4& r0, s16x4& r1, s16x4& r2, s16x4& r3) {
    asm volatile("ds_read_b64_tr_b16 %0, %4\n\tds_read_b64_tr_b16 %1, %5\n\tds_read_b64_tr_b16 %2, %6\n\tds_read_b64_tr_b16 %3, %7\n\ts_waitcnt lgkmcnt(0)"
                 : "=&v"(r0), "=&v"(r1), "=&v"(r2), "=&v"(r3) : "v"(a0), "v"(a1), "v"(a2), "v"(a3) : "memory");
}
#define SHX(x, o) __builtin_bit_cast(float, __builtin_amdgcn_ds_bpermute(((lane) ^ (o)) << 2, __builtin_bit_cast(int, (float)(x))))
#define SHXU(x, o) ((unsigned)__builtin_amdgcn_ds_bpermute(((lane) ^ (o)) << 2, (int)(x)))
__device__ __forceinline__ float wave_sum(float v, int lane) {
#pragma unroll
    for (int o = 1; o < 64; o <<= 1) v += SHX(v, o);
    return v;
}
template <bool OUT8 = false>
__device__ __forceinline__ void conv_item(const GAS float* W, int ldw, int k0, int c0, int nvalid, GAS bf16* dst, int dld, int drow0, int dk0, float scale, const GAS float* gain, LAS float* scr, int lane) {
    const int c = lane & 31;
#pragma unroll 8
    for (int i = 0; i < 32; ++i) { const int kk = 2 * i + (lane >> 5); float v = 0.f;
        if (c < nvalid) v = W[(size_t)(k0 + kk) * ldw + c0 + c] * scale;
        scr[kk * 33 + c] = v; }
    LDS_WAIT(); asm volatile("" ::: "memory");
    const int c8 = lane & 7;
    f32x4 ga = {1.f, 1.f, 1.f, 1.f}, gb = {1.f, 1.f, 1.f, 1.f};
    if (gain) { ga = *(const GAS f32x4*)(gain + k0 + 8 * c8); gb = *(const GAS f32x4*)(gain + k0 + 8 * c8 + 4); }
#pragma unroll
    for (int j = 0; j < 4; ++j) { const int n = (lane >> 3) + 8 * j; const LAS float* s = scr + (8 * c8) * 33 + n;
        if constexpr (OUT8) { int p = 0, q = 0;
            p = __builtin_amdgcn_cvt_pk_fp8_f32(s[0 * 33] * ga.x, s[1 * 33] * ga.y, p, false); p = __builtin_amdgcn_cvt_pk_fp8_f32(s[2 * 33] * ga.z, s[3 * 33] * ga.w, p, true);
            q = __builtin_amdgcn_cvt_pk_fp8_f32(s[4 * 33] * gb.x, s[5 * 33] * gb.y, q, false); q = __builtin_amdgcn_cvt_pk_fp8_f32(s[6 * 33] * gb.z, s[7 * 33] * gb.w, q, true);
            *(GAS unsigned long long*)((GAS unsigned char*)dst + (size_t)(drow0 + n) * dld + dk0 + k0 + 8 * c8) = (unsigned long long)(unsigned)p | ((unsigned long long)(unsigned)q << 32); }
        else { v4u o; o.x = pk2(s[0 * 33] * ga.x, s[1 * 33] * ga.y); o.y = pk2(s[2 * 33] * ga.z, s[3 * 33] * ga.w); o.z = pk2(s[4 * 33] * gb.x, s[5 * 33] * gb.y); o.w = pk2(s[6 * 33] * gb.z, s[7 * 33] * gb.w);
            *(GAS v4u*)(dst + (size_t)(drow0 + n) * dld + dk0 + k0 + 8 * c8) = o; } }
    LDS_WAIT(); asm volatile("" ::: "memory");
}
__device__ __forceinline__ void rmsnorm_rows_bf16(const GAS float* X, const GAS float* g, GAS bf16* O, int gw, int NGW, int lane) {
    f32x4 gv[8];
#pragma unroll
    for (int j = 0; j < 8; ++j) gv[j] = ((const GAS f32x4*)g)[lane + 64 * j];
    for (int m = gw; m < M; m += NGW) {
        const GAS f32x4* xr = (const GAS f32x4*)(X + (size_t)m * D) + lane;
        f32x4 v[8]; float s = 0.f;
#pragma unroll
        for (int j = 0; j < 8; ++j) { v[j] = xr[64 * j]; s += (v[j].x * v[j].x + v[j].y * v[j].y) + (v[j].z * v[j].z + v[j].w * v[j].w); }
        const float r = 1.0f / sqrtf(wave_sum(s, lane) * (1.0f / D) + EPS);
        GAS unsigned long long* o8 = (GAS unsigned long long*)(O + (size_t)m * D) + lane;
#pragma unroll
        for (int j = 0; j < 8; ++j) { const f32x4 y = v[j] * r * gv[j]; o8[64 * j] = (unsigned long long)pk2(y.x, y.y) | ((unsigned long long)pk2(y.z, y.w) << 32); }
    }
}
__device__ __forceinline__ void rows_bf16_ss(const GAS float* X, GAS bf16* O, GAS unsigned char* O8, GAS float* ss, int gw, int NGW, int lane) {
    for (int m = gw; m < M; m += NGW) {
        const GAS f32x4* xr = (const GAS f32x4*)(X + (size_t)m * D) + lane;
        f32x4 v[8]; float s = 0.f;
#pragma unroll
        for (int j = 0; j < 8; ++j) { v[j] = xr[64 * j]; s += (v[j].x * v[j].x + v[j].y * v[j].y) + (v[j].z * v[j].z + v[j].w * v[j].w); }
        s = wave_sum(s, lane);
        GAS unsigned long long* o8 = (GAS unsigned long long*)(O + (size_t)m * D) + lane;
#pragma unroll
        for (int j = 0; j < 8; ++j) o8[64 * j] = (unsigned long long)pk2(v[j].x, v[j].y) | ((unsigned long long)pk2(v[j].z, v[j].w) << 32);
        if (O8) { GAS unsigned* q8 = (GAS unsigned*)(O8 + (size_t)m * D) + lane;
#pragma unroll
            for (int j = 0; j < 8; ++j) { int p = 0; p = __builtin_amdgcn_cvt_pk_fp8_f32(v[j].x, v[j].y, p, false); p = __builtin_amdgcn_cvt_pk_fp8_f32(v[j].z, v[j].w, p, true); q8[64 * j] = (unsigned)p; } }
        if (lane < 32) ss[(size_t)m * 32 + lane] = lane == 0 ? s : 0.f;
    }
}
__device__ __forceinline__ void final_rows(const GAS bf16* HB, GAS float* OUT, const GAS float* g, const GAS float* ss, int gw, int NGW, int lane) {
    f32x4 gv[8];
#pragma unroll
    for (int j = 0; j < 8; ++j) gv[j] = ((const GAS f32x4*)g)[lane + 64 * j];
    for (int m = gw; m < M; m += NGW) {
        const GAS unsigned long long* hr = (const GAS unsigned long long*)(HB + (size_t)m * D) + lane; GAS f32x4* orow = (GAS f32x4*)(OUT + (size_t)m * D) + lane;
        unsigned long long raw[8];
#pragma unroll
        for (int j = 0; j < 8; ++j) raw[j] = hr[64 * j];
        const float r = 1.0f / sqrtf(wave_sum(lane < 32 ? ss[(size_t)m * 32 + lane] : 0.f, lane) * (1.0f / D) + EPS);
#pragma unroll
        for (int j = 0; j < 8; ++j) { const unsigned lo = (unsigned)raw[j], hi = (unsigned)(raw[j] >> 32);
            f32x4 v = {__builtin_bit_cast(float, lo << 16), __builtin_bit_cast(float, lo & 0xffff0000u), __builtin_bit_cast(float, hi << 16), __builtin_bit_cast(float, hi & 0xffff0000u)};
            orow[64 * j] = v * r * gv[j]; }
    }
}
__device__ __forceinline__ void rmsnorm_rows_f32_inplace(GAS float* X, const GAS float* g, int gw, int NGW, int lane) {
    f32x4 gv[8];
#pragma unroll
    for (int j = 0; j < 8; ++j) gv[j] = ((const GAS f32x4*)g)[lane + 64 * j];
    for (int m = gw; m < M; m += NGW) {
        GAS f32x4* xr = (GAS f32x4*)(X + (size_t)m * D) + lane;
        f32x4 v[8]; float s = 0.f;
#pragma unroll
        for (int j = 0; j < 8; ++j) { v[j] = xr[64 * j]; s += (v[j].x * v[j].x + v[j].y * v[j].y) + (v[j].z * v[j].z + v[j].w * v[j].w); }
        const float r = 1.0f / sqrtf(wave_sum(s, lane) * (1.0f / D) + EPS);
#pragma unroll
        for (int j = 0; j < 8; ++j) xr[64 * j] = v[j] * r * gv[j];
    }
}

template <bool P_IFAST, bool OUT8 = false>
__device__ __forceinline__ void absorb_unit(const GAS float* Psrc, size_t p_ri, size_t p_rd, const GAS float* Qsrc, size_t q_rj, GAS bf16* out, size_t out_ld, float scale, const GAS float* qgain, LAS float* Ps, LAS float* Qs, int tid) {
#pragma unroll 4
    for (int j = 0; j < 16; ++j) { const int e = tid + 512 * j; const int i = P_IFAST ? (e & 63) : (e >> 7), d = P_IFAST ? (e >> 6) : (e & 127);
        Ps[i * 129 + d] = Psrc[(size_t)i * p_ri + (size_t)d * p_rd];
        const int jj = e >> 7, dd = e & 127; Qs[jj * 129 + dd] = Qsrc[(size_t)jj * q_rj + dd] * (qgain ? qgain[jj] : 1.0f); }
    __syncthreads();
    const int ty = tid >> 6, tx = tid & 63; float acc[8];
#pragma unroll
    for (int i = 0; i < 8; ++i) acc[i] = 0.f;
#pragma unroll 4
    for (int d = 0; d < 128; ++d) { const float q = Qs[tx * 129 + d];
#pragma unroll
        for (int i = 0; i < 8; ++i) acc[i] = fmaf(Ps[(ty * 8 + i) * 129 + d], q, acc[i]); }
#pragma unroll
    for (int i = 0; i < 8; ++i) { if constexpr (OUT8) ((GAS unsigned char*)out)[(size_t)(ty * 8 + i) * out_ld + tx] = (unsigned char)__builtin_amdgcn_cvt_pk_fp8_f32(acc[i] * scale, 0.f, 0, false);
        else out[(size_t)(ty * 8 + i) * out_ld + tx] = (bf16)f2bf(acc[i] * scale); }
    __syncthreads();
}
__device__ __forceinline__ void post_rows(const GAS bf16* Z, const GAS float* gkv, const GAS float* gki, const GAS float* bki, GAS bf16* CKVN, GAS bf16* KIN, GAS float* WIF, int gw, int NGW, int lane) {
    const f32x4 g4 = ((const GAS f32x4*)gkv)[lane]; const float gk = gki[lane], bk = bki[lane];
    for (int m = gw; m < M; m += NGW) {
        const GAS bf16* zr = Z + (size_t)m * ZLD;
        const unsigned long long raw = *(const GAS unsigned long long*)(zr + ZC_CKV + 4 * lane);
        const float kraw = bf2f(zr[ZC_KI + lane]);
        const float wraw = bf2f(zr[ZC_WI + (lane & 7)]);
        const float c0 = bf2f((unsigned short)raw), c1 = bf2f((unsigned short)(raw >> 16)), c2 = bf2f((unsigned short)(raw >> 32)), c3 = bf2f((unsigned short)(raw >> 48));
        const float r = 1.0f / sqrtf(wave_sum((c0 * c0 + c1 * c1) + (c2 * c2 + c3 * c3), lane) * (1.0f / RANK) + EPS);
        *(GAS unsigned long long*)(CKVN + (size_t)m * RANK + 4 * lane) = (unsigned long long)pk2(c0 * r * g4.x, c1 * r * g4.y) | ((unsigned long long)pk2(c2 * r * g4.z, c3 * r * g4.w) << 32);
        const float mu = wave_sum(kraw, lane) * (1.0f / IDIM); const float dv = kraw - mu;
        const float var = wave_sum(dv * dv, lane) * (1.0f / IDIM);
        KIN[(size_t)m * IDIM + lane] = (bf16)f2bf(dv * (1.0f / sqrtf(var + EPS)) * gk + bk);
        if (lane < 8) WIF[(size_t)m * IH + lane] = wraw;
    }
}
constexpr int SWA_KP = 144, SWA_VP = 192;
constexpr int SWA_K_OFF = 0, SWA_V_OFF = 160 * SWA_KP, SWA_TAB_OFF = SWA_V_OFF + 160 * SWA_VP;
static_assert(SWA_TAB_OFF + 16 * 128 * 4 <= RING_BYTES, "SWA LDS map");
__device__ __forceinline__ void swa_phase(LAS unsigned char* lds, const GAS bf16* Z, GAS bf16* O, const GAS float* rel_bias, const GAS float* sinks, int vcu, int G, int tid, int lane, int wave) {
    LAS float* tab = (LAS float*)(lds + SWA_TAB_OFF);
    for (int e = tid; e < 16 * 128; e += NWAVES * 64) { const int h = e >> 7, dist = e & 127; tab[e] = rel_bias[(int)T5_BUCKET[dist] * 24 + H_A + h]; }
    __syncthreads();
    const int q = lane & 31, hh = lane >> 5;
    const unsigned ldsb = (unsigned)(size_t)lds;
    for (int item = vcu; item < BATCH * 128 * KVH; item += G) {
        const int kvh = item & 1, qt = (item >> 1) & 127, b = item >> 8;
        const int t0 = 32 * qt, s0 = t0 - 128;
        const size_t rowbase = (size_t)b * SEQ;
        for (int c = tid; c < 1280; c += NWAVES * 64) { const int row = c >> 3, ch = c & 7; const int s = s0 + row;
            if (s >= 0) { const GAS bf16* zr = Z + (rowbase + s) * ZLD + kvh * 64 + ch * 8;
                const v4u kv = *(const GAS v4u*)(zr + ZC_KB); const v4u vv = *(const GAS v4u*)(zr + ZC_VB);
                *(LAS v4u*)(lds + SWA_K_OFF + row * SWA_KP + ch * 16) = kv; *(LAS v4u*)(lds + SWA_V_OFF + row * SWA_VP + ch * 16) = vv; } }
        const int hq = kvh * 8 + wave; const int t = t0 + q;
        bf16x8 qf[4];
#pragma unroll
        for (int st = 0; st < 4; ++st) qf[st] = *(const GAS bf16x8*)(Z + (rowbase + t) * ZLD + ZC_QB + hq * 64 + 16 * st + 8 * hh);
        __syncthreads();
        const int kt0 = qt >= 4 ? 0 : 4 - qt;
        f32x16 sacc[5];
#pragma unroll
        for (int kt = 0; kt < 5; ++kt) {
#pragma unroll
            for (int r = 0; r < 16; ++r) sacc[kt][r] = 0.f;
            if (kt >= kt0) {
#pragma unroll
                for (int st = 0; st < 4; ++st) { const bf16x8 kf = *(const LAS bf16x8*)(lds + SWA_K_OFF + (kt * 32 + q) * SWA_KP + (2 * st + hh) * 16);
                    sacc[kt] = __builtin_amdgcn_mfma_f32_32x32x16_bf16(kf, qf[st], sacc[kt], 0, 0, 0); } } }
        const float sink = sinks[hq]; float mx = sink;
        const LAS float* tabh = tab + hq * 128;
#pragma unroll
        for (int kt = 0; kt < 5; ++kt) if (kt >= kt0) {
#pragma unroll
            for (int r = 0; r < 16; ++r) { const int ko = (r & 3) + 8 * (r >> 2) + 4 * hh; const int dist = q + 128 - 32 * kt - ko;
                const float lg = (dist >= 0 && dist < WINDOW) ? sacc[kt][r] + tabh[dist & 127] : -1e30f; sacc[kt][r] = lg; mx = fmaxf(mx, lg); } }
        mx = fmaxf(mx, SHX(mx, 32));
        float l = 0.f;
#pragma unroll
        for (int kt = 0; kt < 5; ++kt) if (kt >= kt0) {
#pragma unroll
            for (int r = 0; r < 16; ++r) { const float p = __expf(sacc[kt][r] - mx); sacc[kt][r] = p; l += p; } }
        l += SHX(l, 32); l += __expf(sink - mx);
        f32x16 oacc[2];
#pragma unroll
        for (int dt = 0; dt < 2; ++dt)
#pragma unroll
            for (int r = 0; r < 16; ++r) oacc[dt][r] = 0.f;
        const unsigned vlane = ldsb + SWA_V_OFF + (unsigned)((4 * hh + ((lane & 15) >> 2)) * SWA_VP + (16 * ((lane >> 4) & 1) + 4 * (lane & 3)) * 2);
#pragma unroll
        for (int kt = 0; kt < 5; ++kt) if (kt >= kt0) {
#pragma unroll
            for (int s2 = 0; s2 < 2; ++s2) {
                bf16x8 pf; { const unsigned w0 = pg8::cvt_pk_bf16(sacc[kt][8 * s2 + 0], sacc[kt][8 * s2 + 1]), w1 = pg8::cvt_pk_bf16(sacc[kt][8 * s2 + 2], sacc[kt][8 * s2 + 3]),
                                     w2 = pg8::cvt_pk_bf16(sacc[kt][8 * s2 + 4], sacc[kt][8 * s2 + 5]), w3 = pg8::cvt_pk_bf16(sacc[kt][8 * s2 + 6], sacc[kt][8 * s2 + 7]);
                    const v4u w = {w0, w1, w2, w3}; pf = __builtin_bit_cast(bf16x8, w); }
                const unsigned a = vlane + (unsigned)((kt * 32 + 16 * s2) * SWA_VP);
                s16x4 r0, r1, r2, r3; tr_read4(a, a + 8 * SWA_VP, a + 64, a + 8 * SWA_VP + 64, r0, r1, r2, r3);
                oacc[0] = __builtin_amdgcn_mfma_f32_32x32x16_bf16(cat4(r0, r1), pf, oacc[0], 0, 0, 0);
                oacc[1] = __builtin_amdgcn_mfma_f32_32x32x16_bf16(cat4(r2, r3), pf, oacc[1], 0, 0, 0); } }
        const float inv = (OUT_F8 ? O8_SCALE : 1.0f) / l;
        if constexpr (OUT_F8) { GAS unsigned char* orow = (GAS unsigned char*)O + (rowbase + t) * OLD + 2048 + hq * 64 + 4 * hh;
#pragma unroll
            for (int dt = 0; dt < 2; ++dt)
#pragma unroll
                for (int g4 = 0; g4 < 4; ++g4) { int p = 0; p = __builtin_amdgcn_cvt_pk_fp8_f32(oacc[dt][4 * g4] * inv, oacc[dt][4 * g4 + 1] * inv, p, false); p = __builtin_amdgcn_cvt_pk_fp8_f32(oacc[dt][4 * g4 + 2] * inv, oacc[dt][4 * g4 + 3] * inv, p, true);
                    *(GAS unsigned*)(orow + 32 * dt + 8 * g4) = (unsigned)p; } }
        else { GAS bf16* orow = O + (rowbase + t) * OLD + 2048 + hq * 64 + 4 * hh;
#pragma unroll
        for (int dt = 0; dt < 2; ++dt)
#pragma unroll
            for (int g4 = 0; g4 < 4; ++g4) { const unsigned long long w = (unsigned long long)pk2(oacc[dt][4 * g4] * inv, oacc[dt][4 * g4 + 1] * inv) | ((unsigned long long)pk2(oacc[dt][4 * g4 + 2] * inv, oacc[dt][4 * g4 + 3] * inv) << 32);
                *(GAS unsigned long long*)(orow + 32 * dt + 8 * g4) = w; } }
        __syncthreads();
    }
}
constexpr int TK_BINS = 512, TK_CAP = 128;
#define LDS_ADD(p) __hip_atomic_fetch_add((p), 1u, __ATOMIC_RELAXED, __HIP_MEMORY_SCOPE_WORKGROUP)
constexpr int TK_HIST_OFF = 0, TK_CSC_OFF = 65536, TK_CIX_OFF = TK_CSC_OFF + 32 * TK_CAP * 4, TK_SEL_OFF = TK_CIX_OFF + 32 * TK_CAP * 2, TK_CNT_OFF = TK_SEL_OFF + 32 * 256 * 2, TK_DUM_OFF = TK_CNT_OFF + 32 * 2 * 4, TK_KB_OFF = TK_DUM_OFF + 8 * 64 * 4, TK_KB_BYTES = 64 * 144, TK_FLAG_OFF = TK_KB_OFF + 2 * TK_KB_BYTES;
static_assert(TK_FLAG_OFF + 16 <= RING_BYTES, "top-k LDS map");
__device__ __forceinline__ float tk_relu(float x) { const int b = __builtin_bit_cast(int, x); return __builtin_bit_cast(float, b < 0 ? 0 : b); }
__device__ __forceinline__ float tk_score(const f32x16& acc, int a, const float (&w)[8]) {
    float s = w[0] * tk_relu(acc[8 * a + 0]);
#pragma unroll
    for (int h = 1; h < 8; ++h) s = fmaf(w[h], tk_relu(acc[8 * a + h]), s);
    return s;
}
__device__ __forceinline__ float tk_x(float s, float sc) { return fmaf(s, sc, 256.0f); }
__device__ __forceinline__ int tk_key(float s, float sc) {
    const float x = tk_x(s, sc); int b0 = (int)x; b0 = b0 < 0 ? 0 : (b0 > TK_BINS - 1 ? TK_BINS - 1 : b0);
    int sub = (int)((x - (float)b0) * 512.0f); sub = sub < 0 ? 0 : (sub > 511 ? 511 : sub);
    return b0 * 512 + sub;
}
__device__ __forceinline__ void tk_find(const LAS unsigned* h, unsigned need, int lane, int& bin_out, unsigned& above_out) {
    unsigned v[8]; unsigned s = 0;
#pragma unroll
    for (int i = 0; i < 8; ++i) { v[i] = h[8 * lane + i]; s += v[i]; }
    unsigned S = s;
#pragma unroll
    for (int o = 1; o < 64; o <<= 1) { const unsigned t = (unsigned)__builtin_amdgcn_ds_bpermute((lane + o) << 2, (int)S); if (lane + o < 64) S += t; }
    const unsigned long long mask = __ballot(S >= need);
    const int Lm = mask ? 63 - __builtin_clzll(mask) : 0;
    unsigned cum = S - s; int bsel = 8 * lane; unsigned ab = cum; bool found = false;
#pragma unroll
    for (int i = 7; i >= 0; --i) { if (!found) { if (cum + v[i] >= need) { bsel = 8 * lane + i; ab = cum; found = true; } else cum += v[i]; } }
    bin_out = __builtin_amdgcn_readlane(bsel, Lm); above_out = (unsigned)__builtin_amdgcn_readlane((int)ab, Lm);
}
__device__ __forceinline__ void topk_phase(LAS unsigned char* lds, const GAS bf16* Z, const GAS bf16* KIN, const GAS float* WIF, GAS unsigned short* IDX, int vcu, int G, int lane, int wave) {
    LAS unsigned* hist = (LAS unsigned*)(lds + TK_HIST_OFF) + wave * 4 * TK_BINS;
    LAS float* csc = (LAS float*)(lds + TK_CSC_OFF) + wave * 4 * TK_CAP;
    LAS unsigned short* cix = (LAS unsigned short*)(lds + TK_CIX_OFF) + wave * 4 * TK_CAP;
    LAS unsigned short* sel = (LAS unsigned short*)(lds + TK_SEL_OFF) + wave * 4 * 256;
    LAS unsigned* cnt = (LAS unsigned*)(lds + TK_CNT_OFF) + wave * 8;
    LAS unsigned* dum = (LAS unsigned*)(lds + TK_DUM_OFF) + wave * 64 + lane;
    const int n = lane & 31, c = lane >> 5;
    const int am = (lane >> 4) & 1, bbm = (lane >> 3) & 1, ccm = (lane >> 2) & 1, dm = lane & 3;
    for (int p2 = vcu; p2 < BATCH * 64; p2 += G) {
#pragma unroll 1
        for (int half = 0; half < 2; ++half) {
            const int b = p2 >> 6, jj = p2 & 63, j = half ? 127 - jj : jj;
            const int t0 = 32 * j + 4 * wave; const size_t rb = (size_t)b * SEQ;
            bf16x8 qa[4];
#pragma unroll
            for (int st = 0; st < 4; ++st) qa[st] = *(const GAS bf16x8*)(Z + (rb + t0 + 2 * ccm + am) * ZLD + ZC_QI + (4 * bbm + dm) * 64 + 16 * st + 8 * c);
            float w0[8], w1[8];
            { const GAS f32x4* wp = (const GAS f32x4*)(WIF + (rb + t0 + 2 * c) * IH); const f32x4 x0 = wp[0], x1 = wp[1], x2 = wp[2], x3 = wp[3];
              w0[0] = x0.x; w0[1] = x0.y; w0[2] = x0.z; w0[3] = x0.w; w0[4] = x1.x; w0[5] = x1.y; w0[6] = x1.z; w0[7] = x1.w;
              w1[0] = x2.x; w1[1] = x2.y; w1[2] = x2.z; w1[3] = x2.w; w1[4] = x3.x; w1[5] = x3.y; w1[6] = x3.z; w1[7] = x3.w; }
            float scA, scB;
            { float a = 0.f, bq = 0.f;
#pragma unroll
              for (int h = 0; h < 8; ++h) { a = fmaf(w0[h], w0[h], a); bq = fmaf(w1[h], w1[h], bq); }
              scA = 32.0f / fmaxf(sqrtf(32.0f * a), 1e-20f); scB = 32.0f / fmaxf(sqrtf(32.0f * bq), 1e-20f); }
            const int tA = t0 + 2 * c, tB = tA + 1;
            for (int i = lane; i < 4 * TK_BINS; i += 64) hist[i] = 0u;
            for (int i = lane; i < 4 * 128; i += 64) ((LAS unsigned*)sel)[i] = 0u;
            if (lane < 8) cnt[lane] = 0u;
            asm volatile("s_waitcnt lgkmcnt(0)" ::: "memory");
            int lo[4], hi[4]; unsigned ab0[4]; bool ov[4];
#pragma unroll
            for (int tk = 0; tk < 4; ++tk) { lo[tk] = 0x7fffffff; hi[tk] = -1; ab0[tk] = 0u; ov[tk] = false; }
            const bool need_sel = (t0 + 3) >= TOPK;
            const GAS bf16* kbase = KIN + (rb + n) * IDIM + 8 * c;
            const int tidk = wave * 64 + lane; const int ng = (j + 2) >> 1;
            const GAS bf16* kg0 = KIN + (rb + (tidk >> 3)) * IDIM + (tidk & 7) * 8; const int koff = (tidk >> 3) * 144 + (tidk & 7) * 16;
            LAS unsigned char* kbuf = lds + TK_KB_OFF; volatile LAS unsigned* sflag = (volatile LAS unsigned*)(lds + TK_FLAG_OFF);
            if (tidk == 0) *sflag = 0u;
#define TK_PRIME() { const v4u kr0 = *(const GAS v4u*)kg0; *(LAS v4u*)(kbuf + koff) = kr0; } __syncthreads();
#define TK_GROUP_BEGIN() \
                v4u kr = {0u, 0u, 0u, 0u}; const bool more = g + 1 < ng; if (more) kr = *(const GAS v4u*)(kg0 + (size_t)(g + 1) * 64 * IDIM); \
                const LAS unsigned char* kb_ = kbuf + (g & 1) * TK_KB_BYTES; \
                _Pragma("unroll") for (int u4 = 0; u4 < 2; ++u4) { \
                    f32x16 acc; _Pragma("unroll") for (int r = 0; r < 16; ++r) acc[r] = 0.f; \
                    _Pragma("unroll") for (int st = 0; st < 4; ++st) { const bf16x8 kf = *(const LAS bf16x8*)(kb_ + (32 * u4 + n) * 144 + (2 * st + c) * 16); acc = __builtin_amdgcn_mfma_f32_32x32x16_bf16(qa[st], kf, acc, 0, 0, 0); } \
                    const float s0 = tk_score(acc, 0, w0), s1 = tk_score(acc, 1, w1); const int s = 32 * (2 * g + u4) + n;
#define TK_GROUP_END() } \
                if (more) *(LAS v4u*)(kbuf + ((g + 1) & 1) * TK_KB_BYTES + koff) = kr; \
                __syncthreads();
            bool slow = false;
            if (need_sel) {
                {   TK_PRIME();
#pragma unroll 1
                    for (int g = 0; g < ng; ++g) { TK_GROUP_BEGIN()
                        int b0 = (int)tk_x(s0, scA), b1 = (int)tk_x(s1, scB); b0 = b0 < 0 ? 0 : (b0 > TK_BINS - 1 ? TK_BINS - 1 : b0); b1 = b1 < 0 ? 0 : (b1 > TK_BINS - 1 ? TK_BINS - 1 : b1);
                        LAS unsigned* p0 = (s <= tA) ? &hist[(2 * c) * TK_BINS + b0] : dum; LAS unsigned* p1 = (s <= tB) ? &hist[(2 * c + 1) * TK_BINS + b1] : dum;
                        LDS_ADD(p0); LDS_ADD(p1);
                        TK_GROUP_END() }
                }
                asm volatile("s_waitcnt lgkmcnt(0)" ::: "memory");
#pragma unroll
                for (int tk = 0; tk < 4; ++tk) { int bin; unsigned above; tk_find(hist + tk * TK_BINS, (unsigned)TOPK, lane, bin, above);
                    const unsigned ceq = hist[tk * TK_BINS + bin]; ov[tk] = ceq > (unsigned)TK_CAP; slow |= ov[tk]; ab0[tk] = above; lo[tk] = bin * 512; hi[tk] = bin * 512 + 511; }
                if (slow && lane == 0) *sflag = 1u;
                __syncthreads();
                slow = *sflag != 0u;
            }
            if (!slow) {
                float thi[4], tlo[4];
#pragma unroll
                for (int tk = 0; tk < 4; ++tk) { const int bin = lo[tk] >> 9;
                    thi[tk] = !need_sel ? -__builtin_inff() : (bin >= TK_BINS - 1 ? __builtin_inff() : (float)(bin + 1));
                    tlo[tk] = !need_sel ? __builtin_inff() : (bin == 0 ? -__builtin_inff() : (float)bin); }
                const float thiA = c ? thi[2] : thi[0], tloA = c ? tlo[2] : tlo[0], thiB = c ? thi[3] : thi[1], tloB = c ? tlo[3] : tlo[1];
                unsigned cntA = 0u, cntB = 0u;
                LAS unsigned short* selA = sel + (2 * c) * 256; LAS unsigned short* selB = sel + (2 * c + 1) * 256; LAS unsigned short* dum16 = (LAS unsigned short*)dum;
                TK_PRIME();
#pragma unroll 1
                for (int g = 0; g < ng; ++g) { TK_GROUP_BEGIN()
                    const float x0 = (s <= tA) ? tk_x(s0, scA) : __builtin_nanf(""), x1 = (s <= tB) ? tk_x(s1, scB) : __builtin_nanf("");
                    const bool a0 = x0 >= thiA, a1 = x1 >= thiB; const bool c0 = !a0 && x0 >= tloA, c1 = !a1 && x1 >= tloB;
                    const unsigned long long m0 = __ballot(a0), m1 = __ballot(a1);
                    const unsigned pre0 = c ? __builtin_amdgcn_mbcnt_hi((unsigned)(m0 >> 32), 0u) : __builtin_amdgcn_mbcnt_lo((unsigned)m0, 0u);
                    const unsigned pre1 = c ? __builtin_amdgcn_mbcnt_hi((unsigned)(m1 >> 32), 0u) : __builtin_amdgcn_mbcnt_lo((unsigned)m1, 0u);
                    const unsigned pos0 = cntA + pre0, pos1 = cntB + pre1;
                    LAS unsigned short* q0 = (a0 && pos0 < 256u) ? selA + pos0 : dum16; LAS unsigned short* q1 = (a1 && pos1 < 256u) ? selB + pos1 : dum16;
                    *q0 = (unsigned short)s; *q1 = (unsigned short)s;
                    cntA += c ? (unsigned)__builtin_popcount((unsigned)(m0 >> 32)) : (unsigned)__builtin_popcount((unsigned)m0);
                    cntB += c ? (unsigned)__builtin_popcount((unsigned)(m1 >> 32)) : (unsigned)__builtin_popcount((unsigned)m1);
                    if (__ballot(c0 || c1)) {
                        if (c0) { const unsigned pos = LDS_ADD(&cnt[(2 * c) * 2 + 1]); if (pos < (unsigned)TK_CAP) { csc[(2 * c) * TK_CAP + pos] = s0; cix[(2 * c) * TK_CAP + pos] = (unsigned short)s; } }
                        if (c1) { const unsigned pos = LDS_ADD(&cnt[(2 * c + 1) * 2 + 1]); if (pos < (unsigned)TK_CAP) { csc[(2 * c + 1) * TK_CAP + pos] = s1; cix[(2 * c + 1) * TK_CAP + pos] = (unsigned short)s; } } }
                    TK_GROUP_END() }
                if ((lane & 31) == 0) { cnt[(2 * c) * 2] = cntA; cnt[(2 * c + 1) * 2] = cntB; }
                asm volatile("s_waitcnt lgkmcnt(0)" ::: "memory");
            } else {
                for (int i = lane; i < 4 * TK_BINS; i += 64) hist[i] = 0u;
                asm volatile("s_waitcnt lgkmcnt(0)" ::: "memory");
                int mode = 1;
#pragma unroll 1
                for (;;) {
                const int klo0 = c ? lo[2] : lo[0], khi0 = c ? hi[2] : hi[0], klo1 = c ? lo[3] : lo[1], khi1 = c ? hi[3] : hi[1];
                const bool ov0 = c ? ov[2] : ov[0], ov1 = c ? ov[3] : ov[1];
                bf16x8 kb[4][4];
#pragma unroll
                for (int u4 = 0; u4 < 4; ++u4) { const int kq = u4 < j ? u4 : j;
#pragma unroll
                    for (int st = 0; st < 4; ++st) kb[u4][st] = *(const GAS bf16x8*)(kbase + (size_t)kq * 32 * IDIM + 16 * st); }
#pragma unroll 1
                for (int kt = 0; kt <= j; kt += 4) {
                    bf16x8 kn[4][4];
#pragma unroll
                    for (int u4 = 0; u4 < 4; ++u4) { const int kq = kt + 4 + u4 < j ? kt + 4 + u4 : j;
#pragma unroll
                        for (int st = 0; st < 4; ++st) kn[u4][st] = *(const GAS bf16x8*)(kbase + (size_t)kq * 32 * IDIM + 16 * st); }
#pragma unroll
                    for (int u4 = 0; u4 < 4; ++u4) {
                        f32x16 acc;
#pragma unroll
                        for (int r = 0; r < 16; ++r) acc[r] = 0.f;
#pragma unroll
                        for (int st = 0; st < 4; ++st) acc = __builtin_amdgcn_mfma_f32_32x32x16_bf16(qa[st], kb[u4][st], acc, 0, 0, 0);
                        const float s0 = tk_score(acc, 0, w0), s1 = tk_score(acc, 1, w1);
                        const int s = 32 * (kt + u4) + n; const int k0 = tk_key(s0, scA), k1 = tk_key(s1, scB);
                        const bool v0 = s <= tA, v1 = s <= tB;
                        if (mode == 0) {
                            if (v0 && tA >= TOPK) LDS_ADD(&hist[(2 * c) * TK_BINS + (k0 >> 9)]);
                            if (v1 && tB >= TOPK) LDS_ADD(&hist[(2 * c + 1) * TK_BINS + (k1 >> 9)]);
                        } else if (mode == 1) {
                            if (v0 && ov0 && k0 >= klo0 && k0 <= khi0) LDS_ADD(&hist[(2 * c) * TK_BINS + (k0 & 511)]);
                            if (v1 && ov1 && k1 >= klo1 && k1 <= khi1) LDS_ADD(&hist[(2 * c + 1) * TK_BINS + (k1 & 511)]);
                        } else {
                            if (v0) { if (k0 > khi0) { const unsigned pos = LDS_ADD(&cnt[(2 * c) * 2]); if (pos < 256u) sel[(2 * c) * 256 + pos] = (unsigned short)s; }
                                      else if (k0 >= klo0) { const unsigned pos = LDS_ADD(&cnt[(2 * c) * 2 + 1]); if (pos < (unsigned)TK_CAP) { csc[(2 * c) * TK_CAP + pos] = s0; cix[(2 * c) * TK_CAP + pos] = (unsigned short)s; } } }
                            if (v1) { if (k1 > khi1) { const unsigned pos = LDS_ADD(&cnt[(2 * c + 1) * 2]); if (pos < 256u) sel[(2 * c + 1) * 256 + pos] = (unsigned short)s; }
                                      else if (k1 >= klo1) { const unsigned pos = LDS_ADD(&cnt[(2 * c + 1) * 2 + 1]); if (pos < (unsigned)TK_CAP) { csc[(2 * c + 1) * TK_CAP + pos] = s1; cix[(2 * c + 1) * TK_CAP + pos] = (unsigned short)s; } } }
                        }
                    }
#pragma unroll
                    for (int u4 = 0; u4 < 4; ++u4)
#pragma unroll
                        for (int st = 0; st < 4; ++st) kb[u4][st] = kn[u4][st];
                }
                    asm volatile("s_waitcnt lgkmcnt(0)" ::: "memory");
                    if (mode == 2) break;
#pragma unroll
                    for (int tk = 0; tk < 4; ++tk) if (ov[tk]) { int sub; unsigned above; tk_find(hist + tk * TK_BINS, (unsigned)TOPK - ab0[tk], lane, sub, above); lo[tk] += sub; hi[tk] = lo[tk]; }
                    mode = 2;
                }
            }
#undef TK_GROUP_BEGIN
#undef TK_GROUP_END
#undef TK_PRIME
#pragma unroll 1
            for (int tk = 0; tk < 4; ++tk) { const int t = t0 + tk;
                if (t >= TOPK) { const unsigned nsel = cnt[tk * 2]; unsigned nc = cnt[tk * 2 + 1]; nc = nc > (unsigned)TK_CAP ? (unsigned)TK_CAP : nc; const unsigned need = nsel < 256u ? 256u - nsel : 0u;
                    for (unsigned q = 0; q < 2; ++q) { const unsigned i = lane + 64 * q;
                        const float si = i < nc ? csc[tk * TK_CAP + i] : 0.f; const unsigned xi = i < nc ? cix[tk * TK_CAP + i] : 0u; unsigned rank = 0;
                        for (unsigned jx = 0; jx < nc; ++jx) { const float sj = csc[tk * TK_CAP + jx]; const unsigned xj = cix[tk * TK_CAP + jx]; rank += (sj > si || (sj == si && xj < xi)) ? 1u : 0u; }
                        if (i < nc && rank < need) sel[tk * 256 + nsel + rank] = (unsigned short)xi; } } }
            asm volatile("s_waitcnt lgkmcnt(0)" ::: "memory");
            { const LAS v4u* sv = (const LAS v4u*)sel; GAS v4u* ov = (GAS v4u*)(IDX + (rb + t0) * TOPK);
              ov[lane] = sv[lane]; ov[lane + 64] = sv[lane + 64]; }
            asm volatile("s_waitcnt vmcnt(0) lgkmcnt(0)" ::: "memory");
        }
    }
}
constexpr int DSA_TAB_OFF = RING_BYTES + 1024;
static_assert(DSA_TAB_OFF + 8 * 129 * 4 <= LDS_BYTES, "DSA LDS map");
__device__ __forceinline__ void dsa_phase(LAS unsigned char* lds_all, const GAS bf16* Z, const GAS bf16* CKVN, const GAS unsigned short* IDX, GAS bf16* O, const GAS float* rel_bias, int gw, int NGW, int tid, int lane, int wave) {
    LAS float* tab = (LAS float*)(lds_all + DSA_TAB_OFF);
    for (int e = tid; e < 8 * 129; e += NWAVES * 64) { const int hh = e / 129, dist = e - hh * 129; tab[e] = rel_bias[(dist < 128 ? (int)T5_BUCKET[dist] : 31) * 24 + hh]; }
    __syncthreads();
    LAS unsigned char* img = lds_all + RING_OFF + wave * 16384;
    const unsigned imgb = (unsigned)(size_t)img;
    const int h = lane & 15, g = lane >> 4;
    const LAS float* tabh = tab + (h & 7) * 129;
    const int TPW = (M + NGW - 1) / NGW;
    const int tok_end = (gw + 1) * TPW < M ? (gw + 1) * TPW : M;
    const int xq = 2 * (lane & 7);
    const int qk_off = (lane & 15) * 512;
    const int q4 = (lane & 15) >> 2, p4 = lane & 3; const int xr = 2 * (4 * (g & 1) + q4);
    const unsigned pv_base = imgb + (unsigned)((4 * g + q4) * 512 + 8 * (p4 & 1));
#pragma unroll 1
    for (int tok = gw * TPW; tok < tok_end; ++tok) {
        const int t = tok & (SEQ - 1); const size_t rb = (size_t)(tok - t);
        const int nsel = t + 1 < TOPK ? t + 1 : TOPK;
        bf16x8 qf[8];
#pragma unroll
        for (int st = 0; st < 8; ++st) { qf[st] = *(const GAS bf16x8*)(Z + (size_t)tok * ZLD + ZC_QLAT + (h & 7) * 256 + 32 * st + 8 * g); if (h >= 8) qf[st] = (bf16x8){0, 0, 0, 0, 0, 0, 0, 0}; }
        f32x4 oacc[16];
#pragma unroll
        for (int rt = 0; rt < 16; ++rt) oacc[rt] = (f32x4){0.f, 0.f, 0.f, 0.f};
        float mrun = -1e30f, lsum = 0.f;
        const GAS unsigned short* ip = IDX + (size_t)tok * TOPK;
#pragma unroll 1
        for (int ch = 0; ch < 8; ++ch) {
            if (32 * ch >= nsel) break;
            const int ixv = (int)ip[32 * ch + (lane & 31)];
            const unsigned long long i0 = *(const GAS unsigned long long*)(ip + 32 * ch + 4 * g), i1 = *(const GAS unsigned long long*)(ip + 32 * ch + 16 + 4 * g);
            asm volatile("s_waitcnt lgkmcnt(0)" ::: "memory");
#pragma unroll
            for (int i = 0; i < 16; ++i) { const int r0 = __builtin_amdgcn_readlane(ixv, 2 * i), r1 = __builtin_amdgcn_readlane(ixv, 2 * i + 1);
                const int row = 2 * i + (lane >> 5); const int ridx = lane < 32 ? r0 : r1; const int chunk = (lane & 31) ^ (2 * (row & 7));
                const GAS unsigned char* src = (const GAS unsigned char*)(CKVN + (rb + ridx) * RANK) + chunk * 16;
                __builtin_amdgcn_global_load_lds((const GAS unsigned*)src, (LAS unsigned*)(img + i * 1024), 16, 0, 0); }
            asm volatile("s_waitcnt vmcnt(0)" ::: "memory");
            f32x4 sa[2];
#pragma unroll
            for (int tl = 0; tl < 2; ++tl) { sa[tl] = (f32x4){0.f, 0.f, 0.f, 0.f};
#pragma unroll
                for (int st = 0; st < 8; ++st) { const bf16x8 a = *(const LAS bf16x8*)(img + qk_off + tl * 16 * 512 + (((4 * st + g) ^ xq) * 16));
                    sa[tl] = __builtin_amdgcn_mfma_f32_16x16x32_bf16(a, qf[st], sa[tl], 0, 0, 0); } }
            float lg[8]; float cmax = -1e30f;
#pragma unroll
            for (int e = 0; e < 8; ++e) { const int tl = e >> 2, jx = e & 3; const int kk = 32 * ch + 16 * tl + 4 * g + jx;
                const int sidx = (int)(((tl ? i1 : i0) >> (16 * jx)) & 0xffffull); int dd = t - sidx; dd = dd < 0 ? 0 : (dd > 128 ? 128 : dd);
                const float v = kk < nsel ? sa[tl][jx] + tabh[dd] : -1e30f; lg[e] = v; cmax = fmaxf(cmax, v); }
            cmax = fmaxf(cmax, SHX(cmax, 16)); cmax = fmaxf(cmax, SHX(cmax, 32));
            const float mnew = fmaxf(mrun, cmax);
            if (__any(mnew > mrun)) { const float alpha = __expf(mrun - mnew); lsum *= alpha;
#pragma unroll
                for (int rt = 0; rt < 16; ++rt) oacc[rt] = oacc[rt] * alpha; }
            mrun = mnew;
            float pe[8];
#pragma unroll
            for (int e = 0; e < 8; ++e) { pe[e] = __expf(lg[e] - mnew); lsum += pe[e]; }
            bf16x8 pf; { const v4u wv = {pg8::cvt_pk_bf16(pe[0], pe[1]), pg8::cvt_pk_bf16(pe[2], pe[3]), pg8::cvt_pk_bf16(pe[4], pe[5]), pg8::cvt_pk_bf16(pe[6], pe[7])}; pf = __builtin_bit_cast(bf16x8, wv); }
#pragma unroll
            for (int rt = 0; rt < 16; rt += 2) {
                const unsigned a0 = pv_base + (unsigned)((((2 * rt) ^ xr) | (p4 >> 1)) * 16), a1 = pv_base + (unsigned)((((2 * rt + 2) ^ xr) | (p4 >> 1)) * 16);
                s16x4 r0, r1, r2, r3; tr_read4(a0, a0 + 16 * 512, a1, a1 + 16 * 512, r0, r1, r2, r3);
                oacc[rt] = __builtin_amdgcn_mfma_f32_16x16x32_bf16(cat4(r0, r1), pf, oacc[rt], 0, 0, 0);
                oacc[rt + 1] = __builtin_amdgcn_mfma_f32_16x16x32_bf16(cat4(r2, r3), pf, oacc[rt + 1], 0, 0, 0); }
        }
        lsum += SHX(lsum, 16); lsum += SHX(lsum, 32);
        const float inv = (OUT_F8 ? O8_SCALE : 1.0f) / lsum;
        if (h < 8) {
            if constexpr (OUT_F8) { GAS unsigned char* orow = (GAS unsigned char*)O + (size_t)tok * OLD + h * 256 + 4 * g;
#pragma unroll
                for (int rt = 0; rt < 16; ++rt) { int p = 0; p = __builtin_amdgcn_cvt_pk_fp8_f32(oacc[rt][0] * inv, oacc[rt][1] * inv, p, false); p = __builtin_amdgcn_cvt_pk_fp8_f32(oacc[rt][2] * inv, oacc[rt][3] * inv, p, true); *(GAS unsigned*)(orow + 16 * rt) = (unsigned)p; } }
            else { GAS bf16* orow = O + (size_t)tok * OLD + h * 256 + 4 * g;
#pragma unroll
            for (int rt = 0; rt < 16; ++rt) *(GAS unsigned long long*)(orow + 16 * rt) = (unsigned long long)pk2(oacc[rt][0] * inv, oacc[rt][1] * inv) | ((unsigned long long)pk2(oacc[rt][2] * inv, oacc[rt][3] * inv) << 32); } }
    }
}
struct Args { const float* in[20]; float* out; unsigned char* ws; };
__device__ __forceinline__ unsigned long long karg_u64(int idx) { unsigned long long r; const unsigned off = (unsigned)idx * 8u;
    asm volatile("s_load_dwordx2 %0, %1, %2\n\ts_waitcnt lgkmcnt(0)" : "=s"(r) : "s"(__builtin_amdgcn_kernarg_segment_ptr()), "s"(off) : "memory"); return r; }
__device__ __forceinline__ const GAS float* karg_in(int i) { return (const GAS float*)karg_u64(i); }
__device__ __forceinline__ GAS float* karg_out() { return (GAS float*)karg_u64(20); }
__device__ __forceinline__ GAS unsigned char* karg_ws() { return (GAS unsigned char*)karg_u64(21); }
#ifndef REP_P0
#define REP_P0 1
#endif
#ifndef REP_NORM
#define REP_NORM 1
#endif
#ifndef REP_GU
#define REP_GU 1
#endif
#ifndef REP_IN
#define REP_IN 1
#endif
#ifndef REP_POST
#define REP_POST 1
#endif
#ifndef REP_TOPK
#define REP_TOPK 1
#endif
#ifndef REP_DSA
#define REP_DSA 1
#endif
#define REPEAT(n) _Pragma("unroll 1") for (int rep_ = 0; rep_ < (n); ++rep_)
#define PHASE_IDS() int tid = threadIdx.x; asm volatile("" : "+v"(tid)); int bx = blockIdx.x; asm volatile("" : "+s"(bx)); int G = gridDim.x; asm volatile("" : "+s"(G)); \
    const int lane = tid & 63, wave = __builtin_amdgcn_readfirstlane(tid >> 6); const int vcu = (G % 8 == 0) ? (bx % 8) * (G / 8) + bx / 8 : bx; const int gw = vcu * NWAVES + wave, NGW = G * NWAVES; \
    GAS unsigned char* ws = karg_ws(); (void)lane; (void)gw; (void)NGW; (void)vcu; (void)ws
__global__ void __launch_bounds__(NWAVES * 64, 2) mk_fwd(Args args) {
    extern __shared__ __attribute__((aligned(16))) unsigned char lds_raw[];
    LAS unsigned char* lds = (LAS unsigned char*)lds_raw;
    volatile LAS unsigned* MISC = (volatile LAS unsigned*)(lds + MISC_OFF);
    for (int u = threadIdx.x; u < (LDS_BYTES - LDSCTL_OFF) / 4; u += NWAVES * 64) ((LAS unsigned*)(lds + LDSCTL_OFF))[u] = 0u;
    __syncthreads();
    (void)xcd_barrier_post((unsigned*)((gu32*)(karg_ws() + WS_CTL) + CW_BAR), MISC + 8);
#define GRID_BAR() do { XcdBarrier b_; b_.bar = (unsigned*)((gu32*)(karg_ws() + WS_CTL) + CW_BAR); b_.x = xb_xcc_id(); b_.st = MISC + 8; xcd_barrier(b_); } while (0)

    REPEAT(REP_P0) {   PHASE_IDS();
        LAS float* scr = (LAS float*)(lds + RING_OFF + wave * 16384);
        rows_bf16_ss(karg_in(0), (GAS bf16*)(ws + WS_XN), f8_on(0, 0) ? (GAS unsigned char*)(ws + WS_HB8) : (GAS unsigned char*)nullptr, (GAS float*)(ws + WS_SS), gw, NGW, lane);
        constexpr int I_GU = (D / 64) * (FF / 32), I_DN = (FF / 64) * (D / 32);
        constexpr int I_FFN = 2 * I_GU + I_DN, I_IN = 72 * (D / 64), I_OB = (1024 / 64) * (D / 32);
        constexpr int PER_LAYER = 2 * I_FFN + I_IN + I_OB;
        for (int it = gw; it < DEPTH * PER_LAYER; it += NGW) {
            const int l = it / PER_LAYER; int r = it - l * PER_LAYER;
            GAS unsigned char* wl = ws + WS_W0 + (size_t)l * W_LAYER;
            if (r < 2 * I_FFN) {
                const int f = r / I_FFN; r -= f * I_FFN;
                GAS bf16* dgu = (GAS bf16*)(wl + (f ? WO_GU2 : WO_GU1)); GAS bf16* dd = (GAS bf16*)(wl + (f ? WO_D2 : WO_D1));
                if (r < 2 * I_GU) { const int up = r >= I_GU; if (up) r -= I_GU; const int kb = r / (FF / 32), nb = r % (FF / 32), n0 = 32 * nb;
                    const GAS float* wsrc = karg_in(up ? (f ? 17 : 4) : (f ? 16 : 3)) + (size_t)l * D * FF;
                    const int drow = (n0 >> 7) * 256 + (up ? 128 : 0) + (n0 & 127);
                    if (f8_on(l, f)) conv_item<true>(wsrc, FF, 64 * kb, n0, 32, dgu, D, drow, 0, W8_SCALE, karg_in(f ? 15 : 2) + (size_t)l * D, scr, lane);
                    else conv_item(wsrc, FF, 64 * kb, n0, 32, dgu, D, drow, 0, 1.0f, karg_in(f ? 15 : 2) + (size_t)l * D, scr, lane); }
                else { r -= 2 * I_GU; const int kb = r / (D / 32), nb = r % (D / 32);
                    if (d8_on(l, f)) conv_item<true>(karg_in(f ? 18 : 5) + (size_t)l * FF * D, D, 64 * kb, 32 * nb, 32, dd, FF, 32 * nb, 0, W8_SCALE, nullptr, scr, lane);
                    else conv_item(karg_in(f ? 18 : 5) + (size_t)l * FF * D, D, 64 * kb, 32 * nb, 32, dd, FF, 32 * nb, 0, 1.0f, nullptr, scr, lane); }
            } else if (r < 2 * I_FFN + I_IN) {
                r -= 2 * I_FFN; const int j = r >> 5, kb = r & 31; int src, nvalid = 32; float sc = 1.0f;
                if (j < 8) src = 1024 + 32 * j;
                else if (j < 24) src = 1280 + 32 * (j - 8);
                else if (j < 56) { src = 1864 + 32 * (j - 24); sc = 0.125f; }
                else if (j < 60) src = 2888 + 32 * (j - 56);
                else if (j < 64) src = 3016 + 32 * (j - 60);
                else if (j < 66) src = 1792 + 32 * (j - 64);
                else if (j == 66) { src = 1856; nvalid = 8; sc = 0.044194173824159216f; }
                else { src = 0; nvalid = 0; }
                conv_item(karg_in(7) + (size_t)l * D * D_IN, D_IN, 64 * kb, src, nvalid, (GAS bf16*)(wl + WO_IN), D, 2048 + 32 * j, 0, sc, karg_in(6) + (size_t)l * D, scr, lane);
            } else {
                r -= 2 * I_FFN + I_IN; const int kb = r >> 6, nb = r & 63;
                if constexpr (OUT_F8) conv_item<true>(karg_in(14) + (size_t)l * D * D + (size_t)1024 * D, D, 64 * kb, 32 * nb, 32, (GAS bf16*)(wl + WO_OUT), OLD, 32 * nb, 2048, W8_SCALE, nullptr, scr, lane);
                else conv_item(karg_in(14) + (size_t)l * D * D + (size_t)1024 * D, D, 64 * kb, 32 * nb, 32, (GAS bf16*)(wl + WO_OUT), OLD, 32 * nb, 2048, 1.0f, nullptr, scr, lane);
            }
        }
        __syncthreads();
        LAS float* Ps = (LAS float*)(lds + RING_OFF); LAS float* Qs = Ps + 64 * 129;
        for (int u = vcu; u < DEPTH * 2048; u += G) {
            const int l = u >> 11, which = (u >> 10) & 1, v = u & 1023;
            GAS unsigned char* wl = ws + WS_W0 + (size_t)l * W_LAYER;
            if (which == 0) { const int h = v >> 7, rt = (v >> 5) & 3, kt = v & 31;
                absorb_unit<false>(karg_in(11) + (size_t)l * RANK * 1024 + ((size_t)(64 * rt) * 8 + h) * 128, 1024, 1, karg_in(7) + (size_t)l * D * D_IN + (size_t)(64 * kt) * D_IN + h * 128, D_IN,
                                   (GAS bf16*)(wl + WO_IN) + (size_t)(h * 256 + 64 * rt) * D + 64 * kt, D, 0.08838834764831845f, karg_in(6) + (size_t)l * D + 64 * kt, Ps, Qs, tid); }
            else { const int h = v >> 7, nt = (v >> 2) & 31, rt = v & 3;
                if constexpr (OUT_F8) absorb_unit<true, true>(karg_in(14) + (size_t)l * D * D + (size_t)(h * 128) * D + 64 * nt, 1, D, karg_in(12) + (size_t)l * RANK * 1024 + ((size_t)(64 * rt) * 8 + h) * 128, 1024,
                                  (GAS bf16*)((GAS unsigned char*)(wl + WO_OUT) + (size_t)(64 * nt) * OLD + h * 256 + 64 * rt), OLD, W8_SCALE, nullptr, Ps, Qs, tid);
                else absorb_unit<true>(karg_in(14) + (size_t)l * D * D + (size_t)(h * 128) * D + 64 * nt, 1, D, karg_in(12) + (size_t)l * RANK * 1024 + ((size_t)(64 * rt) * 8 + h) * 128, 1024,
                                  (GAS bf16*)(wl + WO_OUT) + (size_t)(64 * nt) * OLD + h * 256 + 64 * rt, OLD, 1.0f, nullptr, Ps, Qs, tid); }
        }
    }
    GRID_BAR();

#pragma unroll 1
    for (int s = 0; s < 2 * DEPTH; ++s) {
        const int l = s >> 1, f = s & 1;
        REPEAT(REP_GU) {   PHASE_IDS(); GAS unsigned char* wl = ws + WS_W0 + (size_t)l * W_LAYER;
            pg8::StaticOrder S; S.init(M, NGU, G, bx);
            const GAS float* ssp = (const GAS float*)(ws + WS_SS + (size_t)((3 * l + 2 * f) & 1) * SS_BYTES);
            if ((F8_MASK == 0xF) || (F8_MASK != 0 && f8_on(l, f))) {
                if constexpr (F8_MASK != 0) {
                    pg8::Gemm g{(const GAS bf16*)(ws + WS_HB8), (const GAS bf16*)(wl + (f ? WO_GU2 : WO_GU1)), M, NGU, D / 2};
                    pg8::EpiSwiglu E{(GAS bf16*)(ws + WS_ACT), FF, ssp, 1.0f / D, EPS, 1.0f / W8_SCALE, d8_on(l, f) ? A8_SCALE : 0.f};
                    pg8::gemm_phase<pg8::EpiSwiglu, pg8::StaticOrder, true, true, true>(lds + RING_OFF, g, S, E); }
            } else {
                if constexpr (F8_MASK != 0xF) {
                    pg8::Gemm g{(const GAS bf16*)(ws + WS_XN), (const GAS bf16*)(wl + (f ? WO_GU2 : WO_GU1)), M, NGU, D};
                    pg8::EpiSwiglu E{(GAS bf16*)(ws + WS_ACT), FF, ssp, 1.0f / D, EPS, 1.0f, d8_on(l, f) ? A8_SCALE : 0.f};
                    pg8::gemm_phase<pg8::EpiSwiglu, pg8::StaticOrder, true, true, false>(lds + RING_OFF, g, S, E); }
            } }
        GRID_BAR();
        {   PHASE_IDS(); GAS unsigned char* wl = ws + WS_W0 + (size_t)l * W_LAYER;
            pg8::StaticOrder S; S.init(M, D, G, bx);
            const unsigned sso = (unsigned)(WS_SS + (size_t)((3 * l + 2 * f + 1) & 1) * SS_BYTES), h8o = (f == 1 && l + 1 < DEPTH && f8_on(l + 1, 0)) ? (unsigned)WS_HB8 : 0u;
            if ((D8_MASK == 0xF) || (D8_MASK != 0 && d8_on(l, f))) {
                if constexpr (D8_MASK != 0) {
                    pg8::Gemm g{(const GAS bf16*)(ws + WS_ACT), (const GAS bf16*)(wl + (f ? WO_D2 : WO_D1)), M, D, FF / 2};
                    pg8::EpiResid E{0.5f / (W8_SCALE * A8_SCALE), (unsigned)WS_XN, sso, h8o};
                    pg8::gemm_phase<pg8::EpiResid, pg8::StaticOrder, true, true, true>(lds + RING_OFF, g, S, E); }
            } else {
                if constexpr (D8_MASK != 0xF) {
                    pg8::Gemm g{(const GAS bf16*)(ws + WS_ACT), (const GAS bf16*)(wl + (f ? WO_D2 : WO_D1)), M, D, FF};
                    pg8::EpiResid E{0.5f, (unsigned)WS_XN, sso, h8o};
                    pg8::gemm_phase<pg8::EpiResid, pg8::StaticOrder, true, true, false>(lds + RING_OFF, g, S, E); }
            } }
        GRID_BAR();
        if (f == 0) {
            REPEAT(REP_IN) {   PHASE_IDS(); GAS unsigned char* wl = ws + WS_W0 + (size_t)l * W_LAYER;
                pg8::Gemm g{(const GAS bf16*)(ws + WS_XN), (const GAS bf16*)(wl + WO_IN), M, ZLD, D}; pg8::StaticOrder S; S.init(M, ZLD, G, bx);
                pg8::EpiBf16 E{(GAS bf16*)(ws + WS_Z), ZLD, (const GAS float*)(ws + WS_SS + (size_t)((3 * l + 1) & 1) * SS_BYTES), 1.0f / D, EPS};
                pg8::gemm_phase<pg8::EpiBf16, pg8::StaticOrder, true, true>(lds + RING_OFF, g, S, E); }
            GRID_BAR();
            REPEAT(REP_POST) {   PHASE_IDS();
                post_rows((const GAS bf16*)(ws + WS_Z), karg_in(8) + (size_t)l * RANK, karg_in(9) + (size_t)l * IDIM, karg_in(10) + (size_t)l * IDIM, (GAS bf16*)(ws + WS_CKVN), (GAS bf16*)(ws + WS_KIN), (GAS float*)(ws + WS_WIF), gw, NGW, lane);
                swa_phase(lds + RING_OFF, (const GAS bf16*)(ws + WS_Z), (GAS bf16*)(ws + WS_O), karg_in(1), karg_in(13) + (size_t)l * H_B, vcu, G, tid, lane, wave);
            }
            GRID_BAR();
            REPEAT(REP_TOPK) {   PHASE_IDS(); topk_phase(lds + RING_OFF, (const GAS bf16*)(ws + WS_Z), (const GAS bf16*)(ws + WS_KIN), (const GAS float*)(ws + WS_WIF), (GAS unsigned short*)(ws + WS_IDX), vcu, G, lane, wave); }
            GRID_BAR();
            REPEAT(REP_DSA) {   PHASE_IDS(); dsa_phase(lds, (const GAS bf16*)(ws + WS_Z), (const GAS bf16*)(ws + WS_CKVN), (const GAS unsigned short*)(ws + WS_IDX), (GAS bf16*)(ws + WS_O), karg_in(1), gw, NGW, tid, lane, wave); }
            GRID_BAR();
            {   PHASE_IDS(); GAS unsigned char* wl = ws + WS_W0 + (size_t)l * W_LAYER;
                pg8::Gemm g{(const GAS bf16*)(ws + WS_O), (const GAS bf16*)(wl + WO_OUT), M, D, OUT_F8 ? OLD / 2 : OLD}; pg8::StaticOrder S; S.init(M, D, G, bx);
                pg8::EpiResid E{OUT_F8 ? 1.0f / (W8_SCALE * O8_SCALE) : 1.0f, (unsigned)WS_XN, (unsigned)(WS_SS + (size_t)((3 * l + 2) & 1) * SS_BYTES), f8_on(l, 1) ? (unsigned)WS_HB8 : 0u};
                pg8::gemm_phase<pg8::EpiResid, pg8::StaticOrder, true, true, OUT_F8 != 0>(lds + RING_OFF, g, S, E); }
            GRID_BAR();
        }
    }
    {   PHASE_IDS(); final_rows((const GAS bf16*)(ws + WS_XN), karg_out(), karg_in(19), (const GAS float*)(ws + WS_SS + (size_t)(6 & 1) * SS_BYTES), gw, NGW, lane); }
}

extern "C" void kernel_launch(void* const* d_in, const int* in_sizes, int n_in, void* d_out, int out_size, void* d_ws, size_t ws_size, hipStream_t stream) {
    static int grid = 0;
    if (grid == 0) {
        if (n_in != 20 || in_sizes[0] != M * D || out_size != M * D || ws_size < WS_END) { fprintf(stderr, "kernel_launch: unexpected shapes (n_in %d, in0 %d, out %d, ws %zu); nothing launched\n", n_in, n_in > 0 ? in_sizes[0] : -1, out_size, ws_size); grid = -1; return; }
        int dev = 0, cus = 0, per_cu = 0;
        if (hipGetDevice(&dev) != hipSuccess || hipDeviceGetAttribute(&cus, hipDeviceAttributeMultiprocessorCount, dev) != hipSuccess) { grid = -1; return; }
        if (hipFuncSetAttribute((const void*)mk_fwd, hipFuncAttributeMaxDynamicSharedMemorySize, LDS_BYTES) != hipSuccess) { fprintf(stderr, "kernel_launch: hipFuncSetAttribute failed\n"); grid = -1; return; }
        if (hipOccupancyMaxActiveBlocksPerMultiprocessor(&per_cu, (const void*)mk_fwd, NWAVES * 64, LDS_BYTES) != hipSuccess || per_cu < 1) { fprintf(stderr, "kernel_launch: occupancy query reports %d workgroups per CU\n", per_cu); }
        (void)hipGetLastError();
        grid = cus;
    }
    if (grid < 0) return;
    if (hipMemsetAsync((char*)d_ws + WS_CTL, 0, CTL_ZERO_BYTES, stream) != hipSuccess) return;
    Args a{};
    for (int i = 0; i < 20; ++i) a.in[i] = (const float*)d_in[i];
    a.out = (float*)d_out; a.ws = (unsigned char*)d_ws;
    hipLaunchKernelGGL(mk_fwd, dim3(grid), dim3(NWAVES * 64), LDS_BYTES, stream, a);
}
```

```cpp
#define F8_MASK 0xA
#define D8_MASK 0xA
#include <hip/hip_runtime.h>
#include <cstdio>
#include <cstdint>
namespace pg8 {
#define PG8_LAS __attribute__((address_space(3)))
#define PG8_GAS __attribute__((address_space(1)))
typedef unsigned short bf16_t;
typedef short bf16x8 __attribute__((ext_vector_type(8)));
typedef float f32x4 __attribute__((ext_vector_type(4)));
typedef unsigned u32x4 __attribute__((ext_vector_type(4)));
constexpr int BM = 256, BK = 64, HALF = 128, HTB = HALF * BK * 2  , STAGE_BYTES = 8 * HTB, NXCD = 8, WGM = 8;

__host__ __device__ __forceinline__ int lds_byte(int r, int c) { const int st = (r >> 4) * 2 + (c >> 5), rr = r & 15, cc = c & 31, ob = rr * 64 + cc * 2; return st * 1024 + (ob ^ (((ob >> 9) & 1) << 5)); }
__host__ __device__ __forceinline__ void stage_rc(int b, int& R, int& C) { const int st = b / 1024, sb = b % 1024, swz = sb ^ (((sb >> 9) & 1) << 5); R = (st >> 1) * 16 + swz / 64; C = (st & 1) * 32 + (swz % 64) / 2; }
__host__ __device__ __forceinline__ int perm32(int rho) { const int n = rho >> 4, i = rho & 15; return 8 * (i >> 2) + 4 * n + (i & 3); }

typedef int i32x8 __attribute__((ext_vector_type(8))); typedef int i32x4v __attribute__((ext_vector_type(4)));
__device__ __forceinline__ i32x8 cat8(bf16x8 a, bf16x8 b) { return __builtin_shufflevector(__builtin_bit_cast(i32x4v, a), __builtin_bit_cast(i32x4v, b), 0, 1, 2, 3, 4, 5, 6, 7); }
struct Unit { int pm, pn; };
struct Gemm { const PG8_GAS bf16_t* A; const PG8_GAS bf16_t* Bt; int M, N, K; };

struct StaticOrder {
    int nM, nN, nwg, G, c;
    __host__ __device__ void init(int M, int N, int G_, int c_) { nM = M / BM; nN = N / BM; nwg = nM * nN; G = G_; c = c_; }
    __host__ __device__ bool next(int i, Unit& u) const {
        const long L = (long)i * G + c; if (L >= nwg) return false;
        int wgid = (int)L; { const int q = nwg / NXCD, r = nwg % NXCD, xcd = wgid % NXCD, off = wgid / NXCD; wgid = (xcd < r ? xcd * (q + 1) : r * (q + 1) + (xcd - r) * q) + off; }
        const int nig = WGM * nN, gid = wgid / nig, fm = gid * WGM, gsz = (nM - fm) < WGM ? (nM - fm) : WGM;
        u.pm = fm + ((wgid % nig) % gsz); u.pn = (wgid % nig) / gsz; return true;
    }
    __device__ __forceinline__ void a_ready(const Unit&) const {}
    __device__ __forceinline__ void done(const Unit&) const {}
};
__device__ __forceinline__ unsigned long long karg64(int idx) { unsigned long long r; const unsigned off = (unsigned)idx * 8u;
    asm volatile("s_load_dwordx2 %0, %1, %2\n\ts_waitcnt lgkmcnt(0)" : "=s"(r) : "s"(__builtin_amdgcn_kernarg_segment_ptr()), "s"(off) : "memory"); return r; }
__device__ __forceinline__ unsigned cvt_pk_bf16(float lo, float hi) { unsigned r; asm volatile("v_cvt_pk_bf16_f32 %0, %1, %2" : "=v"(r) : "v"(lo), "v"(hi)); return r; }
__device__ __forceinline__ float silu_f(float g) { return g * __builtin_amdgcn_rcpf(1.0f + __builtin_amdgcn_exp2f(-1.4426950408889634f * g)); }

struct EpiSwiglu {
    static constexpr bool PERM = true, AFTER_DRAIN = false;
    PG8_GAS bf16_t* O; int ldc; const PG8_GAS float* ss; float inv_k, eps, post; float out8;
    __device__ __forceinline__ void operator()(const f32x4 (&acc)[2][2][4][2], const Unit& u, int wr, int wc, int fr, int fq) const {
        const int row0 = u.pm * BM + wr * 64 + fr, col0 = u.pn * HALF + wc * 32 + 8 * fq;
        float rs[8]; const int lane_ = fr + 16 * fq;
#pragma unroll
        for (int k = 0; k < 8; ++k) { const PG8_GAS f32x4* p4 = (const PG8_GAS f32x4*)(ss + (size_t)(row0 + (k >> 2) * HALF + (k & 3) * 16) * 32 + 8 * fq); const f32x4 a = p4[0], b = p4[1];
            float t = ((a[0] + a[1]) + (a[2] + a[3])) + ((b[0] + b[1]) + (b[2] + b[3]));
            t += __builtin_bit_cast(float, __builtin_amdgcn_ds_bpermute((lane_ ^ 16) << 2, __builtin_bit_cast(int, t)));
            t += __builtin_bit_cast(float, __builtin_amdgcn_ds_bpermute((lane_ ^ 32) << 2, __builtin_bit_cast(int, t))); rs[k] = t; }
#pragma unroll
        for (int ai = 0; ai < 2; ++ai)
#pragma unroll
            for (int m = 0; m < 4; ++m) { PG8_GAS bf16_t* rowp = O + (size_t)(row0 + ai * HALF + m * 16) * ldc + col0;
                const float r = __builtin_amdgcn_rsqf(rs[ai * 4 + m] * inv_k + eps) * post;
                const f32x4 g0 = acc[ai][0][m][0] * r, g1 = acc[ai][0][m][1] * r, u0 = acc[ai][1][m][0] * r, u1 = acc[ai][1][m][1] * r;
                if (out8 != 0.f) { int p = 0, q = 0;
                    p = __builtin_amdgcn_cvt_pk_fp8_f32(silu_f(g0[0]) * u0[0] * out8, silu_f(g0[1]) * u0[1] * out8, p, false); p = __builtin_amdgcn_cvt_pk_fp8_f32(silu_f(g0[2]) * u0[2] * out8, silu_f(g0[3]) * u0[3] * out8, p, true);
                    q = __builtin_amdgcn_cvt_pk_fp8_f32(silu_f(g1[0]) * u1[0] * out8, silu_f(g1[1]) * u1[1] * out8, q, false); q = __builtin_amdgcn_cvt_pk_fp8_f32(silu_f(g1[2]) * u1[2] * out8, silu_f(g1[3]) * u1[3] * out8, q, true);
                    typedef unsigned u32x2v __attribute__((ext_vector_type(2))); u32x2v w8; w8.x = (unsigned)p; w8.y = (unsigned)q;
                    *(PG8_GAS u32x2v*)((PG8_GAS unsigned char*)O + (size_t)(row0 + ai * HALF + m * 16) * ldc + col0) = w8; }
                else { u32x4 w; w.x = cvt_pk_bf16(silu_f(g0[0]) * u0[0], silu_f(g0[1]) * u0[1]); w.y = cvt_pk_bf16(silu_f(g0[2]) * u0[2], silu_f(g0[3]) * u0[3]);
                w.z = cvt_pk_bf16(silu_f(g1[0]) * u1[0], silu_f(g1[1]) * u1[1]); w.w = cvt_pk_bf16(silu_f(g1[2]) * u1[2], silu_f(g1[3]) * u1[3]);
                *(PG8_GAS u32x4*)rowp = w; } }
    }
};
struct EpiResid {
    static constexpr bool PERM = true, AFTER_DRAIN = false;
    float alpha; unsigned hb_off; unsigned ss_off; unsigned h8_off;
    __device__ __forceinline__ void operator()(const f32x4 (&acc)[2][2][4][2], const Unit& u, int wr, int wc, int fr, int fq) const {
        constexpr int ldc = 2048;
        PG8_GAS unsigned char* wsb = (PG8_GAS unsigned char*)karg64(21); PG8_GAS bf16_t* hb = (PG8_GAS bf16_t*)(wsb + hb_off); PG8_GAS float* ss = (PG8_GAS float*)(wsb + ss_off);
        const int row0 = u.pm * BM + wr * 64 + fr, col0 = u.pn * BM + wc * 32 + 8 * fq; const int lane = fr + 16 * fq;
        u32x4 cur[2], nxt[2];
        { const size_t off = (size_t)row0 * ldc + col0; cur[0] = *(const PG8_GAS u32x4*)(hb + off); cur[1] = *(const PG8_GAS u32x4*)(hb + off + HALF); }
#pragma unroll
        for (int k = 0; k < 8; ++k) { const int ai = k >> 2, m = k & 3; const int row = row0 + ai * HALF + m * 16; const size_t off = (size_t)row * ldc + col0;
            if (k < 7) { const int ai2 = (k + 1) >> 2, m2 = (k + 1) & 3; const size_t off2 = (size_t)(row0 + ai2 * HALF + m2 * 16) * ldc + col0;
                nxt[0] = *(const PG8_GAS u32x4*)(hb + off2); nxt[1] = *(const PG8_GAS u32x4*)(hb + off2 + HALF); }
            float sq = 0.f;
#pragma unroll
            for (int bj = 0; bj < 2; ++bj) { const u32x4 b = cur[bj]; const f32x4 a0 = acc[ai][bj][m][0], a1 = acc[ai][bj][m][1]; u32x4 w;
                w.x = cvt_pk_bf16(__builtin_bit_cast(float, b.x << 16) + a0[0] * alpha, __builtin_bit_cast(float, b.x & 0xffff0000u) + a0[1] * alpha);
                w.y = cvt_pk_bf16(__builtin_bit_cast(float, b.y << 16) + a0[2] * alpha, __builtin_bit_cast(float, b.y & 0xffff0000u) + a0[3] * alpha);
                w.z = cvt_pk_bf16(__builtin_bit_cast(float, b.z << 16) + a1[0] * alpha, __builtin_bit_cast(float, b.z & 0xffff0000u) + a1[1] * alpha);
                w.w = cvt_pk_bf16(__builtin_bit_cast(float, b.w << 16) + a1[2] * alpha, __builtin_bit_cast(float, b.w & 0xffff0000u) + a1[3] * alpha);
                *(PG8_GAS u32x4*)(hb + off + bj * HALF) = w;
                if (h8_off) { typedef unsigned u32x2v __attribute__((ext_vector_type(2))); u32x2v q8; int p = 0;
                    p = __builtin_amdgcn_cvt_pk_fp8_f32(__builtin_bit_cast(float, w.x << 16), __builtin_bit_cast(float, w.x & 0xffff0000u), p, false);
                    p = __builtin_amdgcn_cvt_pk_fp8_f32(__builtin_bit_cast(float, w.y << 16), __builtin_bit_cast(float, w.y & 0xffff0000u), p, true); q8.x = (unsigned)p; p = 0;
                    p = __builtin_amdgcn_cvt_pk_fp8_f32(__builtin_bit_cast(float, w.z << 16), __builtin_bit_cast(float, w.z & 0xffff0000u), p, false);
                    p = __builtin_amdgcn_cvt_pk_fp8_f32(__builtin_bit_cast(float, w.w << 16), __builtin_bit_cast(float, w.w & 0xffff0000u), p, true); q8.y = (unsigned)p;
                    *(PG8_GAS u32x2v*)(wsb + h8_off + off + bj * HALF) = q8; }
#pragma unroll
                for (int e = 0; e < 4; ++e) { const float lo = __builtin_bit_cast(float, w[e] << 16), hi = __builtin_bit_cast(float, w[e] & 0xffff0000u); sq = fmaf(lo, lo, sq); sq = fmaf(hi, hi, sq); } }
            sq += __builtin_bit_cast(float, __builtin_amdgcn_ds_bpermute((lane ^ 16) << 2, __builtin_bit_cast(int, sq)));
            sq += __builtin_bit_cast(float, __builtin_amdgcn_ds_bpermute((lane ^ 32) << 2, __builtin_bit_cast(int, sq)));
            if (fq == 0) ss[(size_t)row * 32 + u.pn * 4 + wc] = sq;
            cur[0] = nxt[0]; cur[1] = nxt[1]; }
    }
};
struct EpiBf16 {
    static constexpr bool PERM = true, AFTER_DRAIN = false;
    PG8_GAS bf16_t* O; int ldc; const PG8_GAS float* ss; float inv_k, eps;
    __device__ __forceinline__ void operator()(const f32x4 (&acc)[2][2][4][2], const Unit& u, int wr, int wc, int fr, int fq) const {
        const int row0 = u.pm * BM + wr * 64 + fr, col0 = u.pn * BM + wc * 32 + 8 * fq;
        float rs[8]; const int lane_ = fr + 16 * fq;
#pragma unroll
        for (int k = 0; k < 8; ++k) { const PG8_GAS f32x4* p4 = (const PG8_GAS f32x4*)(ss + (size_t)(row0 + (k >> 2) * HALF + (k & 3) * 16) * 32 + 8 * fq); const f32x4 a = p4[0], b = p4[1];
            float t = ((a[0] + a[1]) + (a[2] + a[3])) + ((b[0] + b[1]) + (b[2] + b[3]));
            t += __builtin_bit_cast(float, __builtin_amdgcn_ds_bpermute((lane_ ^ 16) << 2, __builtin_bit_cast(int, t)));
            t += __builtin_bit_cast(float, __builtin_amdgcn_ds_bpermute((lane_ ^ 32) << 2, __builtin_bit_cast(int, t))); rs[k] = t; }
#pragma unroll
        for (int ai = 0; ai < 2; ++ai)
#pragma unroll
            for (int m = 0; m < 4; ++m) { PG8_GAS bf16_t* rowp = O + (size_t)(row0 + ai * HALF + m * 16) * ldc + col0;
                const float r = __builtin_amdgcn_rsqf(rs[ai * 4 + m] * inv_k + eps);
#pragma unroll
                for (int bj = 0; bj < 2; ++bj) { const f32x4 v0 = acc[ai][bj][m][0] * r, v1 = acc[ai][bj][m][1] * r;
                    u32x4 w; w.x = cvt_pk_bf16(v0[0], v0[1]); w.y = cvt_pk_bf16(v0[2], v0[3]); w.z = cvt_pk_bf16(v1[0], v1[1]); w.w = cvt_pk_bf16(v1[2], v1[3]);
                    *(PG8_GAS u32x4*)(rowp + bj * HALF) = w; } }
    }
};
template <class Epi, class Sched, bool ALIGN_EPI = false, bool SP2 = false, bool F8 = false>
__device__ __forceinline__ void gemm_phase(PG8_LAS unsigned char* lds, const Gemm g, const Sched& S, const Epi& E, int tid_in  ) {
    int tid_ = tid_in; asm volatile("" : "+v"(tid_));
    const int tid = tid_, wid = __builtin_amdgcn_readfirstlane(tid >> 6), lane = tid & 63, wr = wid >> 2, wc = wid & 3, fr = lane & 15, fq = lane >> 4;
    const int K = g.K, nt = K / BK;
    unsigned voffA[2], voffB[2];
#pragma unroll
    for (int i = 0; i < 2; ++i) { int R, C; stage_rc(tid * 16 + i * 8192, R, C); const int Rb = Epi::PERM ? ((R & ~31) + perm32(R & 31)) : R;
        voffA[i] = (unsigned)(R * K + C) * 2u; voffB[i] = (unsigned)(Rb * K + C) * 2u; }
    const size_t kstep = (size_t)(BK * 2);
    const size_t hstep = (size_t)HALF * K * 2;
    const size_t tstep = 2 * hstep;
    const unsigned ldsw = (unsigned)wid * 1024u;
    const int aoff = lds_byte(wr * 64 + fr, fq * 8), boff = lds_byte(wc * 32 + fr, fq * 8);
#define PG8_SA(b, h) (((b) * 2 + (h)) * HTB)
#define PG8_SB(b, h) ((4 + (b) * 2 + (h)) * HTB)
#define PG8_STAGE(bufoff, gbase, voff) do { _Pragma("unroll") for (int _i = 0; _i < 2; ++_i) \
        __builtin_amdgcn_global_load_lds((const PG8_GAS unsigned*)((const PG8_GAS char*)(gbase) + (voff)[_i]), (PG8_LAS unsigned*)(lds + (bufoff) + ldsw + _i * 8192), 16, 0, 0); } while (0)
#define PG8_LDA(dst, b, h) do { _Pragma("unroll") for (int m = 0; m < 4; ++m) _Pragma("unroll") for (int k = 0; k < 2; ++k) dst[m][k] = *(const PG8_LAS bf16x8*)(lds + PG8_SA(b, h) + aoff + m * 2048 + k * 1024); } while (0)
#define PG8_LDB(dst, b, h) do { _Pragma("unroll") for (int n = 0; n < 2; ++n) _Pragma("unroll") for (int k = 0; k < 2; ++k) dst[n][k] = *(const PG8_LAS bf16x8*)(lds + PG8_SB(b, h) + boff + n * 2048 + k * 1024); } while (0)
#define PG8_MMA(ai, bj, At, Bt) do { __builtin_amdgcn_s_setprio(1); _Pragma("unroll") for (int m = 0; m < 4; ++m) _Pragma("unroll") for (int n = 0; n < 2; ++n) { \
        if constexpr (F8) { asm volatile("v_mfma_f32_16x16x128_f8f6f4 %0, %1, %2, %0" : "+v"(acc[ai][bj][m][n]) : "v"(cat8(Bt[n][0], Bt[n][1])), "v"(cat8(At[m][0], At[m][1]))); } \
        else { _Pragma("unroll") for (int k = 0; k < 2; ++k) acc[ai][bj][m][n] = __builtin_amdgcn_mfma_f32_16x16x32_bf16(Bt[n][k], At[m][k], acc[ai][bj][m][n], 0, 0, 0); } } \
        __builtin_amdgcn_s_setprio(0); } while (0)
#define PG8_WAIT_V(n) asm volatile("s_waitcnt vmcnt(" #n ")" ::: "memory")
#define PG8_WAIT_L(n) asm volatile("s_waitcnt lgkmcnt(" #n ")" ::: "memory")
#define PG8_BAR __builtin_amdgcn_s_barrier()
#define PG8_SCHED __builtin_amdgcn_sched_barrier(0)
    Unit cur, nxt; int ui = 0;
    if (!S.next(0, cur)) return;
    f32x4 acc[2][2][4][2];
#pragma unroll
    for (int a = 0; a < 2; ++a)
#pragma unroll
        for (int b = 0; b < 2; ++b)
#pragma unroll
            for (int m = 0; m < 4; ++m)
#pragma unroll
                for (int n = 0; n < 2; ++n) acc[a][b][m][n] = (f32x4){0.f, 0.f, 0.f, 0.f};
    bf16x8 At[4][2], B0[2][2], B1[2][2];
    const PG8_GAS char* cA = (const PG8_GAS char*)g.A + (size_t)cur.pm * tstep; const PG8_GAS char* cB = (const PG8_GAS char*)g.Bt + (size_t)cur.pn * tstep;
    S.a_ready(cur);
    if constexpr (SP2) {
        PG8_STAGE(PG8_SB(0, 0), cB, voffB); PG8_STAGE(PG8_SB(0, 1), cB + hstep, voffB); PG8_STAGE(PG8_SA(0, 0), cA, voffA); PG8_STAGE(PG8_SA(0, 1), cA + hstep, voffA);
        if (wr == 1) PG8_BAR;
        PG8_WAIT_V(2); PG8_BAR;
        PG8_STAGE(PG8_SB(1, 0), cB + kstep, voffB); PG8_STAGE(PG8_SA(1, 0), cA + kstep, voffA); PG8_STAGE(PG8_SB(1, 1), cB + hstep + kstep, voffB);
        PG8_WAIT_V(6); PG8_BAR;
    } else {
        PG8_STAGE(PG8_SB(0, 0), cB, voffB); PG8_STAGE(PG8_SA(0, 0), cA, voffA); PG8_STAGE(PG8_SB(0, 1), cB + hstep, voffB); PG8_STAGE(PG8_SA(0, 1), cA + hstep, voffA);
        if (wr == 1) PG8_BAR;
        PG8_WAIT_V(4); PG8_BAR;
        PG8_STAGE(PG8_SB(1, 0), cB + kstep, voffB); PG8_STAGE(PG8_SA(1, 0), cA + kstep, voffA); PG8_STAGE(PG8_SB(1, 1), cB + hstep + kstep, voffB);
        PG8_WAIT_V(6); PG8_BAR;
    }
    for (;;) {
        const bool has_next = S.next(ui + 1, nxt);
        const PG8_GAS char* nA = has_next ? (const PG8_GAS char*)g.A + (size_t)nxt.pm * tstep : cA; const PG8_GAS char* nB = has_next ? (const PG8_GAS char*)g.Bt + (size_t)nxt.pn * tstep : cB;
        for (int t = 0; t < nt; t += 2) {
            const bool last = (t == nt - 2);
            const PG8_GAS char* a1 = cA + (size_t)(t + 1) * kstep;
            const PG8_GAS char* a2 = last ? nA : cA + (size_t)(t + 2) * kstep; const PG8_GAS char* b2 = last ? nB : cB + (size_t)(t + 2) * kstep;
            const PG8_GAS char* a3 = a2 + kstep; const PG8_GAS char* b3 = b2 + kstep;
            if (last && has_next) S.a_ready(nxt);
            if constexpr (SP2) {
            PG8_LDB(B0, 0, 0); PG8_LDB(B1, 0, 1); PG8_SCHED; PG8_LDA(At, 0, 0); PG8_STAGE(PG8_SA(1, 1), a1 + hstep, voffA);
            PG8_WAIT_V(8); PG8_WAIT_L(0); PG8_BAR; PG8_MMA(0, 0, At, B0); PG8_MMA(0, 1, At, B1); PG8_BAR; PG8_SCHED;
            PG8_LDA(At, 0, 1); PG8_STAGE(PG8_SB(0, 0), b2, voffB); PG8_STAGE(PG8_SB(0, 1), b2 + hstep, voffB); PG8_STAGE(PG8_SA(0, 0), a2, voffA);
            PG8_WAIT_V(8); PG8_WAIT_L(0); PG8_BAR; PG8_MMA(1, 0, At, B0); PG8_MMA(1, 1, At, B1); PG8_BAR; PG8_SCHED;
            PG8_LDB(B0, 1, 0); PG8_LDB(B1, 1, 1); PG8_SCHED; PG8_LDA(At, 1, 0); PG8_STAGE(PG8_SA(0, 1), a2 + hstep, voffA);
            PG8_WAIT_V(8); PG8_WAIT_L(0); PG8_BAR; PG8_MMA(0, 0, At, B0); PG8_MMA(0, 1, At, B1); PG8_BAR; PG8_SCHED;
            PG8_LDA(At, 1, 1); PG8_STAGE(PG8_SB(1, 0), b3, voffB); PG8_STAGE(PG8_SB(1, 1), b3 + hstep, voffB); PG8_STAGE(PG8_SA(1, 0), a3, voffA);
            PG8_WAIT_V(8); PG8_WAIT_L(0); PG8_BAR; PG8_MMA(1, 0, At, B0); PG8_MMA(1, 1, At, B1); PG8_BAR; PG8_SCHED;
            } else {
            PG8_LDB(B0, 0, 0); PG8_SCHED; PG8_LDA(At, 0, 0); PG8_STAGE(PG8_SA(1, 1), a1 + hstep, voffA);
            PG8_WAIT_L(8); PG8_BAR; PG8_WAIT_L(0); PG8_MMA(0, 0, At, B0); PG8_BAR; PG8_SCHED;
            PG8_LDB(B1, 0, 1); PG8_STAGE(PG8_SB(0, 0), b2, voffB);
            PG8_BAR; PG8_WAIT_L(0); PG8_MMA(0, 1, At, B1); PG8_BAR;
            PG8_LDA(At, 0, 1); PG8_STAGE(PG8_SA(0, 0), a2, voffA);
            PG8_BAR; PG8_WAIT_L(0); PG8_MMA(1, 0, At, B0); PG8_BAR; PG8_SCHED;
            PG8_STAGE(PG8_SB(0, 1), b2 + hstep, voffB);
            PG8_WAIT_V(6); PG8_BAR; PG8_MMA(1, 1, At, B1); PG8_BAR;
            PG8_LDB(B0, 1, 0); PG8_SCHED; PG8_LDA(At, 1, 0); PG8_STAGE(PG8_SA(0, 1), a2 + hstep, voffA);
            PG8_WAIT_L(8); PG8_BAR; PG8_WAIT_L(0); PG8_MMA(0, 0, At, B0); PG8_BAR; PG8_SCHED;
            PG8_LDB(B1, 1, 1); PG8_STAGE(PG8_SB(1, 0), b3, voffB);
            PG8_BAR; PG8_WAIT_L(0); PG8_MMA(0, 1, At, B1); PG8_BAR;
            PG8_LDA(At, 1, 1); PG8_STAGE(PG8_SA(1, 0), a3, voffA);
            PG8_BAR; PG8_WAIT_L(0); PG8_MMA(1, 0, At, B0); PG8_BAR; PG8_SCHED;
            PG8_STAGE(PG8_SB(1, 1), b3 + hstep, voffB);
            PG8_WAIT_V(6); PG8_BAR; PG8_MMA(1, 1, At, B1); PG8_BAR;
            }
        }
        if constexpr (ALIGN_EPI) { if (wr == 0) PG8_BAR; }
        if constexpr (!Epi::AFTER_DRAIN) { E(acc, cur, wr, wc, fr, fq); S.done(cur); }
        if (!has_next) break;
#pragma unroll
        for (int a = 0; a < 2; ++a)
#pragma unroll
            for (int b = 0; b < 2; ++b)
#pragma unroll
                for (int m = 0; m < 4; ++m)
#pragma unroll
                    for (int n = 0; n < 2; ++n) acc[a][b][m][n] = (f32x4){0.f, 0.f, 0.f, 0.f};
        cur = nxt; cA = nA; cB = nB; ++ui;
        if constexpr (ALIGN_EPI) { if (wr == 1) PG8_BAR; }
    }
    PG8_WAIT_V(0);
    if constexpr (!ALIGN_EPI) { if (wr == 0) PG8_BAR; }
    PG8_BAR;
    if constexpr (Epi::AFTER_DRAIN) { E.fused(acc, cur, wr, wc, fr, fq, lds, wid, lane); S.done(cur); }
#undef PG8_SA
#undef PG8_SB
#undef PG8_STAGE
#undef PG8_LDA
#undef PG8_LDB
#undef PG8_MMA
#undef PG8_WAIT_V
#undef PG8_WAIT_L
#undef PG8_BAR
#undef PG8_SCHED
}
}
constexpr int NWAVES = 8;
constexpr int BATCH = 8, SEQ = 4096, D = 2048, FF = 5632, DEPTH = 2;
constexpr int M = BATCH * SEQ;
constexpr int NGU = 2 * FF;
constexpr int H_A = 8, HD_A = 128, RANK = 256, IH = 8, IDIM = 64, TOPK = 256;
constexpr int H_B = 16, KVH = 2, GQA = 8, HD_B = 64, WINDOW = 128;
constexpr int D_IN = 3144;
constexpr float EPS = 1e-6f;
constexpr size_t MiB = 1u << 20;
constexpr size_t WS_CTL = 0, CTL_ZERO_BYTES = 1 * MiB;
#ifndef F8_MASK
#define F8_MASK 0xF
#endif
constexpr float W8_SCALE = 64.0f;
#ifndef D8_MASK
#define D8_MASK 0xA
#endif
constexpr float A8_SCALE = 8.0f;
__host__ __device__ constexpr bool d8_on(int l, int f) { return ((D8_MASK >> (2 * l + f)) & 1) != 0; }
constexpr float O8_SCALE = 16.0f;
#ifndef OUT_F8
#define OUT_F8 1
#endif
constexpr bool F8_ALL1 = (F8_MASK & 0x5) == 0x5, F8_ALL2 = (F8_MASK & 0xA) == 0xA;
__host__ __device__ constexpr bool f8_on(int l, int f) { return ((F8_MASK >> (2 * l + f)) & 1) != 0; }
constexpr size_t GU1_B = (F8_ALL1 ? 22 : 44) * MiB, GU2_B = (F8_ALL2 ? 22 : 44) * MiB;
constexpr size_t WS_W0 = 2 * MiB;
constexpr size_t WO_GU1 = 0, WO_D1 = GU1_B, WO_GU2 = WO_D1 + 22 * MiB, WO_D2 = WO_GU2 + GU2_B, WO_IN = WO_D2 + 22 * MiB, WO_OUT = WO_IN + 17 * MiB, W_LAYER = WO_OUT + 12 * MiB;
constexpr size_t WS_XN = WS_W0 + 2 * W_LAYER;
constexpr size_t WS_HB8 = WS_XN + 128 * MiB;
constexpr size_t WS_ACT = WS_HB8 + (F8_MASK ? 64 : 0) * MiB;
constexpr size_t WS_Z = WS_ACT, WS_CKVN = WS_ACT + 272 * MiB, WS_KIN = WS_ACT + 288 * MiB, WS_WIF = WS_ACT + 292 * MiB, WS_IDX = WS_ACT + 294 * MiB;
constexpr int ZLD = 4352, ZC_QLAT = 0, ZC_CKV = 2048, ZC_QI = 2304, ZC_QB = 2816, ZC_KB = 3840, ZC_VB = 3968, ZC_KI = 4096, ZC_WI = 4160;
constexpr int OLD = 3072;
constexpr size_t WS_O = WS_ACT + 352 * MiB;
constexpr size_t WS_SS = WS_O + 192 * MiB, SS_BYTES = 4 * MiB;
constexpr size_t WS_END = WS_SS + 2 * SS_BYTES;
static_assert(WS_END <= 1024 * MiB, "d_ws map exceeds 1 GiB");
constexpr int CW_TMO = 0, CW_CODE = 1, CW_BAR = 4096;
constexpr int RING_OFF = 0, RING_BYTES = 131072;
constexpr int LDSCTL_OFF = RING_BYTES, MISC_OFF = LDSCTL_OFF + 320;
constexpr int LDS_BYTES = 147456;
#define GAS __attribute__((address_space(1)))
#define LAS __attribute__((address_space(3)))
typedef unsigned short bf16;
typedef unsigned v4u __attribute__((ext_vector_type(4)));
typedef float f32x4 __attribute__((ext_vector_type(4)));
typedef short bf16x8 __attribute__((ext_vector_type(8)));
typedef GAS unsigned gu32;
typedef GAS unsigned long long gu64;
#define RLX_AGENT __ATOMIC_RELAXED, __HIP_MEMORY_SCOPE_AGENT
#define LDS_WAIT() asm volatile("s_waitcnt lgkmcnt(0)" ::: "memory")
#define VM_WAIT() asm volatile("s_waitcnt vmcnt(0)" ::: "memory")
__device__ __forceinline__ unsigned long long rt() { return __builtin_amdgcn_s_memrealtime(); }
__device__ __forceinline__ unsigned f2bf(float f) { unsigned u = __builtin_bit_cast(unsigned, f); return (u + 0x7fffu + ((u >> 16) & 1u)) >> 16; }
__device__ __forceinline__ unsigned pk2(float lo, float hi) { return f2bf(lo) | (f2bf(hi) << 16); }

#define XB_TMO      128
#define XB_XCNT(j)  (256  + 64 * (j))
#define XB_XSUB(j)  (1280 + 64 * (j))
#define XB_XGEN(j)  (2304 + 64 * (j))
#define XB_TOP      3328
#define XB_TOPGEN   3392
#define XCD_BAR_WORDS 3456
#define XB_SPIN_CAP (1u << 18)

__device__ __forceinline__ unsigned xb_ld(unsigned* p)              { return __hip_atomic_load(p, __ATOMIC_RELAXED, __HIP_MEMORY_SCOPE_AGENT); }
__device__ __forceinline__ unsigned xb_add(unsigned* p, unsigned v) { return __hip_atomic_fetch_add(p, v, __ATOMIC_RELAXED, __HIP_MEMORY_SCOPE_AGENT); }
__device__ __forceinline__ unsigned xb_xcc_id() { return (unsigned)__builtin_amdgcn_s_getreg((3 << 11) | 20) & 0xFu; }
#define XB_SPIN(cond, bar) do { unsigned _sp = 0; while (cond) { __builtin_amdgcn_s_sleep(1); \
    if ((++_sp & 255u) == 0u) { if (xb_ld(&(bar)[XB_TMO])) break; if (_sp > XB_SPIN_CAP) { atomicAdd(&(bar)[XB_TMO], 1u); break; } } } } while (0)

struct XcdBarrier {
    unsigned* bar; unsigned x;
    volatile LAS unsigned* st;
};

__device__ __forceinline__ XcdBarrier xcd_barrier_post(unsigned* bar, volatile LAS unsigned* st, bool leader  ) {
    XcdBarrier b; b.bar = bar; b.x = xb_xcc_id(); b.st = st;
    if (leader) (void)xb_add(&bar[XB_XCNT(b.x)], 1u);
    return b;
}
__device__ __forceinline__ void xcd_barrier_complete(unsigned* bar, unsigned x, unsigned& nloc, unsigned& nx) {
    const unsigned G = gridDim.x * gridDim.y * gridDim.z;
    unsigned sum, cnt, mine, sp = 0u;
    for (;;) {
        sum = 0u; cnt = 0u; mine = 0u;
#pragma unroll
        for (unsigned j = 0; j < 16; ++j) { const unsigned c = xb_ld(&bar[XB_XCNT(j)]); sum += c; cnt += (c > 0u) ? 1u : 0u; mine = (j == x) ? c : mine; }
        if (sum == G) break;
        __builtin_amdgcn_s_sleep(1);
        if ((++sp & 255u) == 0u) { if (xb_ld(&bar[XB_TMO])) break; if (sp > XB_SPIN_CAP) { atomicAdd(&bar[XB_TMO], 1u); break; } }
    }
    nloc = mine > 0u ? mine : 1u; nx = cnt > 0u ? cnt : 1u;
}

__device__ __forceinline__ void xcd_barrier(const XcdBarrier& b, bool leader  ) {
    asm volatile("s_waitcnt vmcnt(0)" ::: "memory");
    __syncthreads();
    if (leader) {
        unsigned* bar = b.bar;
        __builtin_amdgcn_s_waitcnt(0);
        unsigned nloc = b.st[0], nx = b.st[1];
        if (nloc == 0u) { xcd_barrier_complete(bar, b.x, nloc, nx); b.st[0] = nloc; b.st[1] = nx; }
        const unsigned old = xb_add(&bar[XB_XSUB(b.x)], 1u);
        const unsigned gen = old / nloc;
        if (old + 1u == (gen + 1u) * nloc) {
            __builtin_amdgcn_fence(__ATOMIC_RELEASE, "agent");
            asm volatile("s_waitcnt vmcnt(0)" ::: "memory");
            const unsigned og = xb_add(&bar[XB_TOP], 1u);
            const unsigned tg = og / nx;
            if (og + 1u == (tg + 1u) * nx) xb_add(&bar[XB_TOPGEN], 1u);
            else XB_SPIN(xb_ld(&bar[XB_TOPGEN]) == tg, bar);
            __builtin_amdgcn_fence(__ATOMIC_ACQUIRE, "agent");
            xb_add(&bar[XB_XGEN(b.x)], 1u);
            asm volatile("s_waitcnt vmcnt(0)" ::: "memory");
        } else {
            XB_SPIN(xb_ld(&bar[XB_XGEN(b.x)]) == gen, bar);
            __builtin_amdgcn_fence(__ATOMIC_ACQUIRE, "agent");
            asm volatile("s_waitcnt vmcnt(0)" ::: "memory");
        }
    }
    __syncthreads();
}
__constant__ unsigned char T5_BUCKET[128] = {0, 1, 2, 3, 4, 5, 6, 7, 8, 9, 10, 11, 12, 13, 14, 15, 16, 16, 16, 17, 17, 18, 18, 18, 19, 19, 19, 20, 20, 20, 20, 21, 21, 21, 21, 22, 22, 22, 22, 22, 23, 23, 23, 23, 23, 23, 24, 24, 24, 24, 24, 24, 25, 25, 25, 25, 25, 25, 25, 26, 26, 26, 26, 26, 26, 26, 26, 27, 27, 27, 27, 27, 27, 27, 27, 27, 27, 28, 28, 28, 28, 28, 28, 28, 28, 28, 28, 29, 29, 29, 29, 29, 29, 29, 29, 29, 29, 29, 29, 30, 30, 30, 30, 30, 30, 30, 30, 30, 30, 30, 30, 30, 30, 31, 31, 31, 31, 31, 31, 31, 31, 31, 31, 31, 31, 31, 31, 31};
typedef short s16x4 __attribute__((ext_vector_type(4)));
typedef float f32x16 __attribute__((ext_vector_type(16)));
__device__ __forceinline__ float bf2f(unsigned short b) { return __builtin_bit_cast(float, (unsigned)b << 16); }
__device__ __forceinline__ bf16x8 cat4(s16x4 lo, s16x4 hi) { return __builtin_shufflevector(lo, hi, 0, 1, 2, 3, 4, 5, 6, 7); }
__device__ __forceinline__ void tr_read4(unsigned a0, unsigned a1, unsigned a2, unsigned a3, s16x4& r0, s16x4& r1, s16x4& r2, s16x4& r3) {
    asm volatile("ds_read_b64_tr_b16 %0, %4\n\tds_read_b64_tr_b16 %1, %5\n\tds_read_b64_tr_b16 %2, %6\n\tds_read_b64_tr_b16 %3, %7\n\ts_waitcnt lgkmcnt(0)"
                 : "=&v"(r0), "=&v"(r1), "=&v"(r2), "=&v"(r3) : "v"(a0), "v"(a1), "v"(a2), "v"(a3) : "memory");
}
#define SHX(x, o) __builtin_bit_cast(float, __builtin_amdgcn_ds_bpermute(((lane) ^ (o)) << 2, __builtin_bit_cast(int, (float)(x))))
#define SHXU(x, o) ((unsigned)__builtin_amdgcn_ds_bpermute(((lane) ^ (o)) << 2, (int)(x)))
__device__ __forceinline__ float wave_sum(float v, int lane) {
#pragma unroll
    for (int o = 1; o < 64; o <<= 1) v += SHX(v, o);
    return v;
}
template <bool OUT8 = false>
__device__ __forceinline__ void conv_item(const GAS float* W, int ldw, int k0, int c0, int nvalid, GAS bf16* dst, int dld, int drow0, int dk0, float scale, const GAS float* gain, LAS float* scr, int lane) {
    const int c = lane & 31;
    float vin[32];
#pragma unroll
    for (int i = 0; i < 32; ++i) { const int kk = 2 * i + (lane >> 5); vin[i] = 0.f;
        if (c < nvalid) vin[i] = W[(size_t)(k0 + kk) * ldw + c0 + c]; }
#pragma unroll
    for (int i = 0; i < 32; ++i) { const int kk = 2 * i + (lane >> 5); scr[kk * 33 + c] = vin[i] * scale; }
    LDS_WAIT(); asm volatile("" ::: "memory");
    const int c8 = lane & 7;
    f32x4 ga = {1.f, 1.f, 1.f, 1.f}, gb = {1.f, 1.f, 1.f, 1.f};
    if (gain) { ga = *(const GAS f32x4*)(gain + k0 + 8 * c8); gb = *(const GAS f32x4*)(gain + k0 + 8 * c8 + 4); }
#pragma unroll
    for (int j = 0; j < 4; ++j) { const int n = (lane >> 3) + 8 * j; const LAS float* s = scr + (8 * c8) * 33 + n;
        if constexpr (OUT8) { int p = 0, q = 0;
            p = __builtin_amdgcn_cvt_pk_fp8_f32(s[0 * 33] * ga.x, s[1 * 33] * ga.y, p, false); p = __builtin_amdgcn_cvt_pk_fp8_f32(s[2 * 33] * ga.z, s[3 * 33] * ga.w, p, true);
            q = __builtin_amdgcn_cvt_pk_fp8_f32(s[4 * 33] * gb.x, s[5 * 33] * gb.y, q, false); q = __builtin_amdgcn_cvt_pk_fp8_f32(s[6 * 33] * gb.z, s[7 * 33] * gb.w, q, true);
            *(GAS unsigned long long*)((GAS unsigned char*)dst + (size_t)(drow0 + n) * dld + dk0 + k0 + 8 * c8) = (unsigned long long)(unsigned)p | ((unsigned long long)(unsigned)q << 32); }
        else { v4u o; o.x = pk2(s[0 * 33] * ga.x, s[1 * 33] * ga.y); o.y = pk2(s[2 * 33] * ga.z, s[3 * 33] * ga.w); o.z = pk2(s[4 * 33] * gb.x, s[5 * 33] * gb.y); o.w = pk2(s[6 * 33] * gb.z, s[7 * 33] * gb.w);
            *(GAS v4u*)(dst + (size_t)(drow0 + n) * dld + dk0 + k0 + 8 * c8) = o; } }
    LDS_WAIT(); asm volatile("" ::: "memory");
}
__device__ __forceinline__ void rmsnorm_rows_bf16(const GAS float* X, const GAS float* g, GAS bf16* O, int gw, int NGW, int lane) {
    f32x4 gv[8];
#pragma unroll
    for (int j = 0; j < 8; ++j) gv[j] = ((const GAS f32x4*)g)[lane + 64 * j];
    for (int m = gw; m < M; m += NGW) {
        const GAS f32x4* xr = (const GAS f32x4*)(X + (size_t)m * D) + lane;
        f32x4 v[8]; float s = 0.f;
#pragma unroll
        for (int j = 0; j < 8; ++j) { v[j] = xr[64 * j]; s += (v[j].x * v[j].x + v[j].y * v[j].y) + (v[j].z * v[j].z + v[j].w * v[j].w); }
        const float r = 1.0f / sqrtf(wave_sum(s, lane) * (1.0f / D) + EPS);
        GAS unsigned long long* o8 = (GAS unsigned long long*)(O + (size_t)m * D) + lane;
#pragma unroll
        for (int j = 0; j < 8; ++j) { const f32x4 y = v[j] * r * gv[j]; o8[64 * j] = (unsigned long long)pk2(y.x, y.y) | ((unsigned long long)pk2(y.z, y.w) << 32); }
    }
}
__device__ __forceinline__ void rows_bf16_ss(const GAS float* X, GAS bf16* O, GAS unsigned char* O8, GAS float* ss, int gw, int NGW, int lane) {
    for (int m = gw; m < M; m += NGW) {
        const GAS f32x4* xr = (const GAS f32x4*)(X + (size_t)m * D) + lane;
        f32x4 v[8]; float s = 0.f;
#pragma unroll
        for (int j = 0; j < 8; ++j) { v[j] = xr[64 * j]; s += (v[j].x * v[j].x + v[j].y * v[j].y) + (v[j].z * v[j].z + v[j].w * v[j].w); }
        s = wave_sum(s, lane);
        GAS unsigned long long* o8 = (GAS unsigned long long*)(O + (size_t)m * D) + lane;
#pragma unroll
        for (int j = 0; j < 8; ++j) o8[64 * j] = (unsigned long long)pk2(v[j].x, v[j].y) | ((unsigned long long)pk2(v[j].z, v[j].w) << 32);
        if (O8) { GAS unsigned* q8 = (GAS unsigned*)(O8 + (size_t)m * D) + lane;
#pragma unroll
            for (int j = 0; j < 8; ++j) { int p = 0; p = __builtin_amdgcn_cvt_pk_fp8_f32(v[j].x, v[j].y, p, false); p = __builtin_amdgcn_cvt_pk_fp8_f32(v[j].z, v[j].w, p, true); q8[64 * j] = (unsigned)p; } }
        if (lane < 32) ss[(size_t)m * 32 + lane] = lane == 0 ? s : 0.f;
    }
}
__device__ __forceinline__ void final_rows(const GAS bf16* HB, GAS float* OUT, const GAS float* g, const GAS float* ss, int gw, int NGW, int lane) {
    f32x4 gv[8];
#pragma unroll
    for (int j = 0; j < 8; ++j) gv[j] = ((const GAS f32x4*)g)[lane + 64 * j];
    for (int m = gw; m < M; m += NGW) {
        const GAS unsigned long long* hr = (const GAS unsigned long long*)(HB + (size_t)m * D) + lane; GAS f32x4* orow = (GAS f32x4*)(OUT + (size_t)m * D) + lane;
        unsigned long long raw[8];
#pragma unroll
        for (int j = 0; j < 8; ++j) raw[j] = hr[64 * j];
        const float r = 1.0f / sqrtf(wave_sum(lane < 32 ? ss[(size_t)m * 32 + lane] : 0.f, lane) * (1.0f / D) + EPS);
#pragma unroll
        for (int j = 0; j < 8; ++j) { const unsigned lo = (unsigned)raw[j], hi = (unsigned)(raw[j] >> 32);
            f32x4 v = {__builtin_bit_cast(float, lo << 16), __builtin_bit_cast(float, lo & 0xffff0000u), __builtin_bit_cast(float, hi << 16), __builtin_bit_cast(float, hi & 0xffff0000u)};
            orow[64 * j] = v * r * gv[j]; }
    }
}
__device__ __forceinline__ void rmsnorm_rows_f32_inplace(GAS float* X, const GAS float* g, int gw, int NGW, int lane) {
    f32x4 gv[8];
#pragma unroll
    for (int j = 0; j < 8; ++j) gv[j] = ((const GAS f32x4*)g)[lane + 64 * j];
    for (int m = gw; m < M; m += NGW) {
        GAS f32x4* xr = (GAS f32x4*)(X + (size_t)m * D) + lane;
        f32x4 v[8]; float s = 0.f;
#pragma unroll
        for (int j = 0; j < 8; ++j) { v[j] = xr[64 * j]; s += (v[j].x * v[j].x + v[j].y * v[j].y) + (v[j].z * v[j].z + v[j].w * v[j].w); }
        const float r = 1.0f / sqrtf(wave_sum(s, lane) * (1.0f / D) + EPS);
#pragma unroll
        for (int j = 0; j < 8; ++j) xr[64 * j] = v[j] * r * gv[j];
    }
}

template <bool P_IFAST, bool OUT8 = false>
__device__ __forceinline__ void absorb_unit(const GAS float* Psrc, size_t p_ri, size_t p_rd, const GAS float* Qsrc, size_t q_rj, GAS bf16* out, size_t out_ld, float scale, const GAS float* qgain, LAS float* Ps_, LAS float* Qs_, int tid) {
    LAS bf16* Ps = (LAS bf16*)Ps_; LAS bf16* Qs = Ps + 64 * 136;
    float pv[16], qv[16];
#pragma unroll
    for (int j = 0; j < 16; ++j) { const int e = tid + 512 * j; const int i = P_IFAST ? (e & 63) : (e >> 7), d = P_IFAST ? (e >> 6) : (e & 127);
        pv[j] = Psrc[(size_t)i * p_ri + (size_t)d * p_rd];
        const int jj = e >> 7, dd = e & 127; qv[j] = Qsrc[(size_t)jj * q_rj + dd] * (qgain ? qgain[jj] : 1.0f); }
#pragma unroll
    for (int j = 0; j < 16; ++j) { const int e = tid + 512 * j; const int i = P_IFAST ? (e & 63) : (e >> 7), d = P_IFAST ? (e >> 6) : (e & 127);
        Ps[i * 136 + d] = (bf16)f2bf(pv[j]); const int jj = e >> 7, dd = e & 127; Qs[jj * 136 + dd] = (bf16)f2bf(qv[j]); }
    __syncthreads();
    const int wv = tid >> 6, ln = tid & 63, it = wv >> 1, r16 = ln & 15, g = ln >> 4;
#pragma unroll
    for (int jq = 0; jq < 2; ++jq) { const int jt = 2 * (wv & 1) + jq; f32x4 acc = {0.f, 0.f, 0.f, 0.f};
#pragma unroll
        for (int st = 0; st < 4; ++st) { const bf16x8 a = *(const LAS bf16x8*)(Ps + (16 * it + r16) * 136 + 32 * st + 8 * g); const bf16x8 b = *(const LAS bf16x8*)(Qs + (16 * jt + r16) * 136 + 32 * st + 8 * g);
            acc = __builtin_amdgcn_mfma_f32_16x16x32_bf16(a, b, acc, 0, 0, 0); }
#pragma unroll
        for (int rg = 0; rg < 4; ++rg) { const size_t o = (size_t)(16 * it + 4 * g + rg) * out_ld + 16 * jt + r16;
            if constexpr (OUT8) ((GAS unsigned char*)out)[o] = (unsigned char)__builtin_amdgcn_cvt_pk_fp8_f32(acc[rg] * scale, 0.f, 0, false);
            else out[o] = (bf16)f2bf(acc[rg] * scale); } }
    __syncthreads();
}
__device__ __forceinline__ void post_rows(const GAS bf16* Z, const GAS float* gkv, const GAS float* gki, const GAS float* bki, GAS bf16* CKVN, GAS bf16* KIN, GAS float* WIF, int gw, int NGW, int lane) {
    const f32x4 g4 = ((const GAS f32x4*)gkv)[lane]; const float gk = gki[lane], bk = bki[lane];
    for (int m = gw; m < M; m += NGW) {
        const GAS bf16* zr = Z + (size_t)m * ZLD;
        const unsigned long long raw = *(const GAS unsigned long long*)(zr + ZC_CKV + 4 * lane);
        const float kraw = bf2f(zr[ZC_KI + lane]);
        const float wraw = bf2f(zr[ZC_WI + (lane & 7)]);
        const float c0 = bf2f((unsigned short)raw), c1 = bf2f((unsigned short)(raw >> 16)), c2 = bf2f((unsigned short)(raw >> 32)), c3 = bf2f((unsigned short)(raw >> 48));
        const float r = 1.0f / sqrtf(wave_sum((c0 * c0 + c1 * c1) + (c2 * c2 + c3 * c3), lane) * (1.0f / RANK) + EPS);
        *(GAS unsigned long long*)(CKVN + (size_t)m * RANK + 4 * lane) = (unsigned long long)pk2(c0 * r * g4.x, c1 * r * g4.y) | ((unsigned long long)pk2(c2 * r * g4.z, c3 * r * g4.w) << 32);
        const float mu = wave_sum(kraw, lane) * (1.0f / IDIM); const float dv = kraw - mu;
        const float var = wave_sum(dv * dv, lane) * (1.0f / IDIM);
        KIN[(size_t)m * IDIM + lane] = (bf16)f2bf(dv * (1.0f / sqrtf(var + EPS)) * gk + bk);
        if (lane < 8) WIF[(size_t)m * IH + lane] = wraw;
    }
}
constexpr int SWA_KP = 144, SWA_VP = 192;
constexpr int SWA_K_OFF = 0, SWA_V_OFF = 160 * SWA_KP, SWA_TAB_OFF = SWA_V_OFF + 160 * SWA_VP;
static_assert(SWA_TAB_OFF + 16 * 128 * 4 <= RING_BYTES, "SWA LDS map");
__device__ __forceinline__ void swa_phase(LAS unsigned char* lds, const GAS bf16* Z, GAS bf16* O, const GAS float* rel_bias, const GAS float* sinks, int vcu, int G, int tid, int lane, int wave) {
    LAS float* tab = (LAS float*)(lds + SWA_TAB_OFF);
    for (int e = tid; e < 16 * 128; e += NWAVES * 64) { const int h = e >> 7, dist = e & 127; tab[e] = rel_bias[(int)T5_BUCKET[dist] * 24 + H_A + h]; }
    __syncthreads();
    const int q = lane & 31, hh = lane >> 5;
    const unsigned ldsb = (unsigned)(size_t)lds;
    for (int item = vcu; item < BATCH * 128 * KVH; item += G) {
        const int kvh = item & 1, qt = (item >> 1) & 127, b = item >> 8;
        const int t0 = 32 * qt, s0 = t0 - 128;
        const size_t rowbase = (size_t)b * SEQ;
        for (int c = tid; c < 1280; c += NWAVES * 64) { const int row = c >> 3, ch = c & 7; const int s = s0 + row;
            if (s >= 0) { const GAS bf16* zr = Z + (rowbase + s) * ZLD + kvh * 64 + ch * 8;
                const v4u kv = *(const GAS v4u*)(zr + ZC_KB); const v4u vv = *(const GAS v4u*)(zr + ZC_VB);
                *(LAS v4u*)(lds + SWA_K_OFF + row * SWA_KP + ch * 16) = kv; *(LAS v4u*)(lds + SWA_V_OFF + row * SWA_VP + ch * 16) = vv; } }
        const int hq = kvh * 8 + wave; const int t = t0 + q;
        bf16x8 qf[4];
#pragma unroll
        for (int st = 0; st < 4; ++st) qf[st] = *(const GAS bf16x8*)(Z + (rowbase + t) * ZLD + ZC_QB + hq * 64 + 16 * st + 8 * hh);
        __syncthreads();
        const int kt0 = qt >= 4 ? 0 : 4 - qt;
        f32x16 sacc[5];
#pragma unroll
        for (int kt = 0; kt < 5; ++kt) {
#pragma unroll
            for (int r = 0; r < 16; ++r) sacc[kt][r] = 0.f;
            if (kt >= kt0) {
#pragma unroll
                for (int st = 0; st < 4; ++st) { const bf16x8 kf = *(const LAS bf16x8*)(lds + SWA_K_OFF + (kt * 32 + q) * SWA_KP + (2 * st + hh) * 16);
                    sacc[kt] = __builtin_amdgcn_mfma_f32_32x32x16_bf16(kf, qf[st], sacc[kt], 0, 0, 0); } } }
        const float sink = sinks[hq]; float mx = sink;
        const LAS float* tabh = tab + hq * 128;
#pragma unroll
        for (int kt = 0; kt < 5; ++kt) if (kt >= kt0) {
#pragma unroll
            for (int r = 0; r < 16; ++r) { const int ko = (r & 3) + 8 * (r >> 2) + 4 * hh; const int dist = q + 128 - 32 * kt - ko;
                const float lg = (dist >= 0 && dist < WINDOW) ? sacc[kt][r] + tabh[dist & 127] : -1e30f; sacc[kt][r] = lg; mx = fmaxf(mx, lg); } }
        mx = fmaxf(mx, SHX(mx, 32));
        float l = 0.f;
#pragma unroll
        for (int kt = 0; kt < 5; ++kt) if (kt >= kt0) {
#pragma unroll
            for (int r = 0; r < 16; ++r) { const float p = __expf(sacc[kt][r] - mx); sacc[kt][r] = p; l += p; } }
        l += SHX(l, 32); l += __expf(sink - mx);
        f32x16 oacc[2];
#pragma unroll
        for (int dt = 0; dt < 2; ++dt)
#pragma unroll
            for (int r = 0; r < 16; ++r) oacc[dt][r] = 0.f;
        const unsigned vlane = ldsb + SWA_V_OFF + (unsigned)((4 * hh + ((lane & 15) >> 2)) * SWA_VP + (16 * ((lane >> 4) & 1) + 4 * (lane & 3)) * 2);
#pragma unroll
        for (int kt = 0; kt < 5; ++kt) if (kt >= kt0) {
#pragma unroll
            for (int s2 = 0; s2 < 2; ++s2) {
                bf16x8 pf; { const unsigned w0 = pg8::cvt_pk_bf16(sacc[kt][8 * s2 + 0], sacc[kt][8 * s2 + 1]), w1 = pg8::cvt_pk_bf16(sacc[kt][8 * s2 + 2], sacc[kt][8 * s2 + 3]),
                                     w2 = pg8::cvt_pk_bf16(sacc[kt][8 * s2 + 4], sacc[kt][8 * s2 + 5]), w3 = pg8::cvt_pk_bf16(sacc[kt][8 * s2 + 6], sacc[kt][8 * s2 + 7]);
                    const v4u w = {w0, w1, w2, w3}; pf = __builtin_bit_cast(bf16x8, w); }
                const unsigned a = vlane + (unsigned)((kt * 32 + 16 * s2) * SWA_VP);
                s16x4 r0, r1, r2, r3; tr_read4(a, a + 8 * SWA_VP, a + 64, a + 8 * SWA_VP + 64, r0, r1, r2, r3);
                oacc[0] = __builtin_amdgcn_mfma_f32_32x32x16_bf16(cat4(r0, r1), pf, oacc[0], 0, 0, 0);
                oacc[1] = __builtin_amdgcn_mfma_f32_32x32x16_bf16(cat4(r2, r3), pf, oacc[1], 0, 0, 0); } }
        const float inv = (OUT_F8 ? O8_SCALE : 1.0f) / l;
        if constexpr (OUT_F8) { GAS unsigned char* orow = (GAS unsigned char*)O + (rowbase + t) * OLD + 2048 + hq * 64 + 4 * hh;
#pragma unroll
            for (int dt = 0; dt < 2; ++dt)
#pragma unroll
                for (int g4 = 0; g4 < 4; ++g4) { int p = 0; p = __builtin_amdgcn_cvt_pk_fp8_f32(oacc[dt][4 * g4] * inv, oacc[dt][4 * g4 + 1] * inv, p, false); p = __builtin_amdgcn_cvt_pk_fp8_f32(oacc[dt][4 * g4 + 2] * inv, oacc[dt][4 * g4 + 3] * inv, p, true);
                    *(GAS unsigned*)(orow + 32 * dt + 8 * g4) = (unsigned)p; } }
        else { GAS bf16* orow = O + (rowbase + t) * OLD + 2048 + hq * 64 + 4 * hh;
#pragma unroll
        for (int dt = 0; dt < 2; ++dt)
#pragma unroll
            for (int g4 = 0; g4 < 4; ++g4) { const unsigned long long w = (unsigned long long)pk2(oacc[dt][4 * g4] * inv, oacc[dt][4 * g4 + 1] * inv) | ((unsigned long long)pk2(oacc[dt][4 * g4 + 2] * inv, oacc[dt][4 * g4 + 3] * inv) << 32);
                *(GAS unsigned long long*)(orow + 32 * dt + 8 * g4) = w; } }
        __syncthreads();
    }
}
constexpr int TK_BINS = 512, TK_CAP = 128;
#define LDS_ADD(p) __hip_atomic_fetch_add((p), 1u, __ATOMIC_RELAXED, __HIP_MEMORY_SCOPE_WORKGROUP)
#define LDS_ADDV(p, v) __hip_atomic_fetch_add((p), (v), __ATOMIC_RELAXED, __HIP_MEMORY_SCOPE_WORKGROUP)
#define HIST_WORD(tok, bin) (((tok) * TK_BINS + (bin)) >> 1)
#define HIST_INC(bin) (1u << (((bin) & 1) * 16))
constexpr int TK_HIST_OFF = 0, TK_CSC_OFF = 32768, TK_CIX_OFF = TK_CSC_OFF + 32 * TK_CAP * 4, TK_SEL_OFF = TK_CIX_OFF + 32 * TK_CAP * 2, TK_CNT_OFF = TK_SEL_OFF + 32 * 256 * 2, TK_DUM_OFF = TK_CNT_OFF + 32 * 2 * 4, TK_KB_OFF = TK_DUM_OFF + 8 * 64 * 4, TK_KB_BYTES = 128 * 144, TK_FLAG_OFF = TK_KB_OFF + 2 * TK_KB_BYTES;
static_assert(TK_FLAG_OFF + 16 <= RING_BYTES, "top-k LDS map");
__device__ __forceinline__ float tk_relu(float x) { const int b = __builtin_bit_cast(int, x); return __builtin_bit_cast(float, b < 0 ? 0 : b); }
__device__ __forceinline__ float tk_score(const f32x16& acc, int a, const float (&w)[8]) {
    float s = w[0] * tk_relu(acc[8 * a + 0]);
#pragma unroll
    for (int h = 1; h < 8; ++h) s = fmaf(w[h], tk_relu(acc[8 * a + h]), s);
    return s;
}
__device__ __forceinline__ float tk_x(float s, float sc) { return fmaf(s, sc, 256.0f); }
__device__ __forceinline__ int tk_key(float s, float sc) {
    const float x = tk_x(s, sc); int b0 = (int)x; b0 = b0 < 0 ? 0 : (b0 > TK_BINS - 1 ? TK_BINS - 1 : b0);
    int sub = (int)((x - (float)b0) * 512.0f); sub = sub < 0 ? 0 : (sub > 511 ? 511 : sub);
    return b0 * 512 + sub;
}
__device__ __forceinline__ void tk_find(const LAS unsigned* h, unsigned need, int lane, int& bin_out, unsigned& above_out) {
    unsigned v[8]; unsigned s = 0;
#pragma unroll
    for (int i = 0; i < 4; ++i) { const unsigned w = h[4 * lane + i]; v[2 * i] = w & 0xffffu; v[2 * i + 1] = w >> 16; s += v[2 * i] + v[2 * i + 1]; }
    unsigned S = s;
#pragma unroll
    for (int o = 1; o < 64; o <<= 1) { const unsigned t = (unsigned)__builtin_amdgcn_ds_bpermute((lane + o) << 2, (int)S); if (lane + o < 64) S += t; }
    const unsigned long long mask = __ballot(S >= need);
    const int Lm = mask ? 63 - __builtin_clzll(mask) : 0;
    unsigned cum = S - s; int bsel = 8 * lane; unsigned ab = cum; bool found = false;
#pragma unroll
    for (int i = 7; i >= 0; --i) { if (!found) { if (cum + v[i] >= need) { bsel = 8 * lane + i; ab = cum; found = true; } else cum += v[i]; } }
    bin_out = __builtin_amdgcn_readlane(bsel, Lm); above_out = (unsigned)__builtin_amdgcn_readlane((int)ab, Lm);
}
__device__ __forceinline__ void topk_phase(LAS unsigned char* lds, const GAS bf16* Z, const GAS bf16* KIN, const GAS float* WIF, GAS unsigned short* IDX, int vcu, int G, int lane, int wave) {
    LAS unsigned* hist = (LAS unsigned*)(lds + TK_HIST_OFF) + wave * 4 * (TK_BINS / 2);
    LAS float* csc = (LAS float*)(lds + TK_CSC_OFF) + wave * 4 * TK_CAP;
    LAS unsigned short* cix = (LAS unsigned short*)(lds + TK_CIX_OFF) + wave * 4 * TK_CAP;
    LAS unsigned short* sel = (LAS unsigned short*)(lds + TK_SEL_OFF) + wave * 4 * 256;
    LAS unsigned* cnt = (LAS unsigned*)(lds + TK_CNT_OFF) + wave * 8;
    LAS unsigned* dum = (LAS unsigned*)(lds + TK_DUM_OFF) + wave * 64 + lane;
    const int n = lane & 31, c = lane >> 5;
    const int am = (lane >> 4) & 1, bbm = (lane >> 3) & 1, ccm = (lane >> 2) & 1, dm = lane & 3;
    for (int p2 = vcu; p2 < BATCH * 64; p2 += G) {
#pragma unroll 1
        for (int half = 0; half < 2; ++half) {
            const int b = p2 >> 6, jj = p2 & 63, j = half ? 127 - jj : jj;
            const int t0 = 32 * j + 4 * wave; const size_t rb = (size_t)b * SEQ;
            bf16x8 qa[4];
#pragma unroll
            for (int st = 0; st < 4; ++st) qa[st] = *(const GAS bf16x8*)(Z + (rb + t0 + 2 * ccm + am) * ZLD + ZC_QI + (4 * bbm + dm) * 64 + 16 * st + 8 * c);
            float w0[8], w1[8];
            { const GAS f32x4* wp = (const GAS f32x4*)(WIF + (rb + t0 + 2 * c) * IH); const f32x4 x0 = wp[0], x1 = wp[1], x2 = wp[2], x3 = wp[3];
              w0[0] = x0.x; w0[1] = x0.y; w0[2] = x0.z; w0[3] = x0.w; w0[4] = x1.x; w0[5] = x1.y; w0[6] = x1.z; w0[7] = x1.w;
              w1[0] = x2.x; w1[1] = x2.y; w1[2] = x2.z; w1[3] = x2.w; w1[4] = x3.x; w1[5] = x3.y; w1[6] = x3.z; w1[7] = x3.w; }
            float scA, scB;
            { float a = 0.f, bq = 0.f;
#pragma unroll
              for (int h = 0; h < 8; ++h) { a = fmaf(w0[h], w0[h], a); bq = fmaf(w1[h], w1[h], bq); }
              scA = 32.0f / fmaxf(sqrtf(32.0f * a), 1e-20f); scB = 32.0f / fmaxf(sqrtf(32.0f * bq), 1e-20f); }
            const int tA = t0 + 2 * c, tB = tA + 1;
            for (int i = lane; i < 4 * (TK_BINS / 2); i += 64) hist[i] = 0u;
            for (int i = lane; i < 4 * 128; i += 64) ((LAS unsigned*)sel)[i] = 0u;
            if (lane < 8) cnt[lane] = 0u;
            asm volatile("s_waitcnt lgkmcnt(0)" ::: "memory");
            int lo[4], hi[4]; unsigned ab0[4]; bool ov[4];
#pragma unroll
            for (int tk = 0; tk < 4; ++tk) { lo[tk] = 0x7fffffff; hi[tk] = -1; ab0[tk] = 0u; ov[tk] = false; }
            const bool need_sel = (t0 + 3) >= TOPK;
            const GAS bf16* kbase = KIN + (rb + n) * IDIM + 8 * c;
            const int tidk = wave * 64 + lane; const int ng = (j + 4) >> 2;
            const GAS bf16* kg0 = KIN + (rb + (tidk >> 3)) * IDIM + (tidk & 7) * 8; const int koff = (tidk >> 3) * 144 + (tidk & 7) * 16;
            LAS unsigned char* kbuf = lds + TK_KB_OFF; volatile LAS unsigned* sflag = (volatile LAS unsigned*)(lds + TK_FLAG_OFF);
            if (tidk == 0) *sflag = 0u;
#define TK_PRIME() { const v4u kr0 = *(const GAS v4u*)kg0, kr1 = *(const GAS v4u*)(kg0 + 64 * IDIM); *(LAS v4u*)(kbuf + koff) = kr0; *(LAS v4u*)(kbuf + koff + 64 * 144) = kr1; } __syncthreads();
#define TK_GROUP_BEGIN() \
                v4u kr = {0u, 0u, 0u, 0u}, kr2 = {0u, 0u, 0u, 0u}; const bool more = g + 1 < ng; \
                if (more) { const int r1 = 128 * (g + 1) + 64 + (tidk >> 3) < SEQ ? 64 : 0;     \
                    kr = *(const GAS v4u*)(kg0 + (size_t)(g + 1) * 128 * IDIM); kr2 = *(const GAS v4u*)(kg0 + ((size_t)(g + 1) * 128 + r1) * IDIM); } \
                const LAS unsigned char* kb_ = kbuf + (g & 1) * TK_KB_BYTES; \
                _Pragma("unroll") for (int u4 = 0; u4 < 4; ++u4) { \
                    f32x16 acc; _Pragma("unroll") for (int r = 0; r < 16; ++r) acc[r] = 0.f; \
                    _Pragma("unroll") for (int st = 0; st < 4; ++st) { const bf16x8 kf = *(const LAS bf16x8*)(kb_ + (32 * u4 + n) * 144 + (2 * st + c) * 16); acc = __builtin_amdgcn_mfma_f32_32x32x16_bf16(qa[st], kf, acc, 0, 0, 0); } \
                    const float s0 = tk_score(acc, 0, w0), s1 = tk_score(acc, 1, w1); const int s = 32 * (4 * g + u4) + n;
#define TK_GROUP_END() } \
                if (more) { *(LAS v4u*)(kbuf + ((g + 1) & 1) * TK_KB_BYTES + koff) = kr; *(LAS v4u*)(kbuf + ((g + 1) & 1) * TK_KB_BYTES + koff + 64 * 144) = kr2; } \
                __syncthreads();
            bool slow = false;
            if (need_sel) {
                {   TK_PRIME();
#pragma unroll 1
                    for (int g = 0; g < ng; ++g) { TK_GROUP_BEGIN()
                        int b0 = (int)tk_x(s0, scA), b1 = (int)tk_x(s1, scB); b0 = b0 < 0 ? 0 : (b0 > TK_BINS - 1 ? TK_BINS - 1 : b0); b1 = b1 < 0 ? 0 : (b1 > TK_BINS - 1 ? TK_BINS - 1 : b1);
                        LAS unsigned* p0 = (s <= tA) ? &hist[HIST_WORD(2 * c, b0)] : dum; LAS unsigned* p1 = (s <= tB) ? &hist[HIST_WORD(2 * c + 1, b1)] : dum;
                        LDS_ADDV(p0, HIST_INC(b0)); LDS_ADDV(p1, HIST_INC(b1));
                        TK_GROUP_END() }
                }
                asm volatile("s_waitcnt lgkmcnt(0)" ::: "memory");
#pragma unroll
                for (int tk = 0; tk < 4; ++tk) { int bin; unsigned above; tk_find(hist + tk * (TK_BINS / 2), (unsigned)TOPK, lane, bin, above);
                    const unsigned ceq = (hist[HIST_WORD(tk, bin)] >> ((bin & 1) * 16)) & 0xffffu; ov[tk] = ceq > (unsigned)TK_CAP; slow |= ov[tk]; ab0[tk] = above; lo[tk] = bin * 512; hi[tk] = bin * 512 + 511; }
                if (slow && lane == 0) *sflag = 1u;
                __syncthreads();
                slow = *sflag != 0u;
            }
            if (!slow) {
                float thi[4], tlo[4];
#pragma unroll
                for (int tk = 0; tk < 4; ++tk) { const int bin = lo[tk] >> 9;
                    thi[tk] = !need_sel ? -__builtin_inff() : (bin >= TK_BINS - 1 ? __builtin_inff() : (float)(bin + 1));
                    tlo[tk] = !need_sel ? __builtin_inff() : (bin == 0 ? -__builtin_inff() : (float)bin); }
                const float thiA = c ? thi[2] : thi[0], tloA = c ? tlo[2] : tlo[0], thiB = c ? thi[3] : thi[1], tloB = c ? tlo[3] : tlo[1];
                unsigned cntA = 0u, cntB = 0u;
                LAS unsigned short* selA = sel + (2 * c) * 256; LAS unsigned short* selB = sel + (2 * c + 1) * 256; LAS unsigned short* dum16 = (LAS unsigned short*)dum;
                TK_PRIME();
#pragma unroll 1
                for (int g = 0; g < ng; ++g) { TK_GROUP_BEGIN()
                    const float x0 = (s <= tA) ? tk_x(s0, scA) : __builtin_nanf(""), x1 = (s <= tB) ? tk_x(s1, scB) : __builtin_nanf("");
                    const bool a0 = x0 >= thiA, a1 = x1 >= thiB; const bool c0 = !a0 && x0 >= tloA, c1 = !a1 && x1 >= tloB;
                    const unsigned long long m0 = __ballot(a0), m1 = __ballot(a1);
                    const unsigned pre0 = c ? __builtin_amdgcn_mbcnt_hi((unsigned)(m0 >> 32), 0u) : __builtin_amdgcn_mbcnt_lo((unsigned)m0, 0u);
                    const unsigned pre1 = c ? __builtin_amdgcn_mbcnt_hi((unsigned)(m1 >> 32), 0u) : __builtin_amdgcn_mbcnt_lo((unsigned)m1, 0u);
                    const unsigned pos0 = cntA + pre0, pos1 = cntB + pre1;
                    LAS unsigned short* q0 = (a0 && pos0 < 256u) ? selA + pos0 : dum16; LAS unsigned short* q1 = (a1 && pos1 < 256u) ? selB + pos1 : dum16;
                    *q0 = (unsigned short)s; *q1 = (unsigned short)s;
                    cntA += c ? (unsigned)__builtin_popcount((unsigned)(m0 >> 32)) : (unsigned)__builtin_popcount((unsigned)m0);
                    cntB += c ? (unsigned)__builtin_popcount((unsigned)(m1 >> 32)) : (unsigned)__builtin_popcount((unsigned)m1);
                    if (__ballot(c0 || c1)) {
                        if (c0) { const unsigned pos = LDS_ADD(&cnt[(2 * c) * 2 + 1]); if (pos < (unsigned)TK_CAP) { csc[(2 * c) * TK_CAP + pos] = s0; cix[(2 * c) * TK_CAP + pos] = (unsigned short)s; } }
                        if (c1) { const unsigned pos = LDS_ADD(&cnt[(2 * c + 1) * 2 + 1]); if (pos < (unsigned)TK_CAP) { csc[(2 * c + 1) * TK_CAP + pos] = s1; cix[(2 * c + 1) * TK_CAP + pos] = (unsigned short)s; } } }
                    TK_GROUP_END() }
                if ((lane & 31) == 0) { cnt[(2 * c) * 2] = cntA; cnt[(2 * c + 1) * 2] = cntB; }
                asm volatile("s_waitcnt lgkmcnt(0)" ::: "memory");
            } else {
                for (int i = lane; i < 4 * (TK_BINS / 2); i += 64) hist[i] = 0u;
                asm volatile("s_waitcnt lgkmcnt(0)" ::: "memory");
                int mode = 1;
#pragma unroll 1
                for (;;) {
                const int klo0 = c ? lo[2] : lo[0], khi0 = c ? hi[2] : hi[0], klo1 = c ? lo[3] : lo[1], khi1 = c ? hi[3] : hi[1];
                const bool ov0 = c ? ov[2] : ov[0], ov1 = c ? ov[3] : ov[1];
                bf16x8 kb[4][4];
#pragma unroll
                for (int u4 = 0; u4 < 4; ++u4) { const int kq = u4 < j ? u4 : j;
#pragma unroll
                    for (int st = 0; st < 4; ++st) kb[u4][st] = *(const GAS bf16x8*)(kbase + (size_t)kq * 32 * IDIM + 16 * st); }
#pragma unroll 1
                for (int kt = 0; kt <= j; kt += 4) {
                    bf16x8 kn[4][4];
#pragma unroll
                    for (int u4 = 0; u4 < 4; ++u4) { const int kq = kt + 4 + u4 < j ? kt + 4 + u4 : j;
#pragma unroll
                        for (int st = 0; st < 4; ++st) kn[u4][st] = *(const GAS bf16x8*)(kbase + (size_t)kq * 32 * IDIM + 16 * st); }
#pragma unroll
                    for (int u4 = 0; u4 < 4; ++u4) {
                        f32x16 acc;
#pragma unroll
                        for (int r = 0; r < 16; ++r) acc[r] = 0.f;
#pragma unroll
                        for (int st = 0; st < 4; ++st) acc = __builtin_amdgcn_mfma_f32_32x32x16_bf16(qa[st], kb[u4][st], acc, 0, 0, 0);
                        const float s0 = tk_score(acc, 0, w0), s1 = tk_score(acc, 1, w1);
                        const int s = 32 * (kt + u4) + n; const int k0 = tk_key(s0, scA), k1 = tk_key(s1, scB);
                        const bool v0 = s <= tA, v1 = s <= tB;
                        if (mode == 0) {
                            if (v0 && tA >= TOPK) LDS_ADDV(&hist[HIST_WORD(2 * c, k0 >> 9)], HIST_INC(k0 >> 9));
                            if (v1 && tB >= TOPK) LDS_ADDV(&hist[HIST_WORD(2 * c + 1, k1 >> 9)], HIST_INC(k1 >> 9));
                        } else if (mode == 1) {
                            if (v0 && ov0 && k0 >= klo0 && k0 <= khi0) LDS_ADDV(&hist[HIST_WORD(2 * c, k0 & 511)], HIST_INC(k0 & 511));
                            if (v1 && ov1 && k1 >= klo1 && k1 <= khi1) LDS_ADDV(&hist[HIST_WORD(2 * c + 1, k1 & 511)], HIST_INC(k1 & 511));
                        } else {
                            if (v0) { if (k0 > khi0) { const unsigned pos = LDS_ADD(&cnt[(2 * c) * 2]); if (pos < 256u) sel[(2 * c) * 256 + pos] = (unsigned short)s; }
                                      else if (k0 >= klo0) { const unsigned pos = LDS_ADD(&cnt[(2 * c) * 2 + 1]); if (pos < (unsigned)TK_CAP) { csc[(2 * c) * TK_CAP + pos] = s0; cix[(2 * c) * TK_CAP + pos] = (unsigned short)s; } } }
                            if (v1) { if (k1 > khi1) { const unsigned pos = LDS_ADD(&cnt[(2 * c + 1) * 2]); if (pos < 256u) sel[(2 * c + 1) * 256 + pos] = (unsigned short)s; }
                                      else if (k1 >= klo1) { const unsigned pos = LDS_ADD(&cnt[(2 * c + 1) * 2 + 1]); if (pos < (unsigned)TK_CAP) { csc[(2 * c + 1) * TK_CAP + pos] = s1; cix[(2 * c + 1) * TK_CAP + pos] = (unsigned short)s; } } }
                        }
                    }
#pragma unroll
                    for (int u4 = 0; u4 < 4; ++u4)
#pragma unroll
                        for (int st = 0; st < 4; ++st) kb[u4][st] = kn[u4][st];
                }
                    asm volatile("s_waitcnt lgkmcnt(0)" ::: "memory");
                    if (mode == 2) break;
#pragma unroll
                    for (int tk = 0; tk < 4; ++tk) if (ov[tk]) { int sub; unsigned above; tk_find(hist + tk * (TK_BINS / 2), (unsigned)TOPK - ab0[tk], lane, sub, above); lo[tk] += sub; hi[tk] = lo[tk]; }
                    mode = 2;
                }
            }
#undef TK_GROUP_BEGIN
#undef TK_GROUP_END
#undef TK_PRIME
#pragma unroll 1
            for (int tk = 0; tk < 4; ++tk) { const int t = t0 + tk;
                if (t >= TOPK) { const unsigned nsel = cnt[tk * 2]; unsigned nc = cnt[tk * 2 + 1]; nc = nc > (unsigned)TK_CAP ? (unsigned)TK_CAP : nc; const unsigned need = nsel < 256u ? 256u - nsel : 0u;
                    for (unsigned q = 0; q < 2; ++q) { const unsigned i = lane + 64 * q;
                        const float si = i < nc ? csc[tk * TK_CAP + i] : 0.f; const unsigned xi = i < nc ? cix[tk * TK_CAP + i] : 0u; unsigned rank = 0;
                        for (unsigned jx = 0; jx < nc; ++jx) { const float sj = csc[tk * TK_CAP + jx]; const unsigned xj = cix[tk * TK_CAP + jx]; rank += (sj > si || (sj == si && xj < xi)) ? 1u : 0u; }
                        if (i < nc && rank < need) sel[tk * 256 + nsel + rank] = (unsigned short)xi; } } }
            asm volatile("s_waitcnt lgkmcnt(0)" ::: "memory");
            { const LAS v4u* sv = (const LAS v4u*)sel; GAS v4u* ov = (GAS v4u*)(IDX + (rb + t0) * TOPK);
              ov[lane] = sv[lane]; ov[lane + 64] = sv[lane + 64]; }
            asm volatile("s_waitcnt vmcnt(0) lgkmcnt(0)" ::: "memory");
        }
    }
}
constexpr int DSA_TAB_OFF = RING_BYTES + 1024;
static_assert(DSA_TAB_OFF + 8 * 129 * 4 <= LDS_BYTES, "DSA LDS map");
__device__ __forceinline__ void dsa_phase(LAS unsigned char* lds_all, const GAS bf16* Z, const GAS bf16* CKVN, const GAS unsigned short* IDX, GAS bf16* O, const GAS float* rel_bias, int gw, int NGW, int tid, int lane, int wave) {
    LAS float* tab = (LAS float*)(lds_all + DSA_TAB_OFF);
    for (int e = tid; e < 8 * 129; e += NWAVES * 64) { const int hh = e / 129, dist = e - hh * 129; tab[e] = rel_bias[(dist < 128 ? (int)T5_BUCKET[dist] : 31) * 24 + hh]; }
    __syncthreads();
    LAS unsigned char* img = lds_all + RING_OFF + wave * 16384;
    const unsigned imgb = (unsigned)(size_t)img;
    const int h = lane & 15, g = lane >> 4;
    const LAS float* tabh = tab + (h & 7) * 129;
    const int TPW = (M + NGW - 1) / NGW;
    const int tok_end = (gw + 1) * TPW < M ? (gw + 1) * TPW : M;
    const int xq = 2 * (lane & 7);
    const int qk_off = (lane & 15) * 512;
    const int q4 = (lane & 15) >> 2, p4 = lane & 3; const int xr = 2 * (4 * (g & 1) + q4);
    const unsigned pv_base = imgb + (unsigned)((4 * g + q4) * 512 + 8 * (p4 & 1));
#pragma unroll 1
    for (int tok = gw * TPW; tok < tok_end; ++tok) {
        const int t = tok & (SEQ - 1); const size_t rb = (size_t)(tok - t);
        const int nsel = t + 1 < TOPK ? t + 1 : TOPK;
        bf16x8 qf[8];
#pragma unroll
        for (int st = 0; st < 8; ++st) { qf[st] = *(const GAS bf16x8*)(Z + (size_t)tok * ZLD + ZC_QLAT + (h & 7) * 256 + 32 * st + 8 * g); if (h >= 8) qf[st] = (bf16x8){0, 0, 0, 0, 0, 0, 0, 0}; }
        f32x4 oacc[16];
#pragma unroll
        for (int rt = 0; rt < 16; ++rt) oacc[rt] = (f32x4){0.f, 0.f, 0.f, 0.f};
        float mrun = -1e30f, lsum = 0.f;
        const GAS unsigned short* ip = IDX + (size_t)tok * TOPK;
#pragma unroll 1
        for (int ch = 0; ch < 8; ++ch) {
            if (32 * ch >= nsel) break;
            const int ixv = (int)ip[32 * ch + (lane & 31)];
            const unsigned long long i0 = *(const GAS unsigned long long*)(ip + 32 * ch + 4 * g), i1 = *(const GAS unsigned long long*)(ip + 32 * ch + 16 + 4 * g);
            asm volatile("s_waitcnt lgkmcnt(0)" ::: "memory");
#pragma unroll
            for (int i = 0; i < 16; ++i) { const int r0 = __builtin_amdgcn_readlane(ixv, 2 * i), r1 = __builtin_amdgcn_readlane(ixv, 2 * i + 1);
                const int row = 2 * i + (lane >> 5); const int ridx = lane < 32 ? r0 : r1; const int chunk = (lane & 31) ^ (2 * (row & 7));
                const GAS unsigned char* src = (const GAS unsigned char*)(CKVN + (rb + ridx) * RANK) + chunk * 16;
                __builtin_amdgcn_global_load_lds((const GAS unsigned*)src, (LAS unsigned*)(img + i * 1024), 16, 0, 0); }
            asm volatile("s_waitcnt vmcnt(0)" ::: "memory");
            f32x4 sa[2];
#pragma unroll
            for (int tl = 0; tl < 2; ++tl) { sa[tl] = (f32x4){0.f, 0.f, 0.f, 0.f};
#pragma unroll
                for (int st = 0; st < 8; ++st) { const bf16x8 a = *(const LAS bf16x8*)(img + qk_off + tl * 16 * 512 + (((4 * st + g) ^ xq) * 16));
                    sa[tl] = __builtin_amdgcn_mfma_f32_16x16x32_bf16(a, qf[st], sa[tl], 0, 0, 0); } }
            float lg[8]; float cmax = -1e30f;
#pragma unroll
            for (int e = 0; e < 8; ++e) { const int tl = e >> 2, jx = e & 3; const int kk = 32 * ch + 16 * tl + 4 * g + jx;
                const int sidx = (int)(((tl ? i1 : i0) >> (16 * jx)) & 0xffffull); int dd = t - sidx; dd = dd < 0 ? 0 : (dd > 128 ? 128 : dd);
                const float v = kk < nsel ? sa[tl][jx] + tabh[dd] : -1e30f; lg[e] = v; cmax = fmaxf(cmax, v); }
            cmax = fmaxf(cmax, SHX(cmax, 16)); cmax = fmaxf(cmax, SHX(cmax, 32));
            const float mnew = fmaxf(mrun, cmax);
            if (__any(mnew > mrun)) { const float alpha = __expf(mrun - mnew); lsum *= alpha;
#pragma unroll
                for (int rt = 0; rt < 16; ++rt) oacc[rt] = oacc[rt] * alpha; }
            mrun = mnew;
            float pe[8];
#pragma unroll
            for (int e = 0; e < 8; ++e) { pe[e] = __expf(lg[e] - mnew); lsum += pe[e]; }
            bf16x8 pf; { const v4u wv = {pg8::cvt_pk_bf16(pe[0], pe[1]), pg8::cvt_pk_bf16(pe[2], pe[3]), pg8::cvt_pk_bf16(pe[4], pe[5]), pg8::cvt_pk_bf16(pe[6], pe[7])}; pf = __builtin_bit_cast(bf16x8, wv); }
#pragma unroll
            for (int rt = 0; rt < 16; rt += 2) {
                const unsigned a0 = pv_base + (unsigned)((((2 * rt) ^ xr) | (p4 >> 1)) * 16), a1 = pv_base + (unsigned)((((2 * rt + 2) ^ xr) | (p4 >> 1)) * 16);
                s16x4 r0, r1, r2, r3; tr_read4(a0, a0 + 16 * 512, a1, a1 + 16 * 512, r0, r1, r2, r3);
                oacc[rt] = __builtin_amdgcn_mfma_f32_16x16x32_bf16(cat4(r0, r1), pf, oacc[rt], 0, 0, 0);
                oacc[rt + 1] = __builtin_amdgcn_mfma_f32_16x16x32_bf16(cat4(r2, r3), pf, oacc[rt + 1], 0, 0, 0); }
        }
        lsum += SHX(lsum, 16); lsum += SHX(lsum, 32);
        const float inv = (OUT_F8 ? O8_SCALE : 1.0f) / lsum;
        if (h < 8) {
            if constexpr (OUT_F8) { GAS unsigned char* orow = (GAS unsigned char*)O + (size_t)tok * OLD + h * 256 + 4 * g;
#pragma unroll
                for (int rt = 0; rt < 16; ++rt) { int p = 0; p = __builtin_amdgcn_cvt_pk_fp8_f32(oacc[rt][0] * inv, oacc[rt][1] * inv, p, false); p = __builtin_amdgcn_cvt_pk_fp8_f32(oacc[rt][2] * inv, oacc[rt][3] * inv, p, true); *(GAS unsigned*)(orow + 16 * rt) = (unsigned)p; } }
            else { GAS bf16* orow = O + (size_t)tok * OLD + h * 256 + 4 * g;
#pragma unroll
            for (int rt = 0; rt < 16; ++rt) *(GAS unsigned long long*)(orow + 16 * rt) = (unsigned long long)pk2(oacc[rt][0] * inv, oacc[rt][1] * inv) | ((unsigned long long)pk2(oacc[rt][2] * inv, oacc[rt][3] * inv) << 32); } }
    }
}
struct Args { const float* in[20]; float* out; unsigned char* ws; };
__device__ __forceinline__ unsigned long long karg_u64(int idx) { unsigned long long r; const unsigned off = (unsigned)idx * 8u;
    asm volatile("s_load_dwordx2 %0, %1, %2\n\ts_waitcnt lgkmcnt(0)" : "=s"(r) : "s"(__builtin_amdgcn_kernarg_segment_ptr()), "s"(off) : "memory"); return r; }
__device__ __forceinline__ const GAS float* karg_in(int i) { return (const GAS float*)karg_u64(i); }
__device__ __forceinline__ GAS float* karg_out() { return (GAS float*)karg_u64(20); }
__device__ __forceinline__ GAS unsigned char* karg_ws() { return (GAS unsigned char*)karg_u64(21); }
#ifndef REP_P0
#define REP_P0 1
#endif
#ifndef REP_NORM
#define REP_NORM 1
#endif
#ifndef REP_GU
#define REP_GU 1
#endif
#ifndef REP_IN
#define REP_IN 1
#endif
#ifndef REP_POST
#define REP_POST 1
#endif
#ifndef REP_TOPK
#define REP_TOPK 1
#endif
#ifndef REP_DSA
#define REP_DSA 1
#endif
#define REPEAT(n) _Pragma("unroll 1") for (int rep_ = 0; rep_ < (n); ++rep_)
#define PHASE_IDS() int wave = wave0; asm volatile("" : "+s"(wave)); int lane; asm volatile("v_mbcnt_lo_u32_b32 %0, -1, 0\n\tv_mbcnt_hi_u32_b32 %0, -1, %0" : "=v"(lane)); const int tid = wave * 64 + lane; int bx = blockIdx.x; asm volatile("" : "+s"(bx)); int G = gridDim.x; asm volatile("" : "+s"(G)); \
    const int vcu = (G % 8 == 0) ? (bx % 8) * (G / 8) + bx / 8 : bx; const int gw = vcu * NWAVES + wave, NGW = G * NWAVES; \
    GAS unsigned char* ws = karg_ws(); (void)lane; (void)gw; (void)NGW; (void)vcu; (void)ws
__global__ void __launch_bounds__(NWAVES * 64, 2) mk_fwd(Args args) {
    extern __shared__ __attribute__((aligned(16))) unsigned char lds_raw[];
    LAS unsigned char* lds = (LAS unsigned char*)lds_raw;
    volatile LAS unsigned* MISC = (volatile LAS unsigned*)(lds + MISC_OFF);
    const int wave0 = __builtin_amdgcn_readfirstlane(threadIdx.x >> 6);
    for (int u = threadIdx.x; u < (LDS_BYTES - LDSCTL_OFF) / 4; u += NWAVES * 64) ((LAS unsigned*)(lds + LDSCTL_OFF))[u] = 0u;
    __syncthreads();
    (void)xcd_barrier_post((unsigned*)((gu32*)(karg_ws() + WS_CTL) + CW_BAR), MISC + 8, threadIdx.x == 0);
#define GRID_BAR() do { XcdBarrier b_; b_.bar = (unsigned*)((gu32*)(karg_ws() + WS_CTL) + CW_BAR); b_.x = xb_xcc_id(); b_.st = MISC + 8; int w_ = wave0; asm volatile("" : "+s"(w_)); int l_; asm volatile("v_mbcnt_lo_u32_b32 %0, -1, 0\n\tv_mbcnt_hi_u32_b32 %0, -1, %0" : "=v"(l_)); xcd_barrier(b_, (w_ | l_) == 0); } while (0)

    REPEAT(REP_P0) {   PHASE_IDS();
        LAS float* scr = (LAS float*)(lds + RING_OFF + wave * 16384);
        rows_bf16_ss(karg_in(0), (GAS bf16*)(ws + WS_XN), f8_on(0, 0) ? (GAS unsigned char*)(ws + WS_HB8) : (GAS unsigned char*)nullptr, (GAS float*)(ws + WS_SS), gw, NGW, lane);
        constexpr int I_GU = (D / 64) * (FF / 32), I_DN = (FF / 64) * (D / 32);
        constexpr int I_FFN = 2 * I_GU + I_DN, I_IN = 72 * (D / 64), I_OB = (1024 / 64) * (D / 32);
        constexpr int PER_LAYER = 2 * I_FFN + I_IN + I_OB;
        for (int it = gw; it < DEPTH * PER_LAYER; it += NGW) {
            const int l = it / PER_LAYER; int r = it - l * PER_LAYER;
            GAS unsigned char* wl = ws + WS_W0 + (size_t)l * W_LAYER;
            if (r < 2 * I_FFN) {
                const int f = r / I_FFN; r -= f * I_FFN;
                GAS bf16* dgu = (GAS bf16*)(wl + (f ? WO_GU2 : WO_GU1)); GAS bf16* dd = (GAS bf16*)(wl + (f ? WO_D2 : WO_D1));
                if (r < 2 * I_GU) { const int up = r >= I_GU; if (up) r -= I_GU; const int kb = r / (FF / 32), nb = r % (FF / 32), n0 = 32 * nb;
                    const GAS float* wsrc = karg_in(up ? (f ? 17 : 4) : (f ? 16 : 3)) + (size_t)l * D * FF;
                    const int drow = (n0 >> 7) * 256 + (up ? 128 : 0) + (n0 & 127);
                    if (f8_on(l, f)) conv_item<true>(wsrc, FF, 64 * kb, n0, 32, dgu, D, drow, 0, W8_SCALE, karg_in(f ? 15 : 2) + (size_t)l * D, scr, lane);
                    else conv_item(wsrc, FF, 64 * kb, n0, 32, dgu, D, drow, 0, 1.0f, karg_in(f ? 15 : 2) + (size_t)l * D, scr, lane); }
                else { r -= 2 * I_GU; const int kb = r / (D / 32), nb = r % (D / 32);
                    if (d8_on(l, f)) conv_item<true>(karg_in(f ? 18 : 5) + (size_t)l * FF * D, D, 64 * kb, 32 * nb, 32, dd, FF, 32 * nb, 0, W8_SCALE, nullptr, scr, lane);
                    else conv_item(karg_in(f ? 18 : 5) + (size_t)l * FF * D, D, 64 * kb, 32 * nb, 32, dd, FF, 32 * nb, 0, 1.0f, nullptr, scr, lane); }
            } else if (r < 2 * I_FFN + I_IN) {
                r -= 2 * I_FFN; const int j = r >> 5, kb = r & 31; int src, nvalid = 32; float sc = 1.0f;
                if (j < 8) src = 1024 + 32 * j;
                else if (j < 24) src = 1280 + 32 * (j - 8);
                else if (j < 56) { src = 1864 + 32 * (j - 24); sc = 0.125f; }
                else if (j < 60) src = 2888 + 32 * (j - 56);
                else if (j < 64) src = 3016 + 32 * (j - 60);
                else if (j < 66) src = 1792 + 32 * (j - 64);
                else if (j == 66) { src = 1856; nvalid = 8; sc = 0.044194173824159216f; }
                else { src = 0; nvalid = 0; }
                conv_item(karg_in(7) + (size_t)l * D * D_IN, D_IN, 64 * kb, src, nvalid, (GAS bf16*)(wl + WO_IN), D, 2048 + 32 * j, 0, sc, karg_in(6) + (size_t)l * D, scr, lane);
            } else {
                r -= 2 * I_FFN + I_IN; const int kb = r >> 6, nb = r & 63;
                if constexpr (OUT_F8) conv_item<true>(karg_in(14) + (size_t)l * D * D + (size_t)1024 * D, D, 64 * kb, 32 * nb, 32, (GAS bf16*)(wl + WO_OUT), OLD, 32 * nb, 2048, W8_SCALE, nullptr, scr, lane);
                else conv_item(karg_in(14) + (size_t)l * D * D + (size_t)1024 * D, D, 64 * kb, 32 * nb, 32, (GAS bf16*)(wl + WO_OUT), OLD, 32 * nb, 2048, 1.0f, nullptr, scr, lane);
            }
        }
        __syncthreads();
        LAS float* Ps = (LAS float*)(lds + RING_OFF); LAS float* Qs = Ps + 64 * 129;
        for (int u = vcu; u < DEPTH * 2048; u += G) {
            const int l = u >> 11, which = (u >> 10) & 1, v = u & 1023;
            GAS unsigned char* wl = ws + WS_W0 + (size_t)l * W_LAYER;
            if (which == 0) { const int h = v >> 7, rt = (v >> 5) & 3, kt = v & 31;
                absorb_unit<false>(karg_in(11) + (size_t)l * RANK * 1024 + ((size_t)(64 * rt) * 8 + h) * 128, 1024, 1, karg_in(7) + (size_t)l * D * D_IN + (size_t)(64 * kt) * D_IN + h * 128, D_IN,
                                   (GAS bf16*)(wl + WO_IN) + (size_t)(h * 256 + 64 * rt) * D + 64 * kt, D, 0.08838834764831845f, karg_in(6) + (size_t)l * D + 64 * kt, Ps, Qs, tid); }
            else { const int h = v >> 7, nt = (v >> 2) & 31, rt = v & 3;
                if constexpr (OUT_F8) absorb_unit<true, true>(karg_in(14) + (size_t)l * D * D + (size_t)(h * 128) * D + 64 * nt, 1, D, karg_in(12) + (size_t)l * RANK * 1024 + ((size_t)(64 * rt) * 8 + h) * 128, 1024,
                                  (GAS bf16*)((GAS unsigned char*)(wl + WO_OUT) + (size_t)(64 * nt) * OLD + h * 256 + 64 * rt), OLD, W8_SCALE, nullptr, Ps, Qs, tid);
                else absorb_unit<true>(karg_in(14) + (size_t)l * D * D + (size_t)(h * 128) * D + 64 * nt, 1, D, karg_in(12) + (size_t)l * RANK * 1024 + ((size_t)(64 * rt) * 8 + h) * 128, 1024,
                                  (GAS bf16*)(wl + WO_OUT) + (size_t)(64 * nt) * OLD + h * 256 + 64 * rt, OLD, 1.0f, nullptr, Ps, Qs, tid); }
        }
    }
    GRID_BAR();

#pragma unroll 1
    for (int s = 0; s < 2 * DEPTH; ++s) {
        const int l = s >> 1, f = s & 1;
        REPEAT(REP_GU) {   PHASE_IDS(); GAS unsigned char* wl = ws + WS_W0 + (size_t)l * W_LAYER;
            pg8::StaticOrder S; S.init(M, NGU, G, bx);
            const GAS float* ssp = (const GAS float*)(ws + WS_SS + (size_t)((3 * l + 2 * f) & 1) * SS_BYTES);
            if ((F8_MASK == 0xF) || (F8_MASK != 0 && f8_on(l, f))) {
                if constexpr (F8_MASK != 0) {
                    pg8::Gemm g{(const GAS bf16*)(ws + WS_HB8), (const GAS bf16*)(wl + (f ? WO_GU2 : WO_GU1)), M, NGU, D / 2};
                    pg8::EpiSwiglu E{(GAS bf16*)(ws + WS_ACT), FF, ssp, 1.0f / D, EPS, 1.0f / W8_SCALE, d8_on(l, f) ? A8_SCALE : 0.f};
                    pg8::gemm_phase<pg8::EpiSwiglu, pg8::StaticOrder, true, true, true>(lds + RING_OFF, g, S, E, tid); }
            } else {
                if constexpr (F8_MASK != 0xF) {
                    pg8::Gemm g{(const GAS bf16*)(ws + WS_XN), (const GAS bf16*)(wl + (f ? WO_GU2 : WO_GU1)), M, NGU, D};
                    pg8::EpiSwiglu E{(GAS bf16*)(ws + WS_ACT), FF, ssp, 1.0f / D, EPS, 1.0f, d8_on(l, f) ? A8_SCALE : 0.f};
                    pg8::gemm_phase<pg8::EpiSwiglu, pg8::StaticOrder, true, true, false>(lds + RING_OFF, g, S, E, tid); }
            } }
        GRID_BAR();
        {   PHASE_IDS(); GAS unsigned char* wl = ws + WS_W0 + (size_t)l * W_LAYER;
            pg8::StaticOrder S; S.init(M, D, G, bx);
            const unsigned sso = (unsigned)(WS_SS + (size_t)((3 * l + 2 * f + 1) & 1) * SS_BYTES), h8o = (f == 1 && l + 1 < DEPTH && f8_on(l + 1, 0)) ? (unsigned)WS_HB8 : 0u;
            if ((D8_MASK == 0xF) || (D8_MASK != 0 && d8_on(l, f))) {
                if constexpr (D8_MASK != 0) {
                    pg8::Gemm g{(const GAS bf16*)(ws + WS_ACT), (const GAS bf16*)(wl + (f ? WO_D2 : WO_D1)), M, D, FF / 2};
                    pg8::EpiResid E{0.5f / (W8_SCALE * A8_SCALE), (unsigned)WS_XN, sso, h8o};
                    pg8::gemm_phase<pg8::EpiResid, pg8::StaticOrder, true, true, true>(lds + RING_OFF, g, S, E, tid); }
            } else {
                if constexpr (D8_MASK != 0xF) {
                    pg8::Gemm g{(const GAS bf16*)(ws + WS_ACT), (const GAS bf16*)(wl + (f ? WO_D2 : WO_D1)), M, D, FF};
                    pg8::EpiResid E{0.5f, (unsigned)WS_XN, sso, h8o};
                    pg8::gemm_phase<pg8::EpiResid, pg8::StaticOrder, true, true, false>(lds + RING_OFF, g, S, E, tid); }
            } }
        GRID_BAR();
        if (f == 0) {
            REPEAT(REP_IN) {   PHASE_IDS(); GAS unsigned char* wl = ws + WS_W0 + (size_t)l * W_LAYER;
                pg8::Gemm g{(const GAS bf16*)(ws + WS_XN), (const GAS bf16*)(wl + WO_IN), M, ZLD, D}; pg8::StaticOrder S; S.init(M, ZLD, G, bx);
                pg8::EpiBf16 E{(GAS bf16*)(ws + WS_Z), ZLD, (const GAS float*)(ws + WS_SS + (size_t)((3 * l + 1) & 1) * SS_BYTES), 1.0f / D, EPS};
                pg8::gemm_phase<pg8::EpiBf16, pg8::StaticOrder, true, true>(lds + RING_OFF, g, S, E, tid); }
            GRID_BAR();
            REPEAT(REP_POST) {   PHASE_IDS();
                post_rows((const GAS bf16*)(ws + WS_Z), karg_in(8) + (size_t)l * RANK, karg_in(9) + (size_t)l * IDIM, karg_in(10) + (size_t)l * IDIM, (GAS bf16*)(ws + WS_CKVN), (GAS bf16*)(ws + WS_KIN), (GAS float*)(ws + WS_WIF), gw, NGW, lane);
                swa_phase(lds + RING_OFF, (const GAS bf16*)(ws + WS_Z), (GAS bf16*)(ws + WS_O), karg_in(1), karg_in(13) + (size_t)l * H_B, vcu, G, tid, lane, wave);
            }
            GRID_BAR();
            REPEAT(REP_TOPK) {   PHASE_IDS(); topk_phase(lds + RING_OFF, (const GAS bf16*)(ws + WS_Z), (const GAS bf16*)(ws + WS_KIN), (const GAS float*)(ws + WS_WIF), (GAS unsigned short*)(ws + WS_IDX), vcu, G, lane, wave); }
            GRID_BAR();
            REPEAT(REP_DSA) {   PHASE_IDS(); dsa_phase(lds, (const GAS bf16*)(ws + WS_Z), (const GAS bf16*)(ws + WS_CKVN), (const GAS unsigned short*)(ws + WS_IDX), (GAS bf16*)(ws + WS_O), karg_in(1), gw, NGW, tid, lane, wave); }
            GRID_BAR();
            {   PHASE_IDS(); GAS unsigned char* wl = ws + WS_W0 + (size_t)l * W_LAYER;
                pg8::Gemm g{(const GAS bf16*)(ws + WS_O), (const GAS bf16*)(wl + WO_OUT), M, D, OUT_F8 ? OLD / 2 : OLD}; pg8::StaticOrder S; S.init(M, D, G, bx);
                pg8::EpiResid E{OUT_F8 ? 1.0f / (W8_SCALE * O8_SCALE) : 1.0f, (unsigned)WS_XN, (unsigned)(WS_SS + (size_t)((3 * l + 2) & 1) * SS_BYTES), f8_on(l, 1) ? (unsigned)WS_HB8 : 0u};
                pg8::gemm_phase<pg8::EpiResid, pg8::StaticOrder, true, true, OUT_F8 != 0>(lds + RING_OFF, g, S, E, tid); }
            GRID_BAR();
        }
    }
    {   PHASE_IDS(); final_rows((const GAS bf16*)(ws + WS_XN), karg_out(), karg_in(19), (const GAS float*)(ws + WS_SS + (size_t)(6 & 1) * SS_BYTES), gw, NGW, lane); }
}

extern "C" void kernel_launch(void* const* d_in, const int* in_sizes, int n_in, void* d_out, int out_size, void* d_ws, size_t ws_size, hipStream_t stream) {
    static int grid = 0;
    if (grid == 0) {
        if (n_in != 20 || in_sizes[0] != M * D || out_size != M * D || ws_size < WS_END) { fprintf(stderr, "kernel_launch: unexpected shapes (n_in %d, in0 %d, out %d, ws %zu); nothing launched\n", n_in, n_in > 0 ? in_sizes[0] : -1, out_size, ws_size); grid = -1; return; }
        int dev = 0, cus = 0, per_cu = 0;
        if (hipGetDevice(&dev) != hipSuccess || hipDeviceGetAttribute(&cus, hipDeviceAttributeMultiprocessorCount, dev) != hipSuccess) { grid = -1; return; }
        if (hipFuncSetAttribute((const void*)mk_fwd, hipFuncAttributeMaxDynamicSharedMemorySize, LDS_BYTES) != hipSuccess) { fprintf(stderr, "kernel_launch: hipFuncSetAttribute failed\n"); grid = -1; return; }
        if (hipOccupancyMaxActiveBlocksPerMultiprocessor(&per_cu, (const void*)mk_fwd, NWAVES * 64, LDS_BYTES) != hipSuccess || per_cu < 1) { fprintf(stderr, "kernel_launch: occupancy query reports %d workgroups per CU\n", per_cu); }
        (void)hipGetLastError();
        grid = cus;
    }
    if (grid < 0) return;
    if (hipMemsetAsync((char*)d_ws + WS_CTL, 0, CTL_ZERO_BYTES, stream) != hipSuccess) return;
    Args a{};
    for (int i = 0; i < 20; ++i) a.in[i] = (const float*)d_in[i];
    a.out = (float*)d_out; a.ws = (unsigned char*)d_ws;
    hipLaunchKernelGGL(mk_fwd, dim3(grid), dim3(NWAVES * 64), LDS_BYTES, stream, a);
}
```

```cpp
#define F8_MASK 0xA
#define D8_MASK 0xA
#include <hip/hip_runtime.h>
#include <cstdio>
#include <cstdint>
namespace pg8 {
#define PG8_LAS __attribute__((address_space(3)))
#define PG8_GAS __attribute__((address_space(1)))
typedef unsigned short bf16_t;
typedef short bf16x8 __attribute__((ext_vector_type(8)));
typedef float f32x4 __attribute__((ext_vector_type(4)));
typedef unsigned u32x4 __attribute__((ext_vector_type(4)));
constexpr int BM = 256, BK = 64, HALF = 128, HTB = HALF * BK * 2  , STAGE_BYTES = 8 * HTB, NXCD = 8, WGM = 8;

__host__ __device__ __forceinline__ int lds_byte(int r, int c) { const int st = (r >> 4) * 2 + (c >> 5), rr = r & 15, cc = c & 31, ob = rr * 64 + cc * 2; return st * 1024 + (ob ^ (((ob >> 9) & 1) << 5)); }
__host__ __device__ __forceinline__ void stage_rc(int b, int& R, int& C) { const int st = b / 1024, sb = b % 1024, swz = sb ^ (((sb >> 9) & 1) << 5); R = (st >> 1) * 16 + swz / 64; C = (st & 1) * 32 + (swz % 64) / 2; }
__host__ __device__ __forceinline__ int perm32(int rho) { const int n = rho >> 4, i = rho & 15; return 8 * (i >> 2) + 4 * n + (i & 3); }

typedef int i32x8 __attribute__((ext_vector_type(8))); typedef int i32x4v __attribute__((ext_vector_type(4)));
__device__ __forceinline__ i32x8 cat8(bf16x8 a, bf16x8 b) { return __builtin_shufflevector(__builtin_bit_cast(i32x4v, a), __builtin_bit_cast(i32x4v, b), 0, 1, 2, 3, 4, 5, 6, 7); }
struct Unit { int pm, pn; };
struct Gemm { const PG8_GAS bf16_t* A; const PG8_GAS bf16_t* Bt; int M, N, K; };

struct StaticOrder {
    int nM, nN, nwg, G, c;
    __host__ __device__ void init(int M, int N, int G_, int c_) { nM = M / BM; nN = N / BM; nwg = nM * nN; G = G_; c = c_; }
    __host__ __device__ bool next(int i, Unit& u) const {
        const long L = (long)i * G + c; if (L >= nwg) return false;
        int wgid = (int)L; { const int q = nwg / NXCD, r = nwg % NXCD, xcd = wgid % NXCD, off = wgid / NXCD; wgid = (xcd < r ? xcd * (q + 1) : r * (q + 1) + (xcd - r) * q) + off; }
        const int nig = WGM * nN, gid = wgid / nig, fm = gid * WGM, gsz = (nM - fm) < WGM ? (nM - fm) : WGM;
        u.pm = fm + ((wgid % nig) % gsz); u.pn = (wgid % nig) / gsz; return true;
    }
    __device__ __forceinline__ void a_ready(const Unit&) const {}
    __device__ __forceinline__ void done(const Unit&) const {}
};
__device__ __forceinline__ unsigned long long karg64(int idx) { unsigned long long r; const unsigned off = (unsigned)idx * 8u;
    asm volatile("s_load_dwordx2 %0, %1, %2\n\ts_waitcnt lgkmcnt(0)" : "=s"(r) : "s"(__builtin_amdgcn_kernarg_segment_ptr()), "s"(off) : "memory"); return r; }
__device__ __forceinline__ unsigned cvt_pk_bf16(float lo, float hi) { unsigned r; asm volatile("v_cvt_pk_bf16_f32 %0, %1, %2" : "=v"(r) : "v"(lo), "v"(hi)); return r; }
__device__ __forceinline__ float silu_f(float g) { return g * __builtin_amdgcn_rcpf(1.0f + __builtin_amdgcn_exp2f(-1.4426950408889634f * g)); }

struct EpiSwiglu {
    static constexpr bool PERM = true, AFTER_DRAIN = false;
    PG8_GAS bf16_t* O; int ldc; const PG8_GAS float* ss; float inv_k, eps, post; float out8;
    __device__ __forceinline__ void operator()(const f32x4 (&acc)[2][2][4][2], const Unit& u, int wr, int wc, int fr, int fq) const {
        const int row0 = u.pm * BM + wr * 64 + fr, col0 = u.pn * HALF + wc * 32 + 8 * fq;
        float rs[8]; const int lane_ = fr + 16 * fq;
#pragma unroll
        for (int k = 0; k < 8; ++k) { const PG8_GAS f32x4* p4 = (const PG8_GAS f32x4*)(ss + (size_t)(row0 + (k >> 2) * HALF + (k & 3) * 16) * 32 + 8 * fq); const f32x4 a = p4[0], b = p4[1];
            float t = ((a[0] + a[1]) + (a[2] + a[3])) + ((b[0] + b[1]) + (b[2] + b[3]));
            t += __builtin_bit_cast(float, __builtin_amdgcn_ds_bpermute((lane_ ^ 16) << 2, __builtin_bit_cast(int, t)));
            t += __builtin_bit_cast(float, __builtin_amdgcn_ds_bpermute((lane_ ^ 32) << 2, __builtin_bit_cast(int, t))); rs[k] = t; }
#pragma unroll
        for (int ai = 0; ai < 2; ++ai)
#pragma unroll
            for (int m = 0; m < 4; ++m) { PG8_GAS bf16_t* rowp = O + (size_t)(row0 + ai * HALF + m * 16) * ldc + col0;
                const float r = __builtin_amdgcn_rsqf(rs[ai * 4 + m] * inv_k + eps) * post;
                const f32x4 g0 = acc[ai][0][m][0] * r, g1 = acc[ai][0][m][1] * r, u0 = acc[ai][1][m][0] * r, u1 = acc[ai][1][m][1] * r;
                if (out8 != 0.f) { int p = 0, q = 0;
                    p = __builtin_amdgcn_cvt_pk_fp8_f32(silu_f(g0[0]) * u0[0] * out8, silu_f(g0[1]) * u0[1] * out8, p, false); p = __builtin_amdgcn_cvt_pk_fp8_f32(silu_f(g0[2]) * u0[2] * out8, silu_f(g0[3]) * u0[3] * out8, p, true);
                    q = __builtin_amdgcn_cvt_pk_fp8_f32(silu_f(g1[0]) * u1[0] * out8, silu_f(g1[1]) * u1[1] * out8, q, false); q = __builtin_amdgcn_cvt_pk_fp8_f32(silu_f(g1[2]) * u1[2] * out8, silu_f(g1[3]) * u1[3] * out8, q, true);
                    typedef unsigned u32x2v __attribute__((ext_vector_type(2))); u32x2v w8; w8.x = (unsigned)p; w8.y = (unsigned)q;
                    *(PG8_GAS u32x2v*)((PG8_GAS unsigned char*)O + (size_t)(row0 + ai * HALF + m * 16) * ldc + col0) = w8; }
                else { u32x4 w; w.x = cvt_pk_bf16(silu_f(g0[0]) * u0[0], silu_f(g0[1]) * u0[1]); w.y = cvt_pk_bf16(silu_f(g0[2]) * u0[2], silu_f(g0[3]) * u0[3]);
                w.z = cvt_pk_bf16(silu_f(g1[0]) * u1[0], silu_f(g1[1]) * u1[1]); w.w = cvt_pk_bf16(silu_f(g1[2]) * u1[2], silu_f(g1[3]) * u1[3]);
                *(PG8_GAS u32x4*)rowp = w; } }
    }
};
struct EpiResid {
    static constexpr bool PERM = true, AFTER_DRAIN = false;
    float alpha; unsigned hb_off; unsigned ss_off; unsigned h8_off;
    __device__ __forceinline__ void operator()(const f32x4 (&acc)[2][2][4][2], const Unit& u, int wr, int wc, int fr, int fq) const {
        constexpr int ldc = 2048;
        PG8_GAS unsigned char* wsb = (PG8_GAS unsigned char*)karg64(21); PG8_GAS bf16_t* hb = (PG8_GAS bf16_t*)(wsb + hb_off); PG8_GAS float* ss = (PG8_GAS float*)(wsb + ss_off);
        const int row0 = u.pm * BM + wr * 64 + fr, col0 = u.pn * BM + wc * 32 + 8 * fq; const int lane = fr + 16 * fq;
        u32x4 cur[2], nxt[2];
        { const size_t off = (size_t)row0 * ldc + col0; cur[0] = *(const PG8_GAS u32x4*)(hb + off); cur[1] = *(const PG8_GAS u32x4*)(hb + off + HALF); }
#pragma unroll
        for (int k = 0; k < 8; ++k) { const int ai = k >> 2, m = k & 3; const int row = row0 + ai * HALF + m * 16; const size_t off = (size_t)row * ldc + col0;
            if (k < 7) { const int ai2 = (k + 1) >> 2, m2 = (k + 1) & 3; const size_t off2 = (size_t)(row0 + ai2 * HALF + m2 * 16) * ldc + col0;
                nxt[0] = *(const PG8_GAS u32x4*)(hb + off2); nxt[1] = *(const PG8_GAS u32x4*)(hb + off2 + HALF); }
            float sq = 0.f;
#pragma unroll
            for (int bj = 0; bj < 2; ++bj) { const u32x4 b = cur[bj]; const f32x4 a0 = acc[ai][bj][m][0], a1 = acc[ai][bj][m][1]; u32x4 w;
                w.x = cvt_pk_bf16(__builtin_bit_cast(float, b.x << 16) + a0[0] * alpha, __builtin_bit_cast(float, b.x & 0xffff0000u) + a0[1] * alpha);
                w.y = cvt_pk_bf16(__builtin_bit_cast(float, b.y << 16) + a0[2] * alpha, __builtin_bit_cast(float, b.y & 0xffff0000u) + a0[3] * alpha);
                w.z = cvt_pk_bf16(__builtin_bit_cast(float, b.z << 16) + a1[0] * alpha, __builtin_bit_cast(float, b.z & 0xffff0000u) + a1[1] * alpha);
                w.w = cvt_pk_bf16(__builtin_bit_cast(float, b.w << 16) + a1[2] * alpha, __builtin_bit_cast(float, b.w & 0xffff0000u) + a1[3] * alpha);
                *(PG8_GAS u32x4*)(hb + off + bj * HALF) = w;
                if (h8_off) { typedef unsigned u32x2v __attribute__((ext_vector_type(2))); u32x2v q8; int p = 0;
                    p = __builtin_amdgcn_cvt_pk_fp8_f32(__builtin_bit_cast(float, w.x << 16), __builtin_bit_cast(float, w.x & 0xffff0000u), p, false);
                    p = __builtin_amdgcn_cvt_pk_fp8_f32(__builtin_bit_cast(float, w.y << 16), __builtin_bit_cast(float, w.y & 0xffff0000u), p, true); q8.x = (unsigned)p; p = 0;
                    p = __builtin_amdgcn_cvt_pk_fp8_f32(__builtin_bit_cast(float, w.z << 16), __builtin_bit_cast(float, w.z & 0xffff0000u), p, false);
                    p = __builtin_amdgcn_cvt_pk_fp8_f32(__builtin_bit_cast(float, w.w << 16), __builtin_bit_cast(float, w.w & 0xffff0000u), p, true); q8.y = (unsigned)p;
                    *(PG8_GAS u32x2v*)(wsb + h8_off + off + bj * HALF) = q8; }
#pragma unroll
                for (int e = 0; e < 4; ++e) { const float lo = __builtin_bit_cast(float, w[e] << 16), hi = __builtin_bit_cast(float, w[e] & 0xffff0000u); sq = fmaf(lo, lo, sq); sq = fmaf(hi, hi, sq); } }
            sq += __builtin_bit_cast(float, __builtin_amdgcn_ds_bpermute((lane ^ 16) << 2, __builtin_bit_cast(int, sq)));
            sq += __builtin_bit_cast(float, __builtin_amdgcn_ds_bpermute((lane ^ 32) << 2, __builtin_bit_cast(int, sq)));
            if (fq == 0) ss[(size_t)row * 32 + u.pn * 4 + wc] = sq;
            cur[0] = nxt[0]; cur[1] = nxt[1]; }
    }
};
struct EpiBf16 {
    static constexpr bool PERM = true, AFTER_DRAIN = false;
    PG8_GAS bf16_t* O; int ldc; const PG8_GAS float* ss; float inv_k, eps;
    __device__ __forceinline__ void operator()(const f32x4 (&acc)[2][2][4][2], const Unit& u, int wr, int wc, int fr, int fq) const {
        const int row0 = u.pm * BM + wr * 64 + fr, col0 = u.pn * BM + wc * 32 + 8 * fq;
        float rs[8]; const int lane_ = fr + 16 * fq;
#pragma unroll
        for (int k = 0; k < 8; ++k) { const PG8_GAS f32x4* p4 = (const PG8_GAS f32x4*)(ss + (size_t)(row0 + (k >> 2) * HALF + (k & 3) * 16) * 32 + 8 * fq); const f32x4 a = p4[0], b = p4[1];
            float t = ((a[0] + a[1]) + (a[2] + a[3])) + ((b[0] + b[1]) + (b[2] + b[3]));
            t += __builtin_bit_cast(float, __builtin_amdgcn_ds_bpermute((lane_ ^ 16) << 2, __builtin_bit_cast(int, t)));
            t += __builtin_bit_cast(float, __builtin_amdgcn_ds_bpermute((lane_ ^ 32) << 2, __builtin_bit_cast(int, t))); rs[k] = t; }
#pragma unroll
        for (int ai = 0; ai < 2; ++ai)
#pragma unroll
            for (int m = 0; m < 4; ++m) { PG8_GAS bf16_t* rowp = O + (size_t)(row0 + ai * HALF + m * 16) * ldc + col0;
                const float r = __builtin_amdgcn_rsqf(rs[ai * 4 + m] * inv_k + eps);
#pragma unroll
                for (int bj = 0; bj < 2; ++bj) { const f32x4 v0 = acc[ai][bj][m][0] * r, v1 = acc[ai][bj][m][1] * r;
                    u32x4 w; w.x = cvt_pk_bf16(v0[0], v0[1]); w.y = cvt_pk_bf16(v0[2], v0[3]); w.z = cvt_pk_bf16(v1[0], v1[1]); w.w = cvt_pk_bf16(v1[2], v1[3]);
                    *(PG8_GAS u32x4*)(rowp + bj * HALF) = w; } }
    }
};
template <class Epi, class Sched, bool ALIGN_EPI = false, bool SP2 = false, bool F8 = false>
__device__ __forceinline__ void gemm_phase(PG8_LAS unsigned char* lds, const Gemm g, const Sched& S, const Epi& E, int tid_in  ) {
    int tid_ = tid_in; asm volatile("" : "+v"(tid_));
    const int tid = tid_, wid = __builtin_amdgcn_readfirstlane(tid >> 6), lane = tid & 63, wr = wid >> 2, wc = wid & 3, fr = lane & 15, fq = lane >> 4;
    const int K = g.K, nt = K / BK;
    unsigned voffA[2], voffB[2];
#pragma unroll
    for (int i = 0; i < 2; ++i) { int R, C; stage_rc(tid * 16 + i * 8192, R, C); const int Rb = Epi::PERM ? ((R & ~31) + perm32(R & 31)) : R;
        voffA[i] = (unsigned)(R * K + C) * 2u; voffB[i] = (unsigned)(Rb * K + C) * 2u; }
    const size_t kstep = (size_t)(BK * 2);
    const size_t hstep = (size_t)HALF * K * 2;
    const size_t tstep = 2 * hstep;
    const unsigned ldsw = (unsigned)wid * 1024u;
    const int aoff = lds_byte(wr * 64 + fr, fq * 8), boff = lds_byte(wc * 32 + fr, fq * 8);
#define PG8_SA(b, h) (((b) * 2 + (h)) * HTB)
#define PG8_SB(b, h) ((4 + (b) * 2 + (h)) * HTB)
#define PG8_STAGE(bufoff, gbase, voff) do { _Pragma("unroll") for (int _i = 0; _i < 2; ++_i) \
        __builtin_amdgcn_global_load_lds((const PG8_GAS unsigned*)((const PG8_GAS char*)(gbase) + (voff)[_i]), (PG8_LAS unsigned*)(lds + (bufoff) + ldsw + _i * 8192), 16, 0, 0); } while (0)
#define PG8_LDA(dst, b, h) do { _Pragma("unroll") for (int m = 0; m < 4; ++m) _Pragma("unroll") for (int k = 0; k < 2; ++k) dst[m][k] = *(const PG8_LAS bf16x8*)(lds + PG8_SA(b, h) + aoff + m * 2048 + k * 1024); } while (0)
#define PG8_LDB(dst, b, h) do { _Pragma("unroll") for (int n = 0; n < 2; ++n) _Pragma("unroll") for (int k = 0; k < 2; ++k) dst[n][k] = *(const PG8_LAS bf16x8*)(lds + PG8_SB(b, h) + boff + n * 2048 + k * 1024); } while (0)
#define PG8_MMA(ai, bj, At, Bt) do { __builtin_amdgcn_s_setprio(1); _Pragma("unroll") for (int m = 0; m < 4; ++m) _Pragma("unroll") for (int n = 0; n < 2; ++n) { \
        if constexpr (F8) { asm volatile("v_mfma_f32_16x16x128_f8f6f4 %0, %1, %2, %0" : "+v"(acc[ai][bj][m][n]) : "v"(cat8(Bt[n][0], Bt[n][1])), "v"(cat8(At[m][0], At[m][1]))); } \
        else { _Pragma("unroll") for (int k = 0; k < 2; ++k) acc[ai][bj][m][n] = __builtin_amdgcn_mfma_f32_16x16x32_bf16(Bt[n][k], At[m][k], acc[ai][bj][m][n], 0, 0, 0); } } \
        __builtin_amdgcn_s_setprio(0); } while (0)
#define PG8_WAIT_V(n) asm volatile("s_waitcnt vmcnt(" #n ")" ::: "memory")
#define PG8_WAIT_L(n) asm volatile("s_waitcnt lgkmcnt(" #n ")" ::: "memory")
#define PG8_BAR __builtin_amdgcn_s_barrier()
#define PG8_SCHED __builtin_amdgcn_sched_barrier(0)
    Unit cur, nxt; int ui = 0;
    if (!S.next(0, cur)) return;
    f32x4 acc[2][2][4][2];
#pragma unroll
    for (int a = 0; a < 2; ++a)
#pragma unroll
        for (int b = 0; b < 2; ++b)
#pragma unroll
            for (int m = 0; m < 4; ++m)
#pragma unroll
                for (int n = 0; n < 2; ++n) acc[a][b][m][n] = (f32x4){0.f, 0.f, 0.f, 0.f};
    bf16x8 At[4][2], B0[2][2], B1[2][2];
    const PG8_GAS char* cA = (const PG8_GAS char*)g.A + (size_t)cur.pm * tstep; const PG8_GAS char* cB = (const PG8_GAS char*)g.Bt + (size_t)cur.pn * tstep;
    S.a_ready(cur);
    if constexpr (SP2) {
        PG8_STAGE(PG8_SB(0, 0), cB, voffB); PG8_STAGE(PG8_SB(0, 1), cB + hstep, voffB); PG8_STAGE(PG8_SA(0, 0), cA, voffA); PG8_STAGE(PG8_SA(0, 1), cA + hstep, voffA);
        if (wr == 1) PG8_BAR;
        PG8_WAIT_V(2); PG8_BAR;
        PG8_STAGE(PG8_SB(1, 0), cB + kstep, voffB); PG8_STAGE(PG8_SA(1, 0), cA + kstep, voffA); PG8_STAGE(PG8_SB(1, 1), cB + hstep + kstep, voffB);
        PG8_WAIT_V(6); PG8_BAR;
    } else {
        PG8_STAGE(PG8_SB(0, 0), cB, voffB); PG8_STAGE(PG8_SA(0, 0), cA, voffA); PG8_STAGE(PG8_SB(0, 1), cB + hstep, voffB); PG8_STAGE(PG8_SA(0, 1), cA + hstep, voffA);
        if (wr == 1) PG8_BAR;
        PG8_WAIT_V(4); PG8_BAR;
        PG8_STAGE(PG8_SB(1, 0), cB + kstep, voffB); PG8_STAGE(PG8_SA(1, 0), cA + kstep, voffA); PG8_STAGE(PG8_SB(1, 1), cB + hstep + kstep, voffB);
        PG8_WAIT_V(6); PG8_BAR;
    }
    for (;;) {
        const bool has_next = S.next(ui + 1, nxt);
        const PG8_GAS char* nA = has_next ? (const PG8_GAS char*)g.A + (size_t)nxt.pm * tstep : cA; const PG8_GAS char* nB = has_next ? (const PG8_GAS char*)g.Bt + (size_t)nxt.pn * tstep : cB;
        for (int t = 0; t < nt; t += 2) {
            const bool last = (t == nt - 2);
            const PG8_GAS char* a1 = cA + (size_t)(t + 1) * kstep;
            const PG8_GAS char* a2 = last ? nA : cA + (size_t)(t + 2) * kstep; const PG8_GAS char* b2 = last ? nB : cB + (size_t)(t + 2) * kstep;
            const PG8_GAS char* a3 = a2 + kstep; const PG8_GAS char* b3 = b2 + kstep;
            if (last && has_next) S.a_ready(nxt);
            if constexpr (SP2) {
            PG8_LDB(B0, 0, 0); PG8_LDB(B1, 0, 1); PG8_SCHED; PG8_LDA(At, 0, 0); PG8_STAGE(PG8_SA(1, 1), a1 + hstep, voffA);
            PG8_WAIT_V(8); PG8_WAIT_L(0); PG8_BAR; PG8_MMA(0, 0, At, B0); PG8_MMA(0, 1, At, B1); PG8_BAR; PG8_SCHED;
            PG8_LDA(At, 0, 1); PG8_STAGE(PG8_SB(0, 0), b2, voffB); PG8_STAGE(PG8_SB(0, 1), b2 + hstep, voffB); PG8_STAGE(PG8_SA(0, 0), a2, voffA);
            PG8_WAIT_V(8); PG8_WAIT_L(0); PG8_BAR; PG8_MMA(1, 0, At, B0); PG8_MMA(1, 1, At, B1); PG8_BAR; PG8_SCHED;
            PG8_LDB(B0, 1, 0); PG8_LDB(B1, 1, 1); PG8_SCHED; PG8_LDA(At, 1, 0); PG8_STAGE(PG8_SA(0, 1), a2 + hstep, voffA);
            PG8_WAIT_V(8); PG8_WAIT_L(0); PG8_BAR; PG8_MMA(0, 0, At, B0); PG8_MMA(0, 1, At, B1); PG8_BAR; PG8_SCHED;
            PG8_LDA(At, 1, 1); PG8_STAGE(PG8_SB(1, 0), b3, voffB); PG8_STAGE(PG8_SB(1, 1), b3 + hstep, voffB); PG8_STAGE(PG8_SA(1, 0), a3, voffA);
            PG8_WAIT_V(8); PG8_WAIT_L(0); PG8_BAR; PG8_MMA(1, 0, At, B0); PG8_MMA(1, 1, At, B1); PG8_BAR; PG8_SCHED;
            } else {
            PG8_LDB(B0, 0, 0); PG8_SCHED; PG8_LDA(At, 0, 0); PG8_STAGE(PG8_SA(1, 1), a1 + hstep, voffA);
            PG8_WAIT_L(8); PG8_BAR; PG8_WAIT_L(0); PG8_MMA(0, 0, At, B0); PG8_BAR; PG8_SCHED;
            PG8_LDB(B1, 0, 1); PG8_STAGE(PG8_SB(0, 0), b2, voffB);
            PG8_BAR; PG8_WAIT_L(0); PG8_MMA(0, 1, At, B1); PG8_BAR;
            PG8_LDA(At, 0, 1); PG8_STAGE(PG8_SA(0, 0), a2, voffA);
            PG8_BAR; PG8_WAIT_L(0); PG8_MMA(1, 0, At, B0); PG8_BAR; PG8_SCHED;
            PG8_STAGE(PG8_SB(0, 1), b2 + hstep, voffB);
            PG8_WAIT_V(6); PG8_BAR; PG8_MMA(1, 1, At, B1); PG8_BAR;
            PG8_LDB(B0, 1, 0); PG8_SCHED; PG8_LDA(At, 1, 0); PG8_STAGE(PG8_SA(0, 1), a2 + hstep, voffA);
            PG8_WAIT_L(8); PG8_BAR; PG8_WAIT_L(0); PG8_MMA(0, 0, At, B0); PG8_BAR; PG8_SCHED;
            PG8_LDB(B1, 1, 1); PG8_STAGE(PG8_SB(1, 0), b3, voffB);
            PG8_BAR; PG8_WAIT_L(0); PG8_MMA(0, 1, At, B1); PG8_BAR;
            PG8_LDA(At, 1, 1); PG8_STAGE(PG8_SA(1, 0), a3, voffA);
            PG8_BAR; PG8_WAIT_L(0); PG8_MMA(1, 0, At, B0); PG8_BAR; PG8_SCHED;
            PG8_STAGE(PG8_SB(1, 1), b3 + hstep, voffB);
            PG8_WAIT_V(6); PG8_BAR; PG8_MMA(1, 1, At, B1); PG8_BAR;
            }
        }
        if constexpr (ALIGN_EPI) { if (wr == 0) PG8_BAR; }
        if constexpr (!Epi::AFTER_DRAIN) { E(acc, cur, wr, wc, fr, fq); S.done(cur); }
        if (!has_next) break;
#pragma unroll
        for (int a = 0; a < 2; ++a)
#pragma unroll
            for (int b = 0; b < 2; ++b)
#pragma unroll
                for (int m = 0; m < 4; ++m)
#pragma unroll
                    for (int n = 0; n < 2; ++n) acc[a][b][m][n] = (f32x4){0.f, 0.f, 0.f, 0.f};
        cur = nxt; cA = nA; cB = nB; ++ui;
        if constexpr (ALIGN_EPI) { if (wr == 1) PG8_BAR; }
    }
    PG8_WAIT_V(0);
    if constexpr (!ALIGN_EPI) { if (wr == 0) PG8_BAR; }
    PG8_BAR;
    if constexpr (Epi::AFTER_DRAIN) { E.fused(acc, cur, wr, wc, fr, fq, lds, wid, lane); S.done(cur); }
#undef PG8_SA
#undef PG8_SB
#undef PG8_STAGE
#undef PG8_LDA
#undef PG8_LDB
#undef PG8_MMA
#undef PG8_WAIT_V
#undef PG8_WAIT_L
#undef PG8_BAR
#undef PG8_SCHED
}
}
constexpr int NWAVES = 8;
constexpr int BATCH = 8, SEQ = 4096, D = 2048, FF = 5632, DEPTH = 2;
constexpr int M = BATCH * SEQ;
constexpr int NGU = 2 * FF;
constexpr int H_A = 8, HD_A = 128, RANK = 256, IH = 8, IDIM = 64, TOPK = 256;
constexpr int H_B = 16, KVH = 2, GQA = 8, HD_B = 64, WINDOW = 128;
constexpr int D_IN = 3144;
constexpr float EPS = 1e-6f;
constexpr size_t MiB = 1u << 20;
constexpr size_t WS_CTL = 0, CTL_ZERO_BYTES = 1 * MiB;
#ifndef F8_MASK
#define F8_MASK 0xF
#endif
constexpr float W8_SCALE = 64.0f;
#ifndef D8_MASK
#define D8_MASK 0xA
#endif
constexpr float A8_SCALE = 8.0f;
__host__ __device__ constexpr bool d8_on(int l, int f) { return ((D8_MASK >> (2 * l + f)) & 1) != 0; }
constexpr float O8_SCALE = 16.0f;
#ifndef OUT_F8
#define OUT_F8 1
#endif
constexpr bool F8_ALL1 = (F8_MASK & 0x5) == 0x5, F8_ALL2 = (F8_MASK & 0xA) == 0xA;
__host__ __device__ constexpr bool f8_on(int l, int f) { return ((F8_MASK >> (2 * l + f)) & 1) != 0; }
constexpr size_t GU1_B = (F8_ALL1 ? 22 : 44) * MiB, GU2_B = (F8_ALL2 ? 22 : 44) * MiB;
constexpr size_t WS_W0 = 2 * MiB;
constexpr size_t WO_GU1 = 0, WO_D1 = GU1_B, WO_GU2 = WO_D1 + 22 * MiB, WO_D2 = WO_GU2 + GU2_B, WO_IN = WO_D2 + 22 * MiB, WO_OUT = WO_IN + 17 * MiB, W_LAYER = WO_OUT + 12 * MiB;
constexpr size_t WS_XN = WS_W0 + 2 * W_LAYER;
constexpr size_t WS_HB8 = WS_XN + 128 * MiB;
constexpr size_t WS_ACT = WS_HB8 + (F8_MASK ? 64 : 0) * MiB;
constexpr size_t WS_Z = WS_ACT, WS_CKVN = WS_ACT + 272 * MiB, WS_KIN = WS_ACT + 288 * MiB, WS_WIF = WS_ACT + 292 * MiB, WS_IDX = WS_ACT + 294 * MiB;
constexpr int ZLD = 4352, ZC_QLAT = 0, ZC_CKV = 2048, ZC_QI = 2304, ZC_QB = 2816, ZC_KB = 3840, ZC_VB = 3968, ZC_KI = 4096, ZC_WI = 4160;
constexpr int OLD = 3072;
constexpr size_t WS_O = WS_ACT + 352 * MiB;
constexpr size_t WS_SS = WS_O + 192 * MiB, SS_BYTES = 4 * MiB;
constexpr size_t WS_END = WS_SS + 2 * SS_BYTES;
static_assert(WS_END <= 1024 * MiB, "d_ws map exceeds 1 GiB");
constexpr int CW_TMO = 0, CW_CODE = 1, CW_BAR = 4096;
constexpr int RING_OFF = 0, RING_BYTES = 131072;
constexpr int LDSCTL_OFF = RING_BYTES, MISC_OFF = LDSCTL_OFF + 320;
constexpr int LDS_BYTES = 147456;
#define GAS __attribute__((address_space(1)))
#define LAS __attribute__((address_space(3)))
typedef unsigned short bf16;
typedef unsigned v4u __attribute__((ext_vector_type(4)));
typedef float f32x4 __attribute__((ext_vector_type(4)));
typedef short bf16x8 __attribute__((ext_vector_type(8)));
typedef GAS unsigned gu32;
typedef GAS unsigned long long gu64;
#define RLX_AGENT __ATOMIC_RELAXED, __HIP_MEMORY_SCOPE_AGENT
#define LDS_WAIT() asm volatile("s_waitcnt lgkmcnt(0)" ::: "memory")
#define VM_WAIT() asm volatile("s_waitcnt vmcnt(0)" ::: "memory")
__device__ __forceinline__ unsigned long long rt() { return __builtin_amdgcn_s_memrealtime(); }
__device__ __forceinline__ unsigned f2bf(float f) { unsigned u = __builtin_bit_cast(unsigned, f); return (u + 0x7fffu + ((u >> 16) & 1u)) >> 16; }
__device__ __forceinline__ unsigned pk2(float lo, float hi) { return f2bf(lo) | (f2bf(hi) << 16); }

#define XB_TMO      128
#define XB_XCNT(j)  (256  + 64 * (j))
#define XB_XSUB(j)  (1280 + 64 * (j))
#define XB_XGEN(j)  (2304 + 64 * (j))
#define XB_TOP      3328
#define XB_TOPGEN   3392
#define XCD_BAR_WORDS 3456
#define XB_SPIN_CAP (1u << 18)

__device__ __forceinline__ unsigned xb_ld(unsigned* p)              { return __hip_atomic_load(p, __ATOMIC_RELAXED, __HIP_MEMORY_SCOPE_AGENT); }
__device__ __forceinline__ unsigned xb_add(unsigned* p, unsigned v) { return __hip_atomic_fetch_add(p, v, __ATOMIC_RELAXED, __HIP_MEMORY_SCOPE_AGENT); }
__device__ __forceinline__ unsigned xb_xcc_id() { return (unsigned)__builtin_amdgcn_s_getreg((3 << 11) | 20) & 0xFu; }
#define XB_SPIN(cond, bar) do { unsigned _sp = 0; while (cond) { __builtin_amdgcn_s_sleep(1); \
    if ((++_sp & 255u) == 0u) { if (xb_ld(&(bar)[XB_TMO])) break; if (_sp > XB_SPIN_CAP) { atomicAdd(&(bar)[XB_TMO], 1u); break; } } } } while (0)

struct XcdBarrier {
    unsigned* bar; unsigned x;
    volatile LAS unsigned* st;
};

__device__ __forceinline__ XcdBarrier xcd_barrier_post(unsigned* bar, volatile LAS unsigned* st, bool leader  ) {
    XcdBarrier b; b.bar = bar; b.x = xb_xcc_id(); b.st = st;
    if (leader) (void)xb_add(&bar[XB_XCNT(b.x)], 1u);
    return b;
}
__device__ __forceinline__ void xcd_barrier_complete(unsigned* bar, unsigned x, unsigned& nloc, unsigned& nx) {
    const unsigned G = gridDim.x * gridDim.y * gridDim.z;
    unsigned sum, cnt, mine, sp = 0u;
    for (;;) {
        sum = 0u; cnt = 0u; mine = 0u;
#pragma unroll
        for (unsigned j = 0; j < 16; ++j) { const unsigned c = xb_ld(&bar[XB_XCNT(j)]); sum += c; cnt += (c > 0u) ? 1u : 0u; mine = (j == x) ? c : mine; }
        if (sum == G) break;
        __builtin_amdgcn_s_sleep(1);
        if ((++sp & 255u) == 0u) { if (xb_ld(&bar[XB_TMO])) break; if (sp > XB_SPIN_CAP) { atomicAdd(&bar[XB_TMO], 1u); break; } }
    }
    nloc = mine > 0u ? mine : 1u; nx = cnt > 0u ? cnt : 1u;
}

__device__ __forceinline__ void xcd_barrier(const XcdBarrier& b, bool leader  ) {
    asm volatile("s_waitcnt vmcnt(0)" ::: "memory");
    __syncthreads();
    if (leader) {
        unsigned* bar = b.bar;
        __builtin_amdgcn_s_waitcnt(0);
        unsigned nloc = b.st[0], nx = b.st[1];
        if (nloc == 0u) { xcd_barrier_complete(bar, b.x, nloc, nx); b.st[0] = nloc; b.st[1] = nx; }
        const unsigned old = xb_add(&bar[XB_XSUB(b.x)], 1u);
        const unsigned gen = old / nloc;
        if (old + 1u == (gen + 1u) * nloc) {
            __builtin_amdgcn_fence(__ATOMIC_RELEASE, "agent");
            asm volatile("s_waitcnt vmcnt(0)" ::: "memory");
            const unsigned og = xb_add(&bar[XB_TOP], 1u);
            const unsigned tg = og / nx;
            if (og + 1u == (tg + 1u) * nx) xb_add(&bar[XB_TOPGEN], 1u);
            else XB_SPIN(xb_ld(&bar[XB_TOPGEN]) == tg, bar);
            __builtin_amdgcn_fence(__ATOMIC_ACQUIRE, "agent");
            xb_add(&bar[XB_XGEN(b.x)], 1u);
            asm volatile("s_waitcnt vmcnt(0)" ::: "memory");
        } else {
            XB_SPIN(xb_ld(&bar[XB_XGEN(b.x)]) == gen, bar);
            __builtin_amdgcn_fence(__ATOMIC_ACQUIRE, "agent");
            asm volatile("s_waitcnt vmcnt(0)" ::: "memory");
        }
    }
    __syncthreads();
}
__constant__ unsigned char T5_BUCKET[128] = {0, 1, 2, 3, 4, 5, 6, 7, 8, 9, 10, 11, 12, 13, 14, 15, 16, 16, 16, 17, 17, 18, 18, 18, 19, 19, 19, 20, 20, 20, 20, 21, 21, 21, 21, 22, 22, 22, 22, 22, 23, 23, 23, 23, 23, 23, 24, 24, 24, 24, 24, 24, 25, 25, 25, 25, 25, 25, 25, 26, 26, 26, 26, 26, 26, 26, 26, 27, 27, 27, 27, 27, 27, 27, 27, 27, 27, 28, 28, 28, 28, 28, 28, 28, 28, 28, 28, 29, 29, 29, 29, 29, 29, 29, 29, 29, 29, 29, 29, 30, 30, 30, 30, 30, 30, 30, 30, 30, 30, 30, 30, 30, 30, 31, 31, 31, 31, 31, 31, 31, 31, 31, 31, 31, 31, 31, 31, 31};
typedef short s16x4 __attribute__((ext_vector_type(4)));
typedef float f32x16 __attribute__((ext_vector_type(16)));
__device__ __forceinline__ float bf2f(unsigned short b) { return __builtin_bit_cast(float, (unsigned)b << 16); }
__device__ __forceinline__ bf16x8 cat4(s16x4 lo, s16x4 hi) { return __builtin_shufflevector(lo, hi, 0, 1, 2, 3, 4, 5, 6, 7); }
__device__ __forceinline__ void tr_read4(unsigned a0, unsigned a1, unsigned a2, unsigned a3, s16x4& r0, s16x4& r1, s16x4& r2, s16x4& r3) {
    asm volatile("ds_read_b64_tr_b16 %0, %4\n\tds_read_b64_tr_b16 %1, %5\n\tds_read_b64_tr_b16 %2, %6\n\tds_read_b64_tr_b16 %3, %7\n\ts_waitcnt lgkmcnt(0)"
                 : "=&v"(r0), "=&v"(r1), "=&v"(r2), "=&v"(r3) : "v"(a0), "v"(a1), "v"(a2), "v"(a3) : "memory");
}
#define SHX(x, o) __builtin_bit_cast(float, __builtin_amdgcn_ds_bpermute(((lane) ^ (o)) << 2, __builtin_bit_cast(int, (float)(x))))
#define SHXU(x, o) ((unsigned)__builtin_amdgcn_ds_bpermute(((lane) ^ (o)) << 2, (int)(x)))
__device__ __forceinline__ float wave_sum(float v, int lane) {
#pragma unroll
    for (int o = 1; o < 64; o <<= 1) v += SHX(v, o);
    return v;
}
template <bool OUT8 = false>
__device__ __forceinline__ void conv_item(const GAS float* W, int ldw, int k0, int c0, int nvalid, GAS bf16* dst, int dld, int drow0, int dk0, float scale, const GAS float* gain, LAS float* scr, int lane) {
    const int c = lane & 31;
    float vin[32];
#pragma unroll
    for (int i = 0; i < 32; ++i) { const int kk = 2 * i + (lane >> 5); vin[i] = 0.f;
        if (c < nvalid) vin[i] = W[(size_t)(k0 + kk) * ldw + c0 + c]; }
#pragma unroll
    for (int i = 0; i < 32; ++i) { const int kk = 2 * i + (lane >> 5); scr[kk * 33 + c] = vin[i] * scale; }
    LDS_WAIT(); asm volatile("" ::: "memory");
    const int c8 = lane & 7;
    f32x4 ga = {1.f, 1.f, 1.f, 1.f}, gb = {1.f, 1.f, 1.f, 1.f};
    if (gain) { ga = *(const GAS f32x4*)(gain + k0 + 8 * c8); gb = *(const GAS f32x4*)(gain + k0 + 8 * c8 + 4); }
#pragma unroll
    for (int j = 0; j < 4; ++j) { const int n = (lane >> 3) + 8 * j; const LAS float* s = scr + (8 * c8) * 33 + n;
        if constexpr (OUT8) { int p = 0, q = 0;
            p = __builtin_amdgcn_cvt_pk_fp8_f32(s[0 * 33] * ga.x, s[1 * 33] * ga.y, p, false); p = __builtin_amdgcn_cvt_pk_fp8_f32(s[2 * 33] * ga.z, s[3 * 33] * ga.w, p, true);
            q = __builtin_amdgcn_cvt_pk_fp8_f32(s[4 * 33] * gb.x, s[5 * 33] * gb.y, q, false); q = __builtin_amdgcn_cvt_pk_fp8_f32(s[6 * 33] * gb.z, s[7 * 33] * gb.w, q, true);
            *(GAS unsigned long long*)((GAS unsigned char*)dst + (size_t)(drow0 + n) * dld + dk0 + k0 + 8 * c8) = (unsigned long long)(unsigned)p | ((unsigned long long)(unsigned)q << 32); }
        else { v4u o; o.x = pk2(s[0 * 33] * ga.x, s[1 * 33] * ga.y); o.y = pk2(s[2 * 33] * ga.z, s[3 * 33] * ga.w); o.z = pk2(s[4 * 33] * gb.x, s[5 * 33] * gb.y); o.w = pk2(s[6 * 33] * gb.z, s[7 * 33] * gb.w);
            *(GAS v4u*)(dst + (size_t)(drow0 + n) * dld + dk0 + k0 + 8 * c8) = o; } }
    LDS_WAIT(); asm volatile("" ::: "memory");
}
__device__ __forceinline__ void rmsnorm_rows_bf16(const GAS float* X, const GAS float* g, GAS bf16* O, int gw, int NGW, int lane) {
    f32x4 gv[8];
#pragma unroll
    for (int j = 0; j < 8; ++j) gv[j] = ((const GAS f32x4*)g)[lane + 64 * j];
    for (int m = gw; m < M; m += NGW) {
        const GAS f32x4* xr = (const GAS f32x4*)(X + (size_t)m * D) + lane;
        f32x4 v[8]; float s = 0.f;
#pragma unroll
        for (int j = 0; j < 8; ++j) { v[j] = xr[64 * j]; s += (v[j].x * v[j].x + v[j].y * v[j].y) + (v[j].z * v[j].z + v[j].w * v[j].w); }
        const float r = 1.0f / sqrtf(wave_sum(s, lane) * (1.0f / D) + EPS);
        GAS unsigned long long* o8 = (GAS unsigned long long*)(O + (size_t)m * D) + lane;
#pragma unroll
        for (int j = 0; j < 8; ++j) { const f32x4 y = v[j] * r * gv[j]; o8[64 * j] = (unsigned long long)pk2(y.x, y.y) | ((unsigned long long)pk2(y.z, y.w) << 32); }
    }
}
__device__ __forceinline__ void rows_bf16_ss(const GAS float* X, GAS bf16* O, GAS unsigned char* O8, GAS float* ss, int gw, int NGW, int lane) {
    for (int m = gw; m < M; m += NGW) {
        const GAS f32x4* xr = (const GAS f32x4*)(X + (size_t)m * D) + lane;
        f32x4 v[8]; float s = 0.f;
#pragma unroll
        for (int j = 0; j < 8; ++j) { v[j] = xr[64 * j]; s += (v[j].x * v[j].x + v[j].y * v[j].y) + (v[j].z * v[j].z + v[j].w * v[j].w); }
        s = wave_sum(s, lane);
        GAS unsigned long long* o8 = (GAS unsigned long long*)(O + (size_t)m * D) + lane;
#pragma unroll
        for (int j = 0; j < 8; ++j) o8[64 * j] = (unsigned long long)pk2(v[j].x, v[j].y) | ((unsigned long long)pk2(v[j].z, v[j].w) << 32);
        if (O8) { GAS unsigned* q8 = (GAS unsigned*)(O8 + (size_t)m * D) + lane;
#pragma unroll
            for (int j = 0; j < 8; ++j) { int p = 0; p = __builtin_amdgcn_cvt_pk_fp8_f32(v[j].x, v[j].y, p, false); p = __builtin_amdgcn_cvt_pk_fp8_f32(v[j].z, v[j].w, p, true); q8[64 * j] = (unsigned)p; } }
        if (lane < 32) ss[(size_t)m * 32 + lane] = lane == 0 ? s : 0.f;
    }
}
__device__ __forceinline__ void final_rows(const GAS bf16* HB, GAS float* OUT, const GAS float* g, const GAS float* ss, int gw, int NGW, int lane) {
    f32x4 gv[8];
#pragma unroll
    for (int j = 0; j < 8; ++j) gv[j] = ((const GAS f32x4*)g)[lane + 64 * j];
    for (int m = gw; m < M; m += NGW) {
        const GAS unsigned long long* hr = (const GAS unsigned long long*)(HB + (size_t)m * D) + lane; GAS f32x4* orow = (GAS f32x4*)(OUT + (size_t)m * D) + lane;
        unsigned long long raw[8];
#pragma unroll
        for (int j = 0; j < 8; ++j) raw[j] = hr[64 * j];
        const float r = 1.0f / sqrtf(wave_sum(lane < 32 ? ss[(size_t)m * 32 + lane] : 0.f, lane) * (1.0f / D) + EPS);
#pragma unroll
        for (int j = 0; j < 8; ++j) { const unsigned lo = (unsigned)raw[j], hi = (unsigned)(raw[j] >> 32);
            f32x4 v = {__builtin_bit_cast(float, lo << 16), __builtin_bit_cast(float, lo & 0xffff0000u), __builtin_bit_cast(float, hi << 16), __builtin_bit_cast(float, hi & 0xffff0000u)};
            orow[64 * j] = v * r * gv[j]; }
    }
}
__device__ __forceinline__ void rmsnorm_rows_f32_inplace(GAS float* X, const GAS float* g, int gw, int NGW, int lane) {
    f32x4 gv[8];
#pragma unroll
    for (int j = 0; j < 8; ++j) gv[j] = ((const GAS f32x4*)g)[lane + 64 * j];
    for (int m = gw; m < M; m += NGW) {
        GAS f32x4* xr = (GAS f32x4*)(X + (size_t)m * D) + lane;
        f32x4 v[8]; float s = 0.f;
#pragma unroll
        for (int j = 0; j < 8; ++j) { v[j] = xr[64 * j]; s += (v[j].x * v[j].x + v[j].y * v[j].y) + (v[j].z * v[j].z + v[j].w * v[j].w); }
        const float r = 1.0f / sqrtf(wave_sum(s, lane) * (1.0f / D) + EPS);
#pragma unroll
        for (int j = 0; j < 8; ++j) xr[64 * j] = v[j] * r * gv[j];
    }
}

template <bool P_IFAST, bool OUT8 = false>
__device__ __forceinline__ void absorb_unit(const GAS float* Psrc, size_t p_ri, size_t p_rd, const GAS float* Qsrc, size_t q_rj, GAS bf16* out, size_t out_ld, float scale, const GAS float* qgain, LAS float* Ps_, LAS float* Qs_, int tid) {
    LAS bf16* Ps = (LAS bf16*)Ps_; LAS bf16* Qs = Ps + 64 * 136;
    float pv[16], qv[16];
#pragma unroll
    for (int j = 0; j < 16; ++j) { const int e = tid + 512 * j; const int i = P_IFAST ? (e & 63) : (e >> 7), d = P_IFAST ? (e >> 6) : (e & 127);
        pv[j] = Psrc[(size_t)i * p_ri + (size_t)d * p_rd];
        const int jj = e >> 7, dd = e & 127; qv[j] = Qsrc[(size_t)jj * q_rj + dd] * (qgain ? qgain[jj] : 1.0f); }
#pragma unroll
    for (int j = 0; j < 16; ++j) { const int e = tid + 512 * j; const int i = P_IFAST ? (e & 63) : (e >> 7), d = P_IFAST ? (e >> 6) : (e & 127);
        Ps[i * 136 + d] = (bf16)f2bf(pv[j]); const int jj = e >> 7, dd = e & 127; Qs[jj * 136 + dd] = (bf16)f2bf(qv[j]); }
    __syncthreads();
    const int wv = tid >> 6, ln = tid & 63, it = wv >> 1, r16 = ln & 15, g = ln >> 4;
#pragma unroll
    for (int jq = 0; jq < 2; ++jq) { const int jt = 2 * (wv & 1) + jq; f32x4 acc = {0.f, 0.f, 0.f, 0.f};
#pragma unroll
        for (int st = 0; st < 4; ++st) { const bf16x8 a = *(const LAS bf16x8*)(Ps + (16 * it + r16) * 136 + 32 * st + 8 * g); const bf16x8 b = *(const LAS bf16x8*)(Qs + (16 * jt + r16) * 136 + 32 * st + 8 * g);
            acc = __builtin_amdgcn_mfma_f32_16x16x32_bf16(a, b, acc, 0, 0, 0); }
#pragma unroll
        for (int rg = 0; rg < 4; ++rg) { const size_t o = (size_t)(16 * it + 4 * g + rg) * out_ld + 16 * jt + r16;
            if constexpr (OUT8) ((GAS unsigned char*)out)[o] = (unsigned char)__builtin_amdgcn_cvt_pk_fp8_f32(acc[rg] * scale, 0.f, 0, false);
            else out[o] = (bf16)f2bf(acc[rg] * scale); } }
    __syncthreads();
}
__device__ __forceinline__ void post_rows(const GAS bf16* Z, const GAS float* gkv, const GAS float* gki, const GAS float* bki, GAS bf16* CKVN, GAS bf16* KIN, GAS float* WIF, int gw, int NGW, int lane) {
    const f32x4 g4 = ((const GAS f32x4*)gkv)[lane]; const float gk = gki[lane], bk = bki[lane];
    for (int m = gw; m < M; m += NGW) {
        const GAS bf16* zr = Z + (size_t)m * ZLD;
        const unsigned long long raw = *(const GAS unsigned long long*)(zr + ZC_CKV + 4 * lane);
        const float kraw = bf2f(zr[ZC_KI + lane]);
        const float wraw = bf2f(zr[ZC_WI + (lane & 7)]);
        const float c0 = bf2f((unsigned short)raw), c1 = bf2f((unsigned short)(raw >> 16)), c2 = bf2f((unsigned short)(raw >> 32)), c3 = bf2f((unsigned short)(raw >> 48));
        const float r = 1.0f / sqrtf(wave_sum((c0 * c0 + c1 * c1) + (c2 * c2 + c3 * c3), lane) * (1.0f / RANK) + EPS);
        *(GAS unsigned long long*)(CKVN + (size_t)m * RANK + 4 * lane) = (unsigned long long)pk2(c0 * r * g4.x, c1 * r * g4.y) | ((unsigned long long)pk2(c2 * r * g4.z, c3 * r * g4.w) << 32);
        const float mu = wave_sum(kraw, lane) * (1.0f / IDIM); const float dv = kraw - mu;
        const float var = wave_sum(dv * dv, lane) * (1.0f / IDIM);
        KIN[(size_t)m * IDIM + lane] = (bf16)f2bf(dv * (1.0f / sqrtf(var + EPS)) * gk + bk);
        if (lane < 8) WIF[(size_t)m * IH + lane] = wraw;
    }
}
constexpr int SWA_KP = 144, SWA_VP = 192;
constexpr int SWA_K_OFF = 0, SWA_V_OFF = 160 * SWA_KP, SWA_TAB_OFF = SWA_V_OFF + 160 * SWA_VP;
static_assert(SWA_TAB_OFF + 16 * 128 * 4 <= RING_BYTES, "SWA LDS map");
__device__ __forceinline__ void swa_phase(LAS unsigned char* lds, const GAS bf16* Z, GAS bf16* O, const GAS float* rel_bias, const GAS float* sinks, int vcu, int G, int tid, int lane, int wave) {
    LAS float* tab = (LAS float*)(lds + SWA_TAB_OFF);
    for (int e = tid; e < 16 * 128; e += NWAVES * 64) { const int h = e >> 7, dist = e & 127; tab[e] = rel_bias[(int)T5_BUCKET[dist] * 24 + H_A + h]; }
    __syncthreads();
    const int q = lane & 31, hh = lane >> 5;
    const unsigned ldsb = (unsigned)(size_t)lds;
    for (int item = vcu; item < BATCH * 128 * KVH; item += G) {
        const int kvh = item & 1, qt = (item >> 1) & 127, b = item >> 8;
        const int t0 = 32 * qt, s0 = t0 - 128;
        const size_t rowbase = (size_t)b * SEQ;
        for (int c = tid; c < 1280; c += NWAVES * 64) { const int row = c >> 3, ch = c & 7; const int s = s0 + row;
            if (s >= 0) { const GAS bf16* zr = Z + (rowbase + s) * ZLD + kvh * 64 + ch * 8;
                const v4u kv = *(const GAS v4u*)(zr + ZC_KB); const v4u vv = *(const GAS v4u*)(zr + ZC_VB);
                *(LAS v4u*)(lds + SWA_K_OFF + row * SWA_KP + ch * 16) = kv; *(LAS v4u*)(lds + SWA_V_OFF + row * SWA_VP + ch * 16) = vv; } }
        const int hq = kvh * 8 + wave; const int t = t0 + q;
        bf16x8 qf[4];
#pragma unroll
        for (int st = 0; st < 4; ++st) qf[st] = *(const GAS bf16x8*)(Z + (rowbase + t) * ZLD + ZC_QB + hq * 64 + 16 * st + 8 * hh);
        __syncthreads();
        const int kt0 = qt >= 4 ? 0 : 4 - qt;
        f32x16 sacc[5];
#pragma unroll
        for (int kt = 0; kt < 5; ++kt) {
#pragma unroll
            for (int r = 0; r < 16; ++r) sacc[kt][r] = 0.f;
            if (kt >= kt0) {
#pragma unroll
                for (int st = 0; st < 4; ++st) { const bf16x8 kf = *(const LAS bf16x8*)(lds + SWA_K_OFF + (kt * 32 + q) * SWA_KP + (2 * st + hh) * 16);
                    sacc[kt] = __builtin_amdgcn_mfma_f32_32x32x16_bf16(kf, qf[st], sacc[kt], 0, 0, 0); } } }
        const float sink = sinks[hq]; float mx = sink;
        const LAS float* tabh = tab + hq * 128;
#pragma unroll
        for (int kt = 0; kt < 5; ++kt) if (kt >= kt0) {
#pragma unroll
            for (int r = 0; r < 16; ++r) { const int ko = (r & 3) + 8 * (r >> 2) + 4 * hh; const int dist = q + 128 - 32 * kt - ko;
                const float lg = (dist >= 0 && dist < WINDOW) ? sacc[kt][r] + tabh[dist & 127] : -1e30f; sacc[kt][r] = lg; mx = fmaxf(mx, lg); } }
        mx = fmaxf(mx, SHX(mx, 32));
        float l = 0.f;
#pragma unroll
        for (int kt = 0; kt < 5; ++kt) if (kt >= kt0) {
#pragma unroll
            for (int r = 0; r < 16; ++r) { const float p = __expf(sacc[kt][r] - mx); sacc[kt][r] = p; l += p; } }
        l += SHX(l, 32); l += __expf(sink - mx);
        f32x16 oacc[2];
#pragma unroll
        for (int dt = 0; dt < 2; ++dt)
#pragma unroll
            for (int r = 0; r < 16; ++r) oacc[dt][r] = 0.f;
        const unsigned vlane = ldsb + SWA_V_OFF + (unsigned)((4 * hh + ((lane & 15) >> 2)) * SWA_VP + (16 * ((lane >> 4) & 1) + 4 * (lane & 3)) * 2);
#pragma unroll
        for (int kt = 0; kt < 5; ++kt) if (kt >= kt0) {
#pragma unroll
            for (int s2 = 0; s2 < 2; ++s2) {
                bf16x8 pf; { const unsigned w0 = pg8::cvt_pk_bf16(sacc[kt][8 * s2 + 0], sacc[kt][8 * s2 + 1]), w1 = pg8::cvt_pk_bf16(sacc[kt][8 * s2 + 2], sacc[kt][8 * s2 + 3]),
                                     w2 = pg8::cvt_pk_bf16(sacc[kt][8 * s2 + 4], sacc[kt][8 * s2 + 5]), w3 = pg8::cvt_pk_bf16(sacc[kt][8 * s2 + 6], sacc[kt][8 * s2 + 7]);
                    const v4u w = {w0, w1, w2, w3}; pf = __builtin_bit_cast(bf16x8, w); }
                const unsigned a = vlane + (unsigned)((kt * 32 + 16 * s2) * SWA_VP);
                s16x4 r0, r1, r2, r3; tr_read4(a, a + 8 * SWA_VP, a + 64, a + 8 * SWA_VP + 64, r0, r1, r2, r3);
                oacc[0] = __builtin_amdgcn_mfma_f32_32x32x16_bf16(cat4(r0, r1), pf, oacc[0], 0, 0, 0);
                oacc[1] = __builtin_amdgcn_mfma_f32_32x32x16_bf16(cat4(r2, r3), pf, oacc[1], 0, 0, 0); } }
        const float inv = (OUT_F8 ? O8_SCALE : 1.0f) / l;
        if constexpr (OUT_F8) { GAS unsigned char* orow = (GAS unsigned char*)O + (rowbase + t) * OLD + 2048 + hq * 64 + 4 * hh;
#pragma unroll
            for (int dt = 0; dt < 2; ++dt)
#pragma unroll
                for (int g4 = 0; g4 < 4; ++g4) { int p = 0; p = __builtin_amdgcn_cvt_pk_fp8_f32(oacc[dt][4 * g4] * inv, oacc[dt][4 * g4 + 1] * inv, p, false); p = __builtin_amdgcn_cvt_pk_fp8_f32(oacc[dt][4 * g4 + 2] * inv, oacc[dt][4 * g4 + 3] * inv, p, true);
                    *(GAS unsigned*)(orow + 32 * dt + 8 * g4) = (unsigned)p; } }
        else { GAS bf16* orow = O + (rowbase + t) * OLD + 2048 + hq * 64 + 4 * hh;
#pragma unroll
        for (int dt = 0; dt < 2; ++dt)
#pragma unroll
            for (int g4 = 0; g4 < 4; ++g4) { const unsigned long long w = (unsigned long long)pk2(oacc[dt][4 * g4] * inv, oacc[dt][4 * g4 + 1] * inv) | ((unsigned long long)pk2(oacc[dt][4 * g4 + 2] * inv, oacc[dt][4 * g4 + 3] * inv) << 32);
                *(GAS unsigned long long*)(orow + 32 * dt + 8 * g4) = w; } }
        __syncthreads();
    }
}
constexpr int TK_BINS = 512, TK_CAP = 256;
#define LDS_ADD(p) __hip_atomic_fetch_add((p), 1u, __ATOMIC_RELAXED, __HIP_MEMORY_SCOPE_WORKGROUP)
#define LDS_ADDV(p, v) __hip_atomic_fetch_add((p), (v), __ATOMIC_RELAXED, __HIP_MEMORY_SCOPE_WORKGROUP)
#define HIST_WORD(tok, bin) (((tok) * TK_BINS + (bin)) >> 1)
#define HIST_INC(bin) (1u << (((bin) & 1) * 16))
constexpr int TK_HIST_OFF = 0, TK_CSC_OFF = 32768, TK_CIX_OFF = TK_CSC_OFF + 32 * TK_CAP * 4, TK_SEL_OFF = TK_CIX_OFF + 32 * TK_CAP * 2, TK_CNT_OFF = TK_SEL_OFF + 32 * 256 * 2, TK_DUM_OFF = TK_CNT_OFF + 32 * 2 * 4, TK_KB_OFF = TK_DUM_OFF + 8 * 64 * 4, TK_KB_BYTES = 64 * 144, TK_FLAG_OFF = TK_KB_OFF + 2 * TK_KB_BYTES;
static_assert(TK_FLAG_OFF + 16 <= RING_BYTES, "top-k LDS map");
typedef _Float16 tk_h2 __attribute__((ext_vector_type(2)));
__device__ __forceinline__ void tk_score2(const f32x16& acc, const tk_h2 (&wh)[8], float& s0, float& s1) {
    tk_h2 s = {(_Float16)0, (_Float16)0}; const tk_h2 zero = {(_Float16)0, (_Float16)0};
#pragma unroll
    for (int h = 0; h < 8; ++h) { tk_h2 d = __builtin_bit_cast(tk_h2, __builtin_amdgcn_cvt_pkrtz(acc[h], acc[8 + h])); d = __builtin_elementwise_max(d, zero); s = __builtin_elementwise_fma(wh[h], d, s); }
    s0 = (float)s.x; s1 = (float)s.y;
}
__device__ __forceinline__ float tk_x(float s, float sc) { return fmaf(s, sc, 256.0f); }
__device__ __forceinline__ int tk_key(float s, float sc) {
    const float x = tk_x(s, sc); int b0 = (int)x; b0 = b0 < 0 ? 0 : (b0 > TK_BINS - 1 ? TK_BINS - 1 : b0);
    int sub = (int)((x - (float)b0) * 512.0f); sub = sub < 0 ? 0 : (sub > 511 ? 511 : sub);
    return b0 * 512 + sub;
}
__device__ __forceinline__ void tk_find(const LAS unsigned* h, unsigned need, int lane, int& bin_out, unsigned& above_out) {
    unsigned v[8]; unsigned s = 0;
#pragma unroll
    for (int i = 0; i < 4; ++i) { const unsigned w = h[4 * lane + i]; v[2 * i] = w & 0xffffu; v[2 * i + 1] = w >> 16; s += v[2 * i] + v[2 * i + 1]; }
    unsigned S = s;
#pragma unroll
    for (int o = 1; o < 64; o <<= 1) { const unsigned t = (unsigned)__builtin_amdgcn_ds_bpermute((lane + o) << 2, (int)S); if (lane + o < 64) S += t; }
    const unsigned long long mask = __ballot(S >= need);
    const int Lm = mask ? 63 - __builtin_clzll(mask) : 0;
    unsigned cum = S - s; int bsel = 8 * lane; unsigned ab = cum; bool found = false;
#pragma unroll
    for (int i = 7; i >= 0; --i) { if (!found) { if (cum + v[i] >= need) { bsel = 8 * lane + i; ab = cum; found = true; } else cum += v[i]; } }
    bin_out = __builtin_amdgcn_readlane(bsel, Lm); above_out = (unsigned)__builtin_amdgcn_readlane((int)ab, Lm);
}
__device__ __forceinline__ void topk_phase(LAS unsigned char* lds, const GAS bf16* Z, const GAS bf16* KIN, const GAS float* WIF, GAS unsigned short* IDX, int vcu, int G, int lane, int wave) {
    LAS unsigned* hist = (LAS unsigned*)(lds + TK_HIST_OFF) + wave * 4 * (TK_BINS / 2);
    LAS float* csc = (LAS float*)(lds + TK_CSC_OFF) + wave * 4 * TK_CAP;
    LAS unsigned short* cix = (LAS unsigned short*)(lds + TK_CIX_OFF) + wave * 4 * TK_CAP;
    LAS unsigned short* sel = (LAS unsigned short*)(lds + TK_SEL_OFF) + wave * 4 * 256;
    LAS unsigned* cnt = (LAS unsigned*)(lds + TK_CNT_OFF) + wave * 8;
    LAS unsigned* dum = (LAS unsigned*)(lds + TK_DUM_OFF) + wave * 64 + lane;
    const int n = lane & 31, c = lane >> 5;
    const int am = (lane >> 4) & 1, bbm = (lane >> 3) & 1, ccm = (lane >> 2) & 1, dm = lane & 3;
    for (int p2 = vcu; p2 < BATCH * 64; p2 += G) {
#pragma unroll 1
        for (int half = 0; half < 2; ++half) {
            const int b = p2 >> 6, jj = p2 & 63, j = half ? 127 - jj : jj;
            const int t0 = 32 * j + 4 * wave; const size_t rb = (size_t)b * SEQ;
            bf16x8 qa[4];
#pragma unroll
            for (int st = 0; st < 4; ++st) qa[st] = *(const GAS bf16x8*)(Z + (rb + t0 + 2 * ccm + am) * ZLD + ZC_QI + (4 * bbm + dm) * 64 + 16 * st + 8 * c);
            float w0[8], w1[8];
            { const GAS f32x4* wp = (const GAS f32x4*)(WIF + (rb + t0 + 2 * c) * IH); const f32x4 x0 = wp[0], x1 = wp[1], x2 = wp[2], x3 = wp[3];
              w0[0] = x0.x; w0[1] = x0.y; w0[2] = x0.z; w0[3] = x0.w; w0[4] = x1.x; w0[5] = x1.y; w0[6] = x1.z; w0[7] = x1.w;
              w1[0] = x2.x; w1[1] = x2.y; w1[2] = x2.z; w1[3] = x2.w; w1[4] = x3.x; w1[5] = x3.y; w1[6] = x3.z; w1[7] = x3.w; }
            tk_h2 wh[8];
#pragma unroll
            for (int h = 0; h < 8; ++h) { wh[h].x = (_Float16)w0[h]; wh[h].y = (_Float16)w1[h]; }
            float scA, scB;
            { float a = 0.f, bq = 0.f;
#pragma unroll
              for (int h = 0; h < 8; ++h) { a = fmaf(w0[h], w0[h], a); bq = fmaf(w1[h], w1[h], bq); }
              scA = 32.0f / fmaxf(sqrtf(32.0f * a), 1e-20f); scB = 32.0f / fmaxf(sqrtf(32.0f * bq), 1e-20f); }
            const int tA = t0 + 2 * c, tB = tA + 1;
            for (int i = lane; i < 4 * (TK_BINS / 2); i += 64) hist[i] = 0u;
            for (int i = lane; i < 4 * 128; i += 64) ((LAS unsigned*)sel)[i] = 0u;
            if (lane < 8) cnt[lane] = 0u;
            asm volatile("s_waitcnt lgkmcnt(0)" ::: "memory");
            int lo[4], hi[4]; unsigned ab0[4]; bool ov[4];
#pragma unroll
            for (int tk = 0; tk < 4; ++tk) { lo[tk] = 0x7fffffff; hi[tk] = -1; ab0[tk] = 0u; ov[tk] = false; }
            const bool need_sel = (t0 + 3) >= TOPK;
            const GAS bf16* kbase = KIN + (rb + n) * IDIM + 8 * c;
            const int tidk = wave * 64 + lane; const int ng = (j + 2) >> 1;
            const GAS bf16* kg0 = KIN + (rb + (tidk >> 3)) * IDIM + (tidk & 7) * 8; const int koff = (tidk >> 3) * 144 + (tidk & 7) * 16;
            LAS unsigned char* kbuf = lds + TK_KB_OFF; volatile LAS unsigned* sflag = (volatile LAS unsigned*)(lds + TK_FLAG_OFF);
            if (tidk == 0) *sflag = 0u;
#define TK_PRIME() { const v4u kr0 = *(const GAS v4u*)kg0; *(LAS v4u*)(kbuf + koff) = kr0; } __syncthreads();
#define TK_GROUP_BEGIN() \
                v4u kr = {0u, 0u, 0u, 0u}; const bool more = g + 1 < ng; \
                if (more) kr = *(const GAS v4u*)(kg0 + (size_t)(g + 1) * 64 * IDIM); \
                const LAS unsigned char* kb_ = kbuf + (g & 1) * TK_KB_BYTES; \
                float s0v[2], s1v[2];     \
                { f32x16 accv[2]; \
                  _Pragma("unroll") for (int u4 = 0; u4 < 2; ++u4) { _Pragma("unroll") for (int r = 0; r < 16; ++r) accv[u4][r] = 0.f; \
                    _Pragma("unroll") for (int st = 0; st < 4; ++st) { const bf16x8 kf = *(const LAS bf16x8*)(kb_ + (32 * u4 + n) * 144 + (2 * st + c) * 16); accv[u4] = __builtin_amdgcn_mfma_f32_32x32x16_bf16(qa[st], kf, accv[u4], 0, 0, 0); } } \
                  _Pragma("unroll") for (int u4 = 0; u4 < 2; ++u4) tk_score2(accv[u4], wh, s0v[u4], s1v[u4]); } \
                _Pragma("unroll") for (int u4 = 0; u4 < 2; ++u4) { \
                    const float s0 = s0v[u4], s1 = s1v[u4]; const int s = 32 * (2 * g + u4) + n;
#define TK_GROUP_END() } \
                if (more) *(LAS v4u*)(kbuf + ((g + 1) & 1) * TK_KB_BYTES + koff) = kr; \
                __syncthreads();
            bool slow = false;
            if (need_sel) {
                {   TK_PRIME();
#pragma unroll 1
                    for (int g = 0; g < ng; ++g) { TK_GROUP_BEGIN()
                        int b0 = (int)tk_x(s0, scA), b1 = (int)tk_x(s1, scB); b0 = b0 < 0 ? 0 : (b0 > TK_BINS - 1 ? TK_BINS - 1 : b0); b1 = b1 < 0 ? 0 : (b1 > TK_BINS - 1 ? TK_BINS - 1 : b1);
                        LAS unsigned* p0 = (s <= tA) ? &hist[HIST_WORD(2 * c, b0)] : dum; LAS unsigned* p1 = (s <= tB) ? &hist[HIST_WORD(2 * c + 1, b1)] : dum;
                        LDS_ADDV(p0, HIST_INC(b0)); LDS_ADDV(p1, HIST_INC(b1));
                        TK_GROUP_END() }
                }
                asm volatile("s_waitcnt lgkmcnt(0)" ::: "memory");
#pragma unroll
                for (int tk = 0; tk < 4; ++tk) { int bin; unsigned above; tk_find(hist + tk * (TK_BINS / 2), (unsigned)TOPK, lane, bin, above);
                    const unsigned ceq = (hist[HIST_WORD(tk, bin)] >> ((bin & 1) * 16)) & 0xffffu; ov[tk] = ceq > (unsigned)TK_CAP; slow |= ov[tk]; ab0[tk] = above; lo[tk] = bin * 512; hi[tk] = bin * 512 + 511; }
                if (slow && lane == 0) *sflag = 1u;
                __syncthreads();
                slow = *sflag != 0u;
            }
            if (!slow) {
                float thi[4], tlo[4];
#pragma unroll
                for (int tk = 0; tk < 4; ++tk) { const int bin = lo[tk] >> 9;
                    thi[tk] = !need_sel ? -__builtin_inff() : (bin >= TK_BINS - 1 ? __builtin_inff() : (float)(bin + 1));
                    tlo[tk] = !need_sel ? __builtin_inff() : (bin == 0 ? -__builtin_inff() : (float)bin); }
                const float thiA = c ? thi[2] : thi[0], tloA = c ? tlo[2] : tlo[0], thiB = c ? thi[3] : thi[1], tloB = c ? tlo[3] : tlo[1];
                unsigned cntA = 0u, cntB = 0u;
                LAS unsigned short* selA = sel + (2 * c) * 256; LAS unsigned short* selB = sel + (2 * c + 1) * 256; LAS unsigned short* dum16 = (LAS unsigned short*)dum;
                TK_PRIME();
#pragma unroll 1
                for (int g = 0; g < ng; ++g) { TK_GROUP_BEGIN()
                    const float x0 = (s <= tA) ? tk_x(s0, scA) : __builtin_nanf(""), x1 = (s <= tB) ? tk_x(s1, scB) : __builtin_nanf("");
                    const bool a0 = x0 >= thiA, a1 = x1 >= thiB; const bool c0 = !a0 && x0 >= tloA, c1 = !a1 && x1 >= tloB;
                    const unsigned long long m0 = __ballot(a0), m1 = __ballot(a1);
                    const unsigned pre0 = c ? __builtin_amdgcn_mbcnt_hi((unsigned)(m0 >> 32), 0u) : __builtin_amdgcn_mbcnt_lo((unsigned)m0, 0u);
                    const unsigned pre1 = c ? __builtin_amdgcn_mbcnt_hi((unsigned)(m1 >> 32), 0u) : __builtin_amdgcn_mbcnt_lo((unsigned)m1, 0u);
                    const unsigned pos0 = cntA + pre0, pos1 = cntB + pre1;
                    LAS unsigned short* q0 = (a0 && pos0 < 256u) ? selA + pos0 : dum16; LAS unsigned short* q1 = (a1 && pos1 < 256u) ? selB + pos1 : dum16;
                    *q0 = (unsigned short)s; *q1 = (unsigned short)s;
                    cntA += c ? (unsigned)__builtin_popcount((unsigned)(m0 >> 32)) : (unsigned)__builtin_popcount((unsigned)m0);
                    cntB += c ? (unsigned)__builtin_popcount((unsigned)(m1 >> 32)) : (unsigned)__builtin_popcount((unsigned)m1);
                    if (__ballot(c0 || c1)) {
                        if (c0) { const unsigned pos = LDS_ADD(&cnt[(2 * c) * 2 + 1]); if (pos < (unsigned)TK_CAP) { csc[(2 * c) * TK_CAP + pos] = s0; cix[(2 * c) * TK_CAP + pos] = (unsigned short)s; } }
                        if (c1) { const unsigned pos = LDS_ADD(&cnt[(2 * c + 1) * 2 + 1]); if (pos < (unsigned)TK_CAP) { csc[(2 * c + 1) * TK_CAP + pos] = s1; cix[(2 * c + 1) * TK_CAP + pos] = (unsigned short)s; } } }
                    TK_GROUP_END() }
                if ((lane & 31) == 0) { cnt[(2 * c) * 2] = cntA; cnt[(2 * c + 1) * 2] = cntB; }
                asm volatile("s_waitcnt lgkmcnt(0)" ::: "memory");
            } else {
                for (int i = lane; i < 4 * (TK_BINS / 2); i += 64) hist[i] = 0u;
                asm volatile("s_waitcnt lgkmcnt(0)" ::: "memory");
                int mode = 1;
#pragma unroll 1
                for (;;) {
                const int klo0 = c ? lo[2] : lo[0], khi0 = c ? hi[2] : hi[0], klo1 = c ? lo[3] : lo[1], khi1 = c ? hi[3] : hi[1];
                const bool ov0 = c ? ov[2] : ov[0], ov1 = c ? ov[3] : ov[1];
                bf16x8 kb[4][4];
#pragma unroll
                for (int u4 = 0; u4 < 4; ++u4) { const int kq = u4 < j ? u4 : j;
#pragma unroll
                    for (int st = 0; st < 4; ++st) kb[u4][st] = *(const GAS bf16x8*)(kbase + (size_t)kq * 32 * IDIM + 16 * st); }
#pragma unroll 1
                for (int kt = 0; kt <= j; kt += 4) {
                    bf16x8 kn[4][4];
#pragma unroll
                    for (int u4 = 0; u4 < 4; ++u4) { const int kq = kt + 4 + u4 < j ? kt + 4 + u4 : j;
#pragma unroll
                        for (int st = 0; st < 4; ++st) kn[u4][st] = *(const GAS bf16x8*)(kbase + (size_t)kq * 32 * IDIM + 16 * st); }
#pragma unroll
                    for (int u4 = 0; u4 < 4; ++u4) {
                        f32x16 acc;
#pragma unroll
                        for (int r = 0; r < 16; ++r) acc[r] = 0.f;
#pragma unroll
                        for (int st = 0; st < 4; ++st) acc = __builtin_amdgcn_mfma_f32_32x32x16_bf16(qa[st], kb[u4][st], acc, 0, 0, 0);
                        float s0, s1; tk_score2(acc, wh, s0, s1);
                        const int s = 32 * (kt + u4) + n; const int k0 = tk_key(s0, scA), k1 = tk_key(s1, scB);
                        const bool v0 = s <= tA, v1 = s <= tB;
                        if (mode == 0) {
                            if (v0 && tA >= TOPK) LDS_ADDV(&hist[HIST_WORD(2 * c, k0 >> 9)], HIST_INC(k0 >> 9));
                            if (v1 && tB >= TOPK) LDS_ADDV(&hist[HIST_WORD(2 * c + 1, k1 >> 9)], HIST_INC(k1 >> 9));
                        } else if (mode == 1) {
                            if (v0 && ov0 && k0 >= klo0 && k0 <= khi0) LDS_ADDV(&hist[HIST_WORD(2 * c, k0 & 511)], HIST_INC(k0 & 511));
                            if (v1 && ov1 && k1 >= klo1 && k1 <= khi1) LDS_ADDV(&hist[HIST_WORD(2 * c + 1, k1 & 511)], HIST_INC(k1 & 511));
                        } else {
                            if (v0) { if (k0 > khi0) { const unsigned pos = LDS_ADD(&cnt[(2 * c) * 2]); if (pos < 256u) sel[(2 * c) * 256 + pos] = (unsigned short)s; }
                                      else if (k0 >= klo0) { const unsigned pos = LDS_ADD(&cnt[(2 * c) * 2 + 1]); if (pos < (unsigned)TK_CAP) { csc[(2 * c) * TK_CAP + pos] = s0; cix[(2 * c) * TK_CAP + pos] = (unsigned short)s; } } }
                            if (v1) { if (k1 > khi1) { const unsigned pos = LDS_ADD(&cnt[(2 * c + 1) * 2]); if (pos < 256u) sel[(2 * c + 1) * 256 + pos] = (unsigned short)s; }
                                      else if (k1 >= klo1) { const unsigned pos = LDS_ADD(&cnt[(2 * c + 1) * 2 + 1]); if (pos < (unsigned)TK_CAP) { csc[(2 * c + 1) * TK_CAP + pos] = s1; cix[(2 * c + 1) * TK_CAP + pos] = (unsigned short)s; } } }
                        }
                    }
#pragma unroll
                    for (int u4 = 0; u4 < 4; ++u4)
#pragma unroll
                        for (int st = 0; st < 4; ++st) kb[u4][st] = kn[u4][st];
                }
                    asm volatile("s_waitcnt lgkmcnt(0)" ::: "memory");
                    if (mode == 2) break;
#pragma unroll
                    for (int tk = 0; tk < 4; ++tk) if (ov[tk]) { int sub; unsigned above; tk_find(hist + tk * (TK_BINS / 2), (unsigned)TOPK - ab0[tk], lane, sub, above); lo[tk] += sub; hi[tk] = lo[tk]; }
                    mode = 2;
                }
            }
#undef TK_GROUP_BEGIN
#undef TK_GROUP_END
#undef TK_PRIME
#pragma unroll 1
            for (int tk = 0; tk < 4; ++tk) { const int t = t0 + tk;
                if (t >= TOPK) { const unsigned nsel = cnt[tk * 2]; unsigned nc = cnt[tk * 2 + 1]; nc = nc > (unsigned)TK_CAP ? (unsigned)TK_CAP : nc; const unsigned need = nsel < 256u ? 256u - nsel : 0u;
                    for (unsigned q = 0; q * 64 < nc; ++q) { const unsigned i = lane + 64 * q;
                        const float si = i < nc ? csc[tk * TK_CAP + i] : 0.f; const unsigned xi = i < nc ? cix[tk * TK_CAP + i] : 0u; unsigned rank = 0;
                        for (unsigned jx = 0; jx < nc; ++jx) { const float sj = csc[tk * TK_CAP + jx]; const unsigned xj = cix[tk * TK_CAP + jx]; rank += (sj > si || (sj == si && xj < xi)) ? 1u : 0u; }
                        if (i < nc && rank < need) sel[tk * 256 + nsel + rank] = (unsigned short)xi; } } }
            asm volatile("s_waitcnt lgkmcnt(0)" ::: "memory");
            { const LAS v4u* sv = (const LAS v4u*)sel; GAS v4u* ov = (GAS v4u*)(IDX + (rb + t0) * TOPK);
              ov[lane] = sv[lane]; ov[lane + 64] = sv[lane + 64]; }
            asm volatile("s_waitcnt vmcnt(0) lgkmcnt(0)" ::: "memory");
        }
    }
}
constexpr int DSA_TAB_OFF = RING_BYTES + 1024;
static_assert(DSA_TAB_OFF + 8 * 129 * 4 <= LDS_BYTES, "DSA LDS map");
__device__ __forceinline__ void dsa_phase(LAS unsigned char* lds_all, const GAS bf16* Z, const GAS bf16* CKVN, const GAS unsigned short* IDX, GAS bf16* O, const GAS float* rel_bias, int gw, int NGW, int tid, int lane, int wave) {
    LAS float* tab = (LAS float*)(lds_all + DSA_TAB_OFF);
    for (int e = tid; e < 8 * 129; e += NWAVES * 64) { const int hh = e / 129, dist = e - hh * 129; tab[e] = rel_bias[(dist < 128 ? (int)T5_BUCKET[dist] : 31) * 24 + hh]; }
    __syncthreads();
    LAS unsigned char* img = lds_all + RING_OFF + wave * 16384;
    const unsigned imgb = (unsigned)(size_t)img;
    const int h = lane & 15, g = lane >> 4;
    const LAS float* tabh = tab + (h & 7) * 129;
    const int TPW = (M + NGW - 1) / NGW;
    const int tok_end = (gw + 1) * TPW < M ? (gw + 1) * TPW : M;
    const int xq = 2 * (lane & 7);
    const int qk_off = (lane & 15) * 512;
    const int q4 = (lane & 15) >> 2, p4 = lane & 3; const int xr = 2 * (4 * (g & 1) + q4);
    const unsigned pv_base = imgb + (unsigned)((4 * g + q4) * 512 + 8 * (p4 & 1));
#pragma unroll 1
    for (int tok = gw * TPW; tok < tok_end; ++tok) {
        const int t = tok & (SEQ - 1); const size_t rb = (size_t)(tok - t);
        const int nsel = t + 1 < TOPK ? t + 1 : TOPK;
        bf16x8 qf[8];
#pragma unroll
        for (int st = 0; st < 8; ++st) { qf[st] = *(const GAS bf16x8*)(Z + (size_t)tok * ZLD + ZC_QLAT + (h & 7) * 256 + 32 * st + 8 * g); if (h >= 8) qf[st] = (bf16x8){0, 0, 0, 0, 0, 0, 0, 0}; }
        f32x4 oacc[16];
#pragma unroll
        for (int rt = 0; rt < 16; ++rt) oacc[rt] = (f32x4){0.f, 0.f, 0.f, 0.f};
        float mrun = -1e30f, lsum = 0.f;
        const GAS unsigned short* ip = IDX + (size_t)tok * TOPK;
#pragma unroll 1
        for (int ch = 0; ch < 8; ++ch) {
            if (32 * ch >= nsel) break;
            const int ixv = (int)ip[32 * ch + (lane & 31)];
            const unsigned long long i0 = *(const GAS unsigned long long*)(ip + 32 * ch + 4 * g), i1 = *(const GAS unsigned long long*)(ip + 32 * ch + 16 + 4 * g);
            asm volatile("s_waitcnt lgkmcnt(0)" ::: "memory");
#pragma unroll
            for (int i = 0; i < 16; ++i) { const int r0 = __builtin_amdgcn_readlane(ixv, 2 * i), r1 = __builtin_amdgcn_readlane(ixv, 2 * i + 1);
                const int row = 2 * i + (lane >> 5); const int ridx = lane < 32 ? r0 : r1; const int chunk = (lane & 31) ^ (2 * (row & 7));
                const GAS unsigned char* src = (const GAS unsigned char*)(CKVN + (rb + ridx) * RANK) + chunk * 16;
                __builtin_amdgcn_global_load_lds((const GAS unsigned*)src, (LAS unsigned*)(img + i * 1024), 16, 0, 0); }
            asm volatile("s_waitcnt vmcnt(0)" ::: "memory");
            f32x4 sa[2];
#pragma unroll
            for (int tl = 0; tl < 2; ++tl) { sa[tl] = (f32x4){0.f, 0.f, 0.f, 0.f};
#pragma unroll
                for (int st = 0; st < 8; ++st) { const bf16x8 a = *(const LAS bf16x8*)(img + qk_off + tl * 16 * 512 + (((4 * st + g) ^ xq) * 16));
                    sa[tl] = __builtin_amdgcn_mfma_f32_16x16x32_bf16(a, qf[st], sa[tl], 0, 0, 0); } }
            float lg[8]; float cmax = -1e30f;
#pragma unroll
            for (int e = 0; e < 8; ++e) { const int tl = e >> 2, jx = e & 3; const int kk = 32 * ch + 16 * tl + 4 * g + jx;
                const int sidx = (int)(((tl ? i1 : i0) >> (16 * jx)) & 0xffffull); int dd = t - sidx; dd = dd < 0 ? 0 : (dd > 128 ? 128 : dd);
                const float v = kk < nsel ? sa[tl][jx] + tabh[dd] : -1e30f; lg[e] = v; cmax = fmaxf(cmax, v); }
            cmax = fmaxf(cmax, SHX(cmax, 16)); cmax = fmaxf(cmax, SHX(cmax, 32));
            const float mnew = fmaxf(mrun, cmax);
            if (__any(mnew > mrun)) { const float alpha = __expf(mrun - mnew); lsum *= alpha;
#pragma unroll
                for (int rt = 0; rt < 16; ++rt) oacc[rt] = oacc[rt] * alpha; }
            mrun = mnew;
            float pe[8];
#pragma unroll
            for (int e = 0; e < 8; ++e) { pe[e] = __expf(lg[e] - mnew); lsum += pe[e]; }
            bf16x8 pf; { const v4u wv = {pg8::cvt_pk_bf16(pe[0], pe[1]), pg8::cvt_pk_bf16(pe[2], pe[3]), pg8::cvt_pk_bf16(pe[4], pe[5]), pg8::cvt_pk_bf16(pe[6], pe[7])}; pf = __builtin_bit_cast(bf16x8, wv); }
#pragma unroll
            for (int rt = 0; rt < 16; rt += 2) {
                const unsigned a0 = pv_base + (unsigned)((((2 * rt) ^ xr) | (p4 >> 1)) * 16), a1 = pv_base + (unsigned)((((2 * rt + 2) ^ xr) | (p4 >> 1)) * 16);
                s16x4 r0, r1, r2, r3; tr_read4(a0, a0 + 16 * 512, a1, a1 + 16 * 512, r0, r1, r2, r3);
                oacc[rt] = __builtin_amdgcn_mfma_f32_16x16x32_bf16(cat4(r0, r1), pf, oacc[rt], 0, 0, 0);
                oacc[rt + 1] = __builtin_amdgcn_mfma_f32_16x16x32_bf16(cat4(r2, r3), pf, oacc[rt + 1], 0, 0, 0); }
        }
        lsum += SHX(lsum, 16); lsum += SHX(lsum, 32);
        const float inv = (OUT_F8 ? O8_SCALE : 1.0f) / lsum;
        if (h < 8) {
            if constexpr (OUT_F8) { GAS unsigned char* orow = (GAS unsigned char*)O + (size_t)tok * OLD + h * 256 + 4 * g;
#pragma unroll
                for (int rt = 0; rt < 16; ++rt) { int p = 0; p = __builtin_amdgcn_cvt_pk_fp8_f32(oacc[rt][0] * inv, oacc[rt][1] * inv, p, false); p = __builtin_amdgcn_cvt_pk_fp8_f32(oacc[rt][2] * inv, oacc[rt][3] * inv, p, true); *(GAS unsigned*)(orow + 16 * rt) = (unsigned)p; } }
            else { GAS bf16* orow = O + (size_t)tok * OLD + h * 256 + 4 * g;
#pragma unroll
            for (int rt = 0; rt < 16; ++rt) *(GAS unsigned long long*)(orow + 16 * rt) = (unsigned long long)pk2(oacc[rt][0] * inv, oacc[rt][1] * inv) | ((unsigned long long)pk2(oacc[rt][2] * inv, oacc[rt][3] * inv) << 32); } }
    }
}
struct Args { const float* in[20]; float* out; unsigned char* ws; };
__device__ __forceinline__ unsigned long long karg_u64(int idx) { unsigned long long r; const unsigned off = (unsigned)idx * 8u;
    asm volatile("s_load_dwordx2 %0, %1, %2\n\ts_waitcnt lgkmcnt(0)" : "=s"(r) : "s"(__builtin_amdgcn_kernarg_segment_ptr()), "s"(off) : "memory"); return r; }
__device__ __forceinline__ const GAS float* karg_in(int i) { return (const GAS float*)karg_u64(i); }
__device__ __forceinline__ GAS float* karg_out() { return (GAS float*)karg_u64(20); }
__device__ __forceinline__ GAS unsigned char* karg_ws() { return (GAS unsigned char*)karg_u64(21); }
#ifndef REP_P0
#define REP_P0 1
#endif
#ifndef REP_NORM
#define REP_NORM 1
#endif
#ifndef REP_GU
#define REP_GU 1
#endif
#ifndef REP_IN
#define REP_IN 1
#endif
#ifndef REP_POST
#define REP_POST 1
#endif
#ifndef REP_TOPK
#define REP_TOPK 1
#endif
#ifndef REP_DSA
#define REP_DSA 1
#endif
#define REPEAT(n) _Pragma("unroll 1") for (int rep_ = 0; rep_ < (n); ++rep_)
#define PHASE_IDS() int wave = wave0; asm volatile("" : "+s"(wave)); int lane; asm volatile("v_mbcnt_lo_u32_b32 %0, -1, 0\n\tv_mbcnt_hi_u32_b32 %0, -1, %0" : "=v"(lane)); const int tid = wave * 64 + lane; int bx = blockIdx.x; asm volatile("" : "+s"(bx)); int G = gridDim.x; asm volatile("" : "+s"(G)); \
    const int vcu = (G % 8 == 0) ? (bx % 8) * (G / 8) + bx / 8 : bx; const int gw = vcu * NWAVES + wave, NGW = G * NWAVES; \
    GAS unsigned char* ws = karg_ws(); (void)lane; (void)gw; (void)NGW; (void)vcu; (void)ws
__global__ void __launch_bounds__(NWAVES * 64, 2) mk_fwd(Args args) {
    extern __shared__ __attribute__((aligned(16))) unsigned char lds_raw[];
    LAS unsigned char* lds = (LAS unsigned char*)lds_raw;
    volatile LAS unsigned* MISC = (volatile LAS unsigned*)(lds + MISC_OFF);
    const int wave0 = __builtin_amdgcn_readfirstlane(threadIdx.x >> 6);
    for (int u = threadIdx.x; u < (LDS_BYTES - LDSCTL_OFF) / 4; u += NWAVES * 64) ((LAS unsigned*)(lds + LDSCTL_OFF))[u] = 0u;
    __syncthreads();
    (void)xcd_barrier_post((unsigned*)((gu32*)(karg_ws() + WS_CTL) + CW_BAR), MISC + 8, threadIdx.x == 0);
#define GRID_BAR() do { XcdBarrier b_; b_.bar = (unsigned*)((gu32*)(karg_ws() + WS_CTL) + CW_BAR); b_.x = xb_xcc_id(); b_.st = MISC + 8; int w_ = wave0; asm volatile("" : "+s"(w_)); int l_; asm volatile("v_mbcnt_lo_u32_b32 %0, -1, 0\n\tv_mbcnt_hi_u32_b32 %0, -1, %0" : "=v"(l_)); xcd_barrier(b_, (w_ | l_) == 0); } while (0)

    REPEAT(REP_P0) {   PHASE_IDS();
        LAS float* scr = (LAS float*)(lds + RING_OFF + wave * 16384);
        rows_bf16_ss(karg_in(0), (GAS bf16*)(ws + WS_XN), f8_on(0, 0) ? (GAS unsigned char*)(ws + WS_HB8) : (GAS unsigned char*)nullptr, (GAS float*)(ws + WS_SS), gw, NGW, lane);
        constexpr int I_GU = (D / 64) * (FF / 32), I_DN = (FF / 64) * (D / 32);
        constexpr int I_FFN = 2 * I_GU + I_DN, I_IN = 72 * (D / 64), I_OB = (1024 / 64) * (D / 32);
        constexpr int PER_LAYER = 2 * I_FFN + I_IN + I_OB;
        for (int it = gw; it < DEPTH * PER_LAYER; it += NGW) {
            const int l = it / PER_LAYER; int r = it - l * PER_LAYER;
            GAS unsigned char* wl = ws + WS_W0 + (size_t)l * W_LAYER;
            if (r < 2 * I_FFN) {
                const int f = r / I_FFN; r -= f * I_FFN;
                GAS bf16* dgu = (GAS bf16*)(wl + (f ? WO_GU2 : WO_GU1)); GAS bf16* dd = (GAS bf16*)(wl + (f ? WO_D2 : WO_D1));
                if (r < 2 * I_GU) { const int up = r >= I_GU; if (up) r -= I_GU; const int kb = r / (FF / 32), nb = r % (FF / 32), n0 = 32 * nb;
                    const GAS float* wsrc = karg_in(up ? (f ? 17 : 4) : (f ? 16 : 3)) + (size_t)l * D * FF;
                    const int drow = (n0 >> 7) * 256 + (up ? 128 : 0) + (n0 & 127);
                    if (f8_on(l, f)) conv_item<true>(wsrc, FF, 64 * kb, n0, 32, dgu, D, drow, 0, W8_SCALE, karg_in(f ? 15 : 2) + (size_t)l * D, scr, lane);
                    else conv_item(wsrc, FF, 64 * kb, n0, 32, dgu, D, drow, 0, 1.0f, karg_in(f ? 15 : 2) + (size_t)l * D, scr, lane); }
                else { r -= 2 * I_GU; const int kb = r / (D / 32), nb = r % (D / 32);
                    if (d8_on(l, f)) conv_item<true>(karg_in(f ? 18 : 5) + (size_t)l * FF * D, D, 64 * kb, 32 * nb, 32, dd, FF, 32 * nb, 0, W8_SCALE, nullptr, scr, lane);
                    else conv_item(karg_in(f ? 18 : 5) + (size_t)l * FF * D, D, 64 * kb, 32 * nb, 32, dd, FF, 32 * nb, 0, 1.0f, nullptr, scr, lane); }
            } else if (r < 2 * I_FFN + I_IN) {
                r -= 2 * I_FFN; const int j = r >> 5, kb = r & 31; int src, nvalid = 32; float sc = 1.0f;
                if (j < 8) src = 1024 + 32 * j;
                else if (j < 24) src = 1280 + 32 * (j - 8);
                else if (j < 56) { src = 1864 + 32 * (j - 24); sc = 0.125f; }
                else if (j < 60) src = 2888 + 32 * (j - 56);
                else if (j < 64) src = 3016 + 32 * (j - 60);
                else if (j < 66) src = 1792 + 32 * (j - 64);
                else if (j == 66) { src = 1856; nvalid = 8; sc = 0.044194173824159216f; }
                else { src = 0; nvalid = 0; }
                conv_item(karg_in(7) + (size_t)l * D * D_IN, D_IN, 64 * kb, src, nvalid, (GAS bf16*)(wl + WO_IN), D, 2048 + 32 * j, 0, sc, karg_in(6) + (size_t)l * D, scr, lane);
            } else {
                r -= 2 * I_FFN + I_IN; const int kb = r >> 6, nb = r & 63;
                if constexpr (OUT_F8) conv_item<true>(karg_in(14) + (size_t)l * D * D + (size_t)1024 * D, D, 64 * kb, 32 * nb, 32, (GAS bf16*)(wl + WO_OUT), OLD, 32 * nb, 2048, W8_SCALE, nullptr, scr, lane);
                else conv_item(karg_in(14) + (size_t)l * D * D + (size_t)1024 * D, D, 64 * kb, 32 * nb, 32, (GAS bf16*)(wl + WO_OUT), OLD, 32 * nb, 2048, 1.0f, nullptr, scr, lane);
            }
        }
        __syncthreads();
        LAS float* Ps = (LAS float*)(lds + RING_OFF); LAS float* Qs = Ps + 64 * 129;
        for (int u = vcu; u < DEPTH * 2048; u += G) {
            const int l = u >> 11, which = (u >> 10) & 1, v = u & 1023;
            GAS unsigned char* wl = ws + WS_W0 + (size_t)l * W_LAYER;
            if (which == 0) { const int h = v >> 7, rt = (v >> 5) & 3, kt = v & 31;
                absorb_unit<false>(karg_in(11) + (size_t)l * RANK * 1024 + ((size_t)(64 * rt) * 8 + h) * 128, 1024, 1, karg_in(7) + (size_t)l * D * D_IN + (size_t)(64 * kt) * D_IN + h * 128, D_IN,
                                   (GAS bf16*)(wl + WO_IN) + (size_t)(h * 256 + 64 * rt) * D + 64 * kt, D, 0.08838834764831845f, karg_in(6) + (size_t)l * D + 64 * kt, Ps, Qs, tid); }
            else { const int h = v >> 7, nt = (v >> 2) & 31, rt = v & 3;
                if constexpr (OUT_F8) absorb_unit<true, true>(karg_in(14) + (size_t)l * D * D + (size_t)(h * 128) * D + 64 * nt, 1, D, karg_in(12) + (size_t)l * RANK * 1024 + ((size_t)(64 * rt) * 8 + h) * 128, 1024,
                                  (GAS bf16*)((GAS unsigned char*)(wl + WO_OUT) + (size_t)(64 * nt) * OLD + h * 256 + 64 * rt), OLD, W8_SCALE, nullptr, Ps, Qs, tid);
                else absorb_unit<true>(karg_in(14) + (size_t)l * D * D + (size_t)(h * 128) * D + 64 * nt, 1, D, karg_in(12) + (size_t)l * RANK * 1024 + ((size_t)(64 * rt) * 8 + h) * 128, 1024,
                                  (GAS bf16*)(wl + WO_OUT) + (size_t)(64 * nt) * OLD + h * 256 + 64 * rt, OLD, 1.0f, nullptr, Ps, Qs, tid); }
        }
    }
    GRID_BAR();

#pragma unroll 1
    for (int s = 0; s < 2 * DEPTH; ++s) {
        const int l = s >> 1, f = s & 1;
        REPEAT(REP_GU) {   PHASE_IDS(); GAS unsigned char* wl = ws + WS_W0 + (size_t)l * W_LAYER;
            pg8::StaticOrder S; S.init(M, NGU, G, bx);
            const GAS float* ssp = (const GAS float*)(ws + WS_SS + (size_t)((3 * l + 2 * f) & 1) * SS_BYTES);
            if ((F8_MASK == 0xF) || (F8_MASK != 0 && f8_on(l, f))) {
                if constexpr (F8_MASK != 0) {
                    pg8::Gemm g{(const GAS bf16*)(ws + WS_HB8), (const GAS bf16*)(wl + (f ? WO_GU2 : WO_GU1)), M, NGU, D / 2};
                    pg8::EpiSwiglu E{(GAS bf16*)(ws + WS_ACT), FF, ssp, 1.0f / D, EPS, 1.0f / W8_SCALE, d8_on(l, f) ? A8_SCALE : 0.f};
                    pg8::gemm_phase<pg8::EpiSwiglu, pg8::StaticOrder, true, true, true>(lds + RING_OFF, g, S, E, tid); }
            } else {
                if constexpr (F8_MASK != 0xF) {
                    pg8::Gemm g{(const GAS bf16*)(ws + WS_XN), (const GAS bf16*)(wl + (f ? WO_GU2 : WO_GU1)), M, NGU, D};
                    pg8::EpiSwiglu E{(GAS bf16*)(ws + WS_ACT), FF, ssp, 1.0f / D, EPS, 1.0f, d8_on(l, f) ? A8_SCALE : 0.f};
                    pg8::gemm_phase<pg8::EpiSwiglu, pg8::StaticOrder, true, true, false>(lds + RING_OFF, g, S, E, tid); }
            } }
        GRID_BAR();
        {   PHASE_IDS(); GAS unsigned char* wl = ws + WS_W0 + (size_t)l * W_LAYER;
            pg8::StaticOrder S; S.init(M, D, G, bx);
            const unsigned sso = (unsigned)(WS_SS + (size_t)((3 * l + 2 * f + 1) & 1) * SS_BYTES), h8o = (f == 1 && l + 1 < DEPTH && f8_on(l + 1, 0)) ? (unsigned)WS_HB8 : 0u;
            if ((D8_MASK == 0xF) || (D8_MASK != 0 && d8_on(l, f))) {
                if constexpr (D8_MASK != 0) {
                    pg8::Gemm g{(const GAS bf16*)(ws + WS_ACT), (const GAS bf16*)(wl + (f ? WO_D2 : WO_D1)), M, D, FF / 2};
                    pg8::EpiResid E{0.5f / (W8_SCALE * A8_SCALE), (unsigned)WS_XN, sso, h8o};
                    pg8::gemm_phase<pg8::EpiResid, pg8::StaticOrder, true, true, true>(lds + RING_OFF, g, S, E, tid); }
            } else {
                if constexpr (D8_MASK != 0xF) {
                    pg8::Gemm g{(const GAS bf16*)(ws + WS_ACT), (const GAS bf16*)(wl + (f ? WO_D2 : WO_D1)), M, D, FF};
                    pg8::EpiResid E{0.5f, (unsigned)WS_XN, sso, h8o};
                    pg8::gemm_phase<pg8::EpiResid, pg8::StaticOrder, true, true, false>(lds + RING_OFF, g, S, E, tid); }
            } }
        GRID_BAR();
        if (f == 0) {
            REPEAT(REP_IN) {   PHASE_IDS(); GAS unsigned char* wl = ws + WS_W0 + (size_t)l * W_LAYER;
                pg8::Gemm g{(const GAS bf16*)(ws + WS_XN), (const GAS bf16*)(wl + WO_IN), M, ZLD, D}; pg8::StaticOrder S; S.init(M, ZLD, G, bx);
                pg8::EpiBf16 E{(GAS bf16*)(ws + WS_Z), ZLD, (const GAS float*)(ws + WS_SS + (size_t)((3 * l + 1) & 1) * SS_BYTES), 1.0f / D, EPS};
                pg8::gemm_phase<pg8::EpiBf16, pg8::StaticOrder, true, true>(lds + RING_OFF, g, S, E, tid); }
            GRID_BAR();
            REPEAT(REP_POST) {   PHASE_IDS();
                post_rows((const GAS bf16*)(ws + WS_Z), karg_in(8) + (size_t)l * RANK, karg_in(9) + (size_t)l * IDIM, karg_in(10) + (size_t)l * IDIM, (GAS bf16*)(ws + WS_CKVN), (GAS bf16*)(ws + WS_KIN), (GAS float*)(ws + WS_WIF), gw, NGW, lane);
                swa_phase(lds + RING_OFF, (const GAS bf16*)(ws + WS_Z), (GAS bf16*)(ws + WS_O), karg_in(1), karg_in(13) + (size_t)l * H_B, vcu, G, tid, lane, wave);
            }
            GRID_BAR();
            REPEAT(REP_TOPK) {   PHASE_IDS(); topk_phase(lds + RING_OFF, (const GAS bf16*)(ws + WS_Z), (const GAS bf16*)(ws + WS_KIN), (const GAS float*)(ws + WS_WIF), (GAS unsigned short*)(ws + WS_IDX), vcu, G, lane, wave); }
            GRID_BAR();
            REPEAT(REP_DSA) {   PHASE_IDS(); dsa_phase(lds, (const GAS bf16*)(ws + WS_Z), (const GAS bf16*)(ws + WS_CKVN), (const GAS unsigned short*)(ws + WS_IDX), (GAS bf16*)(ws + WS_O), karg_in(1), gw, NGW, tid, lane, wave); }
            GRID_BAR();
            {   PHASE_IDS(); GAS unsigned char* wl = ws + WS_W0 + (size_t)l * W_LAYER;
                pg8::Gemm g{(const GAS bf16*)(ws + WS_O), (const GAS bf16*)(wl + WO_OUT), M, D, OUT_F8 ? OLD / 2 : OLD}; pg8::StaticOrder S; S.init(M, D, G, bx);
                pg8::EpiResid E{OUT_F8 ? 1.0f / (W8_SCALE * O8_SCALE) : 1.0f, (unsigned)WS_XN, (unsigned)(WS_SS + (size_t)((3 * l + 2) & 1) * SS_BYTES), f8_on(l, 1) ? (unsigned)WS_HB8 : 0u};
                pg8::gemm_phase<pg8::EpiResid, pg8::StaticOrder, true, true, OUT_F8 != 0>(lds + RING_OFF, g, S, E, tid); }
            GRID_BAR();
        }
    }
    {   PHASE_IDS(); final_rows((const GAS bf16*)(ws + WS_XN), karg_out(), karg_in(19), (const GAS float*)(ws + WS_SS + (size_t)(6 & 1) * SS_BYTES), gw, NGW, lane); }
}

extern "C" void kernel_launch(void* const* d_in, const int* in_sizes, int n_in, void* d_out, int out_size, void* d_ws, size_t ws_size, hipStream_t stream) {
    static int grid = 0;
    if (grid == 0) {
        if (n_in != 20 || in_sizes[0] != M * D || out_size != M * D || ws_size < WS_END) { fprintf(stderr, "kernel_launch: unexpected shapes (n_in %d, in0 %d, out %d, ws %zu); nothing launched\n", n_in, n_in > 0 ? in_sizes[0] : -1, out_size, ws_size); grid = -1; return; }
        int dev = 0, cus = 0, per_cu = 0;
        if (hipGetDevice(&dev) != hipSuccess || hipDeviceGetAttribute(&cus, hipDeviceAttributeMultiprocessorCount, dev) != hipSuccess) { grid = -1; return; }
        if (hipFuncSetAttribute((const void*)mk_fwd, hipFuncAttributeMaxDynamicSharedMemorySize, LDS_BYTES) != hipSuccess) { fprintf(stderr, "kernel_launch: hipFuncSetAttribute failed\n"); grid = -1; return; }
        if (hipOccupancyMaxActiveBlocksPerMultiprocessor(&per_cu, (const void*)mk_fwd, NWAVES * 64, LDS_BYTES) != hipSuccess || per_cu < 1) { fprintf(stderr, "kernel_launch: occupancy query reports %d workgroups per CU\n", per_cu); }
        (void)hipGetLastError();
        grid = cus;
    }
    if (grid < 0) return;
    if (hipMemsetAsync((char*)d_ws + WS_CTL, 0, CTL_ZERO_BYTES, stream) != hipSuccess) return;
    Args a{};
    for (int i = 0; i < 20; ++i) a.in[i] = (const float*)d_in[i];
    a.out = (float*)d_out; a.ws = (unsigned char*)d_ws;
    hipLaunchKernelGGL(mk_fwd, dim3(grid), dim3(NWAVES * 64), LDS_BYTES, stream, a);
}
```

```cpp
#define F8_MASK 0xF
#define D8_MASK 0xA
#include <hip/hip_runtime.h>
#include <cstdio>
#include <cstdint>
namespace pg8 {
#define PG8_LAS __attribute__((address_space(3)))
#define PG8_GAS __attribute__((address_space(1)))
typedef unsigned short bf16_t;
typedef short bf16x8 __attribute__((ext_vector_type(8)));
typedef float f32x4 __attribute__((ext_vector_type(4)));
typedef unsigned u32x4 __attribute__((ext_vector_type(4)));
constexpr int BM = 256, BK = 64, HALF = 128, HTB = HALF * BK * 2  , STAGE_BYTES = 8 * HTB, NXCD = 8, WGM = 8;

__host__ __device__ __forceinline__ int lds_byte(int r, int c) { const int st = (r >> 4) * 2 + (c >> 5), rr = r & 15, cc = c & 31, ob = rr * 64 + cc * 2; return st * 1024 + (ob ^ (((ob >> 9) & 1) << 5)); }
__host__ __device__ __forceinline__ void stage_rc(int b, int& R, int& C) { const int st = b / 1024, sb = b % 1024, swz = sb ^ (((sb >> 9) & 1) << 5); R = (st >> 1) * 16 + swz / 64; C = (st & 1) * 32 + (swz % 64) / 2; }
__host__ __device__ __forceinline__ int perm32(int rho) { const int n = rho >> 4, i = rho & 15; return 8 * (i >> 2) + 4 * n + (i & 3); }

typedef int i32x8 __attribute__((ext_vector_type(8))); typedef int i32x4v __attribute__((ext_vector_type(4)));
__device__ __forceinline__ i32x8 cat8(bf16x8 a, bf16x8 b) { return __builtin_shufflevector(__builtin_bit_cast(i32x4v, a), __builtin_bit_cast(i32x4v, b), 0, 1, 2, 3, 4, 5, 6, 7); }
struct Unit { int pm, pn; };
struct Gemm { const PG8_GAS bf16_t* A; const PG8_GAS bf16_t* Bt; int M, N, K; };

struct StaticOrder {
    int nM, nN, nwg, G, c;
    __host__ __device__ void init(int M, int N, int G_, int c_) { nM = M / BM; nN = N / BM; nwg = nM * nN; G = G_; c = c_; }
    __host__ __device__ bool next(int i, Unit& u) const {
        const long L = (long)i * G + c; if (L >= nwg) return false;
        int wgid = (int)L; { const int q = nwg / NXCD, r = nwg % NXCD, xcd = wgid % NXCD, off = wgid / NXCD; wgid = (xcd < r ? xcd * (q + 1) : r * (q + 1) + (xcd - r) * q) + off; }
        const int nig = WGM * nN, gid = wgid / nig, fm = gid * WGM, gsz = (nM - fm) < WGM ? (nM - fm) : WGM;
        u.pm = fm + ((wgid % nig) % gsz); u.pn = (wgid % nig) / gsz; return true;
    }
    __device__ __forceinline__ void a_ready(const Unit&) const {}
    __device__ __forceinline__ void done(const Unit&) const {}
};
__device__ __forceinline__ unsigned long long karg64(int idx) { unsigned long long r; const unsigned off = (unsigned)idx * 8u;
    asm volatile("s_load_dwordx2 %0, %1, %2\n\ts_waitcnt lgkmcnt(0)" : "=s"(r) : "s"(__builtin_amdgcn_kernarg_segment_ptr()), "s"(off) : "memory"); return r; }
__device__ __forceinline__ unsigned cvt_pk_bf16(float lo, float hi) { unsigned r; asm volatile("v_cvt_pk_bf16_f32 %0, %1, %2" : "=v"(r) : "v"(lo), "v"(hi)); return r; }
__device__ __forceinline__ unsigned pack4_i8(float a, float b, float c, float d, float S) {
    const int qa = (int)__builtin_rintf(__builtin_fminf(__builtin_fmaxf(a * S, -127.f), 127.f)), qb = (int)__builtin_rintf(__builtin_fminf(__builtin_fmaxf(b * S, -127.f), 127.f));
    const int qc = (int)__builtin_rintf(__builtin_fminf(__builtin_fmaxf(c * S, -127.f), 127.f)), qd = (int)__builtin_rintf(__builtin_fminf(__builtin_fmaxf(d * S, -127.f), 127.f));
    return ((unsigned)qa & 0xffu) | (((unsigned)qb & 0xffu) << 8) | (((unsigned)qc & 0xffu) << 16) | ((unsigned)qd << 24);
}
__device__ __forceinline__ float silu_f(float g) { return g * __builtin_amdgcn_rcpf(1.0f + __builtin_amdgcn_exp2f(-1.4426950408889634f * g)); }

template <bool ACC_I32 = false>
struct EpiSwiglu {
    static constexpr bool PERM = true, AFTER_DRAIN = false;
    static __device__ __forceinline__ f32x4 cv(const f32x4& a) { if constexpr (ACC_I32) { typedef int i32x4e __attribute__((ext_vector_type(4))); const i32x4e q = __builtin_bit_cast(i32x4e, a); return (f32x4){(float)q[0], (float)q[1], (float)q[2], (float)q[3]}; } else return a; }
    PG8_GAS bf16_t* O; int ldc; const PG8_GAS float* ss; float inv_k, eps, post; float out8;
    __device__ __forceinline__ void operator()(const f32x4 (&acc)[2][2][4][2], const Unit& u, int wr, int wc, int fr, int fq) const {
        const int row0 = u.pm * BM + wr * 64 + fr, col0 = u.pn * HALF + wc * 32 + 8 * fq;
        float rs[8]; const int lane_ = fr + 16 * fq;
#pragma unroll
        for (int k = 0; k < 8; ++k) { const PG8_GAS f32x4* p4 = (const PG8_GAS f32x4*)(ss + (size_t)(row0 + (k >> 2) * HALF + (k & 3) * 16) * 32 + 8 * fq); const f32x4 a = p4[0], b = p4[1];
            float t = ((a[0] + a[1]) + (a[2] + a[3])) + ((b[0] + b[1]) + (b[2] + b[3]));
            t += __builtin_bit_cast(float, __builtin_amdgcn_ds_bpermute((lane_ ^ 16) << 2, __builtin_bit_cast(int, t)));
            t += __builtin_bit_cast(float, __builtin_amdgcn_ds_bpermute((lane_ ^ 32) << 2, __builtin_bit_cast(int, t))); rs[k] = t; }
#pragma unroll
        for (int ai = 0; ai < 2; ++ai)
#pragma unroll
            for (int m = 0; m < 4; ++m) { PG8_GAS bf16_t* rowp = O + (size_t)(row0 + ai * HALF + m * 16) * ldc + col0;
                const float r = __builtin_amdgcn_rsqf(rs[ai * 4 + m] * inv_k + eps) * post;
                const f32x4 g0 = cv(acc[ai][0][m][0]) * r, g1 = cv(acc[ai][0][m][1]) * r, u0 = cv(acc[ai][1][m][0]) * r, u1 = cv(acc[ai][1][m][1]) * r;
                if (out8 != 0.f) { int p = 0, q = 0;
                    p = __builtin_amdgcn_cvt_pk_fp8_f32(silu_f(g0[0]) * u0[0] * out8, silu_f(g0[1]) * u0[1] * out8, p, false); p = __builtin_amdgcn_cvt_pk_fp8_f32(silu_f(g0[2]) * u0[2] * out8, silu_f(g0[3]) * u0[3] * out8, p, true);
                    q = __builtin_amdgcn_cvt_pk_fp8_f32(silu_f(g1[0]) * u1[0] * out8, silu_f(g1[1]) * u1[1] * out8, q, false); q = __builtin_amdgcn_cvt_pk_fp8_f32(silu_f(g1[2]) * u1[2] * out8, silu_f(g1[3]) * u1[3] * out8, q, true);
                    typedef unsigned u32x2v __attribute__((ext_vector_type(2))); u32x2v w8; w8.x = (unsigned)p; w8.y = (unsigned)q;
                    *(PG8_GAS u32x2v*)((PG8_GAS unsigned char*)O + (size_t)(row0 + ai * HALF + m * 16) * ldc + col0) = w8; }
                else { u32x4 w; w.x = cvt_pk_bf16(silu_f(g0[0]) * u0[0], silu_f(g0[1]) * u0[1]); w.y = cvt_pk_bf16(silu_f(g0[2]) * u0[2], silu_f(g0[3]) * u0[3]);
                w.z = cvt_pk_bf16(silu_f(g1[0]) * u1[0], silu_f(g1[1]) * u1[1]); w.w = cvt_pk_bf16(silu_f(g1[2]) * u1[2], silu_f(g1[3]) * u1[3]);
                *(PG8_GAS u32x4*)rowp = w; } }
    }
};
struct EpiResid {
    static constexpr bool PERM = true, AFTER_DRAIN = false;
    float alpha; unsigned hb_off; unsigned ss_off; unsigned h8_off; float h8_i8;
    __device__ __forceinline__ void operator()(const f32x4 (&acc)[2][2][4][2], const Unit& u, int wr, int wc, int fr, int fq) const {
        constexpr int ldc = 2048;
        PG8_GAS unsigned char* wsb = (PG8_GAS unsigned char*)karg64(21); PG8_GAS bf16_t* hb = (PG8_GAS bf16_t*)(wsb + hb_off); PG8_GAS float* ss = (PG8_GAS float*)(wsb + ss_off);
        const int row0 = u.pm * BM + wr * 64 + fr, col0 = u.pn * BM + wc * 32 + 8 * fq; const int lane = fr + 16 * fq;
        u32x4 cur[2], nxt[2];
        { const size_t off = (size_t)row0 * ldc + col0; cur[0] = *(const PG8_GAS u32x4*)(hb + off); cur[1] = *(const PG8_GAS u32x4*)(hb + off + HALF); }
#pragma unroll
        for (int k = 0; k < 8; ++k) { const int ai = k >> 2, m = k & 3; const int row = row0 + ai * HALF + m * 16; const size_t off = (size_t)row * ldc + col0;
            if (k < 7) { const int ai2 = (k + 1) >> 2, m2 = (k + 1) & 3; const size_t off2 = (size_t)(row0 + ai2 * HALF + m2 * 16) * ldc + col0;
                nxt[0] = *(const PG8_GAS u32x4*)(hb + off2); nxt[1] = *(const PG8_GAS u32x4*)(hb + off2 + HALF); }
            float sq = 0.f;
#pragma unroll
            for (int bj = 0; bj < 2; ++bj) { const u32x4 b = cur[bj]; const f32x4 a0 = acc[ai][bj][m][0], a1 = acc[ai][bj][m][1]; u32x4 w;
                w.x = cvt_pk_bf16(__builtin_bit_cast(float, b.x << 16) + a0[0] * alpha, __builtin_bit_cast(float, b.x & 0xffff0000u) + a0[1] * alpha);
                w.y = cvt_pk_bf16(__builtin_bit_cast(float, b.y << 16) + a0[2] * alpha, __builtin_bit_cast(float, b.y & 0xffff0000u) + a0[3] * alpha);
                w.z = cvt_pk_bf16(__builtin_bit_cast(float, b.z << 16) + a1[0] * alpha, __builtin_bit_cast(float, b.z & 0xffff0000u) + a1[1] * alpha);
                w.w = cvt_pk_bf16(__builtin_bit_cast(float, b.w << 16) + a1[2] * alpha, __builtin_bit_cast(float, b.w & 0xffff0000u) + a1[3] * alpha);
                *(PG8_GAS u32x4*)(hb + off + bj * HALF) = w;
                if (h8_off) { typedef unsigned u32x2v __attribute__((ext_vector_type(2))); u32x2v q8; int p = 0;
                    const float e0 = __builtin_bit_cast(float, w.x << 16), e1 = __builtin_bit_cast(float, w.x & 0xffff0000u), e2 = __builtin_bit_cast(float, w.y << 16), e3 = __builtin_bit_cast(float, w.y & 0xffff0000u);
                    const float e4 = __builtin_bit_cast(float, w.z << 16), e5 = __builtin_bit_cast(float, w.z & 0xffff0000u), e6 = __builtin_bit_cast(float, w.w << 16), e7 = __builtin_bit_cast(float, w.w & 0xffff0000u);
                    if (h8_i8 != 0.f) { q8.x = pack4_i8(e0, e1, e2, e3, h8_i8); q8.y = pack4_i8(e4, e5, e6, e7, h8_i8); }
                    else { p = __builtin_amdgcn_cvt_pk_fp8_f32(e0, e1, p, false); p = __builtin_amdgcn_cvt_pk_fp8_f32(e2, e3, p, true); q8.x = (unsigned)p; p = 0;
                        p = __builtin_amdgcn_cvt_pk_fp8_f32(e4, e5, p, false); p = __builtin_amdgcn_cvt_pk_fp8_f32(e6, e7, p, true); q8.y = (unsigned)p; }
                    *(PG8_GAS u32x2v*)(wsb + h8_off + off + bj * HALF) = q8; }
#pragma unroll
                for (int e = 0; e < 4; ++e) { const float lo = __builtin_bit_cast(float, w[e] << 16), hi = __builtin_bit_cast(float, w[e] & 0xffff0000u); sq = fmaf(lo, lo, sq); sq = fmaf(hi, hi, sq); } }
            sq += __builtin_bit_cast(float, __builtin_amdgcn_ds_bpermute((lane ^ 16) << 2, __builtin_bit_cast(int, sq)));
            sq += __builtin_bit_cast(float, __builtin_amdgcn_ds_bpermute((lane ^ 32) << 2, __builtin_bit_cast(int, sq)));
            if (fq == 0) ss[(size_t)row * 32 + u.pn * 4 + wc] = sq;
            cur[0] = nxt[0]; cur[1] = nxt[1]; }
    }
};
struct EpiBf16 {
    static constexpr bool PERM = true, AFTER_DRAIN = false;
    PG8_GAS bf16_t* O; int ldc; const PG8_GAS float* ss; float inv_k, eps;
    __device__ __forceinline__ void operator()(const f32x4 (&acc)[2][2][4][2], const Unit& u, int wr, int wc, int fr, int fq) const {
        const int row0 = u.pm * BM + wr * 64 + fr, col0 = u.pn * BM + wc * 32 + 8 * fq;
        float rs[8]; const int lane_ = fr + 16 * fq;
#pragma unroll
        for (int k = 0; k < 8; ++k) { const PG8_GAS f32x4* p4 = (const PG8_GAS f32x4*)(ss + (size_t)(row0 + (k >> 2) * HALF + (k & 3) * 16) * 32 + 8 * fq); const f32x4 a = p4[0], b = p4[1];
            float t = ((a[0] + a[1]) + (a[2] + a[3])) + ((b[0] + b[1]) + (b[2] + b[3]));
            t += __builtin_bit_cast(float, __builtin_amdgcn_ds_bpermute((lane_ ^ 16) << 2, __builtin_bit_cast(int, t)));
            t += __builtin_bit_cast(float, __builtin_amdgcn_ds_bpermute((lane_ ^ 32) << 2, __builtin_bit_cast(int, t))); rs[k] = t; }
#pragma unroll
        for (int ai = 0; ai < 2; ++ai)
#pragma unroll
            for (int m = 0; m < 4; ++m) { PG8_GAS bf16_t* rowp = O + (size_t)(row0 + ai * HALF + m * 16) * ldc + col0;
                const float r = __builtin_amdgcn_rsqf(rs[ai * 4 + m] * inv_k + eps);
#pragma unroll
                for (int bj = 0; bj < 2; ++bj) { const f32x4 v0 = acc[ai][bj][m][0] * r, v1 = acc[ai][bj][m][1] * r;
                    u32x4 w; w.x = cvt_pk_bf16(v0[0], v0[1]); w.y = cvt_pk_bf16(v0[2], v0[3]); w.z = cvt_pk_bf16(v1[0], v1[1]); w.w = cvt_pk_bf16(v1[2], v1[3]);
                    *(PG8_GAS u32x4*)(rowp + bj * HALF) = w; } }
    }
};
template <class Epi, class Sched, bool ALIGN_EPI = false, bool SP2 = false, bool F8 = false, bool I8 = false>
__device__ __forceinline__ void gemm_phase(PG8_LAS unsigned char* lds, const Gemm g, const Sched& S, const Epi& E, int tid_in  ) {
    int tid_ = tid_in; asm volatile("" : "+v"(tid_));
    const int tid = tid_, wid = __builtin_amdgcn_readfirstlane(tid >> 6), lane = tid & 63, wr = wid >> 2, wc = wid & 3, fr = lane & 15, fq = lane >> 4;
    const int K = g.K, nt = K / BK;
    unsigned voffA[2], voffB[2];
#pragma unroll
    for (int i = 0; i < 2; ++i) { int R, C; stage_rc(tid * 16 + i * 8192, R, C); const int Rb = Epi::PERM ? ((R & ~31) + perm32(R & 31)) : R;
        voffA[i] = (unsigned)(R * K + C) * 2u; voffB[i] = (unsigned)(Rb * K + C) * 2u; }
    const size_t kstep = (size_t)(BK * 2);
    const size_t hstep = (size_t)HALF * K * 2;
    const size_t tstep = 2 * hstep;
    const unsigned ldsw = (unsigned)wid * 1024u;
    const int aoff = lds_byte(wr * 64 + fr, fq * 8), boff = lds_byte(wc * 32 + fr, fq * 8);
#define PG8_SA(b, h) (((b) * 2 + (h)) * HTB)
#define PG8_SB(b, h) ((4 + (b) * 2 + (h)) * HTB)
#define PG8_STAGE(bufoff, gbase, voff) do { _Pragma("unroll") for (int _i = 0; _i < 2; ++_i) \
        __builtin_amdgcn_global_load_lds((const PG8_GAS unsigned*)((const PG8_GAS char*)(gbase) + (voff)[_i]), (PG8_LAS unsigned*)(lds + (bufoff) + ldsw + _i * 8192), 16, 0, 0); } while (0)
#define PG8_LDA(dst, b, h) do { _Pragma("unroll") for (int m = 0; m < 4; ++m) _Pragma("unroll") for (int k = 0; k < 2; ++k) dst[m][k] = *(const PG8_LAS bf16x8*)(lds + PG8_SA(b, h) + aoff + m * 2048 + k * 1024); } while (0)
#define PG8_LDB(dst, b, h) do { _Pragma("unroll") for (int n = 0; n < 2; ++n) _Pragma("unroll") for (int k = 0; k < 2; ++k) dst[n][k] = *(const PG8_LAS bf16x8*)(lds + PG8_SB(b, h) + boff + n * 2048 + k * 1024); } while (0)
#define PG8_MMA(ai, bj, At, Bt) do { __builtin_amdgcn_s_setprio(1); _Pragma("unroll") for (int m = 0; m < 4; ++m) _Pragma("unroll") for (int n = 0; n < 2; ++n) { \
        if constexpr (F8) { asm volatile("v_mfma_f32_16x16x128_f8f6f4 %0, %1, %2, %0" : "+v"(acc[ai][bj][m][n]) : "v"(cat8(Bt[n][0], Bt[n][1])), "v"(cat8(At[m][0], At[m][1]))); } \
        else if constexpr (I8) { _Pragma("unroll") for (int k = 0; k < 2; ++k) asm volatile("v_mfma_i32_16x16x64_i8 %0, %1, %2, %0" : "+v"(acc[ai][bj][m][n]) : "v"(Bt[n][k]), "v"(At[m][k])); } \
        else { _Pragma("unroll") for (int k = 0; k < 2; ++k) acc[ai][bj][m][n] = __builtin_amdgcn_mfma_f32_16x16x32_bf16(Bt[n][k], At[m][k], acc[ai][bj][m][n], 0, 0, 0); } } \
        __builtin_amdgcn_s_setprio(0); } while (0)
#define PG8_WAIT_V(n) asm volatile("s_waitcnt vmcnt(" #n ")" ::: "memory")
#define PG8_WAIT_L(n) asm volatile("s_waitcnt lgkmcnt(" #n ")" ::: "memory")
#define PG8_BAR __builtin_amdgcn_s_barrier()
#define PG8_SCHED __builtin_amdgcn_sched_barrier(0)
    Unit cur, nxt; int ui = 0;
    if (!S.next(0, cur)) return;
    f32x4 acc[2][2][4][2];
#pragma unroll
    for (int a = 0; a < 2; ++a)
#pragma unroll
        for (int b = 0; b < 2; ++b)
#pragma unroll
            for (int m = 0; m < 4; ++m)
#pragma unroll
                for (int n = 0; n < 2; ++n) acc[a][b][m][n] = (f32x4){0.f, 0.f, 0.f, 0.f};
    bf16x8 At[4][2], B0[2][2], B1[2][2];
    const PG8_GAS char* cA = (const PG8_GAS char*)g.A + (size_t)cur.pm * tstep; const PG8_GAS char* cB = (const PG8_GAS char*)g.Bt + (size_t)cur.pn * tstep;
    S.a_ready(cur);
    if constexpr (SP2) {
        PG8_STAGE(PG8_SB(0, 0), cB, voffB); PG8_STAGE(PG8_SB(0, 1), cB + hstep, voffB); PG8_STAGE(PG8_SA(0, 0), cA, voffA); PG8_STAGE(PG8_SA(0, 1), cA + hstep, voffA);
        if (wr == 1) PG8_BAR;
        PG8_WAIT_V(2); PG8_BAR;
        PG8_STAGE(PG8_SB(1, 0), cB + kstep, voffB); PG8_STAGE(PG8_SA(1, 0), cA + kstep, voffA); PG8_STAGE(PG8_SB(1, 1), cB + hstep + kstep, voffB);
        PG8_WAIT_V(6); PG8_BAR;
    } else {
        PG8_STAGE(PG8_SB(0, 0), cB, voffB); PG8_STAGE(PG8_SA(0, 0), cA, voffA); PG8_STAGE(PG8_SB(0, 1), cB + hstep, voffB); PG8_STAGE(PG8_SA(0, 1), cA + hstep, voffA);
        if (wr == 1) PG8_BAR;
        PG8_WAIT_V(4); PG8_BAR;
        PG8_STAGE(PG8_SB(1, 0), cB + kstep, voffB); PG8_STAGE(PG8_SA(1, 0), cA + kstep, voffA); PG8_STAGE(PG8_SB(1, 1), cB + hstep + kstep, voffB);
        PG8_WAIT_V(6); PG8_BAR;
    }
    for (;;) {
        const bool has_next = S.next(ui + 1, nxt);
        const PG8_GAS char* nA = has_next ? (const PG8_GAS char*)g.A + (size_t)nxt.pm * tstep : cA; const PG8_GAS char* nB = has_next ? (const PG8_GAS char*)g.Bt + (size_t)nxt.pn * tstep : cB;
        for (int t = 0; t < nt; t += 2) {
            const bool last = (t == nt - 2);
            const PG8_GAS char* a1 = cA + (size_t)(t + 1) * kstep;
            const PG8_GAS char* a2 = last ? nA : cA + (size_t)(t + 2) * kstep; const PG8_GAS char* b2 = last ? nB : cB + (size_t)(t + 2) * kstep;
            const PG8_GAS char* a3 = a2 + kstep; const PG8_GAS char* b3 = b2 + kstep;
            if (last && has_next) S.a_ready(nxt);
            if constexpr (SP2) {
            PG8_LDB(B0, 0, 0); PG8_LDB(B1, 0, 1); PG8_SCHED; PG8_LDA(At, 0, 0); PG8_STAGE(PG8_SA(1, 1), a1 + hstep, voffA);
            PG8_WAIT_V(8); PG8_WAIT_L(0); PG8_BAR; PG8_MMA(0, 0, At, B0); PG8_MMA(0, 1, At, B1); PG8_BAR; PG8_SCHED;
            PG8_LDA(At, 0, 1); PG8_STAGE(PG8_SB(0, 0), b2, voffB); PG8_STAGE(PG8_SB(0, 1), b2 + hstep, voffB); PG8_STAGE(PG8_SA(0, 0), a2, voffA);
            PG8_WAIT_V(8); PG8_WAIT_L(0); PG8_BAR; PG8_MMA(1, 0, At, B0); PG8_MMA(1, 1, At, B1); PG8_BAR; PG8_SCHED;
            PG8_LDB(B0, 1, 0); PG8_LDB(B1, 1, 1); PG8_SCHED; PG8_LDA(At, 1, 0); PG8_STAGE(PG8_SA(0, 1), a2 + hstep, voffA);
            PG8_WAIT_V(8); PG8_WAIT_L(0); PG8_BAR; PG8_MMA(0, 0, At, B0); PG8_MMA(0, 1, At, B1); PG8_BAR; PG8_SCHED;
            PG8_LDA(At, 1, 1); PG8_STAGE(PG8_SB(1, 0), b3, voffB); PG8_STAGE(PG8_SB(1, 1), b3 + hstep, voffB); PG8_STAGE(PG8_SA(1, 0), a3, voffA);
            PG8_WAIT_V(8); PG8_WAIT_L(0); PG8_BAR; PG8_MMA(1, 0, At, B0); PG8_MMA(1, 1, At, B1); PG8_BAR; PG8_SCHED;
            } else {
            PG8_LDB(B0, 0, 0); PG8_SCHED; PG8_LDA(At, 0, 0); PG8_STAGE(PG8_SA(1, 1), a1 + hstep, voffA);
            PG8_WAIT_L(8); PG8_BAR; PG8_WAIT_L(0); PG8_MMA(0, 0, At, B0); PG8_BAR; PG8_SCHED;
            PG8_LDB(B1, 0, 1); PG8_STAGE(PG8_SB(0, 0), b2, voffB);
            PG8_BAR; PG8_WAIT_L(0); PG8_MMA(0, 1, At, B1); PG8_BAR;
            PG8_LDA(At, 0, 1); PG8_STAGE(PG8_SA(0, 0), a2, voffA);
            PG8_BAR; PG8_WAIT_L(0); PG8_MMA(1, 0, At, B0); PG8_BAR; PG8_SCHED;
            PG8_STAGE(PG8_SB(0, 1), b2 + hstep, voffB);
            PG8_WAIT_V(6); PG8_BAR; PG8_MMA(1, 1, At, B1); PG8_BAR;
            PG8_LDB(B0, 1, 0); PG8_SCHED; PG8_LDA(At, 1, 0); PG8_STAGE(PG8_SA(0, 1), a2 + hstep, voffA);
            PG8_WAIT_L(8); PG8_BAR; PG8_WAIT_L(0); PG8_MMA(0, 0, At, B0); PG8_BAR; PG8_SCHED;
            PG8_LDB(B1, 1, 1); PG8_STAGE(PG8_SB(1, 0), b3, voffB);
            PG8_BAR; PG8_WAIT_L(0); PG8_MMA(0, 1, At, B1); PG8_BAR;
            PG8_LDA(At, 1, 1); PG8_STAGE(PG8_SA(1, 0), a3, voffA);
            PG8_BAR; PG8_WAIT_L(0); PG8_MMA(1, 0, At, B0); PG8_BAR; PG8_SCHED;
            PG8_STAGE(PG8_SB(1, 1), b3 + hstep, voffB);
            PG8_WAIT_V(6); PG8_BAR; PG8_MMA(1, 1, At, B1); PG8_BAR;
            }
        }
        if constexpr (ALIGN_EPI) { if (wr == 0) PG8_BAR; }
        if constexpr (!Epi::AFTER_DRAIN) { E(acc, cur, wr, wc, fr, fq); S.done(cur); }
        if (!has_next) break;
#pragma unroll
        for (int a = 0; a < 2; ++a)
#pragma unroll
            for (int b = 0; b < 2; ++b)
#pragma unroll
                for (int m = 0; m < 4; ++m)
#pragma unroll
                    for (int n = 0; n < 2; ++n) acc[a][b][m][n] = (f32x4){0.f, 0.f, 0.f, 0.f};
        cur = nxt; cA = nA; cB = nB; ++ui;
        if constexpr (ALIGN_EPI) { if (wr == 1) PG8_BAR; }
    }
    PG8_WAIT_V(0);
    if constexpr (!ALIGN_EPI) { if (wr == 0) PG8_BAR; }
    PG8_BAR;
    if constexpr (Epi::AFTER_DRAIN) { E.fused(acc, cur, wr, wc, fr, fq, lds, wid, lane); S.done(cur); }
#undef PG8_SA
#undef PG8_SB
#undef PG8_STAGE
#undef PG8_LDA
#undef PG8_LDB
#undef PG8_MMA
#undef PG8_WAIT_V
#undef PG8_WAIT_L
#undef PG8_BAR
#undef PG8_SCHED
}
}
constexpr int NWAVES = 8;
constexpr int BATCH = 8, SEQ = 4096, D = 2048, FF = 5632, DEPTH = 2;
constexpr int M = BATCH * SEQ;
constexpr int NGU = 2 * FF;
constexpr int H_A = 8, HD_A = 128, RANK = 256, IH = 8, IDIM = 64, TOPK = 256;
constexpr int H_B = 16, KVH = 2, GQA = 8, HD_B = 64, WINDOW = 128;
constexpr int D_IN = 3144;
constexpr float EPS = 1e-6f;
constexpr size_t MiB = 1u << 20;
constexpr size_t WS_CTL = 0, CTL_ZERO_BYTES = 1 * MiB;
#ifndef F8_MASK
#define F8_MASK 0xF
#endif
constexpr float W8_SCALE = 64.0f;
#ifndef GU_I8
#define GU_I8 1
#endif
constexpr float H8I_SCALE = 127.0f / 6.0f, W8I_SCALE = 127.0f / (6.3f * 0.022097086912079608f);
#ifndef D8_MASK
#define D8_MASK 0xA
#endif
constexpr float A8_SCALE = 8.0f;
__host__ __device__ constexpr bool d8_on(int l, int f) { return ((D8_MASK >> (2 * l + f)) & 1) != 0; }
constexpr float O8_SCALE = 16.0f;
#ifndef OUT_F8
#define OUT_F8 1
#endif
constexpr bool F8_ALL1 = (F8_MASK & 0x5) == 0x5, F8_ALL2 = (F8_MASK & 0xA) == 0xA;
__host__ __device__ constexpr bool f8_on(int l, int f) { return ((F8_MASK >> (2 * l + f)) & 1) != 0; }
constexpr size_t GU1_B = (F8_ALL1 ? 22 : 44) * MiB, GU2_B = (F8_ALL2 ? 22 : 44) * MiB;
constexpr size_t WS_W0 = 2 * MiB;
constexpr size_t WO_GU1 = 0, WO_D1 = GU1_B, WO_GU2 = WO_D1 + 22 * MiB, WO_D2 = WO_GU2 + GU2_B, WO_IN = WO_D2 + 22 * MiB, WO_OUT = WO_IN + 17 * MiB, W_LAYER = WO_OUT + 12 * MiB;
constexpr size_t WS_XN = WS_W0 + 2 * W_LAYER;
constexpr size_t WS_HB8 = WS_XN + 128 * MiB;
constexpr size_t WS_ACT = WS_HB8 + (F8_MASK ? 64 : 0) * MiB;
constexpr size_t WS_Z = WS_ACT, WS_CKVN = WS_ACT + 272 * MiB, WS_KIN = WS_ACT + 288 * MiB, WS_WIF = WS_ACT + 292 * MiB, WS_IDX = WS_ACT + 294 * MiB;
constexpr int ZLD = 4352, ZC_QLAT = 0, ZC_CKV = 2048, ZC_QI = 2304, ZC_QB = 2816, ZC_KB = 3840, ZC_VB = 3968, ZC_KI = 4096, ZC_WI = 4160;
constexpr int OLD = 3072;
constexpr size_t WS_O = WS_ACT + 352 * MiB;
constexpr size_t WS_SS = WS_O + 192 * MiB, SS_BYTES = 4 * MiB;
constexpr size_t WS_END = WS_SS + 2 * SS_BYTES;
static_assert(WS_END <= 1024 * MiB, "d_ws map exceeds 1 GiB");
constexpr int CW_TMO = 0, CW_CODE = 1, CW_BAR = 4096;
constexpr int RING_OFF = 0, RING_BYTES = 131072;
constexpr int LDSCTL_OFF = RING_BYTES, MISC_OFF = LDSCTL_OFF + 320;
constexpr int LDS_BYTES = 147456;
#define GAS __attribute__((address_space(1)))
#define LAS __attribute__((address_space(3)))
typedef unsigned short bf16;
typedef unsigned v4u __attribute__((ext_vector_type(4)));
typedef float f32x4 __attribute__((ext_vector_type(4)));
typedef short bf16x8 __attribute__((ext_vector_type(8)));
typedef GAS unsigned gu32;
typedef GAS unsigned long long gu64;
#define RLX_AGENT __ATOMIC_RELAXED, __HIP_MEMORY_SCOPE_AGENT
#define LDS_WAIT() asm volatile("s_waitcnt lgkmcnt(0)" ::: "memory")
#define VM_WAIT() asm volatile("s_waitcnt vmcnt(0)" ::: "memory")
__device__ __forceinline__ unsigned long long rt() { return __builtin_amdgcn_s_memrealtime(); }
__device__ __forceinline__ unsigned f2bf(float f) { unsigned u = __builtin_bit_cast(unsigned, f); return (u + 0x7fffu + ((u >> 16) & 1u)) >> 16; }
__device__ __forceinline__ unsigned pk2(float lo, float hi) { return f2bf(lo) | (f2bf(hi) << 16); }

#define XB_TMO      128
#define XB_XCNT(j)  (256  + 64 * (j))
#define XB_XSUB(j)  (1280 + 64 * (j))
#define XB_XGEN(j)  (2304 + 64 * (j))
#define XB_TOP      3328
#define XB_TOPGEN   3392
#define XCD_BAR_WORDS 3456
#define XB_SPIN_CAP (1u << 18)

__device__ __forceinline__ unsigned xb_ld(unsigned* p)              { return __hip_atomic_load(p, __ATOMIC_RELAXED, __HIP_MEMORY_SCOPE_AGENT); }
__device__ __forceinline__ unsigned xb_add(unsigned* p, unsigned v) { return __hip_atomic_fetch_add(p, v, __ATOMIC_RELAXED, __HIP_MEMORY_SCOPE_AGENT); }
__device__ __forceinline__ unsigned xb_xcc_id() { return (unsigned)__builtin_amdgcn_s_getreg((3 << 11) | 20) & 0xFu; }
#define XB_SPIN(cond, bar) do { unsigned _sp = 0; while (cond) { __builtin_amdgcn_s_sleep(1); \
    if ((++_sp & 255u) == 0u) { if (xb_ld(&(bar)[XB_TMO])) break; if (_sp > XB_SPIN_CAP) { atomicAdd(&(bar)[XB_TMO], 1u); break; } } } } while (0)

struct XcdBarrier {
    unsigned* bar; unsigned x;
    volatile LAS unsigned* st;
};

__device__ __forceinline__ XcdBarrier xcd_barrier_post(unsigned* bar, volatile LAS unsigned* st, bool leader  ) {
    XcdBarrier b; b.bar = bar; b.x = xb_xcc_id(); b.st = st;
    if (leader) (void)xb_add(&bar[XB_XCNT(b.x)], 1u);
    return b;
}
__device__ __forceinline__ void xcd_barrier_complete(unsigned* bar, unsigned x, unsigned& nloc, unsigned& nx) {
    const unsigned G = gridDim.x * gridDim.y * gridDim.z;
    unsigned sum, cnt, mine, sp = 0u;
    for (;;) {
        sum = 0u; cnt = 0u; mine = 0u;
#pragma unroll
        for (unsigned j = 0; j < 16; ++j) { const unsigned c = xb_ld(&bar[XB_XCNT(j)]); sum += c; cnt += (c > 0u) ? 1u : 0u; mine = (j == x) ? c : mine; }
        if (sum == G) break;
        __builtin_amdgcn_s_sleep(1);
        if ((++sp & 255u) == 0u) { if (xb_ld(&bar[XB_TMO])) break; if (sp > XB_SPIN_CAP) { atomicAdd(&bar[XB_TMO], 1u); break; } }
    }
    nloc = mine > 0u ? mine : 1u; nx = cnt > 0u ? cnt : 1u;
}

__device__ __forceinline__ void xcd_barrier(const XcdBarrier& b, bool leader  ) {
    asm volatile("s_waitcnt vmcnt(0)" ::: "memory");
    __syncthreads();
    if (leader) {
        unsigned* bar = b.bar;
        __builtin_amdgcn_s_waitcnt(0);
        unsigned nloc = b.st[0], nx = b.st[1];
        if (nloc == 0u) { xcd_barrier_complete(bar, b.x, nloc, nx); b.st[0] = nloc; b.st[1] = nx; }
        const unsigned old = xb_add(&bar[XB_XSUB(b.x)], 1u);
        const unsigned gen = old / nloc;
        if (old + 1u == (gen + 1u) * nloc) {
            __builtin_amdgcn_fence(__ATOMIC_RELEASE, "agent");
            asm volatile("s_waitcnt vmcnt(0)" ::: "memory");
            const unsigned og = xb_add(&bar[XB_TOP], 1u);
            const unsigned tg = og / nx;
            if (og + 1u == (tg + 1u) * nx) xb_add(&bar[XB_TOPGEN], 1u);
            else XB_SPIN(xb_ld(&bar[XB_TOPGEN]) == tg, bar);
            __builtin_amdgcn_fence(__ATOMIC_ACQUIRE, "agent");
            xb_add(&bar[XB_XGEN(b.x)], 1u);
            asm volatile("s_waitcnt vmcnt(0)" ::: "memory");
        } else {
            XB_SPIN(xb_ld(&bar[XB_XGEN(b.x)]) == gen, bar);
            __builtin_amdgcn_fence(__ATOMIC_ACQUIRE, "agent");
            asm volatile("s_waitcnt vmcnt(0)" ::: "memory");
        }
    }
    __syncthreads();
}
__constant__ unsigned char T5_BUCKET[128] = {0, 1, 2, 3, 4, 5, 6, 7, 8, 9, 10, 11, 12, 13, 14, 15, 16, 16, 16, 17, 17, 18, 18, 18, 19, 19, 19, 20, 20, 20, 20, 21, 21, 21, 21, 22, 22, 22, 22, 22, 23, 23, 23, 23, 23, 23, 24, 24, 24, 24, 24, 24, 25, 25, 25, 25, 25, 25, 25, 26, 26, 26, 26, 26, 26, 26, 26, 27, 27, 27, 27, 27, 27, 27, 27, 27, 27, 28, 28, 28, 28, 28, 28, 28, 28, 28, 28, 29, 29, 29, 29, 29, 29, 29, 29, 29, 29, 29, 29, 30, 30, 30, 30, 30, 30, 30, 30, 30, 30, 30, 30, 30, 30, 31, 31, 31, 31, 31, 31, 31, 31, 31, 31, 31, 31, 31, 31, 31};
typedef short s16x4 __attribute__((ext_vector_type(4)));
typedef float f32x16 __attribute__((ext_vector_type(16)));
__device__ __forceinline__ float bf2f(unsigned short b) { return __builtin_bit_cast(float, (unsigned)b << 16); }
__device__ __forceinline__ bf16x8 cat4(s16x4 lo, s16x4 hi) { return __builtin_shufflevector(lo, hi, 0, 1, 2, 3, 4, 5, 6, 7); }
__device__ __forceinline__ void tr_read4(unsigned a0, unsigned a1, unsigned a2, unsigned a3, s16x4& r0, s16x4& r1, s16x4& r2, s16x4& r3) {
    asm volatile("ds_read_b64_tr_b16 %0, %4\n\tds_read_b64_tr_b16 %1, %5\n\tds_read_b64_tr_b16 %2, %6\n\tds_read_b64_tr_b16 %3, %7\n\ts_waitcnt lgkmcnt(0)"
                 : "=&v"(r0), "=&v"(r1), "=&v"(r2), "=&v"(r3) : "v"(a0), "v"(a1), "v"(a2), "v"(a3) : "memory");
}
#define SHX(x, o) __builtin_bit_cast(float, __builtin_amdgcn_ds_bpermute(((lane) ^ (o)) << 2, __builtin_bit_cast(int, (float)(x))))
#define SHXU(x, o) ((unsigned)__builtin_amdgcn_ds_bpermute(((lane) ^ (o)) << 2, (int)(x)))
__device__ __forceinline__ float wave_sum(float v, int lane) {
#pragma unroll
    for (int o = 1; o < 64; o <<= 1) v += SHX(v, o);
    return v;
}
template <int OUT8 = 0>
__device__ __forceinline__ void conv_item(const GAS float* W, int ldw, int k0, int c0, int nvalid, GAS bf16* dst, int dld, int drow0, int dk0, float scale, const GAS float* gain, LAS float* scr, int lane) {
    const int c = lane & 31;
    float vin[32];
#pragma unroll
    for (int i = 0; i < 32; ++i) { const int kk = 2 * i + (lane >> 5); vin[i] = 0.f;
        if (c < nvalid) vin[i] = W[(size_t)(k0 + kk) * ldw + c0 + c]; }
#pragma unroll
    for (int i = 0; i < 32; ++i) { const int kk = 2 * i + (lane >> 5); scr[kk * 33 + c] = vin[i] * scale; }
    LDS_WAIT(); asm volatile("" ::: "memory");
    const int c8 = lane & 7;
    f32x4 ga = {1.f, 1.f, 1.f, 1.f}, gb = {1.f, 1.f, 1.f, 1.f};
    if (gain) { ga = *(const GAS f32x4*)(gain + k0 + 8 * c8); gb = *(const GAS f32x4*)(gain + k0 + 8 * c8 + 4); }
#pragma unroll
    for (int j = 0; j < 4; ++j) { const int n = (lane >> 3) + 8 * j; const LAS float* s = scr + (8 * c8) * 33 + n;
        if constexpr (OUT8 == 2) { const unsigned p = pg8::pack4_i8(s[0 * 33] * ga.x, s[1 * 33] * ga.y, s[2 * 33] * ga.z, s[3 * 33] * ga.w, 1.0f), q = pg8::pack4_i8(s[4 * 33] * gb.x, s[5 * 33] * gb.y, s[6 * 33] * gb.z, s[7 * 33] * gb.w, 1.0f);
            *(GAS unsigned long long*)((GAS unsigned char*)dst + (size_t)(drow0 + n) * dld + dk0 + k0 + 8 * c8) = (unsigned long long)p | ((unsigned long long)q << 32); }
        else if constexpr (OUT8 == 1) { int p = 0, q = 0;
            p = __builtin_amdgcn_cvt_pk_fp8_f32(s[0 * 33] * ga.x, s[1 * 33] * ga.y, p, false); p = __builtin_amdgcn_cvt_pk_fp8_f32(s[2 * 33] * ga.z, s[3 * 33] * ga.w, p, true);
            q = __builtin_amdgcn_cvt_pk_fp8_f32(s[4 * 33] * gb.x, s[5 * 33] * gb.y, q, false); q = __builtin_amdgcn_cvt_pk_fp8_f32(s[6 * 33] * gb.z, s[7 * 33] * gb.w, q, true);
            *(GAS unsigned long long*)((GAS unsigned char*)dst + (size_t)(drow0 + n) * dld + dk0 + k0 + 8 * c8) = (unsigned long long)(unsigned)p | ((unsigned long long)(unsigned)q << 32); }
        else { v4u o; o.x = pk2(s[0 * 33] * ga.x, s[1 * 33] * ga.y); o.y = pk2(s[2 * 33] * ga.z, s[3 * 33] * ga.w); o.z = pk2(s[4 * 33] * gb.x, s[5 * 33] * gb.y); o.w = pk2(s[6 * 33] * gb.z, s[7 * 33] * gb.w);
            *(GAS v4u*)(dst + (size_t)(drow0 + n) * dld + dk0 + k0 + 8 * c8) = o; } }
    LDS_WAIT(); asm volatile("" ::: "memory");
}
__device__ __forceinline__ void rmsnorm_rows_bf16(const GAS float* X, const GAS float* g, GAS bf16* O, int gw, int NGW, int lane) {
    f32x4 gv[8];
#pragma unroll
    for (int j = 0; j < 8; ++j) gv[j] = ((const GAS f32x4*)g)[lane + 64 * j];
    for (int m = gw; m < M; m += NGW) {
        const GAS f32x4* xr = (const GAS f32x4*)(X + (size_t)m * D) + lane;
        f32x4 v[8]; float s = 0.f;
#pragma unroll
        for (int j = 0; j < 8; ++j) { v[j] = xr[64 * j]; s += (v[j].x * v[j].x + v[j].y * v[j].y) + (v[j].z * v[j].z + v[j].w * v[j].w); }
        const float r = 1.0f / sqrtf(wave_sum(s, lane) * (1.0f / D) + EPS);
        GAS unsigned long long* o8 = (GAS unsigned long long*)(O + (size_t)m * D) + lane;
#pragma unroll
        for (int j = 0; j < 8; ++j) { const f32x4 y = v[j] * r * gv[j]; o8[64 * j] = (unsigned long long)pk2(y.x, y.y) | ((unsigned long long)pk2(y.z, y.w) << 32); }
    }
}
__device__ __forceinline__ void rows_bf16_ss(const GAS float* X, GAS bf16* O, GAS unsigned char* O8, GAS float* ss, int gw, int NGW, int lane) {
    for (int m = gw; m < M; m += NGW) {
        const GAS f32x4* xr = (const GAS f32x4*)(X + (size_t)m * D) + lane;
        f32x4 v[8]; float s = 0.f;
#pragma unroll
        for (int j = 0; j < 8; ++j) { v[j] = xr[64 * j]; s += (v[j].x * v[j].x + v[j].y * v[j].y) + (v[j].z * v[j].z + v[j].w * v[j].w); }
        s = wave_sum(s, lane);
        GAS unsigned long long* o8 = (GAS unsigned long long*)(O + (size_t)m * D) + lane;
#pragma unroll
        for (int j = 0; j < 8; ++j) o8[64 * j] = (unsigned long long)pk2(v[j].x, v[j].y) | ((unsigned long long)pk2(v[j].z, v[j].w) << 32);
        if (O8) { GAS unsigned* q8 = (GAS unsigned*)(O8 + (size_t)m * D) + lane;
#pragma unroll
            for (int j = 0; j < 8; ++j) { if constexpr (GU_I8) q8[64 * j] = pg8::pack4_i8(v[j].x, v[j].y, v[j].z, v[j].w, H8I_SCALE); else { int p = 0; p = __builtin_amdgcn_cvt_pk_fp8_f32(v[j].x, v[j].y, p, false); p = __builtin_amdgcn_cvt_pk_fp8_f32(v[j].z, v[j].w, p, true); q8[64 * j] = (unsigned)p; } } }
        if (lane < 32) ss[(size_t)m * 32 + lane] = lane == 0 ? s : 0.f;
    }
}
__device__ __forceinline__ void final_rows(const GAS bf16* HB, GAS float* OUT, const GAS float* g, const GAS float* ss, int gw, int NGW, int lane) {
    f32x4 gv[8];
#pragma unroll
    for (int j = 0; j < 8; ++j) gv[j] = ((const GAS f32x4*)g)[lane + 64 * j];
    for (int m = gw; m < M; m += NGW) {
        const GAS unsigned long long* hr = (const GAS unsigned long long*)(HB + (size_t)m * D) + lane; GAS f32x4* orow = (GAS f32x4*)(OUT + (size_t)m * D) + lane;
        unsigned long long raw[8];
#pragma unroll
        for (int j = 0; j < 8; ++j) raw[j] = hr[64 * j];
        const float r = 1.0f / sqrtf(wave_sum(lane < 32 ? ss[(size_t)m * 32 + lane] : 0.f, lane) * (1.0f / D) + EPS);
#pragma unroll
        for (int j = 0; j < 8; ++j) { const unsigned lo = (unsigned)raw[j], hi = (unsigned)(raw[j] >> 32);
            f32x4 v = {__builtin_bit_cast(float, lo << 16), __builtin_bit_cast(float, lo & 0xffff0000u), __builtin_bit_cast(float, hi << 16), __builtin_bit_cast(float, hi & 0xffff0000u)};
            orow[64 * j] = v * r * gv[j]; }
    }
}
__device__ __forceinline__ void rmsnorm_rows_f32_inplace(GAS float* X, const GAS float* g, int gw, int NGW, int lane) {
    f32x4 gv[8];
#pragma unroll
    for (int j = 0; j < 8; ++j) gv[j] = ((const GAS f32x4*)g)[lane + 64 * j];
    for (int m = gw; m < M; m += NGW) {
        GAS f32x4* xr = (GAS f32x4*)(X + (size_t)m * D) + lane;
        f32x4 v[8]; float s = 0.f;
#pragma unroll
        for (int j = 0; j < 8; ++j) { v[j] = xr[64 * j]; s += (v[j].x * v[j].x + v[j].y * v[j].y) + (v[j].z * v[j].z + v[j].w * v[j].w); }
        const float r = 1.0f / sqrtf(wave_sum(s, lane) * (1.0f / D) + EPS);
#pragma unroll
        for (int j = 0; j < 8; ++j) xr[64 * j] = v[j] * r * gv[j];
    }
}

template <bool P_IFAST, bool OUT8 = false>
__device__ __forceinline__ void absorb_unit(const GAS float* Psrc, size_t p_ri, size_t p_rd, const GAS float* Qsrc, size_t q_rj, GAS bf16* out, size_t out_ld, float scale, const GAS float* qgain, LAS float* Ps_, LAS float* Qs_, int tid) {
    LAS bf16* Ps = (LAS bf16*)Ps_; LAS bf16* Qs = Ps + 64 * 136;
    float pv[16], qv[16];
#pragma unroll
    for (int j = 0; j < 16; ++j) { const int e = tid + 512 * j; const int i = P_IFAST ? (e & 63) : (e >> 7), d = P_IFAST ? (e >> 6) : (e & 127);
        pv[j] = Psrc[(size_t)i * p_ri + (size_t)d * p_rd];
        const int jj = e >> 7, dd = e & 127; qv[j] = Qsrc[(size_t)jj * q_rj + dd] * (qgain ? qgain[jj] : 1.0f); }
#pragma unroll
    for (int j = 0; j < 16; ++j) { const int e = tid + 512 * j; const int i = P_IFAST ? (e & 63) : (e >> 7), d = P_IFAST ? (e >> 6) : (e & 127);
        Ps[i * 136 + d] = (bf16)f2bf(pv[j]); const int jj = e >> 7, dd = e & 127; Qs[jj * 136 + dd] = (bf16)f2bf(qv[j]); }
    __syncthreads();
    const int wv = tid >> 6, ln = tid & 63, it = wv >> 1, r16 = ln & 15, g = ln >> 4;
#pragma unroll
    for (int jq = 0; jq < 2; ++jq) { const int jt = 2 * (wv & 1) + jq; f32x4 acc = {0.f, 0.f, 0.f, 0.f};
#pragma unroll
        for (int st = 0; st < 4; ++st) { const bf16x8 a = *(const LAS bf16x8*)(Ps + (16 * it + r16) * 136 + 32 * st + 8 * g); const bf16x8 b = *(const LAS bf16x8*)(Qs + (16 * jt + r16) * 136 + 32 * st + 8 * g);
            acc = __builtin_amdgcn_mfma_f32_16x16x32_bf16(a, b, acc, 0, 0, 0); }
#pragma unroll
        for (int rg = 0; rg < 4; ++rg) { const size_t o = (size_t)(16 * it + 4 * g + rg) * out_ld + 16 * jt + r16;
            if constexpr (OUT8) ((GAS unsigned char*)out)[o] = (unsigned char)__builtin_amdgcn_cvt_pk_fp8_f32(acc[rg] * scale, 0.f, 0, false);
            else out[o] = (bf16)f2bf(acc[rg] * scale); } }
    __syncthreads();
}
__device__ __forceinline__ void post_rows(const GAS bf16* Z, const GAS float* gkv, const GAS float* gki, const GAS float* bki, GAS bf16* CKVN, GAS bf16* KIN, GAS float* WIF, int gw, int NGW, int lane) {
    const f32x4 g4 = ((const GAS f32x4*)gkv)[lane]; const float gk = gki[lane], bk = bki[lane];
    for (int m = gw; m < M; m += NGW) {
        const GAS bf16* zr = Z + (size_t)m * ZLD;
        const unsigned long long raw = *(const GAS unsigned long long*)(zr + ZC_CKV + 4 * lane);
        const float kraw = bf2f(zr[ZC_KI + lane]);
        const float wraw = bf2f(zr[ZC_WI + (lane & 7)]);
        const float c0 = bf2f((unsigned short)raw), c1 = bf2f((unsigned short)(raw >> 16)), c2 = bf2f((unsigned short)(raw >> 32)), c3 = bf2f((unsigned short)(raw >> 48));
        const float r = 1.0f / sqrtf(wave_sum((c0 * c0 + c1 * c1) + (c2 * c2 + c3 * c3), lane) * (1.0f / RANK) + EPS);
        *(GAS unsigned long long*)(CKVN + (size_t)m * RANK + 4 * lane) = (unsigned long long)pk2(c0 * r * g4.x, c1 * r * g4.y) | ((unsigned long long)pk2(c2 * r * g4.z, c3 * r * g4.w) << 32);
        const float mu = wave_sum(kraw, lane) * (1.0f / IDIM); const float dv = kraw - mu;
        const float var = wave_sum(dv * dv, lane) * (1.0f / IDIM);
        KIN[(size_t)m * IDIM + lane] = (bf16)f2bf(dv * (1.0f / sqrtf(var + EPS)) * gk + bk);
        if (lane < 8) WIF[(size_t)m * IH + lane] = wraw;
    }
}
constexpr int SWA_KP = 144, SWA_VP = 192;
constexpr int SWA_K_OFF = 0, SWA_V_OFF = 160 * SWA_KP, SWA_TAB_OFF = SWA_V_OFF + 160 * SWA_VP;
static_assert(SWA_TAB_OFF + 16 * 128 * 4 <= RING_BYTES, "SWA LDS map");
__device__ __forceinline__ void swa_phase(LAS unsigned char* lds, const GAS bf16* Z, GAS bf16* O, const GAS float* rel_bias, const GAS float* sinks, int vcu, int G, int tid, int lane, int wave) {
    LAS float* tab = (LAS float*)(lds + SWA_TAB_OFF);
    for (int e = tid; e < 16 * 128; e += NWAVES * 64) { const int h = e >> 7, dist = e & 127; tab[e] = rel_bias[(int)T5_BUCKET[dist] * 24 + H_A + h]; }
    __syncthreads();
    const int q = lane & 31, hh = lane >> 5;
    const unsigned ldsb = (unsigned)(size_t)lds;
    for (int item = vcu; item < BATCH * 128 * KVH; item += G) {
        const int kvh = item & 1, qt = (item >> 1) & 127, b = item >> 8;
        const int t0 = 32 * qt, s0 = t0 - 128;
        const size_t rowbase = (size_t)b * SEQ;
        for (int c = tid; c < 1280; c += NWAVES * 64) { const int row = c >> 3, ch = c & 7; const int s = s0 + row;
            if (s >= 0) { const GAS bf16* zr = Z + (rowbase + s) * ZLD + kvh * 64 + ch * 8;
                const v4u kv = *(const GAS v4u*)(zr + ZC_KB); const v4u vv = *(const GAS v4u*)(zr + ZC_VB);
                *(LAS v4u*)(lds + SWA_K_OFF + row * SWA_KP + ch * 16) = kv; *(LAS v4u*)(lds + SWA_V_OFF + row * SWA_VP + ch * 16) = vv; } }
        const int hq = kvh * 8 + wave; const int t = t0 + q;
        bf16x8 qf[4];
#pragma unroll
        for (int st = 0; st < 4; ++st) qf[st] = *(const GAS bf16x8*)(Z + (rowbase + t) * ZLD + ZC_QB + hq * 64 + 16 * st + 8 * hh);
        __syncthreads();
        const int kt0 = qt >= 4 ? 0 : 4 - qt;
        f32x16 sacc[5];
#pragma unroll
        for (int kt = 0; kt < 5; ++kt) {
#pragma unroll
            for (int r = 0; r < 16; ++r) sacc[kt][r] = 0.f;
            if (kt >= kt0) {
#pragma unroll
                for (int st = 0; st < 4; ++st) { const bf16x8 kf = *(const LAS bf16x8*)(lds + SWA_K_OFF + (kt * 32 + q) * SWA_KP + (2 * st + hh) * 16);
                    sacc[kt] = __builtin_amdgcn_mfma_f32_32x32x16_bf16(kf, qf[st], sacc[kt], 0, 0, 0); } } }
        const float sink = sinks[hq]; float mx = sink;
        const LAS float* tabh = tab + hq * 128;
#pragma unroll
        for (int kt = 0; kt < 5; ++kt) if (kt >= kt0) {
#pragma unroll
            for (int r = 0; r < 16; ++r) { const int ko = (r & 3) + 8 * (r >> 2) + 4 * hh; const int dist = q + 128 - 32 * kt - ko;
                const float lg = (dist >= 0 && dist < WINDOW) ? sacc[kt][r] + tabh[dist & 127] : -1e30f; sacc[kt][r] = lg; mx = fmaxf(mx, lg); } }
        mx = fmaxf(mx, SHX(mx, 32));
        float l = 0.f;
#pragma unroll
        for (int kt = 0; kt < 5; ++kt) if (kt >= kt0) {
#pragma unroll
            for (int r = 0; r < 16; ++r) { const float p = __expf(sacc[kt][r] - mx); sacc[kt][r] = p; l += p; } }
        l += SHX(l, 32); l += __expf(sink - mx);
        f32x16 oacc[2];
#pragma unroll
        for (int dt = 0; dt < 2; ++dt)
#pragma unroll
            for (int r = 0; r < 16; ++r) oacc[dt][r] = 0.f;
        const unsigned vlane = ldsb + SWA_V_OFF + (unsigned)((4 * hh + ((lane & 15) >> 2)) * SWA_VP + (16 * ((lane >> 4) & 1) + 4 * (lane & 3)) * 2);
#pragma unroll
        for (int kt = 0; kt < 5; ++kt) if (kt >= kt0) {
#pragma unroll
            for (int s2 = 0; s2 < 2; ++s2) {
                bf16x8 pf; { const unsigned w0 = pg8::cvt_pk_bf16(sacc[kt][8 * s2 + 0], sacc[kt][8 * s2 + 1]), w1 = pg8::cvt_pk_bf16(sacc[kt][8 * s2 + 2], sacc[kt][8 * s2 + 3]),
                                     w2 = pg8::cvt_pk_bf16(sacc[kt][8 * s2 + 4], sacc[kt][8 * s2 + 5]), w3 = pg8::cvt_pk_bf16(sacc[kt][8 * s2 + 6], sacc[kt][8 * s2 + 7]);
                    const v4u w = {w0, w1, w2, w3}; pf = __builtin_bit_cast(bf16x8, w); }
                const unsigned a = vlane + (unsigned)((kt * 32 + 16 * s2) * SWA_VP);
                s16x4 r0, r1, r2, r3; tr_read4(a, a + 8 * SWA_VP, a + 64, a + 8 * SWA_VP + 64, r0, r1, r2, r3);
                oacc[0] = __builtin_amdgcn_mfma_f32_32x32x16_bf16(cat4(r0, r1), pf, oacc[0], 0, 0, 0);
                oacc[1] = __builtin_amdgcn_mfma_f32_32x32x16_bf16(cat4(r2, r3), pf, oacc[1], 0, 0, 0); } }
        const float inv = (OUT_F8 ? O8_SCALE : 1.0f) / l;
        if constexpr (OUT_F8) { GAS unsigned char* orow = (GAS unsigned char*)O + (rowbase + t) * OLD + 2048 + hq * 64 + 4 * hh;
#pragma unroll
            for (int dt = 0; dt < 2; ++dt)
#pragma unroll
                for (int g4 = 0; g4 < 4; ++g4) { int p = 0; p = __builtin_amdgcn_cvt_pk_fp8_f32(oacc[dt][4 * g4] * inv, oacc[dt][4 * g4 + 1] * inv, p, false); p = __builtin_amdgcn_cvt_pk_fp8_f32(oacc[dt][4 * g4 + 2] * inv, oacc[dt][4 * g4 + 3] * inv, p, true);
                    *(GAS unsigned*)(orow + 32 * dt + 8 * g4) = (unsigned)p; } }
        else { GAS bf16* orow = O + (rowbase + t) * OLD + 2048 + hq * 64 + 4 * hh;
#pragma unroll
        for (int dt = 0; dt < 2; ++dt)
#pragma unroll
            for (int g4 = 0; g4 < 4; ++g4) { const unsigned long long w = (unsigned long long)pk2(oacc[dt][4 * g4] * inv, oacc[dt][4 * g4 + 1] * inv) | ((unsigned long long)pk2(oacc[dt][4 * g4 + 2] * inv, oacc[dt][4 * g4 + 3] * inv) << 32);
                *(GAS unsigned long long*)(orow + 32 * dt + 8 * g4) = w; } }
        __syncthreads();
    }
}
constexpr int TK_BINS = 512, TK_CAP = 256;
#define LDS_ADD(p) __hip_atomic_fetch_add((p), 1u, __ATOMIC_RELAXED, __HIP_MEMORY_SCOPE_WORKGROUP)
#define LDS_ADDV(p, v) __hip_atomic_fetch_add((p), (v), __ATOMIC_RELAXED, __HIP_MEMORY_SCOPE_WORKGROUP)
#define HIST_WORD(tok, bin) (((tok) * TK_BINS + (bin)) >> 1)
#define HIST_INC(bin) (1u << (((bin) & 1) * 16))
constexpr int TK_HIST_OFF = 0, TK_CSC_OFF = 32768, TK_CIX_OFF = TK_CSC_OFF + 32 * TK_CAP * 4, TK_SEL_OFF = TK_CIX_OFF + 32 * TK_CAP * 2, TK_CNT_OFF = TK_SEL_OFF + 32 * 256 * 2, TK_DUM_OFF = TK_CNT_OFF + 32 * 2 * 4, TK_KB_OFF = TK_DUM_OFF + 8 * 64 * 4, TK_KB_BYTES = 64 * 144, TK_FLAG_OFF = TK_KB_OFF + 2 * TK_KB_BYTES;
static_assert(TK_FLAG_OFF + 16 <= RING_BYTES, "top-k LDS map");
typedef _Float16 tk_h2 __attribute__((ext_vector_type(2)));
__device__ __forceinline__ void tk_score2(const f32x16& acc, const tk_h2 (&wh)[8], float& s0, float& s1) {
    tk_h2 s = {(_Float16)0, (_Float16)0}; const tk_h2 zero = {(_Float16)0, (_Float16)0};
#pragma unroll
    for (int h = 0; h < 8; ++h) { tk_h2 d = __builtin_bit_cast(tk_h2, __builtin_amdgcn_cvt_pkrtz(acc[h], acc[8 + h])); d = __builtin_elementwise_max(d, zero); s = __builtin_elementwise_fma(wh[h], d, s); }
    s0 = (float)s.x; s1 = (float)s.y;
}
__device__ __forceinline__ float tk_x(float s, float sc) { return fmaf(s, sc, 256.0f); }
__device__ __forceinline__ int tk_key(float s, float sc) {
    const float x = tk_x(s, sc); int b0 = (int)x; b0 = b0 < 0 ? 0 : (b0 > TK_BINS - 1 ? TK_BINS - 1 : b0);
    int sub = (int)((x - (float)b0) * 512.0f); sub = sub < 0 ? 0 : (sub > 511 ? 511 : sub);
    return b0 * 512 + sub;
}
__device__ __forceinline__ void tk_find(const LAS unsigned* h, unsigned need, int lane, int& bin_out, unsigned& above_out) {
    unsigned v[8]; unsigned s = 0;
#pragma unroll
    for (int i = 0; i < 4; ++i) { const unsigned w = h[4 * lane + i]; v[2 * i] = w & 0xffffu; v[2 * i + 1] = w >> 16; s += v[2 * i] + v[2 * i + 1]; }
    unsigned S = s;
#pragma unroll
    for (int o = 1; o < 64; o <<= 1) { const unsigned t = (unsigned)__builtin_amdgcn_ds_bpermute((lane + o) << 2, (int)S); if (lane + o < 64) S += t; }
    const unsigned long long mask = __ballot(S >= need);
    const int Lm = mask ? 63 - __builtin_clzll(mask) : 0;
    unsigned cum = S - s; int bsel = 8 * lane; unsigned ab = cum; bool found = false;
#pragma unroll
    for (int i = 7; i >= 0; --i) { if (!found) { if (cum + v[i] >= need) { bsel = 8 * lane + i; ab = cum; found = true; } else cum += v[i]; } }
    bin_out = __builtin_amdgcn_readlane(bsel, Lm); above_out = (unsigned)__builtin_amdgcn_readlane((int)ab, Lm);
}
__device__ __forceinline__ void topk_phase(LAS unsigned char* lds, const GAS bf16* Z, const GAS bf16* KIN, const GAS float* WIF, GAS unsigned short* IDX, int vcu, int G, int lane, int wave) {
    LAS unsigned* hist = (LAS unsigned*)(lds + TK_HIST_OFF) + wave * 4 * (TK_BINS / 2);
    LAS float* csc = (LAS float*)(lds + TK_CSC_OFF) + wave * 4 * TK_CAP;
    LAS unsigned short* cix = (LAS unsigned short*)(lds + TK_CIX_OFF) + wave * 4 * TK_CAP;
    LAS unsigned short* sel = (LAS unsigned short*)(lds + TK_SEL_OFF) + wave * 4 * 256;
    LAS unsigned* cnt = (LAS unsigned*)(lds + TK_CNT_OFF) + wave * 8;
    LAS unsigned* dum = (LAS unsigned*)(lds + TK_DUM_OFF) + wave * 64 + lane;
    const int n = lane & 31, c = lane >> 5;
    const int am = (lane >> 4) & 1, bbm = (lane >> 3) & 1, ccm = (lane >> 2) & 1, dm = lane & 3;
    for (int p2 = vcu; p2 < BATCH * 64; p2 += G) {
#pragma unroll 1
        for (int half = 0; half < 2; ++half) {
            const int b = p2 >> 6, jj = p2 & 63, j = half ? 127 - jj : jj;
            const int t0 = 32 * j + 4 * wave; const size_t rb = (size_t)b * SEQ;
            bf16x8 qa[4];
#pragma unroll
            for (int st = 0; st < 4; ++st) qa[st] = *(const GAS bf16x8*)(Z + (rb + t0 + 2 * ccm + am) * ZLD + ZC_QI + (4 * bbm + dm) * 64 + 16 * st + 8 * c);
            float w0[8], w1[8];
            { const GAS f32x4* wp = (const GAS f32x4*)(WIF + (rb + t0 + 2 * c) * IH); const f32x4 x0 = wp[0], x1 = wp[1], x2 = wp[2], x3 = wp[3];
              w0[0] = x0.x; w0[1] = x0.y; w0[2] = x0.z; w0[3] = x0.w; w0[4] = x1.x; w0[5] = x1.y; w0[6] = x1.z; w0[7] = x1.w;
              w1[0] = x2.x; w1[1] = x2.y; w1[2] = x2.z; w1[3] = x2.w; w1[4] = x3.x; w1[5] = x3.y; w1[6] = x3.z; w1[7] = x3.w; }
            tk_h2 wh[8];
#pragma unroll
            for (int h = 0; h < 8; ++h) { wh[h].x = (_Float16)w0[h]; wh[h].y = (_Float16)w1[h]; }
            float scA, scB;
            { float a = 0.f, bq = 0.f;
#pragma unroll
              for (int h = 0; h < 8; ++h) { a = fmaf(w0[h], w0[h], a); bq = fmaf(w1[h], w1[h], bq); }
              scA = 32.0f / fmaxf(sqrtf(32.0f * a), 1e-20f); scB = 32.0f / fmaxf(sqrtf(32.0f * bq), 1e-20f); }
            const int tA = t0 + 2 * c, tB = tA + 1;
            for (int i = lane; i < 4 * (TK_BINS / 2); i += 64) hist[i] = 0u;
            for (int i = lane; i < 4 * 128; i += 64) ((LAS unsigned*)sel)[i] = 0u;
            if (lane < 8) cnt[lane] = 0u;
            asm volatile("s_waitcnt lgkmcnt(0)" ::: "memory");
            int lo[4], hi[4]; unsigned ab0[4]; bool ov[4];
#pragma unroll
            for (int tk = 0; tk < 4; ++tk) { lo[tk] = 0x7fffffff; hi[tk] = -1; ab0[tk] = 0u; ov[tk] = false; }
            const bool need_sel = (t0 + 3) >= TOPK;
            const GAS bf16* kbase = KIN + (rb + n) * IDIM + 8 * c;
            const int tidk = wave * 64 + lane; const int ng = (j + 2) >> 1;
            const GAS bf16* kg0 = KIN + (rb + (tidk >> 3)) * IDIM + (tidk & 7) * 8; const int koff = (tidk >> 3) * 144 + (tidk & 7) * 16;
            LAS unsigned char* kbuf = lds + TK_KB_OFF; volatile LAS unsigned* sflag = (volatile LAS unsigned*)(lds + TK_FLAG_OFF);
            if (tidk == 0) *sflag = 0u;
#define TK_PRIME() { const v4u kr0 = *(const GAS v4u*)kg0; *(LAS v4u*)(kbuf + koff) = kr0; } __syncthreads();
#define TK_GROUP_BEGIN() \
                v4u kr = {0u, 0u, 0u, 0u}; const bool more = g + 1 < ng; \
                if (more) kr = *(const GAS v4u*)(kg0 + (size_t)(g + 1) * 64 * IDIM); \
                const LAS unsigned char* kb_ = kbuf + (g & 1) * TK_KB_BYTES; \
                float s0v[2], s1v[2];     \
                { f32x16 accv[2]; \
                  _Pragma("unroll") for (int u4 = 0; u4 < 2; ++u4) { _Pragma("unroll") for (int r = 0; r < 16; ++r) accv[u4][r] = 0.f; \
                    _Pragma("unroll") for (int st = 0; st < 4; ++st) { const bf16x8 kf = *(const LAS bf16x8*)(kb_ + (32 * u4 + n) * 144 + (2 * st + c) * 16); accv[u4] = __builtin_amdgcn_mfma_f32_32x32x16_bf16(qa[st], kf, accv[u4], 0, 0, 0); } } \
                  _Pragma("unroll") for (int u4 = 0; u4 < 2; ++u4) tk_score2(accv[u4], wh, s0v[u4], s1v[u4]); } \
                _Pragma("unroll") for (int u4 = 0; u4 < 2; ++u4) { \
                    const float s0 = s0v[u4], s1 = s1v[u4]; const int s = 32 * (2 * g + u4) + n;
#define TK_GROUP_END() } \
                if (more) *(LAS v4u*)(kbuf + ((g + 1) & 1) * TK_KB_BYTES + koff) = kr; \
                __syncthreads();
            bool slow = false;
            if (need_sel) {
                {   TK_PRIME();
#pragma unroll 1
                    for (int g = 0; g < ng; ++g) { TK_GROUP_BEGIN()
                        int b0 = (int)tk_x(s0, scA), b1 = (int)tk_x(s1, scB); b0 = b0 < 0 ? 0 : (b0 > TK_BINS - 1 ? TK_BINS - 1 : b0); b1 = b1 < 0 ? 0 : (b1 > TK_BINS - 1 ? TK_BINS - 1 : b1);
                        LAS unsigned* p0 = (s <= tA) ? &hist[HIST_WORD(2 * c, b0)] : dum; LAS unsigned* p1 = (s <= tB) ? &hist[HIST_WORD(2 * c + 1, b1)] : dum;
                        LDS_ADDV(p0, HIST_INC(b0)); LDS_ADDV(p1, HIST_INC(b1));
                        TK_GROUP_END() }
                }
                asm volatile("s_waitcnt lgkmcnt(0)" ::: "memory");
#pragma unroll
                for (int tk = 0; tk < 4; ++tk) { int bin; unsigned above; tk_find(hist + tk * (TK_BINS / 2), (unsigned)TOPK, lane, bin, above);
                    const unsigned ceq = (hist[HIST_WORD(tk, bin)] >> ((bin & 1) * 16)) & 0xffffu; ov[tk] = ceq > (unsigned)TK_CAP; slow |= ov[tk]; ab0[tk] = above; lo[tk] = bin * 512; hi[tk] = bin * 512 + 511; }
                if (slow && lane == 0) *sflag = 1u;
                __syncthreads();
                slow = *sflag != 0u;
            }
            if (!slow) {
                float thi[4], tlo[4];
#pragma unroll
                for (int tk = 0; tk < 4; ++tk) { const int bin = lo[tk] >> 9;
                    thi[tk] = !need_sel ? -__builtin_inff() : (bin >= TK_BINS - 1 ? __builtin_inff() : (float)(bin + 1));
                    tlo[tk] = !need_sel ? __builtin_inff() : (bin == 0 ? -__builtin_inff() : (float)bin); }
                const float thiA = c ? thi[2] : thi[0], tloA = c ? tlo[2] : tlo[0], thiB = c ? thi[3] : thi[1], tloB = c ? tlo[3] : tlo[1];
                unsigned cntA = 0u, cntB = 0u;
                LAS unsigned short* selA = sel + (2 * c) * 256; LAS unsigned short* selB = sel + (2 * c + 1) * 256; LAS unsigned short* dum16 = (LAS unsigned short*)dum;
                TK_PRIME();
#pragma unroll 1
                for (int g = 0; g < ng; ++g) { TK_GROUP_BEGIN()
                    const float x0 = (s <= tA) ? tk_x(s0, scA) : __builtin_nanf(""), x1 = (s <= tB) ? tk_x(s1, scB) : __builtin_nanf("");
                    const bool a0 = x0 >= thiA, a1 = x1 >= thiB; const bool c0 = !a0 && x0 >= tloA, c1 = !a1 && x1 >= tloB;
                    const unsigned long long m0 = __ballot(a0), m1 = __ballot(a1);
                    const unsigned pre0 = c ? __builtin_amdgcn_mbcnt_hi((unsigned)(m0 >> 32), 0u) : __builtin_amdgcn_mbcnt_lo((unsigned)m0, 0u);
                    const unsigned pre1 = c ? __builtin_amdgcn_mbcnt_hi((unsigned)(m1 >> 32), 0u) : __builtin_amdgcn_mbcnt_lo((unsigned)m1, 0u);
                    const unsigned pos0 = cntA + pre0, pos1 = cntB + pre1;
                    LAS unsigned short* q0 = (a0 && pos0 < 256u) ? selA + pos0 : dum16; LAS unsigned short* q1 = (a1 && pos1 < 256u) ? selB + pos1 : dum16;
                    *q0 = (unsigned short)s; *q1 = (unsigned short)s;
                    cntA += c ? (unsigned)__builtin_popcount((unsigned)(m0 >> 32)) : (unsigned)__builtin_popcount((unsigned)m0);
                    cntB += c ? (unsigned)__builtin_popcount((unsigned)(m1 >> 32)) : (unsigned)__builtin_popcount((unsigned)m1);
                    if (__ballot(c0 || c1)) {
                        if (c0) { const unsigned pos = LDS_ADD(&cnt[(2 * c) * 2 + 1]); if (pos < (unsigned)TK_CAP) { csc[(2 * c) * TK_CAP + pos] = s0; cix[(2 * c) * TK_CAP + pos] = (unsigned short)s; } }
                        if (c1) { const unsigned pos = LDS_ADD(&cnt[(2 * c + 1) * 2 + 1]); if (pos < (unsigned)TK_CAP) { csc[(2 * c + 1) * TK_CAP + pos] = s1; cix[(2 * c + 1) * TK_CAP + pos] = (unsigned short)s; } } }
                    TK_GROUP_END() }
                if ((lane & 31) == 0) { cnt[(2 * c) * 2] = cntA; cnt[(2 * c + 1) * 2] = cntB; }
                asm volatile("s_waitcnt lgkmcnt(0)" ::: "memory");
            } else {
                for (int i = lane; i < 4 * (TK_BINS / 2); i += 64) hist[i] = 0u;
                asm volatile("s_waitcnt lgkmcnt(0)" ::: "memory");
                int mode = 1;
#pragma unroll 1
                for (;;) {
                const int klo0 = c ? lo[2] : lo[0], khi0 = c ? hi[2] : hi[0], klo1 = c ? lo[3] : lo[1], khi1 = c ? hi[3] : hi[1];
                const bool ov0 = c ? ov[2] : ov[0], ov1 = c ? ov[3] : ov[1];
                bf16x8 kb[4][4];
#pragma unroll
                for (int u4 = 0; u4 < 4; ++u4) { const int kq = u4 < j ? u4 : j;
#pragma unroll
                    for (int st = 0; st < 4; ++st) kb[u4][st] = *(const GAS bf16x8*)(kbase + (size_t)kq * 32 * IDIM + 16 * st); }
#pragma unroll 1
                for (int kt = 0; kt <= j; kt += 4) {
                    bf16x8 kn[4][4];
#pragma unroll
                    for (int u4 = 0; u4 < 4; ++u4) { const int kq = kt + 4 + u4 < j ? kt + 4 + u4 : j;
#pragma unroll
                        for (int st = 0; st < 4; ++st) kn[u4][st] = *(const GAS bf16x8*)(kbase + (size_t)kq * 32 * IDIM + 16 * st); }
#pragma unroll
                    for (int u4 = 0; u4 < 4; ++u4) {
                        f32x16 acc;
#pragma unroll
                        for (int r = 0; r < 16; ++r) acc[r] = 0.f;
#pragma unroll
                        for (int st = 0; st < 4; ++st) acc = __builtin_amdgcn_mfma_f32_32x32x16_bf16(qa[st], kb[u4][st], acc, 0, 0, 0);
                        float s0, s1; tk_score2(acc, wh, s0, s1);
                        const int s = 32 * (kt + u4) + n; const int k0 = tk_key(s0, scA), k1 = tk_key(s1, scB);
                        const bool v0 = s <= tA, v1 = s <= tB;
                        if (mode == 0) {
                            if (v0 && tA >= TOPK) LDS_ADDV(&hist[HIST_WORD(2 * c, k0 >> 9)], HIST_INC(k0 >> 9));
                            if (v1 && tB >= TOPK) LDS_ADDV(&hist[HIST_WORD(2 * c + 1, k1 >> 9)], HIST_INC(k1 >> 9));
                        } else if (mode == 1) {
                            if (v0 && ov0 && k0 >= klo0 && k0 <= khi0) LDS_ADDV(&hist[HIST_WORD(2 * c, k0 & 511)], HIST_INC(k0 & 511));
                            if (v1 && ov1 && k1 >= klo1 && k1 <= khi1) LDS_ADDV(&hist[HIST_WORD(2 * c + 1, k1 & 511)], HIST_INC(k1 & 511));
                        } else {
                            if (v0) { if (k0 > khi0) { const unsigned pos = LDS_ADD(&cnt[(2 * c) * 2]); if (pos < 256u) sel[(2 * c) * 256 + pos] = (unsigned short)s; }
                                      else if (k0 >= klo0) { const unsigned pos = LDS_ADD(&cnt[(2 * c) * 2 + 1]); if (pos < (unsigned)TK_CAP) { csc[(2 * c) * TK_CAP + pos] = s0; cix[(2 * c) * TK_CAP + pos] = (unsigned short)s; } } }
                            if (v1) { if (k1 > khi1) { const unsigned pos = LDS_ADD(&cnt[(2 * c + 1) * 2]); if (pos < 256u) sel[(2 * c + 1) * 256 + pos] = (unsigned short)s; }
                                      else if (k1 >= klo1) { const unsigned pos = LDS_ADD(&cnt[(2 * c + 1) * 2 + 1]); if (pos < (unsigned)TK_CAP) { csc[(2 * c + 1) * TK_CAP + pos] = s1; cix[(2 * c + 1) * TK_CAP + pos] = (unsigned short)s; } } }
                        }
                    }
#pragma unroll
                    for (int u4 = 0; u4 < 4; ++u4)
#pragma unroll
                        for (int st = 0; st < 4; ++st) kb[u4][st] = kn[u4][st];
                }
                    asm volatile("s_waitcnt lgkmcnt(0)" ::: "memory");
                    if (mode == 2) break;
#pragma unroll
                    for (int tk = 0; tk < 4; ++tk) if (ov[tk]) { int sub; unsigned above; tk_find(hist + tk * (TK_BINS / 2), (unsigned)TOPK - ab0[tk], lane, sub, above); lo[tk] += sub; hi[tk] = lo[tk]; }
                    mode = 2;
                }
            }
#undef TK_GROUP_BEGIN
#undef TK_GROUP_END
#undef TK_PRIME
#pragma unroll 1
            for (int tk = 0; tk < 4; ++tk) { const int t = t0 + tk;
                if (t >= TOPK) { const unsigned nsel = cnt[tk * 2]; unsigned nc = cnt[tk * 2 + 1]; nc = nc > (unsigned)TK_CAP ? (unsigned)TK_CAP : nc; const unsigned need = nsel < 256u ? 256u - nsel : 0u;
                    for (unsigned q = 0; q * 64 < nc; ++q) { const unsigned i = lane + 64 * q;
                        const float si = i < nc ? csc[tk * TK_CAP + i] : 0.f; const unsigned xi = i < nc ? cix[tk * TK_CAP + i] : 0u; unsigned rank = 0;
                        for (unsigned jx = 0; jx < nc; ++jx) { const float sj = csc[tk * TK_CAP + jx]; const unsigned xj = cix[tk * TK_CAP + jx]; rank += (sj > si || (sj == si && xj < xi)) ? 1u : 0u; }
                        if (i < nc && rank < need) sel[tk * 256 + nsel + rank] = (unsigned short)xi; } } }
            asm volatile("s_waitcnt lgkmcnt(0)" ::: "memory");
            { const LAS v4u* sv = (const LAS v4u*)sel; GAS v4u* ov = (GAS v4u*)(IDX + (rb + t0) * TOPK);
              ov[lane] = sv[lane]; ov[lane + 64] = sv[lane + 64]; }
            asm volatile("s_waitcnt vmcnt(0) lgkmcnt(0)" ::: "memory");
        }
    }
}
constexpr int DSA_TAB_OFF = RING_BYTES + 1024;
static_assert(DSA_TAB_OFF + 8 * 129 * 4 <= LDS_BYTES, "DSA LDS map");
__device__ __forceinline__ void dsa_phase(LAS unsigned char* lds_all, const GAS bf16* Z, const GAS bf16* CKVN, const GAS unsigned short* IDX, GAS bf16* O, const GAS float* rel_bias, int gw, int NGW, int tid, int lane, int wave) {
    LAS float* tab = (LAS float*)(lds_all + DSA_TAB_OFF);
    for (int e = tid; e < 8 * 129; e += NWAVES * 64) { const int hh = e / 129, dist = e - hh * 129; tab[e] = rel_bias[(dist < 128 ? (int)T5_BUCKET[dist] : 31) * 24 + hh]; }
    __syncthreads();
    LAS unsigned char* img = lds_all + RING_OFF + wave * 16384;
    const unsigned imgb = (unsigned)(size_t)img;
    const int h = lane & 15, g = lane >> 4;
    const LAS float* tabh = tab + (h & 7) * 129;
    const int TPW = (M + NGW - 1) / NGW;
    const int tok_end = (gw + 1) * TPW < M ? (gw + 1) * TPW : M;
    const int xq = 2 * (lane & 7);
    const int qk_off = (lane & 15) * 512;
    const int q4 = (lane & 15) >> 2, p4 = lane & 3; const int xr = 2 * (4 * (g & 1) + q4);
    const unsigned pv_base = imgb + (unsigned)((4 * g + q4) * 512 + 8 * (p4 & 1));
#pragma unroll 1
    for (int tok = gw * TPW; tok < tok_end; ++tok) {
        const int t = tok & (SEQ - 1); const size_t rb = (size_t)(tok - t);
        const int nsel = t + 1 < TOPK ? t + 1 : TOPK;
        bf16x8 qf[8];
#pragma unroll
        for (int st = 0; st < 8; ++st) { qf[st] = *(const GAS bf16x8*)(Z + (size_t)tok * ZLD + ZC_QLAT + (h & 7) * 256 + 32 * st + 8 * g); if (h >= 8) qf[st] = (bf16x8){0, 0, 0, 0, 0, 0, 0, 0}; }
        f32x4 oacc[16];
#pragma unroll
        for (int rt = 0; rt < 16; ++rt) oacc[rt] = (f32x4){0.f, 0.f, 0.f, 0.f};
        float mrun = -1e30f, lsum = 0.f;
        const GAS unsigned short* ip = IDX + (size_t)tok * TOPK;
        int ixa[8];
#pragma unroll
        for (int ch = 0; ch < 8; ++ch) ixa[ch] = (int)ip[32 * ch + (lane & 31)];
        unsigned long long i0n = *(const GAS unsigned long long*)(ip + 4 * g), i1n = *(const GAS unsigned long long*)(ip + 16 + 4 * g);
#pragma unroll
        for (int ch = 0; ch < 8; ++ch) {
            if (32 * ch >= nsel) break;
            const int ixv = ixa[ch];
            const unsigned long long i0 = i0n, i1 = i1n;
            if (ch < 7) { i0n = *(const GAS unsigned long long*)(ip + 32 * (ch + 1) + 4 * g); i1n = *(const GAS unsigned long long*)(ip + 32 * (ch + 1) + 16 + 4 * g); }
            asm volatile("s_waitcnt lgkmcnt(0)" ::: "memory");
#pragma unroll
            for (int i = 0; i < 16; ++i) { const int r0 = __builtin_amdgcn_readlane(ixv, 2 * i), r1 = __builtin_amdgcn_readlane(ixv, 2 * i + 1);
                const int row = 2 * i + (lane >> 5); const int ridx = lane < 32 ? r0 : r1; const int chunk = (lane & 31) ^ (2 * (row & 7));
                const GAS unsigned char* src = (const GAS unsigned char*)(CKVN + (rb + ridx) * RANK) + chunk * 16;
                __builtin_amdgcn_global_load_lds((const GAS unsigned*)src, (LAS unsigned*)(img + i * 1024), 16, 0, 0); }
            asm volatile("s_waitcnt vmcnt(0)" ::: "memory");
            f32x4 sa[2];
#pragma unroll
            for (int tl = 0; tl < 2; ++tl) { sa[tl] = (f32x4){0.f, 0.f, 0.f, 0.f};
#pragma unroll
                for (int st = 0; st < 8; ++st) { const bf16x8 a = *(const LAS bf16x8*)(img + qk_off + tl * 16 * 512 + (((4 * st + g) ^ xq) * 16));
                    sa[tl] = __builtin_amdgcn_mfma_f32_16x16x32_bf16(a, qf[st], sa[tl], 0, 0, 0); } }
            float lg[8]; float cmax = -1e30f;
#pragma unroll
            for (int e = 0; e < 8; ++e) { const int tl = e >> 2, jx = e & 3; const int kk = 32 * ch + 16 * tl + 4 * g + jx;
                const int sidx = (int)(((tl ? i1 : i0) >> (16 * jx)) & 0xffffull); int dd = t - sidx; dd = dd < 0 ? 0 : (dd > 128 ? 128 : dd);
                const float v = kk < nsel ? sa[tl][jx] + tabh[dd] : -1e30f; lg[e] = v; cmax = fmaxf(cmax, v); }
            cmax = fmaxf(cmax, SHX(cmax, 16)); cmax = fmaxf(cmax, SHX(cmax, 32));
            const float mnew = fmaxf(mrun, cmax);
            if (__any(mnew > mrun)) { const float alpha = __expf(mrun - mnew); lsum *= alpha;
#pragma unroll
                for (int rt = 0; rt < 16; ++rt) oacc[rt] = oacc[rt] * alpha; }
            mrun = mnew;
            float pe[8];
#pragma unroll
            for (int e = 0; e < 8; ++e) { pe[e] = __expf(lg[e] - mnew); lsum += pe[e]; }
            bf16x8 pf; { const v4u wv = {pg8::cvt_pk_bf16(pe[0], pe[1]), pg8::cvt_pk_bf16(pe[2], pe[3]), pg8::cvt_pk_bf16(pe[4], pe[5]), pg8::cvt_pk_bf16(pe[6], pe[7])}; pf = __builtin_bit_cast(bf16x8, wv); }
#pragma unroll
            for (int rt = 0; rt < 16; rt += 2) {
                const unsigned a0 = pv_base + (unsigned)((((2 * rt) ^ xr) | (p4 >> 1)) * 16), a1 = pv_base + (unsigned)((((2 * rt + 2) ^ xr) | (p4 >> 1)) * 16);
                s16x4 r0, r1, r2, r3; tr_read4(a0, a0 + 16 * 512, a1, a1 + 16 * 512, r0, r1, r2, r3);
                oacc[rt] = __builtin_amdgcn_mfma_f32_16x16x32_bf16(cat4(r0, r1), pf, oacc[rt], 0, 0, 0);
                oacc[rt + 1] = __builtin_amdgcn_mfma_f32_16x16x32_bf16(cat4(r2, r3), pf, oacc[rt + 1], 0, 0, 0); }
        }
        lsum += SHX(lsum, 16); lsum += SHX(lsum, 32);
        const float inv = (OUT_F8 ? O8_SCALE : 1.0f) / lsum;
        if (h < 8) {
            if constexpr (OUT_F8) { GAS unsigned char* orow = (GAS unsigned char*)O + (size_t)tok * OLD + h * 256 + 4 * g;
#pragma unroll
                for (int rt = 0; rt < 16; ++rt) { int p = 0; p = __builtin_amdgcn_cvt_pk_fp8_f32(oacc[rt][0] * inv, oacc[rt][1] * inv, p, false); p = __builtin_amdgcn_cvt_pk_fp8_f32(oacc[rt][2] * inv, oacc[rt][3] * inv, p, true); *(GAS unsigned*)(orow + 16 * rt) = (unsigned)p; } }
            else { GAS bf16* orow = O + (size_t)tok * OLD + h * 256 + 4 * g;
#pragma unroll
            for (int rt = 0; rt < 16; ++rt) *(GAS unsigned long long*)(orow + 16 * rt) = (unsigned long long)pk2(oacc[rt][0] * inv, oacc[rt][1] * inv) | ((unsigned long long)pk2(oacc[rt][2] * inv, oacc[rt][3] * inv) << 32); } }
    }
}
struct Args { const float* in[20]; float* out; unsigned char* ws; };
__device__ __forceinline__ unsigned long long karg_u64(int idx) { unsigned long long r; const unsigned off = (unsigned)idx * 8u;
    asm volatile("s_load_dwordx2 %0, %1, %2\n\ts_waitcnt lgkmcnt(0)" : "=s"(r) : "s"(__builtin_amdgcn_kernarg_segment_ptr()), "s"(off) : "memory"); return r; }
__device__ __forceinline__ const GAS float* karg_in(int i) { return (const GAS float*)karg_u64(i); }
__device__ __forceinline__ GAS float* karg_out() { return (GAS float*)karg_u64(20); }
__device__ __forceinline__ GAS unsigned char* karg_ws() { return (GAS unsigned char*)karg_u64(21); }
#ifndef REP_P0
#define REP_P0 1
#endif
#ifndef REP_NORM
#define REP_NORM 1
#endif
#ifndef REP_GU
#define REP_GU 1
#endif
#ifndef REP_IN
#define REP_IN 1
#endif
#ifndef REP_POST
#define REP_POST 1
#endif
#ifndef REP_TOPK
#define REP_TOPK 1
#endif
#ifndef REP_DSA
#define REP_DSA 1
#endif
#define REPEAT(n) _Pragma("unroll 1") for (int rep_ = 0; rep_ < (n); ++rep_)
#define PHASE_IDS() int wave = wave0; asm volatile("" : "+s"(wave)); int lane; asm volatile("v_mbcnt_lo_u32_b32 %0, -1, 0\n\tv_mbcnt_hi_u32_b32 %0, -1, %0" : "=v"(lane)); const int tid = wave * 64 + lane; int bx = blockIdx.x; asm volatile("" : "+s"(bx)); int G = gridDim.x; asm volatile("" : "+s"(G)); \
    const int vcu = (G % 8 == 0) ? (bx % 8) * (G / 8) + bx / 8 : bx; const int gw = vcu * NWAVES + wave, NGW = G * NWAVES; \
    GAS unsigned char* ws = karg_ws(); (void)lane; (void)gw; (void)NGW; (void)vcu; (void)ws
__global__ void __launch_bounds__(NWAVES * 64, 2) mk_fwd(Args args) {
    extern __shared__ __attribute__((aligned(16))) unsigned char lds_raw[];
    LAS unsigned char* lds = (LAS unsigned char*)lds_raw;
    volatile LAS unsigned* MISC = (volatile LAS unsigned*)(lds + MISC_OFF);
    const int wave0 = __builtin_amdgcn_readfirstlane(threadIdx.x >> 6);
    for (int u = threadIdx.x; u < (LDS_BYTES - LDSCTL_OFF) / 4; u += NWAVES * 64) ((LAS unsigned*)(lds + LDSCTL_OFF))[u] = 0u;
    __syncthreads();
    (void)xcd_barrier_post((unsigned*)((gu32*)(karg_ws() + WS_CTL) + CW_BAR), MISC + 8, threadIdx.x == 0);
#define GRID_BAR() do { XcdBarrier b_; b_.bar = (unsigned*)((gu32*)(karg_ws() + WS_CTL) + CW_BAR); b_.x = xb_xcc_id(); b_.st = MISC + 8; int w_ = wave0; asm volatile("" : "+s"(w_)); int l_; asm volatile("v_mbcnt_lo_u32_b32 %0, -1, 0\n\tv_mbcnt_hi_u32_b32 %0, -1, %0" : "=v"(l_)); xcd_barrier(b_, (w_ | l_) == 0); } while (0)

    REPEAT(REP_P0) {   PHASE_IDS();
        LAS float* scr = (LAS float*)(lds + RING_OFF + wave * 16384);
        rows_bf16_ss(karg_in(0), (GAS bf16*)(ws + WS_XN), f8_on(0, 0) ? (GAS unsigned char*)(ws + WS_HB8) : (GAS unsigned char*)nullptr, (GAS float*)(ws + WS_SS), gw, NGW, lane);
        constexpr int I_GU = (D / 64) * (FF / 32), I_DN = (FF / 64) * (D / 32);
        constexpr int I_FFN = 2 * I_GU + I_DN, I_IN = 72 * (D / 64), I_OB = (1024 / 64) * (D / 32);
        constexpr int PER_LAYER = 2 * I_FFN + I_IN + I_OB;
        for (int it = gw; it < DEPTH * PER_LAYER; it += NGW) {
            const int l = it / PER_LAYER; int r = it - l * PER_LAYER;
            GAS unsigned char* wl = ws + WS_W0 + (size_t)l * W_LAYER;
            if (r < 2 * I_FFN) {
                const int f = r / I_FFN; r -= f * I_FFN;
                GAS bf16* dgu = (GAS bf16*)(wl + (f ? WO_GU2 : WO_GU1)); GAS bf16* dd = (GAS bf16*)(wl + (f ? WO_D2 : WO_D1));
                if (r < 2 * I_GU) { const int up = r >= I_GU; if (up) r -= I_GU; const int kb = r / (FF / 32), nb = r % (FF / 32), n0 = 32 * nb;
                    const GAS float* wsrc = karg_in(up ? (f ? 17 : 4) : (f ? 16 : 3)) + (size_t)l * D * FF;
                    const int drow = (n0 >> 7) * 256 + (up ? 128 : 0) + (n0 & 127);
                    if (f8_on(l, f)) { if constexpr (GU_I8) conv_item<2>(wsrc, FF, 64 * kb, n0, 32, dgu, D, drow, 0, W8I_SCALE, karg_in(f ? 15 : 2) + (size_t)l * D, scr, lane); else conv_item<1>(wsrc, FF, 64 * kb, n0, 32, dgu, D, drow, 0, W8_SCALE, karg_in(f ? 15 : 2) + (size_t)l * D, scr, lane); }
                    else conv_item(wsrc, FF, 64 * kb, n0, 32, dgu, D, drow, 0, 1.0f, karg_in(f ? 15 : 2) + (size_t)l * D, scr, lane); }
                else { r -= 2 * I_GU; const int kb = r / (D / 32), nb = r % (D / 32);
                    if (d8_on(l, f)) conv_item<1>(karg_in(f ? 18 : 5) + (size_t)l * FF * D, D, 64 * kb, 32 * nb, 32, dd, FF, 32 * nb, 0, W8_SCALE, nullptr, scr, lane);
                    else conv_item(karg_in(f ? 18 : 5) + (size_t)l * FF * D, D, 64 * kb, 32 * nb, 32, dd, FF, 32 * nb, 0, 1.0f, nullptr, scr, lane); }
            } else if (r < 2 * I_FFN + I_IN) {
                r -= 2 * I_FFN; const int j = r >> 5, kb = r & 31; int src, nvalid = 32; float sc = 1.0f;
                if (j < 8) src = 1024 + 32 * j;
                else if (j < 24) src = 1280 + 32 * (j - 8);
                else if (j < 56) { src = 1864 + 32 * (j - 24); sc = 0.125f; }
                else if (j < 60) src = 2888 + 32 * (j - 56);
                else if (j < 64) src = 3016 + 32 * (j - 60);
                else if (j < 66) src = 1792 + 32 * (j - 64);
                else if (j == 66) { src = 1856; nvalid = 8; sc = 0.044194173824159216f; }
                else { src = 0; nvalid = 0; }
                conv_item(karg_in(7) + (size_t)l * D * D_IN, D_IN, 64 * kb, src, nvalid, (GAS bf16*)(wl + WO_IN), D, 2048 + 32 * j, 0, sc, karg_in(6) + (size_t)l * D, scr, lane);
            } else {
                r -= 2 * I_FFN + I_IN; const int kb = r >> 6, nb = r & 63;
                if constexpr (OUT_F8) conv_item<1>(karg_in(14) + (size_t)l * D * D + (size_t)1024 * D, D, 64 * kb, 32 * nb, 32, (GAS bf16*)(wl + WO_OUT), OLD, 32 * nb, 2048, W8_SCALE, nullptr, scr, lane);
                else conv_item(karg_in(14) + (size_t)l * D * D + (size_t)1024 * D, D, 64 * kb, 32 * nb, 32, (GAS bf16*)(wl + WO_OUT), OLD, 32 * nb, 2048, 1.0f, nullptr, scr, lane);
            }
        }
        __syncthreads();
        LAS float* Ps = (LAS float*)(lds + RING_OFF); LAS float* Qs = Ps + 64 * 129;
        for (int u = vcu; u < DEPTH * 2048; u += G) {
            const int l = u >> 11, which = (u >> 10) & 1, v = u & 1023;
            GAS unsigned char* wl = ws + WS_W0 + (size_t)l * W_LAYER;
            if (which == 0) { const int h = v >> 7, rt = (v >> 5) & 3, kt = v & 31;
                absorb_unit<false>(karg_in(11) + (size_t)l * RANK * 1024 + ((size_t)(64 * rt) * 8 + h) * 128, 1024, 1, karg_in(7) + (size_t)l * D * D_IN + (size_t)(64 * kt) * D_IN + h * 128, D_IN,
                                   (GAS bf16*)(wl + WO_IN) + (size_t)(h * 256 + 64 * rt) * D + 64 * kt, D, 0.08838834764831845f, karg_in(6) + (size_t)l * D + 64 * kt, Ps, Qs, tid); }
            else { const int h = v >> 7, nt = (v >> 2) & 31, rt = v & 3;
                if constexpr (OUT_F8) absorb_unit<true, true>(karg_in(14) + (size_t)l * D * D + (size_t)(h * 128) * D + 64 * nt, 1, D, karg_in(12) + (size_t)l * RANK * 1024 + ((size_t)(64 * rt) * 8 + h) * 128, 1024,
                                  (GAS bf16*)((GAS unsigned char*)(wl + WO_OUT) + (size_t)(64 * nt) * OLD + h * 256 + 64 * rt), OLD, W8_SCALE, nullptr, Ps, Qs, tid);
                else absorb_unit<true>(karg_in(14) + (size_t)l * D * D + (size_t)(h * 128) * D + 64 * nt, 1, D, karg_in(12) + (size_t)l * RANK * 1024 + ((size_t)(64 * rt) * 8 + h) * 128, 1024,
                                  (GAS bf16*)(wl + WO_OUT) + (size_t)(64 * nt) * OLD + h * 256 + 64 * rt, OLD, 1.0f, nullptr, Ps, Qs, tid); }
        }
    }
    GRID_BAR();

#pragma unroll 1
    for (int s = 0; s < 2 * DEPTH; ++s) {
        const int l = s >> 1, f = s & 1;
        REPEAT(REP_GU) {   PHASE_IDS(); GAS unsigned char* wl = ws + WS_W0 + (size_t)l * W_LAYER;
            pg8::StaticOrder S; S.init(M, NGU, G, bx);
            const GAS float* ssp = (const GAS float*)(ws + WS_SS + (size_t)((3 * l + 2 * f) & 1) * SS_BYTES);
            if ((F8_MASK == 0xF) || (F8_MASK != 0 && f8_on(l, f))) {
                if constexpr (F8_MASK != 0) {
                    pg8::Gemm g{(const GAS bf16*)(ws + WS_HB8), (const GAS bf16*)(wl + (f ? WO_GU2 : WO_GU1)), M, NGU, D / 2};
                    if constexpr (GU_I8) { pg8::EpiSwiglu<true> E{(GAS bf16*)(ws + WS_ACT), FF, ssp, 1.0f / D, EPS, 1.0f / (H8I_SCALE * W8I_SCALE), d8_on(l, f) ? A8_SCALE : 0.f};
                        pg8::gemm_phase<pg8::EpiSwiglu<true>, pg8::StaticOrder, true, true, false, true>(lds + RING_OFF, g, S, E, tid); }
                    else { pg8::EpiSwiglu<false> E{(GAS bf16*)(ws + WS_ACT), FF, ssp, 1.0f / D, EPS, 1.0f / W8_SCALE, d8_on(l, f) ? A8_SCALE : 0.f};
                        pg8::gemm_phase<pg8::EpiSwiglu<false>, pg8::StaticOrder, true, true, true>(lds + RING_OFF, g, S, E, tid); } }
            } else {
                if constexpr (F8_MASK != 0xF) {
                    pg8::Gemm g{(const GAS bf16*)(ws + WS_XN), (const GAS bf16*)(wl + (f ? WO_GU2 : WO_GU1)), M, NGU, D};
                    pg8::EpiSwiglu<false> E{(GAS bf16*)(ws + WS_ACT), FF, ssp, 1.0f / D, EPS, 1.0f, d8_on(l, f) ? A8_SCALE : 0.f};
                    pg8::gemm_phase<pg8::EpiSwiglu<false>, pg8::StaticOrder, true, true, false>(lds + RING_OFF, g, S, E, tid); }
            } }
        GRID_BAR();
        {   PHASE_IDS(); GAS unsigned char* wl = ws + WS_W0 + (size_t)l * W_LAYER;
            pg8::StaticOrder S; S.init(M, D, G, bx);
            const unsigned sso = (unsigned)(WS_SS + (size_t)((3 * l + 2 * f + 1) & 1) * SS_BYTES), h8o = (f == 1 && l + 1 < DEPTH && f8_on(l + 1, 0)) ? (unsigned)WS_HB8 : 0u;
            if ((D8_MASK == 0xF) || (D8_MASK != 0 && d8_on(l, f))) {
                if constexpr (D8_MASK != 0) {
                    pg8::Gemm g{(const GAS bf16*)(ws + WS_ACT), (const GAS bf16*)(wl + (f ? WO_D2 : WO_D1)), M, D, FF / 2};
                    pg8::EpiResid E{0.5f / (W8_SCALE * A8_SCALE), (unsigned)WS_XN, sso, h8o, GU_I8 ? H8I_SCALE : 0.f};
                    pg8::gemm_phase<pg8::EpiResid, pg8::StaticOrder, true, true, true>(lds + RING_OFF, g, S, E, tid); }
            } else {
                if constexpr (D8_MASK != 0xF) {
                    pg8::Gemm g{(const GAS bf16*)(ws + WS_ACT), (const GAS bf16*)(wl + (f ? WO_D2 : WO_D1)), M, D, FF};
                    pg8::EpiResid E{0.5f, (unsigned)WS_XN, sso, h8o, GU_I8 ? H8I_SCALE : 0.f};
                    pg8::gemm_phase<pg8::EpiResid, pg8::StaticOrder, true, true, false>(lds + RING_OFF, g, S, E, tid); }
            } }
        GRID_BAR();
        if (f == 0) {
            REPEAT(REP_IN) {   PHASE_IDS(); GAS unsigned char* wl = ws + WS_W0 + (size_t)l * W_LAYER;
                pg8::Gemm g{(const GAS bf16*)(ws + WS_XN), (const GAS bf16*)(wl + WO_IN), M, ZLD, D}; pg8::StaticOrder S; S.init(M, ZLD, G, bx);
                pg8::EpiBf16 E{(GAS bf16*)(ws + WS_Z), ZLD, (const GAS float*)(ws + WS_SS + (size_t)((3 * l + 1) & 1) * SS_BYTES), 1.0f / D, EPS};
                pg8::gemm_phase<pg8::EpiBf16, pg8::StaticOrder, true, true>(lds + RING_OFF, g, S, E, tid); }
            GRID_BAR();
            REPEAT(REP_POST) {   PHASE_IDS();
                post_rows((const GAS bf16*)(ws + WS_Z), karg_in(8) + (size_t)l * RANK, karg_in(9) + (size_t)l * IDIM, karg_in(10) + (size_t)l * IDIM, (GAS bf16*)(ws + WS_CKVN), (GAS bf16*)(ws + WS_KIN), (GAS float*)(ws + WS_WIF), gw, NGW, lane);
                swa_phase(lds + RING_OFF, (const GAS bf16*)(ws + WS_Z), (GAS bf16*)(ws + WS_O), karg_in(1), karg_in(13) + (size_t)l * H_B, vcu, G, tid, lane, wave);
            }
            GRID_BAR();
            REPEAT(REP_TOPK) {   PHASE_IDS(); topk_phase(lds + RING_OFF, (const GAS bf16*)(ws + WS_Z), (const GAS bf16*)(ws + WS_KIN), (const GAS float*)(ws + WS_WIF), (GAS unsigned short*)(ws + WS_IDX), vcu, G, lane, wave); }
            GRID_BAR();
            REPEAT(REP_DSA) {   PHASE_IDS(); dsa_phase(lds, (const GAS bf16*)(ws + WS_Z), (const GAS bf16*)(ws + WS_CKVN), (const GAS unsigned short*)(ws + WS_IDX), (GAS bf16*)(ws + WS_O), karg_in(1), gw, NGW, tid, lane, wave); }
            GRID_BAR();
            {   PHASE_IDS(); GAS unsigned char* wl = ws + WS_W0 + (size_t)l * W_LAYER;
                pg8::Gemm g{(const GAS bf16*)(ws + WS_O), (const GAS bf16*)(wl + WO_OUT), M, D, OUT_F8 ? OLD / 2 : OLD}; pg8::StaticOrder S; S.init(M, D, G, bx);
                pg8::EpiResid E{OUT_F8 ? 1.0f / (W8_SCALE * O8_SCALE) : 1.0f, (unsigned)WS_XN, (unsigned)(WS_SS + (size_t)((3 * l + 2) & 1) * SS_BYTES), f8_on(l, 1) ? (unsigned)WS_HB8 : 0u, GU_I8 ? H8I_SCALE : 0.f};
                pg8::gemm_phase<pg8::EpiResid, pg8::StaticOrder, true, true, OUT_F8 != 0>(lds + RING_OFF, g, S, E, tid); }
            GRID_BAR();
        }
    }
    {   PHASE_IDS(); final_rows((const GAS bf16*)(ws + WS_XN), karg_out(), karg_in(19), (const GAS float*)(ws + WS_SS + (size_t)(6 & 1) * SS_BYTES), gw, NGW, lane); }
}

extern "C" void kernel_launch(void* const* d_in, const int* in_sizes, int n_in, void* d_out, int out_size, void* d_ws, size_t ws_size, hipStream_t stream) {
    static int grid = 0;
    if (grid == 0) {
        if (n_in != 20 || in_sizes[0] != M * D || out_size != M * D || ws_size < WS_END) { fprintf(stderr, "kernel_launch: unexpected shapes (n_in %d, in0 %d, out %d, ws %zu); nothing launched\n", n_in, n_in > 0 ? in_sizes[0] : -1, out_size, ws_size); grid = -1; return; }
        int dev = 0, cus = 0, per_cu = 0;
        if (hipGetDevice(&dev) != hipSuccess || hipDeviceGetAttribute(&cus, hipDeviceAttributeMultiprocessorCount, dev) != hipSuccess) { grid = -1; return; }
        if (hipFuncSetAttribute((const void*)mk_fwd, hipFuncAttributeMaxDynamicSharedMemorySize, LDS_BYTES) != hipSuccess) { fprintf(stderr, "kernel_launch: hipFuncSetAttribute failed\n"); grid = -1; return; }
        if (hipOccupancyMaxActiveBlocksPerMultiprocessor(&per_cu, (const void*)mk_fwd, NWAVES * 64, LDS_BYTES) != hipSuccess || per_cu < 1) { fprintf(stderr, "kernel_launch: occupancy query reports %d workgroups per CU\n", per_cu); }
        (void)hipGetLastError();
        grid = cus;
    }
    if (grid < 0) return;
    if (hipMemsetAsync((char*)d_ws + WS_CTL, 0, CTL_ZERO_BYTES, stream) != hipSuccess) return;
    Args a{};
    for (int i = 0; i < 20; ++i) a.in[i] = (const float*)d_in[i];
    a.out = (float*)d_out; a.ws = (unsigned char*)d_ws;
    hipLaunchKernelGGL(mk_fwd, dim3(grid), dim3(NWAVES * 64), LDS_BYTES, stream, a);
}
```

```cpp
#define F8_MASK 0xF
#define D8_MASK 0xF
#include <hip/hip_runtime.h>
#include <cstdio>
#include <cstdint>
namespace pg8 {
#define PG8_LAS __attribute__((address_space(3)))
#define PG8_GAS __attribute__((address_space(1)))
typedef unsigned short bf16_t;
typedef short bf16x8 __attribute__((ext_vector_type(8)));
typedef float f32x4 __attribute__((ext_vector_type(4)));
typedef unsigned u32x4 __attribute__((ext_vector_type(4)));
constexpr int BM = 256, BK = 64, HALF = 128, HTB = HALF * BK * 2  , STAGE_BYTES = 8 * HTB, NXCD = 8, WGM = 8;

__host__ __device__ __forceinline__ int lds_byte(int r, int c) { const int st = (r >> 4) * 2 + (c >> 5), rr = r & 15, cc = c & 31, ob = rr * 64 + cc * 2; return st * 1024 + (ob ^ (((ob >> 9) & 1) << 5)); }
__host__ __device__ __forceinline__ void stage_rc(int b, int& R, int& C) { const int st = b / 1024, sb = b % 1024, swz = sb ^ (((sb >> 9) & 1) << 5); R = (st >> 1) * 16 + swz / 64; C = (st & 1) * 32 + (swz % 64) / 2; }
__host__ __device__ __forceinline__ int perm32(int rho) { const int n = rho >> 4, i = rho & 15; return 8 * (i >> 2) + 4 * n + (i & 3); }

typedef int i32x8 __attribute__((ext_vector_type(8))); typedef int i32x4v __attribute__((ext_vector_type(4)));
__device__ __forceinline__ i32x8 cat8(bf16x8 a, bf16x8 b) { return __builtin_shufflevector(__builtin_bit_cast(i32x4v, a), __builtin_bit_cast(i32x4v, b), 0, 1, 2, 3, 4, 5, 6, 7); }
struct Unit { int pm, pn; };
struct Gemm { const PG8_GAS bf16_t* A; const PG8_GAS bf16_t* Bt; int M, N, K; };

struct StaticOrder {
    int nM, nN, nwg, G, c;
    __host__ __device__ void init(int M, int N, int G_, int c_) { nM = M / BM; nN = N / BM; nwg = nM * nN; G = G_; c = c_; }
    __host__ __device__ bool next(int i, Unit& u) const {
        const long L = (long)i * G + c; if (L >= nwg) return false;
        int wgid = (int)L; { const int q = nwg / NXCD, r = nwg % NXCD, xcd = wgid % NXCD, off = wgid / NXCD; wgid = (xcd < r ? xcd * (q + 1) : r * (q + 1) + (xcd - r) * q) + off; }
        const int nig = WGM * nN, gid = wgid / nig, fm = gid * WGM, gsz = (nM - fm) < WGM ? (nM - fm) : WGM;
        u.pm = fm + ((wgid % nig) % gsz); u.pn = (wgid % nig) / gsz; return true;
    }
    __device__ __forceinline__ void a_ready(const Unit&) const {}
    __device__ __forceinline__ void done(const Unit&) const {}
};
__device__ __forceinline__ unsigned long long karg64(int idx) { unsigned long long r; const unsigned off = (unsigned)idx * 8u;
    asm volatile("s_load_dwordx2 %0, %1, %2\n\ts_waitcnt lgkmcnt(0)" : "=s"(r) : "s"(__builtin_amdgcn_kernarg_segment_ptr()), "s"(off) : "memory"); return r; }
__device__ __forceinline__ unsigned cvt_pk_bf16(float lo, float hi) { unsigned r; asm volatile("v_cvt_pk_bf16_f32 %0, %1, %2" : "=v"(r) : "v"(lo), "v"(hi)); return r; }
__device__ __forceinline__ unsigned pack4_i8(float a, float b, float c, float d, float S) {
    const int qa = (int)__builtin_rintf(__builtin_fminf(__builtin_fmaxf(a * S, -127.f), 127.f)), qb = (int)__builtin_rintf(__builtin_fminf(__builtin_fmaxf(b * S, -127.f), 127.f));
    const int qc = (int)__builtin_rintf(__builtin_fminf(__builtin_fmaxf(c * S, -127.f), 127.f)), qd = (int)__builtin_rintf(__builtin_fminf(__builtin_fmaxf(d * S, -127.f), 127.f));
    return ((unsigned)qa & 0xffu) | (((unsigned)qb & 0xffu) << 8) | (((unsigned)qc & 0xffu) << 16) | ((unsigned)qd << 24);
}
__device__ __forceinline__ float silu_f(float g) { return g * __builtin_amdgcn_rcpf(1.0f + __builtin_amdgcn_exp2f(-1.4426950408889634f * g)); }

template <bool ACC_I32 = false>
struct EpiSwiglu {
    static constexpr bool PERM = true, AFTER_DRAIN = false;
    static __device__ __forceinline__ f32x4 cv(const f32x4& a) { if constexpr (ACC_I32) { typedef int i32x4e __attribute__((ext_vector_type(4))); const i32x4e q = __builtin_bit_cast(i32x4e, a); return (f32x4){(float)q[0], (float)q[1], (float)q[2], (float)q[3]}; } else return a; }
    PG8_GAS bf16_t* O; int ldc; const PG8_GAS float* ss; float inv_k, eps, post; float out8;
    __device__ __forceinline__ void operator()(const f32x4 (&acc)[2][2][4][2], const Unit& u, int wr, int wc, int fr, int fq) const {
        const int row0 = u.pm * BM + wr * 64 + fr, col0 = u.pn * HALF + wc * 32 + 8 * fq;
        float rs[8]; const int lane_ = fr + 16 * fq;
#pragma unroll
        for (int k = 0; k < 8; ++k) { const PG8_GAS f32x4* p4 = (const PG8_GAS f32x4*)(ss + (size_t)(row0 + (k >> 2) * HALF + (k & 3) * 16) * 32 + 8 * fq); const f32x4 a = p4[0], b = p4[1];
            float t = ((a[0] + a[1]) + (a[2] + a[3])) + ((b[0] + b[1]) + (b[2] + b[3]));
            t += __builtin_bit_cast(float, __builtin_amdgcn_ds_bpermute((lane_ ^ 16) << 2, __builtin_bit_cast(int, t)));
            t += __builtin_bit_cast(float, __builtin_amdgcn_ds_bpermute((lane_ ^ 32) << 2, __builtin_bit_cast(int, t))); rs[k] = t; }
#pragma unroll
        for (int ai = 0; ai < 2; ++ai)
#pragma unroll
            for (int m = 0; m < 4; ++m) { PG8_GAS bf16_t* rowp = O + (size_t)(row0 + ai * HALF + m * 16) * ldc + col0;
                const float r = __builtin_amdgcn_rsqf(rs[ai * 4 + m] * inv_k + eps) * post;
                const f32x4 g0 = cv(acc[ai][0][m][0]) * r, g1 = cv(acc[ai][0][m][1]) * r, u0 = cv(acc[ai][1][m][0]) * r, u1 = cv(acc[ai][1][m][1]) * r;
                if (out8 != 0.f) { int p = 0, q = 0;
                    p = __builtin_amdgcn_cvt_pk_fp8_f32(silu_f(g0[0]) * u0[0] * out8, silu_f(g0[1]) * u0[1] * out8, p, false); p = __builtin_amdgcn_cvt_pk_fp8_f32(silu_f(g0[2]) * u0[2] * out8, silu_f(g0[3]) * u0[3] * out8, p, true);
                    q = __builtin_amdgcn_cvt_pk_fp8_f32(silu_f(g1[0]) * u1[0] * out8, silu_f(g1[1]) * u1[1] * out8, q, false); q = __builtin_amdgcn_cvt_pk_fp8_f32(silu_f(g1[2]) * u1[2] * out8, silu_f(g1[3]) * u1[3] * out8, q, true);
                    typedef unsigned u32x2v __attribute__((ext_vector_type(2))); u32x2v w8; w8.x = (unsigned)p; w8.y = (unsigned)q;
                    *(PG8_GAS u32x2v*)((PG8_GAS unsigned char*)O + (size_t)(row0 + ai * HALF + m * 16) * ldc + col0) = w8; }
                else { u32x4 w; w.x = cvt_pk_bf16(silu_f(g0[0]) * u0[0], silu_f(g0[1]) * u0[1]); w.y = cvt_pk_bf16(silu_f(g0[2]) * u0[2], silu_f(g0[3]) * u0[3]);
                w.z = cvt_pk_bf16(silu_f(g1[0]) * u1[0], silu_f(g1[1]) * u1[1]); w.w = cvt_pk_bf16(silu_f(g1[2]) * u1[2], silu_f(g1[3]) * u1[3]);
                *(PG8_GAS u32x4*)rowp = w; } }
    }
};
struct EpiResid {
    static constexpr bool PERM = true, AFTER_DRAIN = false;
    float alpha; unsigned hb_off; unsigned ss_off; unsigned h8_off; float h8_i8;
    __device__ __forceinline__ void operator()(const f32x4 (&acc)[2][2][4][2], const Unit& u, int wr, int wc, int fr, int fq) const {
        constexpr int ldc = 2048;
        PG8_GAS unsigned char* wsb = (PG8_GAS unsigned char*)karg64(21); PG8_GAS bf16_t* hb = (PG8_GAS bf16_t*)(wsb + hb_off); PG8_GAS float* ss = (PG8_GAS float*)(wsb + ss_off);
        const int row0 = u.pm * BM + wr * 64 + fr, col0 = u.pn * BM + wc * 32 + 8 * fq; const int lane = fr + 16 * fq;
        u32x4 cur[2], nxt[2];
        { const size_t off = (size_t)row0 * ldc + col0; cur[0] = *(const PG8_GAS u32x4*)(hb + off); cur[1] = *(const PG8_GAS u32x4*)(hb + off + HALF); }
#pragma unroll
        for (int k = 0; k < 8; ++k) { const int ai = k >> 2, m = k & 3; const int row = row0 + ai * HALF + m * 16; const size_t off = (size_t)row * ldc + col0;
            if (k < 7) { const int ai2 = (k + 1) >> 2, m2 = (k + 1) & 3; const size_t off2 = (size_t)(row0 + ai2 * HALF + m2 * 16) * ldc + col0;
                nxt[0] = *(const PG8_GAS u32x4*)(hb + off2); nxt[1] = *(const PG8_GAS u32x4*)(hb + off2 + HALF); }
            float sq = 0.f;
#pragma unroll
            for (int bj = 0; bj < 2; ++bj) { const u32x4 b = cur[bj]; const f32x4 a0 = acc[ai][bj][m][0], a1 = acc[ai][bj][m][1]; u32x4 w;
                w.x = cvt_pk_bf16(__builtin_bit_cast(float, b.x << 16) + a0[0] * alpha, __builtin_bit_cast(float, b.x & 0xffff0000u) + a0[1] * alpha);
                w.y = cvt_pk_bf16(__builtin_bit_cast(float, b.y << 16) + a0[2] * alpha, __builtin_bit_cast(float, b.y & 0xffff0000u) + a0[3] * alpha);
                w.z = cvt_pk_bf16(__builtin_bit_cast(float, b.z << 16) + a1[0] * alpha, __builtin_bit_cast(float, b.z & 0xffff0000u) + a1[1] * alpha);
                w.w = cvt_pk_bf16(__builtin_bit_cast(float, b.w << 16) + a1[2] * alpha, __builtin_bit_cast(float, b.w & 0xffff0000u) + a1[3] * alpha);
                *(PG8_GAS u32x4*)(hb + off + bj * HALF) = w;
                if (h8_off) { typedef unsigned u32x2v __attribute__((ext_vector_type(2))); u32x2v q8; int p = 0;
                    const float e0 = __builtin_bit_cast(float, w.x << 16), e1 = __builtin_bit_cast(float, w.x & 0xffff0000u), e2 = __builtin_bit_cast(float, w.y << 16), e3 = __builtin_bit_cast(float, w.y & 0xffff0000u);
                    const float e4 = __builtin_bit_cast(float, w.z << 16), e5 = __builtin_bit_cast(float, w.z & 0xffff0000u), e6 = __builtin_bit_cast(float, w.w << 16), e7 = __builtin_bit_cast(float, w.w & 0xffff0000u);
                    if (h8_i8 != 0.f) { q8.x = pack4_i8(e0, e1, e2, e3, h8_i8); q8.y = pack4_i8(e4, e5, e6, e7, h8_i8); }
                    else { p = __builtin_amdgcn_cvt_pk_fp8_f32(e0, e1, p, false); p = __builtin_amdgcn_cvt_pk_fp8_f32(e2, e3, p, true); q8.x = (unsigned)p; p = 0;
                        p = __builtin_amdgcn_cvt_pk_fp8_f32(e4, e5, p, false); p = __builtin_amdgcn_cvt_pk_fp8_f32(e6, e7, p, true); q8.y = (unsigned)p; }
                    *(PG8_GAS u32x2v*)(wsb + h8_off + off + bj * HALF) = q8; }
#pragma unroll
                for (int e = 0; e < 4; ++e) { const float lo = __builtin_bit_cast(float, w[e] << 16), hi = __builtin_bit_cast(float, w[e] & 0xffff0000u); sq = fmaf(lo, lo, sq); sq = fmaf(hi, hi, sq); } }
            sq += __builtin_bit_cast(float, __builtin_amdgcn_ds_bpermute((lane ^ 16) << 2, __builtin_bit_cast(int, sq)));
            sq += __builtin_bit_cast(float, __builtin_amdgcn_ds_bpermute((lane ^ 32) << 2, __builtin_bit_cast(int, sq)));
            if (fq == 0) ss[(size_t)row * 32 + u.pn * 4 + wc] = sq;
            cur[0] = nxt[0]; cur[1] = nxt[1]; }
    }
};
template <bool ACC_I32 = false>
struct EpiBf16 {
    static constexpr bool PERM = true, AFTER_DRAIN = false;
    static __device__ __forceinline__ f32x4 cv(const f32x4& a) { if constexpr (ACC_I32) { typedef int i32x4e __attribute__((ext_vector_type(4))); const i32x4e q = __builtin_bit_cast(i32x4e, a); return (f32x4){(float)q[0], (float)q[1], (float)q[2], (float)q[3]}; } else return a; }
    PG8_GAS bf16_t* O; int ldc; const PG8_GAS float* ss; float inv_k, eps; float post_a, post_b, post_c;
    __device__ __forceinline__ void operator()(const f32x4 (&acc)[2][2][4][2], const Unit& u, int wr, int wc, int fr, int fq) const {
        const int row0 = u.pm * BM + wr * 64 + fr, col0 = u.pn * BM + wc * 32 + 8 * fq;
        const float pfac = fmaf(u.pn < 8 ? 1.0f : 0.0f, post_a - post_b, fmaf((u.pn >= 9 && u.pn < 13) ? 1.0f : 0.0f, post_c - post_b, post_b));
        float rs[8]; const int lane_ = fr + 16 * fq;
#pragma unroll
        for (int k = 0; k < 8; ++k) { const PG8_GAS f32x4* p4 = (const PG8_GAS f32x4*)(ss + (size_t)(row0 + (k >> 2) * HALF + (k & 3) * 16) * 32 + 8 * fq); const f32x4 a = p4[0], b = p4[1];
            float t = ((a[0] + a[1]) + (a[2] + a[3])) + ((b[0] + b[1]) + (b[2] + b[3]));
            t += __builtin_bit_cast(float, __builtin_amdgcn_ds_bpermute((lane_ ^ 16) << 2, __builtin_bit_cast(int, t)));
            t += __builtin_bit_cast(float, __builtin_amdgcn_ds_bpermute((lane_ ^ 32) << 2, __builtin_bit_cast(int, t))); rs[k] = t; }
#pragma unroll
        for (int ai = 0; ai < 2; ++ai)
#pragma unroll
            for (int m = 0; m < 4; ++m) { PG8_GAS bf16_t* rowp = O + (size_t)(row0 + ai * HALF + m * 16) * ldc + col0;
                const float r = __builtin_amdgcn_rsqf(rs[ai * 4 + m] * inv_k + eps) * pfac;
#pragma unroll
                for (int bj = 0; bj < 2; ++bj) { const f32x4 v0 = cv(acc[ai][bj][m][0]) * r, v1 = cv(acc[ai][bj][m][1]) * r;
                    u32x4 w; w.x = cvt_pk_bf16(v0[0], v0[1]); w.y = cvt_pk_bf16(v0[2], v0[3]); w.z = cvt_pk_bf16(v1[0], v1[1]); w.w = cvt_pk_bf16(v1[2], v1[3]);
                    *(PG8_GAS u32x4*)(rowp + bj * HALF) = w; } }
    }
};
template <class Epi, class Sched, bool ALIGN_EPI = false, bool SP2 = false, bool F8 = false, bool I8 = false>
__device__ __forceinline__ void gemm_phase(PG8_LAS unsigned char* lds, const Gemm g, const Sched& S, const Epi& E, int tid_in  ) {
    int tid_ = tid_in; asm volatile("" : "+v"(tid_));
    const int tid = tid_, wid = __builtin_amdgcn_readfirstlane(tid >> 6), lane = tid & 63, wr = wid >> 2, wc = wid & 3, fr = lane & 15, fq = lane >> 4;
    const int K = g.K, nt = K / BK;
    unsigned voffA[2], voffB[2];
#pragma unroll
    for (int i = 0; i < 2; ++i) { int R, C; stage_rc(tid * 16 + i * 8192, R, C); const int Rb = Epi::PERM ? ((R & ~31) + perm32(R & 31)) : R;
        voffA[i] = (unsigned)(R * K + C) * 2u; voffB[i] = (unsigned)(Rb * K + C) * 2u; }
    const size_t kstep = (size_t)(BK * 2);
    const size_t hstep = (size_t)HALF * K * 2;
    const size_t tstep = 2 * hstep;
    const unsigned ldsw = (unsigned)wid * 1024u;
    const int aoff = lds_byte(wr * 64 + fr, fq * 8), boff = lds_byte(wc * 32 + fr, fq * 8);
#define PG8_SA(b, h) (((b) * 2 + (h)) * HTB)
#define PG8_SB(b, h) ((4 + (b) * 2 + (h)) * HTB)
#define PG8_STAGE(bufoff, gbase, voff) do { _Pragma("unroll") for (int _i = 0; _i < 2; ++_i) \
        __builtin_amdgcn_global_load_lds((const PG8_GAS unsigned*)((const PG8_GAS char*)(gbase) + (voff)[_i]), (PG8_LAS unsigned*)(lds + (bufoff) + ldsw + _i * 8192), 16, 0, 0); } while (0)
#define PG8_LDA(dst, b, h) do { _Pragma("unroll") for (int m = 0; m < 4; ++m) _Pragma("unroll") for (int k = 0; k < 2; ++k) dst[m][k] = *(const PG8_LAS bf16x8*)(lds + PG8_SA(b, h) + aoff + m * 2048 + k * 1024); } while (0)
#define PG8_LDB(dst, b, h) do { _Pragma("unroll") for (int n = 0; n < 2; ++n) _Pragma("unroll") for (int k = 0; k < 2; ++k) dst[n][k] = *(const PG8_LAS bf16x8*)(lds + PG8_SB(b, h) + boff + n * 2048 + k * 1024); } while (0)
#define PG8_MMA(ai, bj, At, Bt) do { __builtin_amdgcn_s_setprio(1); _Pragma("unroll") for (int m = 0; m < 4; ++m) _Pragma("unroll") for (int n = 0; n < 2; ++n) { \
        if constexpr (F8) { asm volatile("v_mfma_f32_16x16x128_f8f6f4 %0, %1, %2, %0" : "+v"(acc[ai][bj][m][n]) : "v"(cat8(Bt[n][0], Bt[n][1])), "v"(cat8(At[m][0], At[m][1]))); } \
        else if constexpr (I8) { _Pragma("unroll") for (int k = 0; k < 2; ++k) asm volatile("v_mfma_i32_16x16x64_i8 %0, %1, %2, %0" : "+v"(acc[ai][bj][m][n]) : "v"(Bt[n][k]), "v"(At[m][k])); } \
        else { _Pragma("unroll") for (int k = 0; k < 2; ++k) acc[ai][bj][m][n] = __builtin_amdgcn_mfma_f32_16x16x32_bf16(Bt[n][k], At[m][k], acc[ai][bj][m][n], 0, 0, 0); } } \
        __builtin_amdgcn_s_setprio(0); } while (0)
#define PG8_WAIT_V(n) asm volatile("s_waitcnt vmcnt(" #n ")" ::: "memory")
#define PG8_WAIT_L(n) asm volatile("s_waitcnt lgkmcnt(" #n ")" ::: "memory")
#define PG8_BAR __builtin_amdgcn_s_barrier()
#define PG8_SCHED __builtin_amdgcn_sched_barrier(0)
    Unit cur, nxt; int ui = 0;
    if (!S.next(0, cur)) return;
    f32x4 acc[2][2][4][2];
#pragma unroll
    for (int a = 0; a < 2; ++a)
#pragma unroll
        for (int b = 0; b < 2; ++b)
#pragma unroll
            for (int m = 0; m < 4; ++m)
#pragma unroll
                for (int n = 0; n < 2; ++n) acc[a][b][m][n] = (f32x4){0.f, 0.f, 0.f, 0.f};
    bf16x8 At[4][2], B0[2][2], B1[2][2];
    const PG8_GAS char* cA = (const PG8_GAS char*)g.A + (size_t)cur.pm * tstep; const PG8_GAS char* cB = (const PG8_GAS char*)g.Bt + (size_t)cur.pn * tstep;
    S.a_ready(cur);
    if constexpr (SP2) {
        PG8_STAGE(PG8_SB(0, 0), cB, voffB); PG8_STAGE(PG8_SB(0, 1), cB + hstep, voffB); PG8_STAGE(PG8_SA(0, 0), cA, voffA); PG8_STAGE(PG8_SA(0, 1), cA + hstep, voffA);
        if (wr == 1) PG8_BAR;
        PG8_WAIT_V(2); PG8_BAR;
        PG8_STAGE(PG8_SB(1, 0), cB + kstep, voffB); PG8_STAGE(PG8_SA(1, 0), cA + kstep, voffA); PG8_STAGE(PG8_SB(1, 1), cB + hstep + kstep, voffB);
        PG8_WAIT_V(6); PG8_BAR;
    } else {
        PG8_STAGE(PG8_SB(0, 0), cB, voffB); PG8_STAGE(PG8_SA(0, 0), cA, voffA); PG8_STAGE(PG8_SB(0, 1), cB + hstep, voffB); PG8_STAGE(PG8_SA(0, 1), cA + hstep, voffA);
        if (wr == 1) PG8_BAR;
        PG8_WAIT_V(4); PG8_BAR;
        PG8_STAGE(PG8_SB(1, 0), cB + kstep, voffB); PG8_STAGE(PG8_SA(1, 0), cA + kstep, voffA); PG8_STAGE(PG8_SB(1, 1), cB + hstep + kstep, voffB);
        PG8_WAIT_V(6); PG8_BAR;
    }
    for (;;) {
        const bool has_next = S.next(ui + 1, nxt);
        const PG8_GAS char* nA = has_next ? (const PG8_GAS char*)g.A + (size_t)nxt.pm * tstep : cA; const PG8_GAS char* nB = has_next ? (const PG8_GAS char*)g.Bt + (size_t)nxt.pn * tstep : cB;
        for (int t = 0; t < nt; t += 2) {
            const bool last = (t == nt - 2);
            const PG8_GAS char* a1 = cA + (size_t)(t + 1) * kstep;
            const PG8_GAS char* a2 = last ? nA : cA + (size_t)(t + 2) * kstep; const PG8_GAS char* b2 = last ? nB : cB + (size_t)(t + 2) * kstep;
            const PG8_GAS char* a3 = a2 + kstep; const PG8_GAS char* b3 = b2 + kstep;
            if (last && has_next) S.a_ready(nxt);
            if constexpr (SP2) {
            PG8_LDB(B0, 0, 0); PG8_LDB(B1, 0, 1); PG8_SCHED; PG8_LDA(At, 0, 0); PG8_STAGE(PG8_SA(1, 1), a1 + hstep, voffA);
            PG8_WAIT_V(8); PG8_WAIT_L(0); PG8_BAR; PG8_MMA(0, 0, At, B0); PG8_MMA(0, 1, At, B1); PG8_BAR; PG8_SCHED;
            PG8_LDA(At, 0, 1); PG8_STAGE(PG8_SB(0, 0), b2, voffB); PG8_STAGE(PG8_SB(0, 1), b2 + hstep, voffB); PG8_STAGE(PG8_SA(0, 0), a2, voffA);
            PG8_WAIT_V(8); PG8_WAIT_L(0); PG8_BAR; PG8_MMA(1, 0, At, B0); PG8_MMA(1, 1, At, B1); PG8_BAR; PG8_SCHED;
            PG8_LDB(B0, 1, 0); PG8_LDB(B1, 1, 1); PG8_SCHED; PG8_LDA(At, 1, 0); PG8_STAGE(PG8_SA(0, 1), a2 + hstep, voffA);
            PG8_WAIT_V(8); PG8_WAIT_L(0); PG8_BAR; PG8_MMA(0, 0, At, B0); PG8_MMA(0, 1, At, B1); PG8_BAR; PG8_SCHED;
            PG8_LDA(At, 1, 1); PG8_STAGE(PG8_SB(1, 0), b3, voffB); PG8_STAGE(PG8_SB(1, 1), b3 + hstep, voffB); PG8_STAGE(PG8_SA(1, 0), a3, voffA);
            PG8_WAIT_V(8); PG8_WAIT_L(0); PG8_BAR; PG8_MMA(1, 0, At, B0); PG8_MMA(1, 1, At, B1); PG8_BAR; PG8_SCHED;
            } else {
            PG8_LDB(B0, 0, 0); PG8_SCHED; PG8_LDA(At, 0, 0); PG8_STAGE(PG8_SA(1, 1), a1 + hstep, voffA);
            PG8_WAIT_L(8); PG8_BAR; PG8_WAIT_L(0); PG8_MMA(0, 0, At, B0); PG8_BAR; PG8_SCHED;
            PG8_LDB(B1, 0, 1); PG8_STAGE(PG8_SB(0, 0), b2, voffB);
            PG8_BAR; PG8_WAIT_L(0); PG8_MMA(0, 1, At, B1); PG8_BAR;
            PG8_LDA(At, 0, 1); PG8_STAGE(PG8_SA(0, 0), a2, voffA);
            PG8_BAR; PG8_WAIT_L(0); PG8_MMA(1, 0, At, B0); PG8_BAR; PG8_SCHED;
            PG8_STAGE(PG8_SB(0, 1), b2 + hstep, voffB);
            PG8_WAIT_V(6); PG8_BAR; PG8_MMA(1, 1, At, B1); PG8_BAR;
            PG8_LDB(B0, 1, 0); PG8_SCHED; PG8_LDA(At, 1, 0); PG8_STAGE(PG8_SA(0, 1), a2 + hstep, voffA);
            PG8_WAIT_L(8); PG8_BAR; PG8_WAIT_L(0); PG8_MMA(0, 0, At, B0); PG8_BAR; PG8_SCHED;
            PG8_LDB(B1, 1, 1); PG8_STAGE(PG8_SB(1, 0), b3, voffB);
            PG8_BAR; PG8_WAIT_L(0); PG8_MMA(0, 1, At, B1); PG8_BAR;
            PG8_LDA(At, 1, 1); PG8_STAGE(PG8_SA(1, 0), a3, voffA);
            PG8_BAR; PG8_WAIT_L(0); PG8_MMA(1, 0, At, B0); PG8_BAR; PG8_SCHED;
            PG8_STAGE(PG8_SB(1, 1), b3 + hstep, voffB);
            PG8_WAIT_V(6); PG8_BAR; PG8_MMA(1, 1, At, B1); PG8_BAR;
            }
        }
        if constexpr (ALIGN_EPI) { if (wr == 0) PG8_BAR; }
        if constexpr (!Epi::AFTER_DRAIN) { E(acc, cur, wr, wc, fr, fq); S.done(cur); }
        if (!has_next) break;
#pragma unroll
        for (int a = 0; a < 2; ++a)
#pragma unroll
            for (int b = 0; b < 2; ++b)
#pragma unroll
                for (int m = 0; m < 4; ++m)
#pragma unroll
                    for (int n = 0; n < 2; ++n) acc[a][b][m][n] = (f32x4){0.f, 0.f, 0.f, 0.f};
        cur = nxt; cA = nA; cB = nB; ++ui;
        if constexpr (ALIGN_EPI) { if (wr == 1) PG8_BAR; }
    }
    PG8_WAIT_V(0);
    if constexpr (!ALIGN_EPI) { if (wr == 0) PG8_BAR; }
    PG8_BAR;
    if constexpr (Epi::AFTER_DRAIN) { E.fused(acc, cur, wr, wc, fr, fq, lds, wid, lane); S.done(cur); }
#undef PG8_SA
#undef PG8_SB
#undef PG8_STAGE
#undef PG8_LDA
#undef PG8_LDB
#undef PG8_MMA
#undef PG8_WAIT_V
#undef PG8_WAIT_L
#undef PG8_BAR
#undef PG8_SCHED
}
}
constexpr int NWAVES = 8;
constexpr int BATCH = 8, SEQ = 4096, D = 2048, FF = 5632, DEPTH = 2;
constexpr int M = BATCH * SEQ;
constexpr int NGU = 2 * FF;
constexpr int H_A = 8, HD_A = 128, RANK = 256, IH = 8, IDIM = 64, TOPK = 256;
constexpr int H_B = 16, KVH = 2, GQA = 8, HD_B = 64, WINDOW = 128;
constexpr int D_IN = 3144;
constexpr float EPS = 1e-6f;
constexpr size_t MiB = 1u << 20;
constexpr size_t WS_CTL = 0, CTL_ZERO_BYTES = 1 * MiB;
#ifndef F8_MASK
#define F8_MASK 0xF
#endif
constexpr float W8_SCALE = 64.0f;
#ifndef GU_I8
#define GU_I8 1
#endif
constexpr float H8I_SCALE = 127.0f / 4.6f, W8I_SCALE = 127.0f / (4.2f * 0.022097086912079608f);
#ifndef D8_MASK
#define D8_MASK 0xA
#endif
constexpr float A8_SCALE = 8.0f;
__host__ __device__ constexpr bool d8_on(int l, int f) { return ((D8_MASK >> (2 * l + f)) & 1) != 0; }
constexpr float O8_SCALE = 16.0f;
#ifndef OUT_F8
#define OUT_F8 1
#endif
constexpr bool F8_ALL1 = (F8_MASK & 0x5) == 0x5, F8_ALL2 = (F8_MASK & 0xA) == 0xA;
__host__ __device__ constexpr bool f8_on(int l, int f) { return ((F8_MASK >> (2 * l + f)) & 1) != 0; }
constexpr size_t GU1_B = (F8_ALL1 ? 22 : 44) * MiB, GU2_B = (F8_ALL2 ? 22 : 44) * MiB;
constexpr size_t WS_W0 = 2 * MiB;
constexpr size_t WO_GU1 = 0, WO_D1 = GU1_B, WO_GU2 = WO_D1 + 22 * MiB, WO_D2 = WO_GU2 + GU2_B, WO_IN = WO_D2 + 22 * MiB, WO_OUT = WO_IN + 17 * MiB, W_LAYER = WO_OUT + 12 * MiB;
constexpr size_t WS_XN = WS_W0 + 2 * W_LAYER;
constexpr size_t WS_HB8 = WS_XN + 128 * MiB;
constexpr size_t WS_ACT = WS_HB8 + (F8_MASK ? 64 : 0) * MiB;
constexpr size_t WS_Z = WS_ACT, WS_CKVN = WS_ACT + 272 * MiB, WS_KIN = WS_ACT + 288 * MiB, WS_WIF = WS_ACT + 292 * MiB, WS_IDX = WS_ACT + 294 * MiB;
constexpr int ZLD = 4352, ZC_QLAT = 0, ZC_CKV = 2048, ZC_QB = 2304, ZC_KB = 3328, ZC_VB = 3456, ZC_QI = 3584, ZC_KI = 4096, ZC_WI = 4160;
constexpr int ZN8 = 3584;
#ifndef IN_I8
#define IN_I8 1
#endif
constexpr float WQ8I_SCALE = 127.0f / (4.2f * 0.015625f);
constexpr int OLD = 3072;
constexpr size_t WS_O = WS_ACT + 352 * MiB;
constexpr size_t WS_SS = WS_O + 192 * MiB, SS_BYTES = 4 * MiB;
constexpr size_t WS_END = WS_SS + 2 * SS_BYTES;
static_assert(WS_END <= 1024 * MiB, "d_ws map exceeds 1 GiB");
constexpr int CW_TMO = 0, CW_CODE = 1, CW_BAR = 4096;
constexpr int RING_OFF = 0, RING_BYTES = 131072;
constexpr int LDSCTL_OFF = RING_BYTES, MISC_OFF = LDSCTL_OFF + 320;
constexpr int LDS_BYTES = 147456;
#define GAS __attribute__((address_space(1)))
#define LAS __attribute__((address_space(3)))
typedef unsigned short bf16;
typedef unsigned v4u __attribute__((ext_vector_type(4)));
typedef float f32x4 __attribute__((ext_vector_type(4)));
typedef short bf16x8 __attribute__((ext_vector_type(8)));
typedef GAS unsigned gu32;
typedef GAS unsigned long long gu64;
#define RLX_AGENT __ATOMIC_RELAXED, __HIP_MEMORY_SCOPE_AGENT
#define LDS_WAIT() asm volatile("s_waitcnt lgkmcnt(0)" ::: "memory")
#define VM_WAIT() asm volatile("s_waitcnt vmcnt(0)" ::: "memory")
__device__ __forceinline__ unsigned long long rt() { return __builtin_amdgcn_s_memrealtime(); }
__device__ __forceinline__ unsigned f2bf(float f) { unsigned u = __builtin_bit_cast(unsigned, f); return (u + 0x7fffu + ((u >> 16) & 1u)) >> 16; }
__device__ __forceinline__ unsigned pk2(float lo, float hi) { return f2bf(lo) | (f2bf(hi) << 16); }

#define XB_TMO      128
#define XB_XCNT(j)  (256  + 64 * (j))
#define XB_XSUB(j)  (1280 + 64 * (j))
#define XB_XGEN(j)  (2304 + 64 * (j))
#define XB_TOP      3328
#define XB_TOPGEN   3392
#define XCD_BAR_WORDS 3456
#define XB_SPIN_CAP (1u << 18)

__device__ __forceinline__ unsigned xb_ld(unsigned* p)              { return __hip_atomic_load(p, __ATOMIC_RELAXED, __HIP_MEMORY_SCOPE_AGENT); }
__device__ __forceinline__ unsigned xb_add(unsigned* p, unsigned v) { return __hip_atomic_fetch_add(p, v, __ATOMIC_RELAXED, __HIP_MEMORY_SCOPE_AGENT); }
__device__ __forceinline__ unsigned xb_xcc_id() { return (unsigned)__builtin_amdgcn_s_getreg((3 << 11) | 20) & 0xFu; }
#define XB_SPIN(cond, bar) do { unsigned _sp = 0; while (cond) { __builtin_amdgcn_s_sleep(1); \
    if ((++_sp & 255u) == 0u) { if (xb_ld(&(bar)[XB_TMO])) break; if (_sp > XB_SPIN_CAP) { atomicAdd(&(bar)[XB_TMO], 1u); break; } } } } while (0)

struct XcdBarrier {
    unsigned* bar; unsigned x;
    volatile LAS unsigned* st;
};

__device__ __forceinline__ XcdBarrier xcd_barrier_post(unsigned* bar, volatile LAS unsigned* st, bool leader  ) {
    XcdBarrier b; b.bar = bar; b.x = xb_xcc_id(); b.st = st;
    if (leader) (void)xb_add(&bar[XB_XCNT(b.x)], 1u);
    return b;
}
__device__ __forceinline__ void xcd_barrier_complete(unsigned* bar, unsigned x, unsigned& nloc, unsigned& nx) {
    const unsigned G = gridDim.x * gridDim.y * gridDim.z;
    unsigned sum, cnt, mine, sp = 0u;
    for (;;) {
        sum = 0u; cnt = 0u; mine = 0u;
#pragma unroll
        for (unsigned j = 0; j < 16; ++j) { const unsigned c = xb_ld(&bar[XB_XCNT(j)]); sum += c; cnt += (c > 0u) ? 1u : 0u; mine = (j == x) ? c : mine; }
        if (sum == G) break;
        __builtin_amdgcn_s_sleep(1);
        if ((++sp & 255u) == 0u) { if (xb_ld(&bar[XB_TMO])) break; if (sp > XB_SPIN_CAP) { atomicAdd(&bar[XB_TMO], 1u); break; } }
    }
    nloc = mine > 0u ? mine : 1u; nx = cnt > 0u ? cnt : 1u;
}

__device__ __forceinline__ void xcd_barrier(const XcdBarrier& b, bool leader  ) {
    asm volatile("s_waitcnt vmcnt(0)" ::: "memory");
    __syncthreads();
    if (leader) {
        unsigned* bar = b.bar;
        __builtin_amdgcn_s_waitcnt(0);
        unsigned nloc = b.st[0], nx = b.st[1];
        if (nloc == 0u) { xcd_barrier_complete(bar, b.x, nloc, nx); b.st[0] = nloc; b.st[1] = nx; }
        const unsigned old = xb_add(&bar[XB_XSUB(b.x)], 1u);
        const unsigned gen = old / nloc;
        if (old + 1u == (gen + 1u) * nloc) {
            __builtin_amdgcn_fence(__ATOMIC_RELEASE, "agent");
            asm volatile("s_waitcnt vmcnt(0)" ::: "memory");
            const unsigned og = xb_add(&bar[XB_TOP], 1u);
            const unsigned tg = og / nx;
            if (og + 1u == (tg + 1u) * nx) xb_add(&bar[XB_TOPGEN], 1u);
            else XB_SPIN(xb_ld(&bar[XB_TOPGEN]) == tg, bar);
            __builtin_amdgcn_fence(__ATOMIC_ACQUIRE, "agent");
            xb_add(&bar[XB_XGEN(b.x)], 1u);
            asm volatile("s_waitcnt vmcnt(0)" ::: "memory");
        } else {
            XB_SPIN(xb_ld(&bar[XB_XGEN(b.x)]) == gen, bar);
            __builtin_amdgcn_fence(__ATOMIC_ACQUIRE, "agent");
            asm volatile("s_waitcnt vmcnt(0)" ::: "memory");
        }
    }
    __syncthreads();
}
__constant__ unsigned char T5_BUCKET[128] = {0, 1, 2, 3, 4, 5, 6, 7, 8, 9, 10, 11, 12, 13, 14, 15, 16, 16, 16, 17, 17, 18, 18, 18, 19, 19, 19, 20, 20, 20, 20, 21, 21, 21, 21, 22, 22, 22, 22, 22, 23, 23, 23, 23, 23, 23, 24, 24, 24, 24, 24, 24, 25, 25, 25, 25, 25, 25, 25, 26, 26, 26, 26, 26, 26, 26, 26, 27, 27, 27, 27, 27, 27, 27, 27, 27, 27, 28, 28, 28, 28, 28, 28, 28, 28, 28, 28, 29, 29, 29, 29, 29, 29, 29, 29, 29, 29, 29, 29, 30, 30, 30, 30, 30, 30, 30, 30, 30, 30, 30, 30, 30, 30, 31, 31, 31, 31, 31, 31, 31, 31, 31, 31, 31, 31, 31, 31, 31};
typedef short s16x4 __attribute__((ext_vector_type(4)));
typedef float f32x16 __attribute__((ext_vector_type(16)));
__device__ __forceinline__ float bf2f(unsigned short b) { return __builtin_bit_cast(float, (unsigned)b << 16); }
__device__ __forceinline__ bf16x8 cat4(s16x4 lo, s16x4 hi) { return __builtin_shufflevector(lo, hi, 0, 1, 2, 3, 4, 5, 6, 7); }
__device__ __forceinline__ void tr_read4(unsigned a0, unsigned a1, unsigned a2, unsigned a3, s16x4& r0, s16x4& r1, s16x4& r2, s16x4& r3) {
    asm volatile("ds_read_b64_tr_b16 %0, %4\n\tds_read_b64_tr_b16 %1, %5\n\tds_read_b64_tr_b16 %2, %6\n\tds_read_b64_tr_b16 %3, %7\n\ts_waitcnt lgkmcnt(0)"
                 : "=&v"(r0), "=&v"(r1), "=&v"(r2), "=&v"(r3) : "v"(a0), "v"(a1), "v"(a2), "v"(a3) : "memory");
}
#define SHX(x, o) __builtin_bit_cast(float, __builtin_amdgcn_ds_bpermute(((lane) ^ (o)) << 2, __builtin_bit_cast(int, (float)(x))))
#define SHXU(x, o) ((unsigned)__builtin_amdgcn_ds_bpermute(((lane) ^ (o)) << 2, (int)(x)))
__device__ __forceinline__ float wave_sum(float v, int lane) {
#pragma unroll
    for (int o = 1; o < 64; o <<= 1) v += SHX(v, o);
    return v;
}
template <int OUT8 = 0>
__device__ __forceinline__ void conv_item(const GAS float* W, int ldw, int k0, int c0, int nvalid, GAS bf16* dst, int dld, int drow0, int dk0, float scale, const GAS float* gain, LAS float* scr, int lane) {
    const int c = lane & 31;
    float vin[32];
#pragma unroll
    for (int i = 0; i < 32; ++i) { const int kk = 2 * i + (lane >> 5); vin[i] = 0.f;
        if (c < nvalid) vin[i] = W[(size_t)(k0 + kk) * ldw + c0 + c]; }
#pragma unroll
    for (int i = 0; i < 32; ++i) { const int kk = 2 * i + (lane >> 5); scr[kk * 33 + c] = vin[i] * scale; }
    LDS_WAIT(); asm volatile("" ::: "memory");
    const int c8 = lane & 7;
    f32x4 ga = {1.f, 1.f, 1.f, 1.f}, gb = {1.f, 1.f, 1.f, 1.f};
    if (gain) { ga = *(const GAS f32x4*)(gain + k0 + 8 * c8); gb = *(const GAS f32x4*)(gain + k0 + 8 * c8 + 4); }
#pragma unroll
    for (int j = 0; j < 4; ++j) { const int n = (lane >> 3) + 8 * j; const LAS float* s = scr + (8 * c8) * 33 + n;
        if constexpr (OUT8 == 2) { const unsigned p = pg8::pack4_i8(s[0 * 33] * ga.x, s[1 * 33] * ga.y, s[2 * 33] * ga.z, s[3 * 33] * ga.w, 1.0f), q = pg8::pack4_i8(s[4 * 33] * gb.x, s[5 * 33] * gb.y, s[6 * 33] * gb.z, s[7 * 33] * gb.w, 1.0f);
            *(GAS unsigned long long*)((GAS unsigned char*)dst + (size_t)(drow0 + n) * dld + dk0 + k0 + 8 * c8) = (unsigned long long)p | ((unsigned long long)q << 32); }
        else if constexpr (OUT8 == 1) { int p = 0, q = 0;
            p = __builtin_amdgcn_cvt_pk_fp8_f32(s[0 * 33] * ga.x, s[1 * 33] * ga.y, p, false); p = __builtin_amdgcn_cvt_pk_fp8_f32(s[2 * 33] * ga.z, s[3 * 33] * ga.w, p, true);
            q = __builtin_amdgcn_cvt_pk_fp8_f32(s[4 * 33] * gb.x, s[5 * 33] * gb.y, q, false); q = __builtin_amdgcn_cvt_pk_fp8_f32(s[6 * 33] * gb.z, s[7 * 33] * gb.w, q, true);
            *(GAS unsigned long long*)((GAS unsigned char*)dst + (size_t)(drow0 + n) * dld + dk0 + k0 + 8 * c8) = (unsigned long long)(unsigned)p | ((unsigned long long)(unsigned)q << 32); }
        else { v4u o; o.x = pk2(s[0 * 33] * ga.x, s[1 * 33] * ga.y); o.y = pk2(s[2 * 33] * ga.z, s[3 * 33] * ga.w); o.z = pk2(s[4 * 33] * gb.x, s[5 * 33] * gb.y); o.w = pk2(s[6 * 33] * gb.z, s[7 * 33] * gb.w);
            *(GAS v4u*)(dst + (size_t)(drow0 + n) * dld + dk0 + k0 + 8 * c8) = o; } }
    LDS_WAIT(); asm volatile("" ::: "memory");
}
__device__ __forceinline__ void rmsnorm_rows_bf16(const GAS float* X, const GAS float* g, GAS bf16* O, int gw, int NGW, int lane) {
    f32x4 gv[8];
#pragma unroll
    for (int j = 0; j < 8; ++j) gv[j] = ((const GAS f32x4*)g)[lane + 64 * j];
    for (int m = gw; m < M; m += NGW) {
        const GAS f32x4* xr = (const GAS f32x4*)(X + (size_t)m * D) + lane;
        f32x4 v[8]; float s = 0.f;
#pragma unroll
        for (int j = 0; j < 8; ++j) { v[j] = xr[64 * j]; s += (v[j].x * v[j].x + v[j].y * v[j].y) + (v[j].z * v[j].z + v[j].w * v[j].w); }
        const float r = 1.0f / sqrtf(wave_sum(s, lane) * (1.0f / D) + EPS);
        GAS unsigned long long* o8 = (GAS unsigned long long*)(O + (size_t)m * D) + lane;
#pragma unroll
        for (int j = 0; j < 8; ++j) { const f32x4 y = v[j] * r * gv[j]; o8[64 * j] = (unsigned long long)pk2(y.x, y.y) | ((unsigned long long)pk2(y.z, y.w) << 32); }
    }
}
__device__ __forceinline__ void rows_bf16_ss(const GAS float* X, GAS bf16* O, GAS unsigned char* O8, GAS float* ss, int gw, int NGW, int lane) {
    for (int m = gw; m < M; m += NGW) {
        const GAS f32x4* xr = (const GAS f32x4*)(X + (size_t)m * D) + lane;
        f32x4 v[8]; float s = 0.f;
#pragma unroll
        for (int j = 0; j < 8; ++j) { v[j] = xr[64 * j]; s += (v[j].x * v[j].x + v[j].y * v[j].y) + (v[j].z * v[j].z + v[j].w * v[j].w); }
        s = wave_sum(s, lane);
        GAS unsigned long long* o8 = (GAS unsigned long long*)(O + (size_t)m * D) + lane;
#pragma unroll
        for (int j = 0; j < 8; ++j) o8[64 * j] = (unsigned long long)pk2(v[j].x, v[j].y) | ((unsigned long long)pk2(v[j].z, v[j].w) << 32);
        if (O8) { GAS unsigned* q8 = (GAS unsigned*)(O8 + (size_t)m * D) + lane;
#pragma unroll
            for (int j = 0; j < 8; ++j) { if constexpr (GU_I8) q8[64 * j] = pg8::pack4_i8(v[j].x, v[j].y, v[j].z, v[j].w, H8I_SCALE); else { int p = 0; p = __builtin_amdgcn_cvt_pk_fp8_f32(v[j].x, v[j].y, p, false); p = __builtin_amdgcn_cvt_pk_fp8_f32(v[j].z, v[j].w, p, true); q8[64 * j] = (unsigned)p; } } }
        if (lane < 32) ss[(size_t)m * 32 + lane] = lane == 0 ? s : 0.f;
    }
}
__device__ __forceinline__ void final_rows(const GAS bf16* HB, GAS float* OUT, const GAS float* g, const GAS float* ss, int gw, int NGW, int lane) {
    f32x4 gv[8];
#pragma unroll
    for (int j = 0; j < 8; ++j) gv[j] = ((const GAS f32x4*)g)[lane + 64 * j];
    for (int m = gw; m < M; m += NGW) {
        const GAS unsigned long long* hr = (const GAS unsigned long long*)(HB + (size_t)m * D) + lane; GAS f32x4* orow = (GAS f32x4*)(OUT + (size_t)m * D) + lane;
        unsigned long long raw[8];
#pragma unroll
        for (int j = 0; j < 8; ++j) raw[j] = hr[64 * j];
        const float r = 1.0f / sqrtf(wave_sum(lane < 32 ? ss[(size_t)m * 32 + lane] : 0.f, lane) * (1.0f / D) + EPS);
#pragma unroll
        for (int j = 0; j < 8; ++j) { const unsigned lo = (unsigned)raw[j], hi = (unsigned)(raw[j] >> 32);
            f32x4 v = {__builtin_bit_cast(float, lo << 16), __builtin_bit_cast(float, lo & 0xffff0000u), __builtin_bit_cast(float, hi << 16), __builtin_bit_cast(float, hi & 0xffff0000u)};
            orow[64 * j] = v * r * gv[j]; }
    }
}
__device__ __forceinline__ void rmsnorm_rows_f32_inplace(GAS float* X, const GAS float* g, int gw, int NGW, int lane) {
    f32x4 gv[8];
#pragma unroll
    for (int j = 0; j < 8; ++j) gv[j] = ((const GAS f32x4*)g)[lane + 64 * j];
    for (int m = gw; m < M; m += NGW) {
        GAS f32x4* xr = (GAS f32x4*)(X + (size_t)m * D) + lane;
        f32x4 v[8]; float s = 0.f;
#pragma unroll
        for (int j = 0; j < 8; ++j) { v[j] = xr[64 * j]; s += (v[j].x * v[j].x + v[j].y * v[j].y) + (v[j].z * v[j].z + v[j].w * v[j].w); }
        const float r = 1.0f / sqrtf(wave_sum(s, lane) * (1.0f / D) + EPS);
#pragma unroll
        for (int j = 0; j < 8; ++j) xr[64 * j] = v[j] * r * gv[j];
    }
}

template <bool P_IFAST, int OUT8 = 0>
__device__ __forceinline__ void absorb_unit(const GAS float* Psrc, size_t p_ri, size_t p_rd, const GAS float* Qsrc, size_t q_rj, GAS bf16* out, size_t out_ld, float scale, const GAS float* qgain, LAS float* Ps_, LAS float* Qs_, int tid) {
    LAS bf16* Ps = (LAS bf16*)Ps_; LAS bf16* Qs = Ps + 64 * 136;
    float pv[16], qv[16];
#pragma unroll
    for (int j = 0; j < 16; ++j) { const int e = tid + 512 * j; const int i = P_IFAST ? (e & 63) : (e >> 7), d = P_IFAST ? (e >> 6) : (e & 127);
        pv[j] = Psrc[(size_t)i * p_ri + (size_t)d * p_rd];
        const int jj = e >> 7, dd = e & 127; qv[j] = Qsrc[(size_t)jj * q_rj + dd] * (qgain ? qgain[jj] : 1.0f); }
#pragma unroll
    for (int j = 0; j < 16; ++j) { const int e = tid + 512 * j; const int i = P_IFAST ? (e & 63) : (e >> 7), d = P_IFAST ? (e >> 6) : (e & 127);
        Ps[i * 136 + d] = (bf16)f2bf(pv[j]); const int jj = e >> 7, dd = e & 127; Qs[jj * 136 + dd] = (bf16)f2bf(qv[j]); }
    __syncthreads();
    const int wv = tid >> 6, ln = tid & 63, it = wv >> 1, r16 = ln & 15, g = ln >> 4;
#pragma unroll
    for (int jq = 0; jq < 2; ++jq) { const int jt = 2 * (wv & 1) + jq; f32x4 acc = {0.f, 0.f, 0.f, 0.f};
#pragma unroll
        for (int st = 0; st < 4; ++st) { const bf16x8 a = *(const LAS bf16x8*)(Ps + (16 * it + r16) * 136 + 32 * st + 8 * g); const bf16x8 b = *(const LAS bf16x8*)(Qs + (16 * jt + r16) * 136 + 32 * st + 8 * g);
            acc = __builtin_amdgcn_mfma_f32_16x16x32_bf16(a, b, acc, 0, 0, 0); }
#pragma unroll
        for (int rg = 0; rg < 4; ++rg) { const size_t o = (size_t)(16 * it + 4 * g + rg) * out_ld + 16 * jt + r16;
            if constexpr (OUT8 == 2) ((GAS unsigned char*)out)[o] = (unsigned char)(pg8::pack4_i8(acc[rg], 0.f, 0.f, 0.f, scale) & 0xffu);
            else if constexpr (OUT8 == 1) ((GAS unsigned char*)out)[o] = (unsigned char)__builtin_amdgcn_cvt_pk_fp8_f32(acc[rg] * scale, 0.f, 0, false);
            else out[o] = (bf16)f2bf(acc[rg] * scale); } }
    __syncthreads();
}
__device__ __forceinline__ void post_rows(const GAS bf16* Z, const GAS float* gkv, const GAS float* gki, const GAS float* bki, GAS bf16* CKVN, GAS bf16* KIN, GAS float* WIF, int gw, int NGW, int lane) {
    const f32x4 g4 = ((const GAS f32x4*)gkv)[lane]; const float gk = gki[lane], bk = bki[lane];
    for (int m = gw; m < M; m += NGW) {
        const GAS bf16* zr = Z + (size_t)m * ZLD;
        const unsigned long long raw = *(const GAS unsigned long long*)(zr + ZC_CKV + 4 * lane);
        const float kraw = bf2f(zr[ZC_KI + lane]);
        const float wraw = bf2f(zr[ZC_WI + (lane & 7)]);
        const float c0 = bf2f((unsigned short)raw), c1 = bf2f((unsigned short)(raw >> 16)), c2 = bf2f((unsigned short)(raw >> 32)), c3 = bf2f((unsigned short)(raw >> 48));
        const float r = 1.0f / sqrtf(wave_sum((c0 * c0 + c1 * c1) + (c2 * c2 + c3 * c3), lane) * (1.0f / RANK) + EPS);
        *(GAS unsigned long long*)(CKVN + (size_t)m * RANK + 4 * lane) = (unsigned long long)pk2(c0 * r * g4.x, c1 * r * g4.y) | ((unsigned long long)pk2(c2 * r * g4.z, c3 * r * g4.w) << 32);
        const float mu = wave_sum(kraw, lane) * (1.0f / IDIM); const float dv = kraw - mu;
        const float var = wave_sum(dv * dv, lane) * (1.0f / IDIM);
        KIN[(size_t)m * IDIM + lane] = (bf16)f2bf(dv * (1.0f / sqrtf(var + EPS)) * gk + bk);
        if (lane < 8) WIF[(size_t)m * IH + lane] = wraw;
    }
}
constexpr int SWA_KP = 144, SWA_VP = 192;
constexpr int SWA_K_OFF = 0, SWA_V_OFF = 160 * SWA_KP, SWA_TAB_OFF = SWA_V_OFF + 160 * SWA_VP;
static_assert(SWA_TAB_OFF + 16 * 128 * 4 <= RING_BYTES, "SWA LDS map");
__device__ __forceinline__ void swa_phase(LAS unsigned char* lds, const GAS bf16* Z, GAS bf16* O, const GAS float* rel_bias, const GAS float* sinks, int vcu, int G, int tid, int lane, int wave) {
    LAS float* tab = (LAS float*)(lds + SWA_TAB_OFF);
    for (int e = tid; e < 16 * 128; e += NWAVES * 64) { const int h = e >> 7, dist = e & 127; tab[e] = rel_bias[(int)T5_BUCKET[dist] * 24 + H_A + h]; }
    __syncthreads();
    const int q = lane & 31, hh = lane >> 5;
    const unsigned ldsb = (unsigned)(size_t)lds;
    for (int item = vcu; item < BATCH * 128 * KVH; item += G) {
        const int kvh = item & 1, qt = (item >> 1) & 127, b = item >> 8;
        const int t0 = 32 * qt, s0 = t0 - 128;
        const size_t rowbase = (size_t)b * SEQ;
        for (int c = tid; c < 1280; c += NWAVES * 64) { const int row = c >> 3, ch = c & 7; const int s = s0 + row;
            if (s >= 0) { const GAS bf16* zr = Z + (rowbase + s) * ZLD + kvh * 64 + ch * 8;
                const v4u kv = *(const GAS v4u*)(zr + ZC_KB); const v4u vv = *(const GAS v4u*)(zr + ZC_VB);
                *(LAS v4u*)(lds + SWA_K_OFF + row * SWA_KP + ch * 16) = kv; *(LAS v4u*)(lds + SWA_V_OFF + row * SWA_VP + ch * 16) = vv; } }
        const int hq = kvh * 8 + wave; const int t = t0 + q;
        bf16x8 qf[4];
#pragma unroll
        for (int st = 0; st < 4; ++st) qf[st] = *(const GAS bf16x8*)(Z + (rowbase + t) * ZLD + ZC_QB + hq * 64 + 16 * st + 8 * hh);
        __syncthreads();
        const int kt0 = qt >= 4 ? 0 : 4 - qt;
        f32x16 sacc[5];
#pragma unroll
        for (int kt = 0; kt < 5; ++kt) {
#pragma unroll
            for (int r = 0; r < 16; ++r) sacc[kt][r] = 0.f;
            if (kt >= kt0) {
#pragma unroll
                for (int st = 0; st < 4; ++st) { const bf16x8 kf = *(const LAS bf16x8*)(lds + SWA_K_OFF + (kt * 32 + q) * SWA_KP + (2 * st + hh) * 16);
                    sacc[kt] = __builtin_amdgcn_mfma_f32_32x32x16_bf16(kf, qf[st], sacc[kt], 0, 0, 0); } } }
        const float sink = sinks[hq]; float mx = sink;
        const LAS float* tabh = tab + hq * 128;
#pragma unroll
        for (int kt = 0; kt < 5; ++kt) if (kt >= kt0) {
#pragma unroll
            for (int r = 0; r < 16; ++r) { const int ko = (r & 3) + 8 * (r >> 2) + 4 * hh; const int dist = q + 128 - 32 * kt - ko;
                const float lg = (dist >= 0 && dist < WINDOW) ? sacc[kt][r] + tabh[dist & 127] : -1e30f; sacc[kt][r] = lg; mx = fmaxf(mx, lg); } }
        mx = fmaxf(mx, SHX(mx, 32));
        float l = 0.f;
#pragma unroll
        for (int kt = 0; kt < 5; ++kt) if (kt >= kt0) {
#pragma unroll
            for (int r = 0; r < 16; ++r) { const float p = __expf(sacc[kt][r] - mx); sacc[kt][r] = p; l += p; } }
        l += SHX(l, 32); l += __expf(sink - mx);
        f32x16 oacc[2];
#pragma unroll
        for (int dt = 0; dt < 2; ++dt)
#pragma unroll
            for (int r = 0; r < 16; ++r) oacc[dt][r] = 0.f;
        const unsigned vlane = ldsb + SWA_V_OFF + (unsigned)((4 * hh + ((lane & 15) >> 2)) * SWA_VP + (16 * ((lane >> 4) & 1) + 4 * (lane & 3)) * 2);
#pragma unroll
        for (int kt = 0; kt < 5; ++kt) if (kt >= kt0) {
#pragma unroll
            for (int s2 = 0; s2 < 2; ++s2) {
                bf16x8 pf; { const unsigned w0 = pg8::cvt_pk_bf16(sacc[kt][8 * s2 + 0], sacc[kt][8 * s2 + 1]), w1 = pg8::cvt_pk_bf16(sacc[kt][8 * s2 + 2], sacc[kt][8 * s2 + 3]),
                                     w2 = pg8::cvt_pk_bf16(sacc[kt][8 * s2 + 4], sacc[kt][8 * s2 + 5]), w3 = pg8::cvt_pk_bf16(sacc[kt][8 * s2 + 6], sacc[kt][8 * s2 + 7]);
                    const v4u w = {w0, w1, w2, w3}; pf = __builtin_bit_cast(bf16x8, w); }
                const unsigned a = vlane + (unsigned)((kt * 32 + 16 * s2) * SWA_VP);
                s16x4 r0, r1, r2, r3; tr_read4(a, a + 8 * SWA_VP, a + 64, a + 8 * SWA_VP + 64, r0, r1, r2, r3);
                oacc[0] = __builtin_amdgcn_mfma_f32_32x32x16_bf16(cat4(r0, r1), pf, oacc[0], 0, 0, 0);
                oacc[1] = __builtin_amdgcn_mfma_f32_32x32x16_bf16(cat4(r2, r3), pf, oacc[1], 0, 0, 0); } }
        const float inv = (OUT_F8 ? O8_SCALE : 1.0f) / l;
        if constexpr (OUT_F8) { GAS unsigned char* orow = (GAS unsigned char*)O + (rowbase + t) * OLD + 2048 + hq * 64 + 4 * hh;
#pragma unroll
            for (int dt = 0; dt < 2; ++dt)
#pragma unroll
                for (int g4 = 0; g4 < 4; ++g4) { int p = 0; p = __builtin_amdgcn_cvt_pk_fp8_f32(oacc[dt][4 * g4] * inv, oacc[dt][4 * g4 + 1] * inv, p, false); p = __builtin_amdgcn_cvt_pk_fp8_f32(oacc[dt][4 * g4 + 2] * inv, oacc[dt][4 * g4 + 3] * inv, p, true);
                    *(GAS unsigned*)(orow + 32 * dt + 8 * g4) = (unsigned)p; } }
        else { GAS bf16* orow = O + (rowbase + t) * OLD + 2048 + hq * 64 + 4 * hh;
#pragma unroll
        for (int dt = 0; dt < 2; ++dt)
#pragma unroll
            for (int g4 = 0; g4 < 4; ++g4) { const unsigned long long w = (unsigned long long)pk2(oacc[dt][4 * g4] * inv, oacc[dt][4 * g4 + 1] * inv) | ((unsigned long long)pk2(oacc[dt][4 * g4 + 2] * inv, oacc[dt][4 * g4 + 3] * inv) << 32);
                *(GAS unsigned long long*)(orow + 32 * dt + 8 * g4) = w; } }
        __syncthreads();
    }
}
constexpr int TK_BINS = 512, TK_CAP = 256;
#define LDS_ADD(p) __hip_atomic_fetch_add((p), 1u, __ATOMIC_RELAXED, __HIP_MEMORY_SCOPE_WORKGROUP)
#define LDS_ADDV(p, v) __hip_atomic_fetch_add((p), (v), __ATOMIC_RELAXED, __HIP_MEMORY_SCOPE_WORKGROUP)
#define HIST_WORD(tok, bin) (((tok) * TK_BINS + (bin)) >> 1)
#define HIST_INC(bin) (1u << (((bin) & 1) * 16))
constexpr int TK_HIST_OFF = 0, TK_CSC_OFF = 32768, TK_CIX_OFF = TK_CSC_OFF + 32 * TK_CAP * 4, TK_SEL_OFF = TK_CIX_OFF + 32 * TK_CAP * 2, TK_CNT_OFF = TK_SEL_OFF + 32 * 256 * 2, TK_DUM_OFF = TK_CNT_OFF + 32 * 2 * 4, TK_KB_OFF = TK_DUM_OFF + 8 * 64 * 4, TK_KB_BYTES = 64 * 144, TK_FLAG_OFF = TK_KB_OFF + 2 * TK_KB_BYTES;
static_assert(TK_FLAG_OFF + 16 <= RING_BYTES, "top-k LDS map");
typedef _Float16 tk_h2 __attribute__((ext_vector_type(2)));
__device__ __forceinline__ void tk_score2(const f32x16& acc, const tk_h2 (&wh)[8], float& s0, float& s1) {
    tk_h2 s = {(_Float16)0, (_Float16)0}; const tk_h2 zero = {(_Float16)0, (_Float16)0};
#pragma unroll
    for (int h = 0; h < 8; ++h) { tk_h2 d = __builtin_bit_cast(tk_h2, __builtin_amdgcn_cvt_pkrtz(acc[h], acc[8 + h])); d = __builtin_elementwise_max(d, zero); s = __builtin_elementwise_fma(wh[h], d, s); }
    s0 = (float)s.x; s1 = (float)s.y;
}
__device__ __forceinline__ float tk_x(float s, float sc) { return fmaf(s, sc, 256.0f); }
__device__ __forceinline__ int tk_key(float s, float sc) {
    const float x = tk_x(s, sc); int b0 = (int)x; b0 = b0 < 0 ? 0 : (b0 > TK_BINS - 1 ? TK_BINS - 1 : b0);
    int sub = (int)((x - (float)b0) * 512.0f); sub = sub < 0 ? 0 : (sub > 511 ? 511 : sub);
    return b0 * 512 + sub;
}
__device__ __forceinline__ void tk_find(const LAS unsigned* h, unsigned need, int lane, int& bin_out, unsigned& above_out) {
    unsigned v[8]; unsigned s = 0;
#pragma unroll
    for (int i = 0; i < 4; ++i) { const unsigned w = h[4 * lane + i]; v[2 * i] = w & 0xffffu; v[2 * i + 1] = w >> 16; s += v[2 * i] + v[2 * i + 1]; }
    unsigned S = s;
#pragma unroll
    for (int o = 1; o < 64; o <<= 1) { const unsigned t = (unsigned)__builtin_amdgcn_ds_bpermute((lane + o) << 2, (int)S); if (lane + o < 64) S += t; }
    const unsigned long long mask = __ballot(S >= need);
    const int Lm = mask ? 63 - __builtin_clzll(mask) : 0;
    unsigned cum = S - s; int bsel = 8 * lane; unsigned ab = cum; bool found = false;
#pragma unroll
    for (int i = 7; i >= 0; --i) { if (!found) { if (cum + v[i] >= need) { bsel = 8 * lane + i; ab = cum; found = true; } else cum += v[i]; } }
    bin_out = __builtin_amdgcn_readlane(bsel, Lm); above_out = (unsigned)__builtin_amdgcn_readlane((int)ab, Lm);
}
__device__ __forceinline__ void topk_phase(LAS unsigned char* lds, const GAS bf16* Z, const GAS bf16* KIN, const GAS float* WIF, GAS unsigned short* IDX, int vcu, int G, int lane, int wave) {
    LAS unsigned* hist = (LAS unsigned*)(lds + TK_HIST_OFF) + wave * 4 * (TK_BINS / 2);
    LAS float* csc = (LAS float*)(lds + TK_CSC_OFF) + wave * 4 * TK_CAP;
    LAS unsigned short* cix = (LAS unsigned short*)(lds + TK_CIX_OFF) + wave * 4 * TK_CAP;
    LAS unsigned short* sel = (LAS unsigned short*)(lds + TK_SEL_OFF) + wave * 4 * 256;
    LAS unsigned* cnt = (LAS unsigned*)(lds + TK_CNT_OFF) + wave * 8;
    LAS unsigned* dum = (LAS unsigned*)(lds + TK_DUM_OFF) + wave * 64 + lane;
    const int n = lane & 31, c = lane >> 5;
    const int am = (lane >> 4) & 1, bbm = (lane >> 3) & 1, ccm = (lane >> 2) & 1, dm = lane & 3;
    for (int p2 = vcu; p2 < BATCH * 64; p2 += G) {
#pragma unroll 1
        for (int half = 0; half < 2; ++half) {
            const int b = p2 >> 6, jj = p2 & 63, j = half ? 127 - jj : jj;
            const int t0 = 32 * j + 4 * wave; const size_t rb = (size_t)b * SEQ;
            bf16x8 qa[4];
#pragma unroll
            for (int st = 0; st < 4; ++st) qa[st] = *(const GAS bf16x8*)(Z + (rb + t0 + 2 * ccm + am) * ZLD + ZC_QI + (4 * bbm + dm) * 64 + 16 * st + 8 * c);
            float w0[8], w1[8];
            { const GAS f32x4* wp = (const GAS f32x4*)(WIF + (rb + t0 + 2 * c) * IH); const f32x4 x0 = wp[0], x1 = wp[1], x2 = wp[2], x3 = wp[3];
              w0[0] = x0.x; w0[1] = x0.y; w0[2] = x0.z; w0[3] = x0.w; w0[4] = x1.x; w0[5] = x1.y; w0[6] = x1.z; w0[7] = x1.w;
              w1[0] = x2.x; w1[1] = x2.y; w1[2] = x2.z; w1[3] = x2.w; w1[4] = x3.x; w1[5] = x3.y; w1[6] = x3.z; w1[7] = x3.w; }
            tk_h2 wh[8];
#pragma unroll
            for (int h = 0; h < 8; ++h) { wh[h].x = (_Float16)w0[h]; wh[h].y = (_Float16)w1[h]; }
            float scA, scB;
            { float a = 0.f, bq = 0.f;
#pragma unroll
              for (int h = 0; h < 8; ++h) { a = fmaf(w0[h], w0[h], a); bq = fmaf(w1[h], w1[h], bq); }
              scA = 32.0f / fmaxf(sqrtf(32.0f * a), 1e-20f); scB = 32.0f / fmaxf(sqrtf(32.0f * bq), 1e-20f); }
            const int tA = t0 + 2 * c, tB = tA + 1;
            for (int i = lane; i < 4 * (TK_BINS / 2); i += 64) hist[i] = 0u;
            for (int i = lane; i < 4 * 128; i += 64) ((LAS unsigned*)sel)[i] = 0u;
            if (lane < 8) cnt[lane] = 0u;
            asm volatile("s_waitcnt lgkmcnt(0)" ::: "memory");
            int lo[4], hi[4]; unsigned ab0[4]; bool ov[4];
#pragma unroll
            for (int tk = 0; tk < 4; ++tk) { lo[tk] = 0x7fffffff; hi[tk] = -1; ab0[tk] = 0u; ov[tk] = false; }
            const bool need_sel = (t0 + 3) >= TOPK;
            const GAS bf16* kbase = KIN + (rb + n) * IDIM + 8 * c;
            const int tidk = wave * 64 + lane; const int ng = (j + 2) >> 1;
            const GAS bf16* kg0 = KIN + (rb + (tidk >> 3)) * IDIM + (tidk & 7) * 8; const int koff = (tidk >> 3) * 144 + (tidk & 7) * 16;
            LAS unsigned char* kbuf = lds + TK_KB_OFF; volatile LAS unsigned* sflag = (volatile LAS unsigned*)(lds + TK_FLAG_OFF);
            if (tidk == 0) *sflag = 0u;
#define TK_PRIME() { const v4u kr0 = *(const GAS v4u*)kg0; *(LAS v4u*)(kbuf + koff) = kr0; } __syncthreads();
#define TK_GROUP_BEGIN() \
                v4u kr = {0u, 0u, 0u, 0u}; const bool more = g + 1 < ng; \
                if (more) kr = *(const GAS v4u*)(kg0 + (size_t)(g + 1) * 64 * IDIM); \
                const LAS unsigned char* kb_ = kbuf + (g & 1) * TK_KB_BYTES; \
                float s0v[2], s1v[2];     \
                { f32x16 accv[2]; \
                  _Pragma("unroll") for (int u4 = 0; u4 < 2; ++u4) { _Pragma("unroll") for (int r = 0; r < 16; ++r) accv[u4][r] = 0.f; \
                    _Pragma("unroll") for (int st = 0; st < 4; ++st) { const bf16x8 kf = *(const LAS bf16x8*)(kb_ + (32 * u4 + n) * 144 + (2 * st + c) * 16); accv[u4] = __builtin_amdgcn_mfma_f32_32x32x16_bf16(qa[st], kf, accv[u4], 0, 0, 0); } } \
                  _Pragma("unroll") for (int u4 = 0; u4 < 2; ++u4) tk_score2(accv[u4], wh, s0v[u4], s1v[u4]); } \
                _Pragma("unroll") for (int u4 = 0; u4 < 2; ++u4) { \
                    const float s0 = s0v[u4], s1 = s1v[u4]; const int s = 32 * (2 * g + u4) + n;
#define TK_GROUP_END() } \
                if (more) *(LAS v4u*)(kbuf + ((g + 1) & 1) * TK_KB_BYTES + koff) = kr; \
                __syncthreads();
            bool slow = false;
            if (need_sel) {
                {   TK_PRIME();
#pragma unroll 1
                    for (int g = 0; g < ng; ++g) { TK_GROUP_BEGIN()
                        int b0 = (int)tk_x(s0, scA), b1 = (int)tk_x(s1, scB); b0 = b0 < 0 ? 0 : (b0 > TK_BINS - 1 ? TK_BINS - 1 : b0); b1 = b1 < 0 ? 0 : (b1 > TK_BINS - 1 ? TK_BINS - 1 : b1);
                        LAS unsigned* p0 = (s <= tA) ? &hist[HIST_WORD(2 * c, b0)] : dum; LAS unsigned* p1 = (s <= tB) ? &hist[HIST_WORD(2 * c + 1, b1)] : dum;
                        LDS_ADDV(p0, HIST_INC(b0)); LDS_ADDV(p1, HIST_INC(b1));
                        TK_GROUP_END() }
                }
                asm volatile("s_waitcnt lgkmcnt(0)" ::: "memory");
#pragma unroll
                for (int tk = 0; tk < 4; ++tk) { int bin; unsigned above; tk_find(hist + tk * (TK_BINS / 2), (unsigned)TOPK, lane, bin, above);
                    const unsigned ceq = (hist[HIST_WORD(tk, bin)] >> ((bin & 1) * 16)) & 0xffffu; ov[tk] = ceq > (unsigned)TK_CAP; slow |= ov[tk]; ab0[tk] = above; lo[tk] = bin * 512; hi[tk] = bin * 512 + 511; }
                if (slow && lane == 0) *sflag = 1u;
                __syncthreads();
                slow = *sflag != 0u;
            }
            if (!slow) {
                float thi[4], tlo[4];
#pragma unroll
                for (int tk = 0; tk < 4; ++tk) { const int bin = lo[tk] >> 9;
                    thi[tk] = !need_sel ? -__builtin_inff() : (bin >= TK_BINS - 1 ? __builtin_inff() : (float)(bin + 1));
                    tlo[tk] = !need_sel ? __builtin_inff() : (bin == 0 ? -__builtin_inff() : (float)bin); }
                const float thiA = c ? thi[2] : thi[0], tloA = c ? tlo[2] : tlo[0], thiB = c ? thi[3] : thi[1], tloB = c ? tlo[3] : tlo[1];
                unsigned cntA = 0u, cntB = 0u;
                LAS unsigned short* selA = sel + (2 * c) * 256; LAS unsigned short* selB = sel + (2 * c + 1) * 256; LAS unsigned short* dum16 = (LAS unsigned short*)dum;
                TK_PRIME();
#pragma unroll 1
                for (int g = 0; g < ng; ++g) { TK_GROUP_BEGIN()
                    const float x0 = (s <= tA) ? tk_x(s0, scA) : __builtin_nanf(""), x1 = (s <= tB) ? tk_x(s1, scB) : __builtin_nanf("");
                    const bool a0 = x0 >= thiA, a1 = x1 >= thiB; const bool c0 = !a0 && x0 >= tloA, c1 = !a1 && x1 >= tloB;
                    const unsigned long long m0 = __ballot(a0), m1 = __ballot(a1);
                    const unsigned pre0 = c ? __builtin_amdgcn_mbcnt_hi((unsigned)(m0 >> 32), 0u) : __builtin_amdgcn_mbcnt_lo((unsigned)m0, 0u);
                    const unsigned pre1 = c ? __builtin_amdgcn_mbcnt_hi((unsigned)(m1 >> 32), 0u) : __builtin_amdgcn_mbcnt_lo((unsigned)m1, 0u);
                    const unsigned pos0 = cntA + pre0, pos1 = cntB + pre1;
                    LAS unsigned short* q0 = (a0 && pos0 < 256u) ? selA + pos0 : dum16; LAS unsigned short* q1 = (a1 && pos1 < 256u) ? selB + pos1 : dum16;
                    *q0 = (unsigned short)s; *q1 = (unsigned short)s;
                    cntA += c ? (unsigned)__builtin_popcount((unsigned)(m0 >> 32)) : (unsigned)__builtin_popcount((unsigned)m0);
                    cntB += c ? (unsigned)__builtin_popcount((unsigned)(m1 >> 32)) : (unsigned)__builtin_popcount((unsigned)m1);
                    if (__ballot(c0 || c1)) {
                        if (c0) { const unsigned pos = LDS_ADD(&cnt[(2 * c) * 2 + 1]); if (pos < (unsigned)TK_CAP) { csc[(2 * c) * TK_CAP + pos] = s0; cix[(2 * c) * TK_CAP + pos] = (unsigned short)s; } }
                        if (c1) { const unsigned pos = LDS_ADD(&cnt[(2 * c + 1) * 2 + 1]); if (pos < (unsigned)TK_CAP) { csc[(2 * c + 1) * TK_CAP + pos] = s1; cix[(2 * c + 1) * TK_CAP + pos] = (unsigned short)s; } } }
                    TK_GROUP_END() }
                if ((lane & 31) == 0) { cnt[(2 * c) * 2] = cntA; cnt[(2 * c + 1) * 2] = cntB; }
                asm volatile("s_waitcnt lgkmcnt(0)" ::: "memory");
            } else {
                for (int i = lane; i < 4 * (TK_BINS / 2); i += 64) hist[i] = 0u;
                asm volatile("s_waitcnt lgkmcnt(0)" ::: "memory");
                int mode = 1;
#pragma unroll 1
                for (;;) {
                const int klo0 = c ? lo[2] : lo[0], khi0 = c ? hi[2] : hi[0], klo1 = c ? lo[3] : lo[1], khi1 = c ? hi[3] : hi[1];
                const bool ov0 = c ? ov[2] : ov[0], ov1 = c ? ov[3] : ov[1];
                bf16x8 kb[4][4];
#pragma unroll
                for (int u4 = 0; u4 < 4; ++u4) { const int kq = u4 < j ? u4 : j;
#pragma unroll
                    for (int st = 0; st < 4; ++st) kb[u4][st] = *(const GAS bf16x8*)(kbase + (size_t)kq * 32 * IDIM + 16 * st); }
#pragma unroll 1
                for (int kt = 0; kt <= j; kt += 4) {
                    bf16x8 kn[4][4];
#pragma unroll
                    for (int u4 = 0; u4 < 4; ++u4) { const int kq = kt + 4 + u4 < j ? kt + 4 + u4 : j;
#pragma unroll
                        for (int st = 0; st < 4; ++st) kn[u4][st] = *(const GAS bf16x8*)(kbase + (size_t)kq * 32 * IDIM + 16 * st); }
#pragma unroll
                    for (int u4 = 0; u4 < 4; ++u4) {
                        f32x16 acc;
#pragma unroll
                        for (int r = 0; r < 16; ++r) acc[r] = 0.f;
#pragma unroll
                        for (int st = 0; st < 4; ++st) acc = __builtin_amdgcn_mfma_f32_32x32x16_bf16(qa[st], kb[u4][st], acc, 0, 0, 0);
                        float s0, s1; tk_score2(acc, wh, s0, s1);
                        const int s = 32 * (kt + u4) + n; const int k0 = tk_key(s0, scA), k1 = tk_key(s1, scB);
                        const bool v0 = s <= tA, v1 = s <= tB;
                        if (mode == 0) {
                            if (v0 && tA >= TOPK) LDS_ADDV(&hist[HIST_WORD(2 * c, k0 >> 9)], HIST_INC(k0 >> 9));
                            if (v1 && tB >= TOPK) LDS_ADDV(&hist[HIST_WORD(2 * c + 1, k1 >> 9)], HIST_INC(k1 >> 9));
                        } else if (mode == 1) {
                            if (v0 && ov0 && k0 >= klo0 && k0 <= khi0) LDS_ADDV(&hist[HIST_WORD(2 * c, k0 & 511)], HIST_INC(k0 & 511));
                            if (v1 && ov1 && k1 >= klo1 && k1 <= khi1) LDS_ADDV(&hist[HIST_WORD(2 * c + 1, k1 & 511)], HIST_INC(k1 & 511));
                        } else {
                            if (v0) { if (k0 > khi0) { const unsigned pos = LDS_ADD(&cnt[(2 * c) * 2]); if (pos < 256u) sel[(2 * c) * 256 + pos] = (unsigned short)s; }
                                      else if (k0 >= klo0) { const unsigned pos = LDS_ADD(&cnt[(2 * c) * 2 + 1]); if (pos < (unsigned)TK_CAP) { csc[(2 * c) * TK_CAP + pos] = s0; cix[(2 * c) * TK_CAP + pos] = (unsigned short)s; } } }
                            if (v1) { if (k1 > khi1) { const unsigned pos = LDS_ADD(&cnt[(2 * c + 1) * 2]); if (pos < 256u) sel[(2 * c + 1) * 256 + pos] = (unsigned short)s; }
                                      else if (k1 >= klo1) { const unsigned pos = LDS_ADD(&cnt[(2 * c + 1) * 2 + 1]); if (pos < (unsigned)TK_CAP) { csc[(2 * c + 1) * TK_CAP + pos] = s1; cix[(2 * c + 1) * TK_CAP + pos] = (unsigned short)s; } } }
                        }
                    }
#pragma unroll
                    for (int u4 = 0; u4 < 4; ++u4)
#pragma unroll
                        for (int st = 0; st < 4; ++st) kb[u4][st] = kn[u4][st];
                }
                    asm volatile("s_waitcnt lgkmcnt(0)" ::: "memory");
                    if (mode == 2) break;
#pragma unroll
                    for (int tk = 0; tk < 4; ++tk) if (ov[tk]) { int sub; unsigned above; tk_find(hist + tk * (TK_BINS / 2), (unsigned)TOPK - ab0[tk], lane, sub, above); lo[tk] += sub; hi[tk] = lo[tk]; }
                    mode = 2;
                }
            }
#undef TK_GROUP_BEGIN
#undef TK_GROUP_END
#undef TK_PRIME
#pragma unroll 1
            for (int tk = 0; tk < 4; ++tk) { const int t = t0 + tk;
                if (t >= TOPK) { const unsigned nsel = cnt[tk * 2]; unsigned nc = cnt[tk * 2 + 1]; nc = nc > (unsigned)TK_CAP ? (unsigned)TK_CAP : nc; const unsigned need = nsel < 256u ? 256u - nsel : 0u;
                    for (unsigned q = 0; q * 64 < nc; ++q) { const unsigned i = lane + 64 * q;
                        const float si = i < nc ? csc[tk * TK_CAP + i] : 0.f; const unsigned xi = i < nc ? cix[tk * TK_CAP + i] : 0u; unsigned rank = 0;
                        for (unsigned jx = 0; jx < nc; ++jx) { const float sj = csc[tk * TK_CAP + jx]; const unsigned xj = cix[tk * TK_CAP + jx]; rank += (sj > si || (sj == si && xj < xi)) ? 1u : 0u; }
                        if (i < nc && rank < need) sel[tk * 256 + nsel + rank] = (unsigned short)xi; } } }
            asm volatile("s_waitcnt lgkmcnt(0)" ::: "memory");
            { const LAS v4u* sv = (const LAS v4u*)sel; GAS v4u* ov = (GAS v4u*)(IDX + (rb + t0) * TOPK);
              ov[lane] = sv[lane]; ov[lane + 64] = sv[lane + 64]; }
            asm volatile("s_waitcnt vmcnt(0) lgkmcnt(0)" ::: "memory");
        }
    }
}
constexpr int DSA_TAB_OFF = RING_BYTES + 1024;
static_assert(DSA_TAB_OFF + 8 * 129 * 4 <= LDS_BYTES, "DSA LDS map");
__device__ __forceinline__ void dsa_phase(LAS unsigned char* lds_all, const GAS bf16* Z, const GAS bf16* CKVN, const GAS unsigned short* IDX, GAS bf16* O, const GAS float* rel_bias, int gw, int NGW, int tid, int lane, int wave) {
    LAS float* tab = (LAS float*)(lds_all + DSA_TAB_OFF);
    for (int e = tid; e < 8 * 129; e += NWAVES * 64) { const int hh = e / 129, dist = e - hh * 129; tab[e] = rel_bias[(dist < 128 ? (int)T5_BUCKET[dist] : 31) * 24 + hh]; }
    __syncthreads();
    LAS unsigned char* img = lds_all + RING_OFF + wave * 16384;
    const unsigned imgb = (unsigned)(size_t)img;
    const int h = lane & 15, g = lane >> 4;
    const LAS float* tabh = tab + (h & 7) * 129;
    const int TPW = (M + NGW - 1) / NGW;
    const int tok_end = (gw + 1) * TPW < M ? (gw + 1) * TPW : M;
    const int xq = 2 * (lane & 7);
    const int qk_off = (lane & 15) * 512;
    const int q4 = (lane & 15) >> 2, p4 = lane & 3; const int xr = 2 * (4 * (g & 1) + q4);
    const unsigned pv_base = imgb + (unsigned)((4 * g + q4) * 512 + 8 * (p4 & 1));
#pragma unroll 1
    for (int tok = gw * TPW; tok < tok_end; ++tok) {
        const int t = tok & (SEQ - 1); const size_t rb = (size_t)(tok - t);
        const int nsel = t + 1 < TOPK ? t + 1 : TOPK;
        bf16x8 qf[8];
#pragma unroll
        for (int st = 0; st < 8; ++st) { qf[st] = *(const GAS bf16x8*)(Z + (size_t)tok * ZLD + ZC_QLAT + (h & 7) * 256 + 32 * st + 8 * g); if (h >= 8) qf[st] = (bf16x8){0, 0, 0, 0, 0, 0, 0, 0}; }
        f32x4 oacc[16];
#pragma unroll
        for (int rt = 0; rt < 16; ++rt) oacc[rt] = (f32x4){0.f, 0.f, 0.f, 0.f};
        float mrun = -1e30f, lsum = 0.f;
        const GAS unsigned short* ip = IDX + (size_t)tok * TOPK;
        int ixa[8];
#pragma unroll
        for (int ch = 0; ch < 8; ++ch) ixa[ch] = (int)ip[32 * ch + (lane & 31)];
        unsigned long long i0n = *(const GAS unsigned long long*)(ip + 4 * g), i1n = *(const GAS unsigned long long*)(ip + 16 + 4 * g);
#pragma unroll
        for (int ch = 0; ch < 8; ++ch) {
            if (32 * ch >= nsel) break;
            const int ixv = ixa[ch];
            const unsigned long long i0 = i0n, i1 = i1n;
            if (ch < 7) { i0n = *(const GAS unsigned long long*)(ip + 32 * (ch + 1) + 4 * g); i1n = *(const GAS unsigned long long*)(ip + 32 * (ch + 1) + 16 + 4 * g); }
            asm volatile("s_waitcnt lgkmcnt(0)" ::: "memory");
#pragma unroll
            for (int i = 0; i < 16; ++i) { const int r0 = __builtin_amdgcn_readlane(ixv, 2 * i), r1 = __builtin_amdgcn_readlane(ixv, 2 * i + 1);
                const int row = 2 * i + (lane >> 5); const int ridx = lane < 32 ? r0 : r1; const int chunk = (lane & 31) ^ (2 * (row & 7));
                const GAS unsigned char* src = (const GAS unsigned char*)(CKVN + (rb + ridx) * RANK) + chunk * 16;
                __builtin_amdgcn_global_load_lds((const GAS unsigned*)src, (LAS unsigned*)(img + i * 1024), 16, 0, 0); }
            asm volatile("s_waitcnt vmcnt(0)" ::: "memory");
            f32x4 sa[2];
#pragma unroll
            for (int tl = 0; tl < 2; ++tl) { sa[tl] = (f32x4){0.f, 0.f, 0.f, 0.f};
#pragma unroll
                for (int st = 0; st < 8; ++st) { const bf16x8 a = *(const LAS bf16x8*)(img + qk_off + tl * 16 * 512 + (((4 * st + g) ^ xq) * 16));
                    sa[tl] = __builtin_amdgcn_mfma_f32_16x16x32_bf16(a, qf[st], sa[tl], 0, 0, 0); } }
            float lg[8]; float cmax = -1e30f;
#pragma unroll
            for (int e = 0; e < 8; ++e) { const int tl = e >> 2, jx = e & 3; const int kk = 32 * ch + 16 * tl + 4 * g + jx;
                const int sidx = (int)(((tl ? i1 : i0) >> (16 * jx)) & 0xffffull); int dd = t - sidx; dd = dd < 0 ? 0 : (dd > 128 ? 128 : dd);
                const float v = kk < nsel ? sa[tl][jx] + tabh[dd] : -1e30f; lg[e] = v; cmax = fmaxf(cmax, v); }
            cmax = fmaxf(cmax, SHX(cmax, 16)); cmax = fmaxf(cmax, SHX(cmax, 32));
            const float mnew = fmaxf(mrun, cmax);
            if (__any(mnew > mrun)) { const float alpha = __expf(mrun - mnew); lsum *= alpha;
#pragma unroll
                for (int rt = 0; rt < 16; ++rt) oacc[rt] = oacc[rt] * alpha; }
            mrun = mnew;
            float pe[8];
#pragma unroll
            for (int e = 0; e < 8; ++e) { pe[e] = __expf(lg[e] - mnew); lsum += pe[e]; }
            bf16x8 pf; { const v4u wv = {pg8::cvt_pk_bf16(pe[0], pe[1]), pg8::cvt_pk_bf16(pe[2], pe[3]), pg8::cvt_pk_bf16(pe[4], pe[5]), pg8::cvt_pk_bf16(pe[6], pe[7])}; pf = __builtin_bit_cast(bf16x8, wv); }
#pragma unroll
            for (int rt = 0; rt < 16; rt += 2) {
                const unsigned a0 = pv_base + (unsigned)((((2 * rt) ^ xr) | (p4 >> 1)) * 16), a1 = pv_base + (unsigned)((((2 * rt + 2) ^ xr) | (p4 >> 1)) * 16);
                s16x4 r0, r1, r2, r3; tr_read4(a0, a0 + 16 * 512, a1, a1 + 16 * 512, r0, r1, r2, r3);
                oacc[rt] = __builtin_amdgcn_mfma_f32_16x16x32_bf16(cat4(r0, r1), pf, oacc[rt], 0, 0, 0);
                oacc[rt + 1] = __builtin_amdgcn_mfma_f32_16x16x32_bf16(cat4(r2, r3), pf, oacc[rt + 1], 0, 0, 0); }
        }
        lsum += SHX(lsum, 16); lsum += SHX(lsum, 32);
        const float inv = (OUT_F8 ? O8_SCALE : 1.0f) / lsum;
        if (h < 8) {
            if constexpr (OUT_F8) { GAS unsigned char* orow = (GAS unsigned char*)O + (size_t)tok * OLD + h * 256 + 4 * g;
#pragma unroll
                for (int rt = 0; rt < 16; ++rt) { int p = 0; p = __builtin_amdgcn_cvt_pk_fp8_f32(oacc[rt][0] * inv, oacc[rt][1] * inv, p, false); p = __builtin_amdgcn_cvt_pk_fp8_f32(oacc[rt][2] * inv, oacc[rt][3] * inv, p, true); *(GAS unsigned*)(orow + 16 * rt) = (unsigned)p; } }
            else { GAS bf16* orow = O + (size_t)tok * OLD + h * 256 + 4 * g;
#pragma unroll
            for (int rt = 0; rt < 16; ++rt) *(GAS unsigned long long*)(orow + 16 * rt) = (unsigned long long)pk2(oacc[rt][0] * inv, oacc[rt][1] * inv) | ((unsigned long long)pk2(oacc[rt][2] * inv, oacc[rt][3] * inv) << 32); } }
    }
}
struct Args { const float* in[20]; float* out; unsigned char* ws; };
__device__ __forceinline__ unsigned long long karg_u64(int idx) { unsigned long long r; const unsigned off = (unsigned)idx * 8u;
    asm volatile("s_load_dwordx2 %0, %1, %2\n\ts_waitcnt lgkmcnt(0)" : "=s"(r) : "s"(__builtin_amdgcn_kernarg_segment_ptr()), "s"(off) : "memory"); return r; }
__device__ __forceinline__ const GAS float* karg_in(int i) { return (const GAS float*)karg_u64(i); }
__device__ __forceinline__ GAS float* karg_out() { return (GAS float*)karg_u64(20); }
__device__ __forceinline__ GAS unsigned char* karg_ws() { return (GAS unsigned char*)karg_u64(21); }
#ifndef REP_P0
#define REP_P0 1
#endif
#ifndef REP_NORM
#define REP_NORM 1
#endif
#ifndef REP_GU
#define REP_GU 1
#endif
#ifndef REP_IN
#define REP_IN 1
#endif
#ifndef REP_POST
#define REP_POST 1
#endif
#ifndef REP_TOPK
#define REP_TOPK 1
#endif
#ifndef REP_DSA
#define REP_DSA 1
#endif
#define REPEAT(n) _Pragma("unroll 1") for (int rep_ = 0; rep_ < (n); ++rep_)
#define PHASE_IDS() int wave = wave0; asm volatile("" : "+s"(wave)); int lane; asm volatile("v_mbcnt_lo_u32_b32 %0, -1, 0\n\tv_mbcnt_hi_u32_b32 %0, -1, %0" : "=v"(lane)); const int tid = wave * 64 + lane; int bx = blockIdx.x; asm volatile("" : "+s"(bx)); int G = gridDim.x; asm volatile("" : "+s"(G)); \
    const int vcu = (G % 8 == 0) ? (bx % 8) * (G / 8) + bx / 8 : bx; const int gw = vcu * NWAVES + wave, NGW = G * NWAVES; \
    GAS unsigned char* ws = karg_ws(); (void)lane; (void)gw; (void)NGW; (void)vcu; (void)ws
__global__ void __launch_bounds__(NWAVES * 64, 2) mk_fwd(Args args) {
    extern __shared__ __attribute__((aligned(16))) unsigned char lds_raw[];
    LAS unsigned char* lds = (LAS unsigned char*)lds_raw;
    volatile LAS unsigned* MISC = (volatile LAS unsigned*)(lds + MISC_OFF);
    const int wave0 = __builtin_amdgcn_readfirstlane(threadIdx.x >> 6);
    for (int u = threadIdx.x; u < (LDS_BYTES - LDSCTL_OFF) / 4; u += NWAVES * 64) ((LAS unsigned*)(lds + LDSCTL_OFF))[u] = 0u;
    __syncthreads();
    (void)xcd_barrier_post((unsigned*)((gu32*)(karg_ws() + WS_CTL) + CW_BAR), MISC + 8, threadIdx.x == 0);
#define GRID_BAR() do { XcdBarrier b_; b_.bar = (unsigned*)((gu32*)(karg_ws() + WS_CTL) + CW_BAR); b_.x = xb_xcc_id(); b_.st = MISC + 8; int w_ = wave0; asm volatile("" : "+s"(w_)); int l_; asm volatile("v_mbcnt_lo_u32_b32 %0, -1, 0\n\tv_mbcnt_hi_u32_b32 %0, -1, %0" : "=v"(l_)); xcd_barrier(b_, (w_ | l_) == 0); } while (0)

    REPEAT(REP_P0) {   PHASE_IDS();
        LAS float* scr = (LAS float*)(lds + RING_OFF + wave * 16384);
        rows_bf16_ss(karg_in(0), (GAS bf16*)(ws + WS_XN), f8_on(0, 0) ? (GAS unsigned char*)(ws + WS_HB8) : (GAS unsigned char*)nullptr, (GAS float*)(ws + WS_SS), gw, NGW, lane);
        constexpr int I_GU = (D / 64) * (FF / 32), I_DN = (FF / 64) * (D / 32);
        constexpr int I_FFN = 2 * I_GU + I_DN, I_IN = 72 * (D / 64), I_OB = (1024 / 64) * (D / 32);
        constexpr int PER_LAYER = 2 * I_FFN + I_IN + I_OB;
        for (int it = gw; it < DEPTH * PER_LAYER; it += NGW) {
            const int l = it / PER_LAYER; int r = it - l * PER_LAYER;
            GAS unsigned char* wl = ws + WS_W0 + (size_t)l * W_LAYER;
            if (r < 2 * I_FFN) {
                const int f = r / I_FFN; r -= f * I_FFN;
                GAS bf16* dgu = (GAS bf16*)(wl + (f ? WO_GU2 : WO_GU1)); GAS bf16* dd = (GAS bf16*)(wl + (f ? WO_D2 : WO_D1));
                if (r < 2 * I_GU) { const int up = r >= I_GU; if (up) r -= I_GU; const int kb = r / (FF / 32), nb = r % (FF / 32), n0 = 32 * nb;
                    const GAS float* wsrc = karg_in(up ? (f ? 17 : 4) : (f ? 16 : 3)) + (size_t)l * D * FF;
                    const int drow = (n0 >> 7) * 256 + (up ? 128 : 0) + (n0 & 127);
                    if (f8_on(l, f)) { if constexpr (GU_I8) conv_item<2>(wsrc, FF, 64 * kb, n0, 32, dgu, D, drow, 0, W8I_SCALE, karg_in(f ? 15 : 2) + (size_t)l * D, scr, lane); else conv_item<1>(wsrc, FF, 64 * kb, n0, 32, dgu, D, drow, 0, W8_SCALE, karg_in(f ? 15 : 2) + (size_t)l * D, scr, lane); }
                    else conv_item(wsrc, FF, 64 * kb, n0, 32, dgu, D, drow, 0, 1.0f, karg_in(f ? 15 : 2) + (size_t)l * D, scr, lane); }
                else { r -= 2 * I_GU; const int kb = r / (D / 32), nb = r % (D / 32);
                    if (d8_on(l, f)) conv_item<1>(karg_in(f ? 18 : 5) + (size_t)l * FF * D, D, 64 * kb, 32 * nb, 32, dd, FF, 32 * nb, 0, W8_SCALE, nullptr, scr, lane);
                    else conv_item(karg_in(f ? 18 : 5) + (size_t)l * FF * D, D, 64 * kb, 32 * nb, 32, dd, FF, 32 * nb, 0, 1.0f, nullptr, scr, lane); }
            } else if (r < 2 * I_FFN + I_IN) {
                r -= 2 * I_FFN; const int j = r >> 5, kb = r & 31; int src, nvalid = 32; float sc = 1.0f;
                if (j < 8) src = 1024 + 32 * j;
                else if (j < 40) src = 1864 + 32 * (j - 8);
                else if (j < 44) src = 2888 + 32 * (j - 40);
                else if (j < 48) src = 3016 + 32 * (j - 44);
                else if (j < 64) src = 1280 + 32 * (j - 48);
                else if (j < 66) src = 1792 + 32 * (j - 64);
                else if (j == 66) { src = 1856; nvalid = 8; sc = 0.044194173824159216f; }
                else { src = 0; nvalid = 0; }
                const GAS float* win = karg_in(7) + (size_t)l * D * D_IN; const GAS float* gmix = karg_in(6) + (size_t)l * D;
                if (IN_I8 && j < 48) conv_item<2>(win, D_IN, 64 * kb, src, nvalid, (GAS bf16*)(wl + WO_IN), D, 2048 + 32 * j, 0, W8I_SCALE, gmix, scr, lane);
                else if (IN_I8) conv_item(win, D_IN, 64 * kb, src, nvalid, (GAS bf16*)(wl + WO_IN + (size_t)ZN8 * D), D, 32 * (j - 48), 0, sc, gmix, scr, lane);
                else conv_item(win, D_IN, 64 * kb, src, nvalid, (GAS bf16*)(wl + WO_IN), D, 2048 + 32 * j, 0, (j >= 8 && j < 40) ? 0.125f : sc, gmix, scr, lane);
            } else {
                r -= 2 * I_FFN + I_IN; const int kb = r >> 6, nb = r & 63;
                if constexpr (OUT_F8) conv_item<1>(karg_in(14) + (size_t)l * D * D + (size_t)1024 * D, D, 64 * kb, 32 * nb, 32, (GAS bf16*)(wl + WO_OUT), OLD, 32 * nb, 2048, W8_SCALE, nullptr, scr, lane);
                else conv_item(karg_in(14) + (size_t)l * D * D + (size_t)1024 * D, D, 64 * kb, 32 * nb, 32, (GAS bf16*)(wl + WO_OUT), OLD, 32 * nb, 2048, 1.0f, nullptr, scr, lane);
            }
        }
        __syncthreads();
        LAS float* Ps = (LAS float*)(lds + RING_OFF); LAS float* Qs = Ps + 64 * 129;
        for (int u = vcu; u < DEPTH * 2048; u += G) {
            const int l = u >> 11, which = (u >> 10) & 1, v = u & 1023;
            GAS unsigned char* wl = ws + WS_W0 + (size_t)l * W_LAYER;
            if (which == 0) { const int h = v >> 7, rt = (v >> 5) & 3, kt = v & 31;
                if constexpr (IN_I8) absorb_unit<false, 2>(karg_in(11) + (size_t)l * RANK * 1024 + ((size_t)(64 * rt) * 8 + h) * 128, 1024, 1, karg_in(7) + (size_t)l * D * D_IN + (size_t)(64 * kt) * D_IN + h * 128, D_IN,
                                   (GAS bf16*)((GAS unsigned char*)(wl + WO_IN) + (size_t)(h * 256 + 64 * rt) * D + 64 * kt), D, WQ8I_SCALE, karg_in(6) + (size_t)l * D + 64 * kt, Ps, Qs, tid);
                else absorb_unit<false>(karg_in(11) + (size_t)l * RANK * 1024 + ((size_t)(64 * rt) * 8 + h) * 128, 1024, 1, karg_in(7) + (size_t)l * D * D_IN + (size_t)(64 * kt) * D_IN + h * 128, D_IN,
                                   (GAS bf16*)(wl + WO_IN) + (size_t)(h * 256 + 64 * rt) * D + 64 * kt, D, 0.08838834764831845f, karg_in(6) + (size_t)l * D + 64 * kt, Ps, Qs, tid); }
            else { const int h = v >> 7, nt = (v >> 2) & 31, rt = v & 3;
                if constexpr (OUT_F8) absorb_unit<true, 1>(karg_in(14) + (size_t)l * D * D + (size_t)(h * 128) * D + 64 * nt, 1, D, karg_in(12) + (size_t)l * RANK * 1024 + ((size_t)(64 * rt) * 8 + h) * 128, 1024,
                                  (GAS bf16*)((GAS unsigned char*)(wl + WO_OUT) + (size_t)(64 * nt) * OLD + h * 256 + 64 * rt), OLD, W8_SCALE, nullptr, Ps, Qs, tid);
                else absorb_unit<true>(karg_in(14) + (size_t)l * D * D + (size_t)(h * 128) * D + 64 * nt, 1, D, karg_in(12) + (size_t)l * RANK * 1024 + ((size_t)(64 * rt) * 8 + h) * 128, 1024,
                                  (GAS bf16*)(wl + WO_OUT) + (size_t)(64 * nt) * OLD + h * 256 + 64 * rt, OLD, 1.0f, nullptr, Ps, Qs, tid); }
        }
    }
    GRID_BAR();

#pragma unroll 1
    for (int s = 0; s < 2 * DEPTH; ++s) {
        const int l = s >> 1, f = s & 1;
        REPEAT(REP_GU) {   PHASE_IDS(); GAS unsigned char* wl = ws + WS_W0 + (size_t)l * W_LAYER;
            pg8::StaticOrder S; S.init(M, NGU, G, bx);
            const GAS float* ssp = (const GAS float*)(ws + WS_SS + (size_t)((3 * l + 2 * f) & 1) * SS_BYTES);
            if ((F8_MASK == 0xF) || (F8_MASK != 0 && f8_on(l, f))) {
                if constexpr (F8_MASK != 0) {
                    pg8::Gemm g{(const GAS bf16*)(ws + WS_HB8), (const GAS bf16*)(wl + (f ? WO_GU2 : WO_GU1)), M, NGU, D / 2};
                    if constexpr (GU_I8) { pg8::EpiSwiglu<true> E{(GAS bf16*)(ws + WS_ACT), FF, ssp, 1.0f / D, EPS, 1.0f / (H8I_SCALE * W8I_SCALE), d8_on(l, f) ? A8_SCALE : 0.f};
                        pg8::gemm_phase<pg8::EpiSwiglu<true>, pg8::StaticOrder, true, true, false, true>(lds + RING_OFF, g, S, E, tid); }
                    else { pg8::EpiSwiglu<false> E{(GAS bf16*)(ws + WS_ACT), FF, ssp, 1.0f / D, EPS, 1.0f / W8_SCALE, d8_on(l, f) ? A8_SCALE : 0.f};
                        pg8::gemm_phase<pg8::EpiSwiglu<false>, pg8::StaticOrder, true, true, true>(lds + RING_OFF, g, S, E, tid); } }
            } else {
                if constexpr (F8_MASK != 0xF) {
                    pg8::Gemm g{(const GAS bf16*)(ws + WS_XN), (const GAS bf16*)(wl + (f ? WO_GU2 : WO_GU1)), M, NGU, D};
                    pg8::EpiSwiglu<false> E{(GAS bf16*)(ws + WS_ACT), FF, ssp, 1.0f / D, EPS, 1.0f, d8_on(l, f) ? A8_SCALE : 0.f};
                    pg8::gemm_phase<pg8::EpiSwiglu<false>, pg8::StaticOrder, true, true, false>(lds + RING_OFF, g, S, E, tid); }
            } }
        GRID_BAR();
        {   PHASE_IDS(); GAS unsigned char* wl = ws + WS_W0 + (size_t)l * W_LAYER;
            pg8::StaticOrder S; S.init(M, D, G, bx);
            const unsigned sso = (unsigned)(WS_SS + (size_t)((3 * l + 2 * f + 1) & 1) * SS_BYTES), h8o = ((f == 0 && IN_I8) || (f == 1 && l + 1 < DEPTH && f8_on(l + 1, 0))) ? (unsigned)WS_HB8 : 0u;
            if ((D8_MASK == 0xF) || (D8_MASK != 0 && d8_on(l, f))) {
                if constexpr (D8_MASK != 0) {
                    pg8::Gemm g{(const GAS bf16*)(ws + WS_ACT), (const GAS bf16*)(wl + (f ? WO_D2 : WO_D1)), M, D, FF / 2};
                    pg8::EpiResid E{0.5f / (W8_SCALE * A8_SCALE), (unsigned)WS_XN, sso, h8o, GU_I8 ? H8I_SCALE : 0.f};
                    pg8::gemm_phase<pg8::EpiResid, pg8::StaticOrder, true, true, true>(lds + RING_OFF, g, S, E, tid); }
            } else {
                if constexpr (D8_MASK != 0xF) {
                    pg8::Gemm g{(const GAS bf16*)(ws + WS_ACT), (const GAS bf16*)(wl + (f ? WO_D2 : WO_D1)), M, D, FF};
                    pg8::EpiResid E{0.5f, (unsigned)WS_XN, sso, h8o, GU_I8 ? H8I_SCALE : 0.f};
                    pg8::gemm_phase<pg8::EpiResid, pg8::StaticOrder, true, true, false>(lds + RING_OFF, g, S, E, tid); }
            } }
        GRID_BAR();
        if (f == 0) {
            REPEAT(REP_IN) {   PHASE_IDS(); GAS unsigned char* wl = ws + WS_W0 + (size_t)l * W_LAYER;
                const GAS float* ssp = (const GAS float*)(ws + WS_SS + (size_t)((3 * l + 1) & 1) * SS_BYTES);
                if constexpr (IN_I8) {
                    {   pg8::Gemm g{(const GAS bf16*)(ws + WS_HB8), (const GAS bf16*)(wl + WO_IN), M, ZN8, D / 2}; pg8::StaticOrder S; S.init(M, ZN8, G, bx);
                        pg8::EpiBf16<true> E{(GAS bf16*)(ws + WS_Z), ZLD, ssp, 1.0f / D, EPS, 0.08838834764831845f / (H8I_SCALE * WQ8I_SCALE), 1.0f / (H8I_SCALE * W8I_SCALE), 0.125f / (H8I_SCALE * W8I_SCALE)};
                        pg8::gemm_phase<pg8::EpiBf16<true>, pg8::StaticOrder, true, true, false, true>(lds + RING_OFF, g, S, E, tid); }
                    {   pg8::Gemm g{(const GAS bf16*)(ws + WS_XN), (const GAS bf16*)(wl + WO_IN + (size_t)ZN8 * D), M, ZLD - ZN8, D}; pg8::StaticOrder S; S.init(M, ZLD - ZN8, G, bx);
                        pg8::EpiBf16<false> E{(GAS bf16*)(ws + WS_Z) + ZN8, ZLD, ssp, 1.0f / D, EPS, 1.0f, 1.0f, 1.0f};
                        pg8::gemm_phase<pg8::EpiBf16<false>, pg8::StaticOrder, true, true, false, false>(lds + RING_OFF, g, S, E, tid); }
                } else {
                    pg8::Gemm g{(const GAS bf16*)(ws + WS_XN), (const GAS bf16*)(wl + WO_IN), M, ZLD, D}; pg8::StaticOrder S; S.init(M, ZLD, G, bx);
                    pg8::EpiBf16<false> E{(GAS bf16*)(ws + WS_Z), ZLD, ssp, 1.0f / D, EPS, 1.0f, 1.0f, 1.0f};
                    pg8::gemm_phase<pg8::EpiBf16<false>, pg8::StaticOrder, true, true, false, false>(lds + RING_OFF, g, S, E, tid); } }
            GRID_BAR();
            REPEAT(REP_POST) {   PHASE_IDS();
                post_rows((const GAS bf16*)(ws + WS_Z), karg_in(8) + (size_t)l * RANK, karg_in(9) + (size_t)l * IDIM, karg_in(10) + (size_t)l * IDIM, (GAS bf16*)(ws + WS_CKVN), (GAS bf16*)(ws + WS_KIN), (GAS float*)(ws + WS_WIF), gw, NGW, lane);
                swa_phase(lds + RING_OFF, (const GAS bf16*)(ws + WS_Z), (GAS bf16*)(ws + WS_O), karg_in(1), karg_in(13) + (size_t)l * H_B, vcu, G, tid, lane, wave);
            }
            GRID_BAR();
            REPEAT(REP_TOPK) {   PHASE_IDS(); topk_phase(lds + RING_OFF, (const GAS bf16*)(ws + WS_Z), (const GAS bf16*)(ws + WS_KIN), (const GAS float*)(ws + WS_WIF), (GAS unsigned short*)(ws + WS_IDX), vcu, G, lane, wave); }
            GRID_BAR();
            REPEAT(REP_DSA) {   PHASE_IDS(); dsa_phase(lds, (const GAS bf16*)(ws + WS_Z), (const GAS bf16*)(ws + WS_CKVN), (const GAS unsigned short*)(ws + WS_IDX), (GAS bf16*)(ws + WS_O), karg_in(1), gw, NGW, tid, lane, wave); }
            GRID_BAR();
            {   PHASE_IDS(); GAS unsigned char* wl = ws + WS_W0 + (size_t)l * W_LAYER;
                pg8::Gemm g{(const GAS bf16*)(ws + WS_O), (const GAS bf16*)(wl + WO_OUT), M, D, OUT_F8 ? OLD / 2 : OLD}; pg8::StaticOrder S; S.init(M, D, G, bx);
                pg8::EpiResid E{OUT_F8 ? 1.0f / (W8_SCALE * O8_SCALE) : 1.0f, (unsigned)WS_XN, (unsigned)(WS_SS + (size_t)((3 * l + 2) & 1) * SS_BYTES), f8_on(l, 1) ? (unsigned)WS_HB8 : 0u, GU_I8 ? H8I_SCALE : 0.f};
                pg8::gemm_phase<pg8::EpiResid, pg8::StaticOrder, true, true, OUT_F8 != 0>(lds + RING_OFF, g, S, E, tid); }
            GRID_BAR();
        }
    }
    {   PHASE_IDS(); final_rows((const GAS bf16*)(ws + WS_XN), karg_out(), karg_in(19), (const GAS float*)(ws + WS_SS + (size_t)(6 & 1) * SS_BYTES), gw, NGW, lane); }
}

extern "C" void kernel_launch(void* const* d_in, const int* in_sizes, int n_in, void* d_out, int out_size, void* d_ws, size_t ws_size, hipStream_t stream) {
    static int grid = 0;
    if (grid == 0) {
        if (n_in != 20 || in_sizes[0] != M * D || out_size != M * D || ws_size < WS_END) { fprintf(stderr, "kernel_launch: unexpected shapes (n_in %d, in0 %d, out %d, ws %zu); nothing launched\n", n_in, n_in > 0 ? in_sizes[0] : -1, out_size, ws_size); grid = -1; return; }
        int dev = 0, cus = 0, per_cu = 0;
        if (hipGetDevice(&dev) != hipSuccess || hipDeviceGetAttribute(&cus, hipDeviceAttributeMultiprocessorCount, dev) != hipSuccess) { grid = -1; return; }
        if (hipFuncSetAttribute((const void*)mk_fwd, hipFuncAttributeMaxDynamicSharedMemorySize, LDS_BYTES) != hipSuccess) { fprintf(stderr, "kernel_launch: hipFuncSetAttribute failed\n"); grid = -1; return; }
        if (hipOccupancyMaxActiveBlocksPerMultiprocessor(&per_cu, (const void*)mk_fwd, NWAVES * 64, LDS_BYTES) != hipSuccess || per_cu < 1) { fprintf(stderr, "kernel_launch: occupancy query reports %d workgroups per CU\n", per_cu); }
        (void)hipGetLastError();
        grid = cus;
    }
    if (grid < 0) return;
    if (hipMemsetAsync((char*)d_ws + WS_CTL, 0, CTL_ZERO_BYTES, stream) != hipSuccess) return;
    Args a{};
    for (int i = 0; i < 20; ++i) a.in[i] = (const float*)d_in[i];
    a.out = (float*)d_out; a.ws = (unsigned char*)d_ws;
    hipLaunchKernelGGL(mk_fwd, dim3(grid), dim3(NWAVES * 64), LDS_BYTES, stream, a);
}
```

```cpp
#include <hip/hip_runtime.h>
#include <cstdio>
#include <cstdint>
namespace pg8 {
#define PG8_LAS __attribute__((address_space(3)))
#define PG8_GAS __attribute__((address_space(1)))
typedef unsigned short bf16_t;
typedef short bf16x8 __attribute__((ext_vector_type(8)));
typedef float f32x4 __attribute__((ext_vector_type(4)));
typedef unsigned u32x4 __attribute__((ext_vector_type(4)));
constexpr int BM = 256, BK = 64, HALF = 128, HTB = HALF * BK * 2  , STAGE_BYTES = 8 * HTB, NXCD = 8, WGM = 8;

__host__ __device__ __forceinline__ int lds_byte(int r, int c) { const int st = (r >> 4) * 2 + (c >> 5), rr = r & 15, cc = c & 31, ob = rr * 64 + cc * 2; return st * 1024 + (ob ^ (((ob >> 9) & 1) << 5)); }
__host__ __device__ __forceinline__ void stage_rc(int b, int& R, int& C) { const int st = b / 1024, sb = b % 1024, swz = sb ^ (((sb >> 9) & 1) << 5); R = (st >> 1) * 16 + swz / 64; C = (st & 1) * 32 + (swz % 64) / 2; }
__host__ __device__ __forceinline__ int perm32(int rho) { const int n = rho >> 4, i = rho & 15; return 8 * (i >> 2) + 4 * n + (i & 3); }

typedef int i32x8 __attribute__((ext_vector_type(8))); typedef int i32x4v __attribute__((ext_vector_type(4)));
__device__ __forceinline__ i32x8 cat8(bf16x8 a, bf16x8 b) { return __builtin_shufflevector(__builtin_bit_cast(i32x4v, a), __builtin_bit_cast(i32x4v, b), 0, 1, 2, 3, 4, 5, 6, 7); }
struct Unit { int pm, pn; };
struct Gemm { const PG8_GAS bf16_t* A; const PG8_GAS bf16_t* Bt; int M, N, K; };

struct StaticOrder {
    int nM, nN, nwg, G, c;
    __host__ __device__ void init(int M, int N, int G_, int c_) { nM = M / BM; nN = N / BM; nwg = nM * nN; G = G_; c = c_; }
    __host__ __device__ bool next(int i, Unit& u) const {
        const long L = (long)i * G + c; if (L >= nwg) return false;
        int wgid = (int)L; { const int q = nwg / NXCD, r = nwg % NXCD, xcd = wgid % NXCD, off = wgid / NXCD; wgid = (xcd < r ? xcd * (q + 1) : r * (q + 1) + (xcd - r) * q) + off; }
        const int nig = WGM * nN, gid = wgid / nig, fm = gid * WGM, gsz = (nM - fm) < WGM ? (nM - fm) : WGM;
        u.pm = fm + ((wgid % nig) % gsz); u.pn = (wgid % nig) / gsz; return true;
    }
    __device__ __forceinline__ void a_ready(const Unit&) const {}
    __device__ __forceinline__ void done(const Unit&) const {}
};
__device__ __forceinline__ unsigned long long karg64(int idx) { unsigned long long r; const unsigned off = (unsigned)idx * 8u;
    asm volatile("s_load_dwordx2 %0, %1, %2\n\ts_waitcnt lgkmcnt(0)" : "=s"(r) : "s"(__builtin_amdgcn_kernarg_segment_ptr()), "s"(off) : "memory"); return r; }
__device__ __forceinline__ unsigned cvt_pk_bf16(float lo, float hi) { unsigned r; asm volatile("v_cvt_pk_bf16_f32 %0, %1, %2" : "=v"(r) : "v"(lo), "v"(hi)); return r; }
typedef float f32x2 __attribute__((ext_vector_type(2)));
__device__ __forceinline__ unsigned pack4_i8(float a, float b, float c, float d, float S) {
    const int qa = (int)__builtin_rintf(__builtin_fminf(__builtin_fmaxf(a * S, -127.f), 127.f)), qb = (int)__builtin_rintf(__builtin_fminf(__builtin_fmaxf(b * S, -127.f), 127.f));
    const int qc = (int)__builtin_rintf(__builtin_fminf(__builtin_fmaxf(c * S, -127.f), 127.f)), qd = (int)__builtin_rintf(__builtin_fminf(__builtin_fmaxf(d * S, -127.f), 127.f));
    return ((unsigned)qa & 0xffu) | (((unsigned)qb & 0xffu) << 8) | (((unsigned)qc & 0xffu) << 16) | ((unsigned)qd << 24);
}
__device__ __forceinline__ float silu_f(float g) { return g * __builtin_amdgcn_rcpf(1.0f + __builtin_amdgcn_exp2f(-1.4426950408889634f * g)); }

template <bool ACC_I32 = false>
struct EpiSwiglu {
    static constexpr bool PERM = true, AFTER_DRAIN = false;
    static __device__ __forceinline__ f32x4 cv(const f32x4& a) { if constexpr (ACC_I32) { typedef int i32x4e __attribute__((ext_vector_type(4))); const i32x4e q = __builtin_bit_cast(i32x4e, a); return (f32x4){(float)q[0], (float)q[1], (float)q[2], (float)q[3]}; } else return a; }
    PG8_GAS bf16_t* O; int ldc; const PG8_GAS float* ss; float inv_k, eps, post; float out8;
    __device__ __forceinline__ void operator()(const f32x4 (&acc)[2][2][4][2], const Unit& u, int wr, int wc, int fr, int fq) const {
        const int row0 = u.pm * BM + wr * 64 + fr, col0 = u.pn * HALF + wc * 32 + 8 * fq;
        float rs[8]; const int lane_ = fr + 16 * fq;
#pragma unroll
        for (int k = 0; k < 8; ++k) { const PG8_GAS f32x4* p4 = (const PG8_GAS f32x4*)(ss + (size_t)(row0 + (k >> 2) * HALF + (k & 3) * 16) * 32 + 8 * fq); const f32x4 a = p4[0], b = p4[1];
            float t = ((a[0] + a[1]) + (a[2] + a[3])) + ((b[0] + b[1]) + (b[2] + b[3]));
            t += __builtin_bit_cast(float, __builtin_amdgcn_ds_bpermute((lane_ ^ 16) << 2, __builtin_bit_cast(int, t)));
            t += __builtin_bit_cast(float, __builtin_amdgcn_ds_bpermute((lane_ ^ 32) << 2, __builtin_bit_cast(int, t))); rs[k] = t; }
#pragma unroll
        for (int ai = 0; ai < 2; ++ai)
#pragma unroll
            for (int m = 0; m < 4; ++m) { PG8_GAS bf16_t* rowp = O + (size_t)(row0 + ai * HALF + m * 16) * ldc + col0;
                const float r = __builtin_amdgcn_rsqf(rs[ai * 4 + m] * inv_k + eps) * post;
                const f32x2 r2 = {r, r}, c2 = {-1.4426950408889634f * r, -1.4426950408889634f * r}; const float rs8 = out8 != 0.f ? r * out8 : r; const f32x2 q2 = {rs8, rs8}, one2 = {1.0f, 1.0f};
                f32x2 o[4];
#pragma unroll
                for (int h = 0; h < 4; ++h) { const f32x4 gq = cv(acc[ai][0][m][h >> 1]), uq = cv(acc[ai][1][m][h >> 1]);
                    const f32x2 gv = {gq[2 * (h & 1)], gq[2 * (h & 1) + 1]}, uv = {uq[2 * (h & 1)], uq[2 * (h & 1) + 1]};
                    const f32x2 t = gv * c2; f32x2 e; e.x = __builtin_amdgcn_exp2f(t.x); e.y = __builtin_amdgcn_exp2f(t.y);
                    const f32x2 d = e + one2; f32x2 rc; rc.x = __builtin_amdgcn_rcpf(d.x); rc.y = __builtin_amdgcn_rcpf(d.y);
                    o[h] = ((gv * r2) * rc) * (uv * q2); }
                if (out8 != 0.f) { int p = 0, q = 0;
                    p = __builtin_amdgcn_cvt_pk_fp8_f32(o[0].x, o[0].y, p, false); p = __builtin_amdgcn_cvt_pk_fp8_f32(o[1].x, o[1].y, p, true);
                    q = __builtin_amdgcn_cvt_pk_fp8_f32(o[2].x, o[2].y, q, false); q = __builtin_amdgcn_cvt_pk_fp8_f32(o[3].x, o[3].y, q, true);
                    typedef unsigned u32x2v __attribute__((ext_vector_type(2))); u32x2v w8; w8.x = (unsigned)p; w8.y = (unsigned)q;
                    *(PG8_GAS u32x2v*)((PG8_GAS unsigned char*)O + (size_t)(row0 + ai * HALF + m * 16) * ldc + col0) = w8; }
                else { u32x4 w; w.x = cvt_pk_bf16(o[0].x, o[0].y); w.y = cvt_pk_bf16(o[1].x, o[1].y); w.z = cvt_pk_bf16(o[2].x, o[2].y); w.w = cvt_pk_bf16(o[3].x, o[3].y);
                    *(PG8_GAS u32x4*)rowp = w; } }
    }
};
struct EpiResid {
    static constexpr bool PERM = true, AFTER_DRAIN = false;
    float alpha; unsigned hb_off; unsigned ss_off; unsigned h8_off; float h8_i8;
    __device__ __forceinline__ void operator()(const f32x4 (&acc)[2][2][4][2], const Unit& u, int wr, int wc, int fr, int fq) const {
        constexpr int ldc = 2048;
        PG8_GAS unsigned char* wsb = (PG8_GAS unsigned char*)karg64(21); PG8_GAS bf16_t* hb = (PG8_GAS bf16_t*)(wsb + hb_off); PG8_GAS float* ss = (PG8_GAS float*)(wsb + ss_off);
        const int row0 = u.pm * BM + wr * 64 + fr, col0 = u.pn * BM + wc * 32 + 8 * fq; const int lane = fr + 16 * fq;
        u32x4 cur[2], nxt[2];
        { const size_t off = (size_t)row0 * ldc + col0; cur[0] = *(const PG8_GAS u32x4*)(hb + off); cur[1] = *(const PG8_GAS u32x4*)(hb + off + HALF); }
#pragma unroll
        for (int k = 0; k < 8; ++k) { const int ai = k >> 2, m = k & 3; const int row = row0 + ai * HALF + m * 16; const size_t off = (size_t)row * ldc + col0;
            if (k < 7) { const int ai2 = (k + 1) >> 2, m2 = (k + 1) & 3; const size_t off2 = (size_t)(row0 + ai2 * HALF + m2 * 16) * ldc + col0;
                nxt[0] = *(const PG8_GAS u32x4*)(hb + off2); nxt[1] = *(const PG8_GAS u32x4*)(hb + off2 + HALF); }
            float sq = 0.f;
#pragma unroll
            for (int bj = 0; bj < 2; ++bj) { const u32x4 b = cur[bj]; const f32x4 a0 = acc[ai][bj][m][0], a1 = acc[ai][bj][m][1]; u32x4 w;
                w.x = cvt_pk_bf16(__builtin_bit_cast(float, b.x << 16) + a0[0] * alpha, __builtin_bit_cast(float, b.x & 0xffff0000u) + a0[1] * alpha);
                w.y = cvt_pk_bf16(__builtin_bit_cast(float, b.y << 16) + a0[2] * alpha, __builtin_bit_cast(float, b.y & 0xffff0000u) + a0[3] * alpha);
                w.z = cvt_pk_bf16(__builtin_bit_cast(float, b.z << 16) + a1[0] * alpha, __builtin_bit_cast(float, b.z & 0xffff0000u) + a1[1] * alpha);
                w.w = cvt_pk_bf16(__builtin_bit_cast(float, b.w << 16) + a1[2] * alpha, __builtin_bit_cast(float, b.w & 0xffff0000u) + a1[3] * alpha);
                *(PG8_GAS u32x4*)(hb + off + bj * HALF) = w;
                if (h8_off) { typedef unsigned u32x2v __attribute__((ext_vector_type(2))); u32x2v q8; int p = 0;
                    const float e0 = __builtin_bit_cast(float, w.x << 16), e1 = __builtin_bit_cast(float, w.x & 0xffff0000u), e2 = __builtin_bit_cast(float, w.y << 16), e3 = __builtin_bit_cast(float, w.y & 0xffff0000u);
                    const float e4 = __builtin_bit_cast(float, w.z << 16), e5 = __builtin_bit_cast(float, w.z & 0xffff0000u), e6 = __builtin_bit_cast(float, w.w << 16), e7 = __builtin_bit_cast(float, w.w & 0xffff0000u);
                    if (h8_i8 != 0.f) { q8.x = pack4_i8(e0, e1, e2, e3, h8_i8); q8.y = pack4_i8(e4, e5, e6, e7, h8_i8); }
                    else { p = __builtin_amdgcn_cvt_pk_fp8_f32(e0, e1, p, false); p = __builtin_amdgcn_cvt_pk_fp8_f32(e2, e3, p, true); q8.x = (unsigned)p; p = 0;
                        p = __builtin_amdgcn_cvt_pk_fp8_f32(e4, e5, p, false); p = __builtin_amdgcn_cvt_pk_fp8_f32(e6, e7, p, true); q8.y = (unsigned)p; }
                    *(PG8_GAS u32x2v*)(wsb + h8_off + off + bj * HALF) = q8; }
#pragma unroll
                for (int e = 0; e < 4; ++e) { const float lo = __builtin_bit_cast(float, w[e] << 16), hi = __builtin_bit_cast(float, w[e] & 0xffff0000u); sq = fmaf(lo, lo, sq); sq = fmaf(hi, hi, sq); } }
            sq += __builtin_bit_cast(float, __builtin_amdgcn_ds_bpermute((lane ^ 16) << 2, __builtin_bit_cast(int, sq)));
            sq += __builtin_bit_cast(float, __builtin_amdgcn_ds_bpermute((lane ^ 32) << 2, __builtin_bit_cast(int, sq)));
            if (fq == 0) ss[(size_t)row * 32 + u.pn * 4 + wc] = sq;
            cur[0] = nxt[0]; cur[1] = nxt[1]; }
    }
};
template <bool ACC_I32 = false>
struct EpiBf16 {
    static constexpr bool PERM = true, AFTER_DRAIN = false;
    static __device__ __forceinline__ f32x4 cv(const f32x4& a) { if constexpr (ACC_I32) { typedef int i32x4e __attribute__((ext_vector_type(4))); const i32x4e q = __builtin_bit_cast(i32x4e, a); return (f32x4){(float)q[0], (float)q[1], (float)q[2], (float)q[3]}; } else return a; }
    PG8_GAS bf16_t* O; int ldc; const PG8_GAS float* ss; float inv_k, eps; float post_a, post_b, post_c;
    __device__ __forceinline__ void operator()(const f32x4 (&acc)[2][2][4][2], const Unit& u, int wr, int wc, int fr, int fq) const {
        const int row0 = u.pm * BM + wr * 64 + fr, col0 = u.pn * BM + wc * 32 + 8 * fq;
        const float pfac = fmaf(u.pn < 8 ? 1.0f : 0.0f, post_a - post_b, fmaf((u.pn >= 9 && u.pn < 13) ? 1.0f : 0.0f, post_c - post_b, post_b));
        float rs[8]; const int lane_ = fr + 16 * fq;
#pragma unroll
        for (int k = 0; k < 8; ++k) { const PG8_GAS f32x4* p4 = (const PG8_GAS f32x4*)(ss + (size_t)(row0 + (k >> 2) * HALF + (k & 3) * 16) * 32 + 8 * fq); const f32x4 a = p4[0], b = p4[1];
            float t = ((a[0] + a[1]) + (a[2] + a[3])) + ((b[0] + b[1]) + (b[2] + b[3]));
            t += __builtin_bit_cast(float, __builtin_amdgcn_ds_bpermute((lane_ ^ 16) << 2, __builtin_bit_cast(int, t)));
            t += __builtin_bit_cast(float, __builtin_amdgcn_ds_bpermute((lane_ ^ 32) << 2, __builtin_bit_cast(int, t))); rs[k] = t; }
#pragma unroll
        for (int ai = 0; ai < 2; ++ai)
#pragma unroll
            for (int m = 0; m < 4; ++m) { PG8_GAS bf16_t* rowp = O + (size_t)(row0 + ai * HALF + m * 16) * ldc + col0;
                const float r = __builtin_amdgcn_rsqf(rs[ai * 4 + m] * inv_k + eps) * pfac;
#pragma unroll
                for (int bj = 0; bj < 2; ++bj) { const f32x4 v0 = cv(acc[ai][bj][m][0]) * r, v1 = cv(acc[ai][bj][m][1]) * r;
                    u32x4 w; w.x = cvt_pk_bf16(v0[0], v0[1]); w.y = cvt_pk_bf16(v0[2], v0[3]); w.z = cvt_pk_bf16(v1[0], v1[1]); w.w = cvt_pk_bf16(v1[2], v1[3]);
                    *(PG8_GAS u32x4*)(rowp + bj * HALF) = w; } }
    }
};
template <class Epi, class Sched, bool ALIGN_EPI = false, bool SP2 = false, bool F8 = false, bool I8 = false>
__device__ __forceinline__ void gemm_phase(PG8_LAS unsigned char* lds, const Gemm g, const Sched& S, const Epi& E, int tid_in  ) {
    int tid_ = tid_in; asm volatile("" : "+v"(tid_));
    const int tid = tid_, wid = __builtin_amdgcn_readfirstlane(tid >> 6), lane = tid & 63, wr = wid >> 2, wc = wid & 3, fr = lane & 15, fq = lane >> 4;
    const int K = g.K, nt = K / BK;
    unsigned voffA[2], voffB[2];
#pragma unroll
    for (int i = 0; i < 2; ++i) { int R, C; stage_rc(tid * 16 + i * 8192, R, C); const int Rb = Epi::PERM ? ((R & ~31) + perm32(R & 31)) : R;
        voffA[i] = (unsigned)(R * K + C) * 2u; voffB[i] = (unsigned)(Rb * K + C) * 2u; }
    const size_t kstep = (size_t)(BK * 2);
    const size_t hstep = (size_t)HALF * K * 2;
    const size_t tstep = 2 * hstep;
    const unsigned ldsw = (unsigned)wid * 1024u;
    const int aoff = lds_byte(wr * 64 + fr, fq * 8), boff = lds_byte(wc * 32 + fr, fq * 8);
#define PG8_SA(b, h) (((b) * 2 + (h)) * HTB)
#define PG8_SB(b, h) ((4 + (b) * 2 + (h)) * HTB)
#define PG8_STAGE(bufoff, gbase, voff) do { _Pragma("unroll") for (int _i = 0; _i < 2; ++_i) \
        __builtin_amdgcn_global_load_lds((const PG8_GAS unsigned*)((const PG8_GAS char*)(gbase) + (voff)[_i]), (PG8_LAS unsigned*)(lds + (bufoff) + ldsw + _i * 8192), 16, 0, 0); } while (0)
#define PG8_LDA(dst, b, h) do { _Pragma("unroll") for (int m = 0; m < 4; ++m) _Pragma("unroll") for (int k = 0; k < 2; ++k) dst[m][k] = *(const PG8_LAS bf16x8*)(lds + PG8_SA(b, h) + aoff + m * 2048 + k * 1024); } while (0)
#define PG8_LDB(dst, b, h) do { _Pragma("unroll") for (int n = 0; n < 2; ++n) _Pragma("unroll") for (int k = 0; k < 2; ++k) dst[n][k] = *(const PG8_LAS bf16x8*)(lds + PG8_SB(b, h) + boff + n * 2048 + k * 1024); } while (0)
#define PG8_MMA(ai, bj, At, Bt) do { __builtin_amdgcn_s_setprio(1); _Pragma("unroll") for (int m = 0; m < 4; ++m) _Pragma("unroll") for (int n = 0; n < 2; ++n) { \
        if constexpr (F8) { asm volatile("v_mfma_f32_16x16x128_f8f6f4 %0, %1, %2, %0" : "+v"(acc[ai][bj][m][n]) : "v"(cat8(Bt[n][0], Bt[n][1])), "v"(cat8(At[m][0], At[m][1]))); } \
        else if constexpr (I8) { _Pragma("unroll") for (int k = 0; k < 2; ++k) asm volatile("v_mfma_i32_16x16x64_i8 %0, %1, %2, %0" : "+v"(acc[ai][bj][m][n]) : "v"(Bt[n][k]), "v"(At[m][k])); } \
        else { _Pragma("unroll") for (int k = 0; k < 2; ++k) acc[ai][bj][m][n] = __builtin_amdgcn_mfma_f32_16x16x32_bf16(Bt[n][k], At[m][k], acc[ai][bj][m][n], 0, 0, 0); } } \
        __builtin_amdgcn_s_setprio(0); } while (0)
#define PG8_WAIT_V(n) asm volatile("s_waitcnt vmcnt(" #n ")" ::: "memory")
#define PG8_WAIT_L(n) asm volatile("s_waitcnt lgkmcnt(" #n ")" ::: "memory")
#define PG8_BAR __builtin_amdgcn_s_barrier()
#define PG8_SCHED __builtin_amdgcn_sched_barrier(0)
    Unit cur, nxt; int ui = 0;
    if (!S.next(0, cur)) return;
    f32x4 acc[2][2][4][2];
#pragma unroll
    for (int a = 0; a < 2; ++a)
#pragma unroll
        for (int b = 0; b < 2; ++b)
#pragma unroll
            for (int m = 0; m < 4; ++m)
#pragma unroll
                for (int n = 0; n < 2; ++n) acc[a][b][m][n] = (f32x4){0.f, 0.f, 0.f, 0.f};
    bf16x8 At[4][2], B0[2][2], B1[2][2];
    const PG8_GAS char* cA = (const PG8_GAS char*)g.A + (size_t)cur.pm * tstep; const PG8_GAS char* cB = (const PG8_GAS char*)g.Bt + (size_t)cur.pn * tstep;
    S.a_ready(cur);
    if constexpr (SP2) {
        PG8_STAGE(PG8_SB(0, 0), cB, voffB); PG8_STAGE(PG8_SB(0, 1), cB + hstep, voffB); PG8_STAGE(PG8_SA(0, 0), cA, voffA); PG8_STAGE(PG8_SA(0, 1), cA + hstep, voffA);
        if (wr == 1) PG8_BAR;
        PG8_WAIT_V(2); PG8_BAR;
        PG8_STAGE(PG8_SB(1, 0), cB + kstep, voffB); PG8_STAGE(PG8_SA(1, 0), cA + kstep, voffA); PG8_STAGE(PG8_SB(1, 1), cB + hstep + kstep, voffB);
        PG8_WAIT_V(6); PG8_BAR;
    } else {
        PG8_STAGE(PG8_SB(0, 0), cB, voffB); PG8_STAGE(PG8_SA(0, 0), cA, voffA); PG8_STAGE(PG8_SB(0, 1), cB + hstep, voffB); PG8_STAGE(PG8_SA(0, 1), cA + hstep, voffA);
        if (wr == 1) PG8_BAR;
        PG8_WAIT_V(4); PG8_BAR;
        PG8_STAGE(PG8_SB(1, 0), cB + kstep, voffB); PG8_STAGE(PG8_SA(1, 0), cA + kstep, voffA); PG8_STAGE(PG8_SB(1, 1), cB + hstep + kstep, voffB);
        PG8_WAIT_V(6); PG8_BAR;
    }
    for (;;) {
        const bool has_next = S.next(ui + 1, nxt);
        const PG8_GAS char* nA = has_next ? (const PG8_GAS char*)g.A + (size_t)nxt.pm * tstep : cA; const PG8_GAS char* nB = has_next ? (const PG8_GAS char*)g.Bt + (size_t)nxt.pn * tstep : cB;
        for (int t = 0; t < nt; t += 2) {
            const bool last = (t == nt - 2);
            const PG8_GAS char* a1 = cA + (size_t)(t + 1) * kstep;
            const PG8_GAS char* a2 = last ? nA : cA + (size_t)(t + 2) * kstep; const PG8_GAS char* b2 = last ? nB : cB + (size_t)(t + 2) * kstep;
            const PG8_GAS char* a3 = a2 + kstep; const PG8_GAS char* b3 = b2 + kstep;
            if (last && has_next) S.a_ready(nxt);
            if constexpr (SP2) {
            PG8_LDB(B0, 0, 0); PG8_LDB(B1, 0, 1); PG8_SCHED; PG8_LDA(At, 0, 0); PG8_STAGE(PG8_SA(1, 1), a1 + hstep, voffA);
            PG8_WAIT_V(8); PG8_WAIT_L(0); PG8_BAR; PG8_MMA(0, 0, At, B0); PG8_MMA(0, 1, At, B1); PG8_BAR; PG8_SCHED;
            PG8_LDA(At, 0, 1); PG8_STAGE(PG8_SB(0, 0), b2, voffB); PG8_STAGE(PG8_SB(0, 1), b2 + hstep, voffB); PG8_STAGE(PG8_SA(0, 0), a2, voffA);
            PG8_WAIT_V(8); PG8_WAIT_L(0); PG8_BAR; PG8_MMA(1, 0, At, B0); PG8_MMA(1, 1, At, B1); PG8_BAR; PG8_SCHED;
            PG8_LDB(B0, 1, 0); PG8_LDB(B1, 1, 1); PG8_SCHED; PG8_LDA(At, 1, 0); PG8_STAGE(PG8_SA(0, 1), a2 + hstep, voffA);
            PG8_WAIT_V(8); PG8_WAIT_L(0); PG8_BAR; PG8_MMA(0, 0, At, B0); PG8_MMA(0, 1, At, B1); PG8_BAR; PG8_SCHED;
            PG8_LDA(At, 1, 1); PG8_STAGE(PG8_SB(1, 0), b3, voffB); PG8_STAGE(PG8_SB(1, 1), b3 + hstep, voffB); PG8_STAGE(PG8_SA(1, 0), a3, voffA);
            PG8_WAIT_V(8); PG8_WAIT_L(0); PG8_BAR; PG8_MMA(1, 0, At, B0); PG8_MMA(1, 1, At, B1); PG8_BAR; PG8_SCHED;
            } else {
            PG8_LDB(B0, 0, 0); PG8_SCHED; PG8_LDA(At, 0, 0); PG8_STAGE(PG8_SA(1, 1), a1 + hstep, voffA);
            PG8_WAIT_L(8); PG8_BAR; PG8_WAIT_L(0); PG8_MMA(0, 0, At, B0); PG8_BAR; PG8_SCHED;
            PG8_LDB(B1, 0, 1); PG8_STAGE(PG8_SB(0, 0), b2, voffB);
            PG8_BAR; PG8_WAIT_L(0); PG8_MMA(0, 1, At, B1); PG8_BAR;
            PG8_LDA(At, 0, 1); PG8_STAGE(PG8_SA(0, 0), a2, voffA);
            PG8_BAR; PG8_WAIT_L(0); PG8_MMA(1, 0, At, B0); PG8_BAR; PG8_SCHED;
            PG8_STAGE(PG8_SB(0, 1), b2 + hstep, voffB);
            PG8_WAIT_V(6); PG8_BAR; PG8_MMA(1, 1, At, B1); PG8_BAR;
            PG8_LDB(B0, 1, 0); PG8_SCHED; PG8_LDA(At, 1, 0); PG8_STAGE(PG8_SA(0, 1), a2 + hstep, voffA);
            PG8_WAIT_L(8); PG8_BAR; PG8_WAIT_L(0); PG8_MMA(0, 0, At, B0); PG8_BAR; PG8_SCHED;
            PG8_LDB(B1, 1, 1); PG8_STAGE(PG8_SB(1, 0), b3, voffB);
            PG8_BAR; PG8_WAIT_L(0); PG8_MMA(0, 1, At, B1); PG8_BAR;
            PG8_LDA(At, 1, 1); PG8_STAGE(PG8_SA(1, 0), a3, voffA);
            PG8_BAR; PG8_WAIT_L(0); PG8_MMA(1, 0, At, B0); PG8_BAR; PG8_SCHED;
            PG8_STAGE(PG8_SB(1, 1), b3 + hstep, voffB);
            PG8_WAIT_V(6); PG8_BAR; PG8_MMA(1, 1, At, B1); PG8_BAR;
            }
        }
        if constexpr (ALIGN_EPI) { if (wr == 0) PG8_BAR; }
        if constexpr (!Epi::AFTER_DRAIN) { E(acc, cur, wr, wc, fr, fq); S.done(cur); }
        if (!has_next) break;
#pragma unroll
        for (int a = 0; a < 2; ++a)
#pragma unroll
            for (int b = 0; b < 2; ++b)
#pragma unroll
                for (int m = 0; m < 4; ++m)
#pragma unroll
                    for (int n = 0; n < 2; ++n) acc[a][b][m][n] = (f32x4){0.f, 0.f, 0.f, 0.f};
        cur = nxt; cA = nA; cB = nB; ++ui;
        if constexpr (ALIGN_EPI) { if (wr == 1) PG8_BAR; }
    }
    PG8_WAIT_V(0);
    if constexpr (!ALIGN_EPI) { if (wr == 0) PG8_BAR; }
    PG8_BAR;
    if constexpr (Epi::AFTER_DRAIN) { E.fused(acc, cur, wr, wc, fr, fq, lds, wid, lane); S.done(cur); }
#undef PG8_SA
#undef PG8_SB
#undef PG8_STAGE
#undef PG8_LDA
#undef PG8_LDB
#undef PG8_MMA
#undef PG8_WAIT_V
#undef PG8_WAIT_L
#undef PG8_BAR
#undef PG8_SCHED
}
}
constexpr int NWAVES = 8;
constexpr int BATCH = 8, SEQ = 4096, D = 2048, FF = 5632, DEPTH = 2;
constexpr int M = BATCH * SEQ;
constexpr int NGU = 2 * FF;
constexpr int H_A = 8, HD_A = 128, RANK = 256, IH = 8, IDIM = 64, TOPK = 256;
constexpr int H_B = 16, KVH = 2, GQA = 8, HD_B = 64, WINDOW = 128;
constexpr int D_IN = 3144;
constexpr float EPS = 1e-6f;
constexpr size_t MiB = 1u << 20;
constexpr size_t WS_CTL = 0, CTL_ZERO_BYTES = 1 * MiB;
#ifndef F8_MASK
#define F8_MASK 0xF
#endif
constexpr float W8_SCALE = 64.0f;
#ifndef GU_I8
#define GU_I8 1
#endif
constexpr float H8I_SCALE = 127.0f / 4.6f, W8I_SCALE = 127.0f / (4.2f * 0.022097086912079608f);
#ifndef D8_MASK
#define D8_MASK 0xF
#endif
constexpr float A8_SCALE = 8.0f;
__host__ __device__ constexpr bool d8_on(int l, int f) { return ((D8_MASK >> (2 * l + f)) & 1) != 0; }
constexpr float O8_SCALE = 16.0f;
#ifndef OUT_F8
#define OUT_F8 1
#endif
constexpr bool F8_ALL1 = (F8_MASK & 0x5) == 0x5, F8_ALL2 = (F8_MASK & 0xA) == 0xA;
__host__ __device__ constexpr bool f8_on(int l, int f) { return ((F8_MASK >> (2 * l + f)) & 1) != 0; }
constexpr size_t GU1_B = (F8_ALL1 ? 22 : 44) * MiB, GU2_B = (F8_ALL2 ? 22 : 44) * MiB;
constexpr size_t WS_W0 = 2 * MiB;
constexpr size_t WO_GU1 = 0, WO_D1 = GU1_B, WO_GU2 = WO_D1 + 22 * MiB, WO_D2 = WO_GU2 + GU2_B, WO_IN = WO_D2 + 22 * MiB, WO_OUT = WO_IN + 17 * MiB, W_LAYER = WO_OUT + 12 * MiB;
constexpr size_t WS_XN = WS_W0 + 2 * W_LAYER;
constexpr size_t WS_HB8 = WS_XN + 128 * MiB;
constexpr size_t WS_ACT = WS_HB8 + (F8_MASK ? 64 : 0) * MiB;
constexpr size_t WS_Z = WS_ACT, WS_CKVN = WS_ACT + 272 * MiB, WS_KIN = WS_ACT + 288 * MiB, WS_WIF = WS_ACT + 292 * MiB, WS_IDX = WS_ACT + 294 * MiB;
constexpr int ZLD = 4352, ZC_QLAT = 0, ZC_CKV = 2048, ZC_QB = 2304, ZC_KB = 3328, ZC_VB = 3456, ZC_QI = 3584, ZC_KI = 4096, ZC_WI = 4160;
constexpr int ZN8 = 3584;
#ifndef IN_I8
#define IN_I8 1
#endif
constexpr float WQ8I_SCALE = 127.0f / (4.2f * 0.015625f);
constexpr int OLD = 3072;
constexpr size_t WS_O = WS_ACT + 352 * MiB;
constexpr size_t WS_SS = WS_O + 192 * MiB, SS_BYTES = 4 * MiB;
constexpr size_t WS_END = WS_SS + 2 * SS_BYTES;
static_assert(WS_END <= 1024 * MiB, "d_ws map exceeds 1 GiB");
constexpr int CW_TMO = 0, CW_CODE = 1, CW_BAR = 4096;
constexpr int RING_OFF = 0, RING_BYTES = 131072;
constexpr int LDSCTL_OFF = RING_BYTES, MISC_OFF = LDSCTL_OFF + 320;
constexpr int LDS_BYTES = 147456;
constexpr int RSL_OFF = RING_BYTES + 5632;
#define GAS __attribute__((address_space(1)))
#define LAS __attribute__((address_space(3)))
typedef unsigned short bf16;
typedef unsigned v4u __attribute__((ext_vector_type(4)));
typedef float f32x4 __attribute__((ext_vector_type(4)));
typedef short bf16x8 __attribute__((ext_vector_type(8)));
typedef GAS unsigned gu32;
typedef GAS unsigned long long gu64;
#define RLX_AGENT __ATOMIC_RELAXED, __HIP_MEMORY_SCOPE_AGENT
#define LDS_WAIT() asm volatile("s_waitcnt lgkmcnt(0)" ::: "memory")
#define VM_WAIT() asm volatile("s_waitcnt vmcnt(0)" ::: "memory")
__device__ __forceinline__ unsigned long long rt() { return __builtin_amdgcn_s_memrealtime(); }
__device__ __forceinline__ unsigned f2bf(float f) { unsigned u = __builtin_bit_cast(unsigned, f); return (u + 0x7fffu + ((u >> 16) & 1u)) >> 16; }
__device__ __forceinline__ unsigned pk2(float lo, float hi) { return f2bf(lo) | (f2bf(hi) << 16); }

#define XB_TMO      128
#define XB_XCNT(j)  (256  + 64 * (j))
#define XB_XSUB(j)  (1280 + 64 * (j))
#define XB_XGEN(j)  (2304 + 64 * (j))
#define XB_TOP      3328
#define XB_TOPGEN   3392
#define XCD_BAR_WORDS 3456
#define XB_SPIN_CAP (1u << 18)

__device__ __forceinline__ unsigned xb_ld(unsigned* p)              { return __hip_atomic_load(p, __ATOMIC_RELAXED, __HIP_MEMORY_SCOPE_AGENT); }
__device__ __forceinline__ unsigned xb_add(unsigned* p, unsigned v) { return __hip_atomic_fetch_add(p, v, __ATOMIC_RELAXED, __HIP_MEMORY_SCOPE_AGENT); }
__device__ __forceinline__ unsigned xb_xcc_id() { return (unsigned)__builtin_amdgcn_s_getreg((3 << 11) | 20) & 0xFu; }
#define XB_SPIN(cond, bar) do { unsigned _sp = 0; while (cond) { __builtin_amdgcn_s_sleep(1); \
    if ((++_sp & 255u) == 0u) { if (xb_ld(&(bar)[XB_TMO])) break; if (_sp > XB_SPIN_CAP) { atomicAdd(&(bar)[XB_TMO], 1u); break; } } } } while (0)

struct XcdBarrier {
    unsigned* bar; unsigned x;
    volatile LAS unsigned* st;
};

__device__ __forceinline__ XcdBarrier xcd_barrier_post(unsigned* bar, volatile LAS unsigned* st, bool leader  ) {
    XcdBarrier b; b.bar = bar; b.x = xb_xcc_id(); b.st = st;
    if (leader) (void)xb_add(&bar[XB_XCNT(b.x)], 1u);
    return b;
}
__device__ __forceinline__ void xcd_barrier_complete(unsigned* bar, unsigned x, unsigned& nloc, unsigned& nx) {
    const unsigned G = gridDim.x * gridDim.y * gridDim.z;
    unsigned sum, cnt, mine, sp = 0u;
    for (;;) {
        sum = 0u; cnt = 0u; mine = 0u;
#pragma unroll
        for (unsigned j = 0; j < 16; ++j) { const unsigned c = xb_ld(&bar[XB_XCNT(j)]); sum += c; cnt += (c > 0u) ? 1u : 0u; mine = (j == x) ? c : mine; }
        if (sum == G) break;
        __builtin_amdgcn_s_sleep(1);
        if ((++sp & 255u) == 0u) { if (xb_ld(&bar[XB_TMO])) break; if (sp > XB_SPIN_CAP) { atomicAdd(&bar[XB_TMO], 1u); break; } }
    }
    nloc = mine > 0u ? mine : 1u; nx = cnt > 0u ? cnt : 1u;
}

__device__ __forceinline__ void xcd_barrier(const XcdBarrier& b, bool leader  ) {
    asm volatile("s_waitcnt vmcnt(0)" ::: "memory");
    __syncthreads();
    if (leader) {
        unsigned* bar = b.bar;
        __builtin_amdgcn_s_waitcnt(0);
        unsigned nloc = b.st[0], nx = b.st[1];
        if (nloc == 0u) { xcd_barrier_complete(bar, b.x, nloc, nx); b.st[0] = nloc; b.st[1] = nx; }
        const unsigned old = xb_add(&bar[XB_XSUB(b.x)], 1u);
        const unsigned gen = old / nloc;
        if (old + 1u == (gen + 1u) * nloc) {
            __builtin_amdgcn_fence(__ATOMIC_RELEASE, "agent");
            asm volatile("s_waitcnt vmcnt(0)" ::: "memory");
            const unsigned og = xb_add(&bar[XB_TOP], 1u);
            const unsigned tg = og / nx;
            if (og + 1u == (tg + 1u) * nx) xb_add(&bar[XB_TOPGEN], 1u);
            else XB_SPIN(xb_ld(&bar[XB_TOPGEN]) == tg, bar);
            __builtin_amdgcn_fence(__ATOMIC_ACQUIRE, "agent");
            xb_add(&bar[XB_XGEN(b.x)], 1u);
            asm volatile("s_waitcnt vmcnt(0)" ::: "memory");
        } else {
            XB_SPIN(xb_ld(&bar[XB_XGEN(b.x)]) == gen, bar);
            __builtin_amdgcn_fence(__ATOMIC_ACQUIRE, "agent");
            asm volatile("s_waitcnt vmcnt(0)" ::: "memory");
        }
    }
    __syncthreads();
}
__constant__ unsigned char T5_BUCKET[128] = {0, 1, 2, 3, 4, 5, 6, 7, 8, 9, 10, 11, 12, 13, 14, 15, 16, 16, 16, 17, 17, 18, 18, 18, 19, 19, 19, 20, 20, 20, 20, 21, 21, 21, 21, 22, 22, 22, 22, 22, 23, 23, 23, 23, 23, 23, 24, 24, 24, 24, 24, 24, 25, 25, 25, 25, 25, 25, 25, 26, 26, 26, 26, 26, 26, 26, 26, 27, 27, 27, 27, 27, 27, 27, 27, 27, 27, 28, 28, 28, 28, 28, 28, 28, 28, 28, 28, 29, 29, 29, 29, 29, 29, 29, 29, 29, 29, 29, 29, 30, 30, 30, 30, 30, 30, 30, 30, 30, 30, 30, 30, 30, 30, 31, 31, 31, 31, 31, 31, 31, 31, 31, 31, 31, 31, 31, 31, 31};
typedef short s16x4 __attribute__((ext_vector_type(4)));
typedef float f32x16 __attribute__((ext_vector_type(16)));
__device__ __forceinline__ float bf2f(unsigned short b) { return __builtin_bit_cast(float, (unsigned)b << 16); }
__device__ __forceinline__ bf16x8 cat4(s16x4 lo, s16x4 hi) { return __builtin_shufflevector(lo, hi, 0, 1, 2, 3, 4, 5, 6, 7); }
__device__ __forceinline__ void tr_read4(unsigned a0, unsigned a1, unsigned a2, unsigned a3, s16x4& r0, s16x4& r1, s16x4& r2, s16x4& r3) {
    asm volatile("ds_read_b64_tr_b16 %0, %4\n\tds_read_b64_tr_b16 %1, %5\n\tds_read_b64_tr_b16 %2, %6\n\tds_read_b64_tr_b16 %3, %7\n\ts_waitcnt lgkmcnt(0)"
                 : "=&v"(r0), "=&v"(r1), "=&v"(r2), "=&v"(r3) : "v"(a0), "v"(a1), "v"(a2), "v"(a3) : "memory");
}
#define SHX(x, o) __builtin_bit_cast(float, __builtin_amdgcn_ds_bpermute(((lane) ^ (o)) << 2, __builtin_bit_cast(int, (float)(x))))
#define SHXU(x, o) ((unsigned)__builtin_amdgcn_ds_bpermute(((lane) ^ (o)) << 2, (int)(x)))
__device__ __forceinline__ float wave_sum(float v, int lane) {
#pragma unroll
    for (int o = 1; o < 64; o <<= 1) v += SHX(v, o);
    return v;
}
template <int OUT8 = 0>
__device__ __forceinline__ void conv_item(const GAS float* W, int ldw, int k0, int c0, int nvalid, GAS bf16* dst, int dld, int drow0, int dk0, float scale, const GAS float* gain, LAS float* scr, int lane) {
    const int c = lane & 31;
    float vin[32];
#pragma unroll
    for (int i = 0; i < 32; ++i) { const int kk = 2 * i + (lane >> 5); vin[i] = 0.f;
        if (c < nvalid) vin[i] = W[(size_t)(k0 + kk) * ldw + c0 + c]; }
#pragma unroll
    for (int i = 0; i < 32; ++i) { const int kk = 2 * i + (lane >> 5); scr[kk * 33 + c] = vin[i] * scale; }
    LDS_WAIT(); asm volatile("" ::: "memory");
    const int c8 = lane & 7;
    f32x4 ga = {1.f, 1.f, 1.f, 1.f}, gb = {1.f, 1.f, 1.f, 1.f};
    if (gain) { ga = *(const GAS f32x4*)(gain + k0 + 8 * c8); gb = *(const GAS f32x4*)(gain + k0 + 8 * c8 + 4); }
#pragma unroll
    for (int j = 0; j < 4; ++j) { const int n = (lane >> 3) + 8 * j; const LAS float* s = scr + (8 * c8) * 33 + n;
        if constexpr (OUT8 == 2) { const unsigned p = pg8::pack4_i8(s[0 * 33] * ga.x, s[1 * 33] * ga.y, s[2 * 33] * ga.z, s[3 * 33] * ga.w, 1.0f), q = pg8::pack4_i8(s[4 * 33] * gb.x, s[5 * 33] * gb.y, s[6 * 33] * gb.z, s[7 * 33] * gb.w, 1.0f);
            *(GAS unsigned long long*)((GAS unsigned char*)dst + (size_t)(drow0 + n) * dld + dk0 + k0 + 8 * c8) = (unsigned long long)p | ((unsigned long long)q << 32); }
        else if constexpr (OUT8 == 1) { int p = 0, q = 0;
            p = __builtin_amdgcn_cvt_pk_fp8_f32(s[0 * 33] * ga.x, s[1 * 33] * ga.y, p, false); p = __builtin_amdgcn_cvt_pk_fp8_f32(s[2 * 33] * ga.z, s[3 * 33] * ga.w, p, true);
            q = __builtin_amdgcn_cvt_pk_fp8_f32(s[4 * 33] * gb.x, s[5 * 33] * gb.y, q, false); q = __builtin_amdgcn_cvt_pk_fp8_f32(s[6 * 33] * gb.z, s[7 * 33] * gb.w, q, true);
            *(GAS unsigned long long*)((GAS unsigned char*)dst + (size_t)(drow0 + n) * dld + dk0 + k0 + 8 * c8) = (unsigned long long)(unsigned)p | ((unsigned long long)(unsigned)q << 32); }
        else { v4u o; o.x = pk2(s[0 * 33] * ga.x, s[1 * 33] * ga.y); o.y = pk2(s[2 * 33] * ga.z, s[3 * 33] * ga.w); o.z = pk2(s[4 * 33] * gb.x, s[5 * 33] * gb.y); o.w = pk2(s[6 * 33] * gb.z, s[7 * 33] * gb.w);
            *(GAS v4u*)(dst + (size_t)(drow0 + n) * dld + dk0 + k0 + 8 * c8) = o; } }
    LDS_WAIT(); asm volatile("" ::: "memory");
}
__device__ __forceinline__ void rmsnorm_rows_bf16(const GAS float* X, const GAS float* g, GAS bf16* O, int gw, int NGW, int lane) {
    f32x4 gv[8];
#pragma unroll
    for (int j = 0; j < 8; ++j) gv[j] = ((const GAS f32x4*)g)[lane + 64 * j];
    for (int m = gw; m < M; m += NGW) {
        const GAS f32x4* xr = (const GAS f32x4*)(X + (size_t)m * D) + lane;
        f32x4 v[8]; float s = 0.f;
#pragma unroll
        for (int j = 0; j < 8; ++j) { v[j] = xr[64 * j]; s += (v[j].x * v[j].x + v[j].y * v[j].y) + (v[j].z * v[j].z + v[j].w * v[j].w); }
        const float r = 1.0f / sqrtf(wave_sum(s, lane) * (1.0f / D) + EPS);
        GAS unsigned long long* o8 = (GAS unsigned long long*)(O + (size_t)m * D) + lane;
#pragma unroll
        for (int j = 0; j < 8; ++j) { const f32x4 y = v[j] * r * gv[j]; o8[64 * j] = (unsigned long long)pk2(y.x, y.y) | ((unsigned long long)pk2(y.z, y.w) << 32); }
    }
}
__device__ __forceinline__ void rows_bf16_ss(const GAS float* X, GAS bf16* O, GAS unsigned char* O8, GAS float* ss, int gw, int NGW, int lane) {
    for (int m = gw; m < M; m += NGW) {
        const GAS f32x4* xr = (const GAS f32x4*)(X + (size_t)m * D) + lane;
        f32x4 v[8]; float s = 0.f;
#pragma unroll
        for (int j = 0; j < 8; ++j) { v[j] = xr[64 * j]; s += (v[j].x * v[j].x + v[j].y * v[j].y) + (v[j].z * v[j].z + v[j].w * v[j].w); }
        s = wave_sum(s, lane);
        GAS unsigned long long* o8 = (GAS unsigned long long*)(O + (size_t)m * D) + lane;
#pragma unroll
        for (int j = 0; j < 8; ++j) o8[64 * j] = (unsigned long long)pk2(v[j].x, v[j].y) | ((unsigned long long)pk2(v[j].z, v[j].w) << 32);
        if (O8) { GAS unsigned* q8 = (GAS unsigned*)(O8 + (size_t)m * D) + lane;
#pragma unroll
            for (int j = 0; j < 8; ++j) { if constexpr (GU_I8) q8[64 * j] = pg8::pack4_i8(v[j].x, v[j].y, v[j].z, v[j].w, H8I_SCALE); else { int p = 0; p = __builtin_amdgcn_cvt_pk_fp8_f32(v[j].x, v[j].y, p, false); p = __builtin_amdgcn_cvt_pk_fp8_f32(v[j].z, v[j].w, p, true); q8[64 * j] = (unsigned)p; } } }
        if (lane < 32) ss[(size_t)m * 32 + lane] = lane == 0 ? s : 0.f;
    }
}
__device__ __forceinline__ void final_rows(const GAS bf16* HB, GAS float* OUT, const GAS float* g, const GAS float* ss, int gw, int NGW, int lane) {
    f32x4 gv[8];
#pragma unroll
    for (int j = 0; j < 8; ++j) gv[j] = ((const GAS f32x4*)g)[lane + 64 * j];
    for (int m = gw; m < M; m += NGW) {
        const GAS unsigned long long* hr = (const GAS unsigned long long*)(HB + (size_t)m * D) + lane; GAS f32x4* orow = (GAS f32x4*)(OUT + (size_t)m * D) + lane;
        unsigned long long raw[8];
#pragma unroll
        for (int j = 0; j < 8; ++j) raw[j] = hr[64 * j];
        const float r = 1.0f / sqrtf(wave_sum(lane < 32 ? ss[(size_t)m * 32 + lane] : 0.f, lane) * (1.0f / D) + EPS);
#pragma unroll
        for (int j = 0; j < 8; ++j) { const unsigned lo = (unsigned)raw[j], hi = (unsigned)(raw[j] >> 32);
            f32x4 v = {__builtin_bit_cast(float, lo << 16), __builtin_bit_cast(float, lo & 0xffff0000u), __builtin_bit_cast(float, hi << 16), __builtin_bit_cast(float, hi & 0xffff0000u)};
            orow[64 * j] = v * r * gv[j]; }
    }
}
__device__ __forceinline__ void rmsnorm_rows_f32_inplace(GAS float* X, const GAS float* g, int gw, int NGW, int lane) {
    f32x4 gv[8];
#pragma unroll
    for (int j = 0; j < 8; ++j) gv[j] = ((const GAS f32x4*)g)[lane + 64 * j];
    for (int m = gw; m < M; m += NGW) {
        GAS f32x4* xr = (GAS f32x4*)(X + (size_t)m * D) + lane;
        f32x4 v[8]; float s = 0.f;
#pragma unroll
        for (int j = 0; j < 8; ++j) { v[j] = xr[64 * j]; s += (v[j].x * v[j].x + v[j].y * v[j].y) + (v[j].z * v[j].z + v[j].w * v[j].w); }
        const float r = 1.0f / sqrtf(wave_sum(s, lane) * (1.0f / D) + EPS);
#pragma unroll
        for (int j = 0; j < 8; ++j) xr[64 * j] = v[j] * r * gv[j];
    }
}

template <bool P_IFAST, int OUT8 = 0>
__device__ __forceinline__ void absorb_unit(const GAS float* Psrc, size_t p_ri, size_t p_rd, const GAS float* Qsrc, size_t q_rj, GAS bf16* out, size_t out_ld, float scale, const GAS float* qgain, LAS float* Ps_, LAS float* Qs_, int tid) {
    LAS bf16* Ps = (LAS bf16*)Ps_; LAS bf16* Qs = Ps + 64 * 136;
    float pv[16], qv[16];
#pragma unroll
    for (int j = 0; j < 16; ++j) { const int e = tid + 512 * j; const int i = P_IFAST ? (e & 63) : (e >> 7), d = P_IFAST ? (e >> 6) : (e & 127);
        pv[j] = Psrc[(size_t)i * p_ri + (size_t)d * p_rd];
        const int jj = e >> 7, dd = e & 127; qv[j] = Qsrc[(size_t)jj * q_rj + dd] * (qgain ? qgain[jj] : 1.0f); }
#pragma unroll
    for (int j = 0; j < 16; ++j) { const int e = tid + 512 * j; const int i = P_IFAST ? (e & 63) : (e >> 7), d = P_IFAST ? (e >> 6) : (e & 127);
        Ps[i * 136 + d] = (bf16)f2bf(pv[j]); const int jj = e >> 7, dd = e & 127; Qs[jj * 136 + dd] = (bf16)f2bf(qv[j]); }
    __syncthreads();
    const int wv = tid >> 6, ln = tid & 63, it = wv >> 1, r16 = ln & 15, g = ln >> 4;
#pragma unroll
    for (int jq = 0; jq < 2; ++jq) { const int jt = 2 * (wv & 1) + jq; f32x4 acc = {0.f, 0.f, 0.f, 0.f};
#pragma unroll
        for (int st = 0; st < 4; ++st) { const bf16x8 a = *(const LAS bf16x8*)(Ps + (16 * it + r16) * 136 + 32 * st + 8 * g); const bf16x8 b = *(const LAS bf16x8*)(Qs + (16 * jt + r16) * 136 + 32 * st + 8 * g);
            acc = __builtin_amdgcn_mfma_f32_16x16x32_bf16(a, b, acc, 0, 0, 0); }
#pragma unroll
        for (int rg = 0; rg < 4; ++rg) { const size_t o = (size_t)(16 * it + 4 * g + rg) * out_ld + 16 * jt + r16;
            if constexpr (OUT8 == 2) ((GAS unsigned char*)out)[o] = (unsigned char)(pg8::pack4_i8(acc[rg], 0.f, 0.f, 0.f, scale) & 0xffu);
            else if constexpr (OUT8 == 1) ((GAS unsigned char*)out)[o] = (unsigned char)__builtin_amdgcn_cvt_pk_fp8_f32(acc[rg] * scale, 0.f, 0, false);
            else out[o] = (bf16)f2bf(acc[rg] * scale); } }
    __syncthreads();
}
__device__ __forceinline__ void post_rows(const GAS bf16* Z, const GAS float* gkv, const GAS float* gki, const GAS float* bki, GAS bf16* CKVN, GAS bf16* KIN, GAS float* WIF, int gw, int NGW, int lane) {
    const f32x4 g4 = ((const GAS f32x4*)gkv)[lane]; const float gk = gki[lane], bk = bki[lane];
    for (int m = gw; m < M; m += NGW) {
        const GAS bf16* zr = Z + (size_t)m * ZLD;
        const unsigned long long raw = *(const GAS unsigned long long*)(zr + ZC_CKV + 4 * lane);
        const float kraw = bf2f(zr[ZC_KI + lane]);
        const float wraw = bf2f(zr[ZC_WI + (lane & 7)]);
        const float c0 = bf2f((unsigned short)raw), c1 = bf2f((unsigned short)(raw >> 16)), c2 = bf2f((unsigned short)(raw >> 32)), c3 = bf2f((unsigned short)(raw >> 48));
        const float r = 1.0f / sqrtf(wave_sum((c0 * c0 + c1 * c1) + (c2 * c2 + c3 * c3), lane) * (1.0f / RANK) + EPS);
        *(GAS unsigned long long*)(CKVN + (size_t)m * RANK + 4 * lane) = (unsigned long long)pk2(c0 * r * g4.x, c1 * r * g4.y) | ((unsigned long long)pk2(c2 * r * g4.z, c3 * r * g4.w) << 32);
        const float mu = wave_sum(kraw, lane) * (1.0f / IDIM); const float dv = kraw - mu;
        const float var = wave_sum(dv * dv, lane) * (1.0f / IDIM);
        KIN[(size_t)m * IDIM + lane] = (bf16)f2bf(dv * (1.0f / sqrtf(var + EPS)) * gk + bk);
        if (lane < 8) WIF[(size_t)m * IH + lane] = wraw;
    }
}
constexpr int SWA_KP = 144, SWA_VP = 192;
constexpr int SWA_K_OFF = 0, SWA_V_OFF = 160 * SWA_KP, SWA_TAB_OFF = SWA_V_OFF + 160 * SWA_VP;
static_assert(SWA_TAB_OFF + 16 * 128 * 4 <= RING_BYTES, "SWA LDS map");
__device__ __forceinline__ void swa_phase(LAS unsigned char* lds, const GAS bf16* Z, GAS bf16* O, const GAS float* rel_bias, const GAS float* sinks, int vcu, int G, int tid, int lane, int wave) {
    LAS float* tab = (LAS float*)(lds + SWA_TAB_OFF);
    for (int e = tid; e < 16 * 128; e += NWAVES * 64) { const int h = e >> 7, dist = e & 127; tab[e] = rel_bias[(int)T5_BUCKET[dist] * 24 + H_A + h]; }
    __syncthreads();
    const int q = lane & 31, hh = lane >> 5;
    const unsigned ldsb = (unsigned)(size_t)lds;
    for (int item = vcu; item < BATCH * 128 * KVH; item += G) {
        const int kvh = item & 1, qt = (item >> 1) & 127, b = item >> 8;
        const int t0 = 32 * qt, s0 = t0 - 128;
        const size_t rowbase = (size_t)b * SEQ;
        for (int c = tid; c < 1280; c += NWAVES * 64) { const int row = c >> 3, ch = c & 7; const int s = s0 + row;
            if (s >= 0) { const GAS bf16* zr = Z + (rowbase + s) * ZLD + kvh * 64 + ch * 8;
                const v4u kv = *(const GAS v4u*)(zr + ZC_KB); const v4u vv = *(const GAS v4u*)(zr + ZC_VB);
                *(LAS v4u*)(lds + SWA_K_OFF + row * SWA_KP + ch * 16) = kv; *(LAS v4u*)(lds + SWA_V_OFF + row * SWA_VP + ch * 16) = vv; } }
        const int hq = kvh * 8 + wave; const int t = t0 + q;
        bf16x8 qf[4];
#pragma unroll
        for (int st = 0; st < 4; ++st) qf[st] = *(const GAS bf16x8*)(Z + (rowbase + t) * ZLD + ZC_QB + hq * 64 + 16 * st + 8 * hh);
        __syncthreads();
        const int kt0 = qt >= 4 ? 0 : 4 - qt;
        f32x16 sacc[5];
#pragma unroll
        for (int kt = 0; kt < 5; ++kt) {
#pragma unroll
            for (int r = 0; r < 16; ++r) sacc[kt][r] = 0.f;
            if (kt >= kt0) {
#pragma unroll
                for (int st = 0; st < 4; ++st) { const bf16x8 kf = *(const LAS bf16x8*)(lds + SWA_K_OFF + (kt * 32 + q) * SWA_KP + (2 * st + hh) * 16);
                    sacc[kt] = __builtin_amdgcn_mfma_f32_32x32x16_bf16(kf, qf[st], sacc[kt], 0, 0, 0); } } }
        const float sink = sinks[hq]; float mx = sink;
        const LAS float* tabh = tab + hq * 128;
#pragma unroll
        for (int kt = 0; kt < 5; ++kt) if (kt >= kt0) {
#pragma unroll
            for (int r = 0; r < 16; ++r) { const int ko = (r & 3) + 8 * (r >> 2) + 4 * hh; const int dist = q + 128 - 32 * kt - ko;
                const float lg = (dist >= 0 && dist < WINDOW) ? sacc[kt][r] + tabh[dist & 127] : -1e30f; sacc[kt][r] = lg; mx = fmaxf(mx, lg); } }
        mx = fmaxf(mx, SHX(mx, 32));
        float l = 0.f;
#pragma unroll
        for (int kt = 0; kt < 5; ++kt) if (kt >= kt0) {
#pragma unroll
            for (int r = 0; r < 16; ++r) { const float p = __expf(sacc[kt][r] - mx); sacc[kt][r] = p; l += p; } }
        l += SHX(l, 32); l += __expf(sink - mx);
        f32x16 oacc[2];
#pragma unroll
        for (int dt = 0; dt < 2; ++dt)
#pragma unroll
            for (int r = 0; r < 16; ++r) oacc[dt][r] = 0.f;
        const unsigned vlane = ldsb + SWA_V_OFF + (unsigned)((4 * hh + ((lane & 15) >> 2)) * SWA_VP + (16 * ((lane >> 4) & 1) + 4 * (lane & 3)) * 2);
#pragma unroll
        for (int kt = 0; kt < 5; ++kt) if (kt >= kt0) {
#pragma unroll
            for (int s2 = 0; s2 < 2; ++s2) {
                bf16x8 pf; { const unsigned w0 = pg8::cvt_pk_bf16(sacc[kt][8 * s2 + 0], sacc[kt][8 * s2 + 1]), w1 = pg8::cvt_pk_bf16(sacc[kt][8 * s2 + 2], sacc[kt][8 * s2 + 3]),
                                     w2 = pg8::cvt_pk_bf16(sacc[kt][8 * s2 + 4], sacc[kt][8 * s2 + 5]), w3 = pg8::cvt_pk_bf16(sacc[kt][8 * s2 + 6], sacc[kt][8 * s2 + 7]);
                    const v4u w = {w0, w1, w2, w3}; pf = __builtin_bit_cast(bf16x8, w); }
                const unsigned a = vlane + (unsigned)((kt * 32 + 16 * s2) * SWA_VP);
                s16x4 r0, r1, r2, r3; tr_read4(a, a + 8 * SWA_VP, a + 64, a + 8 * SWA_VP + 64, r0, r1, r2, r3);
                oacc[0] = __builtin_amdgcn_mfma_f32_32x32x16_bf16(cat4(r0, r1), pf, oacc[0], 0, 0, 0);
                oacc[1] = __builtin_amdgcn_mfma_f32_32x32x16_bf16(cat4(r2, r3), pf, oacc[1], 0, 0, 0); } }
        const float inv = (OUT_F8 ? O8_SCALE : 1.0f) / l;
        if constexpr (OUT_F8) { GAS unsigned char* orow = (GAS unsigned char*)O + (rowbase + t) * OLD + 2048 + hq * 64 + 4 * hh;
#pragma unroll
            for (int dt = 0; dt < 2; ++dt)
#pragma unroll
                for (int g4 = 0; g4 < 4; ++g4) { int p = 0; p = __builtin_amdgcn_cvt_pk_fp8_f32(oacc[dt][4 * g4] * inv, oacc[dt][4 * g4 + 1] * inv, p, false); p = __builtin_amdgcn_cvt_pk_fp8_f32(oacc[dt][4 * g4 + 2] * inv, oacc[dt][4 * g4 + 3] * inv, p, true);
                    *(GAS unsigned*)(orow + 32 * dt + 8 * g4) = (unsigned)p; } }
        else { GAS bf16* orow = O + (rowbase + t) * OLD + 2048 + hq * 64 + 4 * hh;
#pragma unroll
        for (int dt = 0; dt < 2; ++dt)
#pragma unroll
            for (int g4 = 0; g4 < 4; ++g4) { const unsigned long long w = (unsigned long long)pk2(oacc[dt][4 * g4] * inv, oacc[dt][4 * g4 + 1] * inv) | ((unsigned long long)pk2(oacc[dt][4 * g4 + 2] * inv, oacc[dt][4 * g4 + 3] * inv) << 32);
                *(GAS unsigned long long*)(orow + 32 * dt + 8 * g4) = w; } }
        __syncthreads();
    }
}
constexpr int TK_BINS = 512, TK_CAP = 256;
#define LDS_ADD(p) __hip_atomic_fetch_add((p), 1u, __ATOMIC_RELAXED, __HIP_MEMORY_SCOPE_WORKGROUP)
#define LDS_ADDV(p, v) __hip_atomic_fetch_add((p), (v), __ATOMIC_RELAXED, __HIP_MEMORY_SCOPE_WORKGROUP)
#define HIST_WORD(tok, bin) (((tok) * TK_BINS + (bin)) >> 1)
#define HIST_INC(bin) (1u << (((bin) & 1) * 16))
constexpr int TK_HIST_OFF = 0, TK_CSC_OFF = 32768, TK_CIX_OFF = TK_CSC_OFF + 32 * TK_CAP * 4, TK_SEL_OFF = TK_CIX_OFF + 32 * TK_CAP * 2, TK_CNT_OFF = TK_SEL_OFF + 32 * 256 * 2, TK_DUM_OFF = TK_CNT_OFF + 32 * 2 * 4, TK_KB_OFF = TK_DUM_OFF + 8 * 64 * 4, TK_KB_BYTES = 64 * 144, TK_FLAG_OFF = TK_KB_OFF + 2 * TK_KB_BYTES;
static_assert(TK_FLAG_OFF + 16 <= RING_BYTES, "top-k LDS map");
typedef _Float16 tk_h2 __attribute__((ext_vector_type(2)));
__device__ __forceinline__ void tk_score2(const f32x16& acc, const tk_h2 (&wh)[8], float& s0, float& s1) {
    tk_h2 s = {(_Float16)0, (_Float16)0}; const tk_h2 zero = {(_Float16)0, (_Float16)0};
#pragma unroll
    for (int h = 0; h < 8; ++h) { tk_h2 d = __builtin_bit_cast(tk_h2, __builtin_amdgcn_cvt_pkrtz(acc[h], acc[8 + h])); d = __builtin_elementwise_max(d, zero); s = __builtin_elementwise_fma(wh[h], d, s); }
    s0 = (float)s.x; s1 = (float)s.y;
}
__device__ __forceinline__ float tk_x(float s, float sc) { return fmaf(s, sc, 256.0f); }
__device__ __forceinline__ int tk_key(float s, float sc) {
    const float x = tk_x(s, sc); int b0 = (int)x; b0 = b0 < 0 ? 0 : (b0 > TK_BINS - 1 ? TK_BINS - 1 : b0);
    int sub = (int)((x - (float)b0) * 512.0f); sub = sub < 0 ? 0 : (sub > 511 ? 511 : sub);
    return b0 * 512 + sub;
}
__device__ __forceinline__ void tk_find(const LAS unsigned* h, unsigned need, int lane, int& bin_out, unsigned& above_out) {
    unsigned v[8]; unsigned s = 0;
#pragma unroll
    for (int i = 0; i < 4; ++i) { const unsigned w = h[4 * lane + i]; v[2 * i] = w & 0xffffu; v[2 * i + 1] = w >> 16; s += v[2 * i] + v[2 * i + 1]; }
    unsigned S = s;
#pragma unroll
    for (int o = 1; o < 64; o <<= 1) { const unsigned t = (unsigned)__builtin_amdgcn_ds_bpermute((lane + o) << 2, (int)S); if (lane + o < 64) S += t; }
    const unsigned long long mask = __ballot(S >= need);
    const int Lm = mask ? 63 - __builtin_clzll(mask) : 0;
    unsigned cum = S - s; int bsel = 8 * lane; unsigned ab = cum; bool found = false;
#pragma unroll
    for (int i = 7; i >= 0; --i) { if (!found) { if (cum + v[i] >= need) { bsel = 8 * lane + i; ab = cum; found = true; } else cum += v[i]; } }
    bin_out = __builtin_amdgcn_readlane(bsel, Lm); above_out = (unsigned)__builtin_amdgcn_readlane((int)ab, Lm);
}
__device__ __forceinline__ void topk_phase(LAS unsigned char* lds, const GAS bf16* Z, const GAS bf16* KIN, const GAS float* WIF, GAS unsigned short* IDX, int vcu, int G, int lane, int wave) {
    LAS unsigned* hist = (LAS unsigned*)(lds + TK_HIST_OFF) + wave * 4 * (TK_BINS / 2);
    LAS float* csc = (LAS float*)(lds + TK_CSC_OFF) + wave * 4 * TK_CAP;
    LAS unsigned short* cix = (LAS unsigned short*)(lds + TK_CIX_OFF) + wave * 4 * TK_CAP;
    LAS unsigned short* sel = (LAS unsigned short*)(lds + TK_SEL_OFF) + wave * 4 * 256;
    LAS unsigned* cnt = (LAS unsigned*)(lds + TK_CNT_OFF) + wave * 8;
    LAS unsigned* dum = (LAS unsigned*)(lds + TK_DUM_OFF) + wave * 64 + lane;
    const int n = lane & 31, c = lane >> 5;
    const int am = (lane >> 4) & 1, bbm = (lane >> 3) & 1, ccm = (lane >> 2) & 1, dm = lane & 3;
    for (int p2 = vcu; p2 < BATCH * 64; p2 += G) {
#pragma unroll 1
        for (int half = 0; half < 2; ++half) {
            const int b = p2 >> 6, jj = p2 & 63, j = half ? 127 - jj : jj;
            const int t0 = 32 * j + 4 * wave; const size_t rb = (size_t)b * SEQ;
            bf16x8 qa[4];
#pragma unroll
            for (int st = 0; st < 4; ++st) qa[st] = *(const GAS bf16x8*)(Z + (rb + t0 + 2 * ccm + am) * ZLD + ZC_QI + (4 * bbm + dm) * 64 + 16 * st + 8 * c);
            float w0[8], w1[8];
            { const GAS f32x4* wp = (const GAS f32x4*)(WIF + (rb + t0 + 2 * c) * IH); const f32x4 x0 = wp[0], x1 = wp[1], x2 = wp[2], x3 = wp[3];
              w0[0] = x0.x; w0[1] = x0.y; w0[2] = x0.z; w0[3] = x0.w; w0[4] = x1.x; w0[5] = x1.y; w0[6] = x1.z; w0[7] = x1.w;
              w1[0] = x2.x; w1[1] = x2.y; w1[2] = x2.z; w1[3] = x2.w; w1[4] = x3.x; w1[5] = x3.y; w1[6] = x3.z; w1[7] = x3.w; }
            tk_h2 wh[8];
#pragma unroll
            for (int h = 0; h < 8; ++h) { wh[h].x = (_Float16)w0[h]; wh[h].y = (_Float16)w1[h]; }
            float scA, scB;
            { float a = 0.f, bq = 0.f;
#pragma unroll
              for (int h = 0; h < 8; ++h) { a = fmaf(w0[h], w0[h], a); bq = fmaf(w1[h], w1[h], bq); }
              scA = 32.0f / fmaxf(sqrtf(32.0f * a), 1e-20f); scB = 32.0f / fmaxf(sqrtf(32.0f * bq), 1e-20f); }
            const int tA = t0 + 2 * c, tB = tA + 1;
            for (int i = lane; i < 4 * (TK_BINS / 2); i += 64) hist[i] = 0u;
            for (int i = lane; i < 4 * 128; i += 64) ((LAS unsigned*)sel)[i] = 0u;
            if (lane < 8) cnt[lane] = 0u;
            asm volatile("s_waitcnt lgkmcnt(0)" ::: "memory");
            int lo[4], hi[4]; unsigned ab0[4]; bool ov[4];
#pragma unroll
            for (int tk = 0; tk < 4; ++tk) { lo[tk] = 0x7fffffff; hi[tk] = -1; ab0[tk] = 0u; ov[tk] = false; }
            const bool need_sel = (t0 + 3) >= TOPK;
            const GAS bf16* kbase = KIN + (rb + n) * IDIM + 8 * c;
            const int tidk = wave * 64 + lane; const int ng = (j + 2) >> 1;
            const GAS bf16* kg0 = KIN + (rb + (tidk >> 3)) * IDIM + (tidk & 7) * 8; const int koff = (tidk >> 3) * 144 + (tidk & 7) * 16;
            LAS unsigned char* kbuf = lds + TK_KB_OFF; volatile LAS unsigned* sflag = (volatile LAS unsigned*)(lds + TK_FLAG_OFF);
            if (tidk == 0) *sflag = 0u;
#define TK_PRIME() { const v4u kr0 = *(const GAS v4u*)kg0; *(LAS v4u*)(kbuf + koff) = kr0; } __syncthreads();
#define TK_GROUP_BEGIN() \
                v4u kr = {0u, 0u, 0u, 0u}; const bool more = g + 1 < ng; \
                if (more) kr = *(const GAS v4u*)(kg0 + (size_t)(g + 1) * 64 * IDIM); \
                const LAS unsigned char* kb_ = kbuf + (g & 1) * TK_KB_BYTES; \
                float s0v[2], s1v[2];     \
                { f32x16 accv[2]; \
                  _Pragma("unroll") for (int u4 = 0; u4 < 2; ++u4) { _Pragma("unroll") for (int r = 0; r < 16; ++r) accv[u4][r] = 0.f; \
                    _Pragma("unroll") for (int st = 0; st < 4; ++st) { const bf16x8 kf = *(const LAS bf16x8*)(kb_ + (32 * u4 + n) * 144 + (2 * st + c) * 16); accv[u4] = __builtin_amdgcn_mfma_f32_32x32x16_bf16(qa[st], kf, accv[u4], 0, 0, 0); } } \
                  _Pragma("unroll") for (int u4 = 0; u4 < 2; ++u4) tk_score2(accv[u4], wh, s0v[u4], s1v[u4]); } \
                _Pragma("unroll") for (int u4 = 0; u4 < 2; ++u4) { \
                    const float s0 = s0v[u4], s1 = s1v[u4]; const int s = 32 * (2 * g + u4) + n;
#define TK_GROUP_END() } \
                if (more) *(LAS v4u*)(kbuf + ((g + 1) & 1) * TK_KB_BYTES + koff) = kr; \
                __syncthreads();
            bool slow = false;
            if (need_sel) {
                {   TK_PRIME();
#pragma unroll 1
                    for (int g = 0; g < ng; ++g) { TK_GROUP_BEGIN()
                        int b0 = (int)tk_x(s0, scA), b1 = (int)tk_x(s1, scB); b0 = b0 < 0 ? 0 : (b0 > TK_BINS - 1 ? TK_BINS - 1 : b0); b1 = b1 < 0 ? 0 : (b1 > TK_BINS - 1 ? TK_BINS - 1 : b1);
                        LAS unsigned* p0 = (s <= tA) ? &hist[HIST_WORD(2 * c, b0)] : dum; LAS unsigned* p1 = (s <= tB) ? &hist[HIST_WORD(2 * c + 1, b1)] : dum;
                        LDS_ADDV(p0, HIST_INC(b0)); LDS_ADDV(p1, HIST_INC(b1));
                        TK_GROUP_END() }
                }
                asm volatile("s_waitcnt lgkmcnt(0)" ::: "memory");
#pragma unroll
                for (int tk = 0; tk < 4; ++tk) { int bin; unsigned above; tk_find(hist + tk * (TK_BINS / 2), (unsigned)TOPK, lane, bin, above);
                    const unsigned ceq = (hist[HIST_WORD(tk, bin)] >> ((bin & 1) * 16)) & 0xffffu; ov[tk] = ceq > (unsigned)TK_CAP; slow |= ov[tk]; ab0[tk] = above; lo[tk] = bin * 512; hi[tk] = bin * 512 + 511; }
                if (slow && lane == 0) *sflag = 1u;
                __syncthreads();
                slow = *sflag != 0u;
            }
            if (!slow) {
                float thi[4], tlo[4];
#pragma unroll
                for (int tk = 0; tk < 4; ++tk) { const int bin = lo[tk] >> 9;
                    thi[tk] = !need_sel ? -__builtin_inff() : (bin >= TK_BINS - 1 ? __builtin_inff() : (float)(bin + 1));
                    tlo[tk] = !need_sel ? __builtin_inff() : (bin == 0 ? -__builtin_inff() : (float)bin); }
                const float thiA = c ? thi[2] : thi[0], tloA = c ? tlo[2] : tlo[0], thiB = c ? thi[3] : thi[1], tloB = c ? tlo[3] : tlo[1];
                unsigned cntA = 0u, cntB = 0u;
                LAS unsigned short* selA = sel + (2 * c) * 256; LAS unsigned short* selB = sel + (2 * c + 1) * 256; LAS unsigned short* dum16 = (LAS unsigned short*)dum;
                TK_PRIME();
#pragma unroll 1
                for (int g = 0; g < ng; ++g) { TK_GROUP_BEGIN()
                    const float x0 = (s <= tA) ? tk_x(s0, scA) : __builtin_nanf(""), x1 = (s <= tB) ? tk_x(s1, scB) : __builtin_nanf("");
                    const bool a0 = x0 >= thiA, a1 = x1 >= thiB; const bool c0 = !a0 && x0 >= tloA, c1 = !a1 && x1 >= tloB;
                    const unsigned long long m0 = __ballot(a0), m1 = __ballot(a1);
                    const unsigned pre0 = c ? __builtin_amdgcn_mbcnt_hi((unsigned)(m0 >> 32), 0u) : __builtin_amdgcn_mbcnt_lo((unsigned)m0, 0u);
                    const unsigned pre1 = c ? __builtin_amdgcn_mbcnt_hi((unsigned)(m1 >> 32), 0u) : __builtin_amdgcn_mbcnt_lo((unsigned)m1, 0u);
                    const unsigned pos0 = cntA + pre0, pos1 = cntB + pre1;
                    LAS unsigned short* q0 = (a0 && pos0 < 256u) ? selA + pos0 : dum16; LAS unsigned short* q1 = (a1 && pos1 < 256u) ? selB + pos1 : dum16;
                    *q0 = (unsigned short)s; *q1 = (unsigned short)s;
                    cntA += c ? (unsigned)__builtin_popcount((unsigned)(m0 >> 32)) : (unsigned)__builtin_popcount((unsigned)m0);
                    cntB += c ? (unsigned)__builtin_popcount((unsigned)(m1 >> 32)) : (unsigned)__builtin_popcount((unsigned)m1);
                    if (__ballot(c0 || c1)) {
                        if (c0) { const unsigned pos = LDS_ADD(&cnt[(2 * c) * 2 + 1]); if (pos < (unsigned)TK_CAP) { csc[(2 * c) * TK_CAP + pos] = s0; cix[(2 * c) * TK_CAP + pos] = (unsigned short)s; } }
                        if (c1) { const unsigned pos = LDS_ADD(&cnt[(2 * c + 1) * 2 + 1]); if (pos < (unsigned)TK_CAP) { csc[(2 * c + 1) * TK_CAP + pos] = s1; cix[(2 * c + 1) * TK_CAP + pos] = (unsigned short)s; } } }
                    TK_GROUP_END() }
                if ((lane & 31) == 0) { cnt[(2 * c) * 2] = cntA; cnt[(2 * c + 1) * 2] = cntB; }
                asm volatile("s_waitcnt lgkmcnt(0)" ::: "memory");
            } else {
                for (int i = lane; i < 4 * (TK_BINS / 2); i += 64) hist[i] = 0u;
                asm volatile("s_waitcnt lgkmcnt(0)" ::: "memory");
                int mode = 1;
#pragma unroll 1
                for (;;) {
                const int klo0 = c ? lo[2] : lo[0], khi0 = c ? hi[2] : hi[0], klo1 = c ? lo[3] : lo[1], khi1 = c ? hi[3] : hi[1];
                const bool ov0 = c ? ov[2] : ov[0], ov1 = c ? ov[3] : ov[1];
                bf16x8 kb[4][4];
#pragma unroll
                for (int u4 = 0; u4 < 4; ++u4) { const int kq = u4 < j ? u4 : j;
#pragma unroll
                    for (int st = 0; st < 4; ++st) kb[u4][st] = *(const GAS bf16x8*)(kbase + (size_t)kq * 32 * IDIM + 16 * st); }
#pragma unroll 1
                for (int kt = 0; kt <= j; kt += 4) {
                    bf16x8 kn[4][4];
#pragma unroll
                    for (int u4 = 0; u4 < 4; ++u4) { const int kq = kt + 4 + u4 < j ? kt + 4 + u4 : j;
#pragma unroll
                        for (int st = 0; st < 4; ++st) kn[u4][st] = *(const GAS bf16x8*)(kbase + (size_t)kq * 32 * IDIM + 16 * st); }
#pragma unroll
                    for (int u4 = 0; u4 < 4; ++u4) {
                        f32x16 acc;
#pragma unroll
                        for (int r = 0; r < 16; ++r) acc[r] = 0.f;
#pragma unroll
                        for (int st = 0; st < 4; ++st) acc = __builtin_amdgcn_mfma_f32_32x32x16_bf16(qa[st], kb[u4][st], acc, 0, 0, 0);
                        float s0, s1; tk_score2(acc, wh, s0, s1);
                        const int s = 32 * (kt + u4) + n; const int k0 = tk_key(s0, scA), k1 = tk_key(s1, scB);
                        const bool v0 = s <= tA, v1 = s <= tB;
                        if (mode == 0) {
                            if (v0 && tA >= TOPK) LDS_ADDV(&hist[HIST_WORD(2 * c, k0 >> 9)], HIST_INC(k0 >> 9));
                            if (v1 && tB >= TOPK) LDS_ADDV(&hist[HIST_WORD(2 * c + 1, k1 >> 9)], HIST_INC(k1 >> 9));
                        } else if (mode == 1) {
                            if (v0 && ov0 && k0 >= klo0 && k0 <= khi0) LDS_ADDV(&hist[HIST_WORD(2 * c, k0 & 511)], HIST_INC(k0 & 511));
                            if (v1 && ov1 && k1 >= klo1 && k1 <= khi1) LDS_ADDV(&hist[HIST_WORD(2 * c + 1, k1 & 511)], HIST_INC(k1 & 511));
                        } else {
                            if (v0) { if (k0 > khi0) { const unsigned pos = LDS_ADD(&cnt[(2 * c) * 2]); if (pos < 256u) sel[(2 * c) * 256 + pos] = (unsigned short)s; }
                                      else if (k0 >= klo0) { const unsigned pos = LDS_ADD(&cnt[(2 * c) * 2 + 1]); if (pos < (unsigned)TK_CAP) { csc[(2 * c) * TK_CAP + pos] = s0; cix[(2 * c) * TK_CAP + pos] = (unsigned short)s; } } }
                            if (v1) { if (k1 > khi1) { const unsigned pos = LDS_ADD(&cnt[(2 * c + 1) * 2]); if (pos < 256u) sel[(2 * c + 1) * 256 + pos] = (unsigned short)s; }
                                      else if (k1 >= klo1) { const unsigned pos = LDS_ADD(&cnt[(2 * c + 1) * 2 + 1]); if (pos < (unsigned)TK_CAP) { csc[(2 * c + 1) * TK_CAP + pos] = s1; cix[(2 * c + 1) * TK_CAP + pos] = (unsigned short)s; } } }
                        }
                    }
#pragma unroll
                    for (int u4 = 0; u4 < 4; ++u4)
#pragma unroll
                        for (int st = 0; st < 4; ++st) kb[u4][st] = kn[u4][st];
                }
                    asm volatile("s_waitcnt lgkmcnt(0)" ::: "memory");
                    if (mode == 2) break;
#pragma unroll
                    for (int tk = 0; tk < 4; ++tk) if (ov[tk]) { int sub; unsigned above; tk_find(hist + tk * (TK_BINS / 2), (unsigned)TOPK - ab0[tk], lane, sub, above); lo[tk] += sub; hi[tk] = lo[tk]; }
                    mode = 2;
                }
            }
#undef TK_GROUP_BEGIN
#undef TK_GROUP_END
#undef TK_PRIME
#pragma unroll 1
            for (int tk = 0; tk < 4; ++tk) { const int t = t0 + tk;
                if (t >= TOPK) { const unsigned nsel = cnt[tk * 2]; unsigned nc = cnt[tk * 2 + 1]; nc = nc > (unsigned)TK_CAP ? (unsigned)TK_CAP : nc; const unsigned need = nsel < 256u ? 256u - nsel : 0u;
                    for (unsigned q = 0; q * 64 < nc; ++q) { const unsigned i = lane + 64 * q;
                        const float si = i < nc ? csc[tk * TK_CAP + i] : 0.f; const unsigned xi = i < nc ? cix[tk * TK_CAP + i] : 0u; unsigned rank = 0;
                        for (unsigned jx = 0; jx < nc; ++jx) { const float sj = csc[tk * TK_CAP + jx]; const unsigned xj = cix[tk * TK_CAP + jx]; rank += (sj > si || (sj == si && xj < xi)) ? 1u : 0u; }
                        if (i < nc && rank < need) sel[tk * 256 + nsel + rank] = (unsigned short)xi; } } }
            asm volatile("s_waitcnt lgkmcnt(0)" ::: "memory");
            { const LAS v4u* sv = (const LAS v4u*)sel; GAS v4u* ov = (GAS v4u*)(IDX + (rb + t0) * TOPK);
              ov[lane] = sv[lane]; ov[lane + 64] = sv[lane + 64]; }
            asm volatile("s_waitcnt vmcnt(0) lgkmcnt(0)" ::: "memory");
        }
    }
}
constexpr int DSA_TAB_OFF = RING_BYTES + 1024;
static_assert(DSA_TAB_OFF + 8 * 129 * 4 <= LDS_BYTES, "DSA LDS map");
__device__ __forceinline__ void dsa_phase(LAS unsigned char* lds_all, const GAS bf16* Z, const GAS bf16* CKVN, const GAS unsigned short* IDX, GAS bf16* O, const GAS float* rel_bias, int gw, int NGW, int tid, int lane, int wave) {
    LAS float* tab = (LAS float*)(lds_all + DSA_TAB_OFF);
    for (int e = tid; e < 8 * 129; e += NWAVES * 64) { const int hh = e / 129, dist = e - hh * 129; tab[e] = rel_bias[(dist < 128 ? (int)T5_BUCKET[dist] : 31) * 24 + hh]; }
    __syncthreads();
    LAS unsigned char* img = lds_all + RING_OFF + wave * 16384;
    const unsigned imgb = (unsigned)(size_t)img;
    const int h = lane & 15, g = lane >> 4;
    const LAS float* tabh = tab + (h & 7) * 129;
    const int TPW = (M + NGW - 1) / NGW;
    const int tok_end = (gw + 1) * TPW < M ? (gw + 1) * TPW : M;
    const int xq = 2 * (lane & 7);
    const int qk_off = (lane & 15) * 512;
    const int q4 = (lane & 15) >> 2, p4 = lane & 3; const int xr = 2 * (4 * (g & 1) + q4);
    const unsigned pv_base = imgb + (unsigned)((4 * g + q4) * 512 + 8 * (p4 & 1));
#pragma unroll 1
    for (int tok = gw * TPW; tok < tok_end; ++tok) {
        const int t = tok & (SEQ - 1); const size_t rb = (size_t)(tok - t);
        const int nsel = t + 1 < TOPK ? t + 1 : TOPK;
        bf16x8 qf[8];
#pragma unroll
        for (int st = 0; st < 8; ++st) { qf[st] = *(const GAS bf16x8*)(Z + (size_t)tok * ZLD + ZC_QLAT + (h & 7) * 256 + 32 * st + 8 * g); if (h >= 8) qf[st] = (bf16x8){0, 0, 0, 0, 0, 0, 0, 0}; }
        f32x4 oacc[16];
#pragma unroll
        for (int rt = 0; rt < 16; ++rt) oacc[rt] = (f32x4){0.f, 0.f, 0.f, 0.f};
        float mrun = -1e30f, lsum = 0.f;
        const GAS unsigned short* ip = IDX + (size_t)tok * TOPK;
        int ixa[8];
#pragma unroll
        for (int ch = 0; ch < 8; ++ch) ixa[ch] = (int)ip[32 * ch + (lane & 31)];
        unsigned long long i0n = *(const GAS unsigned long long*)(ip + 4 * g), i1n = *(const GAS unsigned long long*)(ip + 16 + 4 * g);
#pragma unroll
        for (int ch = 0; ch < 8; ++ch) {
            if (32 * ch >= nsel) break;
            const int ixv = ixa[ch];
            const unsigned long long i0 = i0n, i1 = i1n;
            if (ch < 7) { i0n = *(const GAS unsigned long long*)(ip + 32 * (ch + 1) + 4 * g); i1n = *(const GAS unsigned long long*)(ip + 32 * (ch + 1) + 16 + 4 * g); }
            asm volatile("s_waitcnt lgkmcnt(0)" ::: "memory");
#pragma unroll
            for (int i = 0; i < 16; ++i) { const int r0 = __builtin_amdgcn_readlane(ixv, 2 * i), r1 = __builtin_amdgcn_readlane(ixv, 2 * i + 1);
                const int row = 2 * i + (lane >> 5); const int ridx = lane < 32 ? r0 : r1; const int chunk = (lane & 31) ^ (2 * (row & 7));
                const GAS unsigned char* src = (const GAS unsigned char*)(CKVN + (rb + ridx) * RANK) + chunk * 16;
                __builtin_amdgcn_global_load_lds((const GAS unsigned*)src, (LAS unsigned*)(img + i * 1024), 16, 0, 0); }
            asm volatile("s_waitcnt vmcnt(0)" ::: "memory");
            f32x4 sa[2];
#pragma unroll
            for (int tl = 0; tl < 2; ++tl) { sa[tl] = (f32x4){0.f, 0.f, 0.f, 0.f};
#pragma unroll
                for (int st = 0; st < 8; ++st) { const bf16x8 a = *(const LAS bf16x8*)(img + qk_off + tl * 16 * 512 + (((4 * st + g) ^ xq) * 16));
                    sa[tl] = __builtin_amdgcn_mfma_f32_16x16x32_bf16(a, qf[st], sa[tl], 0, 0, 0); } }
            float lg[8]; float cmax = -1e30f;
#pragma unroll
            for (int e = 0; e < 8; ++e) { const int tl = e >> 2, jx = e & 3; const int kk = 32 * ch + 16 * tl + 4 * g + jx;
                const int sidx = (int)(((tl ? i1 : i0) >> (16 * jx)) & 0xffffull); int dd = t - sidx; dd = dd < 0 ? 0 : (dd > 128 ? 128 : dd);
                const float v = kk < nsel ? sa[tl][jx] + tabh[dd] : -1e30f; lg[e] = v; cmax = fmaxf(cmax, v); }
            cmax = fmaxf(cmax, SHX(cmax, 16)); cmax = fmaxf(cmax, SHX(cmax, 32));
            const float mnew = fmaxf(mrun, cmax);
            if (__any(mnew > mrun)) { const float alpha = __expf(mrun - mnew); lsum *= alpha;
#pragma unroll
                for (int rt = 0; rt < 16; ++rt) oacc[rt] = oacc[rt] * alpha; }
            mrun = mnew;
            float pe[8];
#pragma unroll
            for (int e = 0; e < 8; ++e) { pe[e] = __expf(lg[e] - mnew); lsum += pe[e]; }
            bf16x8 pf; { const v4u wv = {pg8::cvt_pk_bf16(pe[0], pe[1]), pg8::cvt_pk_bf16(pe[2], pe[3]), pg8::cvt_pk_bf16(pe[4], pe[5]), pg8::cvt_pk_bf16(pe[6], pe[7])}; pf = __builtin_bit_cast(bf16x8, wv); }
#pragma unroll
            for (int rt = 0; rt < 16; rt += 2) {
                const unsigned a0 = pv_base + (unsigned)((((2 * rt) ^ xr) | (p4 >> 1)) * 16), a1 = pv_base + (unsigned)((((2 * rt + 2) ^ xr) | (p4 >> 1)) * 16);
                s16x4 r0, r1, r2, r3; tr_read4(a0, a0 + 16 * 512, a1, a1 + 16 * 512, r0, r1, r2, r3);
                oacc[rt] = __builtin_amdgcn_mfma_f32_16x16x32_bf16(cat4(r0, r1), pf, oacc[rt], 0, 0, 0);
                oacc[rt + 1] = __builtin_amdgcn_mfma_f32_16x16x32_bf16(cat4(r2, r3), pf, oacc[rt + 1], 0, 0, 0); }
        }
        lsum += SHX(lsum, 16); lsum += SHX(lsum, 32);
        const float inv = (OUT_F8 ? O8_SCALE : 1.0f) / lsum;
        if (h < 8) {
            if constexpr (OUT_F8) { GAS unsigned char* orow = (GAS unsigned char*)O + (size_t)tok * OLD + h * 256 + 4 * g;
#pragma unroll
                for (int rt = 0; rt < 16; ++rt) { int p = 0; p = __builtin_amdgcn_cvt_pk_fp8_f32(oacc[rt][0] * inv, oacc[rt][1] * inv, p, false); p = __builtin_amdgcn_cvt_pk_fp8_f32(oacc[rt][2] * inv, oacc[rt][3] * inv, p, true); *(GAS unsigned*)(orow + 16 * rt) = (unsigned)p; } }
            else { GAS bf16* orow = O + (size_t)tok * OLD + h * 256 + 4 * g;
#pragma unroll
            for (int rt = 0; rt < 16; ++rt) *(GAS unsigned long long*)(orow + 16 * rt) = (unsigned long long)pk2(oacc[rt][0] * inv, oacc[rt][1] * inv) | ((unsigned long long)pk2(oacc[rt][2] * inv, oacc[rt][3] * inv) << 32); } }
    }
}
struct Args { const float* in[20]; float* out; unsigned char* ws; };
__device__ __forceinline__ unsigned long long karg_u64(int idx) { unsigned long long r; const unsigned off = (unsigned)idx * 8u;
    asm volatile("s_load_dwordx2 %0, %1, %2\n\ts_waitcnt lgkmcnt(0)" : "=s"(r) : "s"(__builtin_amdgcn_kernarg_segment_ptr()), "s"(off) : "memory"); return r; }
__device__ __forceinline__ const GAS float* karg_in(int i) { return (const GAS float*)karg_u64(i); }
__device__ __forceinline__ GAS float* karg_out() { return (GAS float*)karg_u64(20); }
__device__ __forceinline__ GAS unsigned char* karg_ws() { return (GAS unsigned char*)karg_u64(21); }
#ifndef REP_P0
#define REP_P0 1
#endif
#ifndef REP_NORM
#define REP_NORM 1
#endif
#ifndef REP_GU
#define REP_GU 1
#endif
#ifndef REP_IN
#define REP_IN 1
#endif
#ifndef REP_POST
#define REP_POST 1
#endif
#ifndef REP_TOPK
#define REP_TOPK 1
#endif
#ifndef REP_DSA
#define REP_DSA 1
#endif
#define REPEAT(n) _Pragma("unroll 1") for (int rep_ = 0; rep_ < (n); ++rep_)
#define PHASE_IDS() int wave = wave0; asm volatile("" : "+s"(wave)); int lane; asm volatile("v_mbcnt_lo_u32_b32 %0, -1, 0\n\tv_mbcnt_hi_u32_b32 %0, -1, %0" : "=v"(lane)); const int tid = wave * 64 + lane; int bx = blockIdx.x; asm volatile("" : "+s"(bx)); int G = gridDim.x; asm volatile("" : "+s"(G)); \
    const int vcu = (G % 8 == 0) ? (bx % 8) * (G / 8) + bx / 8 : bx; const int gw = vcu * NWAVES + wave, NGW = G * NWAVES; \
    GAS unsigned char* ws = karg_ws(); (void)lane; (void)gw; (void)NGW; (void)vcu; (void)ws
__global__ void __launch_bounds__(NWAVES * 64, 2) mk_fwd(Args args) {
    extern __shared__ __attribute__((aligned(16))) unsigned char lds_raw[];
    LAS unsigned char* lds = (LAS unsigned char*)lds_raw;
    volatile LAS unsigned* MISC = (volatile LAS unsigned*)(lds + MISC_OFF);
    const int wave0 = __builtin_amdgcn_readfirstlane(threadIdx.x >> 6);
    for (int u = threadIdx.x; u < (LDS_BYTES - LDSCTL_OFF) / 4; u += NWAVES * 64) ((LAS unsigned*)(lds + LDSCTL_OFF))[u] = 0u;
    __syncthreads();
    (void)xcd_barrier_post((unsigned*)((gu32*)(karg_ws() + WS_CTL) + CW_BAR), MISC + 8, threadIdx.x == 0);
#define GRID_BAR() do { XcdBarrier b_; b_.bar = (unsigned*)((gu32*)(karg_ws() + WS_CTL) + CW_BAR); b_.x = xb_xcc_id(); b_.st = MISC + 8; int w_ = wave0; asm volatile("" : "+s"(w_)); int l_; asm volatile("v_mbcnt_lo_u32_b32 %0, -1, 0\n\tv_mbcnt_hi_u32_b32 %0, -1, %0" : "=v"(l_)); xcd_barrier(b_, (w_ | l_) == 0); } while (0)

    REPEAT(REP_P0) {   PHASE_IDS();
        LAS float* scr = (LAS float*)(lds + RING_OFF + wave * 16384);
        rows_bf16_ss(karg_in(0), (GAS bf16*)(ws + WS_XN), f8_on(0, 0) ? (GAS unsigned char*)(ws + WS_HB8) : (GAS unsigned char*)nullptr, (GAS float*)(ws + WS_SS), gw, NGW, lane);
        constexpr int I_GU = (D / 64) * (FF / 32), I_DN = (FF / 64) * (D / 32);
        constexpr int I_FFN = 2 * I_GU + I_DN, I_IN = 72 * (D / 64), I_OB = (1024 / 64) * (D / 32);
        constexpr int PER_LAYER = 2 * I_FFN + I_IN + I_OB;
        for (int it = gw; it < DEPTH * PER_LAYER; it += NGW) {
            const int l = it / PER_LAYER; int r = it - l * PER_LAYER;
            GAS unsigned char* wl = ws + WS_W0 + (size_t)l * W_LAYER;
            if (r < 2 * I_FFN) {
                const int f = r / I_FFN; r -= f * I_FFN;
                GAS bf16* dgu = (GAS bf16*)(wl + (f ? WO_GU2 : WO_GU1)); GAS bf16* dd = (GAS bf16*)(wl + (f ? WO_D2 : WO_D1));
                if (r < 2 * I_GU) { const int up = r >= I_GU; if (up) r -= I_GU; const int kb = r / (FF / 32), nb = r % (FF / 32), n0 = 32 * nb;
                    const GAS float* wsrc = karg_in(up ? (f ? 17 : 4) : (f ? 16 : 3)) + (size_t)l * D * FF;
                    const int drow = (n0 >> 7) * 256 + (up ? 128 : 0) + (n0 & 127);
                    if (f8_on(l, f)) { if constexpr (GU_I8) conv_item<2>(wsrc, FF, 64 * kb, n0, 32, dgu, D, drow, 0, W8I_SCALE, karg_in(f ? 15 : 2) + (size_t)l * D, scr, lane); else conv_item<1>(wsrc, FF, 64 * kb, n0, 32, dgu, D, drow, 0, W8_SCALE, karg_in(f ? 15 : 2) + (size_t)l * D, scr, lane); }
                    else conv_item(wsrc, FF, 64 * kb, n0, 32, dgu, D, drow, 0, 1.0f, karg_in(f ? 15 : 2) + (size_t)l * D, scr, lane); }
                else { r -= 2 * I_GU; const int kb = r / (D / 32), nb = r % (D / 32);
                    if (d8_on(l, f)) conv_item<1>(karg_in(f ? 18 : 5) + (size_t)l * FF * D, D, 64 * kb, 32 * nb, 32, dd, FF, 32 * nb, 0, W8_SCALE, nullptr, scr, lane);
                    else conv_item(karg_in(f ? 18 : 5) + (size_t)l * FF * D, D, 64 * kb, 32 * nb, 32, dd, FF, 32 * nb, 0, 1.0f, nullptr, scr, lane); }
            } else if (r < 2 * I_FFN + I_IN) {
                r -= 2 * I_FFN; const int j = r >> 5, kb = r & 31; int src, nvalid = 32; float sc = 1.0f;
                if (j < 8) src = 1024 + 32 * j;
                else if (j < 40) src = 1864 + 32 * (j - 8);
                else if (j < 44) src = 2888 + 32 * (j - 40);
                else if (j < 48) src = 3016 + 32 * (j - 44);
                else if (j < 64) src = 1280 + 32 * (j - 48);
                else if (j < 66) src = 1792 + 32 * (j - 64);
                else if (j == 66) { src = 1856; nvalid = 8; sc = 0.044194173824159216f; }
                else { src = 0; nvalid = 0; }
                const GAS float* win = karg_in(7) + (size_t)l * D * D_IN; const GAS float* gmix = karg_in(6) + (size_t)l * D;
                if (IN_I8 && j < 48) conv_item<2>(win, D_IN, 64 * kb, src, nvalid, (GAS bf16*)(wl + WO_IN), D, 2048 + 32 * j, 0, W8I_SCALE, gmix, scr, lane);
                else if (IN_I8) conv_item(win, D_IN, 64 * kb, src, nvalid, (GAS bf16*)(wl + WO_IN + (size_t)ZN8 * D), D, 32 * (j - 48), 0, sc, gmix, scr, lane);
                else conv_item(win, D_IN, 64 * kb, src, nvalid, (GAS bf16*)(wl + WO_IN), D, 2048 + 32 * j, 0, (j >= 8 && j < 40) ? 0.125f : sc, gmix, scr, lane);
            } else {
                r -= 2 * I_FFN + I_IN; const int kb = r >> 6, nb = r & 63;
                if constexpr (OUT_F8) conv_item<1>(karg_in(14) + (size_t)l * D * D + (size_t)1024 * D, D, 64 * kb, 32 * nb, 32, (GAS bf16*)(wl + WO_OUT), OLD, 32 * nb, 2048, W8_SCALE, nullptr, scr, lane);
                else conv_item(karg_in(14) + (size_t)l * D * D + (size_t)1024 * D, D, 64 * kb, 32 * nb, 32, (GAS bf16*)(wl + WO_OUT), OLD, 32 * nb, 2048, 1.0f, nullptr, scr, lane);
            }
        }
        __syncthreads();
        LAS float* Ps = (LAS float*)(lds + RING_OFF); LAS float* Qs = Ps + 64 * 129;
        for (int u = vcu; u < DEPTH * 2048; u += G) {
            const int l = u >> 11, which = (u >> 10) & 1, v = u & 1023;
            GAS unsigned char* wl = ws + WS_W0 + (size_t)l * W_LAYER;
            if (which == 0) { const int h = v >> 7, rt = (v >> 5) & 3, kt = v & 31;
                if constexpr (IN_I8) absorb_unit<false, 2>(karg_in(11) + (size_t)l * RANK * 1024 + ((size_t)(64 * rt) * 8 + h) * 128, 1024, 1, karg_in(7) + (size_t)l * D * D_IN + (size_t)(64 * kt) * D_IN + h * 128, D_IN,
                                   (GAS bf16*)((GAS unsigned char*)(wl + WO_IN) + (size_t)(h * 256 + 64 * rt) * D + 64 * kt), D, WQ8I_SCALE, karg_in(6) + (size_t)l * D + 64 * kt, Ps, Qs, tid);
                else absorb_unit<false>(karg_in(11) + (size_t)l * RANK * 1024 + ((size_t)(64 * rt) * 8 + h) * 128, 1024, 1, karg_in(7) + (size_t)l * D * D_IN + (size_t)(64 * kt) * D_IN + h * 128, D_IN,
                                   (GAS bf16*)(wl + WO_IN) + (size_t)(h * 256 + 64 * rt) * D + 64 * kt, D, 0.08838834764831845f, karg_in(6) + (size_t)l * D + 64 * kt, Ps, Qs, tid); }
            else { const int h = v >> 7, nt = (v >> 2) & 31, rt = v & 3;
                if constexpr (OUT_F8) absorb_unit<true, 1>(karg_in(14) + (size_t)l * D * D + (size_t)(h * 128) * D + 64 * nt, 1, D, karg_in(12) + (size_t)l * RANK * 1024 + ((size_t)(64 * rt) * 8 + h) * 128, 1024,
                                  (GAS bf16*)((GAS unsigned char*)(wl + WO_OUT) + (size_t)(64 * nt) * OLD + h * 256 + 64 * rt), OLD, W8_SCALE, nullptr, Ps, Qs, tid);
                else absorb_unit<true>(karg_in(14) + (size_t)l * D * D + (size_t)(h * 128) * D + 64 * nt, 1, D, karg_in(12) + (size_t)l * RANK * 1024 + ((size_t)(64 * rt) * 8 + h) * 128, 1024,
                                  (GAS bf16*)(wl + WO_OUT) + (size_t)(64 * nt) * OLD + h * 256 + 64 * rt, OLD, 1.0f, nullptr, Ps, Qs, tid); }
        }
    }
    GRID_BAR();

#pragma unroll 1
    for (int s = 0; s < 2 * DEPTH; ++s) {
        const int l = s >> 1, f = s & 1;
        REPEAT(REP_GU) {   PHASE_IDS(); GAS unsigned char* wl = ws + WS_W0 + (size_t)l * W_LAYER;
            pg8::StaticOrder S; S.init(M, NGU, G, bx);
            const GAS float* ssp = (const GAS float*)(ws + WS_SS + (size_t)((3 * l + 2 * f) & 1) * SS_BYTES);
            if ((F8_MASK == 0xF) || (F8_MASK != 0 && f8_on(l, f))) {
                if constexpr (F8_MASK != 0) {
                    pg8::Gemm g{(const GAS bf16*)(ws + WS_HB8), (const GAS bf16*)(wl + (f ? WO_GU2 : WO_GU1)), M, NGU, D / 2};
                    if constexpr (GU_I8) { pg8::EpiSwiglu<true> E{(GAS bf16*)(ws + WS_ACT), FF, ssp, 1.0f / D, EPS, 1.0f / (H8I_SCALE * W8I_SCALE), d8_on(l, f) ? A8_SCALE : 0.f};
                        pg8::gemm_phase<pg8::EpiSwiglu<true>, pg8::StaticOrder, true, true, false, true>(lds + RING_OFF, g, S, E, tid); }
                    else { pg8::EpiSwiglu<false> E{(GAS bf16*)(ws + WS_ACT), FF, ssp, 1.0f / D, EPS, 1.0f / W8_SCALE, d8_on(l, f) ? A8_SCALE : 0.f};
                        pg8::gemm_phase<pg8::EpiSwiglu<false>, pg8::StaticOrder, true, true, true>(lds + RING_OFF, g, S, E, tid); } }
            } else {
                if constexpr (F8_MASK != 0xF) {
                    pg8::Gemm g{(const GAS bf16*)(ws + WS_XN), (const GAS bf16*)(wl + (f ? WO_GU2 : WO_GU1)), M, NGU, D};
                    pg8::EpiSwiglu<false> E{(GAS bf16*)(ws + WS_ACT), FF, ssp, 1.0f / D, EPS, 1.0f, d8_on(l, f) ? A8_SCALE : 0.f};
                    pg8::gemm_phase<pg8::EpiSwiglu<false>, pg8::StaticOrder, true, true, false>(lds + RING_OFF, g, S, E, tid); }
            } }
        GRID_BAR();
        {   PHASE_IDS(); GAS unsigned char* wl = ws + WS_W0 + (size_t)l * W_LAYER;
            pg8::StaticOrder S; S.init(M, D, G, bx);
            const unsigned sso = (unsigned)(WS_SS + (size_t)((3 * l + 2 * f + 1) & 1) * SS_BYTES), h8o = ((f == 0 && IN_I8) || (f == 1 && l + 1 < DEPTH && f8_on(l + 1, 0))) ? (unsigned)WS_HB8 : 0u;
            if ((D8_MASK == 0xF) || (D8_MASK != 0 && d8_on(l, f))) {
                if constexpr (D8_MASK != 0) {
                    pg8::Gemm g{(const GAS bf16*)(ws + WS_ACT), (const GAS bf16*)(wl + (f ? WO_D2 : WO_D1)), M, D, FF / 2};
                    pg8::EpiResid E{0.5f / (W8_SCALE * A8_SCALE), (unsigned)WS_XN, sso, h8o, GU_I8 ? H8I_SCALE : 0.f};
                    pg8::gemm_phase<pg8::EpiResid, pg8::StaticOrder, true, true, true>(lds + RING_OFF, g, S, E, tid); }
            } else {
                if constexpr (D8_MASK != 0xF) {
                    pg8::Gemm g{(const GAS bf16*)(ws + WS_ACT), (const GAS bf16*)(wl + (f ? WO_D2 : WO_D1)), M, D, FF};
                    pg8::EpiResid E{0.5f, (unsigned)WS_XN, sso, h8o, GU_I8 ? H8I_SCALE : 0.f};
                    pg8::gemm_phase<pg8::EpiResid, pg8::StaticOrder, true, true, false>(lds + RING_OFF, g, S, E, tid); }
            } }
        GRID_BAR();
        if (f == 0) {
            REPEAT(REP_IN) {   PHASE_IDS(); GAS unsigned char* wl = ws + WS_W0 + (size_t)l * W_LAYER;
                const GAS float* ssp = (const GAS float*)(ws + WS_SS + (size_t)((3 * l + 1) & 1) * SS_BYTES);
                if constexpr (IN_I8) {
                    {   pg8::Gemm g{(const GAS bf16*)(ws + WS_HB8), (const GAS bf16*)(wl + WO_IN), M, ZN8, D / 2}; pg8::StaticOrder S; S.init(M, ZN8, G, bx);
                        pg8::EpiBf16<true> E{(GAS bf16*)(ws + WS_Z), ZLD, ssp, 1.0f / D, EPS, 0.08838834764831845f / (H8I_SCALE * WQ8I_SCALE), 1.0f / (H8I_SCALE * W8I_SCALE), 0.125f / (H8I_SCALE * W8I_SCALE)};
                        pg8::gemm_phase<pg8::EpiBf16<true>, pg8::StaticOrder, true, true, false, true>(lds + RING_OFF, g, S, E, tid); }
                    {   pg8::Gemm g{(const GAS bf16*)(ws + WS_XN), (const GAS bf16*)(wl + WO_IN + (size_t)ZN8 * D), M, ZLD - ZN8, D}; pg8::StaticOrder S; S.init(M, ZLD - ZN8, G, bx);
                        pg8::EpiBf16<false> E{(GAS bf16*)(ws + WS_Z) + ZN8, ZLD, ssp, 1.0f / D, EPS, 1.0f, 1.0f, 1.0f};
                        pg8::gemm_phase<pg8::EpiBf16<false>, pg8::StaticOrder, true, true, false, false>(lds + RING_OFF, g, S, E, tid); }
                } else {
                    pg8::Gemm g{(const GAS bf16*)(ws + WS_XN), (const GAS bf16*)(wl + WO_IN), M, ZLD, D}; pg8::StaticOrder S; S.init(M, ZLD, G, bx);
                    pg8::EpiBf16<false> E{(GAS bf16*)(ws + WS_Z), ZLD, ssp, 1.0f / D, EPS, 1.0f, 1.0f, 1.0f};
                    pg8::gemm_phase<pg8::EpiBf16<false>, pg8::StaticOrder, true, true, false, false>(lds + RING_OFF, g, S, E, tid); } }
            GRID_BAR();
            REPEAT(REP_POST) {   PHASE_IDS();
                post_rows((const GAS bf16*)(ws + WS_Z), karg_in(8) + (size_t)l * RANK, karg_in(9) + (size_t)l * IDIM, karg_in(10) + (size_t)l * IDIM, (GAS bf16*)(ws + WS_CKVN), (GAS bf16*)(ws + WS_KIN), (GAS float*)(ws + WS_WIF), gw, NGW, lane);
                swa_phase(lds + RING_OFF, (const GAS bf16*)(ws + WS_Z), (GAS bf16*)(ws + WS_O), karg_in(1), karg_in(13) + (size_t)l * H_B, vcu, G, tid, lane, wave);
            }
            GRID_BAR();
            REPEAT(REP_TOPK) {   PHASE_IDS(); topk_phase(lds + RING_OFF, (const GAS bf16*)(ws + WS_Z), (const GAS bf16*)(ws + WS_KIN), (const GAS float*)(ws + WS_WIF), (GAS unsigned short*)(ws + WS_IDX), vcu, G, lane, wave); }
            GRID_BAR();
            REPEAT(REP_DSA) {   PHASE_IDS(); dsa_phase(lds, (const GAS bf16*)(ws + WS_Z), (const GAS bf16*)(ws + WS_CKVN), (const GAS unsigned short*)(ws + WS_IDX), (GAS bf16*)(ws + WS_O), karg_in(1), gw, NGW, tid, lane, wave); }
            GRID_BAR();
            {   PHASE_IDS(); GAS unsigned char* wl = ws + WS_W0 + (size_t)l * W_LAYER;
                pg8::Gemm g{(const GAS bf16*)(ws + WS_O), (const GAS bf16*)(wl + WO_OUT), M, D, OUT_F8 ? OLD / 2 : OLD}; pg8::StaticOrder S; S.init(M, D, G, bx);
                pg8::EpiResid E{OUT_F8 ? 1.0f / (W8_SCALE * O8_SCALE) : 1.0f, (unsigned)WS_XN, (unsigned)(WS_SS + (size_t)((3 * l + 2) & 1) * SS_BYTES), f8_on(l, 1) ? (unsigned)WS_HB8 : 0u, GU_I8 ? H8I_SCALE : 0.f};
                pg8::gemm_phase<pg8::EpiResid, pg8::StaticOrder, true, true, OUT_F8 != 0>(lds + RING_OFF, g, S, E, tid); }
            GRID_BAR();
        }
    }
    {   PHASE_IDS(); final_rows((const GAS bf16*)(ws + WS_XN), karg_out(), karg_in(19), (const GAS float*)(ws + WS_SS + (size_t)(6 & 1) * SS_BYTES), gw, NGW, lane); }
}

extern "C" void kernel_launch(void* const* d_in, const int* in_sizes, int n_in, void* d_out, int out_size, void* d_ws, size_t ws_size, hipStream_t stream) {
    static int grid = 0;
    if (grid == 0) {
        if (n_in != 20 || in_sizes[0] != M * D || out_size != M * D || ws_size < WS_END) { fprintf(stderr, "kernel_launch: unexpected shapes (n_in %d, in0 %d, out %d, ws %zu); nothing launched\n", n_in, n_in > 0 ? in_sizes[0] : -1, out_size, ws_size); grid = -1; return; }
        int dev = 0, cus = 0, per_cu = 0;
        if (hipGetDevice(&dev) != hipSuccess || hipDeviceGetAttribute(&cus, hipDeviceAttributeMultiprocessorCount, dev) != hipSuccess) { grid = -1; return; }
        if (hipFuncSetAttribute((const void*)mk_fwd, hipFuncAttributeMaxDynamicSharedMemorySize, LDS_BYTES) != hipSuccess) { fprintf(stderr, "kernel_launch: hipFuncSetAttribute failed\n"); grid = -1; return; }
        if (hipOccupancyMaxActiveBlocksPerMultiprocessor(&per_cu, (const void*)mk_fwd, NWAVES * 64, LDS_BYTES) != hipSuccess || per_cu < 1) { fprintf(stderr, "kernel_launch: occupancy query reports %d workgroups per CU\n", per_cu); }
        (void)hipGetLastError();
        grid = cus;
    }
    if (grid < 0) return;
    if (hipMemsetAsync((char*)d_ws + WS_CTL, 0, CTL_ZERO_BYTES, stream) != hipSuccess) return;
    Args a{};
    for (int i = 0; i < 20; ++i) a.in[i] = (const float*)d_in[i];
    a.out = (float*)d_out; a.ws = (unsigned char*)d_ws;
    hipLaunchKernelGGL(mk_fwd, dim3(grid), dim3(NWAVES * 64), LDS_BYTES, stream, a);
}
```

```cpp
#include <hip/hip_runtime.h>
#include <cstdio>
#include <cstdint>
namespace pg8 {
#define PG8_LAS __attribute__((address_space(3)))
#define PG8_GAS __attribute__((address_space(1)))
typedef unsigned short bf16_t;
typedef short bf16x8 __attribute__((ext_vector_type(8)));
typedef float f32x4 __attribute__((ext_vector_type(4)));
typedef unsigned u32x4 __attribute__((ext_vector_type(4)));
constexpr int BM = 256, BK = 64, HALF = 128, HTB = HALF * BK * 2  , STAGE_BYTES = 8 * HTB, NXCD = 8, WGM = 4;

__host__ __device__ __forceinline__ int lds_byte(int r, int c) { const int st = (r >> 4) * 2 + (c >> 5), rr = r & 15, cc = c & 31, ob = rr * 64 + cc * 2; return st * 1024 + (ob ^ (((ob >> 9) & 1) << 5)); }
__host__ __device__ __forceinline__ void stage_rc(int b, int& R, int& C) { const int st = b / 1024, sb = b % 1024, swz = sb ^ (((sb >> 9) & 1) << 5); R = (st >> 1) * 16 + swz / 64; C = (st & 1) * 32 + (swz % 64) / 2; }
__host__ __device__ __forceinline__ int perm32(int rho) { const int n = rho >> 4, i = rho & 15; return 8 * (i >> 2) + 4 * n + (i & 3); }

typedef int i32x8 __attribute__((ext_vector_type(8))); typedef int i32x4v __attribute__((ext_vector_type(4)));
__device__ __forceinline__ i32x8 cat8(bf16x8 a, bf16x8 b) { return __builtin_shufflevector(__builtin_bit_cast(i32x4v, a), __builtin_bit_cast(i32x4v, b), 0, 1, 2, 3, 4, 5, 6, 7); }
struct Unit { int pm, pn; };
struct Gemm { const PG8_GAS bf16_t* A; const PG8_GAS bf16_t* Bt; int M, N, K; };

struct StaticOrder {
    int nM, nN, nwg, G, c;
    __host__ __device__ void init(int M, int N, int G_, int c_) { nM = M / BM; nN = N / BM; nwg = nM * nN; G = G_; c = c_; }
    __host__ __device__ bool next(int i, Unit& u) const {
        const long L = (long)i * G + c; if (L >= nwg) return false;
        int wgid = (int)L; { const int q = nwg / NXCD, r = nwg % NXCD, xcd = wgid % NXCD, off = wgid / NXCD; wgid = (xcd < r ? xcd * (q + 1) : r * (q + 1) + (xcd - r) * q) + off; }
        const int nig = WGM * nN, gid = wgid / nig, fm = gid * WGM, gsz = (nM - fm) < WGM ? (nM - fm) : WGM;
        u.pm = fm + ((wgid % nig) % gsz); u.pn = (wgid % nig) / gsz; return true;
    }
    __device__ __forceinline__ void a_ready(const Unit&) const {}
    __device__ __forceinline__ void done(const Unit&) const {}
};
__device__ __forceinline__ unsigned long long karg64(int idx) { unsigned long long r; const unsigned off = (unsigned)idx * 8u;
    asm volatile("s_load_dwordx2 %0, %1, %2\n\ts_waitcnt lgkmcnt(0)" : "=s"(r) : "s"(__builtin_amdgcn_kernarg_segment_ptr()), "s"(off) : "memory"); return r; }
__device__ __forceinline__ unsigned cvt_pk_bf16(float lo, float hi) { unsigned r; asm volatile("v_cvt_pk_bf16_f32 %0, %1, %2" : "=v"(r) : "v"(lo), "v"(hi)); return r; }
typedef float f32x2 __attribute__((ext_vector_type(2)));
__device__ __forceinline__ unsigned pack4_i8(float a, float b, float c, float d, float S) {
    const int qa = (int)__builtin_rintf(__builtin_fminf(__builtin_fmaxf(a * S, -127.f), 127.f)), qb = (int)__builtin_rintf(__builtin_fminf(__builtin_fmaxf(b * S, -127.f), 127.f));
    const int qc = (int)__builtin_rintf(__builtin_fminf(__builtin_fmaxf(c * S, -127.f), 127.f)), qd = (int)__builtin_rintf(__builtin_fminf(__builtin_fmaxf(d * S, -127.f), 127.f));
    return ((unsigned)qa & 0xffu) | (((unsigned)qb & 0xffu) << 8) | (((unsigned)qc & 0xffu) << 16) | ((unsigned)qd << 24);
}
__device__ __forceinline__ float silu_f(float g) { return g * __builtin_amdgcn_rcpf(1.0f + __builtin_amdgcn_exp2f(-1.4426950408889634f * g)); }

template <bool ACC_I32 = false>
struct EpiSwiglu {
    static constexpr bool PERM = true, AFTER_DRAIN = false;
    static __device__ __forceinline__ f32x4 cv(const f32x4& a) { if constexpr (ACC_I32) { typedef int i32x4e __attribute__((ext_vector_type(4))); const i32x4e q = __builtin_bit_cast(i32x4e, a); return (f32x4){(float)q[0], (float)q[1], (float)q[2], (float)q[3]}; } else return a; }
    PG8_GAS bf16_t* O; int ldc; const PG8_GAS float* ss; float inv_k, eps, post; float out8;
    __device__ __forceinline__ void operator()(const f32x4 (&acc)[2][2][4][2], const Unit& u, int wr, int wc, int fr, int fq) const {
        const int row0 = u.pm * BM + wr * 64 + fr, col0 = u.pn * HALF + wc * 32 + 8 * fq;
        float rs[8]; const int lane_ = fr + 16 * fq;
#pragma unroll
        for (int k = 0; k < 8; ++k) { const PG8_GAS f32x4* p4 = (const PG8_GAS f32x4*)(ss + (size_t)(row0 + (k >> 2) * HALF + (k & 3) * 16) * 32 + 8 * fq); const f32x4 a = p4[0], b = p4[1];
            float t = ((a[0] + a[1]) + (a[2] + a[3])) + ((b[0] + b[1]) + (b[2] + b[3]));
            t += __builtin_bit_cast(float, __builtin_amdgcn_ds_bpermute((lane_ ^ 16) << 2, __builtin_bit_cast(int, t)));
            t += __builtin_bit_cast(float, __builtin_amdgcn_ds_bpermute((lane_ ^ 32) << 2, __builtin_bit_cast(int, t))); rs[k] = t; }
#pragma unroll
        for (int ai = 0; ai < 2; ++ai)
#pragma unroll
            for (int m = 0; m < 4; ++m) { PG8_GAS bf16_t* rowp = O + (size_t)(row0 + ai * HALF + m * 16) * ldc + col0;
                const float r = __builtin_amdgcn_rsqf(rs[ai * 4 + m] * inv_k + eps) * post;
                const f32x2 r2 = {r, r}, c2 = {-1.4426950408889634f * r, -1.4426950408889634f * r}; const float rs8 = out8 != 0.f ? r * out8 : r; const f32x2 q2 = {rs8, rs8}, one2 = {1.0f, 1.0f};
                f32x2 o[4];
#pragma unroll
                for (int h = 0; h < 4; ++h) { const f32x4 gq = cv(acc[ai][0][m][h >> 1]), uq = cv(acc[ai][1][m][h >> 1]);
                    const f32x2 gv = {gq[2 * (h & 1)], gq[2 * (h & 1) + 1]}, uv = {uq[2 * (h & 1)], uq[2 * (h & 1) + 1]};
                    const f32x2 t = gv * c2; f32x2 e; e.x = __builtin_amdgcn_exp2f(t.x); e.y = __builtin_amdgcn_exp2f(t.y);
                    const f32x2 d = e + one2; f32x2 rc; rc.x = __builtin_amdgcn_rcpf(d.x); rc.y = __builtin_amdgcn_rcpf(d.y);
                    o[h] = ((gv * r2) * rc) * (uv * q2); }
                if (out8 != 0.f) { int p = 0, q = 0;
                    p = __builtin_amdgcn_cvt_pk_fp8_f32(o[0].x, o[0].y, p, false); p = __builtin_amdgcn_cvt_pk_fp8_f32(o[1].x, o[1].y, p, true);
                    q = __builtin_amdgcn_cvt_pk_fp8_f32(o[2].x, o[2].y, q, false); q = __builtin_amdgcn_cvt_pk_fp8_f32(o[3].x, o[3].y, q, true);
                    typedef unsigned u32x2v __attribute__((ext_vector_type(2))); u32x2v w8; w8.x = (unsigned)p; w8.y = (unsigned)q;
                    *(PG8_GAS u32x2v*)((PG8_GAS unsigned char*)O + (size_t)(row0 + ai * HALF + m * 16) * ldc + col0) = w8; }
                else { u32x4 w; w.x = cvt_pk_bf16(o[0].x, o[0].y); w.y = cvt_pk_bf16(o[1].x, o[1].y); w.z = cvt_pk_bf16(o[2].x, o[2].y); w.w = cvt_pk_bf16(o[3].x, o[3].y);
                    *(PG8_GAS u32x4*)rowp = w; } }
    }
};
struct EpiResid {
    static constexpr bool PERM = true, AFTER_DRAIN = false;
    float alpha; unsigned hb_off; unsigned ss_off; unsigned h8_off; float h8_i8;
    __device__ __forceinline__ void operator()(const f32x4 (&acc)[2][2][4][2], const Unit& u, int wr, int wc, int fr, int fq) const {
        constexpr int ldc = 2048;
        PG8_GAS unsigned char* wsb = (PG8_GAS unsigned char*)karg64(21); PG8_GAS bf16_t* hb = (PG8_GAS bf16_t*)(wsb + hb_off); PG8_GAS float* ss = (PG8_GAS float*)(wsb + ss_off);
        const int row0 = u.pm * BM + wr * 64 + fr, col0 = u.pn * BM + wc * 32 + 8 * fq; const int lane = fr + 16 * fq;
        u32x4 cur[2], nxt[2];
        { const size_t off = (size_t)row0 * ldc + col0; cur[0] = *(const PG8_GAS u32x4*)(hb + off); cur[1] = *(const PG8_GAS u32x4*)(hb + off + HALF); }
#pragma unroll
        for (int k = 0; k < 8; ++k) { const int ai = k >> 2, m = k & 3; const int row = row0 + ai * HALF + m * 16; const size_t off = (size_t)row * ldc + col0;
            if (k < 7) { const int ai2 = (k + 1) >> 2, m2 = (k + 1) & 3; const size_t off2 = (size_t)(row0 + ai2 * HALF + m2 * 16) * ldc + col0;
                nxt[0] = *(const PG8_GAS u32x4*)(hb + off2); nxt[1] = *(const PG8_GAS u32x4*)(hb + off2 + HALF); }
            float sq = 0.f;
#pragma unroll
            for (int bj = 0; bj < 2; ++bj) { const u32x4 b = cur[bj]; const f32x4 a0 = acc[ai][bj][m][0], a1 = acc[ai][bj][m][1]; u32x4 w;
                w.x = cvt_pk_bf16(__builtin_bit_cast(float, b.x << 16) + a0[0] * alpha, __builtin_bit_cast(float, b.x & 0xffff0000u) + a0[1] * alpha);
                w.y = cvt_pk_bf16(__builtin_bit_cast(float, b.y << 16) + a0[2] * alpha, __builtin_bit_cast(float, b.y & 0xffff0000u) + a0[3] * alpha);
                w.z = cvt_pk_bf16(__builtin_bit_cast(float, b.z << 16) + a1[0] * alpha, __builtin_bit_cast(float, b.z & 0xffff0000u) + a1[1] * alpha);
                w.w = cvt_pk_bf16(__builtin_bit_cast(float, b.w << 16) + a1[2] * alpha, __builtin_bit_cast(float, b.w & 0xffff0000u) + a1[3] * alpha);
                *(PG8_GAS u32x4*)(hb + off + bj * HALF) = w;
                if (h8_off) { typedef unsigned u32x2v __attribute__((ext_vector_type(2))); u32x2v q8; int p = 0;
                    const float e0 = __builtin_bit_cast(float, w.x << 16), e1 = __builtin_bit_cast(float, w.x & 0xffff0000u), e2 = __builtin_bit_cast(float, w.y << 16), e3 = __builtin_bit_cast(float, w.y & 0xffff0000u);
                    const float e4 = __builtin_bit_cast(float, w.z << 16), e5 = __builtin_bit_cast(float, w.z & 0xffff0000u), e6 = __builtin_bit_cast(float, w.w << 16), e7 = __builtin_bit_cast(float, w.w & 0xffff0000u);
                    if (h8_i8 != 0.f) { q8.x = pack4_i8(e0, e1, e2, e3, h8_i8); q8.y = pack4_i8(e4, e5, e6, e7, h8_i8); }
                    else { p = __builtin_amdgcn_cvt_pk_fp8_f32(e0, e1, p, false); p = __builtin_amdgcn_cvt_pk_fp8_f32(e2, e3, p, true); q8.x = (unsigned)p; p = 0;
                        p = __builtin_amdgcn_cvt_pk_fp8_f32(e4, e5, p, false); p = __builtin_amdgcn_cvt_pk_fp8_f32(e6, e7, p, true); q8.y = (unsigned)p; }
                    *(PG8_GAS u32x2v*)(wsb + h8_off + off + bj * HALF) = q8; }
#pragma unroll
                for (int e = 0; e < 4; ++e) { const float lo = __builtin_bit_cast(float, w[e] << 16), hi = __builtin_bit_cast(float, w[e] & 0xffff0000u); sq = fmaf(lo, lo, sq); sq = fmaf(hi, hi, sq); } }
            sq += __builtin_bit_cast(float, __builtin_amdgcn_ds_bpermute((lane ^ 16) << 2, __builtin_bit_cast(int, sq)));
            sq += __builtin_bit_cast(float, __builtin_amdgcn_ds_bpermute((lane ^ 32) << 2, __builtin_bit_cast(int, sq)));
            if (fq == 0) ss[(size_t)row * 32 + u.pn * 4 + wc] = sq;
            cur[0] = nxt[0]; cur[1] = nxt[1]; }
    }
};
template <bool ACC_I32 = false>
struct EpiBf16 {
    static constexpr bool PERM = true, AFTER_DRAIN = false;
    static __device__ __forceinline__ f32x4 cv(const f32x4& a) { if constexpr (ACC_I32) { typedef int i32x4e __attribute__((ext_vector_type(4))); const i32x4e q = __builtin_bit_cast(i32x4e, a); return (f32x4){(float)q[0], (float)q[1], (float)q[2], (float)q[3]}; } else return a; }
    PG8_GAS bf16_t* O; int ldc; const PG8_GAS float* ss; float inv_k, eps; float post_a, post_b, post_c;
    __device__ __forceinline__ void operator()(const f32x4 (&acc)[2][2][4][2], const Unit& u, int wr, int wc, int fr, int fq) const {
        const int row0 = u.pm * BM + wr * 64 + fr, col0 = u.pn * BM + wc * 32 + 8 * fq;
        const float pfac = fmaf(u.pn < 8 ? 1.0f : 0.0f, post_a - post_b, fmaf((u.pn >= 9 && u.pn < 13) ? 1.0f : 0.0f, post_c - post_b, post_b));
        float rs[8]; const int lane_ = fr + 16 * fq;
#pragma unroll
        for (int k = 0; k < 8; ++k) { const PG8_GAS f32x4* p4 = (const PG8_GAS f32x4*)(ss + (size_t)(row0 + (k >> 2) * HALF + (k & 3) * 16) * 32 + 8 * fq); const f32x4 a = p4[0], b = p4[1];
            float t = ((a[0] + a[1]) + (a[2] + a[3])) + ((b[0] + b[1]) + (b[2] + b[3]));
            t += __builtin_bit_cast(float, __builtin_amdgcn_ds_bpermute((lane_ ^ 16) << 2, __builtin_bit_cast(int, t)));
            t += __builtin_bit_cast(float, __builtin_amdgcn_ds_bpermute((lane_ ^ 32) << 2, __builtin_bit_cast(int, t))); rs[k] = t; }
#pragma unroll
        for (int ai = 0; ai < 2; ++ai)
#pragma unroll
            for (int m = 0; m < 4; ++m) { PG8_GAS bf16_t* rowp = O + (size_t)(row0 + ai * HALF + m * 16) * ldc + col0;
                const float r = __builtin_amdgcn_rsqf(rs[ai * 4 + m] * inv_k + eps) * pfac;
#pragma unroll
                for (int bj = 0; bj < 2; ++bj) { const f32x4 v0 = cv(acc[ai][bj][m][0]) * r, v1 = cv(acc[ai][bj][m][1]) * r;
                    u32x4 w; w.x = cvt_pk_bf16(v0[0], v0[1]); w.y = cvt_pk_bf16(v0[2], v0[3]); w.z = cvt_pk_bf16(v1[0], v1[1]); w.w = cvt_pk_bf16(v1[2], v1[3]);
                    *(PG8_GAS u32x4*)(rowp + bj * HALF) = w; } }
    }
};
template <class Epi, class Sched, bool ALIGN_EPI = false, bool SP2 = false, bool F8 = false, bool I8 = false>
__device__ __forceinline__ void gemm_phase(PG8_LAS unsigned char* lds, const Gemm g, const Sched& S, const Epi& E, int tid_in  ) {
    int tid_ = tid_in; asm volatile("" : "+v"(tid_));
    const int tid = tid_, wid = __builtin_amdgcn_readfirstlane(tid >> 6), lane = tid & 63, wr = wid >> 2, wc = wid & 3, fr = lane & 15, fq = lane >> 4;
    const int K = g.K, nt = K / BK;
    unsigned voffA[2], voffB[2];
#pragma unroll
    for (int i = 0; i < 2; ++i) { int R, C; stage_rc(tid * 16 + i * 8192, R, C); const int Rb = Epi::PERM ? ((R & ~31) + perm32(R & 31)) : R;
        voffA[i] = (unsigned)(R * K + C) * 2u; voffB[i] = (unsigned)(Rb * K + C) * 2u; }
    const size_t kstep = (size_t)(BK * 2);
    const size_t hstep = (size_t)HALF * K * 2;
    const size_t tstep = 2 * hstep;
    const unsigned ldsw = (unsigned)wid * 1024u;
    const int aoff = lds_byte(wr * 64 + fr, fq * 8), boff = lds_byte(wc * 32 + fr, fq * 8);
#define PG8_SA(b, h) (((b) * 2 + (h)) * HTB)
#define PG8_SB(b, h) ((4 + (b) * 2 + (h)) * HTB)
#define PG8_STAGE(bufoff, gbase, voff) do { _Pragma("unroll") for (int _i = 0; _i < 2; ++_i) \
        __builtin_amdgcn_global_load_lds((const PG8_GAS unsigned*)((const PG8_GAS char*)(gbase) + (voff)[_i]), (PG8_LAS unsigned*)(lds + (bufoff) + ldsw + _i * 8192), 16, 0, 0); } while (0)
#define PG8_LDA(dst, b, h) do { _Pragma("unroll") for (int m = 0; m < 4; ++m) _Pragma("unroll") for (int k = 0; k < 2; ++k) dst[m][k] = *(const PG8_LAS bf16x8*)(lds + PG8_SA(b, h) + aoff + m * 2048 + k * 1024); } while (0)
#define PG8_LDB(dst, b, h) do { _Pragma("unroll") for (int n = 0; n < 2; ++n) _Pragma("unroll") for (int k = 0; k < 2; ++k) dst[n][k] = *(const PG8_LAS bf16x8*)(lds + PG8_SB(b, h) + boff + n * 2048 + k * 1024); } while (0)
#define PG8_MMA(ai, bj, At, Bt) do { __builtin_amdgcn_s_setprio(1); _Pragma("unroll") for (int m = 0; m < 4; ++m) _Pragma("unroll") for (int n = 0; n < 2; ++n) { \
        if constexpr (F8) { asm volatile("v_mfma_f32_16x16x128_f8f6f4 %0, %1, %2, %0" : "+v"(acc[ai][bj][m][n]) : "v"(cat8(Bt[n][0], Bt[n][1])), "v"(cat8(At[m][0], At[m][1]))); } \
        else if constexpr (I8) { _Pragma("unroll") for (int k = 0; k < 2; ++k) asm volatile("v_mfma_i32_16x16x64_i8 %0, %1, %2, %0" : "+v"(acc[ai][bj][m][n]) : "v"(Bt[n][k]), "v"(At[m][k])); } \
        else { _Pragma("unroll") for (int k = 0; k < 2; ++k) acc[ai][bj][m][n] = __builtin_amdgcn_mfma_f32_16x16x32_bf16(Bt[n][k], At[m][k], acc[ai][bj][m][n], 0, 0, 0); } } \
        __builtin_amdgcn_s_setprio(0); } while (0)
#define PG8_WAIT_V(n) asm volatile("s_waitcnt vmcnt(" #n ")" ::: "memory")
#define PG8_WAIT_L(n) asm volatile("s_waitcnt lgkmcnt(" #n ")" ::: "memory")
#define PG8_BAR __builtin_amdgcn_s_barrier()
#define PG8_SCHED __builtin_amdgcn_sched_barrier(0)
    Unit cur, nxt; int ui = 0;
    if (!S.next(0, cur)) return;
    f32x4 acc[2][2][4][2];
#pragma unroll
    for (int a = 0; a < 2; ++a)
#pragma unroll
        for (int b = 0; b < 2; ++b)
#pragma unroll
            for (int m = 0; m < 4; ++m)
#pragma unroll
                for (int n = 0; n < 2; ++n) acc[a][b][m][n] = (f32x4){0.f, 0.f, 0.f, 0.f};
    bf16x8 At[4][2], B0[2][2], B1[2][2];
    const PG8_GAS char* cA = (const PG8_GAS char*)g.A + (size_t)cur.pm * tstep; const PG8_GAS char* cB = (const PG8_GAS char*)g.Bt + (size_t)cur.pn * tstep;
    S.a_ready(cur);
    if constexpr (SP2) {
        PG8_STAGE(PG8_SB(0, 0), cB, voffB); PG8_STAGE(PG8_SB(0, 1), cB + hstep, voffB); PG8_STAGE(PG8_SA(0, 0), cA, voffA); PG8_STAGE(PG8_SA(0, 1), cA + hstep, voffA);
        if (wr == 1) PG8_BAR;
        PG8_WAIT_V(2); PG8_BAR;
        PG8_STAGE(PG8_SB(1, 0), cB + kstep, voffB); PG8_STAGE(PG8_SA(1, 0), cA + kstep, voffA); PG8_STAGE(PG8_SB(1, 1), cB + hstep + kstep, voffB);
        PG8_WAIT_V(6); PG8_BAR;
    } else {
        PG8_STAGE(PG8_SB(0, 0), cB, voffB); PG8_STAGE(PG8_SA(0, 0), cA, voffA); PG8_STAGE(PG8_SB(0, 1), cB + hstep, voffB); PG8_STAGE(PG8_SA(0, 1), cA + hstep, voffA);
        if (wr == 1) PG8_BAR;
        PG8_WAIT_V(4); PG8_BAR;
        PG8_STAGE(PG8_SB(1, 0), cB + kstep, voffB); PG8_STAGE(PG8_SA(1, 0), cA + kstep, voffA); PG8_STAGE(PG8_SB(1, 1), cB + hstep + kstep, voffB);
        PG8_WAIT_V(6); PG8_BAR;
    }
    for (;;) {
        const bool has_next = S.next(ui + 1, nxt);
        const PG8_GAS char* nA = has_next ? (const PG8_GAS char*)g.A + (size_t)nxt.pm * tstep : cA; const PG8_GAS char* nB = has_next ? (const PG8_GAS char*)g.Bt + (size_t)nxt.pn * tstep : cB;
        for (int t = 0; t < nt; t += 2) {
            const bool last = (t == nt - 2);
            const PG8_GAS char* a1 = cA + (size_t)(t + 1) * kstep;
            const PG8_GAS char* a2 = last ? nA : cA + (size_t)(t + 2) * kstep; const PG8_GAS char* b2 = last ? nB : cB + (size_t)(t + 2) * kstep;
            const PG8_GAS char* a3 = a2 + kstep; const PG8_GAS char* b3 = b2 + kstep;
            if (last && has_next) S.a_ready(nxt);
            if constexpr (SP2) {
            PG8_LDB(B0, 0, 0); PG8_LDB(B1, 0, 1); PG8_SCHED; PG8_LDA(At, 0, 0); PG8_STAGE(PG8_SA(1, 1), a1 + hstep, voffA);
            PG8_WAIT_V(8); PG8_WAIT_L(0); PG8_BAR; PG8_MMA(0, 0, At, B0); PG8_MMA(0, 1, At, B1); PG8_BAR; PG8_SCHED;
            PG8_LDA(At, 0, 1); PG8_STAGE(PG8_SB(0, 0), b2, voffB); PG8_STAGE(PG8_SB(0, 1), b2 + hstep, voffB); PG8_STAGE(PG8_SA(0, 0), a2, voffA);
            PG8_WAIT_V(8); PG8_WAIT_L(0); PG8_BAR; PG8_MMA(1, 0, At, B0); PG8_MMA(1, 1, At, B1); PG8_BAR; PG8_SCHED;
            PG8_LDB(B0, 1, 0); PG8_LDB(B1, 1, 1); PG8_SCHED; PG8_LDA(At, 1, 0); PG8_STAGE(PG8_SA(0, 1), a2 + hstep, voffA);
            PG8_WAIT_V(8); PG8_WAIT_L(0); PG8_BAR; PG8_MMA(0, 0, At, B0); PG8_MMA(0, 1, At, B1); PG8_BAR; PG8_SCHED;
            PG8_LDA(At, 1, 1); PG8_STAGE(PG8_SB(1, 0), b3, voffB); PG8_STAGE(PG8_SB(1, 1), b3 + hstep, voffB); PG8_STAGE(PG8_SA(1, 0), a3, voffA);
            PG8_WAIT_V(8); PG8_WAIT_L(0); PG8_BAR; PG8_MMA(1, 0, At, B0); PG8_MMA(1, 1, At, B1); PG8_BAR; PG8_SCHED;
            } else {
            PG8_LDB(B0, 0, 0); PG8_SCHED; PG8_LDA(At, 0, 0); PG8_STAGE(PG8_SA(1, 1), a1 + hstep, voffA);
            PG8_WAIT_L(8); PG8_BAR; PG8_WAIT_L(0); PG8_MMA(0, 0, At, B0); PG8_BAR; PG8_SCHED;
            PG8_LDB(B1, 0, 1); PG8_STAGE(PG8_SB(0, 0), b2, voffB);
            PG8_BAR; PG8_WAIT_L(0); PG8_MMA(0, 1, At, B1); PG8_BAR;
            PG8_LDA(At, 0, 1); PG8_STAGE(PG8_SA(0, 0), a2, voffA);
            PG8_BAR; PG8_WAIT_L(0); PG8_MMA(1, 0, At, B0); PG8_BAR; PG8_SCHED;
            PG8_STAGE(PG8_SB(0, 1), b2 + hstep, voffB);
            PG8_WAIT_V(6); PG8_BAR; PG8_MMA(1, 1, At, B1); PG8_BAR;
            PG8_LDB(B0, 1, 0); PG8_SCHED; PG8_LDA(At, 1, 0); PG8_STAGE(PG8_SA(0, 1), a2 + hstep, voffA);
            PG8_WAIT_L(8); PG8_BAR; PG8_WAIT_L(0); PG8_MMA(0, 0, At, B0); PG8_BAR; PG8_SCHED;
            PG8_LDB(B1, 1, 1); PG8_STAGE(PG8_SB(1, 0), b3, voffB);
            PG8_BAR; PG8_WAIT_L(0); PG8_MMA(0, 1, At, B1); PG8_BAR;
            PG8_LDA(At, 1, 1); PG8_STAGE(PG8_SA(1, 0), a3, voffA);
            PG8_BAR; PG8_WAIT_L(0); PG8_MMA(1, 0, At, B0); PG8_BAR; PG8_SCHED;
            PG8_STAGE(PG8_SB(1, 1), b3 + hstep, voffB);
            PG8_WAIT_V(6); PG8_BAR; PG8_MMA(1, 1, At, B1); PG8_BAR;
            }
        }
        if constexpr (ALIGN_EPI) { if (wr == 0) PG8_BAR; }
        if constexpr (!Epi::AFTER_DRAIN) { int ln_; asm volatile("v_mbcnt_lo_u32_b32 %0, -1, 0\n\tv_mbcnt_hi_u32_b32 %0, -1, %0" : "=v"(ln_));
            E(acc, cur, wr, wc, ln_ & 15, ln_ >> 4); S.done(cur); }
        if (!has_next) break;
#pragma unroll
        for (int a = 0; a < 2; ++a)
#pragma unroll
            for (int b = 0; b < 2; ++b)
#pragma unroll
                for (int m = 0; m < 4; ++m)
#pragma unroll
                    for (int n = 0; n < 2; ++n) acc[a][b][m][n] = (f32x4){0.f, 0.f, 0.f, 0.f};
        cur = nxt; cA = nA; cB = nB; ++ui;
        if constexpr (ALIGN_EPI) { if (wr == 1) PG8_BAR; }
    }
    PG8_WAIT_V(0);
    if constexpr (!ALIGN_EPI) { if (wr == 0) PG8_BAR; }
    PG8_BAR;
    if constexpr (Epi::AFTER_DRAIN) { E.fused(acc, cur, wr, wc, fr, fq, lds, wid, lane); S.done(cur); }
#undef PG8_SA
#undef PG8_SB
#undef PG8_STAGE
#undef PG8_LDA
#undef PG8_LDB
#undef PG8_MMA
#undef PG8_WAIT_V
#undef PG8_WAIT_L
#undef PG8_BAR
#undef PG8_SCHED
}
}
constexpr int NWAVES = 8;
constexpr int BATCH = 8, SEQ = 4096, D = 2048, FF = 5632, DEPTH = 2;
constexpr int M = BATCH * SEQ;
constexpr int NGU = 2 * FF;
constexpr int H_A = 8, HD_A = 128, RANK = 256, IH = 8, IDIM = 64, TOPK = 256;
constexpr int H_B = 16, KVH = 2, GQA = 8, HD_B = 64, WINDOW = 128;
constexpr int D_IN = 3144;
constexpr float EPS = 1e-6f;
constexpr size_t MiB = 1u << 20;
constexpr size_t WS_CTL = 0, CTL_ZERO_BYTES = 1 * MiB;
#ifndef F8_MASK
#define F8_MASK 0xF
#endif
constexpr float W8_SCALE = 64.0f;
#ifndef GU_I8
#define GU_I8 1
#endif
constexpr float H8I_SCALE = 127.0f / 4.6f, W8I_SCALE = 127.0f / (4.2f * 0.022097086912079608f);
#ifndef D8_MASK
#define D8_MASK 0xF
#endif
constexpr float A8_SCALE = 8.0f;
__host__ __device__ constexpr bool d8_on(int l, int f) { return ((D8_MASK >> (2 * l + f)) & 1) != 0; }
constexpr float O8_SCALE = 16.0f;
#ifndef OUT_F8
#define OUT_F8 1
#endif
constexpr bool F8_ALL1 = (F8_MASK & 0x5) == 0x5, F8_ALL2 = (F8_MASK & 0xA) == 0xA;
__host__ __device__ constexpr bool f8_on(int l, int f) { return ((F8_MASK >> (2 * l + f)) & 1) != 0; }
constexpr size_t GU1_B = (F8_ALL1 ? 22 : 44) * MiB, GU2_B = (F8_ALL2 ? 22 : 44) * MiB;
constexpr size_t WS_W0 = 2 * MiB;
constexpr size_t WO_GU1 = 0, WO_D1 = GU1_B, WO_GU2 = WO_D1 + 22 * MiB, WO_D2 = WO_GU2 + GU2_B, WO_IN = WO_D2 + 22 * MiB, WO_OUT = WO_IN + 17 * MiB, W_LAYER = WO_OUT + 12 * MiB;
constexpr size_t WS_XN = WS_W0 + 2 * W_LAYER;
constexpr size_t WS_HB8 = WS_XN + 128 * MiB;
constexpr size_t WS_ACT = WS_HB8 + (F8_MASK ? 64 : 0) * MiB;
constexpr size_t WS_Z = WS_ACT, WS_CKVN = WS_ACT + 272 * MiB, WS_KIN = WS_ACT + 288 * MiB, WS_WIF = WS_ACT + 292 * MiB, WS_IDX = WS_ACT + 294 * MiB;
constexpr int ZLD = 4352, ZC_QLAT = 0, ZC_CKV = 2048, ZC_QB = 2304, ZC_KB = 3328, ZC_VB = 3456, ZC_QI = 3584, ZC_KI = 4096, ZC_WI = 4160;
constexpr int ZN8 = 3584;
#ifndef IN_I8
#define IN_I8 1
#endif
constexpr float WQ8I_SCALE = 127.0f / (4.2f * 0.015625f);
constexpr int OLD = 3072;
constexpr size_t WS_O = WS_ACT + 352 * MiB;
constexpr size_t WS_SS = WS_O + 192 * MiB, SS_BYTES = 4 * MiB;
constexpr size_t WS_END = WS_SS + 2 * SS_BYTES;
static_assert(WS_END <= 1024 * MiB, "d_ws map exceeds 1 GiB");
constexpr int CW_TMO = 0, CW_CODE = 1, CW_BAR = 4096, CW_XRANK = 8192;
constexpr int RING_OFF = 0, RING_BYTES = 131072;
constexpr int LDSCTL_OFF = RING_BYTES, MISC_OFF = LDSCTL_OFF + 320;
constexpr int LDS_BYTES = 147456;
constexpr int RSL_OFF = RING_BYTES + 5632;
#define GAS __attribute__((address_space(1)))
#define LAS __attribute__((address_space(3)))
typedef unsigned short bf16;
typedef unsigned v4u __attribute__((ext_vector_type(4)));
typedef float f32x4 __attribute__((ext_vector_type(4)));
typedef short bf16x8 __attribute__((ext_vector_type(8)));
typedef GAS unsigned gu32;
typedef GAS unsigned long long gu64;
#define RLX_AGENT __ATOMIC_RELAXED, __HIP_MEMORY_SCOPE_AGENT
#define LDS_WAIT() asm volatile("s_waitcnt lgkmcnt(0)" ::: "memory")
#define VM_WAIT() asm volatile("s_waitcnt vmcnt(0)" ::: "memory")
__device__ __forceinline__ unsigned long long rt() { return __builtin_amdgcn_s_memrealtime(); }
__device__ __forceinline__ unsigned f2bf(float f) { unsigned u = __builtin_bit_cast(unsigned, f); return (u + 0x7fffu + ((u >> 16) & 1u)) >> 16; }
__device__ __forceinline__ unsigned pk2(float lo, float hi) { return f2bf(lo) | (f2bf(hi) << 16); }

#define XB_TMO      128
#define XB_XCNT(j)  (256  + 64 * (j))
#define XB_XSUB(j)  (1280 + 64 * (j))
#define XB_XGEN(j)  (2304 + 64 * (j))
#define XB_TOP      3328
#define XB_TOPGEN   3392
#define XCD_BAR_WORDS 3456
#define XB_SPIN_CAP (1u << 18)

__device__ __forceinline__ unsigned xb_ld(unsigned* p)              { return __hip_atomic_load(p, __ATOMIC_RELAXED, __HIP_MEMORY_SCOPE_AGENT); }
__device__ __forceinline__ unsigned xb_add(unsigned* p, unsigned v) { return __hip_atomic_fetch_add(p, v, __ATOMIC_RELAXED, __HIP_MEMORY_SCOPE_AGENT); }
__device__ __forceinline__ unsigned xb_xcc_id() { return (unsigned)__builtin_amdgcn_s_getreg((3 << 11) | 20) & 0xFu; }
#define XB_SPIN(cond, bar) do { unsigned _sp = 0; while (cond) { __builtin_amdgcn_s_sleep(1); \
    if ((++_sp & 255u) == 0u) { if (xb_ld(&(bar)[XB_TMO])) break; if (_sp > XB_SPIN_CAP) { atomicAdd(&(bar)[XB_TMO], 1u); break; } } } } while (0)

struct XcdBarrier {
    unsigned* bar; unsigned x;
    volatile LAS unsigned* st;
};

__device__ __forceinline__ XcdBarrier xcd_barrier_post(unsigned* bar, volatile LAS unsigned* st, bool leader  ) {
    XcdBarrier b; b.bar = bar; b.x = xb_xcc_id(); b.st = st;
    if (leader) (void)xb_add(&bar[XB_XCNT(b.x)], 1u);
    return b;
}
__device__ __forceinline__ void xcd_barrier_complete(unsigned* bar, unsigned x, unsigned& nloc, unsigned& nx) {
    const unsigned G = gridDim.x * gridDim.y * gridDim.z;
    unsigned sum, cnt, mine, sp = 0u;
    for (;;) {
        sum = 0u; cnt = 0u; mine = 0u;
#pragma unroll
        for (unsigned j = 0; j < 16; ++j) { const unsigned c = xb_ld(&bar[XB_XCNT(j)]); sum += c; cnt += (c > 0u) ? 1u : 0u; mine = (j == x) ? c : mine; }
        if (sum == G) break;
        __builtin_amdgcn_s_sleep(1);
        if ((++sp & 255u) == 0u) { if (xb_ld(&bar[XB_TMO])) break; if (sp > XB_SPIN_CAP) { atomicAdd(&bar[XB_TMO], 1u); break; } }
    }
    nloc = mine > 0u ? mine : 1u; nx = cnt > 0u ? cnt : 1u;
}

__device__ __forceinline__ void xcd_barrier(const XcdBarrier& b, bool leader  ) {
    asm volatile("s_waitcnt vmcnt(0)" ::: "memory");
    __syncthreads();
    if (leader) {
        unsigned* bar = b.bar;
        __builtin_amdgcn_s_waitcnt(0);
        unsigned nloc = b.st[0], nx = b.st[1];
        if (nloc == 0u) { xcd_barrier_complete(bar, b.x, nloc, nx); b.st[0] = nloc; b.st[1] = nx; }
        const unsigned old = xb_add(&bar[XB_XSUB(b.x)], 1u);
        const unsigned gen = old / nloc;
        if (old + 1u == (gen + 1u) * nloc) {
            __builtin_amdgcn_fence(__ATOMIC_RELEASE, "agent");
            asm volatile("s_waitcnt vmcnt(0)" ::: "memory");
            const unsigned og = xb_add(&bar[XB_TOP], 1u);
            const unsigned tg = og / nx;
            if (og + 1u == (tg + 1u) * nx) xb_add(&bar[XB_TOPGEN], 1u);
            else XB_SPIN(xb_ld(&bar[XB_TOPGEN]) == tg, bar);
            __builtin_amdgcn_fence(__ATOMIC_ACQUIRE, "agent");
            xb_add(&bar[XB_XGEN(b.x)], 1u);
            asm volatile("s_waitcnt vmcnt(0)" ::: "memory");
        } else {
            XB_SPIN(xb_ld(&bar[XB_XGEN(b.x)]) == gen, bar);
            __builtin_amdgcn_fence(__ATOMIC_ACQUIRE, "agent");
            asm volatile("s_waitcnt vmcnt(0)" ::: "memory");
        }
    }
    __syncthreads();
}
__constant__ unsigned char T5_BUCKET[128] = {0, 1, 2, 3, 4, 5, 6, 7, 8, 9, 10, 11, 12, 13, 14, 15, 16, 16, 16, 17, 17, 18, 18, 18, 19, 19, 19, 20, 20, 20, 20, 21, 21, 21, 21, 22, 22, 22, 22, 22, 23, 23, 23, 23, 23, 23, 24, 24, 24, 24, 24, 24, 25, 25, 25, 25, 25, 25, 25, 26, 26, 26, 26, 26, 26, 26, 26, 27, 27, 27, 27, 27, 27, 27, 27, 27, 27, 28, 28, 28, 28, 28, 28, 28, 28, 28, 28, 29, 29, 29, 29, 29, 29, 29, 29, 29, 29, 29, 29, 30, 30, 30, 30, 30, 30, 30, 30, 30, 30, 30, 30, 30, 30, 31, 31, 31, 31, 31, 31, 31, 31, 31, 31, 31, 31, 31, 31, 31};
typedef short s16x4 __attribute__((ext_vector_type(4)));
typedef float f32x16 __attribute__((ext_vector_type(16)));
__device__ __forceinline__ float bf2f(unsigned short b) { return __builtin_bit_cast(float, (unsigned)b << 16); }
__device__ __forceinline__ bf16x8 cat4(s16x4 lo, s16x4 hi) { return __builtin_shufflevector(lo, hi, 0, 1, 2, 3, 4, 5, 6, 7); }
__device__ __forceinline__ void tr_read4(unsigned a0, unsigned a1, unsigned a2, unsigned a3, s16x4& r0, s16x4& r1, s16x4& r2, s16x4& r3) {
    asm volatile("ds_read_b64_tr_b16 %0, %4\n\tds_read_b64_tr_b16 %1, %5\n\tds_read_b64_tr_b16 %2, %6\n\tds_read_b64_tr_b16 %3, %7\n\ts_waitcnt lgkmcnt(0)"
                 : "=&v"(r0), "=&v"(r1), "=&v"(r2), "=&v"(r3) : "v"(a0), "v"(a1), "v"(a2), "v"(a3) : "memory");
}
#define SHX(x, o) __builtin_bit_cast(float, __builtin_amdgcn_ds_bpermute(((lane) ^ (o)) << 2, __builtin_bit_cast(int, (float)(x))))
#define SHXU(x, o) ((unsigned)__builtin_amdgcn_ds_bpermute(((lane) ^ (o)) << 2, (int)(x)))
__device__ __forceinline__ float wave_sum(float v, int lane) {
#pragma unroll
    for (int o = 1; o < 64; o <<= 1) v += SHX(v, o);
    return v;
}
template <int OUT8 = 0>
__device__ __forceinline__ void conv_item(const GAS float* W, int ldw, int k0, int c0, int nvalid, GAS bf16* dst, int dld, int drow0, int dk0, float scale, const GAS float* gain, LAS float* scr, int lane) {
    const int c = lane & 31;
    float vin[32];
#pragma unroll
    for (int i = 0; i < 32; ++i) { const int kk = 2 * i + (lane >> 5); vin[i] = 0.f;
        if (c < nvalid) vin[i] = W[(size_t)(k0 + kk) * ldw + c0 + c]; }
#pragma unroll
    for (int i = 0; i < 32; ++i) { const int kk = 2 * i + (lane >> 5); scr[kk * 33 + c] = vin[i] * scale; }
    LDS_WAIT(); asm volatile("" ::: "memory");
    const int c8 = lane & 7;
    f32x4 ga = {1.f, 1.f, 1.f, 1.f}, gb = {1.f, 1.f, 1.f, 1.f};
    if (gain) { ga = *(const GAS f32x4*)(gain + k0 + 8 * c8); gb = *(const GAS f32x4*)(gain + k0 + 8 * c8 + 4); }
#pragma unroll
    for (int j = 0; j < 4; ++j) { const int n = (lane >> 3) + 8 * j; const LAS float* s = scr + (8 * c8) * 33 + n;
        if constexpr (OUT8 == 2) { const unsigned p = pg8::pack4_i8(s[0 * 33] * ga.x, s[1 * 33] * ga.y, s[2 * 33] * ga.z, s[3 * 33] * ga.w, 1.0f), q = pg8::pack4_i8(s[4 * 33] * gb.x, s[5 * 33] * gb.y, s[6 * 33] * gb.z, s[7 * 33] * gb.w, 1.0f);
            *(GAS unsigned long long*)((GAS unsigned char*)dst + (size_t)(drow0 + n) * dld + dk0 + k0 + 8 * c8) = (unsigned long long)p | ((unsigned long long)q << 32); }
        else if constexpr (OUT8 == 1) { int p = 0, q = 0;
            p = __builtin_amdgcn_cvt_pk_fp8_f32(s[0 * 33] * ga.x, s[1 * 33] * ga.y, p, false); p = __builtin_amdgcn_cvt_pk_fp8_f32(s[2 * 33] * ga.z, s[3 * 33] * ga.w, p, true);
            q = __builtin_amdgcn_cvt_pk_fp8_f32(s[4 * 33] * gb.x, s[5 * 33] * gb.y, q, false); q = __builtin_amdgcn_cvt_pk_fp8_f32(s[6 * 33] * gb.z, s[7 * 33] * gb.w, q, true);
            *(GAS unsigned long long*)((GAS unsigned char*)dst + (size_t)(drow0 + n) * dld + dk0 + k0 + 8 * c8) = (unsigned long long)(unsigned)p | ((unsigned long long)(unsigned)q << 32); }
        else { v4u o; o.x = pk2(s[0 * 33] * ga.x, s[1 * 33] * ga.y); o.y = pk2(s[2 * 33] * ga.z, s[3 * 33] * ga.w); o.z = pk2(s[4 * 33] * gb.x, s[5 * 33] * gb.y); o.w = pk2(s[6 * 33] * gb.z, s[7 * 33] * gb.w);
            *(GAS v4u*)(dst + (size_t)(drow0 + n) * dld + dk0 + k0 + 8 * c8) = o; } }
    LDS_WAIT(); asm volatile("" ::: "memory");
}
__device__ __forceinline__ void rmsnorm_rows_bf16(const GAS float* X, const GAS float* g, GAS bf16* O, int gw, int NGW, int lane) {
    f32x4 gv[8];
#pragma unroll
    for (int j = 0; j < 8; ++j) gv[j] = ((const GAS f32x4*)g)[lane + 64 * j];
    for (int m = gw; m < M; m += NGW) {
        const GAS f32x4* xr = (const GAS f32x4*)(X + (size_t)m * D) + lane;
        f32x4 v[8]; float s = 0.f;
#pragma unroll
        for (int j = 0; j < 8; ++j) { v[j] = xr[64 * j]; s += (v[j].x * v[j].x + v[j].y * v[j].y) + (v[j].z * v[j].z + v[j].w * v[j].w); }
        const float r = 1.0f / sqrtf(wave_sum(s, lane) * (1.0f / D) + EPS);
        GAS unsigned long long* o8 = (GAS unsigned long long*)(O + (size_t)m * D) + lane;
#pragma unroll
        for (int j = 0; j < 8; ++j) { const f32x4 y = v[j] * r * gv[j]; o8[64 * j] = (unsigned long long)pk2(y.x, y.y) | ((unsigned long long)pk2(y.z, y.w) << 32); }
    }
}
__device__ __forceinline__ void rows_bf16_ss(const GAS float* X, GAS bf16* O, GAS unsigned char* O8, GAS float* ss, int gw, int NGW, int lane) {
    for (int m = gw; m < M; m += NGW) {
        const GAS f32x4* xr = (const GAS f32x4*)(X + (size_t)m * D) + lane;
        f32x4 v[8]; float s = 0.f;
#pragma unroll
        for (int j = 0; j < 8; ++j) { v[j] = xr[64 * j]; s += (v[j].x * v[j].x + v[j].y * v[j].y) + (v[j].z * v[j].z + v[j].w * v[j].w); }
        s = wave_sum(s, lane);
        GAS unsigned long long* o8 = (GAS unsigned long long*)(O + (size_t)m * D) + lane;
#pragma unroll
        for (int j = 0; j < 8; ++j) o8[64 * j] = (unsigned long long)pk2(v[j].x, v[j].y) | ((unsigned long long)pk2(v[j].z, v[j].w) << 32);
        if (O8) { GAS unsigned* q8 = (GAS unsigned*)(O8 + (size_t)m * D) + lane;
#pragma unroll
            for (int j = 0; j < 8; ++j) { if constexpr (GU_I8) q8[64 * j] = pg8::pack4_i8(v[j].x, v[j].y, v[j].z, v[j].w, H8I_SCALE); else { int p = 0; p = __builtin_amdgcn_cvt_pk_fp8_f32(v[j].x, v[j].y, p, false); p = __builtin_amdgcn_cvt_pk_fp8_f32(v[j].z, v[j].w, p, true); q8[64 * j] = (unsigned)p; } } }
        if (lane < 32) ss[(size_t)m * 32 + lane] = lane == 0 ? s : 0.f;
    }
}
__device__ __forceinline__ void final_rows(const GAS bf16* HB, GAS float* OUT, const GAS float* g, const GAS float* ss, int gw, int NGW, int lane) {
    f32x4 gv[8];
#pragma unroll
    for (int j = 0; j < 8; ++j) gv[j] = ((const GAS f32x4*)g)[lane + 64 * j];
    for (int m = gw; m < M; m += NGW) {
        const GAS unsigned long long* hr = (const GAS unsigned long long*)(HB + (size_t)m * D) + lane; GAS f32x4* orow = (GAS f32x4*)(OUT + (size_t)m * D) + lane;
        unsigned long long raw[8];
#pragma unroll
        for (int j = 0; j < 8; ++j) raw[j] = hr[64 * j];
        const float r = 1.0f / sqrtf(wave_sum(lane < 32 ? ss[(size_t)m * 32 + lane] : 0.f, lane) * (1.0f / D) + EPS);
#pragma unroll
        for (int j = 0; j < 8; ++j) { const unsigned lo = (unsigned)raw[j], hi = (unsigned)(raw[j] >> 32);
            f32x4 v = {__builtin_bit_cast(float, lo << 16), __builtin_bit_cast(float, lo & 0xffff0000u), __builtin_bit_cast(float, hi << 16), __builtin_bit_cast(float, hi & 0xffff0000u)};
            orow[64 * j] = v * r * gv[j]; }
    }
}
__device__ __forceinline__ void rmsnorm_rows_f32_inplace(GAS float* X, const GAS float* g, int gw, int NGW, int lane) {
    f32x4 gv[8];
#pragma unroll
    for (int j = 0; j < 8; ++j) gv[j] = ((const GAS f32x4*)g)[lane + 64 * j];
    for (int m = gw; m < M; m += NGW) {
        GAS f32x4* xr = (GAS f32x4*)(X + (size_t)m * D) + lane;
        f32x4 v[8]; float s = 0.f;
#pragma unroll
        for (int j = 0; j < 8; ++j) { v[j] = xr[64 * j]; s += (v[j].x * v[j].x + v[j].y * v[j].y) + (v[j].z * v[j].z + v[j].w * v[j].w); }
        const float r = 1.0f / sqrtf(wave_sum(s, lane) * (1.0f / D) + EPS);
#pragma unroll
        for (int j = 0; j < 8; ++j) xr[64 * j] = v[j] * r * gv[j];
    }
}

template <bool P_IFAST, int OUT8 = 0>
__device__ __forceinline__ void absorb_unit(const GAS float* Psrc, size_t p_ri, size_t p_rd, const GAS float* Qsrc, size_t q_rj, GAS bf16* out, size_t out_ld, float scale, const GAS float* qgain, LAS float* Ps_, LAS float* Qs_, int tid) {
    LAS bf16* Ps = (LAS bf16*)Ps_; LAS bf16* Qs = Ps + 64 * 136;
    float pv[16], qv[16];
#pragma unroll
    for (int j = 0; j < 16; ++j) { const int e = tid + 512 * j; const int i = P_IFAST ? (e & 63) : (e >> 7), d = P_IFAST ? (e >> 6) : (e & 127);
        pv[j] = Psrc[(size_t)i * p_ri + (size_t)d * p_rd];
        const int jj = e >> 7, dd = e & 127; qv[j] = Qsrc[(size_t)jj * q_rj + dd] * (qgain ? qgain[jj] : 1.0f); }
#pragma unroll
    for (int j = 0; j < 16; ++j) { const int e = tid + 512 * j; const int i = P_IFAST ? (e & 63) : (e >> 7), d = P_IFAST ? (e >> 6) : (e & 127);
        Ps[i * 136 + d] = (bf16)f2bf(pv[j]); const int jj = e >> 7, dd = e & 127; Qs[jj * 136 + dd] = (bf16)f2bf(qv[j]); }
    __syncthreads();
    const int wv = tid >> 6, ln = tid & 63, it = wv >> 1, r16 = ln & 15, g = ln >> 4;
#pragma unroll
    for (int jq = 0; jq < 2; ++jq) { const int jt = 2 * (wv & 1) + jq; f32x4 acc = {0.f, 0.f, 0.f, 0.f};
#pragma unroll
        for (int st = 0; st < 4; ++st) { const bf16x8 a = *(const LAS bf16x8*)(Ps + (16 * it + r16) * 136 + 32 * st + 8 * g); const bf16x8 b = *(const LAS bf16x8*)(Qs + (16 * jt + r16) * 136 + 32 * st + 8 * g);
            acc = __builtin_amdgcn_mfma_f32_16x16x32_bf16(a, b, acc, 0, 0, 0); }
#pragma unroll
        for (int rg = 0; rg < 4; ++rg) { const size_t o = (size_t)(16 * it + 4 * g + rg) * out_ld + 16 * jt + r16;
            if constexpr (OUT8 == 2) ((GAS unsigned char*)out)[o] = (unsigned char)(pg8::pack4_i8(acc[rg], 0.f, 0.f, 0.f, scale) & 0xffu);
            else if constexpr (OUT8 == 1) ((GAS unsigned char*)out)[o] = (unsigned char)__builtin_amdgcn_cvt_pk_fp8_f32(acc[rg] * scale, 0.f, 0, false);
            else out[o] = (bf16)f2bf(acc[rg] * scale); } }
    __syncthreads();
}
__device__ __forceinline__ void post_rows(const GAS bf16* Z, const GAS float* gkv, const GAS float* gki, const GAS float* bki, GAS bf16* CKVN, GAS bf16* KIN, GAS float* WIF, int gw, int NGW, int lane) {
    const f32x4 g4 = ((const GAS f32x4*)gkv)[lane]; const float gk = gki[lane], bk = bki[lane];
    for (int m = gw; m < M; m += NGW) {
        const GAS bf16* zr = Z + (size_t)m * ZLD;
        const unsigned long long raw = *(const GAS unsigned long long*)(zr + ZC_CKV + 4 * lane);
        const float kraw = bf2f(zr[ZC_KI + lane]);
        const float wraw = bf2f(zr[ZC_WI + (lane & 7)]);
        const float c0 = bf2f((unsigned short)raw), c1 = bf2f((unsigned short)(raw >> 16)), c2 = bf2f((unsigned short)(raw >> 32)), c3 = bf2f((unsigned short)(raw >> 48));
        const float r = 1.0f / sqrtf(wave_sum((c0 * c0 + c1 * c1) + (c2 * c2 + c3 * c3), lane) * (1.0f / RANK) + EPS);
        *(GAS unsigned long long*)(CKVN + (size_t)m * RANK + 4 * lane) = (unsigned long long)pk2(c0 * r * g4.x, c1 * r * g4.y) | ((unsigned long long)pk2(c2 * r * g4.z, c3 * r * g4.w) << 32);
        const float mu = wave_sum(kraw, lane) * (1.0f / IDIM); const float dv = kraw - mu;
        const float var = wave_sum(dv * dv, lane) * (1.0f / IDIM);
        KIN[(size_t)m * IDIM + lane] = (bf16)f2bf(dv * (1.0f / sqrtf(var + EPS)) * gk + bk);
        if (lane < 8) WIF[(size_t)m * IH + lane] = wraw;
    }
}
constexpr int SWA_KP = 144, SWA_VP = 192;
constexpr int SWA_K_OFF = 0, SWA_V_OFF = 160 * SWA_KP, SWA_TAB_OFF = SWA_V_OFF + 160 * SWA_VP;
static_assert(SWA_TAB_OFF + 16 * 128 * 4 <= RING_BYTES, "SWA LDS map");
__device__ __forceinline__ void swa_phase(LAS unsigned char* lds, const GAS bf16* Z, GAS bf16* O, const GAS float* rel_bias, const GAS float* sinks, int vcu, int G, int tid, int lane, int wave) {
    LAS float* tab = (LAS float*)(lds + SWA_TAB_OFF);
    for (int e = tid; e < 16 * 128; e += NWAVES * 64) { const int h = e >> 7, dist = e & 127; tab[e] = rel_bias[(int)T5_BUCKET[dist] * 24 + H_A + h]; }
    __syncthreads();
    const int q = lane & 31, hh = lane >> 5;
    const unsigned ldsb = (unsigned)(size_t)lds;
    for (int item = vcu; item < BATCH * 128 * KVH; item += G) {
        const int kvh = item & 1, qt = (item >> 1) & 127, b = item >> 8;
        const int t0 = 32 * qt, s0 = t0 - 128;
        const size_t rowbase = (size_t)b * SEQ;
        for (int c = tid; c < 1280; c += NWAVES * 64) { const int row = c >> 3, ch = c & 7; const int s = s0 + row;
            if (s >= 0) { const GAS bf16* zr = Z + (rowbase + s) * ZLD + kvh * 64 + ch * 8;
                const v4u kv = *(const GAS v4u*)(zr + ZC_KB); const v4u vv = *(const GAS v4u*)(zr + ZC_VB);
                *(LAS v4u*)(lds + SWA_K_OFF + row * SWA_KP + ch * 16) = kv; *(LAS v4u*)(lds + SWA_V_OFF + row * SWA_VP + ch * 16) = vv; } }
        const int hq = kvh * 8 + wave; const int t = t0 + q;
        bf16x8 qf[4];
#pragma unroll
        for (int st = 0; st < 4; ++st) qf[st] = *(const GAS bf16x8*)(Z + (rowbase + t) * ZLD + ZC_QB + hq * 64 + 16 * st + 8 * hh);
        __syncthreads();
        const int kt0 = qt >= 4 ? 0 : 4 - qt;
        f32x16 sacc[5];
#pragma unroll
        for (int kt = 0; kt < 5; ++kt) {
#pragma unroll
            for (int r = 0; r < 16; ++r) sacc[kt][r] = 0.f;
            if (kt >= kt0) {
#pragma unroll
                for (int st = 0; st < 4; ++st) { const bf16x8 kf = *(const LAS bf16x8*)(lds + SWA_K_OFF + (kt * 32 + q) * SWA_KP + (2 * st + hh) * 16);
                    sacc[kt] = __builtin_amdgcn_mfma_f32_32x32x16_bf16(kf, qf[st], sacc[kt], 0, 0, 0); } } }
        const float sink = sinks[hq]; float mx = sink;
        const LAS float* tabh = tab + hq * 128;
#pragma unroll
        for (int kt = 0; kt < 5; ++kt) if (kt >= kt0) {
#pragma unroll
            for (int r = 0; r < 16; ++r) { const int ko = (r & 3) + 8 * (r >> 2) + 4 * hh; const int dist = q + 128 - 32 * kt - ko;
                const float lg = (dist >= 0 && dist < WINDOW) ? sacc[kt][r] + tabh[dist & 127] : -1e30f; sacc[kt][r] = lg; mx = fmaxf(mx, lg); } }
        mx = fmaxf(mx, SHX(mx, 32));
        float l = 0.f;
#pragma unroll
        for (int kt = 0; kt < 5; ++kt) if (kt >= kt0) {
#pragma unroll
            for (int r = 0; r < 16; ++r) { const float p = __expf(sacc[kt][r] - mx); sacc[kt][r] = p; l += p; } }
        l += SHX(l, 32); l += __expf(sink - mx);
        f32x16 oacc[2];
#pragma unroll
        for (int dt = 0; dt < 2; ++dt)
#pragma unroll
            for (int r = 0; r < 16; ++r) oacc[dt][r] = 0.f;
        const unsigned vlane = ldsb + SWA_V_OFF + (unsigned)((4 * hh + ((lane & 15) >> 2)) * SWA_VP + (16 * ((lane >> 4) & 1) + 4 * (lane & 3)) * 2);
#pragma unroll
        for (int kt = 0; kt < 5; ++kt) if (kt >= kt0) {
#pragma unroll
            for (int s2 = 0; s2 < 2; ++s2) {
                bf16x8 pf; { const unsigned w0 = pg8::cvt_pk_bf16(sacc[kt][8 * s2 + 0], sacc[kt][8 * s2 + 1]), w1 = pg8::cvt_pk_bf16(sacc[kt][8 * s2 + 2], sacc[kt][8 * s2 + 3]),
                                     w2 = pg8::cvt_pk_bf16(sacc[kt][8 * s2 + 4], sacc[kt][8 * s2 + 5]), w3 = pg8::cvt_pk_bf16(sacc[kt][8 * s2 + 6], sacc[kt][8 * s2 + 7]);
                    const v4u w = {w0, w1, w2, w3}; pf = __builtin_bit_cast(bf16x8, w); }
                const unsigned a = vlane + (unsigned)((kt * 32 + 16 * s2) * SWA_VP);
                s16x4 r0, r1, r2, r3; tr_read4(a, a + 8 * SWA_VP, a + 64, a + 8 * SWA_VP + 64, r0, r1, r2, r3);
                oacc[0] = __builtin_amdgcn_mfma_f32_32x32x16_bf16(cat4(r0, r1), pf, oacc[0], 0, 0, 0);
                oacc[1] = __builtin_amdgcn_mfma_f32_32x32x16_bf16(cat4(r2, r3), pf, oacc[1], 0, 0, 0); } }
        const float inv = (OUT_F8 ? O8_SCALE : 1.0f) / l;
        if constexpr (OUT_F8) { GAS unsigned char* orow = (GAS unsigned char*)O + (rowbase + t) * OLD + 2048 + hq * 64 + 4 * hh;
#pragma unroll
            for (int dt = 0; dt < 2; ++dt)
#pragma unroll
                for (int g4 = 0; g4 < 4; ++g4) { int p = 0; p = __builtin_amdgcn_cvt_pk_fp8_f32(oacc[dt][4 * g4] * inv, oacc[dt][4 * g4 + 1] * inv, p, false); p = __builtin_amdgcn_cvt_pk_fp8_f32(oacc[dt][4 * g4 + 2] * inv, oacc[dt][4 * g4 + 3] * inv, p, true);
                    *(GAS unsigned*)(orow + 32 * dt + 8 * g4) = (unsigned)p; } }
        else { GAS bf16* orow = O + (rowbase + t) * OLD + 2048 + hq * 64 + 4 * hh;
#pragma unroll
        for (int dt = 0; dt < 2; ++dt)
#pragma unroll
            for (int g4 = 0; g4 < 4; ++g4) { const unsigned long long w = (unsigned long long)pk2(oacc[dt][4 * g4] * inv, oacc[dt][4 * g4 + 1] * inv) | ((unsigned long long)pk2(oacc[dt][4 * g4 + 2] * inv, oacc[dt][4 * g4 + 3] * inv) << 32);
                *(GAS unsigned long long*)(orow + 32 * dt + 8 * g4) = w; } }
        __syncthreads();
    }
}
constexpr int TK_BINS = 512, TK_CAP = 256;
#define LDS_ADD(p) __hip_atomic_fetch_add((p), 1u, __ATOMIC_RELAXED, __HIP_MEMORY_SCOPE_WORKGROUP)
#define LDS_ADDV(p, v) __hip_atomic_fetch_add((p), (v), __ATOMIC_RELAXED, __HIP_MEMORY_SCOPE_WORKGROUP)
#define HIST_WORD(tok, bin) (((tok) * TK_BINS + (bin)) >> 1)
#define HIST_INC(bin) (1u << (((bin) & 1) * 16))
constexpr int TK_HIST_OFF = 0, TK_CSC_OFF = 32768, TK_CIX_OFF = TK_CSC_OFF + 32 * TK_CAP * 4, TK_SEL_OFF = TK_CIX_OFF + 32 * TK_CAP * 2, TK_CNT_OFF = TK_SEL_OFF + 32 * 256 * 2, TK_DUM_OFF = TK_CNT_OFF + 32 * 2 * 4, TK_KB_OFF = TK_DUM_OFF + 8 * 64 * 4, TK_KB_BYTES = 64 * 144, TK_FLAG_OFF = TK_KB_OFF + 2 * TK_KB_BYTES;
static_assert(TK_FLAG_OFF + 16 <= RING_BYTES, "top-k LDS map");
typedef _Float16 tk_h2 __attribute__((ext_vector_type(2)));
__device__ __forceinline__ void tk_score2(const f32x16& acc, const tk_h2 (&wh)[8], float& s0, float& s1) {
    tk_h2 s = {(_Float16)0, (_Float16)0}; const tk_h2 zero = {(_Float16)0, (_Float16)0};
#pragma unroll
    for (int h = 0; h < 8; ++h) { tk_h2 d = __builtin_bit_cast(tk_h2, __builtin_amdgcn_cvt_pkrtz(acc[h], acc[8 + h])); d = __builtin_elementwise_max(d, zero); s = __builtin_elementwise_fma(wh[h], d, s); }
    s0 = (float)s.x; s1 = (float)s.y;
}
__device__ __forceinline__ float tk_x(float s, float sc) { return fmaf(s, sc, 256.0f); }
__device__ __forceinline__ int tk_key(float s, float sc) {
    const float x = tk_x(s, sc); int b0 = (int)x; b0 = b0 < 0 ? 0 : (b0 > TK_BINS - 1 ? TK_BINS - 1 : b0);
    int sub = (int)((x - (float)b0) * 512.0f); sub = sub < 0 ? 0 : (sub > 511 ? 511 : sub);
    return b0 * 512 + sub;
}
__device__ __forceinline__ void tk_find(const LAS unsigned* h, unsigned need, int lane, int& bin_out, unsigned& above_out) {
    unsigned v[8]; unsigned s = 0;
#pragma unroll
    for (int i = 0; i < 4; ++i) { const unsigned w = h[4 * lane + i]; v[2 * i] = w & 0xffffu; v[2 * i + 1] = w >> 16; s += v[2 * i] + v[2 * i + 1]; }
    unsigned S = s;
#pragma unroll
    for (int o = 1; o < 64; o <<= 1) { const unsigned t = (unsigned)__builtin_amdgcn_ds_bpermute((lane + o) << 2, (int)S); if (lane + o < 64) S += t; }
    const unsigned long long mask = __ballot(S >= need);
    const int Lm = mask ? 63 - __builtin_clzll(mask) : 0;
    unsigned cum = S - s; int bsel = 8 * lane; unsigned ab = cum; bool found = false;
#pragma unroll
    for (int i = 7; i >= 0; --i) { if (!found) { if (cum + v[i] >= need) { bsel = 8 * lane + i; ab = cum; found = true; } else cum += v[i]; } }
    bin_out = __builtin_amdgcn_readlane(bsel, Lm); above_out = (unsigned)__builtin_amdgcn_readlane((int)ab, Lm);
}
__device__ __forceinline__ void topk_phase(LAS unsigned char* lds, const GAS bf16* Z, const GAS bf16* KIN, const GAS float* WIF, GAS unsigned short* IDX, int vcu, int G, int lane, int wave) {
    LAS unsigned* hist = (LAS unsigned*)(lds + TK_HIST_OFF) + wave * 4 * (TK_BINS / 2);
    LAS float* csc = (LAS float*)(lds + TK_CSC_OFF) + wave * 4 * TK_CAP;
    LAS unsigned short* cix = (LAS unsigned short*)(lds + TK_CIX_OFF) + wave * 4 * TK_CAP;
    LAS unsigned short* sel = (LAS unsigned short*)(lds + TK_SEL_OFF) + wave * 4 * 256;
    LAS unsigned* cnt = (LAS unsigned*)(lds + TK_CNT_OFF) + wave * 8;
    LAS unsigned* dum = (LAS unsigned*)(lds + TK_DUM_OFF) + wave * 64 + lane;
    const int n = lane & 31, c = lane >> 5;
    const int am = (lane >> 4) & 1, bbm = (lane >> 3) & 1, ccm = (lane >> 2) & 1, dm = lane & 3;
    for (int p2 = vcu; p2 < BATCH * 64; p2 += G) {
#pragma unroll 1
        for (int half = 0; half < 2; ++half) {
            const int b = p2 >> 6, jj = p2 & 63, j = half ? 127 - jj : jj;
            const int t0 = 32 * j + 4 * wave; const size_t rb = (size_t)b * SEQ;
            bf16x8 qa[4];
#pragma unroll
            for (int st = 0; st < 4; ++st) qa[st] = *(const GAS bf16x8*)(Z + (rb + t0 + 2 * ccm + am) * ZLD + ZC_QI + (4 * bbm + dm) * 64 + 16 * st + 8 * c);
            float w0[8], w1[8];
            { const GAS f32x4* wp = (const GAS f32x4*)(WIF + (rb + t0 + 2 * c) * IH); const f32x4 x0 = wp[0], x1 = wp[1], x2 = wp[2], x3 = wp[3];
              w0[0] = x0.x; w0[1] = x0.y; w0[2] = x0.z; w0[3] = x0.w; w0[4] = x1.x; w0[5] = x1.y; w0[6] = x1.z; w0[7] = x1.w;
              w1[0] = x2.x; w1[1] = x2.y; w1[2] = x2.z; w1[3] = x2.w; w1[4] = x3.x; w1[5] = x3.y; w1[6] = x3.z; w1[7] = x3.w; }
            tk_h2 wh[8];
#pragma unroll
            for (int h = 0; h < 8; ++h) { wh[h].x = (_Float16)w0[h]; wh[h].y = (_Float16)w1[h]; }
            float scA, scB;
            { float a = 0.f, bq = 0.f;
#pragma unroll
              for (int h = 0; h < 8; ++h) { a = fmaf(w0[h], w0[h], a); bq = fmaf(w1[h], w1[h], bq); }
              scA = 32.0f / fmaxf(sqrtf(32.0f * a), 1e-20f); scB = 32.0f / fmaxf(sqrtf(32.0f * bq), 1e-20f); }
            const int tA = t0 + 2 * c, tB = tA + 1;
            for (int i = lane; i < 4 * (TK_BINS / 2); i += 64) hist[i] = 0u;
            for (int i = lane; i < 4 * 128; i += 64) ((LAS unsigned*)sel)[i] = 0u;
            if (lane < 8) cnt[lane] = 0u;
            asm volatile("s_waitcnt lgkmcnt(0)" ::: "memory");
            int lo[4], hi[4]; unsigned ab0[4]; bool ov[4];
#pragma unroll
            for (int tk = 0; tk < 4; ++tk) { lo[tk] = 0x7fffffff; hi[tk] = -1; ab0[tk] = 0u; ov[tk] = false; }
            const bool need_sel = (t0 + 3) >= TOPK;
            const GAS bf16* kbase = KIN + (rb + n) * IDIM + 8 * c;
            const int tidk = wave * 64 + lane; const int ng = (j + 2) >> 1;
            const GAS bf16* kg0 = KIN + (rb + (tidk >> 3)) * IDIM + (tidk & 7) * 8; const int koff = (tidk >> 3) * 144 + (tidk & 7) * 16;
            LAS unsigned char* kbuf = lds + TK_KB_OFF; volatile LAS unsigned* sflag = (volatile LAS unsigned*)(lds + TK_FLAG_OFF);
            if (tidk == 0) *sflag = 0u;
#define TK_PRIME() { const v4u kr0 = *(const GAS v4u*)kg0; *(LAS v4u*)(kbuf + koff) = kr0; } __syncthreads();
#define TK_GROUP_BEGIN() \
                v4u kr = {0u, 0u, 0u, 0u}; const bool more = g + 1 < ng; \
                if (more) kr = *(const GAS v4u*)(kg0 + (size_t)(g + 1) * 64 * IDIM); \
                const LAS unsigned char* kb_ = kbuf + (g & 1) * TK_KB_BYTES; \
                float s0v[2], s1v[2];     \
                { f32x16 accv[2]; \
                  _Pragma("unroll") for (int u4 = 0; u4 < 2; ++u4) { _Pragma("unroll") for (int r = 0; r < 16; ++r) accv[u4][r] = 0.f; \
                    _Pragma("unroll") for (int st = 0; st < 4; ++st) { const bf16x8 kf = *(const LAS bf16x8*)(kb_ + (32 * u4 + n) * 144 + (2 * st + c) * 16); accv[u4] = __builtin_amdgcn_mfma_f32_32x32x16_bf16(qa[st], kf, accv[u4], 0, 0, 0); } } \
                  _Pragma("unroll") for (int u4 = 0; u4 < 2; ++u4) tk_score2(accv[u4], wh, s0v[u4], s1v[u4]); } \
                _Pragma("unroll") for (int u4 = 0; u4 < 2; ++u4) { \
                    const float s0 = s0v[u4], s1 = s1v[u4]; const int s = 32 * (2 * g + u4) + n;
#define TK_GROUP_END() } \
                if (more) *(LAS v4u*)(kbuf + ((g + 1) & 1) * TK_KB_BYTES + koff) = kr; \
                __syncthreads();
            bool slow = false;
            if (need_sel) {
                {   TK_PRIME();
#pragma unroll 1
                    for (int g = 0; g < ng; ++g) { TK_GROUP_BEGIN()
                        int b0 = (int)tk_x(s0, scA), b1 = (int)tk_x(s1, scB); b0 = b0 < 0 ? 0 : (b0 > TK_BINS - 1 ? TK_BINS - 1 : b0); b1 = b1 < 0 ? 0 : (b1 > TK_BINS - 1 ? TK_BINS - 1 : b1);
                        LAS unsigned* p0 = (s <= tA) ? &hist[HIST_WORD(2 * c, b0)] : dum; LAS unsigned* p1 = (s <= tB) ? &hist[HIST_WORD(2 * c + 1, b1)] : dum;
                        LDS_ADDV(p0, HIST_INC(b0)); LDS_ADDV(p1, HIST_INC(b1));
                        TK_GROUP_END() }
                }
                asm volatile("s_waitcnt lgkmcnt(0)" ::: "memory");
#pragma unroll
                for (int tk = 0; tk < 4; ++tk) { int bin; unsigned above; tk_find(hist + tk * (TK_BINS / 2), (unsigned)TOPK, lane, bin, above);
                    const unsigned ceq = (hist[HIST_WORD(tk, bin)] >> ((bin & 1) * 16)) & 0xffffu; ov[tk] = ceq > (unsigned)TK_CAP; slow |= ov[tk]; ab0[tk] = above; lo[tk] = bin * 512; hi[tk] = bin * 512 + 511; }
                if (slow && lane == 0) *sflag = 1u;
                __syncthreads();
                slow = *sflag != 0u;
            }
            if (!slow) {
                float thi[4], tlo[4];
#pragma unroll
                for (int tk = 0; tk < 4; ++tk) { const int bin = lo[tk] >> 9;
                    thi[tk] = !need_sel ? -__builtin_inff() : (bin >= TK_BINS - 1 ? __builtin_inff() : (float)(bin + 1));
                    tlo[tk] = !need_sel ? __builtin_inff() : (bin == 0 ? -__builtin_inff() : (float)bin); }
                const float thiA = c ? thi[2] : thi[0], tloA = c ? tlo[2] : tlo[0], thiB = c ? thi[3] : thi[1], tloB = c ? tlo[3] : tlo[1];
                unsigned cntA = 0u, cntB = 0u;
                LAS unsigned short* selA = sel + (2 * c) * 256; LAS unsigned short* selB = sel + (2 * c + 1) * 256; LAS unsigned short* dum16 = (LAS unsigned short*)dum;
                TK_PRIME();
#pragma unroll 1
                for (int g = 0; g < ng; ++g) { TK_GROUP_BEGIN()
                    const float x0 = (s <= tA) ? tk_x(s0, scA) : __builtin_nanf(""), x1 = (s <= tB) ? tk_x(s1, scB) : __builtin_nanf("");
                    const bool a0 = x0 >= thiA, a1 = x1 >= thiB; const bool c0 = !a0 && x0 >= tloA, c1 = !a1 && x1 >= tloB;
                    const unsigned long long m0 = __ballot(a0), m1 = __ballot(a1);
                    const unsigned pre0 = c ? __builtin_amdgcn_mbcnt_hi((unsigned)(m0 >> 32), 0u) : __builtin_amdgcn_mbcnt_lo((unsigned)m0, 0u);
                    const unsigned pre1 = c ? __builtin_amdgcn_mbcnt_hi((unsigned)(m1 >> 32), 0u) : __builtin_amdgcn_mbcnt_lo((unsigned)m1, 0u);
                    const unsigned pos0 = cntA + pre0, pos1 = cntB + pre1;
                    LAS unsigned short* q0 = (a0 && pos0 < 256u) ? selA + pos0 : dum16; LAS unsigned short* q1 = (a1 && pos1 < 256u) ? selB + pos1 : dum16;
                    *q0 = (unsigned short)s; *q1 = (unsigned short)s;
                    cntA += c ? (unsigned)__builtin_popcount((unsigned)(m0 >> 32)) : (unsigned)__builtin_popcount((unsigned)m0);
                    cntB += c ? (unsigned)__builtin_popcount((unsigned)(m1 >> 32)) : (unsigned)__builtin_popcount((unsigned)m1);
                    if (__ballot(c0 || c1)) {
                        if (c0) { const unsigned pos = LDS_ADD(&cnt[(2 * c) * 2 + 1]); if (pos < (unsigned)TK_CAP) { csc[(2 * c) * TK_CAP + pos] = s0; cix[(2 * c) * TK_CAP + pos] = (unsigned short)s; } }
                        if (c1) { const unsigned pos = LDS_ADD(&cnt[(2 * c + 1) * 2 + 1]); if (pos < (unsigned)TK_CAP) { csc[(2 * c + 1) * TK_CAP + pos] = s1; cix[(2 * c + 1) * TK_CAP + pos] = (unsigned short)s; } } }
                    TK_GROUP_END() }
                if ((lane & 31) == 0) { cnt[(2 * c) * 2] = cntA; cnt[(2 * c + 1) * 2] = cntB; }
                asm volatile("s_waitcnt lgkmcnt(0)" ::: "memory");
            } else {
                for (int i = lane; i < 4 * (TK_BINS / 2); i += 64) hist[i] = 0u;
                asm volatile("s_waitcnt lgkmcnt(0)" ::: "memory");
                int mode = 1;
#pragma unroll 1
                for (;;) {
                const int klo0 = c ? lo[2] : lo[0], khi0 = c ? hi[2] : hi[0], klo1 = c ? lo[3] : lo[1], khi1 = c ? hi[3] : hi[1];
                const bool ov0 = c ? ov[2] : ov[0], ov1 = c ? ov[3] : ov[1];
                bf16x8 kb[4][4];
#pragma unroll
                for (int u4 = 0; u4 < 4; ++u4) { const int kq = u4 < j ? u4 : j;
#pragma unroll
                    for (int st = 0; st < 4; ++st) kb[u4][st] = *(const GAS bf16x8*)(kbase + (size_t)kq * 32 * IDIM + 16 * st); }
#pragma unroll 1
                for (int kt = 0; kt <= j; kt += 4) {
                    bf16x8 kn[4][4];
#pragma unroll
                    for (int u4 = 0; u4 < 4; ++u4) { const int kq = kt + 4 + u4 < j ? kt + 4 + u4 : j;
#pragma unroll
                        for (int st = 0; st < 4; ++st) kn[u4][st] = *(const GAS bf16x8*)(kbase + (size_t)kq * 32 * IDIM + 16 * st); }
#pragma unroll
                    for (int u4 = 0; u4 < 4; ++u4) {
                        f32x16 acc;
#pragma unroll
                        for (int r = 0; r < 16; ++r) acc[r] = 0.f;
#pragma unroll
                        for (int st = 0; st < 4; ++st) acc = __builtin_amdgcn_mfma_f32_32x32x16_bf16(qa[st], kb[u4][st], acc, 0, 0, 0);
                        float s0, s1; tk_score2(acc, wh, s0, s1);
                        const int s = 32 * (kt + u4) + n; const int k0 = tk_key(s0, scA), k1 = tk_key(s1, scB);
                        const bool v0 = s <= tA, v1 = s <= tB;
                        if (mode == 0) {
                            if (v0 && tA >= TOPK) LDS_ADDV(&hist[HIST_WORD(2 * c, k0 >> 9)], HIST_INC(k0 >> 9));
                            if (v1 && tB >= TOPK) LDS_ADDV(&hist[HIST_WORD(2 * c + 1, k1 >> 9)], HIST_INC(k1 >> 9));
                        } else if (mode == 1) {
                            if (v0 && ov0 && k0 >= klo0 && k0 <= khi0) LDS_ADDV(&hist[HIST_WORD(2 * c, k0 & 511)], HIST_INC(k0 & 511));
                            if (v1 && ov1 && k1 >= klo1 && k1 <= khi1) LDS_ADDV(&hist[HIST_WORD(2 * c + 1, k1 & 511)], HIST_INC(k1 & 511));
                        } else {
                            if (v0) { if (k0 > khi0) { const unsigned pos = LDS_ADD(&cnt[(2 * c) * 2]); if (pos < 256u) sel[(2 * c) * 256 + pos] = (unsigned short)s; }
                                      else if (k0 >= klo0) { const unsigned pos = LDS_ADD(&cnt[(2 * c) * 2 + 1]); if (pos < (unsigned)TK_CAP) { csc[(2 * c) * TK_CAP + pos] = s0; cix[(2 * c) * TK_CAP + pos] = (unsigned short)s; } } }
                            if (v1) { if (k1 > khi1) { const unsigned pos = LDS_ADD(&cnt[(2 * c + 1) * 2]); if (pos < 256u) sel[(2 * c + 1) * 256 + pos] = (unsigned short)s; }
                                      else if (k1 >= klo1) { const unsigned pos = LDS_ADD(&cnt[(2 * c + 1) * 2 + 1]); if (pos < (unsigned)TK_CAP) { csc[(2 * c + 1) * TK_CAP + pos] = s1; cix[(2 * c + 1) * TK_CAP + pos] = (unsigned short)s; } } }
                        }
                    }
#pragma unroll
                    for (int u4 = 0; u4 < 4; ++u4)
#pragma unroll
                        for (int st = 0; st < 4; ++st) kb[u4][st] = kn[u4][st];
                }
                    asm volatile("s_waitcnt lgkmcnt(0)" ::: "memory");
                    if (mode == 2) break;
#pragma unroll
                    for (int tk = 0; tk < 4; ++tk) if (ov[tk]) { int sub; unsigned above; tk_find(hist + tk * (TK_BINS / 2), (unsigned)TOPK - ab0[tk], lane, sub, above); lo[tk] += sub; hi[tk] = lo[tk]; }
                    mode = 2;
                }
            }
#undef TK_GROUP_BEGIN
#undef TK_GROUP_END
#undef TK_PRIME
#pragma unroll 1
            for (int tk = 0; tk < 4; ++tk) { const int t = t0 + tk;
                if (t >= TOPK) { const unsigned nsel = cnt[tk * 2]; unsigned nc = cnt[tk * 2 + 1]; nc = nc > (unsigned)TK_CAP ? (unsigned)TK_CAP : nc; const unsigned need = nsel < 256u ? 256u - nsel : 0u;
                    for (unsigned q = 0; q * 64 < nc; ++q) { const unsigned i = lane + 64 * q;
                        const float si = i < nc ? csc[tk * TK_CAP + i] : 0.f; const unsigned xi = i < nc ? cix[tk * TK_CAP + i] : 0u; unsigned rank = 0;
                        for (unsigned jx = 0; jx < nc; ++jx) { const float sj = csc[tk * TK_CAP + jx]; const unsigned xj = cix[tk * TK_CAP + jx]; rank += (sj > si || (sj == si && xj < xi)) ? 1u : 0u; }
                        if (i < nc && rank < need) sel[tk * 256 + nsel + rank] = (unsigned short)xi; } } }
            asm volatile("s_waitcnt lgkmcnt(0)" ::: "memory");
            { const LAS v4u* sv = (const LAS v4u*)sel; GAS v4u* ov = (GAS v4u*)(IDX + (rb + t0) * TOPK);
              ov[lane] = sv[lane]; ov[lane + 64] = sv[lane + 64]; }
            asm volatile("s_waitcnt vmcnt(0) lgkmcnt(0)" ::: "memory");
        }
    }
}
constexpr int DSA_TAB_OFF = RING_BYTES + 1024;
static_assert(DSA_TAB_OFF + 8 * 129 * 4 <= LDS_BYTES, "DSA LDS map");
__device__ __forceinline__ void dsa_phase(LAS unsigned char* lds_all, const GAS bf16* Z, const GAS bf16* CKVN, const GAS unsigned short* IDX, GAS bf16* O, const GAS float* rel_bias, int gw, int NGW, int tid, int lane, int wave) {
    LAS float* tab = (LAS float*)(lds_all + DSA_TAB_OFF);
    for (int e = tid; e < 8 * 129; e += NWAVES * 64) { const int hh = e / 129, dist = e - hh * 129; tab[e] = rel_bias[(dist < 128 ? (int)T5_BUCKET[dist] : 31) * 24 + hh]; }
    __syncthreads();
    LAS unsigned char* img = lds_all + RING_OFF + wave * 16384;
    const unsigned imgb = (unsigned)(size_t)img;
    const int h = lane & 15, g = lane >> 4;
    const LAS float* tabh = tab + (h & 7) * 129;
    const int TPW = (M + NGW - 1) / NGW;
    const int tok_end = (gw + 1) * TPW < M ? (gw + 1) * TPW : M;
    const int xq = 2 * (lane & 7);
    const int qk_off = (lane & 15) * 512;
    const int q4 = (lane & 15) >> 2, p4 = lane & 3; const int xr = 2 * (4 * (g & 1) + q4);
    const unsigned pv_base = imgb + (unsigned)((4 * g + q4) * 512 + 8 * (p4 & 1));
#pragma unroll 1
    for (int tok = gw * TPW; tok < tok_end; ++tok) {
        const int t = tok & (SEQ - 1); const size_t rb = (size_t)(tok - t);
        const int nsel = t + 1 < TOPK ? t + 1 : TOPK;
        bf16x8 qf[8];
#pragma unroll
        for (int st = 0; st < 8; ++st) { qf[st] = *(const GAS bf16x8*)(Z + (size_t)tok * ZLD + ZC_QLAT + (h & 7) * 256 + 32 * st + 8 * g); if (h >= 8) qf[st] = (bf16x8){0, 0, 0, 0, 0, 0, 0, 0}; }
        f32x4 oacc[16];
#pragma unroll
        for (int rt = 0; rt < 16; ++rt) oacc[rt] = (f32x4){0.f, 0.f, 0.f, 0.f};
        float mrun = -1e30f, lsum = 0.f;
        const GAS unsigned short* ip = IDX + (size_t)tok * TOPK;
        int ixa[8];
#pragma unroll
        for (int ch = 0; ch < 8; ++ch) ixa[ch] = (int)ip[32 * ch + (lane & 31)];
        unsigned long long i0n = *(const GAS unsigned long long*)(ip + 4 * g), i1n = *(const GAS unsigned long long*)(ip + 16 + 4 * g);
#pragma unroll
        for (int ch = 0; ch < 8; ++ch) {
            if (32 * ch >= nsel) break;
            const int ixv = ixa[ch];
            const unsigned long long i0 = i0n, i1 = i1n;
            if (ch < 7) { i0n = *(const GAS unsigned long long*)(ip + 32 * (ch + 1) + 4 * g); i1n = *(const GAS unsigned long long*)(ip + 32 * (ch + 1) + 16 + 4 * g); }
            asm volatile("s_waitcnt lgkmcnt(0)" ::: "memory");
#pragma unroll
            for (int i = 0; i < 16; ++i) { const int r0 = __builtin_amdgcn_readlane(ixv, 2 * i), r1 = __builtin_amdgcn_readlane(ixv, 2 * i + 1);
                const int row = 2 * i + (lane >> 5); const int ridx = lane < 32 ? r0 : r1; const int chunk = (lane & 31) ^ (2 * (row & 7));
                const GAS unsigned char* src = (const GAS unsigned char*)(CKVN + (rb + ridx) * RANK) + chunk * 16;
                __builtin_amdgcn_global_load_lds((const GAS unsigned*)src, (LAS unsigned*)(img + i * 1024), 16, 0, 0); }
            asm volatile("s_waitcnt vmcnt(0)" ::: "memory");
            f32x4 sa[2];
#pragma unroll
            for (int tl = 0; tl < 2; ++tl) { sa[tl] = (f32x4){0.f, 0.f, 0.f, 0.f};
#pragma unroll
                for (int st = 0; st < 8; ++st) { const bf16x8 a = *(const LAS bf16x8*)(img + qk_off + tl * 16 * 512 + (((4 * st + g) ^ xq) * 16));
                    sa[tl] = __builtin_amdgcn_mfma_f32_16x16x32_bf16(a, qf[st], sa[tl], 0, 0, 0); } }
            float lg[8]; float cmax = -1e30f;
#pragma unroll
            for (int e = 0; e < 8; ++e) { const int tl = e >> 2, jx = e & 3; const int kk = 32 * ch + 16 * tl + 4 * g + jx;
                const int sidx = (int)(((tl ? i1 : i0) >> (16 * jx)) & 0xffffull); int dd = t - sidx; dd = dd < 0 ? 0 : (dd > 128 ? 128 : dd);
                const float v = kk < nsel ? sa[tl][jx] + tabh[dd] : -1e30f; lg[e] = v; cmax = fmaxf(cmax, v); }
            cmax = fmaxf(cmax, SHX(cmax, 16)); cmax = fmaxf(cmax, SHX(cmax, 32));
            const float mnew = fmaxf(mrun, cmax);
            if (__any(mnew > mrun)) { const float alpha = __expf(mrun - mnew); lsum *= alpha;
#pragma unroll
                for (int rt = 0; rt < 16; ++rt) oacc[rt] = oacc[rt] * alpha; }
            mrun = mnew;
            float pe[8];
#pragma unroll
            for (int e = 0; e < 8; ++e) { pe[e] = __expf(lg[e] - mnew); lsum += pe[e]; }
            bf16x8 pf; { const v4u wv = {pg8::cvt_pk_bf16(pe[0], pe[1]), pg8::cvt_pk_bf16(pe[2], pe[3]), pg8::cvt_pk_bf16(pe[4], pe[5]), pg8::cvt_pk_bf16(pe[6], pe[7])}; pf = __builtin_bit_cast(bf16x8, wv); }
#pragma unroll
            for (int rt = 0; rt < 16; rt += 2) {
                const unsigned a0 = pv_base + (unsigned)((((2 * rt) ^ xr) | (p4 >> 1)) * 16), a1 = pv_base + (unsigned)((((2 * rt + 2) ^ xr) | (p4 >> 1)) * 16);
                s16x4 r0, r1, r2, r3; tr_read4(a0, a0 + 16 * 512, a1, a1 + 16 * 512, r0, r1, r2, r3);
                oacc[rt] = __builtin_amdgcn_mfma_f32_16x16x32_bf16(cat4(r0, r1), pf, oacc[rt], 0, 0, 0);
                oacc[rt + 1] = __builtin_amdgcn_mfma_f32_16x16x32_bf16(cat4(r2, r3), pf, oacc[rt + 1], 0, 0, 0); }
        }
        lsum += SHX(lsum, 16); lsum += SHX(lsum, 32);
        const float inv = (OUT_F8 ? O8_SCALE : 1.0f) / lsum;
        if (h < 8) {
            if constexpr (OUT_F8) { GAS unsigned char* orow = (GAS unsigned char*)O + (size_t)tok * OLD + h * 256 + 4 * g;
#pragma unroll
                for (int rt = 0; rt < 16; ++rt) { int p = 0; p = __builtin_amdgcn_cvt_pk_fp8_f32(oacc[rt][0] * inv, oacc[rt][1] * inv, p, false); p = __builtin_amdgcn_cvt_pk_fp8_f32(oacc[rt][2] * inv, oacc[rt][3] * inv, p, true); *(GAS unsigned*)(orow + 16 * rt) = (unsigned)p; } }
            else { GAS bf16* orow = O + (size_t)tok * OLD + h * 256 + 4 * g;
#pragma unroll
            for (int rt = 0; rt < 16; ++rt) *(GAS unsigned long long*)(orow + 16 * rt) = (unsigned long long)pk2(oacc[rt][0] * inv, oacc[rt][1] * inv) | ((unsigned long long)pk2(oacc[rt][2] * inv, oacc[rt][3] * inv) << 32); } }
    }
}
struct Args { const float* in[20]; float* out; unsigned char* ws; };
__device__ __forceinline__ unsigned long long karg_u64(int idx) { unsigned long long r; const unsigned off = (unsigned)idx * 8u;
    asm volatile("s_load_dwordx2 %0, %1, %2\n\ts_waitcnt lgkmcnt(0)" : "=s"(r) : "s"(__builtin_amdgcn_kernarg_segment_ptr()), "s"(off) : "memory"); return r; }
__device__ __forceinline__ const GAS float* karg_in(int i) { return (const GAS float*)karg_u64(i); }
__device__ __forceinline__ GAS float* karg_out() { return (GAS float*)karg_u64(20); }
__device__ __forceinline__ GAS unsigned char* karg_ws() { return (GAS unsigned char*)karg_u64(21); }
#ifndef REP_P0
#define REP_P0 1
#endif
#ifndef REP_NORM
#define REP_NORM 1
#endif
#ifndef REP_GU
#define REP_GU 1
#endif
#ifndef REP_IN
#define REP_IN 1
#endif
#ifndef REP_POST
#define REP_POST 1
#endif
#ifndef REP_TOPK
#define REP_TOPK 1
#endif
#ifndef REP_DSA
#define REP_DSA 1
#endif
#define REPEAT(n) _Pragma("unroll 1") for (int rep_ = 0; rep_ < (n); ++rep_)
#define PHASE_IDS() int wave = wave0; asm volatile("" : "+s"(wave)); int lane; asm volatile("v_mbcnt_lo_u32_b32 %0, -1, 0\n\tv_mbcnt_hi_u32_b32 %0, -1, %0" : "=v"(lane)); const int tid = wave * 64 + lane; int bx = blockIdx.x; asm volatile("" : "+s"(bx)); int G = gridDim.x; asm volatile("" : "+s"(G)); \
    const int vcu = (G % 8 == 0) ? (bx % 8) * (G / 8) + bx / 8 : bx; const int gw = vcu * NWAVES + wave, NGW = G * NWAVES; \
    GAS unsigned char* ws = karg_ws(); (void)lane; (void)gw; (void)NGW; (void)vcu; (void)ws
__global__ void __launch_bounds__(NWAVES * 64, 2) mk_fwd(Args args) {
    extern __shared__ __attribute__((aligned(16))) unsigned char lds_raw[];
    LAS unsigned char* lds = (LAS unsigned char*)lds_raw;
    volatile LAS unsigned* MISC = (volatile LAS unsigned*)(lds + MISC_OFF);
    const int wave0 = __builtin_amdgcn_readfirstlane(threadIdx.x >> 6);
    for (int u = threadIdx.x; u < (LDS_BYTES - LDSCTL_OFF) / 4; u += NWAVES * 64) ((LAS unsigned*)(lds + LDSCTL_OFF))[u] = 0u;
    __syncthreads();
    (void)xcd_barrier_post((unsigned*)((gu32*)(karg_ws() + WS_CTL) + CW_BAR), MISC + 8, threadIdx.x == 0);
#define GRID_BAR() do { XcdBarrier b_; b_.bar = (unsigned*)((gu32*)(karg_ws() + WS_CTL) + CW_BAR); b_.x = xb_xcc_id(); b_.st = MISC + 8; int w_ = wave0; asm volatile("" : "+s"(w_)); int l_; asm volatile("v_mbcnt_lo_u32_b32 %0, -1, 0\n\tv_mbcnt_hi_u32_b32 %0, -1, %0" : "=v"(l_)); xcd_barrier(b_, (w_ | l_) == 0); } while (0)

    REPEAT(REP_P0) {   PHASE_IDS();
        LAS float* scr = (LAS float*)(lds + RING_OFF + wave * 16384);
        rows_bf16_ss(karg_in(0), (GAS bf16*)(ws + WS_XN), f8_on(0, 0) ? (GAS unsigned char*)(ws + WS_HB8) : (GAS unsigned char*)nullptr, (GAS float*)(ws + WS_SS), gw, NGW, lane);
        constexpr int I_GU = (D / 64) * (FF / 32), I_DN = (FF / 64) * (D / 32);
        constexpr int I_FFN = 2 * I_GU + I_DN, I_IN = 72 * (D / 64), I_OB = (1024 / 64) * (D / 32);
        constexpr int PER_LAYER = 2 * I_FFN + I_IN + I_OB;
        for (int it = gw; it < DEPTH * PER_LAYER; it += NGW) {
            const int l = it / PER_LAYER; int r = it - l * PER_LAYER;
            GAS unsigned char* wl = ws + WS_W0 + (size_t)l * W_LAYER;
            if (r < 2 * I_FFN) {
                const int f = r / I_FFN; r -= f * I_FFN;
                GAS bf16* dgu = (GAS bf16*)(wl + (f ? WO_GU2 : WO_GU1)); GAS bf16* dd = (GAS bf16*)(wl + (f ? WO_D2 : WO_D1));
                if (r < 2 * I_GU) { const int up = r >= I_GU; if (up) r -= I_GU; const int kb = r / (FF / 32), nb = r % (FF / 32), n0 = 32 * nb;
                    const GAS float* wsrc = karg_in(up ? (f ? 17 : 4) : (f ? 16 : 3)) + (size_t)l * D * FF;
                    const int drow = (n0 >> 7) * 256 + (up ? 128 : 0) + (n0 & 127);
                    if (f8_on(l, f)) { if constexpr (GU_I8) conv_item<2>(wsrc, FF, 64 * kb, n0, 32, dgu, D, drow, 0, W8I_SCALE, karg_in(f ? 15 : 2) + (size_t)l * D, scr, lane); else conv_item<1>(wsrc, FF, 64 * kb, n0, 32, dgu, D, drow, 0, W8_SCALE, karg_in(f ? 15 : 2) + (size_t)l * D, scr, lane); }
                    else conv_item(wsrc, FF, 64 * kb, n0, 32, dgu, D, drow, 0, 1.0f, karg_in(f ? 15 : 2) + (size_t)l * D, scr, lane); }
                else { r -= 2 * I_GU; const int kb = r / (D / 32), nb = r % (D / 32);
                    if (d8_on(l, f)) conv_item<1>(karg_in(f ? 18 : 5) + (size_t)l * FF * D, D, 64 * kb, 32 * nb, 32, dd, FF, 32 * nb, 0, W8_SCALE, nullptr, scr, lane);
                    else conv_item(karg_in(f ? 18 : 5) + (size_t)l * FF * D, D, 64 * kb, 32 * nb, 32, dd, FF, 32 * nb, 0, 1.0f, nullptr, scr, lane); }
            } else if (r < 2 * I_FFN + I_IN) {
                r -= 2 * I_FFN; const int j = r >> 5, kb = r & 31; int src, nvalid = 32; float sc = 1.0f;
                if (j < 8) src = 1024 + 32 * j;
                else if (j < 40) src = 1864 + 32 * (j - 8);
                else if (j < 44) src = 2888 + 32 * (j - 40);
                else if (j < 48) src = 3016 + 32 * (j - 44);
                else if (j < 64) src = 1280 + 32 * (j - 48);
                else if (j < 66) src = 1792 + 32 * (j - 64);
                else if (j == 66) { src = 1856; nvalid = 8; sc = 0.044194173824159216f; }
                else { src = 0; nvalid = 0; }
                const GAS float* win = karg_in(7) + (size_t)l * D * D_IN; const GAS float* gmix = karg_in(6) + (size_t)l * D;
                if (IN_I8 && j < 48) conv_item<2>(win, D_IN, 64 * kb, src, nvalid, (GAS bf16*)(wl + WO_IN), D, 2048 + 32 * j, 0, W8I_SCALE, gmix, scr, lane);
                else if (IN_I8) conv_item(win, D_IN, 64 * kb, src, nvalid, (GAS bf16*)(wl + WO_IN + (size_t)ZN8 * D), D, 32 * (j - 48), 0, sc, gmix, scr, lane);
                else conv_item(win, D_IN, 64 * kb, src, nvalid, (GAS bf16*)(wl + WO_IN), D, 2048 + 32 * j, 0, (j >= 8 && j < 40) ? 0.125f : sc, gmix, scr, lane);
            } else {
                r -= 2 * I_FFN + I_IN; const int kb = r >> 6, nb = r & 63;
                if constexpr (OUT_F8) conv_item<1>(karg_in(14) + (size_t)l * D * D + (size_t)1024 * D, D, 64 * kb, 32 * nb, 32, (GAS bf16*)(wl + WO_OUT), OLD, 32 * nb, 2048, W8_SCALE, nullptr, scr, lane);
                else conv_item(karg_in(14) + (size_t)l * D * D + (size_t)1024 * D, D, 64 * kb, 32 * nb, 32, (GAS bf16*)(wl + WO_OUT), OLD, 32 * nb, 2048, 1.0f, nullptr, scr, lane);
            }
        }
        __syncthreads();
        LAS float* Ps = (LAS float*)(lds + RING_OFF); LAS float* Qs = Ps + 64 * 129;
        for (int u = vcu; u < DEPTH * 2048; u += G) {
            const int l = u >> 11, which = (u >> 10) & 1, v = u & 1023;
            GAS unsigned char* wl = ws + WS_W0 + (size_t)l * W_LAYER;
            if (which == 0) { const int h = v >> 7, rt = (v >> 5) & 3, kt = v & 31;
                if constexpr (IN_I8) absorb_unit<false, 2>(karg_in(11) + (size_t)l * RANK * 1024 + ((size_t)(64 * rt) * 8 + h) * 128, 1024, 1, karg_in(7) + (size_t)l * D * D_IN + (size_t)(64 * kt) * D_IN + h * 128, D_IN,
                                   (GAS bf16*)((GAS unsigned char*)(wl + WO_IN) + (size_t)(h * 256 + 64 * rt) * D + 64 * kt), D, WQ8I_SCALE, karg_in(6) + (size_t)l * D + 64 * kt, Ps, Qs, tid);
                else absorb_unit<false>(karg_in(11) + (size_t)l * RANK * 1024 + ((size_t)(64 * rt) * 8 + h) * 128, 1024, 1, karg_in(7) + (size_t)l * D * D_IN + (size_t)(64 * kt) * D_IN + h * 128, D_IN,
                                   (GAS bf16*)(wl + WO_IN) + (size_t)(h * 256 + 64 * rt) * D + 64 * kt, D, 0.08838834764831845f, karg_in(6) + (size_t)l * D + 64 * kt, Ps, Qs, tid); }
            else { const int h = v >> 7, nt = (v >> 2) & 31, rt = v & 3;
                if constexpr (OUT_F8) absorb_unit<true, 1>(karg_in(14) + (size_t)l * D * D + (size_t)(h * 128) * D + 64 * nt, 1, D, karg_in(12) + (size_t)l * RANK * 1024 + ((size_t)(64 * rt) * 8 + h) * 128, 1024,
                                  (GAS bf16*)((GAS unsigned char*)(wl + WO_OUT) + (size_t)(64 * nt) * OLD + h * 256 + 64 * rt), OLD, W8_SCALE, nullptr, Ps, Qs, tid);
                else absorb_unit<true>(karg_in(14) + (size_t)l * D * D + (size_t)(h * 128) * D + 64 * nt, 1, D, karg_in(12) + (size_t)l * RANK * 1024 + ((size_t)(64 * rt) * 8 + h) * 128, 1024,
                                  (GAS bf16*)(wl + WO_OUT) + (size_t)(64 * nt) * OLD + h * 256 + 64 * rt, OLD, 1.0f, nullptr, Ps, Qs, tid); }
        }
    }
    GRID_BAR();

#pragma unroll 1
    for (int s = 0; s < 2 * DEPTH; ++s) {
        const int l = s >> 1, f = s & 1;
        REPEAT(REP_GU) {   PHASE_IDS(); GAS unsigned char* wl = ws + WS_W0 + (size_t)l * W_LAYER;
            pg8::StaticOrder S; S.init(M, NGU, G, bx);
            const GAS float* ssp = (const GAS float*)(ws + WS_SS + (size_t)((3 * l + 2 * f) & 1) * SS_BYTES);
            if ((F8_MASK == 0xF) || (F8_MASK != 0 && f8_on(l, f))) {
                if constexpr (F8_MASK != 0) {
                    pg8::Gemm g{(const GAS bf16*)(ws + WS_HB8), (const GAS bf16*)(wl + (f ? WO_GU2 : WO_GU1)), M, NGU, D / 2};
                    if constexpr (GU_I8) { pg8::EpiSwiglu<true> E{(GAS bf16*)(ws + WS_ACT), FF, ssp, 1.0f / D, EPS, 1.0f / (H8I_SCALE * W8I_SCALE), d8_on(l, f) ? A8_SCALE : 0.f};
                        pg8::gemm_phase<pg8::EpiSwiglu<true>, pg8::StaticOrder, true, true, false, true>(lds + RING_OFF, g, S, E, tid); }
                    else { pg8::EpiSwiglu<false> E{(GAS bf16*)(ws + WS_ACT), FF, ssp, 1.0f / D, EPS, 1.0f / W8_SCALE, d8_on(l, f) ? A8_SCALE : 0.f};
                        pg8::gemm_phase<pg8::EpiSwiglu<false>, pg8::StaticOrder, true, true, true>(lds + RING_OFF, g, S, E, tid); } }
            } else {
                if constexpr (F8_MASK != 0xF) {
                    pg8::Gemm g{(const GAS bf16*)(ws + WS_XN), (const GAS bf16*)(wl + (f ? WO_GU2 : WO_GU1)), M, NGU, D};
                    pg8::EpiSwiglu<false> E{(GAS bf16*)(ws + WS_ACT), FF, ssp, 1.0f / D, EPS, 1.0f, d8_on(l, f) ? A8_SCALE : 0.f};
                    pg8::gemm_phase<pg8::EpiSwiglu<false>, pg8::StaticOrder, true, true, false>(lds + RING_OFF, g, S, E, tid); }
            } }
        GRID_BAR();
        {   PHASE_IDS(); GAS unsigned char* wl = ws + WS_W0 + (size_t)l * W_LAYER;
            pg8::StaticOrder S; S.init(M, D, G, bx);
            const unsigned sso = (unsigned)(WS_SS + (size_t)((3 * l + 2 * f + 1) & 1) * SS_BYTES), h8o = ((f == 0 && IN_I8) || (f == 1 && l + 1 < DEPTH && f8_on(l + 1, 0))) ? (unsigned)WS_HB8 : 0u;
            if ((D8_MASK == 0xF) || (D8_MASK != 0 && d8_on(l, f))) {
                if constexpr (D8_MASK != 0) {
                    pg8::Gemm g{(const GAS bf16*)(ws + WS_ACT), (const GAS bf16*)(wl + (f ? WO_D2 : WO_D1)), M, D, FF / 2};
                    pg8::EpiResid E{0.5f / (W8_SCALE * A8_SCALE), (unsigned)WS_XN, sso, h8o, GU_I8 ? H8I_SCALE : 0.f};
                    pg8::gemm_phase<pg8::EpiResid, pg8::StaticOrder, true, true, true>(lds + RING_OFF, g, S, E, tid); }
            } else {
                if constexpr (D8_MASK != 0xF) {
                    pg8::Gemm g{(const GAS bf16*)(ws + WS_ACT), (const GAS bf16*)(wl + (f ? WO_D2 : WO_D1)), M, D, FF};
                    pg8::EpiResid E{0.5f, (unsigned)WS_XN, sso, h8o, GU_I8 ? H8I_SCALE : 0.f};
                    pg8::gemm_phase<pg8::EpiResid, pg8::StaticOrder, true, true, false>(lds + RING_OFF, g, S, E, tid); }
            } }
        GRID_BAR();
        if (f == 0) {
            REPEAT(REP_IN) {   PHASE_IDS(); GAS unsigned char* wl = ws + WS_W0 + (size_t)l * W_LAYER;
                const GAS float* ssp = (const GAS float*)(ws + WS_SS + (size_t)((3 * l + 1) & 1) * SS_BYTES);
                if constexpr (IN_I8) {
                    {   pg8::Gemm g{(const GAS bf16*)(ws + WS_HB8), (const GAS bf16*)(wl + WO_IN), M, ZN8, D / 2}; pg8::StaticOrder S; S.init(M, ZN8, G, bx);
                        pg8::EpiBf16<true> E{(GAS bf16*)(ws + WS_Z), ZLD, ssp, 1.0f / D, EPS, 0.08838834764831845f / (H8I_SCALE * WQ8I_SCALE), 1.0f / (H8I_SCALE * W8I_SCALE), 0.125f / (H8I_SCALE * W8I_SCALE)};
                        pg8::gemm_phase<pg8::EpiBf16<true>, pg8::StaticOrder, true, true, false, true>(lds + RING_OFF, g, S, E, tid); }
                    {   pg8::Gemm g{(const GAS bf16*)(ws + WS_XN), (const GAS bf16*)(wl + WO_IN + (size_t)ZN8 * D), M, ZLD - ZN8, D}; pg8::StaticOrder S; S.init(M, ZLD - ZN8, G, bx);
                        pg8::EpiBf16<false> E{(GAS bf16*)(ws + WS_Z) + ZN8, ZLD, ssp, 1.0f / D, EPS, 1.0f, 1.0f, 1.0f};
                        pg8::gemm_phase<pg8::EpiBf16<false>, pg8::StaticOrder, true, true, false, false>(lds + RING_OFF, g, S, E, tid); }
                } else {
                    pg8::Gemm g{(const GAS bf16*)(ws + WS_XN), (const GAS bf16*)(wl + WO_IN), M, ZLD, D}; pg8::StaticOrder S; S.init(M, ZLD, G, bx);
                    pg8::EpiBf16<false> E{(GAS bf16*)(ws + WS_Z), ZLD, ssp, 1.0f / D, EPS, 1.0f, 1.0f, 1.0f};
                    pg8::gemm_phase<pg8::EpiBf16<false>, pg8::StaticOrder, true, true, false, false>(lds + RING_OFF, g, S, E, tid); } }
            GRID_BAR();
            REPEAT(REP_POST) {   PHASE_IDS();
                post_rows((const GAS bf16*)(ws + WS_Z), karg_in(8) + (size_t)l * RANK, karg_in(9) + (size_t)l * IDIM, karg_in(10) + (size_t)l * IDIM, (GAS bf16*)(ws + WS_CKVN), (GAS bf16*)(ws + WS_KIN), (GAS float*)(ws + WS_WIF), gw, NGW, lane);
                swa_phase(lds + RING_OFF, (const GAS bf16*)(ws + WS_Z), (GAS bf16*)(ws + WS_O), karg_in(1), karg_in(13) + (size_t)l * H_B, vcu, G, tid, lane, wave);
            }
            GRID_BAR();
            REPEAT(REP_TOPK) {   PHASE_IDS(); topk_phase(lds + RING_OFF, (const GAS bf16*)(ws + WS_Z), (const GAS bf16*)(ws + WS_KIN), (const GAS float*)(ws + WS_WIF), (GAS unsigned short*)(ws + WS_IDX), vcu, G, lane, wave); }
            GRID_BAR();
            REPEAT(REP_DSA) {   PHASE_IDS(); dsa_phase(lds, (const GAS bf16*)(ws + WS_Z), (const GAS bf16*)(ws + WS_CKVN), (const GAS unsigned short*)(ws + WS_IDX), (GAS bf16*)(ws + WS_O), karg_in(1), gw, NGW, tid, lane, wave); }
            GRID_BAR();
            {   PHASE_IDS(); GAS unsigned char* wl = ws + WS_W0 + (size_t)l * W_LAYER;
                pg8::Gemm g{(const GAS bf16*)(ws + WS_O), (const GAS bf16*)(wl + WO_OUT), M, D, OUT_F8 ? OLD / 2 : OLD}; pg8::StaticOrder S; S.init(M, D, G, bx);
                pg8::EpiResid E{OUT_F8 ? 1.0f / (W8_SCALE * O8_SCALE) : 1.0f, (unsigned)WS_XN, (unsigned)(WS_SS + (size_t)((3 * l + 2) & 1) * SS_BYTES), f8_on(l, 1) ? (unsigned)WS_HB8 : 0u, GU_I8 ? H8I_SCALE : 0.f};
                pg8::gemm_phase<pg8::EpiResid, pg8::StaticOrder, true, true, OUT_F8 != 0>(lds + RING_OFF, g, S, E, tid); }
            GRID_BAR();
        }
    }
    {   PHASE_IDS(); final_rows((const GAS bf16*)(ws + WS_XN), karg_out(), karg_in(19), (const GAS float*)(ws + WS_SS + (size_t)(6 & 1) * SS_BYTES), gw, NGW, lane); }
}

extern "C" void kernel_launch(void* const* d_in, const int* in_sizes, int n_in, void* d_out, int out_size, void* d_ws, size_t ws_size, hipStream_t stream) {
    static int grid = 0;
    if (grid == 0) {
        if (n_in != 20 || in_sizes[0] != M * D || out_size != M * D || ws_size < WS_END) { fprintf(stderr, "kernel_launch: unexpected shapes (n_in %d, in0 %d, out %d, ws %zu); nothing launched\n", n_in, n_in > 0 ? in_sizes[0] : -1, out_size, ws_size); grid = -1; return; }
        int dev = 0, cus = 0, per_cu = 0;
        if (hipGetDevice(&dev) != hipSuccess || hipDeviceGetAttribute(&cus, hipDeviceAttributeMultiprocessorCount, dev) != hipSuccess) { grid = -1; return; }
        if (hipFuncSetAttribute((const void*)mk_fwd, hipFuncAttributeMaxDynamicSharedMemorySize, LDS_BYTES) != hipSuccess) { fprintf(stderr, "kernel_launch: hipFuncSetAttribute failed\n"); grid = -1; return; }
        if (hipOccupancyMaxActiveBlocksPerMultiprocessor(&per_cu, (const void*)mk_fwd, NWAVES * 64, LDS_BYTES) != hipSuccess || per_cu < 1) { fprintf(stderr, "kernel_launch: occupancy query reports %d workgroups per CU\n", per_cu); }
        (void)hipGetLastError();
        grid = cus;
    }
    if (grid < 0) return;
    if (hipMemsetAsync((char*)d_ws + WS_CTL, 0, CTL_ZERO_BYTES, stream) != hipSuccess) return;
    Args a{};
    for (int i = 0; i < 20; ++i) a.in[i] = (const float*)d_in[i];
    a.out = (float*)d_out; a.ws = (unsigned char*)d_ws;
    hipLaunchKernelGGL(mk_fwd, dim3(grid), dim3(NWAVES * 64), LDS_BYTES, stream, a);
}
```

```cpp
#include <hip/hip_runtime.h>
#include <cstdio>
#include <cstdint>
namespace pg8 {
#define PG8_LAS __attribute__((address_space(3)))
#define PG8_GAS __attribute__((address_space(1)))
typedef unsigned short bf16_t;
typedef short bf16x8 __attribute__((ext_vector_type(8)));
typedef float f32x4 __attribute__((ext_vector_type(4)));
typedef unsigned u32x4 __attribute__((ext_vector_type(4)));
constexpr int BM = 256, BK = 64, HALF = 128, HTB = HALF * BK * 2  , STAGE_BYTES = 8 * HTB, NXCD = 8, WGM = 4;

__host__ __device__ __forceinline__ int lds_byte(int r, int c) { const int st = (r >> 4) * 2 + (c >> 5), rr = r & 15, cc = c & 31, ob = rr * 64 + cc * 2; return st * 1024 + (ob ^ (((ob >> 9) & 1) << 5)); }
__host__ __device__ __forceinline__ void stage_rc(int b, int& R, int& C) { const int st = b / 1024, sb = b % 1024, swz = sb ^ (((sb >> 9) & 1) << 5); R = (st >> 1) * 16 + swz / 64; C = (st & 1) * 32 + (swz % 64) / 2; }
__host__ __device__ __forceinline__ int perm32(int rho) { const int n = rho >> 4, i = rho & 15; return 8 * (i >> 2) + 4 * n + (i & 3); }

typedef int i32x8 __attribute__((ext_vector_type(8))); typedef int i32x4v __attribute__((ext_vector_type(4)));
__device__ __forceinline__ i32x8 cat8(bf16x8 a, bf16x8 b) { return __builtin_shufflevector(__builtin_bit_cast(i32x4v, a), __builtin_bit_cast(i32x4v, b), 0, 1, 2, 3, 4, 5, 6, 7); }
struct Unit { int pm, pn; };
struct Gemm { const PG8_GAS bf16_t* A; const PG8_GAS bf16_t* Bt; int M, N, K; };

struct StaticOrder {
    int nM, nN, nwg, G, c;
    __host__ __device__ void init(int M, int N, int G_, int c_) { nM = M / BM; nN = N / BM; nwg = nM * nN; G = G_; c = c_; }
    __host__ __device__ bool next(int i, Unit& u) const {
        const long L = (long)i * G + c; if (L >= nwg) return false;
        int wgid = (int)L; { const int q = nwg / NXCD, r = nwg % NXCD, xcd = wgid % NXCD, off = wgid / NXCD; wgid = (xcd < r ? xcd * (q + 1) : r * (q + 1) + (xcd - r) * q) + off; }
        const int nig = WGM * nN, gid = wgid / nig, fm = gid * WGM, gsz = (nM - fm) < WGM ? (nM - fm) : WGM;
        u.pm = fm + ((wgid % nig) % gsz); u.pn = (wgid % nig) / gsz; return true;
    }
    __device__ __forceinline__ void a_ready(const Unit&) const {}
    __device__ __forceinline__ void done(const Unit&) const {}
};
__device__ __forceinline__ unsigned long long karg64(int idx) { unsigned long long r; const unsigned off = (unsigned)idx * 8u;
    asm volatile("s_load_dwordx2 %0, %1, %2\n\ts_waitcnt lgkmcnt(0)" : "=s"(r) : "s"(__builtin_amdgcn_kernarg_segment_ptr()), "s"(off) : "memory"); return r; }
__device__ __forceinline__ unsigned cvt_pk_bf16(float lo, float hi) { unsigned r; asm volatile("v_cvt_pk_bf16_f32 %0, %1, %2" : "=v"(r) : "v"(lo), "v"(hi)); return r; }
typedef float f32x2 __attribute__((ext_vector_type(2)));
__device__ __forceinline__ unsigned pack4_i8(float a, float b, float c, float d, float S) {
    const int qa = (int)__builtin_rintf(__builtin_fminf(__builtin_fmaxf(a * S, -127.f), 127.f)), qb = (int)__builtin_rintf(__builtin_fminf(__builtin_fmaxf(b * S, -127.f), 127.f));
    const int qc = (int)__builtin_rintf(__builtin_fminf(__builtin_fmaxf(c * S, -127.f), 127.f)), qd = (int)__builtin_rintf(__builtin_fminf(__builtin_fmaxf(d * S, -127.f), 127.f));
    return ((unsigned)qa & 0xffu) | (((unsigned)qb & 0xffu) << 8) | (((unsigned)qc & 0xffu) << 16) | ((unsigned)qd << 24);
}
__device__ __forceinline__ float silu_f(float g) { return g * __builtin_amdgcn_rcpf(1.0f + __builtin_amdgcn_exp2f(-1.4426950408889634f * g)); }

template <bool ACC_I32 = false>
struct EpiSwiglu {
    static constexpr bool PERM = true, AFTER_DRAIN = false;
    static __device__ __forceinline__ f32x4 cv(const f32x4& a) { if constexpr (ACC_I32) { typedef int i32x4e __attribute__((ext_vector_type(4))); const i32x4e q = __builtin_bit_cast(i32x4e, a); return (f32x4){(float)q[0], (float)q[1], (float)q[2], (float)q[3]}; } else return a; }
    PG8_GAS bf16_t* O; int ldc; const PG8_GAS float* ss; float inv_k, eps, post; float out8;
    __device__ __forceinline__ void operator()(const f32x4 (&acc)[2][2][4][2], const Unit& u, int wr, int wc, int fr, int fq) const {
        const int row0 = u.pm * BM + wr * 64 + fr, col0 = u.pn * HALF + wc * 32 + 8 * fq;
        float rs[8]; const int lane_ = fr + 16 * fq;
#pragma unroll
        for (int k = 0; k < 8; ++k) { const PG8_GAS f32x4* p4 = (const PG8_GAS f32x4*)(ss + (size_t)(row0 + (k >> 2) * HALF + (k & 3) * 16) * 32 + 8 * fq); const f32x4 a = p4[0], b = p4[1];
            float t = ((a[0] + a[1]) + (a[2] + a[3])) + ((b[0] + b[1]) + (b[2] + b[3]));
            t += __builtin_bit_cast(float, __builtin_amdgcn_ds_bpermute((lane_ ^ 16) << 2, __builtin_bit_cast(int, t)));
            t += __builtin_bit_cast(float, __builtin_amdgcn_ds_bpermute((lane_ ^ 32) << 2, __builtin_bit_cast(int, t))); rs[k] = t; }
        unsigned pk[8][2];
#pragma unroll
        for (int ai = 0; ai < 2; ++ai)
#pragma unroll
            for (int m = 0; m < 4; ++m) { PG8_GAS bf16_t* rowp = O + (size_t)(row0 + ai * HALF + m * 16) * ldc + col0;
                const float r = __builtin_amdgcn_rsqf(rs[ai * 4 + m] * inv_k + eps) * post;
                const f32x2 r2 = {r, r}, c2 = {-1.4426950408889634f * r, -1.4426950408889634f * r}; const float rs8 = out8 != 0.f ? r * out8 : r; const f32x2 q2 = {rs8, rs8}, one2 = {1.0f, 1.0f};
                f32x2 o[4];
#pragma unroll
                for (int h = 0; h < 4; ++h) { const f32x4 gq = cv(acc[ai][0][m][h >> 1]), uq = cv(acc[ai][1][m][h >> 1]);
                    const f32x2 gv = {gq[2 * (h & 1)], gq[2 * (h & 1) + 1]}, uv = {uq[2 * (h & 1)], uq[2 * (h & 1) + 1]};
                    const f32x2 t = gv * c2; f32x2 e; e.x = __builtin_amdgcn_exp2f(t.x); e.y = __builtin_amdgcn_exp2f(t.y);
                    const f32x2 d = e + one2; f32x2 rc; rc.x = __builtin_amdgcn_rcpf(d.x); rc.y = __builtin_amdgcn_rcpf(d.y);
                    o[h] = ((gv * r2) * rc) * (uv * q2); }
                if (out8 != 0.f) { int p = 0, q = 0;
                    p = __builtin_amdgcn_cvt_pk_fp8_f32(o[0].x, o[0].y, p, false); p = __builtin_amdgcn_cvt_pk_fp8_f32(o[1].x, o[1].y, p, true);
                    q = __builtin_amdgcn_cvt_pk_fp8_f32(o[2].x, o[2].y, q, false); q = __builtin_amdgcn_cvt_pk_fp8_f32(o[3].x, o[3].y, q, true);
                    pk[ai * 4 + m][0] = (unsigned)p; pk[ai * 4 + m][1] = (unsigned)q; }
                else { u32x4 w; w.x = cvt_pk_bf16(o[0].x, o[0].y); w.y = cvt_pk_bf16(o[1].x, o[1].y); w.z = cvt_pk_bf16(o[2].x, o[2].y); w.w = cvt_pk_bf16(o[3].x, o[3].y);
                    *(PG8_GAS u32x4*)rowp = w; } }
        if (out8 != 0.f) {
#pragma unroll
            for (int k = 0; k < 8; k += 2) {
                typedef unsigned u2v __attribute__((ext_vector_type(2)));
                const u2v sp = __builtin_amdgcn_permlane16_swap(pk[k][0], pk[k + 1][0], false, false), sq = __builtin_amdgcn_permlane16_swap(pk[k][1], pk[k + 1][1], false, false);
                const int kk = k + (fq & 1); const int rowk = row0 + (kk >> 2) * HALF + (kk & 3) * 16;
                u32x4 w; w.x = sp.x; w.y = sq.x; w.z = sp.y; w.w = sq.y;
                *(PG8_GAS u32x4*)((PG8_GAS unsigned char*)O + (size_t)rowk * ldc + (col0 - 8 * (fq & 1))) = w; } }
    }
};
struct EpiResid {
    static constexpr bool PERM = true, AFTER_DRAIN = false;
    float alpha; unsigned hb_off; unsigned ss_off; unsigned h8_off; float h8_i8;
    __device__ __forceinline__ void operator()(const f32x4 (&acc)[2][2][4][2], const Unit& u, int wr, int wc, int fr, int fq) const {
        constexpr int ldc = 2048;
        PG8_GAS unsigned char* wsb = (PG8_GAS unsigned char*)karg64(21); PG8_GAS bf16_t* hb = (PG8_GAS bf16_t*)(wsb + hb_off); PG8_GAS float* ss = (PG8_GAS float*)(wsb + ss_off);
        const int row0 = u.pm * BM + wr * 64 + fr, col0 = u.pn * BM + wc * 32 + 8 * fq; const int lane = fr + 16 * fq;
        u32x4 cur[2], nxt[2];
        { const size_t off = (size_t)row0 * ldc + col0; cur[0] = *(const PG8_GAS u32x4*)(hb + off); cur[1] = *(const PG8_GAS u32x4*)(hb + off + HALF); }
#pragma unroll
        for (int k = 0; k < 8; ++k) { const int ai = k >> 2, m = k & 3; const int row = row0 + ai * HALF + m * 16; const size_t off = (size_t)row * ldc + col0;
            if (k < 7) { const int ai2 = (k + 1) >> 2, m2 = (k + 1) & 3; const size_t off2 = (size_t)(row0 + ai2 * HALF + m2 * 16) * ldc + col0;
                nxt[0] = *(const PG8_GAS u32x4*)(hb + off2); nxt[1] = *(const PG8_GAS u32x4*)(hb + off2 + HALF); }
            float sq = 0.f;
#pragma unroll
            for (int bj = 0; bj < 2; ++bj) { const u32x4 b = cur[bj]; const f32x4 a0 = acc[ai][bj][m][0], a1 = acc[ai][bj][m][1]; u32x4 w;
                w.x = cvt_pk_bf16(__builtin_bit_cast(float, b.x << 16) + a0[0] * alpha, __builtin_bit_cast(float, b.x & 0xffff0000u) + a0[1] * alpha);
                w.y = cvt_pk_bf16(__builtin_bit_cast(float, b.y << 16) + a0[2] * alpha, __builtin_bit_cast(float, b.y & 0xffff0000u) + a0[3] * alpha);
                w.z = cvt_pk_bf16(__builtin_bit_cast(float, b.z << 16) + a1[0] * alpha, __builtin_bit_cast(float, b.z & 0xffff0000u) + a1[1] * alpha);
                w.w = cvt_pk_bf16(__builtin_bit_cast(float, b.w << 16) + a1[2] * alpha, __builtin_bit_cast(float, b.w & 0xffff0000u) + a1[3] * alpha);
                *(PG8_GAS u32x4*)(hb + off + bj * HALF) = w;
                if (h8_off) { typedef unsigned u32x2v __attribute__((ext_vector_type(2))); u32x2v q8; int p = 0;
                    const float e0 = __builtin_bit_cast(float, w.x << 16), e1 = __builtin_bit_cast(float, w.x & 0xffff0000u), e2 = __builtin_bit_cast(float, w.y << 16), e3 = __builtin_bit_cast(float, w.y & 0xffff0000u);
                    const float e4 = __builtin_bit_cast(float, w.z << 16), e5 = __builtin_bit_cast(float, w.z & 0xffff0000u), e6 = __builtin_bit_cast(float, w.w << 16), e7 = __builtin_bit_cast(float, w.w & 0xffff0000u);
                    if (h8_i8 != 0.f) { q8.x = pack4_i8(e0, e1, e2, e3, h8_i8); q8.y = pack4_i8(e4, e5, e6, e7, h8_i8); }
                    else { p = __builtin_amdgcn_cvt_pk_fp8_f32(e0, e1, p, false); p = __builtin_amdgcn_cvt_pk_fp8_f32(e2, e3, p, true); q8.x = (unsigned)p; p = 0;
                        p = __builtin_amdgcn_cvt_pk_fp8_f32(e4, e5, p, false); p = __builtin_amdgcn_cvt_pk_fp8_f32(e6, e7, p, true); q8.y = (unsigned)p; }
                    *(PG8_GAS u32x2v*)(wsb + h8_off + off + bj * HALF) = q8; }
#pragma unroll
                for (int e = 0; e < 4; ++e) { const float lo = __builtin_bit_cast(float, w[e] << 16), hi = __builtin_bit_cast(float, w[e] & 0xffff0000u); sq = fmaf(lo, lo, sq); sq = fmaf(hi, hi, sq); } }
            sq += __builtin_bit_cast(float, __builtin_amdgcn_ds_bpermute((lane ^ 16) << 2, __builtin_bit_cast(int, sq)));
            sq += __builtin_bit_cast(float, __builtin_amdgcn_ds_bpermute((lane ^ 32) << 2, __builtin_bit_cast(int, sq)));
            if (fq == 0) ss[(size_t)row * 32 + u.pn * 4 + wc] = sq;
            cur[0] = nxt[0]; cur[1] = nxt[1]; }
    }
};
template <bool ACC_I32 = false>
struct EpiBf16 {
    static constexpr bool PERM = true, AFTER_DRAIN = false;
    static __device__ __forceinline__ f32x4 cv(const f32x4& a) { if constexpr (ACC_I32) { typedef int i32x4e __attribute__((ext_vector_type(4))); const i32x4e q = __builtin_bit_cast(i32x4e, a); return (f32x4){(float)q[0], (float)q[1], (float)q[2], (float)q[3]}; } else return a; }
    PG8_GAS bf16_t* O; int ldc; const PG8_GAS float* ss; float inv_k, eps; float post_a, post_b, post_c;
    __device__ __forceinline__ void operator()(const f32x4 (&acc)[2][2][4][2], const Unit& u, int wr, int wc, int fr, int fq) const {
        const int row0 = u.pm * BM + wr * 64 + fr, col0 = u.pn * BM + wc * 32 + 8 * fq;
        const float pfac = fmaf(u.pn < 8 ? 1.0f : 0.0f, post_a - post_b, fmaf((u.pn >= 9 && u.pn < 13) ? 1.0f : 0.0f, post_c - post_b, post_b));
        float rs[8]; const int lane_ = fr + 16 * fq;
#pragma unroll
        for (int k = 0; k < 8; ++k) { const PG8_GAS f32x4* p4 = (const PG8_GAS f32x4*)(ss + (size_t)(row0 + (k >> 2) * HALF + (k & 3) * 16) * 32 + 8 * fq); const f32x4 a = p4[0], b = p4[1];
            float t = ((a[0] + a[1]) + (a[2] + a[3])) + ((b[0] + b[1]) + (b[2] + b[3]));
            t += __builtin_bit_cast(float, __builtin_amdgcn_ds_bpermute((lane_ ^ 16) << 2, __builtin_bit_cast(int, t)));
            t += __builtin_bit_cast(float, __builtin_amdgcn_ds_bpermute((lane_ ^ 32) << 2, __builtin_bit_cast(int, t))); rs[k] = t; }
#pragma unroll
        for (int ai = 0; ai < 2; ++ai)
#pragma unroll
            for (int m = 0; m < 4; ++m) { PG8_GAS bf16_t* rowp = O + (size_t)(row0 + ai * HALF + m * 16) * ldc + col0;
                const float r = __builtin_amdgcn_rsqf(rs[ai * 4 + m] * inv_k + eps) * pfac;
#pragma unroll
                for (int bj = 0; bj < 2; ++bj) { const f32x4 v0 = cv(acc[ai][bj][m][0]) * r, v1 = cv(acc[ai][bj][m][1]) * r;
                    u32x4 w; w.x = cvt_pk_bf16(v0[0], v0[1]); w.y = cvt_pk_bf16(v0[2], v0[3]); w.z = cvt_pk_bf16(v1[0], v1[1]); w.w = cvt_pk_bf16(v1[2], v1[3]);
                    *(PG8_GAS u32x4*)(rowp + bj * HALF) = w; } }
    }
};
template <class Epi, class Sched, bool ALIGN_EPI = false, bool SP2 = false, bool F8 = false, bool I8 = false>
__device__ __forceinline__ void gemm_phase(PG8_LAS unsigned char* lds, const Gemm g, const Sched& S, const Epi& E, int tid_in  ) {
    int tid_ = tid_in; asm volatile("" : "+v"(tid_));
    const int tid = tid_, wid = __builtin_amdgcn_readfirstlane(tid >> 6), lane = tid & 63, wr = wid >> 2, wc = wid & 3, fr = lane & 15, fq = lane >> 4;
    const int K = g.K, nt = K / BK;
    unsigned voffA[2], voffB[2];
#pragma unroll
    for (int i = 0; i < 2; ++i) { int R, C; stage_rc(tid * 16 + i * 8192, R, C); const int Rb = Epi::PERM ? ((R & ~31) + perm32(R & 31)) : R;
        voffA[i] = (unsigned)(R * K + C) * 2u; voffB[i] = (unsigned)(Rb * K + C) * 2u; }
    const size_t kstep = (size_t)(BK * 2);
    const size_t hstep = (size_t)HALF * K * 2;
    const size_t tstep = 2 * hstep;
    const unsigned ldsw = (unsigned)wid * 1024u;
    const int aoff = lds_byte(wr * 64 + fr, fq * 8), boff = lds_byte(wc * 32 + fr, fq * 8);
#define PG8_SA(b, h) (((b) * 2 + (h)) * HTB)
#define PG8_SB(b, h) ((4 + (b) * 2 + (h)) * HTB)
#define PG8_STAGE(bufoff, gbase, voff) do { _Pragma("unroll") for (int _i = 0; _i < 2; ++_i) \
        __builtin_amdgcn_global_load_lds((const PG8_GAS unsigned*)((const PG8_GAS char*)(gbase) + (voff)[_i]), (PG8_LAS unsigned*)(lds + (bufoff) + ldsw + _i * 8192), 16, 0, 0); } while (0)
#define PG8_LDA(dst, b, h) do { _Pragma("unroll") for (int m = 0; m < 4; ++m) _Pragma("unroll") for (int k = 0; k < 2; ++k) dst[m][k] = *(const PG8_LAS bf16x8*)(lds + PG8_SA(b, h) + aoff + m * 2048 + k * 1024); } while (0)
#define PG8_LDB(dst, b, h) do { _Pragma("unroll") for (int n = 0; n < 2; ++n) _Pragma("unroll") for (int k = 0; k < 2; ++k) dst[n][k] = *(const PG8_LAS bf16x8*)(lds + PG8_SB(b, h) + boff + n * 2048 + k * 1024); } while (0)
#define PG8_MMA(ai, bj, At, Bt) do { __builtin_amdgcn_s_setprio(1); _Pragma("unroll") for (int m = 0; m < 4; ++m) _Pragma("unroll") for (int n = 0; n < 2; ++n) { \
        if constexpr (F8) { asm volatile("v_mfma_f32_16x16x128_f8f6f4 %0, %1, %2, %0" : "+v"(acc[ai][bj][m][n]) : "v"(cat8(Bt[n][0], Bt[n][1])), "v"(cat8(At[m][0], At[m][1]))); } \
        else if constexpr (I8) { _Pragma("unroll") for (int k = 0; k < 2; ++k) asm volatile("v_mfma_i32_16x16x64_i8 %0, %1, %2, %0" : "+v"(acc[ai][bj][m][n]) : "v"(Bt[n][k]), "v"(At[m][k])); } \
        else { _Pragma("unroll") for (int k = 0; k < 2; ++k) acc[ai][bj][m][n] = __builtin_amdgcn_mfma_f32_16x16x32_bf16(Bt[n][k], At[m][k], acc[ai][bj][m][n], 0, 0, 0); } } \
        __builtin_amdgcn_s_setprio(0); } while (0)
#define PG8_WAIT_V(n) asm volatile("s_waitcnt vmcnt(" #n ")" ::: "memory")
#define PG8_WAIT_L(n) asm volatile("s_waitcnt lgkmcnt(" #n ")" ::: "memory")
#define PG8_BAR __builtin_amdgcn_s_barrier()
#define PG8_SCHED __builtin_amdgcn_sched_barrier(0)
    Unit cur, nxt; int ui = 0;
    if (!S.next(0, cur)) return;
    f32x4 acc[2][2][4][2];
#pragma unroll
    for (int a = 0; a < 2; ++a)
#pragma unroll
        for (int b = 0; b < 2; ++b)
#pragma unroll
            for (int m = 0; m < 4; ++m)
#pragma unroll
                for (int n = 0; n < 2; ++n) acc[a][b][m][n] = (f32x4){0.f, 0.f, 0.f, 0.f};
    bf16x8 At[4][2], B0[2][2], B1[2][2];
    const PG8_GAS char* cA = (const PG8_GAS char*)g.A + (size_t)cur.pm * tstep; const PG8_GAS char* cB = (const PG8_GAS char*)g.Bt + (size_t)cur.pn * tstep;
    S.a_ready(cur);
    if constexpr (SP2) {
        PG8_STAGE(PG8_SB(0, 0), cB, voffB); PG8_STAGE(PG8_SB(0, 1), cB + hstep, voffB); PG8_STAGE(PG8_SA(0, 0), cA, voffA); PG8_STAGE(PG8_SA(0, 1), cA + hstep, voffA);
        if (wr == 1) PG8_BAR;
        PG8_WAIT_V(2); PG8_BAR;
        PG8_STAGE(PG8_SB(1, 0), cB + kstep, voffB); PG8_STAGE(PG8_SA(1, 0), cA + kstep, voffA); PG8_STAGE(PG8_SB(1, 1), cB + hstep + kstep, voffB);
        PG8_WAIT_V(6); PG8_BAR;
    } else {
        PG8_STAGE(PG8_SB(0, 0), cB, voffB); PG8_STAGE(PG8_SA(0, 0), cA, voffA); PG8_STAGE(PG8_SB(0, 1), cB + hstep, voffB); PG8_STAGE(PG8_SA(0, 1), cA + hstep, voffA);
        if (wr == 1) PG8_BAR;
        PG8_WAIT_V(4); PG8_BAR;
        PG8_STAGE(PG8_SB(1, 0), cB + kstep, voffB); PG8_STAGE(PG8_SA(1, 0), cA + kstep, voffA); PG8_STAGE(PG8_SB(1, 1), cB + hstep + kstep, voffB);
        PG8_WAIT_V(6); PG8_BAR;
    }
    for (;;) {
        const bool has_next = S.next(ui + 1, nxt);
        const PG8_GAS char* nA = has_next ? (const PG8_GAS char*)g.A + (size_t)nxt.pm * tstep : cA; const PG8_GAS char* nB = has_next ? (const PG8_GAS char*)g.Bt + (size_t)nxt.pn * tstep : cB;
        for (int t = 0; t < nt; t += 2) {
            const bool last = (t == nt - 2);
            const PG8_GAS char* a1 = cA + (size_t)(t + 1) * kstep;
            const PG8_GAS char* a2 = last ? nA : cA + (size_t)(t + 2) * kstep; const PG8_GAS char* b2 = last ? nB : cB + (size_t)(t + 2) * kstep;
            const PG8_GAS char* a3 = a2 + kstep; const PG8_GAS char* b3 = b2 + kstep;
            if (last && has_next) S.a_ready(nxt);
            if constexpr (SP2) {
            PG8_LDB(B0, 0, 0); PG8_LDB(B1, 0, 1); PG8_SCHED; PG8_LDA(At, 0, 0); PG8_STAGE(PG8_SA(1, 1), a1 + hstep, voffA);
            PG8_WAIT_V(8); PG8_WAIT_L(0); PG8_BAR; PG8_MMA(0, 0, At, B0); PG8_MMA(0, 1, At, B1); PG8_BAR; PG8_SCHED;
            PG8_LDA(At, 0, 1); PG8_STAGE(PG8_SB(0, 0), b2, voffB); PG8_STAGE(PG8_SB(0, 1), b2 + hstep, voffB); PG8_STAGE(PG8_SA(0, 0), a2, voffA);
            PG8_WAIT_V(8); PG8_WAIT_L(0); PG8_BAR; PG8_MMA(1, 0, At, B0); PG8_MMA(1, 1, At, B1); PG8_BAR; PG8_SCHED;
            PG8_LDB(B0, 1, 0); PG8_LDB(B1, 1, 1); PG8_SCHED; PG8_LDA(At, 1, 0); PG8_STAGE(PG8_SA(0, 1), a2 + hstep, voffA);
            PG8_WAIT_V(8); PG8_WAIT_L(0); PG8_BAR; PG8_MMA(0, 0, At, B0); PG8_MMA(0, 1, At, B1); PG8_BAR; PG8_SCHED;
            PG8_LDA(At, 1, 1); PG8_STAGE(PG8_SB(1, 0), b3, voffB); PG8_STAGE(PG8_SB(1, 1), b3 + hstep, voffB); PG8_STAGE(PG8_SA(1, 0), a3, voffA);
            PG8_WAIT_V(8); PG8_WAIT_L(0); PG8_BAR; PG8_MMA(1, 0, At, B0); PG8_MMA(1, 1, At, B1); PG8_BAR; PG8_SCHED;
            } else {
            PG8_LDB(B0, 0, 0); PG8_SCHED; PG8_LDA(At, 0, 0); PG8_STAGE(PG8_SA(1, 1), a1 + hstep, voffA);
            PG8_WAIT_L(8); PG8_BAR; PG8_WAIT_L(0); PG8_MMA(0, 0, At, B0); PG8_BAR; PG8_SCHED;
            PG8_LDB(B1, 0, 1); PG8_STAGE(PG8_SB(0, 0), b2, voffB);
            PG8_BAR; PG8_WAIT_L(0); PG8_MMA(0, 1, At, B1); PG8_BAR;
            PG8_LDA(At, 0, 1); PG8_STAGE(PG8_SA(0, 0), a2, voffA);
            PG8_BAR; PG8_WAIT_L(0); PG8_MMA(1, 0, At, B0); PG8_BAR; PG8_SCHED;
            PG8_STAGE(PG8_SB(0, 1), b2 + hstep, voffB);
            PG8_WAIT_V(6); PG8_BAR; PG8_MMA(1, 1, At, B1); PG8_BAR;
            PG8_LDB(B0, 1, 0); PG8_SCHED; PG8_LDA(At, 1, 0); PG8_STAGE(PG8_SA(0, 1), a2 + hstep, voffA);
            PG8_WAIT_L(8); PG8_BAR; PG8_WAIT_L(0); PG8_MMA(0, 0, At, B0); PG8_BAR; PG8_SCHED;
            PG8_LDB(B1, 1, 1); PG8_STAGE(PG8_SB(1, 0), b3, voffB);
            PG8_BAR; PG8_WAIT_L(0); PG8_MMA(0, 1, At, B1); PG8_BAR;
            PG8_LDA(At, 1, 1); PG8_STAGE(PG8_SA(1, 0), a3, voffA);
            PG8_BAR; PG8_WAIT_L(0); PG8_MMA(1, 0, At, B0); PG8_BAR; PG8_SCHED;
            PG8_STAGE(PG8_SB(1, 1), b3 + hstep, voffB);
            PG8_WAIT_V(6); PG8_BAR; PG8_MMA(1, 1, At, B1); PG8_BAR;
            }
        }
        if constexpr (ALIGN_EPI) { if (wr == 0) PG8_BAR; }
        if constexpr (!Epi::AFTER_DRAIN) { int ln_; asm volatile("v_mbcnt_lo_u32_b32 %0, -1, 0\n\tv_mbcnt_hi_u32_b32 %0, -1, %0" : "=v"(ln_));
            E(acc, cur, wr, wc, ln_ & 15, ln_ >> 4); S.done(cur); }
        if (!has_next) break;
#pragma unroll
        for (int a = 0; a < 2; ++a)
#pragma unroll
            for (int b = 0; b < 2; ++b)
#pragma unroll
                for (int m = 0; m < 4; ++m)
#pragma unroll
                    for (int n = 0; n < 2; ++n) acc[a][b][m][n] = (f32x4){0.f, 0.f, 0.f, 0.f};
        cur = nxt; cA = nA; cB = nB; ++ui;
        if constexpr (ALIGN_EPI) { if (wr == 1) PG8_BAR; }
    }
    PG8_WAIT_V(0);
    if constexpr (!ALIGN_EPI) { if (wr == 0) PG8_BAR; }
    PG8_BAR;
    if constexpr (Epi::AFTER_DRAIN) { E.fused(acc, cur, wr, wc, fr, fq, lds, wid, lane); S.done(cur); }
#undef PG8_SA
#undef PG8_SB
#undef PG8_STAGE
#undef PG8_LDA
#undef PG8_LDB
#undef PG8_MMA
#undef PG8_WAIT_V
#undef PG8_WAIT_L
#undef PG8_BAR
#undef PG8_SCHED
}
}
constexpr int NWAVES = 8;
constexpr int BATCH = 8, SEQ = 4096, D = 2048, FF = 5632, DEPTH = 2;
constexpr int M = BATCH * SEQ;
constexpr int NGU = 2 * FF;
constexpr int H_A = 8, HD_A = 128, RANK = 256, IH = 8, IDIM = 64, TOPK = 256;
constexpr int H_B = 16, KVH = 2, GQA = 8, HD_B = 64, WINDOW = 128;
constexpr int D_IN = 3144;
constexpr float EPS = 1e-6f;
constexpr size_t MiB = 1u << 20;
constexpr size_t WS_CTL = 0, CTL_ZERO_BYTES = 1 * MiB;
#ifndef F8_MASK
#define F8_MASK 0xF
#endif
constexpr float W8_SCALE = 64.0f;
#ifndef GU_I8
#define GU_I8 1
#endif
constexpr float H8I_SCALE = 127.0f / 4.6f, W8I_SCALE = 127.0f / (4.2f * 0.022097086912079608f);
#ifndef D8_MASK
#define D8_MASK 0xF
#endif
constexpr float A8_SCALE = 8.0f;
__host__ __device__ constexpr bool d8_on(int l, int f) { return ((D8_MASK >> (2 * l + f)) & 1) != 0; }
constexpr float O8_SCALE = 16.0f;
#ifndef OUT_F8
#define OUT_F8 1
#endif
constexpr bool F8_ALL1 = (F8_MASK & 0x5) == 0x5, F8_ALL2 = (F8_MASK & 0xA) == 0xA;
__host__ __device__ constexpr bool f8_on(int l, int f) { return ((F8_MASK >> (2 * l + f)) & 1) != 0; }
constexpr size_t GU1_B = (F8_ALL1 ? 22 : 44) * MiB, GU2_B = (F8_ALL2 ? 22 : 44) * MiB;
constexpr size_t WS_W0 = 2 * MiB;
constexpr size_t WO_GU1 = 0, WO_D1 = GU1_B, WO_GU2 = WO_D1 + 22 * MiB, WO_D2 = WO_GU2 + GU2_B, WO_IN = WO_D2 + 22 * MiB, WO_OUT = WO_IN + 17 * MiB, W_LAYER = WO_OUT + 12 * MiB;
constexpr size_t WS_XN = WS_W0 + 2 * W_LAYER;
constexpr size_t WS_HB8 = WS_XN + 128 * MiB;
constexpr size_t WS_ACT = WS_HB8 + (F8_MASK ? 64 : 0) * MiB;
constexpr size_t WS_Z = WS_ACT, WS_CKVN = WS_ACT + 272 * MiB, WS_KIN = WS_ACT + 288 * MiB, WS_WIF = WS_ACT + 292 * MiB, WS_IDX = WS_ACT + 294 * MiB;
constexpr int ZLD = 4352, ZC_QLAT = 0, ZC_CKV = 2048, ZC_QB = 2304, ZC_KB = 3328, ZC_VB = 3456, ZC_QI = 3584, ZC_KI = 4096, ZC_WI = 4160;
constexpr int ZN8 = 3584;
#ifndef IN_I8
#define IN_I8 1
#endif
constexpr float WQ8I_SCALE = 127.0f / (4.2f * 0.015625f);
constexpr int OLD = 3072;
constexpr size_t WS_O = WS_ACT + 352 * MiB;
constexpr size_t WS_SS = WS_O + 192 * MiB, SS_BYTES = 4 * MiB;
constexpr size_t WS_END = WS_SS + 2 * SS_BYTES;
static_assert(WS_END <= 1024 * MiB, "d_ws map exceeds 1 GiB");
constexpr int CW_TMO = 0, CW_CODE = 1, CW_BAR = 4096, CW_XRANK = 8192;
constexpr int RING_OFF = 0, RING_BYTES = 131072;
constexpr int LDSCTL_OFF = RING_BYTES, MISC_OFF = LDSCTL_OFF + 320;
constexpr int LDS_BYTES = 147456;
constexpr int RSL_OFF = RING_BYTES + 5632;
#define GAS __attribute__((address_space(1)))
#define LAS __attribute__((address_space(3)))
typedef unsigned short bf16;
typedef unsigned v4u __attribute__((ext_vector_type(4)));
typedef float f32x4 __attribute__((ext_vector_type(4)));
typedef short bf16x8 __attribute__((ext_vector_type(8)));
typedef GAS unsigned gu32;
typedef GAS unsigned long long gu64;
#define RLX_AGENT __ATOMIC_RELAXED, __HIP_MEMORY_SCOPE_AGENT
#define LDS_WAIT() asm volatile("s_waitcnt lgkmcnt(0)" ::: "memory")
#define VM_WAIT() asm volatile("s_waitcnt vmcnt(0)" ::: "memory")
__device__ __forceinline__ unsigned long long rt() { return __builtin_amdgcn_s_memrealtime(); }
__device__ __forceinline__ unsigned f2bf(float f) { unsigned u = __builtin_bit_cast(unsigned, f); return (u + 0x7fffu + ((u >> 16) & 1u)) >> 16; }
__device__ __forceinline__ unsigned pk2(float lo, float hi) { return f2bf(lo) | (f2bf(hi) << 16); }

#define XB_TMO      128
#define XB_XCNT(j)  (256  + 64 * (j))
#define XB_XSUB(j)  (1280 + 64 * (j))
#define XB_XGEN(j)  (2304 + 64 * (j))
#define XB_TOP      3328
#define XB_TOPGEN   3392
#define XCD_BAR_WORDS 3456
#define XB_SPIN_CAP (1u << 18)

__device__ __forceinline__ unsigned xb_ld(unsigned* p)              { return __hip_atomic_load(p, __ATOMIC_RELAXED, __HIP_MEMORY_SCOPE_AGENT); }
__device__ __forceinline__ unsigned xb_add(unsigned* p, unsigned v) { return __hip_atomic_fetch_add(p, v, __ATOMIC_RELAXED, __HIP_MEMORY_SCOPE_AGENT); }
__device__ __forceinline__ unsigned xb_xcc_id() { return (unsigned)__builtin_amdgcn_s_getreg((3 << 11) | 20) & 0xFu; }
#define XB_SPIN(cond, bar) do { unsigned _sp = 0; while (cond) { __builtin_amdgcn_s_sleep(1); \
    if ((++_sp & 255u) == 0u) { if (xb_ld(&(bar)[XB_TMO])) break; if (_sp > XB_SPIN_CAP) { atomicAdd(&(bar)[XB_TMO], 1u); break; } } } } while (0)

struct XcdBarrier {
    unsigned* bar; unsigned x;
    volatile LAS unsigned* st;
};

__device__ __forceinline__ XcdBarrier xcd_barrier_post(unsigned* bar, volatile LAS unsigned* st, bool leader  ) {
    XcdBarrier b; b.bar = bar; b.x = xb_xcc_id(); b.st = st;
    if (leader) (void)xb_add(&bar[XB_XCNT(b.x)], 1u);
    return b;
}
__device__ __forceinline__ void xcd_barrier_complete(unsigned* bar, unsigned x, unsigned& nloc, unsigned& nx) {
    const unsigned G = gridDim.x * gridDim.y * gridDim.z;
    unsigned sum, cnt, mine, sp = 0u;
    for (;;) {
        sum = 0u; cnt = 0u; mine = 0u;
#pragma unroll
        for (unsigned j = 0; j < 16; ++j) { const unsigned c = xb_ld(&bar[XB_XCNT(j)]); sum += c; cnt += (c > 0u) ? 1u : 0u; mine = (j == x) ? c : mine; }
        if (sum == G) break;
        __builtin_amdgcn_s_sleep(1);
        if ((++sp & 255u) == 0u) { if (xb_ld(&bar[XB_TMO])) break; if (sp > XB_SPIN_CAP) { atomicAdd(&bar[XB_TMO], 1u); break; } }
    }
    nloc = mine > 0u ? mine : 1u; nx = cnt > 0u ? cnt : 1u;
}

__device__ __forceinline__ void xcd_barrier(const XcdBarrier& b, bool leader  ) {
    asm volatile("s_waitcnt vmcnt(0)" ::: "memory");
    __syncthreads();
    if (leader) {
        unsigned* bar = b.bar;
        __builtin_amdgcn_s_waitcnt(0);
        unsigned nloc = b.st[0], nx = b.st[1];
        if (nloc == 0u) { xcd_barrier_complete(bar, b.x, nloc, nx); b.st[0] = nloc; b.st[1] = nx; }
        const unsigned old = xb_add(&bar[XB_XSUB(b.x)], 1u);
        const unsigned gen = old / nloc;
        if (old + 1u == (gen + 1u) * nloc) {
            __builtin_amdgcn_fence(__ATOMIC_RELEASE, "agent");
            asm volatile("s_waitcnt vmcnt(0)" ::: "memory");
            const unsigned og = xb_add(&bar[XB_TOP], 1u);
            const unsigned tg = og / nx;
            if (og + 1u == (tg + 1u) * nx) xb_add(&bar[XB_TOPGEN], 1u);
            else XB_SPIN(xb_ld(&bar[XB_TOPGEN]) == tg, bar);
            __builtin_amdgcn_fence(__ATOMIC_ACQUIRE, "agent");
            xb_add(&bar[XB_XGEN(b.x)], 1u);
            asm volatile("s_waitcnt vmcnt(0)" ::: "memory");
        } else {
            XB_SPIN(xb_ld(&bar[XB_XGEN(b.x)]) == gen, bar);
            __builtin_amdgcn_fence(__ATOMIC_ACQUIRE, "agent");
            asm volatile("s_waitcnt vmcnt(0)" ::: "memory");
        }
    }
    __syncthreads();
}
__constant__ unsigned char T5_BUCKET[128] = {0, 1, 2, 3, 4, 5, 6, 7, 8, 9, 10, 11, 12, 13, 14, 15, 16, 16, 16, 17, 17, 18, 18, 18, 19, 19, 19, 20, 20, 20, 20, 21, 21, 21, 21, 22, 22, 22, 22, 22, 23, 23, 23, 23, 23, 23, 24, 24, 24, 24, 24, 24, 25, 25, 25, 25, 25, 25, 25, 26, 26, 26, 26, 26, 26, 26, 26, 27, 27, 27, 27, 27, 27, 27, 27, 27, 27, 28, 28, 28, 28, 28, 28, 28, 28, 28, 28, 29, 29, 29, 29, 29, 29, 29, 29, 29, 29, 29, 29, 30, 30, 30, 30, 30, 30, 30, 30, 30, 30, 30, 30, 30, 30, 31, 31, 31, 31, 31, 31, 31, 31, 31, 31, 31, 31, 31, 31, 31};
typedef short s16x4 __attribute__((ext_vector_type(4)));
typedef float f32x16 __attribute__((ext_vector_type(16)));
__device__ __forceinline__ float bf2f(unsigned short b) { return __builtin_bit_cast(float, (unsigned)b << 16); }
__device__ __forceinline__ bf16x8 cat4(s16x4 lo, s16x4 hi) { return __builtin_shufflevector(lo, hi, 0, 1, 2, 3, 4, 5, 6, 7); }
__device__ __forceinline__ void tr_read4(unsigned a0, unsigned a1, unsigned a2, unsigned a3, s16x4& r0, s16x4& r1, s16x4& r2, s16x4& r3) {
    asm volatile("ds_read_b64_tr_b16 %0, %4\n\tds_read_b64_tr_b16 %1, %5\n\tds_read_b64_tr_b16 %2, %6\n\tds_read_b64_tr_b16 %3, %7\n\ts_waitcnt lgkmcnt(0)"
                 : "=&v"(r0), "=&v"(r1), "=&v"(r2), "=&v"(r3) : "v"(a0), "v"(a1), "v"(a2), "v"(a3) : "memory");
}
#define SHX(x, o) __builtin_bit_cast(float, __builtin_amdgcn_ds_bpermute(((lane) ^ (o)) << 2, __builtin_bit_cast(int, (float)(x))))
#define SHXU(x, o) ((unsigned)__builtin_amdgcn_ds_bpermute(((lane) ^ (o)) << 2, (int)(x)))
__device__ __forceinline__ float wave_sum(float v, int lane) {
#pragma unroll
    for (int o = 1; o < 64; o <<= 1) v += SHX(v, o);
    return v;
}
template <int OUT8 = 0>
__device__ __forceinline__ void conv_item(const GAS float* W, int ldw, int k0, int c0, int nvalid, GAS bf16* dst, int dld, int drow0, int dk0, float scale, const GAS float* gain, LAS float* scr, int lane) {
    const int c = lane & 31;
    float vin[32];
#pragma unroll
    for (int i = 0; i < 32; ++i) { const int kk = 2 * i + (lane >> 5); vin[i] = 0.f;
        if (c < nvalid) vin[i] = W[(size_t)(k0 + kk) * ldw + c0 + c]; }
#pragma unroll
    for (int i = 0; i < 32; ++i) { const int kk = 2 * i + (lane >> 5); scr[kk * 33 + c] = vin[i] * scale; }
    LDS_WAIT(); asm volatile("" ::: "memory");
    const int c8 = lane & 7;
    f32x4 ga = {1.f, 1.f, 1.f, 1.f}, gb = {1.f, 1.f, 1.f, 1.f};
    if (gain) { ga = *(const GAS f32x4*)(gain + k0 + 8 * c8); gb = *(const GAS f32x4*)(gain + k0 + 8 * c8 + 4); }
#pragma unroll
    for (int j = 0; j < 4; ++j) { const int n = (lane >> 3) + 8 * j; const LAS float* s = scr + (8 * c8) * 33 + n;
        if constexpr (OUT8 == 2) { const unsigned p = pg8::pack4_i8(s[0 * 33] * ga.x, s[1 * 33] * ga.y, s[2 * 33] * ga.z, s[3 * 33] * ga.w, 1.0f), q = pg8::pack4_i8(s[4 * 33] * gb.x, s[5 * 33] * gb.y, s[6 * 33] * gb.z, s[7 * 33] * gb.w, 1.0f);
            *(GAS unsigned long long*)((GAS unsigned char*)dst + (size_t)(drow0 + n) * dld + dk0 + k0 + 8 * c8) = (unsigned long long)p | ((unsigned long long)q << 32); }
        else if constexpr (OUT8 == 1) { int p = 0, q = 0;
            p = __builtin_amdgcn_cvt_pk_fp8_f32(s[0 * 33] * ga.x, s[1 * 33] * ga.y, p, false); p = __builtin_amdgcn_cvt_pk_fp8_f32(s[2 * 33] * ga.z, s[3 * 33] * ga.w, p, true);
            q = __builtin_amdgcn_cvt_pk_fp8_f32(s[4 * 33] * gb.x, s[5 * 33] * gb.y, q, false); q = __builtin_amdgcn_cvt_pk_fp8_f32(s[6 * 33] * gb.z, s[7 * 33] * gb.w, q, true);
            *(GAS unsigned long long*)((GAS unsigned char*)dst + (size_t)(drow0 + n) * dld + dk0 + k0 + 8 * c8) = (unsigned long long)(unsigned)p | ((unsigned long long)(unsigned)q << 32); }
        else { v4u o; o.x = pk2(s[0 * 33] * ga.x, s[1 * 33] * ga.y); o.y = pk2(s[2 * 33] * ga.z, s[3 * 33] * ga.w); o.z = pk2(s[4 * 33] * gb.x, s[5 * 33] * gb.y); o.w = pk2(s[6 * 33] * gb.z, s[7 * 33] * gb.w);
            *(GAS v4u*)(dst + (size_t)(drow0 + n) * dld + dk0 + k0 + 8 * c8) = o; } }
    LDS_WAIT(); asm volatile("" ::: "memory");
}
__device__ __forceinline__ void rmsnorm_rows_bf16(const GAS float* X, const GAS float* g, GAS bf16* O, int gw, int NGW, int lane) {
    f32x4 gv[8];
#pragma unroll
    for (int j = 0; j < 8; ++j) gv[j] = ((const GAS f32x4*)g)[lane + 64 * j];
    for (int m = gw; m < M; m += NGW) {
        const GAS f32x4* xr = (const GAS f32x4*)(X + (size_t)m * D) + lane;
        f32x4 v[8]; float s = 0.f;
#pragma unroll
        for (int j = 0; j < 8; ++j) { v[j] = xr[64 * j]; s += (v[j].x * v[j].x + v[j].y * v[j].y) + (v[j].z * v[j].z + v[j].w * v[j].w); }
        const float r = 1.0f / sqrtf(wave_sum(s, lane) * (1.0f / D) + EPS);
        GAS unsigned long long* o8 = (GAS unsigned long long*)(O + (size_t)m * D) + lane;
#pragma unroll
        for (int j = 0; j < 8; ++j) { const f32x4 y = v[j] * r * gv[j]; o8[64 * j] = (unsigned long long)pk2(y.x, y.y) | ((unsigned long long)pk2(y.z, y.w) << 32); }
    }
}
__device__ __forceinline__ void rows_bf16_ss(const GAS float* X, GAS bf16* O, GAS unsigned char* O8, GAS float* ss, int gw, int NGW, int lane) {
    for (int m = gw; m < M; m += NGW) {
        const GAS f32x4* xr = (const GAS f32x4*)(X + (size_t)m * D) + lane;
        f32x4 v[8]; float s = 0.f;
#pragma unroll
        for (int j = 0; j < 8; ++j) { v[j] = xr[64 * j]; s += (v[j].x * v[j].x + v[j].y * v[j].y) + (v[j].z * v[j].z + v[j].w * v[j].w); }
        s = wave_sum(s, lane);
        GAS unsigned long long* o8 = (GAS unsigned long long*)(O + (size_t)m * D) + lane;
#pragma unroll
        for (int j = 0; j < 8; ++j) o8[64 * j] = (unsigned long long)pk2(v[j].x, v[j].y) | ((unsigned long long)pk2(v[j].z, v[j].w) << 32);
        if (O8) { GAS unsigned* q8 = (GAS unsigned*)(O8 + (size_t)m * D) + lane;
#pragma unroll
            for (int j = 0; j < 8; ++j) { if constexpr (GU_I8) q8[64 * j] = pg8::pack4_i8(v[j].x, v[j].y, v[j].z, v[j].w, H8I_SCALE); else { int p = 0; p = __builtin_amdgcn_cvt_pk_fp8_f32(v[j].x, v[j].y, p, false); p = __builtin_amdgcn_cvt_pk_fp8_f32(v[j].z, v[j].w, p, true); q8[64 * j] = (unsigned)p; } } }
        if (lane < 32) ss[(size_t)m * 32 + lane] = lane == 0 ? s : 0.f;
    }
}
__device__ __forceinline__ void final_rows(const GAS bf16* HB, GAS float* OUT, const GAS float* g, const GAS float* ss, int gw, int NGW, int lane) {
    f32x4 gv[8];
#pragma unroll
    for (int j = 0; j < 8; ++j) gv[j] = ((const GAS f32x4*)g)[lane + 64 * j];
    for (int m = gw; m < M; m += NGW) {
        const GAS unsigned long long* hr = (const GAS unsigned long long*)(HB + (size_t)m * D) + lane; GAS f32x4* orow = (GAS f32x4*)(OUT + (size_t)m * D) + lane;
        unsigned long long raw[8];
#pragma unroll
        for (int j = 0; j < 8; ++j) raw[j] = hr[64 * j];
        const float r = 1.0f / sqrtf(wave_sum(lane < 32 ? ss[(size_t)m * 32 + lane] : 0.f, lane) * (1.0f / D) + EPS);
#pragma unroll
        for (int j = 0; j < 8; ++j) { const unsigned lo = (unsigned)raw[j], hi = (unsigned)(raw[j] >> 32);
            f32x4 v = {__builtin_bit_cast(float, lo << 16), __builtin_bit_cast(float, lo & 0xffff0000u), __builtin_bit_cast(float, hi << 16), __builtin_bit_cast(float, hi & 0xffff0000u)};
            orow[64 * j] = v * r * gv[j]; }
    }
}
__device__ __forceinline__ void rmsnorm_rows_f32_inplace(GAS float* X, const GAS float* g, int gw, int NGW, int lane) {
    f32x4 gv[8];
#pragma unroll
    for (int j = 0; j < 8; ++j) gv[j] = ((const GAS f32x4*)g)[lane + 64 * j];
    for (int m = gw; m < M; m += NGW) {
        GAS f32x4* xr = (GAS f32x4*)(X + (size_t)m * D) + lane;
        f32x4 v[8]; float s = 0.f;
#pragma unroll
        for (int j = 0; j < 8; ++j) { v[j] = xr[64 * j]; s += (v[j].x * v[j].x + v[j].y * v[j].y) + (v[j].z * v[j].z + v[j].w * v[j].w); }
        const float r = 1.0f / sqrtf(wave_sum(s, lane) * (1.0f / D) + EPS);
#pragma unroll
        for (int j = 0; j < 8; ++j) xr[64 * j] = v[j] * r * gv[j];
    }
}

template <bool P_IFAST, int OUT8 = 0>
__device__ __forceinline__ void absorb_unit(const GAS float* Psrc, size_t p_ri, size_t p_rd, const GAS float* Qsrc, size_t q_rj, GAS bf16* out, size_t out_ld, float scale, const GAS float* qgain, LAS float* Ps_, LAS float* Qs_, int tid) {
    LAS bf16* Ps = (LAS bf16*)Ps_; LAS bf16* Qs = Ps + 64 * 136;
    float pv[16], qv[16];
#pragma unroll
    for (int j = 0; j < 16; ++j) { const int e = tid + 512 * j; const int i = P_IFAST ? (e & 63) : (e >> 7), d = P_IFAST ? (e >> 6) : (e & 127);
        pv[j] = Psrc[(size_t)i * p_ri + (size_t)d * p_rd];
        const int jj = e >> 7, dd = e & 127; qv[j] = Qsrc[(size_t)jj * q_rj + dd] * (qgain ? qgain[jj] : 1.0f); }
#pragma unroll
    for (int j = 0; j < 16; ++j) { const int e = tid + 512 * j; const int i = P_IFAST ? (e & 63) : (e >> 7), d = P_IFAST ? (e >> 6) : (e & 127);
        Ps[i * 136 + d] = (bf16)f2bf(pv[j]); const int jj = e >> 7, dd = e & 127; Qs[jj * 136 + dd] = (bf16)f2bf(qv[j]); }
    __syncthreads();
    const int wv = tid >> 6, ln = tid & 63, it = wv >> 1, r16 = ln & 15, g = ln >> 4;
#pragma unroll
    for (int jq = 0; jq < 2; ++jq) { const int jt = 2 * (wv & 1) + jq; f32x4 acc = {0.f, 0.f, 0.f, 0.f};
#pragma unroll
        for (int st = 0; st < 4; ++st) { const bf16x8 a = *(const LAS bf16x8*)(Ps + (16 * it + r16) * 136 + 32 * st + 8 * g); const bf16x8 b = *(const LAS bf16x8*)(Qs + (16 * jt + r16) * 136 + 32 * st + 8 * g);
            acc = __builtin_amdgcn_mfma_f32_16x16x32_bf16(a, b, acc, 0, 0, 0); }
#pragma unroll
        for (int rg = 0; rg < 4; ++rg) { const size_t o = (size_t)(16 * it + 4 * g + rg) * out_ld + 16 * jt + r16;
            if constexpr (OUT8 == 2) ((GAS unsigned char*)out)[o] = (unsigned char)(pg8::pack4_i8(acc[rg], 0.f, 0.f, 0.f, scale) & 0xffu);
            else if constexpr (OUT8 == 1) ((GAS unsigned char*)out)[o] = (unsigned char)__builtin_amdgcn_cvt_pk_fp8_f32(acc[rg] * scale, 0.f, 0, false);
            else out[o] = (bf16)f2bf(acc[rg] * scale); } }
    __syncthreads();
}
__device__ __forceinline__ void post_rows(const GAS bf16* Z, const GAS float* gkv, const GAS float* gki, const GAS float* bki, GAS bf16* CKVN, GAS bf16* KIN, GAS float* WIF, int gw, int NGW, int lane) {
    const f32x4 g4 = ((const GAS f32x4*)gkv)[lane]; const float gk = gki[lane], bk = bki[lane];
    for (int m = gw; m < M; m += NGW) {
        const GAS bf16* zr = Z + (size_t)m * ZLD;
        const unsigned long long raw = *(const GAS unsigned long long*)(zr + ZC_CKV + 4 * lane);
        const float kraw = bf2f(zr[ZC_KI + lane]);
        const float wraw = bf2f(zr[ZC_WI + (lane & 7)]);
        const float c0 = bf2f((unsigned short)raw), c1 = bf2f((unsigned short)(raw >> 16)), c2 = bf2f((unsigned short)(raw >> 32)), c3 = bf2f((unsigned short)(raw >> 48));
        const float r = 1.0f / sqrtf(wave_sum((c0 * c0 + c1 * c1) + (c2 * c2 + c3 * c3), lane) * (1.0f / RANK) + EPS);
        *(GAS unsigned long long*)(CKVN + (size_t)m * RANK + 4 * lane) = (unsigned long long)pk2(c0 * r * g4.x, c1 * r * g4.y) | ((unsigned long long)pk2(c2 * r * g4.z, c3 * r * g4.w) << 32);
        const float mu = wave_sum(kraw, lane) * (1.0f / IDIM); const float dv = kraw - mu;
        const float var = wave_sum(dv * dv, lane) * (1.0f / IDIM);
        KIN[(size_t)m * IDIM + lane] = (bf16)f2bf(dv * (1.0f / sqrtf(var + EPS)) * gk + bk);
        if (lane < 8) WIF[(size_t)m * IH + lane] = wraw;
    }
}
constexpr int SWA_KP = 144, SWA_VP = 192;
constexpr int SWA_K_OFF = 0, SWA_V_OFF = 160 * SWA_KP, SWA_TAB_OFF = SWA_V_OFF + 160 * SWA_VP;
static_assert(SWA_TAB_OFF + 16 * 128 * 4 <= RING_BYTES, "SWA LDS map");
__device__ __forceinline__ void swa_phase(LAS unsigned char* lds, const GAS bf16* Z, GAS bf16* O, const GAS float* rel_bias, const GAS float* sinks, int vcu, int G, int tid, int lane, int wave) {
    LAS float* tab = (LAS float*)(lds + SWA_TAB_OFF);
    for (int e = tid; e < 16 * 128; e += NWAVES * 64) { const int h = e >> 7, dist = e & 127; tab[e] = rel_bias[(int)T5_BUCKET[dist] * 24 + H_A + h]; }
    __syncthreads();
    const int q = lane & 31, hh = lane >> 5;
    const unsigned ldsb = (unsigned)(size_t)lds;
    for (int item = vcu; item < BATCH * 128 * KVH; item += G) {
        const int kvh = item & 1, qt = (item >> 1) & 127, b = item >> 8;
        const int t0 = 32 * qt, s0 = t0 - 128;
        const size_t rowbase = (size_t)b * SEQ;
        for (int c = tid; c < 1280; c += NWAVES * 64) { const int row = c >> 3, ch = c & 7; const int s = s0 + row;
            if (s >= 0) { const GAS bf16* zr = Z + (rowbase + s) * ZLD + kvh * 64 + ch * 8;
                const v4u kv = *(const GAS v4u*)(zr + ZC_KB); const v4u vv = *(const GAS v4u*)(zr + ZC_VB);
                *(LAS v4u*)(lds + SWA_K_OFF + row * SWA_KP + ch * 16) = kv; *(LAS v4u*)(lds + SWA_V_OFF + row * SWA_VP + ch * 16) = vv; } }
        const int hq = kvh * 8 + wave; const int t = t0 + q;
        bf16x8 qf[4];
#pragma unroll
        for (int st = 0; st < 4; ++st) qf[st] = *(const GAS bf16x8*)(Z + (rowbase + t) * ZLD + ZC_QB + hq * 64 + 16 * st + 8 * hh);
        __syncthreads();
        const int kt0 = qt >= 4 ? 0 : 4 - qt;
        f32x16 sacc[5];
#pragma unroll
        for (int kt = 0; kt < 5; ++kt) {
#pragma unroll
            for (int r = 0; r < 16; ++r) sacc[kt][r] = 0.f;
            if (kt >= kt0) {
#pragma unroll
                for (int st = 0; st < 4; ++st) { const bf16x8 kf = *(const LAS bf16x8*)(lds + SWA_K_OFF + (kt * 32 + q) * SWA_KP + (2 * st + hh) * 16);
                    sacc[kt] = __builtin_amdgcn_mfma_f32_32x32x16_bf16(kf, qf[st], sacc[kt], 0, 0, 0); } } }
        const float sink = sinks[hq]; float mx = sink;
        const LAS float* tabh = tab + hq * 128;
#pragma unroll
        for (int kt = 0; kt < 5; ++kt) if (kt >= kt0) {
#pragma unroll
            for (int r = 0; r < 16; ++r) { const int ko = (r & 3) + 8 * (r >> 2) + 4 * hh; const int dist = q + 128 - 32 * kt - ko;
                const float lg = (dist >= 0 && dist < WINDOW) ? sacc[kt][r] + tabh[dist & 127] : -1e30f; sacc[kt][r] = lg; mx = fmaxf(mx, lg); } }
        mx = fmaxf(mx, SHX(mx, 32));
        float l = 0.f;
#pragma unroll
        for (int kt = 0; kt < 5; ++kt) if (kt >= kt0) {
#pragma unroll
            for (int r = 0; r < 16; ++r) { const float p = __expf(sacc[kt][r] - mx); sacc[kt][r] = p; l += p; } }
        l += SHX(l, 32); l += __expf(sink - mx);
        f32x16 oacc[2];
#pragma unroll
        for (int dt = 0; dt < 2; ++dt)
#pragma unroll
            for (int r = 0; r < 16; ++r) oacc[dt][r] = 0.f;
        const unsigned vlane = ldsb + SWA_V_OFF + (unsigned)((4 * hh + ((lane & 15) >> 2)) * SWA_VP + (16 * ((lane >> 4) & 1) + 4 * (lane & 3)) * 2);
#pragma unroll
        for (int kt = 0; kt < 5; ++kt) if (kt >= kt0) {
#pragma unroll
            for (int s2 = 0; s2 < 2; ++s2) {
                bf16x8 pf; { const unsigned w0 = pg8::cvt_pk_bf16(sacc[kt][8 * s2 + 0], sacc[kt][8 * s2 + 1]), w1 = pg8::cvt_pk_bf16(sacc[kt][8 * s2 + 2], sacc[kt][8 * s2 + 3]),
                                     w2 = pg8::cvt_pk_bf16(sacc[kt][8 * s2 + 4], sacc[kt][8 * s2 + 5]), w3 = pg8::cvt_pk_bf16(sacc[kt][8 * s2 + 6], sacc[kt][8 * s2 + 7]);
                    const v4u w = {w0, w1, w2, w3}; pf = __builtin_bit_cast(bf16x8, w); }
                const unsigned a = vlane + (unsigned)((kt * 32 + 16 * s2) * SWA_VP);
                s16x4 r0, r1, r2, r3; tr_read4(a, a + 8 * SWA_VP, a + 64, a + 8 * SWA_VP + 64, r0, r1, r2, r3);
                oacc[0] = __builtin_amdgcn_mfma_f32_32x32x16_bf16(cat4(r0, r1), pf, oacc[0], 0, 0, 0);
                oacc[1] = __builtin_amdgcn_mfma_f32_32x32x16_bf16(cat4(r2, r3), pf, oacc[1], 0, 0, 0); } }
        const float inv = (OUT_F8 ? O8_SCALE : 1.0f) / l;
        if constexpr (OUT_F8) { GAS unsigned char* orow = (GAS unsigned char*)O + (rowbase + t) * OLD + 2048 + hq * 64 + 4 * hh;
#pragma unroll
            for (int dt = 0; dt < 2; ++dt)
#pragma unroll
                for (int g4 = 0; g4 < 4; ++g4) { int p = 0; p = __builtin_amdgcn_cvt_pk_fp8_f32(oacc[dt][4 * g4] * inv, oacc[dt][4 * g4 + 1] * inv, p, false); p = __builtin_amdgcn_cvt_pk_fp8_f32(oacc[dt][4 * g4 + 2] * inv, oacc[dt][4 * g4 + 3] * inv, p, true);
                    *(GAS unsigned*)(orow + 32 * dt + 8 * g4) = (unsigned)p; } }
        else { GAS bf16* orow = O + (rowbase + t) * OLD + 2048 + hq * 64 + 4 * hh;
#pragma unroll
        for (int dt = 0; dt < 2; ++dt)
#pragma unroll
            for (int g4 = 0; g4 < 4; ++g4) { const unsigned long long w = (unsigned long long)pk2(oacc[dt][4 * g4] * inv, oacc[dt][4 * g4 + 1] * inv) | ((unsigned long long)pk2(oacc[dt][4 * g4 + 2] * inv, oacc[dt][4 * g4 + 3] * inv) << 32);
                *(GAS unsigned long long*)(orow + 32 * dt + 8 * g4) = w; } }
        __syncthreads();
    }
}
constexpr int TK_BINS = 512, TK_CAP = 256;
#define LDS_ADD(p) __hip_atomic_fetch_add((p), 1u, __ATOMIC_RELAXED, __HIP_MEMORY_SCOPE_WORKGROUP)
#define LDS_ADDV(p, v) __hip_atomic_fetch_add((p), (v), __ATOMIC_RELAXED, __HIP_MEMORY_SCOPE_WORKGROUP)
#define HIST_WORD(tok, bin) (((tok) * TK_BINS + (bin)) >> 1)
#define HIST_INC(bin) (1u << (((bin) & 1) * 16))
constexpr int TK_HIST_OFF = 0, TK_CSC_OFF = 32768, TK_CIX_OFF = TK_CSC_OFF + 32 * TK_CAP * 4, TK_SEL_OFF = TK_CIX_OFF + 32 * TK_CAP * 2, TK_CNT_OFF = TK_SEL_OFF + 32 * 256 * 2, TK_DUM_OFF = TK_CNT_OFF + 32 * 2 * 4, TK_KB_OFF = TK_DUM_OFF + 8 * 64 * 4, TK_KB_BYTES = 64 * 144, TK_FLAG_OFF = TK_KB_OFF + 2 * TK_KB_BYTES;
static_assert(TK_FLAG_OFF + 16 <= RING_BYTES, "top-k LDS map");
typedef _Float16 tk_h2 __attribute__((ext_vector_type(2)));
__device__ __forceinline__ void tk_score2(const f32x16& acc, const tk_h2 (&wh)[8], float& s0, float& s1) {
    tk_h2 s = {(_Float16)0, (_Float16)0}; const tk_h2 zero = {(_Float16)0, (_Float16)0};
#pragma unroll
    for (int h = 0; h < 8; ++h) { tk_h2 d = __builtin_bit_cast(tk_h2, __builtin_amdgcn_cvt_pkrtz(acc[h], acc[8 + h])); d = __builtin_elementwise_max(d, zero); s = __builtin_elementwise_fma(wh[h], d, s); }
    s0 = (float)s.x; s1 = (float)s.y;
}
__device__ __forceinline__ float tk_x(float s, float sc) { return fmaf(s, sc, 256.0f); }
__device__ __forceinline__ int tk_key(float s, float sc) {
    const float x = tk_x(s, sc); int b0 = (int)x; b0 = b0 < 0 ? 0 : (b0 > TK_BINS - 1 ? TK_BINS - 1 : b0);
    int sub = (int)((x - (float)b0) * 512.0f); sub = sub < 0 ? 0 : (sub > 511 ? 511 : sub);
    return b0 * 512 + sub;
}
__device__ __forceinline__ void tk_find(const LAS unsigned* h, unsigned need, int lane, int& bin_out, unsigned& above_out) {
    unsigned v[8]; unsigned s = 0;
#pragma unroll
    for (int i = 0; i < 4; ++i) { const unsigned w = h[4 * lane + i]; v[2 * i] = w & 0xffffu; v[2 * i + 1] = w >> 16; s += v[2 * i] + v[2 * i + 1]; }
    unsigned S = s;
#pragma unroll
    for (int o = 1; o < 64; o <<= 1) { const unsigned t = (unsigned)__builtin_amdgcn_ds_bpermute((lane + o) << 2, (int)S); if (lane + o < 64) S += t; }
    const unsigned long long mask = __ballot(S >= need);
    const int Lm = mask ? 63 - __builtin_clzll(mask) : 0;
    unsigned cum = S - s; int bsel = 8 * lane; unsigned ab = cum; bool found = false;
#pragma unroll
    for (int i = 7; i >= 0; --i) { if (!found) { if (cum + v[i] >= need) { bsel = 8 * lane + i; ab = cum; found = true; } else cum += v[i]; } }
    bin_out = __builtin_amdgcn_readlane(bsel, Lm); above_out = (unsigned)__builtin_amdgcn_readlane((int)ab, Lm);
}
__device__ __forceinline__ void topk_phase(LAS unsigned char* lds, const GAS bf16* Z, const GAS bf16* KIN, const GAS float* WIF, GAS unsigned short* IDX, int vcu, int G, int lane, int wave) {
    LAS unsigned* hist = (LAS unsigned*)(lds + TK_HIST_OFF) + wave * 4 * (TK_BINS / 2);
    LAS float* csc = (LAS float*)(lds + TK_CSC_OFF) + wave * 4 * TK_CAP;
    LAS unsigned short* cix = (LAS unsigned short*)(lds + TK_CIX_OFF) + wave * 4 * TK_CAP;
    LAS unsigned short* sel = (LAS unsigned short*)(lds + TK_SEL_OFF) + wave * 4 * 256;
    LAS unsigned* cnt = (LAS unsigned*)(lds + TK_CNT_OFF) + wave * 8;
    LAS unsigned* dum = (LAS unsigned*)(lds + TK_DUM_OFF) + wave * 64 + lane;
    const int n = lane & 31, c = lane >> 5;
    const int am = (lane >> 4) & 1, bbm = (lane >> 3) & 1, ccm = (lane >> 2) & 1, dm = lane & 3;
    for (int p2 = vcu; p2 < BATCH * 64; p2 += G) {
#pragma unroll 1
        for (int half = 0; half < 2; ++half) {
            const int b = p2 >> 6, jj = p2 & 63, j = half ? 127 - jj : jj;
            const int t0 = 32 * j + 4 * wave; const size_t rb = (size_t)b * SEQ;
            bf16x8 qa[4];
#pragma unroll
            for (int st = 0; st < 4; ++st) qa[st] = *(const GAS bf16x8*)(Z + (rb + t0 + 2 * ccm + am) * ZLD + ZC_QI + (4 * bbm + dm) * 64 + 16 * st + 8 * c);
            float w0[8], w1[8];
            { const GAS f32x4* wp = (const GAS f32x4*)(WIF + (rb + t0 + 2 * c) * IH); const f32x4 x0 = wp[0], x1 = wp[1], x2 = wp[2], x3 = wp[3];
              w0[0] = x0.x; w0[1] = x0.y; w0[2] = x0.z; w0[3] = x0.w; w0[4] = x1.x; w0[5] = x1.y; w0[6] = x1.z; w0[7] = x1.w;
              w1[0] = x2.x; w1[1] = x2.y; w1[2] = x2.z; w1[3] = x2.w; w1[4] = x3.x; w1[5] = x3.y; w1[6] = x3.z; w1[7] = x3.w; }
            tk_h2 wh[8];
#pragma unroll
            for (int h = 0; h < 8; ++h) { wh[h].x = (_Float16)w0[h]; wh[h].y = (_Float16)w1[h]; }
            float scA, scB;
            { float a = 0.f, bq = 0.f;
#pragma unroll
              for (int h = 0; h < 8; ++h) { a = fmaf(w0[h], w0[h], a); bq = fmaf(w1[h], w1[h], bq); }
              scA = 32.0f / fmaxf(sqrtf(32.0f * a), 1e-20f); scB = 32.0f / fmaxf(sqrtf(32.0f * bq), 1e-20f); }
            const int tA = t0 + 2 * c, tB = tA + 1;
            for (int i = lane; i < 4 * (TK_BINS / 2); i += 64) hist[i] = 0u;
            for (int i = lane; i < 4 * 128; i += 64) ((LAS unsigned*)sel)[i] = 0u;
            if (lane < 8) cnt[lane] = 0u;
            asm volatile("s_waitcnt lgkmcnt(0)" ::: "memory");
            int lo[4], hi[4]; unsigned ab0[4]; bool ov[4];
#pragma unroll
            for (int tk = 0; tk < 4; ++tk) { lo[tk] = 0x7fffffff; hi[tk] = -1; ab0[tk] = 0u; ov[tk] = false; }
            const bool need_sel = (t0 + 3) >= TOPK;
            const GAS bf16* kbase = KIN + (rb + n) * IDIM + 8 * c;
            const int tidk = wave * 64 + lane; const int ng = (j + 2) >> 1;
            const GAS bf16* kg0 = KIN + (rb + (tidk >> 3)) * IDIM + (tidk & 7) * 8; const int koff = (tidk >> 3) * 144 + (tidk & 7) * 16;
            LAS unsigned char* kbuf = lds + TK_KB_OFF; volatile LAS unsigned* sflag = (volatile LAS unsigned*)(lds + TK_FLAG_OFF);
            if (tidk == 0) *sflag = 0u;
#define TK_PRIME() { const v4u kr0 = *(const GAS v4u*)kg0; *(LAS v4u*)(kbuf + koff) = kr0; } __syncthreads();
#define TK_GROUP_BEGIN() \
                v4u kr = {0u, 0u, 0u, 0u}; const bool more = g + 1 < ng; \
                if (more) kr = *(const GAS v4u*)(kg0 + (size_t)(g + 1) * 64 * IDIM); \
                const LAS unsigned char* kb_ = kbuf + (g & 1) * TK_KB_BYTES; \
                float s0v[2], s1v[2];     \
                { f32x16 accv[2]; \
                  _Pragma("unroll") for (int u4 = 0; u4 < 2; ++u4) { _Pragma("unroll") for (int r = 0; r < 16; ++r) accv[u4][r] = 0.f; \
                    _Pragma("unroll") for (int st = 0; st < 4; ++st) { const bf16x8 kf = *(const LAS bf16x8*)(kb_ + (32 * u4 + n) * 144 + (2 * st + c) * 16); accv[u4] = __builtin_amdgcn_mfma_f32_32x32x16_bf16(qa[st], kf, accv[u4], 0, 0, 0); } } \
                  _Pragma("unroll") for (int u4 = 0; u4 < 2; ++u4) tk_score2(accv[u4], wh, s0v[u4], s1v[u4]); } \
                _Pragma("unroll") for (int u4 = 0; u4 < 2; ++u4) { \
                    const float s0 = s0v[u4], s1 = s1v[u4]; const int s = 32 * (2 * g + u4) + n;
#define TK_GROUP_END() } \
                if (more) *(LAS v4u*)(kbuf + ((g + 1) & 1) * TK_KB_BYTES + koff) = kr; \
                __syncthreads();
            bool slow = false;
            if (need_sel) {
                {   TK_PRIME();
#pragma unroll 1
                    for (int g = 0; g < ng; ++g) { TK_GROUP_BEGIN()
                        int b0 = (int)tk_x(s0, scA), b1 = (int)tk_x(s1, scB); b0 = b0 < 0 ? 0 : (b0 > TK_BINS - 1 ? TK_BINS - 1 : b0); b1 = b1 < 0 ? 0 : (b1 > TK_BINS - 1 ? TK_BINS - 1 : b1);
                        LAS unsigned* p0 = (s <= tA) ? &hist[HIST_WORD(2 * c, b0)] : dum; LAS unsigned* p1 = (s <= tB) ? &hist[HIST_WORD(2 * c + 1, b1)] : dum;
                        LDS_ADDV(p0, HIST_INC(b0)); LDS_ADDV(p1, HIST_INC(b1));
                        TK_GROUP_END() }
                }
                asm volatile("s_waitcnt lgkmcnt(0)" ::: "memory");
#pragma unroll
                for (int tk = 0; tk < 4; ++tk) { int bin; unsigned above; tk_find(hist + tk * (TK_BINS / 2), (unsigned)TOPK, lane, bin, above);
                    const unsigned ceq = (hist[HIST_WORD(tk, bin)] >> ((bin & 1) * 16)) & 0xffffu; ov[tk] = ceq > (unsigned)TK_CAP; slow |= ov[tk]; ab0[tk] = above; lo[tk] = bin * 512; hi[tk] = bin * 512 + 511; }
                if (slow && lane == 0) *sflag = 1u;
                __syncthreads();
                slow = *sflag != 0u;
            }
            if (!slow) {
                float thi[4], tlo[4];
#pragma unroll
                for (int tk = 0; tk < 4; ++tk) { const int bin = lo[tk] >> 9;
                    thi[tk] = !need_sel ? -__builtin_inff() : (bin >= TK_BINS - 1 ? __builtin_inff() : (float)(bin + 1));
                    tlo[tk] = !need_sel ? __builtin_inff() : (bin == 0 ? -__builtin_inff() : (float)bin); }
                const float thiA = c ? thi[2] : thi[0], tloA = c ? tlo[2] : tlo[0], thiB = c ? thi[3] : thi[1], tloB = c ? tlo[3] : tlo[1];
                unsigned cntA = 0u, cntB = 0u;
                LAS unsigned short* selA = sel + (2 * c) * 256; LAS unsigned short* selB = sel + (2 * c + 1) * 256; LAS unsigned short* dum16 = (LAS unsigned short*)dum;
                TK_PRIME();
#pragma unroll 1
                for (int g = 0; g < ng; ++g) { TK_GROUP_BEGIN()
                    const float x0 = (s <= tA) ? tk_x(s0, scA) : __builtin_nanf(""), x1 = (s <= tB) ? tk_x(s1, scB) : __builtin_nanf("");
                    const bool a0 = x0 >= thiA, a1 = x1 >= thiB; const bool c0 = !a0 && x0 >= tloA, c1 = !a1 && x1 >= tloB;
                    const unsigned long long m0 = __ballot(a0), m1 = __ballot(a1);
                    const unsigned pre0 = c ? __builtin_amdgcn_mbcnt_hi((unsigned)(m0 >> 32), 0u) : __builtin_amdgcn_mbcnt_lo((unsigned)m0, 0u);
                    const unsigned pre1 = c ? __builtin_amdgcn_mbcnt_hi((unsigned)(m1 >> 32), 0u) : __builtin_amdgcn_mbcnt_lo((unsigned)m1, 0u);
                    const unsigned pos0 = cntA + pre0, pos1 = cntB + pre1;
                    LAS unsigned short* q0 = (a0 && pos0 < 256u) ? selA + pos0 : dum16; LAS unsigned short* q1 = (a1 && pos1 < 256u) ? selB + pos1 : dum16;
                    *q0 = (unsigned short)s; *q1 = (unsigned short)s;
                    cntA += c ? (unsigned)__builtin_popcount((unsigned)(m0 >> 32)) : (unsigned)__builtin_popcount((unsigned)m0);
                    cntB += c ? (unsigned)__builtin_popcount((unsigned)(m1 >> 32)) : (unsigned)__builtin_popcount((unsigned)m1);
                    if (__ballot(c0 || c1)) {
                        if (c0) { const unsigned pos = LDS_ADD(&cnt[(2 * c) * 2 + 1]); if (pos < (unsigned)TK_CAP) { csc[(2 * c) * TK_CAP + pos] = s0; cix[(2 * c) * TK_CAP + pos] = (unsigned short)s; } }
                        if (c1) { const unsigned pos = LDS_ADD(&cnt[(2 * c + 1) * 2 + 1]); if (pos < (unsigned)TK_CAP) { csc[(2 * c + 1) * TK_CAP + pos] = s1; cix[(2 * c + 1) * TK_CAP + pos] = (unsigned short)s; } } }
                    TK_GROUP_END() }
                if ((lane & 31) == 0) { cnt[(2 * c) * 2] = cntA; cnt[(2 * c + 1) * 2] = cntB; }
                asm volatile("s_waitcnt lgkmcnt(0)" ::: "memory");
            } else {
                for (int i = lane; i < 4 * (TK_BINS / 2); i += 64) hist[i] = 0u;
                asm volatile("s_waitcnt lgkmcnt(0)" ::: "memory");
                int mode = 1;
#pragma unroll 1
                for (;;) {
                const int klo0 = c ? lo[2] : lo[0], khi0 = c ? hi[2] : hi[0], klo1 = c ? lo[3] : lo[1], khi1 = c ? hi[3] : hi[1];
                const bool ov0 = c ? ov[2] : ov[0], ov1 = c ? ov[3] : ov[1];
                bf16x8 kb[4][4];
#pragma unroll
                for (int u4 = 0; u4 < 4; ++u4) { const int kq = u4 < j ? u4 : j;
#pragma unroll
                    for (int st = 0; st < 4; ++st) kb[u4][st] = *(const GAS bf16x8*)(kbase + (size_t)kq * 32 * IDIM + 16 * st); }
#pragma unroll 1
                for (int kt = 0; kt <= j; kt += 4) {
                    bf16x8 kn[4][4];
#pragma unroll
                    for (int u4 = 0; u4 < 4; ++u4) { const int kq = kt + 4 + u4 < j ? kt + 4 + u4 : j;
#pragma unroll
                        for (int st = 0; st < 4; ++st) kn[u4][st] = *(const GAS bf16x8*)(kbase + (size_t)kq * 32 * IDIM + 16 * st); }
#pragma unroll
                    for (int u4 = 0; u4 < 4; ++u4) {
                        f32x16 acc;
#pragma unroll
                        for (int r = 0; r < 16; ++r) acc[r] = 0.f;
#pragma unroll
                        for (int st = 0; st < 4; ++st) acc = __builtin_amdgcn_mfma_f32_32x32x16_bf16(qa[st], kb[u4][st], acc, 0, 0, 0);
                        float s0, s1; tk_score2(acc, wh, s0, s1);
                        const int s = 32 * (kt + u4) + n; const int k0 = tk_key(s0, scA), k1 = tk_key(s1, scB);
                        const bool v0 = s <= tA, v1 = s <= tB;
                        if (mode == 0) {
                            if (v0 && tA >= TOPK) LDS_ADDV(&hist[HIST_WORD(2 * c, k0 >> 9)], HIST_INC(k0 >> 9));
                            if (v1 && tB >= TOPK) LDS_ADDV(&hist[HIST_WORD(2 * c + 1, k1 >> 9)], HIST_INC(k1 >> 9));
                        } else if (mode == 1) {
                            if (v0 && ov0 && k0 >= klo0 && k0 <= khi0) LDS_ADDV(&hist[HIST_WORD(2 * c, k0 & 511)], HIST_INC(k0 & 511));
                            if (v1 && ov1 && k1 >= klo1 && k1 <= khi1) LDS_ADDV(&hist[HIST_WORD(2 * c + 1, k1 & 511)], HIST_INC(k1 & 511));
                        } else {
                            if (v0) { if (k0 > khi0) { const unsigned pos = LDS_ADD(&cnt[(2 * c) * 2]); if (pos < 256u) sel[(2 * c) * 256 + pos] = (unsigned short)s; }
                                      else if (k0 >= klo0) { const unsigned pos = LDS_ADD(&cnt[(2 * c) * 2 + 1]); if (pos < (unsigned)TK_CAP) { csc[(2 * c) * TK_CAP + pos] = s0; cix[(2 * c) * TK_CAP + pos] = (unsigned short)s; } } }
                            if (v1) { if (k1 > khi1) { const unsigned pos = LDS_ADD(&cnt[(2 * c + 1) * 2]); if (pos < 256u) sel[(2 * c + 1) * 256 + pos] = (unsigned short)s; }
                                      else if (k1 >= klo1) { const unsigned pos = LDS_ADD(&cnt[(2 * c + 1) * 2 + 1]); if (pos < (unsigned)TK_CAP) { csc[(2 * c + 1) * TK_CAP + pos] = s1; cix[(2 * c + 1) * TK_CAP + pos] = (unsigned short)s; } } }
                        }
                    }
#pragma unroll
                    for (int u4 = 0; u4 < 4; ++u4)
#pragma unroll
                        for (int st = 0; st < 4; ++st) kb[u4][st] = kn[u4][st];
                }
                    asm volatile("s_waitcnt lgkmcnt(0)" ::: "memory");
                    if (mode == 2) break;
#pragma unroll
                    for (int tk = 0; tk < 4; ++tk) if (ov[tk]) { int sub; unsigned above; tk_find(hist + tk * (TK_BINS / 2), (unsigned)TOPK - ab0[tk], lane, sub, above); lo[tk] += sub; hi[tk] = lo[tk]; }
                    mode = 2;
                }
            }
#undef TK_GROUP_BEGIN
#undef TK_GROUP_END
#undef TK_PRIME
#pragma unroll 1
            for (int tk = 0; tk < 4; ++tk) { const int t = t0 + tk;
                if (t >= TOPK) { const unsigned nsel = cnt[tk * 2]; unsigned nc = cnt[tk * 2 + 1]; nc = nc > (unsigned)TK_CAP ? (unsigned)TK_CAP : nc; const unsigned need = nsel < 256u ? 256u - nsel : 0u;
                    for (unsigned q = 0; q * 64 < nc; ++q) { const unsigned i = lane + 64 * q;
                        const float si = i < nc ? csc[tk * TK_CAP + i] : 0.f; const unsigned xi = i < nc ? cix[tk * TK_CAP + i] : 0u; unsigned rank = 0;
                        for (unsigned jx = 0; jx < nc; ++jx) { const float sj = csc[tk * TK_CAP + jx]; const unsigned xj = cix[tk * TK_CAP + jx]; rank += (sj > si || (sj == si && xj < xi)) ? 1u : 0u; }
                        if (i < nc && rank < need) sel[tk * 256 + nsel + rank] = (unsigned short)xi; } } }
            asm volatile("s_waitcnt lgkmcnt(0)" ::: "memory");
            { const LAS v4u* sv = (const LAS v4u*)sel; GAS v4u* ov = (GAS v4u*)(IDX + (rb + t0) * TOPK);
              ov[lane] = sv[lane]; ov[lane + 64] = sv[lane + 64]; }
            asm volatile("s_waitcnt vmcnt(0) lgkmcnt(0)" ::: "memory");
        }
    }
}
constexpr int DSA_TAB_OFF = RING_BYTES + 1024;
static_assert(DSA_TAB_OFF + 8 * 129 * 4 <= LDS_BYTES, "DSA LDS map");
__device__ __forceinline__ void dsa_phase(LAS unsigned char* lds_all, const GAS bf16* Z, const GAS bf16* CKVN, const GAS unsigned short* IDX, GAS bf16* O, const GAS float* rel_bias, int gw, int NGW, int tid, int lane, int wave) {
    LAS float* tab = (LAS float*)(lds_all + DSA_TAB_OFF);
    for (int e = tid; e < 8 * 129; e += NWAVES * 64) { const int hh = e / 129, dist = e - hh * 129; tab[e] = rel_bias[(dist < 128 ? (int)T5_BUCKET[dist] : 31) * 24 + hh]; }
    __syncthreads();
    LAS unsigned char* img = lds_all + RING_OFF + wave * 16384;
    const unsigned imgb = (unsigned)(size_t)img;
    const int h = lane & 15, g = lane >> 4;
    const LAS float* tabh = tab + (h & 7) * 129;
    const int TPW = (M + NGW - 1) / NGW;
    const int tok_end = (gw + 1) * TPW < M ? (gw + 1) * TPW : M;
    const int xq = 2 * (lane & 7);
    const int qk_off = (lane & 15) * 512;
    const int q4 = (lane & 15) >> 2, p4 = lane & 3; const int xr = 2 * (4 * (g & 1) + q4);
    const unsigned pv_base = imgb + (unsigned)((4 * g + q4) * 512 + 8 * (p4 & 1));
#pragma unroll 1
    for (int tok = gw * TPW; tok < tok_end; ++tok) {
        const int t = tok & (SEQ - 1); const size_t rb = (size_t)(tok - t);
        const int nsel = t + 1 < TOPK ? t + 1 : TOPK;
        bf16x8 qf[8];
#pragma unroll
        for (int st = 0; st < 8; ++st) { qf[st] = *(const GAS bf16x8*)(Z + (size_t)tok * ZLD + ZC_QLAT + (h & 7) * 256 + 32 * st + 8 * g); if (h >= 8) qf[st] = (bf16x8){0, 0, 0, 0, 0, 0, 0, 0}; }
        f32x4 oacc[16];
#pragma unroll
        for (int rt = 0; rt < 16; ++rt) oacc[rt] = (f32x4){0.f, 0.f, 0.f, 0.f};
        float mrun = -1e30f, lsum = 0.f;
        const GAS unsigned short* ip = IDX + (size_t)tok * TOPK;
        int ixa[8];
#pragma unroll
        for (int ch = 0; ch < 8; ++ch) ixa[ch] = (int)ip[32 * ch + (lane & 31)];
        unsigned long long i0n = *(const GAS unsigned long long*)(ip + 4 * g), i1n = *(const GAS unsigned long long*)(ip + 16 + 4 * g);
#pragma unroll
        for (int ch = 0; ch < 8; ++ch) {
            if (32 * ch >= nsel) break;
            const int ixv = ixa[ch];
            const unsigned long long i0 = i0n, i1 = i1n;
            if (ch < 7) { i0n = *(const GAS unsigned long long*)(ip + 32 * (ch + 1) + 4 * g); i1n = *(const GAS unsigned long long*)(ip + 32 * (ch + 1) + 16 + 4 * g); }
            asm volatile("s_waitcnt lgkmcnt(0)" ::: "memory");
#pragma unroll
            for (int i = 0; i < 16; ++i) { const int r0 = __builtin_amdgcn_readlane(ixv, 2 * i), r1 = __builtin_amdgcn_readlane(ixv, 2 * i + 1);
                const int row = 2 * i + (lane >> 5); const int ridx = lane < 32 ? r0 : r1; const int chunk = (lane & 31) ^ (2 * (row & 7));
                const GAS unsigned char* src = (const GAS unsigned char*)(CKVN + (rb + ridx) * RANK) + chunk * 16;
                __builtin_amdgcn_global_load_lds((const GAS unsigned*)src, (LAS unsigned*)(img + i * 1024), 16, 0, 0); }
            asm volatile("s_waitcnt vmcnt(0)" ::: "memory");
            f32x4 sa[2];
#pragma unroll
            for (int tl = 0; tl < 2; ++tl) { sa[tl] = (f32x4){0.f, 0.f, 0.f, 0.f};
#pragma unroll
                for (int st = 0; st < 8; ++st) { const bf16x8 a = *(const LAS bf16x8*)(img + qk_off + tl * 16 * 512 + (((4 * st + g) ^ xq) * 16));
                    sa[tl] = __builtin_amdgcn_mfma_f32_16x16x32_bf16(a, qf[st], sa[tl], 0, 0, 0); } }
            float lg[8]; float cmax = -1e30f;
#pragma unroll
            for (int e = 0; e < 8; ++e) { const int tl = e >> 2, jx = e & 3; const int kk = 32 * ch + 16 * tl + 4 * g + jx;
                const int sidx = (int)(((tl ? i1 : i0) >> (16 * jx)) & 0xffffull); int dd = t - sidx; dd = dd < 0 ? 0 : (dd > 128 ? 128 : dd);
                const float v = kk < nsel ? sa[tl][jx] + tabh[dd] : -1e30f; lg[e] = v; cmax = fmaxf(cmax, v); }
            cmax = fmaxf(cmax, SHX(cmax, 16)); cmax = fmaxf(cmax, SHX(cmax, 32));
            const float mnew = fmaxf(mrun, cmax);
            if (__any(mnew > mrun)) { const float alpha = __expf(mrun - mnew); lsum *= alpha;
#pragma unroll
                for (int rt = 0; rt < 16; ++rt) oacc[rt] = oacc[rt] * alpha; }
            mrun = mnew;
            float pe[8];
#pragma unroll
            for (int e = 0; e < 8; ++e) { pe[e] = __expf(lg[e] - mnew); lsum += pe[e]; }
            bf16x8 pf; { const v4u wv = {pg8::cvt_pk_bf16(pe[0], pe[1]), pg8::cvt_pk_bf16(pe[2], pe[3]), pg8::cvt_pk_bf16(pe[4], pe[5]), pg8::cvt_pk_bf16(pe[6], pe[7])}; pf = __builtin_bit_cast(bf16x8, wv); }
#pragma unroll
            for (int rt = 0; rt < 16; rt += 2) {
                const unsigned a0 = pv_base + (unsigned)((((2 * rt) ^ xr) | (p4 >> 1)) * 16), a1 = pv_base + (unsigned)((((2 * rt + 2) ^ xr) | (p4 >> 1)) * 16);
                s16x4 r0, r1, r2, r3; tr_read4(a0, a0 + 16 * 512, a1, a1 + 16 * 512, r0, r1, r2, r3);
                oacc[rt] = __builtin_amdgcn_mfma_f32_16x16x32_bf16(cat4(r0, r1), pf, oacc[rt], 0, 0, 0);
                oacc[rt + 1] = __builtin_amdgcn_mfma_f32_16x16x32_bf16(cat4(r2, r3), pf, oacc[rt + 1], 0, 0, 0); }
        }
        lsum += SHX(lsum, 16); lsum += SHX(lsum, 32);
        const float inv = (OUT_F8 ? O8_SCALE : 1.0f) / lsum;
        if (h < 8) {
            if constexpr (OUT_F8) { GAS unsigned char* orow = (GAS unsigned char*)O + (size_t)tok * OLD + h * 256 + 4 * g;
#pragma unroll
                for (int rt = 0; rt < 16; ++rt) { int p = 0; p = __builtin_amdgcn_cvt_pk_fp8_f32(oacc[rt][0] * inv, oacc[rt][1] * inv, p, false); p = __builtin_amdgcn_cvt_pk_fp8_f32(oacc[rt][2] * inv, oacc[rt][3] * inv, p, true); *(GAS unsigned*)(orow + 16 * rt) = (unsigned)p; } }
            else { GAS bf16* orow = O + (size_t)tok * OLD + h * 256 + 4 * g;
#pragma unroll
            for (int rt = 0; rt < 16; ++rt) *(GAS unsigned long long*)(orow + 16 * rt) = (unsigned long long)pk2(oacc[rt][0] * inv, oacc[rt][1] * inv) | ((unsigned long long)pk2(oacc[rt][2] * inv, oacc[rt][3] * inv) << 32); } }
    }
}
struct Args { const float* in[20]; float* out; unsigned char* ws; };
__device__ __forceinline__ unsigned long long karg_u64(int idx) { unsigned long long r; const unsigned off = (unsigned)idx * 8u;
    asm volatile("s_load_dwordx2 %0, %1, %2\n\ts_waitcnt lgkmcnt(0)" : "=s"(r) : "s"(__builtin_amdgcn_kernarg_segment_ptr()), "s"(off) : "memory"); return r; }
__device__ __forceinline__ const GAS float* karg_in(int i) { return (const GAS float*)karg_u64(i); }
__device__ __forceinline__ GAS float* karg_out() { return (GAS float*)karg_u64(20); }
__device__ __forceinline__ GAS unsigned char* karg_ws() { return (GAS unsigned char*)karg_u64(21); }
#ifndef REP_P0
#define REP_P0 1
#endif
#ifndef REP_NORM
#define REP_NORM 1
#endif
#ifndef REP_GU
#define REP_GU 1
#endif
#ifndef REP_IN
#define REP_IN 1
#endif
#ifndef REP_POST
#define REP_POST 1
#endif
#ifndef REP_TOPK
#define REP_TOPK 1
#endif
#ifndef REP_DSA
#define REP_DSA 1
#endif
#define REPEAT(n) _Pragma("unroll 1") for (int rep_ = 0; rep_ < (n); ++rep_)
#define PHASE_IDS() int wave = wave0; asm volatile("" : "+s"(wave)); int lane; asm volatile("v_mbcnt_lo_u32_b32 %0, -1, 0\n\tv_mbcnt_hi_u32_b32 %0, -1, %0" : "=v"(lane)); const int tid = wave * 64 + lane; int bx = blockIdx.x; asm volatile("" : "+s"(bx)); int G = gridDim.x; asm volatile("" : "+s"(G)); \
    const int vcu = (G % 8 == 0) ? (bx % 8) * (G / 8) + bx / 8 : bx; const int gw = vcu * NWAVES + wave, NGW = G * NWAVES; \
    GAS unsigned char* ws = karg_ws(); (void)lane; (void)gw; (void)NGW; (void)vcu; (void)ws
__global__ void __launch_bounds__(NWAVES * 64, 2) mk_fwd(Args args) {
    extern __shared__ __attribute__((aligned(16))) unsigned char lds_raw[];
    LAS unsigned char* lds = (LAS unsigned char*)lds_raw;
    volatile LAS unsigned* MISC = (volatile LAS unsigned*)(lds + MISC_OFF);
    const int wave0 = __builtin_amdgcn_readfirstlane(threadIdx.x >> 6);
    for (int u = threadIdx.x; u < (LDS_BYTES - LDSCTL_OFF) / 4; u += NWAVES * 64) ((LAS unsigned*)(lds + LDSCTL_OFF))[u] = 0u;
    __syncthreads();
    (void)xcd_barrier_post((unsigned*)((gu32*)(karg_ws() + WS_CTL) + CW_BAR), MISC + 8, threadIdx.x == 0);
#define GRID_BAR() do { XcdBarrier b_; b_.bar = (unsigned*)((gu32*)(karg_ws() + WS_CTL) + CW_BAR); b_.x = xb_xcc_id(); b_.st = MISC + 8; int w_ = wave0; asm volatile("" : "+s"(w_)); int l_; asm volatile("v_mbcnt_lo_u32_b32 %0, -1, 0\n\tv_mbcnt_hi_u32_b32 %0, -1, %0" : "=v"(l_)); xcd_barrier(b_, (w_ | l_) == 0); } while (0)

    REPEAT(REP_P0) {   PHASE_IDS();
        LAS float* scr = (LAS float*)(lds + RING_OFF + wave * 16384);
        rows_bf16_ss(karg_in(0), (GAS bf16*)(ws + WS_XN), f8_on(0, 0) ? (GAS unsigned char*)(ws + WS_HB8) : (GAS unsigned char*)nullptr, (GAS float*)(ws + WS_SS), gw, NGW, lane);
        constexpr int I_GU = (D / 64) * (FF / 32), I_DN = (FF / 64) * (D / 32);
        constexpr int I_FFN = 2 * I_GU + I_DN, I_IN = 72 * (D / 64), I_OB = (1024 / 64) * (D / 32);
        constexpr int PER_LAYER = 2 * I_FFN + I_IN + I_OB;
        for (int it = gw; it < DEPTH * PER_LAYER; it += NGW) {
            const int l = it / PER_LAYER; int r = it - l * PER_LAYER;
            GAS unsigned char* wl = ws + WS_W0 + (size_t)l * W_LAYER;
            if (r < 2 * I_FFN) {
                const int f = r / I_FFN; r -= f * I_FFN;
                GAS bf16* dgu = (GAS bf16*)(wl + (f ? WO_GU2 : WO_GU1)); GAS bf16* dd = (GAS bf16*)(wl + (f ? WO_D2 : WO_D1));
                if (r < 2 * I_GU) { const int up = r >= I_GU; if (up) r -= I_GU; const int kb = r / (FF / 32), nb = r % (FF / 32), n0 = 32 * nb;
                    const GAS float* wsrc = karg_in(up ? (f ? 17 : 4) : (f ? 16 : 3)) + (size_t)l * D * FF;
                    const int drow = (n0 >> 7) * 256 + (up ? 128 : 0) + (n0 & 127);
                    if (f8_on(l, f)) { if constexpr (GU_I8) conv_item<2>(wsrc, FF, 64 * kb, n0, 32, dgu, D, drow, 0, W8I_SCALE, karg_in(f ? 15 : 2) + (size_t)l * D, scr, lane); else conv_item<1>(wsrc, FF, 64 * kb, n0, 32, dgu, D, drow, 0, W8_SCALE, karg_in(f ? 15 : 2) + (size_t)l * D, scr, lane); }
                    else conv_item(wsrc, FF, 64 * kb, n0, 32, dgu, D, drow, 0, 1.0f, karg_in(f ? 15 : 2) + (size_t)l * D, scr, lane); }
                else { r -= 2 * I_GU; const int kb = r / (D / 32), nb = r % (D / 32);
                    if (d8_on(l, f)) conv_item<1>(karg_in(f ? 18 : 5) + (size_t)l * FF * D, D, 64 * kb, 32 * nb, 32, dd, FF, 32 * nb, 0, W8_SCALE, nullptr, scr, lane);
                    else conv_item(karg_in(f ? 18 : 5) + (size_t)l * FF * D, D, 64 * kb, 32 * nb, 32, dd, FF, 32 * nb, 0, 1.0f, nullptr, scr, lane); }
            } else if (r < 2 * I_FFN + I_IN) {
                r -= 2 * I_FFN; const int j = r >> 5, kb = r & 31; int src, nvalid = 32; float sc = 1.0f;
                if (j < 8) src = 1024 + 32 * j;
                else if (j < 40) src = 1864 + 32 * (j - 8);
                else if (j < 44) src = 2888 + 32 * (j - 40);
                else if (j < 48) src = 3016 + 32 * (j - 44);
                else if (j < 64) src = 1280 + 32 * (j - 48);
                else if (j < 66) src = 1792 + 32 * (j - 64);
                else if (j == 66) { src = 1856; nvalid = 8; sc = 0.044194173824159216f; }
                else { src = 0; nvalid = 0; }
                const GAS float* win = karg_in(7) + (size_t)l * D * D_IN; const GAS float* gmix = karg_in(6) + (size_t)l * D;
                if (IN_I8 && j < 48) conv_item<2>(win, D_IN, 64 * kb, src, nvalid, (GAS bf16*)(wl + WO_IN), D, 2048 + 32 * j, 0, W8I_SCALE, gmix, scr, lane);
                else if (IN_I8) conv_item(win, D_IN, 64 * kb, src, nvalid, (GAS bf16*)(wl + WO_IN + (size_t)ZN8 * D), D, 32 * (j - 48), 0, sc, gmix, scr, lane);
                else conv_item(win, D_IN, 64 * kb, src, nvalid, (GAS bf16*)(wl + WO_IN), D, 2048 + 32 * j, 0, (j >= 8 && j < 40) ? 0.125f : sc, gmix, scr, lane);
            } else {
                r -= 2 * I_FFN + I_IN; const int kb = r >> 6, nb = r & 63;
                if constexpr (OUT_F8) conv_item<1>(karg_in(14) + (size_t)l * D * D + (size_t)1024 * D, D, 64 * kb, 32 * nb, 32, (GAS bf16*)(wl + WO_OUT), OLD, 32 * nb, 2048, W8_SCALE, nullptr, scr, lane);
                else conv_item(karg_in(14) + (size_t)l * D * D + (size_t)1024 * D, D, 64 * kb, 32 * nb, 32, (GAS bf16*)(wl + WO_OUT), OLD, 32 * nb, 2048, 1.0f, nullptr, scr, lane);
            }
        }
        __syncthreads();
        LAS float* Ps = (LAS float*)(lds + RING_OFF); LAS float* Qs = Ps + 64 * 129;
        for (int u = vcu; u < DEPTH * 2048; u += G) {
            const int l = u >> 11, which = (u >> 10) & 1, v = u & 1023;
            GAS unsigned char* wl = ws + WS_W0 + (size_t)l * W_LAYER;
            if (which == 0) { const int h = v >> 7, rt = (v >> 5) & 3, kt = v & 31;
                if constexpr (IN_I8) absorb_unit<false, 2>(karg_in(11) + (size_t)l * RANK * 1024 + ((size_t)(64 * rt) * 8 + h) * 128, 1024, 1, karg_in(7) + (size_t)l * D * D_IN + (size_t)(64 * kt) * D_IN + h * 128, D_IN,
                                   (GAS bf16*)((GAS unsigned char*)(wl + WO_IN) + (size_t)(h * 256 + 64 * rt) * D + 64 * kt), D, WQ8I_SCALE, karg_in(6) + (size_t)l * D + 64 * kt, Ps, Qs, tid);
                else absorb_unit<false>(karg_in(11) + (size_t)l * RANK * 1024 + ((size_t)(64 * rt) * 8 + h) * 128, 1024, 1, karg_in(7) + (size_t)l * D * D_IN + (size_t)(64 * kt) * D_IN + h * 128, D_IN,
                                   (GAS bf16*)(wl + WO_IN) + (size_t)(h * 256 + 64 * rt) * D + 64 * kt, D, 0.08838834764831845f, karg_in(6) + (size_t)l * D + 64 * kt, Ps, Qs, tid); }
            else { const int h = v >> 7, nt = (v >> 2) & 31, rt = v & 3;
                if constexpr (OUT_F8) absorb_unit<true, 1>(karg_in(14) + (size_t)l * D * D + (size_t)(h * 128) * D + 64 * nt, 1, D, karg_in(12) + (size_t)l * RANK * 1024 + ((size_t)(64 * rt) * 8 + h) * 128, 1024,
                                  (GAS bf16*)((GAS unsigned char*)(wl + WO_OUT) + (size_t)(64 * nt) * OLD + h * 256 + 64 * rt), OLD, W8_SCALE, nullptr, Ps, Qs, tid);
                else absorb_unit<true>(karg_in(14) + (size_t)l * D * D + (size_t)(h * 128) * D + 64 * nt, 1, D, karg_in(12) + (size_t)l * RANK * 1024 + ((size_t)(64 * rt) * 8 + h) * 128, 1024,
                                  (GAS bf16*)(wl + WO_OUT) + (size_t)(64 * nt) * OLD + h * 256 + 64 * rt, OLD, 1.0f, nullptr, Ps, Qs, tid); }
        }
    }
    GRID_BAR();

#pragma unroll 1
    for (int s = 0; s < 2 * DEPTH; ++s) {
        const int l = s >> 1, f = s & 1;
        REPEAT(REP_GU) {   PHASE_IDS(); GAS unsigned char* wl = ws + WS_W0 + (size_t)l * W_LAYER;
            pg8::StaticOrder S; S.init(M, NGU, G, bx);
            const GAS float* ssp = (const GAS float*)(ws + WS_SS + (size_t)((3 * l + 2 * f) & 1) * SS_BYTES);
            if ((F8_MASK == 0xF) || (F8_MASK != 0 && f8_on(l, f))) {
                if constexpr (F8_MASK != 0) {
                    pg8::Gemm g{(const GAS bf16*)(ws + WS_HB8), (const GAS bf16*)(wl + (f ? WO_GU2 : WO_GU1)), M, NGU, D / 2};
                    if constexpr (GU_I8) { pg8::EpiSwiglu<true> E{(GAS bf16*)(ws + WS_ACT), FF, ssp, 1.0f / D, EPS, 1.0f / (H8I_SCALE * W8I_SCALE), d8_on(l, f) ? A8_SCALE : 0.f};
                        pg8::gemm_phase<pg8::EpiSwiglu<true>, pg8::StaticOrder, true, true, false, true>(lds + RING_OFF, g, S, E, tid); }
                    else { pg8::EpiSwiglu<false> E{(GAS bf16*)(ws + WS_ACT), FF, ssp, 1.0f / D, EPS, 1.0f / W8_SCALE, d8_on(l, f) ? A8_SCALE : 0.f};
                        pg8::gemm_phase<pg8::EpiSwiglu<false>, pg8::StaticOrder, true, true, true>(lds + RING_OFF, g, S, E, tid); } }
            } else {
                if constexpr (F8_MASK != 0xF) {
                    pg8::Gemm g{(const GAS bf16*)(ws + WS_XN), (const GAS bf16*)(wl + (f ? WO_GU2 : WO_GU1)), M, NGU, D};
                    pg8::EpiSwiglu<false> E{(GAS bf16*)(ws + WS_ACT), FF, ssp, 1.0f / D, EPS, 1.0f, d8_on(l, f) ? A8_SCALE : 0.f};
                    pg8::gemm_phase<pg8::EpiSwiglu<false>, pg8::StaticOrder, true, true, false>(lds + RING_OFF, g, S, E, tid); }
            } }
        GRID_BAR();
        {   PHASE_IDS(); GAS unsigned char* wl = ws + WS_W0 + (size_t)l * W_LAYER;
            pg8::StaticOrder S; S.init(M, D, G, bx);
            const unsigned sso = (unsigned)(WS_SS + (size_t)((3 * l + 2 * f + 1) & 1) * SS_BYTES), h8o = ((f == 0 && IN_I8) || (f == 1 && l + 1 < DEPTH && f8_on(l + 1, 0))) ? (unsigned)WS_HB8 : 0u;
            if ((D8_MASK == 0xF) || (D8_MASK != 0 && d8_on(l, f))) {
                if constexpr (D8_MASK != 0) {
                    pg8::Gemm g{(const GAS bf16*)(ws + WS_ACT), (const GAS bf16*)(wl + (f ? WO_D2 : WO_D1)), M, D, FF / 2};
                    pg8::EpiResid E{0.5f / (W8_SCALE * A8_SCALE), (unsigned)WS_XN, sso, h8o, GU_I8 ? H8I_SCALE : 0.f};
                    pg8::gemm_phase<pg8::EpiResid, pg8::StaticOrder, true, true, true>(lds + RING_OFF, g, S, E, tid); }
            } else {
                if constexpr (D8_MASK != 0xF) {
                    pg8::Gemm g{(const GAS bf16*)(ws + WS_ACT), (const GAS bf16*)(wl + (f ? WO_D2 : WO_D1)), M, D, FF};
                    pg8::EpiResid E{0.5f, (unsigned)WS_XN, sso, h8o, GU_I8 ? H8I_SCALE : 0.f};
                    pg8::gemm_phase<pg8::EpiResid, pg8::StaticOrder, true, true, false>(lds + RING_OFF, g, S, E, tid); }
            } }
        GRID_BAR();
        if (f == 0) {
            REPEAT(REP_IN) {   PHASE_IDS(); GAS unsigned char* wl = ws + WS_W0 + (size_t)l * W_LAYER;
                const GAS float* ssp = (const GAS float*)(ws + WS_SS + (size_t)((3 * l + 1) & 1) * SS_BYTES);
                if constexpr (IN_I8) {
                    {   pg8::Gemm g{(const GAS bf16*)(ws + WS_HB8), (const GAS bf16*)(wl + WO_IN), M, ZN8, D / 2}; pg8::StaticOrder S; S.init(M, ZN8, G, bx);
                        pg8::EpiBf16<true> E{(GAS bf16*)(ws + WS_Z), ZLD, ssp, 1.0f / D, EPS, 0.08838834764831845f / (H8I_SCALE * WQ8I_SCALE), 1.0f / (H8I_SCALE * W8I_SCALE), 0.125f / (H8I_SCALE * W8I_SCALE)};
                        pg8::gemm_phase<pg8::EpiBf16<true>, pg8::StaticOrder, true, true, false, true>(lds + RING_OFF, g, S, E, tid); }
                    {   pg8::Gemm g{(const GAS bf16*)(ws + WS_XN), (const GAS bf16*)(wl + WO_IN + (size_t)ZN8 * D), M, ZLD - ZN8, D}; pg8::StaticOrder S; S.init(M, ZLD - ZN8, G, bx);
                        pg8::EpiBf16<false> E{(GAS bf16*)(ws + WS_Z) + ZN8, ZLD, ssp, 1.0f / D, EPS, 1.0f, 1.0f, 1.0f};
                        pg8::gemm_phase<pg8::EpiBf16<false>, pg8::StaticOrder, true, true, false, false>(lds + RING_OFF, g, S, E, tid); }
                } else {
                    pg8::Gemm g{(const GAS bf16*)(ws + WS_XN), (const GAS bf16*)(wl + WO_IN), M, ZLD, D}; pg8::StaticOrder S; S.init(M, ZLD, G, bx);
                    pg8::EpiBf16<false> E{(GAS bf16*)(ws + WS_Z), ZLD, ssp, 1.0f / D, EPS, 1.0f, 1.0f, 1.0f};
                    pg8::gemm_phase<pg8::EpiBf16<false>, pg8::StaticOrder, true, true, false, false>(lds + RING_OFF, g, S, E, tid); } }
            GRID_BAR();
            REPEAT(REP_POST) {   PHASE_IDS();
                post_rows((const GAS bf16*)(ws + WS_Z), karg_in(8) + (size_t)l * RANK, karg_in(9) + (size_t)l * IDIM, karg_in(10) + (size_t)l * IDIM, (GAS bf16*)(ws + WS_CKVN), (GAS bf16*)(ws + WS_KIN), (GAS float*)(ws + WS_WIF), gw, NGW, lane);
                swa_phase(lds + RING_OFF, (const GAS bf16*)(ws + WS_Z), (GAS bf16*)(ws + WS_O), karg_in(1), karg_in(13) + (size_t)l * H_B, vcu, G, tid, lane, wave);
            }
            GRID_BAR();
            REPEAT(REP_TOPK) {   PHASE_IDS(); topk_phase(lds + RING_OFF, (const GAS bf16*)(ws + WS_Z), (const GAS bf16*)(ws + WS_KIN), (const GAS float*)(ws + WS_WIF), (GAS unsigned short*)(ws + WS_IDX), vcu, G, lane, wave); }
            GRID_BAR();
            REPEAT(REP_DSA) {   PHASE_IDS(); dsa_phase(lds, (const GAS bf16*)(ws + WS_Z), (const GAS bf16*)(ws + WS_CKVN), (const GAS unsigned short*)(ws + WS_IDX), (GAS bf16*)(ws + WS_O), karg_in(1), gw, NGW, tid, lane, wave); }
            GRID_BAR();
            {   PHASE_IDS(); GAS unsigned char* wl = ws + WS_W0 + (size_t)l * W_LAYER;
                pg8::Gemm g{(const GAS bf16*)(ws + WS_O), (const GAS bf16*)(wl + WO_OUT), M, D, OUT_F8 ? OLD / 2 : OLD}; pg8::StaticOrder S; S.init(M, D, G, bx);
                pg8::EpiResid E{OUT_F8 ? 1.0f / (W8_SCALE * O8_SCALE) : 1.0f, (unsigned)WS_XN, (unsigned)(WS_SS + (size_t)((3 * l + 2) & 1) * SS_BYTES), f8_on(l, 1) ? (unsigned)WS_HB8 : 0u, GU_I8 ? H8I_SCALE : 0.f};
                pg8::gemm_phase<pg8::EpiResid, pg8::StaticOrder, true, true, OUT_F8 != 0>(lds + RING_OFF, g, S, E, tid); }
            GRID_BAR();
        }
    }
    {   PHASE_IDS(); final_rows((const GAS bf16*)(ws + WS_XN), karg_out(), karg_in(19), (const GAS float*)(ws + WS_SS + (size_t)(6 & 1) * SS_BYTES), gw, NGW, lane); }
}

extern "C" void kernel_launch(void* const* d_in, const int* in_sizes, int n_in, void* d_out, int out_size, void* d_ws, size_t ws_size, hipStream_t stream) {
    static int grid = 0;
    if (grid == 0) {
        if (n_in != 20 || in_sizes[0] != M * D || out_size != M * D || ws_size < WS_END) { fprintf(stderr, "kernel_launch: unexpected shapes (n_in %d, in0 %d, out %d, ws %zu); nothing launched\n", n_in, n_in > 0 ? in_sizes[0] : -1, out_size, ws_size); grid = -1; return; }
        int dev = 0, cus = 0, per_cu = 0;
        if (hipGetDevice(&dev) != hipSuccess || hipDeviceGetAttribute(&cus, hipDeviceAttributeMultiprocessorCount, dev) != hipSuccess) { grid = -1; return; }
        if (hipFuncSetAttribute((const void*)mk_fwd, hipFuncAttributeMaxDynamicSharedMemorySize, LDS_BYTES) != hipSuccess) { fprintf(stderr, "kernel_launch: hipFuncSetAttribute failed\n"); grid = -1; return; }
        if (hipOccupancyMaxActiveBlocksPerMultiprocessor(&per_cu, (const void*)mk_fwd, NWAVES * 64, LDS_BYTES) != hipSuccess || per_cu < 1) { fprintf(stderr, "kernel_launch: occupancy query reports %d workgroups per CU\n", per_cu); }
        (void)hipGetLastError();
        grid = cus;
    }
    if (grid < 0) return;
    if (hipMemsetAsync((char*)d_ws + WS_CTL, 0, CTL_ZERO_BYTES, stream) != hipSuccess) return;
    Args a{};
    for (int i = 0; i < 20; ++i) a.in[i] = (const float*)d_in[i];
    a.out = (float*)d_out; a.ws = (unsigned char*)d_ws;
    hipLaunchKernelGGL(mk_fwd, dim3(grid), dim3(NWAVES * 64), LDS_BYTES, stream, a);
}
```

```cpp
#include <hip/hip_runtime.h>
#include <cstdio>
#include <cstdint>
namespace pg8 {
#define PG8_LAS __attribute__((address_space(3)))
#define PG8_GAS __attribute__((address_space(1)))
typedef unsigned short bf16_t;
typedef short bf16x8 __attribute__((ext_vector_type(8)));
typedef float f32x4 __attribute__((ext_vector_type(4)));
typedef unsigned u32x4 __attribute__((ext_vector_type(4)));
constexpr int BM = 256, BK = 64, HALF = 128, HTB = HALF * BK * 2  , STAGE_BYTES = 8 * HTB, NXCD = 8, WGM = 4;

__host__ __device__ __forceinline__ int lds_byte(int r, int c) { const int st = (r >> 4) * 2 + (c >> 5), rr = r & 15, cc = c & 31, ob = rr * 64 + cc * 2; return st * 1024 + (ob ^ (((ob >> 9) & 1) << 5)); }
__host__ __device__ __forceinline__ void stage_rc(int b, int& R, int& C) { const int st = b / 1024, sb = b % 1024, swz = sb ^ (((sb >> 9) & 1) << 5); R = (st >> 1) * 16 + swz / 64; C = (st & 1) * 32 + (swz % 64) / 2; }
__host__ __device__ __forceinline__ int perm32(int rho) { const int n = rho >> 4, i = rho & 15; return 8 * (i >> 2) + 4 * n + (i & 3); }

typedef int i32x8 __attribute__((ext_vector_type(8))); typedef int i32x4v __attribute__((ext_vector_type(4)));
__device__ __forceinline__ i32x8 cat8(bf16x8 a, bf16x8 b) { return __builtin_shufflevector(__builtin_bit_cast(i32x4v, a), __builtin_bit_cast(i32x4v, b), 0, 1, 2, 3, 4, 5, 6, 7); }
struct Unit { int pm, pn; };
struct Gemm { const PG8_GAS bf16_t* A; const PG8_GAS bf16_t* Bt; int M, N, K; };

struct StaticOrder {
    int nM, nN, nwg, G, c;
    __host__ __device__ void init(int M, int N, int G_, int c_) { nM = M / BM; nN = N / BM; nwg = nM * nN; G = G_; c = c_; }
    __host__ __device__ bool next(int i, Unit& u) const {
        const long L = (long)i * G + c; if (L >= nwg) return false;
        int wgid = (int)L; { const int q = nwg / NXCD, r = nwg % NXCD, xcd = wgid % NXCD, off = wgid / NXCD; wgid = (xcd < r ? xcd * (q + 1) : r * (q + 1) + (xcd - r) * q) + off; }
        const int nig = WGM * nN, gid = wgid / nig, fm = gid * WGM, gsz = (nM - fm) < WGM ? (nM - fm) : WGM;
        u.pm = fm + ((wgid % nig) % gsz); u.pn = (wgid % nig) / gsz; return true;
    }
    __device__ __forceinline__ void a_ready(const Unit&) const {}
    __device__ __forceinline__ void done(const Unit&) const {}
};
__device__ __forceinline__ unsigned long long karg64(int idx) { unsigned long long r; const unsigned off = (unsigned)idx * 8u;
    asm volatile("s_load_dwordx2 %0, %1, %2\n\ts_waitcnt lgkmcnt(0)" : "=s"(r) : "s"(__builtin_amdgcn_kernarg_segment_ptr()), "s"(off) : "memory"); return r; }
__device__ __forceinline__ unsigned cvt_pk_bf16(float lo, float hi) { unsigned r; asm volatile("v_cvt_pk_bf16_f32 %0, %1, %2" : "=v"(r) : "v"(lo), "v"(hi)); return r; }
typedef float f32x2 __attribute__((ext_vector_type(2)));
__device__ __forceinline__ unsigned pack4_i8(float a, float b, float c, float d, float S) {
    const int qa = (int)__builtin_rintf(__builtin_fminf(__builtin_fmaxf(a * S, -127.f), 127.f)), qb = (int)__builtin_rintf(__builtin_fminf(__builtin_fmaxf(b * S, -127.f), 127.f));
    const int qc = (int)__builtin_rintf(__builtin_fminf(__builtin_fmaxf(c * S, -127.f), 127.f)), qd = (int)__builtin_rintf(__builtin_fminf(__builtin_fmaxf(d * S, -127.f), 127.f));
    return ((unsigned)qa & 0xffu) | (((unsigned)qb & 0xffu) << 8) | (((unsigned)qc & 0xffu) << 16) | ((unsigned)qd << 24);
}
__device__ __forceinline__ float silu_f(float g) { return g * __builtin_amdgcn_rcpf(1.0f + __builtin_amdgcn_exp2f(-1.4426950408889634f * g)); }

template <bool ACC_I32 = false>
struct EpiSwiglu {
    static constexpr bool PERM = true, AFTER_DRAIN = false;
    static __device__ __forceinline__ f32x4 cv(const f32x4& a) { if constexpr (ACC_I32) { typedef int i32x4e __attribute__((ext_vector_type(4))); const i32x4e q = __builtin_bit_cast(i32x4e, a); return (f32x4){(float)q[0], (float)q[1], (float)q[2], (float)q[3]}; } else return a; }
    PG8_GAS bf16_t* O; int ldc; const PG8_GAS float* ss; float inv_k, eps, post; float out8;
    __device__ __forceinline__ void operator()(const f32x4 (&acc)[2][2][4][2], const Unit& u, int wr, int wc, int fr, int fq) const {
        const int row0 = u.pm * BM + wr * 64 + fr, col0 = u.pn * HALF + wc * 32 + 8 * fq;
        float rs[8]; const int lane_ = fr + 16 * fq;
#pragma unroll
        for (int k = 0; k < 8; ++k) { const PG8_GAS f32x4* p4 = (const PG8_GAS f32x4*)(ss + (size_t)(row0 + (k >> 2) * HALF + (k & 3) * 16) * 32 + 8 * fq); const f32x4 a = p4[0], b = p4[1];
            float t = ((a[0] + a[1]) + (a[2] + a[3])) + ((b[0] + b[1]) + (b[2] + b[3]));
            t += __builtin_bit_cast(float, __builtin_amdgcn_ds_bpermute((lane_ ^ 16) << 2, __builtin_bit_cast(int, t)));
            t += __builtin_bit_cast(float, __builtin_amdgcn_ds_bpermute((lane_ ^ 32) << 2, __builtin_bit_cast(int, t))); rs[k] = t; }
        unsigned pk[8][2];
#pragma unroll
        for (int ai = 0; ai < 2; ++ai)
#pragma unroll
            for (int m = 0; m < 4; ++m) { PG8_GAS bf16_t* rowp = O + (size_t)(row0 + ai * HALF + m * 16) * ldc + col0;
                const float r = __builtin_amdgcn_rsqf(rs[ai * 4 + m] * inv_k + eps) * post;
                const f32x2 r2 = {r, r}, c2 = {-1.4426950408889634f * r, -1.4426950408889634f * r}; const float rs8 = out8 != 0.f ? r * out8 : r; const f32x2 q2 = {rs8, rs8}, one2 = {1.0f, 1.0f};
                f32x2 o[4];
#pragma unroll
                for (int h = 0; h < 4; ++h) { const f32x4 gq = cv(acc[ai][0][m][h >> 1]), uq = cv(acc[ai][1][m][h >> 1]);
                    const f32x2 gv = {gq[2 * (h & 1)], gq[2 * (h & 1) + 1]}, uv = {uq[2 * (h & 1)], uq[2 * (h & 1) + 1]};
                    const f32x2 t = gv * c2; f32x2 e; e.x = __builtin_amdgcn_exp2f(t.x); e.y = __builtin_amdgcn_exp2f(t.y);
                    const f32x2 d = e + one2; f32x2 rc; rc.x = __builtin_amdgcn_rcpf(d.x); rc.y = __builtin_amdgcn_rcpf(d.y);
                    o[h] = ((gv * r2) * rc) * (uv * q2); }
                if (out8 != 0.f) { int p = 0, q = 0;
                    p = __builtin_amdgcn_cvt_pk_fp8_f32(o[0].x, o[0].y, p, false); p = __builtin_amdgcn_cvt_pk_fp8_f32(o[1].x, o[1].y, p, true);
                    q = __builtin_amdgcn_cvt_pk_fp8_f32(o[2].x, o[2].y, q, false); q = __builtin_amdgcn_cvt_pk_fp8_f32(o[3].x, o[3].y, q, true);
                    pk[ai * 4 + m][0] = (unsigned)p; pk[ai * 4 + m][1] = (unsigned)q; }
                else { u32x4 w; w.x = cvt_pk_bf16(o[0].x, o[0].y); w.y = cvt_pk_bf16(o[1].x, o[1].y); w.z = cvt_pk_bf16(o[2].x, o[2].y); w.w = cvt_pk_bf16(o[3].x, o[3].y);
                    *(PG8_GAS u32x4*)rowp = w; } }
        if (out8 != 0.f) {
#pragma unroll
            for (int k = 0; k < 8; k += 2) {
                typedef unsigned u2v __attribute__((ext_vector_type(2)));
                const u2v sp = __builtin_amdgcn_permlane16_swap(pk[k][0], pk[k + 1][0], false, false), sq = __builtin_amdgcn_permlane16_swap(pk[k][1], pk[k + 1][1], false, false);
                const int kk = k + (fq & 1); const int rowk = row0 + (kk >> 2) * HALF + (kk & 3) * 16;
                u32x4 w; w.x = sp.x; w.y = sq.x; w.z = sp.y; w.w = sq.y;
                *(PG8_GAS u32x4*)((PG8_GAS unsigned char*)O + (size_t)rowk * ldc + (col0 - 8 * (fq & 1))) = w; } }
    }
};
struct EpiResid {
    static constexpr bool PERM = true, AFTER_DRAIN = false;
    float alpha; unsigned hb_off; unsigned ss_off; unsigned h8_off; float h8_i8;
    __device__ __forceinline__ void operator()(const f32x4 (&acc)[2][2][4][2], const Unit& u, int wr, int wc, int fr, int fq) const {
        constexpr int ldc = 2048;
        PG8_GAS unsigned char* wsb = (PG8_GAS unsigned char*)karg64(21); PG8_GAS bf16_t* hb = (PG8_GAS bf16_t*)(wsb + hb_off); PG8_GAS float* ss = (PG8_GAS float*)(wsb + ss_off);
        const int row0 = u.pm * BM + wr * 64 + fr, col0 = u.pn * BM + wc * 32 + 8 * fq; const int lane = fr + 16 * fq;
        u32x4 cur[2], nxt[2];
        { const size_t off = (size_t)row0 * ldc + col0; cur[0] = *(const PG8_GAS u32x4*)(hb + off); cur[1] = *(const PG8_GAS u32x4*)(hb + off + HALF); }
#pragma unroll
        for (int k = 0; k < 8; ++k) { const int ai = k >> 2, m = k & 3; const int row = row0 + ai * HALF + m * 16; const size_t off = (size_t)row * ldc + col0;
            if (k < 7) { const int ai2 = (k + 1) >> 2, m2 = (k + 1) & 3; const size_t off2 = (size_t)(row0 + ai2 * HALF + m2 * 16) * ldc + col0;
                nxt[0] = *(const PG8_GAS u32x4*)(hb + off2); nxt[1] = *(const PG8_GAS u32x4*)(hb + off2 + HALF); }
            float sq = 0.f;
#pragma unroll
            for (int bj = 0; bj < 2; ++bj) { const u32x4 b = cur[bj]; const f32x4 a0 = acc[ai][bj][m][0], a1 = acc[ai][bj][m][1]; u32x4 w;
                w.x = cvt_pk_bf16(__builtin_bit_cast(float, b.x << 16) + a0[0] * alpha, __builtin_bit_cast(float, b.x & 0xffff0000u) + a0[1] * alpha);
                w.y = cvt_pk_bf16(__builtin_bit_cast(float, b.y << 16) + a0[2] * alpha, __builtin_bit_cast(float, b.y & 0xffff0000u) + a0[3] * alpha);
                w.z = cvt_pk_bf16(__builtin_bit_cast(float, b.z << 16) + a1[0] * alpha, __builtin_bit_cast(float, b.z & 0xffff0000u) + a1[1] * alpha);
                w.w = cvt_pk_bf16(__builtin_bit_cast(float, b.w << 16) + a1[2] * alpha, __builtin_bit_cast(float, b.w & 0xffff0000u) + a1[3] * alpha);
                *(PG8_GAS u32x4*)(hb + off + bj * HALF) = w;
                if (h8_off) { typedef unsigned u32x2v __attribute__((ext_vector_type(2))); u32x2v q8; int p = 0;
                    const float e0 = __builtin_bit_cast(float, w.x << 16), e1 = __builtin_bit_cast(float, w.x & 0xffff0000u), e2 = __builtin_bit_cast(float, w.y << 16), e3 = __builtin_bit_cast(float, w.y & 0xffff0000u);
                    const float e4 = __builtin_bit_cast(float, w.z << 16), e5 = __builtin_bit_cast(float, w.z & 0xffff0000u), e6 = __builtin_bit_cast(float, w.w << 16), e7 = __builtin_bit_cast(float, w.w & 0xffff0000u);
                    if (h8_i8 != 0.f) { q8.x = pack4_i8(e0, e1, e2, e3, h8_i8); q8.y = pack4_i8(e4, e5, e6, e7, h8_i8); }
                    else { p = __builtin_amdgcn_cvt_pk_fp8_f32(e0, e1, p, false); p = __builtin_amdgcn_cvt_pk_fp8_f32(e2, e3, p, true); q8.x = (unsigned)p; p = 0;
                        p = __builtin_amdgcn_cvt_pk_fp8_f32(e4, e5, p, false); p = __builtin_amdgcn_cvt_pk_fp8_f32(e6, e7, p, true); q8.y = (unsigned)p; }
                    *(PG8_GAS u32x2v*)(wsb + h8_off + off + bj * HALF) = q8; }
#pragma unroll
                for (int e = 0; e < 4; ++e) { const float lo = __builtin_bit_cast(float, w[e] << 16), hi = __builtin_bit_cast(float, w[e] & 0xffff0000u); sq = fmaf(lo, lo, sq); sq = fmaf(hi, hi, sq); } }
            sq += __builtin_bit_cast(float, __builtin_amdgcn_ds_bpermute((lane ^ 16) << 2, __builtin_bit_cast(int, sq)));
            sq += __builtin_bit_cast(float, __builtin_amdgcn_ds_bpermute((lane ^ 32) << 2, __builtin_bit_cast(int, sq)));
            if (fq == 0) ss[(size_t)row * 32 + u.pn * 4 + wc] = sq;
            cur[0] = nxt[0]; cur[1] = nxt[1]; }
    }
};
template <bool ACC_I32 = false>
struct EpiBf16 {
    static constexpr bool PERM = true, AFTER_DRAIN = false;
    static __device__ __forceinline__ f32x4 cv(const f32x4& a) { if constexpr (ACC_I32) { typedef int i32x4e __attribute__((ext_vector_type(4))); const i32x4e q = __builtin_bit_cast(i32x4e, a); return (f32x4){(float)q[0], (float)q[1], (float)q[2], (float)q[3]}; } else return a; }
    PG8_GAS bf16_t* O; int ldc; const PG8_GAS float* ss; float inv_k, eps; float post_a, post_b, post_c;
    __device__ __forceinline__ void operator()(const f32x4 (&acc)[2][2][4][2], const Unit& u, int wr, int wc, int fr, int fq) const {
        const int row0 = u.pm * BM + wr * 64 + fr, col0 = u.pn * BM + wc * 32 + 8 * fq;
        const float pfac = fmaf(u.pn < 8 ? 1.0f : 0.0f, post_a - post_b, fmaf((u.pn >= 9 && u.pn < 13) ? 1.0f : 0.0f, post_c - post_b, post_b));
        float rs[8]; const int lane_ = fr + 16 * fq;
#pragma unroll
        for (int k = 0; k < 8; ++k) { const PG8_GAS f32x4* p4 = (const PG8_GAS f32x4*)(ss + (size_t)(row0 + (k >> 2) * HALF + (k & 3) * 16) * 32 + 8 * fq); const f32x4 a = p4[0], b = p4[1];
            float t = ((a[0] + a[1]) + (a[2] + a[3])) + ((b[0] + b[1]) + (b[2] + b[3]));
            t += __builtin_bit_cast(float, __builtin_amdgcn_ds_bpermute((lane_ ^ 16) << 2, __builtin_bit_cast(int, t)));
            t += __builtin_bit_cast(float, __builtin_amdgcn_ds_bpermute((lane_ ^ 32) << 2, __builtin_bit_cast(int, t))); rs[k] = t; }
#pragma unroll
        for (int ai = 0; ai < 2; ++ai)
#pragma unroll
            for (int m = 0; m < 4; ++m) { PG8_GAS bf16_t* rowp = O + (size_t)(row0 + ai * HALF + m * 16) * ldc + col0;
                const float r = __builtin_amdgcn_rsqf(rs[ai * 4 + m] * inv_k + eps) * pfac;
#pragma unroll
                for (int bj = 0; bj < 2; ++bj) { const f32x4 v0 = cv(acc[ai][bj][m][0]) * r, v1 = cv(acc[ai][bj][m][1]) * r;
                    u32x4 w; w.x = cvt_pk_bf16(v0[0], v0[1]); w.y = cvt_pk_bf16(v0[2], v0[3]); w.z = cvt_pk_bf16(v1[0], v1[1]); w.w = cvt_pk_bf16(v1[2], v1[3]);
                    *(PG8_GAS u32x4*)(rowp + bj * HALF) = w; } }
    }
};
template <class Epi, class Sched, bool ALIGN_EPI = false, bool SP2 = false, bool F8 = false, bool I8 = false>
__device__ __forceinline__ void gemm_phase(PG8_LAS unsigned char* lds, const Gemm g, const Sched& S, const Epi& E, int tid_in  ) {
    int tid_ = tid_in; asm volatile("" : "+v"(tid_));
    const int tid = tid_, wid = __builtin_amdgcn_readfirstlane(tid >> 6), lane = tid & 63, wr = wid >> 2, wc = wid & 3, fr = lane & 15, fq = lane >> 4;
    const int K = g.K, nt = K / BK;
    unsigned voffA[2], voffB[2];
#pragma unroll
    for (int i = 0; i < 2; ++i) { int R, C; stage_rc(tid * 16 + i * 8192, R, C); const int Rb = Epi::PERM ? ((R & ~31) + perm32(R & 31)) : R;
        voffA[i] = (unsigned)(R * K + C) * 2u; voffB[i] = (unsigned)(Rb * K + C) * 2u; }
    const size_t kstep = (size_t)(BK * 2);
    const size_t hstep = (size_t)HALF * K * 2;
    const size_t tstep = 2 * hstep;
    const unsigned ldsw = (unsigned)wid * 1024u;
    const int aoff = lds_byte(wr * 64 + fr, fq * 8), boff = lds_byte(wc * 32 + fr, fq * 8);
#define PG8_SA(b, h) (((b) * 2 + (h)) * HTB)
#define PG8_SB(b, h) ((4 + (b) * 2 + (h)) * HTB)
#define PG8_STAGE(bufoff, gbase, voff) do { _Pragma("unroll") for (int _i = 0; _i < 2; ++_i) \
        __builtin_amdgcn_global_load_lds((const PG8_GAS unsigned*)((const PG8_GAS char*)(gbase) + (voff)[_i]), (PG8_LAS unsigned*)(lds + (bufoff) + ldsw + _i * 8192), 16, 0, 0); } while (0)
#define PG8_LDA(dst, b, h) do { _Pragma("unroll") for (int m = 0; m < 4; ++m) _Pragma("unroll") for (int k = 0; k < 2; ++k) dst[m][k] = *(const PG8_LAS bf16x8*)(lds + PG8_SA(b, h) + aoff + m * 2048 + k * 1024); } while (0)
#define PG8_LDB(dst, b, h) do { _Pragma("unroll") for (int n = 0; n < 2; ++n) _Pragma("unroll") for (int k = 0; k < 2; ++k) dst[n][k] = *(const PG8_LAS bf16x8*)(lds + PG8_SB(b, h) + boff + n * 2048 + k * 1024); } while (0)
#define PG8_MMA(ai, bj, At, Bt) do { __builtin_amdgcn_s_setprio(1); _Pragma("unroll") for (int m = 0; m < 4; ++m) _Pragma("unroll") for (int n = 0; n < 2; ++n) { \
        if constexpr (F8) { asm volatile("v_mfma_f32_16x16x128_f8f6f4 %0, %1, %2, %0" : "+v"(acc[ai][bj][m][n]) : "v"(cat8(Bt[n][0], Bt[n][1])), "v"(cat8(At[m][0], At[m][1]))); } \
        else if constexpr (I8) { _Pragma("unroll") for (int k = 0; k < 2; ++k) asm volatile("v_mfma_i32_16x16x64_i8 %0, %1, %2, %0" : "+v"(acc[ai][bj][m][n]) : "v"(Bt[n][k]), "v"(At[m][k])); } \
        else { _Pragma("unroll") for (int k = 0; k < 2; ++k) acc[ai][bj][m][n] = __builtin_amdgcn_mfma_f32_16x16x32_bf16(Bt[n][k], At[m][k], acc[ai][bj][m][n], 0, 0, 0); } } \
        __builtin_amdgcn_s_setprio(0); } while (0)
#define PG8_WAIT_V(n) asm volatile("s_waitcnt vmcnt(" #n ")" ::: "memory")
#define PG8_WAIT_L(n) asm volatile("s_waitcnt lgkmcnt(" #n ")" ::: "memory")
#define PG8_BAR __builtin_amdgcn_s_barrier()
#define PG8_SCHED __builtin_amdgcn_sched_barrier(0)
    Unit cur, nxt; int ui = 0;
    if (!S.next(0, cur)) return;
    f32x4 acc[2][2][4][2];
#pragma unroll
    for (int a = 0; a < 2; ++a)
#pragma unroll
        for (int b = 0; b < 2; ++b)
#pragma unroll
            for (int m = 0; m < 4; ++m)
#pragma unroll
                for (int n = 0; n < 2; ++n) acc[a][b][m][n] = (f32x4){0.f, 0.f, 0.f, 0.f};
    bf16x8 At[4][2], B0[2][2], B1[2][2];
    const PG8_GAS char* cA = (const PG8_GAS char*)g.A + (size_t)cur.pm * tstep; const PG8_GAS char* cB = (const PG8_GAS char*)g.Bt + (size_t)cur.pn * tstep;
    S.a_ready(cur);
    if constexpr (SP2) {
        PG8_STAGE(PG8_SB(0, 0), cB, voffB); PG8_STAGE(PG8_SB(0, 1), cB + hstep, voffB); PG8_STAGE(PG8_SA(0, 0), cA, voffA); PG8_STAGE(PG8_SA(0, 1), cA + hstep, voffA);
        if (wr == 1) PG8_BAR;
        PG8_WAIT_V(2); PG8_BAR;
        PG8_STAGE(PG8_SB(1, 0), cB + kstep, voffB); PG8_STAGE(PG8_SA(1, 0), cA + kstep, voffA); PG8_STAGE(PG8_SB(1, 1), cB + hstep + kstep, voffB);
        PG8_WAIT_V(6); PG8_BAR;
    } else {
        PG8_STAGE(PG8_SB(0, 0), cB, voffB); PG8_STAGE(PG8_SA(0, 0), cA, voffA); PG8_STAGE(PG8_SB(0, 1), cB + hstep, voffB); PG8_STAGE(PG8_SA(0, 1), cA + hstep, voffA);
        if (wr == 1) PG8_BAR;
        PG8_WAIT_V(4); PG8_BAR;
        PG8_STAGE(PG8_SB(1, 0), cB + kstep, voffB); PG8_STAGE(PG8_SA(1, 0), cA + kstep, voffA); PG8_STAGE(PG8_SB(1, 1), cB + hstep + kstep, voffB);
        PG8_WAIT_V(6); PG8_BAR;
    }
    for (;;) {
        const bool has_next = S.next(ui + 1, nxt);
        const PG8_GAS char* nA = has_next ? (const PG8_GAS char*)g.A + (size_t)nxt.pm * tstep : cA; const PG8_GAS char* nB = has_next ? (const PG8_GAS char*)g.Bt + (size_t)nxt.pn * tstep : cB;
        for (int t = 0; t < nt; t += 2) {
            const bool last = (t == nt - 2);
            const PG8_GAS char* a1 = cA + (size_t)(t + 1) * kstep;
            const PG8_GAS char* a2 = last ? nA : cA + (size_t)(t + 2) * kstep; const PG8_GAS char* b2 = last ? nB : cB + (size_t)(t + 2) * kstep;
            const PG8_GAS char* a3 = a2 + kstep; const PG8_GAS char* b3 = b2 + kstep;
            if (last && has_next) S.a_ready(nxt);
            if constexpr (SP2) {
            PG8_LDB(B0, 0, 0); PG8_LDB(B1, 0, 1); PG8_SCHED; PG8_LDA(At, 0, 0); PG8_STAGE(PG8_SA(1, 1), a1 + hstep, voffA);
            PG8_WAIT_V(8); PG8_WAIT_L(0); PG8_BAR; PG8_MMA(0, 0, At, B0); PG8_MMA(0, 1, At, B1); PG8_BAR; PG8_SCHED;
            PG8_LDA(At, 0, 1); PG8_STAGE(PG8_SB(0, 0), b2, voffB); PG8_STAGE(PG8_SB(0, 1), b2 + hstep, voffB); PG8_STAGE(PG8_SA(0, 0), a2, voffA);
            PG8_WAIT_V(8); PG8_WAIT_L(0); PG8_BAR; PG8_MMA(1, 0, At, B0); PG8_MMA(1, 1, At, B1); PG8_BAR; PG8_SCHED;
            PG8_LDB(B0, 1, 0); PG8_LDB(B1, 1, 1); PG8_SCHED; PG8_LDA(At, 1, 0); PG8_STAGE(PG8_SA(0, 1), a2 + hstep, voffA);
            PG8_WAIT_V(8); PG8_WAIT_L(0); PG8_BAR; PG8_MMA(0, 0, At, B0); PG8_MMA(0, 1, At, B1); PG8_BAR; PG8_SCHED;
            PG8_LDA(At, 1, 1); PG8_STAGE(PG8_SB(1, 0), b3, voffB); PG8_STAGE(PG8_SB(1, 1), b3 + hstep, voffB); PG8_STAGE(PG8_SA(1, 0), a3, voffA);
            PG8_WAIT_V(8); PG8_WAIT_L(0); PG8_BAR; PG8_MMA(1, 0, At, B0); PG8_MMA(1, 1, At, B1); PG8_BAR; PG8_SCHED;
            } else {
            PG8_LDB(B0, 0, 0); PG8_SCHED; PG8_LDA(At, 0, 0); PG8_STAGE(PG8_SA(1, 1), a1 + hstep, voffA);
            PG8_WAIT_L(8); PG8_BAR; PG8_WAIT_L(0); PG8_MMA(0, 0, At, B0); PG8_BAR; PG8_SCHED;
            PG8_LDB(B1, 0, 1); PG8_STAGE(PG8_SB(0, 0), b2, voffB);
            PG8_BAR; PG8_WAIT_L(0); PG8_MMA(0, 1, At, B1); PG8_BAR;
            PG8_LDA(At, 0, 1); PG8_STAGE(PG8_SA(0, 0), a2, voffA);
            PG8_BAR; PG8_WAIT_L(0); PG8_MMA(1, 0, At, B0); PG8_BAR; PG8_SCHED;
            PG8_STAGE(PG8_SB(0, 1), b2 + hstep, voffB);
            PG8_WAIT_V(6); PG8_BAR; PG8_MMA(1, 1, At, B1); PG8_BAR;
            PG8_LDB(B0, 1, 0); PG8_SCHED; PG8_LDA(At, 1, 0); PG8_STAGE(PG8_SA(0, 1), a2 + hstep, voffA);
            PG8_WAIT_L(8); PG8_BAR; PG8_WAIT_L(0); PG8_MMA(0, 0, At, B0); PG8_BAR; PG8_SCHED;
            PG8_LDB(B1, 1, 1); PG8_STAGE(PG8_SB(1, 0), b3, voffB);
            PG8_BAR; PG8_WAIT_L(0); PG8_MMA(0, 1, At, B1); PG8_BAR;
            PG8_LDA(At, 1, 1); PG8_STAGE(PG8_SA(1, 0), a3, voffA);
            PG8_BAR; PG8_WAIT_L(0); PG8_MMA(1, 0, At, B0); PG8_BAR; PG8_SCHED;
            PG8_STAGE(PG8_SB(1, 1), b3 + hstep, voffB);
            PG8_WAIT_V(6); PG8_BAR; PG8_MMA(1, 1, At, B1); PG8_BAR;
            }
        }
        if constexpr (ALIGN_EPI) { if (wr == 0) PG8_BAR; }
        if constexpr (!Epi::AFTER_DRAIN) { int ln_; asm volatile("v_mbcnt_lo_u32_b32 %0, -1, 0\n\tv_mbcnt_hi_u32_b32 %0, -1, %0" : "=v"(ln_));
            E(acc, cur, wr, wc, ln_ & 15, ln_ >> 4); S.done(cur); }
        if (!has_next) break;
#pragma unroll
        for (int a = 0; a < 2; ++a)
#pragma unroll
            for (int b = 0; b < 2; ++b)
#pragma unroll
                for (int m = 0; m < 4; ++m)
#pragma unroll
                    for (int n = 0; n < 2; ++n) acc[a][b][m][n] = (f32x4){0.f, 0.f, 0.f, 0.f};
        cur = nxt; cA = nA; cB = nB; ++ui;
        if constexpr (ALIGN_EPI) { if (wr == 1) PG8_BAR; }
    }
    PG8_WAIT_V(0);
    if constexpr (!ALIGN_EPI) { if (wr == 0) PG8_BAR; }
    PG8_BAR;
    if constexpr (Epi::AFTER_DRAIN) { E.fused(acc, cur, wr, wc, fr, fq, lds, wid, lane); S.done(cur); }
#undef PG8_SA
#undef PG8_SB
#undef PG8_STAGE
#undef PG8_LDA
#undef PG8_LDB
#undef PG8_MMA
#undef PG8_WAIT_V
#undef PG8_WAIT_L
#undef PG8_BAR
#undef PG8_SCHED
}
}
constexpr int NWAVES = 8;
constexpr int BATCH = 8, SEQ = 4096, D = 2048, FF = 5632, DEPTH = 2;
constexpr int M = BATCH * SEQ;
constexpr int NGU = 2 * FF;
constexpr int H_A = 8, HD_A = 128, RANK = 256, IH = 8, IDIM = 64, TOPK = 256;
constexpr int H_B = 16, KVH = 2, GQA = 8, HD_B = 64, WINDOW = 128;
constexpr int D_IN = 3144;
constexpr float EPS = 1e-6f;
constexpr size_t MiB = 1u << 20;
constexpr size_t WS_CTL = 0, CTL_ZERO_BYTES = 1 * MiB;
#ifndef F8_MASK
#define F8_MASK 0xF
#endif
constexpr float W8_SCALE = 64.0f;
#ifndef GU_I8
#define GU_I8 1
#endif
constexpr float H8I_SCALE = 127.0f / 4.6f, W8I_SCALE = 127.0f / (4.2f * 0.022097086912079608f);
#ifndef D8_MASK
#define D8_MASK 0xF
#endif
constexpr float A8_SCALE = 8.0f;
__host__ __device__ constexpr bool d8_on(int l, int f) { return ((D8_MASK >> (2 * l + f)) & 1) != 0; }
constexpr float O8_SCALE = 16.0f;
#ifndef OUT_F8
#define OUT_F8 1
#endif
constexpr bool F8_ALL1 = (F8_MASK & 0x5) == 0x5, F8_ALL2 = (F8_MASK & 0xA) == 0xA;
__host__ __device__ constexpr bool f8_on(int l, int f) { return ((F8_MASK >> (2 * l + f)) & 1) != 0; }
constexpr size_t GU1_B = (F8_ALL1 ? 22 : 44) * MiB, GU2_B = (F8_ALL2 ? 22 : 44) * MiB;
constexpr size_t WS_W0 = 2 * MiB;
constexpr size_t WO_GU1 = 0, WO_D1 = GU1_B, WO_GU2 = WO_D1 + 22 * MiB, WO_D2 = WO_GU2 + GU2_B, WO_IN = WO_D2 + 22 * MiB, WO_OUT = WO_IN + 17 * MiB, W_LAYER = WO_OUT + 12 * MiB;
constexpr size_t WS_XN = WS_W0 + 2 * W_LAYER;
constexpr size_t WS_HB8 = WS_XN + 128 * MiB;
constexpr size_t WS_ACT = WS_HB8 + (F8_MASK ? 64 : 0) * MiB;
constexpr size_t WS_Z = WS_ACT, WS_CKVN = WS_ACT + 272 * MiB, WS_KIN = WS_ACT + 288 * MiB, WS_WIF = WS_ACT + 292 * MiB, WS_IDX = WS_ACT + 294 * MiB;
constexpr int ZLD = 4352, ZC_QLAT = 0, ZC_CKV = 2048, ZC_QB = 2304, ZC_KB = 3328, ZC_VB = 3456, ZC_QI = 3584, ZC_KI = 4096, ZC_WI = 4160;
constexpr int ZN8 = 3584;
#ifndef IN_I8
#define IN_I8 1
#endif
constexpr float WQ8I_SCALE = 127.0f / (4.2f * 0.015625f);
constexpr int OLD = 3072;
constexpr size_t WS_O = WS_ACT + 352 * MiB;
constexpr size_t WS_SS = WS_O + 192 * MiB, SS_BYTES = 4 * MiB;
constexpr size_t WS_END = WS_SS + 2 * SS_BYTES;
static_assert(WS_END <= 1024 * MiB, "d_ws map exceeds 1 GiB");
constexpr int CW_TMO = 0, CW_CODE = 1, CW_BAR = 4096, CW_XRANK = 8192;
constexpr int RING_OFF = 0, RING_BYTES = 131072;
constexpr int LDSCTL_OFF = RING_BYTES, MISC_OFF = LDSCTL_OFF + 320;
constexpr int LDS_BYTES = 147456;
constexpr int RSL_OFF = RING_BYTES + 5632;
#define GAS __attribute__((address_space(1)))
#define LAS __attribute__((address_space(3)))
typedef unsigned short bf16;
typedef unsigned v4u __attribute__((ext_vector_type(4)));
typedef float f32x4 __attribute__((ext_vector_type(4)));
typedef short bf16x8 __attribute__((ext_vector_type(8)));
typedef GAS unsigned gu32;
typedef GAS unsigned long long gu64;
#define RLX_AGENT __ATOMIC_RELAXED, __HIP_MEMORY_SCOPE_AGENT
#define LDS_WAIT() asm volatile("s_waitcnt lgkmcnt(0)" ::: "memory")
#define VM_WAIT() asm volatile("s_waitcnt vmcnt(0)" ::: "memory")
__device__ __forceinline__ unsigned long long rt() { return __builtin_amdgcn_s_memrealtime(); }
__device__ __forceinline__ unsigned f2bf(float f) { unsigned u = __builtin_bit_cast(unsigned, f); return (u + 0x7fffu + ((u >> 16) & 1u)) >> 16; }
__device__ __forceinline__ unsigned pk2(float lo, float hi) { return f2bf(lo) | (f2bf(hi) << 16); }

#define XB_TMO      128
#define XB_XCNT(j)  (256  + 64 * (j))
#define XB_XSUB(j)  (1280 + 64 * (j))
#define XB_XGEN(j)  (2304 + 64 * (j))
#define XB_TOP      3328
#define XB_TOPGEN   3392
#define XCD_BAR_WORDS 3456
#define XB_SPIN_CAP (1u << 18)

__device__ __forceinline__ unsigned xb_ld(unsigned* p)              { return __hip_atomic_load(p, __ATOMIC_RELAXED, __HIP_MEMORY_SCOPE_AGENT); }
__device__ __forceinline__ unsigned xb_add(unsigned* p, unsigned v) { return __hip_atomic_fetch_add(p, v, __ATOMIC_RELAXED, __HIP_MEMORY_SCOPE_AGENT); }
__device__ __forceinline__ unsigned xb_xcc_id() { return (unsigned)__builtin_amdgcn_s_getreg((3 << 11) | 20) & 0xFu; }
#define XB_SPIN(cond, bar) do { unsigned _sp = 0; while (cond) { __builtin_amdgcn_s_sleep(1); \
    if ((++_sp & 255u) == 0u) { if (xb_ld(&(bar)[XB_TMO])) break; if (_sp > XB_SPIN_CAP) { atomicAdd(&(bar)[XB_TMO], 1u); break; } } } } while (0)

struct XcdBarrier {
    unsigned* bar; unsigned x;
    volatile LAS unsigned* st;
};

__device__ __forceinline__ XcdBarrier xcd_barrier_post(unsigned* bar, volatile LAS unsigned* st, bool leader  ) {
    XcdBarrier b; b.bar = bar; b.x = xb_xcc_id(); b.st = st;
    if (leader) (void)xb_add(&bar[XB_XCNT(b.x)], 1u);
    return b;
}
__device__ __forceinline__ void xcd_barrier_complete(unsigned* bar, unsigned x, unsigned& nloc, unsigned& nx) {
    const unsigned G = gridDim.x * gridDim.y * gridDim.z;
    unsigned sum, cnt, mine, sp = 0u;
    for (;;) {
        sum = 0u; cnt = 0u; mine = 0u;
#pragma unroll
        for (unsigned j = 0; j < 16; ++j) { const unsigned c = xb_ld(&bar[XB_XCNT(j)]); sum += c; cnt += (c > 0u) ? 1u : 0u; mine = (j == x) ? c : mine; }
        if (sum == G) break;
        __builtin_amdgcn_s_sleep(1);
        if ((++sp & 255u) == 0u) { if (xb_ld(&bar[XB_TMO])) break; if (sp > XB_SPIN_CAP) { atomicAdd(&bar[XB_TMO], 1u); break; } }
    }
    nloc = mine > 0u ? mine : 1u; nx = cnt > 0u ? cnt : 1u;
}

__device__ __forceinline__ void xcd_barrier(const XcdBarrier& b, bool leader  ) {
    asm volatile("s_waitcnt vmcnt(0)" ::: "memory");
    __syncthreads();
    if (leader) {
        unsigned* bar = b.bar;
        __builtin_amdgcn_s_waitcnt(0);
        unsigned nloc = b.st[0], nx = b.st[1];
        if (nloc == 0u) { xcd_barrier_complete(bar, b.x, nloc, nx); b.st[0] = nloc; b.st[1] = nx; }
        const unsigned old = xb_add(&bar[XB_XSUB(b.x)], 1u);
        const unsigned gen = old / nloc;
        if (old + 1u == (gen + 1u) * nloc) {
            __builtin_amdgcn_fence(__ATOMIC_RELEASE, "agent");
            asm volatile("s_waitcnt vmcnt(0)" ::: "memory");
            const unsigned og = xb_add(&bar[XB_TOP], 1u);
            const unsigned tg = og / nx;
            if (og + 1u == (tg + 1u) * nx) xb_add(&bar[XB_TOPGEN], 1u);
            else XB_SPIN(xb_ld(&bar[XB_TOPGEN]) == tg, bar);
            __builtin_amdgcn_fence(__ATOMIC_ACQUIRE, "agent");
            xb_add(&bar[XB_XGEN(b.x)], 1u);
            asm volatile("s_waitcnt vmcnt(0)" ::: "memory");
        } else {
            XB_SPIN(xb_ld(&bar[XB_XGEN(b.x)]) == gen, bar);
            __builtin_amdgcn_fence(__ATOMIC_ACQUIRE, "agent");
            asm volatile("s_waitcnt vmcnt(0)" ::: "memory");
        }
    }
    __syncthreads();
}
__constant__ unsigned char T5_BUCKET[128] = {0, 1, 2, 3, 4, 5, 6, 7, 8, 9, 10, 11, 12, 13, 14, 15, 16, 16, 16, 17, 17, 18, 18, 18, 19, 19, 19, 20, 20, 20, 20, 21, 21, 21, 21, 22, 22, 22, 22, 22, 23, 23, 23, 23, 23, 23, 24, 24, 24, 24, 24, 24, 25, 25, 25, 25, 25, 25, 25, 26, 26, 26, 26, 26, 26, 26, 26, 27, 27, 27, 27, 27, 27, 27, 27, 27, 27, 28, 28, 28, 28, 28, 28, 28, 28, 28, 28, 29, 29, 29, 29, 29, 29, 29, 29, 29, 29, 29, 29, 30, 30, 30, 30, 30, 30, 30, 30, 30, 30, 30, 30, 30, 30, 31, 31, 31, 31, 31, 31, 31, 31, 31, 31, 31, 31, 31, 31, 31};
typedef short s16x4 __attribute__((ext_vector_type(4)));
typedef float f32x16 __attribute__((ext_vector_type(16)));
__device__ __forceinline__ float bf2f(unsigned short b) { return __builtin_bit_cast(float, (unsigned)b << 16); }
__device__ __forceinline__ bf16x8 cat4(s16x4 lo, s16x4 hi) { return __builtin_shufflevector(lo, hi, 0, 1, 2, 3, 4, 5, 6, 7); }
__device__ __forceinline__ void tr_read4(unsigned a0, unsigned a1, unsigned a2, unsigned a3, s16x4& r0, s16x4& r1, s16x4& r2, s16x4& r3) {
    asm volatile("ds_read_b64_tr_b16 %0, %4\n\tds_read_b64_tr_b16 %1, %5\n\tds_read_b64_tr_b16 %2, %6\n\tds_read_b64_tr_b16 %3, %7\n\ts_waitcnt lgkmcnt(0)"
                 : "=&v"(r0), "=&v"(r1), "=&v"(r2), "=&v"(r3) : "v"(a0), "v"(a1), "v"(a2), "v"(a3) : "memory");
}
#define SHX(x, o) __builtin_bit_cast(float, __builtin_amdgcn_ds_bpermute(((lane) ^ (o)) << 2, __builtin_bit_cast(int, (float)(x))))
#define SHXU(x, o) ((unsigned)__builtin_amdgcn_ds_bpermute(((lane) ^ (o)) << 2, (int)(x)))
__device__ __forceinline__ float wave_sum(float v, int lane) {
#pragma unroll
    for (int o = 1; o < 64; o <<= 1) v += SHX(v, o);
    return v;
}
template <int OUT8 = 0>
__device__ __forceinline__ void conv_item(const GAS float* W, int ldw, int k0, int c0, int nvalid, GAS bf16* dst, int dld, int drow0, int dk0, float scale, const GAS float* gain, LAS float* scr, int lane) {
    const int c = lane & 31;
    float vin[32];
#pragma unroll
    for (int i = 0; i < 32; ++i) { const int kk = 2 * i + (lane >> 5); vin[i] = 0.f;
        if (c < nvalid) vin[i] = W[(size_t)(k0 + kk) * ldw + c0 + c]; }
#pragma unroll
    for (int i = 0; i < 32; ++i) { const int kk = 2 * i + (lane >> 5); scr[kk * 33 + c] = vin[i] * scale; }
    LDS_WAIT(); asm volatile("" ::: "memory");
    const int c8 = lane & 7;
    f32x4 ga = {1.f, 1.f, 1.f, 1.f}, gb = {1.f, 1.f, 1.f, 1.f};
    if (gain) { ga = *(const GAS f32x4*)(gain + k0 + 8 * c8); gb = *(const GAS f32x4*)(gain + k0 + 8 * c8 + 4); }
#pragma unroll
    for (int j = 0; j < 4; ++j) { const int n = (lane >> 3) + 8 * j; const LAS float* s = scr + (8 * c8) * 33 + n;
        if constexpr (OUT8 == 2) { const unsigned p = pg8::pack4_i8(s[0 * 33] * ga.x, s[1 * 33] * ga.y, s[2 * 33] * ga.z, s[3 * 33] * ga.w, 1.0f), q = pg8::pack4_i8(s[4 * 33] * gb.x, s[5 * 33] * gb.y, s[6 * 33] * gb.z, s[7 * 33] * gb.w, 1.0f);
            *(GAS unsigned long long*)((GAS unsigned char*)dst + (size_t)(drow0 + n) * dld + dk0 + k0 + 8 * c8) = (unsigned long long)p | ((unsigned long long)q << 32); }
        else if constexpr (OUT8 == 1) { int p = 0, q = 0;
            p = __builtin_amdgcn_cvt_pk_fp8_f32(s[0 * 33] * ga.x, s[1 * 33] * ga.y, p, false); p = __builtin_amdgcn_cvt_pk_fp8_f32(s[2 * 33] * ga.z, s[3 * 33] * ga.w, p, true);
            q = __builtin_amdgcn_cvt_pk_fp8_f32(s[4 * 33] * gb.x, s[5 * 33] * gb.y, q, false); q = __builtin_amdgcn_cvt_pk_fp8_f32(s[6 * 33] * gb.z, s[7 * 33] * gb.w, q, true);
            *(GAS unsigned long long*)((GAS unsigned char*)dst + (size_t)(drow0 + n) * dld + dk0 + k0 + 8 * c8) = (unsigned long long)(unsigned)p | ((unsigned long long)(unsigned)q << 32); }
        else { v4u o; o.x = pk2(s[0 * 33] * ga.x, s[1 * 33] * ga.y); o.y = pk2(s[2 * 33] * ga.z, s[3 * 33] * ga.w); o.z = pk2(s[4 * 33] * gb.x, s[5 * 33] * gb.y); o.w = pk2(s[6 * 33] * gb.z, s[7 * 33] * gb.w);
            *(GAS v4u*)(dst + (size_t)(drow0 + n) * dld + dk0 + k0 + 8 * c8) = o; } }
    LDS_WAIT(); asm volatile("" ::: "memory");
}
__device__ __forceinline__ void rmsnorm_rows_bf16(const GAS float* X, const GAS float* g, GAS bf16* O, int gw, int NGW, int lane) {
    f32x4 gv[8];
#pragma unroll
    for (int j = 0; j < 8; ++j) gv[j] = ((const GAS f32x4*)g)[lane + 64 * j];
    for (int m = gw; m < M; m += NGW) {
        const GAS f32x4* xr = (const GAS f32x4*)(X + (size_t)m * D) + lane;
        f32x4 v[8]; float s = 0.f;
#pragma unroll
        for (int j = 0; j < 8; ++j) { v[j] = xr[64 * j]; s += (v[j].x * v[j].x + v[j].y * v[j].y) + (v[j].z * v[j].z + v[j].w * v[j].w); }
        const float r = 1.0f / sqrtf(wave_sum(s, lane) * (1.0f / D) + EPS);
        GAS unsigned long long* o8 = (GAS unsigned long long*)(O + (size_t)m * D) + lane;
#pragma unroll
        for (int j = 0; j < 8; ++j) { const f32x4 y = v[j] * r * gv[j]; o8[64 * j] = (unsigned long long)pk2(y.x, y.y) | ((unsigned long long)pk2(y.z, y.w) << 32); }
    }
}
__device__ __forceinline__ void rows_bf16_ss(const GAS float* X, GAS bf16* O, GAS unsigned char* O8, GAS float* ss, int gw, int NGW, int lane) {
    for (int m = gw; m < M; m += NGW) {
        const GAS f32x4* xr = (const GAS f32x4*)(X + (size_t)m * D) + lane;
        f32x4 v[8]; float s = 0.f;
#pragma unroll
        for (int j = 0; j < 8; ++j) { v[j] = xr[64 * j]; s += (v[j].x * v[j].x + v[j].y * v[j].y) + (v[j].z * v[j].z + v[j].w * v[j].w); }
        s = wave_sum(s, lane);
        GAS unsigned long long* o8 = (GAS unsigned long long*)(O + (size_t)m * D) + lane;
#pragma unroll
        for (int j = 0; j < 8; ++j) o8[64 * j] = (unsigned long long)pk2(v[j].x, v[j].y) | ((unsigned long long)pk2(v[j].z, v[j].w) << 32);
        if (O8) { GAS unsigned* q8 = (GAS unsigned*)(O8 + (size_t)m * D) + lane;
#pragma unroll
            for (int j = 0; j < 8; ++j) { if constexpr (GU_I8) q8[64 * j] = pg8::pack4_i8(v[j].x, v[j].y, v[j].z, v[j].w, H8I_SCALE); else { int p = 0; p = __builtin_amdgcn_cvt_pk_fp8_f32(v[j].x, v[j].y, p, false); p = __builtin_amdgcn_cvt_pk_fp8_f32(v[j].z, v[j].w, p, true); q8[64 * j] = (unsigned)p; } } }
        if (lane < 32) ss[(size_t)m * 32 + lane] = lane == 0 ? s : 0.f;
    }
}
__device__ __forceinline__ void final_rows(const GAS bf16* HB, GAS float* OUT, const GAS float* g, const GAS float* ss, int gw, int NGW, int lane) {
    f32x4 gv[8];
#pragma unroll
    for (int j = 0; j < 8; ++j) gv[j] = ((const GAS f32x4*)g)[lane + 64 * j];
    for (int m = gw; m < M; m += NGW) {
        const GAS unsigned long long* hr = (const GAS unsigned long long*)(HB + (size_t)m * D) + lane; GAS f32x4* orow = (GAS f32x4*)(OUT + (size_t)m * D) + lane;
        unsigned long long raw[8];
#pragma unroll
        for (int j = 0; j < 8; ++j) raw[j] = hr[64 * j];
        const float r = 1.0f / sqrtf(wave_sum(lane < 32 ? ss[(size_t)m * 32 + lane] : 0.f, lane) * (1.0f / D) + EPS);
#pragma unroll
        for (int j = 0; j < 8; ++j) { const unsigned lo = (unsigned)raw[j], hi = (unsigned)(raw[j] >> 32);
            f32x4 v = {__builtin_bit_cast(float, lo << 16), __builtin_bit_cast(float, lo & 0xffff0000u), __builtin_bit_cast(float, hi << 16), __builtin_bit_cast(float, hi & 0xffff0000u)};
            orow[64 * j] = v * r * gv[j]; }
    }
}
__device__ __forceinline__ void rmsnorm_rows_f32_inplace(GAS float* X, const GAS float* g, int gw, int NGW, int lane) {
    f32x4 gv[8];
#pragma unroll
    for (int j = 0; j < 8; ++j) gv[j] = ((const GAS f32x4*)g)[lane + 64 * j];
    for (int m = gw; m < M; m += NGW) {
        GAS f32x4* xr = (GAS f32x4*)(X + (size_t)m * D) + lane;
        f32x4 v[8]; float s = 0.f;
#pragma unroll
        for (int j = 0; j < 8; ++j) { v[j] = xr[64 * j]; s += (v[j].x * v[j].x + v[j].y * v[j].y) + (v[j].z * v[j].z + v[j].w * v[j].w); }
        const float r = 1.0f / sqrtf(wave_sum(s, lane) * (1.0f / D) + EPS);
#pragma unroll
        for (int j = 0; j < 8; ++j) xr[64 * j] = v[j] * r * gv[j];
    }
}

template <bool P_IFAST, int OUT8 = 0>
__device__ __forceinline__ void absorb_unit(const GAS float* Psrc, size_t p_ri, size_t p_rd, const GAS float* Qsrc, size_t q_rj, GAS bf16* out, size_t out_ld, float scale, const GAS float* qgain, LAS float* Ps_, LAS float* Qs_, int tid) {
    LAS bf16* Ps = (LAS bf16*)Ps_; LAS bf16* Qs = Ps + 64 * 136;
    float pv[16], qv[16];
#pragma unroll
    for (int j = 0; j < 16; ++j) { const int e = tid + 512 * j; const int i = P_IFAST ? (e & 63) : (e >> 7), d = P_IFAST ? (e >> 6) : (e & 127);
        pv[j] = Psrc[(size_t)i * p_ri + (size_t)d * p_rd];
        const int jj = e >> 7, dd = e & 127; qv[j] = Qsrc[(size_t)jj * q_rj + dd] * (qgain ? qgain[jj] : 1.0f); }
#pragma unroll
    for (int j = 0; j < 16; ++j) { const int e = tid + 512 * j; const int i = P_IFAST ? (e & 63) : (e >> 7), d = P_IFAST ? (e >> 6) : (e & 127);
        Ps[i * 136 + d] = (bf16)f2bf(pv[j]); const int jj = e >> 7, dd = e & 127; Qs[jj * 136 + dd] = (bf16)f2bf(qv[j]); }
    __syncthreads();
    const int wv = tid >> 6, ln = tid & 63, it = wv >> 1, r16 = ln & 15, g = ln >> 4;
#pragma unroll
    for (int jq = 0; jq < 2; ++jq) { const int jt = 2 * (wv & 1) + jq; f32x4 acc = {0.f, 0.f, 0.f, 0.f};
#pragma unroll
        for (int st = 0; st < 4; ++st) { const bf16x8 a = *(const LAS bf16x8*)(Ps + (16 * it + r16) * 136 + 32 * st + 8 * g); const bf16x8 b = *(const LAS bf16x8*)(Qs + (16 * jt + r16) * 136 + 32 * st + 8 * g);
            acc = __builtin_amdgcn_mfma_f32_16x16x32_bf16(a, b, acc, 0, 0, 0); }
#pragma unroll
        for (int rg = 0; rg < 4; ++rg) { const size_t o = (size_t)(16 * it + 4 * g + rg) * out_ld + 16 * jt + r16;
            if constexpr (OUT8 == 2) ((GAS unsigned char*)out)[o] = (unsigned char)(pg8::pack4_i8(acc[rg], 0.f, 0.f, 0.f, scale) & 0xffu);
            else if constexpr (OUT8 == 1) ((GAS unsigned char*)out)[o] = (unsigned char)__builtin_amdgcn_cvt_pk_fp8_f32(acc[rg] * scale, 0.f, 0, false);
            else out[o] = (bf16)f2bf(acc[rg] * scale); } }
    __syncthreads();
}
__device__ __forceinline__ void post_rows(const GAS bf16* Z, const GAS float* gkv, const GAS float* gki, const GAS float* bki, GAS bf16* CKVN, GAS bf16* KIN, GAS float* WIF, int gw, int NGW, int lane) {
    const f32x4 g4 = ((const GAS f32x4*)gkv)[lane]; const float gk = gki[lane], bk = bki[lane];
    for (int m = gw; m < M; m += NGW) {
        const GAS bf16* zr = Z + (size_t)m * ZLD;
        const unsigned long long raw = *(const GAS unsigned long long*)(zr + ZC_CKV + 4 * lane);
        const float kraw = bf2f(zr[ZC_KI + lane]);
        const float wraw = bf2f(zr[ZC_WI + (lane & 7)]);
        const float c0 = bf2f((unsigned short)raw), c1 = bf2f((unsigned short)(raw >> 16)), c2 = bf2f((unsigned short)(raw >> 32)), c3 = bf2f((unsigned short)(raw >> 48));
        const float r = 1.0f / sqrtf(wave_sum((c0 * c0 + c1 * c1) + (c2 * c2 + c3 * c3), lane) * (1.0f / RANK) + EPS);
        *(GAS unsigned long long*)(CKVN + (size_t)m * RANK + 4 * lane) = (unsigned long long)pk2(c0 * r * g4.x, c1 * r * g4.y) | ((unsigned long long)pk2(c2 * r * g4.z, c3 * r * g4.w) << 32);
        const float mu = wave_sum(kraw, lane) * (1.0f / IDIM); const float dv = kraw - mu;
        const float var = wave_sum(dv * dv, lane) * (1.0f / IDIM);
        KIN[(size_t)m * IDIM + lane] = (bf16)f2bf(dv * (1.0f / sqrtf(var + EPS)) * gk + bk);
        if (lane < 8) WIF[(size_t)m * IH + lane] = wraw;
    }
}
constexpr int SWA_KP = 144, SWA_VP = 192;
constexpr int SWA_K_OFF = 0, SWA_V_OFF = 160 * SWA_KP, SWA_TAB_OFF = SWA_V_OFF + 160 * SWA_VP;
static_assert(SWA_TAB_OFF + 16 * 128 * 4 <= RING_BYTES, "SWA LDS map");
__device__ __forceinline__ void swa_phase(LAS unsigned char* lds, const GAS bf16* Z, GAS bf16* O, const GAS float* rel_bias, const GAS float* sinks, int vcu, int G, int tid, int lane, int wave) {
    LAS float* tab = (LAS float*)(lds + SWA_TAB_OFF);
    for (int e = tid; e < 16 * 128; e += NWAVES * 64) { const int h = e >> 7, dist = e & 127; tab[e] = rel_bias[(int)T5_BUCKET[dist] * 24 + H_A + h]; }
    __syncthreads();
    const int q = lane & 31, hh = lane >> 5;
    const unsigned ldsb = (unsigned)(size_t)lds;
    for (int item = vcu; item < BATCH * 128 * KVH; item += G) {
        const int kvh = item & 1, qt = (item >> 1) & 127, b = item >> 8;
        const int t0 = 32 * qt, s0 = t0 - 128;
        const size_t rowbase = (size_t)b * SEQ;
        for (int c = tid; c < 1280; c += NWAVES * 64) { const int row = c >> 3, ch = c & 7; const int s = s0 + row;
            if (s >= 0) { const GAS bf16* zr = Z + (rowbase + s) * ZLD + kvh * 64 + ch * 8;
                const v4u kv = *(const GAS v4u*)(zr + ZC_KB); const v4u vv = *(const GAS v4u*)(zr + ZC_VB);
                *(LAS v4u*)(lds + SWA_K_OFF + row * SWA_KP + ch * 16) = kv; *(LAS v4u*)(lds + SWA_V_OFF + row * SWA_VP + ch * 16) = vv; } }
        const int hq = kvh * 8 + wave; const int t = t0 + q;
        bf16x8 qf[4];
#pragma unroll
        for (int st = 0; st < 4; ++st) qf[st] = *(const GAS bf16x8*)(Z + (rowbase + t) * ZLD + ZC_QB + hq * 64 + 16 * st + 8 * hh);
        __syncthreads();
        const int kt0 = qt >= 4 ? 0 : 4 - qt;
        f32x16 sacc[5];
#pragma unroll
        for (int kt = 0; kt < 5; ++kt) {
#pragma unroll
            for (int r = 0; r < 16; ++r) sacc[kt][r] = 0.f;
            if (kt >= kt0) {
#pragma unroll
                for (int st = 0; st < 4; ++st) { const bf16x8 kf = *(const LAS bf16x8*)(lds + SWA_K_OFF + (kt * 32 + q) * SWA_KP + (2 * st + hh) * 16);
                    sacc[kt] = __builtin_amdgcn_mfma_f32_32x32x16_bf16(kf, qf[st], sacc[kt], 0, 0, 0); } } }
        const float sink = sinks[hq]; float mx = sink;
        const LAS float* tabh = tab + hq * 128;
#pragma unroll
        for (int kt = 0; kt < 5; ++kt) if (kt >= kt0) {
#pragma unroll
            for (int r = 0; r < 16; ++r) { const int ko = (r & 3) + 8 * (r >> 2) + 4 * hh; const int dist = q + 128 - 32 * kt - ko;
                const float lg = (dist >= 0 && dist < WINDOW) ? sacc[kt][r] + tabh[dist & 127] : -1e30f; sacc[kt][r] = lg; mx = fmaxf(mx, lg); } }
        mx = fmaxf(mx, SHX(mx, 32));
        float l = 0.f;
#pragma unroll
        for (int kt = 0; kt < 5; ++kt) if (kt >= kt0) {
#pragma unroll
            for (int r = 0; r < 16; ++r) { const float p = __expf(sacc[kt][r] - mx); sacc[kt][r] = p; l += p; } }
        l += SHX(l, 32); l += __expf(sink - mx);
        f32x16 oacc[2];
#pragma unroll
        for (int dt = 0; dt < 2; ++dt)
#pragma unroll
            for (int r = 0; r < 16; ++r) oacc[dt][r] = 0.f;
        const unsigned vlane = ldsb + SWA_V_OFF + (unsigned)((4 * hh + ((lane & 15) >> 2)) * SWA_VP + (16 * ((lane >> 4) & 1) + 4 * (lane & 3)) * 2);
#pragma unroll
        for (int kt = 0; kt < 5; ++kt) if (kt >= kt0) {
#pragma unroll
            for (int s2 = 0; s2 < 2; ++s2) {
                bf16x8 pf; { const unsigned w0 = pg8::cvt_pk_bf16(sacc[kt][8 * s2 + 0], sacc[kt][8 * s2 + 1]), w1 = pg8::cvt_pk_bf16(sacc[kt][8 * s2 + 2], sacc[kt][8 * s2 + 3]),
                                     w2 = pg8::cvt_pk_bf16(sacc[kt][8 * s2 + 4], sacc[kt][8 * s2 + 5]), w3 = pg8::cvt_pk_bf16(sacc[kt][8 * s2 + 6], sacc[kt][8 * s2 + 7]);
                    const v4u w = {w0, w1, w2, w3}; pf = __builtin_bit_cast(bf16x8, w); }
                const unsigned a = vlane + (unsigned)((kt * 32 + 16 * s2) * SWA_VP);
                s16x4 r0, r1, r2, r3; tr_read4(a, a + 8 * SWA_VP, a + 64, a + 8 * SWA_VP + 64, r0, r1, r2, r3);
                oacc[0] = __builtin_amdgcn_mfma_f32_32x32x16_bf16(cat4(r0, r1), pf, oacc[0], 0, 0, 0);
                oacc[1] = __builtin_amdgcn_mfma_f32_32x32x16_bf16(cat4(r2, r3), pf, oacc[1], 0, 0, 0); } }
        const float inv = (OUT_F8 ? O8_SCALE : 1.0f) / l;
        if constexpr (OUT_F8) { GAS unsigned char* orow = (GAS unsigned char*)O + (rowbase + t) * OLD + 2048 + hq * 64 + 4 * hh;
#pragma unroll
            for (int dt = 0; dt < 2; ++dt)
#pragma unroll
                for (int g4 = 0; g4 < 4; ++g4) { int p = 0; p = __builtin_amdgcn_cvt_pk_fp8_f32(oacc[dt][4 * g4] * inv, oacc[dt][4 * g4 + 1] * inv, p, false); p = __builtin_amdgcn_cvt_pk_fp8_f32(oacc[dt][4 * g4 + 2] * inv, oacc[dt][4 * g4 + 3] * inv, p, true);
                    *(GAS unsigned*)(orow + 32 * dt + 8 * g4) = (unsigned)p; } }
        else { GAS bf16* orow = O + (rowbase + t) * OLD + 2048 + hq * 64 + 4 * hh;
#pragma unroll
        for (int dt = 0; dt < 2; ++dt)
#pragma unroll
            for (int g4 = 0; g4 < 4; ++g4) { const unsigned long long w = (unsigned long long)pk2(oacc[dt][4 * g4] * inv, oacc[dt][4 * g4 + 1] * inv) | ((unsigned long long)pk2(oacc[dt][4 * g4 + 2] * inv, oacc[dt][4 * g4 + 3] * inv) << 32);
                *(GAS unsigned long long*)(orow + 32 * dt + 8 * g4) = w; } }
        __syncthreads();
    }
}
constexpr int TK_BINS = 512, TK_CAP = 256;
#define LDS_ADD(p) __hip_atomic_fetch_add((p), 1u, __ATOMIC_RELAXED, __HIP_MEMORY_SCOPE_WORKGROUP)
#define LDS_ADDV(p, v) __hip_atomic_fetch_add((p), (v), __ATOMIC_RELAXED, __HIP_MEMORY_SCOPE_WORKGROUP)
#define HIST_WORD(tok, bin) (((tok) * TK_BINS + (bin)) >> 1)
#define HIST_INC(bin) (1u << (((bin) & 1) * 16))
constexpr int TK_HIST_OFF = 0, TK_CSC_OFF = 32768, TK_CIX_OFF = TK_CSC_OFF + 32 * TK_CAP * 4, TK_SEL_OFF = TK_CIX_OFF + 32 * TK_CAP * 2, TK_CNT_OFF = TK_SEL_OFF + 32 * 256 * 2, TK_DUM_OFF = TK_CNT_OFF + 32 * 2 * 4, TK_KB_OFF = TK_DUM_OFF + 8 * 64 * 4, TK_KB_BYTES = 64 * 144, TK_FLAG_OFF = TK_KB_OFF + 2 * TK_KB_BYTES;
static_assert(TK_FLAG_OFF + 16 <= RING_BYTES, "top-k LDS map");
typedef _Float16 tk_h2 __attribute__((ext_vector_type(2)));
__device__ __forceinline__ void tk_score2(const f32x16& acc, const tk_h2 (&wh)[8], float& s0, float& s1) {
    tk_h2 s = {(_Float16)0, (_Float16)0}; const tk_h2 zero = {(_Float16)0, (_Float16)0};
#pragma unroll
    for (int h = 0; h < 8; ++h) { tk_h2 d = __builtin_bit_cast(tk_h2, __builtin_amdgcn_cvt_pkrtz(acc[h], acc[8 + h])); d = __builtin_elementwise_max(d, zero); s = __builtin_elementwise_fma(wh[h], d, s); }
    s0 = (float)s.x; s1 = (float)s.y;
}
__device__ __forceinline__ float tk_x(float s, float sc) { return fmaf(s, sc, 256.0f); }
__device__ __forceinline__ int tk_key(float s, float sc) {
    const float x = tk_x(s, sc); int b0 = (int)x; b0 = b0 < 0 ? 0 : (b0 > TK_BINS - 1 ? TK_BINS - 1 : b0);
    int sub = (int)((x - (float)b0) * 512.0f); sub = sub < 0 ? 0 : (sub > 511 ? 511 : sub);
    return b0 * 512 + sub;
}
__device__ __forceinline__ void tk_find(const LAS unsigned* h, unsigned need, int lane, int& bin_out, unsigned& above_out) {
    unsigned v[8]; unsigned s = 0;
#pragma unroll
    for (int i = 0; i < 4; ++i) { const unsigned w = h[4 * lane + i]; v[2 * i] = w & 0xffffu; v[2 * i + 1] = w >> 16; s += v[2 * i] + v[2 * i + 1]; }
    unsigned S = s;
#pragma unroll
    for (int o = 1; o < 64; o <<= 1) { const unsigned t = (unsigned)__builtin_amdgcn_ds_bpermute((lane + o) << 2, (int)S); if (lane + o < 64) S += t; }
    const unsigned long long mask = __ballot(S >= need);
    const int Lm = mask ? 63 - __builtin_clzll(mask) : 0;
    unsigned cum = S - s; int bsel = 8 * lane; unsigned ab = cum; bool found = false;
#pragma unroll
    for (int i = 7; i >= 0; --i) { if (!found) { if (cum + v[i] >= need) { bsel = 8 * lane + i; ab = cum; found = true; } else cum += v[i]; } }
    bin_out = __builtin_amdgcn_readlane(bsel, Lm); above_out = (unsigned)__builtin_amdgcn_readlane((int)ab, Lm);
}
__device__ __forceinline__ void topk_phase(LAS unsigned char* lds, const GAS bf16* Z, const GAS bf16* KIN, const GAS float* WIF, GAS unsigned short* IDX, int vcu, int G, int lane, int wave) {
    LAS unsigned* hist = (LAS unsigned*)(lds + TK_HIST_OFF) + wave * 4 * (TK_BINS / 2);
    LAS float* csc = (LAS float*)(lds + TK_CSC_OFF) + wave * 4 * TK_CAP;
    LAS unsigned short* cix = (LAS unsigned short*)(lds + TK_CIX_OFF) + wave * 4 * TK_CAP;
    LAS unsigned short* sel = (LAS unsigned short*)(lds + TK_SEL_OFF) + wave * 4 * 256;
    LAS unsigned* cnt = (LAS unsigned*)(lds + TK_CNT_OFF) + wave * 8;
    LAS unsigned* dum = (LAS unsigned*)(lds + TK_DUM_OFF) + wave * 64 + lane;
    const int n = lane & 31, c = lane >> 5;
    const int am = (lane >> 4) & 1, bbm = (lane >> 3) & 1, ccm = (lane >> 2) & 1, dm = lane & 3;
    for (int p2 = vcu; p2 < BATCH * 64; p2 += G) {
#pragma unroll 1
        for (int half = 0; half < 2; ++half) {
            const int b = p2 >> 6, jj = p2 & 63, j = half ? 127 - jj : jj;
            const int t0 = 32 * j + 4 * wave; const size_t rb = (size_t)b * SEQ;
            bf16x8 qa[4];
#pragma unroll
            for (int st = 0; st < 4; ++st) qa[st] = *(const GAS bf16x8*)(Z + (rb + t0 + 2 * ccm + am) * ZLD + ZC_QI + (4 * bbm + dm) * 64 + 16 * st + 8 * c);
            float w0[8], w1[8];
            { const GAS f32x4* wp = (const GAS f32x4*)(WIF + (rb + t0 + 2 * c) * IH); const f32x4 x0 = wp[0], x1 = wp[1], x2 = wp[2], x3 = wp[3];
              w0[0] = x0.x; w0[1] = x0.y; w0[2] = x0.z; w0[3] = x0.w; w0[4] = x1.x; w0[5] = x1.y; w0[6] = x1.z; w0[7] = x1.w;
              w1[0] = x2.x; w1[1] = x2.y; w1[2] = x2.z; w1[3] = x2.w; w1[4] = x3.x; w1[5] = x3.y; w1[6] = x3.z; w1[7] = x3.w; }
            tk_h2 wh[8];
#pragma unroll
            for (int h = 0; h < 8; ++h) { wh[h].x = (_Float16)w0[h]; wh[h].y = (_Float16)w1[h]; }
            float scA, scB;
            { float a = 0.f, bq = 0.f;
#pragma unroll
              for (int h = 0; h < 8; ++h) { a = fmaf(w0[h], w0[h], a); bq = fmaf(w1[h], w1[h], bq); }
              scA = 32.0f / fmaxf(sqrtf(32.0f * a), 1e-20f); scB = 32.0f / fmaxf(sqrtf(32.0f * bq), 1e-20f); }
            const int tA = t0 + 2 * c, tB = tA + 1;
            for (int i = lane; i < 4 * (TK_BINS / 2); i += 64) hist[i] = 0u;
            for (int i = lane; i < 4 * 128; i += 64) ((LAS unsigned*)sel)[i] = 0u;
            if (lane < 8) cnt[lane] = 0u;
            asm volatile("s_waitcnt lgkmcnt(0)" ::: "memory");
            int lo[4], hi[4]; unsigned ab0[4]; bool ov[4];
#pragma unroll
            for (int tk = 0; tk < 4; ++tk) { lo[tk] = 0x7fffffff; hi[tk] = -1; ab0[tk] = 0u; ov[tk] = false; }
            const bool need_sel = (t0 + 3) >= TOPK;
            const GAS bf16* kbase = KIN + (rb + n) * IDIM + 8 * c;
            const int tidk = wave * 64 + lane; const int ng = (j + 2) >> 1;
            const GAS bf16* kg0 = KIN + (rb + (tidk >> 3)) * IDIM + (tidk & 7) * 8; const int koff = (tidk >> 3) * 144 + (tidk & 7) * 16;
            LAS unsigned char* kbuf = lds + TK_KB_OFF; volatile LAS unsigned* sflag = (volatile LAS unsigned*)(lds + TK_FLAG_OFF);
            if (tidk == 0) *sflag = 0u;
#define TK_PRIME() { const v4u kr0 = *(const GAS v4u*)kg0; *(LAS v4u*)(kbuf + koff) = kr0; } __syncthreads();
#define TK_GROUP_BEGIN() \
                v4u kr = {0u, 0u, 0u, 0u}; const bool more = g + 1 < ng; \
                if (more) kr = *(const GAS v4u*)(kg0 + (size_t)(g + 1) * 64 * IDIM); \
                const LAS unsigned char* kb_ = kbuf + (g & 1) * TK_KB_BYTES; \
                float s0v[2], s1v[2];     \
                { f32x16 accv[2]; \
                  _Pragma("unroll") for (int u4 = 0; u4 < 2; ++u4) { _Pragma("unroll") for (int r = 0; r < 16; ++r) accv[u4][r] = 0.f; \
                    _Pragma("unroll") for (int st = 0; st < 4; ++st) { const bf16x8 kf = *(const LAS bf16x8*)(kb_ + (32 * u4 + n) * 144 + (2 * st + c) * 16); accv[u4] = __builtin_amdgcn_mfma_f32_32x32x16_bf16(qa[st], kf, accv[u4], 0, 0, 0); } } \
                  _Pragma("unroll") for (int u4 = 0; u4 < 2; ++u4) tk_score2(accv[u4], wh, s0v[u4], s1v[u4]); } \
                _Pragma("unroll") for (int u4 = 0; u4 < 2; ++u4) { \
                    const float s0 = s0v[u4], s1 = s1v[u4]; const int s = 32 * (2 * g + u4) + n;
#define TK_GROUP_END() } \
                if (more) *(LAS v4u*)(kbuf + ((g + 1) & 1) * TK_KB_BYTES + koff) = kr; \
                __syncthreads();
            bool slow = false;
            if (need_sel) {
                {   TK_PRIME();
#pragma unroll 1
                    for (int g = 0; g < ng; ++g) { TK_GROUP_BEGIN()
                        int b0 = (int)tk_x(s0, scA), b1 = (int)tk_x(s1, scB); b0 = b0 < 0 ? 0 : (b0 > TK_BINS - 1 ? TK_BINS - 1 : b0); b1 = b1 < 0 ? 0 : (b1 > TK_BINS - 1 ? TK_BINS - 1 : b1);
                        LAS unsigned* p0 = (s <= tA) ? &hist[HIST_WORD(2 * c, b0)] : dum; LAS unsigned* p1 = (s <= tB) ? &hist[HIST_WORD(2 * c + 1, b1)] : dum;
                        LDS_ADDV(p0, HIST_INC(b0)); LDS_ADDV(p1, HIST_INC(b1));
                        TK_GROUP_END() }
                }
                asm volatile("s_waitcnt lgkmcnt(0)" ::: "memory");
#pragma unroll
                for (int tk = 0; tk < 4; ++tk) { int bin; unsigned above; tk_find(hist + tk * (TK_BINS / 2), (unsigned)TOPK, lane, bin, above);
                    const unsigned ceq = (hist[HIST_WORD(tk, bin)] >> ((bin & 1) * 16)) & 0xffffu; ov[tk] = ceq > (unsigned)TK_CAP; slow |= ov[tk]; ab0[tk] = above; lo[tk] = bin * 512; hi[tk] = bin * 512 + 511; }
                if (slow && lane == 0) *sflag = 1u;
                __syncthreads();
                slow = *sflag != 0u;
            }
            if (!slow) {
                float thi[4], tlo[4];
#pragma unroll
                for (int tk = 0; tk < 4; ++tk) { const int bin = lo[tk] >> 9;
                    thi[tk] = !need_sel ? -__builtin_inff() : (bin >= TK_BINS - 1 ? __builtin_inff() : (float)(bin + 1));
                    tlo[tk] = !need_sel ? __builtin_inff() : (bin == 0 ? -__builtin_inff() : (float)bin); }
                const float thiA = c ? thi[2] : thi[0], tloA = c ? tlo[2] : tlo[0], thiB = c ? thi[3] : thi[1], tloB = c ? tlo[3] : tlo[1];
                unsigned cntA = 0u, cntB = 0u;
                LAS unsigned short* selA = sel + (2 * c) * 256; LAS unsigned short* selB = sel + (2 * c + 1) * 256; LAS unsigned short* dum16 = (LAS unsigned short*)dum;
                TK_PRIME();
#pragma unroll 1
                for (int g = 0; g < ng; ++g) { TK_GROUP_BEGIN()
                    const float x0 = (s <= tA) ? tk_x(s0, scA) : __builtin_nanf(""), x1 = (s <= tB) ? tk_x(s1, scB) : __builtin_nanf("");
                    const bool a0 = x0 >= thiA, a1 = x1 >= thiB; const bool c0 = !a0 && x0 >= tloA, c1 = !a1 && x1 >= tloB;
                    const unsigned long long m0 = __ballot(a0), m1 = __ballot(a1);
                    const unsigned pre0 = c ? __builtin_amdgcn_mbcnt_hi((unsigned)(m0 >> 32), 0u) : __builtin_amdgcn_mbcnt_lo((unsigned)m0, 0u);
                    const unsigned pre1 = c ? __builtin_amdgcn_mbcnt_hi((unsigned)(m1 >> 32), 0u) : __builtin_amdgcn_mbcnt_lo((unsigned)m1, 0u);
                    const unsigned pos0 = cntA + pre0, pos1 = cntB + pre1;
                    LAS unsigned short* q0 = (a0 && pos0 < 256u) ? selA + pos0 : dum16; LAS unsigned short* q1 = (a1 && pos1 < 256u) ? selB + pos1 : dum16;
                    *q0 = (unsigned short)s; *q1 = (unsigned short)s;
                    cntA += c ? (unsigned)__builtin_popcount((unsigned)(m0 >> 32)) : (unsigned)__builtin_popcount((unsigned)m0);
                    cntB += c ? (unsigned)__builtin_popcount((unsigned)(m1 >> 32)) : (unsigned)__builtin_popcount((unsigned)m1);
                    if (__ballot(c0 || c1)) {
                        if (c0) { const unsigned pos = LDS_ADD(&cnt[(2 * c) * 2 + 1]); if (pos < (unsigned)TK_CAP) { csc[(2 * c) * TK_CAP + pos] = s0; cix[(2 * c) * TK_CAP + pos] = (unsigned short)s; } }
                        if (c1) { const unsigned pos = LDS_ADD(&cnt[(2 * c + 1) * 2 + 1]); if (pos < (unsigned)TK_CAP) { csc[(2 * c + 1) * TK_CAP + pos] = s1; cix[(2 * c + 1) * TK_CAP + pos] = (unsigned short)s; } } }
                    TK_GROUP_END() }
                if ((lane & 31) == 0) { cnt[(2 * c) * 2] = cntA; cnt[(2 * c + 1) * 2] = cntB; }
                asm volatile("s_waitcnt lgkmcnt(0)" ::: "memory");
            } else {
                for (int i = lane; i < 4 * (TK_BINS / 2); i += 64) hist[i] = 0u;
                asm volatile("s_waitcnt lgkmcnt(0)" ::: "memory");
                int mode = 1;
#pragma unroll 1
                for (;;) {
                const int klo0 = c ? lo[2] : lo[0], khi0 = c ? hi[2] : hi[0], klo1 = c ? lo[3] : lo[1], khi1 = c ? hi[3] : hi[1];
                const bool ov0 = c ? ov[2] : ov[0], ov1 = c ? ov[3] : ov[1];
                bf16x8 kb[4][4];
#pragma unroll
                for (int u4 = 0; u4 < 4; ++u4) { const int kq = u4 < j ? u4 : j;
#pragma unroll
                    for (int st = 0; st < 4; ++st) kb[u4][st] = *(const GAS bf16x8*)(kbase + (size_t)kq * 32 * IDIM + 16 * st); }
#pragma unroll 1
                for (int kt = 0; kt <= j; kt += 4) {
                    bf16x8 kn[4][4];
#pragma unroll
                    for (int u4 = 0; u4 < 4; ++u4) { const int kq = kt + 4 + u4 < j ? kt + 4 + u4 : j;
#pragma unroll
                        for (int st = 0; st < 4; ++st) kn[u4][st] = *(const GAS bf16x8*)(kbase + (size_t)kq * 32 * IDIM + 16 * st); }
#pragma unroll
                    for (int u4 = 0; u4 < 4; ++u4) {
                        f32x16 acc;
#pragma unroll
                        for (int r = 0; r < 16; ++r) acc[r] = 0.f;
#pragma unroll
                        for (int st = 0; st < 4; ++st) acc = __builtin_amdgcn_mfma_f32_32x32x16_bf16(qa[st], kb[u4][st], acc, 0, 0, 0);
                        float s0, s1; tk_score2(acc, wh, s0, s1);
                        const int s = 32 * (kt + u4) + n; const int k0 = tk_key(s0, scA), k1 = tk_key(s1, scB);
                        const bool v0 = s <= tA, v1 = s <= tB;
                        if (mode == 0) {
                            if (v0 && tA >= TOPK) LDS_ADDV(&hist[HIST_WORD(2 * c, k0 >> 9)], HIST_INC(k0 >> 9));
                            if (v1 && tB >= TOPK) LDS_ADDV(&hist[HIST_WORD(2 * c + 1, k1 >> 9)], HIST_INC(k1 >> 9));
                        } else if (mode == 1) {
                            if (v0 && ov0 && k0 >= klo0 && k0 <= khi0) LDS_ADDV(&hist[HIST_WORD(2 * c, k0 & 511)], HIST_INC(k0 & 511));
                            if (v1 && ov1 && k1 >= klo1 && k1 <= khi1) LDS_ADDV(&hist[HIST_WORD(2 * c + 1, k1 & 511)], HIST_INC(k1 & 511));
                        } else {
                            if (v0) { if (k0 > khi0) { const unsigned pos = LDS_ADD(&cnt[(2 * c) * 2]); if (pos < 256u) sel[(2 * c) * 256 + pos] = (unsigned short)s; }
                                      else if (k0 >= klo0) { const unsigned pos = LDS_ADD(&cnt[(2 * c) * 2 + 1]); if (pos < (unsigned)TK_CAP) { csc[(2 * c) * TK_CAP + pos] = s0; cix[(2 * c) * TK_CAP + pos] = (unsigned short)s; } } }
                            if (v1) { if (k1 > khi1) { const unsigned pos = LDS_ADD(&cnt[(2 * c + 1) * 2]); if (pos < 256u) sel[(2 * c + 1) * 256 + pos] = (unsigned short)s; }
                                      else if (k1 >= klo1) { const unsigned pos = LDS_ADD(&cnt[(2 * c + 1) * 2 + 1]); if (pos < (unsigned)TK_CAP) { csc[(2 * c + 1) * TK_CAP + pos] = s1; cix[(2 * c + 1) * TK_CAP + pos] = (unsigned short)s; } } }
                        }
                    }
#pragma unroll
                    for (int u4 = 0; u4 < 4; ++u4)
#pragma unroll
                        for (int st = 0; st < 4; ++st) kb[u4][st] = kn[u4][st];
                }
                    asm volatile("s_waitcnt lgkmcnt(0)" ::: "memory");
                    if (mode == 2) break;
#pragma unroll
                    for (int tk = 0; tk < 4; ++tk) if (ov[tk]) { int sub; unsigned above; tk_find(hist + tk * (TK_BINS / 2), (unsigned)TOPK - ab0[tk], lane, sub, above); lo[tk] += sub; hi[tk] = lo[tk]; }
                    mode = 2;
                }
            }
#undef TK_GROUP_BEGIN
#undef TK_GROUP_END
#undef TK_PRIME
#pragma unroll 1
            for (int tk = 0; tk < 4; ++tk) { const int t = t0 + tk;
                if (t >= TOPK) { const unsigned nsel = cnt[tk * 2]; unsigned nc = cnt[tk * 2 + 1]; nc = nc > (unsigned)TK_CAP ? (unsigned)TK_CAP : nc; const unsigned need = nsel < 256u ? 256u - nsel : 0u;
                    for (unsigned q = 0; q * 64 < nc; ++q) { const unsigned i = lane + 64 * q;
                        const float si = i < nc ? csc[tk * TK_CAP + i] : 0.f; const unsigned xi = i < nc ? cix[tk * TK_CAP + i] : 0u; unsigned rank = 0;
                        for (unsigned jx = 0; jx < nc; ++jx) { const float sj = csc[tk * TK_CAP + jx]; const unsigned xj = cix[tk * TK_CAP + jx]; rank += (sj > si || (sj == si && xj < xi)) ? 1u : 0u; }
                        if (i < nc && rank < need) sel[tk * 256 + nsel + rank] = (unsigned short)xi; } } }
            asm volatile("s_waitcnt lgkmcnt(0)" ::: "memory");
            { const LAS v4u* sv = (const LAS v4u*)sel; GAS v4u* ov = (GAS v4u*)(IDX + (rb + t0) * TOPK);
              ov[lane] = sv[lane]; ov[lane + 64] = sv[lane + 64]; }
            asm volatile("s_waitcnt vmcnt(0) lgkmcnt(0)" ::: "memory");
        }
    }
}
constexpr int DSA_TAB_OFF = RING_BYTES + 1024;
constexpr int DSA_IDX_OFF = DSA_TAB_OFF + 4224;
static_assert(8 * 129 * 4 <= 4224 && DSA_IDX_OFF + 8 * 1024 <= LDS_BYTES, "DSA LDS map");
__device__ __forceinline__ void dsa_phase(LAS unsigned char* lds_all, const GAS bf16* Z, const GAS bf16* CKVN, const GAS unsigned short* IDX, GAS bf16* O, const GAS float* rel_bias, int gw, int NGW, int tid, int lane, int wave) {
    LAS float* tab = (LAS float*)(lds_all + DSA_TAB_OFF);
    for (int e = tid; e < 8 * 129; e += NWAVES * 64) { const int hh = e / 129, dist = e - hh * 129; tab[e] = rel_bias[(dist < 128 ? (int)T5_BUCKET[dist] : 31) * 24 + hh]; }
    __syncthreads();
    LAS unsigned char* img = lds_all + RING_OFF + wave * 16384;
    LAS unsigned short* ib = (LAS unsigned short*)(lds_all + DSA_IDX_OFF + wave * 1024);
    const unsigned imgb = (unsigned)(size_t)img;
    const int h = lane & 15, g = lane >> 4, hi = lane >> 5;
    const LAS float* tabh = tab + (h & 7) * 129;
    const int TPW = (M + NGW - 1) / NGW;
    const int tok0 = gw * TPW;
    const int tok_end = (gw + 1) * TPW < M ? (gw + 1) * TPW : M;
    const int xq = 2 * (lane & 7);
    unsigned qa[8];
#pragma unroll
    for (int st = 0; st < 8; ++st) qa[st] = imgb + (unsigned)((lane & 15) * 512 + (((4 * st + g) ^ xq) * 16));
    const int q4 = (lane & 15) >> 2, p4 = lane & 3; const int xr = 2 * (4 * (g & 1) + q4);
    const unsigned pv_base = imgb + (unsigned)((4 * g + q4) * 512 + 8 * (p4 & 1));
    unsigned pva[16];
#pragma unroll
    for (int c2 = 0; c2 < 16; ++c2) pva[c2] = pv_base + (unsigned)((((2 * c2) ^ xr) | (p4 >> 1)) * 16);
    unsigned lc[4];
#pragma unroll
    for (int k = 0; k < 4; ++k) lc[k] = (unsigned)(((lane & 31) ^ (2 * ((2 * k + hi) & 7))) * 16);
    if (tok0 < tok_end) *(LAS unsigned long long*)(ib + 4 * lane) = *(const GAS unsigned long long*)(IDX + (size_t)tok0 * TOPK + 4 * lane);
#pragma unroll 1
    for (int tok = tok0; tok < tok_end; ++tok) {
        const int t = tok & (SEQ - 1); const size_t rb = (size_t)(tok - t);
        const int nsel = t + 1 < TOPK ? t + 1 : TOPK;
        const LAS unsigned short* cur = ib + ((tok - tok0) & 1) * 256;
        const unsigned long long nxi = tok + 1 < tok_end ? *(const GAS unsigned long long*)(IDX + (size_t)(tok + 1) * TOPK + 4 * lane) : 0ull;
        bf16x8 qf[8];
#pragma unroll
        for (int st = 0; st < 8; ++st) { qf[st] = *(const GAS bf16x8*)(Z + (size_t)tok * ZLD + ZC_QLAT + (h & 7) * 256 + 32 * st + 8 * g); if (h >= 8) qf[st] = (bf16x8){0, 0, 0, 0, 0, 0, 0, 0}; }
        f32x4 oacc[16];
#pragma unroll
        for (int rt = 0; rt < 16; ++rt) oacc[rt] = (f32x4){0.f, 0.f, 0.f, 0.f};
        float mrun = -1e30f, lsum = 0.f;
        const GAS unsigned char* cb = (const GAS unsigned char*)(CKVN + rb * RANK);
#pragma unroll
        for (int ch = 0; ch < 8; ++ch) {
            if (32 * ch >= nsel) break;
            unsigned rix[16];
#pragma unroll
            for (int i = 0; i < 16; ++i) rix[i] = cur[32 * ch + 2 * i + hi];
            const unsigned long long i0 = *(const LAS unsigned long long*)(cur + 32 * ch + 4 * g), i1 = *(const LAS unsigned long long*)(cur + 32 * ch + 16 + 4 * g);
            asm volatile("s_waitcnt lgkmcnt(0)" ::: "memory");
#pragma unroll
            for (int i = 0; i < 16; ++i) __builtin_amdgcn_global_load_lds((const GAS unsigned*)(cb + ((rix[i] << 9) + lc[i & 3])), (LAS unsigned*)(img + i * 1024), 16, 0, 0);
            asm volatile("s_waitcnt vmcnt(0)" ::: "memory");
            v4u fa[16];
            asm volatile("ds_read_b128 %0, %8\n\tds_read_b128 %1, %8 offset:8192\n\tds_read_b128 %2, %9\n\tds_read_b128 %3, %9 offset:8192\n\t"
                         "ds_read_b128 %4, %10\n\tds_read_b128 %5, %10 offset:8192\n\tds_read_b128 %6, %11\n\tds_read_b128 %7, %11 offset:8192"
                         : "=&v"(fa[0]), "=&v"(fa[1]), "=&v"(fa[2]), "=&v"(fa[3]), "=&v"(fa[4]), "=&v"(fa[5]), "=&v"(fa[6]), "=&v"(fa[7])
                         : "v"(qa[0]), "v"(qa[1]), "v"(qa[2]), "v"(qa[3]) : "memory");
            asm volatile("ds_read_b128 %0, %16\n\tds_read_b128 %1, %16 offset:8192\n\tds_read_b128 %2, %17\n\tds_read_b128 %3, %17 offset:8192\n\t"
                         "ds_read_b128 %4, %18\n\tds_read_b128 %5, %18 offset:8192\n\tds_read_b128 %6, %19\n\tds_read_b128 %7, %19 offset:8192\n\ts_waitcnt lgkmcnt(8)"
                         : "=&v"(fa[8]), "=&v"(fa[9]), "=&v"(fa[10]), "=&v"(fa[11]), "=&v"(fa[12]), "=&v"(fa[13]), "=&v"(fa[14]), "=&v"(fa[15]),
                           "+v"(fa[0]), "+v"(fa[1]), "+v"(fa[2]), "+v"(fa[3]), "+v"(fa[4]), "+v"(fa[5]), "+v"(fa[6]), "+v"(fa[7])
                         : "v"(qa[4]), "v"(qa[5]), "v"(qa[6]), "v"(qa[7]) : "memory");
            f32x4 sa[2] = {(f32x4){0.f, 0.f, 0.f, 0.f}, (f32x4){0.f, 0.f, 0.f, 0.f}};
#pragma unroll
            for (int st = 0; st < 4; ++st) { sa[0] = __builtin_amdgcn_mfma_f32_16x16x32_bf16(__builtin_bit_cast(bf16x8, fa[2 * st]), qf[st], sa[0], 0, 0, 0);
                sa[1] = __builtin_amdgcn_mfma_f32_16x16x32_bf16(__builtin_bit_cast(bf16x8, fa[2 * st + 1]), qf[st], sa[1], 0, 0, 0); }
            s16x4 pr[2][4];
            asm volatile("s_waitcnt lgkmcnt(0)\n\tds_read_b64_tr_b16 %0, %12\n\tds_read_b64_tr_b16 %1, %12 offset:8192\n\tds_read_b64_tr_b16 %2, %13\n\tds_read_b64_tr_b16 %3, %13 offset:8192"
                         : "=&v"(pr[0][0]), "=&v"(pr[0][1]), "=&v"(pr[0][2]), "=&v"(pr[0][3]),
                           "+v"(fa[8]), "+v"(fa[9]), "+v"(fa[10]), "+v"(fa[11]), "+v"(fa[12]), "+v"(fa[13]), "+v"(fa[14]), "+v"(fa[15])
                         : "v"(pva[0]), "v"(pva[1]) : "memory");
#pragma unroll
            for (int st = 4; st < 8; ++st) { sa[0] = __builtin_amdgcn_mfma_f32_16x16x32_bf16(__builtin_bit_cast(bf16x8, fa[2 * st]), qf[st], sa[0], 0, 0, 0);
                sa[1] = __builtin_amdgcn_mfma_f32_16x16x32_bf16(__builtin_bit_cast(bf16x8, fa[2 * st + 1]), qf[st], sa[1], 0, 0, 0); }
            float bz[8];
#pragma unroll
            for (int e = 0; e < 8; ++e) { const int tl = e >> 2, jx = e & 3; const int sidx = (int)(((tl ? i1 : i0) >> (16 * jx)) & 0xffffull); int dd = t - sidx; dd = dd < 0 ? 0 : (dd > 128 ? 128 : dd); bz[e] = tabh[dd]; }
            float lg[8]; float cmax = -1e30f;
#pragma unroll
            for (int e = 0; e < 8; ++e) { const int tl = e >> 2, jx = e & 3; const int kk = 32 * ch + 16 * tl + 4 * g + jx;
                const float v = kk < nsel ? sa[tl][jx] + bz[e] : -1e30f; lg[e] = v; cmax = fmaxf(cmax, v); }
            cmax = fmaxf(cmax, SHX(cmax, 16)); cmax = fmaxf(cmax, SHX(cmax, 32));
            const float mnew = fmaxf(mrun, cmax);
            if (__any(mnew > mrun)) { const float alpha = __expf(mrun - mnew); lsum *= alpha;
#pragma unroll
                for (int rt = 0; rt < 16; ++rt) oacc[rt] = oacc[rt] * alpha; }
            mrun = mnew;
            float pe[8];
#pragma unroll
            for (int e = 0; e < 8; ++e) { pe[e] = __expf(lg[e] - mnew); lsum += pe[e]; }
            bf16x8 pf; { const v4u wv = {pg8::cvt_pk_bf16(pe[0], pe[1]), pg8::cvt_pk_bf16(pe[2], pe[3]), pg8::cvt_pk_bf16(pe[4], pe[5]), pg8::cvt_pk_bf16(pe[6], pe[7])}; pf = __builtin_bit_cast(bf16x8, wv); }
#pragma unroll
            for (int j = 0; j < 8; ++j) {
                const int cs = j & 1, ns = cs ^ 1;
                if (j < 7) asm volatile("ds_read_b64_tr_b16 %0, %8\n\tds_read_b64_tr_b16 %1, %8 offset:8192\n\tds_read_b64_tr_b16 %2, %9\n\tds_read_b64_tr_b16 %3, %9 offset:8192\n\ts_waitcnt lgkmcnt(4)"
                                        : "=&v"(pr[ns][0]), "=&v"(pr[ns][1]), "=&v"(pr[ns][2]), "=&v"(pr[ns][3]), "+v"(pr[cs][0]), "+v"(pr[cs][1]), "+v"(pr[cs][2]), "+v"(pr[cs][3])
                                        : "v"(pva[2 * j + 2]), "v"(pva[2 * j + 3]) : "memory");
                else asm volatile("s_waitcnt lgkmcnt(0)" : "+v"(pr[cs][0]), "+v"(pr[cs][1]), "+v"(pr[cs][2]), "+v"(pr[cs][3]) :: "memory");
                oacc[2 * j] = __builtin_amdgcn_mfma_f32_16x16x32_bf16(cat4(pr[cs][0], pr[cs][1]), pf, oacc[2 * j], 0, 0, 0);
                oacc[2 * j + 1] = __builtin_amdgcn_mfma_f32_16x16x32_bf16(cat4(pr[cs][2], pr[cs][3]), pf, oacc[2 * j + 1], 0, 0, 0); }
        }
        if (tok + 1 < tok_end) *(LAS unsigned long long*)(ib + (((tok - tok0) & 1) ^ 1) * 256 + 4 * lane) = nxi;
        lsum += SHX(lsum, 16); lsum += SHX(lsum, 32);
        const float inv = (OUT_F8 ? O8_SCALE : 1.0f) / lsum;
        if (h < 8) {
            if constexpr (OUT_F8) { GAS unsigned char* orow = (GAS unsigned char*)O + (size_t)tok * OLD + h * 256 + 4 * g;
#pragma unroll
                for (int rt = 0; rt < 16; ++rt) { int p = 0; p = __builtin_amdgcn_cvt_pk_fp8_f32(oacc[rt][0] * inv, oacc[rt][1] * inv, p, false); p = __builtin_amdgcn_cvt_pk_fp8_f32(oacc[rt][2] * inv, oacc[rt][3] * inv, p, true); *(GAS unsigned*)(orow + 16 * rt) = (unsigned)p; } }
            else { GAS bf16* orow = O + (size_t)tok * OLD + h * 256 + 4 * g;
#pragma unroll
            for (int rt = 0; rt < 16; ++rt) *(GAS unsigned long long*)(orow + 16 * rt) = (unsigned long long)pk2(oacc[rt][0] * inv, oacc[rt][1] * inv) | ((unsigned long long)pk2(oacc[rt][2] * inv, oacc[rt][3] * inv) << 32); } }
    }
}
struct Args { const float* in[20]; float* out; unsigned char* ws; };
__device__ __forceinline__ unsigned long long karg_u64(int idx) { unsigned long long r; const unsigned off = (unsigned)idx * 8u;
    asm volatile("s_load_dwordx2 %0, %1, %2\n\ts_waitcnt lgkmcnt(0)" : "=s"(r) : "s"(__builtin_amdgcn_kernarg_segment_ptr()), "s"(off) : "memory"); return r; }
__device__ __forceinline__ const GAS float* karg_in(int i) { return (const GAS float*)karg_u64(i); }
__device__ __forceinline__ GAS float* karg_out() { return (GAS float*)karg_u64(20); }
__device__ __forceinline__ GAS unsigned char* karg_ws() { return (GAS unsigned char*)karg_u64(21); }
#ifndef REP_P0
#define REP_P0 1
#endif
#ifndef REP_NORM
#define REP_NORM 1
#endif
#ifndef REP_GU
#define REP_GU 1
#endif
#ifndef REP_IN
#define REP_IN 1
#endif
#ifndef REP_POST
#define REP_POST 1
#endif
#ifndef REP_TOPK
#define REP_TOPK 1
#endif
#ifndef REP_DSA
#define REP_DSA 1
#endif
#define REPEAT(n) _Pragma("unroll 1") for (int rep_ = 0; rep_ < (n); ++rep_)
#define PHASE_IDS() int wave = wave0; asm volatile("" : "+s"(wave)); int lane; asm volatile("v_mbcnt_lo_u32_b32 %0, -1, 0\n\tv_mbcnt_hi_u32_b32 %0, -1, %0" : "=v"(lane)); const int tid = wave * 64 + lane; int bx = blockIdx.x; asm volatile("" : "+s"(bx)); int G = gridDim.x; asm volatile("" : "+s"(G)); \
    const int vcu = (G % 8 == 0) ? (bx % 8) * (G / 8) + bx / 8 : bx; const int gw = vcu * NWAVES + wave, NGW = G * NWAVES; \
    GAS unsigned char* ws = karg_ws(); (void)lane; (void)gw; (void)NGW; (void)vcu; (void)ws
__global__ void __launch_bounds__(NWAVES * 64, 2) mk_fwd(Args args) {
    extern __shared__ __attribute__((aligned(16))) unsigned char lds_raw[];
    LAS unsigned char* lds = (LAS unsigned char*)lds_raw;
    volatile LAS unsigned* MISC = (volatile LAS unsigned*)(lds + MISC_OFF);
    const int wave0 = __builtin_amdgcn_readfirstlane(threadIdx.x >> 6);
    for (int u = threadIdx.x; u < (LDS_BYTES - LDSCTL_OFF) / 4; u += NWAVES * 64) ((LAS unsigned*)(lds + LDSCTL_OFF))[u] = 0u;
    __syncthreads();
    (void)xcd_barrier_post((unsigned*)((gu32*)(karg_ws() + WS_CTL) + CW_BAR), MISC + 8, threadIdx.x == 0);
#define GRID_BAR() do { XcdBarrier b_; b_.bar = (unsigned*)((gu32*)(karg_ws() + WS_CTL) + CW_BAR); b_.x = xb_xcc_id(); b_.st = MISC + 8; int w_ = wave0; asm volatile("" : "+s"(w_)); int l_; asm volatile("v_mbcnt_lo_u32_b32 %0, -1, 0\n\tv_mbcnt_hi_u32_b32 %0, -1, %0" : "=v"(l_)); xcd_barrier(b_, (w_ | l_) == 0); } while (0)

    REPEAT(REP_P0) {   PHASE_IDS();
        LAS float* scr = (LAS float*)(lds + RING_OFF + wave * 16384);
        rows_bf16_ss(karg_in(0), (GAS bf16*)(ws + WS_XN), f8_on(0, 0) ? (GAS unsigned char*)(ws + WS_HB8) : (GAS unsigned char*)nullptr, (GAS float*)(ws + WS_SS), gw, NGW, lane);
        constexpr int I_GU = (D / 64) * (FF / 32), I_DN = (FF / 64) * (D / 32);
        constexpr int I_FFN = 2 * I_GU + I_DN, I_IN = 72 * (D / 64), I_OB = (1024 / 64) * (D / 32);
        constexpr int PER_LAYER = 2 * I_FFN + I_IN + I_OB;
        for (int it = gw; it < DEPTH * PER_LAYER; it += NGW) {
            const int l = it / PER_LAYER; int r = it - l * PER_LAYER;
            GAS unsigned char* wl = ws + WS_W0 + (size_t)l * W_LAYER;
            if (r < 2 * I_FFN) {
                const int f = r / I_FFN; r -= f * I_FFN;
                GAS bf16* dgu = (GAS bf16*)(wl + (f ? WO_GU2 : WO_GU1)); GAS bf16* dd = (GAS bf16*)(wl + (f ? WO_D2 : WO_D1));
                if (r < 2 * I_GU) { const int up = r >= I_GU; if (up) r -= I_GU; const int kb = r / (FF / 32), nb = r % (FF / 32), n0 = 32 * nb;
                    const GAS float* wsrc = karg_in(up ? (f ? 17 : 4) : (f ? 16 : 3)) + (size_t)l * D * FF;
                    const int drow = (n0 >> 7) * 256 + (up ? 128 : 0) + (n0 & 127);
                    if (f8_on(l, f)) { if constexpr (GU_I8) conv_item<2>(wsrc, FF, 64 * kb, n0, 32, dgu, D, drow, 0, W8I_SCALE, karg_in(f ? 15 : 2) + (size_t)l * D, scr, lane); else conv_item<1>(wsrc, FF, 64 * kb, n0, 32, dgu, D, drow, 0, W8_SCALE, karg_in(f ? 15 : 2) + (size_t)l * D, scr, lane); }
                    else conv_item(wsrc, FF, 64 * kb, n0, 32, dgu, D, drow, 0, 1.0f, karg_in(f ? 15 : 2) + (size_t)l * D, scr, lane); }
                else { r -= 2 * I_GU; const int kb = r / (D / 32), nb = r % (D / 32);
                    if (d8_on(l, f)) conv_item<1>(karg_in(f ? 18 : 5) + (size_t)l * FF * D, D, 64 * kb, 32 * nb, 32, dd, FF, 32 * nb, 0, W8_SCALE, nullptr, scr, lane);
                    else conv_item(karg_in(f ? 18 : 5) + (size_t)l * FF * D, D, 64 * kb, 32 * nb, 32, dd, FF, 32 * nb, 0, 1.0f, nullptr, scr, lane); }
            } else if (r < 2 * I_FFN + I_IN) {
                r -= 2 * I_FFN; const int j = r >> 5, kb = r & 31; int src, nvalid = 32; float sc = 1.0f;
                if (j < 8) src = 1024 + 32 * j;
                else if (j < 40) src = 1864 + 32 * (j - 8);
                else if (j < 44) src = 2888 + 32 * (j - 40);
                else if (j < 48) src = 3016 + 32 * (j - 44);
                else if (j < 64) src = 1280 + 32 * (j - 48);
                else if (j < 66) src = 1792 + 32 * (j - 64);
                else if (j == 66) { src = 1856; nvalid = 8; sc = 0.044194173824159216f; }
                else { src = 0; nvalid = 0; }
                const GAS float* win = karg_in(7) + (size_t)l * D * D_IN; const GAS float* gmix = karg_in(6) + (size_t)l * D;
                if (IN_I8 && j < 48) conv_item<2>(win, D_IN, 64 * kb, src, nvalid, (GAS bf16*)(wl + WO_IN), D, 2048 + 32 * j, 0, W8I_SCALE, gmix, scr, lane);
                else if (IN_I8) conv_item(win, D_IN, 64 * kb, src, nvalid, (GAS bf16*)(wl + WO_IN + (size_t)ZN8 * D), D, 32 * (j - 48), 0, sc, gmix, scr, lane);
                else conv_item(win, D_IN, 64 * kb, src, nvalid, (GAS bf16*)(wl + WO_IN), D, 2048 + 32 * j, 0, (j >= 8 && j < 40) ? 0.125f : sc, gmix, scr, lane);
            } else {
                r -= 2 * I_FFN + I_IN; const int kb = r >> 6, nb = r & 63;
                if constexpr (OUT_F8) conv_item<1>(karg_in(14) + (size_t)l * D * D + (size_t)1024 * D, D, 64 * kb, 32 * nb, 32, (GAS bf16*)(wl + WO_OUT), OLD, 32 * nb, 2048, W8_SCALE, nullptr, scr, lane);
                else conv_item(karg_in(14) + (size_t)l * D * D + (size_t)1024 * D, D, 64 * kb, 32 * nb, 32, (GAS bf16*)(wl + WO_OUT), OLD, 32 * nb, 2048, 1.0f, nullptr, scr, lane);
            }
        }
        __syncthreads();
        LAS float* Ps = (LAS float*)(lds + RING_OFF); LAS float* Qs = Ps + 64 * 129;
        for (int u = vcu; u < DEPTH * 2048; u += G) {
            const int l = u >> 11, which = (u >> 10) & 1, v = u & 1023;
            GAS unsigned char* wl = ws + WS_W0 + (size_t)l * W_LAYER;
            if (which == 0) { const int h = v >> 7, rt = (v >> 5) & 3, kt = v & 31;
                if constexpr (IN_I8) absorb_unit<false, 2>(karg_in(11) + (size_t)l * RANK * 1024 + ((size_t)(64 * rt) * 8 + h) * 128, 1024, 1, karg_in(7) + (size_t)l * D * D_IN + (size_t)(64 * kt) * D_IN + h * 128, D_IN,
                                   (GAS bf16*)((GAS unsigned char*)(wl + WO_IN) + (size_t)(h * 256 + 64 * rt) * D + 64 * kt), D, WQ8I_SCALE, karg_in(6) + (size_t)l * D + 64 * kt, Ps, Qs, tid);
                else absorb_unit<false>(karg_in(11) + (size_t)l * RANK * 1024 + ((size_t)(64 * rt) * 8 + h) * 128, 1024, 1, karg_in(7) + (size_t)l * D * D_IN + (size_t)(64 * kt) * D_IN + h * 128, D_IN,
                                   (GAS bf16*)(wl + WO_IN) + (size_t)(h * 256 + 64 * rt) * D + 64 * kt, D, 0.08838834764831845f, karg_in(6) + (size_t)l * D + 64 * kt, Ps, Qs, tid); }
            else { const int h = v >> 7, nt = (v >> 2) & 31, rt = v & 3;
                if constexpr (OUT_F8) absorb_unit<true, 1>(karg_in(14) + (size_t)l * D * D + (size_t)(h * 128) * D + 64 * nt, 1, D, karg_in(12) + (size_t)l * RANK * 1024 + ((size_t)(64 * rt) * 8 + h) * 128, 1024,
                                  (GAS bf16*)((GAS unsigned char*)(wl + WO_OUT) + (size_t)(64 * nt) * OLD + h * 256 + 64 * rt), OLD, W8_SCALE, nullptr, Ps, Qs, tid);
                else absorb_unit<true>(karg_in(14) + (size_t)l * D * D + (size_t)(h * 128) * D + 64 * nt, 1, D, karg_in(12) + (size_t)l * RANK * 1024 + ((size_t)(64 * rt) * 8 + h) * 128, 1024,
                                  (GAS bf16*)(wl + WO_OUT) + (size_t)(64 * nt) * OLD + h * 256 + 64 * rt, OLD, 1.0f, nullptr, Ps, Qs, tid); }
        }
    }
    GRID_BAR();

#pragma unroll 1
    for (int s = 0; s < 2 * DEPTH; ++s) {
        const int l = s >> 1, f = s & 1;
        REPEAT(REP_GU) {   PHASE_IDS(); GAS unsigned char* wl = ws + WS_W0 + (size_t)l * W_LAYER;
            pg8::StaticOrder S; S.init(M, NGU, G, bx);
            const GAS float* ssp = (const GAS float*)(ws + WS_SS + (size_t)((3 * l + 2 * f) & 1) * SS_BYTES);
            if ((F8_MASK == 0xF) || (F8_MASK != 0 && f8_on(l, f))) {
                if constexpr (F8_MASK != 0) {
                    pg8::Gemm g{(const GAS bf16*)(ws + WS_HB8), (const GAS bf16*)(wl + (f ? WO_GU2 : WO_GU1)), M, NGU, D / 2};
                    if constexpr (GU_I8) { pg8::EpiSwiglu<true> E{(GAS bf16*)(ws + WS_ACT), FF, ssp, 1.0f / D, EPS, 1.0f / (H8I_SCALE * W8I_SCALE), d8_on(l, f) ? A8_SCALE : 0.f};
                        pg8::gemm_phase<pg8::EpiSwiglu<true>, pg8::StaticOrder, true, true, false, true>(lds + RING_OFF, g, S, E, tid); }
                    else { pg8::EpiSwiglu<false> E{(GAS bf16*)(ws + WS_ACT), FF, ssp, 1.0f / D, EPS, 1.0f / W8_SCALE, d8_on(l, f) ? A8_SCALE : 0.f};
                        pg8::gemm_phase<pg8::EpiSwiglu<false>, pg8::StaticOrder, true, true, true>(lds + RING_OFF, g, S, E, tid); } }
            } else {
                if constexpr (F8_MASK != 0xF) {
                    pg8::Gemm g{(const GAS bf16*)(ws + WS_XN), (const GAS bf16*)(wl + (f ? WO_GU2 : WO_GU1)), M, NGU, D};
                    pg8::EpiSwiglu<false> E{(GAS bf16*)(ws + WS_ACT), FF, ssp, 1.0f / D, EPS, 1.0f, d8_on(l, f) ? A8_SCALE : 0.f};
                    pg8::gemm_phase<pg8::EpiSwiglu<false>, pg8::StaticOrder, true, true, false>(lds + RING_OFF, g, S, E, tid); }
            } }
        GRID_BAR();
        {   PHASE_IDS(); GAS unsigned char* wl = ws + WS_W0 + (size_t)l * W_LAYER;
            pg8::StaticOrder S; S.init(M, D, G, bx);
            const unsigned sso = (unsigned)(WS_SS + (size_t)((3 * l + 2 * f + 1) & 1) * SS_BYTES), h8o = ((f == 0 && IN_I8) || (f == 1 && l + 1 < DEPTH && f8_on(l + 1, 0))) ? (unsigned)WS_HB8 : 0u;
            if ((D8_MASK == 0xF) || (D8_MASK != 0 && d8_on(l, f))) {
                if constexpr (D8_MASK != 0) {
                    pg8::Gemm g{(const GAS bf16*)(ws + WS_ACT), (const GAS bf16*)(wl + (f ? WO_D2 : WO_D1)), M, D, FF / 2};
                    pg8::EpiResid E{0.5f / (W8_SCALE * A8_SCALE), (unsigned)WS_XN, sso, h8o, GU_I8 ? H8I_SCALE : 0.f};
                    pg8::gemm_phase<pg8::EpiResid, pg8::StaticOrder, true, true, true>(lds + RING_OFF, g, S, E, tid); }
            } else {
                if constexpr (D8_MASK != 0xF) {
                    pg8::Gemm g{(const GAS bf16*)(ws + WS_ACT), (const GAS bf16*)(wl + (f ? WO_D2 : WO_D1)), M, D, FF};
                    pg8::EpiResid E{0.5f, (unsigned)WS_XN, sso, h8o, GU_I8 ? H8I_SCALE : 0.f};
                    pg8::gemm_phase<pg8::EpiResid, pg8::StaticOrder, true, true, false>(lds + RING_OFF, g, S, E, tid); }
            } }
        GRID_BAR();
        if (f == 0) {
            REPEAT(REP_IN) {   PHASE_IDS(); GAS unsigned char* wl = ws + WS_W0 + (size_t)l * W_LAYER;
                const GAS float* ssp = (const GAS float*)(ws + WS_SS + (size_t)((3 * l + 1) & 1) * SS_BYTES);
                if constexpr (IN_I8) {
                    {   pg8::Gemm g{(const GAS bf16*)(ws + WS_HB8), (const GAS bf16*)(wl + WO_IN), M, ZN8, D / 2}; pg8::StaticOrder S; S.init(M, ZN8, G, bx);
                        pg8::EpiBf16<true> E{(GAS bf16*)(ws + WS_Z), ZLD, ssp, 1.0f / D, EPS, 0.08838834764831845f / (H8I_SCALE * WQ8I_SCALE), 1.0f / (H8I_SCALE * W8I_SCALE), 0.125f / (H8I_SCALE * W8I_SCALE)};
                        pg8::gemm_phase<pg8::EpiBf16<true>, pg8::StaticOrder, true, true, false, true>(lds + RING_OFF, g, S, E, tid); }
                    {   pg8::Gemm g{(const GAS bf16*)(ws + WS_XN), (const GAS bf16*)(wl + WO_IN + (size_t)ZN8 * D), M, ZLD - ZN8, D}; pg8::StaticOrder S; S.init(M, ZLD - ZN8, G, bx);
                        pg8::EpiBf16<false> E{(GAS bf16*)(ws + WS_Z) + ZN8, ZLD, ssp, 1.0f / D, EPS, 1.0f, 1.0f, 1.0f};
                        pg8::gemm_phase<pg8::EpiBf16<false>, pg8::StaticOrder, true, true, false, false>(lds + RING_OFF, g, S, E, tid); }
                } else {
                    pg8::Gemm g{(const GAS bf16*)(ws + WS_XN), (const GAS bf16*)(wl + WO_IN), M, ZLD, D}; pg8::StaticOrder S; S.init(M, ZLD, G, bx);
                    pg8::EpiBf16<false> E{(GAS bf16*)(ws + WS_Z), ZLD, ssp, 1.0f / D, EPS, 1.0f, 1.0f, 1.0f};
                    pg8::gemm_phase<pg8::EpiBf16<false>, pg8::StaticOrder, true, true, false, false>(lds + RING_OFF, g, S, E, tid); } }
            GRID_BAR();
            REPEAT(REP_POST) {   PHASE_IDS();
                post_rows((const GAS bf16*)(ws + WS_Z), karg_in(8) + (size_t)l * RANK, karg_in(9) + (size_t)l * IDIM, karg_in(10) + (size_t)l * IDIM, (GAS bf16*)(ws + WS_CKVN), (GAS bf16*)(ws + WS_KIN), (GAS float*)(ws + WS_WIF), gw, NGW, lane);
                swa_phase(lds + RING_OFF, (const GAS bf16*)(ws + WS_Z), (GAS bf16*)(ws + WS_O), karg_in(1), karg_in(13) + (size_t)l * H_B, vcu, G, tid, lane, wave);
            }
            GRID_BAR();
            REPEAT(REP_TOPK) {   PHASE_IDS(); topk_phase(lds + RING_OFF, (const GAS bf16*)(ws + WS_Z), (const GAS bf16*)(ws + WS_KIN), (const GAS float*)(ws + WS_WIF), (GAS unsigned short*)(ws + WS_IDX), vcu, G, lane, wave); }
            GRID_BAR();
            REPEAT(REP_DSA) {   PHASE_IDS(); dsa_phase(lds, (const GAS bf16*)(ws + WS_Z), (const GAS bf16*)(ws + WS_CKVN), (const GAS unsigned short*)(ws + WS_IDX), (GAS bf16*)(ws + WS_O), karg_in(1), gw, NGW, tid, lane, wave); }
            GRID_BAR();
            {   PHASE_IDS(); GAS unsigned char* wl = ws + WS_W0 + (size_t)l * W_LAYER;
                pg8::Gemm g{(const GAS bf16*)(ws + WS_O), (const GAS bf16*)(wl + WO_OUT), M, D, OUT_F8 ? OLD / 2 : OLD}; pg8::StaticOrder S; S.init(M, D, G, bx);
                pg8::EpiResid E{OUT_F8 ? 1.0f / (W8_SCALE * O8_SCALE) : 1.0f, (unsigned)WS_XN, (unsigned)(WS_SS + (size_t)((3 * l + 2) & 1) * SS_BYTES), f8_on(l, 1) ? (unsigned)WS_HB8 : 0u, GU_I8 ? H8I_SCALE : 0.f};
                pg8::gemm_phase<pg8::EpiResid, pg8::StaticOrder, true, true, OUT_F8 != 0>(lds + RING_OFF, g, S, E, tid); }
            GRID_BAR();
        }
    }
    {   PHASE_IDS(); final_rows((const GAS bf16*)(ws + WS_XN), karg_out(), karg_in(19), (const GAS float*)(ws + WS_SS + (size_t)(6 & 1) * SS_BYTES), gw, NGW, lane); }
}

extern "C" void kernel_launch(void* const* d_in, const int* in_sizes, int n_in, void* d_out, int out_size, void* d_ws, size_t ws_size, hipStream_t stream) {
    static int grid = 0;
    if (grid == 0) {
        if (n_in != 20 || in_sizes[0] != M * D || out_size != M * D || ws_size < WS_END) { fprintf(stderr, "kernel_launch: unexpected shapes (n_in %d, in0 %d, out %d, ws %zu); nothing launched\n", n_in, n_in > 0 ? in_sizes[0] : -1, out_size, ws_size); grid = -1; return; }
        int dev = 0, cus = 0, per_cu = 0;
        if (hipGetDevice(&dev) != hipSuccess || hipDeviceGetAttribute(&cus, hipDeviceAttributeMultiprocessorCount, dev) != hipSuccess) { grid = -1; return; }
        if (hipFuncSetAttribute((const void*)mk_fwd, hipFuncAttributeMaxDynamicSharedMemorySize, LDS_BYTES) != hipSuccess) { fprintf(stderr, "kernel_launch: hipFuncSetAttribute failed\n"); grid = -1; return; }
        if (hipOccupancyMaxActiveBlocksPerMultiprocessor(&per_cu, (const void*)mk_fwd, NWAVES * 64, LDS_BYTES) != hipSuccess || per_cu < 1) { fprintf(stderr, "kernel_launch: occupancy query reports %d workgroups per CU\n", per_cu); }
        (void)hipGetLastError();
        grid = cus;
    }
    if (grid < 0) return;
    if (hipMemsetAsync((char*)d_ws + WS_CTL, 0, CTL_ZERO_BYTES, stream) != hipSuccess) return;
    Args a{};
    for (int i = 0; i < 20; ++i) a.in[i] = (const float*)d_in[i];
    a.out = (float*)d_out; a.ws = (unsigned char*)d_ws;
    hipLaunchKernelGGL(mk_fwd, dim3(grid), dim3(NWAVES * 64), LDS_BYTES, stream, a);
}
```

```cpp
#include <hip/hip_runtime.h>
#include <cstdio>
#include <cstdint>
namespace pg8 {
#define PG8_LAS __attribute__((address_space(3)))
#define PG8_GAS __attribute__((address_space(1)))
typedef unsigned short bf16_t;
typedef short bf16x8 __attribute__((ext_vector_type(8)));
typedef float f32x4 __attribute__((ext_vector_type(4)));
typedef unsigned u32x4 __attribute__((ext_vector_type(4)));
constexpr int BM = 256, BK = 64, HALF = 128, HTB = HALF * BK * 2  , STAGE_BYTES = 8 * HTB, NXCD = 8, WGM = 4;

__host__ __device__ __forceinline__ int lds_byte(int r, int c) { const int st = (r >> 4) * 2 + (c >> 5), rr = r & 15, cc = c & 31, ob = rr * 64 + cc * 2; return st * 1024 + (ob ^ (((ob >> 9) & 1) << 5)); }
__host__ __device__ __forceinline__ void stage_rc(int b, int& R, int& C) { const int st = b / 1024, sb = b % 1024, swz = sb ^ (((sb >> 9) & 1) << 5); R = (st >> 1) * 16 + swz / 64; C = (st & 1) * 32 + (swz % 64) / 2; }
__host__ __device__ __forceinline__ int perm32(int rho) { const int n = rho >> 4, i = rho & 15; return 8 * (i >> 2) + 4 * n + (i & 3); }

typedef int i32x8 __attribute__((ext_vector_type(8))); typedef int i32x4v __attribute__((ext_vector_type(4)));
__device__ __forceinline__ i32x8 cat8(bf16x8 a, bf16x8 b) { return __builtin_shufflevector(__builtin_bit_cast(i32x4v, a), __builtin_bit_cast(i32x4v, b), 0, 1, 2, 3, 4, 5, 6, 7); }
struct Unit { int pm, pn; };
struct Gemm { const PG8_GAS bf16_t* A; const PG8_GAS bf16_t* Bt; int M, N, K; };

struct StaticOrder {
    int nM, nN, nwg, G, c;
    __host__ __device__ void init(int M, int N, int G_, int c_) { nM = M / BM; nN = N / BM; nwg = nM * nN; G = G_; c = c_; }
    __host__ __device__ bool next(int i, Unit& u) const {
        const long L = (long)i * G + c; if (L >= nwg) return false;
        int wgid = (int)L; { const int q = nwg / NXCD, r = nwg % NXCD, xcd = wgid % NXCD, off = wgid / NXCD; wgid = (xcd < r ? xcd * (q + 1) : r * (q + 1) + (xcd - r) * q) + off; }
        const int nig = WGM * nN, gid = wgid / nig, fm = gid * WGM, gsz = (nM - fm) < WGM ? (nM - fm) : WGM;
        u.pm = fm + ((wgid % nig) % gsz); u.pn = (wgid % nig) / gsz; return true;
    }
    __device__ __forceinline__ void a_ready(const Unit&) const {}
    __device__ __forceinline__ void done(const Unit&) const {}
};
__device__ __forceinline__ unsigned long long karg64(int idx) { unsigned long long r; const unsigned off = (unsigned)idx * 8u;
    asm volatile("s_load_dwordx2 %0, %1, %2\n\ts_waitcnt lgkmcnt(0)" : "=s"(r) : "s"(__builtin_amdgcn_kernarg_segment_ptr()), "s"(off) : "memory"); return r; }
__device__ __forceinline__ unsigned cvt_pk_bf16(float lo, float hi) { unsigned r; asm volatile("v_cvt_pk_bf16_f32 %0, %1, %2" : "=v"(r) : "v"(lo), "v"(hi)); return r; }
typedef float f32x2 __attribute__((ext_vector_type(2)));
__device__ __forceinline__ unsigned pack4_i8(float a, float b, float c, float d, float S) {
    const int qa = (int)__builtin_rintf(__builtin_fminf(__builtin_fmaxf(a * S, -127.f), 127.f)), qb = (int)__builtin_rintf(__builtin_fminf(__builtin_fmaxf(b * S, -127.f), 127.f));
    const int qc = (int)__builtin_rintf(__builtin_fminf(__builtin_fmaxf(c * S, -127.f), 127.f)), qd = (int)__builtin_rintf(__builtin_fminf(__builtin_fmaxf(d * S, -127.f), 127.f));
    return ((unsigned)qa & 0xffu) | (((unsigned)qb & 0xffu) << 8) | (((unsigned)qc & 0xffu) << 16) | ((unsigned)qd << 24);
}
__device__ __forceinline__ float silu_f(float g) { return g * __builtin_amdgcn_rcpf(1.0f + __builtin_amdgcn_exp2f(-1.4426950408889634f * g)); }

template <bool ACC_I32 = false>
struct EpiSwiglu {
    static constexpr bool PERM = true, AFTER_DRAIN = false;
    static __device__ __forceinline__ f32x4 cv(const f32x4& a) { if constexpr (ACC_I32) { typedef int i32x4e __attribute__((ext_vector_type(4))); const i32x4e q = __builtin_bit_cast(i32x4e, a); return (f32x4){(float)q[0], (float)q[1], (float)q[2], (float)q[3]}; } else return a; }
    PG8_GAS bf16_t* O; int ldc; const PG8_GAS float* ss; float inv_k, eps, post; float out8;
    __device__ __forceinline__ void operator()(const f32x4 (&acc)[2][2][4][2], const Unit& u, int wr, int wc, int fr, int fq) const {
        const int row0 = u.pm * BM + wr * 64 + fr, col0 = u.pn * HALF + wc * 32 + 8 * fq;
        float rs[8]; const int lane_ = fr + 16 * fq;
#pragma unroll
        for (int k = 0; k < 8; ++k) { const PG8_GAS f32x4* p4 = (const PG8_GAS f32x4*)(ss + (size_t)(row0 + (k >> 2) * HALF + (k & 3) * 16) * 32 + 8 * fq); const f32x4 a = p4[0], b = p4[1];
            float t = ((a[0] + a[1]) + (a[2] + a[3])) + ((b[0] + b[1]) + (b[2] + b[3]));
            t += __builtin_bit_cast(float, __builtin_amdgcn_ds_bpermute((lane_ ^ 16) << 2, __builtin_bit_cast(int, t)));
            t += __builtin_bit_cast(float, __builtin_amdgcn_ds_bpermute((lane_ ^ 32) << 2, __builtin_bit_cast(int, t))); rs[k] = t; }
        unsigned pk[8][2];
#pragma unroll
        for (int ai = 0; ai < 2; ++ai)
#pragma unroll
            for (int m = 0; m < 4; ++m) { PG8_GAS bf16_t* rowp = O + (size_t)(row0 + ai * HALF + m * 16) * ldc + col0;
                const float r = __builtin_amdgcn_rsqf(rs[ai * 4 + m] * inv_k + eps) * post;
                const f32x2 r2 = {r, r}, c2 = {-1.4426950408889634f * r, -1.4426950408889634f * r}; const float rs8 = out8 != 0.f ? r * out8 : r; const f32x2 q2 = {rs8, rs8}, one2 = {1.0f, 1.0f};
                f32x2 o[4];
#pragma unroll
                for (int h = 0; h < 4; ++h) { const f32x4 gq = cv(acc[ai][0][m][h >> 1]), uq = cv(acc[ai][1][m][h >> 1]);
                    const f32x2 gv = {gq[2 * (h & 1)], gq[2 * (h & 1) + 1]}, uv = {uq[2 * (h & 1)], uq[2 * (h & 1) + 1]};
                    const f32x2 t = gv * c2; f32x2 e; e.x = __builtin_amdgcn_exp2f(t.x); e.y = __builtin_amdgcn_exp2f(t.y);
                    const f32x2 d = e + one2; f32x2 rc; rc.x = __builtin_amdgcn_rcpf(d.x); rc.y = __builtin_amdgcn_rcpf(d.y);
                    o[h] = ((gv * r2) * rc) * (uv * q2); }
                if (out8 != 0.f) { int p = 0, q = 0;
                    p = __builtin_amdgcn_cvt_pk_fp8_f32(o[0].x, o[0].y, p, false); p = __builtin_amdgcn_cvt_pk_fp8_f32(o[1].x, o[1].y, p, true);
                    q = __builtin_amdgcn_cvt_pk_fp8_f32(o[2].x, o[2].y, q, false); q = __builtin_amdgcn_cvt_pk_fp8_f32(o[3].x, o[3].y, q, true);
                    pk[ai * 4 + m][0] = (unsigned)p; pk[ai * 4 + m][1] = (unsigned)q; }
                else { u32x4 w; w.x = cvt_pk_bf16(o[0].x, o[0].y); w.y = cvt_pk_bf16(o[1].x, o[1].y); w.z = cvt_pk_bf16(o[2].x, o[2].y); w.w = cvt_pk_bf16(o[3].x, o[3].y);
                    *(PG8_GAS u32x4*)rowp = w; } }
        if (out8 != 0.f) {
#pragma unroll
            for (int k = 0; k < 8; k += 2) {
                typedef unsigned u2v __attribute__((ext_vector_type(2)));
                const u2v sp = __builtin_amdgcn_permlane16_swap(pk[k][0], pk[k + 1][0], false, false), sq = __builtin_amdgcn_permlane16_swap(pk[k][1], pk[k + 1][1], false, false);
                const int kk = k + (fq & 1); const int rowk = row0 + (kk >> 2) * HALF + (kk & 3) * 16;
                u32x4 w; w.x = sp.x; w.y = sq.x; w.z = sp.y; w.w = sq.y;
                *(PG8_GAS u32x4*)((PG8_GAS unsigned char*)O + (size_t)rowk * ldc + (col0 - 8 * (fq & 1))) = w; } }
    }
};
struct EpiResid {
    static constexpr bool PERM = true, AFTER_DRAIN = false;
    float alpha; unsigned hb_off; unsigned ss_off; unsigned h8_off; float h8_i8;
    __device__ __forceinline__ void operator()(const f32x4 (&acc)[2][2][4][2], const Unit& u, int wr, int wc, int fr, int fq) const {
        constexpr int ldc = 2048;
        PG8_GAS unsigned char* wsb = (PG8_GAS unsigned char*)karg64(21); PG8_GAS bf16_t* hb = (PG8_GAS bf16_t*)(wsb + hb_off); PG8_GAS float* ss = (PG8_GAS float*)(wsb + ss_off);
        const int row0 = u.pm * BM + wr * 64 + fr, col0 = u.pn * BM + wc * 32 + 8 * fq; const int lane = fr + 16 * fq;
        u32x4 cur[2], nxt[2];
        { const size_t off = (size_t)row0 * ldc + col0; cur[0] = *(const PG8_GAS u32x4*)(hb + off); cur[1] = *(const PG8_GAS u32x4*)(hb + off + HALF); }
#pragma unroll
        for (int k = 0; k < 8; ++k) { const int ai = k >> 2, m = k & 3; const int row = row0 + ai * HALF + m * 16; const size_t off = (size_t)row * ldc + col0;
            if (k < 7) { const int ai2 = (k + 1) >> 2, m2 = (k + 1) & 3; const size_t off2 = (size_t)(row0 + ai2 * HALF + m2 * 16) * ldc + col0;
                nxt[0] = *(const PG8_GAS u32x4*)(hb + off2); nxt[1] = *(const PG8_GAS u32x4*)(hb + off2 + HALF); }
            float sq = 0.f;
#pragma unroll
            for (int bj = 0; bj < 2; ++bj) { const u32x4 b = cur[bj]; const f32x4 a0 = acc[ai][bj][m][0], a1 = acc[ai][bj][m][1]; u32x4 w;
                w.x = cvt_pk_bf16(__builtin_bit_cast(float, b.x << 16) + a0[0] * alpha, __builtin_bit_cast(float, b.x & 0xffff0000u) + a0[1] * alpha);
                w.y = cvt_pk_bf16(__builtin_bit_cast(float, b.y << 16) + a0[2] * alpha, __builtin_bit_cast(float, b.y & 0xffff0000u) + a0[3] * alpha);
                w.z = cvt_pk_bf16(__builtin_bit_cast(float, b.z << 16) + a1[0] * alpha, __builtin_bit_cast(float, b.z & 0xffff0000u) + a1[1] * alpha);
                w.w = cvt_pk_bf16(__builtin_bit_cast(float, b.w << 16) + a1[2] * alpha, __builtin_bit_cast(float, b.w & 0xffff0000u) + a1[3] * alpha);
                *(PG8_GAS u32x4*)(hb + off + bj * HALF) = w;
                if (h8_off) { typedef unsigned u32x2v __attribute__((ext_vector_type(2))); u32x2v q8; int p = 0;
                    const float e0 = __builtin_bit_cast(float, w.x << 16), e1 = __builtin_bit_cast(float, w.x & 0xffff0000u), e2 = __builtin_bit_cast(float, w.y << 16), e3 = __builtin_bit_cast(float, w.y & 0xffff0000u);
                    const float e4 = __builtin_bit_cast(float, w.z << 16), e5 = __builtin_bit_cast(float, w.z & 0xffff0000u), e6 = __builtin_bit_cast(float, w.w << 16), e7 = __builtin_bit_cast(float, w.w & 0xffff0000u);
                    if (h8_i8 != 0.f) { q8.x = pack4_i8(e0, e1, e2, e3, h8_i8); q8.y = pack4_i8(e4, e5, e6, e7, h8_i8); }
                    else { p = __builtin_amdgcn_cvt_pk_fp8_f32(e0, e1, p, false); p = __builtin_amdgcn_cvt_pk_fp8_f32(e2, e3, p, true); q8.x = (unsigned)p; p = 0;
                        p = __builtin_amdgcn_cvt_pk_fp8_f32(e4, e5, p, false); p = __builtin_amdgcn_cvt_pk_fp8_f32(e6, e7, p, true); q8.y = (unsigned)p; }
                    *(PG8_GAS u32x2v*)(wsb + h8_off + off + bj * HALF) = q8; }
#pragma unroll
                for (int e = 0; e < 4; ++e) { const float lo = __builtin_bit_cast(float, w[e] << 16), hi = __builtin_bit_cast(float, w[e] & 0xffff0000u); sq = fmaf(lo, lo, sq); sq = fmaf(hi, hi, sq); } }
            sq += __builtin_bit_cast(float, __builtin_amdgcn_ds_bpermute((lane ^ 16) << 2, __builtin_bit_cast(int, sq)));
            sq += __builtin_bit_cast(float, __builtin_amdgcn_ds_bpermute((lane ^ 32) << 2, __builtin_bit_cast(int, sq)));
            if (fq == 0) ss[(size_t)row * 32 + u.pn * 4 + wc] = sq;
            cur[0] = nxt[0]; cur[1] = nxt[1]; }
    }
};
template <bool ACC_I32 = false>
struct EpiBf16 {
    static constexpr bool PERM = true, AFTER_DRAIN = false;
    static __device__ __forceinline__ f32x4 cv(const f32x4& a) { if constexpr (ACC_I32) { typedef int i32x4e __attribute__((ext_vector_type(4))); const i32x4e q = __builtin_bit_cast(i32x4e, a); return (f32x4){(float)q[0], (float)q[1], (float)q[2], (float)q[3]}; } else return a; }
    PG8_GAS bf16_t* O; int ldc; const PG8_GAS float* ss; float inv_k, eps; float post_a, post_b, post_c;
    __device__ __forceinline__ void operator()(const f32x4 (&acc)[2][2][4][2], const Unit& u, int wr, int wc, int fr, int fq) const {
        const int row0 = u.pm * BM + wr * 64 + fr, col0 = u.pn * BM + wc * 32 + 8 * fq;
        const float pfac = fmaf(u.pn < 8 ? 1.0f : 0.0f, post_a - post_b, fmaf((u.pn >= 9 && u.pn < 13) ? 1.0f : 0.0f, post_c - post_b, post_b));
        float rs[8]; const int lane_ = fr + 16 * fq;
#pragma unroll
        for (int k = 0; k < 8; ++k) { const PG8_GAS f32x4* p4 = (const PG8_GAS f32x4*)(ss + (size_t)(row0 + (k >> 2) * HALF + (k & 3) * 16) * 32 + 8 * fq); const f32x4 a = p4[0], b = p4[1];
            float t = ((a[0] + a[1]) + (a[2] + a[3])) + ((b[0] + b[1]) + (b[2] + b[3]));
            t += __builtin_bit_cast(float, __builtin_amdgcn_ds_bpermute((lane_ ^ 16) << 2, __builtin_bit_cast(int, t)));
            t += __builtin_bit_cast(float, __builtin_amdgcn_ds_bpermute((lane_ ^ 32) << 2, __builtin_bit_cast(int, t))); rs[k] = t; }
#pragma unroll
        for (int ai = 0; ai < 2; ++ai)
#pragma unroll
            for (int m = 0; m < 4; ++m) { PG8_GAS bf16_t* rowp = O + (size_t)(row0 + ai * HALF + m * 16) * ldc + col0;
                const float r = __builtin_amdgcn_rsqf(rs[ai * 4 + m] * inv_k + eps) * pfac;
#pragma unroll
                for (int bj = 0; bj < 2; ++bj) { const f32x4 v0 = cv(acc[ai][bj][m][0]) * r, v1 = cv(acc[ai][bj][m][1]) * r;
                    u32x4 w; w.x = cvt_pk_bf16(v0[0], v0[1]); w.y = cvt_pk_bf16(v0[2], v0[3]); w.z = cvt_pk_bf16(v1[0], v1[1]); w.w = cvt_pk_bf16(v1[2], v1[3]);
                    *(PG8_GAS u32x4*)(rowp + bj * HALF) = w; } }
    }
};
template <class Epi, class Sched, bool ALIGN_EPI = false, bool SP2 = false, bool F8 = false, bool I8 = false>
__device__ __forceinline__ void gemm_phase(PG8_LAS unsigned char* lds, const Gemm g, const Sched& S, const Epi& E, int tid_in  ) {
    int tid_ = tid_in; asm volatile("" : "+v"(tid_));
    const int tid = tid_, wid = __builtin_amdgcn_readfirstlane(tid >> 6), lane = tid & 63, wr = wid >> 2, wc = wid & 3, fr = lane & 15, fq = lane >> 4;
    const int K = g.K, nt = K / BK;
    unsigned voffA[2], voffB[2];
#pragma unroll
    for (int i = 0; i < 2; ++i) { int R, C; stage_rc(tid * 16 + i * 8192, R, C); const int Rb = Epi::PERM ? ((R & ~31) + perm32(R & 31)) : R;
        voffA[i] = (unsigned)(R * K + C) * 2u; voffB[i] = (unsigned)(Rb * K + C) * 2u; }
    const size_t kstep = (size_t)(BK * 2);
    const size_t hstep = (size_t)HALF * K * 2;
    const size_t tstep = 2 * hstep;
    const unsigned ldsw = (unsigned)wid * 1024u;
    const int aoff = lds_byte(wr * 64 + fr, fq * 8), boff = lds_byte(wc * 32 + fr, fq * 8);
#define PG8_SA(b, h) (((b) * 2 + (h)) * HTB)
#define PG8_SB(b, h) ((4 + (b) * 2 + (h)) * HTB)
#define PG8_STAGE(bufoff, gbase, voff) do { _Pragma("unroll") for (int _i = 0; _i < 2; ++_i) \
        __builtin_amdgcn_global_load_lds((const PG8_GAS unsigned*)((const PG8_GAS char*)(gbase) + (voff)[_i]), (PG8_LAS unsigned*)(lds + (bufoff) + ldsw + _i * 8192), 16, 0, 0); } while (0)
#define PG8_LDA(dst, b, h) do { _Pragma("unroll") for (int m = 0; m < 4; ++m) _Pragma("unroll") for (int k = 0; k < 2; ++k) dst[m][k] = *(const PG8_LAS bf16x8*)(lds + PG8_SA(b, h) + aoff + m * 2048 + k * 1024); } while (0)
#define PG8_LDB(dst, b, h) do { _Pragma("unroll") for (int n = 0; n < 2; ++n) _Pragma("unroll") for (int k = 0; k < 2; ++k) dst[n][k] = *(const PG8_LAS bf16x8*)(lds + PG8_SB(b, h) + boff + n * 2048 + k * 1024); } while (0)
#define PG8_MMA(ai, bj, At, Bt) do { __builtin_amdgcn_s_setprio(1); _Pragma("unroll") for (int m = 0; m < 4; ++m) _Pragma("unroll") for (int n = 0; n < 2; ++n) { \
        if constexpr (F8) { asm volatile("v_mfma_f32_16x16x128_f8f6f4 %0, %1, %2, %0" : "+v"(acc[ai][bj][m][n]) : "v"(cat8(Bt[n][0], Bt[n][1])), "v"(cat8(At[m][0], At[m][1]))); } \
        else if constexpr (I8) { _Pragma("unroll") for (int k = 0; k < 2; ++k) asm volatile("v_mfma_i32_16x16x64_i8 %0, %1, %2, %0" : "+v"(acc[ai][bj][m][n]) : "v"(Bt[n][k]), "v"(At[m][k])); } \
        else { _Pragma("unroll") for (int k = 0; k < 2; ++k) acc[ai][bj][m][n] = __builtin_amdgcn_mfma_f32_16x16x32_bf16(Bt[n][k], At[m][k], acc[ai][bj][m][n], 0, 0, 0); } } \
        __builtin_amdgcn_s_setprio(0); } while (0)
#define PG8_WAIT_V(n) asm volatile("s_waitcnt vmcnt(" #n ")" ::: "memory")
#define PG8_WAIT_L(n) asm volatile("s_waitcnt lgkmcnt(" #n ")" ::: "memory")
#define PG8_BAR __builtin_amdgcn_s_barrier()
#define PG8_SCHED __builtin_amdgcn_sched_barrier(0)
    Unit cur, nxt; int ui = 0;
    if (!S.next(0, cur)) return;
    f32x4 acc[2][2][4][2];
#pragma unroll
    for (int a = 0; a < 2; ++a)
#pragma unroll
        for (int b = 0; b < 2; ++b)
#pragma unroll
            for (int m = 0; m < 4; ++m)
#pragma unroll
                for (int n = 0; n < 2; ++n) acc[a][b][m][n] = (f32x4){0.f, 0.f, 0.f, 0.f};
    bf16x8 At[4][2], B0[2][2], B1[2][2];
    const PG8_GAS char* cA = (const PG8_GAS char*)g.A + (size_t)cur.pm * tstep; const PG8_GAS char* cB = (const PG8_GAS char*)g.Bt + (size_t)cur.pn * tstep;
    S.a_ready(cur);
    if constexpr (SP2) {
        PG8_STAGE(PG8_SB(0, 0), cB, voffB); PG8_STAGE(PG8_SB(0, 1), cB + hstep, voffB); PG8_STAGE(PG8_SA(0, 0), cA, voffA); PG8_STAGE(PG8_SA(0, 1), cA + hstep, voffA);
        if (wr == 1) PG8_BAR;
        PG8_WAIT_V(2); PG8_BAR;
        PG8_STAGE(PG8_SB(1, 0), cB + kstep, voffB); PG8_STAGE(PG8_SA(1, 0), cA + kstep, voffA); PG8_STAGE(PG8_SB(1, 1), cB + hstep + kstep, voffB);
        PG8_WAIT_V(6); PG8_BAR;
    } else {
        PG8_STAGE(PG8_SB(0, 0), cB, voffB); PG8_STAGE(PG8_SA(0, 0), cA, voffA); PG8_STAGE(PG8_SB(0, 1), cB + hstep, voffB); PG8_STAGE(PG8_SA(0, 1), cA + hstep, voffA);
        if (wr == 1) PG8_BAR;
        PG8_WAIT_V(4); PG8_BAR;
        PG8_STAGE(PG8_SB(1, 0), cB + kstep, voffB); PG8_STAGE(PG8_SA(1, 0), cA + kstep, voffA); PG8_STAGE(PG8_SB(1, 1), cB + hstep + kstep, voffB);
        PG8_WAIT_V(6); PG8_BAR;
    }
    for (;;) {
        const bool has_next = S.next(ui + 1, nxt);
        const PG8_GAS char* nA = has_next ? (const PG8_GAS char*)g.A + (size_t)nxt.pm * tstep : cA; const PG8_GAS char* nB = has_next ? (const PG8_GAS char*)g.Bt + (size_t)nxt.pn * tstep : cB;
        for (int t = 0; t < nt; t += 2) {
            const bool last = (t == nt - 2);
            const PG8_GAS char* a1 = cA + (size_t)(t + 1) * kstep;
            const PG8_GAS char* a2 = last ? nA : cA + (size_t)(t + 2) * kstep; const PG8_GAS char* b2 = last ? nB : cB + (size_t)(t + 2) * kstep;
            const PG8_GAS char* a3 = a2 + kstep; const PG8_GAS char* b3 = b2 + kstep;
            if (last && has_next) S.a_ready(nxt);
            if constexpr (SP2) {
            PG8_LDB(B0, 0, 0); PG8_LDB(B1, 0, 1); PG8_SCHED; PG8_LDA(At, 0, 0); PG8_STAGE(PG8_SA(1, 1), a1 + hstep, voffA);
            PG8_WAIT_V(8); PG8_WAIT_L(0); PG8_BAR; PG8_MMA(0, 0, At, B0); PG8_MMA(0, 1, At, B1); PG8_BAR; PG8_SCHED;
            PG8_LDA(At, 0, 1); PG8_STAGE(PG8_SB(0, 0), b2, voffB); PG8_STAGE(PG8_SB(0, 1), b2 + hstep, voffB); PG8_STAGE(PG8_SA(0, 0), a2, voffA);
            PG8_WAIT_V(8); PG8_WAIT_L(0); PG8_BAR; PG8_MMA(1, 0, At, B0); PG8_MMA(1, 1, At, B1); PG8_BAR; PG8_SCHED;
            PG8_LDB(B0, 1, 0); PG8_LDB(B1, 1, 1); PG8_SCHED; PG8_LDA(At, 1, 0); PG8_STAGE(PG8_SA(0, 1), a2 + hstep, voffA);
            PG8_WAIT_V(8); PG8_WAIT_L(0); PG8_BAR; PG8_MMA(0, 0, At, B0); PG8_MMA(0, 1, At, B1); PG8_BAR; PG8_SCHED;
            PG8_LDA(At, 1, 1); PG8_STAGE(PG8_SB(1, 0), b3, voffB); PG8_STAGE(PG8_SB(1, 1), b3 + hstep, voffB); PG8_STAGE(PG8_SA(1, 0), a3, voffA);
            PG8_WAIT_V(8); PG8_WAIT_L(0); PG8_BAR; PG8_MMA(1, 0, At, B0); PG8_MMA(1, 1, At, B1); PG8_BAR; PG8_SCHED;
            } else {
            PG8_LDB(B0, 0, 0); PG8_SCHED; PG8_LDA(At, 0, 0); PG8_STAGE(PG8_SA(1, 1), a1 + hstep, voffA);
            PG8_WAIT_L(8); PG8_BAR; PG8_WAIT_L(0); PG8_MMA(0, 0, At, B0); PG8_BAR; PG8_SCHED;
            PG8_LDB(B1, 0, 1); PG8_STAGE(PG8_SB(0, 0), b2, voffB);
            PG8_BAR; PG8_WAIT_L(0); PG8_MMA(0, 1, At, B1); PG8_BAR;
            PG8_LDA(At, 0, 1); PG8_STAGE(PG8_SA(0, 0), a2, voffA);
            PG8_BAR; PG8_WAIT_L(0); PG8_MMA(1, 0, At, B0); PG8_BAR; PG8_SCHED;
            PG8_STAGE(PG8_SB(0, 1), b2 + hstep, voffB);
            PG8_WAIT_V(6); PG8_BAR; PG8_MMA(1, 1, At, B1); PG8_BAR;
            PG8_LDB(B0, 1, 0); PG8_SCHED; PG8_LDA(At, 1, 0); PG8_STAGE(PG8_SA(0, 1), a2 + hstep, voffA);
            PG8_WAIT_L(8); PG8_BAR; PG8_WAIT_L(0); PG8_MMA(0, 0, At, B0); PG8_BAR; PG8_SCHED;
            PG8_LDB(B1, 1, 1); PG8_STAGE(PG8_SB(1, 0), b3, voffB);
            PG8_BAR; PG8_WAIT_L(0); PG8_MMA(0, 1, At, B1); PG8_BAR;
            PG8_LDA(At, 1, 1); PG8_STAGE(PG8_SA(1, 0), a3, voffA);
            PG8_BAR; PG8_WAIT_L(0); PG8_MMA(1, 0, At, B0); PG8_BAR; PG8_SCHED;
            PG8_STAGE(PG8_SB(1, 1), b3 + hstep, voffB);
            PG8_WAIT_V(6); PG8_BAR; PG8_MMA(1, 1, At, B1); PG8_BAR;
            }
        }
        if constexpr (ALIGN_EPI) { if (wr == 0) PG8_BAR; }
        if constexpr (!Epi::AFTER_DRAIN) { int ln_; asm volatile("v_mbcnt_lo_u32_b32 %0, -1, 0\n\tv_mbcnt_hi_u32_b32 %0, -1, %0" : "=v"(ln_));
            E(acc, cur, wr, wc, ln_ & 15, ln_ >> 4); S.done(cur); }
        if (!has_next) break;
#pragma unroll
        for (int a = 0; a < 2; ++a)
#pragma unroll
            for (int b = 0; b < 2; ++b)
#pragma unroll
                for (int m = 0; m < 4; ++m)
#pragma unroll
                    for (int n = 0; n < 2; ++n) acc[a][b][m][n] = (f32x4){0.f, 0.f, 0.f, 0.f};
        cur = nxt; cA = nA; cB = nB; ++ui;
        if constexpr (ALIGN_EPI) { if (wr == 1) PG8_BAR; }
    }
    PG8_WAIT_V(0);
    if constexpr (!ALIGN_EPI) { if (wr == 0) PG8_BAR; }
    PG8_BAR;
    if constexpr (Epi::AFTER_DRAIN) { E.fused(acc, cur, wr, wc, fr, fq, lds, wid, lane); S.done(cur); }
#undef PG8_SA
#undef PG8_SB
#undef PG8_STAGE
#undef PG8_LDA
#undef PG8_LDB
#undef PG8_MMA
#undef PG8_WAIT_V
#undef PG8_WAIT_L
#undef PG8_BAR
#undef PG8_SCHED
}
}
constexpr int NWAVES = 8;
constexpr int BATCH = 8, SEQ = 4096, D = 2048, FF = 5632, DEPTH = 2;
constexpr int M = BATCH * SEQ;
constexpr int NGU = 2 * FF;
constexpr int H_A = 8, HD_A = 128, RANK = 256, IH = 8, IDIM = 64, TOPK = 256;
constexpr int H_B = 16, KVH = 2, GQA = 8, HD_B = 64, WINDOW = 128;
constexpr int D_IN = 3144;
constexpr float EPS = 1e-6f;
constexpr size_t MiB = 1u << 20;
constexpr size_t WS_CTL = 0, CTL_ZERO_BYTES = 1 * MiB;
#ifndef F8_MASK
#define F8_MASK 0xF
#endif
constexpr float W8_SCALE = 64.0f;
#ifndef GU_I8
#define GU_I8 1
#endif
constexpr float H8I_SCALE = 127.0f / 4.6f, W8I_SCALE = 127.0f / (4.2f * 0.022097086912079608f);
#ifndef D8_MASK
#define D8_MASK 0xF
#endif
constexpr float A8_SCALE = 8.0f;
__host__ __device__ constexpr bool d8_on(int l, int f) { return ((D8_MASK >> (2 * l + f)) & 1) != 0; }
constexpr float O8_SCALE = 16.0f;
#ifndef OUT_F8
#define OUT_F8 1
#endif
constexpr bool F8_ALL1 = (F8_MASK & 0x5) == 0x5, F8_ALL2 = (F8_MASK & 0xA) == 0xA;
__host__ __device__ constexpr bool f8_on(int l, int f) { return ((F8_MASK >> (2 * l + f)) & 1) != 0; }
constexpr size_t GU1_B = (F8_ALL1 ? 22 : 44) * MiB, GU2_B = (F8_ALL2 ? 22 : 44) * MiB;
constexpr size_t WS_W0 = 2 * MiB;
constexpr size_t WO_GU1 = 0, WO_D1 = GU1_B, WO_GU2 = WO_D1 + 22 * MiB, WO_D2 = WO_GU2 + GU2_B, WO_IN = WO_D2 + 22 * MiB, WO_OUT = WO_IN + 17 * MiB, W_LAYER = WO_OUT + 12 * MiB;
constexpr size_t WS_XN = WS_W0 + 2 * W_LAYER;
constexpr size_t WS_HB8 = WS_XN + 128 * MiB;
constexpr size_t WS_ACT = WS_HB8 + (F8_MASK ? 64 : 0) * MiB;
constexpr size_t WS_Z = WS_ACT, WS_CKVN = WS_ACT + 272 * MiB, WS_KIN = WS_ACT + 288 * MiB, WS_WIF = WS_ACT + 292 * MiB, WS_IDX = WS_ACT + 294 * MiB;
constexpr int ZLD = 4352, ZC_QLAT = 0, ZC_CKV = 2048, ZC_QB = 2304, ZC_KB = 3328, ZC_VB = 3456, ZC_QI = 3584, ZC_KI = 4096, ZC_WI = 4160;
constexpr int ZN8 = 3584;
#ifndef IN_I8
#define IN_I8 1
#endif
constexpr float WQ8I_SCALE = 127.0f / (4.2f * 0.015625f);
constexpr int OLD = 3072;
constexpr size_t WS_O = WS_ACT + 352 * MiB;
constexpr size_t WS_SS = WS_O + 192 * MiB, SS_BYTES = 4 * MiB;
constexpr size_t WS_END = WS_SS + 2 * SS_BYTES;
static_assert(WS_END <= 1024 * MiB, "d_ws map exceeds 1 GiB");
constexpr int CW_TMO = 0, CW_CODE = 1, CW_BAR = 4096, CW_XRANK = 8192;
constexpr int RING_OFF = 0, RING_BYTES = 131072;
constexpr int LDSCTL_OFF = RING_BYTES, MISC_OFF = LDSCTL_OFF + 320;
constexpr int LDS_BYTES = 147456;
constexpr int RSL_OFF = RING_BYTES + 5632;
#define GAS __attribute__((address_space(1)))
#define LAS __attribute__((address_space(3)))
typedef unsigned short bf16;
typedef unsigned v4u __attribute__((ext_vector_type(4)));
typedef float f32x4 __attribute__((ext_vector_type(4)));
typedef short bf16x8 __attribute__((ext_vector_type(8)));
typedef GAS unsigned gu32;
typedef GAS unsigned long long gu64;
#define RLX_AGENT __ATOMIC_RELAXED, __HIP_MEMORY_SCOPE_AGENT
#define LDS_WAIT() asm volatile("s_waitcnt lgkmcnt(0)" ::: "memory")
#define VM_WAIT() asm volatile("s_waitcnt vmcnt(0)" ::: "memory")
__device__ __forceinline__ unsigned long long rt() { return __builtin_amdgcn_s_memrealtime(); }
__device__ __forceinline__ unsigned f2bf(float f) { unsigned u = __builtin_bit_cast(unsigned, f); return (u + 0x7fffu + ((u >> 16) & 1u)) >> 16; }
__device__ __forceinline__ unsigned pk2(float lo, float hi) { return f2bf(lo) | (f2bf(hi) << 16); }

#define XB_TMO      128
#define XB_XCNT(j)  (256  + 64 * (j))
#define XB_XSUB(j)  (1280 + 64 * (j))
#define XB_XGEN(j)  (2304 + 64 * (j))
#define XB_TOP      3328
#define XB_TOPGEN   3392
#define XCD_BAR_WORDS 3456
#define XB_SPIN_CAP (1u << 18)

__device__ __forceinline__ unsigned xb_ld(unsigned* p)              { return __hip_atomic_load(p, __ATOMIC_RELAXED, __HIP_MEMORY_SCOPE_AGENT); }
__device__ __forceinline__ unsigned xb_add(unsigned* p, unsigned v) { return __hip_atomic_fetch_add(p, v, __ATOMIC_RELAXED, __HIP_MEMORY_SCOPE_AGENT); }
__device__ __forceinline__ unsigned xb_xcc_id() { return (unsigned)__builtin_amdgcn_s_getreg((3 << 11) | 20) & 0xFu; }
#define XB_SPIN(cond, bar) do { unsigned _sp = 0; while (cond) { __builtin_amdgcn_s_sleep(1); \
    if ((++_sp & 255u) == 0u) { if (xb_ld(&(bar)[XB_TMO])) break; if (_sp > XB_SPIN_CAP) { atomicAdd(&(bar)[XB_TMO], 1u); break; } } } } while (0)

struct XcdBarrier {
    unsigned* bar; unsigned x;
    volatile LAS unsigned* st;
};

__device__ __forceinline__ XcdBarrier xcd_barrier_post(unsigned* bar, volatile LAS unsigned* st, bool leader  ) {
    XcdBarrier b; b.bar = bar; b.x = xb_xcc_id(); b.st = st;
    if (leader) (void)xb_add(&bar[XB_XCNT(b.x)], 1u);
    return b;
}
__device__ __forceinline__ void xcd_barrier_complete(unsigned* bar, unsigned x, unsigned& nloc, unsigned& nx) {
    const unsigned G = gridDim.x * gridDim.y * gridDim.z;
    unsigned sum, cnt, mine, sp = 0u;
    for (;;) {
        sum = 0u; cnt = 0u; mine = 0u;
#pragma unroll
        for (unsigned j = 0; j < 16; ++j) { const unsigned c = xb_ld(&bar[XB_XCNT(j)]); sum += c; cnt += (c > 0u) ? 1u : 0u; mine = (j == x) ? c : mine; }
        if (sum == G) break;
        __builtin_amdgcn_s_sleep(1);
        if ((++sp & 255u) == 0u) { if (xb_ld(&bar[XB_TMO])) break; if (sp > XB_SPIN_CAP) { atomicAdd(&bar[XB_TMO], 1u); break; } }
    }
    nloc = mine > 0u ? mine : 1u; nx = cnt > 0u ? cnt : 1u;
}

__device__ __forceinline__ void xcd_barrier(const XcdBarrier& b, bool leader  ) {
    asm volatile("s_waitcnt vmcnt(0)" ::: "memory");
    __syncthreads();
    if (leader) {
        unsigned* bar = b.bar;
        __builtin_amdgcn_s_waitcnt(0);
        unsigned nloc = b.st[0], nx = b.st[1];
        if (nloc == 0u) { xcd_barrier_complete(bar, b.x, nloc, nx); b.st[0] = nloc; b.st[1] = nx; }
        const unsigned old = xb_add(&bar[XB_XSUB(b.x)], 1u);
        const unsigned gen = old / nloc;
        if (old + 1u == (gen + 1u) * nloc) {
            __builtin_amdgcn_fence(__ATOMIC_RELEASE, "agent");
            asm volatile("s_waitcnt vmcnt(0)" ::: "memory");
            const unsigned og = xb_add(&bar[XB_TOP], 1u);
            const unsigned tg = og / nx;
            if (og + 1u == (tg + 1u) * nx) xb_add(&bar[XB_TOPGEN], 1u);
            else XB_SPIN(xb_ld(&bar[XB_TOPGEN]) == tg, bar);
            __builtin_amdgcn_fence(__ATOMIC_ACQUIRE, "agent");
            xb_add(&bar[XB_XGEN(b.x)], 1u);
            asm volatile("s_waitcnt vmcnt(0)" ::: "memory");
        } else {
            XB_SPIN(xb_ld(&bar[XB_XGEN(b.x)]) == gen, bar);
            __builtin_amdgcn_fence(__ATOMIC_ACQUIRE, "agent");
            asm volatile("s_waitcnt vmcnt(0)" ::: "memory");
        }
    }
    __syncthreads();
}
__constant__ unsigned char T5_BUCKET[128] = {0, 1, 2, 3, 4, 5, 6, 7, 8, 9, 10, 11, 12, 13, 14, 15, 16, 16, 16, 17, 17, 18, 18, 18, 19, 19, 19, 20, 20, 20, 20, 21, 21, 21, 21, 22, 22, 22, 22, 22, 23, 23, 23, 23, 23, 23, 24, 24, 24, 24, 24, 24, 25, 25, 25, 25, 25, 25, 25, 26, 26, 26, 26, 26, 26, 26, 26, 27, 27, 27, 27, 27, 27, 27, 27, 27, 27, 28, 28, 28, 28, 28, 28, 28, 28, 28, 28, 29, 29, 29, 29, 29, 29, 29, 29, 29, 29, 29, 29, 30, 30, 30, 30, 30, 30, 30, 30, 30, 30, 30, 30, 30, 30, 31, 31, 31, 31, 31, 31, 31, 31, 31, 31, 31, 31, 31, 31, 31};
typedef short s16x4 __attribute__((ext_vector_type(4)));
typedef float f32x16 __attribute__((ext_vector_type(16)));
__device__ __forceinline__ float bf2f(unsigned short b) { return __builtin_bit_cast(float, (unsigned)b << 16); }
__device__ __forceinline__ bf16x8 cat4(s16x4 lo, s16x4 hi) { return __builtin_shufflevector(lo, hi, 0, 1, 2, 3, 4, 5, 6, 7); }
__device__ __forceinline__ void tr_read4(unsigned a0, unsigned a1, unsigned a2, unsigned a3, s16x4& r0, s16x4& r1, s16x4& r2, s16x4& r3) {
    asm volatile("ds_read_b64_tr_b16 %0, %4\n\tds_read_b64_tr_b16 %1, %5\n\tds_read_b64_tr_b16 %2, %6\n\tds_read_b64_tr_b16 %3, %7\n\ts_waitcnt lgkmcnt(0)"
                 : "=&v"(r0), "=&v"(r1), "=&v"(r2), "=&v"(r3) : "v"(a0), "v"(a1), "v"(a2), "v"(a3) : "memory");
}
#define SHX(x, o) __builtin_bit_cast(float, __builtin_amdgcn_ds_bpermute(((lane) ^ (o)) << 2, __builtin_bit_cast(int, (float)(x))))
#define SHXU(x, o) ((unsigned)__builtin_amdgcn_ds_bpermute(((lane) ^ (o)) << 2, (int)(x)))
__device__ __forceinline__ float wave_sum(float v, int lane) {
#pragma unroll
    for (int o = 1; o < 64; o <<= 1) v += SHX(v, o);
    return v;
}
template <int OUT8 = 0>
__device__ __forceinline__ void conv_item(const GAS float* W, int ldw, int k0, int c0, int nvalid, GAS bf16* dst, int dld, int drow0, int dk0, float scale, const GAS float* gain, LAS float* scr, int lane) {
    const int c = lane & 31;
    float vin[32];
#pragma unroll
    for (int i = 0; i < 32; ++i) { const int kk = 2 * i + (lane >> 5); vin[i] = 0.f;
        if (c < nvalid) vin[i] = W[(size_t)(k0 + kk) * ldw + c0 + c]; }
#pragma unroll
    for (int i = 0; i < 32; ++i) { const int kk = 2 * i + (lane >> 5); scr[kk * 33 + c] = vin[i] * scale; }
    LDS_WAIT(); asm volatile("" ::: "memory");
    const int c8 = lane & 7;
    f32x4 ga = {1.f, 1.f, 1.f, 1.f}, gb = {1.f, 1.f, 1.f, 1.f};
    if (gain) { ga = *(const GAS f32x4*)(gain + k0 + 8 * c8); gb = *(const GAS f32x4*)(gain + k0 + 8 * c8 + 4); }
#pragma unroll
    for (int j = 0; j < 4; ++j) { const int n = (lane >> 3) + 8 * j; const LAS float* s = scr + (8 * c8) * 33 + n;
        if constexpr (OUT8 == 2) { const unsigned p = pg8::pack4_i8(s[0 * 33] * ga.x, s[1 * 33] * ga.y, s[2 * 33] * ga.z, s[3 * 33] * ga.w, 1.0f), q = pg8::pack4_i8(s[4 * 33] * gb.x, s[5 * 33] * gb.y, s[6 * 33] * gb.z, s[7 * 33] * gb.w, 1.0f);
            *(GAS unsigned long long*)((GAS unsigned char*)dst + (size_t)(drow0 + n) * dld + dk0 + k0 + 8 * c8) = (unsigned long long)p | ((unsigned long long)q << 32); }
        else if constexpr (OUT8 == 1) { int p = 0, q = 0;
            p = __builtin_amdgcn_cvt_pk_fp8_f32(s[0 * 33] * ga.x, s[1 * 33] * ga.y, p, false); p = __builtin_amdgcn_cvt_pk_fp8_f32(s[2 * 33] * ga.z, s[3 * 33] * ga.w, p, true);
            q = __builtin_amdgcn_cvt_pk_fp8_f32(s[4 * 33] * gb.x, s[5 * 33] * gb.y, q, false); q = __builtin_amdgcn_cvt_pk_fp8_f32(s[6 * 33] * gb.z, s[7 * 33] * gb.w, q, true);
            *(GAS unsigned long long*)((GAS unsigned char*)dst + (size_t)(drow0 + n) * dld + dk0 + k0 + 8 * c8) = (unsigned long long)(unsigned)p | ((unsigned long long)(unsigned)q << 32); }
        else { v4u o; o.x = pk2(s[0 * 33] * ga.x, s[1 * 33] * ga.y); o.y = pk2(s[2 * 33] * ga.z, s[3 * 33] * ga.w); o.z = pk2(s[4 * 33] * gb.x, s[5 * 33] * gb.y); o.w = pk2(s[6 * 33] * gb.z, s[7 * 33] * gb.w);
            *(GAS v4u*)(dst + (size_t)(drow0 + n) * dld + dk0 + k0 + 8 * c8) = o; } }
    LDS_WAIT(); asm volatile("" ::: "memory");
}
__device__ __forceinline__ void rmsnorm_rows_bf16(const GAS float* X, const GAS float* g, GAS bf16* O, int gw, int NGW, int lane) {
    f32x4 gv[8];
#pragma unroll
    for (int j = 0; j < 8; ++j) gv[j] = ((const GAS f32x4*)g)[lane + 64 * j];
    for (int m = gw; m < M; m += NGW) {
        const GAS f32x4* xr = (const GAS f32x4*)(X + (size_t)m * D) + lane;
        f32x4 v[8]; float s = 0.f;
#pragma unroll
        for (int j = 0; j < 8; ++j) { v[j] = xr[64 * j]; s += (v[j].x * v[j].x + v[j].y * v[j].y) + (v[j].z * v[j].z + v[j].w * v[j].w); }
        const float r = 1.0f / sqrtf(wave_sum(s, lane) * (1.0f / D) + EPS);
        GAS unsigned long long* o8 = (GAS unsigned long long*)(O + (size_t)m * D) + lane;
#pragma unroll
        for (int j = 0; j < 8; ++j) { const f32x4 y = v[j] * r * gv[j]; o8[64 * j] = (unsigned long long)pk2(y.x, y.y) | ((unsigned long long)pk2(y.z, y.w) << 32); }
    }
}
__device__ __forceinline__ void rows_bf16_ss(const GAS float* X, GAS bf16* O, GAS unsigned char* O8, GAS float* ss, int gw, int NGW, int lane) {
    for (int m = gw; m < M; m += NGW) {
        const GAS f32x4* xr = (const GAS f32x4*)(X + (size_t)m * D) + lane;
        f32x4 v[8]; float s = 0.f;
#pragma unroll
        for (int j = 0; j < 8; ++j) { v[j] = xr[64 * j]; s += (v[j].x * v[j].x + v[j].y * v[j].y) + (v[j].z * v[j].z + v[j].w * v[j].w); }
        s = wave_sum(s, lane);
        GAS unsigned long long* o8 = (GAS unsigned long long*)(O + (size_t)m * D) + lane;
#pragma unroll
        for (int j = 0; j < 8; ++j) o8[64 * j] = (unsigned long long)pk2(v[j].x, v[j].y) | ((unsigned long long)pk2(v[j].z, v[j].w) << 32);
        if (O8) { GAS unsigned* q8 = (GAS unsigned*)(O8 + (size_t)m * D) + lane;
#pragma unroll
            for (int j = 0; j < 8; ++j) { if constexpr (GU_I8) q8[64 * j] = pg8::pack4_i8(v[j].x, v[j].y, v[j].z, v[j].w, H8I_SCALE); else { int p = 0; p = __builtin_amdgcn_cvt_pk_fp8_f32(v[j].x, v[j].y, p, false); p = __builtin_amdgcn_cvt_pk_fp8_f32(v[j].z, v[j].w, p, true); q8[64 * j] = (unsigned)p; } } }
        if (lane < 32) ss[(size_t)m * 32 + lane] = lane == 0 ? s : 0.f;
    }
}
__device__ __forceinline__ void final_rows(const GAS bf16* HB, GAS float* OUT, const GAS float* g, const GAS float* ss, int gw, int NGW, int lane) {
    f32x4 gv[8];
#pragma unroll
    for (int j = 0; j < 8; ++j) gv[j] = ((const GAS f32x4*)g)[lane + 64 * j];
    for (int m = gw; m < M; m += NGW) {
        const GAS unsigned long long* hr = (const GAS unsigned long long*)(HB + (size_t)m * D) + lane; GAS f32x4* orow = (GAS f32x4*)(OUT + (size_t)m * D) + lane;
        unsigned long long raw[8];
#pragma unroll
        for (int j = 0; j < 8; ++j) raw[j] = hr[64 * j];
        const float r = 1.0f / sqrtf(wave_sum(lane < 32 ? ss[(size_t)m * 32 + lane] : 0.f, lane) * (1.0f / D) + EPS);
#pragma unroll
        for (int j = 0; j < 8; ++j) { const unsigned lo = (unsigned)raw[j], hi = (unsigned)(raw[j] >> 32);
            f32x4 v = {__builtin_bit_cast(float, lo << 16), __builtin_bit_cast(float, lo & 0xffff0000u), __builtin_bit_cast(float, hi << 16), __builtin_bit_cast(float, hi & 0xffff0000u)};
            orow[64 * j] = v * r * gv[j]; }
    }
}
__device__ __forceinline__ void rmsnorm_rows_f32_inplace(GAS float* X, const GAS float* g, int gw, int NGW, int lane) {
    f32x4 gv[8];
#pragma unroll
    for (int j = 0; j < 8; ++j) gv[j] = ((const GAS f32x4*)g)[lane + 64 * j];
    for (int m = gw; m < M; m += NGW) {
        GAS f32x4* xr = (GAS f32x4*)(X + (size_t)m * D) + lane;
        f32x4 v[8]; float s = 0.f;
#pragma unroll
        for (int j = 0; j < 8; ++j) { v[j] = xr[64 * j]; s += (v[j].x * v[j].x + v[j].y * v[j].y) + (v[j].z * v[j].z + v[j].w * v[j].w); }
        const float r = 1.0f / sqrtf(wave_sum(s, lane) * (1.0f / D) + EPS);
#pragma unroll
        for (int j = 0; j < 8; ++j) xr[64 * j] = v[j] * r * gv[j];
    }
}

template <bool P_IFAST, int OUT8 = 0>
__device__ __forceinline__ void absorb_unit(const GAS float* Psrc, size_t p_ri, size_t p_rd, const GAS float* Qsrc, size_t q_rj, GAS bf16* out, size_t out_ld, float scale, const GAS float* qgain, LAS float* Ps_, LAS float* Qs_, int tid) {
    LAS bf16* Ps = (LAS bf16*)Ps_; LAS bf16* Qs = Ps + 64 * 136;
    float pv[16], qv[16];
#pragma unroll
    for (int j = 0; j < 16; ++j) { const int e = tid + 512 * j; const int i = P_IFAST ? (e & 63) : (e >> 7), d = P_IFAST ? (e >> 6) : (e & 127);
        pv[j] = Psrc[(size_t)i * p_ri + (size_t)d * p_rd];
        const int jj = e >> 7, dd = e & 127; qv[j] = Qsrc[(size_t)jj * q_rj + dd] * (qgain ? qgain[jj] : 1.0f); }
#pragma unroll
    for (int j = 0; j < 16; ++j) { const int e = tid + 512 * j; const int i = P_IFAST ? (e & 63) : (e >> 7), d = P_IFAST ? (e >> 6) : (e & 127);
        Ps[i * 136 + d] = (bf16)f2bf(pv[j]); const int jj = e >> 7, dd = e & 127; Qs[jj * 136 + dd] = (bf16)f2bf(qv[j]); }
    __syncthreads();
    const int wv = tid >> 6, ln = tid & 63, it = wv >> 1, r16 = ln & 15, g = ln >> 4;
#pragma unroll
    for (int jq = 0; jq < 2; ++jq) { const int jt = 2 * (wv & 1) + jq; f32x4 acc = {0.f, 0.f, 0.f, 0.f};
#pragma unroll
        for (int st = 0; st < 4; ++st) { const bf16x8 a = *(const LAS bf16x8*)(Ps + (16 * it + r16) * 136 + 32 * st + 8 * g); const bf16x8 b = *(const LAS bf16x8*)(Qs + (16 * jt + r16) * 136 + 32 * st + 8 * g);
            acc = __builtin_amdgcn_mfma_f32_16x16x32_bf16(a, b, acc, 0, 0, 0); }
#pragma unroll
        for (int rg = 0; rg < 4; ++rg) { const size_t o = (size_t)(16 * it + 4 * g + rg) * out_ld + 16 * jt + r16;
            if constexpr (OUT8 == 2) ((GAS unsigned char*)out)[o] = (unsigned char)(pg8::pack4_i8(acc[rg], 0.f, 0.f, 0.f, scale) & 0xffu);
            else if constexpr (OUT8 == 1) ((GAS unsigned char*)out)[o] = (unsigned char)__builtin_amdgcn_cvt_pk_fp8_f32(acc[rg] * scale, 0.f, 0, false);
            else out[o] = (bf16)f2bf(acc[rg] * scale); } }
    __syncthreads();
}
__device__ __forceinline__ void post_rows(const GAS bf16* Z, const GAS float* gkv, const GAS float* gki, const GAS float* bki, GAS bf16* CKVN, GAS bf16* KIN, GAS float* WIF, int gw, int NGW, int lane) {
    const f32x4 g4 = ((const GAS f32x4*)gkv)[lane]; const float gk = gki[lane], bk = bki[lane];
    for (int m = gw; m < M; m += NGW) {
        const GAS bf16* zr = Z + (size_t)m * ZLD;
        const unsigned long long raw = *(const GAS unsigned long long*)(zr + ZC_CKV + 4 * lane);
        const float kraw = bf2f(zr[ZC_KI + lane]);
        const float wraw = bf2f(zr[ZC_WI + (lane & 7)]);
        const float c0 = bf2f((unsigned short)raw), c1 = bf2f((unsigned short)(raw >> 16)), c2 = bf2f((unsigned short)(raw >> 32)), c3 = bf2f((unsigned short)(raw >> 48));
        const float r = 1.0f / sqrtf(wave_sum((c0 * c0 + c1 * c1) + (c2 * c2 + c3 * c3), lane) * (1.0f / RANK) + EPS);
        *(GAS unsigned long long*)(CKVN + (size_t)m * RANK + 4 * lane) = (unsigned long long)pk2(c0 * r * g4.x, c1 * r * g4.y) | ((unsigned long long)pk2(c2 * r * g4.z, c3 * r * g4.w) << 32);
        const float mu = wave_sum(kraw, lane) * (1.0f / IDIM); const float dv = kraw - mu;
        const float var = wave_sum(dv * dv, lane) * (1.0f / IDIM);
        KIN[(size_t)m * IDIM + lane] = (bf16)f2bf(dv * (1.0f / sqrtf(var + EPS)) * gk + bk);
        if (lane < 8) WIF[(size_t)m * IH + lane] = wraw;
    }
}
constexpr int SWA_KP = 144, SWA_VP = 192;
constexpr int SWA_K_OFF = 0, SWA_V_OFF = 160 * SWA_KP, SWA_TAB_OFF = SWA_V_OFF + 160 * SWA_VP;
static_assert(SWA_TAB_OFF + 16 * 128 * 4 <= RING_BYTES, "SWA LDS map");
__device__ __forceinline__ void swa_phase(LAS unsigned char* lds, const GAS bf16* Z, GAS bf16* O, const GAS float* rel_bias, const GAS float* sinks, int vcu, int G, int tid, int lane, int wave) {
    LAS float* tab = (LAS float*)(lds + SWA_TAB_OFF);
    for (int e = tid; e < 16 * 128; e += NWAVES * 64) { const int h = e >> 7, dist = e & 127; tab[e] = rel_bias[(int)T5_BUCKET[dist] * 24 + H_A + h]; }
    __syncthreads();
    const int q = lane & 31, hh = lane >> 5;
    const unsigned ldsb = (unsigned)(size_t)lds;
    for (int item = vcu; item < BATCH * 128 * KVH; item += G) {
        const int kvh = item & 1, qt = (item >> 1) & 127, b = item >> 8;
        const int t0 = 32 * qt, s0 = t0 - 128;
        const size_t rowbase = (size_t)b * SEQ;
        for (int c = tid; c < 1280; c += NWAVES * 64) { const int row = c >> 3, ch = c & 7; const int s = s0 + row;
            if (s >= 0) { const GAS bf16* zr = Z + (rowbase + s) * ZLD + kvh * 64 + ch * 8;
                const v4u kv = *(const GAS v4u*)(zr + ZC_KB); const v4u vv = *(const GAS v4u*)(zr + ZC_VB);
                *(LAS v4u*)(lds + SWA_K_OFF + row * SWA_KP + ch * 16) = kv; *(LAS v4u*)(lds + SWA_V_OFF + row * SWA_VP + ch * 16) = vv; } }
        const int hq = kvh * 8 + wave; const int t = t0 + q;
        bf16x8 qf[4];
#pragma unroll
        for (int st = 0; st < 4; ++st) qf[st] = *(const GAS bf16x8*)(Z + (rowbase + t) * ZLD + ZC_QB + hq * 64 + 16 * st + 8 * hh);
        __syncthreads();
        const int kt0 = qt >= 4 ? 0 : 4 - qt;
        f32x16 sacc[5];
#pragma unroll
        for (int kt = 0; kt < 5; ++kt) {
#pragma unroll
            for (int r = 0; r < 16; ++r) sacc[kt][r] = 0.f;
            if (kt >= kt0) {
#pragma unroll
                for (int st = 0; st < 4; ++st) { const bf16x8 kf = *(const LAS bf16x8*)(lds + SWA_K_OFF + (kt * 32 + q) * SWA_KP + (2 * st + hh) * 16);
                    sacc[kt] = __builtin_amdgcn_mfma_f32_32x32x16_bf16(kf, qf[st], sacc[kt], 0, 0, 0); } } }
        const float sink = sinks[hq]; float mx = sink;
        const LAS float* tabh = tab + hq * 128;
#pragma unroll
        for (int kt = 0; kt < 5; ++kt) if (kt >= kt0) {
#pragma unroll
            for (int r = 0; r < 16; ++r) { const int ko = (r & 3) + 8 * (r >> 2) + 4 * hh; const int dist = q + 128 - 32 * kt - ko;
                const float lg = (dist >= 0 && dist < WINDOW) ? sacc[kt][r] + tabh[dist & 127] : -1e30f; sacc[kt][r] = lg; mx = fmaxf(mx, lg); } }
        mx = fmaxf(mx, SHX(mx, 32));
        float l = 0.f;
#pragma unroll
        for (int kt = 0; kt < 5; ++kt) if (kt >= kt0) {
#pragma unroll
            for (int r = 0; r < 16; ++r) { const float p = __expf(sacc[kt][r] - mx); sacc[kt][r] = p; l += p; } }
        l += SHX(l, 32); l += __expf(sink - mx);
        f32x16 oacc[2];
#pragma unroll
        for (int dt = 0; dt < 2; ++dt)
#pragma unroll
            for (int r = 0; r < 16; ++r) oacc[dt][r] = 0.f;
        const unsigned vlane = ldsb + SWA_V_OFF + (unsigned)((4 * hh + ((lane & 15) >> 2)) * SWA_VP + (16 * ((lane >> 4) & 1) + 4 * (lane & 3)) * 2);
#pragma unroll
        for (int kt = 0; kt < 5; ++kt) if (kt >= kt0) {
#pragma unroll
            for (int s2 = 0; s2 < 2; ++s2) {
                bf16x8 pf; { const unsigned w0 = pg8::cvt_pk_bf16(sacc[kt][8 * s2 + 0], sacc[kt][8 * s2 + 1]), w1 = pg8::cvt_pk_bf16(sacc[kt][8 * s2 + 2], sacc[kt][8 * s2 + 3]),
                                     w2 = pg8::cvt_pk_bf16(sacc[kt][8 * s2 + 4], sacc[kt][8 * s2 + 5]), w3 = pg8::cvt_pk_bf16(sacc[kt][8 * s2 + 6], sacc[kt][8 * s2 + 7]);
                    const v4u w = {w0, w1, w2, w3}; pf = __builtin_bit_cast(bf16x8, w); }
                const unsigned a = vlane + (unsigned)((kt * 32 + 16 * s2) * SWA_VP);
                s16x4 r0, r1, r2, r3; tr_read4(a, a + 8 * SWA_VP, a + 64, a + 8 * SWA_VP + 64, r0, r1, r2, r3);
                oacc[0] = __builtin_amdgcn_mfma_f32_32x32x16_bf16(cat4(r0, r1), pf, oacc[0], 0, 0, 0);
                oacc[1] = __builtin_amdgcn_mfma_f32_32x32x16_bf16(cat4(r2, r3), pf, oacc[1], 0, 0, 0); } }
        const float inv = (OUT_F8 ? O8_SCALE : 1.0f) / l;
        if constexpr (OUT_F8) { GAS unsigned char* orow = (GAS unsigned char*)O + (rowbase + t) * OLD + 2048 + hq * 64 + 4 * hh;
#pragma unroll
            for (int dt = 0; dt < 2; ++dt)
#pragma unroll
                for (int g4 = 0; g4 < 4; ++g4) { int p = 0; p = __builtin_amdgcn_cvt_pk_fp8_f32(oacc[dt][4 * g4] * inv, oacc[dt][4 * g4 + 1] * inv, p, false); p = __builtin_amdgcn_cvt_pk_fp8_f32(oacc[dt][4 * g4 + 2] * inv, oacc[dt][4 * g4 + 3] * inv, p, true);
                    *(GAS unsigned*)(orow + 32 * dt + 8 * g4) = (unsigned)p; } }
        else { GAS bf16* orow = O + (rowbase + t) * OLD + 2048 + hq * 64 + 4 * hh;
#pragma unroll
        for (int dt = 0; dt < 2; ++dt)
#pragma unroll
            for (int g4 = 0; g4 < 4; ++g4) { const unsigned long long w = (unsigned long long)pk2(oacc[dt][4 * g4] * inv, oacc[dt][4 * g4 + 1] * inv) | ((unsigned long long)pk2(oacc[dt][4 * g4 + 2] * inv, oacc[dt][4 * g4 + 3] * inv) << 32);
                *(GAS unsigned long long*)(orow + 32 * dt + 8 * g4) = w; } }
        __syncthreads();
    }
}
constexpr int TK_BINS = 512, TK_CAP = 256;
#define LDS_ADD(p) __hip_atomic_fetch_add((p), 1u, __ATOMIC_RELAXED, __HIP_MEMORY_SCOPE_WORKGROUP)
#define LDS_ADDV(p, v) __hip_atomic_fetch_add((p), (v), __ATOMIC_RELAXED, __HIP_MEMORY_SCOPE_WORKGROUP)
#define HIST_WORD(tok, bin) (((tok) * TK_BINS + (bin)) >> 1)
#define HIST_INC(bin) (1u << (((bin) & 1) * 16))
constexpr int TK_HIST_OFF = 0, TK_CSC_OFF = 32768, TK_CIX_OFF = TK_CSC_OFF + 32 * TK_CAP * 4, TK_SEL_OFF = TK_CIX_OFF + 32 * TK_CAP * 2, TK_CNT_OFF = TK_SEL_OFF + 32 * 256 * 2, TK_DUM_OFF = TK_CNT_OFF + 32 * 2 * 4, TK_KB_OFF = TK_DUM_OFF + 8 * 64 * 4, TK_KB_BYTES = 64 * 144, TK_FLAG_OFF = TK_KB_OFF + 2 * TK_KB_BYTES;
static_assert(TK_FLAG_OFF + 16 <= RING_BYTES, "top-k LDS map");
typedef _Float16 tk_h2 __attribute__((ext_vector_type(2)));
__device__ __forceinline__ void tk_score2(const f32x16& acc, const tk_h2 (&wh)[8], float& s0, float& s1) {
    tk_h2 s = {(_Float16)0, (_Float16)0}; const tk_h2 zero = {(_Float16)0, (_Float16)0};
#pragma unroll
    for (int h = 0; h < 8; ++h) { tk_h2 d = __builtin_bit_cast(tk_h2, __builtin_amdgcn_cvt_pkrtz(acc[h], acc[8 + h])); d = __builtin_elementwise_max(d, zero); s = __builtin_elementwise_fma(wh[h], d, s); }
    s0 = (float)s.x; s1 = (float)s.y;
}
__device__ __forceinline__ float tk_x(float s, float sc) { return fmaf(s, sc, 256.0f); }
__device__ __forceinline__ int tk_key(float s, float sc) {
    const float x = tk_x(s, sc); int b0 = (int)x; b0 = b0 < 0 ? 0 : (b0 > TK_BINS - 1 ? TK_BINS - 1 : b0);
    int sub = (int)((x - (float)b0) * 512.0f); sub = sub < 0 ? 0 : (sub > 511 ? 511 : sub);
    return b0 * 512 + sub;
}
__device__ __forceinline__ void tk_find(const LAS unsigned* h, unsigned need, int lane, int& bin_out, unsigned& above_out) {
    unsigned v[8]; unsigned s = 0;
#pragma unroll
    for (int i = 0; i < 4; ++i) { const unsigned w = h[4 * lane + i]; v[2 * i] = w & 0xffffu; v[2 * i + 1] = w >> 16; s += v[2 * i] + v[2 * i + 1]; }
    unsigned S = s;
#pragma unroll
    for (int o = 1; o < 64; o <<= 1) { const unsigned t = (unsigned)__builtin_amdgcn_ds_bpermute((lane + o) << 2, (int)S); if (lane + o < 64) S += t; }
    const unsigned long long mask = __ballot(S >= need);
    const int Lm = mask ? 63 - __builtin_clzll(mask) : 0;
    unsigned cum = S - s; int bsel = 8 * lane; unsigned ab = cum; bool found = false;
#pragma unroll
    for (int i = 7; i >= 0; --i) { if (!found) { if (cum + v[i] >= need) { bsel = 8 * lane + i; ab = cum; found = true; } else cum += v[i]; } }
    bin_out = __builtin_amdgcn_readlane(bsel, Lm); above_out = (unsigned)__builtin_amdgcn_readlane((int)ab, Lm);
}
__device__ __forceinline__ void topk_phase(LAS unsigned char* lds, const GAS bf16* Z, const GAS bf16* KIN, const GAS float* WIF, GAS unsigned short* IDX, int vcu, int G, int lane, int wave) {
    LAS unsigned* hist = (LAS unsigned*)(lds + TK_HIST_OFF) + wave * 4 * (TK_BINS / 2);
    LAS float* csc = (LAS float*)(lds + TK_CSC_OFF) + wave * 4 * TK_CAP;
    LAS unsigned short* cix = (LAS unsigned short*)(lds + TK_CIX_OFF) + wave * 4 * TK_CAP;
    LAS unsigned short* sel = (LAS unsigned short*)(lds + TK_SEL_OFF) + wave * 4 * 256;
    LAS unsigned* cnt = (LAS unsigned*)(lds + TK_CNT_OFF) + wave * 8;
    LAS unsigned* dum = (LAS unsigned*)(lds + TK_DUM_OFF) + wave * 64 + lane;
    const int n = lane & 31, c = lane >> 5;
    const int am = (lane >> 4) & 1, bbm = (lane >> 3) & 1, ccm = (lane >> 2) & 1, dm = lane & 3;
    for (int p2 = vcu; p2 < BATCH * 64; p2 += G) {
#pragma unroll 1
        for (int half = 0; half < 2; ++half) {
            const int b = p2 >> 6, jj = p2 & 63, j = half ? 127 - jj : jj;
            const int t0 = 32 * j + 4 * wave; const size_t rb = (size_t)b * SEQ;
            bf16x8 qa[4];
#pragma unroll
            for (int st = 0; st < 4; ++st) qa[st] = *(const GAS bf16x8*)(Z + (rb + t0 + 2 * ccm + am) * ZLD + ZC_QI + (4 * bbm + dm) * 64 + 16 * st + 8 * c);
            float w0[8], w1[8];
            { const GAS f32x4* wp = (const GAS f32x4*)(WIF + (rb + t0 + 2 * c) * IH); const f32x4 x0 = wp[0], x1 = wp[1], x2 = wp[2], x3 = wp[3];
              w0[0] = x0.x; w0[1] = x0.y; w0[2] = x0.z; w0[3] = x0.w; w0[4] = x1.x; w0[5] = x1.y; w0[6] = x1.z; w0[7] = x1.w;
              w1[0] = x2.x; w1[1] = x2.y; w1[2] = x2.z; w1[3] = x2.w; w1[4] = x3.x; w1[5] = x3.y; w1[6] = x3.z; w1[7] = x3.w; }
            tk_h2 wh[8];
#pragma unroll
            for (int h = 0; h < 8; ++h) { wh[h].x = (_Float16)w0[h]; wh[h].y = (_Float16)w1[h]; }
            float scA, scB;
            { float a = 0.f, bq = 0.f;
#pragma unroll
              for (int h = 0; h < 8; ++h) { a = fmaf(w0[h], w0[h], a); bq = fmaf(w1[h], w1[h], bq); }
              scA = 32.0f / fmaxf(sqrtf(32.0f * a), 1e-20f); scB = 32.0f / fmaxf(sqrtf(32.0f * bq), 1e-20f); }
            const int tA = t0 + 2 * c, tB = tA + 1;
            for (int i = lane; i < 4 * (TK_BINS / 2); i += 64) hist[i] = 0u;
            for (int i = lane; i < 4 * 128; i += 64) ((LAS unsigned*)sel)[i] = 0u;
            if (lane < 8) cnt[lane] = 0u;
            asm volatile("s_waitcnt lgkmcnt(0)" ::: "memory");
            int lo[4], hi[4]; unsigned ab0[4]; bool ov[4];
#pragma unroll
            for (int tk = 0; tk < 4; ++tk) { lo[tk] = 0x7fffffff; hi[tk] = -1; ab0[tk] = 0u; ov[tk] = false; }
            const bool need_sel = (t0 + 3) >= TOPK;
            const GAS bf16* kbase = KIN + (rb + n) * IDIM + 8 * c;
            const int tidk = wave * 64 + lane; const int ng = (j + 2) >> 1;
            const GAS bf16* kg0 = KIN + (rb + (tidk >> 3)) * IDIM + (tidk & 7) * 8; const int koff = (tidk >> 3) * 144 + (tidk & 7) * 16;
            LAS unsigned char* kbuf = lds + TK_KB_OFF; volatile LAS unsigned* sflag = (volatile LAS unsigned*)(lds + TK_FLAG_OFF);
            if (tidk == 0) *sflag = 0u;
#define TK_PRIME() v4u kr = {0u, 0u, 0u, 0u}; { const v4u kr0 = *(const GAS v4u*)kg0; if (1 < ng) kr = *(const GAS v4u*)(kg0 + (size_t)64 * IDIM); *(LAS v4u*)(kbuf + koff) = kr0; } __syncthreads();
#define TK_GROUP_BEGIN() \
                  \
                if (g + 1 < ng) *(LAS v4u*)(kbuf + ((g + 1) & 1) * TK_KB_BYTES + koff) = kr; \
                if (g + 2 < ng) kr = *(const GAS v4u*)(kg0 + (size_t)(g + 2) * 64 * IDIM); \
                const LAS unsigned char* kb_ = kbuf + (g & 1) * TK_KB_BYTES; \
                float s0v[2], s1v[2];     \
                { f32x16 accv[2]; \
                  _Pragma("unroll") for (int u4 = 0; u4 < 2; ++u4) { _Pragma("unroll") for (int r = 0; r < 16; ++r) accv[u4][r] = 0.f; \
                    _Pragma("unroll") for (int st = 0; st < 4; ++st) { const bf16x8 kf = *(const LAS bf16x8*)(kb_ + (32 * u4 + n) * 144 + (2 * st + c) * 16); accv[u4] = __builtin_amdgcn_mfma_f32_32x32x16_bf16(qa[st], kf, accv[u4], 0, 0, 0); } } \
                  _Pragma("unroll") for (int u4 = 0; u4 < 2; ++u4) tk_score2(accv[u4], wh, s0v[u4], s1v[u4]); } \
                _Pragma("unroll") for (int u4 = 0; u4 < 2; ++u4) { \
                    const float s0 = s0v[u4], s1 = s1v[u4]; const int s = 32 * (2 * g + u4) + n;
#define TK_GROUP_END() } \
                __syncthreads();
            bool slow = false;
            if (need_sel) {
                {   TK_PRIME();
#pragma unroll 1
                    for (int g = 0; g < ng; ++g) { TK_GROUP_BEGIN()
                        int b0 = (int)tk_x(s0, scA), b1 = (int)tk_x(s1, scB); b0 = b0 < 0 ? 0 : (b0 > TK_BINS - 1 ? TK_BINS - 1 : b0); b1 = b1 < 0 ? 0 : (b1 > TK_BINS - 1 ? TK_BINS - 1 : b1);
                        LAS unsigned* p0 = (s <= tA) ? &hist[HIST_WORD(2 * c, b0)] : dum; LAS unsigned* p1 = (s <= tB) ? &hist[HIST_WORD(2 * c + 1, b1)] : dum;
                        LDS_ADDV(p0, HIST_INC(b0)); LDS_ADDV(p1, HIST_INC(b1));
                        TK_GROUP_END() }
                }
                asm volatile("s_waitcnt lgkmcnt(0)" ::: "memory");
#pragma unroll
                for (int tk = 0; tk < 4; ++tk) { int bin; unsigned above; tk_find(hist + tk * (TK_BINS / 2), (unsigned)TOPK, lane, bin, above);
                    const unsigned ceq = (hist[HIST_WORD(tk, bin)] >> ((bin & 1) * 16)) & 0xffffu; ov[tk] = ceq > (unsigned)TK_CAP; slow |= ov[tk]; ab0[tk] = above; lo[tk] = bin * 512; hi[tk] = bin * 512 + 511; }
                if (slow && lane == 0) *sflag = 1u;
                __syncthreads();
                slow = *sflag != 0u;
            }
            if (!slow) {
                float thi[4], tlo[4];
#pragma unroll
                for (int tk = 0; tk < 4; ++tk) { const int bin = lo[tk] >> 9;
                    thi[tk] = !need_sel ? -__builtin_inff() : (bin >= TK_BINS - 1 ? __builtin_inff() : (float)(bin + 1));
                    tlo[tk] = !need_sel ? __builtin_inff() : (bin == 0 ? -__builtin_inff() : (float)bin); }
                const float thiA = c ? thi[2] : thi[0], tloA = c ? tlo[2] : tlo[0], thiB = c ? thi[3] : thi[1], tloB = c ? tlo[3] : tlo[1];
                unsigned cntA = 0u, cntB = 0u;
                LAS unsigned short* selA = sel + (2 * c) * 256; LAS unsigned short* selB = sel + (2 * c + 1) * 256; LAS unsigned short* dum16 = (LAS unsigned short*)dum;
                TK_PRIME();
#pragma unroll 1
                for (int g = 0; g < ng; ++g) { TK_GROUP_BEGIN()
                    const float x0 = (s <= tA) ? tk_x(s0, scA) : __builtin_nanf(""), x1 = (s <= tB) ? tk_x(s1, scB) : __builtin_nanf("");
                    const bool a0 = x0 >= thiA, a1 = x1 >= thiB; const bool c0 = !a0 && x0 >= tloA, c1 = !a1 && x1 >= tloB;
                    const unsigned long long m0 = __ballot(a0), m1 = __ballot(a1);
                    const unsigned pre0 = c ? __builtin_amdgcn_mbcnt_hi((unsigned)(m0 >> 32), 0u) : __builtin_amdgcn_mbcnt_lo((unsigned)m0, 0u);
                    const unsigned pre1 = c ? __builtin_amdgcn_mbcnt_hi((unsigned)(m1 >> 32), 0u) : __builtin_amdgcn_mbcnt_lo((unsigned)m1, 0u);
                    const unsigned pos0 = cntA + pre0, pos1 = cntB + pre1;
                    LAS unsigned short* q0 = (a0 && pos0 < 256u) ? selA + pos0 : dum16; LAS unsigned short* q1 = (a1 && pos1 < 256u) ? selB + pos1 : dum16;
                    *q0 = (unsigned short)s; *q1 = (unsigned short)s;
                    cntA += c ? (unsigned)__builtin_popcount((unsigned)(m0 >> 32)) : (unsigned)__builtin_popcount((unsigned)m0);
                    cntB += c ? (unsigned)__builtin_popcount((unsigned)(m1 >> 32)) : (unsigned)__builtin_popcount((unsigned)m1);
                    if (__ballot(c0 || c1)) {
                        if (c0) { const unsigned pos = LDS_ADD(&cnt[(2 * c) * 2 + 1]); if (pos < (unsigned)TK_CAP) { csc[(2 * c) * TK_CAP + pos] = s0; cix[(2 * c) * TK_CAP + pos] = (unsigned short)s; } }
                        if (c1) { const unsigned pos = LDS_ADD(&cnt[(2 * c + 1) * 2 + 1]); if (pos < (unsigned)TK_CAP) { csc[(2 * c + 1) * TK_CAP + pos] = s1; cix[(2 * c + 1) * TK_CAP + pos] = (unsigned short)s; } } }
                    TK_GROUP_END() }
                if ((lane & 31) == 0) { cnt[(2 * c) * 2] = cntA; cnt[(2 * c + 1) * 2] = cntB; }
                asm volatile("s_waitcnt lgkmcnt(0)" ::: "memory");
            } else {
                for (int i = lane; i < 4 * (TK_BINS / 2); i += 64) hist[i] = 0u;
                asm volatile("s_waitcnt lgkmcnt(0)" ::: "memory");
                int mode = 1;
#pragma unroll 1
                for (;;) {
                const int klo0 = c ? lo[2] : lo[0], khi0 = c ? hi[2] : hi[0], klo1 = c ? lo[3] : lo[1], khi1 = c ? hi[3] : hi[1];
                const bool ov0 = c ? ov[2] : ov[0], ov1 = c ? ov[3] : ov[1];
                bf16x8 kb[4][4];
#pragma unroll
                for (int u4 = 0; u4 < 4; ++u4) { const int kq = u4 < j ? u4 : j;
#pragma unroll
                    for (int st = 0; st < 4; ++st) kb[u4][st] = *(const GAS bf16x8*)(kbase + (size_t)kq * 32 * IDIM + 16 * st); }
#pragma unroll 1
                for (int kt = 0; kt <= j; kt += 4) {
                    bf16x8 kn[4][4];
#pragma unroll
                    for (int u4 = 0; u4 < 4; ++u4) { const int kq = kt + 4 + u4 < j ? kt + 4 + u4 : j;
#pragma unroll
                        for (int st = 0; st < 4; ++st) kn[u4][st] = *(const GAS bf16x8*)(kbase + (size_t)kq * 32 * IDIM + 16 * st); }
#pragma unroll
                    for (int u4 = 0; u4 < 4; ++u4) {
                        f32x16 acc;
#pragma unroll
                        for (int r = 0; r < 16; ++r) acc[r] = 0.f;
#pragma unroll
                        for (int st = 0; st < 4; ++st) acc = __builtin_amdgcn_mfma_f32_32x32x16_bf16(qa[st], kb[u4][st], acc, 0, 0, 0);
                        float s0, s1; tk_score2(acc, wh, s0, s1);
                        const int s = 32 * (kt + u4) + n; const int k0 = tk_key(s0, scA), k1 = tk_key(s1, scB);
                        const bool v0 = s <= tA, v1 = s <= tB;
                        if (mode == 0) {
                            if (v0 && tA >= TOPK) LDS_ADDV(&hist[HIST_WORD(2 * c, k0 >> 9)], HIST_INC(k0 >> 9));
                            if (v1 && tB >= TOPK) LDS_ADDV(&hist[HIST_WORD(2 * c + 1, k1 >> 9)], HIST_INC(k1 >> 9));
                        } else if (mode == 1) {
                            if (v0 && ov0 && k0 >= klo0 && k0 <= khi0) LDS_ADDV(&hist[HIST_WORD(2 * c, k0 & 511)], HIST_INC(k0 & 511));
                            if (v1 && ov1 && k1 >= klo1 && k1 <= khi1) LDS_ADDV(&hist[HIST_WORD(2 * c + 1, k1 & 511)], HIST_INC(k1 & 511));
                        } else {
                            if (v0) { if (k0 > khi0) { const unsigned pos = LDS_ADD(&cnt[(2 * c) * 2]); if (pos < 256u) sel[(2 * c) * 256 + pos] = (unsigned short)s; }
                                      else if (k0 >= klo0) { const unsigned pos = LDS_ADD(&cnt[(2 * c) * 2 + 1]); if (pos < (unsigned)TK_CAP) { csc[(2 * c) * TK_CAP + pos] = s0; cix[(2 * c) * TK_CAP + pos] = (unsigned short)s; } } }
                            if (v1) { if (k1 > khi1) { const unsigned pos = LDS_ADD(&cnt[(2 * c + 1) * 2]); if (pos < 256u) sel[(2 * c + 1) * 256 + pos] = (unsigned short)s; }
                                      else if (k1 >= klo1) { const unsigned pos = LDS_ADD(&cnt[(2 * c + 1) * 2 + 1]); if (pos < (unsigned)TK_CAP) { csc[(2 * c + 1) * TK_CAP + pos] = s1; cix[(2 * c + 1) * TK_CAP + pos] = (unsigned short)s; } } }
                        }
                    }
#pragma unroll
                    for (int u4 = 0; u4 < 4; ++u4)
#pragma unroll
                        for (int st = 0; st < 4; ++st) kb[u4][st] = kn[u4][st];
                }
                    asm volatile("s_waitcnt lgkmcnt(0)" ::: "memory");
                    if (mode == 2) break;
#pragma unroll
                    for (int tk = 0; tk < 4; ++tk) if (ov[tk]) { int sub; unsigned above; tk_find(hist + tk * (TK_BINS / 2), (unsigned)TOPK - ab0[tk], lane, sub, above); lo[tk] += sub; hi[tk] = lo[tk]; }
                    mode = 2;
                }
            }
#undef TK_GROUP_BEGIN
#undef TK_GROUP_END
#undef TK_PRIME
#pragma unroll 1
            for (int tk = 0; tk < 4; ++tk) { const int t = t0 + tk;
                if (t >= TOPK) { const unsigned nsel = cnt[tk * 2]; unsigned nc = cnt[tk * 2 + 1]; nc = nc > (unsigned)TK_CAP ? (unsigned)TK_CAP : nc; const unsigned need = nsel < 256u ? 256u - nsel : 0u;
                    for (unsigned q = 0; q * 64 < nc; ++q) { const unsigned i = lane + 64 * q;
                        const float si = i < nc ? csc[tk * TK_CAP + i] : 0.f; const unsigned xi = i < nc ? cix[tk * TK_CAP + i] : 0u; unsigned rank = 0;
                        for (unsigned jx = 0; jx < nc; ++jx) { const float sj = csc[tk * TK_CAP + jx]; const unsigned xj = cix[tk * TK_CAP + jx]; rank += (sj > si || (sj == si && xj < xi)) ? 1u : 0u; }
                        if (i < nc && rank < need) sel[tk * 256 + nsel + rank] = (unsigned short)xi; } } }
            asm volatile("s_waitcnt lgkmcnt(0)" ::: "memory");
            { const LAS v4u* sv = (const LAS v4u*)sel; GAS v4u* ov = (GAS v4u*)(IDX + (rb + t0) * TOPK);
              ov[lane] = sv[lane]; ov[lane + 64] = sv[lane + 64]; }
            asm volatile("s_waitcnt vmcnt(0) lgkmcnt(0)" ::: "memory");
        }
    }
}
constexpr int DSA_TAB_OFF = RING_BYTES + 1024;
constexpr int DSA_IDX_OFF = DSA_TAB_OFF + 4224;
static_assert(8 * 129 * 4 <= 4224 && DSA_IDX_OFF + 8 * 1024 <= LDS_BYTES, "DSA LDS map");
__device__ __forceinline__ void dsa_phase(LAS unsigned char* lds_all, const GAS bf16* Z, const GAS bf16* CKVN, const GAS unsigned short* IDX, GAS bf16* O, const GAS float* rel_bias, int gw, int NGW, int tid, int lane, int wave) {
    LAS float* tab = (LAS float*)(lds_all + DSA_TAB_OFF);
    for (int e = tid; e < 8 * 129; e += NWAVES * 64) { const int hh = e / 129, dist = e - hh * 129; tab[e] = rel_bias[(dist < 128 ? (int)T5_BUCKET[dist] : 31) * 24 + hh]; }
    __syncthreads();
    LAS unsigned char* img = lds_all + RING_OFF + wave * 16384;
    LAS unsigned short* ib = (LAS unsigned short*)(lds_all + DSA_IDX_OFF + wave * 1024);
    const unsigned imgb = (unsigned)(size_t)img;
    const int h = lane & 15, g = lane >> 4, hi = lane >> 5;
    const LAS float* tabh = tab + (h & 7) * 129;
    const int TPW = (M + NGW - 1) / NGW;
    const int tok0 = gw * TPW;
    const int tok_end = (gw + 1) * TPW < M ? (gw + 1) * TPW : M;
    const int xq = 2 * (lane & 7);
    unsigned qa[8];
#pragma unroll
    for (int st = 0; st < 8; ++st) qa[st] = imgb + (unsigned)((lane & 15) * 512 + (((4 * st + g) ^ xq) * 16));
    const int q4 = (lane & 15) >> 2, p4 = lane & 3; const int xr = 2 * (4 * (g & 1) + q4);
    const unsigned pv_base = imgb + (unsigned)((4 * g + q4) * 512 + 8 * (p4 & 1));
    unsigned pva[16];
#pragma unroll
    for (int c2 = 0; c2 < 16; ++c2) pva[c2] = pv_base + (unsigned)((((2 * c2) ^ xr) | (p4 >> 1)) * 16);
    unsigned lc[4];
#pragma unroll
    for (int k = 0; k < 4; ++k) lc[k] = (unsigned)(((lane & 31) ^ (2 * ((2 * k + hi) & 7))) * 16);
    if (tok0 < tok_end) *(LAS unsigned long long*)(ib + 4 * lane) = *(const GAS unsigned long long*)(IDX + (size_t)tok0 * TOPK + 4 * lane);
#pragma unroll 1
    for (int tok = tok0; tok < tok_end; ++tok) {
        const int t = tok & (SEQ - 1); const size_t rb = (size_t)(tok - t);
        const int nsel = t + 1 < TOPK ? t + 1 : TOPK;
        const LAS unsigned short* cur = ib + ((tok - tok0) & 1) * 256;
        const unsigned long long nxi = tok + 1 < tok_end ? *(const GAS unsigned long long*)(IDX + (size_t)(tok + 1) * TOPK + 4 * lane) : 0ull;
        bf16x8 qf[8];
#pragma unroll
        for (int st = 0; st < 8; ++st) { qf[st] = *(const GAS bf16x8*)(Z + (size_t)tok * ZLD + ZC_QLAT + (h & 7) * 256 + 32 * st + 8 * g); if (h >= 8) qf[st] = (bf16x8){0, 0, 0, 0, 0, 0, 0, 0}; }
        f32x4 oacc[16];
#pragma unroll
        for (int rt = 0; rt < 16; ++rt) oacc[rt] = (f32x4){0.f, 0.f, 0.f, 0.f};
        float mrun = -1e30f, lsum = 0.f;
        const GAS unsigned char* cb = (const GAS unsigned char*)(CKVN + rb * RANK);
#pragma unroll
        for (int ch = 0; ch < 8; ++ch) {
            if (32 * ch >= nsel) break;
            unsigned rix[16];
#pragma unroll
            for (int i = 0; i < 16; ++i) rix[i] = cur[32 * ch + 2 * i + hi];
            const unsigned long long i0 = *(const LAS unsigned long long*)(cur + 32 * ch + 4 * g), i1 = *(const LAS unsigned long long*)(cur + 32 * ch + 16 + 4 * g);
            asm volatile("s_waitcnt lgkmcnt(0)" ::: "memory");
#pragma unroll
            for (int i = 0; i < 16; ++i) __builtin_amdgcn_global_load_lds((const GAS unsigned*)(cb + ((rix[i] << 9) + lc[i & 3])), (LAS unsigned*)(img + i * 1024), 16, 0, 0);
            asm volatile("s_waitcnt vmcnt(0)" ::: "memory");
            v4u fa[16];
            asm volatile("ds_read_b128 %0, %8\n\tds_read_b128 %1, %8 offset:8192\n\tds_read_b128 %2, %9\n\tds_read_b128 %3, %9 offset:8192\n\t"
                         "ds_read_b128 %4, %10\n\tds_read_b128 %5, %10 offset:8192\n\tds_read_b128 %6, %11\n\tds_read_b128 %7, %11 offset:8192"
                         : "=&v"(fa[0]), "=&v"(fa[1]), "=&v"(fa[2]), "=&v"(fa[3]), "=&v"(fa[4]), "=&v"(fa[5]), "=&v"(fa[6]), "=&v"(fa[7])
                         : "v"(qa[0]), "v"(qa[1]), "v"(qa[2]), "v"(qa[3]) : "memory");
            asm volatile("ds_read_b128 %0, %16\n\tds_read_b128 %1, %16 offset:8192\n\tds_read_b128 %2, %17\n\tds_read_b128 %3, %17 offset:8192\n\t"
                         "ds_read_b128 %4, %18\n\tds_read_b128 %5, %18 offset:8192\n\tds_read_b128 %6, %19\n\tds_read_b128 %7, %19 offset:8192\n\ts_waitcnt lgkmcnt(8)"
                         : "=&v"(fa[8]), "=&v"(fa[9]), "=&v"(fa[10]), "=&v"(fa[11]), "=&v"(fa[12]), "=&v"(fa[13]), "=&v"(fa[14]), "=&v"(fa[15]),
                           "+v"(fa[0]), "+v"(fa[1]), "+v"(fa[2]), "+v"(fa[3]), "+v"(fa[4]), "+v"(fa[5]), "+v"(fa[6]), "+v"(fa[7])
                         : "v"(qa[4]), "v"(qa[5]), "v"(qa[6]), "v"(qa[7]) : "memory");
            f32x4 sa[2] = {(f32x4){0.f, 0.f, 0.f, 0.f}, (f32x4){0.f, 0.f, 0.f, 0.f}};
#pragma unroll
            for (int st = 0; st < 4; ++st) { sa[0] = __builtin_amdgcn_mfma_f32_16x16x32_bf16(__builtin_bit_cast(bf16x8, fa[2 * st]), qf[st], sa[0], 0, 0, 0);
                sa[1] = __builtin_amdgcn_mfma_f32_16x16x32_bf16(__builtin_bit_cast(bf16x8, fa[2 * st + 1]), qf[st], sa[1], 0, 0, 0); }
            s16x4 pr[2][4];
            asm volatile("s_waitcnt lgkmcnt(0)\n\tds_read_b64_tr_b16 %0, %12\n\tds_read_b64_tr_b16 %1, %12 offset:8192\n\tds_read_b64_tr_b16 %2, %13\n\tds_read_b64_tr_b16 %3, %13 offset:8192"
                         : "=&v"(pr[0][0]), "=&v"(pr[0][1]), "=&v"(pr[0][2]), "=&v"(pr[0][3]),
                           "+v"(fa[8]), "+v"(fa[9]), "+v"(fa[10]), "+v"(fa[11]), "+v"(fa[12]), "+v"(fa[13]), "+v"(fa[14]), "+v"(fa[15])
                         : "v"(pva[0]), "v"(pva[1]) : "memory");
#pragma unroll
            for (int st = 4; st < 8; ++st) { sa[0] = __builtin_amdgcn_mfma_f32_16x16x32_bf16(__builtin_bit_cast(bf16x8, fa[2 * st]), qf[st], sa[0], 0, 0, 0);
                sa[1] = __builtin_amdgcn_mfma_f32_16x16x32_bf16(__builtin_bit_cast(bf16x8, fa[2 * st + 1]), qf[st], sa[1], 0, 0, 0); }
            float bz[8];
#pragma unroll
            for (int e = 0; e < 8; ++e) { const int tl = e >> 2, jx = e & 3; const int sidx = (int)(((tl ? i1 : i0) >> (16 * jx)) & 0xffffull); int dd = t - sidx; dd = dd < 0 ? 0 : (dd > 128 ? 128 : dd); bz[e] = tabh[dd]; }
            float lg[8]; float cmax = -1e30f;
#pragma unroll
            for (int e = 0; e < 8; ++e) { const int tl = e >> 2, jx = e & 3; const int kk = 32 * ch + 16 * tl + 4 * g + jx;
                const float v = kk < nsel ? sa[tl][jx] + bz[e] : -1e30f; lg[e] = v; cmax = fmaxf(cmax, v); }
            cmax = fmaxf(cmax, SHX(cmax, 16)); cmax = fmaxf(cmax, SHX(cmax, 32));
            const float mnew = fmaxf(mrun, cmax);
            if (__any(mnew > mrun)) { const float alpha = __expf(mrun - mnew); lsum *= alpha;
#pragma unroll
                for (int rt = 0; rt < 16; ++rt) oacc[rt] = oacc[rt] * alpha; }
            mrun = mnew;
            float pe[8];
#pragma unroll
            for (int e = 0; e < 8; ++e) { pe[e] = __expf(lg[e] - mnew); lsum += pe[e]; }
            bf16x8 pf; { const v4u wv = {pg8::cvt_pk_bf16(pe[0], pe[1]), pg8::cvt_pk_bf16(pe[2], pe[3]), pg8::cvt_pk_bf16(pe[4], pe[5]), pg8::cvt_pk_bf16(pe[6], pe[7])}; pf = __builtin_bit_cast(bf16x8, wv); }
#pragma unroll
            for (int j = 0; j < 8; ++j) {
                const int cs = j & 1, ns = cs ^ 1;
                if (j < 7) asm volatile("ds_read_b64_tr_b16 %0, %8\n\tds_read_b64_tr_b16 %1, %8 offset:8192\n\tds_read_b64_tr_b16 %2, %9\n\tds_read_b64_tr_b16 %3, %9 offset:8192\n\ts_waitcnt lgkmcnt(4)"
                                        : "=&v"(pr[ns][0]), "=&v"(pr[ns][1]), "=&v"(pr[ns][2]), "=&v"(pr[ns][3]), "+v"(pr[cs][0]), "+v"(pr[cs][1]), "+v"(pr[cs][2]), "+v"(pr[cs][3])
                                        : "v"(pva[2 * j + 2]), "v"(pva[2 * j + 3]) : "memory");
                else asm volatile("s_waitcnt lgkmcnt(0)" : "+v"(pr[cs][0]), "+v"(pr[cs][1]), "+v"(pr[cs][2]), "+v"(pr[cs][3]) :: "memory");
                oacc[2 * j] = __builtin_amdgcn_mfma_f32_16x16x32_bf16(cat4(pr[cs][0], pr[cs][1]), pf, oacc[2 * j], 0, 0, 0);
                oacc[2 * j + 1] = __builtin_amdgcn_mfma_f32_16x16x32_bf16(cat4(pr[cs][2], pr[cs][3]), pf, oacc[2 * j + 1], 0, 0, 0); }
        }
        if (tok + 1 < tok_end) *(LAS unsigned long long*)(ib + (((tok - tok0) & 1) ^ 1) * 256 + 4 * lane) = nxi;
        lsum += SHX(lsum, 16); lsum += SHX(lsum, 32);
        const float inv = (OUT_F8 ? O8_SCALE : 1.0f) / lsum;
        if (h < 8) {
            if constexpr (OUT_F8) { GAS unsigned char* orow = (GAS unsigned char*)O + (size_t)tok * OLD + h * 256 + 4 * g;
#pragma unroll
                for (int rt = 0; rt < 16; ++rt) { int p = 0; p = __builtin_amdgcn_cvt_pk_fp8_f32(oacc[rt][0] * inv, oacc[rt][1] * inv, p, false); p = __builtin_amdgcn_cvt_pk_fp8_f32(oacc[rt][2] * inv, oacc[rt][3] * inv, p, true); *(GAS unsigned*)(orow + 16 * rt) = (unsigned)p; } }
            else { GAS bf16* orow = O + (size_t)tok * OLD + h * 256 + 4 * g;
#pragma unroll
            for (int rt = 0; rt < 16; ++rt) *(GAS unsigned long long*)(orow + 16 * rt) = (unsigned long long)pk2(oacc[rt][0] * inv, oacc[rt][1] * inv) | ((unsigned long long)pk2(oacc[rt][2] * inv, oacc[rt][3] * inv) << 32); } }
    }
}
struct Args { const float* in[20]; float* out; unsigned char* ws; };
__device__ __forceinline__ unsigned long long karg_u64(int idx) { unsigned long long r; const unsigned off = (unsigned)idx * 8u;
    asm volatile("s_load_dwordx2 %0, %1, %2\n\ts_waitcnt lgkmcnt(0)" : "=s"(r) : "s"(__builtin_amdgcn_kernarg_segment_ptr()), "s"(off) : "memory"); return r; }
__device__ __forceinline__ const GAS float* karg_in(int i) { return (const GAS float*)karg_u64(i); }
__device__ __forceinline__ GAS float* karg_out() { return (GAS float*)karg_u64(20); }
__device__ __forceinline__ GAS unsigned char* karg_ws() { return (GAS unsigned char*)karg_u64(21); }
#ifndef REP_P0
#define REP_P0 1
#endif
#ifndef REP_NORM
#define REP_NORM 1
#endif
#ifndef REP_GU
#define REP_GU 1
#endif
#ifndef REP_IN
#define REP_IN 1
#endif
#ifndef REP_POST
#define REP_POST 1
#endif
#ifndef REP_TOPK
#define REP_TOPK 1
#endif
#ifndef REP_DSA
#define REP_DSA 1
#endif
#define REPEAT(n) _Pragma("unroll 1") for (int rep_ = 0; rep_ < (n); ++rep_)
#define PHASE_IDS() int wave = wave0; asm volatile("" : "+s"(wave)); int lane; asm volatile("v_mbcnt_lo_u32_b32 %0, -1, 0\n\tv_mbcnt_hi_u32_b32 %0, -1, %0" : "=v"(lane)); const int tid = wave * 64 + lane; int bx = blockIdx.x; asm volatile("" : "+s"(bx)); int G = gridDim.x; asm volatile("" : "+s"(G)); \
    const int vcu = (G % 8 == 0) ? (bx % 8) * (G / 8) + bx / 8 : bx; const int gw = vcu * NWAVES + wave, NGW = G * NWAVES; \
    GAS unsigned char* ws = karg_ws(); (void)lane; (void)gw; (void)NGW; (void)vcu; (void)ws
__global__ void __launch_bounds__(NWAVES * 64, 2) mk_fwd(Args args) {
    extern __shared__ __attribute__((aligned(16))) unsigned char lds_raw[];
    LAS unsigned char* lds = (LAS unsigned char*)lds_raw;
    volatile LAS unsigned* MISC = (volatile LAS unsigned*)(lds + MISC_OFF);
    const int wave0 = __builtin_amdgcn_readfirstlane(threadIdx.x >> 6);
    for (int u = threadIdx.x; u < (LDS_BYTES - LDSCTL_OFF) / 4; u += NWAVES * 64) ((LAS unsigned*)(lds + LDSCTL_OFF))[u] = 0u;
    __syncthreads();
    (void)xcd_barrier_post((unsigned*)((gu32*)(karg_ws() + WS_CTL) + CW_BAR), MISC + 8, threadIdx.x == 0);
#define GRID_BAR() do { XcdBarrier b_; b_.bar = (unsigned*)((gu32*)(karg_ws() + WS_CTL) + CW_BAR); b_.x = xb_xcc_id(); b_.st = MISC + 8; int w_ = wave0; asm volatile("" : "+s"(w_)); int l_; asm volatile("v_mbcnt_lo_u32_b32 %0, -1, 0\n\tv_mbcnt_hi_u32_b32 %0, -1, %0" : "=v"(l_)); xcd_barrier(b_, (w_ | l_) == 0); } while (0)

    REPEAT(REP_P0) {   PHASE_IDS();
        LAS float* scr = (LAS float*)(lds + RING_OFF + wave * 16384);
        rows_bf16_ss(karg_in(0), (GAS bf16*)(ws + WS_XN), f8_on(0, 0) ? (GAS unsigned char*)(ws + WS_HB8) : (GAS unsigned char*)nullptr, (GAS float*)(ws + WS_SS), gw, NGW, lane);
        constexpr int I_GU = (D / 64) * (FF / 32), I_DN = (FF / 64) * (D / 32);
        constexpr int I_FFN = 2 * I_GU + I_DN, I_IN = 72 * (D / 64), I_OB = (1024 / 64) * (D / 32);
        constexpr int PER_LAYER = 2 * I_FFN + I_IN + I_OB;
        for (int it = gw; it < DEPTH * PER_LAYER; it += NGW) {
            const int l = it / PER_LAYER; int r = it - l * PER_LAYER;
            GAS unsigned char* wl = ws + WS_W0 + (size_t)l * W_LAYER;
            if (r < 2 * I_FFN) {
                const int f = r / I_FFN; r -= f * I_FFN;
                GAS bf16* dgu = (GAS bf16*)(wl + (f ? WO_GU2 : WO_GU1)); GAS bf16* dd = (GAS bf16*)(wl + (f ? WO_D2 : WO_D1));
                if (r < 2 * I_GU) { const int up = r >= I_GU; if (up) r -= I_GU; const int kb = r / (FF / 32), nb = r % (FF / 32), n0 = 32 * nb;
                    const GAS float* wsrc = karg_in(up ? (f ? 17 : 4) : (f ? 16 : 3)) + (size_t)l * D * FF;
                    const int drow = (n0 >> 7) * 256 + (up ? 128 : 0) + (n0 & 127);
                    if (f8_on(l, f)) { if constexpr (GU_I8) conv_item<2>(wsrc, FF, 64 * kb, n0, 32, dgu, D, drow, 0, W8I_SCALE, karg_in(f ? 15 : 2) + (size_t)l * D, scr, lane); else conv_item<1>(wsrc, FF, 64 * kb, n0, 32, dgu, D, drow, 0, W8_SCALE, karg_in(f ? 15 : 2) + (size_t)l * D, scr, lane); }
                    else conv_item(wsrc, FF, 64 * kb, n0, 32, dgu, D, drow, 0, 1.0f, karg_in(f ? 15 : 2) + (size_t)l * D, scr, lane); }
                else { r -= 2 * I_GU; const int kb = r / (D / 32), nb = r % (D / 32);
                    if (d8_on(l, f)) conv_item<1>(karg_in(f ? 18 : 5) + (size_t)l * FF * D, D, 64 * kb, 32 * nb, 32, dd, FF, 32 * nb, 0, W8_SCALE, nullptr, scr, lane);
                    else conv_item(karg_in(f ? 18 : 5) + (size_t)l * FF * D, D, 64 * kb, 32 * nb, 32, dd, FF, 32 * nb, 0, 1.0f, nullptr, scr, lane); }
            } else if (r < 2 * I_FFN + I_IN) {
                r -= 2 * I_FFN; const int j = r >> 5, kb = r & 31; int src, nvalid = 32; float sc = 1.0f;
                if (j < 8) src = 1024 + 32 * j;
                else if (j < 40) src = 1864 + 32 * (j - 8);
                else if (j < 44) src = 2888 + 32 * (j - 40);
                else if (j < 48) src = 3016 + 32 * (j - 44);
                else if (j < 64) src = 1280 + 32 * (j - 48);
                else if (j < 66) src = 1792 + 32 * (j - 64);
                else if (j == 66) { src = 1856; nvalid = 8; sc = 0.044194173824159216f; }
                else { src = 0; nvalid = 0; }
                const GAS float* win = karg_in(7) + (size_t)l * D * D_IN; const GAS float* gmix = karg_in(6) + (size_t)l * D;
                if (IN_I8 && j < 48) conv_item<2>(win, D_IN, 64 * kb, src, nvalid, (GAS bf16*)(wl + WO_IN), D, 2048 + 32 * j, 0, W8I_SCALE, gmix, scr, lane);
                else if (IN_I8) conv_item(win, D_IN, 64 * kb, src, nvalid, (GAS bf16*)(wl + WO_IN + (size_t)ZN8 * D), D, 32 * (j - 48), 0, sc, gmix, scr, lane);
                else conv_item(win, D_IN, 64 * kb, src, nvalid, (GAS bf16*)(wl + WO_IN), D, 2048 + 32 * j, 0, (j >= 8 && j < 40) ? 0.125f : sc, gmix, scr, lane);
            } else {
                r -= 2 * I_FFN + I_IN; const int kb = r >> 6, nb = r & 63;
                if constexpr (OUT_F8) conv_item<1>(karg_in(14) + (size_t)l * D * D + (size_t)1024 * D, D, 64 * kb, 32 * nb, 32, (GAS bf16*)(wl + WO_OUT), OLD, 32 * nb, 2048, W8_SCALE, nullptr, scr, lane);
                else conv_item(karg_in(14) + (size_t)l * D * D + (size_t)1024 * D, D, 64 * kb, 32 * nb, 32, (GAS bf16*)(wl + WO_OUT), OLD, 32 * nb, 2048, 1.0f, nullptr, scr, lane);
            }
        }
        __syncthreads();
        LAS float* Ps = (LAS float*)(lds + RING_OFF); LAS float* Qs = Ps + 64 * 129;
        for (int u = vcu; u < DEPTH * 2048; u += G) {
            const int l = u >> 11, which = (u >> 10) & 1, v = u & 1023;
            GAS unsigned char* wl = ws + WS_W0 + (size_t)l * W_LAYER;
            if (which == 0) { const int h = v >> 7, rt = (v >> 5) & 3, kt = v & 31;
                if constexpr (IN_I8) absorb_unit<false, 2>(karg_in(11) + (size_t)l * RANK * 1024 + ((size_t)(64 * rt) * 8 + h) * 128, 1024, 1, karg_in(7) + (size_t)l * D * D_IN + (size_t)(64 * kt) * D_IN + h * 128, D_IN,
                                   (GAS bf16*)((GAS unsigned char*)(wl + WO_IN) + (size_t)(h * 256 + 64 * rt) * D + 64 * kt), D, WQ8I_SCALE, karg_in(6) + (size_t)l * D + 64 * kt, Ps, Qs, tid);
                else absorb_unit<false>(karg_in(11) + (size_t)l * RANK * 1024 + ((size_t)(64 * rt) * 8 + h) * 128, 1024, 1, karg_in(7) + (size_t)l * D * D_IN + (size_t)(64 * kt) * D_IN + h * 128, D_IN,
                                   (GAS bf16*)(wl + WO_IN) + (size_t)(h * 256 + 64 * rt) * D + 64 * kt, D, 0.08838834764831845f, karg_in(6) + (size_t)l * D + 64 * kt, Ps, Qs, tid); }
            else { const int h = v >> 7, nt = (v >> 2) & 31, rt = v & 3;
                if constexpr (OUT_F8) absorb_unit<true, 1>(karg_in(14) + (size_t)l * D * D + (size_t)(h * 128) * D + 64 * nt, 1, D, karg_in(12) + (size_t)l * RANK * 1024 + ((size_t)(64 * rt) * 8 + h) * 128, 1024,
                                  (GAS bf16*)((GAS unsigned char*)(wl + WO_OUT) + (size_t)(64 * nt) * OLD + h * 256 + 64 * rt), OLD, W8_SCALE, nullptr, Ps, Qs, tid);
                else absorb_unit<true>(karg_in(14) + (size_t)l * D * D + (size_t)(h * 128) * D + 64 * nt, 1, D, karg_in(12) + (size_t)l * RANK * 1024 + ((size_t)(64 * rt) * 8 + h) * 128, 1024,
                                  (GAS bf16*)(wl + WO_OUT) + (size_t)(64 * nt) * OLD + h * 256 + 64 * rt, OLD, 1.0f, nullptr, Ps, Qs, tid); }
        }
    }
    GRID_BAR();

#pragma unroll 1
    for (int s = 0; s < 2 * DEPTH; ++s) {
        const int l = s >> 1, f = s & 1;
        REPEAT(REP_GU) {   PHASE_IDS(); GAS unsigned char* wl = ws + WS_W0 + (size_t)l * W_LAYER;
            pg8::StaticOrder S; S.init(M, NGU, G, bx);
            const GAS float* ssp = (const GAS float*)(ws + WS_SS + (size_t)((3 * l + 2 * f) & 1) * SS_BYTES);
            if ((F8_MASK == 0xF) || (F8_MASK != 0 && f8_on(l, f))) {
                if constexpr (F8_MASK != 0) {
                    pg8::Gemm g{(const GAS bf16*)(ws + WS_HB8), (const GAS bf16*)(wl + (f ? WO_GU2 : WO_GU1)), M, NGU, D / 2};
                    if constexpr (GU_I8) { pg8::EpiSwiglu<true> E{(GAS bf16*)(ws + WS_ACT), FF, ssp, 1.0f / D, EPS, 1.0f / (H8I_SCALE * W8I_SCALE), d8_on(l, f) ? A8_SCALE : 0.f};
                        pg8::gemm_phase<pg8::EpiSwiglu<true>, pg8::StaticOrder, true, true, false, true>(lds + RING_OFF, g, S, E, tid); }
                    else { pg8::EpiSwiglu<false> E{(GAS bf16*)(ws + WS_ACT), FF, ssp, 1.0f / D, EPS, 1.0f / W8_SCALE, d8_on(l, f) ? A8_SCALE : 0.f};
                        pg8::gemm_phase<pg8::EpiSwiglu<false>, pg8::StaticOrder, true, true, true>(lds + RING_OFF, g, S, E, tid); } }
            } else {
                if constexpr (F8_MASK != 0xF) {
                    pg8::Gemm g{(const GAS bf16*)(ws + WS_XN), (const GAS bf16*)(wl + (f ? WO_GU2 : WO_GU1)), M, NGU, D};
                    pg8::EpiSwiglu<false> E{(GAS bf16*)(ws + WS_ACT), FF, ssp, 1.0f / D, EPS, 1.0f, d8_on(l, f) ? A8_SCALE : 0.f};
                    pg8::gemm_phase<pg8::EpiSwiglu<false>, pg8::StaticOrder, true, true, false>(lds + RING_OFF, g, S, E, tid); }
            } }
        GRID_BAR();
        {   PHASE_IDS(); GAS unsigned char* wl = ws + WS_W0 + (size_t)l * W_LAYER;
            pg8::StaticOrder S; S.init(M, D, G, bx);
            const unsigned sso = (unsigned)(WS_SS + (size_t)((3 * l + 2 * f + 1) & 1) * SS_BYTES), h8o = ((f == 0 && IN_I8) || (f == 1 && l + 1 < DEPTH && f8_on(l + 1, 0))) ? (unsigned)WS_HB8 : 0u;
            if ((D8_MASK == 0xF) || (D8_MASK != 0 && d8_on(l, f))) {
                if constexpr (D8_MASK != 0) {
                    pg8::Gemm g{(const GAS bf16*)(ws + WS_ACT), (const GAS bf16*)(wl + (f ? WO_D2 : WO_D1)), M, D, FF / 2};
                    pg8::EpiResid E{0.5f / (W8_SCALE * A8_SCALE), (unsigned)WS_XN, sso, h8o, GU_I8 ? H8I_SCALE : 0.f};
                    pg8::gemm_phase<pg8::EpiResid, pg8::StaticOrder, true, true, true>(lds + RING_OFF, g, S, E, tid); }
            } else {
                if constexpr (D8_MASK != 0xF) {
                    pg8::Gemm g{(const GAS bf16*)(ws + WS_ACT), (const GAS bf16*)(wl + (f ? WO_D2 : WO_D1)), M, D, FF};
                    pg8::EpiResid E{0.5f, (unsigned)WS_XN, sso, h8o, GU_I8 ? H8I_SCALE : 0.f};
                    pg8::gemm_phase<pg8::EpiResid, pg8::StaticOrder, true, true, false>(lds + RING_OFF, g, S, E, tid); }
            } }
        GRID_BAR();
        if (f == 0) {
            REPEAT(REP_IN) {   PHASE_IDS(); GAS unsigned char* wl = ws + WS_W0 + (size_t)l * W_LAYER;
                const GAS float* ssp = (const GAS float*)(ws + WS_SS + (size_t)((3 * l + 1) & 1) * SS_BYTES);
                if constexpr (IN_I8) {
                    {   pg8::Gemm g{(const GAS bf16*)(ws + WS_HB8), (const GAS bf16*)(wl + WO_IN), M, ZN8, D / 2}; pg8::StaticOrder S; S.init(M, ZN8, G, bx);
                        pg8::EpiBf16<true> E{(GAS bf16*)(ws + WS_Z), ZLD, ssp, 1.0f / D, EPS, 0.08838834764831845f / (H8I_SCALE * WQ8I_SCALE), 1.0f / (H8I_SCALE * W8I_SCALE), 0.125f / (H8I_SCALE * W8I_SCALE)};
                        pg8::gemm_phase<pg8::EpiBf16<true>, pg8::StaticOrder, true, true, false, true>(lds + RING_OFF, g, S, E, tid); }
                    {   pg8::Gemm g{(const GAS bf16*)(ws + WS_XN), (const GAS bf16*)(wl + WO_IN + (size_t)ZN8 * D), M, ZLD - ZN8, D}; pg8::StaticOrder S; S.init(M, ZLD - ZN8, G, bx);
                        pg8::EpiBf16<false> E{(GAS bf16*)(ws + WS_Z) + ZN8, ZLD, ssp, 1.0f / D, EPS, 1.0f, 1.0f, 1.0f};
                        pg8::gemm_phase<pg8::EpiBf16<false>, pg8::StaticOrder, true, true, false, false>(lds + RING_OFF, g, S, E, tid); }
                } else {
                    pg8::Gemm g{(const GAS bf16*)(ws + WS_XN), (const GAS bf16*)(wl + WO_IN), M, ZLD, D}; pg8::StaticOrder S; S.init(M, ZLD, G, bx);
                    pg8::EpiBf16<false> E{(GAS bf16*)(ws + WS_Z), ZLD, ssp, 1.0f / D, EPS, 1.0f, 1.0f, 1.0f};
                    pg8::gemm_phase<pg8::EpiBf16<false>, pg8::StaticOrder, true, true, false, false>(lds + RING_OFF, g, S, E, tid); } }
            GRID_BAR();
            REPEAT(REP_POST) {   PHASE_IDS();
                post_rows((const GAS bf16*)(ws + WS_Z), karg_in(8) + (size_t)l * RANK, karg_in(9) + (size_t)l * IDIM, karg_in(10) + (size_t)l * IDIM, (GAS bf16*)(ws + WS_CKVN), (GAS bf16*)(ws + WS_KIN), (GAS float*)(ws + WS_WIF), gw, NGW, lane);
                swa_phase(lds + RING_OFF, (const GAS bf16*)(ws + WS_Z), (GAS bf16*)(ws + WS_O), karg_in(1), karg_in(13) + (size_t)l * H_B, vcu, G, tid, lane, wave);
            }
            GRID_BAR();
            REPEAT(REP_TOPK) {   PHASE_IDS(); topk_phase(lds + RING_OFF, (const GAS bf16*)(ws + WS_Z), (const GAS bf16*)(ws + WS_KIN), (const GAS float*)(ws + WS_WIF), (GAS unsigned short*)(ws + WS_IDX), vcu, G, lane, wave); }
            GRID_BAR();
            REPEAT(REP_DSA) {   PHASE_IDS(); dsa_phase(lds, (const GAS bf16*)(ws + WS_Z), (const GAS bf16*)(ws + WS_CKVN), (const GAS unsigned short*)(ws + WS_IDX), (GAS bf16*)(ws + WS_O), karg_in(1), gw, NGW, tid, lane, wave); }
            GRID_BAR();
            {   PHASE_IDS(); GAS unsigned char* wl = ws + WS_W0 + (size_t)l * W_LAYER;
                pg8::Gemm g{(const GAS bf16*)(ws + WS_O), (const GAS bf16*)(wl + WO_OUT), M, D, OUT_F8 ? OLD / 2 : OLD}; pg8::StaticOrder S; S.init(M, D, G, bx);
                pg8::EpiResid E{OUT_F8 ? 1.0f / (W8_SCALE * O8_SCALE) : 1.0f, (unsigned)WS_XN, (unsigned)(WS_SS + (size_t)((3 * l + 2) & 1) * SS_BYTES), f8_on(l, 1) ? (unsigned)WS_HB8 : 0u, GU_I8 ? H8I_SCALE : 0.f};
                pg8::gemm_phase<pg8::EpiResid, pg8::StaticOrder, true, true, OUT_F8 != 0>(lds + RING_OFF, g, S, E, tid); }
            GRID_BAR();
        }
    }
    {   PHASE_IDS(); final_rows((const GAS bf16*)(ws + WS_XN), karg_out(), karg_in(19), (const GAS float*)(ws + WS_SS + (size_t)(6 & 1) * SS_BYTES), gw, NGW, lane); }
}

extern "C" void kernel_launch(void* const* d_in, const int* in_sizes, int n_in, void* d_out, int out_size, void* d_ws, size_t ws_size, hipStream_t stream) {
    static int grid = 0;
    if (grid == 0) {
        if (n_in != 20 || in_sizes[0] != M * D || out_size != M * D || ws_size < WS_END) { fprintf(stderr, "kernel_launch: unexpected shapes (n_in %d, in0 %d, out %d, ws %zu); nothing launched\n", n_in, n_in > 0 ? in_sizes[0] : -1, out_size, ws_size); grid = -1; return; }
        int dev = 0, cus = 0, per_cu = 0;
        if (hipGetDevice(&dev) != hipSuccess || hipDeviceGetAttribute(&cus, hipDeviceAttributeMultiprocessorCount, dev) != hipSuccess) { grid = -1; return; }
        if (hipFuncSetAttribute((const void*)mk_fwd, hipFuncAttributeMaxDynamicSharedMemorySize, LDS_BYTES) != hipSuccess) { fprintf(stderr, "kernel_launch: hipFuncSetAttribute failed\n"); grid = -1; return; }
        if (hipOccupancyMaxActiveBlocksPerMultiprocessor(&per_cu, (const void*)mk_fwd, NWAVES * 64, LDS_BYTES) != hipSuccess || per_cu < 1) { fprintf(stderr, "kernel_launch: occupancy query reports %d workgroups per CU\n", per_cu); }
        (void)hipGetLastError();
        grid = cus;
    }
    if (grid < 0) return;
    if (hipMemsetAsync((char*)d_ws + WS_CTL, 0, CTL_ZERO_BYTES, stream) != hipSuccess) return;
    Args a{};
    for (int i = 0; i < 20; ++i) a.in[i] = (const float*)d_in[i];
    a.out = (float*)d_out; a.ws = (unsigned char*)d_ws;
    hipLaunchKernelGGL(mk_fwd, dim3(grid), dim3(NWAVES * 64), LDS_BYTES, stream, a);
}
```

```cpp
#include <hip/hip_runtime.h>
#include <cstdio>
#include <cstdint>
namespace pg8 {
#define PG8_LAS __attribute__((address_space(3)))
#define PG8_GAS __attribute__((address_space(1)))
typedef unsigned short bf16_t;
typedef short bf16x8 __attribute__((ext_vector_type(8)));
typedef float f32x4 __attribute__((ext_vector_type(4)));
typedef unsigned u32x4 __attribute__((ext_vector_type(4)));
constexpr int BM = 256, BK = 64, HALF = 128, HTB = HALF * BK * 2  , STAGE_BYTES = 8 * HTB, NXCD = 8, WGM = 4;

__host__ __device__ __forceinline__ int lds_byte(int r, int c) { const int st = (r >> 4) * 2 + (c >> 5), rr = r & 15, cc = c & 31, ob = rr * 64 + cc * 2; return st * 1024 + (ob ^ (((ob >> 9) & 1) << 5)); }
__host__ __device__ __forceinline__ void stage_rc(int b, int& R, int& C) { const int st = b / 1024, sb = b % 1024, swz = sb ^ (((sb >> 9) & 1) << 5); R = (st >> 1) * 16 + swz / 64; C = (st & 1) * 32 + (swz % 64) / 2; }
__host__ __device__ __forceinline__ int perm32(int rho) { const int n = rho >> 4, i = rho & 15; return 8 * (i >> 2) + 4 * n + (i & 3); }

typedef int i32x8 __attribute__((ext_vector_type(8))); typedef int i32x4v __attribute__((ext_vector_type(4)));
__device__ __forceinline__ i32x8 cat8(bf16x8 a, bf16x8 b) { return __builtin_shufflevector(__builtin_bit_cast(i32x4v, a), __builtin_bit_cast(i32x4v, b), 0, 1, 2, 3, 4, 5, 6, 7); }
struct Unit { int pm, pn; };
struct Gemm { const PG8_GAS bf16_t* A; const PG8_GAS bf16_t* Bt; int M, N, K; };

struct StaticOrder {
    int nM, nN, nwg, G, c;
    __host__ __device__ void init(int M, int N, int G_, int c_) { nM = M / BM; nN = N / BM; nwg = nM * nN; G = G_; c = c_; }
    __host__ __device__ bool next(int i, Unit& u) const {
        const long L = (long)i * G + c; if (L >= nwg) return false;
        int wgid = (int)L; { const int q = nwg / NXCD, r = nwg % NXCD, xcd = wgid % NXCD, off = wgid / NXCD; wgid = (xcd < r ? xcd * (q + 1) : r * (q + 1) + (xcd - r) * q) + off; }
        const int nig = WGM * nN, gid = wgid / nig, fm = gid * WGM, gsz = (nM - fm) < WGM ? (nM - fm) : WGM;
        u.pm = fm + ((wgid % nig) % gsz); u.pn = (wgid % nig) / gsz; return true;
    }
    __device__ __forceinline__ void a_ready(const Unit&) const {}
    __device__ __forceinline__ void done(const Unit&) const {}
};
__device__ __forceinline__ unsigned long long karg64(int idx) { unsigned long long r; const unsigned off = (unsigned)idx * 8u;
    asm volatile("s_load_dwordx2 %0, %1, %2\n\ts_waitcnt lgkmcnt(0)" : "=s"(r) : "s"(__builtin_amdgcn_kernarg_segment_ptr()), "s"(off) : "memory"); return r; }
__device__ __forceinline__ unsigned cvt_pk_bf16(float lo, float hi) { unsigned r; asm volatile("v_cvt_pk_bf16_f32 %0, %1, %2" : "=v"(r) : "v"(lo), "v"(hi)); return r; }
typedef float f32x2 __attribute__((ext_vector_type(2)));
__device__ __forceinline__ unsigned pack4_i8(float a, float b, float c, float d, float S) {
    const int qa = (int)__builtin_rintf(__builtin_fminf(__builtin_fmaxf(a * S, -127.f), 127.f)), qb = (int)__builtin_rintf(__builtin_fminf(__builtin_fmaxf(b * S, -127.f), 127.f));
    const int qc = (int)__builtin_rintf(__builtin_fminf(__builtin_fmaxf(c * S, -127.f), 127.f)), qd = (int)__builtin_rintf(__builtin_fminf(__builtin_fmaxf(d * S, -127.f), 127.f));
    return ((unsigned)qa & 0xffu) | (((unsigned)qb & 0xffu) << 8) | (((unsigned)qc & 0xffu) << 16) | ((unsigned)qd << 24);
}
__device__ __forceinline__ float silu_f(float g) { return g * __builtin_amdgcn_rcpf(1.0f + __builtin_amdgcn_exp2f(-1.4426950408889634f * g)); }

template <bool ACC_I32 = false>
struct EpiSwiglu {
    static constexpr bool PERM = true, AFTER_DRAIN = false;
    static __device__ __forceinline__ f32x4 cv(const f32x4& a) { if constexpr (ACC_I32) { typedef int i32x4e __attribute__((ext_vector_type(4))); const i32x4e q = __builtin_bit_cast(i32x4e, a); return (f32x4){(float)q[0], (float)q[1], (float)q[2], (float)q[3]}; } else return a; }
    PG8_GAS bf16_t* O; int ldc; const PG8_GAS float* ss; float inv_k, eps, post; float out8;
    __device__ __forceinline__ void operator()(const f32x4 (&acc)[2][2][4][2], const Unit& u, int wr, int wc, int fr, int fq) const {
        const int row0 = u.pm * BM + wr * 64 + fr, col0 = u.pn * HALF + wc * 32 + 8 * fq;
        float rs[8]; const int lane_ = fr + 16 * fq;
#pragma unroll
        for (int k = 0; k < 8; ++k) { const PG8_GAS f32x4* p4 = (const PG8_GAS f32x4*)(ss + (size_t)(row0 + (k >> 2) * HALF + (k & 3) * 16) * 32 + 8 * fq); const f32x4 a = p4[0], b = p4[1];
            float t = ((a[0] + a[1]) + (a[2] + a[3])) + ((b[0] + b[1]) + (b[2] + b[3]));
            t += __builtin_bit_cast(float, __builtin_amdgcn_ds_bpermute((lane_ ^ 16) << 2, __builtin_bit_cast(int, t)));
            t += __builtin_bit_cast(float, __builtin_amdgcn_ds_bpermute((lane_ ^ 32) << 2, __builtin_bit_cast(int, t))); rs[k] = t; }
        unsigned pk[8][2];
#pragma unroll
        for (int ai = 0; ai < 2; ++ai)
#pragma unroll
            for (int m = 0; m < 4; ++m) { PG8_GAS bf16_t* rowp = O + (size_t)(row0 + ai * HALF + m * 16) * ldc + col0;
                const float r = __builtin_amdgcn_rsqf(rs[ai * 4 + m] * inv_k + eps) * post;
                const f32x2 r2 = {r, r}, c2 = {-1.4426950408889634f * r, -1.4426950408889634f * r}; const float rs8 = out8 != 0.f ? r * out8 : r; const f32x2 q2 = {rs8, rs8}, one2 = {1.0f, 1.0f};
                f32x2 o[4];
#pragma unroll
                for (int h = 0; h < 4; ++h) { const f32x4 gq = cv(acc[ai][0][m][h >> 1]), uq = cv(acc[ai][1][m][h >> 1]);
                    const f32x2 gv = {gq[2 * (h & 1)], gq[2 * (h & 1) + 1]}, uv = {uq[2 * (h & 1)], uq[2 * (h & 1) + 1]};
                    const f32x2 t = gv * c2; f32x2 e; e.x = __builtin_amdgcn_exp2f(t.x); e.y = __builtin_amdgcn_exp2f(t.y);
                    const f32x2 d = e + one2; f32x2 rc; rc.x = __builtin_amdgcn_rcpf(d.x); rc.y = __builtin_amdgcn_rcpf(d.y);
                    o[h] = ((gv * r2) * rc) * (uv * q2); }
                if (out8 != 0.f) { int p = 0, q = 0;
                    p = __builtin_amdgcn_cvt_pk_fp8_f32(o[0].x, o[0].y, p, false); p = __builtin_amdgcn_cvt_pk_fp8_f32(o[1].x, o[1].y, p, true);
                    q = __builtin_amdgcn_cvt_pk_fp8_f32(o[2].x, o[2].y, q, false); q = __builtin_amdgcn_cvt_pk_fp8_f32(o[3].x, o[3].y, q, true);
                    pk[ai * 4 + m][0] = (unsigned)p; pk[ai * 4 + m][1] = (unsigned)q; }
                else { u32x4 w; w.x = cvt_pk_bf16(o[0].x, o[0].y); w.y = cvt_pk_bf16(o[1].x, o[1].y); w.z = cvt_pk_bf16(o[2].x, o[2].y); w.w = cvt_pk_bf16(o[3].x, o[3].y);
                    *(PG8_GAS u32x4*)rowp = w; } }
        if (out8 != 0.f) {
#pragma unroll
            for (int k = 0; k < 8; k += 2) {
                typedef unsigned u2v __attribute__((ext_vector_type(2)));
                const u2v sp = __builtin_amdgcn_permlane16_swap(pk[k][0], pk[k + 1][0], false, false), sq = __builtin_amdgcn_permlane16_swap(pk[k][1], pk[k + 1][1], false, false);
                const int kk = k + (fq & 1); const int rowk = row0 + (kk >> 2) * HALF + (kk & 3) * 16;
                u32x4 w; w.x = sp.x; w.y = sq.x; w.z = sp.y; w.w = sq.y;
                *(PG8_GAS u32x4*)((PG8_GAS unsigned char*)O + (size_t)rowk * ldc + (col0 - 8 * (fq & 1))) = w; } }
    }
};
struct EpiResid {
    static constexpr bool PERM = true, AFTER_DRAIN = false;
    float alpha; unsigned hb_off; unsigned ss_off; unsigned h8_off; float h8_i8;
    __device__ __forceinline__ void operator()(const f32x4 (&acc)[2][2][4][2], const Unit& u, int wr, int wc, int fr, int fq) const {
        constexpr int ldc = 2048;
        PG8_GAS unsigned char* wsb = (PG8_GAS unsigned char*)karg64(21); PG8_GAS bf16_t* hb = (PG8_GAS bf16_t*)(wsb + hb_off); PG8_GAS float* ss = (PG8_GAS float*)(wsb + ss_off);
        const int row0 = u.pm * BM + wr * 64 + fr, col0 = u.pn * BM + wc * 32 + 8 * fq; const int lane = fr + 16 * fq;
        u32x4 cur[2], nxt[2];
        { const size_t off = (size_t)row0 * ldc + col0; cur[0] = *(const PG8_GAS u32x4*)(hb + off); cur[1] = *(const PG8_GAS u32x4*)(hb + off + HALF); }
#pragma unroll
        for (int k = 0; k < 8; ++k) { const int ai = k >> 2, m = k & 3; const int row = row0 + ai * HALF + m * 16; const size_t off = (size_t)row * ldc + col0;
            if (k < 7) { const int ai2 = (k + 1) >> 2, m2 = (k + 1) & 3; const size_t off2 = (size_t)(row0 + ai2 * HALF + m2 * 16) * ldc + col0;
                nxt[0] = *(const PG8_GAS u32x4*)(hb + off2); nxt[1] = *(const PG8_GAS u32x4*)(hb + off2 + HALF); }
            float sq = 0.f;
#pragma unroll
            for (int bj = 0; bj < 2; ++bj) { const u32x4 b = cur[bj]; const f32x4 a0 = acc[ai][bj][m][0], a1 = acc[ai][bj][m][1]; u32x4 w;
                w.x = cvt_pk_bf16(__builtin_bit_cast(float, b.x << 16) + a0[0] * alpha, __builtin_bit_cast(float, b.x & 0xffff0000u) + a0[1] * alpha);
                w.y = cvt_pk_bf16(__builtin_bit_cast(float, b.y << 16) + a0[2] * alpha, __builtin_bit_cast(float, b.y & 0xffff0000u) + a0[3] * alpha);
                w.z = cvt_pk_bf16(__builtin_bit_cast(float, b.z << 16) + a1[0] * alpha, __builtin_bit_cast(float, b.z & 0xffff0000u) + a1[1] * alpha);
                w.w = cvt_pk_bf16(__builtin_bit_cast(float, b.w << 16) + a1[2] * alpha, __builtin_bit_cast(float, b.w & 0xffff0000u) + a1[3] * alpha);
                *(PG8_GAS u32x4*)(hb + off + bj * HALF) = w;
                if (h8_off) { typedef unsigned u32x2v __attribute__((ext_vector_type(2))); u32x2v q8; int p = 0;
                    const float e0 = __builtin_bit_cast(float, w.x << 16), e1 = __builtin_bit_cast(float, w.x & 0xffff0000u), e2 = __builtin_bit_cast(float, w.y << 16), e3 = __builtin_bit_cast(float, w.y & 0xffff0000u);
                    const float e4 = __builtin_bit_cast(float, w.z << 16), e5 = __builtin_bit_cast(float, w.z & 0xffff0000u), e6 = __builtin_bit_cast(float, w.w << 16), e7 = __builtin_bit_cast(float, w.w & 0xffff0000u);
                    if (h8_i8 != 0.f) { q8.x = pack4_i8(e0, e1, e2, e3, h8_i8); q8.y = pack4_i8(e4, e5, e6, e7, h8_i8); }
                    else { p = __builtin_amdgcn_cvt_pk_fp8_f32(e0, e1, p, false); p = __builtin_amdgcn_cvt_pk_fp8_f32(e2, e3, p, true); q8.x = (unsigned)p; p = 0;
                        p = __builtin_amdgcn_cvt_pk_fp8_f32(e4, e5, p, false); p = __builtin_amdgcn_cvt_pk_fp8_f32(e6, e7, p, true); q8.y = (unsigned)p; }
                    *(PG8_GAS u32x2v*)(wsb + h8_off + off + bj * HALF) = q8; }
#pragma unroll
                for (int e = 0; e < 4; ++e) { const float lo = __builtin_bit_cast(float, w[e] << 16), hi = __builtin_bit_cast(float, w[e] & 0xffff0000u); sq = fmaf(lo, lo, sq); sq = fmaf(hi, hi, sq); } }
            sq += __builtin_bit_cast(float, __builtin_amdgcn_ds_bpermute((lane ^ 16) << 2, __builtin_bit_cast(int, sq)));
            sq += __builtin_bit_cast(float, __builtin_amdgcn_ds_bpermute((lane ^ 32) << 2, __builtin_bit_cast(int, sq)));
            if (fq == 0) ss[(size_t)row * 32 + u.pn * 4 + wc] = sq;
            cur[0] = nxt[0]; cur[1] = nxt[1]; }
    }
};
template <bool ACC_I32 = false>
struct EpiBf16 {
    static constexpr bool PERM = true, AFTER_DRAIN = false;
    static __device__ __forceinline__ f32x4 cv(const f32x4& a) { if constexpr (ACC_I32) { typedef int i32x4e __attribute__((ext_vector_type(4))); const i32x4e q = __builtin_bit_cast(i32x4e, a); return (f32x4){(float)q[0], (float)q[1], (float)q[2], (float)q[3]}; } else return a; }
    PG8_GAS bf16_t* O; int ldc; const PG8_GAS float* ss; float inv_k, eps; float post_a, post_b, post_c;
    __device__ __forceinline__ void operator()(const f32x4 (&acc)[2][2][4][2], const Unit& u, int wr, int wc, int fr, int fq) const {
        const int row0 = u.pm * BM + wr * 64 + fr, col0 = u.pn * BM + wc * 32 + 8 * fq;
        const float pfac = fmaf(u.pn < 8 ? 1.0f : 0.0f, post_a - post_b, fmaf((u.pn >= 9 && u.pn < 13) ? 1.0f : 0.0f, post_c - post_b, post_b));
        float rs[8]; const int lane_ = fr + 16 * fq;
#pragma unroll
        for (int k = 0; k < 8; ++k) { const PG8_GAS f32x4* p4 = (const PG8_GAS f32x4*)(ss + (size_t)(row0 + (k >> 2) * HALF + (k & 3) * 16) * 32 + 8 * fq); const f32x4 a = p4[0], b = p4[1];
            float t = ((a[0] + a[1]) + (a[2] + a[3])) + ((b[0] + b[1]) + (b[2] + b[3]));
            t += __builtin_bit_cast(float, __builtin_amdgcn_ds_bpermute((lane_ ^ 16) << 2, __builtin_bit_cast(int, t)));
            t += __builtin_bit_cast(float, __builtin_amdgcn_ds_bpermute((lane_ ^ 32) << 2, __builtin_bit_cast(int, t))); rs[k] = t; }
#pragma unroll
        for (int ai = 0; ai < 2; ++ai)
#pragma unroll
            for (int m = 0; m < 4; ++m) { PG8_GAS bf16_t* rowp = O + (size_t)(row0 + ai * HALF + m * 16) * ldc + col0;
                const float r = __builtin_amdgcn_rsqf(rs[ai * 4 + m] * inv_k + eps) * pfac;
#pragma unroll
                for (int bj = 0; bj < 2; ++bj) { const f32x4 v0 = cv(acc[ai][bj][m][0]) * r, v1 = cv(acc[ai][bj][m][1]) * r;
                    u32x4 w; w.x = cvt_pk_bf16(v0[0], v0[1]); w.y = cvt_pk_bf16(v0[2], v0[3]); w.z = cvt_pk_bf16(v1[0], v1[1]); w.w = cvt_pk_bf16(v1[2], v1[3]);
                    *(PG8_GAS u32x4*)(rowp + bj * HALF) = w; } }
    }
};
template <class Epi, class Sched, bool ALIGN_EPI = false, bool SP2 = false, bool F8 = false, bool I8 = false>
__device__ __forceinline__ void gemm_phase(PG8_LAS unsigned char* lds, const Gemm g, const Sched& S, const Epi& E, int tid_in  ) {
    int tid_ = tid_in; asm volatile("" : "+v"(tid_));
    const int tid = tid_, wid = __builtin_amdgcn_readfirstlane(tid >> 6), lane = tid & 63, wr = wid >> 2, wc = wid & 3, fr = lane & 15, fq = lane >> 4;
    const int K = g.K, nt = K / BK;
    unsigned voffA[2], voffB[2];
#pragma unroll
    for (int i = 0; i < 2; ++i) { int R, C; stage_rc(tid * 16 + i * 8192, R, C); const int Rb = Epi::PERM ? ((R & ~31) + perm32(R & 31)) : R;
        voffA[i] = (unsigned)(R * K + C) * 2u; voffB[i] = (unsigned)(Rb * K + C) * 2u; }
    const size_t kstep = (size_t)(BK * 2);
    const size_t hstep = (size_t)HALF * K * 2;
    const size_t tstep = 2 * hstep;
    const unsigned ldsw = (unsigned)wid * 1024u;
    const int aoff = lds_byte(wr * 64 + fr, fq * 8), boff = lds_byte(wc * 32 + fr, fq * 8);
#define PG8_SA(b, h) (((b) * 2 + (h)) * HTB)
#define PG8_SB(b, h) ((4 + (b) * 2 + (h)) * HTB)
#define PG8_STAGE(bufoff, gbase, voff) do { _Pragma("unroll") for (int _i = 0; _i < 2; ++_i) \
        __builtin_amdgcn_global_load_lds((const PG8_GAS unsigned*)((const PG8_GAS char*)(gbase) + (voff)[_i]), (PG8_LAS unsigned*)(lds + (bufoff) + ldsw + _i * 8192), 16, 0, 0); } while (0)
#define PG8_LDA(dst, b, h) do { _Pragma("unroll") for (int m = 0; m < 4; ++m) _Pragma("unroll") for (int k = 0; k < 2; ++k) dst[m][k] = *(const PG8_LAS bf16x8*)(lds + PG8_SA(b, h) + aoff + m * 2048 + k * 1024); } while (0)
#define PG8_LDB(dst, b, h) do { _Pragma("unroll") for (int n = 0; n < 2; ++n) _Pragma("unroll") for (int k = 0; k < 2; ++k) dst[n][k] = *(const PG8_LAS bf16x8*)(lds + PG8_SB(b, h) + boff + n * 2048 + k * 1024); } while (0)
#define PG8_MMA(ai, bj, At, Bt) do { __builtin_amdgcn_s_setprio(1); _Pragma("unroll") for (int m = 0; m < 4; ++m) _Pragma("unroll") for (int n = 0; n < 2; ++n) { \
        if constexpr (F8) { asm volatile("v_mfma_f32_16x16x128_f8f6f4 %0, %1, %2, %0" : "+v"(acc[ai][bj][m][n]) : "v"(cat8(Bt[n][0], Bt[n][1])), "v"(cat8(At[m][0], At[m][1]))); } \
        else if constexpr (I8) { _Pragma("unroll") for (int k = 0; k < 2; ++k) asm volatile("v_mfma_i32_16x16x64_i8 %0, %1, %2, %0" : "+v"(acc[ai][bj][m][n]) : "v"(Bt[n][k]), "v"(At[m][k])); } \
        else { _Pragma("unroll") for (int k = 0; k < 2; ++k) acc[ai][bj][m][n] = __builtin_amdgcn_mfma_f32_16x16x32_bf16(Bt[n][k], At[m][k], acc[ai][bj][m][n], 0, 0, 0); } } \
        __builtin_amdgcn_s_setprio(0); } while (0)
#define PG8_WAIT_V(n) asm volatile("s_waitcnt vmcnt(" #n ")" ::: "memory")
#define PG8_WAIT_L(n) asm volatile("s_waitcnt lgkmcnt(" #n ")" ::: "memory")
#define PG8_BAR __builtin_amdgcn_s_barrier()
#define PG8_SCHED __builtin_amdgcn_sched_barrier(0)
    Unit cur, nxt; int ui = 0;
    if (!S.next(0, cur)) return;
    f32x4 acc[2][2][4][2];
#pragma unroll
    for (int a = 0; a < 2; ++a)
#pragma unroll
        for (int b = 0; b < 2; ++b)
#pragma unroll
            for (int m = 0; m < 4; ++m)
#pragma unroll
                for (int n = 0; n < 2; ++n) acc[a][b][m][n] = (f32x4){0.f, 0.f, 0.f, 0.f};
    bf16x8 At[4][2], B0[2][2], B1[2][2];
    const PG8_GAS char* cA = (const PG8_GAS char*)g.A + (size_t)cur.pm * tstep; const PG8_GAS char* cB = (const PG8_GAS char*)g.Bt + (size_t)cur.pn * tstep;
    S.a_ready(cur);
    if constexpr (SP2) {
        PG8_STAGE(PG8_SB(0, 0), cB, voffB); PG8_STAGE(PG8_SB(0, 1), cB + hstep, voffB); PG8_STAGE(PG8_SA(0, 0), cA, voffA); PG8_STAGE(PG8_SA(0, 1), cA + hstep, voffA);
        if (wr == 1) PG8_BAR;
        PG8_WAIT_V(2); PG8_BAR;
        PG8_STAGE(PG8_SB(1, 0), cB + kstep, voffB); PG8_STAGE(PG8_SA(1, 0), cA + kstep, voffA); PG8_STAGE(PG8_SB(1, 1), cB + hstep + kstep, voffB);
        PG8_WAIT_V(6); PG8_BAR;
    } else {
        PG8_STAGE(PG8_SB(0, 0), cB, voffB); PG8_STAGE(PG8_SA(0, 0), cA, voffA); PG8_STAGE(PG8_SB(0, 1), cB + hstep, voffB); PG8_STAGE(PG8_SA(0, 1), cA + hstep, voffA);
        if (wr == 1) PG8_BAR;
        PG8_WAIT_V(4); PG8_BAR;
        PG8_STAGE(PG8_SB(1, 0), cB + kstep, voffB); PG8_STAGE(PG8_SA(1, 0), cA + kstep, voffA); PG8_STAGE(PG8_SB(1, 1), cB + hstep + kstep, voffB);
        PG8_WAIT_V(6); PG8_BAR;
    }
    for (;;) {
        const bool has_next = S.next(ui + 1, nxt);
        const PG8_GAS char* nA = has_next ? (const PG8_GAS char*)g.A + (size_t)nxt.pm * tstep : cA; const PG8_GAS char* nB = has_next ? (const PG8_GAS char*)g.Bt + (size_t)nxt.pn * tstep : cB;
        for (int t = 0; t < nt; t += 2) {
            const bool last = (t == nt - 2);
            const PG8_GAS char* a1 = cA + (size_t)(t + 1) * kstep;
            const PG8_GAS char* a2 = last ? nA : cA + (size_t)(t + 2) * kstep; const PG8_GAS char* b2 = last ? nB : cB + (size_t)(t + 2) * kstep;
            const PG8_GAS char* a3 = a2 + kstep; const PG8_GAS char* b3 = b2 + kstep;
            if (last && has_next) S.a_ready(nxt);
            if constexpr (SP2) {
            PG8_LDB(B0, 0, 0); PG8_LDB(B1, 0, 1); PG8_SCHED; PG8_LDA(At, 0, 0); PG8_STAGE(PG8_SA(1, 1), a1 + hstep, voffA);
            PG8_WAIT_V(8); PG8_WAIT_L(0); PG8_BAR; PG8_MMA(0, 0, At, B0); PG8_MMA(0, 1, At, B1); PG8_BAR; PG8_SCHED;
            PG8_LDA(At, 0, 1); PG8_STAGE(PG8_SB(0, 0), b2, voffB); PG8_STAGE(PG8_SB(0, 1), b2 + hstep, voffB); PG8_STAGE(PG8_SA(0, 0), a2, voffA);
            PG8_WAIT_V(8); PG8_WAIT_L(0); PG8_BAR; PG8_MMA(1, 0, At, B0); PG8_MMA(1, 1, At, B1); PG8_BAR; PG8_SCHED;
            PG8_LDB(B0, 1, 0); PG8_LDB(B1, 1, 1); PG8_SCHED; PG8_LDA(At, 1, 0); PG8_STAGE(PG8_SA(0, 1), a2 + hstep, voffA);
            PG8_WAIT_V(8); PG8_WAIT_L(0); PG8_BAR; PG8_MMA(0, 0, At, B0); PG8_MMA(0, 1, At, B1); PG8_BAR; PG8_SCHED;
            PG8_LDA(At, 1, 1); PG8_STAGE(PG8_SB(1, 0), b3, voffB); PG8_STAGE(PG8_SB(1, 1), b3 + hstep, voffB); PG8_STAGE(PG8_SA(1, 0), a3, voffA);
            PG8_WAIT_V(8); PG8_WAIT_L(0); PG8_BAR; PG8_MMA(1, 0, At, B0); PG8_MMA(1, 1, At, B1); PG8_BAR; PG8_SCHED;
            } else {
            PG8_LDB(B0, 0, 0); PG8_SCHED; PG8_LDA(At, 0, 0); PG8_STAGE(PG8_SA(1, 1), a1 + hstep, voffA);
            PG8_WAIT_L(8); PG8_BAR; PG8_WAIT_L(0); PG8_MMA(0, 0, At, B0); PG8_BAR; PG8_SCHED;
            PG8_LDB(B1, 0, 1); PG8_STAGE(PG8_SB(0, 0), b2, voffB);
            PG8_BAR; PG8_WAIT_L(0); PG8_MMA(0, 1, At, B1); PG8_BAR;
            PG8_LDA(At, 0, 1); PG8_STAGE(PG8_SA(0, 0), a2, voffA);
            PG8_BAR; PG8_WAIT_L(0); PG8_MMA(1, 0, At, B0); PG8_BAR; PG8_SCHED;
            PG8_STAGE(PG8_SB(0, 1), b2 + hstep, voffB);
            PG8_WAIT_V(6); PG8_BAR; PG8_MMA(1, 1, At, B1); PG8_BAR;
            PG8_LDB(B0, 1, 0); PG8_SCHED; PG8_LDA(At, 1, 0); PG8_STAGE(PG8_SA(0, 1), a2 + hstep, voffA);
            PG8_WAIT_L(8); PG8_BAR; PG8_WAIT_L(0); PG8_MMA(0, 0, At, B0); PG8_BAR; PG8_SCHED;
            PG8_LDB(B1, 1, 1); PG8_STAGE(PG8_SB(1, 0), b3, voffB);
            PG8_BAR; PG8_WAIT_L(0); PG8_MMA(0, 1, At, B1); PG8_BAR;
            PG8_LDA(At, 1, 1); PG8_STAGE(PG8_SA(1, 0), a3, voffA);
            PG8_BAR; PG8_WAIT_L(0); PG8_MMA(1, 0, At, B0); PG8_BAR; PG8_SCHED;
            PG8_STAGE(PG8_SB(1, 1), b3 + hstep, voffB);
            PG8_WAIT_V(6); PG8_BAR; PG8_MMA(1, 1, At, B1); PG8_BAR;
            }
        }
        if constexpr (ALIGN_EPI) { if (wr == 0) PG8_BAR; }
        if constexpr (!Epi::AFTER_DRAIN) { int ln_; asm volatile("v_mbcnt_lo_u32_b32 %0, -1, 0\n\tv_mbcnt_hi_u32_b32 %0, -1, %0" : "=v"(ln_));
            E(acc, cur, wr, wc, ln_ & 15, ln_ >> 4); S.done(cur); }
        if (!has_next) break;
#pragma unroll
        for (int a = 0; a < 2; ++a)
#pragma unroll
            for (int b = 0; b < 2; ++b)
#pragma unroll
                for (int m = 0; m < 4; ++m)
#pragma unroll
                    for (int n = 0; n < 2; ++n) acc[a][b][m][n] = (f32x4){0.f, 0.f, 0.f, 0.f};
        cur = nxt; cA = nA; cB = nB; ++ui;
        if constexpr (ALIGN_EPI) { if (wr == 1) PG8_BAR; }
    }
    PG8_WAIT_V(0);
    if constexpr (!ALIGN_EPI) { if (wr == 0) PG8_BAR; }
    PG8_BAR;
    if constexpr (Epi::AFTER_DRAIN) { E.fused(acc, cur, wr, wc, fr, fq, lds, wid, lane); S.done(cur); }
#undef PG8_SA
#undef PG8_SB
#undef PG8_STAGE
#undef PG8_LDA
#undef PG8_LDB
#undef PG8_MMA
#undef PG8_WAIT_V
#undef PG8_WAIT_L
#undef PG8_BAR
#undef PG8_SCHED
}
}
constexpr int NWAVES = 8;
constexpr int BATCH = 8, SEQ = 4096, D = 2048, FF = 5632, DEPTH = 2;
constexpr int M = BATCH * SEQ;
constexpr int NGU = 2 * FF;
constexpr int H_A = 8, HD_A = 128, RANK = 256, IH = 8, IDIM = 64, TOPK = 256;
constexpr int H_B = 16, KVH = 2, GQA = 8, HD_B = 64, WINDOW = 128;
constexpr int D_IN = 3144;
constexpr float EPS = 1e-6f;
constexpr size_t MiB = 1u << 20;
constexpr size_t WS_CTL = 0, CTL_ZERO_BYTES = 1 * MiB;
#ifndef F8_MASK
#define F8_MASK 0xF
#endif
constexpr float W8_SCALE = 64.0f;
#ifndef GU_I8
#define GU_I8 1
#endif
constexpr float H8I_SCALE = 127.0f / 4.6f, W8I_SCALE = 127.0f / (4.2f * 0.022097086912079608f);
#ifndef D8_MASK
#define D8_MASK 0xF
#endif
constexpr float A8_SCALE = 8.0f;
__host__ __device__ constexpr bool d8_on(int l, int f) { return ((D8_MASK >> (2 * l + f)) & 1) != 0; }
constexpr float O8_SCALE = 16.0f;
#ifndef OUT_F8
#define OUT_F8 1
#endif
constexpr bool F8_ALL1 = (F8_MASK & 0x5) == 0x5, F8_ALL2 = (F8_MASK & 0xA) == 0xA;
__host__ __device__ constexpr bool f8_on(int l, int f) { return ((F8_MASK >> (2 * l + f)) & 1) != 0; }
constexpr size_t GU1_B = (F8_ALL1 ? 22 : 44) * MiB, GU2_B = (F8_ALL2 ? 22 : 44) * MiB;
constexpr size_t WS_W0 = 2 * MiB;
constexpr size_t WO_GU1 = 0, WO_D1 = GU1_B, WO_GU2 = WO_D1 + 22 * MiB, WO_D2 = WO_GU2 + GU2_B, WO_IN = WO_D2 + 22 * MiB, WO_OUT = WO_IN + 17 * MiB, W_LAYER = WO_OUT + 12 * MiB;
constexpr size_t WS_XN = WS_W0 + 2 * W_LAYER;
constexpr size_t WS_HB8 = WS_XN + 128 * MiB;
constexpr size_t WS_ACT = WS_HB8 + (F8_MASK ? 64 : 0) * MiB;
constexpr size_t WS_Z = WS_ACT, WS_CKVN = WS_ACT + 272 * MiB, WS_KIN = WS_ACT + 288 * MiB, WS_WIF = WS_ACT + 292 * MiB, WS_IDX = WS_ACT + 294 * MiB;
constexpr int ZLD = 4352, ZC_QLAT = 0, ZC_CKV = 2048, ZC_QB = 2304, ZC_KB = 3328, ZC_VB = 3456, ZC_QI = 3584, ZC_KI = 4096, ZC_WI = 4160;
constexpr int ZN8 = 3584;
#ifndef IN_I8
#define IN_I8 1
#endif
constexpr float WQ8I_SCALE = 127.0f / (4.2f * 0.015625f);
constexpr int OLD = 3072;
constexpr size_t WS_O = WS_ACT + 352 * MiB;
constexpr size_t WS_SS = WS_O + (OUT_F8 ? 96 : 192) * MiB, SS_BYTES = 4 * MiB;
constexpr size_t WS_SCR = WS_SS + 2 * SS_BYTES;
constexpr size_t SCR_TILES = 128 * 129 / 2, SCR_BYTES = (size_t)8 * SCR_TILES * 8 * 64 * 4;
constexpr size_t WS_END = WS_SCR + SCR_BYTES;
static_assert(WS_END <= 1024 * MiB, "d_ws map exceeds 1 GiB");
constexpr int CW_TMO = 0, CW_CODE = 1, CW_BAR = 4096, CW_XRANK = 8192;
constexpr int RING_OFF = 0, RING_BYTES = 131072;
constexpr int LDSCTL_OFF = RING_BYTES, MISC_OFF = LDSCTL_OFF + 320;
constexpr int LDS_BYTES = 147456;
constexpr int RSL_OFF = RING_BYTES + 5632;
#define GAS __attribute__((address_space(1)))
#define LAS __attribute__((address_space(3)))
typedef unsigned short bf16;
typedef unsigned v4u __attribute__((ext_vector_type(4)));
typedef float f32x4 __attribute__((ext_vector_type(4)));
typedef short bf16x8 __attribute__((ext_vector_type(8)));
typedef GAS unsigned gu32;
typedef GAS unsigned long long gu64;
#define RLX_AGENT __ATOMIC_RELAXED, __HIP_MEMORY_SCOPE_AGENT
#define LDS_WAIT() asm volatile("s_waitcnt lgkmcnt(0)" ::: "memory")
#define VM_WAIT() asm volatile("s_waitcnt vmcnt(0)" ::: "memory")
__device__ __forceinline__ unsigned long long rt() { return __builtin_amdgcn_s_memrealtime(); }
__device__ __forceinline__ unsigned f2bf(float f) { unsigned u = __builtin_bit_cast(unsigned, f); return (u + 0x7fffu + ((u >> 16) & 1u)) >> 16; }
__device__ __forceinline__ unsigned pk2(float lo, float hi) { return f2bf(lo) | (f2bf(hi) << 16); }

#define XB_TMO      128
#define XB_XCNT(j)  (256  + 64 * (j))
#define XB_XSUB(j)  (1280 + 64 * (j))
#define XB_XGEN(j)  (2304 + 64 * (j))
#define XB_TOP      3328
#define XB_TOPGEN   3392
#define XCD_BAR_WORDS 3456
#define XB_SPIN_CAP (1u << 18)

__device__ __forceinline__ unsigned xb_ld(unsigned* p)              { return __hip_atomic_load(p, __ATOMIC_RELAXED, __HIP_MEMORY_SCOPE_AGENT); }
__device__ __forceinline__ unsigned xb_add(unsigned* p, unsigned v) { return __hip_atomic_fetch_add(p, v, __ATOMIC_RELAXED, __HIP_MEMORY_SCOPE_AGENT); }
__device__ __forceinline__ unsigned xb_xcc_id() { return (unsigned)__builtin_amdgcn_s_getreg((3 << 11) | 20) & 0xFu; }
#define XB_SPIN(cond, bar) do { unsigned _sp = 0; while (cond) { __builtin_amdgcn_s_sleep(1); \
    if ((++_sp & 255u) == 0u) { if (xb_ld(&(bar)[XB_TMO])) break; if (_sp > XB_SPIN_CAP) { atomicAdd(&(bar)[XB_TMO], 1u); break; } } } } while (0)

struct XcdBarrier {
    unsigned* bar; unsigned x;
    volatile LAS unsigned* st;
};

__device__ __forceinline__ XcdBarrier xcd_barrier_post(unsigned* bar, volatile LAS unsigned* st, bool leader  ) {
    XcdBarrier b; b.bar = bar; b.x = xb_xcc_id(); b.st = st;
    if (leader) (void)xb_add(&bar[XB_XCNT(b.x)], 1u);
    return b;
}
__device__ __forceinline__ void xcd_barrier_complete(unsigned* bar, unsigned x, unsigned& nloc, unsigned& nx) {
    const unsigned G = gridDim.x * gridDim.y * gridDim.z;
    unsigned sum, cnt, mine, sp = 0u;
    for (;;) {
        sum = 0u; cnt = 0u; mine = 0u;
#pragma unroll
        for (unsigned j = 0; j < 16; ++j) { const unsigned c = xb_ld(&bar[XB_XCNT(j)]); sum += c; cnt += (c > 0u) ? 1u : 0u; mine = (j == x) ? c : mine; }
        if (sum == G) break;
        __builtin_amdgcn_s_sleep(1);
        if ((++sp & 255u) == 0u) { if (xb_ld(&bar[XB_TMO])) break; if (sp > XB_SPIN_CAP) { atomicAdd(&bar[XB_TMO], 1u); break; } }
    }
    nloc = mine > 0u ? mine : 1u; nx = cnt > 0u ? cnt : 1u;
}

__device__ __forceinline__ void xcd_barrier(const XcdBarrier& b, bool leader  ) {
    asm volatile("s_waitcnt vmcnt(0)" ::: "memory");
    __syncthreads();
    if (leader) {
        unsigned* bar = b.bar;
        __builtin_amdgcn_s_waitcnt(0);
        unsigned nloc = b.st[0], nx = b.st[1];
        if (nloc == 0u) { xcd_barrier_complete(bar, b.x, nloc, nx); b.st[0] = nloc; b.st[1] = nx; }
        const unsigned old = xb_add(&bar[XB_XSUB(b.x)], 1u);
        const unsigned gen = old / nloc;
        if (old + 1u == (gen + 1u) * nloc) {
            __builtin_amdgcn_fence(__ATOMIC_RELEASE, "agent");
            asm volatile("s_waitcnt vmcnt(0)" ::: "memory");
            const unsigned og = xb_add(&bar[XB_TOP], 1u);
            const unsigned tg = og / nx;
            if (og + 1u == (tg + 1u) * nx) xb_add(&bar[XB_TOPGEN], 1u);
            else XB_SPIN(xb_ld(&bar[XB_TOPGEN]) == tg, bar);
            __builtin_amdgcn_fence(__ATOMIC_ACQUIRE, "agent");
            xb_add(&bar[XB_XGEN(b.x)], 1u);
            asm volatile("s_waitcnt vmcnt(0)" ::: "memory");
        } else {
            XB_SPIN(xb_ld(&bar[XB_XGEN(b.x)]) == gen, bar);
            __builtin_amdgcn_fence(__ATOMIC_ACQUIRE, "agent");
            asm volatile("s_waitcnt vmcnt(0)" ::: "memory");
        }
    }
    __syncthreads();
}
__constant__ unsigned char T5_BUCKET[128] = {0, 1, 2, 3, 4, 5, 6, 7, 8, 9, 10, 11, 12, 13, 14, 15, 16, 16, 16, 17, 17, 18, 18, 18, 19, 19, 19, 20, 20, 20, 20, 21, 21, 21, 21, 22, 22, 22, 22, 22, 23, 23, 23, 23, 23, 23, 24, 24, 24, 24, 24, 24, 25, 25, 25, 25, 25, 25, 25, 26, 26, 26, 26, 26, 26, 26, 26, 27, 27, 27, 27, 27, 27, 27, 27, 27, 27, 28, 28, 28, 28, 28, 28, 28, 28, 28, 28, 29, 29, 29, 29, 29, 29, 29, 29, 29, 29, 29, 29, 30, 30, 30, 30, 30, 30, 30, 30, 30, 30, 30, 30, 30, 30, 31, 31, 31, 31, 31, 31, 31, 31, 31, 31, 31, 31, 31, 31, 31};
typedef short s16x4 __attribute__((ext_vector_type(4)));
typedef float f32x16 __attribute__((ext_vector_type(16)));
__device__ __forceinline__ float bf2f(unsigned short b) { return __builtin_bit_cast(float, (unsigned)b << 16); }
__device__ __forceinline__ bf16x8 cat4(s16x4 lo, s16x4 hi) { return __builtin_shufflevector(lo, hi, 0, 1, 2, 3, 4, 5, 6, 7); }
__device__ __forceinline__ void tr_read4(unsigned a0, unsigned a1, unsigned a2, unsigned a3, s16x4& r0, s16x4& r1, s16x4& r2, s16x4& r3) {
    asm volatile("ds_read_b64_tr_b16 %0, %4\n\tds_read_b64_tr_b16 %1, %5\n\tds_read_b64_tr_b16 %2, %6\n\tds_read_b64_tr_b16 %3, %7\n\ts_waitcnt lgkmcnt(0)"
                 : "=&v"(r0), "=&v"(r1), "=&v"(r2), "=&v"(r3) : "v"(a0), "v"(a1), "v"(a2), "v"(a3) : "memory");
}
#define SHX(x, o) __builtin_bit_cast(float, __builtin_amdgcn_ds_bpermute(((lane) ^ (o)) << 2, __builtin_bit_cast(int, (float)(x))))
#define SHXU(x, o) ((unsigned)__builtin_amdgcn_ds_bpermute(((lane) ^ (o)) << 2, (int)(x)))
__device__ __forceinline__ float wave_sum(float v, int lane) {
#pragma unroll
    for (int o = 1; o < 64; o <<= 1) v += SHX(v, o);
    return v;
}
template <int OUT8 = 0>
__device__ __forceinline__ void conv_item(const GAS float* W, int ldw, int k0, int c0, int nvalid, GAS bf16* dst, int dld, int drow0, int dk0, float scale, const GAS float* gain, LAS float* scr, int lane) {
    const int c = lane & 31;
    float vin[32];
#pragma unroll
    for (int i = 0; i < 32; ++i) { const int kk = 2 * i + (lane >> 5); vin[i] = 0.f;
        if (c < nvalid) vin[i] = W[(size_t)(k0 + kk) * ldw + c0 + c]; }
#pragma unroll
    for (int i = 0; i < 32; ++i) { const int kk = 2 * i + (lane >> 5); scr[kk * 33 + c] = vin[i] * scale; }
    LDS_WAIT(); asm volatile("" ::: "memory");
    const int c8 = lane & 7;
    f32x4 ga = {1.f, 1.f, 1.f, 1.f}, gb = {1.f, 1.f, 1.f, 1.f};
    if (gain) { ga = *(const GAS f32x4*)(gain + k0 + 8 * c8); gb = *(const GAS f32x4*)(gain + k0 + 8 * c8 + 4); }
#pragma unroll
    for (int j = 0; j < 4; ++j) { const int n = (lane >> 3) + 8 * j; const LAS float* s = scr + (8 * c8) * 33 + n;
        if constexpr (OUT8 == 2) { const unsigned p = pg8::pack4_i8(s[0 * 33] * ga.x, s[1 * 33] * ga.y, s[2 * 33] * ga.z, s[3 * 33] * ga.w, 1.0f), q = pg8::pack4_i8(s[4 * 33] * gb.x, s[5 * 33] * gb.y, s[6 * 33] * gb.z, s[7 * 33] * gb.w, 1.0f);
            *(GAS unsigned long long*)((GAS unsigned char*)dst + (size_t)(drow0 + n) * dld + dk0 + k0 + 8 * c8) = (unsigned long long)p | ((unsigned long long)q << 32); }
        else if constexpr (OUT8 == 1) { int p = 0, q = 0;
            p = __builtin_amdgcn_cvt_pk_fp8_f32(s[0 * 33] * ga.x, s[1 * 33] * ga.y, p, false); p = __builtin_amdgcn_cvt_pk_fp8_f32(s[2 * 33] * ga.z, s[3 * 33] * ga.w, p, true);
            q = __builtin_amdgcn_cvt_pk_fp8_f32(s[4 * 33] * gb.x, s[5 * 33] * gb.y, q, false); q = __builtin_amdgcn_cvt_pk_fp8_f32(s[6 * 33] * gb.z, s[7 * 33] * gb.w, q, true);
            *(GAS unsigned long long*)((GAS unsigned char*)dst + (size_t)(drow0 + n) * dld + dk0 + k0 + 8 * c8) = (unsigned long long)(unsigned)p | ((unsigned long long)(unsigned)q << 32); }
        else { v4u o; o.x = pk2(s[0 * 33] * ga.x, s[1 * 33] * ga.y); o.y = pk2(s[2 * 33] * ga.z, s[3 * 33] * ga.w); o.z = pk2(s[4 * 33] * gb.x, s[5 * 33] * gb.y); o.w = pk2(s[6 * 33] * gb.z, s[7 * 33] * gb.w);
            *(GAS v4u*)(dst + (size_t)(drow0 + n) * dld + dk0 + k0 + 8 * c8) = o; } }
    LDS_WAIT(); asm volatile("" ::: "memory");
}
__device__ __forceinline__ void rmsnorm_rows_bf16(const GAS float* X, const GAS float* g, GAS bf16* O, int gw, int NGW, int lane) {
    f32x4 gv[8];
#pragma unroll
    for (int j = 0; j < 8; ++j) gv[j] = ((const GAS f32x4*)g)[lane + 64 * j];
    for (int m = gw; m < M; m += NGW) {
        const GAS f32x4* xr = (const GAS f32x4*)(X + (size_t)m * D) + lane;
        f32x4 v[8]; float s = 0.f;
#pragma unroll
        for (int j = 0; j < 8; ++j) { v[j] = xr[64 * j]; s += (v[j].x * v[j].x + v[j].y * v[j].y) + (v[j].z * v[j].z + v[j].w * v[j].w); }
        const float r = 1.0f / sqrtf(wave_sum(s, lane) * (1.0f / D) + EPS);
        GAS unsigned long long* o8 = (GAS unsigned long long*)(O + (size_t)m * D) + lane;
#pragma unroll
        for (int j = 0; j < 8; ++j) { const f32x4 y = v[j] * r * gv[j]; o8[64 * j] = (unsigned long long)pk2(y.x, y.y) | ((unsigned long long)pk2(y.z, y.w) << 32); }
    }
}
__device__ __forceinline__ void rows_bf16_ss(const GAS float* X, GAS bf16* O, GAS unsigned char* O8, GAS float* ss, int gw, int NGW, int lane) {
    for (int m = gw; m < M; m += NGW) {
        const GAS f32x4* xr = (const GAS f32x4*)(X + (size_t)m * D) + lane;
        f32x4 v[8]; float s = 0.f;
#pragma unroll
        for (int j = 0; j < 8; ++j) { v[j] = xr[64 * j]; s += (v[j].x * v[j].x + v[j].y * v[j].y) + (v[j].z * v[j].z + v[j].w * v[j].w); }
        s = wave_sum(s, lane);
        GAS unsigned long long* o8 = (GAS unsigned long long*)(O + (size_t)m * D) + lane;
#pragma unroll
        for (int j = 0; j < 8; ++j) o8[64 * j] = (unsigned long long)pk2(v[j].x, v[j].y) | ((unsigned long long)pk2(v[j].z, v[j].w) << 32);
        if (O8) { GAS unsigned* q8 = (GAS unsigned*)(O8 + (size_t)m * D) + lane;
#pragma unroll
            for (int j = 0; j < 8; ++j) { if constexpr (GU_I8) q8[64 * j] = pg8::pack4_i8(v[j].x, v[j].y, v[j].z, v[j].w, H8I_SCALE); else { int p = 0; p = __builtin_amdgcn_cvt_pk_fp8_f32(v[j].x, v[j].y, p, false); p = __builtin_amdgcn_cvt_pk_fp8_f32(v[j].z, v[j].w, p, true); q8[64 * j] = (unsigned)p; } } }
        if (lane < 32) ss[(size_t)m * 32 + lane] = lane == 0 ? s : 0.f;
    }
}
__device__ __forceinline__ void final_rows(const GAS bf16* HB, GAS float* OUT, const GAS float* g, const GAS float* ss, int gw, int NGW, int lane) {
    f32x4 gv[8];
#pragma unroll
    for (int j = 0; j < 8; ++j) gv[j] = ((const GAS f32x4*)g)[lane + 64 * j];
    for (int m = gw; m < M; m += NGW) {
        const GAS unsigned long long* hr = (const GAS unsigned long long*)(HB + (size_t)m * D) + lane; GAS f32x4* orow = (GAS f32x4*)(OUT + (size_t)m * D) + lane;
        unsigned long long raw[8];
#pragma unroll
        for (int j = 0; j < 8; ++j) raw[j] = hr[64 * j];
        const float r = 1.0f / sqrtf(wave_sum(lane < 32 ? ss[(size_t)m * 32 + lane] : 0.f, lane) * (1.0f / D) + EPS);
#pragma unroll
        for (int j = 0; j < 8; ++j) { const unsigned lo = (unsigned)raw[j], hi = (unsigned)(raw[j] >> 32);
            f32x4 v = {__builtin_bit_cast(float, lo << 16), __builtin_bit_cast(float, lo & 0xffff0000u), __builtin_bit_cast(float, hi << 16), __builtin_bit_cast(float, hi & 0xffff0000u)};
            orow[64 * j] = v * r * gv[j]; }
    }
}
__device__ __forceinline__ void rmsnorm_rows_f32_inplace(GAS float* X, const GAS float* g, int gw, int NGW, int lane) {
    f32x4 gv[8];
#pragma unroll
    for (int j = 0; j < 8; ++j) gv[j] = ((const GAS f32x4*)g)[lane + 64 * j];
    for (int m = gw; m < M; m += NGW) {
        GAS f32x4* xr = (GAS f32x4*)(X + (size_t)m * D) + lane;
        f32x4 v[8]; float s = 0.f;
#pragma unroll
        for (int j = 0; j < 8; ++j) { v[j] = xr[64 * j]; s += (v[j].x * v[j].x + v[j].y * v[j].y) + (v[j].z * v[j].z + v[j].w * v[j].w); }
        const float r = 1.0f / sqrtf(wave_sum(s, lane) * (1.0f / D) + EPS);
#pragma unroll
        for (int j = 0; j < 8; ++j) xr[64 * j] = v[j] * r * gv[j];
    }
}

template <bool P_IFAST, int OUT8 = 0>
__device__ __forceinline__ void absorb_unit(const GAS float* Psrc, size_t p_ri, size_t p_rd, const GAS float* Qsrc, size_t q_rj, GAS bf16* out, size_t out_ld, float scale, const GAS float* qgain, LAS float* Ps_, LAS float* Qs_, int tid) {
    LAS bf16* Ps = (LAS bf16*)Ps_; LAS bf16* Qs = Ps + 64 * 136;
    float pv[16], qv[16];
#pragma unroll
    for (int j = 0; j < 16; ++j) { const int e = tid + 512 * j; const int i = P_IFAST ? (e & 63) : (e >> 7), d = P_IFAST ? (e >> 6) : (e & 127);
        pv[j] = Psrc[(size_t)i * p_ri + (size_t)d * p_rd];
        const int jj = e >> 7, dd = e & 127; qv[j] = Qsrc[(size_t)jj * q_rj + dd] * (qgain ? qgain[jj] : 1.0f); }
#pragma unroll
    for (int j = 0; j < 16; ++j) { const int e = tid + 512 * j; const int i = P_IFAST ? (e & 63) : (e >> 7), d = P_IFAST ? (e >> 6) : (e & 127);
        Ps[i * 136 + d] = (bf16)f2bf(pv[j]); const int jj = e >> 7, dd = e & 127; Qs[jj * 136 + dd] = (bf16)f2bf(qv[j]); }
    __syncthreads();
    const int wv = tid >> 6, ln = tid & 63, it = wv >> 1, r16 = ln & 15, g = ln >> 4;
#pragma unroll
    for (int jq = 0; jq < 2; ++jq) { const int jt = 2 * (wv & 1) + jq; f32x4 acc = {0.f, 0.f, 0.f, 0.f};
#pragma unroll
        for (int st = 0; st < 4; ++st) { const bf16x8 a = *(const LAS bf16x8*)(Ps + (16 * it + r16) * 136 + 32 * st + 8 * g); const bf16x8 b = *(const LAS bf16x8*)(Qs + (16 * jt + r16) * 136 + 32 * st + 8 * g);
            acc = __builtin_amdgcn_mfma_f32_16x16x32_bf16(a, b, acc, 0, 0, 0); }
#pragma unroll
        for (int rg = 0; rg < 4; ++rg) { const size_t o = (size_t)(16 * it + 4 * g + rg) * out_ld + 16 * jt + r16;
            if constexpr (OUT8 == 2) ((GAS unsigned char*)out)[o] = (unsigned char)(pg8::pack4_i8(acc[rg], 0.f, 0.f, 0.f, scale) & 0xffu);
            else if constexpr (OUT8 == 1) ((GAS unsigned char*)out)[o] = (unsigned char)__builtin_amdgcn_cvt_pk_fp8_f32(acc[rg] * scale, 0.f, 0, false);
            else out[o] = (bf16)f2bf(acc[rg] * scale); } }
    __syncthreads();
}
__device__ __forceinline__ void post_rows(const GAS bf16* Z, const GAS float* gkv, const GAS float* gki, const GAS float* bki, GAS bf16* CKVN, GAS bf16* KIN, GAS float* WIF, int gw, int NGW, int lane) {
    const f32x4 g4 = ((const GAS f32x4*)gkv)[lane]; const float gk = gki[lane], bk = bki[lane];
    for (int m = gw; m < M; m += NGW) {
        const GAS bf16* zr = Z + (size_t)m * ZLD;
        const unsigned long long raw = *(const GAS unsigned long long*)(zr + ZC_CKV + 4 * lane);
        const float kraw = bf2f(zr[ZC_KI + lane]);
        const float wraw = bf2f(zr[ZC_WI + (lane & 7)]);
        const float c0 = bf2f((unsigned short)raw), c1 = bf2f((unsigned short)(raw >> 16)), c2 = bf2f((unsigned short)(raw >> 32)), c3 = bf2f((unsigned short)(raw >> 48));
        const float r = 1.0f / sqrtf(wave_sum((c0 * c0 + c1 * c1) + (c2 * c2 + c3 * c3), lane) * (1.0f / RANK) + EPS);
        *(GAS unsigned long long*)(CKVN + (size_t)m * RANK + 4 * lane) = (unsigned long long)pk2(c0 * r * g4.x, c1 * r * g4.y) | ((unsigned long long)pk2(c2 * r * g4.z, c3 * r * g4.w) << 32);
        const float mu = wave_sum(kraw, lane) * (1.0f / IDIM); const float dv = kraw - mu;
        const float var = wave_sum(dv * dv, lane) * (1.0f / IDIM);
        KIN[(size_t)m * IDIM + lane] = (bf16)f2bf(dv * (1.0f / sqrtf(var + EPS)) * gk + bk);
        if (lane < 8) WIF[(size_t)m * IH + lane] = wraw;
    }
}
constexpr int SWA_KP = 144, SWA_VP = 192;
constexpr int SWA_K_OFF = 0, SWA_V_OFF = 160 * SWA_KP, SWA_TAB_OFF = SWA_V_OFF + 160 * SWA_VP;
static_assert(SWA_TAB_OFF + 16 * 128 * 4 <= RING_BYTES, "SWA LDS map");
__device__ __forceinline__ void swa_phase(LAS unsigned char* lds, const GAS bf16* Z, GAS bf16* O, const GAS float* rel_bias, const GAS float* sinks, int vcu, int G, int tid, int lane, int wave) {
    LAS float* tab = (LAS float*)(lds + SWA_TAB_OFF);
    for (int e = tid; e < 16 * 128; e += NWAVES * 64) { const int h = e >> 7, dist = e & 127; tab[e] = rel_bias[(int)T5_BUCKET[dist] * 24 + H_A + h]; }
    __syncthreads();
    const int q = lane & 31, hh = lane >> 5;
    const unsigned ldsb = (unsigned)(size_t)lds;
    for (int item = vcu; item < BATCH * 128 * KVH; item += G) {
        const int kvh = item & 1, qt = (item >> 1) & 127, b = item >> 8;
        const int t0 = 32 * qt, s0 = t0 - 128;
        const size_t rowbase = (size_t)b * SEQ;
        for (int c = tid; c < 1280; c += NWAVES * 64) { const int row = c >> 3, ch = c & 7; const int s = s0 + row;
            if (s >= 0) { const GAS bf16* zr = Z + (rowbase + s) * ZLD + kvh * 64 + ch * 8;
                const v4u kv = *(const GAS v4u*)(zr + ZC_KB); const v4u vv = *(const GAS v4u*)(zr + ZC_VB);
                *(LAS v4u*)(lds + SWA_K_OFF + row * SWA_KP + ch * 16) = kv; *(LAS v4u*)(lds + SWA_V_OFF + row * SWA_VP + ch * 16) = vv; } }
        const int hq = kvh * 8 + wave; const int t = t0 + q;
        bf16x8 qf[4];
#pragma unroll
        for (int st = 0; st < 4; ++st) qf[st] = *(const GAS bf16x8*)(Z + (rowbase + t) * ZLD + ZC_QB + hq * 64 + 16 * st + 8 * hh);
        __syncthreads();
        const int kt0 = qt >= 4 ? 0 : 4 - qt;
        f32x16 sacc[5];
#pragma unroll
        for (int kt = 0; kt < 5; ++kt) {
#pragma unroll
            for (int r = 0; r < 16; ++r) sacc[kt][r] = 0.f;
            if (kt >= kt0) {
#pragma unroll
                for (int st = 0; st < 4; ++st) { const bf16x8 kf = *(const LAS bf16x8*)(lds + SWA_K_OFF + (kt * 32 + q) * SWA_KP + (2 * st + hh) * 16);
                    sacc[kt] = __builtin_amdgcn_mfma_f32_32x32x16_bf16(kf, qf[st], sacc[kt], 0, 0, 0); } } }
        const float sink = sinks[hq]; float mx = sink;
        const LAS float* tabh = tab + hq * 128;
#pragma unroll
        for (int kt = 0; kt < 5; ++kt) if (kt >= kt0) {
#pragma unroll
            for (int r = 0; r < 16; ++r) { const int ko = (r & 3) + 8 * (r >> 2) + 4 * hh; const int dist = q + 128 - 32 * kt - ko;
                const float lg = (dist >= 0 && dist < WINDOW) ? sacc[kt][r] + tabh[dist & 127] : -1e30f; sacc[kt][r] = lg; mx = fmaxf(mx, lg); } }
        mx = fmaxf(mx, SHX(mx, 32));
        float l = 0.f;
#pragma unroll
        for (int kt = 0; kt < 5; ++kt) if (kt >= kt0) {
#pragma unroll
            for (int r = 0; r < 16; ++r) { const float p = __expf(sacc[kt][r] - mx); sacc[kt][r] = p; l += p; } }
        l += SHX(l, 32); l += __expf(sink - mx);
        f32x16 oacc[2];
#pragma unroll
        for (int dt = 0; dt < 2; ++dt)
#pragma unroll
            for (int r = 0; r < 16; ++r) oacc[dt][r] = 0.f;
        const unsigned vlane = ldsb + SWA_V_OFF + (unsigned)((4 * hh + ((lane & 15) >> 2)) * SWA_VP + (16 * ((lane >> 4) & 1) + 4 * (lane & 3)) * 2);
#pragma unroll
        for (int kt = 0; kt < 5; ++kt) if (kt >= kt0) {
#pragma unroll
            for (int s2 = 0; s2 < 2; ++s2) {
                bf16x8 pf; { const unsigned w0 = pg8::cvt_pk_bf16(sacc[kt][8 * s2 + 0], sacc[kt][8 * s2 + 1]), w1 = pg8::cvt_pk_bf16(sacc[kt][8 * s2 + 2], sacc[kt][8 * s2 + 3]),
                                     w2 = pg8::cvt_pk_bf16(sacc[kt][8 * s2 + 4], sacc[kt][8 * s2 + 5]), w3 = pg8::cvt_pk_bf16(sacc[kt][8 * s2 + 6], sacc[kt][8 * s2 + 7]);
                    const v4u w = {w0, w1, w2, w3}; pf = __builtin_bit_cast(bf16x8, w); }
                const unsigned a = vlane + (unsigned)((kt * 32 + 16 * s2) * SWA_VP);
                s16x4 r0, r1, r2, r3; tr_read4(a, a + 8 * SWA_VP, a + 64, a + 8 * SWA_VP + 64, r0, r1, r2, r3);
                oacc[0] = __builtin_amdgcn_mfma_f32_32x32x16_bf16(cat4(r0, r1), pf, oacc[0], 0, 0, 0);
                oacc[1] = __builtin_amdgcn_mfma_f32_32x32x16_bf16(cat4(r2, r3), pf, oacc[1], 0, 0, 0); } }
        const float inv = (OUT_F8 ? O8_SCALE : 1.0f) / l;
        if constexpr (OUT_F8) { GAS unsigned char* orow = (GAS unsigned char*)O + (rowbase + t) * OLD + 2048 + hq * 64 + 4 * hh;
#pragma unroll
            for (int dt = 0; dt < 2; ++dt)
#pragma unroll
                for (int g4 = 0; g4 < 4; ++g4) { int p = 0; p = __builtin_amdgcn_cvt_pk_fp8_f32(oacc[dt][4 * g4] * inv, oacc[dt][4 * g4 + 1] * inv, p, false); p = __builtin_amdgcn_cvt_pk_fp8_f32(oacc[dt][4 * g4 + 2] * inv, oacc[dt][4 * g4 + 3] * inv, p, true);
                    *(GAS unsigned*)(orow + 32 * dt + 8 * g4) = (unsigned)p; } }
        else { GAS bf16* orow = O + (rowbase + t) * OLD + 2048 + hq * 64 + 4 * hh;
#pragma unroll
        for (int dt = 0; dt < 2; ++dt)
#pragma unroll
            for (int g4 = 0; g4 < 4; ++g4) { const unsigned long long w = (unsigned long long)pk2(oacc[dt][4 * g4] * inv, oacc[dt][4 * g4 + 1] * inv) | ((unsigned long long)pk2(oacc[dt][4 * g4 + 2] * inv, oacc[dt][4 * g4 + 3] * inv) << 32);
                *(GAS unsigned long long*)(orow + 32 * dt + 8 * g4) = w; } }
        __syncthreads();
    }
}
constexpr int TK_BINS = 512, TK_CAP = 256;
#define LDS_ADD(p) __hip_atomic_fetch_add((p), 1u, __ATOMIC_RELAXED, __HIP_MEMORY_SCOPE_WORKGROUP)
#define LDS_ADDV(p, v) __hip_atomic_fetch_add((p), (v), __ATOMIC_RELAXED, __HIP_MEMORY_SCOPE_WORKGROUP)
#define HIST_WORD(tok, bin) (((tok) * TK_BINS + (bin)) >> 1)
#define HIST_INC(bin) (1u << (((bin) & 1) * 16))
constexpr int TK_HIST_OFF = 0, TK_CSC_OFF = 32768, TK_CIX_OFF = TK_CSC_OFF + 32 * TK_CAP * 4, TK_SEL_OFF = TK_CIX_OFF + 32 * TK_CAP * 2, TK_CNT_OFF = TK_SEL_OFF + 32 * 256 * 2, TK_DUM_OFF = TK_CNT_OFF + 32 * 2 * 4, TK_KB_OFF = TK_DUM_OFF + 8 * 64 * 4, TK_KB_BYTES = 64 * 144, TK_FLAG_OFF = TK_KB_OFF + 2 * TK_KB_BYTES;
static_assert(TK_FLAG_OFF + 16 <= RING_BYTES, "top-k LDS map");
typedef _Float16 tk_h2 __attribute__((ext_vector_type(2)));
__device__ __forceinline__ void tk_score2(const f32x16& acc, const tk_h2 (&wh)[8], float& s0, float& s1) {
    tk_h2 s = {(_Float16)0, (_Float16)0}; const tk_h2 zero = {(_Float16)0, (_Float16)0};
#pragma unroll
    for (int h = 0; h < 8; ++h) { tk_h2 d = __builtin_bit_cast(tk_h2, __builtin_amdgcn_cvt_pkrtz(acc[h], acc[8 + h])); d = __builtin_elementwise_max(d, zero); s = __builtin_elementwise_fma(wh[h], d, s); }
    s0 = (float)s.x; s1 = (float)s.y;
}
__device__ __forceinline__ float tk_x(float s, float sc) { return fmaf(s, sc, 256.0f); }
__device__ __forceinline__ int tk_key(float s, float sc) {
    const float x = tk_x(s, sc); int b0 = (int)x; b0 = b0 < 0 ? 0 : (b0 > TK_BINS - 1 ? TK_BINS - 1 : b0);
    int sub = (int)((x - (float)b0) * 512.0f); sub = sub < 0 ? 0 : (sub > 511 ? 511 : sub);
    return b0 * 512 + sub;
}
__device__ __forceinline__ void tk_find(const LAS unsigned* h, unsigned need, int lane, int& bin_out, unsigned& above_out) {
    unsigned v[8]; unsigned s = 0;
#pragma unroll
    for (int i = 0; i < 4; ++i) { const unsigned w = h[4 * lane + i]; v[2 * i] = w & 0xffffu; v[2 * i + 1] = w >> 16; s += v[2 * i] + v[2 * i + 1]; }
    unsigned S = s;
#pragma unroll
    for (int o = 1; o < 64; o <<= 1) { const unsigned t = (unsigned)__builtin_amdgcn_ds_bpermute((lane + o) << 2, (int)S); if (lane + o < 64) S += t; }
    const unsigned long long mask = __ballot(S >= need);
    const int Lm = mask ? 63 - __builtin_clzll(mask) : 0;
    unsigned cum = S - s; int bsel = 8 * lane; unsigned ab = cum; bool found = false;
#pragma unroll
    for (int i = 7; i >= 0; --i) { if (!found) { if (cum + v[i] >= need) { bsel = 8 * lane + i; ab = cum; found = true; } else cum += v[i]; } }
    bin_out = __builtin_amdgcn_readlane(bsel, Lm); above_out = (unsigned)__builtin_amdgcn_readlane((int)ab, Lm);
}
__device__ __forceinline__ void topk_phase(LAS unsigned char* lds, const GAS bf16* Z, const GAS bf16* KIN, const GAS float* WIF, GAS unsigned short* IDX, GAS unsigned* SCR, int vcu, int G, int lane, int wave) {
    LAS unsigned* hist = (LAS unsigned*)(lds + TK_HIST_OFF) + wave * 4 * (TK_BINS / 2);
    LAS float* csc = (LAS float*)(lds + TK_CSC_OFF) + wave * 4 * TK_CAP;
    LAS unsigned short* cix = (LAS unsigned short*)(lds + TK_CIX_OFF) + wave * 4 * TK_CAP;
    LAS unsigned short* sel = (LAS unsigned short*)(lds + TK_SEL_OFF) + wave * 4 * 256;
    LAS unsigned* cnt = (LAS unsigned*)(lds + TK_CNT_OFF) + wave * 8;
    LAS unsigned* dum = (LAS unsigned*)(lds + TK_DUM_OFF) + wave * 64 + lane;
    const int n = lane & 31, c = lane >> 5;
    const int am = (lane >> 4) & 1, bbm = (lane >> 3) & 1, ccm = (lane >> 2) & 1, dm = lane & 3;
    for (int p2 = vcu; p2 < BATCH * 64; p2 += G) {
#pragma unroll 1
        for (int half = 0; half < 2; ++half) {
            const int b = p2 >> 6, jj = p2 & 63, j = half ? 127 - jj : jj;
            const int t0 = 32 * j + 4 * wave; const size_t rb = (size_t)b * SEQ;
            bf16x8 qa[4];
#pragma unroll
            for (int st = 0; st < 4; ++st) qa[st] = *(const GAS bf16x8*)(Z + (rb + t0 + 2 * ccm + am) * ZLD + ZC_QI + (4 * bbm + dm) * 64 + 16 * st + 8 * c);
            float w0[8], w1[8];
            { const GAS f32x4* wp = (const GAS f32x4*)(WIF + (rb + t0 + 2 * c) * IH); const f32x4 x0 = wp[0], x1 = wp[1], x2 = wp[2], x3 = wp[3];
              w0[0] = x0.x; w0[1] = x0.y; w0[2] = x0.z; w0[3] = x0.w; w0[4] = x1.x; w0[5] = x1.y; w0[6] = x1.z; w0[7] = x1.w;
              w1[0] = x2.x; w1[1] = x2.y; w1[2] = x2.z; w1[3] = x2.w; w1[4] = x3.x; w1[5] = x3.y; w1[6] = x3.z; w1[7] = x3.w; }
            tk_h2 wh[8];
#pragma unroll
            for (int h = 0; h < 8; ++h) { wh[h].x = (_Float16)w0[h]; wh[h].y = (_Float16)w1[h]; }
            float scA, scB;
            { float a = 0.f, bq = 0.f;
#pragma unroll
              for (int h = 0; h < 8; ++h) { a = fmaf(w0[h], w0[h], a); bq = fmaf(w1[h], w1[h], bq); }
              scA = 32.0f / fmaxf(sqrtf(32.0f * a), 1e-20f); scB = 32.0f / fmaxf(sqrtf(32.0f * bq), 1e-20f); }
            const int tA = t0 + 2 * c, tB = tA + 1;
            for (int i = lane; i < 4 * (TK_BINS / 2); i += 64) hist[i] = 0u;
            for (int i = lane; i < 4 * 128; i += 64) ((LAS unsigned*)sel)[i] = 0u;
            if (lane < 8) cnt[lane] = 0u;
            asm volatile("s_waitcnt lgkmcnt(0)" ::: "memory");
            int lo[4], hi[4]; unsigned ab0[4]; bool ov[4];
#pragma unroll
            for (int tk = 0; tk < 4; ++tk) { lo[tk] = 0x7fffffff; hi[tk] = -1; ab0[tk] = 0u; ov[tk] = false; }
            const bool need_sel = (t0 + 3) >= TOPK;
            const GAS bf16* kbase = KIN + (rb + n) * IDIM + 8 * c;
            const int tidk = wave * 64 + lane; const int ng = (j + 2) >> 1;
            const GAS bf16* kg0 = KIN + (rb + (tidk >> 3)) * IDIM + (tidk & 7) * 8; const int koff = (tidk >> 3) * 144 + (tidk & 7) * 16;
            LAS unsigned char* kbuf = lds + TK_KB_OFF; volatile LAS unsigned* sflag = (volatile LAS unsigned*)(lds + TK_FLAG_OFF);
            if (tidk == 0) *sflag = 0u;
            GAS unsigned* scrw = SCR + (((size_t)b * SCR_TILES + (size_t)((j * (j + 1)) >> 1)) * 8 + wave) * 64 + lane;
#define TK_PRIME() v4u kr = {0u, 0u, 0u, 0u}; { const v4u kr0 = *(const GAS v4u*)kg0; if (1 < ng) kr = *(const GAS v4u*)(kg0 + (size_t)64 * IDIM); *(LAS v4u*)(kbuf + koff) = kr0; } __syncthreads();
#define TK_GROUP_BEGIN() \
                  \
                if (g + 1 < ng) *(LAS v4u*)(kbuf + ((g + 1) & 1) * TK_KB_BYTES + koff) = kr; \
                if (g + 2 < ng) kr = *(const GAS v4u*)(kg0 + (size_t)(g + 2) * 64 * IDIM); \
                const LAS unsigned char* kb_ = kbuf + (g & 1) * TK_KB_BYTES; \
                float s0v[2], s1v[2];     \
                { f32x16 accv[2]; \
                  _Pragma("unroll") for (int u4 = 0; u4 < 2; ++u4) { _Pragma("unroll") for (int r = 0; r < 16; ++r) accv[u4][r] = 0.f; \
                    _Pragma("unroll") for (int st = 0; st < 4; ++st) { const bf16x8 kf = *(const LAS bf16x8*)(kb_ + (32 * u4 + n) * 144 + (2 * st + c) * 16); accv[u4] = __builtin_amdgcn_mfma_f32_32x32x16_bf16(qa[st], kf, accv[u4], 0, 0, 0); } } \
                  _Pragma("unroll") for (int u4 = 0; u4 < 2; ++u4) tk_score2(accv[u4], wh, s0v[u4], s1v[u4]); } \
                _Pragma("unroll") for (int u4 = 0; u4 < 2; ++u4) { \
                    const float s0 = s0v[u4], s1 = s1v[u4]; const int s = 32 * (2 * g + u4) + n;
#define TK_GROUP_END() } \
                __syncthreads();
            bool slow = false;
            if (need_sel) {
                {   TK_PRIME();
#pragma unroll 1
                    for (int g = 0; g < ng; ++g) { TK_GROUP_BEGIN()
                        int b0 = (int)tk_x(s0, scA), b1 = (int)tk_x(s1, scB); b0 = b0 < 0 ? 0 : (b0 > TK_BINS - 1 ? TK_BINS - 1 : b0); b1 = b1 < 0 ? 0 : (b1 > TK_BINS - 1 ? TK_BINS - 1 : b1);
                        LAS unsigned* p0 = (s <= tA) ? &hist[HIST_WORD(2 * c, b0)] : dum; LAS unsigned* p1 = (s <= tB) ? &hist[HIST_WORD(2 * c + 1, b1)] : dum;
                        LDS_ADDV(p0, HIST_INC(b0)); LDS_ADDV(p1, HIST_INC(b1));
                        if (2 * g + u4 <= j) scrw[(2 * g + u4) * 512] = __builtin_bit_cast(unsigned, __builtin_amdgcn_cvt_pkrtz(s0, s1));
                        TK_GROUP_END() }
                }
                asm volatile("s_waitcnt lgkmcnt(0)" ::: "memory");
#pragma unroll
                for (int tk = 0; tk < 4; ++tk) { int bin; unsigned above; tk_find(hist + tk * (TK_BINS / 2), (unsigned)TOPK, lane, bin, above);
                    const unsigned ceq = (hist[HIST_WORD(tk, bin)] >> ((bin & 1) * 16)) & 0xffffu; ov[tk] = ceq > (unsigned)TK_CAP; slow |= ov[tk]; ab0[tk] = above; lo[tk] = bin * 512; hi[tk] = bin * 512 + 511; }
                if (slow && lane == 0) *sflag = 1u;
                __syncthreads();
                slow = *sflag != 0u;
            }
            if (!slow) {
                float thi[4], tlo[4];
#pragma unroll
                for (int tk = 0; tk < 4; ++tk) { const int bin = lo[tk] >> 9;
                    thi[tk] = !need_sel ? -__builtin_inff() : (bin >= TK_BINS - 1 ? __builtin_inff() : (float)(bin + 1));
                    tlo[tk] = !need_sel ? __builtin_inff() : (bin == 0 ? -__builtin_inff() : (float)bin); }
                const float thiA = c ? thi[2] : thi[0], tloA = c ? tlo[2] : tlo[0], thiB = c ? thi[3] : thi[1], tloB = c ? tlo[3] : tlo[1];
                unsigned cntA = 0u, cntB = 0u;
                LAS unsigned short* selA = sel + (2 * c) * 256; LAS unsigned short* selB = sel + (2 * c + 1) * 256; LAS unsigned short* dum16 = (LAS unsigned short*)dum;
                {   constexpr int U = 8; unsigned cw[U], nw[U];
#pragma unroll
                    for (int u = 0; u < U; ++u) cw[u] = (need_sel && u <= j) ? scrw[u * 512] : 0u;
#pragma unroll 1
                    for (int kt = 0; kt <= j; kt += U) {
#pragma unroll
                        for (int u = 0; u < U; ++u) nw[u] = (need_sel && kt + U + u <= j) ? scrw[(kt + U + u) * 512] : 0u;
#pragma unroll
                        for (int u = 0; u < U; ++u) { if (kt + u <= j) { const tk_h2 hh = __builtin_bit_cast(tk_h2, cw[u]); const float s0 = (float)hh.x, s1 = (float)hh.y; const int s = 32 * (kt + u) + n;
                    const float x0 = (s <= tA) ? tk_x(s0, scA) : __builtin_nanf(""), x1 = (s <= tB) ? tk_x(s1, scB) : __builtin_nanf("");
                    const bool a0 = x0 >= thiA, a1 = x1 >= thiB; const bool c0 = !a0 && x0 >= tloA, c1 = !a1 && x1 >= tloB;
                    const unsigned long long m0 = __ballot(a0), m1 = __ballot(a1);
                    const unsigned pre0 = c ? __builtin_amdgcn_mbcnt_hi((unsigned)(m0 >> 32), 0u) : __builtin_amdgcn_mbcnt_lo((unsigned)m0, 0u);
                    const unsigned pre1 = c ? __builtin_amdgcn_mbcnt_hi((unsigned)(m1 >> 32), 0u) : __builtin_amdgcn_mbcnt_lo((unsigned)m1, 0u);
                    const unsigned pos0 = cntA + pre0, pos1 = cntB + pre1;
                    LAS unsigned short* q0 = (a0 && pos0 < 256u) ? selA + pos0 : dum16; LAS unsigned short* q1 = (a1 && pos1 < 256u) ? selB + pos1 : dum16;
                    *q0 = (unsigned short)s; *q1 = (unsigned short)s;
                    cntA += c ? (unsigned)__builtin_popcount((unsigned)(m0 >> 32)) : (unsigned)__builtin_popcount((unsigned)m0);
                    cntB += c ? (unsigned)__builtin_popcount((unsigned)(m1 >> 32)) : (unsigned)__builtin_popcount((unsigned)m1);
                    if (__ballot(c0 || c1)) {
                        if (c0) { const unsigned pos = LDS_ADD(&cnt[(2 * c) * 2 + 1]); if (pos < (unsigned)TK_CAP) { csc[(2 * c) * TK_CAP + pos] = s0; cix[(2 * c) * TK_CAP + pos] = (unsigned short)s; } }
                        if (c1) { const unsigned pos = LDS_ADD(&cnt[(2 * c + 1) * 2 + 1]); if (pos < (unsigned)TK_CAP) { csc[(2 * c + 1) * TK_CAP + pos] = s1; cix[(2 * c + 1) * TK_CAP + pos] = (unsigned short)s; } } }
                        } }
#pragma unroll
                        for (int u = 0; u < U; ++u) cw[u] = nw[u];
                    } }
                if ((lane & 31) == 0) { cnt[(2 * c) * 2] = cntA; cnt[(2 * c + 1) * 2] = cntB; }
                asm volatile("s_waitcnt lgkmcnt(0)" ::: "memory");
            } else {
                for (int i = lane; i < 4 * (TK_BINS / 2); i += 64) hist[i] = 0u;
                asm volatile("s_waitcnt lgkmcnt(0)" ::: "memory");
                int mode = 1;
#pragma unroll 1
                for (;;) {
                const int klo0 = c ? lo[2] : lo[0], khi0 = c ? hi[2] : hi[0], klo1 = c ? lo[3] : lo[1], khi1 = c ? hi[3] : hi[1];
                const bool ov0 = c ? ov[2] : ov[0], ov1 = c ? ov[3] : ov[1];
                bf16x8 kb[4][4];
#pragma unroll
                for (int u4 = 0; u4 < 4; ++u4) { const int kq = u4 < j ? u4 : j;
#pragma unroll
                    for (int st = 0; st < 4; ++st) kb[u4][st] = *(const GAS bf16x8*)(kbase + (size_t)kq * 32 * IDIM + 16 * st); }
#pragma unroll 1
                for (int kt = 0; kt <= j; kt += 4) {
                    bf16x8 kn[4][4];
#pragma unroll
                    for (int u4 = 0; u4 < 4; ++u4) { const int kq = kt + 4 + u4 < j ? kt + 4 + u4 : j;
#pragma unroll
                        for (int st = 0; st < 4; ++st) kn[u4][st] = *(const GAS bf16x8*)(kbase + (size_t)kq * 32 * IDIM + 16 * st); }
#pragma unroll
                    for (int u4 = 0; u4 < 4; ++u4) {
                        f32x16 acc;
#pragma unroll
                        for (int r = 0; r < 16; ++r) acc[r] = 0.f;
#pragma unroll
                        for (int st = 0; st < 4; ++st) acc = __builtin_amdgcn_mfma_f32_32x32x16_bf16(qa[st], kb[u4][st], acc, 0, 0, 0);
                        float s0, s1; tk_score2(acc, wh, s0, s1);
                        const int s = 32 * (kt + u4) + n; const int k0 = tk_key(s0, scA), k1 = tk_key(s1, scB);
                        const bool v0 = s <= tA, v1 = s <= tB;
                        if (mode == 0) {
                            if (v0 && tA >= TOPK) LDS_ADDV(&hist[HIST_WORD(2 * c, k0 >> 9)], HIST_INC(k0 >> 9));
                            if (v1 && tB >= TOPK) LDS_ADDV(&hist[HIST_WORD(2 * c + 1, k1 >> 9)], HIST_INC(k1 >> 9));
                        } else if (mode == 1) {
                            if (v0 && ov0 && k0 >= klo0 && k0 <= khi0) LDS_ADDV(&hist[HIST_WORD(2 * c, k0 & 511)], HIST_INC(k0 & 511));
                            if (v1 && ov1 && k1 >= klo1 && k1 <= khi1) LDS_ADDV(&hist[HIST_WORD(2 * c + 1, k1 & 511)], HIST_INC(k1 & 511));
                        } else {
                            if (v0) { if (k0 > khi0) { const unsigned pos = LDS_ADD(&cnt[(2 * c) * 2]); if (pos < 256u) sel[(2 * c) * 256 + pos] = (unsigned short)s; }
                                      else if (k0 >= klo0) { const unsigned pos = LDS_ADD(&cnt[(2 * c) * 2 + 1]); if (pos < (unsigned)TK_CAP) { csc[(2 * c) * TK_CAP + pos] = s0; cix[(2 * c) * TK_CAP + pos] = (unsigned short)s; } } }
                            if (v1) { if (k1 > khi1) { const unsigned pos = LDS_ADD(&cnt[(2 * c + 1) * 2]); if (pos < 256u) sel[(2 * c + 1) * 256 + pos] = (unsigned short)s; }
                                      else if (k1 >= klo1) { const unsigned pos = LDS_ADD(&cnt[(2 * c + 1) * 2 + 1]); if (pos < (unsigned)TK_CAP) { csc[(2 * c + 1) * TK_CAP + pos] = s1; cix[(2 * c + 1) * TK_CAP + pos] = (unsigned short)s; } } }
                        }
                    }
#pragma unroll
                    for (int u4 = 0; u4 < 4; ++u4)
#pragma unroll
                        for (int st = 0; st < 4; ++st) kb[u4][st] = kn[u4][st];
                }
                    asm volatile("s_waitcnt lgkmcnt(0)" ::: "memory");
                    if (mode == 2) break;
#pragma unroll
                    for (int tk = 0; tk < 4; ++tk) if (ov[tk]) { int sub; unsigned above; tk_find(hist + tk * (TK_BINS / 2), (unsigned)TOPK - ab0[tk], lane, sub, above); lo[tk] += sub; hi[tk] = lo[tk]; }
                    mode = 2;
                }
            }
#undef TK_GROUP_BEGIN
#undef TK_GROUP_END
#undef TK_PRIME
#pragma unroll 1
            for (int tk = 0; tk < 4; ++tk) { const int t = t0 + tk;
                if (t >= TOPK) { const unsigned nsel = cnt[tk * 2]; unsigned nc = cnt[tk * 2 + 1]; nc = nc > (unsigned)TK_CAP ? (unsigned)TK_CAP : nc; const unsigned need = nsel < 256u ? 256u - nsel : 0u;
                    for (unsigned q = 0; q * 64 < nc; ++q) { const unsigned i = lane + 64 * q;
                        const float si = i < nc ? csc[tk * TK_CAP + i] : 0.f; const unsigned xi = i < nc ? cix[tk * TK_CAP + i] : 0u; unsigned rank = 0;
                        for (unsigned jx = 0; jx < nc; ++jx) { const float sj = csc[tk * TK_CAP + jx]; const unsigned xj = cix[tk * TK_CAP + jx]; rank += (sj > si || (sj == si && xj < xi)) ? 1u : 0u; }
                        if (i < nc && rank < need) sel[tk * 256 + nsel + rank] = (unsigned short)xi; } } }
            asm volatile("s_waitcnt lgkmcnt(0)" ::: "memory");
            { const LAS v4u* sv = (const LAS v4u*)sel; GAS v4u* ov = (GAS v4u*)(IDX + (rb + t0) * TOPK);
              ov[lane] = sv[lane]; ov[lane + 64] = sv[lane + 64]; }
            asm volatile("s_waitcnt vmcnt(0) lgkmcnt(0)" ::: "memory");
        }
    }
}
constexpr int DSA_TAB_OFF = RING_BYTES + 1024;
constexpr int DSA_IDX_OFF = DSA_TAB_OFF + 4224;
static_assert(8 * 129 * 4 <= 4224 && DSA_IDX_OFF + 8 * 1024 <= LDS_BYTES, "DSA LDS map");
__device__ __forceinline__ void dsa_phase(LAS unsigned char* lds_all, const GAS bf16* Z, const GAS bf16* CKVN, const GAS unsigned short* IDX, GAS bf16* O, const GAS float* rel_bias, int gw, int NGW, int tid, int lane, int wave) {
    LAS float* tab = (LAS float*)(lds_all + DSA_TAB_OFF);
    for (int e = tid; e < 8 * 129; e += NWAVES * 64) { const int hh = e / 129, dist = e - hh * 129; tab[e] = rel_bias[(dist < 128 ? (int)T5_BUCKET[dist] : 31) * 24 + hh]; }
    __syncthreads();
    LAS unsigned char* img = lds_all + RING_OFF + wave * 16384;
    LAS unsigned short* ib = (LAS unsigned short*)(lds_all + DSA_IDX_OFF + wave * 1024);
    const unsigned imgb = (unsigned)(size_t)img;
    const int h = lane & 15, g = lane >> 4, hi = lane >> 5;
    const LAS float* tabh = tab + (h & 7) * 129;
    const int TPW = (M + NGW - 1) / NGW;
    const int tok0 = gw * TPW;
    const int tok_end = (gw + 1) * TPW < M ? (gw + 1) * TPW : M;
    const int xq = 2 * (lane & 7);
    unsigned qa[8];
#pragma unroll
    for (int st = 0; st < 8; ++st) qa[st] = imgb + (unsigned)((lane & 15) * 512 + (((4 * st + g) ^ xq) * 16));
    const int q4 = (lane & 15) >> 2, p4 = lane & 3; const int xr = 2 * (4 * (g & 1) + q4);
    const unsigned pv_base = imgb + (unsigned)((4 * g + q4) * 512 + 8 * (p4 & 1));
    unsigned pva[16];
#pragma unroll
    for (int c2 = 0; c2 < 16; ++c2) pva[c2] = pv_base + (unsigned)((((2 * c2) ^ xr) | (p4 >> 1)) * 16);
    unsigned lc[4];
#pragma unroll
    for (int k = 0; k < 4; ++k) lc[k] = (unsigned)(((lane & 31) ^ (2 * ((2 * k + hi) & 7))) * 16);
    if (tok0 < tok_end) *(LAS unsigned long long*)(ib + 4 * lane) = *(const GAS unsigned long long*)(IDX + (size_t)tok0 * TOPK + 4 * lane);
#pragma unroll 1
    for (int tok = tok0; tok < tok_end; ++tok) {
        const int t = tok & (SEQ - 1); const size_t rb = (size_t)(tok - t);
        const int nsel = t + 1 < TOPK ? t + 1 : TOPK;
        const LAS unsigned short* cur = ib + ((tok - tok0) & 1) * 256;
        const unsigned long long nxi = tok + 1 < tok_end ? *(const GAS unsigned long long*)(IDX + (size_t)(tok + 1) * TOPK + 4 * lane) : 0ull;
        bf16x8 qf[8];
#pragma unroll
        for (int st = 0; st < 8; ++st) { qf[st] = *(const GAS bf16x8*)(Z + (size_t)tok * ZLD + ZC_QLAT + (h & 7) * 256 + 32 * st + 8 * g); if (h >= 8) qf[st] = (bf16x8){0, 0, 0, 0, 0, 0, 0, 0}; }
        f32x4 oacc[16];
#pragma unroll
        for (int rt = 0; rt < 16; ++rt) oacc[rt] = (f32x4){0.f, 0.f, 0.f, 0.f};
        float mrun = -1e30f, lsum = 0.f;
        const GAS unsigned char* cb = (const GAS unsigned char*)(CKVN + rb * RANK);
#pragma unroll
        for (int ch = 0; ch < 8; ++ch) {
            if (32 * ch >= nsel) break;
            unsigned rix[16];
#pragma unroll
            for (int i = 0; i < 16; ++i) rix[i] = cur[32 * ch + 2 * i + hi];
            const unsigned long long i0 = *(const LAS unsigned long long*)(cur + 32 * ch + 4 * g), i1 = *(const LAS unsigned long long*)(cur + 32 * ch + 16 + 4 * g);
            asm volatile("s_waitcnt lgkmcnt(0)" ::: "memory");
#pragma unroll
            for (int i = 0; i < 16; ++i) __builtin_amdgcn_global_load_lds((const GAS unsigned*)(cb + ((rix[i] << 9) + lc[i & 3])), (LAS unsigned*)(img + i * 1024), 16, 0, 0);
            asm volatile("s_waitcnt vmcnt(0)" ::: "memory");
            v4u fa[16];
            asm volatile("ds_read_b128 %0, %8\n\tds_read_b128 %1, %8 offset:8192\n\tds_read_b128 %2, %9\n\tds_read_b128 %3, %9 offset:8192\n\t"
                         "ds_read_b128 %4, %10\n\tds_read_b128 %5, %10 offset:8192\n\tds_read_b128 %6, %11\n\tds_read_b128 %7, %11 offset:8192"
                         : "=&v"(fa[0]), "=&v"(fa[1]), "=&v"(fa[2]), "=&v"(fa[3]), "=&v"(fa[4]), "=&v"(fa[5]), "=&v"(fa[6]), "=&v"(fa[7])
                         : "v"(qa[0]), "v"(qa[1]), "v"(qa[2]), "v"(qa[3]) : "memory");
            asm volatile("ds_read_b128 %0, %16\n\tds_read_b128 %1, %16 offset:8192\n\tds_read_b128 %2, %17\n\tds_read_b128 %3, %17 offset:8192\n\t"
                         "ds_read_b128 %4, %18\n\tds_read_b128 %5, %18 offset:8192\n\tds_read_b128 %6, %19\n\tds_read_b128 %7, %19 offset:8192\n\ts_waitcnt lgkmcnt(8)"
                         : "=&v"(fa[8]), "=&v"(fa[9]), "=&v"(fa[10]), "=&v"(fa[11]), "=&v"(fa[12]), "=&v"(fa[13]), "=&v"(fa[14]), "=&v"(fa[15]),
                           "+v"(fa[0]), "+v"(fa[1]), "+v"(fa[2]), "+v"(fa[3]), "+v"(fa[4]), "+v"(fa[5]), "+v"(fa[6]), "+v"(fa[7])
                         : "v"(qa[4]), "v"(qa[5]), "v"(qa[6]), "v"(qa[7]) : "memory");
            f32x4 sa[2] = {(f32x4){0.f, 0.f, 0.f, 0.f}, (f32x4){0.f, 0.f, 0.f, 0.f}};
#pragma unroll
            for (int st = 0; st < 4; ++st) { sa[0] = __builtin_amdgcn_mfma_f32_16x16x32_bf16(__builtin_bit_cast(bf16x8, fa[2 * st]), qf[st], sa[0], 0, 0, 0);
                sa[1] = __builtin_amdgcn_mfma_f32_16x16x32_bf16(__builtin_bit_cast(bf16x8, fa[2 * st + 1]), qf[st], sa[1], 0, 0, 0); }
            s16x4 pr[2][4];
            asm volatile("s_waitcnt lgkmcnt(0)\n\tds_read_b64_tr_b16 %0, %12\n\tds_read_b64_tr_b16 %1, %12 offset:8192\n\tds_read_b64_tr_b16 %2, %13\n\tds_read_b64_tr_b16 %3, %13 offset:8192"
                         : "=&v"(pr[0][0]), "=&v"(pr[0][1]), "=&v"(pr[0][2]), "=&v"(pr[0][3]),
                           "+v"(fa[8]), "+v"(fa[9]), "+v"(fa[10]), "+v"(fa[11]), "+v"(fa[12]), "+v"(fa[13]), "+v"(fa[14]), "+v"(fa[15])
                         : "v"(pva[0]), "v"(pva[1]) : "memory");
#pragma unroll
            for (int st = 4; st < 8; ++st) { sa[0] = __builtin_amdgcn_mfma_f32_16x16x32_bf16(__builtin_bit_cast(bf16x8, fa[2 * st]), qf[st], sa[0], 0, 0, 0);
                sa[1] = __builtin_amdgcn_mfma_f32_16x16x32_bf16(__builtin_bit_cast(bf16x8, fa[2 * st + 1]), qf[st], sa[1], 0, 0, 0); }
            float bz[8];
#pragma unroll
            for (int e = 0; e < 8; ++e) { const int tl = e >> 2, jx = e & 3; const int sidx = (int)(((tl ? i1 : i0) >> (16 * jx)) & 0xffffull); int dd = t - sidx; dd = dd < 0 ? 0 : (dd > 128 ? 128 : dd); bz[e] = tabh[dd]; }
            float lg[8]; float cmax = -1e30f;
#pragma unroll
            for (int e = 0; e < 8; ++e) { const int tl = e >> 2, jx = e & 3; const int kk = 32 * ch + 16 * tl + 4 * g + jx;
                const float v = kk < nsel ? sa[tl][jx] + bz[e] : -1e30f; lg[e] = v; cmax = fmaxf(cmax, v); }
            cmax = fmaxf(cmax, SHX(cmax, 16)); cmax = fmaxf(cmax, SHX(cmax, 32));
            const float mnew = fmaxf(mrun, cmax);
            if (__any(mnew > mrun)) { const float alpha = __expf(mrun - mnew); lsum *= alpha;
#pragma unroll
                for (int rt = 0; rt < 16; ++rt) oacc[rt] = oacc[rt] * alpha; }
            mrun = mnew;
            float pe[8];
#pragma unroll
            for (int e = 0; e < 8; ++e) { pe[e] = __expf(lg[e] - mnew); lsum += pe[e]; }
            bf16x8 pf; { const v4u wv = {pg8::cvt_pk_bf16(pe[0], pe[1]), pg8::cvt_pk_bf16(pe[2], pe[3]), pg8::cvt_pk_bf16(pe[4], pe[5]), pg8::cvt_pk_bf16(pe[6], pe[7])}; pf = __builtin_bit_cast(bf16x8, wv); }
#pragma unroll
            for (int j = 0; j < 8; ++j) {
                const int cs = j & 1, ns = cs ^ 1;
                if (j < 7) asm volatile("ds_read_b64_tr_b16 %0, %8\n\tds_read_b64_tr_b16 %1, %8 offset:8192\n\tds_read_b64_tr_b16 %2, %9\n\tds_read_b64_tr_b16 %3, %9 offset:8192\n\ts_waitcnt lgkmcnt(4)"
                                        : "=&v"(pr[ns][0]), "=&v"(pr[ns][1]), "=&v"(pr[ns][2]), "=&v"(pr[ns][3]), "+v"(pr[cs][0]), "+v"(pr[cs][1]), "+v"(pr[cs][2]), "+v"(pr[cs][3])
                                        : "v"(pva[2 * j + 2]), "v"(pva[2 * j + 3]) : "memory");
                else asm volatile("s_waitcnt lgkmcnt(0)" : "+v"(pr[cs][0]), "+v"(pr[cs][1]), "+v"(pr[cs][2]), "+v"(pr[cs][3]) :: "memory");
                oacc[2 * j] = __builtin_amdgcn_mfma_f32_16x16x32_bf16(cat4(pr[cs][0], pr[cs][1]), pf, oacc[2 * j], 0, 0, 0);
                oacc[2 * j + 1] = __builtin_amdgcn_mfma_f32_16x16x32_bf16(cat4(pr[cs][2], pr[cs][3]), pf, oacc[2 * j + 1], 0, 0, 0); }
        }
        if (tok + 1 < tok_end) *(LAS unsigned long long*)(ib + (((tok - tok0) & 1) ^ 1) * 256 + 4 * lane) = nxi;
        lsum += SHX(lsum, 16); lsum += SHX(lsum, 32);
        const float inv = (OUT_F8 ? O8_SCALE : 1.0f) / lsum;
        if (h < 8) {
            if constexpr (OUT_F8) { GAS unsigned char* orow = (GAS unsigned char*)O + (size_t)tok * OLD + h * 256 + 4 * g;
#pragma unroll
                for (int rt = 0; rt < 16; ++rt) { int p = 0; p = __builtin_amdgcn_cvt_pk_fp8_f32(oacc[rt][0] * inv, oacc[rt][1] * inv, p, false); p = __builtin_amdgcn_cvt_pk_fp8_f32(oacc[rt][2] * inv, oacc[rt][3] * inv, p, true); *(GAS unsigned*)(orow + 16 * rt) = (unsigned)p; } }
            else { GAS bf16* orow = O + (size_t)tok * OLD + h * 256 + 4 * g;
#pragma unroll
            for (int rt = 0; rt < 16; ++rt) *(GAS unsigned long long*)(orow + 16 * rt) = (unsigned long long)pk2(oacc[rt][0] * inv, oacc[rt][1] * inv) | ((unsigned long long)pk2(oacc[rt][2] * inv, oacc[rt][3] * inv) << 32); } }
    }
}
struct Args { const float* in[20]; float* out; unsigned char* ws; };
__device__ __forceinline__ unsigned long long karg_u64(int idx) { unsigned long long r; const unsigned off = (unsigned)idx * 8u;
    asm volatile("s_load_dwordx2 %0, %1, %2\n\ts_waitcnt lgkmcnt(0)" : "=s"(r) : "s"(__builtin_amdgcn_kernarg_segment_ptr()), "s"(off) : "memory"); return r; }
__device__ __forceinline__ const GAS float* karg_in(int i) { return (const GAS float*)karg_u64(i); }
__device__ __forceinline__ GAS float* karg_out() { return (GAS float*)karg_u64(20); }
__device__ __forceinline__ GAS unsigned char* karg_ws() { return (GAS unsigned char*)karg_u64(21); }
#ifndef REP_P0
#define REP_P0 1
#endif
#ifndef REP_NORM
#define REP_NORM 1
#endif
#ifndef REP_GU
#define REP_GU 1
#endif
#ifndef REP_IN
#define REP_IN 1
#endif
#ifndef REP_POST
#define REP_POST 1
#endif
#ifndef REP_TOPK
#define REP_TOPK 1
#endif
#ifndef REP_DSA
#define REP_DSA 1
#endif
#define REPEAT(n) _Pragma("unroll 1") for (int rep_ = 0; rep_ < (n); ++rep_)
#define PHASE_IDS() int wave = wave0; asm volatile("" : "+s"(wave)); int lane; asm volatile("v_mbcnt_lo_u32_b32 %0, -1, 0\n\tv_mbcnt_hi_u32_b32 %0, -1, %0" : "=v"(lane)); const int tid = wave * 64 + lane; int bx = blockIdx.x; asm volatile("" : "+s"(bx)); int G = gridDim.x; asm volatile("" : "+s"(G)); \
    const int vcu = (G % 8 == 0) ? (bx % 8) * (G / 8) + bx / 8 : bx; const int gw = vcu * NWAVES + wave, NGW = G * NWAVES; \
    GAS unsigned char* ws = karg_ws(); (void)lane; (void)gw; (void)NGW; (void)vcu; (void)ws
__global__ void __launch_bounds__(NWAVES * 64, 2) mk_fwd(Args args) {
    extern __shared__ __attribute__((aligned(16))) unsigned char lds_raw[];
    LAS unsigned char* lds = (LAS unsigned char*)lds_raw;
    volatile LAS unsigned* MISC = (volatile LAS unsigned*)(lds + MISC_OFF);
    const int wave0 = __builtin_amdgcn_readfirstlane(threadIdx.x >> 6);
    for (int u = threadIdx.x; u < (LDS_BYTES - LDSCTL_OFF) / 4; u += NWAVES * 64) ((LAS unsigned*)(lds + LDSCTL_OFF))[u] = 0u;
    __syncthreads();
    (void)xcd_barrier_post((unsigned*)((gu32*)(karg_ws() + WS_CTL) + CW_BAR), MISC + 8, threadIdx.x == 0);
#define GRID_BAR() do { XcdBarrier b_; b_.bar = (unsigned*)((gu32*)(karg_ws() + WS_CTL) + CW_BAR); b_.x = xb_xcc_id(); b_.st = MISC + 8; int w_ = wave0; asm volatile("" : "+s"(w_)); int l_; asm volatile("v_mbcnt_lo_u32_b32 %0, -1, 0\n\tv_mbcnt_hi_u32_b32 %0, -1, %0" : "=v"(l_)); xcd_barrier(b_, (w_ | l_) == 0); } while (0)

    REPEAT(REP_P0) {   PHASE_IDS();
        LAS float* scr = (LAS float*)(lds + RING_OFF + wave * 16384);
        rows_bf16_ss(karg_in(0), (GAS bf16*)(ws + WS_XN), f8_on(0, 0) ? (GAS unsigned char*)(ws + WS_HB8) : (GAS unsigned char*)nullptr, (GAS float*)(ws + WS_SS), gw, NGW, lane);
        constexpr int I_GU = (D / 64) * (FF / 32), I_DN = (FF / 64) * (D / 32);
        constexpr int I_FFN = 2 * I_GU + I_DN, I_IN = 72 * (D / 64), I_OB = (1024 / 64) * (D / 32);
        constexpr int PER_LAYER = 2 * I_FFN + I_IN + I_OB;
        for (int it = gw; it < DEPTH * PER_LAYER; it += NGW) {
            const int l = it / PER_LAYER; int r = it - l * PER_LAYER;
            GAS unsigned char* wl = ws + WS_W0 + (size_t)l * W_LAYER;
            if (r < 2 * I_FFN) {
                const int f = r / I_FFN; r -= f * I_FFN;
                GAS bf16* dgu = (GAS bf16*)(wl + (f ? WO_GU2 : WO_GU1)); GAS bf16* dd = (GAS bf16*)(wl + (f ? WO_D2 : WO_D1));
                if (r < 2 * I_GU) { const int up = r >= I_GU; if (up) r -= I_GU; const int kb = r / (FF / 32), nb = r % (FF / 32), n0 = 32 * nb;
                    const GAS float* wsrc = karg_in(up ? (f ? 17 : 4) : (f ? 16 : 3)) + (size_t)l * D * FF;
                    const int drow = (n0 >> 7) * 256 + (up ? 128 : 0) + (n0 & 127);
                    if (f8_on(l, f)) { if constexpr (GU_I8) conv_item<2>(wsrc, FF, 64 * kb, n0, 32, dgu, D, drow, 0, W8I_SCALE, karg_in(f ? 15 : 2) + (size_t)l * D, scr, lane); else conv_item<1>(wsrc, FF, 64 * kb, n0, 32, dgu, D, drow, 0, W8_SCALE, karg_in(f ? 15 : 2) + (size_t)l * D, scr, lane); }
                    else conv_item(wsrc, FF, 64 * kb, n0, 32, dgu, D, drow, 0, 1.0f, karg_in(f ? 15 : 2) + (size_t)l * D, scr, lane); }
                else { r -= 2 * I_GU; const int kb = r / (D / 32), nb = r % (D / 32);
                    if (d8_on(l, f)) conv_item<1>(karg_in(f ? 18 : 5) + (size_t)l * FF * D, D, 64 * kb, 32 * nb, 32, dd, FF, 32 * nb, 0, W8_SCALE, nullptr, scr, lane);
                    else conv_item(karg_in(f ? 18 : 5) + (size_t)l * FF * D, D, 64 * kb, 32 * nb, 32, dd, FF, 32 * nb, 0, 1.0f, nullptr, scr, lane); }
            } else if (r < 2 * I_FFN + I_IN) {
                r -= 2 * I_FFN; const int j = r >> 5, kb = r & 31; int src, nvalid = 32; float sc = 1.0f;
                if (j < 8) src = 1024 + 32 * j;
                else if (j < 40) src = 1864 + 32 * (j - 8);
                else if (j < 44) src = 2888 + 32 * (j - 40);
                else if (j < 48) src = 3016 + 32 * (j - 44);
                else if (j < 64) src = 1280 + 32 * (j - 48);
                else if (j < 66) src = 1792 + 32 * (j - 64);
                else if (j == 66) { src = 1856; nvalid = 8; sc = 0.044194173824159216f; }
                else { src = 0; nvalid = 0; }
                const GAS float* win = karg_in(7) + (size_t)l * D * D_IN; const GAS float* gmix = karg_in(6) + (size_t)l * D;
                if (IN_I8 && j < 48) conv_item<2>(win, D_IN, 64 * kb, src, nvalid, (GAS bf16*)(wl + WO_IN), D, 2048 + 32 * j, 0, W8I_SCALE, gmix, scr, lane);
                else if (IN_I8) conv_item(win, D_IN, 64 * kb, src, nvalid, (GAS bf16*)(wl + WO_IN + (size_t)ZN8 * D), D, 32 * (j - 48), 0, sc, gmix, scr, lane);
                else conv_item(win, D_IN, 64 * kb, src, nvalid, (GAS bf16*)(wl + WO_IN), D, 2048 + 32 * j, 0, (j >= 8 && j < 40) ? 0.125f : sc, gmix, scr, lane);
            } else {
                r -= 2 * I_FFN + I_IN; const int kb = r >> 6, nb = r & 63;
                if constexpr (OUT_F8) conv_item<1>(karg_in(14) + (size_t)l * D * D + (size_t)1024 * D, D, 64 * kb, 32 * nb, 32, (GAS bf16*)(wl + WO_OUT), OLD, 32 * nb, 2048, W8_SCALE, nullptr, scr, lane);
                else conv_item(karg_in(14) + (size_t)l * D * D + (size_t)1024 * D, D, 64 * kb, 32 * nb, 32, (GAS bf16*)(wl + WO_OUT), OLD, 32 * nb, 2048, 1.0f, nullptr, scr, lane);
            }
        }
        __syncthreads();
        LAS float* Ps = (LAS float*)(lds + RING_OFF); LAS float* Qs = Ps + 64 * 129;
        for (int u = vcu; u < DEPTH * 2048; u += G) {
            const int l = u >> 11, which = (u >> 10) & 1, v = u & 1023;
            GAS unsigned char* wl = ws + WS_W0 + (size_t)l * W_LAYER;
            if (which == 0) { const int h = v >> 7, rt = (v >> 5) & 3, kt = v & 31;
                if constexpr (IN_I8) absorb_unit<false, 2>(karg_in(11) + (size_t)l * RANK * 1024 + ((size_t)(64 * rt) * 8 + h) * 128, 1024, 1, karg_in(7) + (size_t)l * D * D_IN + (size_t)(64 * kt) * D_IN + h * 128, D_IN,
                                   (GAS bf16*)((GAS unsigned char*)(wl + WO_IN) + (size_t)(h * 256 + 64 * rt) * D + 64 * kt), D, WQ8I_SCALE, karg_in(6) + (size_t)l * D + 64 * kt, Ps, Qs, tid);
                else absorb_unit<false>(karg_in(11) + (size_t)l * RANK * 1024 + ((size_t)(64 * rt) * 8 + h) * 128, 1024, 1, karg_in(7) + (size_t)l * D * D_IN + (size_t)(64 * kt) * D_IN + h * 128, D_IN,
                                   (GAS bf16*)(wl + WO_IN) + (size_t)(h * 256 + 64 * rt) * D + 64 * kt, D, 0.08838834764831845f, karg_in(6) + (size_t)l * D + 64 * kt, Ps, Qs, tid); }
            else { const int h = v >> 7, nt = (v >> 2) & 31, rt = v & 3;
                if constexpr (OUT_F8) absorb_unit<true, 1>(karg_in(14) + (size_t)l * D * D + (size_t)(h * 128) * D + 64 * nt, 1, D, karg_in(12) + (size_t)l * RANK * 1024 + ((size_t)(64 * rt) * 8 + h) * 128, 1024,
                                  (GAS bf16*)((GAS unsigned char*)(wl + WO_OUT) + (size_t)(64 * nt) * OLD + h * 256 + 64 * rt), OLD, W8_SCALE, nullptr, Ps, Qs, tid);
                else absorb_unit<true>(karg_in(14) + (size_t)l * D * D + (size_t)(h * 128) * D + 64 * nt, 1, D, karg_in(12) + (size_t)l * RANK * 1024 + ((size_t)(64 * rt) * 8 + h) * 128, 1024,
                                  (GAS bf16*)(wl + WO_OUT) + (size_t)(64 * nt) * OLD + h * 256 + 64 * rt, OLD, 1.0f, nullptr, Ps, Qs, tid); }
        }
    }
    GRID_BAR();

#pragma unroll 1
    for (int s = 0; s < 2 * DEPTH; ++s) {
        const int l = s >> 1, f = s & 1;
        REPEAT(REP_GU) {   PHASE_IDS(); GAS unsigned char* wl = ws + WS_W0 + (size_t)l * W_LAYER;
            pg8::StaticOrder S; S.init(M, NGU, G, bx);
            const GAS float* ssp = (const GAS float*)(ws + WS_SS + (size_t)((3 * l + 2 * f) & 1) * SS_BYTES);
            if ((F8_MASK == 0xF) || (F8_MASK != 0 && f8_on(l, f))) {
                if constexpr (F8_MASK != 0) {
                    pg8::Gemm g{(const GAS bf16*)(ws + WS_HB8), (const GAS bf16*)(wl + (f ? WO_GU2 : WO_GU1)), M, NGU, D / 2};
                    if constexpr (GU_I8) { pg8::EpiSwiglu<true> E{(GAS bf16*)(ws + WS_ACT), FF, ssp, 1.0f / D, EPS, 1.0f / (H8I_SCALE * W8I_SCALE), d8_on(l, f) ? A8_SCALE : 0.f};
                        pg8::gemm_phase<pg8::EpiSwiglu<true>, pg8::StaticOrder, true, true, false, true>(lds + RING_OFF, g, S, E, tid); }
                    else { pg8::EpiSwiglu<false> E{(GAS bf16*)(ws + WS_ACT), FF, ssp, 1.0f / D, EPS, 1.0f / W8_SCALE, d8_on(l, f) ? A8_SCALE : 0.f};
                        pg8::gemm_phase<pg8::EpiSwiglu<false>, pg8::StaticOrder, true, true, true>(lds + RING_OFF, g, S, E, tid); } }
            } else {
                if constexpr (F8_MASK != 0xF) {
                    pg8::Gemm g{(const GAS bf16*)(ws + WS_XN), (const GAS bf16*)(wl + (f ? WO_GU2 : WO_GU1)), M, NGU, D};
                    pg8::EpiSwiglu<false> E{(GAS bf16*)(ws + WS_ACT), FF, ssp, 1.0f / D, EPS, 1.0f, d8_on(l, f) ? A8_SCALE : 0.f};
                    pg8::gemm_phase<pg8::EpiSwiglu<false>, pg8::StaticOrder, true, true, false>(lds + RING_OFF, g, S, E, tid); }
            } }
        GRID_BAR();
        {   PHASE_IDS(); GAS unsigned char* wl = ws + WS_W0 + (size_t)l * W_LAYER;
            pg8::StaticOrder S; S.init(M, D, G, bx);
            const unsigned sso = (unsigned)(WS_SS + (size_t)((3 * l + 2 * f + 1) & 1) * SS_BYTES), h8o = ((f == 0 && IN_I8) || (f == 1 && l + 1 < DEPTH && f8_on(l + 1, 0))) ? (unsigned)WS_HB8 : 0u;
            if ((D8_MASK == 0xF) || (D8_MASK != 0 && d8_on(l, f))) {
                if constexpr (D8_MASK != 0) {
                    pg8::Gemm g{(const GAS bf16*)(ws + WS_ACT), (const GAS bf16*)(wl + (f ? WO_D2 : WO_D1)), M, D, FF / 2};
                    pg8::EpiResid E{0.5f / (W8_SCALE * A8_SCALE), (unsigned)WS_XN, sso, h8o, GU_I8 ? H8I_SCALE : 0.f};
                    pg8::gemm_phase<pg8::EpiResid, pg8::StaticOrder, true, true, true>(lds + RING_OFF, g, S, E, tid); }
            } else {
                if constexpr (D8_MASK != 0xF) {
                    pg8::Gemm g{(const GAS bf16*)(ws + WS_ACT), (const GAS bf16*)(wl + (f ? WO_D2 : WO_D1)), M, D, FF};
                    pg8::EpiResid E{0.5f, (unsigned)WS_XN, sso, h8o, GU_I8 ? H8I_SCALE : 0.f};
                    pg8::gemm_phase<pg8::EpiResid, pg8::StaticOrder, true, true, false>(lds + RING_OFF, g, S, E, tid); }
            } }
        GRID_BAR();
        if (f == 0) {
            REPEAT(REP_IN) {   PHASE_IDS(); GAS unsigned char* wl = ws + WS_W0 + (size_t)l * W_LAYER;
                const GAS float* ssp = (const GAS float*)(ws + WS_SS + (size_t)((3 * l + 1) & 1) * SS_BYTES);
                if constexpr (IN_I8) {
                    {   pg8::Gemm g{(const GAS bf16*)(ws + WS_HB8), (const GAS bf16*)(wl + WO_IN), M, ZN8, D / 2}; pg8::StaticOrder S; S.init(M, ZN8, G, bx);
                        pg8::EpiBf16<true> E{(GAS bf16*)(ws + WS_Z), ZLD, ssp, 1.0f / D, EPS, 0.08838834764831845f / (H8I_SCALE * WQ8I_SCALE), 1.0f / (H8I_SCALE * W8I_SCALE), 0.125f / (H8I_SCALE * W8I_SCALE)};
                        pg8::gemm_phase<pg8::EpiBf16<true>, pg8::StaticOrder, true, true, false, true>(lds + RING_OFF, g, S, E, tid); }
                    {   pg8::Gemm g{(const GAS bf16*)(ws + WS_XN), (const GAS bf16*)(wl + WO_IN + (size_t)ZN8 * D), M, ZLD - ZN8, D}; pg8::StaticOrder S; S.init(M, ZLD - ZN8, G, bx);
                        pg8::EpiBf16<false> E{(GAS bf16*)(ws + WS_Z) + ZN8, ZLD, ssp, 1.0f / D, EPS, 1.0f, 1.0f, 1.0f};
                        pg8::gemm_phase<pg8::EpiBf16<false>, pg8::StaticOrder, true, true, false, false>(lds + RING_OFF, g, S, E, tid); }
                } else {
                    pg8::Gemm g{(const GAS bf16*)(ws + WS_XN), (const GAS bf16*)(wl + WO_IN), M, ZLD, D}; pg8::StaticOrder S; S.init(M, ZLD, G, bx);
                    pg8::EpiBf16<false> E{(GAS bf16*)(ws + WS_Z), ZLD, ssp, 1.0f / D, EPS, 1.0f, 1.0f, 1.0f};
                    pg8::gemm_phase<pg8::EpiBf16<false>, pg8::StaticOrder, true, true, false, false>(lds + RING_OFF, g, S, E, tid); } }
            GRID_BAR();
            REPEAT(REP_POST) {   PHASE_IDS();
                post_rows((const GAS bf16*)(ws + WS_Z), karg_in(8) + (size_t)l * RANK, karg_in(9) + (size_t)l * IDIM, karg_in(10) + (size_t)l * IDIM, (GAS bf16*)(ws + WS_CKVN), (GAS bf16*)(ws + WS_KIN), (GAS float*)(ws + WS_WIF), gw, NGW, lane);
                swa_phase(lds + RING_OFF, (const GAS bf16*)(ws + WS_Z), (GAS bf16*)(ws + WS_O), karg_in(1), karg_in(13) + (size_t)l * H_B, vcu, G, tid, lane, wave);
            }
            GRID_BAR();
            REPEAT(REP_TOPK) {   PHASE_IDS(); topk_phase(lds + RING_OFF, (const GAS bf16*)(ws + WS_Z), (const GAS bf16*)(ws + WS_KIN), (const GAS float*)(ws + WS_WIF), (GAS unsigned short*)(ws + WS_IDX), (GAS unsigned*)(ws + WS_SCR), vcu, G, lane, wave); }
            GRID_BAR();
            REPEAT(REP_DSA) {   PHASE_IDS(); dsa_phase(lds, (const GAS bf16*)(ws + WS_Z), (const GAS bf16*)(ws + WS_CKVN), (const GAS unsigned short*)(ws + WS_IDX), (GAS bf16*)(ws + WS_O), karg_in(1), gw, NGW, tid, lane, wave); }
            GRID_BAR();
            {   PHASE_IDS(); GAS unsigned char* wl = ws + WS_W0 + (size_t)l * W_LAYER;
                pg8::Gemm g{(const GAS bf16*)(ws + WS_O), (const GAS bf16*)(wl + WO_OUT), M, D, OUT_F8 ? OLD / 2 : OLD}; pg8::StaticOrder S; S.init(M, D, G, bx);
                pg8::EpiResid E{OUT_F8 ? 1.0f / (W8_SCALE * O8_SCALE) : 1.0f, (unsigned)WS_XN, (unsigned)(WS_SS + (size_t)((3 * l + 2) & 1) * SS_BYTES), f8_on(l, 1) ? (unsigned)WS_HB8 : 0u, GU_I8 ? H8I_SCALE : 0.f};
                pg8::gemm_phase<pg8::EpiResid, pg8::StaticOrder, true, true, OUT_F8 != 0>(lds + RING_OFF, g, S, E, tid); }
            GRID_BAR();
        }
    }
    {   PHASE_IDS(); final_rows((const GAS bf16*)(ws + WS_XN), karg_out(), karg_in(19), (const GAS float*)(ws + WS_SS + (size_t)(6 & 1) * SS_BYTES), gw, NGW, lane); }
}

extern "C" void kernel_launch(void* const* d_in, const int* in_sizes, int n_in, void* d_out, int out_size, void* d_ws, size_t ws_size, hipStream_t stream) {
    static int grid = 0;
    if (grid == 0) {
        if (n_in != 20 || in_sizes[0] != M * D || out_size != M * D || ws_size < WS_END) { fprintf(stderr, "kernel_launch: unexpected shapes (n_in %d, in0 %d, out %d, ws %zu); nothing launched\n", n_in, n_in > 0 ? in_sizes[0] : -1, out_size, ws_size); grid = -1; return; }
        int dev = 0, cus = 0, per_cu = 0;
        if (hipGetDevice(&dev) != hipSuccess || hipDeviceGetAttribute(&cus, hipDeviceAttributeMultiprocessorCount, dev) != hipSuccess) { grid = -1; return; }
        if (hipFuncSetAttribute((const void*)mk_fwd, hipFuncAttributeMaxDynamicSharedMemorySize, LDS_BYTES) != hipSuccess) { fprintf(stderr, "kernel_launch: hipFuncSetAttribute failed\n"); grid = -1; return; }
        if (hipOccupancyMaxActiveBlocksPerMultiprocessor(&per_cu, (const void*)mk_fwd, NWAVES * 64, LDS_BYTES) != hipSuccess || per_cu < 1) { fprintf(stderr, "kernel_launch: occupancy query reports %d workgroups per CU\n", per_cu); }
        (void)hipGetLastError();
        grid = cus;
    }
    if (grid < 0) return;
    if (hipMemsetAsync((char*)d_ws + WS_CTL, 0, CTL_ZERO_BYTES, stream) != hipSuccess) return;
    Args a{};
    for (int i = 0; i < 20; ++i) a.in[i] = (const float*)d_in[i];
    a.out = (float*)d_out; a.ws = (unsigned char*)d_ws;
    hipLaunchKernelGGL(mk_fwd, dim3(grid), dim3(NWAVES * 64), LDS_BYTES, stream, a);
}
```

```cpp
#include <hip/hip_runtime.h>
#include <cstdio>
#include <cstdint>
namespace pg8 {
#define PG8_LAS __attribute__((address_space(3)))
#define PG8_GAS __attribute__((address_space(1)))
typedef unsigned short bf16_t;
typedef short bf16x8 __attribute__((ext_vector_type(8)));
typedef float f32x4 __attribute__((ext_vector_type(4)));
typedef unsigned u32x4 __attribute__((ext_vector_type(4)));
constexpr int BM = 256, BK = 64, HALF = 128, HTB = HALF * BK * 2  , STAGE_BYTES = 8 * HTB, NXCD = 8, WGM = 4;

__host__ __device__ __forceinline__ int lds_byte(int r, int c) { const int st = (r >> 4) * 2 + (c >> 5), rr = r & 15, cc = c & 31, ob = rr * 64 + cc * 2; return st * 1024 + (ob ^ (((ob >> 9) & 1) << 5)); }
__host__ __device__ __forceinline__ void stage_rc(int b, int& R, int& C) { const int st = b / 1024, sb = b % 1024, swz = sb ^ (((sb >> 9) & 1) << 5); R = (st >> 1) * 16 + swz / 64; C = (st & 1) * 32 + (swz % 64) / 2; }
__host__ __device__ __forceinline__ int perm32(int rho) { const int n = rho >> 4, i = rho & 15; return 8 * (i >> 2) + 4 * n + (i & 3); }

typedef int i32x8 __attribute__((ext_vector_type(8))); typedef int i32x4v __attribute__((ext_vector_type(4)));
__device__ __forceinline__ i32x8 cat8(bf16x8 a, bf16x8 b) { return __builtin_shufflevector(__builtin_bit_cast(i32x4v, a), __builtin_bit_cast(i32x4v, b), 0, 1, 2, 3, 4, 5, 6, 7); }
struct Unit { int pm, pn; };
struct Gemm { const PG8_GAS bf16_t* A; const PG8_GAS bf16_t* Bt; int M, N, K; };

struct StaticOrder {
    int nM, nN, nwg, G, c;
    __host__ __device__ void init(int M, int N, int G_, int c_) { nM = M / BM; nN = N / BM; nwg = nM * nN; G = G_; c = c_; }
    __host__ __device__ bool next(int i, Unit& u) const {
        const long L = (long)i * G + c; if (L >= nwg) return false;
        int wgid = (int)L; { const int q = nwg / NXCD, r = nwg % NXCD, xcd = wgid % NXCD, off = wgid / NXCD; wgid = (xcd < r ? xcd * (q + 1) : r * (q + 1) + (xcd - r) * q) + off; }
        const int nig = WGM * nN, gid = wgid / nig, fm = gid * WGM, gsz = (nM - fm) < WGM ? (nM - fm) : WGM;
        u.pm = fm + ((wgid % nig) % gsz); u.pn = (wgid % nig) / gsz; return true;
    }
    __device__ __forceinline__ void a_ready(const Unit&) const {}
    __device__ __forceinline__ void done(const Unit&) const {}
};
__device__ __forceinline__ unsigned long long karg64(int idx) { unsigned long long r; const unsigned off = (unsigned)idx * 8u;
    asm volatile("s_load_dwordx2 %0, %1, %2\n\ts_waitcnt lgkmcnt(0)" : "=s"(r) : "s"(__builtin_amdgcn_kernarg_segment_ptr()), "s"(off) : "memory"); return r; }
__device__ __forceinline__ unsigned cvt_pk_bf16(float lo, float hi) { unsigned r; asm volatile("v_cvt_pk_bf16_f32 %0, %1, %2" : "=v"(r) : "v"(lo), "v"(hi)); return r; }
typedef float f32x2 __attribute__((ext_vector_type(2)));
__device__ __forceinline__ unsigned pack4_i8(float a, float b, float c, float d, float S) {
    const int qa = (int)__builtin_rintf(__builtin_fminf(__builtin_fmaxf(a * S, -127.f), 127.f)), qb = (int)__builtin_rintf(__builtin_fminf(__builtin_fmaxf(b * S, -127.f), 127.f));
    const int qc = (int)__builtin_rintf(__builtin_fminf(__builtin_fmaxf(c * S, -127.f), 127.f)), qd = (int)__builtin_rintf(__builtin_fminf(__builtin_fmaxf(d * S, -127.f), 127.f));
    return ((unsigned)qa & 0xffu) | (((unsigned)qb & 0xffu) << 8) | (((unsigned)qc & 0xffu) << 16) | ((unsigned)qd << 24);
}
__device__ __forceinline__ float silu_f(float g) { return g * __builtin_amdgcn_rcpf(1.0f + __builtin_amdgcn_exp2f(-1.4426950408889634f * g)); }

template <bool ACC_I32 = false>
struct EpiSwiglu {
    static constexpr bool PERM = true, AFTER_DRAIN = false;
    static __device__ __forceinline__ f32x4 cv(const f32x4& a) { if constexpr (ACC_I32) { typedef int i32x4e __attribute__((ext_vector_type(4))); const i32x4e q = __builtin_bit_cast(i32x4e, a); return (f32x4){(float)q[0], (float)q[1], (float)q[2], (float)q[3]}; } else return a; }
    PG8_GAS bf16_t* O; int ldc; const PG8_GAS float* ss; float inv_k, eps, post; float out8;
    __device__ __forceinline__ void operator()(const f32x4 (&acc)[2][2][4][2], const Unit& u, int wr, int wc, int fr, int fq) const {
        const int row0 = u.pm * BM + wr * 64 + fr, col0 = u.pn * HALF + wc * 32 + 8 * fq;
        float rs[8]; const int lane_ = fr + 16 * fq;
#pragma unroll
        for (int k = 0; k < 8; ++k) { const PG8_GAS f32x4* p4 = (const PG8_GAS f32x4*)(ss + (size_t)(row0 + (k >> 2) * HALF + (k & 3) * 16) * 32 + 8 * fq); const f32x4 a = p4[0], b = p4[1];
            float t = ((a[0] + a[1]) + (a[2] + a[3])) + ((b[0] + b[1]) + (b[2] + b[3]));
            t += __builtin_bit_cast(float, __builtin_amdgcn_ds_bpermute((lane_ ^ 16) << 2, __builtin_bit_cast(int, t)));
            t += __builtin_bit_cast(float, __builtin_amdgcn_ds_bpermute((lane_ ^ 32) << 2, __builtin_bit_cast(int, t))); rs[k] = t; }
        unsigned pk[8][2];
#pragma unroll
        for (int ai = 0; ai < 2; ++ai)
#pragma unroll
            for (int m = 0; m < 4; ++m) { PG8_GAS bf16_t* rowp = O + (size_t)(row0 + ai * HALF + m * 16) * ldc + col0;
                const float r = __builtin_amdgcn_rsqf(rs[ai * 4 + m] * inv_k + eps) * post;
                const f32x2 r2 = {r, r}, c2 = {-1.4426950408889634f * r, -1.4426950408889634f * r}; const float rs8 = out8 != 0.f ? r * out8 : r; const f32x2 q2 = {rs8, rs8}, one2 = {1.0f, 1.0f};
                f32x2 o[4];
#pragma unroll
                for (int h = 0; h < 4; ++h) { const f32x4 gq = cv(acc[ai][0][m][h >> 1]), uq = cv(acc[ai][1][m][h >> 1]);
                    const f32x2 gv = {gq[2 * (h & 1)], gq[2 * (h & 1) + 1]}, uv = {uq[2 * (h & 1)], uq[2 * (h & 1) + 1]};
                    const f32x2 t = gv * c2; f32x2 e; e.x = __builtin_amdgcn_exp2f(t.x); e.y = __builtin_amdgcn_exp2f(t.y);
                    const f32x2 d = e + one2; f32x2 rc; rc.x = __builtin_amdgcn_rcpf(d.x); rc.y = __builtin_amdgcn_rcpf(d.y);
                    o[h] = ((gv * r2) * rc) * (uv * q2); }
                if (out8 != 0.f) { int p = 0, q = 0;
                    p = __builtin_amdgcn_cvt_pk_fp8_f32(o[0].x, o[0].y, p, false); p = __builtin_amdgcn_cvt_pk_fp8_f32(o[1].x, o[1].y, p, true);
                    q = __builtin_amdgcn_cvt_pk_fp8_f32(o[2].x, o[2].y, q, false); q = __builtin_amdgcn_cvt_pk_fp8_f32(o[3].x, o[3].y, q, true);
                    pk[ai * 4 + m][0] = (unsigned)p; pk[ai * 4 + m][1] = (unsigned)q; }
                else { u32x4 w; w.x = cvt_pk_bf16(o[0].x, o[0].y); w.y = cvt_pk_bf16(o[1].x, o[1].y); w.z = cvt_pk_bf16(o[2].x, o[2].y); w.w = cvt_pk_bf16(o[3].x, o[3].y);
                    *(PG8_GAS u32x4*)rowp = w; } }
        if (out8 != 0.f) {
#pragma unroll
            for (int k = 0; k < 8; k += 2) {
                typedef unsigned u2v __attribute__((ext_vector_type(2)));
                const u2v sp = __builtin_amdgcn_permlane16_swap(pk[k][0], pk[k + 1][0], false, false), sq = __builtin_amdgcn_permlane16_swap(pk[k][1], pk[k + 1][1], false, false);
                const int kk = k + (fq & 1); const int rowk = row0 + (kk >> 2) * HALF + (kk & 3) * 16;
                u32x4 w; w.x = sp.x; w.y = sq.x; w.z = sp.y; w.w = sq.y;
                *(PG8_GAS u32x4*)((PG8_GAS unsigned char*)O + (size_t)rowk * ldc + (col0 - 8 * (fq & 1))) = w; } }
    }
};
struct EpiResid {
    static constexpr bool PERM = true, AFTER_DRAIN = false;
    float alpha; unsigned hb_off; unsigned ss_off; unsigned h8_off; float h8_i8;
    __device__ __forceinline__ void operator()(const f32x4 (&acc)[2][2][4][2], const Unit& u, int wr, int wc, int fr, int fq) const {
        constexpr int ldc = 2048;
        PG8_GAS unsigned char* wsb = (PG8_GAS unsigned char*)karg64(21); PG8_GAS bf16_t* hb = (PG8_GAS bf16_t*)(wsb + hb_off); PG8_GAS float* ss = (PG8_GAS float*)(wsb + ss_off);
        const int row0 = u.pm * BM + wr * 64 + fr, col0 = u.pn * BM + wc * 32 + 8 * fq; const int lane = fr + 16 * fq;
        u32x4 cur[2], nxt[2];
        { const size_t off = (size_t)row0 * ldc + col0; cur[0] = *(const PG8_GAS u32x4*)(hb + off); cur[1] = *(const PG8_GAS u32x4*)(hb + off + HALF); }
#pragma unroll
        for (int k = 0; k < 8; ++k) { const int ai = k >> 2, m = k & 3; const int row = row0 + ai * HALF + m * 16; const size_t off = (size_t)row * ldc + col0;
            if (k < 7) { const int ai2 = (k + 1) >> 2, m2 = (k + 1) & 3; const size_t off2 = (size_t)(row0 + ai2 * HALF + m2 * 16) * ldc + col0;
                nxt[0] = *(const PG8_GAS u32x4*)(hb + off2); nxt[1] = *(const PG8_GAS u32x4*)(hb + off2 + HALF); }
            float sq = 0.f;
#pragma unroll
            for (int bj = 0; bj < 2; ++bj) { const u32x4 b = cur[bj]; const f32x4 a0 = acc[ai][bj][m][0], a1 = acc[ai][bj][m][1]; u32x4 w;
                w.x = cvt_pk_bf16(__builtin_bit_cast(float, b.x << 16) + a0[0] * alpha, __builtin_bit_cast(float, b.x & 0xffff0000u) + a0[1] * alpha);
                w.y = cvt_pk_bf16(__builtin_bit_cast(float, b.y << 16) + a0[2] * alpha, __builtin_bit_cast(float, b.y & 0xffff0000u) + a0[3] * alpha);
                w.z = cvt_pk_bf16(__builtin_bit_cast(float, b.z << 16) + a1[0] * alpha, __builtin_bit_cast(float, b.z & 0xffff0000u) + a1[1] * alpha);
                w.w = cvt_pk_bf16(__builtin_bit_cast(float, b.w << 16) + a1[2] * alpha, __builtin_bit_cast(float, b.w & 0xffff0000u) + a1[3] * alpha);
                *(PG8_GAS u32x4*)(hb + off + bj * HALF) = w;
                if (h8_off) { typedef unsigned u32x2v __attribute__((ext_vector_type(2))); u32x2v q8; int p = 0;
                    const float e0 = __builtin_bit_cast(float, w.x << 16), e1 = __builtin_bit_cast(float, w.x & 0xffff0000u), e2 = __builtin_bit_cast(float, w.y << 16), e3 = __builtin_bit_cast(float, w.y & 0xffff0000u);
                    const float e4 = __builtin_bit_cast(float, w.z << 16), e5 = __builtin_bit_cast(float, w.z & 0xffff0000u), e6 = __builtin_bit_cast(float, w.w << 16), e7 = __builtin_bit_cast(float, w.w & 0xffff0000u);
                    if (h8_i8 != 0.f) { q8.x = pack4_i8(e0, e1, e2, e3, h8_i8); q8.y = pack4_i8(e4, e5, e6, e7, h8_i8); }
                    else { p = __builtin_amdgcn_cvt_pk_fp8_f32(e0, e1, p, false); p = __builtin_amdgcn_cvt_pk_fp8_f32(e2, e3, p, true); q8.x = (unsigned)p; p = 0;
                        p = __builtin_amdgcn_cvt_pk_fp8_f32(e4, e5, p, false); p = __builtin_amdgcn_cvt_pk_fp8_f32(e6, e7, p, true); q8.y = (unsigned)p; }
                    *(PG8_GAS u32x2v*)(wsb + h8_off + off + bj * HALF) = q8; }
#pragma unroll
                for (int e = 0; e < 4; ++e) { const float lo = __builtin_bit_cast(float, w[e] << 16), hi = __builtin_bit_cast(float, w[e] & 0xffff0000u); sq = fmaf(lo, lo, sq); sq = fmaf(hi, hi, sq); } }
            sq += __builtin_bit_cast(float, __builtin_amdgcn_ds_bpermute((lane ^ 16) << 2, __builtin_bit_cast(int, sq)));
            sq += __builtin_bit_cast(float, __builtin_amdgcn_ds_bpermute((lane ^ 32) << 2, __builtin_bit_cast(int, sq)));
            if (fq == 0) ss[(size_t)row * 32 + u.pn * 4 + wc] = sq;
            cur[0] = nxt[0]; cur[1] = nxt[1]; }
    }
};
template <bool ACC_I32 = false>
struct EpiBf16 {
    static constexpr bool PERM = true, AFTER_DRAIN = false;
    static __device__ __forceinline__ f32x4 cv(const f32x4& a) { if constexpr (ACC_I32) { typedef int i32x4e __attribute__((ext_vector_type(4))); const i32x4e q = __builtin_bit_cast(i32x4e, a); return (f32x4){(float)q[0], (float)q[1], (float)q[2], (float)q[3]}; } else return a; }
    PG8_GAS bf16_t* O; int ldc; const PG8_GAS float* ss; float inv_k, eps; float post_a, post_b, post_c;
    __device__ __forceinline__ void operator()(const f32x4 (&acc)[2][2][4][2], const Unit& u, int wr, int wc, int fr, int fq) const {
        const int row0 = u.pm * BM + wr * 64 + fr, col0 = u.pn * BM + wc * 32 + 8 * fq;
        const float pfac = fmaf(u.pn < 8 ? 1.0f : 0.0f, post_a - post_b, fmaf((u.pn >= 9 && u.pn < 13) ? 1.0f : 0.0f, post_c - post_b, post_b));
        float rs[8]; const int lane_ = fr + 16 * fq;
#pragma unroll
        for (int k = 0; k < 8; ++k) { const PG8_GAS f32x4* p4 = (const PG8_GAS f32x4*)(ss + (size_t)(row0 + (k >> 2) * HALF + (k & 3) * 16) * 32 + 8 * fq); const f32x4 a = p4[0], b = p4[1];
            float t = ((a[0] + a[1]) + (a[2] + a[3])) + ((b[0] + b[1]) + (b[2] + b[3]));
            t += __builtin_bit_cast(float, __builtin_amdgcn_ds_bpermute((lane_ ^ 16) << 2, __builtin_bit_cast(int, t)));
            t += __builtin_bit_cast(float, __builtin_amdgcn_ds_bpermute((lane_ ^ 32) << 2, __builtin_bit_cast(int, t))); rs[k] = t; }
#pragma unroll
        for (int ai = 0; ai < 2; ++ai)
#pragma unroll
            for (int m = 0; m < 4; ++m) { PG8_GAS bf16_t* rowp = O + (size_t)(row0 + ai * HALF + m * 16) * ldc + col0;
                const float r = __builtin_amdgcn_rsqf(rs[ai * 4 + m] * inv_k + eps) * pfac;
#pragma unroll
                for (int bj = 0; bj < 2; ++bj) { const f32x4 v0 = cv(acc[ai][bj][m][0]) * r, v1 = cv(acc[ai][bj][m][1]) * r;
                    u32x4 w; w.x = cvt_pk_bf16(v0[0], v0[1]); w.y = cvt_pk_bf16(v0[2], v0[3]); w.z = cvt_pk_bf16(v1[0], v1[1]); w.w = cvt_pk_bf16(v1[2], v1[3]);
                    *(PG8_GAS u32x4*)(rowp + bj * HALF) = w; } }
    }
};
template <class Epi, class Sched, bool ALIGN_EPI = false, bool SP2 = false, bool F8 = false, bool I8 = false>
__device__ __forceinline__ void gemm_phase(PG8_LAS unsigned char* lds, const Gemm g, const Sched& S, const Epi& E, int tid_in  ) {
    int tid_ = tid_in; asm volatile("" : "+v"(tid_));
    const int tid = tid_, wid = __builtin_amdgcn_readfirstlane(tid >> 6), lane = tid & 63, wr = wid >> 2, wc = wid & 3, fr = lane & 15, fq = lane >> 4;
    const int K = g.K, nt = K / BK;
    unsigned voffA[2], voffB[2];
#pragma unroll
    for (int i = 0; i < 2; ++i) { int R, C; stage_rc(tid * 16 + i * 8192, R, C); const int Rb = Epi::PERM ? ((R & ~31) + perm32(R & 31)) : R;
        voffA[i] = (unsigned)(R * K + C) * 2u; voffB[i] = (unsigned)(Rb * K + C) * 2u; }
    const size_t kstep = (size_t)(BK * 2);
    const size_t hstep = (size_t)HALF * K * 2;
    const size_t tstep = 2 * hstep;
    const unsigned ldsw = (unsigned)wid * 1024u;
    const int aoff = lds_byte(wr * 64 + fr, fq * 8), boff = lds_byte(wc * 32 + fr, fq * 8);
#define PG8_SA(b, h) (((b) * 2 + (h)) * HTB)
#define PG8_SB(b, h) ((4 + (b) * 2 + (h)) * HTB)
#define PG8_STAGE(bufoff, gbase, voff) do { _Pragma("unroll") for (int _i = 0; _i < 2; ++_i) \
        __builtin_amdgcn_global_load_lds((const PG8_GAS unsigned*)((const PG8_GAS char*)(gbase) + (voff)[_i]), (PG8_LAS unsigned*)(lds + (bufoff) + ldsw + _i * 8192), 16, 0, 0); } while (0)
#define PG8_LDA(dst, b, h) do { _Pragma("unroll") for (int m = 0; m < 4; ++m) _Pragma("unroll") for (int k = 0; k < 2; ++k) dst[m][k] = *(const PG8_LAS bf16x8*)(lds + PG8_SA(b, h) + aoff + m * 2048 + k * 1024); } while (0)
#define PG8_LDB(dst, b, h) do { _Pragma("unroll") for (int n = 0; n < 2; ++n) _Pragma("unroll") for (int k = 0; k < 2; ++k) dst[n][k] = *(const PG8_LAS bf16x8*)(lds + PG8_SB(b, h) + boff + n * 2048 + k * 1024); } while (0)
#define PG8_MMA(ai, bj, At, Bt) do { __builtin_amdgcn_s_setprio(1); _Pragma("unroll") for (int m = 0; m < 4; ++m) _Pragma("unroll") for (int n = 0; n < 2; ++n) { \
        if constexpr (F8) { asm volatile("v_mfma_f32_16x16x128_f8f6f4 %0, %1, %2, %0" : "+v"(acc[ai][bj][m][n]) : "v"(cat8(Bt[n][0], Bt[n][1])), "v"(cat8(At[m][0], At[m][1]))); } \
        else if constexpr (I8) { _Pragma("unroll") for (int k = 0; k < 2; ++k) asm volatile("v_mfma_i32_16x16x64_i8 %0, %1, %2, %0" : "+v"(acc[ai][bj][m][n]) : "v"(Bt[n][k]), "v"(At[m][k])); } \
        else { _Pragma("unroll") for (int k = 0; k < 2; ++k) acc[ai][bj][m][n] = __builtin_amdgcn_mfma_f32_16x16x32_bf16(Bt[n][k], At[m][k], acc[ai][bj][m][n], 0, 0, 0); } } \
        __builtin_amdgcn_s_setprio(0); } while (0)
#define PG8_WAIT_V(n) asm volatile("s_waitcnt vmcnt(" #n ")" ::: "memory")
#define PG8_WAIT_L(n) asm volatile("s_waitcnt lgkmcnt(" #n ")" ::: "memory")
#define PG8_BAR __builtin_amdgcn_s_barrier()
#define PG8_SCHED __builtin_amdgcn_sched_barrier(0)
    Unit cur, nxt; int ui = 0;
    if (!S.next(0, cur)) return;
    f32x4 acc[2][2][4][2];
#pragma unroll
    for (int a = 0; a < 2; ++a)
#pragma unroll
        for (int b = 0; b < 2; ++b)
#pragma unroll
            for (int m = 0; m < 4; ++m)
#pragma unroll
                for (int n = 0; n < 2; ++n) acc[a][b][m][n] = (f32x4){0.f, 0.f, 0.f, 0.f};
    bf16x8 At[4][2], B0[2][2], B1[2][2];
    const PG8_GAS char* cA = (const PG8_GAS char*)g.A + (size_t)cur.pm * tstep; const PG8_GAS char* cB = (const PG8_GAS char*)g.Bt + (size_t)cur.pn * tstep;
    S.a_ready(cur);
    if constexpr (SP2) {
        PG8_STAGE(PG8_SB(0, 0), cB, voffB); PG8_STAGE(PG8_SB(0, 1), cB + hstep, voffB); PG8_STAGE(PG8_SA(0, 0), cA, voffA); PG8_STAGE(PG8_SA(0, 1), cA + hstep, voffA);
        if (wr == 1) PG8_BAR;
        PG8_WAIT_V(2); PG8_BAR;
        PG8_STAGE(PG8_SB(1, 0), cB + kstep, voffB); PG8_STAGE(PG8_SA(1, 0), cA + kstep, voffA); PG8_STAGE(PG8_SB(1, 1), cB + hstep + kstep, voffB);
        PG8_WAIT_V(6); PG8_BAR;
    } else {
        PG8_STAGE(PG8_SB(0, 0), cB, voffB); PG8_STAGE(PG8_SA(0, 0), cA, voffA); PG8_STAGE(PG8_SB(0, 1), cB + hstep, voffB); PG8_STAGE(PG8_SA(0, 1), cA + hstep, voffA);
        if (wr == 1) PG8_BAR;
        PG8_WAIT_V(4); PG8_BAR;
        PG8_STAGE(PG8_SB(1, 0), cB + kstep, voffB); PG8_STAGE(PG8_SA(1, 0), cA + kstep, voffA); PG8_STAGE(PG8_SB(1, 1), cB + hstep + kstep, voffB);
        PG8_WAIT_V(6); PG8_BAR;
    }
    for (;;) {
        const bool has_next = S.next(ui + 1, nxt);
        const PG8_GAS char* nA = has_next ? (const PG8_GAS char*)g.A + (size_t)nxt.pm * tstep : cA; const PG8_GAS char* nB = has_next ? (const PG8_GAS char*)g.Bt + (size_t)nxt.pn * tstep : cB;
        for (int t = 0; t < nt; t += 2) {
            const bool last = (t == nt - 2);
            const PG8_GAS char* a1 = cA + (size_t)(t + 1) * kstep;
            const PG8_GAS char* a2 = last ? nA : cA + (size_t)(t + 2) * kstep; const PG8_GAS char* b2 = last ? nB : cB + (size_t)(t + 2) * kstep;
            const PG8_GAS char* a3 = a2 + kstep; const PG8_GAS char* b3 = b2 + kstep;
            if (last && has_next) S.a_ready(nxt);
            if constexpr (SP2) {
            PG8_LDB(B0, 0, 0); PG8_LDB(B1, 0, 1); PG8_SCHED; PG8_LDA(At, 0, 0); PG8_STAGE(PG8_SA(1, 1), a1 + hstep, voffA);
            PG8_WAIT_V(8); PG8_WAIT_L(0); PG8_BAR; PG8_MMA(0, 0, At, B0); PG8_MMA(0, 1, At, B1); PG8_BAR; PG8_SCHED;
            PG8_LDA(At, 0, 1); PG8_STAGE(PG8_SB(0, 0), b2, voffB); PG8_STAGE(PG8_SB(0, 1), b2 + hstep, voffB); PG8_STAGE(PG8_SA(0, 0), a2, voffA);
            PG8_WAIT_V(8); PG8_WAIT_L(0); PG8_BAR; PG8_MMA(1, 0, At, B0); PG8_MMA(1, 1, At, B1); PG8_BAR; PG8_SCHED;
            PG8_LDB(B0, 1, 0); PG8_LDB(B1, 1, 1); PG8_SCHED; PG8_LDA(At, 1, 0); PG8_STAGE(PG8_SA(0, 1), a2 + hstep, voffA);
            PG8_WAIT_V(8); PG8_WAIT_L(0); PG8_BAR; PG8_MMA(0, 0, At, B0); PG8_MMA(0, 1, At, B1); PG8_BAR; PG8_SCHED;
            PG8_LDA(At, 1, 1); PG8_STAGE(PG8_SB(1, 0), b3, voffB); PG8_STAGE(PG8_SB(1, 1), b3 + hstep, voffB); PG8_STAGE(PG8_SA(1, 0), a3, voffA);
            PG8_WAIT_V(8); PG8_WAIT_L(0); PG8_BAR; PG8_MMA(1, 0, At, B0); PG8_MMA(1, 1, At, B1); PG8_BAR; PG8_SCHED;
            } else {
            PG8_LDB(B0, 0, 0); PG8_SCHED; PG8_LDA(At, 0, 0); PG8_STAGE(PG8_SA(1, 1), a1 + hstep, voffA);
            PG8_WAIT_L(8); PG8_BAR; PG8_WAIT_L(0); PG8_MMA(0, 0, At, B0); PG8_BAR; PG8_SCHED;
            PG8_LDB(B1, 0, 1); PG8_STAGE(PG8_SB(0, 0), b2, voffB);
            PG8_BAR; PG8_WAIT_L(0); PG8_MMA(0, 1, At, B1); PG8_BAR;
            PG8_LDA(At, 0, 1); PG8_STAGE(PG8_SA(0, 0), a2, voffA);
            PG8_BAR; PG8_WAIT_L(0); PG8_MMA(1, 0, At, B0); PG8_BAR; PG8_SCHED;
            PG8_STAGE(PG8_SB(0, 1), b2 + hstep, voffB);
            PG8_WAIT_V(6); PG8_BAR; PG8_MMA(1, 1, At, B1); PG8_BAR;
            PG8_LDB(B0, 1, 0); PG8_SCHED; PG8_LDA(At, 1, 0); PG8_STAGE(PG8_SA(0, 1), a2 + hstep, voffA);
            PG8_WAIT_L(8); PG8_BAR; PG8_WAIT_L(0); PG8_MMA(0, 0, At, B0); PG8_BAR; PG8_SCHED;
            PG8_LDB(B1, 1, 1); PG8_STAGE(PG8_SB(1, 0), b3, voffB);
            PG8_BAR; PG8_WAIT_L(0); PG8_MMA(0, 1, At, B1); PG8_BAR;
            PG8_LDA(At, 1, 1); PG8_STAGE(PG8_SA(1, 0), a3, voffA);
            PG8_BAR; PG8_WAIT_L(0); PG8_MMA(1, 0, At, B0); PG8_BAR; PG8_SCHED;
            PG8_STAGE(PG8_SB(1, 1), b3 + hstep, voffB);
            PG8_WAIT_V(6); PG8_BAR; PG8_MMA(1, 1, At, B1); PG8_BAR;
            }
        }
        if constexpr (ALIGN_EPI) { if (wr == 0) PG8_BAR; }
        if constexpr (!Epi::AFTER_DRAIN) { int ln_; asm volatile("v_mbcnt_lo_u32_b32 %0, -1, 0\n\tv_mbcnt_hi_u32_b32 %0, -1, %0" : "=v"(ln_));
            E(acc, cur, wr, wc, ln_ & 15, ln_ >> 4); S.done(cur); }
        if (!has_next) break;
#pragma unroll
        for (int a = 0; a < 2; ++a)
#pragma unroll
            for (int b = 0; b < 2; ++b)
#pragma unroll
                for (int m = 0; m < 4; ++m)
#pragma unroll
                    for (int n = 0; n < 2; ++n) acc[a][b][m][n] = (f32x4){0.f, 0.f, 0.f, 0.f};
        cur = nxt; cA = nA; cB = nB; ++ui;
        if constexpr (ALIGN_EPI) { if (wr == 1) PG8_BAR; }
    }
    PG8_WAIT_V(0);
    if constexpr (!ALIGN_EPI) { if (wr == 0) PG8_BAR; }
    PG8_BAR;
    if constexpr (Epi::AFTER_DRAIN) { E.fused(acc, cur, wr, wc, fr, fq, lds, wid, lane); S.done(cur); }
#undef PG8_SA
#undef PG8_SB
#undef PG8_STAGE
#undef PG8_LDA
#undef PG8_LDB
#undef PG8_MMA
#undef PG8_WAIT_V
#undef PG8_WAIT_L
#undef PG8_BAR
#undef PG8_SCHED
}
}
constexpr int NWAVES = 8;
constexpr int BATCH = 8, SEQ = 4096, D = 2048, FF = 5632, DEPTH = 2;
constexpr int M = BATCH * SEQ;
constexpr int NGU = 2 * FF;
constexpr int H_A = 8, HD_A = 128, RANK = 256, IH = 8, IDIM = 64, TOPK = 256;
constexpr int H_B = 16, KVH = 2, GQA = 8, HD_B = 64, WINDOW = 128;
constexpr int D_IN = 3144;
constexpr float EPS = 1e-6f;
constexpr size_t MiB = 1u << 20;
constexpr size_t WS_CTL = 0, CTL_ZERO_BYTES = 1 * MiB;
#ifndef F8_MASK
#define F8_MASK 0xF
#endif
constexpr float W8_SCALE = 64.0f;
#ifndef GU_I8
#define GU_I8 1
#endif
constexpr float H8I_SCALE = 127.0f / 4.6f, W8I_SCALE = 127.0f / (4.2f * 0.022097086912079608f);
#ifndef D8_MASK
#define D8_MASK 0xF
#endif
constexpr float A8_SCALE = 8.0f;
__host__ __device__ constexpr bool d8_on(int l, int f) { return ((D8_MASK >> (2 * l + f)) & 1) != 0; }
constexpr float O8_SCALE = 16.0f;
#ifndef OUT_F8
#define OUT_F8 1
#endif
constexpr bool F8_ALL1 = (F8_MASK & 0x5) == 0x5, F8_ALL2 = (F8_MASK & 0xA) == 0xA;
__host__ __device__ constexpr bool f8_on(int l, int f) { return ((F8_MASK >> (2 * l + f)) & 1) != 0; }
constexpr size_t GU1_B = (F8_ALL1 ? 22 : 44) * MiB, GU2_B = (F8_ALL2 ? 22 : 44) * MiB;
constexpr size_t WS_W0 = 2 * MiB;
constexpr size_t WO_GU1 = 0, WO_D1 = GU1_B, WO_GU2 = WO_D1 + 22 * MiB, WO_D2 = WO_GU2 + GU2_B, WO_IN = WO_D2 + 22 * MiB, WO_OUT = WO_IN + 17 * MiB, W_LAYER = WO_OUT + 12 * MiB;
constexpr size_t WS_XN = WS_W0 + 2 * W_LAYER;
constexpr size_t WS_HB8 = WS_XN + 128 * MiB;
constexpr size_t WS_ACT = WS_HB8 + (F8_MASK ? 64 : 0) * MiB;
constexpr size_t WS_Z = WS_ACT, WS_CKVN = WS_ACT + 272 * MiB, WS_KIN = WS_ACT + 288 * MiB, WS_WIF = WS_ACT + 292 * MiB, WS_IDX = WS_ACT + 294 * MiB;
constexpr int ZLD = 4352, ZC_QLAT = 0, ZC_CKV = 2048, ZC_QB = 2304, ZC_KB = 3328, ZC_VB = 3456, ZC_QI = 3584, ZC_KI = 4096, ZC_WI = 4160;
constexpr int ZN8 = 3584;
#ifndef IN_I8
#define IN_I8 1
#endif
constexpr float WQ8I_SCALE = 127.0f / (4.2f * 0.015625f);
constexpr int OLD = 3072;
constexpr size_t WS_O = WS_ACT + 352 * MiB;
constexpr size_t WS_SS = WS_O + (OUT_F8 ? 96 : 192) * MiB, SS_BYTES = 4 * MiB;
constexpr size_t WS_SCR = WS_SS + 2 * SS_BYTES;
constexpr size_t SCR_GROUPS = 64 * 65, SCR_BYTES = (size_t)8 * SCR_GROUPS * 8 * 64 * 8;
constexpr size_t WS_END = WS_SCR + SCR_BYTES;
static_assert(WS_END <= 1024 * MiB, "d_ws map exceeds 1 GiB");
constexpr int CW_TMO = 0, CW_CODE = 1, CW_BAR = 4096, CW_XRANK = 8192;
constexpr int RING_OFF = 0, RING_BYTES = 131072;
constexpr int LDSCTL_OFF = RING_BYTES, MISC_OFF = LDSCTL_OFF + 320;
constexpr int LDS_BYTES = 147456;
constexpr int RSL_OFF = RING_BYTES + 5632;
#define GAS __attribute__((address_space(1)))
#define LAS __attribute__((address_space(3)))
typedef unsigned short bf16;
typedef unsigned v4u __attribute__((ext_vector_type(4)));
typedef float f32x4 __attribute__((ext_vector_type(4)));
typedef short bf16x8 __attribute__((ext_vector_type(8)));
typedef GAS unsigned gu32;
typedef GAS unsigned long long gu64;
#define RLX_AGENT __ATOMIC_RELAXED, __HIP_MEMORY_SCOPE_AGENT
#define LDS_WAIT() asm volatile("s_waitcnt lgkmcnt(0)" ::: "memory")
#define VM_WAIT() asm volatile("s_waitcnt vmcnt(0)" ::: "memory")
__device__ __forceinline__ unsigned long long rt() { return __builtin_amdgcn_s_memrealtime(); }
__device__ __forceinline__ unsigned f2bf(float f) { unsigned u = __builtin_bit_cast(unsigned, f); return (u + 0x7fffu + ((u >> 16) & 1u)) >> 16; }
__device__ __forceinline__ unsigned pk2(float lo, float hi) { return f2bf(lo) | (f2bf(hi) << 16); }

#define XB_TMO      128
#define XB_XCNT(j)  (256  + 64 * (j))
#define XB_XSUB(j)  (1280 + 64 * (j))
#define XB_XGEN(j)  (2304 + 64 * (j))
#define XB_TOP      3328
#define XB_TOPGEN   3392
#define XCD_BAR_WORDS 3456
#define XB_SPIN_CAP (1u << 18)

__device__ __forceinline__ unsigned xb_ld(unsigned* p)              { return __hip_atomic_load(p, __ATOMIC_RELAXED, __HIP_MEMORY_SCOPE_AGENT); }
__device__ __forceinline__ unsigned xb_add(unsigned* p, unsigned v) { return __hip_atomic_fetch_add(p, v, __ATOMIC_RELAXED, __HIP_MEMORY_SCOPE_AGENT); }
__device__ __forceinline__ unsigned xb_xcc_id() { return (unsigned)__builtin_amdgcn_s_getreg((3 << 11) | 20) & 0xFu; }
#define XB_SPIN(cond, bar) do { unsigned _sp = 0; while (cond) { __builtin_amdgcn_s_sleep(1); \
    if ((++_sp & 255u) == 0u) { if (xb_ld(&(bar)[XB_TMO])) break; if (_sp > XB_SPIN_CAP) { atomicAdd(&(bar)[XB_TMO], 1u); break; } } } } while (0)

struct XcdBarrier {
    unsigned* bar; unsigned x;
    volatile LAS unsigned* st;
};

__device__ __forceinline__ XcdBarrier xcd_barrier_post(unsigned* bar, volatile LAS unsigned* st, bool leader  ) {
    XcdBarrier b; b.bar = bar; b.x = xb_xcc_id(); b.st = st;
    if (leader) (void)xb_add(&bar[XB_XCNT(b.x)], 1u);
    return b;
}
__device__ __forceinline__ void xcd_barrier_complete(unsigned* bar, unsigned x, unsigned& nloc, unsigned& nx) {
    const unsigned G = gridDim.x * gridDim.y * gridDim.z;
    unsigned sum, cnt, mine, sp = 0u;
    for (;;) {
        sum = 0u; cnt = 0u; mine = 0u;
#pragma unroll
        for (unsigned j = 0; j < 16; ++j) { const unsigned c = xb_ld(&bar[XB_XCNT(j)]); sum += c; cnt += (c > 0u) ? 1u : 0u; mine = (j == x) ? c : mine; }
        if (sum == G) break;
        __builtin_amdgcn_s_sleep(1);
        if ((++sp & 255u) == 0u) { if (xb_ld(&bar[XB_TMO])) break; if (sp > XB_SPIN_CAP) { atomicAdd(&bar[XB_TMO], 1u); break; } }
    }
    nloc = mine > 0u ? mine : 1u; nx = cnt > 0u ? cnt : 1u;
}

__device__ __forceinline__ void xcd_barrier(const XcdBarrier& b, bool leader  ) {
    asm volatile("s_waitcnt vmcnt(0)" ::: "memory");
    __syncthreads();
    if (leader) {
        unsigned* bar = b.bar;
        __builtin_amdgcn_s_waitcnt(0);
        unsigned nloc = b.st[0], nx = b.st[1];
        if (nloc == 0u) { xcd_barrier_complete(bar, b.x, nloc, nx); b.st[0] = nloc; b.st[1] = nx; }
        const unsigned old = xb_add(&bar[XB_XSUB(b.x)], 1u);
        const unsigned gen = old / nloc;
        if (old + 1u == (gen + 1u) * nloc) {
            __builtin_amdgcn_fence(__ATOMIC_RELEASE, "agent");
            asm volatile("s_waitcnt vmcnt(0)" ::: "memory");
            const unsigned og = xb_add(&bar[XB_TOP], 1u);
            const unsigned tg = og / nx;
            if (og + 1u == (tg + 1u) * nx) xb_add(&bar[XB_TOPGEN], 1u);
            else XB_SPIN(xb_ld(&bar[XB_TOPGEN]) == tg, bar);
            __builtin_amdgcn_fence(__ATOMIC_ACQUIRE, "agent");
            xb_add(&bar[XB_XGEN(b.x)], 1u);
            asm volatile("s_waitcnt vmcnt(0)" ::: "memory");
        } else {
            XB_SPIN(xb_ld(&bar[XB_XGEN(b.x)]) == gen, bar);
            __builtin_amdgcn_fence(__ATOMIC_ACQUIRE, "agent");
            asm volatile("s_waitcnt vmcnt(0)" ::: "memory");
        }
    }
    __syncthreads();
}
__constant__ unsigned char T5_BUCKET[128] = {0, 1, 2, 3, 4, 5, 6, 7, 8, 9, 10, 11, 12, 13, 14, 15, 16, 16, 16, 17, 17, 18, 18, 18, 19, 19, 19, 20, 20, 20, 20, 21, 21, 21, 21, 22, 22, 22, 22, 22, 23, 23, 23, 23, 23, 23, 24, 24, 24, 24, 24, 24, 25, 25, 25, 25, 25, 25, 25, 26, 26, 26, 26, 26, 26, 26, 26, 27, 27, 27, 27, 27, 27, 27, 27, 27, 27, 28, 28, 28, 28, 28, 28, 28, 28, 28, 28, 29, 29, 29, 29, 29, 29, 29, 29, 29, 29, 29, 29, 30, 30, 30, 30, 30, 30, 30, 30, 30, 30, 30, 30, 30, 30, 31, 31, 31, 31, 31, 31, 31, 31, 31, 31, 31, 31, 31, 31, 31};
typedef short s16x4 __attribute__((ext_vector_type(4)));
typedef float f32x16 __attribute__((ext_vector_type(16)));
__device__ __forceinline__ float bf2f(unsigned short b) { return __builtin_bit_cast(float, (unsigned)b << 16); }
__device__ __forceinline__ bf16x8 cat4(s16x4 lo, s16x4 hi) { return __builtin_shufflevector(lo, hi, 0, 1, 2, 3, 4, 5, 6, 7); }
__device__ __forceinline__ void tr_read4(unsigned a0, unsigned a1, unsigned a2, unsigned a3, s16x4& r0, s16x4& r1, s16x4& r2, s16x4& r3) {
    asm volatile("ds_read_b64_tr_b16 %0, %4\n\tds_read_b64_tr_b16 %1, %5\n\tds_read_b64_tr_b16 %2, %6\n\tds_read_b64_tr_b16 %3, %7\n\ts_waitcnt lgkmcnt(0)"
                 : "=&v"(r0), "=&v"(r1), "=&v"(r2), "=&v"(r3) : "v"(a0), "v"(a1), "v"(a2), "v"(a3) : "memory");
}
#define SHX(x, o) __builtin_bit_cast(float, __builtin_amdgcn_ds_bpermute(((lane) ^ (o)) << 2, __builtin_bit_cast(int, (float)(x))))
#define SHXU(x, o) ((unsigned)__builtin_amdgcn_ds_bpermute(((lane) ^ (o)) << 2, (int)(x)))
__device__ __forceinline__ float wave_sum(float v, int lane) {
#pragma unroll
    for (int o = 1; o < 64; o <<= 1) v += SHX(v, o);
    return v;
}
template <int OUT8 = 0>
__device__ __forceinline__ void conv_item(const GAS float* W, int ldw, int k0, int c0, int nvalid, GAS bf16* dst, int dld, int drow0, int dk0, float scale, const GAS float* gain, LAS float* scr, int lane) {
    const int c = lane & 31;
    float vin[32];
#pragma unroll
    for (int i = 0; i < 32; ++i) { const int kk = 2 * i + (lane >> 5); vin[i] = 0.f;
        if (c < nvalid) vin[i] = W[(size_t)(k0 + kk) * ldw + c0 + c]; }
#pragma unroll
    for (int i = 0; i < 32; ++i) { const int kk = 2 * i + (lane >> 5); scr[kk * 33 + c] = vin[i] * scale; }
    LDS_WAIT(); asm volatile("" ::: "memory");
    const int c8 = lane & 7;
    f32x4 ga = {1.f, 1.f, 1.f, 1.f}, gb = {1.f, 1.f, 1.f, 1.f};
    if (gain) { ga = *(const GAS f32x4*)(gain + k0 + 8 * c8); gb = *(const GAS f32x4*)(gain + k0 + 8 * c8 + 4); }
#pragma unroll
    for (int j = 0; j < 4; ++j) { const int n = (lane >> 3) + 8 * j; const LAS float* s = scr + (8 * c8) * 33 + n;
        if constexpr (OUT8 == 2) { const unsigned p = pg8::pack4_i8(s[0 * 33] * ga.x, s[1 * 33] * ga.y, s[2 * 33] * ga.z, s[3 * 33] * ga.w, 1.0f), q = pg8::pack4_i8(s[4 * 33] * gb.x, s[5 * 33] * gb.y, s[6 * 33] * gb.z, s[7 * 33] * gb.w, 1.0f);
            *(GAS unsigned long long*)((GAS unsigned char*)dst + (size_t)(drow0 + n) * dld + dk0 + k0 + 8 * c8) = (unsigned long long)p | ((unsigned long long)q << 32); }
        else if constexpr (OUT8 == 1) { int p = 0, q = 0;
            p = __builtin_amdgcn_cvt_pk_fp8_f32(s[0 * 33] * ga.x, s[1 * 33] * ga.y, p, false); p = __builtin_amdgcn_cvt_pk_fp8_f32(s[2 * 33] * ga.z, s[3 * 33] * ga.w, p, true);
            q = __builtin_amdgcn_cvt_pk_fp8_f32(s[4 * 33] * gb.x, s[5 * 33] * gb.y, q, false); q = __builtin_amdgcn_cvt_pk_fp8_f32(s[6 * 33] * gb.z, s[7 * 33] * gb.w, q, true);
            *(GAS unsigned long long*)((GAS unsigned char*)dst + (size_t)(drow0 + n) * dld + dk0 + k0 + 8 * c8) = (unsigned long long)(unsigned)p | ((unsigned long long)(unsigned)q << 32); }
        else { v4u o; o.x = pk2(s[0 * 33] * ga.x, s[1 * 33] * ga.y); o.y = pk2(s[2 * 33] * ga.z, s[3 * 33] * ga.w); o.z = pk2(s[4 * 33] * gb.x, s[5 * 33] * gb.y); o.w = pk2(s[6 * 33] * gb.z, s[7 * 33] * gb.w);
            *(GAS v4u*)(dst + (size_t)(drow0 + n) * dld + dk0 + k0 + 8 * c8) = o; } }
    LDS_WAIT(); asm volatile("" ::: "memory");
}
__device__ __forceinline__ void rmsnorm_rows_bf16(const GAS float* X, const GAS float* g, GAS bf16* O, int gw, int NGW, int lane) {
    f32x4 gv[8];
#pragma unroll
    for (int j = 0; j < 8; ++j) gv[j] = ((const GAS f32x4*)g)[lane + 64 * j];
    for (int m = gw; m < M; m += NGW) {
        const GAS f32x4* xr = (const GAS f32x4*)(X + (size_t)m * D) + lane;
        f32x4 v[8]; float s = 0.f;
#pragma unroll
        for (int j = 0; j < 8; ++j) { v[j] = xr[64 * j]; s += (v[j].x * v[j].x + v[j].y * v[j].y) + (v[j].z * v[j].z + v[j].w * v[j].w); }
        const float r = 1.0f / sqrtf(wave_sum(s, lane) * (1.0f / D) + EPS);
        GAS unsigned long long* o8 = (GAS unsigned long long*)(O + (size_t)m * D) + lane;
#pragma unroll
        for (int j = 0; j < 8; ++j) { const f32x4 y = v[j] * r * gv[j]; o8[64 * j] = (unsigned long long)pk2(y.x, y.y) | ((unsigned long long)pk2(y.z, y.w) << 32); }
    }
}
__device__ __forceinline__ void rows_bf16_ss(const GAS float* X, GAS bf16* O, GAS unsigned char* O8, GAS float* ss, int gw, int NGW, int lane) {
    for (int m = gw; m < M; m += NGW) {
        const GAS f32x4* xr = (const GAS f32x4*)(X + (size_t)m * D) + lane;
        f32x4 v[8]; float s = 0.f;
#pragma unroll
        for (int j = 0; j < 8; ++j) { v[j] = xr[64 * j]; s += (v[j].x * v[j].x + v[j].y * v[j].y) + (v[j].z * v[j].z + v[j].w * v[j].w); }
        s = wave_sum(s, lane);
        GAS unsigned long long* o8 = (GAS unsigned long long*)(O + (size_t)m * D) + lane;
#pragma unroll
        for (int j = 0; j < 8; ++j) o8[64 * j] = (unsigned long long)pk2(v[j].x, v[j].y) | ((unsigned long long)pk2(v[j].z, v[j].w) << 32);
        if (O8) { GAS unsigned* q8 = (GAS unsigned*)(O8 + (size_t)m * D) + lane;
#pragma unroll
            for (int j = 0; j < 8; ++j) { if constexpr (GU_I8) q8[64 * j] = pg8::pack4_i8(v[j].x, v[j].y, v[j].z, v[j].w, H8I_SCALE); else { int p = 0; p = __builtin_amdgcn_cvt_pk_fp8_f32(v[j].x, v[j].y, p, false); p = __builtin_amdgcn_cvt_pk_fp8_f32(v[j].z, v[j].w, p, true); q8[64 * j] = (unsigned)p; } } }
        if (lane < 32) ss[(size_t)m * 32 + lane] = lane == 0 ? s : 0.f;
    }
}
__device__ __forceinline__ void final_rows(const GAS bf16* HB, GAS float* OUT, const GAS float* g, const GAS float* ss, int gw, int NGW, int lane) {
    f32x4 gv[8];
#pragma unroll
    for (int j = 0; j < 8; ++j) gv[j] = ((const GAS f32x4*)g)[lane + 64 * j];
    for (int m = gw; m < M; m += NGW) {
        const GAS unsigned long long* hr = (const GAS unsigned long long*)(HB + (size_t)m * D) + lane; GAS f32x4* orow = (GAS f32x4*)(OUT + (size_t)m * D) + lane;
        unsigned long long raw[8];
#pragma unroll
        for (int j = 0; j < 8; ++j) raw[j] = hr[64 * j];
        const float r = 1.0f / sqrtf(wave_sum(lane < 32 ? ss[(size_t)m * 32 + lane] : 0.f, lane) * (1.0f / D) + EPS);
#pragma unroll
        for (int j = 0; j < 8; ++j) { const unsigned lo = (unsigned)raw[j], hi = (unsigned)(raw[j] >> 32);
            f32x4 v = {__builtin_bit_cast(float, lo << 16), __builtin_bit_cast(float, lo & 0xffff0000u), __builtin_bit_cast(float, hi << 16), __builtin_bit_cast(float, hi & 0xffff0000u)};
            orow[64 * j] = v * r * gv[j]; }
    }
}
__device__ __forceinline__ void rmsnorm_rows_f32_inplace(GAS float* X, const GAS float* g, int gw, int NGW, int lane) {
    f32x4 gv[8];
#pragma unroll
    for (int j = 0; j < 8; ++j) gv[j] = ((const GAS f32x4*)g)[lane + 64 * j];
    for (int m = gw; m < M; m += NGW) {
        GAS f32x4* xr = (GAS f32x4*)(X + (size_t)m * D) + lane;
        f32x4 v[8]; float s = 0.f;
#pragma unroll
        for (int j = 0; j < 8; ++j) { v[j] = xr[64 * j]; s += (v[j].x * v[j].x + v[j].y * v[j].y) + (v[j].z * v[j].z + v[j].w * v[j].w); }
        const float r = 1.0f / sqrtf(wave_sum(s, lane) * (1.0f / D) + EPS);
#pragma unroll
        for (int j = 0; j < 8; ++j) xr[64 * j] = v[j] * r * gv[j];
    }
}

template <bool P_IFAST, int OUT8 = 0>
__device__ __forceinline__ void absorb_unit(const GAS float* Psrc, size_t p_ri, size_t p_rd, const GAS float* Qsrc, size_t q_rj, GAS bf16* out, size_t out_ld, float scale, const GAS float* qgain, LAS float* Ps_, LAS float* Qs_, int tid) {
    LAS bf16* Ps = (LAS bf16*)Ps_; LAS bf16* Qs = Ps + 64 * 136;
    float pv[16], qv[16];
#pragma unroll
    for (int j = 0; j < 16; ++j) { const int e = tid + 512 * j; const int i = P_IFAST ? (e & 63) : (e >> 7), d = P_IFAST ? (e >> 6) : (e & 127);
        pv[j] = Psrc[(size_t)i * p_ri + (size_t)d * p_rd];
        const int jj = e >> 7, dd = e & 127; qv[j] = Qsrc[(size_t)jj * q_rj + dd] * (qgain ? qgain[jj] : 1.0f); }
#pragma unroll
    for (int j = 0; j < 16; ++j) { const int e = tid + 512 * j; const int i = P_IFAST ? (e & 63) : (e >> 7), d = P_IFAST ? (e >> 6) : (e & 127);
        Ps[i * 136 + d] = (bf16)f2bf(pv[j]); const int jj = e >> 7, dd = e & 127; Qs[jj * 136 + dd] = (bf16)f2bf(qv[j]); }
    __syncthreads();
    const int wv = tid >> 6, ln = tid & 63, it = wv >> 1, r16 = ln & 15, g = ln >> 4;
#pragma unroll
    for (int jq = 0; jq < 2; ++jq) { const int jt = 2 * (wv & 1) + jq; f32x4 acc = {0.f, 0.f, 0.f, 0.f};
#pragma unroll
        for (int st = 0; st < 4; ++st) { const bf16x8 a = *(const LAS bf16x8*)(Ps + (16 * it + r16) * 136 + 32 * st + 8 * g); const bf16x8 b = *(const LAS bf16x8*)(Qs + (16 * jt + r16) * 136 + 32 * st + 8 * g);
            acc = __builtin_amdgcn_mfma_f32_16x16x32_bf16(a, b, acc, 0, 0, 0); }
#pragma unroll
        for (int rg = 0; rg < 4; ++rg) { const size_t o = (size_t)(16 * it + 4 * g + rg) * out_ld + 16 * jt + r16;
            if constexpr (OUT8 == 2) ((GAS unsigned char*)out)[o] = (unsigned char)(pg8::pack4_i8(acc[rg], 0.f, 0.f, 0.f, scale) & 0xffu);
            else if constexpr (OUT8 == 1) ((GAS unsigned char*)out)[o] = (unsigned char)__builtin_amdgcn_cvt_pk_fp8_f32(acc[rg] * scale, 0.f, 0, false);
            else out[o] = (bf16)f2bf(acc[rg] * scale); } }
    __syncthreads();
}
__device__ __forceinline__ void post_rows(const GAS bf16* Z, const GAS float* gkv, const GAS float* gki, const GAS float* bki, GAS bf16* CKVN, GAS bf16* KIN, GAS float* WIF, int gw, int NGW, int lane) {
    const f32x4 g4 = ((const GAS f32x4*)gkv)[lane]; const float gk = gki[lane], bk = bki[lane];
    for (int m = gw; m < M; m += NGW) {
        const GAS bf16* zr = Z + (size_t)m * ZLD;
        const unsigned long long raw = *(const GAS unsigned long long*)(zr + ZC_CKV + 4 * lane);
        const float kraw = bf2f(zr[ZC_KI + lane]);
        const float wraw = bf2f(zr[ZC_WI + (lane & 7)]);
        const float c0 = bf2f((unsigned short)raw), c1 = bf2f((unsigned short)(raw >> 16)), c2 = bf2f((unsigned short)(raw >> 32)), c3 = bf2f((unsigned short)(raw >> 48));
        const float r = 1.0f / sqrtf(wave_sum((c0 * c0 + c1 * c1) + (c2 * c2 + c3 * c3), lane) * (1.0f / RANK) + EPS);
        *(GAS unsigned long long*)(CKVN + (size_t)m * RANK + 4 * lane) = (unsigned long long)pk2(c0 * r * g4.x, c1 * r * g4.y) | ((unsigned long long)pk2(c2 * r * g4.z, c3 * r * g4.w) << 32);
        const float mu = wave_sum(kraw, lane) * (1.0f / IDIM); const float dv = kraw - mu;
        const float var = wave_sum(dv * dv, lane) * (1.0f / IDIM);
        KIN[(size_t)m * IDIM + lane] = (bf16)f2bf(dv * (1.0f / sqrtf(var + EPS)) * gk + bk);
        if (lane < 8) WIF[(size_t)m * IH + lane] = wraw;
    }
}
constexpr int SWA_KP = 144, SWA_VP = 192;
constexpr int SWA_K_OFF = 0, SWA_V_OFF = 160 * SWA_KP, SWA_TAB_OFF = SWA_V_OFF + 160 * SWA_VP;
static_assert(SWA_TAB_OFF + 16 * 128 * 4 <= RING_BYTES, "SWA LDS map");
__device__ __forceinline__ void swa_phase(LAS unsigned char* lds, const GAS bf16* Z, GAS bf16* O, const GAS float* rel_bias, const GAS float* sinks, int vcu, int G, int tid, int lane, int wave) {
    LAS float* tab = (LAS float*)(lds + SWA_TAB_OFF);
    for (int e = tid; e < 16 * 128; e += NWAVES * 64) { const int h = e >> 7, dist = e & 127; tab[e] = rel_bias[(int)T5_BUCKET[dist] * 24 + H_A + h]; }
    __syncthreads();
    const int q = lane & 31, hh = lane >> 5;
    const unsigned ldsb = (unsigned)(size_t)lds;
    for (int item = vcu; item < BATCH * 128 * KVH; item += G) {
        const int kvh = item & 1, qt = (item >> 1) & 127, b = item >> 8;
        const int t0 = 32 * qt, s0 = t0 - 128;
        const size_t rowbase = (size_t)b * SEQ;
        for (int c = tid; c < 1280; c += NWAVES * 64) { const int row = c >> 3, ch = c & 7; const int s = s0 + row;
            if (s >= 0) { const GAS bf16* zr = Z + (rowbase + s) * ZLD + kvh * 64 + ch * 8;
                const v4u kv = *(const GAS v4u*)(zr + ZC_KB); const v4u vv = *(const GAS v4u*)(zr + ZC_VB);
                *(LAS v4u*)(lds + SWA_K_OFF + row * SWA_KP + ch * 16) = kv; *(LAS v4u*)(lds + SWA_V_OFF + row * SWA_VP + ch * 16) = vv; } }
        const int hq = kvh * 8 + wave; const int t = t0 + q;
        bf16x8 qf[4];
#pragma unroll
        for (int st = 0; st < 4; ++st) qf[st] = *(const GAS bf16x8*)(Z + (rowbase + t) * ZLD + ZC_QB + hq * 64 + 16 * st + 8 * hh);
        __syncthreads();
        const int kt0 = qt >= 4 ? 0 : 4 - qt;
        f32x16 sacc[5];
#pragma unroll
        for (int kt = 0; kt < 5; ++kt) {
#pragma unroll
            for (int r = 0; r < 16; ++r) sacc[kt][r] = 0.f;
            if (kt >= kt0) {
#pragma unroll
                for (int st = 0; st < 4; ++st) { const bf16x8 kf = *(const LAS bf16x8*)(lds + SWA_K_OFF + (kt * 32 + q) * SWA_KP + (2 * st + hh) * 16);
                    sacc[kt] = __builtin_amdgcn_mfma_f32_32x32x16_bf16(kf, qf[st], sacc[kt], 0, 0, 0); } } }
        const float sink = sinks[hq]; float mx = sink;
        const LAS float* tabh = tab + hq * 128;
#pragma unroll
        for (int kt = 0; kt < 5; ++kt) if (kt >= kt0) {
#pragma unroll
            for (int r = 0; r < 16; ++r) { const int ko = (r & 3) + 8 * (r >> 2) + 4 * hh; const int dist = q + 128 - 32 * kt - ko;
                const float lg = (dist >= 0 && dist < WINDOW) ? sacc[kt][r] + tabh[dist & 127] : -1e30f; sacc[kt][r] = lg; mx = fmaxf(mx, lg); } }
        mx = fmaxf(mx, SHX(mx, 32));
        float l = 0.f;
#pragma unroll
        for (int kt = 0; kt < 5; ++kt) if (kt >= kt0) {
#pragma unroll
            for (int r = 0; r < 16; ++r) { const float p = __expf(sacc[kt][r] - mx); sacc[kt][r] = p; l += p; } }
        l += SHX(l, 32); l += __expf(sink - mx);
        f32x16 oacc[2];
#pragma unroll
        for (int dt = 0; dt < 2; ++dt)
#pragma unroll
            for (int r = 0; r < 16; ++r) oacc[dt][r] = 0.f;
        const unsigned vlane = ldsb + SWA_V_OFF + (unsigned)((4 * hh + ((lane & 15) >> 2)) * SWA_VP + (16 * ((lane >> 4) & 1) + 4 * (lane & 3)) * 2);
#pragma unroll
        for (int kt = 0; kt < 5; ++kt) if (kt >= kt0) {
#pragma unroll
            for (int s2 = 0; s2 < 2; ++s2) {
                bf16x8 pf; { const unsigned w0 = pg8::cvt_pk_bf16(sacc[kt][8 * s2 + 0], sacc[kt][8 * s2 + 1]), w1 = pg8::cvt_pk_bf16(sacc[kt][8 * s2 + 2], sacc[kt][8 * s2 + 3]),
                                     w2 = pg8::cvt_pk_bf16(sacc[kt][8 * s2 + 4], sacc[kt][8 * s2 + 5]), w3 = pg8::cvt_pk_bf16(sacc[kt][8 * s2 + 6], sacc[kt][8 * s2 + 7]);
                    const v4u w = {w0, w1, w2, w3}; pf = __builtin_bit_cast(bf16x8, w); }
                const unsigned a = vlane + (unsigned)((kt * 32 + 16 * s2) * SWA_VP);
                s16x4 r0, r1, r2, r3; tr_read4(a, a + 8 * SWA_VP, a + 64, a + 8 * SWA_VP + 64, r0, r1, r2, r3);
                oacc[0] = __builtin_amdgcn_mfma_f32_32x32x16_bf16(cat4(r0, r1), pf, oacc[0], 0, 0, 0);
                oacc[1] = __builtin_amdgcn_mfma_f32_32x32x16_bf16(cat4(r2, r3), pf, oacc[1], 0, 0, 0); } }
        const float inv = (OUT_F8 ? O8_SCALE : 1.0f) / l;
        if constexpr (OUT_F8) { GAS unsigned char* orow = (GAS unsigned char*)O + (rowbase + t) * OLD + 2048 + hq * 64 + 4 * hh;
#pragma unroll
            for (int dt = 0; dt < 2; ++dt)
#pragma unroll
                for (int g4 = 0; g4 < 4; ++g4) { int p = 0; p = __builtin_amdgcn_cvt_pk_fp8_f32(oacc[dt][4 * g4] * inv, oacc[dt][4 * g4 + 1] * inv, p, false); p = __builtin_amdgcn_cvt_pk_fp8_f32(oacc[dt][4 * g4 + 2] * inv, oacc[dt][4 * g4 + 3] * inv, p, true);
                    *(GAS unsigned*)(orow + 32 * dt + 8 * g4) = (unsigned)p; } }
        else { GAS bf16* orow = O + (rowbase + t) * OLD + 2048 + hq * 64 + 4 * hh;
#pragma unroll
        for (int dt = 0; dt < 2; ++dt)
#pragma unroll
            for (int g4 = 0; g4 < 4; ++g4) { const unsigned long long w = (unsigned long long)pk2(oacc[dt][4 * g4] * inv, oacc[dt][4 * g4 + 1] * inv) | ((unsigned long long)pk2(oacc[dt][4 * g4 + 2] * inv, oacc[dt][4 * g4 + 3] * inv) << 32);
                *(GAS unsigned long long*)(orow + 32 * dt + 8 * g4) = w; } }
        __syncthreads();
    }
}
constexpr int TK_BINS = 512, TK_CAP = 256;
#define LDS_ADD(p) __hip_atomic_fetch_add((p), 1u, __ATOMIC_RELAXED, __HIP_MEMORY_SCOPE_WORKGROUP)
#define LDS_ADDV(p, v) __hip_atomic_fetch_add((p), (v), __ATOMIC_RELAXED, __HIP_MEMORY_SCOPE_WORKGROUP)
#define HIST_WORD(tok, bin) (((tok) * TK_BINS + (bin)) >> 1)
#define HIST_INC(bin) (1u << (((bin) & 1) * 16))
constexpr int TK_HIST_OFF = 0, TK_CSC_OFF = 32768, TK_CIX_OFF = TK_CSC_OFF + 32 * TK_CAP * 4, TK_SEL_OFF = TK_CIX_OFF + 32 * TK_CAP * 2, TK_CNT_OFF = TK_SEL_OFF + 32 * 256 * 2, TK_DUM_OFF = TK_CNT_OFF + 32 * 2 * 4, TK_KB_OFF = TK_DUM_OFF + 8 * 64 * 4, TK_KB_BYTES = 64 * 144, TK_FLAG_OFF = TK_KB_OFF + 2 * TK_KB_BYTES;
static_assert(TK_FLAG_OFF + 16 <= RING_BYTES, "top-k LDS map");
typedef _Float16 tk_h2 __attribute__((ext_vector_type(2)));
__device__ __forceinline__ void tk_score2(const f32x16& acc, const tk_h2 (&wh)[8], float& s0, float& s1) {
    tk_h2 s = {(_Float16)0, (_Float16)0}; const tk_h2 zero = {(_Float16)0, (_Float16)0};
#pragma unroll
    for (int h = 0; h < 8; ++h) { tk_h2 d = __builtin_bit_cast(tk_h2, __builtin_amdgcn_cvt_pkrtz(acc[h], acc[8 + h])); d = __builtin_elementwise_max(d, zero); s = __builtin_elementwise_fma(wh[h], d, s); }
    s0 = (float)s.x; s1 = (float)s.y;
}
__device__ __forceinline__ float tk_x(float s, float sc) { return fmaf(s, sc, 256.0f); }
__device__ __forceinline__ int tk_key(float s, float sc) {
    const float x = tk_x(s, sc); int b0 = (int)x; b0 = b0 < 0 ? 0 : (b0 > TK_BINS - 1 ? TK_BINS - 1 : b0);
    int sub = (int)((x - (float)b0) * 512.0f); sub = sub < 0 ? 0 : (sub > 511 ? 511 : sub);
    return b0 * 512 + sub;
}
__device__ __forceinline__ void tk_find(const LAS unsigned* h, unsigned need, int lane, int& bin_out, unsigned& above_out) {
    unsigned v[8]; unsigned s = 0;
#pragma unroll
    for (int i = 0; i < 4; ++i) { const unsigned w = h[4 * lane + i]; v[2 * i] = w & 0xffffu; v[2 * i + 1] = w >> 16; s += v[2 * i] + v[2 * i + 1]; }
    unsigned S = s;
#pragma unroll
    for (int o = 1; o < 64; o <<= 1) { const unsigned t = (unsigned)__builtin_amdgcn_ds_bpermute((lane + o) << 2, (int)S); if (lane + o < 64) S += t; }
    const unsigned long long mask = __ballot(S >= need);
    const int Lm = mask ? 63 - __builtin_clzll(mask) : 0;
    unsigned cum = S - s; int bsel = 8 * lane; unsigned ab = cum; bool found = false;
#pragma unroll
    for (int i = 7; i >= 0; --i) { if (!found) { if (cum + v[i] >= need) { bsel = 8 * lane + i; ab = cum; found = true; } else cum += v[i]; } }
    bin_out = __builtin_amdgcn_readlane(bsel, Lm); above_out = (unsigned)__builtin_amdgcn_readlane((int)ab, Lm);
}
__device__ __forceinline__ void topk_phase(LAS unsigned char* lds, const GAS bf16* Z, const GAS bf16* KIN, const GAS float* WIF, GAS unsigned short* IDX, GAS unsigned long long* SCR, int vcu, int G, int lane, int wave) {
    LAS unsigned* hist = (LAS unsigned*)(lds + TK_HIST_OFF) + wave * 4 * (TK_BINS / 2);
    LAS float* csc = (LAS float*)(lds + TK_CSC_OFF) + wave * 4 * TK_CAP;
    LAS unsigned short* cix = (LAS unsigned short*)(lds + TK_CIX_OFF) + wave * 4 * TK_CAP;
    LAS unsigned short* sel = (LAS unsigned short*)(lds + TK_SEL_OFF) + wave * 4 * 256;
    LAS unsigned* cnt = (LAS unsigned*)(lds + TK_CNT_OFF) + wave * 8;
    LAS unsigned* dum = (LAS unsigned*)(lds + TK_DUM_OFF) + wave * 64 + lane;
    const int n = lane & 31, c = lane >> 5;
    const int am = (lane >> 4) & 1, bbm = (lane >> 3) & 1, ccm = (lane >> 2) & 1, dm = lane & 3;
    for (int p2 = vcu; p2 < BATCH * 64; p2 += G) {
#pragma unroll 1
        for (int half = 0; half < 2; ++half) {
            const int b = p2 >> 6, jj = p2 & 63, j = half ? 127 - jj : jj;
            const int t0 = 32 * j + 4 * wave; const size_t rb = (size_t)b * SEQ;
            bf16x8 qa[4];
#pragma unroll
            for (int st = 0; st < 4; ++st) qa[st] = *(const GAS bf16x8*)(Z + (rb + t0 + 2 * ccm + am) * ZLD + ZC_QI + (4 * bbm + dm) * 64 + 16 * st + 8 * c);
            float w0[8], w1[8];
            { const GAS f32x4* wp = (const GAS f32x4*)(WIF + (rb + t0 + 2 * c) * IH); const f32x4 x0 = wp[0], x1 = wp[1], x2 = wp[2], x3 = wp[3];
              w0[0] = x0.x; w0[1] = x0.y; w0[2] = x0.z; w0[3] = x0.w; w0[4] = x1.x; w0[5] = x1.y; w0[6] = x1.z; w0[7] = x1.w;
              w1[0] = x2.x; w1[1] = x2.y; w1[2] = x2.z; w1[3] = x2.w; w1[4] = x3.x; w1[5] = x3.y; w1[6] = x3.z; w1[7] = x3.w; }
            tk_h2 wh[8];
#pragma unroll
            for (int h = 0; h < 8; ++h) { wh[h].x = (_Float16)w0[h]; wh[h].y = (_Float16)w1[h]; }
            float scA, scB;
            { float a = 0.f, bq = 0.f;
#pragma unroll
              for (int h = 0; h < 8; ++h) { a = fmaf(w0[h], w0[h], a); bq = fmaf(w1[h], w1[h], bq); }
              scA = 32.0f / fmaxf(sqrtf(32.0f * a), 1e-20f); scB = 32.0f / fmaxf(sqrtf(32.0f * bq), 1e-20f); }
            const int tA = t0 + 2 * c, tB = tA + 1;
            for (int i = lane; i < 4 * (TK_BINS / 2); i += 64) hist[i] = 0u;
            for (int i = lane; i < 4 * 128; i += 64) ((LAS unsigned*)sel)[i] = 0u;
            if (lane < 8) cnt[lane] = 0u;
            asm volatile("s_waitcnt lgkmcnt(0)" ::: "memory");
            int lo[4], hi[4]; unsigned ab0[4]; bool ov[4];
#pragma unroll
            for (int tk = 0; tk < 4; ++tk) { lo[tk] = 0x7fffffff; hi[tk] = -1; ab0[tk] = 0u; ov[tk] = false; }
            const bool need_sel = (t0 + 3) >= TOPK;
            const GAS bf16* kbase = KIN + (rb + n) * IDIM + 8 * c;
            const int tidk = wave * 64 + lane; const int ng = (j + 2) >> 1;
            const GAS bf16* kg0 = KIN + (rb + (tidk >> 3)) * IDIM + (tidk & 7) * 8; const int koff = (tidk >> 3) * 144 + (tidk & 7) * 16;
            LAS unsigned char* kbuf = lds + TK_KB_OFF; volatile LAS unsigned* sflag = (volatile LAS unsigned*)(lds + TK_FLAG_OFF);
            if (tidk == 0) *sflag = 0u;
            GAS unsigned long long* scrw = SCR + (((size_t)b * SCR_GROUPS + (size_t)((j & 1) ? ((j + 1) >> 1) * ((j + 1) >> 1) : (j >> 1) * ((j >> 1) + 1))) * 8 + wave) * 64 + lane;
#define TK_PRIME() v4u kr = {0u, 0u, 0u, 0u}; { const v4u kr0 = *(const GAS v4u*)kg0; if (1 < ng) kr = *(const GAS v4u*)(kg0 + (size_t)64 * IDIM); *(LAS v4u*)(kbuf + koff) = kr0; } __syncthreads();
#define TK_GROUP_BEGIN() \
                  \
                if (g + 1 < ng) *(LAS v4u*)(kbuf + ((g + 1) & 1) * TK_KB_BYTES + koff) = kr; \
                  \
                if (g > 0) scrw[(g - 1) * 512] = (unsigned long long)pkw0 | ((unsigned long long)pkw1 << 32); \
                if (g + 2 < ng) kr = *(const GAS v4u*)(kg0 + (size_t)(g + 2) * 64 * IDIM); \
                const LAS unsigned char* kb_ = kbuf + (g & 1) * TK_KB_BYTES; \
                float s0v[2], s1v[2];     \
                { f32x16 accv[2]; \
                  _Pragma("unroll") for (int u4 = 0; u4 < 2; ++u4) { _Pragma("unroll") for (int r = 0; r < 16; ++r) accv[u4][r] = 0.f; \
                    _Pragma("unroll") for (int st = 0; st < 4; ++st) { const bf16x8 kf = *(const LAS bf16x8*)(kb_ + (32 * u4 + n) * 144 + (2 * st + c) * 16); accv[u4] = __builtin_amdgcn_mfma_f32_32x32x16_bf16(qa[st], kf, accv[u4], 0, 0, 0); } } \
                  _Pragma("unroll") for (int u4 = 0; u4 < 2; ++u4) tk_score2(accv[u4], wh, s0v[u4], s1v[u4]); } \
                _Pragma("unroll") for (int u4 = 0; u4 < 2; ++u4) { \
                    const float s0 = s0v[u4], s1 = s1v[u4]; const int s = 32 * (2 * g + u4) + n;
#define TK_GROUP_END() } \
                __syncthreads();
            bool slow = false;
            if (need_sel) {
                {   TK_PRIME(); unsigned pkw0 = 0u, pkw1 = 0u;
#pragma unroll 1
                    for (int g = 0; g < ng; ++g) { TK_GROUP_BEGIN()
                        int b0 = (int)tk_x(s0, scA), b1 = (int)tk_x(s1, scB); b0 = b0 < 0 ? 0 : (b0 > TK_BINS - 1 ? TK_BINS - 1 : b0); b1 = b1 < 0 ? 0 : (b1 > TK_BINS - 1 ? TK_BINS - 1 : b1);
                        LAS unsigned* p0 = (s <= tA) ? &hist[HIST_WORD(2 * c, b0)] : dum; LAS unsigned* p1 = (s <= tB) ? &hist[HIST_WORD(2 * c + 1, b1)] : dum;
                        LDS_ADDV(p0, HIST_INC(b0)); LDS_ADDV(p1, HIST_INC(b1));
                        { const unsigned w_ = __builtin_bit_cast(unsigned, __builtin_amdgcn_cvt_pkrtz(s0, s1)); if (u4 == 0) pkw0 = w_; else pkw1 = w_; }
                        TK_GROUP_END() }
                    scrw[(ng - 1) * 512] = (unsigned long long)pkw0 | ((unsigned long long)pkw1 << 32);
                }
                asm volatile("s_waitcnt lgkmcnt(0)" ::: "memory");
#pragma unroll
                for (int tk = 0; tk < 4; ++tk) { int bin; unsigned above; tk_find(hist + tk * (TK_BINS / 2), (unsigned)TOPK, lane, bin, above);
                    const unsigned ceq = (hist[HIST_WORD(tk, bin)] >> ((bin & 1) * 16)) & 0xffffu; ov[tk] = ceq > (unsigned)TK_CAP; slow |= ov[tk]; ab0[tk] = above; lo[tk] = bin * 512; hi[tk] = bin * 512 + 511; }
                if (slow && lane == 0) *sflag = 1u;
                __syncthreads();
                slow = *sflag != 0u;
            }
            if (!slow) {
                float thi[4], tlo[4];
#pragma unroll
                for (int tk = 0; tk < 4; ++tk) { const int bin = lo[tk] >> 9;
                    thi[tk] = !need_sel ? -__builtin_inff() : (bin >= TK_BINS - 1 ? __builtin_inff() : (float)(bin + 1));
                    tlo[tk] = !need_sel ? __builtin_inff() : (bin == 0 ? -__builtin_inff() : (float)bin); }
                const float thiA = c ? thi[2] : thi[0], tloA = c ? tlo[2] : tlo[0], thiB = c ? thi[3] : thi[1], tloB = c ? tlo[3] : tlo[1];
                unsigned cntA = 0u, cntB = 0u;
                LAS unsigned short* selA = sel + (2 * c) * 256; LAS unsigned short* selB = sel + (2 * c + 1) * 256; LAS unsigned short* dum16 = (LAS unsigned short*)dum;
                {   constexpr int U = 4; unsigned long long cw[U], nw[U];
#pragma unroll
                    for (int u = 0; u < U; ++u) cw[u] = (need_sel && u < ng) ? scrw[u * 512] : 0ull;
#pragma unroll 1
                    for (int gt = 0; gt < ng; gt += U) {
#pragma unroll
                        for (int u = 0; u < U; ++u) nw[u] = (need_sel && gt + U + u < ng) ? scrw[(gt + U + u) * 512] : 0ull;
#pragma unroll
                        for (int u = 0; u < 2 * U; ++u) { const int kt = 2 * gt + u; if (kt <= j) { const tk_h2 hh = __builtin_bit_cast(tk_h2, (unsigned)(cw[u >> 1] >> (32 * (u & 1)))); const float s0 = (float)hh.x, s1 = (float)hh.y; const int s = 32 * kt + n;
                    const float x0 = (s <= tA) ? tk_x(s0, scA) : __builtin_nanf(""), x1 = (s <= tB) ? tk_x(s1, scB) : __builtin_nanf("");
                    const bool a0 = x0 >= thiA, a1 = x1 >= thiB; const bool c0 = !a0 && x0 >= tloA, c1 = !a1 && x1 >= tloB;
                    const unsigned long long m0 = __ballot(a0), m1 = __ballot(a1);
                    const unsigned pre0 = c ? __builtin_amdgcn_mbcnt_hi((unsigned)(m0 >> 32), 0u) : __builtin_amdgcn_mbcnt_lo((unsigned)m0, 0u);
                    const unsigned pre1 = c ? __builtin_amdgcn_mbcnt_hi((unsigned)(m1 >> 32), 0u) : __builtin_amdgcn_mbcnt_lo((unsigned)m1, 0u);
                    const unsigned pos0 = cntA + pre0, pos1 = cntB + pre1;
                    LAS unsigned short* q0 = (a0 && pos0 < 256u) ? selA + pos0 : dum16; LAS unsigned short* q1 = (a1 && pos1 < 256u) ? selB + pos1 : dum16;
                    *q0 = (unsigned short)s; *q1 = (unsigned short)s;
                    cntA += c ? (unsigned)__builtin_popcount((unsigned)(m0 >> 32)) : (unsigned)__builtin_popcount((unsigned)m0);
                    cntB += c ? (unsigned)__builtin_popcount((unsigned)(m1 >> 32)) : (unsigned)__builtin_popcount((unsigned)m1);
                    if (__ballot(c0 || c1)) {
                        if (c0) { const unsigned pos = LDS_ADD(&cnt[(2 * c) * 2 + 1]); if (pos < (unsigned)TK_CAP) { csc[(2 * c) * TK_CAP + pos] = s0; cix[(2 * c) * TK_CAP + pos] = (unsigned short)s; } }
                        if (c1) { const unsigned pos = LDS_ADD(&cnt[(2 * c + 1) * 2 + 1]); if (pos < (unsigned)TK_CAP) { csc[(2 * c + 1) * TK_CAP + pos] = s1; cix[(2 * c + 1) * TK_CAP + pos] = (unsigned short)s; } } }
                        } }
#pragma unroll
                        for (int u = 0; u < U; ++u) cw[u] = nw[u];
                    } }
                if ((lane & 31) == 0) { cnt[(2 * c) * 2] = cntA; cnt[(2 * c + 1) * 2] = cntB; }
                asm volatile("s_waitcnt lgkmcnt(0)" ::: "memory");
            } else {
                for (int i = lane; i < 4 * (TK_BINS / 2); i += 64) hist[i] = 0u;
                asm volatile("s_waitcnt lgkmcnt(0)" ::: "memory");
                int mode = 1;
#pragma unroll 1
                for (;;) {
                const int klo0 = c ? lo[2] : lo[0], khi0 = c ? hi[2] : hi[0], klo1 = c ? lo[3] : lo[1], khi1 = c ? hi[3] : hi[1];
                const bool ov0 = c ? ov[2] : ov[0], ov1 = c ? ov[3] : ov[1];
                bf16x8 kb[4][4];
#pragma unroll
                for (int u4 = 0; u4 < 4; ++u4) { const int kq = u4 < j ? u4 : j;
#pragma unroll
                    for (int st = 0; st < 4; ++st) kb[u4][st] = *(const GAS bf16x8*)(kbase + (size_t)kq * 32 * IDIM + 16 * st); }
#pragma unroll 1
                for (int kt = 0; kt <= j; kt += 4) {
                    bf16x8 kn[4][4];
#pragma unroll
                    for (int u4 = 0; u4 < 4; ++u4) { const int kq = kt + 4 + u4 < j ? kt + 4 + u4 : j;
#pragma unroll
                        for (int st = 0; st < 4; ++st) kn[u4][st] = *(const GAS bf16x8*)(kbase + (size_t)kq * 32 * IDIM + 16 * st); }
#pragma unroll
                    for (int u4 = 0; u4 < 4; ++u4) {
                        f32x16 acc;
#pragma unroll
                        for (int r = 0; r < 16; ++r) acc[r] = 0.f;
#pragma unroll
                        for (int st = 0; st < 4; ++st) acc = __builtin_amdgcn_mfma_f32_32x32x16_bf16(qa[st], kb[u4][st], acc, 0, 0, 0);
                        float s0, s1; tk_score2(acc, wh, s0, s1);
                        const int s = 32 * (kt + u4) + n; const int k0 = tk_key(s0, scA), k1 = tk_key(s1, scB);
                        const bool v0 = s <= tA, v1 = s <= tB;
                        if (mode == 0) {
                            if (v0 && tA >= TOPK) LDS_ADDV(&hist[HIST_WORD(2 * c, k0 >> 9)], HIST_INC(k0 >> 9));
                            if (v1 && tB >= TOPK) LDS_ADDV(&hist[HIST_WORD(2 * c + 1, k1 >> 9)], HIST_INC(k1 >> 9));
                        } else if (mode == 1) {
                            if (v0 && ov0 && k0 >= klo0 && k0 <= khi0) LDS_ADDV(&hist[HIST_WORD(2 * c, k0 & 511)], HIST_INC(k0 & 511));
                            if (v1 && ov1 && k1 >= klo1 && k1 <= khi1) LDS_ADDV(&hist[HIST_WORD(2 * c + 1, k1 & 511)], HIST_INC(k1 & 511));
                        } else {
                            if (v0) { if (k0 > khi0) { const unsigned pos = LDS_ADD(&cnt[(2 * c) * 2]); if (pos < 256u) sel[(2 * c) * 256 + pos] = (unsigned short)s; }
                                      else if (k0 >= klo0) { const unsigned pos = LDS_ADD(&cnt[(2 * c) * 2 + 1]); if (pos < (unsigned)TK_CAP) { csc[(2 * c) * TK_CAP + pos] = s0; cix[(2 * c) * TK_CAP + pos] = (unsigned short)s; } } }
                            if (v1) { if (k1 > khi1) { const unsigned pos = LDS_ADD(&cnt[(2 * c + 1) * 2]); if (pos < 256u) sel[(2 * c + 1) * 256 + pos] = (unsigned short)s; }
                                      else if (k1 >= klo1) { const unsigned pos = LDS_ADD(&cnt[(2 * c + 1) * 2 + 1]); if (pos < (unsigned)TK_CAP) { csc[(2 * c + 1) * TK_CAP + pos] = s1; cix[(2 * c + 1) * TK_CAP + pos] = (unsigned short)s; } } }
                        }
                    }
#pragma unroll
                    for (int u4 = 0; u4 < 4; ++u4)
#pragma unroll
                        for (int st = 0; st < 4; ++st) kb[u4][st] = kn[u4][st];
                }
                    asm volatile("s_waitcnt lgkmcnt(0)" ::: "memory");
                    if (mode == 2) break;
#pragma unroll
                    for (int tk = 0; tk < 4; ++tk) if (ov[tk]) { int sub; unsigned above; tk_find(hist + tk * (TK_BINS / 2), (unsigned)TOPK - ab0[tk], lane, sub, above); lo[tk] += sub; hi[tk] = lo[tk]; }
                    mode = 2;
                }
            }
#undef TK_GROUP_BEGIN
#undef TK_GROUP_END
#undef TK_PRIME
#pragma unroll 1
            for (int tk = 0; tk < 4; ++tk) { const int t = t0 + tk;
                if (t >= TOPK) { const unsigned nsel = cnt[tk * 2]; unsigned nc = cnt[tk * 2 + 1]; nc = nc > (unsigned)TK_CAP ? (unsigned)TK_CAP : nc; const unsigned need = nsel < 256u ? 256u - nsel : 0u;
                    for (unsigned q = 0; q * 64 < nc; ++q) { const unsigned i = lane + 64 * q;
                        const float si = i < nc ? csc[tk * TK_CAP + i] : 0.f; const unsigned xi = i < nc ? cix[tk * TK_CAP + i] : 0u; unsigned rank = 0;
                        for (unsigned jx = 0; jx < nc; ++jx) { const float sj = csc[tk * TK_CAP + jx]; const unsigned xj = cix[tk * TK_CAP + jx]; rank += (sj > si || (sj == si && xj < xi)) ? 1u : 0u; }
                        if (i < nc && rank < need) sel[tk * 256 + nsel + rank] = (unsigned short)xi; } } }
            asm volatile("s_waitcnt lgkmcnt(0)" ::: "memory");
            { const LAS v4u* sv = (const LAS v4u*)sel; GAS v4u* ov = (GAS v4u*)(IDX + (rb + t0) * TOPK);
              ov[lane] = sv[lane]; ov[lane + 64] = sv[lane + 64]; }
            asm volatile("s_waitcnt vmcnt(0) lgkmcnt(0)" ::: "memory");
        }
    }
}
constexpr int DSA_TAB_OFF = RING_BYTES + 1024;
constexpr int DSA_IDX_OFF = DSA_TAB_OFF + 4224;
static_assert(8 * 129 * 4 <= 4224 && DSA_IDX_OFF + 8 * 1024 <= LDS_BYTES, "DSA LDS map");
__device__ __forceinline__ void dsa_phase(LAS unsigned char* lds_all, const GAS bf16* Z, const GAS bf16* CKVN, const GAS unsigned short* IDX, GAS bf16* O, const GAS float* rel_bias, int gw, int NGW, int tid, int lane, int wave) {
    LAS float* tab = (LAS float*)(lds_all + DSA_TAB_OFF);
    for (int e = tid; e < 8 * 129; e += NWAVES * 64) { const int hh = e / 129, dist = e - hh * 129; tab[e] = rel_bias[(dist < 128 ? (int)T5_BUCKET[dist] : 31) * 24 + hh]; }
    __syncthreads();
    LAS unsigned char* img = lds_all + RING_OFF + wave * 16384;
    LAS unsigned short* ib = (LAS unsigned short*)(lds_all + DSA_IDX_OFF + wave * 1024);
    const unsigned imgb = (unsigned)(size_t)img;
    const int h = lane & 15, g = lane >> 4, hi = lane >> 5;
    const LAS float* tabh = tab + (h & 7) * 129;
    const int TPW = (M + NGW - 1) / NGW;
    const int tok0 = gw * TPW;
    const int tok_end = (gw + 1) * TPW < M ? (gw + 1) * TPW : M;
    const int xq = 2 * (lane & 7);
    unsigned qa[8];
#pragma unroll
    for (int st = 0; st < 8; ++st) qa[st] = imgb + (unsigned)((lane & 15) * 512 + (((4 * st + g) ^ xq) * 16));
    const int q4 = (lane & 15) >> 2, p4 = lane & 3; const int xr = 2 * (4 * (g & 1) + q4);
    const unsigned pv_base = imgb + (unsigned)((4 * g + q4) * 512 + 8 * (p4 & 1));
    unsigned pva[16];
#pragma unroll
    for (int c2 = 0; c2 < 16; ++c2) pva[c2] = pv_base + (unsigned)((((2 * c2) ^ xr) | (p4 >> 1)) * 16);
    unsigned lc[4];
#pragma unroll
    for (int k = 0; k < 4; ++k) lc[k] = (unsigned)(((lane & 31) ^ (2 * ((2 * k + hi) & 7))) * 16);
    if (tok0 < tok_end) *(LAS unsigned long long*)(ib + 4 * lane) = *(const GAS unsigned long long*)(IDX + (size_t)tok0 * TOPK + 4 * lane);
#pragma unroll 1
    for (int tok = tok0; tok < tok_end; ++tok) {
        const int t = tok & (SEQ - 1); const size_t rb = (size_t)(tok - t);
        const int nsel = t + 1 < TOPK ? t + 1 : TOPK;
        const LAS unsigned short* cur = ib + ((tok - tok0) & 1) * 256;
        const unsigned long long nxi = tok + 1 < tok_end ? *(const GAS unsigned long long*)(IDX + (size_t)(tok + 1) * TOPK + 4 * lane) : 0ull;
        bf16x8 qf[8];
#pragma unroll
        for (int st = 0; st < 8; ++st) { qf[st] = *(const GAS bf16x8*)(Z + (size_t)tok * ZLD + ZC_QLAT + (h & 7) * 256 + 32 * st + 8 * g); if (h >= 8) qf[st] = (bf16x8){0, 0, 0, 0, 0, 0, 0, 0}; }
        f32x4 oacc[16];
#pragma unroll
        for (int rt = 0; rt < 16; ++rt) oacc[rt] = (f32x4){0.f, 0.f, 0.f, 0.f};
        float mrun = -1e30f, lsum = 0.f;
        const GAS unsigned char* cb = (const GAS unsigned char*)(CKVN + rb * RANK);
#pragma unroll
        for (int ch = 0; ch < 8; ++ch) {
            if (32 * ch >= nsel) break;
            unsigned rix[16];
#pragma unroll
            for (int i = 0; i < 16; ++i) rix[i] = cur[32 * ch + 2 * i + hi];
            const unsigned long long i0 = *(const LAS unsigned long long*)(cur + 32 * ch + 4 * g), i1 = *(const LAS unsigned long long*)(cur + 32 * ch + 16 + 4 * g);
            asm volatile("s_waitcnt lgkmcnt(0)" ::: "memory");
#pragma unroll
            for (int i = 0; i < 16; ++i) __builtin_amdgcn_global_load_lds((const GAS unsigned*)(cb + ((rix[i] << 9) + lc[i & 3])), (LAS unsigned*)(img + i * 1024), 16, 0, 0);
            asm volatile("s_waitcnt vmcnt(0)" ::: "memory");
            v4u fa[16];
            asm volatile("ds_read_b128 %0, %8\n\tds_read_b128 %1, %8 offset:8192\n\tds_read_b128 %2, %9\n\tds_read_b128 %3, %9 offset:8192\n\t"
                         "ds_read_b128 %4, %10\n\tds_read_b128 %5, %10 offset:8192\n\tds_read_b128 %6, %11\n\tds_read_b128 %7, %11 offset:8192"
                         : "=&v"(fa[0]), "=&v"(fa[1]), "=&v"(fa[2]), "=&v"(fa[3]), "=&v"(fa[4]), "=&v"(fa[5]), "=&v"(fa[6]), "=&v"(fa[7])
                         : "v"(qa[0]), "v"(qa[1]), "v"(qa[2]), "v"(qa[3]) : "memory");
            asm volatile("ds_read_b128 %0, %16\n\tds_read_b128 %1, %16 offset:8192\n\tds_read_b128 %2, %17\n\tds_read_b128 %3, %17 offset:8192\n\t"
                         "ds_read_b128 %4, %18\n\tds_read_b128 %5, %18 offset:8192\n\tds_read_b128 %6, %19\n\tds_read_b128 %7, %19 offset:8192\n\ts_waitcnt lgkmcnt(8)"
                         : "=&v"(fa[8]), "=&v"(fa[9]), "=&v"(fa[10]), "=&v"(fa[11]), "=&v"(fa[12]), "=&v"(fa[13]), "=&v"(fa[14]), "=&v"(fa[15]),
                           "+v"(fa[0]), "+v"(fa[1]), "+v"(fa[2]), "+v"(fa[3]), "+v"(fa[4]), "+v"(fa[5]), "+v"(fa[6]), "+v"(fa[7])
                         : "v"(qa[4]), "v"(qa[5]), "v"(qa[6]), "v"(qa[7]) : "memory");
            f32x4 sa[2] = {(f32x4){0.f, 0.f, 0.f, 0.f}, (f32x4){0.f, 0.f, 0.f, 0.f}};
#pragma unroll
            for (int st = 0; st < 4; ++st) { sa[0] = __builtin_amdgcn_mfma_f32_16x16x32_bf16(__builtin_bit_cast(bf16x8, fa[2 * st]), qf[st], sa[0], 0, 0, 0);
                sa[1] = __builtin_amdgcn_mfma_f32_16x16x32_bf16(__builtin_bit_cast(bf16x8, fa[2 * st + 1]), qf[st], sa[1], 0, 0, 0); }
            s16x4 pr[2][4];
            asm volatile("s_waitcnt lgkmcnt(0)\n\tds_read_b64_tr_b16 %0, %12\n\tds_read_b64_tr_b16 %1, %12 offset:8192\n\tds_read_b64_tr_b16 %2, %13\n\tds_read_b64_tr_b16 %3, %13 offset:8192"
                         : "=&v"(pr[0][0]), "=&v"(pr[0][1]), "=&v"(pr[0][2]), "=&v"(pr[0][3]),
                           "+v"(fa[8]), "+v"(fa[9]), "+v"(fa[10]), "+v"(fa[11]), "+v"(fa[12]), "+v"(fa[13]), "+v"(fa[14]), "+v"(fa[15])
                         : "v"(pva[0]), "v"(pva[1]) : "memory");
#pragma unroll
            for (int st = 4; st < 8; ++st) { sa[0] = __builtin_amdgcn_mfma_f32_16x16x32_bf16(__builtin_bit_cast(bf16x8, fa[2 * st]), qf[st], sa[0], 0, 0, 0);
                sa[1] = __builtin_amdgcn_mfma_f32_16x16x32_bf16(__builtin_bit_cast(bf16x8, fa[2 * st + 1]), qf[st], sa[1], 0, 0, 0); }
            float bz[8];
#pragma unroll
            for (int e = 0; e < 8; ++e) { const int tl = e >> 2, jx = e & 3; const int sidx = (int)(((tl ? i1 : i0) >> (16 * jx)) & 0xffffull); int dd = t - sidx; dd = dd < 0 ? 0 : (dd > 128 ? 128 : dd); bz[e] = tabh[dd]; }
            float lg[8]; float cmax = -1e30f;
#pragma unroll
            for (int e = 0; e < 8; ++e) { const int tl = e >> 2, jx = e & 3; const int kk = 32 * ch + 16 * tl + 4 * g + jx;
                const float v = kk < nsel ? sa[tl][jx] + bz[e] : -1e30f; lg[e] = v; cmax = fmaxf(cmax, v); }
            cmax = fmaxf(cmax, SHX(cmax, 16)); cmax = fmaxf(cmax, SHX(cmax, 32));
            const float mnew = fmaxf(mrun, cmax);
            if (__any(mnew > mrun)) { const float alpha = __expf(mrun - mnew); lsum *= alpha;
#pragma unroll
                for (int rt = 0; rt < 16; ++rt) oacc[rt] = oacc[rt] * alpha; }
            mrun = mnew;
            float pe[8];
#pragma unroll
            for (int e = 0; e < 8; ++e) { pe[e] = __expf(lg[e] - mnew); lsum += pe[e]; }
            bf16x8 pf; { const v4u wv = {pg8::cvt_pk_bf16(pe[0], pe[1]), pg8::cvt_pk_bf16(pe[2], pe[3]), pg8::cvt_pk_bf16(pe[4], pe[5]), pg8::cvt_pk_bf16(pe[6], pe[7])}; pf = __builtin_bit_cast(bf16x8, wv); }
#pragma unroll
            for (int j = 0; j < 8; ++j) {
                const int cs = j & 1, ns = cs ^ 1;
                if (j < 7) asm volatile("ds_read_b64_tr_b16 %0, %8\n\tds_read_b64_tr_b16 %1, %8 offset:8192\n\tds_read_b64_tr_b16 %2, %9\n\tds_read_b64_tr_b16 %3, %9 offset:8192\n\ts_waitcnt lgkmcnt(4)"
                                        : "=&v"(pr[ns][0]), "=&v"(pr[ns][1]), "=&v"(pr[ns][2]), "=&v"(pr[ns][3]), "+v"(pr[cs][0]), "+v"(pr[cs][1]), "+v"(pr[cs][2]), "+v"(pr[cs][3])
                                        : "v"(pva[2 * j + 2]), "v"(pva[2 * j + 3]) : "memory");
                else asm volatile("s_waitcnt lgkmcnt(0)" : "+v"(pr[cs][0]), "+v"(pr[cs][1]), "+v"(pr[cs][2]), "+v"(pr[cs][3]) :: "memory");
                oacc[2 * j] = __builtin_amdgcn_mfma_f32_16x16x32_bf16(cat4(pr[cs][0], pr[cs][1]), pf, oacc[2 * j], 0, 0, 0);
                oacc[2 * j + 1] = __builtin_amdgcn_mfma_f32_16x16x32_bf16(cat4(pr[cs][2], pr[cs][3]), pf, oacc[2 * j + 1], 0, 0, 0); }
        }
        if (tok + 1 < tok_end) *(LAS unsigned long long*)(ib + (((tok - tok0) & 1) ^ 1) * 256 + 4 * lane) = nxi;
        lsum += SHX(lsum, 16); lsum += SHX(lsum, 32);
        const float inv = (OUT_F8 ? O8_SCALE : 1.0f) / lsum;
        if (h < 8) {
            if constexpr (OUT_F8) { GAS unsigned char* orow = (GAS unsigned char*)O + (size_t)tok * OLD + h * 256 + 4 * g;
#pragma unroll
                for (int rt = 0; rt < 16; ++rt) { int p = 0; p = __builtin_amdgcn_cvt_pk_fp8_f32(oacc[rt][0] * inv, oacc[rt][1] * inv, p, false); p = __builtin_amdgcn_cvt_pk_fp8_f32(oacc[rt][2] * inv, oacc[rt][3] * inv, p, true); *(GAS unsigned*)(orow + 16 * rt) = (unsigned)p; } }
            else { GAS bf16* orow = O + (size_t)tok * OLD + h * 256 + 4 * g;
#pragma unroll
            for (int rt = 0; rt < 16; ++rt) *(GAS unsigned long long*)(orow + 16 * rt) = (unsigned long long)pk2(oacc[rt][0] * inv, oacc[rt][1] * inv) | ((unsigned long long)pk2(oacc[rt][2] * inv, oacc[rt][3] * inv) << 32); } }
    }
}
struct Args { const float* in[20]; float* out; unsigned char* ws; };
__device__ __forceinline__ unsigned long long karg_u64(int idx) { unsigned long long r; const unsigned off = (unsigned)idx * 8u;
    asm volatile("s_load_dwordx2 %0, %1, %2\n\ts_waitcnt lgkmcnt(0)" : "=s"(r) : "s"(__builtin_amdgcn_kernarg_segment_ptr()), "s"(off) : "memory"); return r; }
__device__ __forceinline__ const GAS float* karg_in(int i) { return (const GAS float*)karg_u64(i); }
__device__ __forceinline__ GAS float* karg_out() { return (GAS float*)karg_u64(20); }
__device__ __forceinline__ GAS unsigned char* karg_ws() { return (GAS unsigned char*)karg_u64(21); }
#ifndef REP_P0
#define REP_P0 1
#endif
#ifndef REP_NORM
#define REP_NORM 1
#endif
#ifndef REP_GU
#define REP_GU 1
#endif
#ifndef REP_IN
#define REP_IN 1
#endif
#ifndef REP_POST
#define REP_POST 1
#endif
#ifndef REP_TOPK
#define REP_TOPK 1
#endif
#ifndef REP_DSA
#define REP_DSA 1
#endif
#define REPEAT(n) _Pragma("unroll 1") for (int rep_ = 0; rep_ < (n); ++rep_)
#define PHASE_IDS() int wave = wave0; asm volatile("" : "+s"(wave)); int lane; asm volatile("v_mbcnt_lo_u32_b32 %0, -1, 0\n\tv_mbcnt_hi_u32_b32 %0, -1, %0" : "=v"(lane)); const int tid = wave * 64 + lane; int bx = blockIdx.x; asm volatile("" : "+s"(bx)); int G = gridDim.x; asm volatile("" : "+s"(G)); \
    const int vcu = (G % 8 == 0) ? (bx % 8) * (G / 8) + bx / 8 : bx; const int gw = vcu * NWAVES + wave, NGW = G * NWAVES; \
    GAS unsigned char* ws = karg_ws(); (void)lane; (void)gw; (void)NGW; (void)vcu; (void)ws
__global__ void __launch_bounds__(NWAVES * 64, 2) mk_fwd(Args args) {
    extern __shared__ __attribute__((aligned(16))) unsigned char lds_raw[];
    LAS unsigned char* lds = (LAS unsigned char*)lds_raw;
    volatile LAS unsigned* MISC = (volatile LAS unsigned*)(lds + MISC_OFF);
    const int wave0 = __builtin_amdgcn_readfirstlane(threadIdx.x >> 6);
    for (int u = threadIdx.x; u < (LDS_BYTES - LDSCTL_OFF) / 4; u += NWAVES * 64) ((LAS unsigned*)(lds + LDSCTL_OFF))[u] = 0u;
    __syncthreads();
    (void)xcd_barrier_post((unsigned*)((gu32*)(karg_ws() + WS_CTL) + CW_BAR), MISC + 8, threadIdx.x == 0);
#define GRID_BAR() do { XcdBarrier b_; b_.bar = (unsigned*)((gu32*)(karg_ws() + WS_CTL) + CW_BAR); b_.x = xb_xcc_id(); b_.st = MISC + 8; int w_ = wave0; asm volatile("" : "+s"(w_)); int l_; asm volatile("v_mbcnt_lo_u32_b32 %0, -1, 0\n\tv_mbcnt_hi_u32_b32 %0, -1, %0" : "=v"(l_)); xcd_barrier(b_, (w_ | l_) == 0); } while (0)

    REPEAT(REP_P0) {   PHASE_IDS();
        LAS float* scr = (LAS float*)(lds + RING_OFF + wave * 16384);
        rows_bf16_ss(karg_in(0), (GAS bf16*)(ws + WS_XN), f8_on(0, 0) ? (GAS unsigned char*)(ws + WS_HB8) : (GAS unsigned char*)nullptr, (GAS float*)(ws + WS_SS), gw, NGW, lane);
        constexpr int I_GU = (D / 64) * (FF / 32), I_DN = (FF / 64) * (D / 32);
        constexpr int I_FFN = 2 * I_GU + I_DN, I_IN = 72 * (D / 64), I_OB = (1024 / 64) * (D / 32);
        constexpr int PER_LAYER = 2 * I_FFN + I_IN + I_OB;
        for (int it = gw; it < DEPTH * PER_LAYER; it += NGW) {
            const int l = it / PER_LAYER; int r = it - l * PER_LAYER;
            GAS unsigned char* wl = ws + WS_W0 + (size_t)l * W_LAYER;
            if (r < 2 * I_FFN) {
                const int f = r / I_FFN; r -= f * I_FFN;
                GAS bf16* dgu = (GAS bf16*)(wl + (f ? WO_GU2 : WO_GU1)); GAS bf16* dd = (GAS bf16*)(wl + (f ? WO_D2 : WO_D1));
                if (r < 2 * I_GU) { const int up = r >= I_GU; if (up) r -= I_GU; const int kb = r / (FF / 32), nb = r % (FF / 32), n0 = 32 * nb;
                    const GAS float* wsrc = karg_in(up ? (f ? 17 : 4) : (f ? 16 : 3)) + (size_t)l * D * FF;
                    const int drow = (n0 >> 7) * 256 + (up ? 128 : 0) + (n0 & 127);
                    if (f8_on(l, f)) { if constexpr (GU_I8) conv_item<2>(wsrc, FF, 64 * kb, n0, 32, dgu, D, drow, 0, W8I_SCALE, karg_in(f ? 15 : 2) + (size_t)l * D, scr, lane); else conv_item<1>(wsrc, FF, 64 * kb, n0, 32, dgu, D, drow, 0, W8_SCALE, karg_in(f ? 15 : 2) + (size_t)l * D, scr, lane); }
                    else conv_item(wsrc, FF, 64 * kb, n0, 32, dgu, D, drow, 0, 1.0f, karg_in(f ? 15 : 2) + (size_t)l * D, scr, lane); }
                else { r -= 2 * I_GU; const int kb = r / (D / 32), nb = r % (D / 32);
                    if (d8_on(l, f)) conv_item<1>(karg_in(f ? 18 : 5) + (size_t)l * FF * D, D, 64 * kb, 32 * nb, 32, dd, FF, 32 * nb, 0, W8_SCALE, nullptr, scr, lane);
                    else conv_item(karg_in(f ? 18 : 5) + (size_t)l * FF * D, D, 64 * kb, 32 * nb, 32, dd, FF, 32 * nb, 0, 1.0f, nullptr, scr, lane); }
            } else if (r < 2 * I_FFN + I_IN) {
                r -= 2 * I_FFN; const int j = r >> 5, kb = r & 31; int src, nvalid = 32; float sc = 1.0f;
                if (j < 8) src = 1024 + 32 * j;
                else if (j < 40) src = 1864 + 32 * (j - 8);
                else if (j < 44) src = 2888 + 32 * (j - 40);
                else if (j < 48) src = 3016 + 32 * (j - 44);
                else if (j < 64) src = 1280 + 32 * (j - 48);
                else if (j < 66) src = 1792 + 32 * (j - 64);
                else if (j == 66) { src = 1856; nvalid = 8; sc = 0.044194173824159216f; }
                else { src = 0; nvalid = 0; }
                const GAS float* win = karg_in(7) + (size_t)l * D * D_IN; const GAS float* gmix = karg_in(6) + (size_t)l * D;
                if (IN_I8 && j < 48) conv_item<2>(win, D_IN, 64 * kb, src, nvalid, (GAS bf16*)(wl + WO_IN), D, 2048 + 32 * j, 0, W8I_SCALE, gmix, scr, lane);
                else if (IN_I8) conv_item(win, D_IN, 64 * kb, src, nvalid, (GAS bf16*)(wl + WO_IN + (size_t)ZN8 * D), D, 32 * (j - 48), 0, sc, gmix, scr, lane);
                else conv_item(win, D_IN, 64 * kb, src, nvalid, (GAS bf16*)(wl + WO_IN), D, 2048 + 32 * j, 0, (j >= 8 && j < 40) ? 0.125f : sc, gmix, scr, lane);
            } else {
                r -= 2 * I_FFN + I_IN; const int kb = r >> 6, nb = r & 63;
                if constexpr (OUT_F8) conv_item<1>(karg_in(14) + (size_t)l * D * D + (size_t)1024 * D, D, 64 * kb, 32 * nb, 32, (GAS bf16*)(wl + WO_OUT), OLD, 32 * nb, 2048, W8_SCALE, nullptr, scr, lane);
                else conv_item(karg_in(14) + (size_t)l * D * D + (size_t)1024 * D, D, 64 * kb, 32 * nb, 32, (GAS bf16*)(wl + WO_OUT), OLD, 32 * nb, 2048, 1.0f, nullptr, scr, lane);
            }
        }
        __syncthreads();
        LAS float* Ps = (LAS float*)(lds + RING_OFF); LAS float* Qs = Ps + 64 * 129;
        for (int u = vcu; u < DEPTH * 2048; u += G) {
            const int l = u >> 11, which = (u >> 10) & 1, v = u & 1023;
            GAS unsigned char* wl = ws + WS_W0 + (size_t)l * W_LAYER;
            if (which == 0) { const int h = v >> 7, rt = (v >> 5) & 3, kt = v & 31;
                if constexpr (IN_I8) absorb_unit<false, 2>(karg_in(11) + (size_t)l * RANK * 1024 + ((size_t)(64 * rt) * 8 + h) * 128, 1024, 1, karg_in(7) + (size_t)l * D * D_IN + (size_t)(64 * kt) * D_IN + h * 128, D_IN,
                                   (GAS bf16*)((GAS unsigned char*)(wl + WO_IN) + (size_t)(h * 256 + 64 * rt) * D + 64 * kt), D, WQ8I_SCALE, karg_in(6) + (size_t)l * D + 64 * kt, Ps, Qs, tid);
                else absorb_unit<false>(karg_in(11) + (size_t)l * RANK * 1024 + ((size_t)(64 * rt) * 8 + h) * 128, 1024, 1, karg_in(7) + (size_t)l * D * D_IN + (size_t)(64 * kt) * D_IN + h * 128, D_IN,
                                   (GAS bf16*)(wl + WO_IN) + (size_t)(h * 256 + 64 * rt) * D + 64 * kt, D, 0.08838834764831845f, karg_in(6) + (size_t)l * D + 64 * kt, Ps, Qs, tid); }
            else { const int h = v >> 7, nt = (v >> 2) & 31, rt = v & 3;
                if constexpr (OUT_F8) absorb_unit<true, 1>(karg_in(14) + (size_t)l * D * D + (size_t)(h * 128) * D + 64 * nt, 1, D, karg_in(12) + (size_t)l * RANK * 1024 + ((size_t)(64 * rt) * 8 + h) * 128, 1024,
                                  (GAS bf16*)((GAS unsigned char*)(wl + WO_OUT) + (size_t)(64 * nt) * OLD + h * 256 + 64 * rt), OLD, W8_SCALE, nullptr, Ps, Qs, tid);
                else absorb_unit<true>(karg_in(14) + (size_t)l * D * D + (size_t)(h * 128) * D + 64 * nt, 1, D, karg_in(12) + (size_t)l * RANK * 1024 + ((size_t)(64 * rt) * 8 + h) * 128, 1024,
                                  (GAS bf16*)(wl + WO_OUT) + (size_t)(64 * nt) * OLD + h * 256 + 64 * rt, OLD, 1.0f, nullptr, Ps, Qs, tid); }
        }
    }
    GRID_BAR();

#pragma unroll 1
    for (int s = 0; s < 2 * DEPTH; ++s) {
        const int l = s >> 1, f = s & 1;
        REPEAT(REP_GU) {   PHASE_IDS(); GAS unsigned char* wl = ws + WS_W0 + (size_t)l * W_LAYER;
            pg8::StaticOrder S; S.init(M, NGU, G, bx);
            const GAS float* ssp = (const GAS float*)(ws + WS_SS + (size_t)((3 * l + 2 * f) & 1) * SS_BYTES);
            if ((F8_MASK == 0xF) || (F8_MASK != 0 && f8_on(l, f))) {
                if constexpr (F8_MASK != 0) {
                    pg8::Gemm g{(const GAS bf16*)(ws + WS_HB8), (const GAS bf16*)(wl + (f ? WO_GU2 : WO_GU1)), M, NGU, D / 2};
                    if constexpr (GU_I8) { pg8::EpiSwiglu<true> E{(GAS bf16*)(ws + WS_ACT), FF, ssp, 1.0f / D, EPS, 1.0f / (H8I_SCALE * W8I_SCALE), d8_on(l, f) ? A8_SCALE : 0.f};
                        pg8::gemm_phase<pg8::EpiSwiglu<true>, pg8::StaticOrder, true, true, false, true>(lds + RING_OFF, g, S, E, tid); }
                    else { pg8::EpiSwiglu<false> E{(GAS bf16*)(ws + WS_ACT), FF, ssp, 1.0f / D, EPS, 1.0f / W8_SCALE, d8_on(l, f) ? A8_SCALE : 0.f};
                        pg8::gemm_phase<pg8::EpiSwiglu<false>, pg8::StaticOrder, true, true, true>(lds + RING_OFF, g, S, E, tid); } }
            } else {
                if constexpr (F8_MASK != 0xF) {
                    pg8::Gemm g{(const GAS bf16*)(ws + WS_XN), (const GAS bf16*)(wl + (f ? WO_GU2 : WO_GU1)), M, NGU, D};
                    pg8::EpiSwiglu<false> E{(GAS bf16*)(ws + WS_ACT), FF, ssp, 1.0f / D, EPS, 1.0f, d8_on(l, f) ? A8_SCALE : 0.f};
                    pg8::gemm_phase<pg8::EpiSwiglu<false>, pg8::StaticOrder, true, true, false>(lds + RING_OFF, g, S, E, tid); }
            } }
        GRID_BAR();
        {   PHASE_IDS(); GAS unsigned char* wl = ws + WS_W0 + (size_t)l * W_LAYER;
            pg8::StaticOrder S; S.init(M, D, G, bx);
            const unsigned sso = (unsigned)(WS_SS + (size_t)((3 * l + 2 * f + 1) & 1) * SS_BYTES), h8o = ((f == 0 && IN_I8) || (f == 1 && l + 1 < DEPTH && f8_on(l + 1, 0))) ? (unsigned)WS_HB8 : 0u;
            if ((D8_MASK == 0xF) || (D8_MASK != 0 && d8_on(l, f))) {
                if constexpr (D8_MASK != 0) {
                    pg8::Gemm g{(const GAS bf16*)(ws + WS_ACT), (const GAS bf16*)(wl + (f ? WO_D2 : WO_D1)), M, D, FF / 2};
                    pg8::EpiResid E{0.5f / (W8_SCALE * A8_SCALE), (unsigned)WS_XN, sso, h8o, GU_I8 ? H8I_SCALE : 0.f};
                    pg8::gemm_phase<pg8::EpiResid, pg8::StaticOrder, true, true, true>(lds + RING_OFF, g, S, E, tid); }
            } else {
                if constexpr (D8_MASK != 0xF) {
                    pg8::Gemm g{(const GAS bf16*)(ws + WS_ACT), (const GAS bf16*)(wl + (f ? WO_D2 : WO_D1)), M, D, FF};
                    pg8::EpiResid E{0.5f, (unsigned)WS_XN, sso, h8o, GU_I8 ? H8I_SCALE : 0.f};
                    pg8::gemm_phase<pg8::EpiResid, pg8::StaticOrder, true, true, false>(lds + RING_OFF, g, S, E, tid); }
            } }
        GRID_BAR();
        if (f == 0) {
            REPEAT(REP_IN) {   PHASE_IDS(); GAS unsigned char* wl = ws + WS_W0 + (size_t)l * W_LAYER;
                const GAS float* ssp = (const GAS float*)(ws + WS_SS + (size_t)((3 * l + 1) & 1) * SS_BYTES);
                if constexpr (IN_I8) {
                    {   pg8::Gemm g{(const GAS bf16*)(ws + WS_HB8), (const GAS bf16*)(wl + WO_IN), M, ZN8, D / 2}; pg8::StaticOrder S; S.init(M, ZN8, G, bx);
                        pg8::EpiBf16<true> E{(GAS bf16*)(ws + WS_Z), ZLD, ssp, 1.0f / D, EPS, 0.08838834764831845f / (H8I_SCALE * WQ8I_SCALE), 1.0f / (H8I_SCALE * W8I_SCALE), 0.125f / (H8I_SCALE * W8I_SCALE)};
                        pg8::gemm_phase<pg8::EpiBf16<true>, pg8::StaticOrder, true, true, false, true>(lds + RING_OFF, g, S, E, tid); }
                    {   pg8::Gemm g{(const GAS bf16*)(ws + WS_XN), (const GAS bf16*)(wl + WO_IN + (size_t)ZN8 * D), M, ZLD - ZN8, D}; pg8::StaticOrder S; S.init(M, ZLD - ZN8, G, bx);
                        pg8::EpiBf16<false> E{(GAS bf16*)(ws + WS_Z) + ZN8, ZLD, ssp, 1.0f / D, EPS, 1.0f, 1.0f, 1.0f};
                        pg8::gemm_phase<pg8::EpiBf16<false>, pg8::StaticOrder, true, true, false, false>(lds + RING_OFF, g, S, E, tid); }
                } else {
                    pg8::Gemm g{(const GAS bf16*)(ws + WS_XN), (const GAS bf16*)(wl + WO_IN), M, ZLD, D}; pg8::StaticOrder S; S.init(M, ZLD, G, bx);
                    pg8::EpiBf16<false> E{(GAS bf16*)(ws + WS_Z), ZLD, ssp, 1.0f / D, EPS, 1.0f, 1.0f, 1.0f};
                    pg8::gemm_phase<pg8::EpiBf16<false>, pg8::StaticOrder, true, true, false, false>(lds + RING_OFF, g, S, E, tid); } }
            GRID_BAR();
            REPEAT(REP_POST) {   PHASE_IDS();
                post_rows((const GAS bf16*)(ws + WS_Z), karg_in(8) + (size_t)l * RANK, karg_in(9) + (size_t)l * IDIM, karg_in(10) + (size_t)l * IDIM, (GAS bf16*)(ws + WS_CKVN), (GAS bf16*)(ws + WS_KIN), (GAS float*)(ws + WS_WIF), gw, NGW, lane);
                swa_phase(lds + RING_OFF, (const GAS bf16*)(ws + WS_Z), (GAS bf16*)(ws + WS_O), karg_in(1), karg_in(13) + (size_t)l * H_B, vcu, G, tid, lane, wave);
            }
            GRID_BAR();
            REPEAT(REP_TOPK) {   PHASE_IDS(); topk_phase(lds + RING_OFF, (const GAS bf16*)(ws + WS_Z), (const GAS bf16*)(ws + WS_KIN), (const GAS float*)(ws + WS_WIF), (GAS unsigned short*)(ws + WS_IDX), (GAS unsigned long long*)(ws + WS_SCR), vcu, G, lane, wave); }
            GRID_BAR();
            REPEAT(REP_DSA) {   PHASE_IDS(); dsa_phase(lds, (const GAS bf16*)(ws + WS_Z), (const GAS bf16*)(ws + WS_CKVN), (const GAS unsigned short*)(ws + WS_IDX), (GAS bf16*)(ws + WS_O), karg_in(1), gw, NGW, tid, lane, wave); }
            GRID_BAR();
            {   PHASE_IDS(); GAS unsigned char* wl = ws + WS_W0 + (size_t)l * W_LAYER;
                pg8::Gemm g{(const GAS bf16*)(ws + WS_O), (const GAS bf16*)(wl + WO_OUT), M, D, OUT_F8 ? OLD / 2 : OLD}; pg8::StaticOrder S; S.init(M, D, G, bx);
                pg8::EpiResid E{OUT_F8 ? 1.0f / (W8_SCALE * O8_SCALE) : 1.0f, (unsigned)WS_XN, (unsigned)(WS_SS + (size_t)((3 * l + 2) & 1) * SS_BYTES), f8_on(l, 1) ? (unsigned)WS_HB8 : 0u, GU_I8 ? H8I_SCALE : 0.f};
                pg8::gemm_phase<pg8::EpiResid, pg8::StaticOrder, true, true, OUT_F8 != 0>(lds + RING_OFF, g, S, E, tid); }
            GRID_BAR();
        }
    }
    {   PHASE_IDS(); final_rows((const GAS bf16*)(ws + WS_XN), karg_out(), karg_in(19), (const GAS float*)(ws + WS_SS + (size_t)(6 & 1) * SS_BYTES), gw, NGW, lane); }
}

extern "C" void kernel_launch(void* const* d_in, const int* in_sizes, int n_in, void* d_out, int out_size, void* d_ws, size_t ws_size, hipStream_t stream) {
    static int grid = 0;
    if (grid == 0) {
        if (n_in != 20 || in_sizes[0] != M * D || out_size != M * D || ws_size < WS_END) { fprintf(stderr, "kernel_launch: unexpected shapes (n_in %d, in0 %d, out %d, ws %zu); nothing launched\n", n_in, n_in > 0 ? in_sizes[0] : -1, out_size, ws_size); grid = -1; return; }
        int dev = 0, cus = 0, per_cu = 0;
        if (hipGetDevice(&dev) != hipSuccess || hipDeviceGetAttribute(&cus, hipDeviceAttributeMultiprocessorCount, dev) != hipSuccess) { grid = -1; return; }
        if (hipFuncSetAttribute((const void*)mk_fwd, hipFuncAttributeMaxDynamicSharedMemorySize, LDS_BYTES) != hipSuccess) { fprintf(stderr, "kernel_launch: hipFuncSetAttribute failed\n"); grid = -1; return; }
        if (hipOccupancyMaxActiveBlocksPerMultiprocessor(&per_cu, (const void*)mk_fwd, NWAVES * 64, LDS_BYTES) != hipSuccess || per_cu < 1) { fprintf(stderr, "kernel_launch: occupancy query reports %d workgroups per CU\n", per_cu); }
        (void)hipGetLastError();
        grid = cus;
    }
    if (grid < 0) return;
    if (hipMemsetAsync((char*)d_ws + WS_CTL, 0, CTL_ZERO_BYTES, stream) != hipSuccess) return;
    Args a{};
    for (int i = 0; i < 20; ++i) a.in[i] = (const float*)d_in[i];
    a.out = (float*)d_out; a.ws = (unsigned char*)d_ws;
    hipLaunchKernelGGL(mk_fwd, dim3(grid), dim3(NWAVES * 64), LDS_BYTES, stream, a);
}
```

```cpp
#include <hip/hip_runtime.h>
#include <cstdio>
#include <cstdint>
namespace pg8 {
#define PG8_LAS __attribute__((address_space(3)))
#define PG8_GAS __attribute__((address_space(1)))
typedef unsigned short bf16_t;
typedef short bf16x8 __attribute__((ext_vector_type(8)));
typedef float f32x4 __attribute__((ext_vector_type(4)));
typedef unsigned u32x4 __attribute__((ext_vector_type(4)));
constexpr int BM = 256, BK = 64, HALF = 128, HTB = HALF * BK * 2  , STAGE_BYTES = 8 * HTB, NXCD = 8, WGM = 4;

__host__ __device__ __forceinline__ int lds_byte(int r, int c) { const int st = (r >> 4) * 2 + (c >> 5), rr = r & 15, cc = c & 31, ob = rr * 64 + cc * 2; return st * 1024 + (ob ^ (((ob >> 9) & 1) << 5)); }
__host__ __device__ __forceinline__ void stage_rc(int b, int& R, int& C) { const int st = b / 1024, sb = b % 1024, swz = sb ^ (((sb >> 9) & 1) << 5); R = (st >> 1) * 16 + swz / 64; C = (st & 1) * 32 + (swz % 64) / 2; }
__host__ __device__ __forceinline__ int perm32(int rho) { const int n = rho >> 4, i = rho & 15; return 8 * (i >> 2) + 4 * n + (i & 3); }

typedef int i32x8 __attribute__((ext_vector_type(8))); typedef int i32x4v __attribute__((ext_vector_type(4)));
__device__ __forceinline__ i32x8 cat8(bf16x8 a, bf16x8 b) { return __builtin_shufflevector(__builtin_bit_cast(i32x4v, a), __builtin_bit_cast(i32x4v, b), 0, 1, 2, 3, 4, 5, 6, 7); }
struct Unit { int pm, pn; };
struct Gemm { const PG8_GAS bf16_t* A; const PG8_GAS bf16_t* Bt; int M, N, K; };

struct StaticOrder {
    int nM, nN, nwg, G, c, split;
    __host__ __device__ void init(int M, int N, int G_, int c_) { nM = M / BM; nN = N / BM; nwg = nM * nN; G = G_; c = c_; split = 0; }
    __host__ __device__ void init_split68(int M, int N, int G_, int c_) { init(M, N, G_, c_); split = (nwg == 7 * G_ && (G_ & 15) == 0) ? 1 : 0; }
    __host__ __device__ bool next(int i, Unit& u) const {
        long L;
        if (split) { const int hG = G >> 1; if (i < 6) L = (long)i * G + c; else if (c >= hG && i < 8) L = 6L * G + (long)(i - 6) * hG + (c - hG); else return false; }
        else L = (long)i * G + c;
        if (L >= nwg) return false;
        int wgid = (int)L; { const int q = nwg / NXCD, r = nwg % NXCD, xcd = wgid % NXCD, off = wgid / NXCD; wgid = (xcd < r ? xcd * (q + 1) : r * (q + 1) + (xcd - r) * q) + off; }
        const int nig = WGM * nN, gid = wgid / nig, fm = gid * WGM, gsz = (nM - fm) < WGM ? (nM - fm) : WGM;
        u.pm = fm + ((wgid % nig) % gsz); u.pn = (wgid % nig) / gsz; return true;
    }
    __device__ __forceinline__ void a_ready(const Unit&) const {}
    __device__ __forceinline__ void done(const Unit&) const {}
};
__device__ __forceinline__ unsigned long long karg64(int idx) { unsigned long long r; const unsigned off = (unsigned)idx * 8u;
    asm volatile("s_load_dwordx2 %0, %1, %2\n\ts_waitcnt lgkmcnt(0)" : "=s"(r) : "s"(__builtin_amdgcn_kernarg_segment_ptr()), "s"(off) : "memory"); return r; }
__device__ __forceinline__ unsigned cvt_pk_bf16(float lo, float hi) { unsigned r; asm volatile("v_cvt_pk_bf16_f32 %0, %1, %2" : "=v"(r) : "v"(lo), "v"(hi)); return r; }
typedef float f32x2 __attribute__((ext_vector_type(2)));
__device__ __forceinline__ unsigned pack4_i8(float a, float b, float c, float d, float S) {
    const int qa = (int)__builtin_rintf(__builtin_fminf(__builtin_fmaxf(a * S, -127.f), 127.f)), qb = (int)__builtin_rintf(__builtin_fminf(__builtin_fmaxf(b * S, -127.f), 127.f));
    const int qc = (int)__builtin_rintf(__builtin_fminf(__builtin_fmaxf(c * S, -127.f), 127.f)), qd = (int)__builtin_rintf(__builtin_fminf(__builtin_fmaxf(d * S, -127.f), 127.f));
    return ((unsigned)qa & 0xffu) | (((unsigned)qb & 0xffu) << 8) | (((unsigned)qc & 0xffu) << 16) | ((unsigned)qd << 24);
}
__device__ __forceinline__ float silu_f(float g) { return g * __builtin_amdgcn_rcpf(1.0f + __builtin_amdgcn_exp2f(-1.4426950408889634f * g)); }

template <bool ACC_I32 = false>
struct EpiSwiglu {
    static constexpr bool PERM = true, AFTER_DRAIN = false;
    static __device__ __forceinline__ f32x4 cv(const f32x4& a) { if constexpr (ACC_I32) { typedef int i32x4e __attribute__((ext_vector_type(4))); const i32x4e q = __builtin_bit_cast(i32x4e, a); return (f32x4){(float)q[0], (float)q[1], (float)q[2], (float)q[3]}; } else return a; }
    PG8_GAS bf16_t* O; int ldc; const PG8_GAS float* ss; float inv_k, eps, post; float out8;
    __device__ __forceinline__ void operator()(const f32x4 (&acc)[2][2][4][2], const Unit& u, int wr, int wc, int fr, int fq) const {
        const int row0 = u.pm * BM + wr * 64 + fr, col0 = u.pn * HALF + wc * 32 + 8 * fq;
        float rs[8]; const int lane_ = fr + 16 * fq;
#pragma unroll
        for (int k = 0; k < 8; ++k) { const PG8_GAS f32x4* p4 = (const PG8_GAS f32x4*)(ss + (size_t)(row0 + (k >> 2) * HALF + (k & 3) * 16) * 32 + 8 * fq); const f32x4 a = p4[0], b = p4[1];
            float t = ((a[0] + a[1]) + (a[2] + a[3])) + ((b[0] + b[1]) + (b[2] + b[3]));
            t += __builtin_bit_cast(float, __builtin_amdgcn_ds_bpermute((lane_ ^ 16) << 2, __builtin_bit_cast(int, t)));
            t += __builtin_bit_cast(float, __builtin_amdgcn_ds_bpermute((lane_ ^ 32) << 2, __builtin_bit_cast(int, t))); rs[k] = t; }
        unsigned pk[8][2];
#pragma unroll
        for (int ai = 0; ai < 2; ++ai)
#pragma unroll
            for (int m = 0; m < 4; ++m) { PG8_GAS bf16_t* rowp = O + (size_t)(row0 + ai * HALF + m * 16) * ldc + col0;
                const float r = __builtin_amdgcn_rsqf(rs[ai * 4 + m] * inv_k + eps) * post;
                const f32x2 r2 = {r, r}, c2 = {-1.4426950408889634f * r, -1.4426950408889634f * r}; const float rs8 = out8 != 0.f ? r * out8 : r; const f32x2 q2 = {rs8, rs8}, one2 = {1.0f, 1.0f};
                f32x2 o[4];
#pragma unroll
                for (int h = 0; h < 4; ++h) { const f32x4 gq = cv(acc[ai][0][m][h >> 1]), uq = cv(acc[ai][1][m][h >> 1]);
                    const f32x2 gv = {gq[2 * (h & 1)], gq[2 * (h & 1) + 1]}, uv = {uq[2 * (h & 1)], uq[2 * (h & 1) + 1]};
                    const f32x2 t = gv * c2; f32x2 e; e.x = __builtin_amdgcn_exp2f(t.x); e.y = __builtin_amdgcn_exp2f(t.y);
                    const f32x2 d = e + one2; f32x2 rc; rc.x = __builtin_amdgcn_rcpf(d.x); rc.y = __builtin_amdgcn_rcpf(d.y);
                    o[h] = ((gv * r2) * rc) * (uv * q2); }
                if (out8 != 0.f) { int p = 0, q = 0;
                    p = __builtin_amdgcn_cvt_pk_fp8_f32(o[0].x, o[0].y, p, false); p = __builtin_amdgcn_cvt_pk_fp8_f32(o[1].x, o[1].y, p, true);
                    q = __builtin_amdgcn_cvt_pk_fp8_f32(o[2].x, o[2].y, q, false); q = __builtin_amdgcn_cvt_pk_fp8_f32(o[3].x, o[3].y, q, true);
                    pk[ai * 4 + m][0] = (unsigned)p; pk[ai * 4 + m][1] = (unsigned)q; }
                else { u32x4 w; w.x = cvt_pk_bf16(o[0].x, o[0].y); w.y = cvt_pk_bf16(o[1].x, o[1].y); w.z = cvt_pk_bf16(o[2].x, o[2].y); w.w = cvt_pk_bf16(o[3].x, o[3].y);
                    *(PG8_GAS u32x4*)rowp = w; } }
        if (out8 != 0.f) {
#pragma unroll
            for (int k = 0; k < 8; k += 2) {
                typedef unsigned u2v __attribute__((ext_vector_type(2)));
                const u2v sp = __builtin_amdgcn_permlane16_swap(pk[k][0], pk[k + 1][0], false, false), sq = __builtin_amdgcn_permlane16_swap(pk[k][1], pk[k + 1][1], false, false);
                const int kk = k + (fq & 1); const int rowk = row0 + (kk >> 2) * HALF + (kk & 3) * 16;
                u32x4 w; w.x = sp.x; w.y = sq.x; w.z = sp.y; w.w = sq.y;
                *(PG8_GAS u32x4*)((PG8_GAS unsigned char*)O + (size_t)rowk * ldc + (col0 - 8 * (fq & 1))) = w; } }
    }
};
struct EpiResid {
    static constexpr bool PERM = true, AFTER_DRAIN = false;
    float alpha; unsigned hb_off; unsigned ss_off; unsigned h8_off; float h8_i8;
    __device__ __forceinline__ void operator()(const f32x4 (&acc)[2][2][4][2], const Unit& u, int wr, int wc, int fr, int fq) const {
        constexpr int ldc = 2048;
        PG8_GAS unsigned char* wsb = (PG8_GAS unsigned char*)karg64(21); PG8_GAS bf16_t* hb = (PG8_GAS bf16_t*)(wsb + hb_off); PG8_GAS float* ss = (PG8_GAS float*)(wsb + ss_off);
        const int row0 = u.pm * BM + wr * 64 + fr, col0 = u.pn * BM + wc * 32 + 8 * fq; const int lane = fr + 16 * fq;
        u32x4 cur[2], nxt[2];
        { const size_t off = (size_t)row0 * ldc + col0; cur[0] = *(const PG8_GAS u32x4*)(hb + off); cur[1] = *(const PG8_GAS u32x4*)(hb + off + HALF); }
#pragma unroll
        for (int k = 0; k < 8; ++k) { const int ai = k >> 2, m = k & 3; const int row = row0 + ai * HALF + m * 16; const size_t off = (size_t)row * ldc + col0;
            if (k < 7) { const int ai2 = (k + 1) >> 2, m2 = (k + 1) & 3; const size_t off2 = (size_t)(row0 + ai2 * HALF + m2 * 16) * ldc + col0;
                nxt[0] = *(const PG8_GAS u32x4*)(hb + off2); nxt[1] = *(const PG8_GAS u32x4*)(hb + off2 + HALF); }
            float sq = 0.f;
#pragma unroll
            for (int bj = 0; bj < 2; ++bj) { const u32x4 b = cur[bj]; const f32x4 a0 = acc[ai][bj][m][0], a1 = acc[ai][bj][m][1]; u32x4 w;
                w.x = cvt_pk_bf16(__builtin_bit_cast(float, b.x << 16) + a0[0] * alpha, __builtin_bit_cast(float, b.x & 0xffff0000u) + a0[1] * alpha);
                w.y = cvt_pk_bf16(__builtin_bit_cast(float, b.y << 16) + a0[2] * alpha, __builtin_bit_cast(float, b.y & 0xffff0000u) + a0[3] * alpha);
                w.z = cvt_pk_bf16(__builtin_bit_cast(float, b.z << 16) + a1[0] * alpha, __builtin_bit_cast(float, b.z & 0xffff0000u) + a1[1] * alpha);
                w.w = cvt_pk_bf16(__builtin_bit_cast(float, b.w << 16) + a1[2] * alpha, __builtin_bit_cast(float, b.w & 0xffff0000u) + a1[3] * alpha);
                *(PG8_GAS u32x4*)(hb + off + bj * HALF) = w;
                if (h8_off) { typedef unsigned u32x2v __attribute__((ext_vector_type(2))); u32x2v q8; int p = 0;
                    const float e0 = __builtin_bit_cast(float, w.x << 16), e1 = __builtin_bit_cast(float, w.x & 0xffff0000u), e2 = __builtin_bit_cast(float, w.y << 16), e3 = __builtin_bit_cast(float, w.y & 0xffff0000u);
                    const float e4 = __builtin_bit_cast(float, w.z << 16), e5 = __builtin_bit_cast(float, w.z & 0xffff0000u), e6 = __builtin_bit_cast(float, w.w << 16), e7 = __builtin_bit_cast(float, w.w & 0xffff0000u);
                    if (h8_i8 != 0.f) { q8.x = pack4_i8(e0, e1, e2, e3, h8_i8); q8.y = pack4_i8(e4, e5, e6, e7, h8_i8); }
                    else { p = __builtin_amdgcn_cvt_pk_fp8_f32(e0, e1, p, false); p = __builtin_amdgcn_cvt_pk_fp8_f32(e2, e3, p, true); q8.x = (unsigned)p; p = 0;
                        p = __builtin_amdgcn_cvt_pk_fp8_f32(e4, e5, p, false); p = __builtin_amdgcn_cvt_pk_fp8_f32(e6, e7, p, true); q8.y = (unsigned)p; }
                    *(PG8_GAS u32x2v*)(wsb + h8_off + off + bj * HALF) = q8; }
#pragma unroll
                for (int e = 0; e < 4; ++e) { const float lo = __builtin_bit_cast(float, w[e] << 16), hi = __builtin_bit_cast(float, w[e] & 0xffff0000u); sq = fmaf(lo, lo, sq); sq = fmaf(hi, hi, sq); } }
            sq += __builtin_bit_cast(float, __builtin_amdgcn_ds_bpermute((lane ^ 16) << 2, __builtin_bit_cast(int, sq)));
            sq += __builtin_bit_cast(float, __builtin_amdgcn_ds_bpermute((lane ^ 32) << 2, __builtin_bit_cast(int, sq)));
            if (fq == 0) ss[(size_t)row * 32 + u.pn * 4 + wc] = sq;
            cur[0] = nxt[0]; cur[1] = nxt[1]; }
    }
};
template <bool ACC_I32 = false>
struct EpiBf16 {
    static constexpr bool PERM = true, AFTER_DRAIN = false;
    static __device__ __forceinline__ f32x4 cv(const f32x4& a) { if constexpr (ACC_I32) { typedef int i32x4e __attribute__((ext_vector_type(4))); const i32x4e q = __builtin_bit_cast(i32x4e, a); return (f32x4){(float)q[0], (float)q[1], (float)q[2], (float)q[3]}; } else return a; }
    PG8_GAS bf16_t* O; int ldc; const PG8_GAS float* ss; float inv_k, eps; float post_a, post_b, post_c;
    __device__ __forceinline__ void operator()(const f32x4 (&acc)[2][2][4][2], const Unit& u, int wr, int wc, int fr, int fq) const {
        const int row0 = u.pm * BM + wr * 64 + fr, col0 = u.pn * BM + wc * 32 + 8 * fq;
        const float pfac = fmaf(u.pn < 8 ? 1.0f : 0.0f, post_a - post_b, fmaf((u.pn >= 9 && u.pn < 13) ? 1.0f : 0.0f, post_c - post_b, post_b));
        float rs[8]; const int lane_ = fr + 16 * fq;
#pragma unroll
        for (int k = 0; k < 8; ++k) { const PG8_GAS f32x4* p4 = (const PG8_GAS f32x4*)(ss + (size_t)(row0 + (k >> 2) * HALF + (k & 3) * 16) * 32 + 8 * fq); const f32x4 a = p4[0], b = p4[1];
            float t = ((a[0] + a[1]) + (a[2] + a[3])) + ((b[0] + b[1]) + (b[2] + b[3]));
            t += __builtin_bit_cast(float, __builtin_amdgcn_ds_bpermute((lane_ ^ 16) << 2, __builtin_bit_cast(int, t)));
            t += __builtin_bit_cast(float, __builtin_amdgcn_ds_bpermute((lane_ ^ 32) << 2, __builtin_bit_cast(int, t))); rs[k] = t; }
#pragma unroll
        for (int ai = 0; ai < 2; ++ai)
#pragma unroll
            for (int m = 0; m < 4; ++m) { PG8_GAS bf16_t* rowp = O + (size_t)(row0 + ai * HALF + m * 16) * ldc + col0;
                const float r = __builtin_amdgcn_rsqf(rs[ai * 4 + m] * inv_k + eps) * pfac;
#pragma unroll
                for (int bj = 0; bj < 2; ++bj) { const f32x4 v0 = cv(acc[ai][bj][m][0]) * r, v1 = cv(acc[ai][bj][m][1]) * r;
                    u32x4 w; w.x = cvt_pk_bf16(v0[0], v0[1]); w.y = cvt_pk_bf16(v0[2], v0[3]); w.z = cvt_pk_bf16(v1[0], v1[1]); w.w = cvt_pk_bf16(v1[2], v1[3]);
                    *(PG8_GAS u32x4*)(rowp + bj * HALF) = w; } }
    }
};
template <class Epi, class Sched, bool ALIGN_EPI = false, bool SP2 = false, bool F8 = false, bool I8 = false>
__device__ __forceinline__ void gemm_phase(PG8_LAS unsigned char* lds, const Gemm g, const Sched& S, const Epi& E, int tid_in  ) {
    int tid_ = tid_in; asm volatile("" : "+v"(tid_));
    const int tid = tid_, wid = __builtin_amdgcn_readfirstlane(tid >> 6), lane = tid & 63, wr = wid >> 2, wc = wid & 3, fr = lane & 15, fq = lane >> 4;
    const int K = g.K, nt = K / BK;
    unsigned voffA[2], voffB[2];
#pragma unroll
    for (int i = 0; i < 2; ++i) { int R, C; stage_rc(tid * 16 + i * 8192, R, C); const int Rb = Epi::PERM ? ((R & ~31) + perm32(R & 31)) : R;
        voffA[i] = (unsigned)(R * K + C) * 2u; voffB[i] = (unsigned)(Rb * K + C) * 2u; }
    const size_t kstep = (size_t)(BK * 2);
    const size_t hstep = (size_t)HALF * K * 2;
    const size_t tstep = 2 * hstep;
    const unsigned ldsw = (unsigned)wid * 1024u;
    const int aoff = lds_byte(wr * 64 + fr, fq * 8), boff = lds_byte(wc * 32 + fr, fq * 8);
#define PG8_SA(b, h) (((b) * 2 + (h)) * HTB)
#define PG8_SB(b, h) ((4 + (b) * 2 + (h)) * HTB)
#define PG8_STAGE(bufoff, gbase, voff) do { _Pragma("unroll") for (int _i = 0; _i < 2; ++_i) \
        __builtin_amdgcn_global_load_lds((const PG8_GAS unsigned*)((const PG8_GAS char*)(gbase) + (voff)[_i]), (PG8_LAS unsigned*)(lds + (bufoff) + ldsw + _i * 8192), 16, 0, 0); } while (0)
#define PG8_LDA(dst, b, h) do { _Pragma("unroll") for (int m = 0; m < 4; ++m) _Pragma("unroll") for (int k = 0; k < 2; ++k) dst[m][k] = *(const PG8_LAS bf16x8*)(lds + PG8_SA(b, h) + aoff + m * 2048 + k * 1024); } while (0)
#define PG8_LDB(dst, b, h) do { _Pragma("unroll") for (int n = 0; n < 2; ++n) _Pragma("unroll") for (int k = 0; k < 2; ++k) dst[n][k] = *(const PG8_LAS bf16x8*)(lds + PG8_SB(b, h) + boff + n * 2048 + k * 1024); } while (0)
#define PG8_MMA(ai, bj, At, Bt) do { __builtin_amdgcn_s_setprio(1); _Pragma("unroll") for (int m = 0; m < 4; ++m) _Pragma("unroll") for (int n = 0; n < 2; ++n) { \
        if constexpr (F8) { asm volatile("v_mfma_f32_16x16x128_f8f6f4 %0, %1, %2, %0" : "+v"(acc[ai][bj][m][n]) : "v"(cat8(Bt[n][0], Bt[n][1])), "v"(cat8(At[m][0], At[m][1]))); } \
        else if constexpr (I8) { _Pragma("unroll") for (int k = 0; k < 2; ++k) asm volatile("v_mfma_i32_16x16x64_i8 %0, %1, %2, %0" : "+v"(acc[ai][bj][m][n]) : "v"(Bt[n][k]), "v"(At[m][k])); } \
        else { _Pragma("unroll") for (int k = 0; k < 2; ++k) acc[ai][bj][m][n] = __builtin_amdgcn_mfma_f32_16x16x32_bf16(Bt[n][k], At[m][k], acc[ai][bj][m][n], 0, 0, 0); } } \
        __builtin_amdgcn_s_setprio(0); } while (0)
#define PG8_WAIT_V(n) asm volatile("s_waitcnt vmcnt(" #n ")" ::: "memory")
#define PG8_WAIT_L(n) asm volatile("s_waitcnt lgkmcnt(" #n ")" ::: "memory")
#define PG8_BAR __builtin_amdgcn_s_barrier()
#define PG8_SCHED __builtin_amdgcn_sched_barrier(0)
    Unit cur, nxt; int ui = 0;
    if (!S.next(0, cur)) return;
    f32x4 acc[2][2][4][2];
#pragma unroll
    for (int a = 0; a < 2; ++a)
#pragma unroll
        for (int b = 0; b < 2; ++b)
#pragma unroll
            for (int m = 0; m < 4; ++m)
#pragma unroll
                for (int n = 0; n < 2; ++n) acc[a][b][m][n] = (f32x4){0.f, 0.f, 0.f, 0.f};
    bf16x8 At[4][2], B0[2][2], B1[2][2];
    const PG8_GAS char* cA = (const PG8_GAS char*)g.A + (size_t)cur.pm * tstep; const PG8_GAS char* cB = (const PG8_GAS char*)g.Bt + (size_t)cur.pn * tstep;
    S.a_ready(cur);
    if constexpr (SP2) {
        PG8_STAGE(PG8_SB(0, 0), cB, voffB); PG8_STAGE(PG8_SB(0, 1), cB + hstep, voffB); PG8_STAGE(PG8_SA(0, 0), cA, voffA); PG8_STAGE(PG8_SA(0, 1), cA + hstep, voffA);
        if (wr == 1) PG8_BAR;
        PG8_WAIT_V(2); PG8_BAR;
        PG8_STAGE(PG8_SB(1, 0), cB + kstep, voffB); PG8_STAGE(PG8_SA(1, 0), cA + kstep, voffA); PG8_STAGE(PG8_SB(1, 1), cB + hstep + kstep, voffB);
        PG8_WAIT_V(6); PG8_BAR;
    } else {
        PG8_STAGE(PG8_SB(0, 0), cB, voffB); PG8_STAGE(PG8_SA(0, 0), cA, voffA); PG8_STAGE(PG8_SB(0, 1), cB + hstep, voffB); PG8_STAGE(PG8_SA(0, 1), cA + hstep, voffA);
        if (wr == 1) PG8_BAR;
        PG8_WAIT_V(4); PG8_BAR;
        PG8_STAGE(PG8_SB(1, 0), cB + kstep, voffB); PG8_STAGE(PG8_SA(1, 0), cA + kstep, voffA); PG8_STAGE(PG8_SB(1, 1), cB + hstep + kstep, voffB);
        PG8_WAIT_V(6); PG8_BAR;
    }
    for (;;) {
        const bool has_next = S.next(ui + 1, nxt);
        const PG8_GAS char* nA = has_next ? (const PG8_GAS char*)g.A + (size_t)nxt.pm * tstep : cA; const PG8_GAS char* nB = has_next ? (const PG8_GAS char*)g.Bt + (size_t)nxt.pn * tstep : cB;
        for (int t = 0; t < nt; t += 2) {
            const bool last = (t == nt - 2);
            const PG8_GAS char* a1 = cA + (size_t)(t + 1) * kstep;
            const PG8_GAS char* a2 = last ? nA : cA + (size_t)(t + 2) * kstep; const PG8_GAS char* b2 = last ? nB : cB + (size_t)(t + 2) * kstep;
            const PG8_GAS char* a3 = a2 + kstep; const PG8_GAS char* b3 = b2 + kstep;
            if (last && has_next) S.a_ready(nxt);
            if constexpr (SP2) {
            PG8_LDB(B0, 0, 0); PG8_LDB(B1, 0, 1); PG8_SCHED; PG8_LDA(At, 0, 0); PG8_STAGE(PG8_SA(1, 1), a1 + hstep, voffA);
            PG8_WAIT_V(8); PG8_WAIT_L(0); PG8_BAR; PG8_MMA(0, 0, At, B0); PG8_MMA(0, 1, At, B1); PG8_BAR; PG8_SCHED;
            PG8_LDA(At, 0, 1); PG8_STAGE(PG8_SB(0, 0), b2, voffB); PG8_STAGE(PG8_SB(0, 1), b2 + hstep, voffB); PG8_STAGE(PG8_SA(0, 0), a2, voffA);
            PG8_WAIT_V(8); PG8_WAIT_L(0); PG8_BAR; PG8_MMA(1, 0, At, B0); PG8_MMA(1, 1, At, B1); PG8_BAR; PG8_SCHED;
            PG8_LDB(B0, 1, 0); PG8_LDB(B1, 1, 1); PG8_SCHED; PG8_LDA(At, 1, 0); PG8_STAGE(PG8_SA(0, 1), a2 + hstep, voffA);
            PG8_WAIT_V(8); PG8_WAIT_L(0); PG8_BAR; PG8_MMA(0, 0, At, B0); PG8_MMA(0, 1, At, B1); PG8_BAR; PG8_SCHED;
            PG8_LDA(At, 1, 1); PG8_STAGE(PG8_SB(1, 0), b3, voffB); PG8_STAGE(PG8_SB(1, 1), b3 + hstep, voffB); PG8_STAGE(PG8_SA(1, 0), a3, voffA);
            PG8_WAIT_V(8); PG8_WAIT_L(0); PG8_BAR; PG8_MMA(1, 0, At, B0); PG8_MMA(1, 1, At, B1); PG8_BAR; PG8_SCHED;
            } else {
            PG8_LDB(B0, 0, 0); PG8_SCHED; PG8_LDA(At, 0, 0); PG8_STAGE(PG8_SA(1, 1), a1 + hstep, voffA);
            PG8_WAIT_L(8); PG8_BAR; PG8_WAIT_L(0); PG8_MMA(0, 0, At, B0); PG8_BAR; PG8_SCHED;
            PG8_LDB(B1, 0, 1); PG8_STAGE(PG8_SB(0, 0), b2, voffB);
            PG8_BAR; PG8_WAIT_L(0); PG8_MMA(0, 1, At, B1); PG8_BAR;
            PG8_LDA(At, 0, 1); PG8_STAGE(PG8_SA(0, 0), a2, voffA);
            PG8_BAR; PG8_WAIT_L(0); PG8_MMA(1, 0, At, B0); PG8_BAR; PG8_SCHED;
            PG8_STAGE(PG8_SB(0, 1), b2 + hstep, voffB);
            PG8_WAIT_V(6); PG8_BAR; PG8_MMA(1, 1, At, B1); PG8_BAR;
            PG8_LDB(B0, 1, 0); PG8_SCHED; PG8_LDA(At, 1, 0); PG8_STAGE(PG8_SA(0, 1), a2 + hstep, voffA);
            PG8_WAIT_L(8); PG8_BAR; PG8_WAIT_L(0); PG8_MMA(0, 0, At, B0); PG8_BAR; PG8_SCHED;
            PG8_LDB(B1, 1, 1); PG8_STAGE(PG8_SB(1, 0), b3, voffB);
            PG8_BAR; PG8_WAIT_L(0); PG8_MMA(0, 1, At, B1); PG8_BAR;
            PG8_LDA(At, 1, 1); PG8_STAGE(PG8_SA(1, 0), a3, voffA);
            PG8_BAR; PG8_WAIT_L(0); PG8_MMA(1, 0, At, B0); PG8_BAR; PG8_SCHED;
            PG8_STAGE(PG8_SB(1, 1), b3 + hstep, voffB);
            PG8_WAIT_V(6); PG8_BAR; PG8_MMA(1, 1, At, B1); PG8_BAR;
            }
        }
        if constexpr (ALIGN_EPI) { if (wr == 0) PG8_BAR; }
        if constexpr (!Epi::AFTER_DRAIN) { int ln_; asm volatile("v_mbcnt_lo_u32_b32 %0, -1, 0\n\tv_mbcnt_hi_u32_b32 %0, -1, %0" : "=v"(ln_));
            E(acc, cur, wr, wc, ln_ & 15, ln_ >> 4); S.done(cur); }
        if (!has_next) break;
#pragma unroll
        for (int a = 0; a < 2; ++a)
#pragma unroll
            for (int b = 0; b < 2; ++b)
#pragma unroll
                for (int m = 0; m < 4; ++m)
#pragma unroll
                    for (int n = 0; n < 2; ++n) acc[a][b][m][n] = (f32x4){0.f, 0.f, 0.f, 0.f};
        cur = nxt; cA = nA; cB = nB; ++ui;
        if constexpr (ALIGN_EPI) { if (wr == 1) PG8_BAR; }
    }
    PG8_WAIT_V(0);
    if constexpr (!ALIGN_EPI) { if (wr == 0) PG8_BAR; }
    PG8_BAR;
    if constexpr (Epi::AFTER_DRAIN) { E.fused(acc, cur, wr, wc, fr, fq, lds, wid, lane); S.done(cur); }
#undef PG8_SA
#undef PG8_SB
#undef PG8_STAGE
#undef PG8_LDA
#undef PG8_LDB
#undef PG8_MMA
#undef PG8_WAIT_V
#undef PG8_WAIT_L
#undef PG8_BAR
#undef PG8_SCHED
}
}
constexpr int NWAVES = 8;
constexpr int BATCH = 8, SEQ = 4096, D = 2048, FF = 5632, DEPTH = 2;
constexpr int M = BATCH * SEQ;
constexpr int NGU = 2 * FF;
constexpr int H_A = 8, HD_A = 128, RANK = 256, IH = 8, IDIM = 64, TOPK = 256;
constexpr int H_B = 16, KVH = 2, GQA = 8, HD_B = 64, WINDOW = 128;
constexpr int D_IN = 3144;
constexpr float EPS = 1e-6f;
constexpr size_t MiB = 1u << 20;
constexpr size_t WS_CTL = 0, CTL_ZERO_BYTES = 1 * MiB;
#ifndef F8_MASK
#define F8_MASK 0xF
#endif
constexpr float W8_SCALE = 64.0f;
#ifndef GU_I8
#define GU_I8 1
#endif
constexpr float H8I_SCALE = 127.0f / 4.6f, W8I_SCALE = 127.0f / (4.2f * 0.022097086912079608f);
#ifndef D8_MASK
#define D8_MASK 0xF
#endif
constexpr float A8_SCALE = 8.0f;
__host__ __device__ constexpr bool d8_on(int l, int f) { return ((D8_MASK >> (2 * l + f)) & 1) != 0; }
constexpr float O8_SCALE = 16.0f;
#ifndef OUT_F8
#define OUT_F8 1
#endif
constexpr bool F8_ALL1 = (F8_MASK & 0x5) == 0x5, F8_ALL2 = (F8_MASK & 0xA) == 0xA;
__host__ __device__ constexpr bool f8_on(int l, int f) { return ((F8_MASK >> (2 * l + f)) & 1) != 0; }
constexpr size_t GU1_B = (F8_ALL1 ? 22 : 44) * MiB, GU2_B = (F8_ALL2 ? 22 : 44) * MiB;
constexpr size_t WS_W0 = 2 * MiB;
constexpr size_t WO_GU1 = 0, WO_D1 = GU1_B, WO_GU2 = WO_D1 + 22 * MiB, WO_D2 = WO_GU2 + GU2_B, WO_IN = WO_D2 + 22 * MiB, WO_OUT = WO_IN + 17 * MiB, W_LAYER = WO_OUT + 12 * MiB;
constexpr size_t WS_XN = WS_W0 + 2 * W_LAYER;
constexpr size_t WS_HB8 = WS_XN + 128 * MiB;
constexpr size_t WS_ACT = WS_HB8 + (F8_MASK ? 64 : 0) * MiB;
constexpr size_t WS_Z = WS_ACT, WS_CKVN = WS_ACT + 272 * MiB, WS_KIN = WS_ACT + 288 * MiB, WS_WIF = WS_ACT + 292 * MiB, WS_IDX = WS_ACT + 294 * MiB;
constexpr int ZLD = 4352, ZC_QLAT = 0, ZC_CKV = 2048, ZC_QB = 2304, ZC_KB = 3328, ZC_VB = 3456, ZC_QI = 3584, ZC_KI = 4096, ZC_WI = 4160;
constexpr int ZN8 = 3584;
#ifndef IN_I8
#define IN_I8 1
#endif
constexpr float WQ8I_SCALE = 127.0f / (4.2f * 0.015625f);
constexpr int OLD = 3072;
constexpr size_t WS_O = WS_ACT + 352 * MiB;
constexpr size_t WS_SS = WS_O + (OUT_F8 ? 96 : 192) * MiB, SS_BYTES = 4 * MiB;
constexpr size_t WS_SCR = WS_SS + 2 * SS_BYTES;
constexpr size_t SCR_GROUPS = 64 * 65, SCR_BYTES = (size_t)8 * SCR_GROUPS * 8 * 64 * 8;
constexpr size_t WS_END = WS_SCR + SCR_BYTES;
static_assert(WS_END <= 1024 * MiB, "d_ws map exceeds 1 GiB");
constexpr int CW_TMO = 0, CW_CODE = 1, CW_BAR = 4096, CW_XRANK = 8192;
constexpr int RING_OFF = 0, RING_BYTES = 131072;
constexpr int LDSCTL_OFF = RING_BYTES, MISC_OFF = LDSCTL_OFF + 320;
constexpr int LDS_BYTES = 147456;
constexpr int RSL_OFF = RING_BYTES + 5632;
#define GAS __attribute__((address_space(1)))
#define LAS __attribute__((address_space(3)))
typedef unsigned short bf16;
typedef unsigned v4u __attribute__((ext_vector_type(4)));
typedef float f32x4 __attribute__((ext_vector_type(4)));
typedef short bf16x8 __attribute__((ext_vector_type(8)));
typedef GAS unsigned gu32;
typedef GAS unsigned long long gu64;
#define RLX_AGENT __ATOMIC_RELAXED, __HIP_MEMORY_SCOPE_AGENT
#define LDS_WAIT() asm volatile("s_waitcnt lgkmcnt(0)" ::: "memory")
#define VM_WAIT() asm volatile("s_waitcnt vmcnt(0)" ::: "memory")
__device__ __forceinline__ unsigned long long rt() { return __builtin_amdgcn_s_memrealtime(); }
__device__ __forceinline__ unsigned f2bf(float f) { unsigned u = __builtin_bit_cast(unsigned, f); return (u + 0x7fffu + ((u >> 16) & 1u)) >> 16; }
__device__ __forceinline__ unsigned pk2(float lo, float hi) { return f2bf(lo) | (f2bf(hi) << 16); }

#define XB_TMO      128
#define XB_XCNT(j)  (256  + 64 * (j))
#define XB_XSUB(j)  (1280 + 64 * (j))
#define XB_XGEN(j)  (2304 + 64 * (j))
#define XB_TOP      3328
#define XB_TOPGEN   3392
#define XCD_BAR_WORDS 3456
#define XB_SPIN_CAP (1u << 18)

__device__ __forceinline__ unsigned xb_ld(unsigned* p)              { return __hip_atomic_load(p, __ATOMIC_RELAXED, __HIP_MEMORY_SCOPE_AGENT); }
__device__ __forceinline__ unsigned xb_add(unsigned* p, unsigned v) { return __hip_atomic_fetch_add(p, v, __ATOMIC_RELAXED, __HIP_MEMORY_SCOPE_AGENT); }
__device__ __forceinline__ unsigned xb_xcc_id() { return (unsigned)__builtin_amdgcn_s_getreg((3 << 11) | 20) & 0xFu; }
#define XB_SPIN(cond, bar) do { unsigned _sp = 0; while (cond) { __builtin_amdgcn_s_sleep(1); \
    if ((++_sp & 255u) == 0u) { if (xb_ld(&(bar)[XB_TMO])) break; if (_sp > XB_SPIN_CAP) { atomicAdd(&(bar)[XB_TMO], 1u); break; } } } } while (0)

struct XcdBarrier {
    unsigned* bar; unsigned x;
    volatile LAS unsigned* st;
};

__device__ __forceinline__ XcdBarrier xcd_barrier_post(unsigned* bar, volatile LAS unsigned* st, bool leader  ) {
    XcdBarrier b; b.bar = bar; b.x = xb_xcc_id(); b.st = st;
    if (leader) (void)xb_add(&bar[XB_XCNT(b.x)], 1u);
    return b;
}
__device__ __forceinline__ void xcd_barrier_complete(unsigned* bar, unsigned x, unsigned& nloc, unsigned& nx) {
    const unsigned G = gridDim.x * gridDim.y * gridDim.z;
    unsigned sum, cnt, mine, sp = 0u;
    for (;;) {
        sum = 0u; cnt = 0u; mine = 0u;
#pragma unroll
        for (unsigned j = 0; j < 16; ++j) { const unsigned c = xb_ld(&bar[XB_XCNT(j)]); sum += c; cnt += (c > 0u) ? 1u : 0u; mine = (j == x) ? c : mine; }
        if (sum == G) break;
        __builtin_amdgcn_s_sleep(1);
        if ((++sp & 255u) == 0u) { if (xb_ld(&bar[XB_TMO])) break; if (sp > XB_SPIN_CAP) { atomicAdd(&bar[XB_TMO], 1u); break; } }
    }
    nloc = mine > 0u ? mine : 1u; nx = cnt > 0u ? cnt : 1u;
}

__device__ __forceinline__ void xcd_barrier(const XcdBarrier& b, bool leader  ) {
    asm volatile("s_waitcnt vmcnt(0)" ::: "memory");
    __syncthreads();
    if (leader) {
        unsigned* bar = b.bar;
        __builtin_amdgcn_s_waitcnt(0);
        unsigned nloc = b.st[0], nx = b.st[1];
        if (nloc == 0u) { xcd_barrier_complete(bar, b.x, nloc, nx); b.st[0] = nloc; b.st[1] = nx; }
        const unsigned old = xb_add(&bar[XB_XSUB(b.x)], 1u);
        const unsigned gen = old / nloc;
        if (old + 1u == (gen + 1u) * nloc) {
            __builtin_amdgcn_fence(__ATOMIC_RELEASE, "agent");
            asm volatile("s_waitcnt vmcnt(0)" ::: "memory");
            const unsigned og = xb_add(&bar[XB_TOP], 1u);
            const unsigned tg = og / nx;
            if (og + 1u == (tg + 1u) * nx) xb_add(&bar[XB_TOPGEN], 1u);
            else XB_SPIN(xb_ld(&bar[XB_TOPGEN]) == tg, bar);
            __builtin_amdgcn_fence(__ATOMIC_ACQUIRE, "agent");
            xb_add(&bar[XB_XGEN(b.x)], 1u);
            asm volatile("s_waitcnt vmcnt(0)" ::: "memory");
        } else {
            XB_SPIN(xb_ld(&bar[XB_XGEN(b.x)]) == gen, bar);
            __builtin_amdgcn_fence(__ATOMIC_ACQUIRE, "agent");
            asm volatile("s_waitcnt vmcnt(0)" ::: "memory");
        }
    }
    __syncthreads();
}
__constant__ unsigned char T5_BUCKET[128] = {0, 1, 2, 3, 4, 5, 6, 7, 8, 9, 10, 11, 12, 13, 14, 15, 16, 16, 16, 17, 17, 18, 18, 18, 19, 19, 19, 20, 20, 20, 20, 21, 21, 21, 21, 22, 22, 22, 22, 22, 23, 23, 23, 23, 23, 23, 24, 24, 24, 24, 24, 24, 25, 25, 25, 25, 25, 25, 25, 26, 26, 26, 26, 26, 26, 26, 26, 27, 27, 27, 27, 27, 27, 27, 27, 27, 27, 28, 28, 28, 28, 28, 28, 28, 28, 28, 28, 29, 29, 29, 29, 29, 29, 29, 29, 29, 29, 29, 29, 30, 30, 30, 30, 30, 30, 30, 30, 30, 30, 30, 30, 30, 30, 31, 31, 31, 31, 31, 31, 31, 31, 31, 31, 31, 31, 31, 31, 31};
typedef short s16x4 __attribute__((ext_vector_type(4)));
typedef float f32x16 __attribute__((ext_vector_type(16)));
__device__ __forceinline__ float bf2f(unsigned short b) { return __builtin_bit_cast(float, (unsigned)b << 16); }
__device__ __forceinline__ bf16x8 cat4(s16x4 lo, s16x4 hi) { return __builtin_shufflevector(lo, hi, 0, 1, 2, 3, 4, 5, 6, 7); }
__device__ __forceinline__ void tr_read4(unsigned a0, unsigned a1, unsigned a2, unsigned a3, s16x4& r0, s16x4& r1, s16x4& r2, s16x4& r3) {
    asm volatile("ds_read_b64_tr_b16 %0, %4\n\tds_read_b64_tr_b16 %1, %5\n\tds_read_b64_tr_b16 %2, %6\n\tds_read_b64_tr_b16 %3, %7\n\ts_waitcnt lgkmcnt(0)"
                 : "=&v"(r0), "=&v"(r1), "=&v"(r2), "=&v"(r3) : "v"(a0), "v"(a1), "v"(a2), "v"(a3) : "memory");
}
#define SHX(x, o) __builtin_bit_cast(float, __builtin_amdgcn_ds_bpermute(((lane) ^ (o)) << 2, __builtin_bit_cast(int, (float)(x))))
#define SHXU(x, o) ((unsigned)__builtin_amdgcn_ds_bpermute(((lane) ^ (o)) << 2, (int)(x)))
__device__ __forceinline__ float wave_sum(float v, int lane) {
#pragma unroll
    for (int o = 1; o < 64; o <<= 1) v += SHX(v, o);
    return v;
}
template <int OUT8 = 0>
__device__ __forceinline__ void conv_item(const GAS float* W, int ldw, int k0, int c0, int nvalid, GAS bf16* dst, int dld, int drow0, int dk0, float scale, const GAS float* gain, LAS float* scr, int lane) {
    const int c = lane & 31;
    float vin[32];
#pragma unroll
    for (int i = 0; i < 32; ++i) { const int kk = 2 * i + (lane >> 5); vin[i] = 0.f;
        if (c < nvalid) vin[i] = W[(size_t)(k0 + kk) * ldw + c0 + c]; }
#pragma unroll
    for (int i = 0; i < 32; ++i) { const int kk = 2 * i + (lane >> 5); scr[kk * 33 + c] = vin[i] * scale; }
    LDS_WAIT(); asm volatile("" ::: "memory");
    const int c8 = lane & 7;
    f32x4 ga = {1.f, 1.f, 1.f, 1.f}, gb = {1.f, 1.f, 1.f, 1.f};
    if (gain) { ga = *(const GAS f32x4*)(gain + k0 + 8 * c8); gb = *(const GAS f32x4*)(gain + k0 + 8 * c8 + 4); }
#pragma unroll
    for (int j = 0; j < 4; ++j) { const int n = (lane >> 3) + 8 * j; const LAS float* s = scr + (8 * c8) * 33 + n;
        if constexpr (OUT8 == 2) { const unsigned p = pg8::pack4_i8(s[0 * 33] * ga.x, s[1 * 33] * ga.y, s[2 * 33] * ga.z, s[3 * 33] * ga.w, 1.0f), q = pg8::pack4_i8(s[4 * 33] * gb.x, s[5 * 33] * gb.y, s[6 * 33] * gb.z, s[7 * 33] * gb.w, 1.0f);
            *(GAS unsigned long long*)((GAS unsigned char*)dst + (size_t)(drow0 + n) * dld + dk0 + k0 + 8 * c8) = (unsigned long long)p | ((unsigned long long)q << 32); }
        else if constexpr (OUT8 == 1) { int p = 0, q = 0;
            p = __builtin_amdgcn_cvt_pk_fp8_f32(s[0 * 33] * ga.x, s[1 * 33] * ga.y, p, false); p = __builtin_amdgcn_cvt_pk_fp8_f32(s[2 * 33] * ga.z, s[3 * 33] * ga.w, p, true);
            q = __builtin_amdgcn_cvt_pk_fp8_f32(s[4 * 33] * gb.x, s[5 * 33] * gb.y, q, false); q = __builtin_amdgcn_cvt_pk_fp8_f32(s[6 * 33] * gb.z, s[7 * 33] * gb.w, q, true);
            *(GAS unsigned long long*)((GAS unsigned char*)dst + (size_t)(drow0 + n) * dld + dk0 + k0 + 8 * c8) = (unsigned long long)(unsigned)p | ((unsigned long long)(unsigned)q << 32); }
        else { v4u o; o.x = pk2(s[0 * 33] * ga.x, s[1 * 33] * ga.y); o.y = pk2(s[2 * 33] * ga.z, s[3 * 33] * ga.w); o.z = pk2(s[4 * 33] * gb.x, s[5 * 33] * gb.y); o.w = pk2(s[6 * 33] * gb.z, s[7 * 33] * gb.w);
            *(GAS v4u*)(dst + (size_t)(drow0 + n) * dld + dk0 + k0 + 8 * c8) = o; } }
    LDS_WAIT(); asm volatile("" ::: "memory");
}
__device__ __forceinline__ void rmsnorm_rows_bf16(const GAS float* X, const GAS float* g, GAS bf16* O, int gw, int NGW, int lane) {
    f32x4 gv[8];
#pragma unroll
    for (int j = 0; j < 8; ++j) gv[j] = ((const GAS f32x4*)g)[lane + 64 * j];
    for (int m = gw; m < M; m += NGW) {
        const GAS f32x4* xr = (const GAS f32x4*)(X + (size_t)m * D) + lane;
        f32x4 v[8]; float s = 0.f;
#pragma unroll
        for (int j = 0; j < 8; ++j) { v[j] = xr[64 * j]; s += (v[j].x * v[j].x + v[j].y * v[j].y) + (v[j].z * v[j].z + v[j].w * v[j].w); }
        const float r = 1.0f / sqrtf(wave_sum(s, lane) * (1.0f / D) + EPS);
        GAS unsigned long long* o8 = (GAS unsigned long long*)(O + (size_t)m * D) + lane;
#pragma unroll
        for (int j = 0; j < 8; ++j) { const f32x4 y = v[j] * r * gv[j]; o8[64 * j] = (unsigned long long)pk2(y.x, y.y) | ((unsigned long long)pk2(y.z, y.w) << 32); }
    }
}
__device__ __forceinline__ void rows_bf16_ss(const GAS float* X, GAS bf16* O, GAS unsigned char* O8, GAS float* ss, int gw, int NGW, int lane) {
    for (int m = gw; m < M; m += NGW) {
        const GAS f32x4* xr = (const GAS f32x4*)(X + (size_t)m * D) + lane;
        f32x4 v[8]; float s = 0.f;
#pragma unroll
        for (int j = 0; j < 8; ++j) { v[j] = xr[64 * j]; s += (v[j].x * v[j].x + v[j].y * v[j].y) + (v[j].z * v[j].z + v[j].w * v[j].w); }
        s = wave_sum(s, lane);
        GAS unsigned long long* o8 = (GAS unsigned long long*)(O + (size_t)m * D) + lane;
#pragma unroll
        for (int j = 0; j < 8; ++j) o8[64 * j] = (unsigned long long)pk2(v[j].x, v[j].y) | ((unsigned long long)pk2(v[j].z, v[j].w) << 32);
        if (O8) { GAS unsigned* q8 = (GAS unsigned*)(O8 + (size_t)m * D) + lane;
#pragma unroll
            for (int j = 0; j < 8; ++j) { if constexpr (GU_I8) q8[64 * j] = pg8::pack4_i8(v[j].x, v[j].y, v[j].z, v[j].w, H8I_SCALE); else { int p = 0; p = __builtin_amdgcn_cvt_pk_fp8_f32(v[j].x, v[j].y, p, false); p = __builtin_amdgcn_cvt_pk_fp8_f32(v[j].z, v[j].w, p, true); q8[64 * j] = (unsigned)p; } } }
        if (lane < 32) ss[(size_t)m * 32 + lane] = lane == 0 ? s : 0.f;
    }
}
__device__ __forceinline__ void final_rows(const GAS bf16* HB, GAS float* OUT, const GAS float* g, const GAS float* ss, int gw, int NGW, int lane) {
    f32x4 gv[8];
#pragma unroll
    for (int j = 0; j < 8; ++j) gv[j] = ((const GAS f32x4*)g)[lane + 64 * j];
    for (int m = gw; m < M; m += NGW) {
        const GAS unsigned long long* hr = (const GAS unsigned long long*)(HB + (size_t)m * D) + lane; GAS f32x4* orow = (GAS f32x4*)(OUT + (size_t)m * D) + lane;
        unsigned long long raw[8];
#pragma unroll
        for (int j = 0; j < 8; ++j) raw[j] = hr[64 * j];
        const float r = 1.0f / sqrtf(wave_sum(lane < 32 ? ss[(size_t)m * 32 + lane] : 0.f, lane) * (1.0f / D) + EPS);
#pragma unroll
        for (int j = 0; j < 8; ++j) { const unsigned lo = (unsigned)raw[j], hi = (unsigned)(raw[j] >> 32);
            f32x4 v = {__builtin_bit_cast(float, lo << 16), __builtin_bit_cast(float, lo & 0xffff0000u), __builtin_bit_cast(float, hi << 16), __builtin_bit_cast(float, hi & 0xffff0000u)};
            orow[64 * j] = v * r * gv[j]; }
    }
}
__device__ __forceinline__ void rmsnorm_rows_f32_inplace(GAS float* X, const GAS float* g, int gw, int NGW, int lane) {
    f32x4 gv[8];
#pragma unroll
    for (int j = 0; j < 8; ++j) gv[j] = ((const GAS f32x4*)g)[lane + 64 * j];
    for (int m = gw; m < M; m += NGW) {
        GAS f32x4* xr = (GAS f32x4*)(X + (size_t)m * D) + lane;
        f32x4 v[8]; float s = 0.f;
#pragma unroll
        for (int j = 0; j < 8; ++j) { v[j] = xr[64 * j]; s += (v[j].x * v[j].x + v[j].y * v[j].y) + (v[j].z * v[j].z + v[j].w * v[j].w); }
        const float r = 1.0f / sqrtf(wave_sum(s, lane) * (1.0f / D) + EPS);
#pragma unroll
        for (int j = 0; j < 8; ++j) xr[64 * j] = v[j] * r * gv[j];
    }
}

template <bool P_IFAST, int OUT8 = 0>
__device__ __forceinline__ void absorb_unit(const GAS float* Psrc, size_t p_ri, size_t p_rd, const GAS float* Qsrc, size_t q_rj, GAS bf16* out, size_t out_ld, float scale, const GAS float* qgain, LAS float* Ps_, LAS float* Qs_, int tid) {
    LAS bf16* Ps = (LAS bf16*)Ps_; LAS bf16* Qs = Ps + 64 * 136;
    float pv[16], qv[16];
#pragma unroll
    for (int j = 0; j < 16; ++j) { const int e = tid + 512 * j; const int i = P_IFAST ? (e & 63) : (e >> 7), d = P_IFAST ? (e >> 6) : (e & 127);
        pv[j] = Psrc[(size_t)i * p_ri + (size_t)d * p_rd];
        const int jj = e >> 7, dd = e & 127; qv[j] = Qsrc[(size_t)jj * q_rj + dd] * (qgain ? qgain[jj] : 1.0f); }
#pragma unroll
    for (int j = 0; j < 16; ++j) { const int e = tid + 512 * j; const int i = P_IFAST ? (e & 63) : (e >> 7), d = P_IFAST ? (e >> 6) : (e & 127);
        Ps[i * 136 + d] = (bf16)f2bf(pv[j]); const int jj = e >> 7, dd = e & 127; Qs[jj * 136 + dd] = (bf16)f2bf(qv[j]); }
    __syncthreads();
    const int wv = tid >> 6, ln = tid & 63, it = wv >> 1, r16 = ln & 15, g = ln >> 4;
#pragma unroll
    for (int jq = 0; jq < 2; ++jq) { const int jt = 2 * (wv & 1) + jq; f32x4 acc = {0.f, 0.f, 0.f, 0.f};
#pragma unroll
        for (int st = 0; st < 4; ++st) { const bf16x8 a = *(const LAS bf16x8*)(Ps + (16 * it + r16) * 136 + 32 * st + 8 * g); const bf16x8 b = *(const LAS bf16x8*)(Qs + (16 * jt + r16) * 136 + 32 * st + 8 * g);
            acc = __builtin_amdgcn_mfma_f32_16x16x32_bf16(a, b, acc, 0, 0, 0); }
#pragma unroll
        for (int rg = 0; rg < 4; ++rg) { const size_t o = (size_t)(16 * it + 4 * g + rg) * out_ld + 16 * jt + r16;
            if constexpr (OUT8 == 2) ((GAS unsigned char*)out)[o] = (unsigned char)(pg8::pack4_i8(acc[rg], 0.f, 0.f, 0.f, scale) & 0xffu);
            else if constexpr (OUT8 == 1) ((GAS unsigned char*)out)[o] = (unsigned char)__builtin_amdgcn_cvt_pk_fp8_f32(acc[rg] * scale, 0.f, 0, false);
            else out[o] = (bf16)f2bf(acc[rg] * scale); } }
    __syncthreads();
}
__device__ __forceinline__ void post_rows(const GAS bf16* Z, const GAS float* gkv, const GAS float* gki, const GAS float* bki, GAS bf16* CKVN, GAS bf16* KIN, GAS float* WIF, int gw, int NGW, int lane) {
    const f32x4 g4 = ((const GAS f32x4*)gkv)[lane]; const float gk = gki[lane], bk = bki[lane];
    for (int m = gw; m < M; m += NGW) {
        const GAS bf16* zr = Z + (size_t)m * ZLD;
        const unsigned long long raw = *(const GAS unsigned long long*)(zr + ZC_CKV + 4 * lane);
        const float kraw = bf2f(zr[ZC_KI + lane]);
        const float wraw = bf2f(zr[ZC_WI + (lane & 7)]);
        const float c0 = bf2f((unsigned short)raw), c1 = bf2f((unsigned short)(raw >> 16)), c2 = bf2f((unsigned short)(raw >> 32)), c3 = bf2f((unsigned short)(raw >> 48));
        const float r = 1.0f / sqrtf(wave_sum((c0 * c0 + c1 * c1) + (c2 * c2 + c3 * c3), lane) * (1.0f / RANK) + EPS);
        *(GAS unsigned long long*)(CKVN + (size_t)m * RANK + 4 * lane) = (unsigned long long)pk2(c0 * r * g4.x, c1 * r * g4.y) | ((unsigned long long)pk2(c2 * r * g4.z, c3 * r * g4.w) << 32);
        const float mu = wave_sum(kraw, lane) * (1.0f / IDIM); const float dv = kraw - mu;
        const float var = wave_sum(dv * dv, lane) * (1.0f / IDIM);
        KIN[(size_t)m * IDIM + lane] = (bf16)f2bf(dv * (1.0f / sqrtf(var + EPS)) * gk + bk);
        if (lane < 8) WIF[(size_t)m * IH + lane] = wraw;
    }
}
constexpr int SWA_KP = 144, SWA_VP = 192;
constexpr int SWA_K_OFF = 0, SWA_V_OFF = 160 * SWA_KP, SWA_TAB_OFF = SWA_V_OFF + 160 * SWA_VP;
static_assert(SWA_TAB_OFF + 16 * 128 * 4 <= RING_BYTES, "SWA LDS map");
__device__ __forceinline__ void swa_phase(LAS unsigned char* lds, const GAS bf16* Z, GAS bf16* O, const GAS float* rel_bias, const GAS float* sinks, int vcu, int G, int tid, int lane, int wave) {
    LAS float* tab = (LAS float*)(lds + SWA_TAB_OFF);
    for (int e = tid; e < 16 * 128; e += NWAVES * 64) { const int h = e >> 7, dist = e & 127; tab[e] = rel_bias[(int)T5_BUCKET[dist] * 24 + H_A + h]; }
    __syncthreads();
    const int q = lane & 31, hh = lane >> 5;
    const unsigned ldsb = (unsigned)(size_t)lds;
    for (int item = vcu; item < BATCH * 128 * KVH; item += G) {
        const int kvh = item & 1, qt = (item >> 1) & 127, b = item >> 8;
        const int t0 = 32 * qt, s0 = t0 - 128;
        const size_t rowbase = (size_t)b * SEQ;
        for (int c = tid; c < 1280; c += NWAVES * 64) { const int row = c >> 3, ch = c & 7; const int s = s0 + row;
            if (s >= 0) { const GAS bf16* zr = Z + (rowbase + s) * ZLD + kvh * 64 + ch * 8;
                const v4u kv = *(const GAS v4u*)(zr + ZC_KB); const v4u vv = *(const GAS v4u*)(zr + ZC_VB);
                *(LAS v4u*)(lds + SWA_K_OFF + row * SWA_KP + ch * 16) = kv; *(LAS v4u*)(lds + SWA_V_OFF + row * SWA_VP + ch * 16) = vv; } }
        const int hq = kvh * 8 + wave; const int t = t0 + q;
        bf16x8 qf[4];
#pragma unroll
        for (int st = 0; st < 4; ++st) qf[st] = *(const GAS bf16x8*)(Z + (rowbase + t) * ZLD + ZC_QB + hq * 64 + 16 * st + 8 * hh);
        __syncthreads();
        const int kt0 = qt >= 4 ? 0 : 4 - qt;
        f32x16 sacc[5];
#pragma unroll
        for (int kt = 0; kt < 5; ++kt) {
#pragma unroll
            for (int r = 0; r < 16; ++r) sacc[kt][r] = 0.f;
            if (kt >= kt0) {
#pragma unroll
                for (int st = 0; st < 4; ++st) { const bf16x8 kf = *(const LAS bf16x8*)(lds + SWA_K_OFF + (kt * 32 + q) * SWA_KP + (2 * st + hh) * 16);
                    sacc[kt] = __builtin_amdgcn_mfma_f32_32x32x16_bf16(kf, qf[st], sacc[kt], 0, 0, 0); } } }
        const float sink = sinks[hq]; float mx = sink;
        const LAS float* tabh = tab + hq * 128;
#pragma unroll
        for (int kt = 0; kt < 5; ++kt) if (kt >= kt0) {
#pragma unroll
            for (int r = 0; r < 16; ++r) { const int ko = (r & 3) + 8 * (r >> 2) + 4 * hh; const int dist = q + 128 - 32 * kt - ko;
                const float lg = (dist >= 0 && dist < WINDOW) ? sacc[kt][r] + tabh[dist & 127] : -1e30f; sacc[kt][r] = lg; mx = fmaxf(mx, lg); } }
        mx = fmaxf(mx, SHX(mx, 32));
        float l = 0.f;
#pragma unroll
        for (int kt = 0; kt < 5; ++kt) if (kt >= kt0) {
#pragma unroll
            for (int r = 0; r < 16; ++r) { const float p = __expf(sacc[kt][r] - mx); sacc[kt][r] = p; l += p; } }
        l += SHX(l, 32); l += __expf(sink - mx);
        f32x16 oacc[2];
#pragma unroll
        for (int dt = 0; dt < 2; ++dt)
#pragma unroll
            for (int r = 0; r < 16; ++r) oacc[dt][r] = 0.f;
        const unsigned vlane = ldsb + SWA_V_OFF + (unsigned)((4 * hh + ((lane & 15) >> 2)) * SWA_VP + (16 * ((lane >> 4) & 1) + 4 * (lane & 3)) * 2);
#pragma unroll
        for (int kt = 0; kt < 5; ++kt) if (kt >= kt0) {
#pragma unroll
            for (int s2 = 0; s2 < 2; ++s2) {
                bf16x8 pf; { const unsigned w0 = pg8::cvt_pk_bf16(sacc[kt][8 * s2 + 0], sacc[kt][8 * s2 + 1]), w1 = pg8::cvt_pk_bf16(sacc[kt][8 * s2 + 2], sacc[kt][8 * s2 + 3]),
                                     w2 = pg8::cvt_pk_bf16(sacc[kt][8 * s2 + 4], sacc[kt][8 * s2 + 5]), w3 = pg8::cvt_pk_bf16(sacc[kt][8 * s2 + 6], sacc[kt][8 * s2 + 7]);
                    const v4u w = {w0, w1, w2, w3}; pf = __builtin_bit_cast(bf16x8, w); }
                const unsigned a = vlane + (unsigned)((kt * 32 + 16 * s2) * SWA_VP);
                s16x4 r0, r1, r2, r3; tr_read4(a, a + 8 * SWA_VP, a + 64, a + 8 * SWA_VP + 64, r0, r1, r2, r3);
                oacc[0] = __builtin_amdgcn_mfma_f32_32x32x16_bf16(cat4(r0, r1), pf, oacc[0], 0, 0, 0);
                oacc[1] = __builtin_amdgcn_mfma_f32_32x32x16_bf16(cat4(r2, r3), pf, oacc[1], 0, 0, 0); } }
        const float inv = (OUT_F8 ? O8_SCALE : 1.0f) / l;
        if constexpr (OUT_F8) { GAS unsigned char* orow = (GAS unsigned char*)O + (rowbase + t) * OLD + 2048 + hq * 64 + 4 * hh;
#pragma unroll
            for (int dt = 0; dt < 2; ++dt)
#pragma unroll
                for (int g4 = 0; g4 < 4; ++g4) { int p = 0; p = __builtin_amdgcn_cvt_pk_fp8_f32(oacc[dt][4 * g4] * inv, oacc[dt][4 * g4 + 1] * inv, p, false); p = __builtin_amdgcn_cvt_pk_fp8_f32(oacc[dt][4 * g4 + 2] * inv, oacc[dt][4 * g4 + 3] * inv, p, true);
                    *(GAS unsigned*)(orow + 32 * dt + 8 * g4) = (unsigned)p; } }
        else { GAS bf16* orow = O + (rowbase + t) * OLD + 2048 + hq * 64 + 4 * hh;
#pragma unroll
        for (int dt = 0; dt < 2; ++dt)
#pragma unroll
            for (int g4 = 0; g4 < 4; ++g4) { const unsigned long long w = (unsigned long long)pk2(oacc[dt][4 * g4] * inv, oacc[dt][4 * g4 + 1] * inv) | ((unsigned long long)pk2(oacc[dt][4 * g4 + 2] * inv, oacc[dt][4 * g4 + 3] * inv) << 32);
                *(GAS unsigned long long*)(orow + 32 * dt + 8 * g4) = w; } }
        __syncthreads();
    }
}
constexpr int TK_BINS = 512, TK_CAP = 256;
#define LDS_ADD(p) __hip_atomic_fetch_add((p), 1u, __ATOMIC_RELAXED, __HIP_MEMORY_SCOPE_WORKGROUP)
#define LDS_ADDV(p, v) __hip_atomic_fetch_add((p), (v), __ATOMIC_RELAXED, __HIP_MEMORY_SCOPE_WORKGROUP)
#define HIST_WORD(tok, bin) (((tok) * TK_BINS + (bin)) >> 1)
#define HIST_INC(bin) (1u << (((bin) & 1) * 16))
constexpr int TK_HIST_OFF = 0, TK_CSC_OFF = 32768, TK_CIX_OFF = TK_CSC_OFF + 32 * TK_CAP * 4, TK_SEL_OFF = TK_CIX_OFF + 32 * TK_CAP * 2, TK_CNT_OFF = TK_SEL_OFF + 32 * 256 * 2, TK_DUM_OFF = TK_CNT_OFF + 32 * 2 * 4, TK_KB_OFF = TK_DUM_OFF + 8 * 64 * 4, TK_KB_BYTES = 64 * 144, TK_FLAG_OFF = TK_KB_OFF + 2 * TK_KB_BYTES;
static_assert(TK_FLAG_OFF + 16 <= RING_BYTES, "top-k LDS map");
typedef _Float16 tk_h2 __attribute__((ext_vector_type(2)));
__device__ __forceinline__ void tk_score2(const f32x16& acc, const tk_h2 (&wh)[8], float& s0, float& s1) {
    tk_h2 s = {(_Float16)0, (_Float16)0}; const tk_h2 zero = {(_Float16)0, (_Float16)0};
#pragma unroll
    for (int h = 0; h < 8; ++h) { tk_h2 d = __builtin_bit_cast(tk_h2, __builtin_amdgcn_cvt_pkrtz(acc[h], acc[8 + h])); d = __builtin_elementwise_max(d, zero); s = __builtin_elementwise_fma(wh[h], d, s); }
    s0 = (float)s.x; s1 = (float)s.y;
}
__device__ __forceinline__ float tk_x(float s, float sc) { return fmaf(s, sc, 256.0f); }
__device__ __forceinline__ int tk_key(float s, float sc) {
    const float x = tk_x(s, sc); int b0 = (int)x; b0 = b0 < 0 ? 0 : (b0 > TK_BINS - 1 ? TK_BINS - 1 : b0);
    int sub = (int)((x - (float)b0) * 512.0f); sub = sub < 0 ? 0 : (sub > 511 ? 511 : sub);
    return b0 * 512 + sub;
}
__device__ __forceinline__ void tk_find(const LAS unsigned* h, unsigned need, int lane, int& bin_out, unsigned& above_out) {
    unsigned v[8]; unsigned s = 0;
#pragma unroll
    for (int i = 0; i < 4; ++i) { const unsigned w = h[4 * lane + i]; v[2 * i] = w & 0xffffu; v[2 * i + 1] = w >> 16; s += v[2 * i] + v[2 * i + 1]; }
    unsigned S = s;
#pragma unroll
    for (int o = 1; o < 64; o <<= 1) { const unsigned t = (unsigned)__builtin_amdgcn_ds_bpermute((lane + o) << 2, (int)S); if (lane + o < 64) S += t; }
    const unsigned long long mask = __ballot(S >= need);
    const int Lm = mask ? 63 - __builtin_clzll(mask) : 0;
    unsigned cum = S - s; int bsel = 8 * lane; unsigned ab = cum; bool found = false;
#pragma unroll
    for (int i = 7; i >= 0; --i) { if (!found) { if (cum + v[i] >= need) { bsel = 8 * lane + i; ab = cum; found = true; } else cum += v[i]; } }
    bin_out = __builtin_amdgcn_readlane(bsel, Lm); above_out = (unsigned)__builtin_amdgcn_readlane((int)ab, Lm);
}
__device__ __forceinline__ void topk_phase(LAS unsigned char* lds, const GAS bf16* Z, const GAS bf16* KIN, const GAS float* WIF, GAS unsigned short* IDX, GAS unsigned long long* SCR, int vcu, int G, int lane, int wave) {
    LAS unsigned* hist = (LAS unsigned*)(lds + TK_HIST_OFF) + wave * 4 * (TK_BINS / 2);
    LAS float* csc = (LAS float*)(lds + TK_CSC_OFF) + wave * 4 * TK_CAP;
    LAS unsigned short* cix = (LAS unsigned short*)(lds + TK_CIX_OFF) + wave * 4 * TK_CAP;
    LAS unsigned short* sel = (LAS unsigned short*)(lds + TK_SEL_OFF) + wave * 4 * 256;
    LAS unsigned* cnt = (LAS unsigned*)(lds + TK_CNT_OFF) + wave * 8;
    LAS unsigned* dum = (LAS unsigned*)(lds + TK_DUM_OFF) + wave * 64 + lane;
    const int n = lane & 31, c = lane >> 5;
    const int am = (lane >> 4) & 1, bbm = (lane >> 3) & 1, ccm = (lane >> 2) & 1, dm = lane & 3;
    for (int p2 = vcu; p2 < BATCH * 64; p2 += G) {
#pragma unroll 1
        for (int half = 0; half < 2; ++half) {
            const int b = p2 >> 6, jj = p2 & 63, j = half ? 127 - jj : jj;
            const int t0 = 32 * j + 4 * wave; const size_t rb = (size_t)b * SEQ;
            bf16x8 qa[4];
#pragma unroll
            for (int st = 0; st < 4; ++st) qa[st] = *(const GAS bf16x8*)(Z + (rb + t0 + 2 * ccm + am) * ZLD + ZC_QI + (4 * bbm + dm) * 64 + 16 * st + 8 * c);
            float w0[8], w1[8];
            { const GAS f32x4* wp = (const GAS f32x4*)(WIF + (rb + t0 + 2 * c) * IH); const f32x4 x0 = wp[0], x1 = wp[1], x2 = wp[2], x3 = wp[3];
              w0[0] = x0.x; w0[1] = x0.y; w0[2] = x0.z; w0[3] = x0.w; w0[4] = x1.x; w0[5] = x1.y; w0[6] = x1.z; w0[7] = x1.w;
              w1[0] = x2.x; w1[1] = x2.y; w1[2] = x2.z; w1[3] = x2.w; w1[4] = x3.x; w1[5] = x3.y; w1[6] = x3.z; w1[7] = x3.w; }
            tk_h2 wh[8];
#pragma unroll
            for (int h = 0; h < 8; ++h) { wh[h].x = (_Float16)w0[h]; wh[h].y = (_Float16)w1[h]; }
            float scA, scB;
            { float a = 0.f, bq = 0.f;
#pragma unroll
              for (int h = 0; h < 8; ++h) { a = fmaf(w0[h], w0[h], a); bq = fmaf(w1[h], w1[h], bq); }
              scA = 32.0f / fmaxf(sqrtf(32.0f * a), 1e-20f); scB = 32.0f / fmaxf(sqrtf(32.0f * bq), 1e-20f); }
            const int tA = t0 + 2 * c, tB = tA + 1;
            for (int i = lane; i < 4 * (TK_BINS / 2); i += 64) hist[i] = 0u;
            for (int i = lane; i < 4 * 128; i += 64) ((LAS unsigned*)sel)[i] = 0u;
            if (lane < 8) cnt[lane] = 0u;
            asm volatile("s_waitcnt lgkmcnt(0)" ::: "memory");
            int lo[4], hi[4]; unsigned ab0[4]; bool ov[4];
#pragma unroll
            for (int tk = 0; tk < 4; ++tk) { lo[tk] = 0x7fffffff; hi[tk] = -1; ab0[tk] = 0u; ov[tk] = false; }
            const bool need_sel = (t0 + 3) >= TOPK;
            const GAS bf16* kbase = KIN + (rb + n) * IDIM + 8 * c;
            const int tidk = wave * 64 + lane; const int ng = (j + 2) >> 1;
            const GAS bf16* kg0 = KIN + (rb + (tidk >> 3)) * IDIM + (tidk & 7) * 8; const int koff = (tidk >> 3) * 144 + (tidk & 7) * 16;
            LAS unsigned char* kbuf = lds + TK_KB_OFF; volatile LAS unsigned* sflag = (volatile LAS unsigned*)(lds + TK_FLAG_OFF);
            if (tidk == 0) *sflag = 0u;
            GAS unsigned long long* scrw = SCR + (((size_t)b * SCR_GROUPS + (size_t)((j & 1) ? ((j + 1) >> 1) * ((j + 1) >> 1) : (j >> 1) * ((j >> 1) + 1))) * 8 + wave) * 64 + lane;
#define TK_PRIME() v4u kr = {0u, 0u, 0u, 0u}; { const v4u kr0 = *(const GAS v4u*)kg0; if (1 < ng) kr = *(const GAS v4u*)(kg0 + (size_t)64 * IDIM); *(LAS v4u*)(kbuf + koff) = kr0; } __syncthreads();
#define TK_GROUP_BEGIN() \
                  \
                if (g + 1 < ng) *(LAS v4u*)(kbuf + ((g + 1) & 1) * TK_KB_BYTES + koff) = kr; \
                  \
                if (g > 0) scrw[(g - 1) * 512] = (unsigned long long)pkw0 | ((unsigned long long)pkw1 << 32); \
                if (g + 2 < ng) kr = *(const GAS v4u*)(kg0 + (size_t)(g + 2) * 64 * IDIM); \
                const LAS unsigned char* kb_ = kbuf + (g & 1) * TK_KB_BYTES; \
                float s0v[2], s1v[2];     \
                { f32x16 accv[2]; \
                  _Pragma("unroll") for (int u4 = 0; u4 < 2; ++u4) { _Pragma("unroll") for (int r = 0; r < 16; ++r) accv[u4][r] = 0.f; \
                    _Pragma("unroll") for (int st = 0; st < 4; ++st) { const bf16x8 kf = *(const LAS bf16x8*)(kb_ + (32 * u4 + n) * 144 + (2 * st + c) * 16); accv[u4] = __builtin_amdgcn_mfma_f32_32x32x16_bf16(qa[st], kf, accv[u4], 0, 0, 0); } } \
                  _Pragma("unroll") for (int u4 = 0; u4 < 2; ++u4) tk_score2(accv[u4], wh, s0v[u4], s1v[u4]); } \
                _Pragma("unroll") for (int u4 = 0; u4 < 2; ++u4) { \
                    const float s0 = s0v[u4], s1 = s1v[u4]; const int s = 32 * (2 * g + u4) + n;
#define TK_GROUP_END() } \
                __syncthreads();
            bool slow = false;
            if (need_sel) {
                {   TK_PRIME(); unsigned pkw0 = 0u, pkw1 = 0u;
#pragma unroll 1
                    for (int g = 0; g < ng; ++g) { TK_GROUP_BEGIN()
                        int b0 = (int)tk_x(s0, scA), b1 = (int)tk_x(s1, scB); b0 = b0 < 0 ? 0 : (b0 > TK_BINS - 1 ? TK_BINS - 1 : b0); b1 = b1 < 0 ? 0 : (b1 > TK_BINS - 1 ? TK_BINS - 1 : b1);
                        LAS unsigned* p0 = (s <= tA) ? &hist[HIST_WORD(2 * c, b0)] : dum; LAS unsigned* p1 = (s <= tB) ? &hist[HIST_WORD(2 * c + 1, b1)] : dum;
                        LDS_ADDV(p0, HIST_INC(b0)); LDS_ADDV(p1, HIST_INC(b1));
                        { const unsigned w_ = __builtin_bit_cast(unsigned, __builtin_amdgcn_cvt_pkrtz(s0, s1)); if (u4 == 0) pkw0 = w_; else pkw1 = w_; }
                        TK_GROUP_END() }
                    scrw[(ng - 1) * 512] = (unsigned long long)pkw0 | ((unsigned long long)pkw1 << 32);
                }
                asm volatile("s_waitcnt lgkmcnt(0)" ::: "memory");
#pragma unroll
                for (int tk = 0; tk < 4; ++tk) { int bin; unsigned above; tk_find(hist + tk * (TK_BINS / 2), (unsigned)TOPK, lane, bin, above);
                    const unsigned ceq = (hist[HIST_WORD(tk, bin)] >> ((bin & 1) * 16)) & 0xffffu; ov[tk] = ceq > (unsigned)TK_CAP; slow |= ov[tk]; ab0[tk] = above; lo[tk] = bin * 512; hi[tk] = bin * 512 + 511; }
                if (slow && lane == 0) *sflag = 1u;
                __syncthreads();
                slow = *sflag != 0u;
            }
            if (!slow) {
                float thi[4], tlo[4];
#pragma unroll
                for (int tk = 0; tk < 4; ++tk) { const int bin = lo[tk] >> 9;
                    thi[tk] = !need_sel ? -__builtin_inff() : (bin >= TK_BINS - 1 ? __builtin_inff() : (float)(bin + 1));
                    tlo[tk] = !need_sel ? __builtin_inff() : (bin == 0 ? -__builtin_inff() : (float)bin); }
                const float thiA = c ? thi[2] : thi[0], tloA = c ? tlo[2] : tlo[0], thiB = c ? thi[3] : thi[1], tloB = c ? tlo[3] : tlo[1];
                unsigned cntA = 0u, cntB = 0u;
                LAS unsigned short* selA = sel + (2 * c) * 256; LAS unsigned short* selB = sel + (2 * c + 1) * 256; LAS unsigned short* dum16 = (LAS unsigned short*)dum;
                {   constexpr int U = 4; unsigned long long cw[U], nw[U];
#pragma unroll
                    for (int u = 0; u < U; ++u) cw[u] = (need_sel && u < ng) ? scrw[u * 512] : 0ull;
#pragma unroll 1
                    for (int gt = 0; gt < ng; gt += U) {
#pragma unroll
                        for (int u = 0; u < U; ++u) nw[u] = (need_sel && gt + U + u < ng) ? scrw[(gt + U + u) * 512] : 0ull;
#pragma unroll
                        for (int u = 0; u < 2 * U; ++u) { const int kt = 2 * gt + u; if (kt <= j) { const tk_h2 hh = __builtin_bit_cast(tk_h2, (unsigned)(cw[u >> 1] >> (32 * (u & 1)))); const float s0 = (float)hh.x, s1 = (float)hh.y; const int s = 32 * kt + n;
                    const float x0 = (s <= tA) ? tk_x(s0, scA) : __builtin_nanf(""), x1 = (s <= tB) ? tk_x(s1, scB) : __builtin_nanf("");
                    const bool a0 = x0 >= thiA, a1 = x1 >= thiB; const bool c0 = !a0 && x0 >= tloA, c1 = !a1 && x1 >= tloB;
                    const unsigned long long m0 = __ballot(a0), m1 = __ballot(a1);
                    const unsigned pre0 = c ? __builtin_amdgcn_mbcnt_hi((unsigned)(m0 >> 32), 0u) : __builtin_amdgcn_mbcnt_lo((unsigned)m0, 0u);
                    const unsigned pre1 = c ? __builtin_amdgcn_mbcnt_hi((unsigned)(m1 >> 32), 0u) : __builtin_amdgcn_mbcnt_lo((unsigned)m1, 0u);
                    const unsigned pos0 = cntA + pre0, pos1 = cntB + pre1;
                    LAS unsigned short* q0 = (a0 && pos0 < 256u) ? selA + pos0 : dum16; LAS unsigned short* q1 = (a1 && pos1 < 256u) ? selB + pos1 : dum16;
                    *q0 = (unsigned short)s; *q1 = (unsigned short)s;
                    cntA += c ? (unsigned)__builtin_popcount((unsigned)(m0 >> 32)) : (unsigned)__builtin_popcount((unsigned)m0);
                    cntB += c ? (unsigned)__builtin_popcount((unsigned)(m1 >> 32)) : (unsigned)__builtin_popcount((unsigned)m1);
                    if (__ballot(c0 || c1)) {
                        if (c0) { const unsigned pos = LDS_ADD(&cnt[(2 * c) * 2 + 1]); if (pos < (unsigned)TK_CAP) { csc[(2 * c) * TK_CAP + pos] = s0; cix[(2 * c) * TK_CAP + pos] = (unsigned short)s; } }
                        if (c1) { const unsigned pos = LDS_ADD(&cnt[(2 * c + 1) * 2 + 1]); if (pos < (unsigned)TK_CAP) { csc[(2 * c + 1) * TK_CAP + pos] = s1; cix[(2 * c + 1) * TK_CAP + pos] = (unsigned short)s; } } }
                        } }
#pragma unroll
                        for (int u = 0; u < U; ++u) cw[u] = nw[u];
                    } }
                if ((lane & 31) == 0) { cnt[(2 * c) * 2] = cntA; cnt[(2 * c + 1) * 2] = cntB; }
                asm volatile("s_waitcnt lgkmcnt(0)" ::: "memory");
            } else {
                for (int i = lane; i < 4 * (TK_BINS / 2); i += 64) hist[i] = 0u;
                asm volatile("s_waitcnt lgkmcnt(0)" ::: "memory");
                int mode = 1;
#pragma unroll 1
                for (;;) {
                const int klo0 = c ? lo[2] : lo[0], khi0 = c ? hi[2] : hi[0], klo1 = c ? lo[3] : lo[1], khi1 = c ? hi[3] : hi[1];
                const bool ov0 = c ? ov[2] : ov[0], ov1 = c ? ov[3] : ov[1];
                bf16x8 kb[4][4];
#pragma unroll
                for (int u4 = 0; u4 < 4; ++u4) { const int kq = u4 < j ? u4 : j;
#pragma unroll
                    for (int st = 0; st < 4; ++st) kb[u4][st] = *(const GAS bf16x8*)(kbase + (size_t)kq * 32 * IDIM + 16 * st); }
#pragma unroll 1
                for (int kt = 0; kt <= j; kt += 4) {
                    bf16x8 kn[4][4];
#pragma unroll
                    for (int u4 = 0; u4 < 4; ++u4) { const int kq = kt + 4 + u4 < j ? kt + 4 + u4 : j;
#pragma unroll
                        for (int st = 0; st < 4; ++st) kn[u4][st] = *(const GAS bf16x8*)(kbase + (size_t)kq * 32 * IDIM + 16 * st); }
#pragma unroll
                    for (int u4 = 0; u4 < 4; ++u4) {
                        f32x16 acc;
#pragma unroll
                        for (int r = 0; r < 16; ++r) acc[r] = 0.f;
#pragma unroll
                        for (int st = 0; st < 4; ++st) acc = __builtin_amdgcn_mfma_f32_32x32x16_bf16(qa[st], kb[u4][st], acc, 0, 0, 0);
                        float s0, s1; tk_score2(acc, wh, s0, s1);
                        const int s = 32 * (kt + u4) + n; const int k0 = tk_key(s0, scA), k1 = tk_key(s1, scB);
                        const bool v0 = s <= tA, v1 = s <= tB;
                        if (mode == 0) {
                            if (v0 && tA >= TOPK) LDS_ADDV(&hist[HIST_WORD(2 * c, k0 >> 9)], HIST_INC(k0 >> 9));
                            if (v1 && tB >= TOPK) LDS_ADDV(&hist[HIST_WORD(2 * c + 1, k1 >> 9)], HIST_INC(k1 >> 9));
                        } else if (mode == 1) {
                            if (v0 && ov0 && k0 >= klo0 && k0 <= khi0) LDS_ADDV(&hist[HIST_WORD(2 * c, k0 & 511)], HIST_INC(k0 & 511));
                            if (v1 && ov1 && k1 >= klo1 && k1 <= khi1) LDS_ADDV(&hist[HIST_WORD(2 * c + 1, k1 & 511)], HIST_INC(k1 & 511));
                        } else {
                            if (v0) { if (k0 > khi0) { const unsigned pos = LDS_ADD(&cnt[(2 * c) * 2]); if (pos < 256u) sel[(2 * c) * 256 + pos] = (unsigned short)s; }
                                      else if (k0 >= klo0) { const unsigned pos = LDS_ADD(&cnt[(2 * c) * 2 + 1]); if (pos < (unsigned)TK_CAP) { csc[(2 * c) * TK_CAP + pos] = s0; cix[(2 * c) * TK_CAP + pos] = (unsigned short)s; } } }
                            if (v1) { if (k1 > khi1) { const unsigned pos = LDS_ADD(&cnt[(2 * c + 1) * 2]); if (pos < 256u) sel[(2 * c + 1) * 256 + pos] = (unsigned short)s; }
                                      else if (k1 >= klo1) { const unsigned pos = LDS_ADD(&cnt[(2 * c + 1) * 2 + 1]); if (pos < (unsigned)TK_CAP) { csc[(2 * c + 1) * TK_CAP + pos] = s1; cix[(2 * c + 1) * TK_CAP + pos] = (unsigned short)s; } } }
                        }
                    }
#pragma unroll
                    for (int u4 = 0; u4 < 4; ++u4)
#pragma unroll
                        for (int st = 0; st < 4; ++st) kb[u4][st] = kn[u4][st];
                }
                    asm volatile("s_waitcnt lgkmcnt(0)" ::: "memory");
                    if (mode == 2) break;
#pragma unroll
                    for (int tk = 0; tk < 4; ++tk) if (ov[tk]) { int sub; unsigned above; tk_find(hist + tk * (TK_BINS / 2), (unsigned)TOPK - ab0[tk], lane, sub, above); lo[tk] += sub; hi[tk] = lo[tk]; }
                    mode = 2;
                }
            }
#undef TK_GROUP_BEGIN
#undef TK_GROUP_END
#undef TK_PRIME
#pragma unroll 1
            for (int tk = 0; tk < 4; ++tk) { const int t = t0 + tk;
                if (t >= TOPK) { const unsigned nsel = cnt[tk * 2]; unsigned nc = cnt[tk * 2 + 1]; nc = nc > (unsigned)TK_CAP ? (unsigned)TK_CAP : nc; const unsigned need = nsel < 256u ? 256u - nsel : 0u;
                    for (unsigned q = 0; q * 64 < nc; ++q) { const unsigned i = lane + 64 * q;
                        const float si = i < nc ? csc[tk * TK_CAP + i] : 0.f; const unsigned xi = i < nc ? cix[tk * TK_CAP + i] : 0u; unsigned rank = 0;
                        for (unsigned jx = 0; jx < nc; ++jx) { const float sj = csc[tk * TK_CAP + jx]; const unsigned xj = cix[tk * TK_CAP + jx]; rank += (sj > si || (sj == si && xj < xi)) ? 1u : 0u; }
                        if (i < nc && rank < need) sel[tk * 256 + nsel + rank] = (unsigned short)xi; } } }
            asm volatile("s_waitcnt lgkmcnt(0)" ::: "memory");
            { const LAS v4u* sv = (const LAS v4u*)sel; GAS v4u* ov = (GAS v4u*)(IDX + (rb + t0) * TOPK);
              ov[lane] = sv[lane]; ov[lane + 64] = sv[lane + 64]; }
            asm volatile("s_waitcnt vmcnt(0) lgkmcnt(0)" ::: "memory");
        }
    }
}
constexpr int DSA_TAB_OFF = RING_BYTES + 1024;
constexpr int DSA_IDX_OFF = DSA_TAB_OFF + 4224;
static_assert(8 * 129 * 4 <= 4224 && DSA_IDX_OFF + 8 * 1024 <= LDS_BYTES, "DSA LDS map");
__device__ __forceinline__ void dsa_phase(LAS unsigned char* lds_all, const GAS bf16* Z, const GAS bf16* CKVN, const GAS unsigned short* IDX, GAS bf16* O, const GAS float* rel_bias, int gw, int NGW, int tid, int lane, int wave) {
    LAS float* tab = (LAS float*)(lds_all + DSA_TAB_OFF);
    for (int e = tid; e < 8 * 129; e += NWAVES * 64) { const int hh = e / 129, dist = e - hh * 129; tab[e] = rel_bias[(dist < 128 ? (int)T5_BUCKET[dist] : 31) * 24 + hh]; }
    __syncthreads();
    LAS unsigned char* img = lds_all + RING_OFF + wave * 16384;
    LAS unsigned short* ib = (LAS unsigned short*)(lds_all + DSA_IDX_OFF + wave * 1024);
    const unsigned imgb = (unsigned)(size_t)img;
    const int h = lane & 15, g = lane >> 4, hi = lane >> 5;
    const LAS float* tabh = tab + (h & 7) * 129;
    const int TPW = (M + NGW - 1) / NGW;
    const int tok0 = gw * TPW;
    const int tok_end = (gw + 1) * TPW < M ? (gw + 1) * TPW : M;
    const int xq = 2 * (lane & 7);
    unsigned qa[8];
#pragma unroll
    for (int st = 0; st < 8; ++st) qa[st] = imgb + (unsigned)((lane & 15) * 512 + (((4 * st + g) ^ xq) * 16));
    const int q4 = (lane & 15) >> 2, p4 = lane & 3; const int xr = 2 * (4 * (g & 1) + q4);
    const unsigned pv_base = imgb + (unsigned)((4 * g + q4) * 512 + 8 * (p4 & 1));
    unsigned pva[16];
#pragma unroll
    for (int c2 = 0; c2 < 16; ++c2) pva[c2] = pv_base + (unsigned)((((2 * c2) ^ xr) | (p4 >> 1)) * 16);
    unsigned lc[4];
#pragma unroll
    for (int k = 0; k < 4; ++k) lc[k] = (unsigned)(((lane & 31) ^ (2 * ((2 * k + hi) & 7))) * 16);
    if (tok0 < tok_end) *(LAS unsigned long long*)(ib + 4 * lane) = *(const GAS unsigned long long*)(IDX + (size_t)tok0 * TOPK + 4 * lane);
#pragma unroll 1
    for (int tok = tok0; tok < tok_end; ++tok) {
        const int t = tok & (SEQ - 1); const size_t rb = (size_t)(tok - t);
        const int nsel = t + 1 < TOPK ? t + 1 : TOPK;
        const LAS unsigned short* cur = ib + ((tok - tok0) & 1) * 256;
        const unsigned long long nxi = tok + 1 < tok_end ? *(const GAS unsigned long long*)(IDX + (size_t)(tok + 1) * TOPK + 4 * lane) : 0ull;
        bf16x8 qf[8];
#pragma unroll
        for (int st = 0; st < 8; ++st) { qf[st] = *(const GAS bf16x8*)(Z + (size_t)tok * ZLD + ZC_QLAT + (h & 7) * 256 + 32 * st + 8 * g); if (h >= 8) qf[st] = (bf16x8){0, 0, 0, 0, 0, 0, 0, 0}; }
        f32x4 oacc[16];
#pragma unroll
        for (int rt = 0; rt < 16; ++rt) oacc[rt] = (f32x4){0.f, 0.f, 0.f, 0.f};
        float mrun = -1e30f, lsum = 0.f;
        const GAS unsigned char* cb = (const GAS unsigned char*)(CKVN + rb * RANK);
#pragma unroll
        for (int ch = 0; ch < 8; ++ch) {
            if (32 * ch >= nsel) break;
            unsigned rix[16];
#pragma unroll
            for (int i = 0; i < 16; ++i) rix[i] = cur[32 * ch + 2 * i + hi];
            const unsigned long long i0 = *(const LAS unsigned long long*)(cur + 32 * ch + 4 * g), i1 = *(const LAS unsigned long long*)(cur + 32 * ch + 16 + 4 * g);
            asm volatile("s_waitcnt lgkmcnt(0)" ::: "memory");
#pragma unroll
            for (int i = 0; i < 16; ++i) __builtin_amdgcn_global_load_lds((const GAS unsigned*)(cb + ((rix[i] << 9) + lc[i & 3])), (LAS unsigned*)(img + i * 1024), 16, 0, 0);
            asm volatile("s_waitcnt vmcnt(0)" ::: "memory");
            v4u fa[16];
            asm volatile("ds_read_b128 %0, %8\n\tds_read_b128 %1, %8 offset:8192\n\tds_read_b128 %2, %9\n\tds_read_b128 %3, %9 offset:8192\n\t"
                         "ds_read_b128 %4, %10\n\tds_read_b128 %5, %10 offset:8192\n\tds_read_b128 %6, %11\n\tds_read_b128 %7, %11 offset:8192"
                         : "=&v"(fa[0]), "=&v"(fa[1]), "=&v"(fa[2]), "=&v"(fa[3]), "=&v"(fa[4]), "=&v"(fa[5]), "=&v"(fa[6]), "=&v"(fa[7])
                         : "v"(qa[0]), "v"(qa[1]), "v"(qa[2]), "v"(qa[3]) : "memory");
            asm volatile("ds_read_b128 %0, %16\n\tds_read_b128 %1, %16 offset:8192\n\tds_read_b128 %2, %17\n\tds_read_b128 %3, %17 offset:8192\n\t"
                         "ds_read_b128 %4, %18\n\tds_read_b128 %5, %18 offset:8192\n\tds_read_b128 %6, %19\n\tds_read_b128 %7, %19 offset:8192\n\ts_waitcnt lgkmcnt(8)"
                         : "=&v"(fa[8]), "=&v"(fa[9]), "=&v"(fa[10]), "=&v"(fa[11]), "=&v"(fa[12]), "=&v"(fa[13]), "=&v"(fa[14]), "=&v"(fa[15]),
                           "+v"(fa[0]), "+v"(fa[1]), "+v"(fa[2]), "+v"(fa[3]), "+v"(fa[4]), "+v"(fa[5]), "+v"(fa[6]), "+v"(fa[7])
                         : "v"(qa[4]), "v"(qa[5]), "v"(qa[6]), "v"(qa[7]) : "memory");
            f32x4 sa[2] = {(f32x4){0.f, 0.f, 0.f, 0.f}, (f32x4){0.f, 0.f, 0.f, 0.f}};
#pragma unroll
            for (int st = 0; st < 4; ++st) { sa[0] = __builtin_amdgcn_mfma_f32_16x16x32_bf16(__builtin_bit_cast(bf16x8, fa[2 * st]), qf[st], sa[0], 0, 0, 0);
                sa[1] = __builtin_amdgcn_mfma_f32_16x16x32_bf16(__builtin_bit_cast(bf16x8, fa[2 * st + 1]), qf[st], sa[1], 0, 0, 0); }
            s16x4 pr[2][4];
            asm volatile("s_waitcnt lgkmcnt(0)\n\tds_read_b64_tr_b16 %0, %12\n\tds_read_b64_tr_b16 %1, %12 offset:8192\n\tds_read_b64_tr_b16 %2, %13\n\tds_read_b64_tr_b16 %3, %13 offset:8192"
                         : "=&v"(pr[0][0]), "=&v"(pr[0][1]), "=&v"(pr[0][2]), "=&v"(pr[0][3]),
                           "+v"(fa[8]), "+v"(fa[9]), "+v"(fa[10]), "+v"(fa[11]), "+v"(fa[12]), "+v"(fa[13]), "+v"(fa[14]), "+v"(fa[15])
                         : "v"(pva[0]), "v"(pva[1]) : "memory");
#pragma unroll
            for (int st = 4; st < 8; ++st) { sa[0] = __builtin_amdgcn_mfma_f32_16x16x32_bf16(__builtin_bit_cast(bf16x8, fa[2 * st]), qf[st], sa[0], 0, 0, 0);
                sa[1] = __builtin_amdgcn_mfma_f32_16x16x32_bf16(__builtin_bit_cast(bf16x8, fa[2 * st + 1]), qf[st], sa[1], 0, 0, 0); }
            float bz[8];
#pragma unroll
            for (int e = 0; e < 8; ++e) { const int tl = e >> 2, jx = e & 3; const int sidx = (int)(((tl ? i1 : i0) >> (16 * jx)) & 0xffffull); int dd = t - sidx; dd = dd < 0 ? 0 : (dd > 128 ? 128 : dd); bz[e] = tabh[dd]; }
            float lg[8]; float cmax = -1e30f;
#pragma unroll
            for (int e = 0; e < 8; ++e) { const int tl = e >> 2, jx = e & 3; const int kk = 32 * ch + 16 * tl + 4 * g + jx;
                const float v = kk < nsel ? sa[tl][jx] + bz[e] : -1e30f; lg[e] = v; cmax = fmaxf(cmax, v); }
            cmax = fmaxf(cmax, SHX(cmax, 16)); cmax = fmaxf(cmax, SHX(cmax, 32));
            const float mnew = fmaxf(mrun, cmax);
            if (__any(mnew > mrun)) { const float alpha = __expf(mrun - mnew); lsum *= alpha;
#pragma unroll
                for (int rt = 0; rt < 16; ++rt) oacc[rt] = oacc[rt] * alpha; }
            mrun = mnew;
            float pe[8];
#pragma unroll
            for (int e = 0; e < 8; ++e) { pe[e] = __expf(lg[e] - mnew); lsum += pe[e]; }
            bf16x8 pf; { const v4u wv = {pg8::cvt_pk_bf16(pe[0], pe[1]), pg8::cvt_pk_bf16(pe[2], pe[3]), pg8::cvt_pk_bf16(pe[4], pe[5]), pg8::cvt_pk_bf16(pe[6], pe[7])}; pf = __builtin_bit_cast(bf16x8, wv); }
#pragma unroll
            for (int j = 0; j < 8; ++j) {
                const int cs = j & 1, ns = cs ^ 1;
                if (j < 7) asm volatile("ds_read_b64_tr_b16 %0, %8\n\tds_read_b64_tr_b16 %1, %8 offset:8192\n\tds_read_b64_tr_b16 %2, %9\n\tds_read_b64_tr_b16 %3, %9 offset:8192\n\ts_waitcnt lgkmcnt(4)"
                                        : "=&v"(pr[ns][0]), "=&v"(pr[ns][1]), "=&v"(pr[ns][2]), "=&v"(pr[ns][3]), "+v"(pr[cs][0]), "+v"(pr[cs][1]), "+v"(pr[cs][2]), "+v"(pr[cs][3])
                                        : "v"(pva[2 * j + 2]), "v"(pva[2 * j + 3]) : "memory");
                else asm volatile("s_waitcnt lgkmcnt(0)" : "+v"(pr[cs][0]), "+v"(pr[cs][1]), "+v"(pr[cs][2]), "+v"(pr[cs][3]) :: "memory");
                oacc[2 * j] = __builtin_amdgcn_mfma_f32_16x16x32_bf16(cat4(pr[cs][0], pr[cs][1]), pf, oacc[2 * j], 0, 0, 0);
                oacc[2 * j + 1] = __builtin_amdgcn_mfma_f32_16x16x32_bf16(cat4(pr[cs][2], pr[cs][3]), pf, oacc[2 * j + 1], 0, 0, 0); }
        }
        if (tok + 1 < tok_end) *(LAS unsigned long long*)(ib + (((tok - tok0) & 1) ^ 1) * 256 + 4 * lane) = nxi;
        lsum += SHX(lsum, 16); lsum += SHX(lsum, 32);
        const float inv = (OUT_F8 ? O8_SCALE : 1.0f) / lsum;
        if (h < 8) {
            if constexpr (OUT_F8) { GAS unsigned char* orow = (GAS unsigned char*)O + (size_t)tok * OLD + h * 256 + 4 * g;
#pragma unroll
                for (int rt = 0; rt < 16; ++rt) { int p = 0; p = __builtin_amdgcn_cvt_pk_fp8_f32(oacc[rt][0] * inv, oacc[rt][1] * inv, p, false); p = __builtin_amdgcn_cvt_pk_fp8_f32(oacc[rt][2] * inv, oacc[rt][3] * inv, p, true); *(GAS unsigned*)(orow + 16 * rt) = (unsigned)p; } }
            else { GAS bf16* orow = O + (size_t)tok * OLD + h * 256 + 4 * g;
#pragma unroll
            for (int rt = 0; rt < 16; ++rt) *(GAS unsigned long long*)(orow + 16 * rt) = (unsigned long long)pk2(oacc[rt][0] * inv, oacc[rt][1] * inv) | ((unsigned long long)pk2(oacc[rt][2] * inv, oacc[rt][3] * inv) << 32); } }
    }
}
struct Args { const float* in[20]; float* out; unsigned char* ws; };
__device__ __forceinline__ unsigned long long karg_u64(int idx) { unsigned long long r; const unsigned off = (unsigned)idx * 8u;
    asm volatile("s_load_dwordx2 %0, %1, %2\n\ts_waitcnt lgkmcnt(0)" : "=s"(r) : "s"(__builtin_amdgcn_kernarg_segment_ptr()), "s"(off) : "memory"); return r; }
__device__ __forceinline__ const GAS float* karg_in(int i) { return (const GAS float*)karg_u64(i); }
__device__ __forceinline__ GAS float* karg_out() { return (GAS float*)karg_u64(20); }
__device__ __forceinline__ GAS unsigned char* karg_ws() { return (GAS unsigned char*)karg_u64(21); }
#ifndef REP_P0
#define REP_P0 1
#endif
#ifndef REP_NORM
#define REP_NORM 1
#endif
#ifndef REP_GU
#define REP_GU 1
#endif
#ifndef REP_IN
#define REP_IN 1
#endif
#ifndef REP_POST
#define REP_POST 1
#endif
#ifndef REP_TOPK
#define REP_TOPK 1
#endif
#ifndef REP_DSA
#define REP_DSA 1
#endif
#define REPEAT(n) _Pragma("unroll 1") for (int rep_ = 0; rep_ < (n); ++rep_)
#define PHASE_IDS() int wave = wave0; asm volatile("" : "+s"(wave)); int lane; asm volatile("v_mbcnt_lo_u32_b32 %0, -1, 0\n\tv_mbcnt_hi_u32_b32 %0, -1, %0" : "=v"(lane)); const int tid = wave * 64 + lane; int bx = blockIdx.x; asm volatile("" : "+s"(bx)); int G = gridDim.x; asm volatile("" : "+s"(G)); \
    const int vcu = (G % 8 == 0) ? (bx % 8) * (G / 8) + bx / 8 : bx; const int gw = vcu * NWAVES + wave, NGW = G * NWAVES; \
    GAS unsigned char* ws = karg_ws(); (void)lane; (void)gw; (void)NGW; (void)vcu; (void)ws
__global__ void __launch_bounds__(NWAVES * 64, 2) mk_fwd(Args args) {
    extern __shared__ __attribute__((aligned(16))) unsigned char lds_raw[];
    LAS unsigned char* lds = (LAS unsigned char*)lds_raw;
    volatile LAS unsigned* MISC = (volatile LAS unsigned*)(lds + MISC_OFF);
    const int wave0 = __builtin_amdgcn_readfirstlane(threadIdx.x >> 6);
    for (int u = threadIdx.x; u < (LDS_BYTES - LDSCTL_OFF) / 4; u += NWAVES * 64) ((LAS unsigned*)(lds + LDSCTL_OFF))[u] = 0u;
    __syncthreads();
    (void)xcd_barrier_post((unsigned*)((gu32*)(karg_ws() + WS_CTL) + CW_BAR), MISC + 8, threadIdx.x == 0);
#define GRID_BAR() do { XcdBarrier b_; b_.bar = (unsigned*)((gu32*)(karg_ws() + WS_CTL) + CW_BAR); b_.x = xb_xcc_id(); b_.st = MISC + 8; int w_ = wave0; asm volatile("" : "+s"(w_)); int l_; asm volatile("v_mbcnt_lo_u32_b32 %0, -1, 0\n\tv_mbcnt_hi_u32_b32 %0, -1, %0" : "=v"(l_)); xcd_barrier(b_, (w_ | l_) == 0); } while (0)

    REPEAT(REP_P0) {   PHASE_IDS();
        LAS float* scr = (LAS float*)(lds + RING_OFF + wave * 16384);
        rows_bf16_ss(karg_in(0), (GAS bf16*)(ws + WS_XN), f8_on(0, 0) ? (GAS unsigned char*)(ws + WS_HB8) : (GAS unsigned char*)nullptr, (GAS float*)(ws + WS_SS), gw, NGW, lane);
        constexpr int I_GU = (D / 64) * (FF / 32), I_DN = (FF / 64) * (D / 32);
        constexpr int I_FFN = 2 * I_GU + I_DN, I_IN = 72 * (D / 64), I_OB = (1024 / 64) * (D / 32);
        constexpr int PER_LAYER = 2 * I_FFN + I_IN + I_OB;
        for (int it = gw; it < DEPTH * PER_LAYER; it += NGW) {
            const int l = it / PER_LAYER; int r = it - l * PER_LAYER;
            GAS unsigned char* wl = ws + WS_W0 + (size_t)l * W_LAYER;
            if (r < 2 * I_FFN) {
                const int f = r / I_FFN; r -= f * I_FFN;
                GAS bf16* dgu = (GAS bf16*)(wl + (f ? WO_GU2 : WO_GU1)); GAS bf16* dd = (GAS bf16*)(wl + (f ? WO_D2 : WO_D1));
                if (r < 2 * I_GU) { const int up = r >= I_GU; if (up) r -= I_GU; const int kb = r / (FF / 32), nb = r % (FF / 32), n0 = 32 * nb;
                    const GAS float* wsrc = karg_in(up ? (f ? 17 : 4) : (f ? 16 : 3)) + (size_t)l * D * FF;
                    const int drow = (n0 >> 7) * 256 + (up ? 128 : 0) + (n0 & 127);
                    if (f8_on(l, f)) { if constexpr (GU_I8) conv_item<2>(wsrc, FF, 64 * kb, n0, 32, dgu, D, drow, 0, W8I_SCALE, karg_in(f ? 15 : 2) + (size_t)l * D, scr, lane); else conv_item<1>(wsrc, FF, 64 * kb, n0, 32, dgu, D, drow, 0, W8_SCALE, karg_in(f ? 15 : 2) + (size_t)l * D, scr, lane); }
                    else conv_item(wsrc, FF, 64 * kb, n0, 32, dgu, D, drow, 0, 1.0f, karg_in(f ? 15 : 2) + (size_t)l * D, scr, lane); }
                else { r -= 2 * I_GU; const int kb = r / (D / 32), nb = r % (D / 32);
                    if (d8_on(l, f)) conv_item<1>(karg_in(f ? 18 : 5) + (size_t)l * FF * D, D, 64 * kb, 32 * nb, 32, dd, FF, 32 * nb, 0, W8_SCALE, nullptr, scr, lane);
                    else conv_item(karg_in(f ? 18 : 5) + (size_t)l * FF * D, D, 64 * kb, 32 * nb, 32, dd, FF, 32 * nb, 0, 1.0f, nullptr, scr, lane); }
            } else if (r < 2 * I_FFN + I_IN) {
                r -= 2 * I_FFN; const int j = r >> 5, kb = r & 31; int src, nvalid = 32; float sc = 1.0f;
                if (j < 8) src = 1024 + 32 * j;
                else if (j < 40) src = 1864 + 32 * (j - 8);
                else if (j < 44) src = 2888 + 32 * (j - 40);
                else if (j < 48) src = 3016 + 32 * (j - 44);
                else if (j < 64) src = 1280 + 32 * (j - 48);
                else if (j < 66) src = 1792 + 32 * (j - 64);
                else if (j == 66) { src = 1856; nvalid = 8; sc = 0.044194173824159216f; }
                else { src = 0; nvalid = 0; }
                const GAS float* win = karg_in(7) + (size_t)l * D * D_IN; const GAS float* gmix = karg_in(6) + (size_t)l * D;
                if (IN_I8 && j < 48) conv_item<2>(win, D_IN, 64 * kb, src, nvalid, (GAS bf16*)(wl + WO_IN), D, 2048 + 32 * j, 0, W8I_SCALE, gmix, scr, lane);
                else if (IN_I8) conv_item(win, D_IN, 64 * kb, src, nvalid, (GAS bf16*)(wl + WO_IN + (size_t)ZN8 * D), D, 32 * (j - 48), 0, sc, gmix, scr, lane);
                else conv_item(win, D_IN, 64 * kb, src, nvalid, (GAS bf16*)(wl + WO_IN), D, 2048 + 32 * j, 0, (j >= 8 && j < 40) ? 0.125f : sc, gmix, scr, lane);
            } else {
                r -= 2 * I_FFN + I_IN; const int kb = r >> 6, nb = r & 63;
                if constexpr (OUT_F8) conv_item<1>(karg_in(14) + (size_t)l * D * D + (size_t)1024 * D, D, 64 * kb, 32 * nb, 32, (GAS bf16*)(wl + WO_OUT), OLD, 32 * nb, 2048, W8_SCALE, nullptr, scr, lane);
                else conv_item(karg_in(14) + (size_t)l * D * D + (size_t)1024 * D, D, 64 * kb, 32 * nb, 32, (GAS bf16*)(wl + WO_OUT), OLD, 32 * nb, 2048, 1.0f, nullptr, scr, lane);
            }
        }
        __syncthreads();
        LAS float* Ps = (LAS float*)(lds + RING_OFF); LAS float* Qs = Ps + 64 * 129;
        for (int u = vcu; u < DEPTH * 2048; u += G) {
            const int l = u >> 11, which = (u >> 10) & 1, v = u & 1023;
            GAS unsigned char* wl = ws + WS_W0 + (size_t)l * W_LAYER;
            if (which == 0) { const int h = v >> 7, rt = (v >> 5) & 3, kt = v & 31;
                if constexpr (IN_I8) absorb_unit<false, 2>(karg_in(11) + (size_t)l * RANK * 1024 + ((size_t)(64 * rt) * 8 + h) * 128, 1024, 1, karg_in(7) + (size_t)l * D * D_IN + (size_t)(64 * kt) * D_IN + h * 128, D_IN,
                                   (GAS bf16*)((GAS unsigned char*)(wl + WO_IN) + (size_t)(h * 256 + 64 * rt) * D + 64 * kt), D, WQ8I_SCALE, karg_in(6) + (size_t)l * D + 64 * kt, Ps, Qs, tid);
                else absorb_unit<false>(karg_in(11) + (size_t)l * RANK * 1024 + ((size_t)(64 * rt) * 8 + h) * 128, 1024, 1, karg_in(7) + (size_t)l * D * D_IN + (size_t)(64 * kt) * D_IN + h * 128, D_IN,
                                   (GAS bf16*)(wl + WO_IN) + (size_t)(h * 256 + 64 * rt) * D + 64 * kt, D, 0.08838834764831845f, karg_in(6) + (size_t)l * D + 64 * kt, Ps, Qs, tid); }
            else { const int h = v >> 7, nt = (v >> 2) & 31, rt = v & 3;
                if constexpr (OUT_F8) absorb_unit<true, 1>(karg_in(14) + (size_t)l * D * D + (size_t)(h * 128) * D + 64 * nt, 1, D, karg_in(12) + (size_t)l * RANK * 1024 + ((size_t)(64 * rt) * 8 + h) * 128, 1024,
                                  (GAS bf16*)((GAS unsigned char*)(wl + WO_OUT) + (size_t)(64 * nt) * OLD + h * 256 + 64 * rt), OLD, W8_SCALE, nullptr, Ps, Qs, tid);
                else absorb_unit<true>(karg_in(14) + (size_t)l * D * D + (size_t)(h * 128) * D + 64 * nt, 1, D, karg_in(12) + (size_t)l * RANK * 1024 + ((size_t)(64 * rt) * 8 + h) * 128, 1024,
                                  (GAS bf16*)(wl + WO_OUT) + (size_t)(64 * nt) * OLD + h * 256 + 64 * rt, OLD, 1.0f, nullptr, Ps, Qs, tid); }
        }
    }
    GRID_BAR();

#pragma unroll 1
    for (int s = 0; s < 2 * DEPTH; ++s) {
        const int l = s >> 1, f = s & 1;
        REPEAT(REP_GU) {   PHASE_IDS(); GAS unsigned char* wl = ws + WS_W0 + (size_t)l * W_LAYER;
            pg8::StaticOrder S; S.init(M, NGU, G, bx);
            const GAS float* ssp = (const GAS float*)(ws + WS_SS + (size_t)((3 * l + 2 * f) & 1) * SS_BYTES);
            if ((F8_MASK == 0xF) || (F8_MASK != 0 && f8_on(l, f))) {
                if constexpr (F8_MASK != 0) {
                    pg8::Gemm g{(const GAS bf16*)(ws + WS_HB8), (const GAS bf16*)(wl + (f ? WO_GU2 : WO_GU1)), M, NGU, D / 2};
                    if constexpr (GU_I8) { pg8::EpiSwiglu<true> E{(GAS bf16*)(ws + WS_ACT), FF, ssp, 1.0f / D, EPS, 1.0f / (H8I_SCALE * W8I_SCALE), d8_on(l, f) ? A8_SCALE : 0.f};
                        pg8::gemm_phase<pg8::EpiSwiglu<true>, pg8::StaticOrder, true, true, false, true>(lds + RING_OFF, g, S, E, tid); }
                    else { pg8::EpiSwiglu<false> E{(GAS bf16*)(ws + WS_ACT), FF, ssp, 1.0f / D, EPS, 1.0f / W8_SCALE, d8_on(l, f) ? A8_SCALE : 0.f};
                        pg8::gemm_phase<pg8::EpiSwiglu<false>, pg8::StaticOrder, true, true, true>(lds + RING_OFF, g, S, E, tid); } }
            } else {
                if constexpr (F8_MASK != 0xF) {
                    pg8::Gemm g{(const GAS bf16*)(ws + WS_XN), (const GAS bf16*)(wl + (f ? WO_GU2 : WO_GU1)), M, NGU, D};
                    pg8::EpiSwiglu<false> E{(GAS bf16*)(ws + WS_ACT), FF, ssp, 1.0f / D, EPS, 1.0f, d8_on(l, f) ? A8_SCALE : 0.f};
                    pg8::gemm_phase<pg8::EpiSwiglu<false>, pg8::StaticOrder, true, true, false>(lds + RING_OFF, g, S, E, tid); }
            } }
        GRID_BAR();
        {   PHASE_IDS(); GAS unsigned char* wl = ws + WS_W0 + (size_t)l * W_LAYER;
            pg8::StaticOrder S; S.init(M, D, G, bx);
            const unsigned sso = (unsigned)(WS_SS + (size_t)((3 * l + 2 * f + 1) & 1) * SS_BYTES), h8o = ((f == 0 && IN_I8) || (f == 1 && l + 1 < DEPTH && f8_on(l + 1, 0))) ? (unsigned)WS_HB8 : 0u;
            if ((D8_MASK == 0xF) || (D8_MASK != 0 && d8_on(l, f))) {
                if constexpr (D8_MASK != 0) {
                    pg8::Gemm g{(const GAS bf16*)(ws + WS_ACT), (const GAS bf16*)(wl + (f ? WO_D2 : WO_D1)), M, D, FF / 2};
                    pg8::EpiResid E{0.5f / (W8_SCALE * A8_SCALE), (unsigned)WS_XN, sso, h8o, GU_I8 ? H8I_SCALE : 0.f};
                    pg8::gemm_phase<pg8::EpiResid, pg8::StaticOrder, true, true, true>(lds + RING_OFF, g, S, E, tid); }
            } else {
                if constexpr (D8_MASK != 0xF) {
                    pg8::Gemm g{(const GAS bf16*)(ws + WS_ACT), (const GAS bf16*)(wl + (f ? WO_D2 : WO_D1)), M, D, FF};
                    pg8::EpiResid E{0.5f, (unsigned)WS_XN, sso, h8o, GU_I8 ? H8I_SCALE : 0.f};
                    pg8::gemm_phase<pg8::EpiResid, pg8::StaticOrder, true, true, false>(lds + RING_OFF, g, S, E, tid); }
            } }
        GRID_BAR();
        if (f == 0) {
            REPEAT(REP_IN) {   PHASE_IDS(); GAS unsigned char* wl = ws + WS_W0 + (size_t)l * W_LAYER;
                const GAS float* ssp = (const GAS float*)(ws + WS_SS + (size_t)((3 * l + 1) & 1) * SS_BYTES);
                if constexpr (IN_I8) {
                    {   pg8::Gemm g{(const GAS bf16*)(ws + WS_HB8), (const GAS bf16*)(wl + WO_IN), M, ZN8, D / 2}; pg8::StaticOrder S; S.init_split68(M, ZN8, G, bx);
                        pg8::EpiBf16<true> E{(GAS bf16*)(ws + WS_Z), ZLD, ssp, 1.0f / D, EPS, 0.08838834764831845f / (H8I_SCALE * WQ8I_SCALE), 1.0f / (H8I_SCALE * W8I_SCALE), 0.125f / (H8I_SCALE * W8I_SCALE)};
                        pg8::gemm_phase<pg8::EpiBf16<true>, pg8::StaticOrder, true, true, false, true>(lds + RING_OFF, g, S, E, tid); }
                    {   pg8::Gemm g{(const GAS bf16*)(ws + WS_XN), (const GAS bf16*)(wl + WO_IN + (size_t)ZN8 * D), M, ZLD - ZN8, D}; pg8::StaticOrder S; S.init(M, ZLD - ZN8, G, bx);
                        pg8::EpiBf16<false> E{(GAS bf16*)(ws + WS_Z) + ZN8, ZLD, ssp, 1.0f / D, EPS, 1.0f, 1.0f, 1.0f};
                        pg8::gemm_phase<pg8::EpiBf16<false>, pg8::StaticOrder, true, true, false, false>(lds + RING_OFF, g, S, E, tid); }
                } else {
                    pg8::Gemm g{(const GAS bf16*)(ws + WS_XN), (const GAS bf16*)(wl + WO_IN), M, ZLD, D}; pg8::StaticOrder S; S.init(M, ZLD, G, bx);
                    pg8::EpiBf16<false> E{(GAS bf16*)(ws + WS_Z), ZLD, ssp, 1.0f / D, EPS, 1.0f, 1.0f, 1.0f};
                    pg8::gemm_phase<pg8::EpiBf16<false>, pg8::StaticOrder, true, true, false, false>(lds + RING_OFF, g, S, E, tid); } }
            GRID_BAR();
            REPEAT(REP_POST) {   PHASE_IDS();
                post_rows((const GAS bf16*)(ws + WS_Z), karg_in(8) + (size_t)l * RANK, karg_in(9) + (size_t)l * IDIM, karg_in(10) + (size_t)l * IDIM, (GAS bf16*)(ws + WS_CKVN), (GAS bf16*)(ws + WS_KIN), (GAS float*)(ws + WS_WIF), gw, NGW, lane);
                swa_phase(lds + RING_OFF, (const GAS bf16*)(ws + WS_Z), (GAS bf16*)(ws + WS_O), karg_in(1), karg_in(13) + (size_t)l * H_B, vcu, G, tid, lane, wave);
            }
            GRID_BAR();
            REPEAT(REP_TOPK) {   PHASE_IDS(); topk_phase(lds + RING_OFF, (const GAS bf16*)(ws + WS_Z), (const GAS bf16*)(ws + WS_KIN), (const GAS float*)(ws + WS_WIF), (GAS unsigned short*)(ws + WS_IDX), (GAS unsigned long long*)(ws + WS_SCR), vcu, G, lane, wave); }
            GRID_BAR();
            REPEAT(REP_DSA) {   PHASE_IDS(); dsa_phase(lds, (const GAS bf16*)(ws + WS_Z), (const GAS bf16*)(ws + WS_CKVN), (const GAS unsigned short*)(ws + WS_IDX), (GAS bf16*)(ws + WS_O), karg_in(1), gw, NGW, tid, lane, wave); }
            GRID_BAR();
            {   PHASE_IDS(); GAS unsigned char* wl = ws + WS_W0 + (size_t)l * W_LAYER;
                pg8::Gemm g{(const GAS bf16*)(ws + WS_O), (const GAS bf16*)(wl + WO_OUT), M, D, OUT_F8 ? OLD / 2 : OLD}; pg8::StaticOrder S; S.init(M, D, G, bx);
                pg8::EpiResid E{OUT_F8 ? 1.0f / (W8_SCALE * O8_SCALE) : 1.0f, (unsigned)WS_XN, (unsigned)(WS_SS + (size_t)((3 * l + 2) & 1) * SS_BYTES), f8_on(l, 1) ? (unsigned)WS_HB8 : 0u, GU_I8 ? H8I_SCALE : 0.f};
                pg8::gemm_phase<pg8::EpiResid, pg8::StaticOrder, true, true, OUT_F8 != 0>(lds + RING_OFF, g, S, E, tid); }
            GRID_BAR();
        }
    }
    {   PHASE_IDS(); final_rows((const GAS bf16*)(ws + WS_XN), karg_out(), karg_in(19), (const GAS float*)(ws + WS_SS + (size_t)(6 & 1) * SS_BYTES), gw, NGW, lane); }
}

extern "C" void kernel_launch(void* const* d_in, const int* in_sizes, int n_in, void* d_out, int out_size, void* d_ws, size_t ws_size, hipStream_t stream) {
    static int grid = 0;
    if (grid == 0) {
        if (n_in != 20 || in_sizes[0] != M * D || out_size != M * D || ws_size < WS_END) { fprintf(stderr, "kernel_launch: unexpected shapes (n_in %d, in0 %d, out %d, ws %zu); nothing launched\n", n_in, n_in > 0 ? in_sizes[0] : -1, out_size, ws_size); grid = -1; return; }
        int dev = 0, cus = 0, per_cu = 0;
        if (hipGetDevice(&dev) != hipSuccess || hipDeviceGetAttribute(&cus, hipDeviceAttributeMultiprocessorCount, dev) != hipSuccess) { grid = -1; return; }
        if (hipFuncSetAttribute((const void*)mk_fwd, hipFuncAttributeMaxDynamicSharedMemorySize, LDS_BYTES) != hipSuccess) { fprintf(stderr, "kernel_launch: hipFuncSetAttribute failed\n"); grid = -1; return; }
        if (hipOccupancyMaxActiveBlocksPerMultiprocessor(&per_cu, (const void*)mk_fwd, NWAVES * 64, LDS_BYTES) != hipSuccess || per_cu < 1) { fprintf(stderr, "kernel_launch: occupancy query reports %d workgroups per CU\n", per_cu); }
        (void)hipGetLastError();
        grid = cus;
    }
    if (grid < 0) return;
    if (hipMemsetAsync((char*)d_ws + WS_CTL, 0, CTL_ZERO_BYTES, stream) != hipSuccess) return;
    Args a{};
    for (int i = 0; i < 20; ++i) a.in[i] = (const float*)d_in[i];
    a.out = (float*)d_out; a.ws = (unsigned char*)d_ws;
    hipLaunchKernelGGL(mk_fwd, dim3(grid), dim3(NWAVES * 64), LDS_BYTES, stream, a);
}
```
